# Optimizing an MI355X kernel written in HIP

```python
import jax, jax.numpy as jnp
from jax import lax
import numpy as np

D_MODEL = 1024
BATCH = 8
SEQ = 2048
DEPTH = 4

F32 = jnp.float32
CTX_LEN = 256
GRID_W = 64
N_EVEN = (DEPTH + 1) // 2
N_ODD = DEPTH // 2
RMS_EPS = 1e-6
NEG_BIG = -1e30
F_MIN = 1e-30

A_WIDTH = D_MODEL
A_HEADS = 8
A_BLOCK = A_WIDTH // A_HEADS
A_CONV = 4
A_C = 8.0
B_HEADS = 16
B_KV_HEADS = 4
B_HEAD_DIM = 64
B_GROUP = B_HEADS // B_KV_HEADS
B_WIDTH = B_HEADS * B_HEAD_DIM
B_KV_WIDTH = B_KV_HEADS * B_HEAD_DIM
WINDOW = 128
ROPE_BASE = 10000.0
ATTN_SCALE = B_HEAD_DIM ** -0.5
C_EXPAND = 128
C_HEADS = D_MODEL // C_EXPAND
C_FDIM = C_HEADS * C_EXPAND
C_VDIM = D_MODEL
C_HEAD_V = C_VDIM // C_HEADS
C_CHUNK = 64

EVEN_IN = 2 * A_WIDTH + 2 * B_WIDTH + 2 * B_KV_WIDTH
EVEN_MIX = A_WIDTH + B_WIDTH
ODD_IN = 3 * C_FDIM + 2 * C_VDIM

kernel_name = 'hybrid_rglru_swa_hgrn2_dit'


def rmsnorm(x, w):
    xf = x.astype(F32)
    y = xf * lax.rsqrt(jnp.mean(xf * xf, axis=-1, keepdims=True) + RMS_EPS)
    return (y * w.astype(F32)).astype(x.dtype)


def modulate(h, shift, scale):
    return h * (1 + scale) + shift


def axial_rope_tables(n_tokens):
    rows = n_tokens // GRID_W
    row = jnp.repeat(jnp.arange(rows), GRID_W).astype(F32)
    col = jnp.tile(jnp.arange(GRID_W), rows).astype(F32)
    axis_dim = B_HEAD_DIM // 2
    inv = ROPE_BASE ** (-jnp.arange(0, axis_dim, 2, dtype=F32) / axis_dim)
    ang = jnp.concatenate([row[:, None] * inv, col[:, None] * inv], axis=-1)
    return jnp.cos(ang), jnp.sin(ang)


def apply_axial_rope(t, cos, sin):
    c = cos[None, :, None, :].astype(t.dtype)
    s = sin[None, :, None, :].astype(t.dtype)
    t1, t2 = t[..., 0::2], t[..., 1::2]
    return jnp.stack([t1 * c - t2 * s, t1 * s + t2 * c], axis=-1).reshape(t.shape)


def centred_dwconv(x, w, b):
    L = x.shape[1]
    left = (A_CONV - 1) // 2
    xp = jnp.pad(x, ((0, 0), (left, A_CONV - 1 - left), (0, 0)))
    y = b
    for k in range(A_CONV):
        y = y + xp[:, k:k + L] * w[k]
    return y


def block_diag_linear(x, w, b):
    xb = x.reshape(x.shape[0], x.shape[1], A_HEADS, A_BLOCK)
    return jnp.einsum('blhi,hij->blhj', xb, w).reshape(x.shape) + b


def rglru_coeffs(u, wx, bx, wa, ba, lam):
    gate_x = jax.nn.sigmoid(block_diag_linear(u, wx, bx))
    gate_a = jax.nn.sigmoid(block_diag_linear(u, wa, ba))
    log_a = -A_C * gate_a * jax.nn.softplus(-lam.astype(F32))
    mult = jnp.sqrt(-jnp.expm1(2 * log_a))
    return jnp.exp(log_a), mult * gate_x * u


def linear_scan(a, b, h0, reverse):
    def combine(e1, e2):
        a1, b1 = e1
        a2, b2 = e2
        return a1 * a2, a2 * b1 + b2
    a_cum, b_cum = lax.associative_scan(combine, (a, b), reverse=reverse, axis=1)
    return b_cum + a_cum * h0[:, None, :]


def rglru_mixer(xa_ctx, xa_lat, conv_w, conv_b, wx, bx, wa, ba, lam, with_ctx):
    dt = xa_lat.dtype
    u_ctx = centred_dwconv(xa_ctx, conv_w, conv_b).astype(F32)
    u_lat = centred_dwconv(xa_lat, conv_w, conv_b).astype(F32)
    zeros = jnp.zeros((u_ctx.shape[0], A_WIDTH), F32)
    y_ctx, y_lat = [], []
    for d, rev in enumerate((False, True)):
        a_c, b_c = rglru_coeffs(u_ctx, wx[d], bx[d], wa[d], ba[d], lam[d])
        h_c = linear_scan(a_c, b_c, zeros, rev)
        h0 = h_c[:, 0] if rev else h_c[:, -1]
        a_l, b_l = rglru_coeffs(u_lat, wx[d], bx[d], wa[d], ba[d], lam[d])
        y_lat.append(linear_scan(a_l, b_l, h0, rev))
        if with_ctx:
            y_ctx.append(h_c)
    out_ctx = (y_ctx[0] + y_ctx[1]).astype(dt) if with_ctx else None
    return out_ctx, (y_lat[0] + y_lat[1]).astype(dt)


def latent_window_attention(q, k, v, k_ctx, v_ctx, sink):
    Bsz, S = q.shape[0], q.shape[1]
    nb = S // WINDOW
    qb = q.reshape(Bsz, nb, WINDOW, B_KV_HEADS, B_GROUP, B_HEAD_DIM)

    def band(t):
        tp = jnp.pad(t, ((0, 0), (WINDOW, WINDOW), (0, 0), (0, 0)))
        tp = tp.reshape(Bsz, nb + 2, WINDOW, B_KV_HEADS, B_HEAD_DIM)
        return jnp.concatenate([tp[:, :-2], tp[:, 1:-1], tp[:, 2:]], axis=2)

    kw, vw = band(k), band(v)
    s_win = jnp.einsum('bnqhgd,bnkhd->bnhgqk', qb, kw).astype(F32) * ATTN_SCALE
    blk = jnp.arange(nb)[:, None, None] * WINDOW
    q_pos = blk + jnp.arange(WINDOW)[None, :, None]
    k_pos = blk - WINDOW + jnp.arange(3 * WINDOW)[None, None, :]
    valid = (jnp.abs(q_pos - k_pos) <= WINDOW) & (k_pos >= 0) & (k_pos < S)
    s_win = jnp.where(valid[None, :, None, None], s_win, NEG_BIG)
    s_ctx = jnp.einsum('bnqhgd,bchd->bnhgqc', qb, k_ctx).astype(F32) * ATTN_SCALE
    snk = sink.astype(F32).reshape(1, 1, B_KV_HEADS, B_GROUP, 1, 1)
    m = jnp.maximum(jnp.maximum(s_win.max(-1, keepdims=True), s_ctx.max(-1, keepdims=True)), snk)
    p_win = jnp.exp(s_win - m)
    p_ctx = jnp.exp(s_ctx - m)
    denom = p_win.sum(-1, keepdims=True) + p_ctx.sum(-1, keepdims=True) + jnp.exp(snk - m)
    o = (jnp.einsum('bnhgqk,bnkhd->bnhgqd', p_win, vw.astype(F32))
         + jnp.einsum('bnhgqc,bchd->bnhgqd', p_ctx, v_ctx.astype(F32))) / denom
    return o.transpose(0, 1, 4, 2, 3, 5).reshape(Bsz, S, B_WIDTH).astype(q.dtype)


def context_attention(q, k, v, sink):
    Bsz, L = q.shape[0], q.shape[1]
    qc = q.reshape(Bsz, L, B_KV_HEADS, B_GROUP, B_HEAD_DIM)
    s = jnp.einsum('bqhgd,bkhd->bhgqk', qc, k).astype(F32) * ATTN_SCALE
    snk = jnp.broadcast_to(sink.astype(F32).reshape(1, B_KV_HEADS, B_GROUP, 1, 1), s.shape[:-1] + (1,))
    p = jax.nn.softmax(jnp.concatenate([s, snk], axis=-1), axis=-1)[..., :-1]
    o = jnp.einsum('bhgqk,bkhd->bqhgd', p, v.astype(F32))
    return o.reshape(Bsz, L, B_WIDTH).astype(q.dtype)


def even_mixer(u_ctx, u_lat, cos, sin, w_in, conv_w, conv_b, rg_wx, rg_bx, rg_wa, rg_ba, rg_lam,
               sink, w_out, with_ctx):
    n_state = A_WIDTH + 2 * B_KV_WIDTH
    p_lat = u_lat @ w_in
    p_ctx = u_ctx @ (w_in if with_ctx else w_in[:, :n_state])

    def kv(p):
        sh = p.shape[:2] + (B_KV_HEADS, B_HEAD_DIM)
        return (p[..., A_WIDTH:A_WIDTH + B_KV_WIDTH].reshape(sh),
                p[..., A_WIDTH + B_KV_WIDTH:n_state].reshape(sh))

    def gates_q(p):
        o = n_state
        ga = p[..., o:o + A_WIDTH]
        q = p[..., o + A_WIDTH:o + A_WIDTH + B_WIDTH].reshape(p.shape[:2] + (B_HEADS, B_HEAD_DIM))
        gb = p[..., o + A_WIDTH + B_WIDTH:]
        return ga, q, gb

    k_c, v_c = kv(p_ctx)
    k_l, v_l = kv(p_lat)
    ga_l, q_l, gb_l = gates_q(p_lat)
    q_l = apply_axial_rope(q_l, cos, sin)
    k_l = apply_axial_rope(k_l, cos, sin)
    ya_c, ya_l = rglru_mixer(p_ctx[..., :A_WIDTH], p_lat[..., :A_WIDTH], conv_w, conv_b,
                             rg_wx, rg_bx, rg_wa, rg_ba, rg_lam, with_ctx)
    yb_l = latent_window_attention(q_l, k_l, v_l, k_c, v_c, sink)
    out_l = jnp.concatenate([ya_l * jax.nn.silu(ga_l), yb_l * jax.nn.silu(gb_l)], axis=-1) @ w_out
    out_c = None
    if with_ctx:
        ga_c, q_c, gb_c = gates_q(p_ctx)
        yb_c = context_attention(q_c, k_c, v_c, sink)
        out_c = jnp.concatenate([ya_c * jax.nn.silu(ga_c), yb_c * jax.nn.silu(gb_c)], axis=-1) @ w_out
    return out_c, out_l


def gla_chunk_scan(q, k, g, v, s0):
    Bsz, L, H, _ = k.shape
    dv = v.shape[-1]
    n = L // C_CHUNK

    def chunks(t):
        return t.astype(F32).reshape(Bsz, n, C_CHUNK, H, t.shape[-1]).transpose(1, 0, 3, 2, 4)

    lower = jnp.tril(jnp.ones((C_CHUNK, C_CHUNK), dtype=bool))[:, :, None]

    def advance(S, kc, gc, vc):
        b = jnp.cumsum(gc, axis=2)
        b_last = b[:, :, -1:]
        S_new = (jnp.exp(b_last)[:, :, 0, :, None] * S
                 + jnp.einsum('bhsd,bhse->bhde', kc * jnp.exp(b_last - b), vc))
        return b, S_new

    if q is None:
        def step_state(S, inp):
            _, S_new = advance(S, *inp)
            return S_new, None
        s_fin, _ = lax.scan(step_state, s0, (chunks(k), chunks(g), chunks(v)))
        return None, s_fin

    def step(S, inp):
        qc, kc, gc, vc = inp
        b, S_new = advance(S, kc, gc, vc)
        decay = jnp.exp(jnp.where(lower, b[:, :, :, None] - b[:, :, None], NEG_BIG))
        attn = jnp.einsum('bhtd,bhsd,bhtsd->bhts', qc, kc, decay)
        o = (jnp.einsum('bhtd,bhde->bhte', qc * jnp.exp(b), S)
             + jnp.einsum('bhts,bhse->bhte', attn, vc))
        return S_new, o

    s_fin, o = lax.scan(step, s0, (chunks(q), chunks(k), chunks(g), chunks(v)))
    return o.transpose(1, 0, 3, 2, 4).reshape(Bsz, L, H, dv), s_fin


def maybe_flip(t, rev):
    return jnp.flip(t, axis=1) if rev else t


def odd_mixer(u_ctx, u_lat, w_in, lb, gnorm_w, w_out, with_ctx):
    dt = u_lat.dtype
    n_state = 2 * C_FDIM + C_VDIM
    p_lat = u_lat @ w_in
    p_ctx = u_ctx @ (w_in if with_ctx else w_in[:, :n_state])
    lb = lb.reshape(C_HEADS, C_EXPAND)

    def heads(t):
        return t.reshape(t.shape[0], t.shape[1], C_HEADS, -1)

    def forget(z):
        z = heads(z).astype(F32)
        f = lb + (1 - lb) * jax.nn.sigmoid(z)
        return (1 - lb) * jax.nn.sigmoid(-z), jnp.log(jnp.maximum(f, F_MIN))

    def state_parts(p):
        return p[..., :C_FDIM], p[..., C_FDIM:2 * C_FDIM], heads(p[..., 2 * C_FDIM:n_state])

    def out_parts(p):
        return jax.nn.silu(heads(p[..., n_state:n_state + C_FDIM])), p[..., n_state + C_FDIM:]

    ff_c, fb_c, v_c = state_parts(p_ctx)
    ff_l, fb_l, v_l = state_parts(p_lat)
    q_l, og_l = out_parts(p_lat)
    q_c, og_c = out_parts(p_ctx) if with_ctx else (None, None)
    zeros = jnp.zeros((u_lat.shape[0], C_HEADS, C_EXPAND, C_HEAD_V), F32)
    o_ctx, o_lat = [], []
    for f_c, f_l, rev in ((ff_c, ff_l, False), (fb_c, fb_l, True)):
        k_c, g_c = forget(f_c)
        k_l, g_l = forget(f_l)
        oc, s_c = gla_chunk_scan(maybe_flip(q_c, rev) if with_ctx else None, maybe_flip(k_c, rev),
                                 maybe_flip(g_c, rev), maybe_flip(v_c, rev), zeros)
        ol, _ = gla_chunk_scan(maybe_flip(q_l, rev), maybe_flip(k_l, rev), maybe_flip(g_l, rev),
                               maybe_flip(v_l, rev), s_c)
        o_lat.append(maybe_flip(ol, rev))
        if with_ctx:
            o_ctx.append(maybe_flip(oc, rev))

    def readout(o, og):
        y = rmsnorm(o, gnorm_w).reshape(o.shape[0], o.shape[1], C_VDIM) * jax.nn.silu(og.astype(F32))
        return y.astype(dt) @ w_out

    out_c = readout(o_ctx[0] + o_ctx[1], og_c) if with_ctx else None
    return out_c, readout(o_lat[0] + o_lat[1], og_l)


def setup_inputs(seed: int = 0) -> dict:
    key = jax.random.key(seed)
    ks = jax.random.split(key, 24)
    D = D_MODEL

    def nrm(k, shape, s):
        return jax.random.normal(k, shape, F32) * s

    u = jax.random.uniform(ks[14], (N_EVEN, 2, A_WIDTH), F32, 0.9, 0.999)
    sig = u ** (1.0 / A_C)
    return {
        'x': nrm(ks[0], (BATCH, SEQ, D), 1.0),
        'c': nrm(ks[1], (BATCH, D), 1.0),
        'ctx': nrm(ks[2], (BATCH, CTX_LEN, D), 1.0),
        'c_ctx': nrm(ks[3], (D,), 1.0),
        'ada_w': nrm(ks[4], (DEPTH, D, 3 * D), 0.5 * D ** -0.5),
        'ada_b': nrm(ks[5], (DEPTH, 3 * D), 0.02),
        'norm_w': 1.0 + nrm(ks[6], (DEPTH, D), 0.05),
        'ev_w_in': nrm(ks[7], (N_EVEN, D, EVEN_IN), D ** -0.5),
        'ev_conv_w': nrm(ks[8], (N_EVEN, A_CONV, A_WIDTH), A_CONV ** -0.5),
        'ev_conv_b': nrm(ks[9], (N_EVEN, A_WIDTH), 0.02),
        'ev_rg_wx': nrm(ks[10], (N_EVEN, 2, A_HEADS, A_BLOCK, A_BLOCK), A_BLOCK ** -0.5),
        'ev_rg_bx': nrm(ks[11], (N_EVEN, 2, A_WIDTH), 0.02),
        'ev_rg_wa': nrm(ks[12], (N_EVEN, 2, A_HEADS, A_BLOCK, A_BLOCK), A_BLOCK ** -0.5),
        'ev_rg_ba': nrm(ks[13], (N_EVEN, 2, A_WIDTH), 0.02),
        'ev_rg_lambda': jnp.log(sig) - jnp.log1p(-sig),
        'ev_sink': nrm(ks[15], (N_EVEN, B_HEADS), 0.5),
        'ev_w_out': nrm(ks[16], (N_EVEN, EVEN_MIX, D), EVEN_MIX ** -0.5),
        'od_w_in': nrm(ks[17], (N_ODD, D, ODD_IN), D ** -0.5),
        'od_lb_raw': nrm(ks[18], (N_ODD, C_FDIM), 1.0),
        'od_gnorm_w': 1.0 + nrm(ks[19], (N_ODD, C_HEAD_V), 0.05),
        'od_w_out': nrm(ks[20], (N_ODD, C_VDIM, D), C_VDIM ** -0.5),
        'final_norm_w': 1.0 + nrm(ks[21], (D,), 0.05),
    }


def reference(x, c, ctx, c_ctx, ada_w, ada_b, norm_w, ev_w_in, ev_conv_w, ev_conv_b, ev_rg_wx,
              ev_rg_bx, ev_rg_wa, ev_rg_ba, ev_rg_lambda, ev_sink, ev_w_out, od_w_in, od_lb_raw,
              od_gnorm_w, od_w_out, final_norm_w):
    D = D_MODEL
    cos, sin = axial_rope_tables(x.shape[1])
    silu_c = jax.nn.silu(c)
    silu_cc = jax.nn.silu(c_ctx)
    lb_p = jax.nn.softmax(od_lb_raw.astype(F32), axis=0)
    lower_bounds = jnp.cumsum(lb_p, axis=0) - lb_p[0]
    h_lat, h_ctx = x, ctx
    for layer in range(DEPTH):
        last = layer == DEPTH - 1
        j = layer // 2
        mod_l = silu_c @ ada_w[layer] + ada_b[layer]
        sh_l, sc_l, gt_l = jnp.split(mod_l[:, None, :], 3, axis=-1)
        n_mod = 2 * D if last else 3 * D
        mod_c = silu_cc @ ada_w[layer][:, :n_mod] + ada_b[layer][:n_mod]
        u_lat = modulate(rmsnorm(h_lat, norm_w[layer]), sh_l, sc_l)
        u_ctx = modulate(rmsnorm(h_ctx, norm_w[layer]), mod_c[:D], mod_c[D:2 * D])
        if layer % 2 == 0:
            m_ctx, m_lat = even_mixer(u_ctx, u_lat, cos, sin, ev_w_in[j], ev_conv_w[j], ev_conv_b[j],
                                      ev_rg_wx[j], ev_rg_bx[j], ev_rg_wa[j], ev_rg_ba[j],
                                      ev_rg_lambda[j], ev_sink[j], ev_w_out[j], not last)
        else:
            m_ctx, m_lat = odd_mixer(u_ctx, u_lat, od_w_in[j], lower_bounds[j], od_gnorm_w[j],
                                     od_w_out[j], not last)
        h_lat = h_lat + gt_l * m_lat
        if not last:
            h_ctx = h_ctx + mod_c[2 * D:] * m_ctx
    return rmsnorm(h_lat, final_norm_w)
```

```cpp
#include <hip/hip_runtime.h>
#include <hip/hip_cooperative_groups.h>
#include <cstdio>
#include <cstdint>
namespace cg = cooperative_groups;

#ifndef ONE_LAUNCH
#define ONE_LAUNCH 1
#endif

#define DI __device__ __forceinline__
#define LAS __attribute__((address_space(3)))
__device__ __forceinline__ int get_tid() { int t = threadIdx.x; asm volatile("" : "+v"(t)); return t; }
__device__ __forceinline__ int get_bid() { int b = blockIdx.x; asm volatile("" : "+s"(b)); return b; }
namespace pg8 {
#define PG8_LAS __attribute__((address_space(3)))
typedef unsigned short bf16_t;
typedef short bf16x8 __attribute__((ext_vector_type(8)));
typedef float f32x4 __attribute__((ext_vector_type(4)));
typedef unsigned u32x4 __attribute__((ext_vector_type(4)));
constexpr int BM = 256, BK = 64, HALF = 128, HTB = HALF * BK * 2  , STAGE_BYTES = 8 * HTB, NXCD = 8, WGM = 8;

__host__ __device__ __forceinline__ int lds_byte(int r, int c) { const int st = (r >> 4) * 2 + (c >> 5), rr = r & 15, cc = c & 31, ob = rr * 64 + cc * 2; return st * 1024 + (ob ^ (((ob >> 9) & 1) << 5)); }
__host__ __device__ __forceinline__ void stage_rc(int b, int& R, int& C) { const int st = b / 1024, sb = b % 1024, swz = sb ^ (((sb >> 9) & 1) << 5); R = (st >> 1) * 16 + swz / 64; C = (st & 1) * 32 + (swz % 64) / 2; }
__host__ __device__ __forceinline__ int perm32(int rho) { const int n = rho >> 4, i = rho & 15; return 8 * (i >> 2) + 4 * n + (i & 3); }

struct Unit { int pm, pn; };
struct Gemm { const bf16_t* A; const bf16_t* Bt; int M, N, K, lda; };

struct StaticOrder {
    int nM, nN, nwg, G, c;
    __host__ __device__ void init(int M, int N, int G_, int c_) { nM = M / BM; nN = N / BM; nwg = nM * nN; G = G_; c = c_; }
    __host__ __device__ bool next(int i, Unit& u) const {
        const long L = (long)i * G + c; if (L >= nwg) return false;
        int wgid = (int)L; { const int q = nwg / NXCD, r = nwg % NXCD, xcd = wgid % NXCD, off = wgid / NXCD; wgid = (xcd < r ? xcd * (q + 1) : r * (q + 1) + (xcd - r) * q) + off; }
        const int nig = WGM * nN, gid = wgid / nig, fm = gid * WGM, gsz = (nM - fm) < WGM ? (nM - fm) : WGM;
        u.pm = fm + ((wgid % nig) % gsz); u.pn = (wgid % nig) / gsz; return true;
    }
    __device__ __forceinline__ void a_ready(const Unit&) const {}
    __device__ __forceinline__ void done(const Unit&) const {}
};

template <class Epi, class Sched, bool ALIGN_EPI = false, bool SP2 = false>
__device__ __forceinline__ void gemm_phase(PG8_LAS unsigned char* lds, const Gemm g, const Sched& S, const Epi& E) {
    const int tid = get_tid(), wid = __builtin_amdgcn_readfirstlane(tid >> 6), lane = tid & 63, wr = wid >> 2, wc = wid & 3, fr = lane & 15, fq = lane >> 4;
    const int K = g.K, nt = K / BK;
    unsigned voffA[2], voffB[2];
#pragma unroll
    for (int i = 0; i < 2; ++i) { int R, C; stage_rc(tid * 16 + i * 8192, R, C); const int Rb = Epi::PERM ? ((R & ~31) + perm32(R & 31)) : R;
        voffA[i] = (unsigned)(R * g.lda + C) * 2u; voffB[i] = (unsigned)(Rb * K + C) * 2u; }
    const size_t kstep = (size_t)(BK * 2);
    const size_t hstepA = (size_t)HALF * g.lda * 2, hstepB = (size_t)HALF * K * 2;
    const size_t tstepA = 2 * hstepA, tstepB = 2 * hstepB;
    const unsigned ldsw = (unsigned)wid * 1024u;
    const int aoff = lds_byte(wr * 64 + fr, fq * 8), boff = lds_byte(wc * 32 + fr, fq * 8);
#define PG8_SA(b, h) (((b) * 2 + (h)) * HTB)
#define PG8_SB(b, h) ((4 + (b) * 2 + (h)) * HTB)
#define PG8_STAGE(bufoff, gbase, voff) do { _Pragma("unroll") for (int _i = 0; _i < 2; ++_i) \
        __builtin_amdgcn_global_load_lds((const unsigned*)((const char*)(gbase) + (voff)[_i]), (PG8_LAS unsigned*)(lds + (bufoff) + ldsw + _i * 8192), 16, 0, 0); } while (0)
#define PG8_LDA(dst, b, h) do { _Pragma("unroll") for (int m = 0; m < 4; ++m) _Pragma("unroll") for (int k = 0; k < 2; ++k) dst[m][k] = *(const PG8_LAS bf16x8*)(lds + PG8_SA(b, h) + aoff + m * 2048 + k * 1024); } while (0)
#define PG8_LDB(dst, b, h) do { _Pragma("unroll") for (int n = 0; n < 2; ++n) _Pragma("unroll") for (int k = 0; k < 2; ++k) dst[n][k] = *(const PG8_LAS bf16x8*)(lds + PG8_SB(b, h) + boff + n * 2048 + k * 1024); } while (0)
#define PG8_MMA(ai, bj, At, Bt) do { __builtin_amdgcn_s_setprio(1); _Pragma("unroll") for (int m = 0; m < 4; ++m) _Pragma("unroll") for (int n = 0; n < 2; ++n) _Pragma("unroll") for (int k = 0; k < 2; ++k) \
        acc[ai][bj][m][n] = __builtin_amdgcn_mfma_f32_16x16x32_bf16(Bt[n][k], At[m][k], acc[ai][bj][m][n], 0, 0, 0); __builtin_amdgcn_s_setprio(0); } while (0)
#define PG8_WAIT_V(n) asm volatile("s_waitcnt vmcnt(" #n ")" ::: "memory")
#define PG8_WAIT_L(n) asm volatile("s_waitcnt lgkmcnt(" #n ")" ::: "memory")
#define PG8_BAR __builtin_amdgcn_s_barrier()
#define PG8_SCHED __builtin_amdgcn_sched_barrier(0)
    Unit cur, nxt; int ui = 0;
    if (!S.next(0, cur)) return;
    f32x4 acc[2][2][4][2];
#pragma unroll
    for (int a = 0; a < 2; ++a)
#pragma unroll
        for (int b = 0; b < 2; ++b)
#pragma unroll
            for (int m = 0; m < 4; ++m)
#pragma unroll
                for (int n = 0; n < 2; ++n) acc[a][b][m][n] = (f32x4){0.f, 0.f, 0.f, 0.f};
    bf16x8 At[4][2], B0[2][2], B1[2][2];
    const char* cA = (const char*)g.A + (size_t)cur.pm * tstepA; const char* cB = (const char*)g.Bt + (size_t)cur.pn * tstepB;
    S.a_ready(cur);
    if constexpr (SP2) {
        PG8_STAGE(PG8_SB(0, 0), cB, voffB); PG8_STAGE(PG8_SB(0, 1), cB + hstepB, voffB); PG8_STAGE(PG8_SA(0, 0), cA, voffA); PG8_STAGE(PG8_SA(0, 1), cA + hstepA, voffA);
        if (wr == 1) PG8_BAR;
        PG8_WAIT_V(2); PG8_BAR;
        PG8_STAGE(PG8_SB(1, 0), cB + kstep, voffB); PG8_STAGE(PG8_SA(1, 0), cA + kstep, voffA); PG8_STAGE(PG8_SB(1, 1), cB + hstepB + kstep, voffB);
        PG8_WAIT_V(6); PG8_BAR;
    } else {
        PG8_STAGE(PG8_SB(0, 0), cB, voffB); PG8_STAGE(PG8_SA(0, 0), cA, voffA); PG8_STAGE(PG8_SB(0, 1), cB + hstepB, voffB); PG8_STAGE(PG8_SA(0, 1), cA + hstepA, voffA);
        if (wr == 1) PG8_BAR;
        PG8_WAIT_V(4); PG8_BAR;
        PG8_STAGE(PG8_SB(1, 0), cB + kstep, voffB); PG8_STAGE(PG8_SA(1, 0), cA + kstep, voffA); PG8_STAGE(PG8_SB(1, 1), cB + hstepB + kstep, voffB);
        PG8_WAIT_V(6); PG8_BAR;
    }
    for (;;) {
        const bool has_next = S.next(ui + 1, nxt);
        const char* nA = has_next ? (const char*)g.A + (size_t)nxt.pm * tstepA : cA; const char* nB = has_next ? (const char*)g.Bt + (size_t)nxt.pn * tstepB : cB;
        for (int t = 0; t < nt; t += 2) {
            const bool last = (t == nt - 2);
            const char* a1 = cA + (size_t)(t + 1) * kstep;
            const char* a2 = last ? nA : cA + (size_t)(t + 2) * kstep; const char* b2 = last ? nB : cB + (size_t)(t + 2) * kstep;
            const char* a3 = a2 + kstep; const char* b3 = b2 + kstep;
            if (last && has_next) S.a_ready(nxt);
            if constexpr (SP2) {
            PG8_LDB(B0, 0, 0); PG8_LDB(B1, 0, 1); PG8_SCHED; PG8_LDA(At, 0, 0); PG8_STAGE(PG8_SA(1, 1), a1 + hstepA, voffA);
            PG8_WAIT_V(8); PG8_WAIT_L(0); PG8_BAR; PG8_MMA(0, 0, At, B0); PG8_MMA(0, 1, At, B1); PG8_BAR; PG8_SCHED;
            PG8_LDA(At, 0, 1); PG8_STAGE(PG8_SB(0, 0), b2, voffB); PG8_STAGE(PG8_SB(0, 1), b2 + hstepB, voffB); PG8_STAGE(PG8_SA(0, 0), a2, voffA);
            PG8_WAIT_V(8); PG8_WAIT_L(0); PG8_BAR; PG8_MMA(1, 0, At, B0); PG8_MMA(1, 1, At, B1); PG8_BAR; PG8_SCHED;
            PG8_LDB(B0, 1, 0); PG8_LDB(B1, 1, 1); PG8_SCHED; PG8_LDA(At, 1, 0); PG8_STAGE(PG8_SA(0, 1), a2 + hstepA, voffA);
            PG8_WAIT_V(8); PG8_WAIT_L(0); PG8_BAR; PG8_MMA(0, 0, At, B0); PG8_MMA(0, 1, At, B1); PG8_BAR; PG8_SCHED;
            PG8_LDA(At, 1, 1); PG8_STAGE(PG8_SB(1, 0), b3, voffB); PG8_STAGE(PG8_SB(1, 1), b3 + hstepB, voffB); PG8_STAGE(PG8_SA(1, 0), a3, voffA);
            PG8_WAIT_V(8); PG8_WAIT_L(0); PG8_BAR; PG8_MMA(1, 0, At, B0); PG8_MMA(1, 1, At, B1); PG8_BAR; PG8_SCHED;
            } else {
            PG8_LDB(B0, 0, 0); PG8_SCHED; PG8_LDA(At, 0, 0); PG8_STAGE(PG8_SA(1, 1), a1 + hstepA, voffA);
            PG8_WAIT_L(8); PG8_BAR; PG8_WAIT_L(0); PG8_MMA(0, 0, At, B0); PG8_BAR; PG8_SCHED;
            PG8_LDB(B1, 0, 1); PG8_STAGE(PG8_SB(0, 0), b2, voffB);
            PG8_BAR; PG8_WAIT_L(0); PG8_MMA(0, 1, At, B1); PG8_BAR;
            PG8_LDA(At, 0, 1); PG8_STAGE(PG8_SA(0, 0), a2, voffA);
            PG8_BAR; PG8_WAIT_L(0); PG8_MMA(1, 0, At, B0); PG8_BAR; PG8_SCHED;
            PG8_STAGE(PG8_SB(0, 1), b2 + hstepB, voffB);
            PG8_WAIT_V(6); PG8_BAR; PG8_MMA(1, 1, At, B1); PG8_BAR;
            PG8_LDB(B0, 1, 0); PG8_SCHED; PG8_LDA(At, 1, 0); PG8_STAGE(PG8_SA(0, 1), a2 + hstepA, voffA);
            PG8_WAIT_L(8); PG8_BAR; PG8_WAIT_L(0); PG8_MMA(0, 0, At, B0); PG8_BAR; PG8_SCHED;
            PG8_LDB(B1, 1, 1); PG8_STAGE(PG8_SB(1, 0), b3, voffB);
            PG8_BAR; PG8_WAIT_L(0); PG8_MMA(0, 1, At, B1); PG8_BAR;
            PG8_LDA(At, 1, 1); PG8_STAGE(PG8_SA(1, 0), a3, voffA);
            PG8_BAR; PG8_WAIT_L(0); PG8_MMA(1, 0, At, B0); PG8_BAR; PG8_SCHED;
            PG8_STAGE(PG8_SB(1, 1), b3 + hstepB, voffB);
            PG8_WAIT_V(6); PG8_BAR; PG8_MMA(1, 1, At, B1); PG8_BAR;
            }
        }
        if constexpr (ALIGN_EPI) { if (wr == 0) PG8_BAR; }
        if constexpr (!Epi::AFTER_DRAIN) { E(acc, cur, wr, wc, fr, fq); S.done(cur); }
        if (!has_next) break;
#pragma unroll
        for (int a = 0; a < 2; ++a)
#pragma unroll
            for (int b = 0; b < 2; ++b)
#pragma unroll
                for (int m = 0; m < 4; ++m)
#pragma unroll
                    for (int n = 0; n < 2; ++n) acc[a][b][m][n] = (f32x4){0.f, 0.f, 0.f, 0.f};
        cur = nxt; cA = nA; cB = nB; ++ui;
        if constexpr (ALIGN_EPI) { if (wr == 1) PG8_BAR; }
    }
    PG8_WAIT_V(0);
    if constexpr (!ALIGN_EPI) { if (wr == 0) PG8_BAR; }
    PG8_BAR;
    if constexpr (Epi::AFTER_DRAIN) { E.fused(acc, cur, wr, wc, fr, fq, lds, wid, lane); S.done(cur); }
#undef PG8_SA
#undef PG8_SB
#undef PG8_STAGE
#undef PG8_LDA
#undef PG8_LDB
#undef PG8_MMA
#undef PG8_WAIT_V
#undef PG8_WAIT_L
#undef PG8_BAR
#undef PG8_SCHED
}
}

typedef unsigned short bf16_t;
typedef short bf16x8 __attribute__((ext_vector_type(8)));
typedef short s16x4 __attribute__((ext_vector_type(4)));
typedef float f32x4 __attribute__((ext_vector_type(4)));
typedef float f32x16 __attribute__((ext_vector_type(16)));
typedef unsigned u32x4 __attribute__((ext_vector_type(4)));
typedef unsigned u32x2 __attribute__((ext_vector_type(2)));

constexpr int DM = 1024, NB = 8, SEQ = 2048, CTXL = 256, LT = SEQ + CTXL  , MROWS = NB * LT  ;
constexpr int EVEN_IN = 4608, ODD_IN = 5120, NCHUNK = LT / 64  ;
constexpr float RMS_EPS = 1e-6f, LOG2E = 1.4426950408889634f;
constexpr int LDS_BYTES = 160 * 1024;
constexpr int NPHASE = 22;

constexpr size_t WS_CTL = 0;
constexpr size_t WS_MOD = 65536;
constexpr size_t WS_ROPE = 524288;
constexpr size_t WS_AGG = 1048576;
constexpr size_t WS_HCTX = WS_AGG + 4718592;
constexpr size_t WS_WIN = WS_HCTX + 8388608;
constexpr size_t WS_WOUT = WS_WIN + 10485760;
constexpr size_t WS_WRG = WS_WOUT + 4194304;
constexpr size_t WS_OV = WS_WRG + 1048576;
constexpr size_t WS_P = WS_OV + 37748736;
constexpr size_t WS_END = WS_P + 188743680;
static_assert(WS_END <= 268435456, "workspace map exceeds 256 MiB");

struct Params {
    const float *x, *c, *ctx, *c_ctx, *ada_w, *ada_b, *norm_w, *ev_w_in, *ev_conv_w, *ev_conv_b, *ev_rg_wx, *ev_rg_bx, *ev_rg_wa, *ev_rg_ba,
        *ev_rg_lambda, *ev_sink, *ev_w_out, *od_w_in, *od_lb_raw, *od_gnorm_w, *od_w_out, *final_norm_w;
    float* out; unsigned char* ws; int ph_lo, ph_hi;
};

DI float bf2f(unsigned short v) { return __uint_as_float((unsigned)v << 16); }
DI unsigned f2bf(float f) { unsigned u = __float_as_uint(f); return (u + 0x7fffu + ((u >> 16) & 1u)) >> 16; }
DI unsigned pk2(float lo, float hi) { return f2bf(lo) | (f2bf(hi) << 16); }
DI float sigm(float x) { return 1.f / (1.f + __expf(-x)); }
DI float wave_sum(float v) {
#pragma unroll
    for (int o = 1; o < 64; o <<= 1) v += __shfl_xor(v, o);
    return v;
}
DI int crow(int reg, int h) { return (reg & 3) + 8 * (reg >> 2) + 4 * h; }
#define MFMA16(a, b, c) __builtin_amdgcn_mfma_f32_16x16x32_bf16((a), (b), (c), 0, 0, 0)
#define MFMA32(a, b, c) __builtin_amdgcn_mfma_f32_32x32x16_bf16((a), (b), (c), 0, 0, 0)

struct EpiStoreBf16 {
    static constexpr bool PERM = true, AFTER_DRAIN = false;
    bf16_t* O; int ldc;
    DI void operator()(const f32x4 (&acc)[2][2][4][2], const pg8::Unit& u, int wr, int wc, int fr, int fq) const {
        const int row0 = u.pm * 256 + wr * 64 + fr, col0 = u.pn * 256 + wc * 32 + 8 * fq;
#pragma unroll
        for (int ai = 0; ai < 2; ++ai)
#pragma unroll
            for (int m = 0; m < 4; ++m) { bf16_t* rowp = O + (size_t)(row0 + ai * 128 + m * 16) * ldc + col0;
#pragma unroll
                for (int bj = 0; bj < 2; ++bj) { const f32x4 v0 = acc[ai][bj][m][0], v1 = acc[ai][bj][m][1];
                    u32x4 w; w.x = pk2(v0[0], v0[1]); w.y = pk2(v0[2], v0[3]); w.z = pk2(v1[0], v1[1]); w.w = pk2(v1[2], v1[3]);
                    *(u32x4*)(rowp + bj * 128) = w; } }
    }
};
struct EpiResid {
    static constexpr bool PERM = false, AFTER_DRAIN = false;
    const float* in_lat; const float* in_ctx; float* out_lat; float* out_ctx; const float* gate;
    DI void operator()(const f32x4 (&acc)[2][2][4][2], const pg8::Unit& u, int wr, int wc, int fr, int fq) const {
        const int b = u.pm / 9, jt = u.pm % 9;
        const float* ib; float* ob; const float* g;
        if (jt == 0) { const size_t off = (size_t)b * CTXL * DM; ib = in_ctx + off; ob = out_ctx + off; g = gate + 8 * 3072; }
        else { const size_t off = ((size_t)b * SEQ + (size_t)(jt - 1) * 256) * DM; ib = in_lat + off; ob = out_lat + off; g = gate + b * 3072; }
        const int col0 = u.pn * 256 + wc * 32 + 4 * fq;
        f32x4 gv[2][2];
#pragma unroll
        for (int bj = 0; bj < 2; ++bj)
#pragma unroll
            for (int n = 0; n < 2; ++n) gv[bj][n] = *(const f32x4*)(g + col0 + bj * 128 + n * 16);
#pragma unroll
        for (int ai = 0; ai < 2; ++ai)
#pragma unroll
            for (int m = 0; m < 4; ++m) { const int r = ai * 128 + wr * 64 + m * 16 + fr;
#pragma unroll
                for (int bj = 0; bj < 2; ++bj)
#pragma unroll
                    for (int n = 0; n < 2; ++n) { const size_t off = (size_t)r * DM + col0 + bj * 128 + n * 16;
                        const f32x4 o = *(const f32x4*)(ib + off) + gv[bj][n] * acc[ai][bj][m][n]; *(f32x4*)(ob + off) = o; }
                asm volatile("" ::: "memory"); }
    }
};

DI void phase_pro(const Params& P, LAS unsigned char* lds) {
    const int tid = get_tid();
    LAS float* s = (LAS float*)lds;
    LAS float* red = (LAS float*)(lds + 36864);
    float* mod = (float*)(P.ws + WS_MOD);
    for (int i = tid; i < 9 * 1024; i += 512) { const int r = i >> 10, k = i & 1023; const float v = r < 8 ? P.c[r * 1024 + k] : P.c_ctx[k]; s[i] = v * sigm(v); }
    __syncthreads();
    for (int item = get_bid(); item < 384; item += gridDim.x) {
        const int l = item / 96, n0 = (item % 96) * 32, ks = tid >> 5, col = tid & 31;
        const float* w = P.ada_w + (size_t)l * 1024 * 3072 + n0 + col;
        float acc[9];
#pragma unroll
        for (int r = 0; r < 9; ++r) acc[r] = 0.f;
#pragma unroll 8
        for (int kk = 0; kk < 64; ++kk) { const int k = ks * 64 + kk; const float wv = w[(size_t)k * 3072];
#pragma unroll
            for (int r = 0; r < 9; ++r) acc[r] += s[r * 1024 + k] * wv; }
#pragma unroll
        for (int r = 0; r < 9; ++r) red[(ks * 9 + r) * 32 + col] = acc[r];
        __syncthreads();
        if (tid < 288) { const int r = tid >> 5, cc = tid & 31; float sum = 0.f;
#pragma unroll
            for (int k2 = 0; k2 < 16; ++k2) sum += red[(k2 * 9 + r) * 32 + cc];
            mod[(l * 9 + r) * 3072 + n0 + cc] = sum + P.ada_b[l * 3072 + n0 + cc]; }
        __syncthreads();
    }
    float* cos_t = (float*)(P.ws + WS_ROPE); float* sin_t = cos_t + SEQ * 32;
    for (int i = get_bid() * 512 + tid; i < SEQ * 32; i += gridDim.x * 512) {
        const int pos = i >> 5, jj = i & 31, fi = jj & 15;
        const float inv = powf(10000.f, -(float)(2 * fi) / 32.f);
        const float ang = (float)(jj < 16 ? (pos >> 6) : (pos & 63)) * inv;
        cos_t[i] = cosf(ang); sin_t[i] = sinf(ang);
    }
}

DI void transpose_item(const float* W, int K, int N, bf16_t* WT, LAS float* scr, int item, int lane) {
    const int nblk = N / 32, kb = item / nblk, nb = item % nblk, k0 = 64 * kb, n0 = 32 * nb;
#pragma unroll 8
    for (int i = 0; i < 32; ++i) { const int kk = 2 * i + (lane >> 5); scr[kk * 33 + (lane & 31)] = W[(size_t)(k0 + kk) * N + n0 + (lane & 31)]; }
    asm volatile("s_waitcnt lgkmcnt(0)" ::: "memory");
    const int c = lane & 7;
#pragma unroll
    for (int j = 0; j < 4; ++j) { const int n = (lane >> 3) + 8 * j; const LAS float* sp = scr + (8 * c) * 33 + n;
        u32x4 o; o.x = pk2(sp[0 * 33], sp[1 * 33]); o.y = pk2(sp[2 * 33], sp[3 * 33]); o.z = pk2(sp[4 * 33], sp[5 * 33]); o.w = pk2(sp[6 * 33], sp[7 * 33]);
        *(u32x4*)(WT + (size_t)(n0 + n) * K + k0 + 8 * c) = o; }
    asm volatile("s_waitcnt lgkmcnt(0)" ::: "memory");
}

DI void phase_norm(const Params& P, LAS unsigned char* lds, int layer) {
    const int tid = get_tid(), lane = tid & 63, wave = tid >> 6;
    const int gw = get_bid() * 8 + wave, NGW = gridDim.x * 8;
    const int j = layer >> 1;
    LAS float* scr = (LAS float*)(lds + wave * 16384);
    bf16_t* WIN = (bf16_t*)(P.ws + WS_WIN); bf16_t* WOUT = (bf16_t*)(P.ws + WS_WOUT); bf16_t* WRG = (bf16_t*)(P.ws + WS_WRG);
    if ((layer & 1) == 0) {
        constexpr int I_IN = 16 * (EVEN_IN / 32), I_OUT = 32 * 32, I_RG = 32 * 8;
        for (int it = gw; it < I_IN + I_OUT + I_RG; it += NGW) {
            int r = it;
            if (r < I_IN) { transpose_item(P.ev_w_in + (size_t)j * 1024 * EVEN_IN, 1024, EVEN_IN, WIN, scr, r, lane); continue; } r -= I_IN;
            if (r < I_OUT) { transpose_item(P.ev_w_out + (size_t)j * 2048 * 1024, 2048, 1024, WOUT, scr, r, lane); continue; } r -= I_OUT;
            const int mat = r >> 3, sub = r & 7;
            const int dir = mat >> 4, gate = (mat >> 3) & 1, hd = mat & 7;
            const float* src = (gate == 0 ? P.ev_rg_wx : P.ev_rg_wa) + ((size_t)((j * 2 + dir) * 8 + hd)) * 16384;
            transpose_item(src, 128, 128, WRG + (size_t)mat * 16384, scr, sub, lane);
        }
    } else {
        constexpr int I_IN = 16 * (ODD_IN / 32), I_OUT = 16 * 32;
        for (int it = gw; it < I_IN + I_OUT; it += NGW) {
            int r = it;
            if (r < I_IN) { transpose_item(P.od_w_in + (size_t)j * 1024 * ODD_IN, 1024, ODD_IN, WIN, scr, r, lane); continue; } r -= I_IN;
            transpose_item(P.od_w_out + (size_t)j * 1024 * 1024, 1024, 1024, WOUT, scr, r, lane);
        }
    }
    const float* hl = layer == 0 ? P.x : P.out; const float* hc = layer == 0 ? P.ctx : (const float*)(P.ws + WS_HCTX);
    const float* mod = (const float*)(P.ws + WS_MOD) + (size_t)layer * 9 * 3072;
    const float* nw = P.norm_w + layer * 1024;
    bf16_t* U = (bf16_t*)(P.ws + WS_OV);
    for (int R = gw; R < MROWS; R += NGW) {
        const int b = R / LT, jr = R % LT;
        const float* src = jr < CTXL ? hc + ((size_t)b * CTXL + jr) * DM : hl + ((size_t)b * SEQ + (jr - CTXL)) * DM;
        const float* sh = mod + (jr < CTXL ? 8 : b) * 3072; const float* sc = sh + 1024;
        f32x4 v[4]; float ss = 0.f;
#pragma unroll
        for (int q = 0; q < 4; ++q) { v[q] = *(const f32x4*)(src + 4 * lane + 256 * q); ss += (v[q][0] * v[q][0] + v[q][1] * v[q][1]) + (v[q][2] * v[q][2] + v[q][3] * v[q][3]); }
        const float rstd = rsqrtf(wave_sum(ss) * (1.f / DM) + RMS_EPS);
#pragma unroll
        for (int q = 0; q < 4; ++q) { const int k = 4 * lane + 256 * q;
            const f32x4 w4 = *(const f32x4*)(nw + k), s4 = *(const f32x4*)(sc + k), h4 = *(const f32x4*)(sh + k);
            const f32x4 y = (v[q] * rstd) * w4; const f32x4 o = y * (s4 + 1.f) + h4;
            u32x2 w; w.x = pk2(o[0], o[1]); w.y = pk2(o[2], o[3]); *(u32x2*)(U + (size_t)R * DM + k) = w; }
    }
}

template <bool PASS2>
DI void rglru_item(const Params& P, LAS unsigned char* lds, int j, int item) {
    const int tid = get_tid(), lane = tid & 63, wave = tid >> 6, r = lane & 15, g = lane >> 4;
    const int hd = item & 7, ci = (item >> 3) % NCHUNK, b = item / (8 * NCHUNK);
    bf16_t* p = (bf16_t*)(P.ws + WS_P);
    const bf16_t* WRG = (const bf16_t*)(P.ws + WS_WRG);
    float2* AGG = (float2*)(P.ws + WS_AGG);
    const int R0 = b * LT + ci * 64;
    const int seg_lo = b * LT + (ci < 4 ? 0 : CTXL), seg_hi = b * LT + (ci < 4 ? CTXL : LT);
    LAS bf16_t* UT = (LAS bf16_t*)lds;
    LAS float* AL = (LAS float*)(lds + 17408);
    LAS float* BL = (LAS float*)(lds + 17408 + 32768);
    LAS float* YL = (LAS float*)(lds + 17408 + 65536);
    LAS float* QA = (LAS float*)(lds + 17408 + 98304);
    LAS float* CAR = (LAS float*)(lds + 17408 + 98304 + 4096);
#pragma unroll
    for (int rep = 0; rep < 2; ++rep) {
        const int idx = tid + rep * 512, t = idx >> 4, c0 = (idx & 15) * 8, cg0 = hd * 128 + c0;
        float acc[8];
        { const f32x4 b0 = *(const f32x4*)(P.ev_conv_b + j * 1024 + cg0), b1 = *(const f32x4*)(P.ev_conv_b + j * 1024 + cg0 + 4);
          acc[0] = b0[0]; acc[1] = b0[1]; acc[2] = b0[2]; acc[3] = b0[3]; acc[4] = b1[0]; acc[5] = b1[1]; acc[6] = b1[2]; acc[7] = b1[3]; }
#pragma unroll
        for (int k = 0; k < 4; ++k) {
            const int Rg = R0 + t + k - 1;
            if (Rg >= seg_lo && Rg < seg_hi) {
                const u32x4 xv = *(const u32x4*)(p + (size_t)Rg * EVEN_IN + cg0);
                const float* wk = P.ev_conv_w + (size_t)(j * 4 + k) * 1024 + cg0;
                const f32x4 w0 = *(const f32x4*)wk, w1 = *(const f32x4*)(wk + 4);
                acc[0] += w0[0] * __uint_as_float(xv.x << 16); acc[1] += w0[1] * __uint_as_float(xv.x & 0xffff0000u);
                acc[2] += w0[2] * __uint_as_float(xv.y << 16); acc[3] += w0[3] * __uint_as_float(xv.y & 0xffff0000u);
                acc[4] += w1[0] * __uint_as_float(xv.z << 16); acc[5] += w1[1] * __uint_as_float(xv.z & 0xffff0000u);
                acc[6] += w1[2] * __uint_as_float(xv.w << 16); acc[7] += w1[3] * __uint_as_float(xv.w & 0xffff0000u);
            }
        }
        u32x4 o; o.x = pk2(acc[0], acc[1]); o.y = pk2(acc[2], acc[3]); o.z = pk2(acc[4], acc[5]); o.w = pk2(acc[6], acc[7]);
        *(LAS u32x4*)(UT + t * 136 + c0) = o;
    }
    if (PASS2) {
        if (tid < 256) {
            const int dir = tid >> 7, c = tid & 127;
            const int pos = dir == 0 ? ci : (ci < 4 ? 3 - ci : 39 - ci);
            float h = 0.f;
            for (int pp = 0; pp < pos; ++pp) {
                const int cc = dir == 0 ? pp : (pp < 4 ? 3 - pp : 39 - pp);
                const float2 ab = AGG[((size_t)(dir * NB + b) * NCHUNK + cc) * 1024 + hd * 128 + c];
                h = ab.x * h + ab.y;
            }
            CAR[dir * 128 + c] = h;
        }
    }
    __syncthreads();
#pragma unroll 1
    for (int dir = 0; dir < 2; ++dir) {
        f32x4 ax[4], aa[4];
#pragma unroll
        for (int m = 0; m < 4; ++m) { ax[m] = (f32x4){0.f, 0.f, 0.f, 0.f}; aa[m] = (f32x4){0.f, 0.f, 0.f, 0.f}; }
        const bf16_t* Wx = WRG + (size_t)((dir * 2 + 0) * 8 + hd) * 16384 + (16 * wave + r) * 128 + 8 * g;
        const bf16_t* Wa = WRG + (size_t)((dir * 2 + 1) * 8 + hd) * 16384 + (16 * wave + r) * 128 + 8 * g;
#pragma unroll
        for (int ks = 0; ks < 4; ++ks) {
            const bf16x8 bx = *(const bf16x8*)(Wx + 32 * ks), ba = *(const bf16x8*)(Wa + 32 * ks);
#pragma unroll
            for (int m = 0; m < 4; ++m) {
                const bf16x8 a = *(const LAS bf16x8*)(UT + (16 * m + r) * 136 + 32 * ks + 8 * g);
                ax[m] = MFMA16(a, bx, ax[m]); aa[m] = MFMA16(a, ba, aa[m]);
            }
        }
        {
            const int c = 16 * wave + r, idx = (j * 2 + dir) * 1024 + hd * 128 + c;
            const float bxv = P.ev_rg_bx[idx], bav = P.ev_rg_ba[idx], lam = P.ev_rg_lambda[idx];
            const float sp = log1pf(__expf(-lam));
#pragma unroll
            for (int m = 0; m < 4; ++m)
#pragma unroll
                for (int i = 0; i < 4; ++i) {
                    const int t = 16 * m + 4 * g + i;
                    const float gx = sigm(ax[m][i] + bxv), ga = sigm(aa[m][i] + bav);
                    const float la = -8.f * ga * sp;
                    const float a = __expf(la), mult = sqrtf(-expm1f(2.f * la));
                    const float uv = bf2f(UT[t * 136 + c]);
                    AL[t * 128 + c] = a; BL[t * 128 + c] = mult * gx * uv;
                }
        }
        __syncthreads();
        {
            const int c = tid & 127, q = tid >> 7;
            float A = 1.f, B = 0.f;
#pragma unroll
            for (int s = 0; s < 16; ++s) { const int t = dir == 0 ? 16 * q + s : 16 * q + 15 - s; const float a = AL[t * 128 + c], bb = BL[t * 128 + c]; B = a * B + bb; A *= a; }
            QA[(q * 128 + c) * 2] = A; QA[(q * 128 + c) * 2 + 1] = B;
            __syncthreads();
            if (!PASS2) {
                if (q == 0) {
                    float CA = 1.f, CB = 0.f;
#pragma unroll
                    for (int qq = 0; qq < 4; ++qq) { const int qi = dir == 0 ? qq : 3 - qq; const float a = QA[(qi * 128 + c) * 2], bb = QA[(qi * 128 + c) * 2 + 1]; CB = a * CB + bb; CA *= a; }
                    AGG[((size_t)(dir * NB + b) * NCHUNK + ci) * 1024 + hd * 128 + c] = make_float2(CA, CB);
                }
            } else {
                float h = CAR[dir * 128 + c];
                const int nprev = dir == 0 ? q : 3 - q;
                for (int qq = 0; qq < nprev; ++qq) { const int qi = dir == 0 ? qq : 3 - qq; h = QA[(qi * 128 + c) * 2] * h + QA[(qi * 128 + c) * 2 + 1]; }
#pragma unroll
                for (int s = 0; s < 16; ++s) { const int t = dir == 0 ? 16 * q + s : 16 * q + 15 - s; h = AL[t * 128 + c] * h + BL[t * 128 + c];
                    if (dir == 0) YL[t * 128 + c] = h; else YL[t * 128 + c] += h; }
            }
        }
        __syncthreads();
    }
    if (PASS2) {
#pragma unroll
        for (int rep = 0; rep < 2; ++rep) {
            const int idx = tid + rep * 512, t = idx >> 4, c0 = (idx & 15) * 8;
            bf16_t* gp = p + (size_t)(R0 + t) * EVEN_IN + 1536 + hd * 128 + c0;
            const u32x4 gv = *(const u32x4*)gp;
            const f32x4 y0 = *(const LAS f32x4*)(YL + t * 128 + c0), y1 = *(const LAS f32x4*)(YL + t * 128 + c0 + 4);
            float gg[8] = {__uint_as_float(gv.x << 16), __uint_as_float(gv.x & 0xffff0000u), __uint_as_float(gv.y << 16), __uint_as_float(gv.y & 0xffff0000u),
                           __uint_as_float(gv.z << 16), __uint_as_float(gv.z & 0xffff0000u), __uint_as_float(gv.w << 16), __uint_as_float(gv.w & 0xffff0000u)};
            u32x4 o;
            o.x = pk2(y0[0] * gg[0] * sigm(gg[0]), y0[1] * gg[1] * sigm(gg[1])); o.y = pk2(y0[2] * gg[2] * sigm(gg[2]), y0[3] * gg[3] * sigm(gg[3]));
            o.z = pk2(y1[0] * gg[4] * sigm(gg[4]), y1[1] * gg[5] * sigm(gg[5])); o.w = pk2(y1[2] * gg[6] * sigm(gg[6]), y1[3] * gg[7] * sigm(gg[7]));
            *(u32x4*)gp = o;
        }
        __syncthreads();
    }
}

DI void rope8(u32x4& v, const float* cs, const float* sn) {
    unsigned* w = (unsigned*)&v;
#pragma unroll
    for (int i = 0; i < 4; ++i) { const float t1 = __uint_as_float(w[i] << 16), t2 = __uint_as_float(w[i] & 0xffff0000u); w[i] = pk2(t1 * cs[i] - t2 * sn[i], t1 * sn[i] + t2 * cs[i]); }
}
DI void attn_item(const Params& P, LAS unsigned char* lds, int j, int item) {
    const int tid = get_tid(), lane = tid & 63, wave = tid >> 6, r = lane & 31, h = lane >> 5;
    const bool is_lat = item < 512;
    int b, qb, kvh;
    if (is_lat) { b = item >> 6; qb = (item >> 2) & 15; kvh = item & 3; } else { const int it = item - 512; b = it >> 3; qb = (it >> 2) & 1; kvh = it & 3; }
    bf16_t* p = (bf16_t*)(P.ws + WS_P);
    const float* cos_t = (const float*)(P.ws + WS_ROPE); const float* sin_t = cos_t + SEQ * 32;
    LAS unsigned char* KL = lds;
    LAS unsigned char* VT = lds + 9216;
    const int hq = 4 * kvh + (wave >> 1), ql0 = qb * 128 + 64 * (wave & 1);
    const size_t rowbase = (size_t)b * LT + (is_lat ? CTXL : 0);
    LAS unsigned char* QL = lds + 18432 + wave * 9216;
#pragma unroll
    for (int qt = 0; qt < 2; ++qt) {
        const int qi = ql0 + 32 * qt + r;
        const bf16_t* qp = p + (rowbase + qi) * EVEN_IN + 2560 + hq * 64 + 8 * h;
#pragma unroll
        for (int ks = 0; ks < 4; ++ks) {
            u32x4 v = *(const u32x4*)(qp + 16 * ks);
            if (is_lat) rope8(v, cos_t + qi * 32 + 8 * ks + 4 * h, sin_t + qi * 32 + 8 * ks + 4 * h);
            *(LAS u32x4*)(QL + (32 * qt + r) * 144 + (16 * ks + 8 * h) * 2) = v;
        }
    }
    const float sink2 = P.ev_sink[j * 16 + hq] * LOG2E;
    float mrun[2] = {sink2, sink2}, lrun[2] = {h == 0 ? 1.f : 0.f, h == 0 ? 1.f : 0.f};
    f32x16 O[2][2];
#pragma unroll
    for (int a = 0; a < 2; ++a)
#pragma unroll
        for (int c = 0; c < 2; ++c)
#pragma unroll
            for (int i = 0; i < 16; ++i) O[a][c][i] = 0.f;
    const int ntiles = is_lat ? 10 : 4;
    const float SC = 0.125f * LOG2E, NEG = -1e30f;
#pragma unroll 1
    for (int ti = 0; ti < ntiles; ++ti) {
        const bool win = ti >= 4;
        const int k0 = win ? qb * 128 - 128 + 64 * (ti - 4) : 64 * ti;
        if (win && (k0 < 0 || k0 >= SEQ)) continue;
        __syncthreads();
        {
            const int key = tid >> 3, chn = tid & 7;
            const bf16_t* kp = p + ((size_t)b * LT + (win ? CTXL : 0) + k0 + key) * EVEN_IN + 1024 + kvh * 64 + 8 * chn;
            u32x4 kv = *(const u32x4*)kp;
            if (win) rope8(kv, cos_t + (k0 + key) * 32 + 4 * chn, sin_t + (k0 + key) * 32 + 4 * chn);
            *(LAS u32x4*)(KL + key * 144 + chn * 16) = kv;
            const u32x4 vv = *(const u32x4*)(kp + 256);
            const unsigned* vw = (const unsigned*)&vv;
#pragma unroll
            for (int e = 0; e < 4; ++e) {
                *(LAS unsigned short*)(VT + (8 * chn + 2 * e) * 144 + key * 2) = (unsigned short)(vw[e] & 0xffffu);
                *(LAS unsigned short*)(VT + (8 * chn + 2 * e + 1) * 144 + key * 2) = (unsigned short)(vw[e] >> 16);
            }
        }
        __syncthreads();
#pragma unroll
        for (int qt = 0; qt < 2; ++qt) {
            f32x16 s0, s1;
#pragma unroll
            for (int i = 0; i < 16; ++i) { s0[i] = 0.f; s1[i] = 0.f; }
#pragma unroll
            for (int ks = 0; ks < 4; ++ks) {
                const bf16x8 qfr = *(const LAS bf16x8*)(QL + (32 * qt + r) * 144 + (16 * ks + 8 * h) * 2);
                const bf16x8 k0f = *(const LAS bf16x8*)(KL + r * 144 + (16 * ks + 8 * h) * 2), k1f = *(const LAS bf16x8*)(KL + (32 + r) * 144 + (16 * ks + 8 * h) * 2);
                s0 = MFMA32(k0f, qfr, s0); s1 = MFMA32(k1f, qfr, s1);
            }
            const int qpos = ql0 + 32 * qt + r;
            float mx = NEG;
#pragma unroll
            for (int i = 0; i < 16; ++i) {
                const int kp0 = k0 + crow(i, h), kp1 = kp0 + 32;
                float v0 = s0[i] * SC, v1 = s1[i] * SC;
                if (win) { const int d0 = qpos - kp0, d1 = qpos - kp1; if (d0 > 128 || d0 < -128) v0 = NEG; if (d1 > 128 || d1 < -128) v1 = NEG; }
                s0[i] = v0; s1[i] = v1; mx = fmaxf(mx, fmaxf(v0, v1));
            }
            mx = fmaxf(mx, __shfl_xor(mx, 32));
            const float mn = fmaxf(mrun[qt], mx), alpha = __builtin_amdgcn_exp2f(mrun[qt] - mn);
            mrun[qt] = mn;
            float ls = 0.f;
#pragma unroll
            for (int i = 0; i < 16; ++i) { s0[i] = __builtin_amdgcn_exp2f(s0[i] - mn); s1[i] = __builtin_amdgcn_exp2f(s1[i] - mn); ls += s0[i] + s1[i]; }
            lrun[qt] = lrun[qt] * alpha + ls;
#pragma unroll
            for (int dt = 0; dt < 2; ++dt)
#pragma unroll
                for (int i = 0; i < 16; ++i) O[dt][qt][i] *= alpha;
            bf16x8 pf[2][2];
#pragma unroll
            for (int s = 0; s < 2; ++s) {
                u32x4 a, c;
                a.x = pk2(s0[8 * s + 0], s0[8 * s + 1]); a.y = pk2(s0[8 * s + 2], s0[8 * s + 3]); a.z = pk2(s0[8 * s + 4], s0[8 * s + 5]); a.w = pk2(s0[8 * s + 6], s0[8 * s + 7]);
                c.x = pk2(s1[8 * s + 0], s1[8 * s + 1]); c.y = pk2(s1[8 * s + 2], s1[8 * s + 3]); c.z = pk2(s1[8 * s + 4], s1[8 * s + 5]); c.w = pk2(s1[8 * s + 6], s1[8 * s + 7]);
                pf[0][s] = __builtin_bit_cast(bf16x8, a); pf[1][s] = __builtin_bit_cast(bf16x8, c);
            }
#pragma unroll
            for (int dt = 0; dt < 2; ++dt)
#pragma unroll
                for (int kt = 0; kt < 2; ++kt)
#pragma unroll
                    for (int s = 0; s < 2; ++s) {
                        const LAS unsigned char* vp = VT + (32 * dt + r) * 144 + (32 * kt + 16 * s + 4 * h) * 2;
                        const u32x2 lo = *(const LAS u32x2*)vp, hi = *(const LAS u32x2*)(vp + 16);
                        const u32x4 vv = {lo.x, lo.y, hi.x, hi.y};
                        O[dt][qt] = MFMA32(__builtin_bit_cast(bf16x8, vv), pf[kt][s], O[dt][qt]);
                    }
            __builtin_amdgcn_sched_barrier(0);
        }
    }
#pragma unroll
    for (int qt = 0; qt < 2; ++qt) {
        const float lt = lrun[qt] + __shfl_xor(lrun[qt], 32), inv = 1.f / lt;
        const int qi = ql0 + 32 * qt + r;
        bf16_t* rowp = p + (rowbase + qi) * EVEN_IN;
#pragma unroll
        for (int dt = 0; dt < 2; ++dt)
#pragma unroll
            for (int i4 = 0; i4 < 4; ++i4) {
                const int d0 = 32 * dt + 8 * i4 + 4 * h;
                const u32x2 gv = *(const u32x2*)(rowp + 3584 + hq * 64 + d0);
                const float g0 = __uint_as_float(gv.x << 16), g1 = __uint_as_float(gv.x & 0xffff0000u), g2 = __uint_as_float(gv.y << 16), g3 = __uint_as_float(gv.y & 0xffff0000u);
                u32x2 o;
                o.x = pk2(O[dt][qt][4 * i4 + 0] * inv * g0 * sigm(g0), O[dt][qt][4 * i4 + 1] * inv * g1 * sigm(g1));
                o.y = pk2(O[dt][qt][4 * i4 + 2] * inv * g2 * sigm(g2), O[dt][qt][4 * i4 + 3] * inv * g3 * sigm(g3));
                *(u32x2*)(rowp + 2560 + hq * 64 + d0) = o;
            }
    }
    __syncthreads();
}

constexpr int GL_QI = 0, GL_Q1 = 17408, GL_KF = 34816, GL_K2T = 78336, GL_VT = 96768, GL_AM = 101376, GL_ST = 110592, GL_PS = 128000, GL_BL = 130048, GL_ZT = 130560, GL_QT = 146944, GL_END = 163328;
static_assert(GL_END <= LDS_BYTES, "GLA LDS map");

template <int DIR>
DI void gla_step(const Params& P, LAS unsigned char* lds, int layer_j, int b, int hd, int eq, int step, f32x4 (&st)[2]) {
    const int tid = get_tid(), lane = tid & 63, wave = tid >> 6, r = lane & 15, g = lane >> 4;
    const bf16_t* p = (const bf16_t*)(P.ws + WS_P);
    bf16_t* OVb = (bf16_t*)(P.ws + WS_OV);
    LAS bf16_t* QI = (LAS bf16_t*)(lds + GL_QI); LAS bf16_t* Q1 = (LAS bf16_t*)(lds + GL_Q1); LAS bf16_t* KF = (LAS bf16_t*)(lds + GL_KF);
    LAS bf16_t* K2T = (LAS bf16_t*)(lds + GL_K2T); LAS bf16_t* VT = (LAS bf16_t*)(lds + GL_VT); LAS bf16_t* AM = (LAS bf16_t*)(lds + GL_AM);
    LAS bf16_t* ST = (LAS bf16_t*)(lds + GL_ST + DIR * 8704); LAS float* PS = (LAS float*)(lds + GL_PS); LAS float* BLAST = (LAS float*)(lds + GL_BL);
    const int chunk = DIR == 0 ? step : (step < 4 ? 3 - step : 39 - step);
    const int other_pos = DIR == 0 ? (chunk < 4 ? 3 - chunk : 39 - chunk) : chunk;
    const bool second = other_pos < step || (other_pos == step && DIR == 1);
    const size_t Rc0 = (size_t)b * LT + (size_t)chunk * 64;
    LAS bf16_t* ZT = (LAS bf16_t*)(lds + GL_ZT); LAS bf16_t* QT = (LAS bf16_t*)(lds + GL_QT);
#pragma unroll
    for (int rep = 0; rep < 2; ++rep) {
        const int idx = tid + rep * 512, tau = idx >> 4, c0 = (idx & 15) * 8;
        const size_t R = Rc0 + (DIR == 0 ? tau : 63 - tau);
        const u32x4 zv = *(const u32x4*)(p + R * ODD_IN + DIR * 1024 + hd * 128 + c0);
        const u32x4 qv = *(const u32x4*)(p + R * ODD_IN + 3072 + hd * 128 + c0);
        *(LAS u32x4*)(ZT + tau * 128 + c0) = zv; *(LAS u32x4*)(QT + tau * 128 + c0) = qv;
    }
    if (tid < 256) {
        const int tau = tid >> 2, chn = tid & 3;
        const size_t R = Rc0 + (DIR == 0 ? tau : 63 - tau);
        const u32x4 vv = *(const u32x4*)(p + R * ODD_IN + 2048 + hd * 128 + eq * 32 + 8 * chn);
        const unsigned* vw = (const unsigned*)&vv;
#pragma unroll
        for (int e = 0; e < 4; ++e) { VT[(8 * chn + 2 * e) * 72 + tau] = (bf16_t)(vw[e] & 0xffffu); VT[(8 * chn + 2 * e + 1) * 72 + tau] = (bf16_t)(vw[e] >> 16); }
    }
    __syncthreads();
    {
        const int d = tid & 127, I = tid >> 7, cgl = hd * 128 + d;
        float lbv = 0.f;
        if (layer_j > 0) lbv = sigm(P.od_lb_raw[1024 + cgl] - P.od_lb_raw[cgl]);
        const float omlb = 1.f - lbv;
        float e0[16], kk[16], qq[16];
        float run = 1.f;
#pragma unroll
        for (int s = 0; s < 16; ++s) {
            const int tau = 16 * I + s;
            const float z = bf2f(ZT[tau * 128 + d]);
            const float tz = __expf(-z), sg = 1.f / (1.f + tz);
            float f = lbv + omlb * sg; f = fmaxf(f, 1e-30f);
            kk[s] = omlb * (tz * sg);
            run = fmaxf(run * f, 1e-35f); e0[s] = run;
            const float qr = bf2f(QT[tau * 128 + d]);
            qq[s] = qr * sigm(qr);
        }
        PS[I * 128 + d] = run;
        __syncthreads();
        const float P0 = PS[d], P1 = PS[128 + d], P2 = PS[256 + d], P3 = PS[384 + d];
        const float RI = I == 0 ? 1.f : (I == 1 ? P0 : (I == 2 ? P0 * P1 : P0 * P1 * P2));
        float fac[4]; float cur = 1.f;
        fac[0] = cur; if (I <= 0) cur *= P0;
        fac[1] = cur; if (I <= 1) cur *= P1;
        fac[2] = cur; if (I <= 2) cur *= P2;
        fac[3] = cur; cur *= P3;
        const float f4 = cur;
        if (I == 0) BLAST[d] = P0 * P1 * P2 * P3;
#pragma unroll
        for (int s = 0; s < 16; ++s) {
            const int tau = 16 * I + s;
            const float qi = qq[s] * e0[s], kd = kk[s] * (1.f / e0[s]);
            QI[tau * 136 + d] = (bf16_t)f2bf(qi); Q1[tau * 136 + d] = (bf16_t)f2bf(qi * RI);
            if (I <= 0) KF[(0 + tau) * 136 + d] = (bf16_t)f2bf(kd * fac[0]);
            if (I <= 1) KF[(16 + tau) * 136 + d] = (bf16_t)f2bf(kd * fac[1]);
            if (I <= 2) KF[(48 + tau) * 136 + d] = (bf16_t)f2bf(kd * fac[2]);
            KF[(96 + tau) * 136 + d] = (bf16_t)f2bf(kd * fac[3]);
            K2T[d * 72 + tau] = (bf16_t)f2bf(kd * f4);
        }
    }
    __syncthreads();
#pragma unroll 1
    for (int bi = wave; bi < 10; bi += 8) {
        const int I = bi < 1 ? 0 : (bi < 3 ? 1 : (bi < 6 ? 2 : 3)), J = bi - (I * (I + 1)) / 2;
        const int foff = I == 0 ? 0 : (I == 1 ? 16 : (I == 2 ? 48 : 96));
        f32x4 acc = {0.f, 0.f, 0.f, 0.f};
#pragma unroll
        for (int ks = 0; ks < 4; ++ks) {
            const bf16x8 a = *(const LAS bf16x8*)(QI + (16 * I + r) * 136 + 32 * ks + 8 * g);
            const bf16x8 bb = *(const LAS bf16x8*)(KF + (foff + 16 * J + r) * 136 + 32 * ks + 8 * g);
            acc = MFMA16(a, bb, acc);
        }
#pragma unroll
        for (int i = 0; i < 4; ++i) { float v = acc[i]; if (J == I && r > 4 * g + i) v = 0.f; AM[(16 * I + 4 * g + i) * 72 + 16 * J + r] = (bf16_t)f2bf(v); }
    }
    __syncthreads();
    {
        const int tt = wave >> 1, et = wave & 1;
        f32x4 acc = {0.f, 0.f, 0.f, 0.f};
#pragma unroll
        for (int ks = 0; ks < 4; ++ks) {
            const bf16x8 a = *(const LAS bf16x8*)(Q1 + (16 * tt + r) * 136 + 32 * ks + 8 * g);
            const bf16x8 bb = *(const LAS bf16x8*)(ST + (16 * et + r) * 136 + 32 * ks + 8 * g);
            acc = MFMA16(a, bb, acc);
        }
#pragma unroll
        for (int ks = 0; ks < 2; ++ks) {
            const bf16x8 a = *(const LAS bf16x8*)(AM + (16 * tt + r) * 72 + 32 * ks + 8 * g);
            const bf16x8 bb = *(const LAS bf16x8*)(VT + (16 * et + r) * 72 + 32 * ks + 8 * g);
            acc = MFMA16(a, bb, acc);
        }
#pragma unroll
        for (int i = 0; i < 4; ++i) {
            const int tau = 16 * tt + 4 * g + i;
            const size_t R = Rc0 + (DIR == 0 ? tau : 63 - tau);
            bf16_t* op = OVb + R * DM + hd * 128 + eq * 32 + 16 * et + r;
            float v = acc[i];
            if (second) v += bf2f(__hip_atomic_load(op, __ATOMIC_RELAXED, __HIP_MEMORY_SCOPE_AGENT));
            *op = (bf16_t)f2bf(v);
        }
    }
    {
        float bl[4];
#pragma unroll
        for (int i = 0; i < 4; ++i) bl[i] = BLAST[16 * wave + 4 * g + i];
#pragma unroll
        for (int et = 0; et < 2; ++et) {
#pragma unroll
            for (int i = 0; i < 4; ++i) st[et][i] *= bl[i];
#pragma unroll
            for (int ks = 0; ks < 2; ++ks) {
                const bf16x8 a = *(const LAS bf16x8*)(K2T + (16 * wave + r) * 72 + 32 * ks + 8 * g);
                const bf16x8 bb = *(const LAS bf16x8*)(VT + (16 * et + r) * 72 + 32 * ks + 8 * g);
                st[et] = MFMA16(a, bb, st[et]);
            }
        }
    }
    __syncthreads();
#pragma unroll
    for (int et = 0; et < 2; ++et) {
        u32x2 w; w.x = pk2(st[et][0], st[et][1]); w.y = pk2(st[et][2], st[et][3]);
        *(LAS u32x2*)(ST + (16 * et + r) * 136 + 16 * wave + 4 * g) = w;
    }
}

DI void gla_item(const Params& P, LAS unsigned char* lds, int layer_j, int item) {
    const int tid = get_tid();
    const int b = item >> 5, hd = (item >> 2) & 7, eq = item & 3;
    for (int i = tid; i < (9216 + 17408) / 4; i += 512) ((LAS unsigned*)(lds + GL_AM))[i] = 0u;
    f32x4 sf[2], sb[2];
#pragma unroll
    for (int e = 0; e < 2; ++e) { sf[e] = (f32x4){0.f, 0.f, 0.f, 0.f}; sb[e] = (f32x4){0.f, 0.f, 0.f, 0.f}; }
    __syncthreads();
#pragma unroll 1
    for (int step = 0; step < NCHUNK; ++step) {
        gla_step<0>(P, lds, layer_j, b, hd, eq, step, sf);
        __threadfence();
        __syncthreads();
        gla_step<1>(P, lds, layer_j, b, hd, eq, step, sb);
        __threadfence();
        __syncthreads();
    }
}

DI void phase_readout(const Params& P, int layer_j) {
    const int tid = get_tid(), lane = tid & 63, wave = tid >> 6;
    const int gw = get_bid() * 8 + wave, NGW = gridDim.x * 8;
    const bf16_t* OVb = (const bf16_t*)(P.ws + WS_OV); bf16_t* p = (bf16_t*)(P.ws + WS_P);
    const float* gwt = P.od_gnorm_w + layer_j * 128 + (lane & 7) * 16;
    for (int R = gw; R < MROWS; R += NGW) {
        const bf16_t* op = OVb + (size_t)R * DM + 16 * lane; bf16_t* yp = p + (size_t)R * ODD_IN + 4096 + 16 * lane;
        const u32x4 o0 = *(const u32x4*)op, o1 = *(const u32x4*)(op + 8), g0 = *(const u32x4*)yp, g1 = *(const u32x4*)(yp + 8);
        float ov[16], gv[16];
        const unsigned* ow0 = (const unsigned*)&o0; const unsigned* ow1 = (const unsigned*)&o1; const unsigned* gw0 = (const unsigned*)&g0; const unsigned* gw1 = (const unsigned*)&g1;
#pragma unroll
        for (int i = 0; i < 4; ++i) {
            ov[2 * i] = __uint_as_float(ow0[i] << 16); ov[2 * i + 1] = __uint_as_float(ow0[i] & 0xffff0000u); ov[8 + 2 * i] = __uint_as_float(ow1[i] << 16); ov[8 + 2 * i + 1] = __uint_as_float(ow1[i] & 0xffff0000u);
            gv[2 * i] = __uint_as_float(gw0[i] << 16); gv[2 * i + 1] = __uint_as_float(gw0[i] & 0xffff0000u); gv[8 + 2 * i] = __uint_as_float(gw1[i] << 16); gv[8 + 2 * i + 1] = __uint_as_float(gw1[i] & 0xffff0000u);
        }
        float ss = 0.f;
#pragma unroll
        for (int i = 0; i < 16; ++i) ss += ov[i] * ov[i];
        ss += __shfl_xor(ss, 1); ss += __shfl_xor(ss, 2); ss += __shfl_xor(ss, 4);
        const float rstd = rsqrtf(ss * (1.f / 128.f) + RMS_EPS);
        float y[16];
#pragma unroll
        for (int i = 0; i < 16; ++i) y[i] = ov[i] * rstd * gwt[i] * (gv[i] * sigm(gv[i]));
        u32x4 w0, w1;
        w0.x = pk2(y[0], y[1]); w0.y = pk2(y[2], y[3]); w0.z = pk2(y[4], y[5]); w0.w = pk2(y[6], y[7]);
        w1.x = pk2(y[8], y[9]); w1.y = pk2(y[10], y[11]); w1.z = pk2(y[12], y[13]); w1.w = pk2(y[14], y[15]);
        *(u32x4*)yp = w0; *(u32x4*)(yp + 8) = w1;
    }
}

DI void phase_final(const Params& P) {
    const int tid = get_tid(), lane = tid & 63, wave = tid >> 6;
    const int gw = get_bid() * 8 + wave, NGW = gridDim.x * 8;
    for (int R = gw; R < NB * SEQ; R += NGW) {
        float* row = P.out + (size_t)R * DM;
        f32x4 v[4]; float ss = 0.f;
#pragma unroll
        for (int q = 0; q < 4; ++q) { v[q] = *(const f32x4*)(row + 4 * lane + 256 * q); ss += (v[q][0] * v[q][0] + v[q][1] * v[q][1]) + (v[q][2] * v[q][2] + v[q][3] * v[q][3]); }
        const float rstd = rsqrtf(wave_sum(ss) * (1.f / DM) + RMS_EPS);
#pragma unroll
        for (int q = 0; q < 4; ++q) { const f32x4 w4 = *(const f32x4*)(P.final_norm_w + 4 * lane + 256 * q); *(f32x4*)(row + 4 * lane + 256 * q) = (v[q] * rstd) * w4; }
    }
}

constexpr int PARAM_OFF = LDS_BYTES - 256;
static_assert(GL_END <= PARAM_OFF && sizeof(Params) <= 256, "LDS map");
DI const float* ld_uptr(const LAS unsigned long long* s, int i) {
    const unsigned long long v = s[i];
    const unsigned lo = __builtin_amdgcn_readfirstlane((unsigned)v), hi = __builtin_amdgcn_readfirstlane((unsigned)(v >> 32));
    return (const float*)(((unsigned long long)hi << 32) | lo);
}
DI Params load_params(LAS unsigned char* lds) {
    LAS unsigned char* pb = lds + PARAM_OFF; asm volatile("" : "+v"(pb));
    const LAS unsigned long long* s = (const LAS unsigned long long*)pb;
    Params Q;
    Q.x = ld_uptr(s, 0); Q.c = ld_uptr(s, 1); Q.ctx = ld_uptr(s, 2); Q.c_ctx = ld_uptr(s, 3); Q.ada_w = ld_uptr(s, 4); Q.ada_b = ld_uptr(s, 5); Q.norm_w = ld_uptr(s, 6);
    Q.ev_w_in = ld_uptr(s, 7); Q.ev_conv_w = ld_uptr(s, 8); Q.ev_conv_b = ld_uptr(s, 9); Q.ev_rg_wx = ld_uptr(s, 10); Q.ev_rg_bx = ld_uptr(s, 11); Q.ev_rg_wa = ld_uptr(s, 12);
    Q.ev_rg_ba = ld_uptr(s, 13); Q.ev_rg_lambda = ld_uptr(s, 14); Q.ev_sink = ld_uptr(s, 15); Q.ev_w_out = ld_uptr(s, 16); Q.od_w_in = ld_uptr(s, 17); Q.od_lb_raw = ld_uptr(s, 18);
    Q.od_gnorm_w = ld_uptr(s, 19); Q.od_w_out = ld_uptr(s, 20); Q.final_norm_w = ld_uptr(s, 21); Q.out = (float*)ld_uptr(s, 22); Q.ws = (unsigned char*)ld_uptr(s, 23);
    Q.ph_lo = 0; Q.ph_hi = 0;
    return Q;
}
DI void run_phase(LAS unsigned char* lds, int ph) {
    #ifndef PHMASK
#define PHMASK 0xffff
#endif
    if (ph == 0) { if (PHMASK & 1) { const Params P = load_params(lds); phase_pro(P, lds); } return; }
    if (ph == NPHASE - 1) { if (PHMASK & 2) { const Params P = load_params(lds); phase_final(P); } return; }
    const int layer = (ph - 1) / 5, sub = (ph - 1) % 5, j = layer >> 1;
    const bool even = (layer & 1) == 0;
    if (sub == 0) { if (PHMASK & 4) { const Params P = load_params(lds); phase_norm(P, lds, layer); } return; }
    if (sub == 1) {
        const Params P = load_params(lds); bf16_t* pbuf = (bf16_t*)(P.ws + WS_P);
        const int N = even ? EVEN_IN : ODD_IN;
        pg8::Gemm gm{(const bf16_t*)(P.ws + WS_OV), (const bf16_t*)(P.ws + WS_WIN), MROWS, N, 1024, 1024};
        pg8::StaticOrder S; S.init(MROWS, N, (int)gridDim.x, get_bid());
        EpiStoreBf16 E{pbuf, N};
        if (PHMASK & 8) pg8::gemm_phase<EpiStoreBf16, pg8::StaticOrder, true, true>(lds, gm, S, E);
        return;
    }
    if (sub == 2) {
        const Params P = load_params(lds);
        if (even) {
            for (int it = get_bid(); it < 576 + NB * NCHUNK * 8; it += gridDim.x) {
                if (it < 576) { if (PHMASK & 16) attn_item(P, lds, j, it); } else { if (PHMASK & 32) rglru_item<false>(P, lds, j, it - 576); }
            }
        } else {
            for (int it = get_bid(); it < 256; it += gridDim.x) { if (PHMASK & 64) gla_item(P, lds, j, it); }
        }
        return;
    }
    if (sub == 3) {
        const Params P = load_params(lds);
        if (even) { for (int it = get_bid(); it < NB * NCHUNK * 8; it += gridDim.x) { if (PHMASK & 128) rglru_item<true>(P, lds, j, it); } }
        else { if (PHMASK & 256) phase_readout(P, j); }
        return;
    }
    {
        const Params P = load_params(lds); bf16_t* pbuf = (bf16_t*)(P.ws + WS_P);
        const int K = even ? 2048 : 1024, lda = even ? EVEN_IN : ODD_IN;
        pg8::Gemm gm{pbuf + (even ? 1536 : 4096), (const bf16_t*)(P.ws + WS_WOUT), MROWS, 1024, K, lda};
        pg8::StaticOrder S; S.init(MROWS, 1024, (int)gridDim.x, get_bid());
        const float* hl = layer == 0 ? P.x : P.out; const float* hc = layer == 0 ? P.ctx : (const float*)(P.ws + WS_HCTX);
        EpiResid E{hl, hc, P.out, (float*)(P.ws + WS_HCTX), (const float*)(P.ws + WS_MOD) + (size_t)layer * 9 * 3072 + 2048};
        if (PHMASK & 512) pg8::gemm_phase<EpiResid, pg8::StaticOrder, true, true>(lds, gm, S, E);
    }
}

__global__ void __launch_bounds__(512, 2) mega(Params P) {
    extern __shared__ __attribute__((aligned(16))) unsigned char lds_raw[];
    LAS unsigned char* lds = (LAS unsigned char*)lds_raw;
    cg::grid_group grid = cg::this_grid();
    if (threadIdx.x == 0) {
        LAS unsigned long long* d = (LAS unsigned long long*)(lds + PARAM_OFF);
        d[0] = (unsigned long long)P.x; d[1] = (unsigned long long)P.c; d[2] = (unsigned long long)P.ctx; d[3] = (unsigned long long)P.c_ctx; d[4] = (unsigned long long)P.ada_w;
        d[5] = (unsigned long long)P.ada_b; d[6] = (unsigned long long)P.norm_w; d[7] = (unsigned long long)P.ev_w_in; d[8] = (unsigned long long)P.ev_conv_w; d[9] = (unsigned long long)P.ev_conv_b;
        d[10] = (unsigned long long)P.ev_rg_wx; d[11] = (unsigned long long)P.ev_rg_bx; d[12] = (unsigned long long)P.ev_rg_wa; d[13] = (unsigned long long)P.ev_rg_ba; d[14] = (unsigned long long)P.ev_rg_lambda;
        d[15] = (unsigned long long)P.ev_sink; d[16] = (unsigned long long)P.ev_w_out; d[17] = (unsigned long long)P.od_w_in; d[18] = (unsigned long long)P.od_lb_raw; d[19] = (unsigned long long)P.od_gnorm_w;
        d[20] = (unsigned long long)P.od_w_out; d[21] = (unsigned long long)P.final_norm_w; d[22] = (unsigned long long)P.out; d[23] = (unsigned long long)P.ws;
    }
    __syncthreads();
    const int ph_lo = P.ph_lo, ph_hi = P.ph_hi;
#pragma unroll 1
    for (int ph = ph_lo; ph < ph_hi; ++ph) {
        if (ph > ph_lo) grid.sync();
        run_phase(lds, ph);
    }
}

extern "C" void kernel_launch(void* const* d_in, const int* in_sizes, int n_in, void* d_out, int out_size, void* d_ws, size_t ws_size, hipStream_t stream) {
    static int grid = 0;
    if (grid == 0) {
        if (n_in != 22 || ws_size < WS_END) { fprintf(stderr, "kernel_launch: unexpected inputs (n_in %d, ws %zu)\n", n_in, ws_size); grid = -1; return; }
        int dev = 0, cus = 0, per_cu = 0;
        hipGetDevice(&dev);
        hipDeviceGetAttribute(&cus, hipDeviceAttributeMultiprocessorCount, dev);
        if (hipFuncSetAttribute((const void*)mega, hipFuncAttributeMaxDynamicSharedMemorySize, LDS_BYTES) != hipSuccess) { fprintf(stderr, "kernel_launch: hipFuncSetAttribute failed\n"); grid = -1; return; }
        if (hipOccupancyMaxActiveBlocksPerMultiprocessor(&per_cu, (const void*)mega, 512, LDS_BYTES) != hipSuccess || per_cu < 1) { fprintf(stderr, "kernel_launch: occupancy query gives %d\n", per_cu); per_cu = 1; }
        (void)hipGetLastError();
        grid = cus;
    }
    if (grid < 0) return;
    Params P{};
    const float** pp = (const float**)&P;
    for (int i = 0; i < 22; ++i) pp[i] = (const float*)d_in[i];
    P.out = (float*)d_out; P.ws = (unsigned char*)d_ws;
#if ONE_LAUNCH
    P.ph_lo = 0; P.ph_hi = NPHASE;
    { void* args[] = {&P}; hipError_t e = hipLaunchCooperativeKernel((const void*)mega, dim3(grid), dim3(512), args, LDS_BYTES, stream);
      if (e != hipSuccess) fprintf(stderr, "cooperative launch failed: %s (grid %d)\n", hipGetErrorString(e), grid); }
#else
    for (int ph = 0; ph < NPHASE; ++ph) {
        P.ph_lo = ph; P.ph_hi = ph + 1;
        void* args[] = {&P}; hipError_t e = hipLaunchCooperativeKernel((const void*)mega, dim3(grid), dim3(512), args, LDS_BYTES, stream);
        if (e != hipSuccess) { fprintf(stderr, "launch %d failed: %s (grid %d)\n", ph, hipGetErrorString(e), grid); break; }
    }
#endif
}
```

```cpp
#include <hip/hip_runtime.h>
#include <hip/hip_cooperative_groups.h>
#include <cstdio>
#include <cstdint>
namespace cg = cooperative_groups;

#ifndef ONE_LAUNCH
#define ONE_LAUNCH 1
#endif

#define DI __device__ __forceinline__
#define LAS __attribute__((address_space(3)))
__device__ __forceinline__ int get_tid() { int t = threadIdx.x; asm volatile("" : "+v"(t)); return t; }
__device__ __forceinline__ int get_bid() { int b = blockIdx.x; asm volatile("" : "+s"(b)); return b; }
namespace pg8 {
#define PG8_LAS __attribute__((address_space(3)))
typedef unsigned short bf16_t;
typedef short bf16x8 __attribute__((ext_vector_type(8)));
typedef float f32x4 __attribute__((ext_vector_type(4)));
typedef unsigned u32x4 __attribute__((ext_vector_type(4)));
constexpr int BM = 256, BK = 64, HALF = 128, HTB = HALF * BK * 2  , STAGE_BYTES = 8 * HTB, NXCD = 8, WGM = 8;

__host__ __device__ __forceinline__ int lds_byte(int r, int c) { const int st = (r >> 4) * 2 + (c >> 5), rr = r & 15, cc = c & 31, ob = rr * 64 + cc * 2; return st * 1024 + (ob ^ (((ob >> 9) & 1) << 5)); }
__host__ __device__ __forceinline__ void stage_rc(int b, int& R, int& C) { const int st = b / 1024, sb = b % 1024, swz = sb ^ (((sb >> 9) & 1) << 5); R = (st >> 1) * 16 + swz / 64; C = (st & 1) * 32 + (swz % 64) / 2; }
__host__ __device__ __forceinline__ int perm32(int rho) { const int n = rho >> 4, i = rho & 15; return 8 * (i >> 2) + 4 * n + (i & 3); }

struct Unit { int pm, pn; };
struct Gemm { const bf16_t* A; const bf16_t* Bt; int M, N, K, lda; };

struct StaticOrder {
    int nM, nN, nwg, G, c;
    __host__ __device__ void init(int M, int N, int G_, int c_) { nM = M / BM; nN = N / BM; nwg = nM * nN; G = G_; c = c_; }
    __host__ __device__ bool next(int i, Unit& u) const {
        const long L = (long)i * G + c; if (L >= nwg) return false;
        int wgid = (int)L; { const int q = nwg / NXCD, r = nwg % NXCD, xcd = wgid % NXCD, off = wgid / NXCD; wgid = (xcd < r ? xcd * (q + 1) : r * (q + 1) + (xcd - r) * q) + off; }
        const int nig = WGM * nN, gid = wgid / nig, fm = gid * WGM, gsz = (nM - fm) < WGM ? (nM - fm) : WGM;
        u.pm = fm + ((wgid % nig) % gsz); u.pn = (wgid % nig) / gsz; return true;
    }
    __device__ __forceinline__ void a_ready(const Unit&) const {}
    __device__ __forceinline__ void done(const Unit&) const {}
};

template <class Epi, class Sched, bool ALIGN_EPI = false, bool SP2 = false>
__device__ __forceinline__ void gemm_phase(PG8_LAS unsigned char* lds, const Gemm g, const Sched& S, const Epi& E) {
    const int tid = get_tid(), wid = __builtin_amdgcn_readfirstlane(tid >> 6), lane = tid & 63, wr = wid >> 2, wc = wid & 3, fr = lane & 15, fq = lane >> 4;
    const int K = g.K, nt = K / BK;
    unsigned voffA[2], voffB[2];
#pragma unroll
    for (int i = 0; i < 2; ++i) { int R, C; stage_rc(tid * 16 + i * 8192, R, C); const int Rb = Epi::PERM ? ((R & ~31) + perm32(R & 31)) : R;
        voffA[i] = (unsigned)(R * g.lda + C) * 2u; voffB[i] = (unsigned)(Rb * K + C) * 2u; }
    const size_t kstep = (size_t)(BK * 2);
    const size_t hstepA = (size_t)HALF * g.lda * 2, hstepB = (size_t)HALF * K * 2;
    const size_t tstepA = 2 * hstepA, tstepB = 2 * hstepB;
    const unsigned ldsw = (unsigned)wid * 1024u;
    const int aoff = lds_byte(wr * 64 + fr, fq * 8), boff = lds_byte(wc * 32 + fr, fq * 8);
#define PG8_SA(b, h) (((b) * 2 + (h)) * HTB)
#define PG8_SB(b, h) ((4 + (b) * 2 + (h)) * HTB)
#define PG8_STAGE(bufoff, gbase, voff) do { _Pragma("unroll") for (int _i = 0; _i < 2; ++_i) \
        __builtin_amdgcn_global_load_lds((const unsigned*)((const char*)(gbase) + (voff)[_i]), (PG8_LAS unsigned*)(lds + (bufoff) + ldsw + _i * 8192), 16, 0, 0); } while (0)
#define PG8_LDA(dst, b, h) do { _Pragma("unroll") for (int m = 0; m < 4; ++m) _Pragma("unroll") for (int k = 0; k < 2; ++k) dst[m][k] = *(const PG8_LAS bf16x8*)(lds + PG8_SA(b, h) + aoff + m * 2048 + k * 1024); } while (0)
#define PG8_LDB(dst, b, h) do { _Pragma("unroll") for (int n = 0; n < 2; ++n) _Pragma("unroll") for (int k = 0; k < 2; ++k) dst[n][k] = *(const PG8_LAS bf16x8*)(lds + PG8_SB(b, h) + boff + n * 2048 + k * 1024); } while (0)
#define PG8_MMA(ai, bj, At, Bt) do { __builtin_amdgcn_s_setprio(1); _Pragma("unroll") for (int m = 0; m < 4; ++m) _Pragma("unroll") for (int n = 0; n < 2; ++n) _Pragma("unroll") for (int k = 0; k < 2; ++k) \
        acc[ai][bj][m][n] = __builtin_amdgcn_mfma_f32_16x16x32_bf16(Bt[n][k], At[m][k], acc[ai][bj][m][n], 0, 0, 0); __builtin_amdgcn_s_setprio(0); } while (0)
#define PG8_WAIT_V(n) asm volatile("s_waitcnt vmcnt(" #n ")" ::: "memory")
#define PG8_WAIT_L(n) asm volatile("s_waitcnt lgkmcnt(" #n ")" ::: "memory")
#define PG8_BAR __builtin_amdgcn_s_barrier()
#define PG8_SCHED __builtin_amdgcn_sched_barrier(0)
    Unit cur, nxt; int ui = 0;
    if (!S.next(0, cur)) return;
    f32x4 acc[2][2][4][2];
#pragma unroll
    for (int a = 0; a < 2; ++a)
#pragma unroll
        for (int b = 0; b < 2; ++b)
#pragma unroll
            for (int m = 0; m < 4; ++m)
#pragma unroll
                for (int n = 0; n < 2; ++n) acc[a][b][m][n] = (f32x4){0.f, 0.f, 0.f, 0.f};
    bf16x8 At[4][2], B0[2][2], B1[2][2];
    const char* cA = (const char*)g.A + (size_t)cur.pm * tstepA; const char* cB = (const char*)g.Bt + (size_t)cur.pn * tstepB;
    S.a_ready(cur);
    if constexpr (SP2) {
        PG8_STAGE(PG8_SB(0, 0), cB, voffB); PG8_STAGE(PG8_SB(0, 1), cB + hstepB, voffB); PG8_STAGE(PG8_SA(0, 0), cA, voffA); PG8_STAGE(PG8_SA(0, 1), cA + hstepA, voffA);
        if (wr == 1) PG8_BAR;
        PG8_WAIT_V(2); PG8_BAR;
        PG8_STAGE(PG8_SB(1, 0), cB + kstep, voffB); PG8_STAGE(PG8_SA(1, 0), cA + kstep, voffA); PG8_STAGE(PG8_SB(1, 1), cB + hstepB + kstep, voffB);
        PG8_WAIT_V(6); PG8_BAR;
    } else {
        PG8_STAGE(PG8_SB(0, 0), cB, voffB); PG8_STAGE(PG8_SA(0, 0), cA, voffA); PG8_STAGE(PG8_SB(0, 1), cB + hstepB, voffB); PG8_STAGE(PG8_SA(0, 1), cA + hstepA, voffA);
        if (wr == 1) PG8_BAR;
        PG8_WAIT_V(4); PG8_BAR;
        PG8_STAGE(PG8_SB(1, 0), cB + kstep, voffB); PG8_STAGE(PG8_SA(1, 0), cA + kstep, voffA); PG8_STAGE(PG8_SB(1, 1), cB + hstepB + kstep, voffB);
        PG8_WAIT_V(6); PG8_BAR;
    }
    for (;;) {
        const bool has_next = S.next(ui + 1, nxt);
        const char* nA = has_next ? (const char*)g.A + (size_t)nxt.pm * tstepA : cA; const char* nB = has_next ? (const char*)g.Bt + (size_t)nxt.pn * tstepB : cB;
        for (int t = 0; t < nt; t += 2) {
            const bool last = (t == nt - 2);
            const char* a1 = cA + (size_t)(t + 1) * kstep;
            const char* a2 = last ? nA : cA + (size_t)(t + 2) * kstep; const char* b2 = last ? nB : cB + (size_t)(t + 2) * kstep;
            const char* a3 = a2 + kstep; const char* b3 = b2 + kstep;
            if (last && has_next) S.a_ready(nxt);
            if constexpr (SP2) {
            PG8_LDB(B0, 0, 0); PG8_LDB(B1, 0, 1); PG8_SCHED; PG8_LDA(At, 0, 0); PG8_STAGE(PG8_SA(1, 1), a1 + hstepA, voffA);
            PG8_WAIT_V(8); PG8_WAIT_L(0); PG8_BAR; PG8_MMA(0, 0, At, B0); PG8_MMA(0, 1, At, B1); PG8_BAR; PG8_SCHED;
            PG8_LDA(At, 0, 1); PG8_STAGE(PG8_SB(0, 0), b2, voffB); PG8_STAGE(PG8_SB(0, 1), b2 + hstepB, voffB); PG8_STAGE(PG8_SA(0, 0), a2, voffA);
            PG8_WAIT_V(8); PG8_WAIT_L(0); PG8_BAR; PG8_MMA(1, 0, At, B0); PG8_MMA(1, 1, At, B1); PG8_BAR; PG8_SCHED;
            PG8_LDB(B0, 1, 0); PG8_LDB(B1, 1, 1); PG8_SCHED; PG8_LDA(At, 1, 0); PG8_STAGE(PG8_SA(0, 1), a2 + hstepA, voffA);
            PG8_WAIT_V(8); PG8_WAIT_L(0); PG8_BAR; PG8_MMA(0, 0, At, B0); PG8_MMA(0, 1, At, B1); PG8_BAR; PG8_SCHED;
            PG8_LDA(At, 1, 1); PG8_STAGE(PG8_SB(1, 0), b3, voffB); PG8_STAGE(PG8_SB(1, 1), b3 + hstepB, voffB); PG8_STAGE(PG8_SA(1, 0), a3, voffA);
            PG8_WAIT_V(8); PG8_WAIT_L(0); PG8_BAR; PG8_MMA(1, 0, At, B0); PG8_MMA(1, 1, At, B1); PG8_BAR; PG8_SCHED;
            } else {
            PG8_LDB(B0, 0, 0); PG8_SCHED; PG8_LDA(At, 0, 0); PG8_STAGE(PG8_SA(1, 1), a1 + hstepA, voffA);
            PG8_WAIT_L(8); PG8_BAR; PG8_WAIT_L(0); PG8_MMA(0, 0, At, B0); PG8_BAR; PG8_SCHED;
            PG8_LDB(B1, 0, 1); PG8_STAGE(PG8_SB(0, 0), b2, voffB);
            PG8_BAR; PG8_WAIT_L(0); PG8_MMA(0, 1, At, B1); PG8_BAR;
            PG8_LDA(At, 0, 1); PG8_STAGE(PG8_SA(0, 0), a2, voffA);
            PG8_BAR; PG8_WAIT_L(0); PG8_MMA(1, 0, At, B0); PG8_BAR; PG8_SCHED;
            PG8_STAGE(PG8_SB(0, 1), b2 + hstepB, voffB);
            PG8_WAIT_V(6); PG8_BAR; PG8_MMA(1, 1, At, B1); PG8_BAR;
            PG8_LDB(B0, 1, 0); PG8_SCHED; PG8_LDA(At, 1, 0); PG8_STAGE(PG8_SA(0, 1), a2 + hstepA, voffA);
            PG8_WAIT_L(8); PG8_BAR; PG8_WAIT_L(0); PG8_MMA(0, 0, At, B0); PG8_BAR; PG8_SCHED;
            PG8_LDB(B1, 1, 1); PG8_STAGE(PG8_SB(1, 0), b3, voffB);
            PG8_BAR; PG8_WAIT_L(0); PG8_MMA(0, 1, At, B1); PG8_BAR;
            PG8_LDA(At, 1, 1); PG8_STAGE(PG8_SA(1, 0), a3, voffA);
            PG8_BAR; PG8_WAIT_L(0); PG8_MMA(1, 0, At, B0); PG8_BAR; PG8_SCHED;
            PG8_STAGE(PG8_SB(1, 1), b3 + hstepB, voffB);
            PG8_WAIT_V(6); PG8_BAR; PG8_MMA(1, 1, At, B1); PG8_BAR;
            }
        }
        if constexpr (ALIGN_EPI) { if (wr == 0) PG8_BAR; }
        if constexpr (!Epi::AFTER_DRAIN) { E(acc, cur, wr, wc, fr, fq); S.done(cur); }
        if (!has_next) break;
#pragma unroll
        for (int a = 0; a < 2; ++a)
#pragma unroll
            for (int b = 0; b < 2; ++b)
#pragma unroll
                for (int m = 0; m < 4; ++m)
#pragma unroll
                    for (int n = 0; n < 2; ++n) acc[a][b][m][n] = (f32x4){0.f, 0.f, 0.f, 0.f};
        cur = nxt; cA = nA; cB = nB; ++ui;
        if constexpr (ALIGN_EPI) { if (wr == 1) PG8_BAR; }
    }
    PG8_WAIT_V(0);
    if constexpr (!ALIGN_EPI) { if (wr == 0) PG8_BAR; }
    PG8_BAR;
    if constexpr (Epi::AFTER_DRAIN) { E.fused(acc, cur, wr, wc, fr, fq, lds, wid, lane); S.done(cur); }
#undef PG8_SA
#undef PG8_SB
#undef PG8_STAGE
#undef PG8_LDA
#undef PG8_LDB
#undef PG8_MMA
#undef PG8_WAIT_V
#undef PG8_WAIT_L
#undef PG8_BAR
#undef PG8_SCHED
}
}

typedef unsigned short bf16_t;
typedef short bf16x8 __attribute__((ext_vector_type(8)));
typedef short s16x4 __attribute__((ext_vector_type(4)));
typedef float f32x4 __attribute__((ext_vector_type(4)));
typedef float f32x16 __attribute__((ext_vector_type(16)));
typedef unsigned u32x4 __attribute__((ext_vector_type(4)));
typedef unsigned u32x2 __attribute__((ext_vector_type(2)));

constexpr int DM = 1024, NB = 8, SEQ = 2048, CTXL = 256, LT = SEQ + CTXL  , MROWS = NB * LT  ;
constexpr int EVEN_IN = 4608, ODD_IN = 5120, NCHUNK = LT / 64  ;
constexpr float RMS_EPS = 1e-6f, LOG2E = 1.4426950408889634f;
constexpr int LDS_BYTES = 160 * 1024;
constexpr int NPHASE = 22;

constexpr size_t WS_CTL = 0;
constexpr size_t WS_MOD = 65536;
constexpr size_t WS_ROPE = 524288;
constexpr size_t WS_AGG = 1048576;
constexpr size_t WS_HCTX = WS_AGG + 4718592;
constexpr size_t WS_WIN = WS_HCTX + 8388608;
constexpr size_t WS_WOUT = WS_WIN + 10485760;
constexpr size_t WS_WRG = WS_WOUT + 4194304;
constexpr size_t WS_OV = WS_WRG + 1048576;
constexpr size_t WS_P = WS_OV + 37748736;
constexpr size_t WS_END = WS_P + 188743680;
static_assert(WS_END <= 268435456, "workspace map exceeds 256 MiB");

struct Params {
    const float *x, *c, *ctx, *c_ctx, *ada_w, *ada_b, *norm_w, *ev_w_in, *ev_conv_w, *ev_conv_b, *ev_rg_wx, *ev_rg_bx, *ev_rg_wa, *ev_rg_ba,
        *ev_rg_lambda, *ev_sink, *ev_w_out, *od_w_in, *od_lb_raw, *od_gnorm_w, *od_w_out, *final_norm_w;
    float* out; unsigned char* ws; int ph_lo, ph_hi;
};

DI float bf2f(unsigned short v) { return __uint_as_float((unsigned)v << 16); }
DI unsigned f2bf(float f) { unsigned u = __float_as_uint(f); return (u + 0x7fffu + ((u >> 16) & 1u)) >> 16; }
DI unsigned pk2(float lo, float hi) { return f2bf(lo) | (f2bf(hi) << 16); }
DI float sigm(float x) { return 1.f / (1.f + __expf(-x)); }
DI float wave_sum(float v) {
#pragma unroll
    for (int o = 1; o < 64; o <<= 1) v += __shfl_xor(v, o);
    return v;
}
DI int crow(int reg, int h) { return (reg & 3) + 8 * (reg >> 2) + 4 * h; }
#define MFMA16(a, b, c) __builtin_amdgcn_mfma_f32_16x16x32_bf16((a), (b), (c), 0, 0, 0)
#define MFMA32(a, b, c) __builtin_amdgcn_mfma_f32_32x32x16_bf16((a), (b), (c), 0, 0, 0)

struct EpiStoreBf16 {
    static constexpr bool PERM = true, AFTER_DRAIN = false;
    bf16_t* O; int ldc;
    DI void operator()(const f32x4 (&acc)[2][2][4][2], const pg8::Unit& u, int wr, int wc, int fr, int fq) const {
        const int row0 = u.pm * 256 + wr * 64 + fr, col0 = u.pn * 256 + wc * 32 + 8 * fq;
#pragma unroll
        for (int ai = 0; ai < 2; ++ai)
#pragma unroll
            for (int m = 0; m < 4; ++m) { bf16_t* rowp = O + (size_t)(row0 + ai * 128 + m * 16) * ldc + col0;
#pragma unroll
                for (int bj = 0; bj < 2; ++bj) { const f32x4 v0 = acc[ai][bj][m][0], v1 = acc[ai][bj][m][1];
                    u32x4 w; w.x = pk2(v0[0], v0[1]); w.y = pk2(v0[2], v0[3]); w.z = pk2(v1[0], v1[1]); w.w = pk2(v1[2], v1[3]);
                    *(u32x4*)(rowp + bj * 128) = w; } }
    }
};
struct EpiResid {
    static constexpr bool PERM = false, AFTER_DRAIN = false;
    const float* in_lat; const float* in_ctx; float* out_lat; float* out_ctx; const float* gate;
    DI void operator()(const f32x4 (&acc)[2][2][4][2], const pg8::Unit& u, int wr, int wc, int fr, int fq) const {
        const int b = u.pm / 9, jt = u.pm % 9;
        const float* ib; float* ob; const float* g;
        if (jt == 0) { const size_t off = (size_t)b * CTXL * DM; ib = in_ctx + off; ob = out_ctx + off; g = gate + 8 * 3072; }
        else { const size_t off = ((size_t)b * SEQ + (size_t)(jt - 1) * 256) * DM; ib = in_lat + off; ob = out_lat + off; g = gate + b * 3072; }
        const int col0 = u.pn * 256 + wc * 32 + 4 * fq;
        f32x4 gv[2][2];
#pragma unroll
        for (int bj = 0; bj < 2; ++bj)
#pragma unroll
            for (int n = 0; n < 2; ++n) gv[bj][n] = *(const f32x4*)(g + col0 + bj * 128 + n * 16);
#pragma unroll
        for (int ai = 0; ai < 2; ++ai)
#pragma unroll
            for (int m = 0; m < 4; ++m) { const int r = ai * 128 + wr * 64 + m * 16 + fr;
#pragma unroll
                for (int bj = 0; bj < 2; ++bj)
#pragma unroll
                    for (int n = 0; n < 2; ++n) { const size_t off = (size_t)r * DM + col0 + bj * 128 + n * 16;
                        const f32x4 o = *(const f32x4*)(ib + off) + gv[bj][n] * acc[ai][bj][m][n]; *(f32x4*)(ob + off) = o; }
                asm volatile("" ::: "memory"); }
    }
};

DI void phase_pro(const Params& P, LAS unsigned char* lds) {
    const int tid = get_tid();
    LAS float* s = (LAS float*)lds;
    LAS float* red = (LAS float*)(lds + 36864);
    float* mod = (float*)(P.ws + WS_MOD);
    for (int i = tid; i < 9 * 1024; i += 512) { const int r = i >> 10, k = i & 1023; const float v = r < 8 ? P.c[r * 1024 + k] : P.c_ctx[k]; s[i] = v * sigm(v); }
    __syncthreads();
    for (int item = get_bid(); item < 384; item += gridDim.x) {
        const int l = item / 96, n0 = (item % 96) * 32, ks = tid >> 5, col = tid & 31;
        const float* w = P.ada_w + (size_t)l * 1024 * 3072 + n0 + col;
        float acc[9];
#pragma unroll
        for (int r = 0; r < 9; ++r) acc[r] = 0.f;
#pragma unroll 8
        for (int kk = 0; kk < 64; ++kk) { const int k = ks * 64 + kk; const float wv = w[(size_t)k * 3072];
#pragma unroll
            for (int r = 0; r < 9; ++r) acc[r] += s[r * 1024 + k] * wv; }
#pragma unroll
        for (int r = 0; r < 9; ++r) red[(ks * 9 + r) * 32 + col] = acc[r];
        __syncthreads();
        if (tid < 288) { const int r = tid >> 5, cc = tid & 31; float sum = 0.f;
#pragma unroll
            for (int k2 = 0; k2 < 16; ++k2) sum += red[(k2 * 9 + r) * 32 + cc];
            mod[(l * 9 + r) * 3072 + n0 + cc] = sum + P.ada_b[l * 3072 + n0 + cc]; }
        __syncthreads();
    }
    float* cos_t = (float*)(P.ws + WS_ROPE); float* sin_t = cos_t + SEQ * 32;
    for (int i = get_bid() * 512 + tid; i < SEQ * 32; i += gridDim.x * 512) {
        const int pos = i >> 5, jj = i & 31, fi = jj & 15;
        const float inv = powf(10000.f, -(float)(2 * fi) / 32.f);
        const float ang = (float)(jj < 16 ? (pos >> 6) : (pos & 63)) * inv;
        cos_t[i] = cosf(ang); sin_t[i] = sinf(ang);
    }
}

DI void transpose_item(const float* W, int K, int N, bf16_t* WT, LAS float* scr, int item, int lane) {
    const int nblk = N / 32, kb = item / nblk, nb = item % nblk, k0 = 64 * kb, n0 = 32 * nb;
#pragma unroll 8
    for (int i = 0; i < 32; ++i) { const int kk = 2 * i + (lane >> 5); scr[kk * 33 + (lane & 31)] = W[(size_t)(k0 + kk) * N + n0 + (lane & 31)]; }
    asm volatile("s_waitcnt lgkmcnt(0)" ::: "memory");
    const int c = lane & 7;
#pragma unroll
    for (int j = 0; j < 4; ++j) { const int n = (lane >> 3) + 8 * j; const LAS float* sp = scr + (8 * c) * 33 + n;
        u32x4 o; o.x = pk2(sp[0 * 33], sp[1 * 33]); o.y = pk2(sp[2 * 33], sp[3 * 33]); o.z = pk2(sp[4 * 33], sp[5 * 33]); o.w = pk2(sp[6 * 33], sp[7 * 33]);
        *(u32x4*)(WT + (size_t)(n0 + n) * K + k0 + 8 * c) = o; }
    asm volatile("s_waitcnt lgkmcnt(0)" ::: "memory");
}

DI void phase_norm(const Params& P, LAS unsigned char* lds, int layer) {
    const int tid = get_tid(), lane = tid & 63, wave = tid >> 6;
    const int gw = get_bid() * 8 + wave, NGW = gridDim.x * 8;
    const int j = layer >> 1;
    LAS float* scr = (LAS float*)(lds + wave * 16384);
    bf16_t* WIN = (bf16_t*)(P.ws + WS_WIN); bf16_t* WOUT = (bf16_t*)(P.ws + WS_WOUT); bf16_t* WRG = (bf16_t*)(P.ws + WS_WRG);
    if ((layer & 1) == 0) {
        constexpr int I_IN = 16 * (EVEN_IN / 32), I_OUT = 32 * 32, I_RG = 32 * 8;
        for (int it = gw; it < I_IN + I_OUT + I_RG; it += NGW) {
            int r = it;
            if (r < I_IN) { transpose_item(P.ev_w_in + (size_t)j * 1024 * EVEN_IN, 1024, EVEN_IN, WIN, scr, r, lane); continue; } r -= I_IN;
            if (r < I_OUT) { transpose_item(P.ev_w_out + (size_t)j * 2048 * 1024, 2048, 1024, WOUT, scr, r, lane); continue; } r -= I_OUT;
            const int mat = r >> 3, sub = r & 7;
            const int dir = mat >> 4, gate = (mat >> 3) & 1, hd = mat & 7;
            const float* src = (gate == 0 ? P.ev_rg_wx : P.ev_rg_wa) + ((size_t)((j * 2 + dir) * 8 + hd)) * 16384;
            transpose_item(src, 128, 128, WRG + (size_t)mat * 16384, scr, sub, lane);
        }
    } else {
        constexpr int I_IN = 16 * (ODD_IN / 32), I_OUT = 16 * 32;
        for (int it = gw; it < I_IN + I_OUT; it += NGW) {
            int r = it;
            if (r < I_IN) { transpose_item(P.od_w_in + (size_t)j * 1024 * ODD_IN, 1024, ODD_IN, WIN, scr, r, lane); continue; } r -= I_IN;
            transpose_item(P.od_w_out + (size_t)j * 1024 * 1024, 1024, 1024, WOUT, scr, r, lane);
        }
    }
    const float* hl = layer == 0 ? P.x : P.out; const float* hc = layer == 0 ? P.ctx : (const float*)(P.ws + WS_HCTX);
    const float* mod = (const float*)(P.ws + WS_MOD) + (size_t)layer * 9 * 3072;
    const float* nw = P.norm_w + layer * 1024;
    bf16_t* U = (bf16_t*)(P.ws + WS_OV);
    for (int R = gw; R < MROWS; R += NGW) {
        const int b = R / LT, jr = R % LT;
        const float* src = jr < CTXL ? hc + ((size_t)b * CTXL + jr) * DM : hl + ((size_t)b * SEQ + (jr - CTXL)) * DM;
        const float* sh = mod + (jr < CTXL ? 8 : b) * 3072; const float* sc = sh + 1024;
        f32x4 v[4]; float ss = 0.f;
#pragma unroll
        for (int q = 0; q < 4; ++q) { v[q] = *(const f32x4*)(src + 4 * lane + 256 * q); ss += (v[q][0] * v[q][0] + v[q][1] * v[q][1]) + (v[q][2] * v[q][2] + v[q][3] * v[q][3]); }
        const float rstd = rsqrtf(wave_sum(ss) * (1.f / DM) + RMS_EPS);
#pragma unroll
        for (int q = 0; q < 4; ++q) { const int k = 4 * lane + 256 * q;
            const f32x4 w4 = *(const f32x4*)(nw + k), s4 = *(const f32x4*)(sc + k), h4 = *(const f32x4*)(sh + k);
            const f32x4 y = (v[q] * rstd) * w4; const f32x4 o = y * (s4 + 1.f) + h4;
            u32x2 w; w.x = pk2(o[0], o[1]); w.y = pk2(o[2], o[3]); *(u32x2*)(U + (size_t)R * DM + k) = w; }
    }
}

template <bool PASS2>
DI void rglru_item(const Params& P, LAS unsigned char* lds, int j, int item) {
    const int tid = get_tid(), lane = tid & 63, wave = tid >> 6, r = lane & 15, g = lane >> 4;
    const int hd = item & 7, ci = (item >> 3) % NCHUNK, b = item / (8 * NCHUNK);
    bf16_t* p = (bf16_t*)(P.ws + WS_P);
    const bf16_t* WRG = (const bf16_t*)(P.ws + WS_WRG);
    float2* AGG = (float2*)(P.ws + WS_AGG);
    const int R0 = b * LT + ci * 64;
    const int seg_lo = b * LT + (ci < 4 ? 0 : CTXL), seg_hi = b * LT + (ci < 4 ? CTXL : LT);
    LAS bf16_t* UT = (LAS bf16_t*)lds;
    LAS float* AL = (LAS float*)(lds + 17408);
    LAS float* BL = (LAS float*)(lds + 17408 + 32768);
    LAS float* YL = (LAS float*)(lds + 17408 + 65536);
    LAS float* QA = (LAS float*)(lds + 17408 + 98304);
    LAS float* CAR = (LAS float*)(lds + 17408 + 98304 + 4096);
#pragma unroll
    for (int rep = 0; rep < 2; ++rep) {
        const int idx = tid + rep * 512, t = idx >> 4, c0 = (idx & 15) * 8, cg0 = hd * 128 + c0;
        float acc[8];
        { const f32x4 b0 = *(const f32x4*)(P.ev_conv_b + j * 1024 + cg0), b1 = *(const f32x4*)(P.ev_conv_b + j * 1024 + cg0 + 4);
          acc[0] = b0[0]; acc[1] = b0[1]; acc[2] = b0[2]; acc[3] = b0[3]; acc[4] = b1[0]; acc[5] = b1[1]; acc[6] = b1[2]; acc[7] = b1[3]; }
#pragma unroll
        for (int k = 0; k < 4; ++k) {
            const int Rg = R0 + t + k - 1;
            if (Rg >= seg_lo && Rg < seg_hi) {
                const u32x4 xv = *(const u32x4*)(p + (size_t)Rg * EVEN_IN + cg0);
                const float* wk = P.ev_conv_w + (size_t)(j * 4 + k) * 1024 + cg0;
                const f32x4 w0 = *(const f32x4*)wk, w1 = *(const f32x4*)(wk + 4);
                acc[0] += w0[0] * __uint_as_float(xv.x << 16); acc[1] += w0[1] * __uint_as_float(xv.x & 0xffff0000u);
                acc[2] += w0[2] * __uint_as_float(xv.y << 16); acc[3] += w0[3] * __uint_as_float(xv.y & 0xffff0000u);
                acc[4] += w1[0] * __uint_as_float(xv.z << 16); acc[5] += w1[1] * __uint_as_float(xv.z & 0xffff0000u);
                acc[6] += w1[2] * __uint_as_float(xv.w << 16); acc[7] += w1[3] * __uint_as_float(xv.w & 0xffff0000u);
            }
        }
        u32x4 o; o.x = pk2(acc[0], acc[1]); o.y = pk2(acc[2], acc[3]); o.z = pk2(acc[4], acc[5]); o.w = pk2(acc[6], acc[7]);
        *(LAS u32x4*)(UT + t * 136 + c0) = o;
    }
    if (PASS2) {
        if (tid < 256) {
            const int dir = tid >> 7, c = tid & 127;
            const int pos = dir == 0 ? ci : (ci < 4 ? 3 - ci : 39 - ci);
            float h = 0.f;
            for (int pp = 0; pp < pos; ++pp) {
                const int cc = dir == 0 ? pp : (pp < 4 ? 3 - pp : 39 - pp);
                const float2 ab = AGG[((size_t)(dir * NB + b) * NCHUNK + cc) * 1024 + hd * 128 + c];
                h = ab.x * h + ab.y;
            }
            CAR[dir * 128 + c] = h;
        }
    }
    __syncthreads();
#pragma unroll 1
    for (int dir = 0; dir < 2; ++dir) {
        f32x4 ax[4], aa[4];
#pragma unroll
        for (int m = 0; m < 4; ++m) { ax[m] = (f32x4){0.f, 0.f, 0.f, 0.f}; aa[m] = (f32x4){0.f, 0.f, 0.f, 0.f}; }
        const bf16_t* Wx = WRG + (size_t)((dir * 2 + 0) * 8 + hd) * 16384 + (16 * wave + r) * 128 + 8 * g;
        const bf16_t* Wa = WRG + (size_t)((dir * 2 + 1) * 8 + hd) * 16384 + (16 * wave + r) * 128 + 8 * g;
#pragma unroll
        for (int ks = 0; ks < 4; ++ks) {
            const bf16x8 bx = *(const bf16x8*)(Wx + 32 * ks), ba = *(const bf16x8*)(Wa + 32 * ks);
#pragma unroll
            for (int m = 0; m < 4; ++m) {
                const bf16x8 a = *(const LAS bf16x8*)(UT + (16 * m + r) * 136 + 32 * ks + 8 * g);
                ax[m] = MFMA16(a, bx, ax[m]); aa[m] = MFMA16(a, ba, aa[m]);
            }
        }
        {
            const int c = 16 * wave + r, idx = (j * 2 + dir) * 1024 + hd * 128 + c;
            const float bxv = P.ev_rg_bx[idx], bav = P.ev_rg_ba[idx], lam = P.ev_rg_lambda[idx];
            const float sp = log1pf(__expf(-lam));
#pragma unroll
            for (int m = 0; m < 4; ++m)
#pragma unroll
                for (int i = 0; i < 4; ++i) {
                    const int t = 16 * m + 4 * g + i;
                    const float gx = sigm(ax[m][i] + bxv), ga = sigm(aa[m][i] + bav);
                    const float la = -8.f * ga * sp;
                    const float a = __expf(la), mult = sqrtf(-expm1f(2.f * la));
                    const float uv = bf2f(UT[t * 136 + c]);
                    AL[t * 128 + c] = a; BL[t * 128 + c] = mult * gx * uv;
                }
        }
        __syncthreads();
        {
            const int c = tid & 127, q = tid >> 7;
            float A = 1.f, B = 0.f;
#pragma unroll
            for (int s = 0; s < 16; ++s) { const int t = dir == 0 ? 16 * q + s : 16 * q + 15 - s; const float a = AL[t * 128 + c], bb = BL[t * 128 + c]; B = a * B + bb; A *= a; }
            QA[(q * 128 + c) * 2] = A; QA[(q * 128 + c) * 2 + 1] = B;
            __syncthreads();
            if (!PASS2) {
                if (q == 0) {
                    float CA = 1.f, CB = 0.f;
#pragma unroll
                    for (int qq = 0; qq < 4; ++qq) { const int qi = dir == 0 ? qq : 3 - qq; const float a = QA[(qi * 128 + c) * 2], bb = QA[(qi * 128 + c) * 2 + 1]; CB = a * CB + bb; CA *= a; }
                    AGG[((size_t)(dir * NB + b) * NCHUNK + ci) * 1024 + hd * 128 + c] = make_float2(CA, CB);
                }
            } else {
                float h = CAR[dir * 128 + c];
                const int nprev = dir == 0 ? q : 3 - q;
                for (int qq = 0; qq < nprev; ++qq) { const int qi = dir == 0 ? qq : 3 - qq; h = QA[(qi * 128 + c) * 2] * h + QA[(qi * 128 + c) * 2 + 1]; }
#pragma unroll
                for (int s = 0; s < 16; ++s) { const int t = dir == 0 ? 16 * q + s : 16 * q + 15 - s; h = AL[t * 128 + c] * h + BL[t * 128 + c];
                    if (dir == 0) YL[t * 128 + c] = h; else YL[t * 128 + c] += h; }
            }
        }
        __syncthreads();
    }
    if (PASS2) {
#pragma unroll
        for (int rep = 0; rep < 2; ++rep) {
            const int idx = tid + rep * 512, t = idx >> 4, c0 = (idx & 15) * 8;
            bf16_t* gp = p + (size_t)(R0 + t) * EVEN_IN + 1536 + hd * 128 + c0;
            const u32x4 gv = *(const u32x4*)gp;
            const f32x4 y0 = *(const LAS f32x4*)(YL + t * 128 + c0), y1 = *(const LAS f32x4*)(YL + t * 128 + c0 + 4);
            float gg[8] = {__uint_as_float(gv.x << 16), __uint_as_float(gv.x & 0xffff0000u), __uint_as_float(gv.y << 16), __uint_as_float(gv.y & 0xffff0000u),
                           __uint_as_float(gv.z << 16), __uint_as_float(gv.z & 0xffff0000u), __uint_as_float(gv.w << 16), __uint_as_float(gv.w & 0xffff0000u)};
            u32x4 o;
            o.x = pk2(y0[0] * gg[0] * sigm(gg[0]), y0[1] * gg[1] * sigm(gg[1])); o.y = pk2(y0[2] * gg[2] * sigm(gg[2]), y0[3] * gg[3] * sigm(gg[3]));
            o.z = pk2(y1[0] * gg[4] * sigm(gg[4]), y1[1] * gg[5] * sigm(gg[5])); o.w = pk2(y1[2] * gg[6] * sigm(gg[6]), y1[3] * gg[7] * sigm(gg[7]));
            *(u32x4*)gp = o;
        }
        __syncthreads();
    }
}

DI void rope8(u32x4& v, const float* cs, const float* sn) {
    unsigned* w = (unsigned*)&v;
#pragma unroll
    for (int i = 0; i < 4; ++i) { const float t1 = __uint_as_float(w[i] << 16), t2 = __uint_as_float(w[i] & 0xffff0000u); w[i] = pk2(t1 * cs[i] - t2 * sn[i], t1 * sn[i] + t2 * cs[i]); }
}
DI void attn_item(const Params& P, LAS unsigned char* lds, int j, int item) {
    const int tid = get_tid(), lane = tid & 63, wave = tid >> 6, r = lane & 31, h = lane >> 5;
    const bool is_lat = item < 512;
    int b, qb, kvh;
    if (is_lat) { b = item >> 6; qb = (item >> 2) & 15; kvh = item & 3; } else { const int it = item - 512; b = it >> 3; qb = (it >> 2) & 1; kvh = it & 3; }
    bf16_t* p = (bf16_t*)(P.ws + WS_P);
    const float* cos_t = (const float*)(P.ws + WS_ROPE); const float* sin_t = cos_t + SEQ * 32;
    LAS unsigned char* KL = lds;
    LAS unsigned char* VT = lds + 9216;
    const int hq = 4 * kvh + (wave >> 1), ql0 = qb * 128 + 64 * (wave & 1);
    const size_t rowbase = (size_t)b * LT + (is_lat ? CTXL : 0);
    LAS unsigned char* QL = lds + 18432 + wave * 9216;
#pragma unroll
    for (int qt = 0; qt < 2; ++qt) {
        const int qi = ql0 + 32 * qt + r;
        const bf16_t* qp = p + (rowbase + qi) * EVEN_IN + 2560 + hq * 64 + 8 * h;
#pragma unroll
        for (int ks = 0; ks < 4; ++ks) {
            u32x4 v = *(const u32x4*)(qp + 16 * ks);
            if (is_lat) rope8(v, cos_t + qi * 32 + 8 * ks + 4 * h, sin_t + qi * 32 + 8 * ks + 4 * h);
            *(LAS u32x4*)(QL + (32 * qt + r) * 144 + (16 * ks + 8 * h) * 2) = v;
        }
    }
    const float sink2 = P.ev_sink[j * 16 + hq] * LOG2E;
    float mrun[2] = {sink2, sink2}, lrun[2] = {h == 0 ? 1.f : 0.f, h == 0 ? 1.f : 0.f};
    f32x16 O[2][2];
#pragma unroll
    for (int a = 0; a < 2; ++a)
#pragma unroll
        for (int c = 0; c < 2; ++c)
#pragma unroll
            for (int i = 0; i < 16; ++i) O[a][c][i] = 0.f;
    const int ntiles = is_lat ? 10 : 4;
    const float SC = 0.125f * LOG2E, NEG = -1e30f;
#pragma unroll 1
    for (int ti = 0; ti < ntiles; ++ti) {
        const bool win = ti >= 4;
        const int k0 = win ? qb * 128 - 128 + 64 * (ti - 4) : 64 * ti;
        if (win && (k0 < 0 || k0 >= SEQ)) continue;
        __syncthreads();
        {
            const int key = tid >> 3, chn = tid & 7;
            const bf16_t* kp = p + ((size_t)b * LT + (win ? CTXL : 0) + k0 + key) * EVEN_IN + 1024 + kvh * 64 + 8 * chn;
            u32x4 kv = *(const u32x4*)kp;
            if (win) rope8(kv, cos_t + (k0 + key) * 32 + 4 * chn, sin_t + (k0 + key) * 32 + 4 * chn);
            *(LAS u32x4*)(KL + key * 144 + chn * 16) = kv;
            const u32x4 vv = *(const u32x4*)(kp + 256);
            const unsigned* vw = (const unsigned*)&vv;
#pragma unroll
            for (int e = 0; e < 4; ++e) {
                *(LAS unsigned short*)(VT + (8 * chn + 2 * e) * 144 + key * 2) = (unsigned short)(vw[e] & 0xffffu);
                *(LAS unsigned short*)(VT + (8 * chn + 2 * e + 1) * 144 + key * 2) = (unsigned short)(vw[e] >> 16);
            }
        }
        __syncthreads();
#pragma unroll
        for (int qt = 0; qt < 2; ++qt) {
            f32x16 s0, s1;
#pragma unroll
            for (int i = 0; i < 16; ++i) { s0[i] = 0.f; s1[i] = 0.f; }
#pragma unroll
            for (int ks = 0; ks < 4; ++ks) {
                const bf16x8 qfr = *(const LAS bf16x8*)(QL + (32 * qt + r) * 144 + (16 * ks + 8 * h) * 2);
                const bf16x8 k0f = *(const LAS bf16x8*)(KL + r * 144 + (16 * ks + 8 * h) * 2), k1f = *(const LAS bf16x8*)(KL + (32 + r) * 144 + (16 * ks + 8 * h) * 2);
                s0 = MFMA32(k0f, qfr, s0); s1 = MFMA32(k1f, qfr, s1);
            }
            const int qpos = ql0 + 32 * qt + r;
            float mx = NEG;
#pragma unroll
            for (int i = 0; i < 16; ++i) {
                const int kp0 = k0 + crow(i, h), kp1 = kp0 + 32;
                float v0 = s0[i] * SC, v1 = s1[i] * SC;
                if (win) { const int d0 = qpos - kp0, d1 = qpos - kp1; if (d0 > 128 || d0 < -128) v0 = NEG; if (d1 > 128 || d1 < -128) v1 = NEG; }
                s0[i] = v0; s1[i] = v1; mx = fmaxf(mx, fmaxf(v0, v1));
            }
            mx = fmaxf(mx, __shfl_xor(mx, 32));
            const float mn = fmaxf(mrun[qt], mx), alpha = __builtin_amdgcn_exp2f(mrun[qt] - mn);
            mrun[qt] = mn;
            float ls = 0.f;
#pragma unroll
            for (int i = 0; i < 16; ++i) { s0[i] = __builtin_amdgcn_exp2f(s0[i] - mn); s1[i] = __builtin_amdgcn_exp2f(s1[i] - mn); ls += s0[i] + s1[i]; }
            lrun[qt] = lrun[qt] * alpha + ls;
#pragma unroll
            for (int dt = 0; dt < 2; ++dt)
#pragma unroll
                for (int i = 0; i < 16; ++i) O[dt][qt][i] *= alpha;
            bf16x8 pf[2][2];
#pragma unroll
            for (int s = 0; s < 2; ++s) {
                u32x4 a, c;
                a.x = pk2(s0[8 * s + 0], s0[8 * s + 1]); a.y = pk2(s0[8 * s + 2], s0[8 * s + 3]); a.z = pk2(s0[8 * s + 4], s0[8 * s + 5]); a.w = pk2(s0[8 * s + 6], s0[8 * s + 7]);
                c.x = pk2(s1[8 * s + 0], s1[8 * s + 1]); c.y = pk2(s1[8 * s + 2], s1[8 * s + 3]); c.z = pk2(s1[8 * s + 4], s1[8 * s + 5]); c.w = pk2(s1[8 * s + 6], s1[8 * s + 7]);
                pf[0][s] = __builtin_bit_cast(bf16x8, a); pf[1][s] = __builtin_bit_cast(bf16x8, c);
            }
#pragma unroll
            for (int dt = 0; dt < 2; ++dt)
#pragma unroll
                for (int kt = 0; kt < 2; ++kt)
#pragma unroll
                    for (int s = 0; s < 2; ++s) {
                        const LAS unsigned char* vp = VT + (32 * dt + r) * 144 + (32 * kt + 16 * s + 4 * h) * 2;
                        const u32x2 lo = *(const LAS u32x2*)vp, hi = *(const LAS u32x2*)(vp + 16);
                        const u32x4 vv = {lo.x, lo.y, hi.x, hi.y};
                        O[dt][qt] = MFMA32(__builtin_bit_cast(bf16x8, vv), pf[kt][s], O[dt][qt]);
                    }
            __builtin_amdgcn_sched_barrier(0);
        }
    }
#pragma unroll
    for (int qt = 0; qt < 2; ++qt) {
        const float lt = lrun[qt] + __shfl_xor(lrun[qt], 32), inv = 1.f / lt;
        const int qi = ql0 + 32 * qt + r;
        bf16_t* rowp = p + (rowbase + qi) * EVEN_IN;
#pragma unroll
        for (int dt = 0; dt < 2; ++dt)
#pragma unroll
            for (int i4 = 0; i4 < 4; ++i4) {
                const int d0 = 32 * dt + 8 * i4 + 4 * h;
                const u32x2 gv = *(const u32x2*)(rowp + 3584 + hq * 64 + d0);
                const float g0 = __uint_as_float(gv.x << 16), g1 = __uint_as_float(gv.x & 0xffff0000u), g2 = __uint_as_float(gv.y << 16), g3 = __uint_as_float(gv.y & 0xffff0000u);
                u32x2 o;
                o.x = pk2(O[dt][qt][4 * i4 + 0] * inv * g0 * sigm(g0), O[dt][qt][4 * i4 + 1] * inv * g1 * sigm(g1));
                o.y = pk2(O[dt][qt][4 * i4 + 2] * inv * g2 * sigm(g2), O[dt][qt][4 * i4 + 3] * inv * g3 * sigm(g3));
                *(u32x2*)(rowp + 2560 + hq * 64 + d0) = o;
            }
    }
    __syncthreads();
}

constexpr int GL_QI = 0, GL_Q1 = 17408, GL_KF = 34816, GL_K2T = 78336, GL_VT = 96768, GL_AM = 101376, GL_ST = 110592, GL_PS = 128000, GL_BL = 130048, GL_ZT = 130560, GL_QT = 146944, GL_END = 163328;
static_assert(GL_END <= LDS_BYTES, "GLA LDS map");

template <int DIR>
DI void gla_step(const Params& P, LAS unsigned char* lds, int layer_j, int b, int hd, int eq, int step, f32x4 (&st)[2]) {
    const int tid = get_tid(), lane = tid & 63, wave = tid >> 6, r = lane & 15, g = lane >> 4;
    const bf16_t* p = (const bf16_t*)(P.ws + WS_P);
    bf16_t* OVb = (bf16_t*)(P.ws + WS_OV);
    LAS bf16_t* QI = (LAS bf16_t*)(lds + GL_QI); LAS bf16_t* Q1 = (LAS bf16_t*)(lds + GL_Q1); LAS bf16_t* KF = (LAS bf16_t*)(lds + GL_KF);
    LAS bf16_t* K2T = (LAS bf16_t*)(lds + GL_K2T); LAS bf16_t* VT = (LAS bf16_t*)(lds + GL_VT); LAS bf16_t* AM = (LAS bf16_t*)(lds + GL_AM);
    LAS bf16_t* ST = (LAS bf16_t*)(lds + GL_ST + DIR * 8704); LAS float* PS = (LAS float*)(lds + GL_PS); LAS float* BLAST = (LAS float*)(lds + GL_BL);
    const int chunk = DIR == 0 ? step : (step < 4 ? 3 - step : 39 - step);
    const int other_pos = DIR == 0 ? (chunk < 4 ? 3 - chunk : 39 - chunk) : chunk;
    const bool second = other_pos < step || (other_pos == step && DIR == 1);
    const size_t Rc0 = (size_t)b * LT + (size_t)chunk * 64;
    LAS bf16_t* ZT = (LAS bf16_t*)(lds + GL_ZT); LAS bf16_t* QT = (LAS bf16_t*)(lds + GL_QT);
#pragma unroll
    for (int rep = 0; rep < 2; ++rep) {
        const int idx = tid + rep * 512, tau = idx >> 4, c0 = (idx & 15) * 8;
        const size_t R = Rc0 + (DIR == 0 ? tau : 63 - tau);
        const u32x4 zv = *(const u32x4*)(p + R * ODD_IN + DIR * 1024 + hd * 128 + c0);
        const u32x4 qv = *(const u32x4*)(p + R * ODD_IN + 3072 + hd * 128 + c0);
        *(LAS u32x4*)(ZT + tau * 128 + c0) = zv; *(LAS u32x4*)(QT + tau * 128 + c0) = qv;
    }
    if (tid < 256) {
        const int tau = tid >> 2, chn = tid & 3;
        const size_t R = Rc0 + (DIR == 0 ? tau : 63 - tau);
        const u32x4 vv = *(const u32x4*)(p + R * ODD_IN + 2048 + hd * 128 + eq * 32 + 8 * chn);
        const unsigned* vw = (const unsigned*)&vv;
#pragma unroll
        for (int e = 0; e < 4; ++e) { VT[(8 * chn + 2 * e) * 72 + tau] = (bf16_t)(vw[e] & 0xffffu); VT[(8 * chn + 2 * e + 1) * 72 + tau] = (bf16_t)(vw[e] >> 16); }
    }
    __syncthreads();
    {
        const int d = tid & 127, I = tid >> 7, cgl = hd * 128 + d;
        float lbv = 0.f;
        if (layer_j > 0) lbv = sigm(P.od_lb_raw[1024 + cgl] - P.od_lb_raw[cgl]);
        const float omlb = 1.f - lbv;
        float e0[16], kk[16], qq[16];
        float run = 1.f;
#pragma unroll
        for (int s = 0; s < 16; ++s) {
            const int tau = 16 * I + s;
            const float z = bf2f(ZT[tau * 128 + d]);
            const float tz = __expf(-z), sg = 1.f / (1.f + tz);
            float f = lbv + omlb * sg; f = fmaxf(f, 1e-30f);
            kk[s] = omlb * (tz * sg);
            run = fmaxf(run * f, 1e-35f); e0[s] = run;
            const float qr = bf2f(QT[tau * 128 + d]);
            qq[s] = qr * sigm(qr);
        }
        PS[I * 128 + d] = run;
        __syncthreads();
        const float P0 = PS[d], P1 = PS[128 + d], P2 = PS[256 + d], P3 = PS[384 + d];
        const float RI = I == 0 ? 1.f : (I == 1 ? P0 : (I == 2 ? P0 * P1 : P0 * P1 * P2));
        float fac[4]; float cur = 1.f;
        fac[0] = cur; if (I <= 0) cur *= P0;
        fac[1] = cur; if (I <= 1) cur *= P1;
        fac[2] = cur; if (I <= 2) cur *= P2;
        fac[3] = cur; cur *= P3;
        const float f4 = cur;
        if (I == 0) BLAST[d] = P0 * P1 * P2 * P3;
#pragma unroll
        for (int s = 0; s < 16; ++s) {
            const int tau = 16 * I + s;
            const float qi = qq[s] * e0[s], kd = kk[s] * (1.f / e0[s]);
            QI[tau * 136 + d] = (bf16_t)f2bf(qi); Q1[tau * 136 + d] = (bf16_t)f2bf(qi * RI);
            if (I <= 0) KF[(0 + tau) * 136 + d] = (bf16_t)f2bf(kd * fac[0]);
            if (I <= 1) KF[(16 + tau) * 136 + d] = (bf16_t)f2bf(kd * fac[1]);
            if (I <= 2) KF[(48 + tau) * 136 + d] = (bf16_t)f2bf(kd * fac[2]);
            KF[(96 + tau) * 136 + d] = (bf16_t)f2bf(kd * fac[3]);
            K2T[d * 72 + tau] = (bf16_t)f2bf(kd * f4);
        }
    }
    __syncthreads();
#pragma unroll 1
    for (int bi = wave; bi < 10; bi += 8) {
        const int I = bi < 1 ? 0 : (bi < 3 ? 1 : (bi < 6 ? 2 : 3)), J = bi - (I * (I + 1)) / 2;
        const int foff = I == 0 ? 0 : (I == 1 ? 16 : (I == 2 ? 48 : 96));
        f32x4 acc = {0.f, 0.f, 0.f, 0.f};
#pragma unroll
        for (int ks = 0; ks < 4; ++ks) {
            const bf16x8 a = *(const LAS bf16x8*)(QI + (16 * I + r) * 136 + 32 * ks + 8 * g);
            const bf16x8 bb = *(const LAS bf16x8*)(KF + (foff + 16 * J + r) * 136 + 32 * ks + 8 * g);
            acc = MFMA16(a, bb, acc);
        }
#pragma unroll
        for (int i = 0; i < 4; ++i) { float v = acc[i]; if (J == I && r > 4 * g + i) v = 0.f; AM[(16 * I + 4 * g + i) * 72 + 16 * J + r] = (bf16_t)f2bf(v); }
    }
    __syncthreads();
    {
        const int tt = wave >> 1, et = wave & 1;
        f32x4 acc = {0.f, 0.f, 0.f, 0.f};
#pragma unroll
        for (int ks = 0; ks < 4; ++ks) {
            const bf16x8 a = *(const LAS bf16x8*)(Q1 + (16 * tt + r) * 136 + 32 * ks + 8 * g);
            const bf16x8 bb = *(const LAS bf16x8*)(ST + (16 * et + r) * 136 + 32 * ks + 8 * g);
            acc = MFMA16(a, bb, acc);
        }
#pragma unroll
        for (int ks = 0; ks < 2; ++ks) {
            const bf16x8 a = *(const LAS bf16x8*)(AM + (16 * tt + r) * 72 + 32 * ks + 8 * g);
            const bf16x8 bb = *(const LAS bf16x8*)(VT + (16 * et + r) * 72 + 32 * ks + 8 * g);
            acc = MFMA16(a, bb, acc);
        }
#pragma unroll
        for (int i = 0; i < 4; ++i) {
            const int tau = 16 * tt + 4 * g + i;
            const size_t R = Rc0 + (DIR == 0 ? tau : 63 - tau);
            bf16_t* op = OVb + R * DM + hd * 128 + eq * 32 + 16 * et + r;
            float v = acc[i];
            if (second) v += bf2f(__hip_atomic_load(op, __ATOMIC_RELAXED, __HIP_MEMORY_SCOPE_AGENT));
            *op = (bf16_t)f2bf(v);
        }
    }
    {
        float bl[4];
#pragma unroll
        for (int i = 0; i < 4; ++i) bl[i] = BLAST[16 * wave + 4 * g + i];
#pragma unroll
        for (int et = 0; et < 2; ++et) {
#pragma unroll
            for (int i = 0; i < 4; ++i) st[et][i] *= bl[i];
#pragma unroll
            for (int ks = 0; ks < 2; ++ks) {
                const bf16x8 a = *(const LAS bf16x8*)(K2T + (16 * wave + r) * 72 + 32 * ks + 8 * g);
                const bf16x8 bb = *(const LAS bf16x8*)(VT + (16 * et + r) * 72 + 32 * ks + 8 * g);
                st[et] = MFMA16(a, bb, st[et]);
            }
        }
    }
    __syncthreads();
#pragma unroll
    for (int et = 0; et < 2; ++et) {
        u32x2 w; w.x = pk2(st[et][0], st[et][1]); w.y = pk2(st[et][2], st[et][3]);
        *(LAS u32x2*)(ST + (16 * et + r) * 136 + 16 * wave + 4 * g) = w;
    }
}

DI void gla_item(const Params& P, LAS unsigned char* lds, int layer_j, int item) {
    const int tid = get_tid();
    const int b = item >> 5, hd = (item >> 2) & 7, eq = item & 3;
    for (int i = tid; i < (9216 + 17408) / 4; i += 512) ((LAS unsigned*)(lds + GL_AM))[i] = 0u;
    f32x4 sf[2], sb[2];
#pragma unroll
    for (int e = 0; e < 2; ++e) { sf[e] = (f32x4){0.f, 0.f, 0.f, 0.f}; sb[e] = (f32x4){0.f, 0.f, 0.f, 0.f}; }
    __syncthreads();
#pragma unroll 1
    for (int step = 0; step < NCHUNK; ++step) {
        gla_step<0>(P, lds, layer_j, b, hd, eq, step, sf);
        __syncthreads();
        gla_step<1>(P, lds, layer_j, b, hd, eq, step, sb);
        __syncthreads();
    }
}

DI void phase_readout(const Params& P, int layer_j) {
    const int tid = get_tid(), lane = tid & 63, wave = tid >> 6;
    const int gw = get_bid() * 8 + wave, NGW = gridDim.x * 8;
    const bf16_t* OVb = (const bf16_t*)(P.ws + WS_OV); bf16_t* p = (bf16_t*)(P.ws + WS_P);
    const float* gwt = P.od_gnorm_w + layer_j * 128 + (lane & 7) * 16;
    for (int R = gw; R < MROWS; R += NGW) {
        const bf16_t* op = OVb + (size_t)R * DM + 16 * lane; bf16_t* yp = p + (size_t)R * ODD_IN + 4096 + 16 * lane;
        const u32x4 o0 = *(const u32x4*)op, o1 = *(const u32x4*)(op + 8), g0 = *(const u32x4*)yp, g1 = *(const u32x4*)(yp + 8);
        float ov[16], gv[16];
        const unsigned* ow0 = (const unsigned*)&o0; const unsigned* ow1 = (const unsigned*)&o1; const unsigned* gw0 = (const unsigned*)&g0; const unsigned* gw1 = (const unsigned*)&g1;
#pragma unroll
        for (int i = 0; i < 4; ++i) {
            ov[2 * i] = __uint_as_float(ow0[i] << 16); ov[2 * i + 1] = __uint_as_float(ow0[i] & 0xffff0000u); ov[8 + 2 * i] = __uint_as_float(ow1[i] << 16); ov[8 + 2 * i + 1] = __uint_as_float(ow1[i] & 0xffff0000u);
            gv[2 * i] = __uint_as_float(gw0[i] << 16); gv[2 * i + 1] = __uint_as_float(gw0[i] & 0xffff0000u); gv[8 + 2 * i] = __uint_as_float(gw1[i] << 16); gv[8 + 2 * i + 1] = __uint_as_float(gw1[i] & 0xffff0000u);
        }
        float ss = 0.f;
#pragma unroll
        for (int i = 0; i < 16; ++i) ss += ov[i] * ov[i];
        ss += __shfl_xor(ss, 1); ss += __shfl_xor(ss, 2); ss += __shfl_xor(ss, 4);
        const float rstd = rsqrtf(ss * (1.f / 128.f) + RMS_EPS);
        float y[16];
#pragma unroll
        for (int i = 0; i < 16; ++i) y[i] = ov[i] * rstd * gwt[i] * (gv[i] * sigm(gv[i]));
        u32x4 w0, w1;
        w0.x = pk2(y[0], y[1]); w0.y = pk2(y[2], y[3]); w0.z = pk2(y[4], y[5]); w0.w = pk2(y[6], y[7]);
        w1.x = pk2(y[8], y[9]); w1.y = pk2(y[10], y[11]); w1.z = pk2(y[12], y[13]); w1.w = pk2(y[14], y[15]);
        *(u32x4*)yp = w0; *(u32x4*)(yp + 8) = w1;
    }
}

DI void phase_final(const Params& P) {
    const int tid = get_tid(), lane = tid & 63, wave = tid >> 6;
    const int gw = get_bid() * 8 + wave, NGW = gridDim.x * 8;
    for (int R = gw; R < NB * SEQ; R += NGW) {
        float* row = P.out + (size_t)R * DM;
        f32x4 v[4]; float ss = 0.f;
#pragma unroll
        for (int q = 0; q < 4; ++q) { v[q] = *(const f32x4*)(row + 4 * lane + 256 * q); ss += (v[q][0] * v[q][0] + v[q][1] * v[q][1]) + (v[q][2] * v[q][2] + v[q][3] * v[q][3]); }
        const float rstd = rsqrtf(wave_sum(ss) * (1.f / DM) + RMS_EPS);
#pragma unroll
        for (int q = 0; q < 4; ++q) { const f32x4 w4 = *(const f32x4*)(P.final_norm_w + 4 * lane + 256 * q); *(f32x4*)(row + 4 * lane + 256 * q) = (v[q] * rstd) * w4; }
    }
}

constexpr int PARAM_OFF = LDS_BYTES - 256;
static_assert(GL_END <= PARAM_OFF && sizeof(Params) <= 256, "LDS map");
DI const float* ld_uptr(const LAS unsigned long long* s, int i) {
    const unsigned long long v = s[i];
    const unsigned lo = __builtin_amdgcn_readfirstlane((unsigned)v), hi = __builtin_amdgcn_readfirstlane((unsigned)(v >> 32));
    return (const float*)(((unsigned long long)hi << 32) | lo);
}
DI Params load_params(LAS unsigned char* lds) {
    LAS unsigned char* pb = lds + PARAM_OFF; asm volatile("" : "+v"(pb));
    const LAS unsigned long long* s = (const LAS unsigned long long*)pb;
    Params Q;
    Q.x = ld_uptr(s, 0); Q.c = ld_uptr(s, 1); Q.ctx = ld_uptr(s, 2); Q.c_ctx = ld_uptr(s, 3); Q.ada_w = ld_uptr(s, 4); Q.ada_b = ld_uptr(s, 5); Q.norm_w = ld_uptr(s, 6);
    Q.ev_w_in = ld_uptr(s, 7); Q.ev_conv_w = ld_uptr(s, 8); Q.ev_conv_b = ld_uptr(s, 9); Q.ev_rg_wx = ld_uptr(s, 10); Q.ev_rg_bx = ld_uptr(s, 11); Q.ev_rg_wa = ld_uptr(s, 12);
    Q.ev_rg_ba = ld_uptr(s, 13); Q.ev_rg_lambda = ld_uptr(s, 14); Q.ev_sink = ld_uptr(s, 15); Q.ev_w_out = ld_uptr(s, 16); Q.od_w_in = ld_uptr(s, 17); Q.od_lb_raw = ld_uptr(s, 18);
    Q.od_gnorm_w = ld_uptr(s, 19); Q.od_w_out = ld_uptr(s, 20); Q.final_norm_w = ld_uptr(s, 21); Q.out = (float*)ld_uptr(s, 22); Q.ws = (unsigned char*)ld_uptr(s, 23);
    Q.ph_lo = 0; Q.ph_hi = 0;
    return Q;
}
DI void run_phase(LAS unsigned char* lds, int ph) {
    #ifndef PHMASK
#define PHMASK 0xffff
#endif
    if (ph == 0) { if (PHMASK & 1) { const Params P = load_params(lds); phase_pro(P, lds); } return; }
    if (ph == NPHASE - 1) { if (PHMASK & 2) { const Params P = load_params(lds); phase_final(P); } return; }
    const int layer = (ph - 1) / 5, sub = (ph - 1) % 5, j = layer >> 1;
    const bool even = (layer & 1) == 0;
    if (sub == 0) { if (PHMASK & 4) { const Params P = load_params(lds); phase_norm(P, lds, layer); } return; }
    if (sub == 1) {
        const Params P = load_params(lds); bf16_t* pbuf = (bf16_t*)(P.ws + WS_P);
        const int N = even ? EVEN_IN : ODD_IN;
        pg8::Gemm gm{(const bf16_t*)(P.ws + WS_OV), (const bf16_t*)(P.ws + WS_WIN), MROWS, N, 1024, 1024};
        pg8::StaticOrder S; S.init(MROWS, N, (int)gridDim.x, get_bid());
        EpiStoreBf16 E{pbuf, N};
        if (PHMASK & 8) pg8::gemm_phase<EpiStoreBf16, pg8::StaticOrder, true, true>(lds, gm, S, E);
        return;
    }
    if (sub == 2) {
        const Params P = load_params(lds);
        if (even) {
            for (int it = get_bid(); it < 576 + NB * NCHUNK * 8; it += gridDim.x) {
                if (it < 576) { if (PHMASK & 16) attn_item(P, lds, j, it); } else { if (PHMASK & 32) rglru_item<false>(P, lds, j, it - 576); }
            }
        } else {
            for (int it = get_bid(); it < 256; it += gridDim.x) { if (PHMASK & 64) gla_item(P, lds, j, it); }
        }
        return;
    }
    if (sub == 3) {
        const Params P = load_params(lds);
        if (even) { for (int it = get_bid(); it < NB * NCHUNK * 8; it += gridDim.x) { if (PHMASK & 128) rglru_item<true>(P, lds, j, it); } }
        else { if (PHMASK & 256) phase_readout(P, j); }
        return;
    }
    {
        const Params P = load_params(lds); bf16_t* pbuf = (bf16_t*)(P.ws + WS_P);
        const int K = even ? 2048 : 1024, lda = even ? EVEN_IN : ODD_IN;
        pg8::Gemm gm{pbuf + (even ? 1536 : 4096), (const bf16_t*)(P.ws + WS_WOUT), MROWS, 1024, K, lda};
        pg8::StaticOrder S; S.init(MROWS, 1024, (int)gridDim.x, get_bid());
        const float* hl = layer == 0 ? P.x : P.out; const float* hc = layer == 0 ? P.ctx : (const float*)(P.ws + WS_HCTX);
        EpiResid E{hl, hc, P.out, (float*)(P.ws + WS_HCTX), (const float*)(P.ws + WS_MOD) + (size_t)layer * 9 * 3072 + 2048};
        if (PHMASK & 512) pg8::gemm_phase<EpiResid, pg8::StaticOrder, true, true>(lds, gm, S, E);
    }
}

__global__ void __launch_bounds__(512, 2) mega(Params P) {
    extern __shared__ __attribute__((aligned(16))) unsigned char lds_raw[];
    LAS unsigned char* lds = (LAS unsigned char*)lds_raw;
    cg::grid_group grid = cg::this_grid();
    if (threadIdx.x == 0) {
        LAS unsigned long long* d = (LAS unsigned long long*)(lds + PARAM_OFF);
        d[0] = (unsigned long long)P.x; d[1] = (unsigned long long)P.c; d[2] = (unsigned long long)P.ctx; d[3] = (unsigned long long)P.c_ctx; d[4] = (unsigned long long)P.ada_w;
        d[5] = (unsigned long long)P.ada_b; d[6] = (unsigned long long)P.norm_w; d[7] = (unsigned long long)P.ev_w_in; d[8] = (unsigned long long)P.ev_conv_w; d[9] = (unsigned long long)P.ev_conv_b;
        d[10] = (unsigned long long)P.ev_rg_wx; d[11] = (unsigned long long)P.ev_rg_bx; d[12] = (unsigned long long)P.ev_rg_wa; d[13] = (unsigned long long)P.ev_rg_ba; d[14] = (unsigned long long)P.ev_rg_lambda;
        d[15] = (unsigned long long)P.ev_sink; d[16] = (unsigned long long)P.ev_w_out; d[17] = (unsigned long long)P.od_w_in; d[18] = (unsigned long long)P.od_lb_raw; d[19] = (unsigned long long)P.od_gnorm_w;
        d[20] = (unsigned long long)P.od_w_out; d[21] = (unsigned long long)P.final_norm_w; d[22] = (unsigned long long)P.out; d[23] = (unsigned long long)P.ws;
    }
    __syncthreads();
    const int ph_lo = P.ph_lo, ph_hi = P.ph_hi;
#if defined(PROBE_S)
    constexpr int PREP = PROBE_E - PROBE_S + 1;
#pragma unroll 1
    for (int seq = ph_lo; seq < ph_hi + PREP; ++seq) {
        if (seq > ph_lo) grid.sync();
        const int ph = seq <= PROBE_E ? seq : seq - PREP;
        run_phase(lds, ph);
    }
#else
#pragma unroll 1
    for (int ph = ph_lo; ph < ph_hi; ++ph) {
        if (ph > ph_lo) grid.sync();
        run_phase(lds, ph);
    }
#endif
}

extern "C" void kernel_launch(void* const* d_in, const int* in_sizes, int n_in, void* d_out, int out_size, void* d_ws, size_t ws_size, hipStream_t stream) {
    static int grid = 0;
    if (grid == 0) {
        if (n_in != 22 || ws_size < WS_END) { fprintf(stderr, "kernel_launch: unexpected inputs (n_in %d, ws %zu)\n", n_in, ws_size); grid = -1; return; }
        int dev = 0, cus = 0, per_cu = 0;
        hipGetDevice(&dev);
        hipDeviceGetAttribute(&cus, hipDeviceAttributeMultiprocessorCount, dev);
        if (hipFuncSetAttribute((const void*)mega, hipFuncAttributeMaxDynamicSharedMemorySize, LDS_BYTES) != hipSuccess) { fprintf(stderr, "kernel_launch: hipFuncSetAttribute failed\n"); grid = -1; return; }
        if (hipOccupancyMaxActiveBlocksPerMultiprocessor(&per_cu, (const void*)mega, 512, LDS_BYTES) != hipSuccess || per_cu < 1) { fprintf(stderr, "kernel_launch: occupancy query gives %d\n", per_cu); per_cu = 1; }
        (void)hipGetLastError();
        grid = cus;
    }
    if (grid < 0) return;
    Params P{};
    const float** pp = (const float**)&P;
    for (int i = 0; i < 22; ++i) pp[i] = (const float*)d_in[i];
    P.out = (float*)d_out; P.ws = (unsigned char*)d_ws;
#if ONE_LAUNCH
    P.ph_lo = 0; P.ph_hi = NPHASE;
    { void* args[] = {&P}; hipError_t e = hipLaunchCooperativeKernel((const void*)mega, dim3(grid), dim3(512), args, LDS_BYTES, stream);
      if (e != hipSuccess) fprintf(stderr, "cooperative launch failed: %s (grid %d)\n", hipGetErrorString(e), grid); }
#else
    for (int ph = 0; ph < NPHASE; ++ph) {
        P.ph_lo = ph; P.ph_hi = ph + 1;
        void* args[] = {&P}; hipError_t e = hipLaunchCooperativeKernel((const void*)mega, dim3(grid), dim3(512), args, LDS_BYTES, stream);
        if (e != hipSuccess) { fprintf(stderr, "launch %d failed: %s (grid %d)\n", ph, hipGetErrorString(e), grid); break; }
    }
#endif
}
```

```cpp
#include <hip/hip_runtime.h>
#include <hip/hip_cooperative_groups.h>
#include <cstdio>
#include <cstdint>
namespace cg = cooperative_groups;

#ifndef ONE_LAUNCH
#define ONE_LAUNCH 1
#endif

#define DI __device__ __forceinline__
#define LAS __attribute__((address_space(3)))
__device__ __forceinline__ int get_tid() { int t = threadIdx.x; asm volatile("" : "+v"(t)); return t; }
__device__ __forceinline__ int get_bid() { int b = blockIdx.x; asm volatile("" : "+s"(b)); return b; }
namespace pg8 {
#define PG8_LAS __attribute__((address_space(3)))
typedef unsigned short bf16_t;
typedef short bf16x8 __attribute__((ext_vector_type(8)));
typedef float f32x4 __attribute__((ext_vector_type(4)));
typedef unsigned u32x4 __attribute__((ext_vector_type(4)));
constexpr int BM = 256, BK = 64, HALF = 128, HTB = HALF * BK * 2  , STAGE_BYTES = 8 * HTB, NXCD = 8, WGM = 8;

__host__ __device__ __forceinline__ int lds_byte(int r, int c) { const int st = (r >> 4) * 2 + (c >> 5), rr = r & 15, cc = c & 31, ob = rr * 64 + cc * 2; return st * 1024 + (ob ^ (((ob >> 9) & 1) << 5)); }
__host__ __device__ __forceinline__ void stage_rc(int b, int& R, int& C) { const int st = b / 1024, sb = b % 1024, swz = sb ^ (((sb >> 9) & 1) << 5); R = (st >> 1) * 16 + swz / 64; C = (st & 1) * 32 + (swz % 64) / 2; }
__host__ __device__ __forceinline__ int perm32(int rho) { const int n = rho >> 4, i = rho & 15; return 8 * (i >> 2) + 4 * n + (i & 3); }

struct Unit { int pm, pn; };
struct Gemm { const bf16_t* A; const bf16_t* Bt; int M, N, K, lda; };

struct StaticOrder {
    int nM, nN, nwg, G, c;
    __host__ __device__ void init(int M, int N, int G_, int c_) { nM = M / BM; nN = N / BM; nwg = nM * nN; G = G_; c = c_; }
    __host__ __device__ bool next(int i, Unit& u) const {
        const long L = (long)i * G + c; if (L >= nwg) return false;
        int wgid = (int)L; { const int q = nwg / NXCD, r = nwg % NXCD, xcd = wgid % NXCD, off = wgid / NXCD; wgid = (xcd < r ? xcd * (q + 1) : r * (q + 1) + (xcd - r) * q) + off; }
        const int nig = WGM * nN, gid = wgid / nig, fm = gid * WGM, gsz = (nM - fm) < WGM ? (nM - fm) : WGM;
        u.pm = fm + ((wgid % nig) % gsz); u.pn = (wgid % nig) / gsz; return true;
    }
    __device__ __forceinline__ void a_ready(const Unit&) const {}
    __device__ __forceinline__ void done(const Unit&) const {}
};

template <class Epi, class Sched, bool ALIGN_EPI = false, bool SP2 = false>
__device__ __forceinline__ void gemm_phase(PG8_LAS unsigned char* lds, const Gemm g, const Sched& S, const Epi& E) {
    const int tid = get_tid(), wid = __builtin_amdgcn_readfirstlane(tid >> 6), lane = tid & 63, wr = wid >> 2, wc = wid & 3, fr = lane & 15, fq = lane >> 4;
    const int K = g.K, nt = K / BK;
    unsigned voffA[2], voffB[2];
#pragma unroll
    for (int i = 0; i < 2; ++i) { int R, C; stage_rc(tid * 16 + i * 8192, R, C); const int Rb = Epi::PERM ? ((R & ~31) + perm32(R & 31)) : R;
        voffA[i] = (unsigned)(R * g.lda + C) * 2u; voffB[i] = (unsigned)(Rb * K + C) * 2u; }
    const size_t kstep = (size_t)(BK * 2);
    const size_t hstepA = (size_t)HALF * g.lda * 2, hstepB = (size_t)HALF * K * 2;
    const size_t tstepA = 2 * hstepA, tstepB = 2 * hstepB;
    const unsigned ldsw = (unsigned)wid * 1024u;
    const int aoff = lds_byte(wr * 64 + fr, fq * 8), boff = lds_byte(wc * 32 + fr, fq * 8);
#define PG8_SA(b, h) (((b) * 2 + (h)) * HTB)
#define PG8_SB(b, h) ((4 + (b) * 2 + (h)) * HTB)
#define PG8_STAGE(bufoff, gbase, voff) do { _Pragma("unroll") for (int _i = 0; _i < 2; ++_i) \
        __builtin_amdgcn_global_load_lds((const unsigned*)((const char*)(gbase) + (voff)[_i]), (PG8_LAS unsigned*)(lds + (bufoff) + ldsw + _i * 8192), 16, 0, 0); } while (0)
#define PG8_LDA(dst, b, h) do { _Pragma("unroll") for (int m = 0; m < 4; ++m) _Pragma("unroll") for (int k = 0; k < 2; ++k) dst[m][k] = *(const PG8_LAS bf16x8*)(lds + PG8_SA(b, h) + aoff + m * 2048 + k * 1024); } while (0)
#define PG8_LDB(dst, b, h) do { _Pragma("unroll") for (int n = 0; n < 2; ++n) _Pragma("unroll") for (int k = 0; k < 2; ++k) dst[n][k] = *(const PG8_LAS bf16x8*)(lds + PG8_SB(b, h) + boff + n * 2048 + k * 1024); } while (0)
#define PG8_MMA(ai, bj, At, Bt) do { __builtin_amdgcn_s_setprio(1); _Pragma("unroll") for (int m = 0; m < 4; ++m) _Pragma("unroll") for (int n = 0; n < 2; ++n) _Pragma("unroll") for (int k = 0; k < 2; ++k) \
        acc[ai][bj][m][n] = __builtin_amdgcn_mfma_f32_16x16x32_bf16(Bt[n][k], At[m][k], acc[ai][bj][m][n], 0, 0, 0); __builtin_amdgcn_s_setprio(0); } while (0)
#define PG8_WAIT_V(n) asm volatile("s_waitcnt vmcnt(" #n ")" ::: "memory")
#define PG8_WAIT_L(n) asm volatile("s_waitcnt lgkmcnt(" #n ")" ::: "memory")
#define PG8_BAR __builtin_amdgcn_s_barrier()
#define PG8_SCHED __builtin_amdgcn_sched_barrier(0)
    Unit cur, nxt; int ui = 0;
    if (!S.next(0, cur)) return;
    f32x4 acc[2][2][4][2];
#pragma unroll
    for (int a = 0; a < 2; ++a)
#pragma unroll
        for (int b = 0; b < 2; ++b)
#pragma unroll
            for (int m = 0; m < 4; ++m)
#pragma unroll
                for (int n = 0; n < 2; ++n) acc[a][b][m][n] = (f32x4){0.f, 0.f, 0.f, 0.f};
    bf16x8 At[4][2], B0[2][2], B1[2][2];
    const char* cA = (const char*)g.A + (size_t)cur.pm * tstepA; const char* cB = (const char*)g.Bt + (size_t)cur.pn * tstepB;
    S.a_ready(cur);
    if constexpr (SP2) {
        PG8_STAGE(PG8_SB(0, 0), cB, voffB); PG8_STAGE(PG8_SB(0, 1), cB + hstepB, voffB); PG8_STAGE(PG8_SA(0, 0), cA, voffA); PG8_STAGE(PG8_SA(0, 1), cA + hstepA, voffA);
        if (wr == 1) PG8_BAR;
        PG8_WAIT_V(2); PG8_BAR;
        PG8_STAGE(PG8_SB(1, 0), cB + kstep, voffB); PG8_STAGE(PG8_SA(1, 0), cA + kstep, voffA); PG8_STAGE(PG8_SB(1, 1), cB + hstepB + kstep, voffB);
        PG8_WAIT_V(6); PG8_BAR;
    } else {
        PG8_STAGE(PG8_SB(0, 0), cB, voffB); PG8_STAGE(PG8_SA(0, 0), cA, voffA); PG8_STAGE(PG8_SB(0, 1), cB + hstepB, voffB); PG8_STAGE(PG8_SA(0, 1), cA + hstepA, voffA);
        if (wr == 1) PG8_BAR;
        PG8_WAIT_V(4); PG8_BAR;
        PG8_STAGE(PG8_SB(1, 0), cB + kstep, voffB); PG8_STAGE(PG8_SA(1, 0), cA + kstep, voffA); PG8_STAGE(PG8_SB(1, 1), cB + hstepB + kstep, voffB);
        PG8_WAIT_V(6); PG8_BAR;
    }
    for (;;) {
        const bool has_next = S.next(ui + 1, nxt);
        const char* nA = has_next ? (const char*)g.A + (size_t)nxt.pm * tstepA : cA; const char* nB = has_next ? (const char*)g.Bt + (size_t)nxt.pn * tstepB : cB;
        for (int t = 0; t < nt; t += 2) {
            const bool last = (t == nt - 2);
            const char* a1 = cA + (size_t)(t + 1) * kstep;
            const char* a2 = last ? nA : cA + (size_t)(t + 2) * kstep; const char* b2 = last ? nB : cB + (size_t)(t + 2) * kstep;
            const char* a3 = a2 + kstep; const char* b3 = b2 + kstep;
            if (last && has_next) S.a_ready(nxt);
            if constexpr (SP2) {
            PG8_LDB(B0, 0, 0); PG8_LDB(B1, 0, 1); PG8_SCHED; PG8_LDA(At, 0, 0); PG8_STAGE(PG8_SA(1, 1), a1 + hstepA, voffA);
            PG8_WAIT_V(8); PG8_WAIT_L(0); PG8_BAR; PG8_MMA(0, 0, At, B0); PG8_MMA(0, 1, At, B1); PG8_BAR; PG8_SCHED;
            PG8_LDA(At, 0, 1); PG8_STAGE(PG8_SB(0, 0), b2, voffB); PG8_STAGE(PG8_SB(0, 1), b2 + hstepB, voffB); PG8_STAGE(PG8_SA(0, 0), a2, voffA);
            PG8_WAIT_V(8); PG8_WAIT_L(0); PG8_BAR; PG8_MMA(1, 0, At, B0); PG8_MMA(1, 1, At, B1); PG8_BAR; PG8_SCHED;
            PG8_LDB(B0, 1, 0); PG8_LDB(B1, 1, 1); PG8_SCHED; PG8_LDA(At, 1, 0); PG8_STAGE(PG8_SA(0, 1), a2 + hstepA, voffA);
            PG8_WAIT_V(8); PG8_WAIT_L(0); PG8_BAR; PG8_MMA(0, 0, At, B0); PG8_MMA(0, 1, At, B1); PG8_BAR; PG8_SCHED;
            PG8_LDA(At, 1, 1); PG8_STAGE(PG8_SB(1, 0), b3, voffB); PG8_STAGE(PG8_SB(1, 1), b3 + hstepB, voffB); PG8_STAGE(PG8_SA(1, 0), a3, voffA);
            PG8_WAIT_V(8); PG8_WAIT_L(0); PG8_BAR; PG8_MMA(1, 0, At, B0); PG8_MMA(1, 1, At, B1); PG8_BAR; PG8_SCHED;
            } else {
            PG8_LDB(B0, 0, 0); PG8_SCHED; PG8_LDA(At, 0, 0); PG8_STAGE(PG8_SA(1, 1), a1 + hstepA, voffA);
            PG8_WAIT_L(8); PG8_BAR; PG8_WAIT_L(0); PG8_MMA(0, 0, At, B0); PG8_BAR; PG8_SCHED;
            PG8_LDB(B1, 0, 1); PG8_STAGE(PG8_SB(0, 0), b2, voffB);
            PG8_BAR; PG8_WAIT_L(0); PG8_MMA(0, 1, At, B1); PG8_BAR;
            PG8_LDA(At, 0, 1); PG8_STAGE(PG8_SA(0, 0), a2, voffA);
            PG8_BAR; PG8_WAIT_L(0); PG8_MMA(1, 0, At, B0); PG8_BAR; PG8_SCHED;
            PG8_STAGE(PG8_SB(0, 1), b2 + hstepB, voffB);
            PG8_WAIT_V(6); PG8_BAR; PG8_MMA(1, 1, At, B1); PG8_BAR;
            PG8_LDB(B0, 1, 0); PG8_SCHED; PG8_LDA(At, 1, 0); PG8_STAGE(PG8_SA(0, 1), a2 + hstepA, voffA);
            PG8_WAIT_L(8); PG8_BAR; PG8_WAIT_L(0); PG8_MMA(0, 0, At, B0); PG8_BAR; PG8_SCHED;
            PG8_LDB(B1, 1, 1); PG8_STAGE(PG8_SB(1, 0), b3, voffB);
            PG8_BAR; PG8_WAIT_L(0); PG8_MMA(0, 1, At, B1); PG8_BAR;
            PG8_LDA(At, 1, 1); PG8_STAGE(PG8_SA(1, 0), a3, voffA);
            PG8_BAR; PG8_WAIT_L(0); PG8_MMA(1, 0, At, B0); PG8_BAR; PG8_SCHED;
            PG8_STAGE(PG8_SB(1, 1), b3 + hstepB, voffB);
            PG8_WAIT_V(6); PG8_BAR; PG8_MMA(1, 1, At, B1); PG8_BAR;
            }
        }
        if constexpr (ALIGN_EPI) { if (wr == 0) PG8_BAR; }
        if constexpr (!Epi::AFTER_DRAIN) { E(acc, cur, wr, wc, fr, fq); S.done(cur); }
        if (!has_next) break;
#pragma unroll
        for (int a = 0; a < 2; ++a)
#pragma unroll
            for (int b = 0; b < 2; ++b)
#pragma unroll
                for (int m = 0; m < 4; ++m)
#pragma unroll
                    for (int n = 0; n < 2; ++n) acc[a][b][m][n] = (f32x4){0.f, 0.f, 0.f, 0.f};
        cur = nxt; cA = nA; cB = nB; ++ui;
        if constexpr (ALIGN_EPI) { if (wr == 1) PG8_BAR; }
    }
    PG8_WAIT_V(0);
    if constexpr (!ALIGN_EPI) { if (wr == 0) PG8_BAR; }
    PG8_BAR;
    if constexpr (Epi::AFTER_DRAIN) { E.fused(acc, cur, wr, wc, fr, fq, lds, wid, lane); S.done(cur); }
#undef PG8_SA
#undef PG8_SB
#undef PG8_STAGE
#undef PG8_LDA
#undef PG8_LDB
#undef PG8_MMA
#undef PG8_WAIT_V
#undef PG8_WAIT_L
#undef PG8_BAR
#undef PG8_SCHED
}
}

typedef unsigned short bf16_t;
typedef short bf16x8 __attribute__((ext_vector_type(8)));
typedef short s16x4 __attribute__((ext_vector_type(4)));
typedef float f32x4 __attribute__((ext_vector_type(4)));
typedef float f32x16 __attribute__((ext_vector_type(16)));
typedef unsigned u32x4 __attribute__((ext_vector_type(4)));
typedef unsigned u32x2 __attribute__((ext_vector_type(2)));

constexpr int DM = 1024, NB = 8, SEQ = 2048, CTXL = 256, LT = SEQ + CTXL  , MROWS = NB * LT  ;
constexpr int EVEN_IN = 4608, ODD_IN = 5120, NCHUNK = LT / 64  ;
constexpr float RMS_EPS = 1e-6f, LOG2E = 1.4426950408889634f;
constexpr int LDS_BYTES = 160 * 1024;
constexpr int NPHASE = 22;

constexpr size_t WS_CTL = 0;
constexpr size_t WS_MOD = 65536;
constexpr size_t WS_ROPE = 524288;
constexpr size_t WS_AGG = 1048576;
constexpr size_t WS_HCTX = WS_AGG + 4718592;
constexpr size_t WS_WIN = WS_HCTX + 8388608;
constexpr size_t WS_WOUT = WS_WIN + 10485760;
constexpr size_t WS_WRG = WS_WOUT + 4194304;
constexpr size_t WS_OV = WS_WRG + 1048576;
constexpr size_t WS_P = WS_OV + 37748736;
constexpr size_t WS_END = WS_P + 188743680;
static_assert(WS_END <= 268435456, "workspace map exceeds 256 MiB");

struct Params {
    const float *x, *c, *ctx, *c_ctx, *ada_w, *ada_b, *norm_w, *ev_w_in, *ev_conv_w, *ev_conv_b, *ev_rg_wx, *ev_rg_bx, *ev_rg_wa, *ev_rg_ba,
        *ev_rg_lambda, *ev_sink, *ev_w_out, *od_w_in, *od_lb_raw, *od_gnorm_w, *od_w_out, *final_norm_w;
    float* out; unsigned char* ws; int ph_lo, ph_hi;
};

DI float bf2f(unsigned short v) { return __uint_as_float((unsigned)v << 16); }
DI unsigned f2bf(float f) { unsigned u = __float_as_uint(f); return (u + 0x7fffu + ((u >> 16) & 1u)) >> 16; }
DI unsigned pk2(float lo, float hi) { return f2bf(lo) | (f2bf(hi) << 16); }
DI float sigm(float x) { return 1.f / (1.f + __expf(-x)); }
DI float wave_sum(float v) {
#pragma unroll
    for (int o = 1; o < 64; o <<= 1) v += __shfl_xor(v, o);
    return v;
}
DI int crow(int reg, int h) { return (reg & 3) + 8 * (reg >> 2) + 4 * h; }
#define MFMA16(a, b, c) __builtin_amdgcn_mfma_f32_16x16x32_bf16((a), (b), (c), 0, 0, 0)
#define MFMA32(a, b, c) __builtin_amdgcn_mfma_f32_32x32x16_bf16((a), (b), (c), 0, 0, 0)

struct EpiStoreBf16 {
    static constexpr bool PERM = true, AFTER_DRAIN = false;
    bf16_t* O; int ldc;
    DI void operator()(const f32x4 (&acc)[2][2][4][2], const pg8::Unit& u, int wr, int wc, int fr, int fq) const {
        const int row0 = u.pm * 256 + wr * 64 + fr, col0 = u.pn * 256 + wc * 32 + 8 * fq;
#pragma unroll
        for (int ai = 0; ai < 2; ++ai)
#pragma unroll
            for (int m = 0; m < 4; ++m) { bf16_t* rowp = O + (size_t)(row0 + ai * 128 + m * 16) * ldc + col0;
#pragma unroll
                for (int bj = 0; bj < 2; ++bj) { const f32x4 v0 = acc[ai][bj][m][0], v1 = acc[ai][bj][m][1];
                    u32x4 w; w.x = pk2(v0[0], v0[1]); w.y = pk2(v0[2], v0[3]); w.z = pk2(v1[0], v1[1]); w.w = pk2(v1[2], v1[3]);
                    *(u32x4*)(rowp + bj * 128) = w; } }
    }
};
struct EpiResid {
    static constexpr bool PERM = false, AFTER_DRAIN = false;
    const float* in_lat; const float* in_ctx; float* out_lat; float* out_ctx; const float* gate;
    DI void operator()(const f32x4 (&acc)[2][2][4][2], const pg8::Unit& u, int wr, int wc, int fr, int fq) const {
        const int b = u.pm / 9, jt = u.pm % 9;
        const float* ib; float* ob; const float* g;
        if (jt == 0) { const size_t off = (size_t)b * CTXL * DM; ib = in_ctx + off; ob = out_ctx + off; g = gate + 8 * 3072; }
        else { const size_t off = ((size_t)b * SEQ + (size_t)(jt - 1) * 256) * DM; ib = in_lat + off; ob = out_lat + off; g = gate + b * 3072; }
        const int col0 = u.pn * 256 + wc * 32 + 4 * fq;
        f32x4 gv[2][2];
#pragma unroll
        for (int bj = 0; bj < 2; ++bj)
#pragma unroll
            for (int n = 0; n < 2; ++n) gv[bj][n] = *(const f32x4*)(g + col0 + bj * 128 + n * 16);
#pragma unroll
        for (int ai = 0; ai < 2; ++ai)
#pragma unroll
            for (int m = 0; m < 4; ++m) { const int r = ai * 128 + wr * 64 + m * 16 + fr;
#pragma unroll
                for (int bj = 0; bj < 2; ++bj)
#pragma unroll
                    for (int n = 0; n < 2; ++n) { const size_t off = (size_t)r * DM + col0 + bj * 128 + n * 16;
                        const f32x4 o = *(const f32x4*)(ib + off) + gv[bj][n] * acc[ai][bj][m][n]; *(f32x4*)(ob + off) = o; }
                asm volatile("" ::: "memory"); }
    }
};

DI void phase_pro(const Params& P, LAS unsigned char* lds) {
    const int tid = get_tid();
    LAS float* s = (LAS float*)lds;
    LAS float* red = (LAS float*)(lds + 36864);
    float* mod = (float*)(P.ws + WS_MOD);
    for (int i = tid; i < 9 * 1024; i += 512) { const int r = i >> 10, k = i & 1023; const float v = r < 8 ? P.c[r * 1024 + k] : P.c_ctx[k]; s[i] = v * sigm(v); }
    __syncthreads();
    for (int item = get_bid(); item < 384; item += gridDim.x) {
        const int l = item / 96, n0 = (item % 96) * 32, ks = tid >> 5, col = tid & 31;
        const float* w = P.ada_w + (size_t)l * 1024 * 3072 + n0 + col;
        float acc[9];
#pragma unroll
        for (int r = 0; r < 9; ++r) acc[r] = 0.f;
#pragma unroll 8
        for (int kk = 0; kk < 64; ++kk) { const int k = ks * 64 + kk; const float wv = w[(size_t)k * 3072];
#pragma unroll
            for (int r = 0; r < 9; ++r) acc[r] += s[r * 1024 + k] * wv; }
#pragma unroll
        for (int r = 0; r < 9; ++r) red[(ks * 9 + r) * 32 + col] = acc[r];
        __syncthreads();
        if (tid < 288) { const int r = tid >> 5, cc = tid & 31; float sum = 0.f;
#pragma unroll
            for (int k2 = 0; k2 < 16; ++k2) sum += red[(k2 * 9 + r) * 32 + cc];
            mod[(l * 9 + r) * 3072 + n0 + cc] = sum + P.ada_b[l * 3072 + n0 + cc]; }
        __syncthreads();
    }
    float* cos_t = (float*)(P.ws + WS_ROPE); float* sin_t = cos_t + SEQ * 32;
    for (int i = get_bid() * 512 + tid; i < SEQ * 32; i += gridDim.x * 512) {
        const int pos = i >> 5, jj = i & 31, fi = jj & 15;
        const float inv = powf(10000.f, -(float)(2 * fi) / 32.f);
        const float ang = (float)(jj < 16 ? (pos >> 6) : (pos & 63)) * inv;
        cos_t[i] = cosf(ang); sin_t[i] = sinf(ang);
    }
}

DI void transpose_item(const float* W, int K, int N, bf16_t* WT, LAS float* scr, int item, int lane) {
    const int nblk = N / 32, kb = item / nblk, nb = item % nblk, k0 = 64 * kb, n0 = 32 * nb;
#pragma unroll 8
    for (int i = 0; i < 32; ++i) { const int kk = 2 * i + (lane >> 5); scr[kk * 33 + (lane & 31)] = W[(size_t)(k0 + kk) * N + n0 + (lane & 31)]; }
    asm volatile("s_waitcnt lgkmcnt(0)" ::: "memory");
    const int c = lane & 7;
#pragma unroll
    for (int j = 0; j < 4; ++j) { const int n = (lane >> 3) + 8 * j; const LAS float* sp = scr + (8 * c) * 33 + n;
        u32x4 o; o.x = pk2(sp[0 * 33], sp[1 * 33]); o.y = pk2(sp[2 * 33], sp[3 * 33]); o.z = pk2(sp[4 * 33], sp[5 * 33]); o.w = pk2(sp[6 * 33], sp[7 * 33]);
        *(u32x4*)(WT + (size_t)(n0 + n) * K + k0 + 8 * c) = o; }
    asm volatile("s_waitcnt lgkmcnt(0)" ::: "memory");
}

DI void phase_norm(const Params& P, LAS unsigned char* lds, int layer) {
    const int tid = get_tid(), lane = tid & 63, wave = tid >> 6;
    const int gw = get_bid() * 8 + wave, NGW = gridDim.x * 8;
    const int j = layer >> 1;
    LAS float* scr = (LAS float*)(lds + wave * 16384);
    bf16_t* WIN = (bf16_t*)(P.ws + WS_WIN); bf16_t* WOUT = (bf16_t*)(P.ws + WS_WOUT); bf16_t* WRG = (bf16_t*)(P.ws + WS_WRG);
    if ((layer & 1) == 0) {
        constexpr int I_IN = 16 * (EVEN_IN / 32), I_OUT = 32 * 32, I_RG = 32 * 8;
        for (int it = gw; it < I_IN + I_OUT + I_RG; it += NGW) {
            int r = it;
            if (r < I_IN) { transpose_item(P.ev_w_in + (size_t)j * 1024 * EVEN_IN, 1024, EVEN_IN, WIN, scr, r, lane); continue; } r -= I_IN;
            if (r < I_OUT) { transpose_item(P.ev_w_out + (size_t)j * 2048 * 1024, 2048, 1024, WOUT, scr, r, lane); continue; } r -= I_OUT;
            const int mat = r >> 3, sub = r & 7;
            const int dir = mat >> 4, gate = (mat >> 3) & 1, hd = mat & 7;
            const float* src = (gate == 0 ? P.ev_rg_wx : P.ev_rg_wa) + ((size_t)((j * 2 + dir) * 8 + hd)) * 16384;
            transpose_item(src, 128, 128, WRG + (size_t)mat * 16384, scr, sub, lane);
        }
    } else {
        constexpr int I_IN = 16 * (ODD_IN / 32), I_OUT = 16 * 32;
        for (int it = gw; it < I_IN + I_OUT; it += NGW) {
            int r = it;
            if (r < I_IN) { transpose_item(P.od_w_in + (size_t)j * 1024 * ODD_IN, 1024, ODD_IN, WIN, scr, r, lane); continue; } r -= I_IN;
            transpose_item(P.od_w_out + (size_t)j * 1024 * 1024, 1024, 1024, WOUT, scr, r, lane);
        }
    }
    const float* hl = layer == 0 ? P.x : P.out; const float* hc = layer == 0 ? P.ctx : (const float*)(P.ws + WS_HCTX);
    const float* mod = (const float*)(P.ws + WS_MOD) + (size_t)layer * 9 * 3072;
    const float* nw = P.norm_w + layer * 1024;
    bf16_t* U = (bf16_t*)(P.ws + WS_OV);
    for (int R = gw; R < MROWS; R += NGW) {
        const int b = R / LT, jr = R % LT;
        const float* src = jr < CTXL ? hc + ((size_t)b * CTXL + jr) * DM : hl + ((size_t)b * SEQ + (jr - CTXL)) * DM;
        const float* sh = mod + (jr < CTXL ? 8 : b) * 3072; const float* sc = sh + 1024;
        f32x4 v[4]; float ss = 0.f;
#pragma unroll
        for (int q = 0; q < 4; ++q) { v[q] = *(const f32x4*)(src + 4 * lane + 256 * q); ss += (v[q][0] * v[q][0] + v[q][1] * v[q][1]) + (v[q][2] * v[q][2] + v[q][3] * v[q][3]); }
        const float rstd = rsqrtf(wave_sum(ss) * (1.f / DM) + RMS_EPS);
#pragma unroll
        for (int q = 0; q < 4; ++q) { const int k = 4 * lane + 256 * q;
            const f32x4 w4 = *(const f32x4*)(nw + k), s4 = *(const f32x4*)(sc + k), h4 = *(const f32x4*)(sh + k);
            const f32x4 y = (v[q] * rstd) * w4; const f32x4 o = y * (s4 + 1.f) + h4;
            u32x2 w; w.x = pk2(o[0], o[1]); w.y = pk2(o[2], o[3]); *(u32x2*)(U + (size_t)R * DM + k) = w; }
    }
}

template <bool PASS2>
DI void rglru_item(const Params& P, LAS unsigned char* lds, int j, int item) {
    const int tid = get_tid(), lane = tid & 63, wave = tid >> 6, r = lane & 15, g = lane >> 4;
    const int hd = item & 7, ci = (item >> 3) % NCHUNK, b = item / (8 * NCHUNK);
    bf16_t* p = (bf16_t*)(P.ws + WS_P);
    const bf16_t* WRG = (const bf16_t*)(P.ws + WS_WRG);
    float2* AGG = (float2*)(P.ws + WS_AGG);
    const int R0 = b * LT + ci * 64;
    const int seg_lo = b * LT + (ci < 4 ? 0 : CTXL), seg_hi = b * LT + (ci < 4 ? CTXL : LT);
    LAS bf16_t* UT = (LAS bf16_t*)lds;
    LAS float* AL = (LAS float*)(lds + 17408);
    LAS float* BL = (LAS float*)(lds + 17408 + 32768);
    LAS float* YL = (LAS float*)(lds + 17408 + 65536);
    LAS float* QA = (LAS float*)(lds + 17408 + 98304);
    LAS float* CAR = (LAS float*)(lds + 17408 + 98304 + 4096);
#pragma unroll
    for (int rep = 0; rep < 2; ++rep) {
        const int idx = tid + rep * 512, t = idx >> 4, c0 = (idx & 15) * 8, cg0 = hd * 128 + c0;
        float acc[8];
        { const f32x4 b0 = *(const f32x4*)(P.ev_conv_b + j * 1024 + cg0), b1 = *(const f32x4*)(P.ev_conv_b + j * 1024 + cg0 + 4);
          acc[0] = b0[0]; acc[1] = b0[1]; acc[2] = b0[2]; acc[3] = b0[3]; acc[4] = b1[0]; acc[5] = b1[1]; acc[6] = b1[2]; acc[7] = b1[3]; }
#pragma unroll
        for (int k = 0; k < 4; ++k) {
            const int Rg = R0 + t + k - 1;
            if (Rg >= seg_lo && Rg < seg_hi) {
                const u32x4 xv = *(const u32x4*)(p + (size_t)Rg * EVEN_IN + cg0);
                const float* wk = P.ev_conv_w + (size_t)(j * 4 + k) * 1024 + cg0;
                const f32x4 w0 = *(const f32x4*)wk, w1 = *(const f32x4*)(wk + 4);
                acc[0] += w0[0] * __uint_as_float(xv.x << 16); acc[1] += w0[1] * __uint_as_float(xv.x & 0xffff0000u);
                acc[2] += w0[2] * __uint_as_float(xv.y << 16); acc[3] += w0[3] * __uint_as_float(xv.y & 0xffff0000u);
                acc[4] += w1[0] * __uint_as_float(xv.z << 16); acc[5] += w1[1] * __uint_as_float(xv.z & 0xffff0000u);
                acc[6] += w1[2] * __uint_as_float(xv.w << 16); acc[7] += w1[3] * __uint_as_float(xv.w & 0xffff0000u);
            }
        }
        u32x4 o; o.x = pk2(acc[0], acc[1]); o.y = pk2(acc[2], acc[3]); o.z = pk2(acc[4], acc[5]); o.w = pk2(acc[6], acc[7]);
        *(LAS u32x4*)(UT + t * 136 + c0) = o;
    }
    if (PASS2) {
        if (tid < 256) {
            const int dir = tid >> 7, c = tid & 127;
            const int pos = dir == 0 ? ci : (ci < 4 ? 3 - ci : 39 - ci);
            float h = 0.f;
            for (int pp = 0; pp < pos; ++pp) {
                const int cc = dir == 0 ? pp : (pp < 4 ? 3 - pp : 39 - pp);
                const float2 ab = AGG[((size_t)(dir * NB + b) * NCHUNK + cc) * 1024 + hd * 128 + c];
                h = ab.x * h + ab.y;
            }
            CAR[dir * 128 + c] = h;
        }
    }
    __syncthreads();
#pragma unroll 1
    for (int dir = 0; dir < 2; ++dir) {
        f32x4 ax[4], aa[4];
#pragma unroll
        for (int m = 0; m < 4; ++m) { ax[m] = (f32x4){0.f, 0.f, 0.f, 0.f}; aa[m] = (f32x4){0.f, 0.f, 0.f, 0.f}; }
        const bf16_t* Wx = WRG + (size_t)((dir * 2 + 0) * 8 + hd) * 16384 + (16 * wave + r) * 128 + 8 * g;
        const bf16_t* Wa = WRG + (size_t)((dir * 2 + 1) * 8 + hd) * 16384 + (16 * wave + r) * 128 + 8 * g;
#pragma unroll
        for (int ks = 0; ks < 4; ++ks) {
            const bf16x8 bx = *(const bf16x8*)(Wx + 32 * ks), ba = *(const bf16x8*)(Wa + 32 * ks);
#pragma unroll
            for (int m = 0; m < 4; ++m) {
                const bf16x8 a = *(const LAS bf16x8*)(UT + (16 * m + r) * 136 + 32 * ks + 8 * g);
                ax[m] = MFMA16(a, bx, ax[m]); aa[m] = MFMA16(a, ba, aa[m]);
            }
        }
        {
            const int c = 16 * wave + r, idx = (j * 2 + dir) * 1024 + hd * 128 + c;
            const float bxv = P.ev_rg_bx[idx], bav = P.ev_rg_ba[idx], lam = P.ev_rg_lambda[idx];
            const float sp = log1pf(__expf(-lam));
#pragma unroll
            for (int m = 0; m < 4; ++m)
#pragma unroll
                for (int i = 0; i < 4; ++i) {
                    const int t = 16 * m + 4 * g + i;
                    const float gx = sigm(ax[m][i] + bxv), ga = sigm(aa[m][i] + bav);
                    const float la = -8.f * ga * sp;
                    const float a = __expf(la), mult = sqrtf(-expm1f(2.f * la));
                    const float uv = bf2f(UT[t * 136 + c]);
                    AL[t * 128 + c] = a; BL[t * 128 + c] = mult * gx * uv;
                }
        }
        __syncthreads();
        {
            const int c = tid & 127, q = tid >> 7;
            float A = 1.f, B = 0.f;
#pragma unroll
            for (int s = 0; s < 16; ++s) { const int t = dir == 0 ? 16 * q + s : 16 * q + 15 - s; const float a = AL[t * 128 + c], bb = BL[t * 128 + c]; B = a * B + bb; A *= a; }
            QA[(q * 128 + c) * 2] = A; QA[(q * 128 + c) * 2 + 1] = B;
            __syncthreads();
            if (!PASS2) {
                if (q == 0) {
                    float CA = 1.f, CB = 0.f;
#pragma unroll
                    for (int qq = 0; qq < 4; ++qq) { const int qi = dir == 0 ? qq : 3 - qq; const float a = QA[(qi * 128 + c) * 2], bb = QA[(qi * 128 + c) * 2 + 1]; CB = a * CB + bb; CA *= a; }
                    AGG[((size_t)(dir * NB + b) * NCHUNK + ci) * 1024 + hd * 128 + c] = make_float2(CA, CB);
                }
            } else {
                float h = CAR[dir * 128 + c];
                const int nprev = dir == 0 ? q : 3 - q;
                for (int qq = 0; qq < nprev; ++qq) { const int qi = dir == 0 ? qq : 3 - qq; h = QA[(qi * 128 + c) * 2] * h + QA[(qi * 128 + c) * 2 + 1]; }
#pragma unroll
                for (int s = 0; s < 16; ++s) { const int t = dir == 0 ? 16 * q + s : 16 * q + 15 - s; h = AL[t * 128 + c] * h + BL[t * 128 + c];
                    if (dir == 0) YL[t * 128 + c] = h; else YL[t * 128 + c] += h; }
            }
        }
        __syncthreads();
    }
    if (PASS2) {
#pragma unroll
        for (int rep = 0; rep < 2; ++rep) {
            const int idx = tid + rep * 512, t = idx >> 4, c0 = (idx & 15) * 8;
            bf16_t* gp = p + (size_t)(R0 + t) * EVEN_IN + 1536 + hd * 128 + c0;
            const u32x4 gv = *(const u32x4*)gp;
            const f32x4 y0 = *(const LAS f32x4*)(YL + t * 128 + c0), y1 = *(const LAS f32x4*)(YL + t * 128 + c0 + 4);
            float gg[8] = {__uint_as_float(gv.x << 16), __uint_as_float(gv.x & 0xffff0000u), __uint_as_float(gv.y << 16), __uint_as_float(gv.y & 0xffff0000u),
                           __uint_as_float(gv.z << 16), __uint_as_float(gv.z & 0xffff0000u), __uint_as_float(gv.w << 16), __uint_as_float(gv.w & 0xffff0000u)};
            u32x4 o;
            o.x = pk2(y0[0] * gg[0] * sigm(gg[0]), y0[1] * gg[1] * sigm(gg[1])); o.y = pk2(y0[2] * gg[2] * sigm(gg[2]), y0[3] * gg[3] * sigm(gg[3]));
            o.z = pk2(y1[0] * gg[4] * sigm(gg[4]), y1[1] * gg[5] * sigm(gg[5])); o.w = pk2(y1[2] * gg[6] * sigm(gg[6]), y1[3] * gg[7] * sigm(gg[7]));
            *(u32x4*)gp = o;
        }
        __syncthreads();
    }
}

DI void rope8(u32x4& v, const float* cs, const float* sn) {
    unsigned* w = (unsigned*)&v;
#pragma unroll
    for (int i = 0; i < 4; ++i) { const float t1 = __uint_as_float(w[i] << 16), t2 = __uint_as_float(w[i] & 0xffff0000u); w[i] = pk2(t1 * cs[i] - t2 * sn[i], t1 * sn[i] + t2 * cs[i]); }
}
DI void attn_item(const Params& P, LAS unsigned char* lds, int j, int item) {
    const int tid = get_tid(), lane = tid & 63, wave = tid >> 6, r = lane & 31, h = lane >> 5;
    const bool is_lat = item < 512;
    int b, qb, kvh;
    if (is_lat) { b = item >> 6; qb = (item >> 2) & 15; kvh = item & 3; } else { const int it = item - 512; b = it >> 3; qb = (it >> 2) & 1; kvh = it & 3; }
    bf16_t* p = (bf16_t*)(P.ws + WS_P);
    const float* cos_t = (const float*)(P.ws + WS_ROPE); const float* sin_t = cos_t + SEQ * 32;
    LAS unsigned char* KL = lds;
    LAS unsigned char* VT = lds + 9216;
    const int hq = 4 * kvh + (wave >> 1), ql0 = qb * 128 + 64 * (wave & 1);
    const size_t rowbase = (size_t)b * LT + (is_lat ? CTXL : 0);
    LAS unsigned char* QL = lds + 18432 + wave * 9216;
#pragma unroll
    for (int qt = 0; qt < 2; ++qt) {
        const int qi = ql0 + 32 * qt + r;
        const bf16_t* qp = p + (rowbase + qi) * EVEN_IN + 2560 + hq * 64 + 8 * h;
#pragma unroll
        for (int ks = 0; ks < 4; ++ks) {
            u32x4 v = *(const u32x4*)(qp + 16 * ks);
            if (is_lat) rope8(v, cos_t + qi * 32 + 8 * ks + 4 * h, sin_t + qi * 32 + 8 * ks + 4 * h);
            *(LAS u32x4*)(QL + (32 * qt + r) * 144 + (16 * ks + 8 * h) * 2) = v;
        }
    }
    const float sink2 = P.ev_sink[j * 16 + hq] * LOG2E;
    float mrun[2] = {sink2, sink2}, lrun[2] = {h == 0 ? 1.f : 0.f, h == 0 ? 1.f : 0.f};
    f32x16 O[2][2];
#pragma unroll
    for (int a = 0; a < 2; ++a)
#pragma unroll
        for (int c = 0; c < 2; ++c)
#pragma unroll
            for (int i = 0; i < 16; ++i) O[a][c][i] = 0.f;
    const int ntiles = is_lat ? 10 : 4;
    const float SC = 0.125f * LOG2E, NEG = -1e30f;
#pragma unroll 1
    for (int ti = 0; ti < ntiles; ++ti) {
        const bool win = ti >= 4;
        const int k0 = win ? qb * 128 - 128 + 64 * (ti - 4) : 64 * ti;
        if (win && (k0 < 0 || k0 >= SEQ)) continue;
        __syncthreads();
        {
            const int key = tid >> 3, chn = tid & 7;
            const bf16_t* kp = p + ((size_t)b * LT + (win ? CTXL : 0) + k0 + key) * EVEN_IN + 1024 + kvh * 64 + 8 * chn;
            u32x4 kv = *(const u32x4*)kp;
            if (win) rope8(kv, cos_t + (k0 + key) * 32 + 4 * chn, sin_t + (k0 + key) * 32 + 4 * chn);
            *(LAS u32x4*)(KL + key * 144 + chn * 16) = kv;
            const u32x4 vv = *(const u32x4*)(kp + 256);
            const unsigned* vw = (const unsigned*)&vv;
#pragma unroll
            for (int e = 0; e < 4; ++e) {
                *(LAS unsigned short*)(VT + (8 * chn + 2 * e) * 144 + key * 2) = (unsigned short)(vw[e] & 0xffffu);
                *(LAS unsigned short*)(VT + (8 * chn + 2 * e + 1) * 144 + key * 2) = (unsigned short)(vw[e] >> 16);
            }
        }
        __syncthreads();
#pragma unroll
        for (int qt = 0; qt < 2; ++qt) {
            f32x16 s0, s1;
#pragma unroll
            for (int i = 0; i < 16; ++i) { s0[i] = 0.f; s1[i] = 0.f; }
#pragma unroll
            for (int ks = 0; ks < 4; ++ks) {
                const bf16x8 qfr = *(const LAS bf16x8*)(QL + (32 * qt + r) * 144 + (16 * ks + 8 * h) * 2);
                const bf16x8 k0f = *(const LAS bf16x8*)(KL + r * 144 + (16 * ks + 8 * h) * 2), k1f = *(const LAS bf16x8*)(KL + (32 + r) * 144 + (16 * ks + 8 * h) * 2);
                s0 = MFMA32(k0f, qfr, s0); s1 = MFMA32(k1f, qfr, s1);
            }
            const int qpos = ql0 + 32 * qt + r;
            float mx = NEG;
#pragma unroll
            for (int i = 0; i < 16; ++i) {
                const int kp0 = k0 + crow(i, h), kp1 = kp0 + 32;
                float v0 = s0[i] * SC, v1 = s1[i] * SC;
                if (win) { const int d0 = qpos - kp0, d1 = qpos - kp1; if (d0 > 128 || d0 < -128) v0 = NEG; if (d1 > 128 || d1 < -128) v1 = NEG; }
                s0[i] = v0; s1[i] = v1; mx = fmaxf(mx, fmaxf(v0, v1));
            }
            mx = fmaxf(mx, __shfl_xor(mx, 32));
            const float mn = fmaxf(mrun[qt], mx), alpha = __builtin_amdgcn_exp2f(mrun[qt] - mn);
            mrun[qt] = mn;
            float ls = 0.f;
#pragma unroll
            for (int i = 0; i < 16; ++i) { s0[i] = __builtin_amdgcn_exp2f(s0[i] - mn); s1[i] = __builtin_amdgcn_exp2f(s1[i] - mn); ls += s0[i] + s1[i]; }
            lrun[qt] = lrun[qt] * alpha + ls;
#pragma unroll
            for (int dt = 0; dt < 2; ++dt)
#pragma unroll
                for (int i = 0; i < 16; ++i) O[dt][qt][i] *= alpha;
            bf16x8 pf[2][2];
#pragma unroll
            for (int s = 0; s < 2; ++s) {
                u32x4 a, c;
                a.x = pk2(s0[8 * s + 0], s0[8 * s + 1]); a.y = pk2(s0[8 * s + 2], s0[8 * s + 3]); a.z = pk2(s0[8 * s + 4], s0[8 * s + 5]); a.w = pk2(s0[8 * s + 6], s0[8 * s + 7]);
                c.x = pk2(s1[8 * s + 0], s1[8 * s + 1]); c.y = pk2(s1[8 * s + 2], s1[8 * s + 3]); c.z = pk2(s1[8 * s + 4], s1[8 * s + 5]); c.w = pk2(s1[8 * s + 6], s1[8 * s + 7]);
                pf[0][s] = __builtin_bit_cast(bf16x8, a); pf[1][s] = __builtin_bit_cast(bf16x8, c);
            }
#pragma unroll
            for (int dt = 0; dt < 2; ++dt)
#pragma unroll
                for (int kt = 0; kt < 2; ++kt)
#pragma unroll
                    for (int s = 0; s < 2; ++s) {
                        const LAS unsigned char* vp = VT + (32 * dt + r) * 144 + (32 * kt + 16 * s + 4 * h) * 2;
                        const u32x2 lo = *(const LAS u32x2*)vp, hi = *(const LAS u32x2*)(vp + 16);
                        const u32x4 vv = {lo.x, lo.y, hi.x, hi.y};
                        O[dt][qt] = MFMA32(__builtin_bit_cast(bf16x8, vv), pf[kt][s], O[dt][qt]);
                    }
            __builtin_amdgcn_sched_barrier(0);
        }
    }
#pragma unroll
    for (int qt = 0; qt < 2; ++qt) {
        const float lt = lrun[qt] + __shfl_xor(lrun[qt], 32), inv = 1.f / lt;
        const int qi = ql0 + 32 * qt + r;
        bf16_t* rowp = p + (rowbase + qi) * EVEN_IN;
#pragma unroll
        for (int dt = 0; dt < 2; ++dt)
#pragma unroll
            for (int i4 = 0; i4 < 4; ++i4) {
                const int d0 = 32 * dt + 8 * i4 + 4 * h;
                const u32x2 gv = *(const u32x2*)(rowp + 3584 + hq * 64 + d0);
                const float g0 = __uint_as_float(gv.x << 16), g1 = __uint_as_float(gv.x & 0xffff0000u), g2 = __uint_as_float(gv.y << 16), g3 = __uint_as_float(gv.y & 0xffff0000u);
                u32x2 o;
                o.x = pk2(O[dt][qt][4 * i4 + 0] * inv * g0 * sigm(g0), O[dt][qt][4 * i4 + 1] * inv * g1 * sigm(g1));
                o.y = pk2(O[dt][qt][4 * i4 + 2] * inv * g2 * sigm(g2), O[dt][qt][4 * i4 + 3] * inv * g3 * sigm(g3));
                *(u32x2*)(rowp + 2560 + hq * 64 + d0) = o;
            }
    }
    __syncthreads();
}

constexpr int GL_QI = 0, GL_Q1 = 17408, GL_KF = 34816, GL_K2T = 78336, GL_VT = 96768, GL_AM = 101376, GL_ST = 110592, GL_PS = 128000, GL_BL = 130048, GL_ZT = 130560, GL_QT = 146944, GL_END = 163328;
static_assert(GL_END <= LDS_BYTES, "GLA LDS map");

template <int DIR>
DI void gla_step(const Params& P, LAS unsigned char* lds, int layer_j, int b, int hd, int eq, int step, f32x4 (&st)[2]) {
    const int tid = get_tid(), lane = tid & 63, wave = tid >> 6, r = lane & 15, g = lane >> 4;
    const bf16_t* p = (const bf16_t*)(P.ws + WS_P);
    bf16_t* OVb = (bf16_t*)(P.ws + WS_OV);
    LAS bf16_t* QI = (LAS bf16_t*)(lds + GL_QI); LAS bf16_t* Q1 = (LAS bf16_t*)(lds + GL_Q1); LAS bf16_t* KF = (LAS bf16_t*)(lds + GL_KF);
    LAS bf16_t* K2T = (LAS bf16_t*)(lds + GL_K2T); LAS bf16_t* VT = (LAS bf16_t*)(lds + GL_VT); LAS bf16_t* AM = (LAS bf16_t*)(lds + GL_AM);
    LAS bf16_t* ST = (LAS bf16_t*)(lds + GL_ST + DIR * 8704); LAS float* PS = (LAS float*)(lds + GL_PS); LAS float* BLAST = (LAS float*)(lds + GL_BL);
    const int chunk = DIR == 0 ? step : (step < 4 ? 3 - step : 39 - step);
    const int other_pos = DIR == 0 ? (chunk < 4 ? 3 - chunk : 39 - chunk) : chunk;
    const bool second = other_pos < step || (other_pos == step && DIR == 1);
    const size_t Rc0 = (size_t)b * LT + (size_t)chunk * 64;
    LAS bf16_t* ZT = (LAS bf16_t*)(lds + GL_ZT); LAS bf16_t* QT = (LAS bf16_t*)(lds + GL_QT);
#pragma unroll
    for (int rep = 0; rep < 2; ++rep) {
        const int idx = tid + rep * 512, tau = idx >> 4, c0 = (idx & 15) * 8;
        const size_t R = Rc0 + (DIR == 0 ? tau : 63 - tau);
        const u32x4 zv = *(const u32x4*)(p + R * ODD_IN + DIR * 1024 + hd * 128 + c0);
        const u32x4 qv = *(const u32x4*)(p + R * ODD_IN + 3072 + hd * 128 + c0);
        *(LAS u32x4*)(ZT + tau * 128 + c0) = zv; *(LAS u32x4*)(QT + tau * 128 + c0) = qv;
    }
    if (tid < 256) {
        const int tau = tid >> 2, chn = tid & 3;
        const size_t R = Rc0 + (DIR == 0 ? tau : 63 - tau);
        const u32x4 vv = *(const u32x4*)(p + R * ODD_IN + 2048 + hd * 128 + eq * 32 + 8 * chn);
        const unsigned* vw = (const unsigned*)&vv;
#pragma unroll
        for (int e = 0; e < 4; ++e) { VT[(8 * chn + 2 * e) * 72 + tau] = (bf16_t)(vw[e] & 0xffffu); VT[(8 * chn + 2 * e + 1) * 72 + tau] = (bf16_t)(vw[e] >> 16); }
    }
    __syncthreads();
    {
        const int d = tid & 127, I = tid >> 7, cgl = hd * 128 + d;
        float lbv = 0.f;
        if (layer_j > 0) lbv = sigm(P.od_lb_raw[1024 + cgl] - P.od_lb_raw[cgl]);
        const float omlb = 1.f - lbv;
        float e0[16], kk[16], qq[16];
        float run = 1.f;
#pragma unroll
        for (int s = 0; s < 16; ++s) {
            const int tau = 16 * I + s;
            const float z = bf2f(ZT[tau * 128 + d]);
            const float tz = __expf(-z), sg = 1.f / (1.f + tz);
            float f = lbv + omlb * sg; f = fmaxf(f, 1e-30f);
            kk[s] = omlb * (tz * sg);
            run = fmaxf(run * f, 1e-35f); e0[s] = run;
            const float qr = bf2f(QT[tau * 128 + d]);
            qq[s] = qr * sigm(qr);
        }
        PS[I * 128 + d] = run;
        __syncthreads();
        const float P0 = PS[d], P1 = PS[128 + d], P2 = PS[256 + d], P3 = PS[384 + d];
        const float RI = I == 0 ? 1.f : (I == 1 ? P0 : (I == 2 ? P0 * P1 : P0 * P1 * P2));
        float fac[4]; float cur = 1.f;
        fac[0] = cur; if (I <= 0) cur *= P0;
        fac[1] = cur; if (I <= 1) cur *= P1;
        fac[2] = cur; if (I <= 2) cur *= P2;
        fac[3] = cur; cur *= P3;
        const float f4 = cur;
        if (I == 0) BLAST[d] = P0 * P1 * P2 * P3;
#pragma unroll
        for (int s = 0; s < 16; ++s) {
            const int tau = 16 * I + s;
            const float qi = qq[s] * e0[s], kd = kk[s] * (1.f / e0[s]);
            QI[tau * 136 + d] = (bf16_t)f2bf(qi); Q1[tau * 136 + d] = (bf16_t)f2bf(qi * RI);
            if (I <= 0) KF[(0 + tau) * 136 + d] = (bf16_t)f2bf(kd * fac[0]);
            if (I <= 1) KF[(16 + tau) * 136 + d] = (bf16_t)f2bf(kd * fac[1]);
            if (I <= 2) KF[(48 + tau) * 136 + d] = (bf16_t)f2bf(kd * fac[2]);
            KF[(96 + tau) * 136 + d] = (bf16_t)f2bf(kd * fac[3]);
            K2T[d * 72 + tau] = (bf16_t)f2bf(kd * f4);
        }
    }
    __syncthreads();
#pragma unroll 1
    for (int bi = wave; bi < 10; bi += 8) {
        const int I = bi < 1 ? 0 : (bi < 3 ? 1 : (bi < 6 ? 2 : 3)), J = bi - (I * (I + 1)) / 2;
        const int foff = I == 0 ? 0 : (I == 1 ? 16 : (I == 2 ? 48 : 96));
        f32x4 acc = {0.f, 0.f, 0.f, 0.f};
#pragma unroll
        for (int ks = 0; ks < 4; ++ks) {
            const bf16x8 a = *(const LAS bf16x8*)(QI + (16 * I + r) * 136 + 32 * ks + 8 * g);
            const bf16x8 bb = *(const LAS bf16x8*)(KF + (foff + 16 * J + r) * 136 + 32 * ks + 8 * g);
            acc = MFMA16(a, bb, acc);
        }
#pragma unroll
        for (int i = 0; i < 4; ++i) { float v = acc[i]; if (J == I && r > 4 * g + i) v = 0.f; AM[(16 * I + 4 * g + i) * 72 + 16 * J + r] = (bf16_t)f2bf(v); }
    }
    __syncthreads();
    {
        const int tt = wave >> 1, et = wave & 1;
        f32x4 acc = {0.f, 0.f, 0.f, 0.f};
#pragma unroll
        for (int ks = 0; ks < 4; ++ks) {
            const bf16x8 a = *(const LAS bf16x8*)(Q1 + (16 * tt + r) * 136 + 32 * ks + 8 * g);
            const bf16x8 bb = *(const LAS bf16x8*)(ST + (16 * et + r) * 136 + 32 * ks + 8 * g);
            acc = MFMA16(a, bb, acc);
        }
#pragma unroll
        for (int ks = 0; ks < 2; ++ks) {
            const bf16x8 a = *(const LAS bf16x8*)(AM + (16 * tt + r) * 72 + 32 * ks + 8 * g);
            const bf16x8 bb = *(const LAS bf16x8*)(VT + (16 * et + r) * 72 + 32 * ks + 8 * g);
            acc = MFMA16(a, bb, acc);
        }
#pragma unroll
        for (int i = 0; i < 4; ++i) {
            const int tau = 16 * tt + 4 * g + i;
            const size_t R = Rc0 + (DIR == 0 ? tau : 63 - tau);
            bf16_t* op = OVb + R * DM + hd * 128 + eq * 32 + 16 * et + r;
            float v = acc[i];
            if (second) v += bf2f(__hip_atomic_load(op, __ATOMIC_RELAXED, __HIP_MEMORY_SCOPE_AGENT));
            *op = (bf16_t)f2bf(v);
        }
    }
    {
        float bl[4];
#pragma unroll
        for (int i = 0; i < 4; ++i) bl[i] = BLAST[16 * wave + 4 * g + i];
#pragma unroll
        for (int et = 0; et < 2; ++et) {
#pragma unroll
            for (int i = 0; i < 4; ++i) st[et][i] *= bl[i];
#pragma unroll
            for (int ks = 0; ks < 2; ++ks) {
                const bf16x8 a = *(const LAS bf16x8*)(K2T + (16 * wave + r) * 72 + 32 * ks + 8 * g);
                const bf16x8 bb = *(const LAS bf16x8*)(VT + (16 * et + r) * 72 + 32 * ks + 8 * g);
                st[et] = MFMA16(a, bb, st[et]);
            }
        }
    }
    __syncthreads();
#pragma unroll
    for (int et = 0; et < 2; ++et) {
        u32x2 w; w.x = pk2(st[et][0], st[et][1]); w.y = pk2(st[et][2], st[et][3]);
        *(LAS u32x2*)(ST + (16 * et + r) * 136 + 16 * wave + 4 * g) = w;
    }
}

DI void gla_item(const Params& P, LAS unsigned char* lds, int layer_j, int item) {
    const int tid = get_tid();
    const int b = item >> 5, hd = (item >> 2) & 7, eq = item & 3;
    for (int i = tid; i < (9216 + 17408) / 4; i += 512) ((LAS unsigned*)(lds + GL_AM))[i] = 0u;
    f32x4 sf[2], sb[2];
#pragma unroll
    for (int e = 0; e < 2; ++e) { sf[e] = (f32x4){0.f, 0.f, 0.f, 0.f}; sb[e] = (f32x4){0.f, 0.f, 0.f, 0.f}; }
    __syncthreads();
#pragma unroll 1
    for (int step = 0; step < NCHUNK; ++step) {
        gla_step<0>(P, lds, layer_j, b, hd, eq, step, sf);
        __syncthreads();
        gla_step<1>(P, lds, layer_j, b, hd, eq, step, sb);
        __syncthreads();
    }
}

DI void phase_readout(const Params& P, int layer_j) {
    const int tid = get_tid(), lane = tid & 63, wave = tid >> 6;
    const int gw = get_bid() * 8 + wave, NGW = gridDim.x * 8;
    const bf16_t* OVb = (const bf16_t*)(P.ws + WS_OV); bf16_t* p = (bf16_t*)(P.ws + WS_P);
    const float* gwt = P.od_gnorm_w + layer_j * 128 + (lane & 7) * 16;
    for (int R = gw; R < MROWS; R += NGW) {
        const bf16_t* op = OVb + (size_t)R * DM + 16 * lane; bf16_t* yp = p + (size_t)R * ODD_IN + 4096 + 16 * lane;
        const u32x4 o0 = *(const u32x4*)op, o1 = *(const u32x4*)(op + 8), g0 = *(const u32x4*)yp, g1 = *(const u32x4*)(yp + 8);
        float ov[16], gv[16];
        const unsigned* ow0 = (const unsigned*)&o0; const unsigned* ow1 = (const unsigned*)&o1; const unsigned* gw0 = (const unsigned*)&g0; const unsigned* gw1 = (const unsigned*)&g1;
#pragma unroll
        for (int i = 0; i < 4; ++i) {
            ov[2 * i] = __uint_as_float(ow0[i] << 16); ov[2 * i + 1] = __uint_as_float(ow0[i] & 0xffff0000u); ov[8 + 2 * i] = __uint_as_float(ow1[i] << 16); ov[8 + 2 * i + 1] = __uint_as_float(ow1[i] & 0xffff0000u);
            gv[2 * i] = __uint_as_float(gw0[i] << 16); gv[2 * i + 1] = __uint_as_float(gw0[i] & 0xffff0000u); gv[8 + 2 * i] = __uint_as_float(gw1[i] << 16); gv[8 + 2 * i + 1] = __uint_as_float(gw1[i] & 0xffff0000u);
        }
        float ss = 0.f;
#pragma unroll
        for (int i = 0; i < 16; ++i) ss += ov[i] * ov[i];
        ss += __shfl_xor(ss, 1); ss += __shfl_xor(ss, 2); ss += __shfl_xor(ss, 4);
        const float rstd = rsqrtf(ss * (1.f / 128.f) + RMS_EPS);
        float y[16];
#pragma unroll
        for (int i = 0; i < 16; ++i) y[i] = ov[i] * rstd * gwt[i] * (gv[i] * sigm(gv[i]));
        u32x4 w0, w1;
        w0.x = pk2(y[0], y[1]); w0.y = pk2(y[2], y[3]); w0.z = pk2(y[4], y[5]); w0.w = pk2(y[6], y[7]);
        w1.x = pk2(y[8], y[9]); w1.y = pk2(y[10], y[11]); w1.z = pk2(y[12], y[13]); w1.w = pk2(y[14], y[15]);
        *(u32x4*)yp = w0; *(u32x4*)(yp + 8) = w1;
    }
}

DI void phase_final(const Params& P) {
    const int tid = get_tid(), lane = tid & 63, wave = tid >> 6;
    const int gw = get_bid() * 8 + wave, NGW = gridDim.x * 8;
    for (int R = gw; R < NB * SEQ; R += NGW) {
        float* row = P.out + (size_t)R * DM;
        f32x4 v[4]; float ss = 0.f;
#pragma unroll
        for (int q = 0; q < 4; ++q) { v[q] = *(const f32x4*)(row + 4 * lane + 256 * q); ss += (v[q][0] * v[q][0] + v[q][1] * v[q][1]) + (v[q][2] * v[q][2] + v[q][3] * v[q][3]); }
        const float rstd = rsqrtf(wave_sum(ss) * (1.f / DM) + RMS_EPS);
#pragma unroll
        for (int q = 0; q < 4; ++q) { const f32x4 w4 = *(const f32x4*)(P.final_norm_w + 4 * lane + 256 * q); *(f32x4*)(row + 4 * lane + 256 * q) = (v[q] * rstd) * w4; }
    }
}

#define XB_TMO      128
#define XB_XCNT(j)  (256  + 64 * (j))
#define XB_XSUB(j)  (1280 + 64 * (j))
#define XB_XGEN(j)  (2304 + 64 * (j))
#define XB_TOP      3328
#define XB_TOPGEN   3392
#define XCD_BAR_WORDS 3456
#define XB_SPIN_CAP (1u << 18)

__device__ __forceinline__ unsigned xb_ld(unsigned* p)              { return __hip_atomic_load(p, __ATOMIC_RELAXED, __HIP_MEMORY_SCOPE_AGENT); }
__device__ __forceinline__ unsigned xb_add(unsigned* p, unsigned v) { return __hip_atomic_fetch_add(p, v, __ATOMIC_RELAXED, __HIP_MEMORY_SCOPE_AGENT); }
__device__ __forceinline__ unsigned xb_xcc_id() { return (unsigned)__builtin_amdgcn_s_getreg((3 << 11) | 20) & 0xFu; }
#define XB_SPIN(cond, bar) do { unsigned _sp = 0; while (cond) { __builtin_amdgcn_s_sleep(1); \
    if ((++_sp & 255u) == 0u) { if (xb_ld(&(bar)[XB_TMO])) break; if (_sp > XB_SPIN_CAP) { atomicAdd(&(bar)[XB_TMO], 1u); break; } } } } while (0)

struct XcdBarrier {
    unsigned* bar; unsigned x;
    volatile LAS unsigned* st;
};

__device__ __forceinline__ XcdBarrier xcd_barrier_post(unsigned* bar, volatile LAS unsigned* st) {
    XcdBarrier b; b.bar = bar; b.x = xb_xcc_id(); b.st = st;
    if (threadIdx.x == 0) (void)xb_add(&bar[XB_XCNT(b.x)], 1u);
    return b;
}
__device__ __forceinline__ void xcd_barrier_complete(unsigned* bar, unsigned x, unsigned& nloc, unsigned& nx) {
    const unsigned G = gridDim.x * gridDim.y * gridDim.z;
    unsigned sum, cnt, mine, sp = 0u;
    for (;;) {
        sum = 0u; cnt = 0u; mine = 0u;
#pragma unroll
        for (unsigned j = 0; j < 16; ++j) { const unsigned c = xb_ld(&bar[XB_XCNT(j)]); sum += c; cnt += (c > 0u) ? 1u : 0u; mine = (j == x) ? c : mine; }
        if (sum == G) break;
        __builtin_amdgcn_s_sleep(1);
        if ((++sp & 255u) == 0u) { if (xb_ld(&bar[XB_TMO])) break; if (sp > XB_SPIN_CAP) { atomicAdd(&bar[XB_TMO], 1u); break; } }
    }
    nloc = mine > 0u ? mine : 1u; nx = cnt > 0u ? cnt : 1u;
}

__device__ __forceinline__ void xcd_barrier(const XcdBarrier& b) {
    asm volatile("s_waitcnt vmcnt(0)" ::: "memory");
    __syncthreads();
    if (threadIdx.x == 0) {
        unsigned* bar = b.bar;
        __builtin_amdgcn_s_waitcnt(0);
        unsigned nloc = b.st[0], nx = b.st[1];
        if (nloc == 0u) { xcd_barrier_complete(bar, b.x, nloc, nx); b.st[0] = nloc; b.st[1] = nx; }
        const unsigned old = xb_add(&bar[XB_XSUB(b.x)], 1u);
        const unsigned gen = old / nloc;
        if (old + 1u == (gen + 1u) * nloc) {
            __builtin_amdgcn_fence(__ATOMIC_RELEASE, "agent");
            asm volatile("s_waitcnt vmcnt(0)" ::: "memory");
            const unsigned og = xb_add(&bar[XB_TOP], 1u);
            const unsigned tg = og / nx;
            if (og + 1u == (tg + 1u) * nx) xb_add(&bar[XB_TOPGEN], 1u);
            else XB_SPIN(xb_ld(&bar[XB_TOPGEN]) == tg, bar);
            __builtin_amdgcn_fence(__ATOMIC_ACQUIRE, "agent");
            xb_add(&bar[XB_XGEN(b.x)], 1u);
            asm volatile("s_waitcnt vmcnt(0)" ::: "memory");
        } else {
            XB_SPIN(xb_ld(&bar[XB_XGEN(b.x)]) == gen, bar);
            __builtin_amdgcn_fence(__ATOMIC_ACQUIRE, "agent");
            asm volatile("s_waitcnt vmcnt(0)" ::: "memory");
        }
    }
    __syncthreads();
}

constexpr int PARAM_OFF = LDS_BYTES - 256;
static_assert(GL_END <= PARAM_OFF && sizeof(Params) <= 256, "LDS map");
DI const float* ld_uptr(const LAS unsigned long long* s, int i) {
    const unsigned long long v = s[i];
    const unsigned lo = __builtin_amdgcn_readfirstlane((unsigned)v), hi = __builtin_amdgcn_readfirstlane((unsigned)(v >> 32));
    return (const float*)(((unsigned long long)hi << 32) | lo);
}
DI Params load_params(LAS unsigned char* lds) {
    LAS unsigned char* pb = lds + PARAM_OFF; asm volatile("" : "+v"(pb));
    const LAS unsigned long long* s = (const LAS unsigned long long*)pb;
    Params Q;
    Q.x = ld_uptr(s, 0); Q.c = ld_uptr(s, 1); Q.ctx = ld_uptr(s, 2); Q.c_ctx = ld_uptr(s, 3); Q.ada_w = ld_uptr(s, 4); Q.ada_b = ld_uptr(s, 5); Q.norm_w = ld_uptr(s, 6);
    Q.ev_w_in = ld_uptr(s, 7); Q.ev_conv_w = ld_uptr(s, 8); Q.ev_conv_b = ld_uptr(s, 9); Q.ev_rg_wx = ld_uptr(s, 10); Q.ev_rg_bx = ld_uptr(s, 11); Q.ev_rg_wa = ld_uptr(s, 12);
    Q.ev_rg_ba = ld_uptr(s, 13); Q.ev_rg_lambda = ld_uptr(s, 14); Q.ev_sink = ld_uptr(s, 15); Q.ev_w_out = ld_uptr(s, 16); Q.od_w_in = ld_uptr(s, 17); Q.od_lb_raw = ld_uptr(s, 18);
    Q.od_gnorm_w = ld_uptr(s, 19); Q.od_w_out = ld_uptr(s, 20); Q.final_norm_w = ld_uptr(s, 21); Q.out = (float*)ld_uptr(s, 22); Q.ws = (unsigned char*)ld_uptr(s, 23);
    Q.ph_lo = 0; Q.ph_hi = 0;
    return Q;
}
DI void run_phase(LAS unsigned char* lds, int ph) {
    #ifndef PHMASK
#define PHMASK 0xffff
#endif
    if (ph == 0) { if (PHMASK & 1) { const Params P = load_params(lds); phase_pro(P, lds); } return; }
    if (ph == NPHASE - 1) { if (PHMASK & 2) { const Params P = load_params(lds); phase_final(P); } return; }
    const int layer = (ph - 1) / 5, sub = (ph - 1) % 5, j = layer >> 1;
    const bool even = (layer & 1) == 0;
    if (sub == 0) { if (PHMASK & 4) { const Params P = load_params(lds); phase_norm(P, lds, layer); } return; }
    if (sub == 1) {
        const Params P = load_params(lds); bf16_t* pbuf = (bf16_t*)(P.ws + WS_P);
        const int N = even ? EVEN_IN : ODD_IN;
        pg8::Gemm gm{(const bf16_t*)(P.ws + WS_OV), (const bf16_t*)(P.ws + WS_WIN), MROWS, N, 1024, 1024};
        pg8::StaticOrder S; S.init(MROWS, N, (int)gridDim.x, get_bid());
        EpiStoreBf16 E{pbuf, N};
        if (PHMASK & 8) pg8::gemm_phase<EpiStoreBf16, pg8::StaticOrder, true, true>(lds, gm, S, E);
        return;
    }
    if (sub == 2) {
        const Params P = load_params(lds);
        if (even) {
            for (int it = get_bid(); it < 576 + NB * NCHUNK * 8; it += gridDim.x) {
                if (it < 576) { if (PHMASK & 16) attn_item(P, lds, j, it); } else { if (PHMASK & 32) rglru_item<false>(P, lds, j, it - 576); }
            }
        } else {
            for (int it = get_bid(); it < 256; it += gridDim.x) { if (PHMASK & 64) gla_item(P, lds, j, it); }
        }
        return;
    }
    if (sub == 3) {
        const Params P = load_params(lds);
        if (even) { for (int it = get_bid(); it < NB * NCHUNK * 8; it += gridDim.x) { if (PHMASK & 128) rglru_item<true>(P, lds, j, it); } }
        else { if (PHMASK & 256) phase_readout(P, j); }
        return;
    }
    {
        const Params P = load_params(lds); bf16_t* pbuf = (bf16_t*)(P.ws + WS_P);
        const int K = even ? 2048 : 1024, lda = even ? EVEN_IN : ODD_IN;
        pg8::Gemm gm{pbuf + (even ? 1536 : 4096), (const bf16_t*)(P.ws + WS_WOUT), MROWS, 1024, K, lda};
        pg8::StaticOrder S; S.init(MROWS, 1024, (int)gridDim.x, get_bid());
        const float* hl = layer == 0 ? P.x : P.out; const float* hc = layer == 0 ? P.ctx : (const float*)(P.ws + WS_HCTX);
        EpiResid E{hl, hc, P.out, (float*)(P.ws + WS_HCTX), (const float*)(P.ws + WS_MOD) + (size_t)layer * 9 * 3072 + 2048};
        if (PHMASK & 512) pg8::gemm_phase<EpiResid, pg8::StaticOrder, true, true>(lds, gm, S, E);
    }
}

__global__ void __launch_bounds__(512, 2) mega(Params P) {
    extern __shared__ __attribute__((aligned(16))) unsigned char lds_raw[];
    LAS unsigned char* lds = (LAS unsigned char*)lds_raw;
    cg::grid_group grid = cg::this_grid();
    if (threadIdx.x == 0) {
        ((LAS unsigned*)(lds + PARAM_OFF + 208))[0] = 0u; ((LAS unsigned*)(lds + PARAM_OFF + 208))[1] = 0u;
        LAS unsigned long long* d = (LAS unsigned long long*)(lds + PARAM_OFF);
        d[0] = (unsigned long long)P.x; d[1] = (unsigned long long)P.c; d[2] = (unsigned long long)P.ctx; d[3] = (unsigned long long)P.c_ctx; d[4] = (unsigned long long)P.ada_w;
        d[5] = (unsigned long long)P.ada_b; d[6] = (unsigned long long)P.norm_w; d[7] = (unsigned long long)P.ev_w_in; d[8] = (unsigned long long)P.ev_conv_w; d[9] = (unsigned long long)P.ev_conv_b;
        d[10] = (unsigned long long)P.ev_rg_wx; d[11] = (unsigned long long)P.ev_rg_bx; d[12] = (unsigned long long)P.ev_rg_wa; d[13] = (unsigned long long)P.ev_rg_ba; d[14] = (unsigned long long)P.ev_rg_lambda;
        d[15] = (unsigned long long)P.ev_sink; d[16] = (unsigned long long)P.ev_w_out; d[17] = (unsigned long long)P.od_w_in; d[18] = (unsigned long long)P.od_lb_raw; d[19] = (unsigned long long)P.od_gnorm_w;
        d[20] = (unsigned long long)P.od_w_out; d[21] = (unsigned long long)P.final_norm_w; d[22] = (unsigned long long)P.out; d[23] = (unsigned long long)P.ws;
    }
    __syncthreads();
    const int ph_lo = P.ph_lo, ph_hi = P.ph_hi;
    XcdBarrier xbar = xcd_barrier_post((unsigned*)(P.ws + WS_CTL) + 4096, (volatile LAS unsigned*)(lds + PARAM_OFF + 208));
#define GRID_SYNC(first) do { if (first) grid.sync(); else xcd_barrier(xbar); } while (0)
#if defined(PROBE_S)
    constexpr int PREP = PROBE_E - PROBE_S + 1;
#pragma unroll 1
    for (int seq = ph_lo; seq < ph_hi + PREP; ++seq) {
        if (seq > ph_lo) GRID_SYNC(seq == ph_lo + 1);
        const int ph = seq <= PROBE_E ? seq : seq - PREP;
        run_phase(lds, ph);
    }
#else
#pragma unroll 1
    for (int ph = ph_lo; ph < ph_hi; ++ph) {
        if (ph > ph_lo) GRID_SYNC(ph == ph_lo + 1);
        run_phase(lds, ph);
    }
#endif
}

extern "C" void kernel_launch(void* const* d_in, const int* in_sizes, int n_in, void* d_out, int out_size, void* d_ws, size_t ws_size, hipStream_t stream) {
    static int grid = 0;
    if (grid == 0) {
        if (n_in != 22 || ws_size < WS_END) { fprintf(stderr, "kernel_launch: unexpected inputs (n_in %d, ws %zu)\n", n_in, ws_size); grid = -1; return; }
        int dev = 0, cus = 0, per_cu = 0;
        hipGetDevice(&dev);
        hipDeviceGetAttribute(&cus, hipDeviceAttributeMultiprocessorCount, dev);
        if (hipFuncSetAttribute((const void*)mega, hipFuncAttributeMaxDynamicSharedMemorySize, LDS_BYTES) != hipSuccess) { fprintf(stderr, "kernel_launch: hipFuncSetAttribute failed\n"); grid = -1; return; }
        if (hipOccupancyMaxActiveBlocksPerMultiprocessor(&per_cu, (const void*)mega, 512, LDS_BYTES) != hipSuccess || per_cu < 1) { fprintf(stderr, "kernel_launch: occupancy query gives %d\n", per_cu); per_cu = 1; }
        (void)hipGetLastError();
        grid = cus;
    }
    if (grid < 0) return;
    if (hipMemsetAsync((char*)d_ws + WS_CTL, 0, 65536, stream) != hipSuccess) { fprintf(stderr, "kernel_launch: memset failed\n"); return; }
    Params P{};
    const float** pp = (const float**)&P;
    for (int i = 0; i < 22; ++i) pp[i] = (const float*)d_in[i];
    P.out = (float*)d_out; P.ws = (unsigned char*)d_ws;
#if ONE_LAUNCH
    P.ph_lo = 0; P.ph_hi = NPHASE;
    { void* args[] = {&P}; hipError_t e = hipLaunchCooperativeKernel((const void*)mega, dim3(grid), dim3(512), args, LDS_BYTES, stream);
      if (e != hipSuccess) fprintf(stderr, "cooperative launch failed: %s (grid %d)\n", hipGetErrorString(e), grid); }
#else
    for (int ph = 0; ph < NPHASE; ++ph) {
        P.ph_lo = ph; P.ph_hi = ph + 1;
        void* args[] = {&P}; hipError_t e = hipLaunchCooperativeKernel((const void*)mega, dim3(grid), dim3(512), args, LDS_BYTES, stream);
        if (e != hipSuccess) { fprintf(stderr, "launch %d failed: %s (grid %d)\n", ph, hipGetErrorString(e), grid); break; }
    }
#endif
}
```

```cpp
#include <hip/hip_runtime.h>
#include <hip/hip_cooperative_groups.h>
#include <cstdio>
#include <cstdint>
namespace cg = cooperative_groups;

#ifndef ONE_LAUNCH
#define ONE_LAUNCH 1
#endif

#define DI __device__ __forceinline__
#define LAS __attribute__((address_space(3)))
__device__ __forceinline__ int lane_nh() { int l; asm volatile("v_mbcnt_lo_u32_b32 %0, -1, 0\n\tv_mbcnt_hi_u32_b32 %0, -1, %0" : "=v"(l)); return l; }
__device__ __forceinline__ int get_tid(int wv) { asm volatile("" : "+s"(wv)); return wv * 64 + lane_nh(); }
__device__ __forceinline__ float shfl_xor_f(float v, int o) { return __int_as_float(__builtin_amdgcn_ds_bpermute((lane_nh() ^ o) << 2, __float_as_int(v))); }
__device__ __forceinline__ int get_bid() { int b = blockIdx.x; asm volatile("" : "+s"(b)); return b; }
namespace pg8 {
#define PG8_LAS __attribute__((address_space(3)))
typedef unsigned short bf16_t;
typedef short bf16x8 __attribute__((ext_vector_type(8)));
typedef float f32x4 __attribute__((ext_vector_type(4)));
typedef unsigned u32x4 __attribute__((ext_vector_type(4)));
constexpr int BM = 256, BK = 64, HALF = 128, HTB = HALF * BK * 2  , STAGE_BYTES = 8 * HTB, NXCD = 8, WGM = 8;

__host__ __device__ __forceinline__ int lds_byte(int r, int c) { const int st = (r >> 4) * 2 + (c >> 5), rr = r & 15, cc = c & 31, ob = rr * 64 + cc * 2; return st * 1024 + (ob ^ (((ob >> 9) & 1) << 5)); }
__host__ __device__ __forceinline__ void stage_rc(int b, int& R, int& C) { const int st = b / 1024, sb = b % 1024, swz = sb ^ (((sb >> 9) & 1) << 5); R = (st >> 1) * 16 + swz / 64; C = (st & 1) * 32 + (swz % 64) / 2; }
__host__ __device__ __forceinline__ int perm32(int rho) { const int n = rho >> 4, i = rho & 15; return 8 * (i >> 2) + 4 * n + (i & 3); }

struct Unit { int pm, pn; };
struct Gemm { const bf16_t* A; const bf16_t* Bt; int M, N, K, lda; };

struct StaticOrder {
    int nM, nN, nwg, G, c;
    __host__ __device__ void init(int M, int N, int G_, int c_) { nM = M / BM; nN = N / BM; nwg = nM * nN; G = G_; c = c_; }
    __host__ __device__ bool next(int i, Unit& u) const {
        const long L = (long)i * G + c; if (L >= nwg) return false;
        int wgid = (int)L; { const int q = nwg / NXCD, r = nwg % NXCD, xcd = wgid % NXCD, off = wgid / NXCD; wgid = (xcd < r ? xcd * (q + 1) : r * (q + 1) + (xcd - r) * q) + off; }
        const int nig = WGM * nN, gid = wgid / nig, fm = gid * WGM, gsz = (nM - fm) < WGM ? (nM - fm) : WGM;
        u.pm = fm + ((wgid % nig) % gsz); u.pn = (wgid % nig) / gsz; return true;
    }
    __device__ __forceinline__ void a_ready(const Unit&) const {}
    __device__ __forceinline__ void done(const Unit&) const {}
};

template <class Epi, class Sched, bool ALIGN_EPI = false, bool SP2 = false>
__device__ __forceinline__ void gemm_phase(PG8_LAS unsigned char* lds, const Gemm g, const Sched& S, const Epi& E, int wv) {
    const int tid = get_tid(wv), wid = __builtin_amdgcn_readfirstlane(tid >> 6), lane = tid & 63, wr = wid >> 2, wc = wid & 3, fr = lane & 15, fq = lane >> 4;
    const int K = g.K, nt = K / BK;
    unsigned voffA[2], voffB[2];
#pragma unroll
    for (int i = 0; i < 2; ++i) { int R, C; stage_rc(tid * 16 + i * 8192, R, C); const int Rb = Epi::PERM ? ((R & ~31) + perm32(R & 31)) : R;
        voffA[i] = (unsigned)(R * g.lda + C) * 2u; voffB[i] = (unsigned)(Rb * K + C) * 2u; }
    const size_t kstep = (size_t)(BK * 2);
    const size_t hstepA = (size_t)HALF * g.lda * 2, hstepB = (size_t)HALF * K * 2;
    const size_t tstepA = 2 * hstepA, tstepB = 2 * hstepB;
    const unsigned ldsw = (unsigned)wid * 1024u;
    const int aoff = lds_byte(wr * 64 + fr, fq * 8), boff = lds_byte(wc * 32 + fr, fq * 8);
#define PG8_SA(b, h) (((b) * 2 + (h)) * HTB)
#define PG8_SB(b, h) ((4 + (b) * 2 + (h)) * HTB)
#define PG8_STAGE(bufoff, gbase, voff) do { _Pragma("unroll") for (int _i = 0; _i < 2; ++_i) \
        __builtin_amdgcn_global_load_lds((const unsigned*)((const char*)(gbase) + (voff)[_i]), (PG8_LAS unsigned*)(lds + (bufoff) + ldsw + _i * 8192), 16, 0, 0); } while (0)
#define PG8_LDA(dst, b, h) do { _Pragma("unroll") for (int m = 0; m < 4; ++m) _Pragma("unroll") for (int k = 0; k < 2; ++k) dst[m][k] = *(const PG8_LAS bf16x8*)(lds + PG8_SA(b, h) + aoff + m * 2048 + k * 1024); } while (0)
#define PG8_LDB(dst, b, h) do { _Pragma("unroll") for (int n = 0; n < 2; ++n) _Pragma("unroll") for (int k = 0; k < 2; ++k) dst[n][k] = *(const PG8_LAS bf16x8*)(lds + PG8_SB(b, h) + boff + n * 2048 + k * 1024); } while (0)
#define PG8_MMA(ai, bj, At, Bt) do { __builtin_amdgcn_s_setprio(1); _Pragma("unroll") for (int m = 0; m < 4; ++m) _Pragma("unroll") for (int n = 0; n < 2; ++n) _Pragma("unroll") for (int k = 0; k < 2; ++k) \
        acc[ai][bj][m][n] = __builtin_amdgcn_mfma_f32_16x16x32_bf16(Bt[n][k], At[m][k], acc[ai][bj][m][n], 0, 0, 0); __builtin_amdgcn_s_setprio(0); } while (0)
#define PG8_WAIT_V(n) asm volatile("s_waitcnt vmcnt(" #n ")" ::: "memory")
#define PG8_WAIT_L(n) asm volatile("s_waitcnt lgkmcnt(" #n ")" ::: "memory")
#define PG8_BAR __builtin_amdgcn_s_barrier()
#define PG8_SCHED __builtin_amdgcn_sched_barrier(0)
    Unit cur, nxt; int ui = 0;
    if (!S.next(0, cur)) return;
    f32x4 acc[2][2][4][2];
#pragma unroll
    for (int a = 0; a < 2; ++a)
#pragma unroll
        for (int b = 0; b < 2; ++b)
#pragma unroll
            for (int m = 0; m < 4; ++m)
#pragma unroll
                for (int n = 0; n < 2; ++n) acc[a][b][m][n] = (f32x4){0.f, 0.f, 0.f, 0.f};
    bf16x8 At[4][2], B0[2][2], B1[2][2];
    const char* cA = (const char*)g.A + (size_t)cur.pm * tstepA; const char* cB = (const char*)g.Bt + (size_t)cur.pn * tstepB;
    S.a_ready(cur);
    if constexpr (SP2) {
        PG8_STAGE(PG8_SB(0, 0), cB, voffB); PG8_STAGE(PG8_SB(0, 1), cB + hstepB, voffB); PG8_STAGE(PG8_SA(0, 0), cA, voffA); PG8_STAGE(PG8_SA(0, 1), cA + hstepA, voffA);
        if (wr == 1) PG8_BAR;
        PG8_WAIT_V(2); PG8_BAR;
        PG8_STAGE(PG8_SB(1, 0), cB + kstep, voffB); PG8_STAGE(PG8_SA(1, 0), cA + kstep, voffA); PG8_STAGE(PG8_SB(1, 1), cB + hstepB + kstep, voffB);
        PG8_WAIT_V(6); PG8_BAR;
    } else {
        PG8_STAGE(PG8_SB(0, 0), cB, voffB); PG8_STAGE(PG8_SA(0, 0), cA, voffA); PG8_STAGE(PG8_SB(0, 1), cB + hstepB, voffB); PG8_STAGE(PG8_SA(0, 1), cA + hstepA, voffA);
        if (wr == 1) PG8_BAR;
        PG8_WAIT_V(4); PG8_BAR;
        PG8_STAGE(PG8_SB(1, 0), cB + kstep, voffB); PG8_STAGE(PG8_SA(1, 0), cA + kstep, voffA); PG8_STAGE(PG8_SB(1, 1), cB + hstepB + kstep, voffB);
        PG8_WAIT_V(6); PG8_BAR;
    }
    for (;;) {
        const bool has_next = S.next(ui + 1, nxt);
        const char* nA = has_next ? (const char*)g.A + (size_t)nxt.pm * tstepA : cA; const char* nB = has_next ? (const char*)g.Bt + (size_t)nxt.pn * tstepB : cB;
        for (int t = 0; t < nt; t += 2) {
            const bool last = (t == nt - 2);
            const char* a1 = cA + (size_t)(t + 1) * kstep;
            const char* a2 = last ? nA : cA + (size_t)(t + 2) * kstep; const char* b2 = last ? nB : cB + (size_t)(t + 2) * kstep;
            const char* a3 = a2 + kstep; const char* b3 = b2 + kstep;
            if (last && has_next) S.a_ready(nxt);
            if constexpr (SP2) {
            PG8_LDB(B0, 0, 0); PG8_LDB(B1, 0, 1); PG8_SCHED; PG8_LDA(At, 0, 0); PG8_STAGE(PG8_SA(1, 1), a1 + hstepA, voffA);
            PG8_WAIT_V(8); PG8_WAIT_L(0); PG8_BAR; PG8_MMA(0, 0, At, B0); PG8_MMA(0, 1, At, B1); PG8_BAR; PG8_SCHED;
            PG8_LDA(At, 0, 1); PG8_STAGE(PG8_SB(0, 0), b2, voffB); PG8_STAGE(PG8_SB(0, 1), b2 + hstepB, voffB); PG8_STAGE(PG8_SA(0, 0), a2, voffA);
            PG8_WAIT_V(8); PG8_WAIT_L(0); PG8_BAR; PG8_MMA(1, 0, At, B0); PG8_MMA(1, 1, At, B1); PG8_BAR; PG8_SCHED;
            PG8_LDB(B0, 1, 0); PG8_LDB(B1, 1, 1); PG8_SCHED; PG8_LDA(At, 1, 0); PG8_STAGE(PG8_SA(0, 1), a2 + hstepA, voffA);
            PG8_WAIT_V(8); PG8_WAIT_L(0); PG8_BAR; PG8_MMA(0, 0, At, B0); PG8_MMA(0, 1, At, B1); PG8_BAR; PG8_SCHED;
            PG8_LDA(At, 1, 1); PG8_STAGE(PG8_SB(1, 0), b3, voffB); PG8_STAGE(PG8_SB(1, 1), b3 + hstepB, voffB); PG8_STAGE(PG8_SA(1, 0), a3, voffA);
            PG8_WAIT_V(8); PG8_WAIT_L(0); PG8_BAR; PG8_MMA(1, 0, At, B0); PG8_MMA(1, 1, At, B1); PG8_BAR; PG8_SCHED;
            } else {
            PG8_LDB(B0, 0, 0); PG8_SCHED; PG8_LDA(At, 0, 0); PG8_STAGE(PG8_SA(1, 1), a1 + hstepA, voffA);
            PG8_WAIT_L(8); PG8_BAR; PG8_WAIT_L(0); PG8_MMA(0, 0, At, B0); PG8_BAR; PG8_SCHED;
            PG8_LDB(B1, 0, 1); PG8_STAGE(PG8_SB(0, 0), b2, voffB);
            PG8_BAR; PG8_WAIT_L(0); PG8_MMA(0, 1, At, B1); PG8_BAR;
            PG8_LDA(At, 0, 1); PG8_STAGE(PG8_SA(0, 0), a2, voffA);
            PG8_BAR; PG8_WAIT_L(0); PG8_MMA(1, 0, At, B0); PG8_BAR; PG8_SCHED;
            PG8_STAGE(PG8_SB(0, 1), b2 + hstepB, voffB);
            PG8_WAIT_V(6); PG8_BAR; PG8_MMA(1, 1, At, B1); PG8_BAR;
            PG8_LDB(B0, 1, 0); PG8_SCHED; PG8_LDA(At, 1, 0); PG8_STAGE(PG8_SA(0, 1), a2 + hstepA, voffA);
            PG8_WAIT_L(8); PG8_BAR; PG8_WAIT_L(0); PG8_MMA(0, 0, At, B0); PG8_BAR; PG8_SCHED;
            PG8_LDB(B1, 1, 1); PG8_STAGE(PG8_SB(1, 0), b3, voffB);
            PG8_BAR; PG8_WAIT_L(0); PG8_MMA(0, 1, At, B1); PG8_BAR;
            PG8_LDA(At, 1, 1); PG8_STAGE(PG8_SA(1, 0), a3, voffA);
            PG8_BAR; PG8_WAIT_L(0); PG8_MMA(1, 0, At, B0); PG8_BAR; PG8_SCHED;
            PG8_STAGE(PG8_SB(1, 1), b3 + hstepB, voffB);
            PG8_WAIT_V(6); PG8_BAR; PG8_MMA(1, 1, At, B1); PG8_BAR;
            }
        }
        if constexpr (ALIGN_EPI) { if (wr == 0) PG8_BAR; }
        if constexpr (!Epi::AFTER_DRAIN) { E(acc, cur, wr, wc, fr, fq); S.done(cur); }
        if (!has_next) break;
#pragma unroll
        for (int a = 0; a < 2; ++a)
#pragma unroll
            for (int b = 0; b < 2; ++b)
#pragma unroll
                for (int m = 0; m < 4; ++m)
#pragma unroll
                    for (int n = 0; n < 2; ++n) acc[a][b][m][n] = (f32x4){0.f, 0.f, 0.f, 0.f};
        cur = nxt; cA = nA; cB = nB; ++ui;
        if constexpr (ALIGN_EPI) { if (wr == 1) PG8_BAR; }
    }
    PG8_WAIT_V(0);
    if constexpr (!ALIGN_EPI) { if (wr == 0) PG8_BAR; }
    PG8_BAR;
    if constexpr (Epi::AFTER_DRAIN) { E.fused(acc, cur, wr, wc, fr, fq, lds, wid, lane); S.done(cur); }
#undef PG8_SA
#undef PG8_SB
#undef PG8_STAGE
#undef PG8_LDA
#undef PG8_LDB
#undef PG8_MMA
#undef PG8_WAIT_V
#undef PG8_WAIT_L
#undef PG8_BAR
#undef PG8_SCHED
}
}

typedef unsigned short bf16_t;
typedef short bf16x8 __attribute__((ext_vector_type(8)));
typedef short s16x4 __attribute__((ext_vector_type(4)));
typedef float f32x4 __attribute__((ext_vector_type(4)));
typedef float f32x16 __attribute__((ext_vector_type(16)));
typedef unsigned u32x4 __attribute__((ext_vector_type(4)));
typedef unsigned u32x2 __attribute__((ext_vector_type(2)));
typedef float f32x2 __attribute__((ext_vector_type(2)));

constexpr int DM = 1024, NB = 8, SEQ = 2048, CTXL = 256, LT = SEQ + CTXL  , MROWS = NB * LT  ;
constexpr int EVEN_IN = 4608, ODD_IN = 5120, NCHUNK = LT / 64  ;
constexpr float RMS_EPS = 1e-6f, LOG2E = 1.4426950408889634f;
constexpr int LDS_BYTES = 160 * 1024;
constexpr int NPHASE = 22;

constexpr size_t WS_CTL = 0;
constexpr size_t WS_MOD = 65536;
constexpr size_t WS_ROPE = 524288;
constexpr size_t WS_AGG = 1048576;
constexpr size_t WS_HCTX = WS_AGG + 4718592;
constexpr size_t WS_WIN = WS_HCTX + 8388608;
constexpr size_t WS_WOUT = WS_WIN + 10485760;
constexpr size_t WS_WRG = WS_WOUT + 4194304;
constexpr size_t WS_OV = WS_WRG + 1048576;
constexpr size_t WS_P = WS_OV + 37748736;
constexpr size_t WS_END = WS_P + 188743680;
static_assert(WS_END <= 268435456, "workspace map exceeds 256 MiB");

struct Params {
    const float *x, *c, *ctx, *c_ctx, *ada_w, *ada_b, *norm_w, *ev_w_in, *ev_conv_w, *ev_conv_b, *ev_rg_wx, *ev_rg_bx, *ev_rg_wa, *ev_rg_ba,
        *ev_rg_lambda, *ev_sink, *ev_w_out, *od_w_in, *od_lb_raw, *od_gnorm_w, *od_w_out, *final_norm_w;
    float* out; unsigned char* ws; int ph_lo, ph_hi;
};

DI float bf2f(unsigned short v) { return __uint_as_float((unsigned)v << 16); }
DI unsigned f2bf(float f) { unsigned u = __float_as_uint(f); return (u + 0x7fffu + ((u >> 16) & 1u)) >> 16; }
DI unsigned pk2(float lo, float hi) { return f2bf(lo) | (f2bf(hi) << 16); }
DI float sigm(float x) { return __builtin_amdgcn_rcpf(1.f + __expf(-x)); }
DI float softplus_neg(float lam) {
    const float e = __expf(-lam);
    return e < 0.06f ? e * (1.f + e * (-0.5f + e * (0.33333333f + e * (-0.25f + e * 0.2f)))) : __logf(1.f + e);
}
DI float neg_expm1(float x) {
    return x > -0.25f ? -x * (1.f + x * (0.5f + x * (0.16666667f + x * (0.041666668f + x * (0.0083333338f + x * 0.0013888889f))))) : 1.f - __expf(x);
}
DI float wave_sum(float v) {
#pragma unroll
    for (int o = 1; o < 64; o <<= 1) v += shfl_xor_f(v, o);
    return v;
}
DI int crow(int reg, int h) { return (reg & 3) + 8 * (reg >> 2) + 4 * h; }
#define MFMA16(a, b, c) __builtin_amdgcn_mfma_f32_16x16x32_bf16((a), (b), (c), 0, 0, 0)
#define MFMA32(a, b, c) __builtin_amdgcn_mfma_f32_32x32x16_bf16((a), (b), (c), 0, 0, 0)

struct EpiStoreBf16 {
    static constexpr bool PERM = true, AFTER_DRAIN = false;
    bf16_t* O; int ldc;
    DI void operator()(const f32x4 (&acc)[2][2][4][2], const pg8::Unit& u, int wr, int wc, int fr, int fq) const {
        const int row0 = u.pm * 256 + wr * 64 + fr, col0 = u.pn * 256 + wc * 32 + 8 * fq;
#pragma unroll
        for (int ai = 0; ai < 2; ++ai)
#pragma unroll
            for (int m = 0; m < 4; ++m) { bf16_t* rowp = O + (size_t)(row0 + ai * 128 + m * 16) * ldc + col0;
#pragma unroll
                for (int bj = 0; bj < 2; ++bj) { const f32x4 v0 = acc[ai][bj][m][0], v1 = acc[ai][bj][m][1];
                    u32x4 w; w.x = pk2(v0[0], v0[1]); w.y = pk2(v0[2], v0[3]); w.z = pk2(v1[0], v1[1]); w.w = pk2(v1[2], v1[3]);
                    *(u32x4*)(rowp + bj * 128) = w; } }
    }
};
struct EpiResid {
    static constexpr bool PERM = false, AFTER_DRAIN = false;
    const float* in_lat; const float* in_ctx; float* out_lat; float* out_ctx; const float* gate;
    DI void operator()(const f32x4 (&acc)[2][2][4][2], const pg8::Unit& u, int wr, int wc, int fr, int fq) const {
        const int b = u.pm / 9, jt = u.pm % 9;
        const float* ib; float* ob; const float* g;
        if (jt == 0) { const size_t off = (size_t)b * CTXL * DM; ib = in_ctx + off; ob = out_ctx + off; g = gate + 8 * 3072; }
        else { const size_t off = ((size_t)b * SEQ + (size_t)(jt - 1) * 256) * DM; ib = in_lat + off; ob = out_lat + off; g = gate + b * 3072; }
        const int col0 = u.pn * 256 + wc * 32 + 4 * fq;
#pragma unroll
        for (int bj = 0; bj < 2; ++bj)
#pragma unroll
            for (int n = 0; n < 2; ++n) {
                const f32x4 gvv = *(const f32x4*)(g + col0 + bj * 128 + n * 16);
#pragma unroll
                for (int ai = 0; ai < 2; ++ai) {
#pragma unroll
                    for (int m = 0; m < 4; ++m) { const int r = ai * 128 + wr * 64 + m * 16 + fr;
                        const size_t off = (size_t)r * DM + col0 + bj * 128 + n * 16;
                        const f32x4 o = *(const f32x4*)(ib + off) + gvv * acc[ai][bj][m][n]; *(f32x4*)(ob + off) = o; }
                    asm volatile("" ::: "memory");
                }
            }
    }
};

DI void phase_pro(const Params& P, LAS unsigned char* lds, int wv) {
    const int tid = get_tid(wv);
    LAS float* s = (LAS float*)lds;
    LAS float* red = (LAS float*)(lds + 36864);
    float* mod = (float*)(P.ws + WS_MOD);
    for (int i = tid; i < 9 * 1024; i += 512) { const int r = i >> 10, k = i & 1023; const float v = r < 8 ? P.c[r * 1024 + k] : P.c_ctx[k]; s[i] = v * sigm(v); }
    __syncthreads();
    for (int item = get_bid(); item < 384; item += gridDim.x) {
        const int l = item / 96, n0 = (item % 96) * 32, ks = tid >> 5, col = tid & 31;
        const float* w = P.ada_w + (size_t)l * 1024 * 3072 + n0 + col;
        float acc[9];
#pragma unroll
        for (int r = 0; r < 9; ++r) acc[r] = 0.f;
#pragma unroll 8
        for (int kk = 0; kk < 64; ++kk) { const int k = ks * 64 + kk; const float wv = w[(size_t)k * 3072];
#pragma unroll
            for (int r = 0; r < 9; ++r) acc[r] += s[r * 1024 + k] * wv; }
#pragma unroll
        for (int r = 0; r < 9; ++r) red[(ks * 9 + r) * 32 + col] = acc[r];
        __syncthreads();
        if (tid < 288) { const int r = tid >> 5, cc = tid & 31; float sum = 0.f;
#pragma unroll
            for (int k2 = 0; k2 < 16; ++k2) sum += red[(k2 * 9 + r) * 32 + cc];
            mod[(l * 9 + r) * 3072 + n0 + cc] = sum + P.ada_b[l * 3072 + n0 + cc]; }
        __syncthreads();
    }
    float* cos_t = (float*)(P.ws + WS_ROPE); float* sin_t = cos_t + SEQ * 32;
    for (int i = get_bid() * 512 + tid; i < SEQ * 32; i += gridDim.x * 512) {
        const int pos = i >> 5, jj = i & 31, fi = jj & 15;
        const float inv = __builtin_amdgcn_exp2f(-(float)(2 * fi) * (13.287712379549449f / 32.f));
        const float ang = (float)(jj < 16 ? (pos >> 6) : (pos & 63)) * inv;
        cos_t[i] = __cosf(ang); sin_t[i] = __sinf(ang);
    }
}

DI void transpose_item(const float* W, int K, int N, bf16_t* WT, LAS float* scr, int item, int lane) {
    const int nblk = N / 32, kb = item / nblk, nb = item % nblk, k0 = 64 * kb, n0 = 32 * nb;
#pragma unroll 8
    for (int i = 0; i < 32; ++i) { const int kk = 2 * i + (lane >> 5); scr[kk * 33 + (lane & 31)] = W[(size_t)(k0 + kk) * N + n0 + (lane & 31)]; }
    asm volatile("s_waitcnt lgkmcnt(0)" ::: "memory");
    const int c = lane & 7;
#pragma unroll
    for (int j = 0; j < 4; ++j) { const int n = (lane >> 3) + 8 * j; const LAS float* sp = scr + (8 * c) * 33 + n;
        u32x4 o; o.x = pk2(sp[0 * 33], sp[1 * 33]); o.y = pk2(sp[2 * 33], sp[3 * 33]); o.z = pk2(sp[4 * 33], sp[5 * 33]); o.w = pk2(sp[6 * 33], sp[7 * 33]);
        *(u32x4*)(WT + (size_t)(n0 + n) * K + k0 + 8 * c) = o; }
    asm volatile("s_waitcnt lgkmcnt(0)" ::: "memory");
}

DI void phase_norm(const Params& P, LAS unsigned char* lds, int layer, int wv) {
    const int tid = get_tid(wv), lane = tid & 63, wave = tid >> 6;
    const int gw = get_bid() * 8 + wave, NGW = gridDim.x * 8;
    const int j = layer >> 1;
    LAS float* scr = (LAS float*)(lds + wave * 16384);
    bf16_t* WIN = (bf16_t*)(P.ws + WS_WIN); bf16_t* WOUT = (bf16_t*)(P.ws + WS_WOUT); bf16_t* WRG = (bf16_t*)(P.ws + WS_WRG);
    if ((layer & 1) == 0) {
        constexpr int I_IN = 16 * (EVEN_IN / 32), I_OUT = 32 * 32, I_RG = 32 * 8;
        for (int it = gw; it < I_IN + I_OUT + I_RG; it += NGW) {
            int r = it;
            if (r < I_IN) { transpose_item(P.ev_w_in + (size_t)j * 1024 * EVEN_IN, 1024, EVEN_IN, WIN, scr, r, lane); continue; } r -= I_IN;
            if (r < I_OUT) { transpose_item(P.ev_w_out + (size_t)j * 2048 * 1024, 2048, 1024, WOUT, scr, r, lane); continue; } r -= I_OUT;
            const int mat = r >> 3, sub = r & 7;
            const int dir = mat >> 4, gate = (mat >> 3) & 1, hd = mat & 7;
            const float* src = (gate == 0 ? P.ev_rg_wx : P.ev_rg_wa) + ((size_t)((j * 2 + dir) * 8 + hd)) * 16384;
            transpose_item(src, 128, 128, WRG + (size_t)mat * 16384, scr, sub, lane);
        }
    } else {
        constexpr int I_IN = 16 * (ODD_IN / 32), I_OUT = 16 * 32;
        for (int it = gw; it < I_IN + I_OUT; it += NGW) {
            int r = it;
            if (r < I_IN) { transpose_item(P.od_w_in + (size_t)j * 1024 * ODD_IN, 1024, ODD_IN, WIN, scr, r, lane); continue; } r -= I_IN;
            transpose_item(P.od_w_out + (size_t)j * 1024 * 1024, 1024, 1024, WOUT, scr, r, lane);
        }
    }
    const float* hl = layer == 0 ? P.x : P.out; const float* hc = layer == 0 ? P.ctx : (const float*)(P.ws + WS_HCTX);
    const float* mod = (const float*)(P.ws + WS_MOD) + (size_t)layer * 9 * 3072;
    const float* nw = P.norm_w + layer * 1024;
    bf16_t* U = (bf16_t*)(P.ws + WS_OV);
    for (int R = gw; R < MROWS; R += NGW) {
        const int b = R / LT, jr = R % LT;
        const float* src = jr < CTXL ? hc + ((size_t)b * CTXL + jr) * DM : hl + ((size_t)b * SEQ + (jr - CTXL)) * DM;
        const float* sh = mod + (jr < CTXL ? 8 : b) * 3072; const float* sc = sh + 1024;
        f32x4 v[4]; float ss = 0.f;
#pragma unroll
        for (int q = 0; q < 4; ++q) { v[q] = *(const f32x4*)(src + 4 * lane + 256 * q); ss += (v[q][0] * v[q][0] + v[q][1] * v[q][1]) + (v[q][2] * v[q][2] + v[q][3] * v[q][3]); }
        const float rstd = rsqrtf(wave_sum(ss) * (1.f / DM) + RMS_EPS);
#pragma unroll
        for (int q = 0; q < 4; ++q) { const int k = 4 * lane + 256 * q;
            const f32x4 w4 = *(const f32x4*)(nw + k), s4 = *(const f32x4*)(sc + k), h4 = *(const f32x4*)(sh + k);
            const f32x4 y = (v[q] * rstd) * w4; const f32x4 o = y * (s4 + 1.f) + h4;
            u32x2 w; w.x = pk2(o[0], o[1]); w.y = pk2(o[2], o[3]); *(u32x2*)(U + (size_t)R * DM + k) = w; }
    }
}

template <bool PASS2>
DI void rglru_item(const Params& P, LAS unsigned char* lds, int j, int item, int wv) {
    const int tid = get_tid(wv), lane = tid & 63, wave = tid >> 6, r = lane & 15, g = lane >> 4;
    const int hd = item & 7, ci = (item >> 3) % NCHUNK, b = item / (8 * NCHUNK);
    bf16_t* p = (bf16_t*)(P.ws + WS_P);
    const bf16_t* WRG = (const bf16_t*)(P.ws + WS_WRG);
    float2* AGG = (float2*)(P.ws + WS_AGG);
    const int R0 = b * LT + ci * 64;
    const int seg_lo = b * LT + (ci < 4 ? 0 : CTXL), seg_hi = b * LT + (ci < 4 ? CTXL : LT);
    LAS bf16_t* UT = (LAS bf16_t*)lds;
    LAS float* AL = (LAS float*)(lds + 17408);
    LAS float* BL = (LAS float*)(lds + 17408 + 32768);
    LAS float* YL = (LAS float*)(lds + 17408 + 65536);
    LAS float* QA = (LAS float*)(lds + 17408 + 98304);
    LAS float* CAR = (LAS float*)(lds + 17408 + 98304 + 4096);
#pragma unroll
    for (int rep = 0; rep < 2; ++rep) {
        const int idx = tid + rep * 512, t = idx >> 4, c0 = (idx & 15) * 8, cg0 = hd * 128 + c0;
        float acc[8];
        { const f32x4 b0 = *(const f32x4*)(P.ev_conv_b + j * 1024 + cg0), b1 = *(const f32x4*)(P.ev_conv_b + j * 1024 + cg0 + 4);
          acc[0] = b0[0]; acc[1] = b0[1]; acc[2] = b0[2]; acc[3] = b0[3]; acc[4] = b1[0]; acc[5] = b1[1]; acc[6] = b1[2]; acc[7] = b1[3]; }
#pragma unroll
        for (int k = 0; k < 4; ++k) {
            const int Rg = R0 + t + k - 1;
            if (Rg >= seg_lo && Rg < seg_hi) {
                const u32x4 xv = *(const u32x4*)(p + (size_t)Rg * EVEN_IN + cg0);
                const float* wk = P.ev_conv_w + (size_t)(j * 4 + k) * 1024 + cg0;
                const f32x4 w0 = *(const f32x4*)wk, w1 = *(const f32x4*)(wk + 4);
                acc[0] += w0[0] * __uint_as_float(xv.x << 16); acc[1] += w0[1] * __uint_as_float(xv.x & 0xffff0000u);
                acc[2] += w0[2] * __uint_as_float(xv.y << 16); acc[3] += w0[3] * __uint_as_float(xv.y & 0xffff0000u);
                acc[4] += w1[0] * __uint_as_float(xv.z << 16); acc[5] += w1[1] * __uint_as_float(xv.z & 0xffff0000u);
                acc[6] += w1[2] * __uint_as_float(xv.w << 16); acc[7] += w1[3] * __uint_as_float(xv.w & 0xffff0000u);
            }
        }
        u32x4 o; o.x = pk2(acc[0], acc[1]); o.y = pk2(acc[2], acc[3]); o.z = pk2(acc[4], acc[5]); o.w = pk2(acc[6], acc[7]);
        *(LAS u32x4*)(UT + t * 136 + c0) = o;
    }
    if (PASS2) {
        if (tid < 256) {
            const int dir = tid >> 7, c = tid & 127;
            const int pos = dir == 0 ? ci : (ci < 4 ? 3 - ci : 39 - ci);
            float h = 0.f;
            for (int pp = 0; pp < pos; ++pp) {
                const int cc = dir == 0 ? pp : (pp < 4 ? 3 - pp : 39 - pp);
                const float2 ab = AGG[((size_t)(dir * NB + b) * NCHUNK + cc) * 1024 + hd * 128 + c];
                h = ab.x * h + ab.y;
            }
            CAR[dir * 128 + c] = h;
        }
    }
    __syncthreads();
#pragma unroll 1
    for (int dir = 0; dir < 2; ++dir) {
        f32x4 ax[4], aa[4];
#pragma unroll
        for (int m = 0; m < 4; ++m) { ax[m] = (f32x4){0.f, 0.f, 0.f, 0.f}; aa[m] = (f32x4){0.f, 0.f, 0.f, 0.f}; }
        const bf16_t* Wx = WRG + (size_t)((dir * 2 + 0) * 8 + hd) * 16384 + (16 * wave + r) * 128 + 8 * g;
        const bf16_t* Wa = WRG + (size_t)((dir * 2 + 1) * 8 + hd) * 16384 + (16 * wave + r) * 128 + 8 * g;
#pragma unroll
        for (int ks = 0; ks < 4; ++ks) {
            const bf16x8 bx = *(const bf16x8*)(Wx + 32 * ks), ba = *(const bf16x8*)(Wa + 32 * ks);
#pragma unroll
            for (int m = 0; m < 4; ++m) {
                const bf16x8 a = *(const LAS bf16x8*)(UT + (16 * m + r) * 136 + 32 * ks + 8 * g);
                ax[m] = MFMA16(a, bx, ax[m]); aa[m] = MFMA16(a, ba, aa[m]);
            }
        }
        {
            const int c = 16 * wave + r, idx = (j * 2 + dir) * 1024 + hd * 128 + c;
            const float bxv = P.ev_rg_bx[idx], bav = P.ev_rg_ba[idx], lam = P.ev_rg_lambda[idx];
            const float sp = softplus_neg(lam);
#pragma unroll
            for (int m = 0; m < 4; ++m)
#pragma unroll
                for (int i = 0; i < 4; ++i) {
                    const int t = 16 * m + 4 * g + i;
                    const float gx = sigm(ax[m][i] + bxv), ga = sigm(aa[m][i] + bav);
                    const float la = -8.f * ga * sp;
                    const float a = __expf(la), mult = __builtin_amdgcn_sqrtf(neg_expm1(2.f * la));
                    const float uv = bf2f(UT[t * 136 + c]);
                    AL[t * 128 + c] = a; BL[t * 128 + c] = mult * gx * uv;
                }
        }
        __syncthreads();
        {
            const int c = tid & 127, q = tid >> 7;
            float A = 1.f, B = 0.f;
#pragma unroll
            for (int s = 0; s < 16; ++s) { const int t = dir == 0 ? 16 * q + s : 16 * q + 15 - s; const float a = AL[t * 128 + c], bb = BL[t * 128 + c]; B = a * B + bb; A *= a; }
            QA[(q * 128 + c) * 2] = A; QA[(q * 128 + c) * 2 + 1] = B;
            __syncthreads();
            if (!PASS2) {
                if (q == 0) {
                    float CA = 1.f, CB = 0.f;
#pragma unroll
                    for (int qq = 0; qq < 4; ++qq) { const int qi = dir == 0 ? qq : 3 - qq; const float a = QA[(qi * 128 + c) * 2], bb = QA[(qi * 128 + c) * 2 + 1]; CB = a * CB + bb; CA *= a; }
                    AGG[((size_t)(dir * NB + b) * NCHUNK + ci) * 1024 + hd * 128 + c] = make_float2(CA, CB);
                }
            } else {
                float h = CAR[dir * 128 + c];
                const int nprev = dir == 0 ? q : 3 - q;
                for (int qq = 0; qq < nprev; ++qq) { const int qi = dir == 0 ? qq : 3 - qq; h = QA[(qi * 128 + c) * 2] * h + QA[(qi * 128 + c) * 2 + 1]; }
#pragma unroll
                for (int s = 0; s < 16; ++s) { const int t = dir == 0 ? 16 * q + s : 16 * q + 15 - s; h = AL[t * 128 + c] * h + BL[t * 128 + c];
                    if (dir == 0) YL[t * 128 + c] = h; else YL[t * 128 + c] += h; }
            }
        }
        __syncthreads();
    }
    if (PASS2) {
#pragma unroll
        for (int rep = 0; rep < 2; ++rep) {
            const int idx = tid + rep * 512, t = idx >> 4, c0 = (idx & 15) * 8;
            bf16_t* gp = p + (size_t)(R0 + t) * EVEN_IN + 1536 + hd * 128 + c0;
            const u32x4 gv = *(const u32x4*)gp;
            const f32x4 y0 = *(const LAS f32x4*)(YL + t * 128 + c0), y1 = *(const LAS f32x4*)(YL + t * 128 + c0 + 4);
            float gg[8] = {__uint_as_float(gv.x << 16), __uint_as_float(gv.x & 0xffff0000u), __uint_as_float(gv.y << 16), __uint_as_float(gv.y & 0xffff0000u),
                           __uint_as_float(gv.z << 16), __uint_as_float(gv.z & 0xffff0000u), __uint_as_float(gv.w << 16), __uint_as_float(gv.w & 0xffff0000u)};
            u32x4 o;
            o.x = pk2(y0[0] * gg[0] * sigm(gg[0]), y0[1] * gg[1] * sigm(gg[1])); o.y = pk2(y0[2] * gg[2] * sigm(gg[2]), y0[3] * gg[3] * sigm(gg[3]));
            o.z = pk2(y1[0] * gg[4] * sigm(gg[4]), y1[1] * gg[5] * sigm(gg[5])); o.w = pk2(y1[2] * gg[6] * sigm(gg[6]), y1[3] * gg[7] * sigm(gg[7]));
            *(u32x4*)gp = o;
        }
        __syncthreads();
    }
}

DI void rope8(u32x4& v, const float* cs, const float* sn) {
    unsigned* w = (unsigned*)&v;
#pragma unroll
    for (int i = 0; i < 4; ++i) { const float t1 = __uint_as_float(w[i] << 16), t2 = __uint_as_float(w[i] & 0xffff0000u); w[i] = pk2(t1 * cs[i] - t2 * sn[i], t1 * sn[i] + t2 * cs[i]); }
}
DI void attn_item(const Params& P, LAS unsigned char* lds, int j, int item, int wv) {
    const int tid = get_tid(wv), lane = tid & 63, wave = tid >> 6, r = lane & 31, h = lane >> 5;
    const bool is_lat = item < 512;
    int b, qb, kvh;
    if (is_lat) { b = item >> 6; qb = (item >> 2) & 15; kvh = item & 3; } else { const int it = item - 512; b = it >> 3; qb = (it >> 2) & 1; kvh = it & 3; }
    bf16_t* p = (bf16_t*)(P.ws + WS_P);
    const float* cos_t = (const float*)(P.ws + WS_ROPE); const float* sin_t = cos_t + SEQ * 32;
    LAS unsigned char* KL = lds;
    LAS unsigned char* VT = lds + 9216;
    const int hq = 4 * kvh + (wave >> 1), ql0 = qb * 128 + 64 * (wave & 1);
    const size_t rowbase = (size_t)b * LT + (is_lat ? CTXL : 0);
    LAS unsigned char* QL = lds + 18432 + wave * 9216;
#pragma unroll
    for (int qt = 0; qt < 2; ++qt) {
        const int qi = ql0 + 32 * qt + r;
        const bf16_t* qp = p + (rowbase + qi) * EVEN_IN + 2560 + hq * 64 + 8 * h;
#pragma unroll
        for (int ks = 0; ks < 4; ++ks) {
            u32x4 v = *(const u32x4*)(qp + 16 * ks);
            if (is_lat) rope8(v, cos_t + qi * 32 + 8 * ks + 4 * h, sin_t + qi * 32 + 8 * ks + 4 * h);
            *(LAS u32x4*)(QL + (32 * qt + r) * 144 + (16 * ks + 8 * h) * 2) = v;
        }
    }
    const float sink2 = P.ev_sink[j * 16 + hq] * LOG2E;
    float mrun[2] = {sink2, sink2}, lrun[2] = {h == 0 ? 1.f : 0.f, h == 0 ? 1.f : 0.f};
    f32x16 O[2][2];
#pragma unroll
    for (int a = 0; a < 2; ++a)
#pragma unroll
        for (int c = 0; c < 2; ++c)
#pragma unroll
            for (int i = 0; i < 16; ++i) O[a][c][i] = 0.f;
    const int ntiles = is_lat ? 10 : 4;
    const float SC = 0.125f * LOG2E, NEG = -1e30f;
#pragma unroll 1
    for (int ti = 0; ti < ntiles; ++ti) {
        const bool win = ti >= 4;
        const int k0 = win ? qb * 128 - 128 + 64 * (ti - 4) : 64 * ti;
        if (win && (k0 < 0 || k0 >= SEQ)) continue;
        __syncthreads();
        {
            const int key = tid >> 3, chn = tid & 7;
            const bf16_t* kp = p + ((size_t)b * LT + (win ? CTXL : 0) + k0 + key) * EVEN_IN + 1024 + kvh * 64 + 8 * chn;
            u32x4 kv = *(const u32x4*)kp;
            if (win) rope8(kv, cos_t + (k0 + key) * 32 + 4 * chn, sin_t + (k0 + key) * 32 + 4 * chn);
            *(LAS u32x4*)(KL + key * 144 + chn * 16) = kv;
            const u32x4 vv = *(const u32x4*)(kp + 256);
            const unsigned* vw = (const unsigned*)&vv;
#pragma unroll
            for (int e = 0; e < 4; ++e) {
                *(LAS unsigned short*)(VT + (8 * chn + 2 * e) * 144 + key * 2) = (unsigned short)(vw[e] & 0xffffu);
                *(LAS unsigned short*)(VT + (8 * chn + 2 * e + 1) * 144 + key * 2) = (unsigned short)(vw[e] >> 16);
            }
        }
        __syncthreads();
#pragma unroll
        for (int qt = 0; qt < 2; ++qt) {
            f32x16 s0, s1;
#pragma unroll
            for (int i = 0; i < 16; ++i) { s0[i] = 0.f; s1[i] = 0.f; }
#pragma unroll
            for (int ks = 0; ks < 4; ++ks) {
                const bf16x8 qfr = *(const LAS bf16x8*)(QL + (32 * qt + r) * 144 + (16 * ks + 8 * h) * 2);
                const bf16x8 k0f = *(const LAS bf16x8*)(KL + r * 144 + (16 * ks + 8 * h) * 2), k1f = *(const LAS bf16x8*)(KL + (32 + r) * 144 + (16 * ks + 8 * h) * 2);
                s0 = MFMA32(k0f, qfr, s0); s1 = MFMA32(k1f, qfr, s1);
            }
            const int qpos = ql0 + 32 * qt + r;
            float mx = NEG;
#pragma unroll
            for (int i = 0; i < 16; ++i) {
                const int kp0 = k0 + crow(i, h), kp1 = kp0 + 32;
                float v0 = s0[i] * SC, v1 = s1[i] * SC;
                if (win) { const int d0 = qpos - kp0, d1 = qpos - kp1; if (d0 > 128 || d0 < -128) v0 = NEG; if (d1 > 128 || d1 < -128) v1 = NEG; }
                s0[i] = v0; s1[i] = v1; mx = fmaxf(mx, fmaxf(v0, v1));
            }
            mx = fmaxf(mx, shfl_xor_f(mx, 32));
            const float mn = fmaxf(mrun[qt], mx), alpha = __builtin_amdgcn_exp2f(mrun[qt] - mn);
            mrun[qt] = mn;
            float ls = 0.f;
#pragma unroll
            for (int i = 0; i < 16; ++i) { s0[i] = __builtin_amdgcn_exp2f(s0[i] - mn); s1[i] = __builtin_amdgcn_exp2f(s1[i] - mn); ls += s0[i] + s1[i]; }
            lrun[qt] = lrun[qt] * alpha + ls;
#pragma unroll
            for (int dt = 0; dt < 2; ++dt)
#pragma unroll
                for (int i = 0; i < 16; ++i) O[dt][qt][i] *= alpha;
            bf16x8 pf[2][2];
#pragma unroll
            for (int s = 0; s < 2; ++s) {
                u32x4 a, c;
                a.x = pk2(s0[8 * s + 0], s0[8 * s + 1]); a.y = pk2(s0[8 * s + 2], s0[8 * s + 3]); a.z = pk2(s0[8 * s + 4], s0[8 * s + 5]); a.w = pk2(s0[8 * s + 6], s0[8 * s + 7]);
                c.x = pk2(s1[8 * s + 0], s1[8 * s + 1]); c.y = pk2(s1[8 * s + 2], s1[8 * s + 3]); c.z = pk2(s1[8 * s + 4], s1[8 * s + 5]); c.w = pk2(s1[8 * s + 6], s1[8 * s + 7]);
                pf[0][s] = __builtin_bit_cast(bf16x8, a); pf[1][s] = __builtin_bit_cast(bf16x8, c);
            }
#pragma unroll
            for (int dt = 0; dt < 2; ++dt)
#pragma unroll
                for (int kt = 0; kt < 2; ++kt)
#pragma unroll
                    for (int s = 0; s < 2; ++s) {
                        const LAS unsigned char* vp = VT + (32 * dt + r) * 144 + (32 * kt + 16 * s + 4 * h) * 2;
                        const u32x2 lo = *(const LAS u32x2*)vp, hi = *(const LAS u32x2*)(vp + 16);
                        const u32x4 vv = {lo.x, lo.y, hi.x, hi.y};
                        O[dt][qt] = MFMA32(__builtin_bit_cast(bf16x8, vv), pf[kt][s], O[dt][qt]);
                    }
            __builtin_amdgcn_sched_barrier(0);
        }
    }
#pragma unroll
    for (int qt = 0; qt < 2; ++qt) {
        const float lt = lrun[qt] + shfl_xor_f(lrun[qt], 32), inv = __builtin_amdgcn_rcpf(lt);
        const int qi = ql0 + 32 * qt + r;
        bf16_t* rowp = p + (rowbase + qi) * EVEN_IN;
#pragma unroll
        for (int dt = 0; dt < 2; ++dt)
#pragma unroll
            for (int i4 = 0; i4 < 4; ++i4) {
                const int d0 = 32 * dt + 8 * i4 + 4 * h;
                const u32x2 gv = *(const u32x2*)(rowp + 3584 + hq * 64 + d0);
                const float g0 = __uint_as_float(gv.x << 16), g1 = __uint_as_float(gv.x & 0xffff0000u), g2 = __uint_as_float(gv.y << 16), g3 = __uint_as_float(gv.y & 0xffff0000u);
                u32x2 o;
                o.x = pk2(O[dt][qt][4 * i4 + 0] * inv * g0 * sigm(g0), O[dt][qt][4 * i4 + 1] * inv * g1 * sigm(g1));
                o.y = pk2(O[dt][qt][4 * i4 + 2] * inv * g2 * sigm(g2), O[dt][qt][4 * i4 + 3] * inv * g3 * sigm(g3));
                *(u32x2*)(rowp + 2560 + hq * 64 + d0) = o;
            }
    }
    __syncthreads();
}

constexpr int G2_QX = 0, G2_KF = 17408, G2_K2 = 60928, G2_VS = 79360, G2_AM = 96768, G2_ST = 105984, G2_PS = 140800, G2_BL = 144896, G2_Q1 = 145408, G2_END = 162816;
static_assert(G2_END <= LDS_BYTES - 256, "GLA LDS map");
typedef short v4i16_t __attribute__((ext_vector_type(4)));
DI bf16x8 frag_tr(const LAS bf16_t* M, int stride, int k0, int n0, int lane) {
    const int i = lane & 15, g = lane >> 4, q = i >> 2, pp = i & 3;
    const LAS bf16_t* a0 = M + (k0 + 8 * g + q) * stride + n0 + 4 * pp;
    const v4i16_t lo = __builtin_amdgcn_ds_read_tr16_b64_v4i16((LAS v4i16_t*)a0);
    const v4i16_t hi = __builtin_amdgcn_ds_read_tr16_b64_v4i16((LAS v4i16_t*)(a0 + 4 * stride));
    return (bf16x8){lo[0], lo[1], lo[2], lo[3], hi[0], hi[1], hi[2], hi[3]};
}

template <int DIR>
DI void gla2_item(const Params& P, LAS unsigned char* lds, int layer_j, int b, int hd, int wv) {
    const int tid = get_tid(wv), lane = tid & 63, wave = tid >> 6, r = lane & 15, g = lane >> 4;
    bf16_t* p = (bf16_t*)(P.ws + WS_P);
    LAS bf16_t* QX = (LAS bf16_t*)(lds + G2_QX); LAS bf16_t* KF = (LAS bf16_t*)(lds + G2_KF); LAS bf16_t* K2 = (LAS bf16_t*)(lds + G2_K2);
    LAS bf16_t* VS = (LAS bf16_t*)(lds + G2_VS); LAS bf16_t* AM = (LAS bf16_t*)(lds + G2_AM); LAS bf16_t* ST = (LAS bf16_t*)(lds + G2_ST);
    LAS float* PS8 = (LAS float*)(lds + G2_PS); LAS float* BLAST = (LAS float*)(lds + G2_BL); LAS bf16_t* Q1 = (LAS bf16_t*)(lds + G2_Q1);
    const int d0 = 2 * lane, tg = wave, I = tg >> 1, half = tg & 1;
    float lbv[2] = {0.f, 0.f};
    if (layer_j > 0) { lbv[0] = sigm(P.od_lb_raw[1024 + hd * 128 + d0] - P.od_lb_raw[hd * 128 + d0]); lbv[1] = sigm(P.od_lb_raw[1024 + hd * 128 + d0 + 1] - P.od_lb_raw[hd * 128 + d0 + 1]); }
    for (int i = tid; i < (9216 + 34816) / 4; i += 512) ((LAS unsigned*)(lds + G2_AM))[i] = 0u;
    f32x4 st[8];
#pragma unroll
    for (int e = 0; e < 8; ++e) st[e] = (f32x4){0.f, 0.f, 0.f, 0.f};
    unsigned zn[8], qn[8]; u32x4 vn[2];
#define G2_OFFZ(s) ((unsigned)((DIR == 0 ? 8 * tg + (s) : 63 - 8 * tg - (s)) * ODD_IN + d0) * 2u)
#define G2_OFFV(rep) ((unsigned)((DIR == 0 ? ((tid + (rep) * 512) >> 4) : 63 - ((tid + (rep) * 512) >> 4)) * ODD_IN + 8 * ((tid + (rep) * 512) & 15)) * 2u)
    const size_t colz = (size_t)DIR * 1024 + hd * 128, colq = 3072 + hd * 128, colv = 2048 + hd * 128;
    {
        const int chunk = DIR == 0 ? 0 : 3;
        const char* slab = (const char*)(p + ((size_t)b * LT + (size_t)chunk * 64) * ODD_IN);
#pragma unroll
        for (int s = 0; s < 8; ++s) { zn[s] = *(const unsigned*)(slab + colz * 2 + G2_OFFZ(s)); qn[s] = *(const unsigned*)(slab + colq * 2 + G2_OFFZ(s)); }
#pragma unroll
        for (int rep = 0; rep < 2; ++rep) vn[rep] = *(const u32x4*)(slab + colv * 2 + G2_OFFV(rep));
    }
    __syncthreads();
#pragma unroll 1
    for (int step = 0; step < NCHUNK; ++step) {
        const int chunk = DIR == 0 ? step : (step < 4 ? 3 - step : 39 - step);
        const size_t Rc0 = (size_t)b * LT + (size_t)chunk * 64;
        unsigned zc[8], qc[8]; u32x4 vc[2];
#pragma unroll
        for (int s = 0; s < 8; ++s) { zc[s] = zn[s]; qc[s] = qn[s]; }
        vc[0] = vn[0]; vc[1] = vn[1];
        float el[8][2], kk[8][2], qq[8][2];
        {
            float run0 = 1.f, run1 = 1.f;
#pragma unroll
            for (int s = 0; s < 8; ++s) {
                const float z0 = __uint_as_float(zc[s] << 16), z1 = __uint_as_float(zc[s] & 0xffff0000u);
                const float t0 = __expf(-z0), t1 = __expf(-z1), sg0 = __builtin_amdgcn_rcpf(1.f + t0), sg1 = __builtin_amdgcn_rcpf(1.f + t1);
                const float f0 = fmaxf(lbv[0] + (1.f - lbv[0]) * sg0, 1e-30f), f1 = fmaxf(lbv[1] + (1.f - lbv[1]) * sg1, 1e-30f);
                kk[s][0] = (1.f - lbv[0]) * (t0 * sg0); kk[s][1] = (1.f - lbv[1]) * (t1 * sg1);
                run0 = fmaxf(run0 * f0, 1e-35f); run1 = fmaxf(run1 * f1, 1e-35f); el[s][0] = run0; el[s][1] = run1;
                const float q0 = __uint_as_float(qc[s] << 16), q1 = __uint_as_float(qc[s] & 0xffff0000u);
                qq[s][0] = q0 * __builtin_amdgcn_rcpf(1.f + __expf(-q0)); qq[s][1] = q1 * __builtin_amdgcn_rcpf(1.f + __expf(-q1));
                if ((s & 1) == 1) __builtin_amdgcn_sched_barrier(0);
            }
            *(LAS f32x2*)(PS8 + tg * 128 + d0) = (f32x2){run0, run1};
#pragma unroll
            for (int rep = 0; rep < 2; ++rep) { const int idx = tid + rep * 512, tau = idx >> 4, chn = idx & 15; *(LAS u32x4*)(VS + tau * 136 + 8 * chn) = vc[rep]; }
        }
        __syncthreads();
        float RI[2];
        {
            float T[8][2];
#pragma unroll
            for (int q8 = 0; q8 < 8; ++q8) { const f32x2 t = *(const LAS f32x2*)(PS8 + q8 * 128 + d0); T[q8][0] = t[0]; T[q8][1] = t[1]; }
            float pre[2], fac[4][2], f4[2];
#pragma unroll
            for (int x = 0; x < 2; ++x) {
                const float P0 = T[0][x] * T[1][x], P1 = T[2][x] * T[3][x], P2 = T[4][x] * T[5][x], P3 = T[6][x] * T[7][x];
                pre[x] = half ? (I == 0 ? T[0][x] : (I == 1 ? T[2][x] : (I == 2 ? T[4][x] : T[6][x]))) : 1.f;
                RI[x] = I == 0 ? 1.f : (I == 1 ? P0 : (I == 2 ? P0 * P1 : P0 * P1 * P2));
                float cur = 1.f;
                fac[0][x] = cur; if (I <= 0) cur *= P0;
                fac[1][x] = cur; if (I <= 1) cur *= P1;
                fac[2][x] = cur; if (I <= 2) cur *= P2;
                fac[3][x] = cur; cur *= P3;
                f4[x] = cur;
                if (tg == 0) BLAST[d0 + x] = P0 * P1 * P2 * P3;
            }
            unsigned w0[4], w1[4];
#pragma unroll
            for (int s = 0; s < 8; ++s) {
                const int tau = 8 * tg + s;
                const float e00 = fmaxf(pre[0] * el[s][0], 1e-35f), e01 = fmaxf(pre[1] * el[s][1], 1e-35f);
                const float qi0 = qq[s][0] * e00, qi1 = qq[s][1] * e01;
                const float kd0 = kk[s][0] * __builtin_amdgcn_rcpf(e00), kd1 = kk[s][1] * __builtin_amdgcn_rcpf(e01);
                *(LAS unsigned*)(QX + tau * 136 + d0) = pk2(qi0, qi1);
                *(LAS unsigned*)(Q1 + tau * 136 + d0) = pk2(qi0 * RI[0], qi1 * RI[1]);
                if (I <= 0) *(LAS unsigned*)(KF + (0 + tau) * 136 + d0) = pk2(kd0 * fac[0][0], kd1 * fac[0][1]);
                if (I <= 1) *(LAS unsigned*)(KF + (16 + tau) * 136 + d0) = pk2(kd0 * fac[1][0], kd1 * fac[1][1]);
                if (I <= 2) *(LAS unsigned*)(KF + (48 + tau) * 136 + d0) = pk2(kd0 * fac[2][0], kd1 * fac[2][1]);
                *(LAS unsigned*)(KF + (96 + tau) * 136 + d0) = pk2(kd0 * fac[3][0], kd1 * fac[3][1]);
                const unsigned h0 = f2bf(kd0 * f4[0]), h1 = f2bf(kd1 * f4[1]);
                if (s & 1) { w0[s >> 1] |= h0 << 16; w1[s >> 1] |= h1 << 16; } else { w0[s >> 1] = h0; w1[s >> 1] = h1; }
                if ((s & 1) == 1) __builtin_amdgcn_sched_barrier(0);
            }
            *(LAS u32x4*)(K2 + (d0 + 0) * 72 + 8 * tg) = (u32x4){w0[0], w0[1], w0[2], w0[3]};
            *(LAS u32x4*)(K2 + (d0 + 1) * 72 + 8 * tg) = (u32x4){w1[0], w1[1], w1[2], w1[3]};
        }
        __syncthreads();
        if (step + 1 < NCHUNK) {
            const int nchunk = DIR == 0 ? step + 1 : (step + 1 < 4 ? 2 - step : 38 - step);
            const char* slab = (const char*)(p + ((size_t)b * LT + (size_t)nchunk * 64) * ODD_IN);
#pragma unroll
            for (int s = 0; s < 8; ++s) { zn[s] = *(const unsigned*)(slab + colz * 2 + G2_OFFZ(s)); qn[s] = *(const unsigned*)(slab + colq * 2 + G2_OFFZ(s)); }
#pragma unroll
            for (int rep = 0; rep < 2; ++rep) vn[rep] = *(const u32x4*)(slab + colv * 2 + G2_OFFV(rep));
        }
#pragma unroll 1
        for (int bi = wave; bi < 10; bi += 8) {
            const int Ib = bi < 1 ? 0 : (bi < 3 ? 1 : (bi < 6 ? 2 : 3)), Jb = bi - (Ib * (Ib + 1)) / 2;
            const int foff = Ib == 0 ? 0 : (Ib == 1 ? 16 : (Ib == 2 ? 48 : 96));
            f32x4 acc = {0.f, 0.f, 0.f, 0.f};
#pragma unroll
            for (int ks = 0; ks < 4; ++ks) {
                const bf16x8 a = *(const LAS bf16x8*)(QX + (16 * Ib + r) * 136 + 32 * ks + 8 * g);
                const bf16x8 bb = *(const LAS bf16x8*)(KF + (foff + 16 * Jb + r) * 136 + 32 * ks + 8 * g);
                acc = MFMA16(a, bb, acc);
            }
#pragma unroll
            for (int i = 0; i < 4; ++i) { float v = acc[i]; if (Jb == Ib && r > 4 * g + i) v = 0.f; AM[(16 * Ib + 4 * g + i) * 72 + 16 * Jb + r] = (bf16_t)f2bf(v); }
        }
        __syncthreads();
        {
            const int tt = wave >> 1, eb = 4 * (wave & 1);
            char* oslab = (char*)(p + Rc0 * ODD_IN + colz);
            bf16x8 aq[4], am[2];
#pragma unroll
            for (int ks = 0; ks < 4; ++ks) aq[ks] = *(const LAS bf16x8*)(Q1 + (16 * tt + r) * 136 + 32 * ks + 8 * g);
#pragma unroll
            for (int ks = 0; ks < 2; ++ks) am[ks] = *(const LAS bf16x8*)(AM + (16 * tt + r) * 72 + 32 * ks + 8 * g);
#pragma unroll
            for (int e4 = 0; e4 < 4; ++e4) {
                const int et = eb + e4;
                f32x4 acc = {0.f, 0.f, 0.f, 0.f};
#pragma unroll
                for (int ks = 0; ks < 4; ++ks) { const bf16x8 bb = *(const LAS bf16x8*)(ST + (16 * et + r) * 136 + 32 * ks + 8 * g); acc = MFMA16(aq[ks], bb, acc); }
#pragma unroll
                for (int ks = 0; ks < 2; ++ks) acc = MFMA16(am[ks], frag_tr(VS, 136, 32 * ks, 16 * et, lane), acc);
#pragma unroll
                for (int i = 0; i < 4; ++i) {
                    const int tau = 16 * tt + 4 * g + i;
                    const unsigned off = (unsigned)((DIR == 0 ? tau : 63 - tau) * ODD_IN + 16 * et + r) * 2u;
                    *(bf16_t*)(oslab + off) = (bf16_t)f2bf(acc[i]);
                }
                __builtin_amdgcn_sched_barrier(0);
            }
            float bl[4];
#pragma unroll
            for (int i = 0; i < 4; ++i) bl[i] = BLAST[16 * wave + 4 * g + i];
            bf16x8 ak[2];
#pragma unroll
            for (int ks = 0; ks < 2; ++ks) ak[ks] = *(const LAS bf16x8*)(K2 + (16 * wave + r) * 72 + 32 * ks + 8 * g);
#pragma unroll
            for (int et = 0; et < 8; ++et) {
#pragma unroll
                for (int i = 0; i < 4; ++i) st[et][i] *= bl[i];
#pragma unroll
                for (int ks = 0; ks < 2; ++ks) st[et] = MFMA16(ak[ks], frag_tr(VS, 136, 32 * ks, 16 * et, lane), st[et]);
                if (et & 1) __builtin_amdgcn_sched_barrier(0);
            }
        }
        __syncthreads();
#pragma unroll
        for (int et = 0; et < 8; ++et) { u32x2 w; w.x = pk2(st[et][0], st[et][1]); w.y = pk2(st[et][2], st[et][3]); *(LAS u32x2*)(ST + (16 * et + r) * 136 + 16 * wave + 4 * g) = w; }
    }
    __syncthreads();
}

DI void phase_readout(const Params& P, int layer_j, int wv) {
    const int tid = get_tid(wv), lane = tid & 63, wave = tid >> 6;
    const int gw = get_bid() * 8 + wave, NGW = gridDim.x * 8;
    bf16_t* p = (bf16_t*)(P.ws + WS_P);
    const float* gwt = P.od_gnorm_w + layer_j * 128 + (lane & 7) * 16;
    for (int R = gw; R < MROWS; R += NGW) {
        const bf16_t* op = p + (size_t)R * ODD_IN + 16 * lane; bf16_t* yp = p + (size_t)R * ODD_IN + 4096 + 16 * lane;
        const u32x4 o0 = *(const u32x4*)op, o1 = *(const u32x4*)(op + 8), c0 = *(const u32x4*)(op + 1024), c1 = *(const u32x4*)(op + 1032), g0 = *(const u32x4*)yp, g1 = *(const u32x4*)(yp + 8);
        float ov[16], gv[16];
        const unsigned* ow0 = (const unsigned*)&o0; const unsigned* ow1 = (const unsigned*)&o1; const unsigned* cw0 = (const unsigned*)&c0; const unsigned* cw1 = (const unsigned*)&c1;
        const unsigned* gw0 = (const unsigned*)&g0; const unsigned* gw1 = (const unsigned*)&g1;
#pragma unroll
        for (int i = 0; i < 4; ++i) {
            ov[2 * i] = __uint_as_float(ow0[i] << 16) + __uint_as_float(cw0[i] << 16); ov[2 * i + 1] = __uint_as_float(ow0[i] & 0xffff0000u) + __uint_as_float(cw0[i] & 0xffff0000u);
            ov[8 + 2 * i] = __uint_as_float(ow1[i] << 16) + __uint_as_float(cw1[i] << 16); ov[8 + 2 * i + 1] = __uint_as_float(ow1[i] & 0xffff0000u) + __uint_as_float(cw1[i] & 0xffff0000u);
            gv[2 * i] = __uint_as_float(gw0[i] << 16); gv[2 * i + 1] = __uint_as_float(gw0[i] & 0xffff0000u); gv[8 + 2 * i] = __uint_as_float(gw1[i] << 16); gv[8 + 2 * i + 1] = __uint_as_float(gw1[i] & 0xffff0000u);
        }
        float ss = 0.f;
#pragma unroll
        for (int i = 0; i < 16; ++i) ss += ov[i] * ov[i];
        ss += shfl_xor_f(ss, 1); ss += shfl_xor_f(ss, 2); ss += shfl_xor_f(ss, 4);
        const float rstd = rsqrtf(ss * (1.f / 128.f) + RMS_EPS);
        float y[16];
#pragma unroll
        for (int i = 0; i < 16; ++i) y[i] = ov[i] * rstd * gwt[i] * (gv[i] * sigm(gv[i]));
        u32x4 w0, w1;
        w0.x = pk2(y[0], y[1]); w0.y = pk2(y[2], y[3]); w0.z = pk2(y[4], y[5]); w0.w = pk2(y[6], y[7]);
        w1.x = pk2(y[8], y[9]); w1.y = pk2(y[10], y[11]); w1.z = pk2(y[12], y[13]); w1.w = pk2(y[14], y[15]);
        *(u32x4*)yp = w0; *(u32x4*)(yp + 8) = w1;
    }
}

DI void phase_final(const Params& P, int wv) {
    const int tid = get_tid(wv), lane = tid & 63, wave = tid >> 6;
    const int gw = get_bid() * 8 + wave, NGW = gridDim.x * 8;
    for (int R = gw; R < NB * SEQ; R += NGW) {
        float* row = P.out + (size_t)R * DM;
        f32x4 v[4]; float ss = 0.f;
#pragma unroll
        for (int q = 0; q < 4; ++q) { v[q] = *(const f32x4*)(row + 4 * lane + 256 * q); ss += (v[q][0] * v[q][0] + v[q][1] * v[q][1]) + (v[q][2] * v[q][2] + v[q][3] * v[q][3]); }
        const float rstd = rsqrtf(wave_sum(ss) * (1.f / DM) + RMS_EPS);
#pragma unroll
        for (int q = 0; q < 4; ++q) { const f32x4 w4 = *(const f32x4*)(P.final_norm_w + 4 * lane + 256 * q); *(f32x4*)(row + 4 * lane + 256 * q) = (v[q] * rstd) * w4; }
    }
}

#define XB_TMO      128
#define XB_XCNT(j)  (256  + 64 * (j))
#define XB_XSUB(j)  (1280 + 64 * (j))
#define XB_XGEN(j)  (2304 + 64 * (j))
#define XB_TOP      3328
#define XB_TOPGEN   3392
#define XCD_BAR_WORDS 3456
#define XB_SPIN_CAP (1u << 18)

__device__ __forceinline__ unsigned xb_ld(unsigned* p)              { return __hip_atomic_load(p, __ATOMIC_RELAXED, __HIP_MEMORY_SCOPE_AGENT); }
__device__ __forceinline__ unsigned xb_add(unsigned* p, unsigned v) { return __hip_atomic_fetch_add(p, v, __ATOMIC_RELAXED, __HIP_MEMORY_SCOPE_AGENT); }
__device__ __forceinline__ unsigned xb_xcc_id() { return (unsigned)__builtin_amdgcn_s_getreg((3 << 11) | 20) & 0xFu; }
#define XB_SPIN(cond, bar) do { unsigned _sp = 0; while (cond) { __builtin_amdgcn_s_sleep(1); \
    if ((++_sp & 255u) == 0u) { if (xb_ld(&(bar)[XB_TMO])) break; if (_sp > XB_SPIN_CAP) { atomicAdd(&(bar)[XB_TMO], 1u); break; } } } } while (0)

struct XcdBarrier {
    unsigned* bar; unsigned x;
    volatile LAS unsigned* st;
};

__device__ __forceinline__ XcdBarrier xcd_barrier_post(unsigned* bar, volatile LAS unsigned* st, int wv) {
    XcdBarrier b; b.bar = bar; b.x = xb_xcc_id(); b.st = st;
    if (get_tid(wv) == 0) (void)xb_add(&bar[XB_XCNT(b.x)], 1u);
    return b;
}
__device__ __forceinline__ void xcd_barrier_complete(unsigned* bar, unsigned x, unsigned& nloc, unsigned& nx) {
    const unsigned G = gridDim.x * gridDim.y * gridDim.z;
    unsigned sum, cnt, mine, sp = 0u;
    for (;;) {
        sum = 0u; cnt = 0u; mine = 0u;
#pragma unroll
        for (unsigned j = 0; j < 16; ++j) { const unsigned c = xb_ld(&bar[XB_XCNT(j)]); sum += c; cnt += (c > 0u) ? 1u : 0u; mine = (j == x) ? c : mine; }
        if (sum == G) break;
        __builtin_amdgcn_s_sleep(1);
        if ((++sp & 255u) == 0u) { if (xb_ld(&bar[XB_TMO])) break; if (sp > XB_SPIN_CAP) { atomicAdd(&bar[XB_TMO], 1u); break; } }
    }
    nloc = mine > 0u ? mine : 1u; nx = cnt > 0u ? cnt : 1u;
}

__device__ __forceinline__ void xcd_barrier(const XcdBarrier& b, int wv) {
    asm volatile("s_waitcnt vmcnt(0)" ::: "memory");
    __syncthreads();
    if (get_tid(wv) == 0) {
        unsigned* bar = b.bar;
        __builtin_amdgcn_s_waitcnt(0);
        unsigned nloc = b.st[0], nx = b.st[1];
        if (nloc == 0u) { xcd_barrier_complete(bar, b.x, nloc, nx); b.st[0] = nloc; b.st[1] = nx; }
        const unsigned old = xb_add(&bar[XB_XSUB(b.x)], 1u);
        const unsigned gen = old / nloc;
        if (old + 1u == (gen + 1u) * nloc) {
            __builtin_amdgcn_fence(__ATOMIC_RELEASE, "agent");
            asm volatile("s_waitcnt vmcnt(0)" ::: "memory");
            const unsigned og = xb_add(&bar[XB_TOP], 1u);
            const unsigned tg = og / nx;
            if (og + 1u == (tg + 1u) * nx) xb_add(&bar[XB_TOPGEN], 1u);
            else XB_SPIN(xb_ld(&bar[XB_TOPGEN]) == tg, bar);
            __builtin_amdgcn_fence(__ATOMIC_ACQUIRE, "agent");
            xb_add(&bar[XB_XGEN(b.x)], 1u);
            asm volatile("s_waitcnt vmcnt(0)" ::: "memory");
        } else {
            XB_SPIN(xb_ld(&bar[XB_XGEN(b.x)]) == gen, bar);
            __builtin_amdgcn_fence(__ATOMIC_ACQUIRE, "agent");
            asm volatile("s_waitcnt vmcnt(0)" ::: "memory");
        }
    }
    __syncthreads();
}

constexpr int PARAM_OFF = LDS_BYTES - 256;
static_assert(G2_END <= PARAM_OFF && sizeof(Params) <= 208, "LDS map");
DI const float* ld_uptr(const LAS unsigned long long* s, int i) {
    const unsigned long long v = s[i];
    const unsigned lo = __builtin_amdgcn_readfirstlane((unsigned)v), hi = __builtin_amdgcn_readfirstlane((unsigned)(v >> 32));
    return (const float*)(const __attribute__((address_space(1))) float*)(((unsigned long long)hi << 32) | lo);
}
DI Params load_params(LAS unsigned char* lds) {
    LAS unsigned char* pb = lds + PARAM_OFF; asm volatile("" : "+v"(pb));
    const LAS unsigned long long* s = (const LAS unsigned long long*)pb;
    Params Q;
    Q.x = ld_uptr(s, 0); Q.c = ld_uptr(s, 1); Q.ctx = ld_uptr(s, 2); Q.c_ctx = ld_uptr(s, 3); Q.ada_w = ld_uptr(s, 4); Q.ada_b = ld_uptr(s, 5); Q.norm_w = ld_uptr(s, 6);
    Q.ev_w_in = ld_uptr(s, 7); Q.ev_conv_w = ld_uptr(s, 8); Q.ev_conv_b = ld_uptr(s, 9); Q.ev_rg_wx = ld_uptr(s, 10); Q.ev_rg_bx = ld_uptr(s, 11); Q.ev_rg_wa = ld_uptr(s, 12);
    Q.ev_rg_ba = ld_uptr(s, 13); Q.ev_rg_lambda = ld_uptr(s, 14); Q.ev_sink = ld_uptr(s, 15); Q.ev_w_out = ld_uptr(s, 16); Q.od_w_in = ld_uptr(s, 17); Q.od_lb_raw = ld_uptr(s, 18);
    Q.od_gnorm_w = ld_uptr(s, 19); Q.od_w_out = ld_uptr(s, 20); Q.final_norm_w = ld_uptr(s, 21); Q.out = (float*)ld_uptr(s, 22); Q.ws = (unsigned char*)ld_uptr(s, 23);
    Q.ph_lo = 0; Q.ph_hi = 0;
    return Q;
}
DI void run_phase(LAS unsigned char* lds, int ph, int wv) {
    #ifndef PHMASK
#define PHMASK 0xffff
#endif
    if (ph == 0) { if (PHMASK & 1) { const Params P = load_params(lds); phase_pro(P, lds, wv); } return; }
    if (ph == NPHASE - 1) { if (PHMASK & 2) { const Params P = load_params(lds); phase_final(P, wv); } return; }
    const int layer = (ph - 1) / 5, sub = (ph - 1) % 5, j = layer >> 1;
    const bool even = (layer & 1) == 0;
    if (sub == 0) { if (PHMASK & 4) { const Params P = load_params(lds); phase_norm(P, lds, layer, wv); } return; }
    if (sub == 1) {
        const Params P = load_params(lds); bf16_t* pbuf = (bf16_t*)(P.ws + WS_P);
        const int N = even ? EVEN_IN : ODD_IN;
        pg8::Gemm gm{(const bf16_t*)(P.ws + WS_OV), (const bf16_t*)(P.ws + WS_WIN), MROWS, N, 1024, 1024};
        pg8::StaticOrder S; S.init(MROWS, N, (int)gridDim.x, get_bid());
        EpiStoreBf16 E{pbuf, N};
        if (PHMASK & 8) pg8::gemm_phase<EpiStoreBf16, pg8::StaticOrder, true, true>(lds, gm, S, E, wv);
        return;
    }
    if (sub == 2) {
        const Params P = load_params(lds);
        if (even) {
            for (int it = get_bid(); it < 576 + NB * NCHUNK * 8; it += gridDim.x) {
                if (it < 576) { if (PHMASK & 16) attn_item(P, lds, j, it, wv); } else { if (PHMASK & 32) rglru_item<false>(P, lds, j, it - 576, wv); }
            }
        } else {
            for (int it = get_bid(); it < 128; it += gridDim.x) { if (PHMASK & 64) { if (it & 1) gla2_item<1>(P, lds, j, it >> 4, (it >> 1) & 7, wv); else gla2_item<0>(P, lds, j, it >> 4, (it >> 1) & 7, wv); } }
        }
        return;
    }
    if (sub == 3) {
        const Params P = load_params(lds);
        if (even) { for (int it = get_bid(); it < NB * NCHUNK * 8; it += gridDim.x) { if (PHMASK & 128) rglru_item<true>(P, lds, j, it, wv); } }
        else { if (PHMASK & 256) phase_readout(P, j, wv); }
        return;
    }
    {
        const Params P = load_params(lds); bf16_t* pbuf = (bf16_t*)(P.ws + WS_P);
        const int K = even ? 2048 : 1024, lda = even ? EVEN_IN : ODD_IN;
        pg8::Gemm gm{pbuf + (even ? 1536 : 4096), (const bf16_t*)(P.ws + WS_WOUT), MROWS, 1024, K, lda};
        pg8::StaticOrder S; S.init(MROWS, 1024, (int)gridDim.x, get_bid());
        const float* hl = layer == 0 ? P.x : P.out; const float* hc = layer == 0 ? P.ctx : (const float*)(P.ws + WS_HCTX);
        EpiResid E{hl, hc, P.out, (float*)(P.ws + WS_HCTX), (const float*)(P.ws + WS_MOD) + (size_t)layer * 9 * 3072 + 2048};
        if (PHMASK & 512) pg8::gemm_phase<EpiResid, pg8::StaticOrder, true, true>(lds, gm, S, E, wv);
    }
}

__global__ void __launch_bounds__(512, 2) mega(Params P) {
    extern __shared__ __attribute__((aligned(16))) unsigned char lds_raw[];
    LAS unsigned char* lds = (LAS unsigned char*)lds_raw;
    cg::grid_group grid = cg::this_grid();
    const int wv = __builtin_amdgcn_readfirstlane((int)(threadIdx.x >> 6));
    if (get_tid(wv) == 0) {
        ((LAS unsigned*)(lds + PARAM_OFF + 208))[0] = 0u; ((LAS unsigned*)(lds + PARAM_OFF + 208))[1] = 0u;
        LAS unsigned long long* d = (LAS unsigned long long*)(lds + PARAM_OFF);
        d[0] = (unsigned long long)P.x; d[1] = (unsigned long long)P.c; d[2] = (unsigned long long)P.ctx; d[3] = (unsigned long long)P.c_ctx; d[4] = (unsigned long long)P.ada_w;
        d[5] = (unsigned long long)P.ada_b; d[6] = (unsigned long long)P.norm_w; d[7] = (unsigned long long)P.ev_w_in; d[8] = (unsigned long long)P.ev_conv_w; d[9] = (unsigned long long)P.ev_conv_b;
        d[10] = (unsigned long long)P.ev_rg_wx; d[11] = (unsigned long long)P.ev_rg_bx; d[12] = (unsigned long long)P.ev_rg_wa; d[13] = (unsigned long long)P.ev_rg_ba; d[14] = (unsigned long long)P.ev_rg_lambda;
        d[15] = (unsigned long long)P.ev_sink; d[16] = (unsigned long long)P.ev_w_out; d[17] = (unsigned long long)P.od_w_in; d[18] = (unsigned long long)P.od_lb_raw; d[19] = (unsigned long long)P.od_gnorm_w;
        d[20] = (unsigned long long)P.od_w_out; d[21] = (unsigned long long)P.final_norm_w; d[22] = (unsigned long long)P.out; d[23] = (unsigned long long)P.ws;
    }
    __syncthreads();
    const int ph_lo = P.ph_lo, ph_hi = P.ph_hi;
    (void)xcd_barrier_post((unsigned*)(P.ws + WS_CTL) + 4096, (volatile LAS unsigned*)(lds + PARAM_OFF + 208), wv);
#define GRID_SYNC(first) do { if (first) grid.sync(); else { XcdBarrier xb_; xb_.bar = (unsigned*)(load_params(lds).ws + WS_CTL) + 4096; xb_.x = xb_xcc_id(); xb_.st = (volatile LAS unsigned*)(lds + PARAM_OFF + 208); xcd_barrier(xb_, wv); } } while (0)
#if defined(PROBE_S)
    constexpr int PREP = PROBE_E - PROBE_S + 1;
#pragma unroll 1
    for (int seq = ph_lo; seq < ph_hi + PREP; ++seq) {
        if (seq > ph_lo) GRID_SYNC(seq == ph_lo + 1);
        const int ph = seq <= PROBE_E ? seq : seq - PREP;
        run_phase(lds, ph, wv);
    }
#else
#pragma unroll 1
    for (int ph = ph_lo; ph < ph_hi; ++ph) {
        if (ph > ph_lo) GRID_SYNC(ph == ph_lo + 1);
        run_phase(lds, ph, wv);
    }
#endif
}

extern "C" void kernel_launch(void* const* d_in, const int* in_sizes, int n_in, void* d_out, int out_size, void* d_ws, size_t ws_size, hipStream_t stream) {
    static int grid = 0;
    if (grid == 0) {
        if (n_in != 22 || ws_size < WS_END) { fprintf(stderr, "kernel_launch: unexpected inputs (n_in %d, ws %zu)\n", n_in, ws_size); grid = -1; return; }
        int dev = 0, cus = 0, per_cu = 0;
        hipGetDevice(&dev);
        hipDeviceGetAttribute(&cus, hipDeviceAttributeMultiprocessorCount, dev);
        if (hipFuncSetAttribute((const void*)mega, hipFuncAttributeMaxDynamicSharedMemorySize, LDS_BYTES) != hipSuccess) { fprintf(stderr, "kernel_launch: hipFuncSetAttribute failed\n"); grid = -1; return; }
        if (hipOccupancyMaxActiveBlocksPerMultiprocessor(&per_cu, (const void*)mega, 512, LDS_BYTES) != hipSuccess || per_cu < 1) { fprintf(stderr, "kernel_launch: occupancy query gives %d\n", per_cu); per_cu = 1; }
        (void)hipGetLastError();
        grid = cus;
    }
    if (grid < 0) return;
    if (hipMemsetAsync((char*)d_ws + WS_CTL, 0, 65536, stream) != hipSuccess) { fprintf(stderr, "kernel_launch: memset failed\n"); return; }
    Params P{};
    const float** pp = (const float**)&P;
    for (int i = 0; i < 22; ++i) pp[i] = (const float*)d_in[i];
    P.out = (float*)d_out; P.ws = (unsigned char*)d_ws;
#if ONE_LAUNCH
    P.ph_lo = 0; P.ph_hi = NPHASE;
    { void* args[] = {&P}; hipError_t e = hipLaunchCooperativeKernel((const void*)mega, dim3(grid), dim3(512), args, LDS_BYTES, stream);
      if (e != hipSuccess) fprintf(stderr, "cooperative launch failed: %s (grid %d)\n", hipGetErrorString(e), grid); }
#else
    for (int ph = 0; ph < NPHASE; ++ph) {
        P.ph_lo = ph; P.ph_hi = ph + 1;
        void* args[] = {&P}; hipError_t e = hipLaunchCooperativeKernel((const void*)mega, dim3(grid), dim3(512), args, LDS_BYTES, stream);
        if (e != hipSuccess) { fprintf(stderr, "launch %d failed: %s (grid %d)\n", ph, hipGetErrorString(e), grid); break; }
    }
#endif
}
```

```cpp
#include <hip/hip_runtime.h>
#include <hip/hip_cooperative_groups.h>
#include <cstdio>
#include <cstdint>
namespace cg = cooperative_groups;

#ifndef ONE_LAUNCH
#define ONE_LAUNCH 1
#endif

#define DI __device__ __forceinline__
#define LAS __attribute__((address_space(3)))
__device__ __forceinline__ int lane_nh() { int l; asm volatile("v_mbcnt_lo_u32_b32 %0, -1, 0\n\tv_mbcnt_hi_u32_b32 %0, -1, %0" : "=v"(l)); return l; }
__device__ __forceinline__ int get_tid(int wv) { asm volatile("" : "+s"(wv)); return wv * 64 + lane_nh(); }
__device__ __forceinline__ float shfl_xor_f(float v, int o) { return __int_as_float(__builtin_amdgcn_ds_bpermute((lane_nh() ^ o) << 2, __float_as_int(v))); }
__device__ __forceinline__ int get_bid() { int b = blockIdx.x; asm volatile("" : "+s"(b)); return b; }
namespace pg8 {
#define PG8_LAS __attribute__((address_space(3)))
typedef unsigned short bf16_t;
typedef short bf16x8 __attribute__((ext_vector_type(8)));
typedef float f32x4 __attribute__((ext_vector_type(4)));
typedef unsigned u32x4 __attribute__((ext_vector_type(4)));
constexpr int BM = 256, BK = 64, HALF = 128, HTB = HALF * BK * 2  , STAGE_BYTES = 8 * HTB, NXCD = 8, WGM = 8;

__host__ __device__ __forceinline__ int lds_byte(int r, int c) { const int st = (r >> 4) * 2 + (c >> 5), rr = r & 15, cc = c & 31, ob = rr * 64 + cc * 2; return st * 1024 + (ob ^ (((ob >> 9) & 1) << 5)); }
__host__ __device__ __forceinline__ void stage_rc(int b, int& R, int& C) { const int st = b / 1024, sb = b % 1024, swz = sb ^ (((sb >> 9) & 1) << 5); R = (st >> 1) * 16 + swz / 64; C = (st & 1) * 32 + (swz % 64) / 2; }
__host__ __device__ __forceinline__ int perm32(int rho) { const int n = rho >> 4, i = rho & 15; return 8 * (i >> 2) + 4 * n + (i & 3); }

struct Unit { int pm, pn; };
struct Gemm { const bf16_t* A; const bf16_t* Bt; int M, N, K, lda; };

struct StaticOrder {
    int nM, nN, nwg, G, c;
    __host__ __device__ void init(int M, int N, int G_, int c_) { nM = M / BM; nN = N / BM; nwg = nM * nN; G = G_; c = c_; }
    __host__ __device__ bool next(int i, Unit& u) const {
        const long L = (long)i * G + c; if (L >= nwg) return false;
        int wgid = (int)L; { const int q = nwg / NXCD, r = nwg % NXCD, xcd = wgid % NXCD, off = wgid / NXCD; wgid = (xcd < r ? xcd * (q + 1) : r * (q + 1) + (xcd - r) * q) + off; }
        const int nig = WGM * nN, gid = wgid / nig, fm = gid * WGM, gsz = (nM - fm) < WGM ? (nM - fm) : WGM;
        u.pm = fm + ((wgid % nig) % gsz); u.pn = (wgid % nig) / gsz; return true;
    }
    __device__ __forceinline__ void a_ready(const Unit&) const {}
    __device__ __forceinline__ void done(const Unit&) const {}
};

template <class Epi, class Sched, bool ALIGN_EPI = false, bool SP2 = false>
__device__ __forceinline__ void gemm_phase(PG8_LAS unsigned char* lds, const Gemm g, const Sched& S, const Epi& E, int wv) {
    const int tid = get_tid(wv), wid = __builtin_amdgcn_readfirstlane(tid >> 6), lane = tid & 63, wr = wid >> 2, wc = wid & 3, fr = lane & 15, fq = lane >> 4;
    const int K = g.K, nt = K / BK;
    unsigned voffA[2], voffB[2];
#pragma unroll
    for (int i = 0; i < 2; ++i) { int R, C; stage_rc(tid * 16 + i * 8192, R, C); const int Rb = Epi::PERM ? ((R & ~31) + perm32(R & 31)) : R;
        voffA[i] = (unsigned)(R * g.lda + C) * 2u; voffB[i] = (unsigned)(Rb * K + C) * 2u; }
    const size_t kstep = (size_t)(BK * 2);
    const size_t hstepA = (size_t)HALF * g.lda * 2, hstepB = (size_t)HALF * K * 2;
    const size_t tstepA = 2 * hstepA, tstepB = 2 * hstepB;
    const unsigned ldsw = (unsigned)wid * 1024u;
    const int aoff = lds_byte(wr * 64 + fr, fq * 8), boff = lds_byte(wc * 32 + fr, fq * 8);
#define PG8_SA(b, h) (((b) * 2 + (h)) * HTB)
#define PG8_SB(b, h) ((4 + (b) * 2 + (h)) * HTB)
#define PG8_STAGE(bufoff, gbase, voff) do { _Pragma("unroll") for (int _i = 0; _i < 2; ++_i) \
        __builtin_amdgcn_global_load_lds((const unsigned*)((const char*)(gbase) + (voff)[_i]), (PG8_LAS unsigned*)(lds + (bufoff) + ldsw + _i * 8192), 16, 0, 0); } while (0)
#define PG8_LDA(dst, b, h) do { _Pragma("unroll") for (int m = 0; m < 4; ++m) _Pragma("unroll") for (int k = 0; k < 2; ++k) dst[m][k] = *(const PG8_LAS bf16x8*)(lds + PG8_SA(b, h) + aoff + m * 2048 + k * 1024); } while (0)
#define PG8_LDB(dst, b, h) do { _Pragma("unroll") for (int n = 0; n < 2; ++n) _Pragma("unroll") for (int k = 0; k < 2; ++k) dst[n][k] = *(const PG8_LAS bf16x8*)(lds + PG8_SB(b, h) + boff + n * 2048 + k * 1024); } while (0)
#define PG8_MMA(ai, bj, At, Bt) do { __builtin_amdgcn_s_setprio(1); _Pragma("unroll") for (int m = 0; m < 4; ++m) _Pragma("unroll") for (int n = 0; n < 2; ++n) _Pragma("unroll") for (int k = 0; k < 2; ++k) \
        acc[ai][bj][m][n] = __builtin_amdgcn_mfma_f32_16x16x32_bf16(Bt[n][k], At[m][k], acc[ai][bj][m][n], 0, 0, 0); __builtin_amdgcn_s_setprio(0); } while (0)
#define PG8_WAIT_V(n) asm volatile("s_waitcnt vmcnt(" #n ")" ::: "memory")
#define PG8_WAIT_L(n) asm volatile("s_waitcnt lgkmcnt(" #n ")" ::: "memory")
#define PG8_BAR __builtin_amdgcn_s_barrier()
#define PG8_SCHED __builtin_amdgcn_sched_barrier(0)
    Unit cur, nxt; int ui = 0;
    if (!S.next(0, cur)) return;
    f32x4 acc[2][2][4][2];
#pragma unroll
    for (int a = 0; a < 2; ++a)
#pragma unroll
        for (int b = 0; b < 2; ++b)
#pragma unroll
            for (int m = 0; m < 4; ++m)
#pragma unroll
                for (int n = 0; n < 2; ++n) acc[a][b][m][n] = (f32x4){0.f, 0.f, 0.f, 0.f};
    bf16x8 At[4][2], B0[2][2], B1[2][2];
    const char* cA = (const char*)g.A + (size_t)cur.pm * tstepA; const char* cB = (const char*)g.Bt + (size_t)cur.pn * tstepB;
    S.a_ready(cur);
    if constexpr (SP2) {
        PG8_STAGE(PG8_SB(0, 0), cB, voffB); PG8_STAGE(PG8_SB(0, 1), cB + hstepB, voffB); PG8_STAGE(PG8_SA(0, 0), cA, voffA); PG8_STAGE(PG8_SA(0, 1), cA + hstepA, voffA);
        if (wr == 1) PG8_BAR;
        PG8_WAIT_V(2); PG8_BAR;
        PG8_STAGE(PG8_SB(1, 0), cB + kstep, voffB); PG8_STAGE(PG8_SA(1, 0), cA + kstep, voffA); PG8_STAGE(PG8_SB(1, 1), cB + hstepB + kstep, voffB);
        PG8_WAIT_V(6); PG8_BAR;
    } else {
        PG8_STAGE(PG8_SB(0, 0), cB, voffB); PG8_STAGE(PG8_SA(0, 0), cA, voffA); PG8_STAGE(PG8_SB(0, 1), cB + hstepB, voffB); PG8_STAGE(PG8_SA(0, 1), cA + hstepA, voffA);
        if (wr == 1) PG8_BAR;
        PG8_WAIT_V(4); PG8_BAR;
        PG8_STAGE(PG8_SB(1, 0), cB + kstep, voffB); PG8_STAGE(PG8_SA(1, 0), cA + kstep, voffA); PG8_STAGE(PG8_SB(1, 1), cB + hstepB + kstep, voffB);
        PG8_WAIT_V(6); PG8_BAR;
    }
    for (;;) {
        const bool has_next = S.next(ui + 1, nxt);
        const char* nA = has_next ? (const char*)g.A + (size_t)nxt.pm * tstepA : cA; const char* nB = has_next ? (const char*)g.Bt + (size_t)nxt.pn * tstepB : cB;
        for (int t = 0; t < nt; t += 2) {
            const bool last = (t == nt - 2);
            const char* a1 = cA + (size_t)(t + 1) * kstep;
            const char* a2 = last ? nA : cA + (size_t)(t + 2) * kstep; const char* b2 = last ? nB : cB + (size_t)(t + 2) * kstep;
            const char* a3 = a2 + kstep; const char* b3 = b2 + kstep;
            if (last && has_next) S.a_ready(nxt);
            if constexpr (SP2) {
            PG8_LDB(B0, 0, 0); PG8_LDB(B1, 0, 1); PG8_SCHED; PG8_LDA(At, 0, 0); PG8_STAGE(PG8_SA(1, 1), a1 + hstepA, voffA);
            PG8_WAIT_V(8); PG8_WAIT_L(0); PG8_BAR; PG8_MMA(0, 0, At, B0); PG8_MMA(0, 1, At, B1); PG8_BAR; PG8_SCHED;
            PG8_LDA(At, 0, 1); PG8_STAGE(PG8_SB(0, 0), b2, voffB); PG8_STAGE(PG8_SB(0, 1), b2 + hstepB, voffB); PG8_STAGE(PG8_SA(0, 0), a2, voffA);
            PG8_WAIT_V(8); PG8_WAIT_L(0); PG8_BAR; PG8_MMA(1, 0, At, B0); PG8_MMA(1, 1, At, B1); PG8_BAR; PG8_SCHED;
            PG8_LDB(B0, 1, 0); PG8_LDB(B1, 1, 1); PG8_SCHED; PG8_LDA(At, 1, 0); PG8_STAGE(PG8_SA(0, 1), a2 + hstepA, voffA);
            PG8_WAIT_V(8); PG8_WAIT_L(0); PG8_BAR; PG8_MMA(0, 0, At, B0); PG8_MMA(0, 1, At, B1); PG8_BAR; PG8_SCHED;
            PG8_LDA(At, 1, 1); PG8_STAGE(PG8_SB(1, 0), b3, voffB); PG8_STAGE(PG8_SB(1, 1), b3 + hstepB, voffB); PG8_STAGE(PG8_SA(1, 0), a3, voffA);
            PG8_WAIT_V(8); PG8_WAIT_L(0); PG8_BAR; PG8_MMA(1, 0, At, B0); PG8_MMA(1, 1, At, B1); PG8_BAR; PG8_SCHED;
            } else {
            PG8_LDB(B0, 0, 0); PG8_SCHED; PG8_LDA(At, 0, 0); PG8_STAGE(PG8_SA(1, 1), a1 + hstepA, voffA);
            PG8_WAIT_L(8); PG8_BAR; PG8_WAIT_L(0); PG8_MMA(0, 0, At, B0); PG8_BAR; PG8_SCHED;
            PG8_LDB(B1, 0, 1); PG8_STAGE(PG8_SB(0, 0), b2, voffB);
            PG8_BAR; PG8_WAIT_L(0); PG8_MMA(0, 1, At, B1); PG8_BAR;
            PG8_LDA(At, 0, 1); PG8_STAGE(PG8_SA(0, 0), a2, voffA);
            PG8_BAR; PG8_WAIT_L(0); PG8_MMA(1, 0, At, B0); PG8_BAR; PG8_SCHED;
            PG8_STAGE(PG8_SB(0, 1), b2 + hstepB, voffB);
            PG8_WAIT_V(6); PG8_BAR; PG8_MMA(1, 1, At, B1); PG8_BAR;
            PG8_LDB(B0, 1, 0); PG8_SCHED; PG8_LDA(At, 1, 0); PG8_STAGE(PG8_SA(0, 1), a2 + hstepA, voffA);
            PG8_WAIT_L(8); PG8_BAR; PG8_WAIT_L(0); PG8_MMA(0, 0, At, B0); PG8_BAR; PG8_SCHED;
            PG8_LDB(B1, 1, 1); PG8_STAGE(PG8_SB(1, 0), b3, voffB);
            PG8_BAR; PG8_WAIT_L(0); PG8_MMA(0, 1, At, B1); PG8_BAR;
            PG8_LDA(At, 1, 1); PG8_STAGE(PG8_SA(1, 0), a3, voffA);
            PG8_BAR; PG8_WAIT_L(0); PG8_MMA(1, 0, At, B0); PG8_BAR; PG8_SCHED;
            PG8_STAGE(PG8_SB(1, 1), b3 + hstepB, voffB);
            PG8_WAIT_V(6); PG8_BAR; PG8_MMA(1, 1, At, B1); PG8_BAR;
            }
        }
        if constexpr (ALIGN_EPI) { if (wr == 0) PG8_BAR; }
        if constexpr (!Epi::AFTER_DRAIN) { E(acc, cur, wr, wc, fr, fq); S.done(cur); }
        if (!has_next) break;
#pragma unroll
        for (int a = 0; a < 2; ++a)
#pragma unroll
            for (int b = 0; b < 2; ++b)
#pragma unroll
                for (int m = 0; m < 4; ++m)
#pragma unroll
                    for (int n = 0; n < 2; ++n) acc[a][b][m][n] = (f32x4){0.f, 0.f, 0.f, 0.f};
        cur = nxt; cA = nA; cB = nB; ++ui;
        if constexpr (ALIGN_EPI) { if (wr == 1) PG8_BAR; }
    }
    PG8_WAIT_V(0);
    if constexpr (!ALIGN_EPI) { if (wr == 0) PG8_BAR; }
    PG8_BAR;
    if constexpr (Epi::AFTER_DRAIN) { E.fused(acc, cur, wr, wc, fr, fq, lds, wid, lane); S.done(cur); }
#undef PG8_SA
#undef PG8_SB
#undef PG8_STAGE
#undef PG8_LDA
#undef PG8_LDB
#undef PG8_MMA
#undef PG8_WAIT_V
#undef PG8_WAIT_L
#undef PG8_BAR
#undef PG8_SCHED
}
}

typedef unsigned short bf16_t;
typedef short bf16x8 __attribute__((ext_vector_type(8)));
typedef short s16x4 __attribute__((ext_vector_type(4)));
typedef float f32x4 __attribute__((ext_vector_type(4)));
typedef float f32x16 __attribute__((ext_vector_type(16)));
typedef unsigned u32x4 __attribute__((ext_vector_type(4)));
typedef unsigned u32x2 __attribute__((ext_vector_type(2)));
typedef float f32x2 __attribute__((ext_vector_type(2)));

constexpr int DM = 1024, NB = 8, SEQ = 2048, CTXL = 256, LT = SEQ + CTXL  , MROWS = NB * LT  ;
constexpr int EVEN_IN = 4608, ODD_IN = 5120, NCHUNK = LT / 64  ;
constexpr float RMS_EPS = 1e-6f, LOG2E = 1.4426950408889634f;
constexpr int LDS_BYTES = 160 * 1024;
constexpr int NPHASE = 22;

constexpr size_t WS_CTL = 0;
constexpr size_t WS_MOD = 65536;
constexpr size_t WS_ROPE = 524288;
constexpr size_t WS_AGG = 1048576;
constexpr size_t WS_HCTX = WS_AGG + 4718592;
constexpr size_t WS_WIN = WS_HCTX + 8388608;
constexpr size_t WS_WOUT = WS_WIN + 10485760;
constexpr size_t WS_WRG = WS_WOUT + 4194304;
constexpr size_t WS_OV = WS_WRG + 1048576;
constexpr size_t WS_P = WS_OV + 37748736;
constexpr size_t WS_END = WS_P + 188743680;
static_assert(WS_END <= 268435456, "workspace map exceeds 256 MiB");

struct Params {
    const float *x, *c, *ctx, *c_ctx, *ada_w, *ada_b, *norm_w, *ev_w_in, *ev_conv_w, *ev_conv_b, *ev_rg_wx, *ev_rg_bx, *ev_rg_wa, *ev_rg_ba,
        *ev_rg_lambda, *ev_sink, *ev_w_out, *od_w_in, *od_lb_raw, *od_gnorm_w, *od_w_out, *final_norm_w;
    float* out; unsigned char* ws; int ph_lo, ph_hi;
};

DI float bf2f(unsigned short v) { return __uint_as_float((unsigned)v << 16); }
DI unsigned f2bf(float f) { unsigned u = __float_as_uint(f); return (u + 0x7fffu + ((u >> 16) & 1u)) >> 16; }
DI unsigned pk2(float lo, float hi) { return f2bf(lo) | (f2bf(hi) << 16); }
DI float sigm(float x) { return __builtin_amdgcn_rcpf(1.f + __expf(-x)); }
DI float softplus_neg(float lam) {
    const float e = __expf(-lam);
    return e < 0.06f ? e * (1.f + e * (-0.5f + e * (0.33333333f + e * (-0.25f + e * 0.2f)))) : __logf(1.f + e);
}
DI float neg_expm1(float x) {
    return x > -0.25f ? -x * (1.f + x * (0.5f + x * (0.16666667f + x * (0.041666668f + x * (0.0083333338f + x * 0.0013888889f))))) : 1.f - __expf(x);
}
DI float wave_sum(float v) {
#pragma unroll
    for (int o = 1; o < 64; o <<= 1) v += shfl_xor_f(v, o);
    return v;
}
DI int crow(int reg, int h) { return (reg & 3) + 8 * (reg >> 2) + 4 * h; }
#define MFMA16(a, b, c) __builtin_amdgcn_mfma_f32_16x16x32_bf16((a), (b), (c), 0, 0, 0)
#define MFMA32(a, b, c) __builtin_amdgcn_mfma_f32_32x32x16_bf16((a), (b), (c), 0, 0, 0)

struct EpiStoreBf16 {
    static constexpr bool PERM = true, AFTER_DRAIN = false;
    bf16_t* O; int ldc;
    DI void operator()(const f32x4 (&acc)[2][2][4][2], const pg8::Unit& u, int wr, int wc, int fr, int fq) const {
        const int row0 = u.pm * 256 + wr * 64 + fr, col0 = u.pn * 256 + wc * 32 + 8 * fq;
#pragma unroll
        for (int ai = 0; ai < 2; ++ai)
#pragma unroll
            for (int m = 0; m < 4; ++m) { bf16_t* rowp = O + (size_t)(row0 + ai * 128 + m * 16) * ldc + col0;
#pragma unroll
                for (int bj = 0; bj < 2; ++bj) { const f32x4 v0 = acc[ai][bj][m][0], v1 = acc[ai][bj][m][1];
                    u32x4 w; w.x = pk2(v0[0], v0[1]); w.y = pk2(v0[2], v0[3]); w.z = pk2(v1[0], v1[1]); w.w = pk2(v1[2], v1[3]);
                    *(u32x4*)(rowp + bj * 128) = w; } }
    }
};
struct EpiResid {
    static constexpr bool PERM = false, AFTER_DRAIN = false;
    const float* in_lat; const float* in_ctx; float* out_lat; float* out_ctx; const float* gate;
    DI void operator()(const f32x4 (&acc)[2][2][4][2], const pg8::Unit& u, int wr, int wc, int fr, int fq) const {
        const int b = u.pm / 9, jt = u.pm % 9;
        const float* ib; float* ob; const float* g;
        if (jt == 0) { const size_t off = (size_t)b * CTXL * DM; ib = in_ctx + off; ob = out_ctx + off; g = gate + 8 * 3072; }
        else { const size_t off = ((size_t)b * SEQ + (size_t)(jt - 1) * 256) * DM; ib = in_lat + off; ob = out_lat + off; g = gate + b * 3072; }
        const int col0 = u.pn * 256 + wc * 32 + 4 * fq;
#pragma unroll
        for (int bj = 0; bj < 2; ++bj)
#pragma unroll
            for (int n = 0; n < 2; ++n) {
                const f32x4 gvv = *(const f32x4*)(g + col0 + bj * 128 + n * 16);
#pragma unroll
                for (int ai = 0; ai < 2; ++ai) {
#pragma unroll
                    for (int m = 0; m < 4; ++m) { const int r = ai * 128 + wr * 64 + m * 16 + fr;
                        const size_t off = (size_t)r * DM + col0 + bj * 128 + n * 16;
                        const f32x4 o = *(const f32x4*)(ib + off) + gvv * acc[ai][bj][m][n]; *(f32x4*)(ob + off) = o; }
                    asm volatile("" ::: "memory");
                }
            }
    }
};

DI void phase_pro(const Params& P, LAS unsigned char* lds, int wv) {
    const int tid = get_tid(wv);
    LAS float* s = (LAS float*)lds;
    LAS float* red = (LAS float*)(lds + 36864);
    float* mod = (float*)(P.ws + WS_MOD);
    for (int i = tid; i < 9 * 1024; i += 512) { const int r = i >> 10, k = i & 1023; const float v = r < 8 ? P.c[r * 1024 + k] : P.c_ctx[k]; s[i] = v * sigm(v); }
    __syncthreads();
    for (int item = get_bid(); item < 384; item += gridDim.x) {
        const int l = item / 96, n0 = (item % 96) * 32, ks = tid >> 5, col = tid & 31;
        const float* w = P.ada_w + (size_t)l * 1024 * 3072 + n0 + col;
        float acc[9];
#pragma unroll
        for (int r = 0; r < 9; ++r) acc[r] = 0.f;
#pragma unroll 8
        for (int kk = 0; kk < 64; ++kk) { const int k = ks * 64 + kk; const float wv = w[(size_t)k * 3072];
#pragma unroll
            for (int r = 0; r < 9; ++r) acc[r] += s[r * 1024 + k] * wv; }
#pragma unroll
        for (int r = 0; r < 9; ++r) red[(ks * 9 + r) * 32 + col] = acc[r];
        __syncthreads();
        if (tid < 288) { const int r = tid >> 5, cc = tid & 31; float sum = 0.f;
#pragma unroll
            for (int k2 = 0; k2 < 16; ++k2) sum += red[(k2 * 9 + r) * 32 + cc];
            mod[(l * 9 + r) * 3072 + n0 + cc] = sum + P.ada_b[l * 3072 + n0 + cc]; }
        __syncthreads();
    }
    float* cos_t = (float*)(P.ws + WS_ROPE); float* sin_t = cos_t + SEQ * 32;
    for (int i = get_bid() * 512 + tid; i < SEQ * 32; i += gridDim.x * 512) {
        const int pos = i >> 5, jj = i & 31, fi = jj & 15;
        const float inv = __builtin_amdgcn_exp2f(-(float)(2 * fi) * (13.287712379549449f / 32.f));
        const float ang = (float)(jj < 16 ? (pos >> 6) : (pos & 63)) * inv;
        cos_t[i] = __cosf(ang); sin_t[i] = __sinf(ang);
    }
}

DI void transpose_item(const float* W, int K, int N, bf16_t* WT, LAS float* scr, int item, int lane) {
    const int nblk = N / 32, kb = item / nblk, nb = item % nblk, k0 = 64 * kb, n0 = 32 * nb;
#pragma unroll 8
    for (int i = 0; i < 32; ++i) { const int kk = 2 * i + (lane >> 5); scr[kk * 33 + (lane & 31)] = W[(size_t)(k0 + kk) * N + n0 + (lane & 31)]; }
    asm volatile("s_waitcnt lgkmcnt(0)" ::: "memory");
    const int c = lane & 7;
#pragma unroll
    for (int j = 0; j < 4; ++j) { const int n = (lane >> 3) + 8 * j; const LAS float* sp = scr + (8 * c) * 33 + n;
        u32x4 o; o.x = pk2(sp[0 * 33], sp[1 * 33]); o.y = pk2(sp[2 * 33], sp[3 * 33]); o.z = pk2(sp[4 * 33], sp[5 * 33]); o.w = pk2(sp[6 * 33], sp[7 * 33]);
        *(u32x4*)(WT + (size_t)(n0 + n) * K + k0 + 8 * c) = o; }
    asm volatile("s_waitcnt lgkmcnt(0)" ::: "memory");
}

DI void phase_norm(const Params& P, LAS unsigned char* lds, int layer, int wv) {
    const int tid = get_tid(wv), lane = tid & 63, wave = tid >> 6;
    const int gw = get_bid() * 8 + wave, NGW = gridDim.x * 8;
    const int j = layer >> 1;
    LAS float* scr = (LAS float*)(lds + wave * 16384);
    bf16_t* WIN = (bf16_t*)(P.ws + WS_WIN); bf16_t* WOUT = (bf16_t*)(P.ws + WS_WOUT); bf16_t* WRG = (bf16_t*)(P.ws + WS_WRG);
    if ((layer & 1) == 0) {
        constexpr int I_IN = 16 * (EVEN_IN / 32), I_OUT = 32 * 32, I_RG = 32 * 8;
        for (int it = gw; it < I_IN + I_OUT + I_RG; it += NGW) {
            int r = it;
            if (r < I_IN) { transpose_item(P.ev_w_in + (size_t)j * 1024 * EVEN_IN, 1024, EVEN_IN, WIN, scr, r, lane); continue; } r -= I_IN;
            if (r < I_OUT) { transpose_item(P.ev_w_out + (size_t)j * 2048 * 1024, 2048, 1024, WOUT, scr, r, lane); continue; } r -= I_OUT;
            const int mat = r >> 3, sub = r & 7;
            const int dir = mat >> 4, gate = (mat >> 3) & 1, hd = mat & 7;
            const float* src = (gate == 0 ? P.ev_rg_wx : P.ev_rg_wa) + ((size_t)((j * 2 + dir) * 8 + hd)) * 16384;
            transpose_item(src, 128, 128, WRG + (size_t)mat * 16384, scr, sub, lane);
        }
    } else {
        constexpr int I_IN = 16 * (ODD_IN / 32), I_OUT = 16 * 32;
        for (int it = gw; it < I_IN + I_OUT; it += NGW) {
            int r = it;
            if (r < I_IN) { transpose_item(P.od_w_in + (size_t)j * 1024 * ODD_IN, 1024, ODD_IN, WIN, scr, r, lane); continue; } r -= I_IN;
            transpose_item(P.od_w_out + (size_t)j * 1024 * 1024, 1024, 1024, WOUT, scr, r, lane);
        }
    }
    const float* hl = layer == 0 ? P.x : P.out; const float* hc = layer == 0 ? P.ctx : (const float*)(P.ws + WS_HCTX);
    const float* mod = (const float*)(P.ws + WS_MOD) + (size_t)layer * 9 * 3072;
    const float* nw = P.norm_w + layer * 1024;
    bf16_t* U = (bf16_t*)(P.ws + WS_OV);
    for (int R = gw; R < MROWS; R += NGW) {
        const int b = R / LT, jr = R % LT;
        const float* src = jr < CTXL ? hc + ((size_t)b * CTXL + jr) * DM : hl + ((size_t)b * SEQ + (jr - CTXL)) * DM;
        const float* sh = mod + (jr < CTXL ? 8 : b) * 3072; const float* sc = sh + 1024;
        f32x4 v[4]; float ss = 0.f;
#pragma unroll
        for (int q = 0; q < 4; ++q) { v[q] = *(const f32x4*)(src + 4 * lane + 256 * q); ss += (v[q][0] * v[q][0] + v[q][1] * v[q][1]) + (v[q][2] * v[q][2] + v[q][3] * v[q][3]); }
        const float rstd = rsqrtf(wave_sum(ss) * (1.f / DM) + RMS_EPS);
#pragma unroll
        for (int q = 0; q < 4; ++q) { const int k = 4 * lane + 256 * q;
            const f32x4 w4 = *(const f32x4*)(nw + k), s4 = *(const f32x4*)(sc + k), h4 = *(const f32x4*)(sh + k);
            const f32x4 y = (v[q] * rstd) * w4; const f32x4 o = y * (s4 + 1.f) + h4;
            u32x2 w; w.x = pk2(o[0], o[1]); w.y = pk2(o[2], o[3]); *(u32x2*)(U + (size_t)R * DM + k) = w; }
    }
}

typedef _Float16 f16x2_t __attribute__((ext_vector_type(2)));
DI unsigned pkh2(float a, float b) { const f16x2_t v = {(_Float16)a, (_Float16)b}; return __builtin_bit_cast(unsigned, v); }
DI void unpkh2(unsigned u, float& a, float& b) { const f16x2_t v = __builtin_bit_cast(f16x2_t, u); a = (float)v[0]; b = (float)v[1]; }
constexpr int RG_UT = 0, RG_AL = 17408, RG_BL = 50176, RG_HP = 82944, RG_QA = 148480, RG_CAR = 152576, RG_FLAG = 153600, RG_END = 153664;
static_assert(RG_END <= LDS_BYTES - 256, "RG-LRU LDS map");
constexpr int CW_RG = 8192;
DI void rglru_item(const Params& P, LAS unsigned char* lds, int j, int item, int wv) {
    const int tid = get_tid(wv), lane = tid & 63, wave = tid >> 6, r = lane & 15, g = lane >> 4;
    const int grp = item / NCHUNK, ci = item % NCHUNK, b = grp >> 3, hd = grp & 7;
    bf16_t* p = (bf16_t*)(P.ws + WS_P);
    const bf16_t* WRG = (const bf16_t*)(P.ws + WS_WRG);
    unsigned long long* AGG = (unsigned long long*)(P.ws + WS_AGG);
    unsigned* cnt = (unsigned*)(P.ws + WS_CTL) + CW_RG + (j * 64 + grp) * 16;
    const int R0 = b * LT + ci * 64;
    const int seg_lo = b * LT + (ci < 4 ? 0 : CTXL), seg_hi = b * LT + (ci < 4 ? CTXL : LT);
    LAS bf16_t* UT = (LAS bf16_t*)(lds + RG_UT);
    LAS float* AL = (LAS float*)(lds + RG_AL);
    LAS float* BL = (LAS float*)(lds + RG_BL);
    LAS unsigned* HP = (LAS unsigned*)(lds + RG_HP);
    LAS float* QA = (LAS float*)(lds + RG_QA);
    LAS float* CAR = (LAS float*)(lds + RG_CAR);
#pragma unroll
    for (int rep = 0; rep < 2; ++rep) {
        const int idx = tid + rep * 512, t = idx >> 4, c0 = (idx & 15) * 8, cg0 = hd * 128 + c0;
        float acc[8];
        { const f32x4 b0 = *(const f32x4*)(P.ev_conv_b + j * 1024 + cg0), b1 = *(const f32x4*)(P.ev_conv_b + j * 1024 + cg0 + 4);
          acc[0] = b0[0]; acc[1] = b0[1]; acc[2] = b0[2]; acc[3] = b0[3]; acc[4] = b1[0]; acc[5] = b1[1]; acc[6] = b1[2]; acc[7] = b1[3]; }
#pragma unroll
        for (int k = 0; k < 4; ++k) {
            const int Rg = R0 + t + k - 1;
            if (Rg >= seg_lo && Rg < seg_hi) {
                const u32x4 xv = *(const u32x4*)(p + (size_t)Rg * EVEN_IN + cg0);
                const float* wk = P.ev_conv_w + (size_t)(j * 4 + k) * 1024 + cg0;
                const f32x4 w0 = *(const f32x4*)wk, w1 = *(const f32x4*)(wk + 4);
                acc[0] += w0[0] * __uint_as_float(xv.x << 16); acc[1] += w0[1] * __uint_as_float(xv.x & 0xffff0000u);
                acc[2] += w0[2] * __uint_as_float(xv.y << 16); acc[3] += w0[3] * __uint_as_float(xv.y & 0xffff0000u);
                acc[4] += w1[0] * __uint_as_float(xv.z << 16); acc[5] += w1[1] * __uint_as_float(xv.z & 0xffff0000u);
                acc[6] += w1[2] * __uint_as_float(xv.w << 16); acc[7] += w1[3] * __uint_as_float(xv.w & 0xffff0000u);
            }
        }
        u32x4 o; o.x = pk2(acc[0], acc[1]); o.y = pk2(acc[2], acc[3]); o.z = pk2(acc[4], acc[5]); o.w = pk2(acc[6], acc[7]);
        *(LAS u32x4*)(UT + t * 136 + c0) = o;
    }
    __syncthreads();
#pragma unroll 1
    for (int dir = 0; dir < 2; ++dir) {
        f32x4 ax[4], aa[4];
#pragma unroll
        for (int m = 0; m < 4; ++m) { ax[m] = (f32x4){0.f, 0.f, 0.f, 0.f}; aa[m] = (f32x4){0.f, 0.f, 0.f, 0.f}; }
        const bf16_t* Wx = WRG + (size_t)((dir * 2 + 0) * 8 + hd) * 16384 + (16 * wave + r) * 128 + 8 * g;
        const bf16_t* Wa = WRG + (size_t)((dir * 2 + 1) * 8 + hd) * 16384 + (16 * wave + r) * 128 + 8 * g;
#pragma unroll
        for (int ks = 0; ks < 4; ++ks) {
            const bf16x8 bx = *(const bf16x8*)(Wx + 32 * ks), ba = *(const bf16x8*)(Wa + 32 * ks);
#pragma unroll
            for (int m = 0; m < 4; ++m) {
                const bf16x8 a = *(const LAS bf16x8*)(UT + (16 * m + r) * 136 + 32 * ks + 8 * g);
                ax[m] = MFMA16(a, bx, ax[m]); aa[m] = MFMA16(a, ba, aa[m]);
            }
        }
        {
            const int c = 16 * wave + r, idx = (j * 2 + dir) * 1024 + hd * 128 + c;
            const float bxv = P.ev_rg_bx[idx], bav = P.ev_rg_ba[idx], lam = P.ev_rg_lambda[idx];
            const float sp = softplus_neg(lam);
#pragma unroll
            for (int m = 0; m < 4; ++m)
#pragma unroll
                for (int i = 0; i < 4; ++i) {
                    const int t = 16 * m + 4 * g + i;
                    const float gx = sigm(ax[m][i] + bxv), ga = sigm(aa[m][i] + bav);
                    const float la = -8.f * ga * sp;
                    const float a = __expf(la), mult = __builtin_amdgcn_sqrtf(neg_expm1(2.f * la));
                    const float uv = bf2f(UT[t * 136 + c]);
                    AL[t * 128 + c] = a; BL[t * 128 + c] = mult * gx * uv;
                }
        }
        __syncthreads();
        {
            const int c = tid & 127, q = tid >> 7;
            float A = 1.f, B = 0.f;
#pragma unroll
            for (int s = 0; s < 16; ++s) { const int t = dir == 0 ? 16 * q + s : 16 * q + 15 - s; const float a = AL[t * 128 + c], bb = BL[t * 128 + c]; B = a * B + bb; A *= a; }
            QA[(q * 128 + c) * 2] = A; QA[(q * 128 + c) * 2 + 1] = B;
            __syncthreads();
            float h = 0.f, pc = 1.f;
            const int nprev = dir == 0 ? q : 3 - q;
            for (int qq = 0; qq < nprev; ++qq) { const int qi = dir == 0 ? qq : 3 - qq; const float a = QA[(qi * 128 + c) * 2]; h = a * h + QA[(qi * 128 + c) * 2 + 1]; pc *= a; }
#pragma unroll
            for (int s = 0; s < 16; ++s) { const int t = dir == 0 ? 16 * q + s : 16 * q + 15 - s; const float a = AL[t * 128 + c]; h = a * h + BL[t * 128 + c]; pc *= a;
                HP[(dir * 64 + t) * 128 + c] = pkh2(h, pc); }
            if (nprev == 3) {
                const unsigned long long v = ((unsigned long long)__float_as_uint(h) << 32) | __float_as_uint(pc);
                __hip_atomic_store(AGG + ((size_t)(dir * NB + b) * NCHUNK + ci) * 1024 + hd * 128 + c, v, __ATOMIC_RELAXED, __HIP_MEMORY_SCOPE_AGENT);
            }
        }
        __syncthreads();
    }
    asm volatile("s_waitcnt vmcnt(0)" ::: "memory");
    __syncthreads();
    if (tid == 0) {
        __hip_atomic_fetch_add(cnt, 1u, __ATOMIC_RELAXED, __HIP_MEMORY_SCOPE_AGENT);
        unsigned spins = 0;
        while (__hip_atomic_load(cnt, __ATOMIC_RELAXED, __HIP_MEMORY_SCOPE_AGENT) < (unsigned)NCHUNK) { __builtin_amdgcn_s_sleep(2); if (++spins > (1u << 22)) break; }
    }
    __syncthreads();
    if (tid < 256) {
        const int dir = tid >> 7, c = tid & 127;
        const int pos = dir == 0 ? ci : (ci < 4 ? 3 - ci : 39 - ci);
        float h = 0.f;
        for (int pp = 0; pp < pos; ++pp) {
            const int cc = dir == 0 ? pp : (pp < 4 ? 3 - pp : 39 - pp);
            const unsigned long long v = __hip_atomic_load(AGG + ((size_t)(dir * NB + b) * NCHUNK + cc) * 1024 + hd * 128 + c, __ATOMIC_RELAXED, __HIP_MEMORY_SCOPE_AGENT);
            h = __uint_as_float((unsigned)v) * h + __uint_as_float((unsigned)(v >> 32));
        }
        CAR[dir * 128 + c] = h;
    }
    __syncthreads();
#pragma unroll
    for (int rep = 0; rep < 2; ++rep) {
        const int idx = tid + rep * 512, t = idx >> 4, c0 = (idx & 15) * 8;
        bf16_t* gp = p + (size_t)(R0 + t) * EVEN_IN + 1536 + hd * 128 + c0;
        const u32x4 gv = *(const u32x4*)gp;
        float y[8];
#pragma unroll
        for (int e = 0; e < 8; ++e) {
            float h0, p0, h1, p1; unpkh2(HP[t * 128 + c0 + e], h0, p0); unpkh2(HP[(64 + t) * 128 + c0 + e], h1, p1);
            y[e] = (h0 + p0 * CAR[c0 + e]) + (h1 + p1 * CAR[128 + c0 + e]);
        }
        const float gg[8] = {__uint_as_float(gv.x << 16), __uint_as_float(gv.x & 0xffff0000u), __uint_as_float(gv.y << 16), __uint_as_float(gv.y & 0xffff0000u),
                             __uint_as_float(gv.z << 16), __uint_as_float(gv.z & 0xffff0000u), __uint_as_float(gv.w << 16), __uint_as_float(gv.w & 0xffff0000u)};
        u32x4 o;
        o.x = pk2(y[0] * gg[0] * sigm(gg[0]), y[1] * gg[1] * sigm(gg[1])); o.y = pk2(y[2] * gg[2] * sigm(gg[2]), y[3] * gg[3] * sigm(gg[3]));
        o.z = pk2(y[4] * gg[4] * sigm(gg[4]), y[5] * gg[5] * sigm(gg[5])); o.w = pk2(y[6] * gg[6] * sigm(gg[6]), y[7] * gg[7] * sigm(gg[7]));
        *(u32x4*)gp = o;
    }
    __syncthreads();
}

DI void rope8(u32x4& v, const float* cs, const float* sn) {
    unsigned* w = (unsigned*)&v;
#pragma unroll
    for (int i = 0; i < 4; ++i) { const float t1 = __uint_as_float(w[i] << 16), t2 = __uint_as_float(w[i] & 0xffff0000u); w[i] = pk2(t1 * cs[i] - t2 * sn[i], t1 * sn[i] + t2 * cs[i]); }
}
DI void attn_item(const Params& P, LAS unsigned char* lds, int j, int item, int wv) {
    const int tid = get_tid(wv), lane = tid & 63, wave = tid >> 6, r = lane & 31, h = lane >> 5;
    const bool is_lat = item < 512;
    int b, qb, kvh;
    if (is_lat) { b = item >> 6; qb = (item >> 2) & 15; kvh = item & 3; } else { const int it = item - 512; b = it >> 3; qb = (it >> 2) & 1; kvh = it & 3; }
    bf16_t* p = (bf16_t*)(P.ws + WS_P);
    const float* cos_t = (const float*)(P.ws + WS_ROPE); const float* sin_t = cos_t + SEQ * 32;
    LAS unsigned char* KL = lds;
    LAS unsigned char* VT = lds + 9216;
    const int hq = 4 * kvh + (wave >> 1), ql0 = qb * 128 + 64 * (wave & 1);
    const size_t rowbase = (size_t)b * LT + (is_lat ? CTXL : 0);
    LAS unsigned char* QL = lds + 18432 + wave * 9216;
#pragma unroll
    for (int qt = 0; qt < 2; ++qt) {
        const int qi = ql0 + 32 * qt + r;
        const bf16_t* qp = p + (rowbase + qi) * EVEN_IN + 2560 + hq * 64 + 8 * h;
#pragma unroll
        for (int ks = 0; ks < 4; ++ks) {
            u32x4 v = *(const u32x4*)(qp + 16 * ks);
            if (is_lat) rope8(v, cos_t + qi * 32 + 8 * ks + 4 * h, sin_t + qi * 32 + 8 * ks + 4 * h);
            *(LAS u32x4*)(QL + (32 * qt + r) * 144 + (16 * ks + 8 * h) * 2) = v;
        }
    }
    const float sink2 = P.ev_sink[j * 16 + hq] * LOG2E;
    float mrun[2] = {sink2, sink2}, lrun[2] = {h == 0 ? 1.f : 0.f, h == 0 ? 1.f : 0.f};
    f32x16 O[2][2];
#pragma unroll
    for (int a = 0; a < 2; ++a)
#pragma unroll
        for (int c = 0; c < 2; ++c)
#pragma unroll
            for (int i = 0; i < 16; ++i) O[a][c][i] = 0.f;
    const int ntiles = is_lat ? 10 : 4;
    const float SC = 0.125f * LOG2E, NEG = -1e30f;
#pragma unroll 1
    for (int ti = 0; ti < ntiles; ++ti) {
        const bool win = ti >= 4;
        const int k0 = win ? qb * 128 - 128 + 64 * (ti - 4) : 64 * ti;
        if (win && (k0 < 0 || k0 >= SEQ)) continue;
        __syncthreads();
        {
            const int key = tid >> 3, chn = tid & 7;
            const bf16_t* kp = p + ((size_t)b * LT + (win ? CTXL : 0) + k0 + key) * EVEN_IN + 1024 + kvh * 64 + 8 * chn;
            u32x4 kv = *(const u32x4*)kp;
            if (win) rope8(kv, cos_t + (k0 + key) * 32 + 4 * chn, sin_t + (k0 + key) * 32 + 4 * chn);
            *(LAS u32x4*)(KL + key * 144 + chn * 16) = kv;
            const u32x4 vv = *(const u32x4*)(kp + 256);
            const unsigned* vw = (const unsigned*)&vv;
#pragma unroll
            for (int e = 0; e < 4; ++e) {
                *(LAS unsigned short*)(VT + (8 * chn + 2 * e) * 144 + key * 2) = (unsigned short)(vw[e] & 0xffffu);
                *(LAS unsigned short*)(VT + (8 * chn + 2 * e + 1) * 144 + key * 2) = (unsigned short)(vw[e] >> 16);
            }
        }
        __syncthreads();
#pragma unroll
        for (int qt = 0; qt < 2; ++qt) {
            f32x16 s0, s1;
#pragma unroll
            for (int i = 0; i < 16; ++i) { s0[i] = 0.f; s1[i] = 0.f; }
#pragma unroll
            for (int ks = 0; ks < 4; ++ks) {
                const bf16x8 qfr = *(const LAS bf16x8*)(QL + (32 * qt + r) * 144 + (16 * ks + 8 * h) * 2);
                const bf16x8 k0f = *(const LAS bf16x8*)(KL + r * 144 + (16 * ks + 8 * h) * 2), k1f = *(const LAS bf16x8*)(KL + (32 + r) * 144 + (16 * ks + 8 * h) * 2);
                s0 = MFMA32(k0f, qfr, s0); s1 = MFMA32(k1f, qfr, s1);
            }
            const int qpos = ql0 + 32 * qt + r;
            float mx = NEG;
#pragma unroll
            for (int i = 0; i < 16; ++i) {
                const int kp0 = k0 + crow(i, h), kp1 = kp0 + 32;
                float v0 = s0[i] * SC, v1 = s1[i] * SC;
                if (win) { const int d0 = qpos - kp0, d1 = qpos - kp1; if (d0 > 128 || d0 < -128) v0 = NEG; if (d1 > 128 || d1 < -128) v1 = NEG; }
                s0[i] = v0; s1[i] = v1; mx = fmaxf(mx, fmaxf(v0, v1));
            }
            mx = fmaxf(mx, shfl_xor_f(mx, 32));
            const float mn = fmaxf(mrun[qt], mx), alpha = __builtin_amdgcn_exp2f(mrun[qt] - mn);
            mrun[qt] = mn;
            float ls = 0.f;
#pragma unroll
            for (int i = 0; i < 16; ++i) { s0[i] = __builtin_amdgcn_exp2f(s0[i] - mn); s1[i] = __builtin_amdgcn_exp2f(s1[i] - mn); ls += s0[i] + s1[i]; }
            lrun[qt] = lrun[qt] * alpha + ls;
#pragma unroll
            for (int dt = 0; dt < 2; ++dt)
#pragma unroll
                for (int i = 0; i < 16; ++i) O[dt][qt][i] *= alpha;
            bf16x8 pf[2][2];
#pragma unroll
            for (int s = 0; s < 2; ++s) {
                u32x4 a, c;
                a.x = pk2(s0[8 * s + 0], s0[8 * s + 1]); a.y = pk2(s0[8 * s + 2], s0[8 * s + 3]); a.z = pk2(s0[8 * s + 4], s0[8 * s + 5]); a.w = pk2(s0[8 * s + 6], s0[8 * s + 7]);
                c.x = pk2(s1[8 * s + 0], s1[8 * s + 1]); c.y = pk2(s1[8 * s + 2], s1[8 * s + 3]); c.z = pk2(s1[8 * s + 4], s1[8 * s + 5]); c.w = pk2(s1[8 * s + 6], s1[8 * s + 7]);
                pf[0][s] = __builtin_bit_cast(bf16x8, a); pf[1][s] = __builtin_bit_cast(bf16x8, c);
            }
#pragma unroll
            for (int dt = 0; dt < 2; ++dt)
#pragma unroll
                for (int kt = 0; kt < 2; ++kt)
#pragma unroll
                    for (int s = 0; s < 2; ++s) {
                        const LAS unsigned char* vp = VT + (32 * dt + r) * 144 + (32 * kt + 16 * s + 4 * h) * 2;
                        const u32x2 lo = *(const LAS u32x2*)vp, hi = *(const LAS u32x2*)(vp + 16);
                        const u32x4 vv = {lo.x, lo.y, hi.x, hi.y};
                        O[dt][qt] = MFMA32(__builtin_bit_cast(bf16x8, vv), pf[kt][s], O[dt][qt]);
                    }
            __builtin_amdgcn_sched_barrier(0);
        }
    }
#pragma unroll
    for (int qt = 0; qt < 2; ++qt) {
        const float lt = lrun[qt] + shfl_xor_f(lrun[qt], 32), inv = __builtin_amdgcn_rcpf(lt);
        const int qi = ql0 + 32 * qt + r;
        bf16_t* rowp = p + (rowbase + qi) * EVEN_IN;
#pragma unroll
        for (int dt = 0; dt < 2; ++dt)
#pragma unroll
            for (int i4 = 0; i4 < 4; ++i4) {
                const int d0 = 32 * dt + 8 * i4 + 4 * h;
                const u32x2 gv = *(const u32x2*)(rowp + 3584 + hq * 64 + d0);
                const float g0 = __uint_as_float(gv.x << 16), g1 = __uint_as_float(gv.x & 0xffff0000u), g2 = __uint_as_float(gv.y << 16), g3 = __uint_as_float(gv.y & 0xffff0000u);
                u32x2 o;
                o.x = pk2(O[dt][qt][4 * i4 + 0] * inv * g0 * sigm(g0), O[dt][qt][4 * i4 + 1] * inv * g1 * sigm(g1));
                o.y = pk2(O[dt][qt][4 * i4 + 2] * inv * g2 * sigm(g2), O[dt][qt][4 * i4 + 3] * inv * g3 * sigm(g3));
                *(u32x2*)(rowp + 2560 + hq * 64 + d0) = o;
            }
    }
    __syncthreads();
}

constexpr int G2_QX = 0, G2_KF = 17408, G2_K2 = 60928, G2_VS = 79360, G2_AM = 96768, G2_ST = 105984, G2_PS = 140800, G2_BL = 144896, G2_Q1 = 145408, G2_END = 162816;
static_assert(G2_END <= LDS_BYTES - 256, "GLA LDS map");
typedef short v4i16_t __attribute__((ext_vector_type(4)));
DI bf16x8 frag_tr(const LAS bf16_t* M, int stride, int k0, int n0, int lane) {
    const int i = lane & 15, g = lane >> 4, q = i >> 2, pp = i & 3;
    const LAS bf16_t* a0 = M + (k0 + 8 * g + q) * stride + n0 + 4 * pp;
    const v4i16_t lo = __builtin_amdgcn_ds_read_tr16_b64_v4i16((LAS v4i16_t*)a0);
    const v4i16_t hi = __builtin_amdgcn_ds_read_tr16_b64_v4i16((LAS v4i16_t*)(a0 + 4 * stride));
    return (bf16x8){lo[0], lo[1], lo[2], lo[3], hi[0], hi[1], hi[2], hi[3]};
}

template <int DIR>
DI void gla2_item(const Params& P, LAS unsigned char* lds, int layer_j, int b, int hd, int wv) {
    const int tid = get_tid(wv), lane = tid & 63, wave = tid >> 6, r = lane & 15, g = lane >> 4;
    bf16_t* p = (bf16_t*)(P.ws + WS_P);
    LAS bf16_t* QX = (LAS bf16_t*)(lds + G2_QX); LAS bf16_t* KF = (LAS bf16_t*)(lds + G2_KF); LAS bf16_t* K2 = (LAS bf16_t*)(lds + G2_K2);
    LAS bf16_t* VS = (LAS bf16_t*)(lds + G2_VS); LAS bf16_t* AM = (LAS bf16_t*)(lds + G2_AM); LAS bf16_t* ST = (LAS bf16_t*)(lds + G2_ST);
    LAS float* PS8 = (LAS float*)(lds + G2_PS); LAS float* BLAST = (LAS float*)(lds + G2_BL); LAS bf16_t* Q1 = (LAS bf16_t*)(lds + G2_Q1);
    const int d0 = 2 * lane, tg = wave, I = tg >> 1, half = tg & 1;
    float lbv[2] = {0.f, 0.f};
    if (layer_j > 0) { lbv[0] = sigm(P.od_lb_raw[1024 + hd * 128 + d0] - P.od_lb_raw[hd * 128 + d0]); lbv[1] = sigm(P.od_lb_raw[1024 + hd * 128 + d0 + 1] - P.od_lb_raw[hd * 128 + d0 + 1]); }
    for (int i = tid; i < (9216 + 34816) / 4; i += 512) ((LAS unsigned*)(lds + G2_AM))[i] = 0u;
    f32x4 st[8];
#pragma unroll
    for (int e = 0; e < 8; ++e) st[e] = (f32x4){0.f, 0.f, 0.f, 0.f};
    unsigned zn[8], qn[8]; u32x4 vn[2];
#define G2_OFFZ(s) ((unsigned)((DIR == 0 ? 8 * tg + (s) : 63 - 8 * tg - (s)) * ODD_IN + d0) * 2u)
#define G2_OFFV(rep) ((unsigned)((DIR == 0 ? ((tid + (rep) * 512) >> 4) : 63 - ((tid + (rep) * 512) >> 4)) * ODD_IN + 8 * ((tid + (rep) * 512) & 15)) * 2u)
    const size_t colz = (size_t)DIR * 1024 + hd * 128, colq = 3072 + hd * 128, colv = 2048 + hd * 128;
    {
        const int chunk = DIR == 0 ? 0 : 3;
        const char* slab = (const char*)(p + ((size_t)b * LT + (size_t)chunk * 64) * ODD_IN);
#pragma unroll
        for (int s = 0; s < 8; ++s) { zn[s] = *(const unsigned*)(slab + colz * 2 + G2_OFFZ(s)); qn[s] = *(const unsigned*)(slab + colq * 2 + G2_OFFZ(s)); }
#pragma unroll
        for (int rep = 0; rep < 2; ++rep) vn[rep] = *(const u32x4*)(slab + colv * 2 + G2_OFFV(rep));
    }
    __syncthreads();
#pragma unroll 1
    for (int step = 0; step < NCHUNK; ++step) {
        const int chunk = DIR == 0 ? step : (step < 4 ? 3 - step : 39 - step);
        const size_t Rc0 = (size_t)b * LT + (size_t)chunk * 64;
        unsigned zc[8], qc[8]; u32x4 vc[2];
#pragma unroll
        for (int s = 0; s < 8; ++s) { zc[s] = zn[s]; qc[s] = qn[s]; }
        vc[0] = vn[0]; vc[1] = vn[1];
        float el[8][2], kk[8][2], qq[8][2];
        {
            float run0 = 1.f, run1 = 1.f;
#pragma unroll
            for (int s = 0; s < 8; ++s) {
                const float z0 = __uint_as_float(zc[s] << 16), z1 = __uint_as_float(zc[s] & 0xffff0000u);
                const float t0 = __expf(-z0), t1 = __expf(-z1), sg0 = __builtin_amdgcn_rcpf(1.f + t0), sg1 = __builtin_amdgcn_rcpf(1.f + t1);
                const float f0 = fmaxf(lbv[0] + (1.f - lbv[0]) * sg0, 1e-30f), f1 = fmaxf(lbv[1] + (1.f - lbv[1]) * sg1, 1e-30f);
                kk[s][0] = (1.f - lbv[0]) * (t0 * sg0); kk[s][1] = (1.f - lbv[1]) * (t1 * sg1);
                run0 = fmaxf(run0 * f0, 1e-35f); run1 = fmaxf(run1 * f1, 1e-35f); el[s][0] = run0; el[s][1] = run1;
                const float q0 = __uint_as_float(qc[s] << 16), q1 = __uint_as_float(qc[s] & 0xffff0000u);
                qq[s][0] = q0 * __builtin_amdgcn_rcpf(1.f + __expf(-q0)); qq[s][1] = q1 * __builtin_amdgcn_rcpf(1.f + __expf(-q1));
                if ((s & 1) == 1) __builtin_amdgcn_sched_barrier(0);
            }
            *(LAS f32x2*)(PS8 + tg * 128 + d0) = (f32x2){run0, run1};
#pragma unroll
            for (int rep = 0; rep < 2; ++rep) { const int idx = tid + rep * 512, tau = idx >> 4, chn = idx & 15; *(LAS u32x4*)(VS + tau * 136 + 8 * chn) = vc[rep]; }
        }
        __syncthreads();
        float RI[2];
        {
            float T[8][2];
#pragma unroll
            for (int q8 = 0; q8 < 8; ++q8) { const f32x2 t = *(const LAS f32x2*)(PS8 + q8 * 128 + d0); T[q8][0] = t[0]; T[q8][1] = t[1]; }
            float pre[2], fac[4][2], f4[2];
#pragma unroll
            for (int x = 0; x < 2; ++x) {
                const float P0 = T[0][x] * T[1][x], P1 = T[2][x] * T[3][x], P2 = T[4][x] * T[5][x], P3 = T[6][x] * T[7][x];
                pre[x] = half ? (I == 0 ? T[0][x] : (I == 1 ? T[2][x] : (I == 2 ? T[4][x] : T[6][x]))) : 1.f;
                RI[x] = I == 0 ? 1.f : (I == 1 ? P0 : (I == 2 ? P0 * P1 : P0 * P1 * P2));
                float cur = 1.f;
                fac[0][x] = cur; if (I <= 0) cur *= P0;
                fac[1][x] = cur; if (I <= 1) cur *= P1;
                fac[2][x] = cur; if (I <= 2) cur *= P2;
                fac[3][x] = cur; cur *= P3;
                f4[x] = cur;
                if (tg == 0) BLAST[d0 + x] = P0 * P1 * P2 * P3;
            }
            unsigned w0[4], w1[4];
#pragma unroll
            for (int s = 0; s < 8; ++s) {
                const int tau = 8 * tg + s;
                const float e00 = fmaxf(pre[0] * el[s][0], 1e-35f), e01 = fmaxf(pre[1] * el[s][1], 1e-35f);
                const float qi0 = qq[s][0] * e00, qi1 = qq[s][1] * e01;
                const float kd0 = kk[s][0] * __builtin_amdgcn_rcpf(e00), kd1 = kk[s][1] * __builtin_amdgcn_rcpf(e01);
                *(LAS unsigned*)(QX + tau * 136 + d0) = pk2(qi0, qi1);
                *(LAS unsigned*)(Q1 + tau * 136 + d0) = pk2(qi0 * RI[0], qi1 * RI[1]);
                if (I <= 0) *(LAS unsigned*)(KF + (0 + tau) * 136 + d0) = pk2(kd0 * fac[0][0], kd1 * fac[0][1]);
                if (I <= 1) *(LAS unsigned*)(KF + (16 + tau) * 136 + d0) = pk2(kd0 * fac[1][0], kd1 * fac[1][1]);
                if (I <= 2) *(LAS unsigned*)(KF + (48 + tau) * 136 + d0) = pk2(kd0 * fac[2][0], kd1 * fac[2][1]);
                *(LAS unsigned*)(KF + (96 + tau) * 136 + d0) = pk2(kd0 * fac[3][0], kd1 * fac[3][1]);
                const unsigned h0 = f2bf(kd0 * f4[0]), h1 = f2bf(kd1 * f4[1]);
                if (s & 1) { w0[s >> 1] |= h0 << 16; w1[s >> 1] |= h1 << 16; } else { w0[s >> 1] = h0; w1[s >> 1] = h1; }
                if ((s & 1) == 1) __builtin_amdgcn_sched_barrier(0);
            }
            *(LAS u32x4*)(K2 + (d0 + 0) * 72 + 8 * tg) = (u32x4){w0[0], w0[1], w0[2], w0[3]};
            *(LAS u32x4*)(K2 + (d0 + 1) * 72 + 8 * tg) = (u32x4){w1[0], w1[1], w1[2], w1[3]};
        }
        __syncthreads();
        if (step + 1 < NCHUNK) {
            const int nchunk = DIR == 0 ? step + 1 : (step + 1 < 4 ? 2 - step : 38 - step);
            const char* slab = (const char*)(p + ((size_t)b * LT + (size_t)nchunk * 64) * ODD_IN);
#pragma unroll
            for (int s = 0; s < 8; ++s) { zn[s] = *(const unsigned*)(slab + colz * 2 + G2_OFFZ(s)); qn[s] = *(const unsigned*)(slab + colq * 2 + G2_OFFZ(s)); }
#pragma unroll
            for (int rep = 0; rep < 2; ++rep) vn[rep] = *(const u32x4*)(slab + colv * 2 + G2_OFFV(rep));
        }
#pragma unroll 1
        for (int bi = wave; bi < 10; bi += 8) {
            const int Ib = bi < 1 ? 0 : (bi < 3 ? 1 : (bi < 6 ? 2 : 3)), Jb = bi - (Ib * (Ib + 1)) / 2;
            const int foff = Ib == 0 ? 0 : (Ib == 1 ? 16 : (Ib == 2 ? 48 : 96));
            f32x4 acc = {0.f, 0.f, 0.f, 0.f};
#pragma unroll
            for (int ks = 0; ks < 4; ++ks) {
                const bf16x8 a = *(const LAS bf16x8*)(QX + (16 * Ib + r) * 136 + 32 * ks + 8 * g);
                const bf16x8 bb = *(const LAS bf16x8*)(KF + (foff + 16 * Jb + r) * 136 + 32 * ks + 8 * g);
                acc = MFMA16(a, bb, acc);
            }
#pragma unroll
            for (int i = 0; i < 4; ++i) { float v = acc[i]; if (Jb == Ib && r > 4 * g + i) v = 0.f; AM[(16 * Ib + 4 * g + i) * 72 + 16 * Jb + r] = (bf16_t)f2bf(v); }
        }
        __syncthreads();
        {
            const int tt = wave >> 1, eb = 4 * (wave & 1);
            char* oslab = (char*)(p + Rc0 * ODD_IN + colz);
            bf16x8 aq[4], am[2];
#pragma unroll
            for (int ks = 0; ks < 4; ++ks) aq[ks] = *(const LAS bf16x8*)(Q1 + (16 * tt + r) * 136 + 32 * ks + 8 * g);
#pragma unroll
            for (int ks = 0; ks < 2; ++ks) am[ks] = *(const LAS bf16x8*)(AM + (16 * tt + r) * 72 + 32 * ks + 8 * g);
#pragma unroll
            for (int e4 = 0; e4 < 4; ++e4) {
                const int et = eb + e4;
                f32x4 acc = {0.f, 0.f, 0.f, 0.f};
#pragma unroll
                for (int ks = 0; ks < 4; ++ks) { const bf16x8 bb = *(const LAS bf16x8*)(ST + (16 * et + r) * 136 + 32 * ks + 8 * g); acc = MFMA16(aq[ks], bb, acc); }
#pragma unroll
                for (int ks = 0; ks < 2; ++ks) acc = MFMA16(am[ks], frag_tr(VS, 136, 32 * ks, 16 * et, lane), acc);
#pragma unroll
                for (int i = 0; i < 4; ++i) {
                    const int tau = 16 * tt + 4 * g + i;
                    const unsigned off = (unsigned)((DIR == 0 ? tau : 63 - tau) * ODD_IN + 16 * et + r) * 2u;
                    *(bf16_t*)(oslab + off) = (bf16_t)f2bf(acc[i]);
                }
                __builtin_amdgcn_sched_barrier(0);
            }
            float bl[4];
#pragma unroll
            for (int i = 0; i < 4; ++i) bl[i] = BLAST[16 * wave + 4 * g + i];
            bf16x8 ak[2];
#pragma unroll
            for (int ks = 0; ks < 2; ++ks) ak[ks] = *(const LAS bf16x8*)(K2 + (16 * wave + r) * 72 + 32 * ks + 8 * g);
#pragma unroll
            for (int et = 0; et < 8; ++et) {
#pragma unroll
                for (int i = 0; i < 4; ++i) st[et][i] *= bl[i];
#pragma unroll
                for (int ks = 0; ks < 2; ++ks) st[et] = MFMA16(ak[ks], frag_tr(VS, 136, 32 * ks, 16 * et, lane), st[et]);
                if (et & 1) __builtin_amdgcn_sched_barrier(0);
            }
        }
        __syncthreads();
#pragma unroll
        for (int et = 0; et < 8; ++et) { u32x2 w; w.x = pk2(st[et][0], st[et][1]); w.y = pk2(st[et][2], st[et][3]); *(LAS u32x2*)(ST + (16 * et + r) * 136 + 16 * wave + 4 * g) = w; }
    }
    __syncthreads();
}

DI void phase_readout(const Params& P, int layer_j, int wv) {
    const int tid = get_tid(wv), lane = tid & 63, wave = tid >> 6;
    const int gw = get_bid() * 8 + wave, NGW = gridDim.x * 8;
    bf16_t* p = (bf16_t*)(P.ws + WS_P);
    const float* gwt = P.od_gnorm_w + layer_j * 128 + (lane & 7) * 16;
    for (int R = gw; R < MROWS; R += NGW) {
        const bf16_t* op = p + (size_t)R * ODD_IN + 16 * lane; bf16_t* yp = p + (size_t)R * ODD_IN + 4096 + 16 * lane;
        const u32x4 o0 = *(const u32x4*)op, o1 = *(const u32x4*)(op + 8), c0 = *(const u32x4*)(op + 1024), c1 = *(const u32x4*)(op + 1032), g0 = *(const u32x4*)yp, g1 = *(const u32x4*)(yp + 8);
        float ov[16], gv[16];
        const unsigned* ow0 = (const unsigned*)&o0; const unsigned* ow1 = (const unsigned*)&o1; const unsigned* cw0 = (const unsigned*)&c0; const unsigned* cw1 = (const unsigned*)&c1;
        const unsigned* gw0 = (const unsigned*)&g0; const unsigned* gw1 = (const unsigned*)&g1;
#pragma unroll
        for (int i = 0; i < 4; ++i) {
            ov[2 * i] = __uint_as_float(ow0[i] << 16) + __uint_as_float(cw0[i] << 16); ov[2 * i + 1] = __uint_as_float(ow0[i] & 0xffff0000u) + __uint_as_float(cw0[i] & 0xffff0000u);
            ov[8 + 2 * i] = __uint_as_float(ow1[i] << 16) + __uint_as_float(cw1[i] << 16); ov[8 + 2 * i + 1] = __uint_as_float(ow1[i] & 0xffff0000u) + __uint_as_float(cw1[i] & 0xffff0000u);
            gv[2 * i] = __uint_as_float(gw0[i] << 16); gv[2 * i + 1] = __uint_as_float(gw0[i] & 0xffff0000u); gv[8 + 2 * i] = __uint_as_float(gw1[i] << 16); gv[8 + 2 * i + 1] = __uint_as_float(gw1[i] & 0xffff0000u);
        }
        float ss = 0.f;
#pragma unroll
        for (int i = 0; i < 16; ++i) ss += ov[i] * ov[i];
        ss += shfl_xor_f(ss, 1); ss += shfl_xor_f(ss, 2); ss += shfl_xor_f(ss, 4);
        const float rstd = rsqrtf(ss * (1.f / 128.f) + RMS_EPS);
        float y[16];
#pragma unroll
        for (int i = 0; i < 16; ++i) y[i] = ov[i] * rstd * gwt[i] * (gv[i] * sigm(gv[i]));
        u32x4 w0, w1;
        w0.x = pk2(y[0], y[1]); w0.y = pk2(y[2], y[3]); w0.z = pk2(y[4], y[5]); w0.w = pk2(y[6], y[7]);
        w1.x = pk2(y[8], y[9]); w1.y = pk2(y[10], y[11]); w1.z = pk2(y[12], y[13]); w1.w = pk2(y[14], y[15]);
        *(u32x4*)yp = w0; *(u32x4*)(yp + 8) = w1;
    }
}

DI void phase_final(const Params& P, int wv) {
    const int tid = get_tid(wv), lane = tid & 63, wave = tid >> 6;
    const int gw = get_bid() * 8 + wave, NGW = gridDim.x * 8;
    for (int R = gw; R < NB * SEQ; R += NGW) {
        float* row = P.out + (size_t)R * DM;
        f32x4 v[4]; float ss = 0.f;
#pragma unroll
        for (int q = 0; q < 4; ++q) { v[q] = *(const f32x4*)(row + 4 * lane + 256 * q); ss += (v[q][0] * v[q][0] + v[q][1] * v[q][1]) + (v[q][2] * v[q][2] + v[q][3] * v[q][3]); }
        const float rstd = rsqrtf(wave_sum(ss) * (1.f / DM) + RMS_EPS);
#pragma unroll
        for (int q = 0; q < 4; ++q) { const f32x4 w4 = *(const f32x4*)(P.final_norm_w + 4 * lane + 256 * q); *(f32x4*)(row + 4 * lane + 256 * q) = (v[q] * rstd) * w4; }
    }
}

#define XB_TMO      128
#define XB_XCNT(j)  (256  + 64 * (j))
#define XB_XSUB(j)  (1280 + 64 * (j))
#define XB_XGEN(j)  (2304 + 64 * (j))
#define XB_TOP      3328
#define XB_TOPGEN   3392
#define XCD_BAR_WORDS 3456
#define XB_SPIN_CAP (1u << 18)

__device__ __forceinline__ unsigned xb_ld(unsigned* p)              { return __hip_atomic_load(p, __ATOMIC_RELAXED, __HIP_MEMORY_SCOPE_AGENT); }
__device__ __forceinline__ unsigned xb_add(unsigned* p, unsigned v) { return __hip_atomic_fetch_add(p, v, __ATOMIC_RELAXED, __HIP_MEMORY_SCOPE_AGENT); }
__device__ __forceinline__ unsigned xb_xcc_id() { return (unsigned)__builtin_amdgcn_s_getreg((3 << 11) | 20) & 0xFu; }
#define XB_SPIN(cond, bar) do { unsigned _sp = 0; while (cond) { __builtin_amdgcn_s_sleep(1); \
    if ((++_sp & 255u) == 0u) { if (xb_ld(&(bar)[XB_TMO])) break; if (_sp > XB_SPIN_CAP) { atomicAdd(&(bar)[XB_TMO], 1u); break; } } } } while (0)

struct XcdBarrier {
    unsigned* bar; unsigned x;
    volatile LAS unsigned* st;
};

__device__ __forceinline__ XcdBarrier xcd_barrier_post(unsigned* bar, volatile LAS unsigned* st, int wv) {
    XcdBarrier b; b.bar = bar; b.x = xb_xcc_id(); b.st = st;
    if (get_tid(wv) == 0) (void)xb_add(&bar[XB_XCNT(b.x)], 1u);
    return b;
}
__device__ __forceinline__ void xcd_barrier_complete(unsigned* bar, unsigned x, unsigned& nloc, unsigned& nx) {
    const unsigned G = gridDim.x * gridDim.y * gridDim.z;
    unsigned sum, cnt, mine, sp = 0u;
    for (;;) {
        sum = 0u; cnt = 0u; mine = 0u;
#pragma unroll
        for (unsigned j = 0; j < 16; ++j) { const unsigned c = xb_ld(&bar[XB_XCNT(j)]); sum += c; cnt += (c > 0u) ? 1u : 0u; mine = (j == x) ? c : mine; }
        if (sum == G) break;
        __builtin_amdgcn_s_sleep(1);
        if ((++sp & 255u) == 0u) { if (xb_ld(&bar[XB_TMO])) break; if (sp > XB_SPIN_CAP) { atomicAdd(&bar[XB_TMO], 1u); break; } }
    }
    nloc = mine > 0u ? mine : 1u; nx = cnt > 0u ? cnt : 1u;
}

__device__ __forceinline__ void xcd_barrier(const XcdBarrier& b, int wv) {
    asm volatile("s_waitcnt vmcnt(0)" ::: "memory");
    __syncthreads();
    if (get_tid(wv) == 0) {
        unsigned* bar = b.bar;
        __builtin_amdgcn_s_waitcnt(0);
        unsigned nloc = b.st[0], nx = b.st[1];
        if (nloc == 0u) { xcd_barrier_complete(bar, b.x, nloc, nx); b.st[0] = nloc; b.st[1] = nx; }
        const unsigned old = xb_add(&bar[XB_XSUB(b.x)], 1u);
        const unsigned gen = old / nloc;
        if (old + 1u == (gen + 1u) * nloc) {
            __builtin_amdgcn_fence(__ATOMIC_RELEASE, "agent");
            asm volatile("s_waitcnt vmcnt(0)" ::: "memory");
            const unsigned og = xb_add(&bar[XB_TOP], 1u);
            const unsigned tg = og / nx;
            if (og + 1u == (tg + 1u) * nx) xb_add(&bar[XB_TOPGEN], 1u);
            else XB_SPIN(xb_ld(&bar[XB_TOPGEN]) == tg, bar);
            __builtin_amdgcn_fence(__ATOMIC_ACQUIRE, "agent");
            xb_add(&bar[XB_XGEN(b.x)], 1u);
            asm volatile("s_waitcnt vmcnt(0)" ::: "memory");
        } else {
            XB_SPIN(xb_ld(&bar[XB_XGEN(b.x)]) == gen, bar);
            __builtin_amdgcn_fence(__ATOMIC_ACQUIRE, "agent");
            asm volatile("s_waitcnt vmcnt(0)" ::: "memory");
        }
    }
    __syncthreads();
}

constexpr int PARAM_OFF = LDS_BYTES - 256;
static_assert(G2_END <= PARAM_OFF && sizeof(Params) <= 208, "LDS map");
DI const float* ld_uptr(const LAS unsigned long long* s, int i) {
    const unsigned long long v = s[i];
    const unsigned lo = __builtin_amdgcn_readfirstlane((unsigned)v), hi = __builtin_amdgcn_readfirstlane((unsigned)(v >> 32));
    return (const float*)(const __attribute__((address_space(1))) float*)(((unsigned long long)hi << 32) | lo);
}
DI Params load_params(LAS unsigned char* lds) {
    LAS unsigned char* pb = lds + PARAM_OFF; asm volatile("" : "+v"(pb));
    const LAS unsigned long long* s = (const LAS unsigned long long*)pb;
    Params Q;
    Q.x = ld_uptr(s, 0); Q.c = ld_uptr(s, 1); Q.ctx = ld_uptr(s, 2); Q.c_ctx = ld_uptr(s, 3); Q.ada_w = ld_uptr(s, 4); Q.ada_b = ld_uptr(s, 5); Q.norm_w = ld_uptr(s, 6);
    Q.ev_w_in = ld_uptr(s, 7); Q.ev_conv_w = ld_uptr(s, 8); Q.ev_conv_b = ld_uptr(s, 9); Q.ev_rg_wx = ld_uptr(s, 10); Q.ev_rg_bx = ld_uptr(s, 11); Q.ev_rg_wa = ld_uptr(s, 12);
    Q.ev_rg_ba = ld_uptr(s, 13); Q.ev_rg_lambda = ld_uptr(s, 14); Q.ev_sink = ld_uptr(s, 15); Q.ev_w_out = ld_uptr(s, 16); Q.od_w_in = ld_uptr(s, 17); Q.od_lb_raw = ld_uptr(s, 18);
    Q.od_gnorm_w = ld_uptr(s, 19); Q.od_w_out = ld_uptr(s, 20); Q.final_norm_w = ld_uptr(s, 21); Q.out = (float*)ld_uptr(s, 22); Q.ws = (unsigned char*)ld_uptr(s, 23);
    Q.ph_lo = 0; Q.ph_hi = 0;
    return Q;
}
DI void run_phase(LAS unsigned char* lds, int ph, int wv) {
    #ifndef PHMASK
#define PHMASK 0xffff
#endif
    if (ph == 0) { if (PHMASK & 1) { const Params P = load_params(lds); phase_pro(P, lds, wv); } return; }
    if (ph == NPHASE - 1) { if (PHMASK & 2) { const Params P = load_params(lds); phase_final(P, wv); } return; }
    const int layer = (ph - 1) / 5, sub = (ph - 1) % 5, j = layer >> 1;
    const bool even = (layer & 1) == 0;
    if (sub == 0) { if (PHMASK & 4) { const Params P = load_params(lds); phase_norm(P, lds, layer, wv); } return; }
    if (sub == 1) {
        const Params P = load_params(lds); bf16_t* pbuf = (bf16_t*)(P.ws + WS_P);
        const int N = even ? EVEN_IN : ODD_IN;
        pg8::Gemm gm{(const bf16_t*)(P.ws + WS_OV), (const bf16_t*)(P.ws + WS_WIN), MROWS, N, 1024, 1024};
        pg8::StaticOrder S; S.init(MROWS, N, (int)gridDim.x, get_bid());
        EpiStoreBf16 E{pbuf, N};
        if (PHMASK & 8) pg8::gemm_phase<EpiStoreBf16, pg8::StaticOrder, true, true>(lds, gm, S, E, wv);
        return;
    }
    if (sub == 2) {
        const Params P = load_params(lds);
        if (even) {
            constexpr int NRG = NB * NCHUNK * 8;
            for (int it = get_bid(); it < NRG + 576; it += gridDim.x) {
                if (it < NRG) { if (PHMASK & 32) rglru_item(P, lds, j, it, wv); } else { if (PHMASK & 16) attn_item(P, lds, j, it - NRG, wv); }
            }
        } else {
            for (int it = get_bid(); it < 128; it += gridDim.x) { if (PHMASK & 64) { if (it & 1) gla2_item<1>(P, lds, j, it >> 4, (it >> 1) & 7, wv); else gla2_item<0>(P, lds, j, it >> 4, (it >> 1) & 7, wv); } }
        }
        return;
    }
    if (sub == 3) {
        const Params P = load_params(lds);
        if (!even) { if (PHMASK & 256) phase_readout(P, j, wv); }
        return;
    }
    {
        const Params P = load_params(lds); bf16_t* pbuf = (bf16_t*)(P.ws + WS_P);
        const int K = even ? 2048 : 1024, lda = even ? EVEN_IN : ODD_IN;
        pg8::Gemm gm{pbuf + (even ? 1536 : 4096), (const bf16_t*)(P.ws + WS_WOUT), MROWS, 1024, K, lda};
        pg8::StaticOrder S; S.init(MROWS, 1024, (int)gridDim.x, get_bid());
        const float* hl = layer == 0 ? P.x : P.out; const float* hc = layer == 0 ? P.ctx : (const float*)(P.ws + WS_HCTX);
        EpiResid E{hl, hc, P.out, (float*)(P.ws + WS_HCTX), (const float*)(P.ws + WS_MOD) + (size_t)layer * 9 * 3072 + 2048};
        if (PHMASK & 512) pg8::gemm_phase<EpiResid, pg8::StaticOrder, true, true>(lds, gm, S, E, wv);
    }
}

__global__ void __launch_bounds__(512, 2) mega(Params P) {
    extern __shared__ __attribute__((aligned(16))) unsigned char lds_raw[];
    LAS unsigned char* lds = (LAS unsigned char*)lds_raw;
    cg::grid_group grid = cg::this_grid();
    const int wv = __builtin_amdgcn_readfirstlane((int)(threadIdx.x >> 6));
    if (get_tid(wv) == 0) {
        ((LAS unsigned*)(lds + PARAM_OFF + 208))[0] = 0u; ((LAS unsigned*)(lds + PARAM_OFF + 208))[1] = 0u;
        LAS unsigned long long* d = (LAS unsigned long long*)(lds + PARAM_OFF);
        d[0] = (unsigned long long)P.x; d[1] = (unsigned long long)P.c; d[2] = (unsigned long long)P.ctx; d[3] = (unsigned long long)P.c_ctx; d[4] = (unsigned long long)P.ada_w;
        d[5] = (unsigned long long)P.ada_b; d[6] = (unsigned long long)P.norm_w; d[7] = (unsigned long long)P.ev_w_in; d[8] = (unsigned long long)P.ev_conv_w; d[9] = (unsigned long long)P.ev_conv_b;
        d[10] = (unsigned long long)P.ev_rg_wx; d[11] = (unsigned long long)P.ev_rg_bx; d[12] = (unsigned long long)P.ev_rg_wa; d[13] = (unsigned long long)P.ev_rg_ba; d[14] = (unsigned long long)P.ev_rg_lambda;
        d[15] = (unsigned long long)P.ev_sink; d[16] = (unsigned long long)P.ev_w_out; d[17] = (unsigned long long)P.od_w_in; d[18] = (unsigned long long)P.od_lb_raw; d[19] = (unsigned long long)P.od_gnorm_w;
        d[20] = (unsigned long long)P.od_w_out; d[21] = (unsigned long long)P.final_norm_w; d[22] = (unsigned long long)P.out; d[23] = (unsigned long long)P.ws;
    }
    __syncthreads();
    const int ph_lo = P.ph_lo, ph_hi = P.ph_hi;
    (void)xcd_barrier_post((unsigned*)(P.ws + WS_CTL) + 4096, (volatile LAS unsigned*)(lds + PARAM_OFF + 208), wv);
#define GRID_SYNC(first) do { if (first) grid.sync(); else { XcdBarrier xb_; xb_.bar = (unsigned*)(load_params(lds).ws + WS_CTL) + 4096; xb_.x = xb_xcc_id(); xb_.st = (volatile LAS unsigned*)(lds + PARAM_OFF + 208); xcd_barrier(xb_, wv); } } while (0)
#if defined(PROBE_S)
    constexpr int PREP = PROBE_E - PROBE_S + 1;
#pragma unroll 1
    for (int seq = ph_lo; seq < ph_hi + PREP; ++seq) {
        if (seq > ph_lo) GRID_SYNC(seq == ph_lo + 1);
        const int ph = seq <= PROBE_E ? seq : seq - PREP;
        run_phase(lds, ph, wv);
    }
#else
#pragma unroll 1
    for (int ph = ph_lo; ph < ph_hi; ++ph) {
        if (ph >= 1 && ph < NPHASE - 1 && (ph - 1) % 5 == 3 && (((ph - 1) / 5) & 1) == 0) continue;
        if (ph > ph_lo) GRID_SYNC(ph == ph_lo + 1);
        run_phase(lds, ph, wv);
    }
#endif
}

extern "C" void kernel_launch(void* const* d_in, const int* in_sizes, int n_in, void* d_out, int out_size, void* d_ws, size_t ws_size, hipStream_t stream) {
    static int grid = 0;
    if (grid == 0) {
        if (n_in != 22 || ws_size < WS_END) { fprintf(stderr, "kernel_launch: unexpected inputs (n_in %d, ws %zu)\n", n_in, ws_size); grid = -1; return; }
        int dev = 0, cus = 0, per_cu = 0;
        hipGetDevice(&dev);
        hipDeviceGetAttribute(&cus, hipDeviceAttributeMultiprocessorCount, dev);
        if (hipFuncSetAttribute((const void*)mega, hipFuncAttributeMaxDynamicSharedMemorySize, LDS_BYTES) != hipSuccess) { fprintf(stderr, "kernel_launch: hipFuncSetAttribute failed\n"); grid = -1; return; }
        if (hipOccupancyMaxActiveBlocksPerMultiprocessor(&per_cu, (const void*)mega, 512, LDS_BYTES) != hipSuccess || per_cu < 1) { fprintf(stderr, "kernel_launch: occupancy query gives %d\n", per_cu); per_cu = 1; }
        (void)hipGetLastError();
        grid = cus;
    }
    if (grid < 0) return;
    if (hipMemsetAsync((char*)d_ws + WS_CTL, 0, 65536, stream) != hipSuccess) { fprintf(stderr, "kernel_launch: memset failed\n"); return; }
    Params P{};
    const float** pp = (const float**)&P;
    for (int i = 0; i < 22; ++i) pp[i] = (const float*)d_in[i];
    P.out = (float*)d_out; P.ws = (unsigned char*)d_ws;
#if ONE_LAUNCH
    P.ph_lo = 0; P.ph_hi = NPHASE;
    { void* args[] = {&P}; hipError_t e = hipLaunchCooperativeKernel((const void*)mega, dim3(grid), dim3(512), args, LDS_BYTES, stream);
      if (e != hipSuccess) fprintf(stderr, "cooperative launch failed: %s (grid %d)\n", hipGetErrorString(e), grid); }
#else
    for (int ph = 0; ph < NPHASE; ++ph) {
        P.ph_lo = ph; P.ph_hi = ph + 1;
        void* args[] = {&P}; hipError_t e = hipLaunchCooperativeKernel((const void*)mega, dim3(grid), dim3(512), args, LDS_BYTES, stream);
        if (e != hipSuccess) { fprintf(stderr, "launch %d failed: %s (grid %d)\n", ph, hipGetErrorString(e), grid); break; }
    }
#endif
}
```

```cpp
#include <hip/hip_runtime.h>
#include <hip/hip_cooperative_groups.h>
#include <cstdio>
#include <cstdint>
namespace cg = cooperative_groups;

#ifndef ONE_LAUNCH
#define ONE_LAUNCH 1
#endif

#define DI __device__ __forceinline__
#define LAS __attribute__((address_space(3)))
__device__ __forceinline__ int lane_nh() { int l; asm volatile("v_mbcnt_lo_u32_b32 %0, -1, 0\n\tv_mbcnt_hi_u32_b32 %0, -1, %0" : "=v"(l)); return l; }
__device__ __forceinline__ int get_tid(int wv) { asm volatile("" : "+s"(wv)); return wv * 64 + lane_nh(); }
__device__ __forceinline__ float shfl_xor_f(float v, int o) { return __int_as_float(__builtin_amdgcn_ds_bpermute((lane_nh() ^ o) << 2, __float_as_int(v))); }
__device__ __forceinline__ int get_bid() { int b = blockIdx.x; asm volatile("" : "+s"(b)); return b; }
namespace pg8 {
#define PG8_LAS __attribute__((address_space(3)))
typedef unsigned short bf16_t;
typedef short bf16x8 __attribute__((ext_vector_type(8)));
typedef float f32x4 __attribute__((ext_vector_type(4)));
typedef unsigned u32x4 __attribute__((ext_vector_type(4)));
constexpr int BM = 256, BK = 64, HALF = 128, HTB = HALF * BK * 2  , STAGE_BYTES = 8 * HTB, NXCD = 8, WGM = 8;

__host__ __device__ __forceinline__ int lds_byte(int r, int c) { const int st = (r >> 4) * 2 + (c >> 5), rr = r & 15, cc = c & 31, ob = rr * 64 + cc * 2; return st * 1024 + (ob ^ (((ob >> 9) & 1) << 5)); }
__host__ __device__ __forceinline__ void stage_rc(int b, int& R, int& C) { const int st = b / 1024, sb = b % 1024, swz = sb ^ (((sb >> 9) & 1) << 5); R = (st >> 1) * 16 + swz / 64; C = (st & 1) * 32 + (swz % 64) / 2; }
__host__ __device__ __forceinline__ int perm32(int rho) { const int n = rho >> 4, i = rho & 15; return 8 * (i >> 2) + 4 * n + (i & 3); }

struct Unit { int pm, pn; };
struct Gemm { const bf16_t* A; const bf16_t* Bt; int M, N, K, lda; };

struct StaticOrder {
    int nM, nN, nwg, G, c;
    __host__ __device__ void init(int M, int N, int G_, int c_) { nM = M / BM; nN = N / BM; nwg = nM * nN; G = G_; c = c_; }
    __host__ __device__ bool next(int i, Unit& u) const {
        const long L = (long)i * G + c; if (L >= nwg) return false;
        int wgid = (int)L; { const int q = nwg / NXCD, r = nwg % NXCD, xcd = wgid % NXCD, off = wgid / NXCD; wgid = (xcd < r ? xcd * (q + 1) : r * (q + 1) + (xcd - r) * q) + off; }
        const int nig = WGM * nN, gid = wgid / nig, fm = gid * WGM, gsz = (nM - fm) < WGM ? (nM - fm) : WGM;
        u.pm = fm + ((wgid % nig) % gsz); u.pn = (wgid % nig) / gsz; return true;
    }
    __device__ __forceinline__ void a_ready(const Unit&) const {}
    __device__ __forceinline__ void done(const Unit&) const {}
};

template <class Epi, class Sched, bool ALIGN_EPI = false, bool SP2 = false>
__device__ __forceinline__ void gemm_phase(PG8_LAS unsigned char* lds, const Gemm g, const Sched& S, const Epi& E, int wv) {
    const int tid = get_tid(wv), wid = __builtin_amdgcn_readfirstlane(tid >> 6), lane = tid & 63, wr = wid >> 2, wc = wid & 3, fr = lane & 15, fq = lane >> 4;
    const int K = g.K, nt = K / BK;
    unsigned voffA[2], voffB[2];
#pragma unroll
    for (int i = 0; i < 2; ++i) { int R, C; stage_rc(tid * 16 + i * 8192, R, C); const int Rb = Epi::PERM ? ((R & ~31) + perm32(R & 31)) : R;
        voffA[i] = (unsigned)(R * g.lda + C) * 2u; voffB[i] = (unsigned)(Rb * K + C) * 2u; }
    const size_t kstep = (size_t)(BK * 2);
    const size_t hstepA = (size_t)HALF * g.lda * 2, hstepB = (size_t)HALF * K * 2;
    const size_t tstepA = 2 * hstepA, tstepB = 2 * hstepB;
    const unsigned ldsw = (unsigned)wid * 1024u;
    const int aoff = lds_byte(wr * 64 + fr, fq * 8), boff = lds_byte(wc * 32 + fr, fq * 8);
#define PG8_SA(b, h) (((b) * 2 + (h)) * HTB)
#define PG8_SB(b, h) ((4 + (b) * 2 + (h)) * HTB)
#define PG8_STAGE(bufoff, gbase, voff) do { _Pragma("unroll") for (int _i = 0; _i < 2; ++_i) \
        __builtin_amdgcn_global_load_lds((const unsigned*)((const char*)(gbase) + (voff)[_i]), (PG8_LAS unsigned*)(lds + (bufoff) + ldsw + _i * 8192), 16, 0, 0); } while (0)
#define PG8_LDA(dst, b, h) do { _Pragma("unroll") for (int m = 0; m < 4; ++m) _Pragma("unroll") for (int k = 0; k < 2; ++k) dst[m][k] = *(const PG8_LAS bf16x8*)(lds + PG8_SA(b, h) + aoff + m * 2048 + k * 1024); } while (0)
#define PG8_LDB(dst, b, h) do { _Pragma("unroll") for (int n = 0; n < 2; ++n) _Pragma("unroll") for (int k = 0; k < 2; ++k) dst[n][k] = *(const PG8_LAS bf16x8*)(lds + PG8_SB(b, h) + boff + n * 2048 + k * 1024); } while (0)
#define PG8_MMA(ai, bj, At, Bt) do { __builtin_amdgcn_s_setprio(1); _Pragma("unroll") for (int m = 0; m < 4; ++m) _Pragma("unroll") for (int n = 0; n < 2; ++n) _Pragma("unroll") for (int k = 0; k < 2; ++k) \
        acc[ai][bj][m][n] = __builtin_amdgcn_mfma_f32_16x16x32_bf16(Bt[n][k], At[m][k], acc[ai][bj][m][n], 0, 0, 0); __builtin_amdgcn_s_setprio(0); } while (0)
#define PG8_WAIT_V(n) asm volatile("s_waitcnt vmcnt(" #n ")" ::: "memory")
#define PG8_WAIT_L(n) asm volatile("s_waitcnt lgkmcnt(" #n ")" ::: "memory")
#define PG8_BAR __builtin_amdgcn_s_barrier()
#define PG8_SCHED __builtin_amdgcn_sched_barrier(0)
    Unit cur, nxt; int ui = 0;
    if (!S.next(0, cur)) return;
    f32x4 acc[2][2][4][2];
#pragma unroll
    for (int a = 0; a < 2; ++a)
#pragma unroll
        for (int b = 0; b < 2; ++b)
#pragma unroll
            for (int m = 0; m < 4; ++m)
#pragma unroll
                for (int n = 0; n < 2; ++n) acc[a][b][m][n] = (f32x4){0.f, 0.f, 0.f, 0.f};
    bf16x8 At[4][2], B0[2][2], B1[2][2];
    const char* cA = (const char*)g.A + (size_t)cur.pm * tstepA; const char* cB = (const char*)g.Bt + (size_t)cur.pn * tstepB;
    S.a_ready(cur);
    if constexpr (SP2) {
        PG8_STAGE(PG8_SB(0, 0), cB, voffB); PG8_STAGE(PG8_SB(0, 1), cB + hstepB, voffB); PG8_STAGE(PG8_SA(0, 0), cA, voffA); PG8_STAGE(PG8_SA(0, 1), cA + hstepA, voffA);
        if (wr == 1) PG8_BAR;
        PG8_WAIT_V(2); PG8_BAR;
        PG8_STAGE(PG8_SB(1, 0), cB + kstep, voffB); PG8_STAGE(PG8_SA(1, 0), cA + kstep, voffA); PG8_STAGE(PG8_SB(1, 1), cB + hstepB + kstep, voffB);
        PG8_WAIT_V(6); PG8_BAR;
    } else {
        PG8_STAGE(PG8_SB(0, 0), cB, voffB); PG8_STAGE(PG8_SA(0, 0), cA, voffA); PG8_STAGE(PG8_SB(0, 1), cB + hstepB, voffB); PG8_STAGE(PG8_SA(0, 1), cA + hstepA, voffA);
        if (wr == 1) PG8_BAR;
        PG8_WAIT_V(4); PG8_BAR;
        PG8_STAGE(PG8_SB(1, 0), cB + kstep, voffB); PG8_STAGE(PG8_SA(1, 0), cA + kstep, voffA); PG8_STAGE(PG8_SB(1, 1), cB + hstepB + kstep, voffB);
        PG8_WAIT_V(6); PG8_BAR;
    }
    for (;;) {
        const bool has_next = S.next(ui + 1, nxt);
        const char* nA = has_next ? (const char*)g.A + (size_t)nxt.pm * tstepA : cA; const char* nB = has_next ? (const char*)g.Bt + (size_t)nxt.pn * tstepB : cB;
        for (int t = 0; t < nt; t += 2) {
            const bool last = (t == nt - 2);
            const char* a1 = cA + (size_t)(t + 1) * kstep;
            const char* a2 = last ? nA : cA + (size_t)(t + 2) * kstep; const char* b2 = last ? nB : cB + (size_t)(t + 2) * kstep;
            const char* a3 = a2 + kstep; const char* b3 = b2 + kstep;
            if (last && has_next) S.a_ready(nxt);
            if constexpr (SP2) {
            PG8_LDB(B0, 0, 0); PG8_LDB(B1, 0, 1); PG8_SCHED; PG8_LDA(At, 0, 0); PG8_STAGE(PG8_SA(1, 1), a1 + hstepA, voffA);
            PG8_WAIT_V(8); PG8_WAIT_L(0); PG8_BAR; PG8_MMA(0, 0, At, B0); PG8_MMA(0, 1, At, B1); PG8_BAR; PG8_SCHED;
            PG8_LDA(At, 0, 1); PG8_STAGE(PG8_SB(0, 0), b2, voffB); PG8_STAGE(PG8_SB(0, 1), b2 + hstepB, voffB); PG8_STAGE(PG8_SA(0, 0), a2, voffA);
            PG8_WAIT_V(8); PG8_WAIT_L(0); PG8_BAR; PG8_MMA(1, 0, At, B0); PG8_MMA(1, 1, At, B1); PG8_BAR; PG8_SCHED;
            PG8_LDB(B0, 1, 0); PG8_LDB(B1, 1, 1); PG8_SCHED; PG8_LDA(At, 1, 0); PG8_STAGE(PG8_SA(0, 1), a2 + hstepA, voffA);
            PG8_WAIT_V(8); PG8_WAIT_L(0); PG8_BAR; PG8_MMA(0, 0, At, B0); PG8_MMA(0, 1, At, B1); PG8_BAR; PG8_SCHED;
            PG8_LDA(At, 1, 1); PG8_STAGE(PG8_SB(1, 0), b3, voffB); PG8_STAGE(PG8_SB(1, 1), b3 + hstepB, voffB); PG8_STAGE(PG8_SA(1, 0), a3, voffA);
            PG8_WAIT_V(8); PG8_WAIT_L(0); PG8_BAR; PG8_MMA(1, 0, At, B0); PG8_MMA(1, 1, At, B1); PG8_BAR; PG8_SCHED;
            } else {
            PG8_LDB(B0, 0, 0); PG8_SCHED; PG8_LDA(At, 0, 0); PG8_STAGE(PG8_SA(1, 1), a1 + hstepA, voffA);
            PG8_WAIT_L(8); PG8_BAR; PG8_WAIT_L(0); PG8_MMA(0, 0, At, B0); PG8_BAR; PG8_SCHED;
            PG8_LDB(B1, 0, 1); PG8_STAGE(PG8_SB(0, 0), b2, voffB);
            PG8_BAR; PG8_WAIT_L(0); PG8_MMA(0, 1, At, B1); PG8_BAR;
            PG8_LDA(At, 0, 1); PG8_STAGE(PG8_SA(0, 0), a2, voffA);
            PG8_BAR; PG8_WAIT_L(0); PG8_MMA(1, 0, At, B0); PG8_BAR; PG8_SCHED;
            PG8_STAGE(PG8_SB(0, 1), b2 + hstepB, voffB);
            PG8_WAIT_V(6); PG8_BAR; PG8_MMA(1, 1, At, B1); PG8_BAR;
            PG8_LDB(B0, 1, 0); PG8_SCHED; PG8_LDA(At, 1, 0); PG8_STAGE(PG8_SA(0, 1), a2 + hstepA, voffA);
            PG8_WAIT_L(8); PG8_BAR; PG8_WAIT_L(0); PG8_MMA(0, 0, At, B0); PG8_BAR; PG8_SCHED;
            PG8_LDB(B1, 1, 1); PG8_STAGE(PG8_SB(1, 0), b3, voffB);
            PG8_BAR; PG8_WAIT_L(0); PG8_MMA(0, 1, At, B1); PG8_BAR;
            PG8_LDA(At, 1, 1); PG8_STAGE(PG8_SA(1, 0), a3, voffA);
            PG8_BAR; PG8_WAIT_L(0); PG8_MMA(1, 0, At, B0); PG8_BAR; PG8_SCHED;
            PG8_STAGE(PG8_SB(1, 1), b3 + hstepB, voffB);
            PG8_WAIT_V(6); PG8_BAR; PG8_MMA(1, 1, At, B1); PG8_BAR;
            }
        }
        if constexpr (ALIGN_EPI) { if (wr == 0) PG8_BAR; }
        if constexpr (!Epi::AFTER_DRAIN) { E(acc, cur, wr, wc, fr, fq); S.done(cur); }
        if (!has_next) break;
#pragma unroll
        for (int a = 0; a < 2; ++a)
#pragma unroll
            for (int b = 0; b < 2; ++b)
#pragma unroll
                for (int m = 0; m < 4; ++m)
#pragma unroll
                    for (int n = 0; n < 2; ++n) acc[a][b][m][n] = (f32x4){0.f, 0.f, 0.f, 0.f};
        cur = nxt; cA = nA; cB = nB; ++ui;
        if constexpr (ALIGN_EPI) { if (wr == 1) PG8_BAR; }
    }
    PG8_WAIT_V(0);
    if constexpr (!ALIGN_EPI) { if (wr == 0) PG8_BAR; }
    PG8_BAR;
    if constexpr (Epi::AFTER_DRAIN) { E.fused(acc, cur, wr, wc, fr, fq, lds, wid, lane); S.done(cur); }
#undef PG8_SA
#undef PG8_SB
#undef PG8_STAGE
#undef PG8_LDA
#undef PG8_LDB
#undef PG8_MMA
#undef PG8_WAIT_V
#undef PG8_WAIT_L
#undef PG8_BAR
#undef PG8_SCHED
}
}

typedef unsigned short bf16_t;
typedef short bf16x8 __attribute__((ext_vector_type(8)));
typedef short s16x4 __attribute__((ext_vector_type(4)));
typedef float f32x4 __attribute__((ext_vector_type(4)));
typedef float f32x16 __attribute__((ext_vector_type(16)));
typedef unsigned u32x4 __attribute__((ext_vector_type(4)));
typedef unsigned u32x2 __attribute__((ext_vector_type(2)));
typedef float f32x2 __attribute__((ext_vector_type(2)));

constexpr int DM = 1024, NB = 8, SEQ = 2048, CTXL = 256, LT = SEQ + CTXL  , MROWS = NB * LT  ;
constexpr int EVEN_IN = 4608, ODD_IN = 5120, NCHUNK = LT / 64  ;
constexpr float RMS_EPS = 1e-6f, LOG2E = 1.4426950408889634f;
constexpr int LDS_BYTES = 160 * 1024;
constexpr int NPHASE = 22;

constexpr size_t WS_CTL = 0;
constexpr size_t WS_MOD = 65536;
constexpr size_t WS_ROPE = 524288;
constexpr size_t WS_AGG = 1048576;
constexpr size_t WS_HCTX = WS_AGG + 4718592;
constexpr size_t WS_WIN = WS_HCTX + 8388608;
constexpr size_t WS_WOUT = WS_WIN + 10485760;
constexpr size_t WS_WRG = WS_WOUT + 4194304;
constexpr size_t WS_OV = WS_WRG + 1048576;
constexpr size_t WS_P = WS_OV + 37748736;
constexpr size_t WS_END = WS_P + 188743680;
static_assert(WS_END <= 268435456, "workspace map exceeds 256 MiB");

struct Params {
    const float *x, *c, *ctx, *c_ctx, *ada_w, *ada_b, *norm_w, *ev_w_in, *ev_conv_w, *ev_conv_b, *ev_rg_wx, *ev_rg_bx, *ev_rg_wa, *ev_rg_ba,
        *ev_rg_lambda, *ev_sink, *ev_w_out, *od_w_in, *od_lb_raw, *od_gnorm_w, *od_w_out, *final_norm_w;
    float* out; unsigned char* ws; int ph_lo, ph_hi;
};

DI float bf2f(unsigned short v) { return __uint_as_float((unsigned)v << 16); }
DI unsigned f2bf(float f) { unsigned u = __float_as_uint(f); return (u + 0x7fffu + ((u >> 16) & 1u)) >> 16; }
DI unsigned pk2(float lo, float hi) { return f2bf(lo) | (f2bf(hi) << 16); }
DI float sigm(float x) { return __builtin_amdgcn_rcpf(1.f + __expf(-x)); }
DI float softplus_neg(float lam) {
    const float e = __expf(-lam);
    return e < 0.06f ? e * (1.f + e * (-0.5f + e * (0.33333333f + e * (-0.25f + e * 0.2f)))) : __logf(1.f + e);
}
DI float neg_expm1(float x) {
    return x > -0.25f ? -x * (1.f + x * (0.5f + x * (0.16666667f + x * (0.041666668f + x * (0.0083333338f + x * 0.0013888889f))))) : 1.f - __expf(x);
}
DI float wave_sum(float v) {
#pragma unroll
    for (int o = 1; o < 64; o <<= 1) v += shfl_xor_f(v, o);
    return v;
}
DI int crow(int reg, int h) { return (reg & 3) + 8 * (reg >> 2) + 4 * h; }
#define MFMA16(a, b, c) __builtin_amdgcn_mfma_f32_16x16x32_bf16((a), (b), (c), 0, 0, 0)
#define MFMA32(a, b, c) __builtin_amdgcn_mfma_f32_32x32x16_bf16((a), (b), (c), 0, 0, 0)

struct EpiStoreBf16 {
    static constexpr bool PERM = true, AFTER_DRAIN = false;
    bf16_t* O; int ldc;
    DI void operator()(const f32x4 (&acc)[2][2][4][2], const pg8::Unit& u, int wr, int wc, int fr, int fq) const {
        const int row0 = u.pm * 256 + wr * 64 + fr, col0 = u.pn * 256 + wc * 32 + 8 * fq;
#pragma unroll
        for (int ai = 0; ai < 2; ++ai)
#pragma unroll
            for (int m = 0; m < 4; ++m) { bf16_t* rowp = O + (size_t)(row0 + ai * 128 + m * 16) * ldc + col0;
#pragma unroll
                for (int bj = 0; bj < 2; ++bj) { const f32x4 v0 = acc[ai][bj][m][0], v1 = acc[ai][bj][m][1];
                    u32x4 w; w.x = pk2(v0[0], v0[1]); w.y = pk2(v0[2], v0[3]); w.z = pk2(v1[0], v1[1]); w.w = pk2(v1[2], v1[3]);
                    *(u32x4*)(rowp + bj * 128) = w; } }
    }
};
struct EpiResid {
    static constexpr bool PERM = false, AFTER_DRAIN = false;
    const float* in_lat; const float* in_ctx; float* out_lat; float* out_ctx; const float* gate;
    DI void operator()(const f32x4 (&acc)[2][2][4][2], const pg8::Unit& u, int wr, int wc, int fr, int fq) const {
        const int b = u.pm / 9, jt = u.pm % 9;
        const float* ib; float* ob; const float* g;
        if (jt == 0) { const size_t off = (size_t)b * CTXL * DM; ib = in_ctx + off; ob = out_ctx + off; g = gate + 8 * 3072; }
        else { const size_t off = ((size_t)b * SEQ + (size_t)(jt - 1) * 256) * DM; ib = in_lat + off; ob = out_lat + off; g = gate + b * 3072; }
        const int col0 = u.pn * 256 + wc * 32 + 4 * fq;
#pragma unroll
        for (int bj = 0; bj < 2; ++bj)
#pragma unroll
            for (int n = 0; n < 2; ++n) {
                const f32x4 gvv = *(const f32x4*)(g + col0 + bj * 128 + n * 16);
#pragma unroll
                for (int ai = 0; ai < 2; ++ai) {
#pragma unroll
                    for (int m = 0; m < 4; ++m) { const int r = ai * 128 + wr * 64 + m * 16 + fr;
                        const size_t off = (size_t)r * DM + col0 + bj * 128 + n * 16;
                        const f32x4 o = *(const f32x4*)(ib + off) + gvv * acc[ai][bj][m][n]; *(f32x4*)(ob + off) = o; }
                    asm volatile("" ::: "memory");
                }
            }
    }
};

DI void phase_pro(const Params& P, LAS unsigned char* lds, int wv) {
    const int tid = get_tid(wv);
    LAS float* s = (LAS float*)lds;
    LAS float* red = (LAS float*)(lds + 36864);
    float* mod = (float*)(P.ws + WS_MOD);
    for (int i = tid; i < 9 * 1024; i += 512) { const int r = i >> 10, k = i & 1023; const float v = r < 8 ? P.c[r * 1024 + k] : P.c_ctx[k]; s[i] = v * sigm(v); }
    __syncthreads();
    for (int item = get_bid(); item < 384; item += gridDim.x) {
        const int l = item / 96, n0 = (item % 96) * 32, ks = tid >> 5, col = tid & 31;
        const float* w = P.ada_w + (size_t)l * 1024 * 3072 + n0 + col;
        float acc[9];
#pragma unroll
        for (int r = 0; r < 9; ++r) acc[r] = 0.f;
#pragma unroll 8
        for (int kk = 0; kk < 64; ++kk) { const int k = ks * 64 + kk; const float wv = w[(size_t)k * 3072];
#pragma unroll
            for (int r = 0; r < 9; ++r) acc[r] += s[r * 1024 + k] * wv; }
#pragma unroll
        for (int r = 0; r < 9; ++r) red[(ks * 9 + r) * 32 + col] = acc[r];
        __syncthreads();
        if (tid < 288) { const int r = tid >> 5, cc = tid & 31; float sum = 0.f;
#pragma unroll
            for (int k2 = 0; k2 < 16; ++k2) sum += red[(k2 * 9 + r) * 32 + cc];
            mod[(l * 9 + r) * 3072 + n0 + cc] = sum + P.ada_b[l * 3072 + n0 + cc]; }
        __syncthreads();
    }
    float* cos_t = (float*)(P.ws + WS_ROPE); float* sin_t = cos_t + SEQ * 32;
    for (int i = get_bid() * 512 + tid; i < SEQ * 32; i += gridDim.x * 512) {
        const int pos = i >> 5, jj = i & 31, fi = jj & 15;
        const float inv = __builtin_amdgcn_exp2f(-(float)(2 * fi) * (13.287712379549449f / 32.f));
        const float ang = (float)(jj < 16 ? (pos >> 6) : (pos & 63)) * inv;
        cos_t[i] = __cosf(ang); sin_t[i] = __sinf(ang);
    }
}

DI void transpose_item(const float* W, int K, int N, bf16_t* WT, LAS float* scr, int item, int lane) {
    const int nblk = N / 32, kb = item / nblk, nb = item % nblk, k0 = 64 * kb, n0 = 32 * nb;
#pragma unroll 8
    for (int i = 0; i < 32; ++i) { const int kk = 2 * i + (lane >> 5); scr[kk * 33 + (lane & 31)] = W[(size_t)(k0 + kk) * N + n0 + (lane & 31)]; }
    asm volatile("s_waitcnt lgkmcnt(0)" ::: "memory");
    const int c = lane & 7;
#pragma unroll
    for (int j = 0; j < 4; ++j) { const int n = (lane >> 3) + 8 * j; const LAS float* sp = scr + (8 * c) * 33 + n;
        u32x4 o; o.x = pk2(sp[0 * 33], sp[1 * 33]); o.y = pk2(sp[2 * 33], sp[3 * 33]); o.z = pk2(sp[4 * 33], sp[5 * 33]); o.w = pk2(sp[6 * 33], sp[7 * 33]);
        *(u32x4*)(WT + (size_t)(n0 + n) * K + k0 + 8 * c) = o; }
    asm volatile("s_waitcnt lgkmcnt(0)" ::: "memory");
}

DI void phase_norm(const Params& P, LAS unsigned char* lds, int layer, int wv) {
    const int tid = get_tid(wv), lane = tid & 63, wave = tid >> 6;
    const int gw = get_bid() * 8 + wave, NGW = gridDim.x * 8;
    const int j = layer >> 1;
    LAS float* scr = (LAS float*)(lds + wave * 16384);
    bf16_t* WIN = (bf16_t*)(P.ws + WS_WIN); bf16_t* WOUT = (bf16_t*)(P.ws + WS_WOUT); bf16_t* WRG = (bf16_t*)(P.ws + WS_WRG);
    if ((layer & 1) == 0) {
        constexpr int I_IN = 16 * (EVEN_IN / 32), I_OUT = 32 * 32, I_RG = 32 * 8;
        for (int it = gw; it < I_IN + I_OUT + I_RG; it += NGW) {
            int r = it;
            if (r < I_IN) { transpose_item(P.ev_w_in + (size_t)j * 1024 * EVEN_IN, 1024, EVEN_IN, WIN, scr, r, lane); continue; } r -= I_IN;
            if (r < I_OUT) { transpose_item(P.ev_w_out + (size_t)j * 2048 * 1024, 2048, 1024, WOUT, scr, r, lane); continue; } r -= I_OUT;
            const int mat = r >> 3, sub = r & 7;
            const int dir = mat >> 4, gate = (mat >> 3) & 1, hd = mat & 7;
            const float* src = (gate == 0 ? P.ev_rg_wx : P.ev_rg_wa) + ((size_t)((j * 2 + dir) * 8 + hd)) * 16384;
            transpose_item(src, 128, 128, WRG + (size_t)mat * 16384, scr, sub, lane);
        }
    } else {
        constexpr int I_IN = 16 * (ODD_IN / 32), I_OUT = 16 * 32;
        for (int it = gw; it < I_IN + I_OUT; it += NGW) {
            int r = it;
            if (r < I_IN) { transpose_item(P.od_w_in + (size_t)j * 1024 * ODD_IN, 1024, ODD_IN, WIN, scr, r, lane); continue; } r -= I_IN;
            transpose_item(P.od_w_out + (size_t)j * 1024 * 1024, 1024, 1024, WOUT, scr, r, lane);
        }
    }
    const float* hl = layer == 0 ? P.x : P.out; const float* hc = layer == 0 ? P.ctx : (const float*)(P.ws + WS_HCTX);
    const float* mod = (const float*)(P.ws + WS_MOD) + (size_t)layer * 9 * 3072;
    const float* nw = P.norm_w + layer * 1024;
    bf16_t* U = (bf16_t*)(P.ws + WS_OV);
    for (int R = gw; R < MROWS; R += NGW) {
        const int b = R / LT, jr = R % LT;
        const float* src = jr < CTXL ? hc + ((size_t)b * CTXL + jr) * DM : hl + ((size_t)b * SEQ + (jr - CTXL)) * DM;
        const float* sh = mod + (jr < CTXL ? 8 : b) * 3072; const float* sc = sh + 1024;
        f32x4 v[4]; float ss = 0.f;
#pragma unroll
        for (int q = 0; q < 4; ++q) { v[q] = *(const f32x4*)(src + 4 * lane + 256 * q); ss += (v[q][0] * v[q][0] + v[q][1] * v[q][1]) + (v[q][2] * v[q][2] + v[q][3] * v[q][3]); }
        const float rstd = rsqrtf(wave_sum(ss) * (1.f / DM) + RMS_EPS);
#pragma unroll
        for (int q = 0; q < 4; ++q) { const int k = 4 * lane + 256 * q;
            const f32x4 w4 = *(const f32x4*)(nw + k), s4 = *(const f32x4*)(sc + k), h4 = *(const f32x4*)(sh + k);
            const f32x4 y = (v[q] * rstd) * w4; const f32x4 o = y * (s4 + 1.f) + h4;
            u32x2 w; w.x = pk2(o[0], o[1]); w.y = pk2(o[2], o[3]); *(u32x2*)(U + (size_t)R * DM + k) = w; }
    }
}

typedef _Float16 f16x2_t __attribute__((ext_vector_type(2)));
DI unsigned pkh2(float a, float b) { const f16x2_t v = {(_Float16)a, (_Float16)b}; return __builtin_bit_cast(unsigned, v); }
DI void unpkh2(unsigned u, float& a, float& b) { const f16x2_t v = __builtin_bit_cast(f16x2_t, u); a = (float)v[0]; b = (float)v[1]; }
constexpr int RG_UT = 0, RG_AL = 17408, RG_BL = 50176, RG_HP = 82944, RG_QA = 148480, RG_CAR = 152576, RG_FLAG = 153600, RG_END = 153664;
static_assert(RG_END <= LDS_BYTES - 256, "RG-LRU LDS map");
constexpr int CW_RG = 8192;
DI void rglru_item(const Params& P, LAS unsigned char* lds, int j, int item, int wv) {
    const int tid = get_tid(wv), lane = tid & 63, wave = tid >> 6, r = lane & 15, g = lane >> 4;
    const int grp = item / NCHUNK, ci = item % NCHUNK, b = grp >> 3, hd = grp & 7;
    bf16_t* p = (bf16_t*)(P.ws + WS_P);
    const bf16_t* WRG = (const bf16_t*)(P.ws + WS_WRG);
    unsigned long long* AGG = (unsigned long long*)(P.ws + WS_AGG);
    unsigned* cnt = (unsigned*)(P.ws + WS_CTL) + CW_RG + (j * 64 + grp) * 16;
    const int R0 = b * LT + ci * 64;
    const int seg_lo = b * LT + (ci < 4 ? 0 : CTXL), seg_hi = b * LT + (ci < 4 ? CTXL : LT);
    LAS bf16_t* UT = (LAS bf16_t*)(lds + RG_UT);
    LAS float* AL = (LAS float*)(lds + RG_AL);
    LAS float* BL = (LAS float*)(lds + RG_BL);
    LAS unsigned* HP = (LAS unsigned*)(lds + RG_HP);
    LAS float* QA = (LAS float*)(lds + RG_QA);
    LAS float* CAR = (LAS float*)(lds + RG_CAR);
#pragma unroll
    for (int rep = 0; rep < 2; ++rep) {
        const int idx = tid + rep * 512, t = idx >> 4, c0 = (idx & 15) * 8, cg0 = hd * 128 + c0;
        float acc[8];
        { const f32x4 b0 = *(const f32x4*)(P.ev_conv_b + j * 1024 + cg0), b1 = *(const f32x4*)(P.ev_conv_b + j * 1024 + cg0 + 4);
          acc[0] = b0[0]; acc[1] = b0[1]; acc[2] = b0[2]; acc[3] = b0[3]; acc[4] = b1[0]; acc[5] = b1[1]; acc[6] = b1[2]; acc[7] = b1[3]; }
#pragma unroll
        for (int k = 0; k < 4; ++k) {
            const int Rg = R0 + t + k - 1;
            if (Rg >= seg_lo && Rg < seg_hi) {
                const u32x4 xv = *(const u32x4*)(p + (size_t)Rg * EVEN_IN + cg0);
                const float* wk = P.ev_conv_w + (size_t)(j * 4 + k) * 1024 + cg0;
                const f32x4 w0 = *(const f32x4*)wk, w1 = *(const f32x4*)(wk + 4);
                acc[0] += w0[0] * __uint_as_float(xv.x << 16); acc[1] += w0[1] * __uint_as_float(xv.x & 0xffff0000u);
                acc[2] += w0[2] * __uint_as_float(xv.y << 16); acc[3] += w0[3] * __uint_as_float(xv.y & 0xffff0000u);
                acc[4] += w1[0] * __uint_as_float(xv.z << 16); acc[5] += w1[1] * __uint_as_float(xv.z & 0xffff0000u);
                acc[6] += w1[2] * __uint_as_float(xv.w << 16); acc[7] += w1[3] * __uint_as_float(xv.w & 0xffff0000u);
            }
        }
        u32x4 o; o.x = pk2(acc[0], acc[1]); o.y = pk2(acc[2], acc[3]); o.z = pk2(acc[4], acc[5]); o.w = pk2(acc[6], acc[7]);
        *(LAS u32x4*)(UT + t * 136 + c0) = o;
    }
    __syncthreads();
#pragma unroll 1
    for (int dir = 0; dir < 2; ++dir) {
        f32x4 ax[4], aa[4];
#pragma unroll
        for (int m = 0; m < 4; ++m) { ax[m] = (f32x4){0.f, 0.f, 0.f, 0.f}; aa[m] = (f32x4){0.f, 0.f, 0.f, 0.f}; }
        const bf16_t* Wx = WRG + (size_t)((dir * 2 + 0) * 8 + hd) * 16384 + (16 * wave + r) * 128 + 8 * g;
        const bf16_t* Wa = WRG + (size_t)((dir * 2 + 1) * 8 + hd) * 16384 + (16 * wave + r) * 128 + 8 * g;
#pragma unroll
        for (int ks = 0; ks < 4; ++ks) {
            const bf16x8 bx = *(const bf16x8*)(Wx + 32 * ks), ba = *(const bf16x8*)(Wa + 32 * ks);
#pragma unroll
            for (int m = 0; m < 4; ++m) {
                const bf16x8 a = *(const LAS bf16x8*)(UT + (16 * m + r) * 136 + 32 * ks + 8 * g);
                ax[m] = MFMA16(a, bx, ax[m]); aa[m] = MFMA16(a, ba, aa[m]);
            }
        }
        {
            const int c = 16 * wave + r, idx = (j * 2 + dir) * 1024 + hd * 128 + c;
            const float bxv = P.ev_rg_bx[idx], bav = P.ev_rg_ba[idx], lam = P.ev_rg_lambda[idx];
            const float sp = softplus_neg(lam);
#pragma unroll
            for (int m = 0; m < 4; ++m)
#pragma unroll
                for (int i = 0; i < 4; ++i) {
                    const int t = 16 * m + 4 * g + i;
                    const float gx = sigm(ax[m][i] + bxv), ga = sigm(aa[m][i] + bav);
                    const float la = -8.f * ga * sp;
                    const float a = __expf(la), mult = __builtin_amdgcn_sqrtf(neg_expm1(2.f * la));
                    const float uv = bf2f(UT[t * 136 + c]);
                    AL[t * 128 + c] = a; BL[t * 128 + c] = mult * gx * uv;
                }
        }
        __syncthreads();
        {
            const int c = tid & 127, q = tid >> 7;
            float A = 1.f, B = 0.f;
#pragma unroll
            for (int s = 0; s < 16; ++s) { const int t = dir == 0 ? 16 * q + s : 16 * q + 15 - s; const float a = AL[t * 128 + c], bb = BL[t * 128 + c]; B = a * B + bb; A *= a; }
            QA[(q * 128 + c) * 2] = A; QA[(q * 128 + c) * 2 + 1] = B;
            __syncthreads();
            float h = 0.f, pc = 1.f;
            const int nprev = dir == 0 ? q : 3 - q;
            for (int qq = 0; qq < nprev; ++qq) { const int qi = dir == 0 ? qq : 3 - qq; const float a = QA[(qi * 128 + c) * 2]; h = a * h + QA[(qi * 128 + c) * 2 + 1]; pc *= a; }
#pragma unroll
            for (int s = 0; s < 16; ++s) { const int t = dir == 0 ? 16 * q + s : 16 * q + 15 - s; const float a = AL[t * 128 + c]; h = a * h + BL[t * 128 + c]; pc *= a;
                HP[(dir * 64 + t) * 128 + c] = pkh2(h, pc); }
            if (nprev == 3) {
                const unsigned long long v = ((unsigned long long)__float_as_uint(h) << 32) | __float_as_uint(pc);
                __hip_atomic_store(AGG + ((size_t)(dir * NB + b) * NCHUNK + ci) * 1024 + hd * 128 + c, v, __ATOMIC_RELAXED, __HIP_MEMORY_SCOPE_AGENT);
            }
        }
        __syncthreads();
    }
    asm volatile("s_waitcnt vmcnt(0)" ::: "memory");
    __syncthreads();
    if (tid == 0) {
        __hip_atomic_fetch_add(cnt, 1u, __ATOMIC_RELAXED, __HIP_MEMORY_SCOPE_AGENT);
        unsigned spins = 0;
        while (__hip_atomic_load(cnt, __ATOMIC_RELAXED, __HIP_MEMORY_SCOPE_AGENT) < (unsigned)NCHUNK) { __builtin_amdgcn_s_sleep(2); if (++spins > (1u << 22)) break; }
    }
    __syncthreads();
    if (tid < 256) {
        const int dir = tid >> 7, c = tid & 127;
        const int pos = dir == 0 ? ci : (ci < 4 ? 3 - ci : 39 - ci);
        float h = 0.f;
        const unsigned long long* ag = AGG + (size_t)(dir * NB + b) * NCHUNK * 1024 + hd * 128 + c;
#pragma unroll
        for (int half = 0; half < 2; ++half) {
            unsigned long long v[18];
#pragma unroll
            for (int k = 0; k < 18; ++k) { const int pp = half * 18 + k; const int cc = dir == 0 ? pp : (pp < 4 ? 3 - pp : 39 - pp);
                v[k] = __hip_atomic_load(ag + (size_t)cc * 1024, __ATOMIC_RELAXED, __HIP_MEMORY_SCOPE_AGENT); }
#pragma unroll
            for (int k = 0; k < 18; ++k) if (half * 18 + k < pos) h = __uint_as_float((unsigned)v[k]) * h + __uint_as_float((unsigned)(v[k] >> 32));
        }
        CAR[dir * 128 + c] = h;
    }
    __syncthreads();
#pragma unroll
    for (int rep = 0; rep < 2; ++rep) {
        const int idx = tid + rep * 512, t = idx >> 4, c0 = (idx & 15) * 8;
        bf16_t* gp = p + (size_t)(R0 + t) * EVEN_IN + 1536 + hd * 128 + c0;
        const u32x4 gv = *(const u32x4*)gp;
        float y[8];
#pragma unroll
        for (int e = 0; e < 8; ++e) {
            float h0, p0, h1, p1; unpkh2(HP[t * 128 + c0 + e], h0, p0); unpkh2(HP[(64 + t) * 128 + c0 + e], h1, p1);
            y[e] = (h0 + p0 * CAR[c0 + e]) + (h1 + p1 * CAR[128 + c0 + e]);
        }
        const float gg[8] = {__uint_as_float(gv.x << 16), __uint_as_float(gv.x & 0xffff0000u), __uint_as_float(gv.y << 16), __uint_as_float(gv.y & 0xffff0000u),
                             __uint_as_float(gv.z << 16), __uint_as_float(gv.z & 0xffff0000u), __uint_as_float(gv.w << 16), __uint_as_float(gv.w & 0xffff0000u)};
        u32x4 o;
        o.x = pk2(y[0] * gg[0] * sigm(gg[0]), y[1] * gg[1] * sigm(gg[1])); o.y = pk2(y[2] * gg[2] * sigm(gg[2]), y[3] * gg[3] * sigm(gg[3]));
        o.z = pk2(y[4] * gg[4] * sigm(gg[4]), y[5] * gg[5] * sigm(gg[5])); o.w = pk2(y[6] * gg[6] * sigm(gg[6]), y[7] * gg[7] * sigm(gg[7]));
        *(u32x4*)gp = o;
    }
    __syncthreads();
}

DI void rope8(u32x4& v, const float* cs, const float* sn) {
    unsigned* w = (unsigned*)&v;
#pragma unroll
    for (int i = 0; i < 4; ++i) { const float t1 = __uint_as_float(w[i] << 16), t2 = __uint_as_float(w[i] & 0xffff0000u); w[i] = pk2(t1 * cs[i] - t2 * sn[i], t1 * sn[i] + t2 * cs[i]); }
}
DI void attn_item(const Params& P, LAS unsigned char* lds, int j, int item, int wv) {
    const int tid = get_tid(wv), lane = tid & 63, wave = tid >> 6, r = lane & 31, h = lane >> 5;
    const bool is_lat = item < 512;
    int b, qb, kvh;
    if (is_lat) { b = item >> 6; qb = (item >> 2) & 15; kvh = item & 3; } else { const int it = item - 512; b = it >> 3; qb = (it >> 2) & 1; kvh = it & 3; }
    bf16_t* p = (bf16_t*)(P.ws + WS_P);
    const float* cos_t = (const float*)(P.ws + WS_ROPE); const float* sin_t = cos_t + SEQ * 32;
    LAS unsigned char* KL = lds;
    LAS unsigned char* VT = lds + 9216;
    const int hq = 4 * kvh + (wave >> 1), ql0 = qb * 128 + 64 * (wave & 1);
    const size_t rowbase = (size_t)b * LT + (is_lat ? CTXL : 0);
    LAS unsigned char* QL = lds + 18432 + wave * 9216;
#pragma unroll
    for (int qt = 0; qt < 2; ++qt) {
        const int qi = ql0 + 32 * qt + r;
        const bf16_t* qp = p + (rowbase + qi) * EVEN_IN + 2560 + hq * 64 + 8 * h;
#pragma unroll
        for (int ks = 0; ks < 4; ++ks) {
            u32x4 v = *(const u32x4*)(qp + 16 * ks);
            if (is_lat) rope8(v, cos_t + qi * 32 + 8 * ks + 4 * h, sin_t + qi * 32 + 8 * ks + 4 * h);
            *(LAS u32x4*)(QL + (32 * qt + r) * 144 + (16 * ks + 8 * h) * 2) = v;
        }
    }
    const float sink2 = P.ev_sink[j * 16 + hq] * LOG2E;
    float mrun[2] = {sink2, sink2}, lrun[2] = {h == 0 ? 1.f : 0.f, h == 0 ? 1.f : 0.f};
    f32x16 O[2][2];
#pragma unroll
    for (int a = 0; a < 2; ++a)
#pragma unroll
        for (int c = 0; c < 2; ++c)
#pragma unroll
            for (int i = 0; i < 16; ++i) O[a][c][i] = 0.f;
    const int ntiles = is_lat ? 10 : 4;
    const float SC = 0.125f * LOG2E, NEG = -1e30f;
#pragma unroll 1
    for (int ti = 0; ti < ntiles; ++ti) {
        const bool win = ti >= 4;
        const int k0 = win ? qb * 128 - 128 + 64 * (ti - 4) : 64 * ti;
        if (win && (k0 < 0 || k0 >= SEQ)) continue;
        __syncthreads();
        {
            const int key = tid >> 3, chn = tid & 7;
            const bf16_t* kp = p + ((size_t)b * LT + (win ? CTXL : 0) + k0 + key) * EVEN_IN + 1024 + kvh * 64 + 8 * chn;
            u32x4 kv = *(const u32x4*)kp;
            if (win) rope8(kv, cos_t + (k0 + key) * 32 + 4 * chn, sin_t + (k0 + key) * 32 + 4 * chn);
            *(LAS u32x4*)(KL + key * 144 + chn * 16) = kv;
            const u32x4 vv = *(const u32x4*)(kp + 256);
            const unsigned* vw = (const unsigned*)&vv;
#pragma unroll
            for (int e = 0; e < 4; ++e) {
                *(LAS unsigned short*)(VT + (8 * chn + 2 * e) * 144 + key * 2) = (unsigned short)(vw[e] & 0xffffu);
                *(LAS unsigned short*)(VT + (8 * chn + 2 * e + 1) * 144 + key * 2) = (unsigned short)(vw[e] >> 16);
            }
        }
        __syncthreads();
#pragma unroll
        for (int qt = 0; qt < 2; ++qt) {
            f32x16 s0, s1;
#pragma unroll
            for (int i = 0; i < 16; ++i) { s0[i] = 0.f; s1[i] = 0.f; }
#pragma unroll
            for (int ks = 0; ks < 4; ++ks) {
                const bf16x8 qfr = *(const LAS bf16x8*)(QL + (32 * qt + r) * 144 + (16 * ks + 8 * h) * 2);
                const bf16x8 k0f = *(const LAS bf16x8*)(KL + r * 144 + (16 * ks + 8 * h) * 2), k1f = *(const LAS bf16x8*)(KL + (32 + r) * 144 + (16 * ks + 8 * h) * 2);
                s0 = MFMA32(k0f, qfr, s0); s1 = MFMA32(k1f, qfr, s1);
            }
            const int qpos = ql0 + 32 * qt + r;
            float mx = NEG;
#pragma unroll
            for (int i = 0; i < 16; ++i) {
                const int kp0 = k0 + crow(i, h), kp1 = kp0 + 32;
                float v0 = s0[i] * SC, v1 = s1[i] * SC;
                if (win) { const int d0 = qpos - kp0, d1 = qpos - kp1; if (d0 > 128 || d0 < -128) v0 = NEG; if (d1 > 128 || d1 < -128) v1 = NEG; }
                s0[i] = v0; s1[i] = v1; mx = fmaxf(mx, fmaxf(v0, v1));
            }
            mx = fmaxf(mx, shfl_xor_f(mx, 32));
            const float mn = fmaxf(mrun[qt], mx), alpha = __builtin_amdgcn_exp2f(mrun[qt] - mn);
            mrun[qt] = mn;
            float ls = 0.f;
#pragma unroll
            for (int i = 0; i < 16; ++i) { s0[i] = __builtin_amdgcn_exp2f(s0[i] - mn); s1[i] = __builtin_amdgcn_exp2f(s1[i] - mn); ls += s0[i] + s1[i]; }
            lrun[qt] = lrun[qt] * alpha + ls;
#pragma unroll
            for (int dt = 0; dt < 2; ++dt)
#pragma unroll
                for (int i = 0; i < 16; ++i) O[dt][qt][i] *= alpha;
            bf16x8 pf[2][2];
#pragma unroll
            for (int s = 0; s < 2; ++s) {
                u32x4 a, c;
                a.x = pk2(s0[8 * s + 0], s0[8 * s + 1]); a.y = pk2(s0[8 * s + 2], s0[8 * s + 3]); a.z = pk2(s0[8 * s + 4], s0[8 * s + 5]); a.w = pk2(s0[8 * s + 6], s0[8 * s + 7]);
                c.x = pk2(s1[8 * s + 0], s1[8 * s + 1]); c.y = pk2(s1[8 * s + 2], s1[8 * s + 3]); c.z = pk2(s1[8 * s + 4], s1[8 * s + 5]); c.w = pk2(s1[8 * s + 6], s1[8 * s + 7]);
                pf[0][s] = __builtin_bit_cast(bf16x8, a); pf[1][s] = __builtin_bit_cast(bf16x8, c);
            }
#pragma unroll
            for (int dt = 0; dt < 2; ++dt)
#pragma unroll
                for (int kt = 0; kt < 2; ++kt)
#pragma unroll
                    for (int s = 0; s < 2; ++s) {
                        const LAS unsigned char* vp = VT + (32 * dt + r) * 144 + (32 * kt + 16 * s + 4 * h) * 2;
                        const u32x2 lo = *(const LAS u32x2*)vp, hi = *(const LAS u32x2*)(vp + 16);
                        const u32x4 vv = {lo.x, lo.y, hi.x, hi.y};
                        O[dt][qt] = MFMA32(__builtin_bit_cast(bf16x8, vv), pf[kt][s], O[dt][qt]);
                    }
            __builtin_amdgcn_sched_barrier(0);
        }
    }
#pragma unroll
    for (int qt = 0; qt < 2; ++qt) {
        const float lt = lrun[qt] + shfl_xor_f(lrun[qt], 32), inv = __builtin_amdgcn_rcpf(lt);
        const int qi = ql0 + 32 * qt + r;
        bf16_t* rowp = p + (rowbase + qi) * EVEN_IN;
#pragma unroll
        for (int dt = 0; dt < 2; ++dt)
#pragma unroll
            for (int i4 = 0; i4 < 4; ++i4) {
                const int d0 = 32 * dt + 8 * i4 + 4 * h;
                const u32x2 gv = *(const u32x2*)(rowp + 3584 + hq * 64 + d0);
                const float g0 = __uint_as_float(gv.x << 16), g1 = __uint_as_float(gv.x & 0xffff0000u), g2 = __uint_as_float(gv.y << 16), g3 = __uint_as_float(gv.y & 0xffff0000u);
                u32x2 o;
                o.x = pk2(O[dt][qt][4 * i4 + 0] * inv * g0 * sigm(g0), O[dt][qt][4 * i4 + 1] * inv * g1 * sigm(g1));
                o.y = pk2(O[dt][qt][4 * i4 + 2] * inv * g2 * sigm(g2), O[dt][qt][4 * i4 + 3] * inv * g3 * sigm(g3));
                *(u32x2*)(rowp + 2560 + hq * 64 + d0) = o;
            }
    }
    __syncthreads();
}

constexpr int G2_QX = 0, G2_KF = 17408, G2_K2 = 60928, G2_VS = 79360, G2_AM = 96768, G2_ST = 105984, G2_PS = 140800, G2_BL = 144896, G2_Q1 = 145408, G2_END = 162816;
static_assert(G2_END <= LDS_BYTES - 256, "GLA LDS map");
typedef short v4i16_t __attribute__((ext_vector_type(4)));
DI bf16x8 frag_tr(const LAS bf16_t* M, int stride, int k0, int n0, int lane) {
    const int i = lane & 15, g = lane >> 4, q = i >> 2, pp = i & 3;
    const LAS bf16_t* a0 = M + (k0 + 8 * g + q) * stride + n0 + 4 * pp;
    const v4i16_t lo = __builtin_amdgcn_ds_read_tr16_b64_v4i16((LAS v4i16_t*)a0);
    const v4i16_t hi = __builtin_amdgcn_ds_read_tr16_b64_v4i16((LAS v4i16_t*)(a0 + 4 * stride));
    return (bf16x8){lo[0], lo[1], lo[2], lo[3], hi[0], hi[1], hi[2], hi[3]};
}

template <int DIR>
DI void gla2_item(const Params& P, LAS unsigned char* lds, int layer_j, int b, int hd, int wv) {
    const int tid = get_tid(wv), lane = tid & 63, wave = tid >> 6, r = lane & 15, g = lane >> 4;
    bf16_t* p = (bf16_t*)(P.ws + WS_P);
    LAS bf16_t* QX = (LAS bf16_t*)(lds + G2_QX); LAS bf16_t* KF = (LAS bf16_t*)(lds + G2_KF); LAS bf16_t* K2 = (LAS bf16_t*)(lds + G2_K2);
    LAS bf16_t* VS = (LAS bf16_t*)(lds + G2_VS); LAS bf16_t* AM = (LAS bf16_t*)(lds + G2_AM); LAS bf16_t* ST = (LAS bf16_t*)(lds + G2_ST);
    LAS float* PS8 = (LAS float*)(lds + G2_PS); LAS float* BLAST = (LAS float*)(lds + G2_BL); LAS bf16_t* Q1 = (LAS bf16_t*)(lds + G2_Q1);
    const int d0 = 2 * lane, tg = wave, I = tg >> 1, half = tg & 1;
    float lbv[2] = {0.f, 0.f};
    if (layer_j > 0) { lbv[0] = sigm(P.od_lb_raw[1024 + hd * 128 + d0] - P.od_lb_raw[hd * 128 + d0]); lbv[1] = sigm(P.od_lb_raw[1024 + hd * 128 + d0 + 1] - P.od_lb_raw[hd * 128 + d0 + 1]); }
    for (int i = tid; i < (9216 + 34816) / 4; i += 512) ((LAS unsigned*)(lds + G2_AM))[i] = 0u;
    f32x4 st[8];
#pragma unroll
    for (int e = 0; e < 8; ++e) st[e] = (f32x4){0.f, 0.f, 0.f, 0.f};
    unsigned zn[8], qn[8]; u32x4 vn[2];
#define G2_OFFZ(s) ((unsigned)((DIR == 0 ? 8 * tg + (s) : 63 - 8 * tg - (s)) * ODD_IN + d0) * 2u)
#define G2_OFFV(rep) ((unsigned)((DIR == 0 ? ((tid + (rep) * 512) >> 4) : 63 - ((tid + (rep) * 512) >> 4)) * ODD_IN + 8 * ((tid + (rep) * 512) & 15)) * 2u)
    const size_t colz = (size_t)DIR * 1024 + hd * 128, colq = 3072 + hd * 128, colv = 2048 + hd * 128;
    {
        const int chunk = DIR == 0 ? 0 : 3;
        const char* slab = (const char*)(p + ((size_t)b * LT + (size_t)chunk * 64) * ODD_IN);
#pragma unroll
        for (int s = 0; s < 8; ++s) { zn[s] = *(const unsigned*)(slab + colz * 2 + G2_OFFZ(s)); qn[s] = *(const unsigned*)(slab + colq * 2 + G2_OFFZ(s)); }
#pragma unroll
        for (int rep = 0; rep < 2; ++rep) vn[rep] = *(const u32x4*)(slab + colv * 2 + G2_OFFV(rep));
    }
    __syncthreads();
#pragma unroll 1
    for (int step = 0; step < NCHUNK; ++step) {
        const int chunk = DIR == 0 ? step : (step < 4 ? 3 - step : 39 - step);
        const size_t Rc0 = (size_t)b * LT + (size_t)chunk * 64;
        unsigned zc[8], qc[8]; u32x4 vc[2];
#pragma unroll
        for (int s = 0; s < 8; ++s) { zc[s] = zn[s]; qc[s] = qn[s]; }
        vc[0] = vn[0]; vc[1] = vn[1];
        float el[8][2], kk[8][2], qq[8][2];
        {
            float run0 = 1.f, run1 = 1.f;
#pragma unroll
            for (int s = 0; s < 8; ++s) {
                const float z0 = __uint_as_float(zc[s] << 16), z1 = __uint_as_float(zc[s] & 0xffff0000u);
                const float t0 = __expf(-z0), t1 = __expf(-z1), sg0 = __builtin_amdgcn_rcpf(1.f + t0), sg1 = __builtin_amdgcn_rcpf(1.f + t1);
                const float f0 = fmaxf(lbv[0] + (1.f - lbv[0]) * sg0, 1e-30f), f1 = fmaxf(lbv[1] + (1.f - lbv[1]) * sg1, 1e-30f);
                kk[s][0] = (1.f - lbv[0]) * (t0 * sg0); kk[s][1] = (1.f - lbv[1]) * (t1 * sg1);
                run0 = fmaxf(run0 * f0, 1e-35f); run1 = fmaxf(run1 * f1, 1e-35f); el[s][0] = run0; el[s][1] = run1;
                const float q0 = __uint_as_float(qc[s] << 16), q1 = __uint_as_float(qc[s] & 0xffff0000u);
                qq[s][0] = q0 * __builtin_amdgcn_rcpf(1.f + __expf(-q0)); qq[s][1] = q1 * __builtin_amdgcn_rcpf(1.f + __expf(-q1));
                if ((s & 1) == 1) __builtin_amdgcn_sched_barrier(0);
            }
            *(LAS f32x2*)(PS8 + tg * 128 + d0) = (f32x2){run0, run1};
#pragma unroll
            for (int rep = 0; rep < 2; ++rep) { const int idx = tid + rep * 512, tau = idx >> 4, chn = idx & 15; *(LAS u32x4*)(VS + tau * 136 + 8 * chn) = vc[rep]; }
        }
        __syncthreads();
        float RI[2];
        {
            float T[8][2];
#pragma unroll
            for (int q8 = 0; q8 < 8; ++q8) { const f32x2 t = *(const LAS f32x2*)(PS8 + q8 * 128 + d0); T[q8][0] = t[0]; T[q8][1] = t[1]; }
            float pre[2], fac[4][2], f4[2];
#pragma unroll
            for (int x = 0; x < 2; ++x) {
                const float P0 = T[0][x] * T[1][x], P1 = T[2][x] * T[3][x], P2 = T[4][x] * T[5][x], P3 = T[6][x] * T[7][x];
                pre[x] = half ? (I == 0 ? T[0][x] : (I == 1 ? T[2][x] : (I == 2 ? T[4][x] : T[6][x]))) : 1.f;
                RI[x] = I == 0 ? 1.f : (I == 1 ? P0 : (I == 2 ? P0 * P1 : P0 * P1 * P2));
                float cur = 1.f;
                fac[0][x] = cur; if (I <= 0) cur *= P0;
                fac[1][x] = cur; if (I <= 1) cur *= P1;
                fac[2][x] = cur; if (I <= 2) cur *= P2;
                fac[3][x] = cur; cur *= P3;
                f4[x] = cur;
                if (tg == 0) BLAST[d0 + x] = P0 * P1 * P2 * P3;
            }
            unsigned w0[4], w1[4];
#pragma unroll
            for (int s = 0; s < 8; ++s) {
                const int tau = 8 * tg + s;
                const float e00 = fmaxf(pre[0] * el[s][0], 1e-35f), e01 = fmaxf(pre[1] * el[s][1], 1e-35f);
                const float qi0 = qq[s][0] * e00, qi1 = qq[s][1] * e01;
                const float kd0 = kk[s][0] * __builtin_amdgcn_rcpf(e00), kd1 = kk[s][1] * __builtin_amdgcn_rcpf(e01);
                *(LAS unsigned*)(QX + tau * 136 + d0) = pk2(qi0, qi1);
                *(LAS unsigned*)(Q1 + tau * 136 + d0) = pk2(qi0 * RI[0], qi1 * RI[1]);
                if (I <= 0) *(LAS unsigned*)(KF + (0 + tau) * 136 + d0) = pk2(kd0 * fac[0][0], kd1 * fac[0][1]);
                if (I <= 1) *(LAS unsigned*)(KF + (16 + tau) * 136 + d0) = pk2(kd0 * fac[1][0], kd1 * fac[1][1]);
                if (I <= 2) *(LAS unsigned*)(KF + (48 + tau) * 136 + d0) = pk2(kd0 * fac[2][0], kd1 * fac[2][1]);
                *(LAS unsigned*)(KF + (96 + tau) * 136 + d0) = pk2(kd0 * fac[3][0], kd1 * fac[3][1]);
                const unsigned h0 = f2bf(kd0 * f4[0]), h1 = f2bf(kd1 * f4[1]);
                if (s & 1) { w0[s >> 1] |= h0 << 16; w1[s >> 1] |= h1 << 16; } else { w0[s >> 1] = h0; w1[s >> 1] = h1; }
                if ((s & 1) == 1) __builtin_amdgcn_sched_barrier(0);
            }
            *(LAS u32x4*)(K2 + (d0 + 0) * 72 + 8 * tg) = (u32x4){w0[0], w0[1], w0[2], w0[3]};
            *(LAS u32x4*)(K2 + (d0 + 1) * 72 + 8 * tg) = (u32x4){w1[0], w1[1], w1[2], w1[3]};
        }
        __syncthreads();
        if (step + 1 < NCHUNK) {
            const int nchunk = DIR == 0 ? step + 1 : (step + 1 < 4 ? 2 - step : 38 - step);
            const char* slab = (const char*)(p + ((size_t)b * LT + (size_t)nchunk * 64) * ODD_IN);
#pragma unroll
            for (int s = 0; s < 8; ++s) { zn[s] = *(const unsigned*)(slab + colz * 2 + G2_OFFZ(s)); qn[s] = *(const unsigned*)(slab + colq * 2 + G2_OFFZ(s)); }
#pragma unroll
            for (int rep = 0; rep < 2; ++rep) vn[rep] = *(const u32x4*)(slab + colv * 2 + G2_OFFV(rep));
        }
#pragma unroll 1
        for (int bi = wave; bi < 10; bi += 8) {
            const int Ib = bi < 1 ? 0 : (bi < 3 ? 1 : (bi < 6 ? 2 : 3)), Jb = bi - (Ib * (Ib + 1)) / 2;
            const int foff = Ib == 0 ? 0 : (Ib == 1 ? 16 : (Ib == 2 ? 48 : 96));
            f32x4 acc = {0.f, 0.f, 0.f, 0.f};
#pragma unroll
            for (int ks = 0; ks < 4; ++ks) {
                const bf16x8 a = *(const LAS bf16x8*)(QX + (16 * Ib + r) * 136 + 32 * ks + 8 * g);
                const bf16x8 bb = *(const LAS bf16x8*)(KF + (foff + 16 * Jb + r) * 136 + 32 * ks + 8 * g);
                acc = MFMA16(a, bb, acc);
            }
#pragma unroll
            for (int i = 0; i < 4; ++i) { float v = acc[i]; if (Jb == Ib && r > 4 * g + i) v = 0.f; AM[(16 * Ib + 4 * g + i) * 72 + 16 * Jb + r] = (bf16_t)f2bf(v); }
        }
        __syncthreads();
        {
            const int tt = wave >> 1, eb = 4 * (wave & 1);
            char* oslab = (char*)(p + Rc0 * ODD_IN + colz);
            bf16x8 aq[4], am[2];
#pragma unroll
            for (int ks = 0; ks < 4; ++ks) aq[ks] = *(const LAS bf16x8*)(Q1 + (16 * tt + r) * 136 + 32 * ks + 8 * g);
#pragma unroll
            for (int ks = 0; ks < 2; ++ks) am[ks] = *(const LAS bf16x8*)(AM + (16 * tt + r) * 72 + 32 * ks + 8 * g);
#pragma unroll
            for (int e4 = 0; e4 < 4; ++e4) {
                const int et = eb + e4;
                f32x4 acc = {0.f, 0.f, 0.f, 0.f};
#pragma unroll
                for (int ks = 0; ks < 4; ++ks) { const bf16x8 bb = *(const LAS bf16x8*)(ST + (16 * et + r) * 136 + 32 * ks + 8 * g); acc = MFMA16(aq[ks], bb, acc); }
#pragma unroll
                for (int ks = 0; ks < 2; ++ks) acc = MFMA16(am[ks], frag_tr(VS, 136, 32 * ks, 16 * et, lane), acc);
#pragma unroll
                for (int i = 0; i < 4; ++i) {
                    const int tau = 16 * tt + 4 * g + i;
                    const unsigned off = (unsigned)((DIR == 0 ? tau : 63 - tau) * ODD_IN + 16 * et + r) * 2u;
                    *(bf16_t*)(oslab + off) = (bf16_t)f2bf(acc[i]);
                }
                __builtin_amdgcn_sched_barrier(0);
            }
            float bl[4];
#pragma unroll
            for (int i = 0; i < 4; ++i) bl[i] = BLAST[16 * wave + 4 * g + i];
            bf16x8 ak[2];
#pragma unroll
            for (int ks = 0; ks < 2; ++ks) ak[ks] = *(const LAS bf16x8*)(K2 + (16 * wave + r) * 72 + 32 * ks + 8 * g);
#pragma unroll
            for (int et = 0; et < 8; ++et) {
#pragma unroll
                for (int i = 0; i < 4; ++i) st[et][i] *= bl[i];
#pragma unroll
                for (int ks = 0; ks < 2; ++ks) st[et] = MFMA16(ak[ks], frag_tr(VS, 136, 32 * ks, 16 * et, lane), st[et]);
                if (et & 1) __builtin_amdgcn_sched_barrier(0);
            }
        }
        __syncthreads();
#pragma unroll
        for (int et = 0; et < 8; ++et) { u32x2 w; w.x = pk2(st[et][0], st[et][1]); w.y = pk2(st[et][2], st[et][3]); *(LAS u32x2*)(ST + (16 * et + r) * 136 + 16 * wave + 4 * g) = w; }
    }
    __syncthreads();
}

DI void phase_readout(const Params& P, int layer_j, int wv) {
    const int tid = get_tid(wv), lane = tid & 63, wave = tid >> 6;
    const int gw = get_bid() * 8 + wave, NGW = gridDim.x * 8;
    bf16_t* p = (bf16_t*)(P.ws + WS_P);
    const float* gwt = P.od_gnorm_w + layer_j * 128 + (lane & 7) * 16;
    for (int R = gw; R < MROWS; R += NGW) {
        const bf16_t* op = p + (size_t)R * ODD_IN + 16 * lane; bf16_t* yp = p + (size_t)R * ODD_IN + 4096 + 16 * lane;
        const u32x4 o0 = *(const u32x4*)op, o1 = *(const u32x4*)(op + 8), c0 = *(const u32x4*)(op + 1024), c1 = *(const u32x4*)(op + 1032), g0 = *(const u32x4*)yp, g1 = *(const u32x4*)(yp + 8);
        float ov[16], gv[16];
        const unsigned* ow0 = (const unsigned*)&o0; const unsigned* ow1 = (const unsigned*)&o1; const unsigned* cw0 = (const unsigned*)&c0; const unsigned* cw1 = (const unsigned*)&c1;
        const unsigned* gw0 = (const unsigned*)&g0; const unsigned* gw1 = (const unsigned*)&g1;
#pragma unroll
        for (int i = 0; i < 4; ++i) {
            ov[2 * i] = __uint_as_float(ow0[i] << 16) + __uint_as_float(cw0[i] << 16); ov[2 * i + 1] = __uint_as_float(ow0[i] & 0xffff0000u) + __uint_as_float(cw0[i] & 0xffff0000u);
            ov[8 + 2 * i] = __uint_as_float(ow1[i] << 16) + __uint_as_float(cw1[i] << 16); ov[8 + 2 * i + 1] = __uint_as_float(ow1[i] & 0xffff0000u) + __uint_as_float(cw1[i] & 0xffff0000u);
            gv[2 * i] = __uint_as_float(gw0[i] << 16); gv[2 * i + 1] = __uint_as_float(gw0[i] & 0xffff0000u); gv[8 + 2 * i] = __uint_as_float(gw1[i] << 16); gv[8 + 2 * i + 1] = __uint_as_float(gw1[i] & 0xffff0000u);
        }
        float ss = 0.f;
#pragma unroll
        for (int i = 0; i < 16; ++i) ss += ov[i] * ov[i];
        ss += shfl_xor_f(ss, 1); ss += shfl_xor_f(ss, 2); ss += shfl_xor_f(ss, 4);
        const float rstd = rsqrtf(ss * (1.f / 128.f) + RMS_EPS);
        float y[16];
#pragma unroll
        for (int i = 0; i < 16; ++i) y[i] = ov[i] * rstd * gwt[i] * (gv[i] * sigm(gv[i]));
        u32x4 w0, w1;
        w0.x = pk2(y[0], y[1]); w0.y = pk2(y[2], y[3]); w0.z = pk2(y[4], y[5]); w0.w = pk2(y[6], y[7]);
        w1.x = pk2(y[8], y[9]); w1.y = pk2(y[10], y[11]); w1.z = pk2(y[12], y[13]); w1.w = pk2(y[14], y[15]);
        *(u32x4*)yp = w0; *(u32x4*)(yp + 8) = w1;
    }
}

DI void phase_final(const Params& P, int wv) {
    const int tid = get_tid(wv), lane = tid & 63, wave = tid >> 6;
    const int gw = get_bid() * 8 + wave, NGW = gridDim.x * 8;
    for (int R = gw; R < NB * SEQ; R += NGW) {
        float* row = P.out + (size_t)R * DM;
        f32x4 v[4]; float ss = 0.f;
#pragma unroll
        for (int q = 0; q < 4; ++q) { v[q] = *(const f32x4*)(row + 4 * lane + 256 * q); ss += (v[q][0] * v[q][0] + v[q][1] * v[q][1]) + (v[q][2] * v[q][2] + v[q][3] * v[q][3]); }
        const float rstd = rsqrtf(wave_sum(ss) * (1.f / DM) + RMS_EPS);
#pragma unroll
        for (int q = 0; q < 4; ++q) { const f32x4 w4 = *(const f32x4*)(P.final_norm_w + 4 * lane + 256 * q); *(f32x4*)(row + 4 * lane + 256 * q) = (v[q] * rstd) * w4; }
    }
}

#define XB_TMO      128
#define XB_XCNT(j)  (256  + 64 * (j))
#define XB_XSUB(j)  (1280 + 64 * (j))
#define XB_XGEN(j)  (2304 + 64 * (j))
#define XB_TOP      3328
#define XB_TOPGEN   3392
#define XCD_BAR_WORDS 3456
#define XB_SPIN_CAP (1u << 18)

__device__ __forceinline__ unsigned xb_ld(unsigned* p)              { return __hip_atomic_load(p, __ATOMIC_RELAXED, __HIP_MEMORY_SCOPE_AGENT); }
__device__ __forceinline__ unsigned xb_add(unsigned* p, unsigned v) { return __hip_atomic_fetch_add(p, v, __ATOMIC_RELAXED, __HIP_MEMORY_SCOPE_AGENT); }
__device__ __forceinline__ unsigned xb_xcc_id() { return (unsigned)__builtin_amdgcn_s_getreg((3 << 11) | 20) & 0xFu; }
#define XB_SPIN(cond, bar) do { unsigned _sp = 0; while (cond) { __builtin_amdgcn_s_sleep(1); \
    if ((++_sp & 255u) == 0u) { if (xb_ld(&(bar)[XB_TMO])) break; if (_sp > XB_SPIN_CAP) { atomicAdd(&(bar)[XB_TMO], 1u); break; } } } } while (0)

struct XcdBarrier {
    unsigned* bar; unsigned x;
    volatile LAS unsigned* st;
};

__device__ __forceinline__ XcdBarrier xcd_barrier_post(unsigned* bar, volatile LAS unsigned* st, int wv) {
    XcdBarrier b; b.bar = bar; b.x = xb_xcc_id(); b.st = st;
    if (get_tid(wv) == 0) (void)xb_add(&bar[XB_XCNT(b.x)], 1u);
    return b;
}
__device__ __forceinline__ void xcd_barrier_complete(unsigned* bar, unsigned x, unsigned& nloc, unsigned& nx) {
    const unsigned G = gridDim.x * gridDim.y * gridDim.z;
    unsigned sum, cnt, mine, sp = 0u;
    for (;;) {
        sum = 0u; cnt = 0u; mine = 0u;
#pragma unroll
        for (unsigned j = 0; j < 16; ++j) { const unsigned c = xb_ld(&bar[XB_XCNT(j)]); sum += c; cnt += (c > 0u) ? 1u : 0u; mine = (j == x) ? c : mine; }
        if (sum == G) break;
        __builtin_amdgcn_s_sleep(1);
        if ((++sp & 255u) == 0u) { if (xb_ld(&bar[XB_TMO])) break; if (sp > XB_SPIN_CAP) { atomicAdd(&bar[XB_TMO], 1u); break; } }
    }
    nloc = mine > 0u ? mine : 1u; nx = cnt > 0u ? cnt : 1u;
}

__device__ __forceinline__ void xcd_barrier(const XcdBarrier& b, int wv) {
    asm volatile("s_waitcnt vmcnt(0)" ::: "memory");
    __syncthreads();
    if (get_tid(wv) == 0) {
        unsigned* bar = b.bar;
        __builtin_amdgcn_s_waitcnt(0);
        unsigned nloc = b.st[0], nx = b.st[1];
        if (nloc == 0u) { xcd_barrier_complete(bar, b.x, nloc, nx); b.st[0] = nloc; b.st[1] = nx; }
        const unsigned old = xb_add(&bar[XB_XSUB(b.x)], 1u);
        const unsigned gen = old / nloc;
        if (old + 1u == (gen + 1u) * nloc) {
            __builtin_amdgcn_fence(__ATOMIC_RELEASE, "agent");
            asm volatile("s_waitcnt vmcnt(0)" ::: "memory");
            const unsigned og = xb_add(&bar[XB_TOP], 1u);
            const unsigned tg = og / nx;
            if (og + 1u == (tg + 1u) * nx) xb_add(&bar[XB_TOPGEN], 1u);
            else XB_SPIN(xb_ld(&bar[XB_TOPGEN]) == tg, bar);
            __builtin_amdgcn_fence(__ATOMIC_ACQUIRE, "agent");
            xb_add(&bar[XB_XGEN(b.x)], 1u);
            asm volatile("s_waitcnt vmcnt(0)" ::: "memory");
        } else {
            XB_SPIN(xb_ld(&bar[XB_XGEN(b.x)]) == gen, bar);
            __builtin_amdgcn_fence(__ATOMIC_ACQUIRE, "agent");
            asm volatile("s_waitcnt vmcnt(0)" ::: "memory");
        }
    }
    __syncthreads();
}

constexpr int PARAM_OFF = LDS_BYTES - 256;
static_assert(G2_END <= PARAM_OFF && sizeof(Params) <= 208, "LDS map");
DI const float* ld_uptr(const LAS unsigned long long* s, int i) {
    const unsigned long long v = s[i];
    const unsigned lo = __builtin_amdgcn_readfirstlane((unsigned)v), hi = __builtin_amdgcn_readfirstlane((unsigned)(v >> 32));
    return (const float*)(const __attribute__((address_space(1))) float*)(((unsigned long long)hi << 32) | lo);
}
DI Params load_params(LAS unsigned char* lds) {
    LAS unsigned char* pb = lds + PARAM_OFF; asm volatile("" : "+v"(pb));
    const LAS unsigned long long* s = (const LAS unsigned long long*)pb;
    Params Q;
    Q.x = ld_uptr(s, 0); Q.c = ld_uptr(s, 1); Q.ctx = ld_uptr(s, 2); Q.c_ctx = ld_uptr(s, 3); Q.ada_w = ld_uptr(s, 4); Q.ada_b = ld_uptr(s, 5); Q.norm_w = ld_uptr(s, 6);
    Q.ev_w_in = ld_uptr(s, 7); Q.ev_conv_w = ld_uptr(s, 8); Q.ev_conv_b = ld_uptr(s, 9); Q.ev_rg_wx = ld_uptr(s, 10); Q.ev_rg_bx = ld_uptr(s, 11); Q.ev_rg_wa = ld_uptr(s, 12);
    Q.ev_rg_ba = ld_uptr(s, 13); Q.ev_rg_lambda = ld_uptr(s, 14); Q.ev_sink = ld_uptr(s, 15); Q.ev_w_out = ld_uptr(s, 16); Q.od_w_in = ld_uptr(s, 17); Q.od_lb_raw = ld_uptr(s, 18);
    Q.od_gnorm_w = ld_uptr(s, 19); Q.od_w_out = ld_uptr(s, 20); Q.final_norm_w = ld_uptr(s, 21); Q.out = (float*)ld_uptr(s, 22); Q.ws = (unsigned char*)ld_uptr(s, 23);
    Q.ph_lo = 0; Q.ph_hi = 0;
    return Q;
}
DI void run_phase(LAS unsigned char* lds, int ph, int wv) {
    #ifndef PHMASK
#define PHMASK 0xffff
#endif
    if (ph == 0) { if (PHMASK & 1) { const Params P = load_params(lds); phase_pro(P, lds, wv); } return; }
    if (ph == NPHASE - 1) { if (PHMASK & 2) { const Params P = load_params(lds); phase_final(P, wv); } return; }
    const int layer = (ph - 1) / 5, sub = (ph - 1) % 5, j = layer >> 1;
    const bool even = (layer & 1) == 0;
    if (sub == 0) { if (PHMASK & 4) { const Params P = load_params(lds); phase_norm(P, lds, layer, wv); } return; }
    if (sub == 1) {
        const Params P = load_params(lds); bf16_t* pbuf = (bf16_t*)(P.ws + WS_P);
        const int N = even ? EVEN_IN : ODD_IN;
        pg8::Gemm gm{(const bf16_t*)(P.ws + WS_OV), (const bf16_t*)(P.ws + WS_WIN), MROWS, N, 1024, 1024};
        pg8::StaticOrder S; S.init(MROWS, N, (int)gridDim.x, get_bid());
        EpiStoreBf16 E{pbuf, N};
        if (PHMASK & 8) pg8::gemm_phase<EpiStoreBf16, pg8::StaticOrder, true, true>(lds, gm, S, E, wv);
        return;
    }
    if (sub == 2) {
        const Params P = load_params(lds);
        if (even) {
            constexpr int NRG = NB * NCHUNK * 8;
#if defined(SPLIT_ATTN)
            for (int it = get_bid(); it < NRG; it += gridDim.x) rglru_item(P, lds, j, it, wv);
#else
            for (int it = get_bid(); it < NRG + 576; it += gridDim.x) {
                if (it < NRG) { if (PHMASK & 32) rglru_item(P, lds, j, it, wv); } else { if (PHMASK & 16) attn_item(P, lds, j, it - NRG, wv); }
            }
#endif
        } else {
            for (int it = get_bid(); it < 128; it += gridDim.x) { if (PHMASK & 64) { if (it & 1) gla2_item<1>(P, lds, j, it >> 4, (it >> 1) & 7, wv); else gla2_item<0>(P, lds, j, it >> 4, (it >> 1) & 7, wv); } }
        }
        return;
    }
    if (sub == 3) {
        const Params P = load_params(lds);
        if (!even) { if (PHMASK & 256) phase_readout(P, j, wv); }
#if defined(SPLIT_ATTN)
        else { for (int it = get_bid(); it < 576; it += gridDim.x) attn_item(P, lds, j, it, wv); }
#endif
        return;
    }
    {
        const Params P = load_params(lds); bf16_t* pbuf = (bf16_t*)(P.ws + WS_P);
        const int K = even ? 2048 : 1024, lda = even ? EVEN_IN : ODD_IN;
        pg8::Gemm gm{pbuf + (even ? 1536 : 4096), (const bf16_t*)(P.ws + WS_WOUT), MROWS, 1024, K, lda};
        pg8::StaticOrder S; S.init(MROWS, 1024, (int)gridDim.x, get_bid());
        const float* hl = layer == 0 ? P.x : P.out; const float* hc = layer == 0 ? P.ctx : (const float*)(P.ws + WS_HCTX);
        EpiResid E{hl, hc, P.out, (float*)(P.ws + WS_HCTX), (const float*)(P.ws + WS_MOD) + (size_t)layer * 9 * 3072 + 2048};
        if (PHMASK & 512) pg8::gemm_phase<EpiResid, pg8::StaticOrder, true, true>(lds, gm, S, E, wv);
    }
}

__global__ void __launch_bounds__(512, 2) mega(Params P) {
    extern __shared__ __attribute__((aligned(16))) unsigned char lds_raw[];
    LAS unsigned char* lds = (LAS unsigned char*)lds_raw;
    cg::grid_group grid = cg::this_grid();
    const int wv = __builtin_amdgcn_readfirstlane((int)(threadIdx.x >> 6));
    if (get_tid(wv) == 0) {
        ((LAS unsigned*)(lds + PARAM_OFF + 208))[0] = 0u; ((LAS unsigned*)(lds + PARAM_OFF + 208))[1] = 0u;
        LAS unsigned long long* d = (LAS unsigned long long*)(lds + PARAM_OFF);
        d[0] = (unsigned long long)P.x; d[1] = (unsigned long long)P.c; d[2] = (unsigned long long)P.ctx; d[3] = (unsigned long long)P.c_ctx; d[4] = (unsigned long long)P.ada_w;
        d[5] = (unsigned long long)P.ada_b; d[6] = (unsigned long long)P.norm_w; d[7] = (unsigned long long)P.ev_w_in; d[8] = (unsigned long long)P.ev_conv_w; d[9] = (unsigned long long)P.ev_conv_b;
        d[10] = (unsigned long long)P.ev_rg_wx; d[11] = (unsigned long long)P.ev_rg_bx; d[12] = (unsigned long long)P.ev_rg_wa; d[13] = (unsigned long long)P.ev_rg_ba; d[14] = (unsigned long long)P.ev_rg_lambda;
        d[15] = (unsigned long long)P.ev_sink; d[16] = (unsigned long long)P.ev_w_out; d[17] = (unsigned long long)P.od_w_in; d[18] = (unsigned long long)P.od_lb_raw; d[19] = (unsigned long long)P.od_gnorm_w;
        d[20] = (unsigned long long)P.od_w_out; d[21] = (unsigned long long)P.final_norm_w; d[22] = (unsigned long long)P.out; d[23] = (unsigned long long)P.ws;
    }
    __syncthreads();
    const int ph_lo = P.ph_lo, ph_hi = P.ph_hi;
    (void)xcd_barrier_post((unsigned*)(P.ws + WS_CTL) + 4096, (volatile LAS unsigned*)(lds + PARAM_OFF + 208), wv);
#define GRID_SYNC(first) do { if (first) grid.sync(); else { XcdBarrier xb_; xb_.bar = (unsigned*)(load_params(lds).ws + WS_CTL) + 4096; xb_.x = xb_xcc_id(); xb_.st = (volatile LAS unsigned*)(lds + PARAM_OFF + 208); xcd_barrier(xb_, wv); } } while (0)
#if defined(PROBE_S)
    constexpr int PREP = PROBE_E - PROBE_S + 1;
#pragma unroll 1
    for (int seq = ph_lo; seq < ph_hi + PREP; ++seq) {
        if (seq > ph_lo) GRID_SYNC(seq == ph_lo + 1);
        const int ph = seq <= PROBE_E ? seq : seq - PREP;
        run_phase(lds, ph, wv);
    }
#else
#pragma unroll 1
    for (int ph = ph_lo; ph < ph_hi; ++ph) {
#if !defined(SPLIT_ATTN)
        if (ph >= 1 && ph < NPHASE - 1 && (ph - 1) % 5 == 3 && (((ph - 1) / 5) & 1) == 0) continue;
#endif
        if (ph > ph_lo) GRID_SYNC(ph == ph_lo + 1);
        run_phase(lds, ph, wv);
    }
#endif
}

extern "C" void kernel_launch(void* const* d_in, const int* in_sizes, int n_in, void* d_out, int out_size, void* d_ws, size_t ws_size, hipStream_t stream) {
    static int grid = 0;
    if (grid == 0) {
        if (n_in != 22 || ws_size < WS_END) { fprintf(stderr, "kernel_launch: unexpected inputs (n_in %d, ws %zu)\n", n_in, ws_size); grid = -1; return; }
        int dev = 0, cus = 0, per_cu = 0;
        hipGetDevice(&dev);
        hipDeviceGetAttribute(&cus, hipDeviceAttributeMultiprocessorCount, dev);
        if (hipFuncSetAttribute((const void*)mega, hipFuncAttributeMaxDynamicSharedMemorySize, LDS_BYTES) != hipSuccess) { fprintf(stderr, "kernel_launch: hipFuncSetAttribute failed\n"); grid = -1; return; }
        if (hipOccupancyMaxActiveBlocksPerMultiprocessor(&per_cu, (const void*)mega, 512, LDS_BYTES) != hipSuccess || per_cu < 1) { fprintf(stderr, "kernel_launch: occupancy query gives %d\n", per_cu); per_cu = 1; }
        (void)hipGetLastError();
        grid = cus;
    }
    if (grid < 0) return;
    if (hipMemsetAsync((char*)d_ws + WS_CTL, 0, 65536, stream) != hipSuccess) { fprintf(stderr, "kernel_launch: memset failed\n"); return; }
    Params P{};
    const float** pp = (const float**)&P;
    for (int i = 0; i < 22; ++i) pp[i] = (const float*)d_in[i];
    P.out = (float*)d_out; P.ws = (unsigned char*)d_ws;
#if ONE_LAUNCH
    P.ph_lo = 0; P.ph_hi = NPHASE;
    { void* args[] = {&P}; hipError_t e = hipLaunchCooperativeKernel((const void*)mega, dim3(grid), dim3(512), args, LDS_BYTES, stream);
      if (e != hipSuccess) fprintf(stderr, "cooperative launch failed: %s (grid %d)\n", hipGetErrorString(e), grid); }
#else
    for (int ph = 0; ph < NPHASE; ++ph) {
        P.ph_lo = ph; P.ph_hi = ph + 1;
        void* args[] = {&P}; hipError_t e = hipLaunchCooperativeKernel((const void*)mega, dim3(grid), dim3(512), args, LDS_BYTES, stream);
        if (e != hipSuccess) { fprintf(stderr, "launch %d failed: %s (grid %d)\n", ph, hipGetErrorString(e), grid); break; }
    }
#endif
}
```

```cpp
#include <hip/hip_runtime.h>
#include <hip/hip_cooperative_groups.h>
#include <cstdio>
#include <cstdint>
namespace cg = cooperative_groups;

#ifndef ONE_LAUNCH
#define ONE_LAUNCH 1
#endif

#define DI __device__ __forceinline__
#define LAS __attribute__((address_space(3)))
__device__ __forceinline__ int lane_nh() { int l; asm volatile("v_mbcnt_lo_u32_b32 %0, -1, 0\n\tv_mbcnt_hi_u32_b32 %0, -1, %0" : "=v"(l)); return l; }
__device__ __forceinline__ int get_tid(int wv) { asm volatile("" : "+s"(wv)); return wv * 64 + lane_nh(); }
__device__ __forceinline__ float shfl_xor_f(float v, int o) { return __int_as_float(__builtin_amdgcn_ds_bpermute((lane_nh() ^ o) << 2, __float_as_int(v))); }
__device__ __forceinline__ int get_bid() { int b = blockIdx.x; asm volatile("" : "+s"(b)); return b; }
namespace pg8 {
#define PG8_LAS __attribute__((address_space(3)))
typedef unsigned short bf16_t;
typedef short bf16x8 __attribute__((ext_vector_type(8)));
typedef float f32x4 __attribute__((ext_vector_type(4)));
typedef unsigned u32x4 __attribute__((ext_vector_type(4)));
constexpr int BM = 256, BK = 64, HALF = 128, HTB = HALF * BK * 2  , STAGE_BYTES = 8 * HTB, NXCD = 8, WGM = 8;

__host__ __device__ __forceinline__ int lds_byte(int r, int c) { const int st = (r >> 4) * 2 + (c >> 5), rr = r & 15, cc = c & 31, ob = rr * 64 + cc * 2; return st * 1024 + (ob ^ (((ob >> 9) & 1) << 5)); }
__host__ __device__ __forceinline__ void stage_rc(int b, int& R, int& C) { const int st = b / 1024, sb = b % 1024, swz = sb ^ (((sb >> 9) & 1) << 5); R = (st >> 1) * 16 + swz / 64; C = (st & 1) * 32 + (swz % 64) / 2; }
__host__ __device__ __forceinline__ int perm32(int rho) { const int n = rho >> 4, i = rho & 15; return 8 * (i >> 2) + 4 * n + (i & 3); }

struct Unit { int pm, pn; };
struct Gemm { const bf16_t* A; const bf16_t* Bt; int M, N, K, lda; };

struct StaticOrder {
    int nM, nN, nwg, G, c;
    __host__ __device__ void init(int M, int N, int G_, int c_) { nM = M / BM; nN = N / BM; nwg = nM * nN; G = G_; c = c_; }
    __host__ __device__ bool next(int i, Unit& u) const {
        const long L = (long)i * G + c; if (L >= nwg) return false;
        int wgid = (int)L; { const int q = nwg / NXCD, r = nwg % NXCD, xcd = wgid % NXCD, off = wgid / NXCD; wgid = (xcd < r ? xcd * (q + 1) : r * (q + 1) + (xcd - r) * q) + off; }
        const int nig = WGM * nN, gid = wgid / nig, fm = gid * WGM, gsz = (nM - fm) < WGM ? (nM - fm) : WGM;
        u.pm = fm + ((wgid % nig) % gsz); u.pn = (wgid % nig) / gsz; return true;
    }
    __device__ __forceinline__ void a_ready(const Unit&) const {}
    __device__ __forceinline__ void done(const Unit&) const {}
};

template <class Epi, class Sched, bool ALIGN_EPI = false, bool SP2 = false>
__device__ __forceinline__ void gemm_phase(PG8_LAS unsigned char* lds, const Gemm g, const Sched& S, const Epi& E, int wv) {
    const int tid = get_tid(wv), wid = __builtin_amdgcn_readfirstlane(tid >> 6), lane = tid & 63, wr = wid >> 2, wc = wid & 3, fr = lane & 15, fq = lane >> 4;
    const int K = g.K, nt = K / BK;
    unsigned voffA[2], voffB[2];
#pragma unroll
    for (int i = 0; i < 2; ++i) { int R, C; stage_rc(tid * 16 + i * 8192, R, C); const int Rb = Epi::PERM ? ((R & ~31) + perm32(R & 31)) : R;
        voffA[i] = (unsigned)(R * g.lda + C) * 2u; voffB[i] = (unsigned)(Rb * K + C) * 2u; }
    const size_t kstep = (size_t)(BK * 2);
    const size_t hstepA = (size_t)HALF * g.lda * 2, hstepB = (size_t)HALF * K * 2;
    const size_t tstepA = 2 * hstepA, tstepB = 2 * hstepB;
    const unsigned ldsw = (unsigned)wid * 1024u;
    const int aoff = lds_byte(wr * 64 + fr, fq * 8), boff = lds_byte(wc * 32 + fr, fq * 8);
#define PG8_SA(b, h) (((b) * 2 + (h)) * HTB)
#define PG8_SB(b, h) ((4 + (b) * 2 + (h)) * HTB)
#define PG8_STAGE(bufoff, gbase, voff) do { _Pragma("unroll") for (int _i = 0; _i < 2; ++_i) \
        __builtin_amdgcn_global_load_lds((const unsigned*)((const char*)(gbase) + (voff)[_i]), (PG8_LAS unsigned*)(lds + (bufoff) + ldsw + _i * 8192), 16, 0, 0); } while (0)
#define PG8_LDA(dst, b, h) do { _Pragma("unroll") for (int m = 0; m < 4; ++m) _Pragma("unroll") for (int k = 0; k < 2; ++k) dst[m][k] = *(const PG8_LAS bf16x8*)(lds + PG8_SA(b, h) + aoff + m * 2048 + k * 1024); } while (0)
#define PG8_LDB(dst, b, h) do { _Pragma("unroll") for (int n = 0; n < 2; ++n) _Pragma("unroll") for (int k = 0; k < 2; ++k) dst[n][k] = *(const PG8_LAS bf16x8*)(lds + PG8_SB(b, h) + boff + n * 2048 + k * 1024); } while (0)
#define PG8_MMA(ai, bj, At, Bt) do { __builtin_amdgcn_s_setprio(1); _Pragma("unroll") for (int m = 0; m < 4; ++m) _Pragma("unroll") for (int n = 0; n < 2; ++n) _Pragma("unroll") for (int k = 0; k < 2; ++k) \
        acc[ai][bj][m][n] = __builtin_amdgcn_mfma_f32_16x16x32_bf16(Bt[n][k], At[m][k], acc[ai][bj][m][n], 0, 0, 0); __builtin_amdgcn_s_setprio(0); } while (0)
#define PG8_WAIT_V(n) asm volatile("s_waitcnt vmcnt(" #n ")" ::: "memory")
#define PG8_WAIT_L(n) asm volatile("s_waitcnt lgkmcnt(" #n ")" ::: "memory")
#define PG8_BAR __builtin_amdgcn_s_barrier()
#define PG8_SCHED __builtin_amdgcn_sched_barrier(0)
    Unit cur, nxt; int ui = 0;
    if (!S.next(0, cur)) return;
    f32x4 acc[2][2][4][2];
#pragma unroll
    for (int a = 0; a < 2; ++a)
#pragma unroll
        for (int b = 0; b < 2; ++b)
#pragma unroll
            for (int m = 0; m < 4; ++m)
#pragma unroll
                for (int n = 0; n < 2; ++n) acc[a][b][m][n] = (f32x4){0.f, 0.f, 0.f, 0.f};
    bf16x8 At[4][2], B0[2][2], B1[2][2];
    const char* cA = (const char*)g.A + (size_t)cur.pm * tstepA; const char* cB = (const char*)g.Bt + (size_t)cur.pn * tstepB;
    S.a_ready(cur);
    if constexpr (SP2) {
        PG8_STAGE(PG8_SB(0, 0), cB, voffB); PG8_STAGE(PG8_SB(0, 1), cB + hstepB, voffB); PG8_STAGE(PG8_SA(0, 0), cA, voffA); PG8_STAGE(PG8_SA(0, 1), cA + hstepA, voffA);
        if (wr == 1) PG8_BAR;
        PG8_WAIT_V(2); PG8_BAR;
        PG8_STAGE(PG8_SB(1, 0), cB + kstep, voffB); PG8_STAGE(PG8_SA(1, 0), cA + kstep, voffA); PG8_STAGE(PG8_SB(1, 1), cB + hstepB + kstep, voffB);
        PG8_WAIT_V(6); PG8_BAR;
    } else {
        PG8_STAGE(PG8_SB(0, 0), cB, voffB); PG8_STAGE(PG8_SA(0, 0), cA, voffA); PG8_STAGE(PG8_SB(0, 1), cB + hstepB, voffB); PG8_STAGE(PG8_SA(0, 1), cA + hstepA, voffA);
        if (wr == 1) PG8_BAR;
        PG8_WAIT_V(4); PG8_BAR;
        PG8_STAGE(PG8_SB(1, 0), cB + kstep, voffB); PG8_STAGE(PG8_SA(1, 0), cA + kstep, voffA); PG8_STAGE(PG8_SB(1, 1), cB + hstepB + kstep, voffB);
        PG8_WAIT_V(6); PG8_BAR;
    }
    for (;;) {
        const bool has_next = S.next(ui + 1, nxt);
        const char* nA = has_next ? (const char*)g.A + (size_t)nxt.pm * tstepA : cA; const char* nB = has_next ? (const char*)g.Bt + (size_t)nxt.pn * tstepB : cB;
        for (int t = 0; t < nt; t += 2) {
            const bool last = (t == nt - 2);
            const char* a1 = cA + (size_t)(t + 1) * kstep;
            const char* a2 = last ? nA : cA + (size_t)(t + 2) * kstep; const char* b2 = last ? nB : cB + (size_t)(t + 2) * kstep;
            const char* a3 = a2 + kstep; const char* b3 = b2 + kstep;
            if (last && has_next) S.a_ready(nxt);
            if constexpr (SP2) {
            PG8_LDB(B0, 0, 0); PG8_LDB(B1, 0, 1); PG8_SCHED; PG8_LDA(At, 0, 0); PG8_STAGE(PG8_SA(1, 1), a1 + hstepA, voffA);
            PG8_WAIT_V(8); PG8_WAIT_L(0); PG8_BAR; PG8_MMA(0, 0, At, B0); PG8_MMA(0, 1, At, B1); PG8_BAR; PG8_SCHED;
            PG8_LDA(At, 0, 1); PG8_STAGE(PG8_SB(0, 0), b2, voffB); PG8_STAGE(PG8_SB(0, 1), b2 + hstepB, voffB); PG8_STAGE(PG8_SA(0, 0), a2, voffA);
            PG8_WAIT_V(8); PG8_WAIT_L(0); PG8_BAR; PG8_MMA(1, 0, At, B0); PG8_MMA(1, 1, At, B1); PG8_BAR; PG8_SCHED;
            PG8_LDB(B0, 1, 0); PG8_LDB(B1, 1, 1); PG8_SCHED; PG8_LDA(At, 1, 0); PG8_STAGE(PG8_SA(0, 1), a2 + hstepA, voffA);
            PG8_WAIT_V(8); PG8_WAIT_L(0); PG8_BAR; PG8_MMA(0, 0, At, B0); PG8_MMA(0, 1, At, B1); PG8_BAR; PG8_SCHED;
            PG8_LDA(At, 1, 1); PG8_STAGE(PG8_SB(1, 0), b3, voffB); PG8_STAGE(PG8_SB(1, 1), b3 + hstepB, voffB); PG8_STAGE(PG8_SA(1, 0), a3, voffA);
            PG8_WAIT_V(8); PG8_WAIT_L(0); PG8_BAR; PG8_MMA(1, 0, At, B0); PG8_MMA(1, 1, At, B1); PG8_BAR; PG8_SCHED;
            } else {
            PG8_LDB(B0, 0, 0); PG8_SCHED; PG8_LDA(At, 0, 0); PG8_STAGE(PG8_SA(1, 1), a1 + hstepA, voffA);
            PG8_WAIT_L(8); PG8_BAR; PG8_WAIT_L(0); PG8_MMA(0, 0, At, B0); PG8_BAR; PG8_SCHED;
            PG8_LDB(B1, 0, 1); PG8_STAGE(PG8_SB(0, 0), b2, voffB);
            PG8_BAR; PG8_WAIT_L(0); PG8_MMA(0, 1, At, B1); PG8_BAR;
            PG8_LDA(At, 0, 1); PG8_STAGE(PG8_SA(0, 0), a2, voffA);
            PG8_BAR; PG8_WAIT_L(0); PG8_MMA(1, 0, At, B0); PG8_BAR; PG8_SCHED;
            PG8_STAGE(PG8_SB(0, 1), b2 + hstepB, voffB);
            PG8_WAIT_V(6); PG8_BAR; PG8_MMA(1, 1, At, B1); PG8_BAR;
            PG8_LDB(B0, 1, 0); PG8_SCHED; PG8_LDA(At, 1, 0); PG8_STAGE(PG8_SA(0, 1), a2 + hstepA, voffA);
            PG8_WAIT_L(8); PG8_BAR; PG8_WAIT_L(0); PG8_MMA(0, 0, At, B0); PG8_BAR; PG8_SCHED;
            PG8_LDB(B1, 1, 1); PG8_STAGE(PG8_SB(1, 0), b3, voffB);
            PG8_BAR; PG8_WAIT_L(0); PG8_MMA(0, 1, At, B1); PG8_BAR;
            PG8_LDA(At, 1, 1); PG8_STAGE(PG8_SA(1, 0), a3, voffA);
            PG8_BAR; PG8_WAIT_L(0); PG8_MMA(1, 0, At, B0); PG8_BAR; PG8_SCHED;
            PG8_STAGE(PG8_SB(1, 1), b3 + hstepB, voffB);
            PG8_WAIT_V(6); PG8_BAR; PG8_MMA(1, 1, At, B1); PG8_BAR;
            }
        }
        if constexpr (ALIGN_EPI) { if (wr == 0) PG8_BAR; }
        if constexpr (!Epi::AFTER_DRAIN) { E(acc, cur, wr, wc, fr, fq); S.done(cur); }
        if (!has_next) break;
#pragma unroll
        for (int a = 0; a < 2; ++a)
#pragma unroll
            for (int b = 0; b < 2; ++b)
#pragma unroll
                for (int m = 0; m < 4; ++m)
#pragma unroll
                    for (int n = 0; n < 2; ++n) acc[a][b][m][n] = (f32x4){0.f, 0.f, 0.f, 0.f};
        cur = nxt; cA = nA; cB = nB; ++ui;
        if constexpr (ALIGN_EPI) { if (wr == 1) PG8_BAR; }
    }
    PG8_WAIT_V(0);
    if constexpr (!ALIGN_EPI) { if (wr == 0) PG8_BAR; }
    PG8_BAR;
    if constexpr (Epi::AFTER_DRAIN) { E.fused(acc, cur, wr, wc, fr, fq, lds, wid, lane); S.done(cur); }
#undef PG8_SA
#undef PG8_SB
#undef PG8_STAGE
#undef PG8_LDA
#undef PG8_LDB
#undef PG8_MMA
#undef PG8_WAIT_V
#undef PG8_WAIT_L
#undef PG8_BAR
#undef PG8_SCHED
}
}

typedef unsigned short bf16_t;
typedef short bf16x8 __attribute__((ext_vector_type(8)));
typedef short s16x4 __attribute__((ext_vector_type(4)));
typedef float f32x4 __attribute__((ext_vector_type(4)));
typedef float f32x16 __attribute__((ext_vector_type(16)));
typedef unsigned u32x4 __attribute__((ext_vector_type(4)));
typedef unsigned u32x2 __attribute__((ext_vector_type(2)));
typedef float f32x2 __attribute__((ext_vector_type(2)));

constexpr int DM = 1024, NB = 8, SEQ = 2048, CTXL = 256, LT = SEQ + CTXL  , MROWS = NB * LT  ;
constexpr int EVEN_IN = 4608, ODD_IN = 5120, NCHUNK = LT / 64  ;
constexpr float RMS_EPS = 1e-6f, LOG2E = 1.4426950408889634f;
constexpr int LDS_BYTES = 160 * 1024;
constexpr int NPHASE = 22;

constexpr size_t WS_CTL = 0;
constexpr size_t WS_MOD = 65536;
constexpr size_t WS_ROPE = 524288;
constexpr size_t WS_AGG = 1048576;
constexpr size_t WS_HCTX = WS_AGG + 4718592;
constexpr size_t WS_WIN = WS_HCTX + 8388608;
constexpr size_t WS_WOUT = WS_WIN + 10485760;
constexpr size_t WS_WRG = WS_WOUT + 4194304;
constexpr size_t WS_OV = WS_WRG + 1048576;
constexpr size_t WS_P = WS_OV + 37748736;
constexpr size_t WS_END = WS_P + 188743680;
static_assert(WS_END <= 268435456, "workspace map exceeds 256 MiB");

struct Params {
    const float *x, *c, *ctx, *c_ctx, *ada_w, *ada_b, *norm_w, *ev_w_in, *ev_conv_w, *ev_conv_b, *ev_rg_wx, *ev_rg_bx, *ev_rg_wa, *ev_rg_ba,
        *ev_rg_lambda, *ev_sink, *ev_w_out, *od_w_in, *od_lb_raw, *od_gnorm_w, *od_w_out, *final_norm_w;
    float* out; unsigned char* ws; int ph_lo, ph_hi;
};

DI float bf2f(unsigned short v) { return __uint_as_float((unsigned)v << 16); }
DI unsigned f2bf(float f) { unsigned u = __float_as_uint(f); return (u + 0x7fffu + ((u >> 16) & 1u)) >> 16; }
typedef __bf16 bf16x2_hw __attribute__((ext_vector_type(2)));
DI unsigned pk2(float lo, float hi) { const f32x2 v = {lo, hi}; return __builtin_bit_cast(unsigned, __builtin_convertvector(v, bf16x2_hw)); }
DI float sigm(float x) { return __builtin_amdgcn_rcpf(1.f + __expf(-x)); }
DI float softplus_neg(float lam) {
    const float e = __expf(-lam);
    return e < 0.06f ? e * (1.f + e * (-0.5f + e * (0.33333333f + e * (-0.25f + e * 0.2f)))) : __logf(1.f + e);
}
DI float neg_expm1(float x) {
    return x > -0.25f ? -x * (1.f + x * (0.5f + x * (0.16666667f + x * (0.041666668f + x * (0.0083333338f + x * 0.0013888889f))))) : 1.f - __expf(x);
}
DI float wave_sum(float v) {
#pragma unroll
    for (int o = 1; o < 64; o <<= 1) v += shfl_xor_f(v, o);
    return v;
}
DI int crow(int reg, int h) { return (reg & 3) + 8 * (reg >> 2) + 4 * h; }
#define MFMA16(a, b, c) __builtin_amdgcn_mfma_f32_16x16x32_bf16((a), (b), (c), 0, 0, 0)
#define MFMA32(a, b, c) __builtin_amdgcn_mfma_f32_32x32x16_bf16((a), (b), (c), 0, 0, 0)

struct EpiStoreBf16 {
    static constexpr bool PERM = true, AFTER_DRAIN = false;
    bf16_t* O; int ldc;
    DI void operator()(const f32x4 (&acc)[2][2][4][2], const pg8::Unit& u, int wr, int wc, int fr, int fq) const {
        const int row0 = u.pm * 256 + wr * 64 + fr, col0 = u.pn * 256 + wc * 32 + 8 * fq;
#pragma unroll
        for (int ai = 0; ai < 2; ++ai)
#pragma unroll
            for (int m = 0; m < 4; ++m) { bf16_t* rowp = O + (size_t)(row0 + ai * 128 + m * 16) * ldc + col0;
#pragma unroll
                for (int bj = 0; bj < 2; ++bj) { const f32x4 v0 = acc[ai][bj][m][0], v1 = acc[ai][bj][m][1];
                    u32x4 w; w.x = pk2(v0[0], v0[1]); w.y = pk2(v0[2], v0[3]); w.z = pk2(v1[0], v1[1]); w.w = pk2(v1[2], v1[3]);
                    *(u32x4*)(rowp + bj * 128) = w; } }
    }
};
struct EpiResid {
    static constexpr bool PERM = false, AFTER_DRAIN = false;
    const float* in_lat; const float* in_ctx; float* out_lat; float* out_ctx; const float* gate;
    DI void operator()(const f32x4 (&acc)[2][2][4][2], const pg8::Unit& u, int wr, int wc, int fr, int fq) const {
        const int b = u.pm / 9, jt = u.pm % 9;
        const float* ib; float* ob; const float* g;
        if (jt == 0) { const size_t off = (size_t)b * CTXL * DM; ib = in_ctx + off; ob = out_ctx + off; g = gate + 8 * 3072; }
        else { const size_t off = ((size_t)b * SEQ + (size_t)(jt - 1) * 256) * DM; ib = in_lat + off; ob = out_lat + off; g = gate + b * 3072; }
        const int col0 = u.pn * 256 + wc * 32 + 4 * fq;
#pragma unroll
        for (int bj = 0; bj < 2; ++bj)
#pragma unroll
            for (int n = 0; n < 2; ++n) {
                const f32x4 gvv = *(const f32x4*)(g + col0 + bj * 128 + n * 16);
#pragma unroll
                for (int ai = 0; ai < 2; ++ai) {
#pragma unroll
                    for (int m = 0; m < 4; ++m) { const int r = ai * 128 + wr * 64 + m * 16 + fr;
                        const size_t off = (size_t)r * DM + col0 + bj * 128 + n * 16;
                        const f32x4 o = *(const f32x4*)(ib + off) + gvv * acc[ai][bj][m][n]; *(f32x4*)(ob + off) = o; }
                    asm volatile("" ::: "memory");
                }
            }
    }
};

DI void phase_pro(const Params& P, LAS unsigned char* lds, int wv) {
    const int tid = get_tid(wv);
    LAS float* s = (LAS float*)lds;
    LAS float* red = (LAS float*)(lds + 36864);
    float* mod = (float*)(P.ws + WS_MOD);
    for (int i = tid; i < 9 * 1024; i += 512) { const int r = i >> 10, k = i & 1023; const float v = r < 8 ? P.c[r * 1024 + k] : P.c_ctx[k]; s[i] = v * sigm(v); }
    __syncthreads();
    for (int item = get_bid(); item < 384; item += gridDim.x) {
        const int l = item / 96, n0 = (item % 96) * 32, ks = tid >> 5, col = tid & 31;
        const float* w = P.ada_w + (size_t)l * 1024 * 3072 + n0 + col;
        float acc[9];
#pragma unroll
        for (int r = 0; r < 9; ++r) acc[r] = 0.f;
#pragma unroll 8
        for (int kk = 0; kk < 64; ++kk) { const int k = ks * 64 + kk; const float wv = w[(size_t)k * 3072];
#pragma unroll
            for (int r = 0; r < 9; ++r) acc[r] += s[r * 1024 + k] * wv; }
#pragma unroll
        for (int r = 0; r < 9; ++r) red[(ks * 9 + r) * 32 + col] = acc[r];
        __syncthreads();
        if (tid < 288) { const int r = tid >> 5, cc = tid & 31; float sum = 0.f;
#pragma unroll
            for (int k2 = 0; k2 < 16; ++k2) sum += red[(k2 * 9 + r) * 32 + cc];
            mod[(l * 9 + r) * 3072 + n0 + cc] = sum + P.ada_b[l * 3072 + n0 + cc]; }
        __syncthreads();
    }
    float* cos_t = (float*)(P.ws + WS_ROPE); float* sin_t = cos_t + SEQ * 32;
    for (int i = get_bid() * 512 + tid; i < SEQ * 32; i += gridDim.x * 512) {
        const int pos = i >> 5, jj = i & 31, fi = jj & 15;
        const float inv = __builtin_amdgcn_exp2f(-(float)(2 * fi) * (13.287712379549449f / 32.f));
        const float ang = (float)(jj < 16 ? (pos >> 6) : (pos & 63)) * inv;
        cos_t[i] = __cosf(ang); sin_t[i] = __sinf(ang);
    }
}

DI void transpose_item(const float* W, int K, int N, bf16_t* WT, LAS float* scr, int item, int lane) {
    const int nblk = N / 32, kb = item / nblk, nb = item % nblk, k0 = 64 * kb, n0 = 32 * nb;
#pragma unroll 8
    for (int i = 0; i < 32; ++i) { const int kk = 2 * i + (lane >> 5); scr[kk * 33 + (lane & 31)] = W[(size_t)(k0 + kk) * N + n0 + (lane & 31)]; }
    asm volatile("s_waitcnt lgkmcnt(0)" ::: "memory");
    const int c = lane & 7;
#pragma unroll
    for (int j = 0; j < 4; ++j) { const int n = (lane >> 3) + 8 * j; const LAS float* sp = scr + (8 * c) * 33 + n;
        u32x4 o; o.x = pk2(sp[0 * 33], sp[1 * 33]); o.y = pk2(sp[2 * 33], sp[3 * 33]); o.z = pk2(sp[4 * 33], sp[5 * 33]); o.w = pk2(sp[6 * 33], sp[7 * 33]);
        *(u32x4*)(WT + (size_t)(n0 + n) * K + k0 + 8 * c) = o; }
    asm volatile("s_waitcnt lgkmcnt(0)" ::: "memory");
}

DI void phase_norm(const Params& P, LAS unsigned char* lds, int layer, int wv) {
    const int tid = get_tid(wv), lane = tid & 63, wave = tid >> 6;
    const int gw = get_bid() * 8 + wave, NGW = gridDim.x * 8;
    const int j = layer >> 1;
    LAS float* scr = (LAS float*)(lds + wave * 16384);
    bf16_t* WIN = (bf16_t*)(P.ws + WS_WIN); bf16_t* WOUT = (bf16_t*)(P.ws + WS_WOUT); bf16_t* WRG = (bf16_t*)(P.ws + WS_WRG);
    if ((layer & 1) == 0) {
        constexpr int I_IN = 16 * (EVEN_IN / 32), I_OUT = 32 * 32, I_RG = 32 * 8;
        for (int it = gw; it < I_IN + I_OUT + I_RG; it += NGW) {
            int r = it;
            if (r < I_IN) { transpose_item(P.ev_w_in + (size_t)j * 1024 * EVEN_IN, 1024, EVEN_IN, WIN, scr, r, lane); continue; } r -= I_IN;
            if (r < I_OUT) { transpose_item(P.ev_w_out + (size_t)j * 2048 * 1024, 2048, 1024, WOUT, scr, r, lane); continue; } r -= I_OUT;
            const int mat = r >> 3, sub = r & 7;
            const int dir = mat >> 4, gate = (mat >> 3) & 1, hd = mat & 7;
            const float* src = (gate == 0 ? P.ev_rg_wx : P.ev_rg_wa) + ((size_t)((j * 2 + dir) * 8 + hd)) * 16384;
            transpose_item(src, 128, 128, WRG + (size_t)mat * 16384, scr, sub, lane);
        }
    } else {
        constexpr int I_IN = 16 * (ODD_IN / 32), I_OUT = 16 * 32;
        for (int it = gw; it < I_IN + I_OUT; it += NGW) {
            int r = it;
            if (r < I_IN) { transpose_item(P.od_w_in + (size_t)j * 1024 * ODD_IN, 1024, ODD_IN, WIN, scr, r, lane); continue; } r -= I_IN;
            transpose_item(P.od_w_out + (size_t)j * 1024 * 1024, 1024, 1024, WOUT, scr, r, lane);
        }
    }
    const float* hl = layer == 0 ? P.x : P.out; const float* hc = layer == 0 ? P.ctx : (const float*)(P.ws + WS_HCTX);
    const float* mod = (const float*)(P.ws + WS_MOD) + (size_t)layer * 9 * 3072;
    const float* nw = P.norm_w + layer * 1024;
    bf16_t* U = (bf16_t*)(P.ws + WS_OV);
    for (int R = gw; R < MROWS; R += NGW) {
        const int b = R / LT, jr = R % LT;
        const float* src = jr < CTXL ? hc + ((size_t)b * CTXL + jr) * DM : hl + ((size_t)b * SEQ + (jr - CTXL)) * DM;
        const float* sh = mod + (jr < CTXL ? 8 : b) * 3072; const float* sc = sh + 1024;
        f32x4 v[4]; float ss = 0.f;
#pragma unroll
        for (int q = 0; q < 4; ++q) { v[q] = *(const f32x4*)(src + 4 * lane + 256 * q); ss += (v[q][0] * v[q][0] + v[q][1] * v[q][1]) + (v[q][2] * v[q][2] + v[q][3] * v[q][3]); }
        const float rstd = rsqrtf(wave_sum(ss) * (1.f / DM) + RMS_EPS);
#pragma unroll
        for (int q = 0; q < 4; ++q) { const int k = 4 * lane + 256 * q;
            const f32x4 w4 = *(const f32x4*)(nw + k), s4 = *(const f32x4*)(sc + k), h4 = *(const f32x4*)(sh + k);
            const f32x4 y = (v[q] * rstd) * w4; const f32x4 o = y * (s4 + 1.f) + h4;
            u32x2 w; w.x = pk2(o[0], o[1]); w.y = pk2(o[2], o[3]); *(u32x2*)(U + (size_t)R * DM + k) = w; }
    }
}

typedef _Float16 f16x2_t __attribute__((ext_vector_type(2)));
DI unsigned pkh2(float a, float b) { const f16x2_t v = {(_Float16)a, (_Float16)b}; return __builtin_bit_cast(unsigned, v); }
DI void unpkh2(unsigned u, float& a, float& b) { const f16x2_t v = __builtin_bit_cast(f16x2_t, u); a = (float)v[0]; b = (float)v[1]; }
constexpr int RG_UT = 0, RG_AL = 17408, RG_BL = 50176, RG_HP = 82944, RG_QA = 148480, RG_CAR = 152576, RG_FLAG = 153600, RG_END = 153664;
static_assert(RG_END <= LDS_BYTES - 256, "RG-LRU LDS map");
constexpr int CW_RG = 8192;
DI void rglru_item(const Params& P, LAS unsigned char* lds, int j, int item, int wv) {
    const int tid = get_tid(wv), lane = tid & 63, wave = tid >> 6, r = lane & 15, g = lane >> 4;
    const int grp = item / NCHUNK, ci = item % NCHUNK, b = grp >> 3, hd = grp & 7;
    bf16_t* p = (bf16_t*)(P.ws + WS_P);
    const bf16_t* WRG = (const bf16_t*)(P.ws + WS_WRG);
    unsigned long long* AGG = (unsigned long long*)(P.ws + WS_AGG);
    unsigned* cnt = (unsigned*)(P.ws + WS_CTL) + CW_RG + (j * 64 + grp) * 16;
    const int R0 = b * LT + ci * 64;
    const int seg_lo = b * LT + (ci < 4 ? 0 : CTXL), seg_hi = b * LT + (ci < 4 ? CTXL : LT);
    LAS bf16_t* UT = (LAS bf16_t*)(lds + RG_UT);
    LAS float* AL = (LAS float*)(lds + RG_AL);
    LAS float* BL = (LAS float*)(lds + RG_BL);
    LAS unsigned* HP = (LAS unsigned*)(lds + RG_HP);
    LAS float* QA = (LAS float*)(lds + RG_QA);
    LAS float* CAR = (LAS float*)(lds + RG_CAR);
#pragma unroll
    for (int rep = 0; rep < 2; ++rep) {
        const int idx = tid + rep * 512, t = idx >> 4, c0 = (idx & 15) * 8, cg0 = hd * 128 + c0;
        float acc[8];
        { const f32x4 b0 = *(const f32x4*)(P.ev_conv_b + j * 1024 + cg0), b1 = *(const f32x4*)(P.ev_conv_b + j * 1024 + cg0 + 4);
          acc[0] = b0[0]; acc[1] = b0[1]; acc[2] = b0[2]; acc[3] = b0[3]; acc[4] = b1[0]; acc[5] = b1[1]; acc[6] = b1[2]; acc[7] = b1[3]; }
#pragma unroll
        for (int k = 0; k < 4; ++k) {
            const int Rg = R0 + t + k - 1;
            if (Rg >= seg_lo && Rg < seg_hi) {
                const u32x4 xv = *(const u32x4*)(p + (size_t)Rg * EVEN_IN + cg0);
                const float* wk = P.ev_conv_w + (size_t)(j * 4 + k) * 1024 + cg0;
                const f32x4 w0 = *(const f32x4*)wk, w1 = *(const f32x4*)(wk + 4);
                acc[0] += w0[0] * __uint_as_float(xv.x << 16); acc[1] += w0[1] * __uint_as_float(xv.x & 0xffff0000u);
                acc[2] += w0[2] * __uint_as_float(xv.y << 16); acc[3] += w0[3] * __uint_as_float(xv.y & 0xffff0000u);
                acc[4] += w1[0] * __uint_as_float(xv.z << 16); acc[5] += w1[1] * __uint_as_float(xv.z & 0xffff0000u);
                acc[6] += w1[2] * __uint_as_float(xv.w << 16); acc[7] += w1[3] * __uint_as_float(xv.w & 0xffff0000u);
            }
        }
        u32x4 o; o.x = pk2(acc[0], acc[1]); o.y = pk2(acc[2], acc[3]); o.z = pk2(acc[4], acc[5]); o.w = pk2(acc[6], acc[7]);
        *(LAS u32x4*)(UT + t * 136 + c0) = o;
    }
    __syncthreads();
#pragma unroll 1
    for (int dir = 0; dir < 2; ++dir) {
        f32x4 ax[4], aa[4];
#pragma unroll
        for (int m = 0; m < 4; ++m) { ax[m] = (f32x4){0.f, 0.f, 0.f, 0.f}; aa[m] = (f32x4){0.f, 0.f, 0.f, 0.f}; }
        const bf16_t* Wx = WRG + (size_t)((dir * 2 + 0) * 8 + hd) * 16384 + (16 * wave + r) * 128 + 8 * g;
        const bf16_t* Wa = WRG + (size_t)((dir * 2 + 1) * 8 + hd) * 16384 + (16 * wave + r) * 128 + 8 * g;
#pragma unroll
        for (int ks = 0; ks < 4; ++ks) {
            const bf16x8 bx = *(const bf16x8*)(Wx + 32 * ks), ba = *(const bf16x8*)(Wa + 32 * ks);
#pragma unroll
            for (int m = 0; m < 4; ++m) {
                const bf16x8 a = *(const LAS bf16x8*)(UT + (16 * m + r) * 136 + 32 * ks + 8 * g);
                ax[m] = MFMA16(a, bx, ax[m]); aa[m] = MFMA16(a, ba, aa[m]);
            }
        }
        {
            const int c = 16 * wave + r, idx = (j * 2 + dir) * 1024 + hd * 128 + c;
            const float bxv = P.ev_rg_bx[idx], bav = P.ev_rg_ba[idx], lam = P.ev_rg_lambda[idx];
            const float sp = softplus_neg(lam);
#pragma unroll
            for (int m = 0; m < 4; ++m)
#pragma unroll
                for (int i = 0; i < 4; ++i) {
                    const int t = 16 * m + 4 * g + i;
                    const float gx = sigm(ax[m][i] + bxv), ga = sigm(aa[m][i] + bav);
                    const float la = -8.f * ga * sp;
                    const float a = __expf(la), mult = __builtin_amdgcn_sqrtf(neg_expm1(2.f * la));
                    const float uv = bf2f(UT[t * 136 + c]);
                    AL[t * 128 + c] = a; BL[t * 128 + c] = mult * gx * uv;
                }
        }
        __syncthreads();
        {
            const int c = tid & 127, q = tid >> 7;
            float A = 1.f, B = 0.f;
#pragma unroll
            for (int s = 0; s < 16; ++s) { const int t = dir == 0 ? 16 * q + s : 16 * q + 15 - s; const float a = AL[t * 128 + c], bb = BL[t * 128 + c]; B = a * B + bb; A *= a; }
            QA[(q * 128 + c) * 2] = A; QA[(q * 128 + c) * 2 + 1] = B;
            __syncthreads();
            float h = 0.f, pc = 1.f;
            const int nprev = dir == 0 ? q : 3 - q;
            for (int qq = 0; qq < nprev; ++qq) { const int qi = dir == 0 ? qq : 3 - qq; const float a = QA[(qi * 128 + c) * 2]; h = a * h + QA[(qi * 128 + c) * 2 + 1]; pc *= a; }
#pragma unroll
            for (int s = 0; s < 16; ++s) { const int t = dir == 0 ? 16 * q + s : 16 * q + 15 - s; const float a = AL[t * 128 + c]; h = a * h + BL[t * 128 + c]; pc *= a;
                HP[(dir * 64 + t) * 128 + c] = pkh2(h, pc); }
            if (nprev == 3) {
                const unsigned long long v = ((unsigned long long)__float_as_uint(h) << 32) | __float_as_uint(pc);
                __hip_atomic_store(AGG + ((size_t)(dir * NB + b) * NCHUNK + ci) * 1024 + hd * 128 + c, v, __ATOMIC_RELAXED, __HIP_MEMORY_SCOPE_AGENT);
            }
        }
        __syncthreads();
    }
    asm volatile("s_waitcnt vmcnt(0)" ::: "memory");
    __syncthreads();
    if (tid == 0) {
        __hip_atomic_fetch_add(cnt, 1u, __ATOMIC_RELAXED, __HIP_MEMORY_SCOPE_AGENT);
        unsigned spins = 0;
        while (__hip_atomic_load(cnt, __ATOMIC_RELAXED, __HIP_MEMORY_SCOPE_AGENT) < (unsigned)NCHUNK) { __builtin_amdgcn_s_sleep(2); if (++spins > (1u << 22)) break; }
    }
    __syncthreads();
    if (tid < 256) {
        const int dir = tid >> 7, c = tid & 127;
        const int pos = dir == 0 ? ci : (ci < 4 ? 3 - ci : 39 - ci);
        float h = 0.f;
        const unsigned long long* ag = AGG + (size_t)(dir * NB + b) * NCHUNK * 1024 + hd * 128 + c;
#pragma unroll
        for (int half = 0; half < 2; ++half) {
            unsigned long long v[18];
#pragma unroll
            for (int k = 0; k < 18; ++k) { const int pp = half * 18 + k; const int cc = dir == 0 ? pp : (pp < 4 ? 3 - pp : 39 - pp);
                v[k] = __hip_atomic_load(ag + (size_t)cc * 1024, __ATOMIC_RELAXED, __HIP_MEMORY_SCOPE_AGENT); }
#pragma unroll
            for (int k = 0; k < 18; ++k) if (half * 18 + k < pos) h = __uint_as_float((unsigned)v[k]) * h + __uint_as_float((unsigned)(v[k] >> 32));
        }
        CAR[dir * 128 + c] = h;
    }
    __syncthreads();
#pragma unroll
    for (int rep = 0; rep < 2; ++rep) {
        const int idx = tid + rep * 512, t = idx >> 4, c0 = (idx & 15) * 8;
        bf16_t* gp = p + (size_t)(R0 + t) * EVEN_IN + 1536 + hd * 128 + c0;
        const u32x4 gv = *(const u32x4*)gp;
        float y[8];
#pragma unroll
        for (int e = 0; e < 8; ++e) {
            float h0, p0, h1, p1; unpkh2(HP[t * 128 + c0 + e], h0, p0); unpkh2(HP[(64 + t) * 128 + c0 + e], h1, p1);
            y[e] = (h0 + p0 * CAR[c0 + e]) + (h1 + p1 * CAR[128 + c0 + e]);
        }
        const float gg[8] = {__uint_as_float(gv.x << 16), __uint_as_float(gv.x & 0xffff0000u), __uint_as_float(gv.y << 16), __uint_as_float(gv.y & 0xffff0000u),
                             __uint_as_float(gv.z << 16), __uint_as_float(gv.z & 0xffff0000u), __uint_as_float(gv.w << 16), __uint_as_float(gv.w & 0xffff0000u)};
        u32x4 o;
        o.x = pk2(y[0] * gg[0] * sigm(gg[0]), y[1] * gg[1] * sigm(gg[1])); o.y = pk2(y[2] * gg[2] * sigm(gg[2]), y[3] * gg[3] * sigm(gg[3]));
        o.z = pk2(y[4] * gg[4] * sigm(gg[4]), y[5] * gg[5] * sigm(gg[5])); o.w = pk2(y[6] * gg[6] * sigm(gg[6]), y[7] * gg[7] * sigm(gg[7]));
        *(u32x4*)gp = o;
    }
    __syncthreads();
}

DI void rope8(u32x4& v, const float* cs, const float* sn) {
    unsigned* w = (unsigned*)&v;
#pragma unroll
    for (int i = 0; i < 4; ++i) { const float t1 = __uint_as_float(w[i] << 16), t2 = __uint_as_float(w[i] & 0xffff0000u); w[i] = pk2(t1 * cs[i] - t2 * sn[i], t1 * sn[i] + t2 * cs[i]); }
}
DI void attn_item(const Params& P, LAS unsigned char* lds, int j, int item, int wv) {
    const int tid = get_tid(wv), lane = tid & 63, wave = tid >> 6, r = lane & 31, h = lane >> 5;
    const bool is_lat = item < 512;
    int b, qb, kvh;
    if (is_lat) { b = item >> 6; qb = (item >> 2) & 15; kvh = item & 3; } else { const int it = item - 512; b = it >> 3; qb = (it >> 2) & 1; kvh = it & 3; }
    bf16_t* p = (bf16_t*)(P.ws + WS_P);
    const float* cos_t = (const float*)(P.ws + WS_ROPE); const float* sin_t = cos_t + SEQ * 32;
    LAS unsigned char* KL = lds;
    LAS unsigned char* VT = lds + 9216;
    const int hq = 4 * kvh + (wave >> 1), ql0 = qb * 128 + 64 * (wave & 1);
    const size_t rowbase = (size_t)b * LT + (is_lat ? CTXL : 0);
    LAS unsigned char* QL = lds + 18432 + wave * 9216;
#pragma unroll
    for (int qt = 0; qt < 2; ++qt) {
        const int qi = ql0 + 32 * qt + r;
        const bf16_t* qp = p + (rowbase + qi) * EVEN_IN + 2560 + hq * 64 + 8 * h;
#pragma unroll
        for (int ks = 0; ks < 4; ++ks) {
            u32x4 v = *(const u32x4*)(qp + 16 * ks);
            if (is_lat) rope8(v, cos_t + qi * 32 + 8 * ks + 4 * h, sin_t + qi * 32 + 8 * ks + 4 * h);
            *(LAS u32x4*)(QL + (32 * qt + r) * 144 + (16 * ks + 8 * h) * 2) = v;
        }
    }
    const float sink2 = P.ev_sink[j * 16 + hq] * LOG2E;
    float mrun[2] = {sink2, sink2}, lrun[2] = {h == 0 ? 1.f : 0.f, h == 0 ? 1.f : 0.f};
    f32x16 O[2][2];
#pragma unroll
    for (int a = 0; a < 2; ++a)
#pragma unroll
        for (int c = 0; c < 2; ++c)
#pragma unroll
            for (int i = 0; i < 16; ++i) O[a][c][i] = 0.f;
    const int ntiles = is_lat ? 10 : 4;
    const float SC = 0.125f * LOG2E, NEG = -1e30f;
#pragma unroll 1
    for (int ti = 0; ti < ntiles; ++ti) {
        const bool win = ti >= 4;
        const int k0 = win ? qb * 128 - 128 + 64 * (ti - 4) : 64 * ti;
        if (win && (k0 < 0 || k0 >= SEQ)) continue;
        __syncthreads();
        {
            const int key = tid >> 3, chn = tid & 7;
            const bf16_t* kp = p + ((size_t)b * LT + (win ? CTXL : 0) + k0 + key) * EVEN_IN + 1024 + kvh * 64 + 8 * chn;
            u32x4 kv = *(const u32x4*)kp;
            if (win) rope8(kv, cos_t + (k0 + key) * 32 + 4 * chn, sin_t + (k0 + key) * 32 + 4 * chn);
            *(LAS u32x4*)(KL + key * 144 + chn * 16) = kv;
            const u32x4 vv = *(const u32x4*)(kp + 256);
            const unsigned* vw = (const unsigned*)&vv;
#pragma unroll
            for (int e = 0; e < 4; ++e) {
                *(LAS unsigned short*)(VT + (8 * chn + 2 * e) * 144 + key * 2) = (unsigned short)(vw[e] & 0xffffu);
                *(LAS unsigned short*)(VT + (8 * chn + 2 * e + 1) * 144 + key * 2) = (unsigned short)(vw[e] >> 16);
            }
        }
        __syncthreads();
#pragma unroll
        for (int qt = 0; qt < 2; ++qt) {
            f32x16 s0, s1;
#pragma unroll
            for (int i = 0; i < 16; ++i) { s0[i] = 0.f; s1[i] = 0.f; }
#pragma unroll
            for (int ks = 0; ks < 4; ++ks) {
                const bf16x8 qfr = *(const LAS bf16x8*)(QL + (32 * qt + r) * 144 + (16 * ks + 8 * h) * 2);
                const bf16x8 k0f = *(const LAS bf16x8*)(KL + r * 144 + (16 * ks + 8 * h) * 2), k1f = *(const LAS bf16x8*)(KL + (32 + r) * 144 + (16 * ks + 8 * h) * 2);
                s0 = MFMA32(k0f, qfr, s0); s1 = MFMA32(k1f, qfr, s1);
            }
            const int qpos = ql0 + 32 * qt + r;
            float mx = NEG;
#pragma unroll
            for (int i = 0; i < 16; ++i) {
                const int kp0 = k0 + crow(i, h), kp1 = kp0 + 32;
                float v0 = s0[i] * SC, v1 = s1[i] * SC;
                if (win) { const int d0 = qpos - kp0, d1 = qpos - kp1; if (d0 > 128 || d0 < -128) v0 = NEG; if (d1 > 128 || d1 < -128) v1 = NEG; }
                s0[i] = v0; s1[i] = v1; mx = fmaxf(mx, fmaxf(v0, v1));
            }
            mx = fmaxf(mx, shfl_xor_f(mx, 32));
            const float mn = fmaxf(mrun[qt], mx), alpha = __builtin_amdgcn_exp2f(mrun[qt] - mn);
            mrun[qt] = mn;
            float ls = 0.f;
#pragma unroll
            for (int i = 0; i < 16; ++i) { s0[i] = __builtin_amdgcn_exp2f(s0[i] - mn); s1[i] = __builtin_amdgcn_exp2f(s1[i] - mn); ls += s0[i] + s1[i]; }
            lrun[qt] = lrun[qt] * alpha + ls;
#pragma unroll
            for (int dt = 0; dt < 2; ++dt)
#pragma unroll
                for (int i = 0; i < 16; ++i) O[dt][qt][i] *= alpha;
            bf16x8 pf[2][2];
#pragma unroll
            for (int s = 0; s < 2; ++s) {
                u32x4 a, c;
                a.x = pk2(s0[8 * s + 0], s0[8 * s + 1]); a.y = pk2(s0[8 * s + 2], s0[8 * s + 3]); a.z = pk2(s0[8 * s + 4], s0[8 * s + 5]); a.w = pk2(s0[8 * s + 6], s0[8 * s + 7]);
                c.x = pk2(s1[8 * s + 0], s1[8 * s + 1]); c.y = pk2(s1[8 * s + 2], s1[8 * s + 3]); c.z = pk2(s1[8 * s + 4], s1[8 * s + 5]); c.w = pk2(s1[8 * s + 6], s1[8 * s + 7]);
                pf[0][s] = __builtin_bit_cast(bf16x8, a); pf[1][s] = __builtin_bit_cast(bf16x8, c);
            }
#pragma unroll
            for (int dt = 0; dt < 2; ++dt)
#pragma unroll
                for (int kt = 0; kt < 2; ++kt)
#pragma unroll
                    for (int s = 0; s < 2; ++s) {
                        const LAS unsigned char* vp = VT + (32 * dt + r) * 144 + (32 * kt + 16 * s + 4 * h) * 2;
                        const u32x2 lo = *(const LAS u32x2*)vp, hi = *(const LAS u32x2*)(vp + 16);
                        const u32x4 vv = {lo.x, lo.y, hi.x, hi.y};
                        O[dt][qt] = MFMA32(__builtin_bit_cast(bf16x8, vv), pf[kt][s], O[dt][qt]);
                    }
            __builtin_amdgcn_sched_barrier(0);
        }
    }
#pragma unroll
    for (int qt = 0; qt < 2; ++qt) {
        const float lt = lrun[qt] + shfl_xor_f(lrun[qt], 32), inv = __builtin_amdgcn_rcpf(lt);
        const int qi = ql0 + 32 * qt + r;
        bf16_t* rowp = p + (rowbase + qi) * EVEN_IN;
#pragma unroll
        for (int dt = 0; dt < 2; ++dt)
#pragma unroll
            for (int i4 = 0; i4 < 4; ++i4) {
                const int d0 = 32 * dt + 8 * i4 + 4 * h;
                const u32x2 gv = *(const u32x2*)(rowp + 3584 + hq * 64 + d0);
                const float g0 = __uint_as_float(gv.x << 16), g1 = __uint_as_float(gv.x & 0xffff0000u), g2 = __uint_as_float(gv.y << 16), g3 = __uint_as_float(gv.y & 0xffff0000u);
                u32x2 o;
                o.x = pk2(O[dt][qt][4 * i4 + 0] * inv * g0 * sigm(g0), O[dt][qt][4 * i4 + 1] * inv * g1 * sigm(g1));
                o.y = pk2(O[dt][qt][4 * i4 + 2] * inv * g2 * sigm(g2), O[dt][qt][4 * i4 + 3] * inv * g3 * sigm(g3));
                *(u32x2*)(rowp + 2560 + hq * 64 + d0) = o;
            }
    }
    __syncthreads();
}

constexpr int G2_QX = 0, G2_KF = 17408, G2_K2 = 60928, G2_VS = 79360, G2_AM = 96768, G2_ST = 105984, G2_PS = 140800, G2_BL = 144896, G2_Q1 = 145408, G2_END = 162816;
static_assert(G2_END <= LDS_BYTES - 256, "GLA LDS map");
typedef short v4i16_t __attribute__((ext_vector_type(4)));
DI bf16x8 frag_tr(const LAS bf16_t* M, int stride, int k0, int n0, int lane) {
    const int i = lane & 15, g = lane >> 4, q = i >> 2, pp = i & 3;
    const LAS bf16_t* a0 = M + (k0 + 8 * g + q) * stride + n0 + 4 * pp;
    const v4i16_t lo = __builtin_amdgcn_ds_read_tr16_b64_v4i16((LAS v4i16_t*)a0);
    const v4i16_t hi = __builtin_amdgcn_ds_read_tr16_b64_v4i16((LAS v4i16_t*)(a0 + 4 * stride));
    return (bf16x8){lo[0], lo[1], lo[2], lo[3], hi[0], hi[1], hi[2], hi[3]};
}

template <int DIR>
DI void gla2_item(const Params& P, LAS unsigned char* lds, int layer_j, int b, int hd, int wv) {
    const int tid = get_tid(wv), lane = tid & 63, wave = tid >> 6, r = lane & 15, g = lane >> 4;
    bf16_t* p = (bf16_t*)(P.ws + WS_P);
    LAS bf16_t* QX = (LAS bf16_t*)(lds + G2_QX); LAS bf16_t* KF = (LAS bf16_t*)(lds + G2_KF); LAS bf16_t* K2 = (LAS bf16_t*)(lds + G2_K2);
    LAS bf16_t* VS = (LAS bf16_t*)(lds + G2_VS); LAS bf16_t* AM = (LAS bf16_t*)(lds + G2_AM); LAS bf16_t* ST = (LAS bf16_t*)(lds + G2_ST);
    LAS float* PS8 = (LAS float*)(lds + G2_PS); LAS float* BLAST = (LAS float*)(lds + G2_BL); LAS bf16_t* Q1 = (LAS bf16_t*)(lds + G2_Q1);
    const int d0 = 2 * lane, tg = wave, I = tg >> 1, half = tg & 1;
    float lbv[2] = {0.f, 0.f};
    if (layer_j > 0) { lbv[0] = sigm(P.od_lb_raw[1024 + hd * 128 + d0] - P.od_lb_raw[hd * 128 + d0]); lbv[1] = sigm(P.od_lb_raw[1024 + hd * 128 + d0 + 1] - P.od_lb_raw[hd * 128 + d0 + 1]); }
    for (int i = tid; i < (9216 + 34816) / 4; i += 512) ((LAS unsigned*)(lds + G2_AM))[i] = 0u;
    f32x4 st[8];
#pragma unroll
    for (int e = 0; e < 8; ++e) st[e] = (f32x4){0.f, 0.f, 0.f, 0.f};
    unsigned zn[8], qn[8]; u32x4 vn[2];
#define G2_OFFZ(s) ((unsigned)((DIR == 0 ? 8 * tg + (s) : 63 - 8 * tg - (s)) * ODD_IN + d0) * 2u)
#define G2_OFFV(rep) ((unsigned)((DIR == 0 ? ((tid + (rep) * 512) >> 4) : 63 - ((tid + (rep) * 512) >> 4)) * ODD_IN + 8 * ((tid + (rep) * 512) & 15)) * 2u)
    const size_t colz = (size_t)DIR * 1024 + hd * 128, colq = 3072 + hd * 128, colv = 2048 + hd * 128;
    {
        const int chunk = DIR == 0 ? 0 : 3;
        const char* slab = (const char*)(p + ((size_t)b * LT + (size_t)chunk * 64) * ODD_IN);
#pragma unroll
        for (int s = 0; s < 8; ++s) { zn[s] = *(const unsigned*)(slab + colz * 2 + G2_OFFZ(s)); qn[s] = *(const unsigned*)(slab + colq * 2 + G2_OFFZ(s)); }
#pragma unroll
        for (int rep = 0; rep < 2; ++rep) vn[rep] = *(const u32x4*)(slab + colv * 2 + G2_OFFV(rep));
    }
    __syncthreads();
#pragma unroll 1
    for (int step = 0; step < NCHUNK; ++step) {
        const int chunk = DIR == 0 ? step : (step < 4 ? 3 - step : 39 - step);
        const size_t Rc0 = (size_t)b * LT + (size_t)chunk * 64;
        unsigned zc[8], qc[8]; u32x4 vc[2];
#pragma unroll
        for (int s = 0; s < 8; ++s) { zc[s] = zn[s]; qc[s] = qn[s]; }
        vc[0] = vn[0]; vc[1] = vn[1];
        float el[8][2], kk[8][2], qq[8][2];
        {
            float run0 = 1.f, run1 = 1.f;
#pragma unroll
            for (int s = 0; s < 8; ++s) {
                const float z0 = __uint_as_float(zc[s] << 16), z1 = __uint_as_float(zc[s] & 0xffff0000u);
                const float t0 = __expf(-z0), t1 = __expf(-z1), sg0 = __builtin_amdgcn_rcpf(1.f + t0), sg1 = __builtin_amdgcn_rcpf(1.f + t1);
                const float f0 = fmaxf(lbv[0] + (1.f - lbv[0]) * sg0, 1e-30f), f1 = fmaxf(lbv[1] + (1.f - lbv[1]) * sg1, 1e-30f);
                kk[s][0] = (1.f - lbv[0]) * (t0 * sg0); kk[s][1] = (1.f - lbv[1]) * (t1 * sg1);
                run0 = fmaxf(run0 * f0, 1e-35f); run1 = fmaxf(run1 * f1, 1e-35f); el[s][0] = run0; el[s][1] = run1;
                const float q0 = __uint_as_float(qc[s] << 16), q1 = __uint_as_float(qc[s] & 0xffff0000u);
                qq[s][0] = q0 * __builtin_amdgcn_rcpf(1.f + __expf(-q0)); qq[s][1] = q1 * __builtin_amdgcn_rcpf(1.f + __expf(-q1));
                if ((s & 1) == 1) __builtin_amdgcn_sched_barrier(0);
            }
            *(LAS f32x2*)(PS8 + tg * 128 + d0) = (f32x2){run0, run1};
#pragma unroll
            for (int rep = 0; rep < 2; ++rep) { const int idx = tid + rep * 512, tau = idx >> 4, chn = idx & 15; *(LAS u32x4*)(VS + tau * 136 + 8 * chn) = vc[rep]; }
        }
        __syncthreads();
        float RI[2];
        {
            float T[8][2];
#pragma unroll
            for (int q8 = 0; q8 < 8; ++q8) { const f32x2 t = *(const LAS f32x2*)(PS8 + q8 * 128 + d0); T[q8][0] = t[0]; T[q8][1] = t[1]; }
            float pre[2], fac[4][2], f4[2];
#pragma unroll
            for (int x = 0; x < 2; ++x) {
                const float P0 = T[0][x] * T[1][x], P1 = T[2][x] * T[3][x], P2 = T[4][x] * T[5][x], P3 = T[6][x] * T[7][x];
                pre[x] = half ? (I == 0 ? T[0][x] : (I == 1 ? T[2][x] : (I == 2 ? T[4][x] : T[6][x]))) : 1.f;
                RI[x] = I == 0 ? 1.f : (I == 1 ? P0 : (I == 2 ? P0 * P1 : P0 * P1 * P2));
                float cur = 1.f;
                fac[0][x] = cur; if (I <= 0) cur *= P0;
                fac[1][x] = cur; if (I <= 1) cur *= P1;
                fac[2][x] = cur; if (I <= 2) cur *= P2;
                fac[3][x] = cur; cur *= P3;
                f4[x] = cur;
                if (tg == 0) BLAST[d0 + x] = P0 * P1 * P2 * P3;
            }
            unsigned w0[4], w1[4];
#pragma unroll
            for (int s = 0; s < 8; ++s) {
                const int tau = 8 * tg + s;
                const float e00 = fmaxf(pre[0] * el[s][0], 1e-35f), e01 = fmaxf(pre[1] * el[s][1], 1e-35f);
                const float qi0 = qq[s][0] * e00, qi1 = qq[s][1] * e01;
                const float kd0 = kk[s][0] * __builtin_amdgcn_rcpf(e00), kd1 = kk[s][1] * __builtin_amdgcn_rcpf(e01);
                *(LAS unsigned*)(QX + tau * 136 + d0) = pk2(qi0, qi1);
                *(LAS unsigned*)(Q1 + tau * 136 + d0) = pk2(qi0 * RI[0], qi1 * RI[1]);
                if (I <= 0) *(LAS unsigned*)(KF + (0 + tau) * 136 + d0) = pk2(kd0 * fac[0][0], kd1 * fac[0][1]);
                if (I <= 1) *(LAS unsigned*)(KF + (16 + tau) * 136 + d0) = pk2(kd0 * fac[1][0], kd1 * fac[1][1]);
                if (I <= 2) *(LAS unsigned*)(KF + (48 + tau) * 136 + d0) = pk2(kd0 * fac[2][0], kd1 * fac[2][1]);
                *(LAS unsigned*)(KF + (96 + tau) * 136 + d0) = pk2(kd0 * fac[3][0], kd1 * fac[3][1]);
                const unsigned h0 = f2bf(kd0 * f4[0]), h1 = f2bf(kd1 * f4[1]);
                if (s & 1) { w0[s >> 1] |= h0 << 16; w1[s >> 1] |= h1 << 16; } else { w0[s >> 1] = h0; w1[s >> 1] = h1; }
                if ((s & 1) == 1) __builtin_amdgcn_sched_barrier(0);
            }
            *(LAS u32x4*)(K2 + (d0 + 0) * 72 + 8 * tg) = (u32x4){w0[0], w0[1], w0[2], w0[3]};
            *(LAS u32x4*)(K2 + (d0 + 1) * 72 + 8 * tg) = (u32x4){w1[0], w1[1], w1[2], w1[3]};
        }
        __syncthreads();
        if (step + 1 < NCHUNK) {
            const int nchunk = DIR == 0 ? step + 1 : (step + 1 < 4 ? 2 - step : 38 - step);
            const char* slab = (const char*)(p + ((size_t)b * LT + (size_t)nchunk * 64) * ODD_IN);
#pragma unroll
            for (int s = 0; s < 8; ++s) { zn[s] = *(const unsigned*)(slab + colz * 2 + G2_OFFZ(s)); qn[s] = *(const unsigned*)(slab + colq * 2 + G2_OFFZ(s)); }
#pragma unroll
            for (int rep = 0; rep < 2; ++rep) vn[rep] = *(const u32x4*)(slab + colv * 2 + G2_OFFV(rep));
        }
#pragma unroll 1
        for (int bi = wave; bi < 10; bi += 8) {
            const int Ib = bi < 1 ? 0 : (bi < 3 ? 1 : (bi < 6 ? 2 : 3)), Jb = bi - (Ib * (Ib + 1)) / 2;
            const int foff = Ib == 0 ? 0 : (Ib == 1 ? 16 : (Ib == 2 ? 48 : 96));
            f32x4 acc = {0.f, 0.f, 0.f, 0.f};
#pragma unroll
            for (int ks = 0; ks < 4; ++ks) {
                const bf16x8 a = *(const LAS bf16x8*)(QX + (16 * Ib + r) * 136 + 32 * ks + 8 * g);
                const bf16x8 bb = *(const LAS bf16x8*)(KF + (foff + 16 * Jb + r) * 136 + 32 * ks + 8 * g);
                acc = MFMA16(a, bb, acc);
            }
#pragma unroll
            for (int i = 0; i < 4; ++i) { float v = acc[i]; if (Jb == Ib && r > 4 * g + i) v = 0.f; AM[(16 * Ib + 4 * g + i) * 72 + 16 * Jb + r] = (bf16_t)f2bf(v); }
        }
        __syncthreads();
        {
            const int tt = wave >> 1, eb = 4 * (wave & 1);
            char* oslab = (char*)(p + Rc0 * ODD_IN + colz);
            bf16x8 aq[4], am[2];
#pragma unroll
            for (int ks = 0; ks < 4; ++ks) aq[ks] = *(const LAS bf16x8*)(Q1 + (16 * tt + r) * 136 + 32 * ks + 8 * g);
#pragma unroll
            for (int ks = 0; ks < 2; ++ks) am[ks] = *(const LAS bf16x8*)(AM + (16 * tt + r) * 72 + 32 * ks + 8 * g);
#pragma unroll
            for (int e4 = 0; e4 < 4; ++e4) {
                const int et = eb + e4;
                f32x4 acc = {0.f, 0.f, 0.f, 0.f};
#pragma unroll
                for (int ks = 0; ks < 4; ++ks) { const bf16x8 bb = *(const LAS bf16x8*)(ST + (16 * et + r) * 136 + 32 * ks + 8 * g); acc = MFMA16(aq[ks], bb, acc); }
#pragma unroll
                for (int ks = 0; ks < 2; ++ks) acc = MFMA16(am[ks], frag_tr(VS, 136, 32 * ks, 16 * et, lane), acc);
#pragma unroll
                for (int i = 0; i < 4; ++i) {
                    const int tau = 16 * tt + 4 * g + i;
                    const unsigned off = (unsigned)((DIR == 0 ? tau : 63 - tau) * ODD_IN + 16 * et + r) * 2u;
                    *(bf16_t*)(oslab + off) = (bf16_t)f2bf(acc[i]);
                }
                __builtin_amdgcn_sched_barrier(0);
            }
            float bl[4];
#pragma unroll
            for (int i = 0; i < 4; ++i) bl[i] = BLAST[16 * wave + 4 * g + i];
            bf16x8 ak[2];
#pragma unroll
            for (int ks = 0; ks < 2; ++ks) ak[ks] = *(const LAS bf16x8*)(K2 + (16 * wave + r) * 72 + 32 * ks + 8 * g);
#pragma unroll
            for (int et = 0; et < 8; ++et) {
#pragma unroll
                for (int i = 0; i < 4; ++i) st[et][i] *= bl[i];
#pragma unroll
                for (int ks = 0; ks < 2; ++ks) st[et] = MFMA16(ak[ks], frag_tr(VS, 136, 32 * ks, 16 * et, lane), st[et]);
                if (et & 1) __builtin_amdgcn_sched_barrier(0);
            }
        }
        __syncthreads();
#pragma unroll
        for (int et = 0; et < 8; ++et) { u32x2 w; w.x = pk2(st[et][0], st[et][1]); w.y = pk2(st[et][2], st[et][3]); *(LAS u32x2*)(ST + (16 * et + r) * 136 + 16 * wave + 4 * g) = w; }
    }
    __syncthreads();
}

DI void phase_readout(const Params& P, int layer_j, int wv) {
    const int tid = get_tid(wv), lane = tid & 63, wave = tid >> 6;
    const int gw = get_bid() * 8 + wave, NGW = gridDim.x * 8;
    bf16_t* p = (bf16_t*)(P.ws + WS_P);
    const float* gwt = P.od_gnorm_w + layer_j * 128 + (lane & 7) * 16;
    for (int R = gw; R < MROWS; R += NGW) {
        const bf16_t* op = p + (size_t)R * ODD_IN + 16 * lane; bf16_t* yp = p + (size_t)R * ODD_IN + 4096 + 16 * lane;
        const u32x4 o0 = *(const u32x4*)op, o1 = *(const u32x4*)(op + 8), c0 = *(const u32x4*)(op + 1024), c1 = *(const u32x4*)(op + 1032), g0 = *(const u32x4*)yp, g1 = *(const u32x4*)(yp + 8);
        float ov[16], gv[16];
        const unsigned* ow0 = (const unsigned*)&o0; const unsigned* ow1 = (const unsigned*)&o1; const unsigned* cw0 = (const unsigned*)&c0; const unsigned* cw1 = (const unsigned*)&c1;
        const unsigned* gw0 = (const unsigned*)&g0; const unsigned* gw1 = (const unsigned*)&g1;
#pragma unroll
        for (int i = 0; i < 4; ++i) {
            ov[2 * i] = __uint_as_float(ow0[i] << 16) + __uint_as_float(cw0[i] << 16); ov[2 * i + 1] = __uint_as_float(ow0[i] & 0xffff0000u) + __uint_as_float(cw0[i] & 0xffff0000u);
            ov[8 + 2 * i] = __uint_as_float(ow1[i] << 16) + __uint_as_float(cw1[i] << 16); ov[8 + 2 * i + 1] = __uint_as_float(ow1[i] & 0xffff0000u) + __uint_as_float(cw1[i] & 0xffff0000u);
            gv[2 * i] = __uint_as_float(gw0[i] << 16); gv[2 * i + 1] = __uint_as_float(gw0[i] & 0xffff0000u); gv[8 + 2 * i] = __uint_as_float(gw1[i] << 16); gv[8 + 2 * i + 1] = __uint_as_float(gw1[i] & 0xffff0000u);
        }
        float ss = 0.f;
#pragma unroll
        for (int i = 0; i < 16; ++i) ss += ov[i] * ov[i];
        ss += shfl_xor_f(ss, 1); ss += shfl_xor_f(ss, 2); ss += shfl_xor_f(ss, 4);
        const float rstd = rsqrtf(ss * (1.f / 128.f) + RMS_EPS);
        float y[16];
#pragma unroll
        for (int i = 0; i < 16; ++i) y[i] = ov[i] * rstd * gwt[i] * (gv[i] * sigm(gv[i]));
        u32x4 w0, w1;
        w0.x = pk2(y[0], y[1]); w0.y = pk2(y[2], y[3]); w0.z = pk2(y[4], y[5]); w0.w = pk2(y[6], y[7]);
        w1.x = pk2(y[8], y[9]); w1.y = pk2(y[10], y[11]); w1.z = pk2(y[12], y[13]); w1.w = pk2(y[14], y[15]);
        *(u32x4*)yp = w0; *(u32x4*)(yp + 8) = w1;
    }
}

DI void phase_final(const Params& P, int wv) {
    const int tid = get_tid(wv), lane = tid & 63, wave = tid >> 6;
    const int gw = get_bid() * 8 + wave, NGW = gridDim.x * 8;
    for (int R = gw; R < NB * SEQ; R += NGW) {
        float* row = P.out + (size_t)R * DM;
        f32x4 v[4]; float ss = 0.f;
#pragma unroll
        for (int q = 0; q < 4; ++q) { v[q] = *(const f32x4*)(row + 4 * lane + 256 * q); ss += (v[q][0] * v[q][0] + v[q][1] * v[q][1]) + (v[q][2] * v[q][2] + v[q][3] * v[q][3]); }
        const float rstd = rsqrtf(wave_sum(ss) * (1.f / DM) + RMS_EPS);
#pragma unroll
        for (int q = 0; q < 4; ++q) { const f32x4 w4 = *(const f32x4*)(P.final_norm_w + 4 * lane + 256 * q); *(f32x4*)(row + 4 * lane + 256 * q) = (v[q] * rstd) * w4; }
    }
}

#define XB_TMO      128
#define XB_XCNT(j)  (256  + 64 * (j))
#define XB_XSUB(j)  (1280 + 64 * (j))
#define XB_XGEN(j)  (2304 + 64 * (j))
#define XB_TOP      3328
#define XB_TOPGEN   3392
#define XCD_BAR_WORDS 3456
#define XB_SPIN_CAP (1u << 18)

__device__ __forceinline__ unsigned xb_ld(unsigned* p)              { return __hip_atomic_load(p, __ATOMIC_RELAXED, __HIP_MEMORY_SCOPE_AGENT); }
__device__ __forceinline__ unsigned xb_add(unsigned* p, unsigned v) { return __hip_atomic_fetch_add(p, v, __ATOMIC_RELAXED, __HIP_MEMORY_SCOPE_AGENT); }
__device__ __forceinline__ unsigned xb_xcc_id() { return (unsigned)__builtin_amdgcn_s_getreg((3 << 11) | 20) & 0xFu; }
#define XB_SPIN(cond, bar) do { unsigned _sp = 0; while (cond) { __builtin_amdgcn_s_sleep(1); \
    if ((++_sp & 255u) == 0u) { if (xb_ld(&(bar)[XB_TMO])) break; if (_sp > XB_SPIN_CAP) { atomicAdd(&(bar)[XB_TMO], 1u); break; } } } } while (0)

struct XcdBarrier {
    unsigned* bar; unsigned x;
    volatile LAS unsigned* st;
};

__device__ __forceinline__ XcdBarrier xcd_barrier_post(unsigned* bar, volatile LAS unsigned* st, int wv) {
    XcdBarrier b; b.bar = bar; b.x = xb_xcc_id(); b.st = st;
    if (get_tid(wv) == 0) (void)xb_add(&bar[XB_XCNT(b.x)], 1u);
    return b;
}
__device__ __forceinline__ void xcd_barrier_complete(unsigned* bar, unsigned x, unsigned& nloc, unsigned& nx) {
    const unsigned G = gridDim.x * gridDim.y * gridDim.z;
    unsigned sum, cnt, mine, sp = 0u;
    for (;;) {
        sum = 0u; cnt = 0u; mine = 0u;
#pragma unroll
        for (unsigned j = 0; j < 16; ++j) { const unsigned c = xb_ld(&bar[XB_XCNT(j)]); sum += c; cnt += (c > 0u) ? 1u : 0u; mine = (j == x) ? c : mine; }
        if (sum == G) break;
        __builtin_amdgcn_s_sleep(1);
        if ((++sp & 255u) == 0u) { if (xb_ld(&bar[XB_TMO])) break; if (sp > XB_SPIN_CAP) { atomicAdd(&bar[XB_TMO], 1u); break; } }
    }
    nloc = mine > 0u ? mine : 1u; nx = cnt > 0u ? cnt : 1u;
}

__device__ __forceinline__ void xcd_barrier(const XcdBarrier& b, int wv) {
    asm volatile("s_waitcnt vmcnt(0)" ::: "memory");
    __syncthreads();
    if (get_tid(wv) == 0) {
        unsigned* bar = b.bar;
        __builtin_amdgcn_s_waitcnt(0);
        unsigned nloc = b.st[0], nx = b.st[1];
        if (nloc == 0u) { xcd_barrier_complete(bar, b.x, nloc, nx); b.st[0] = nloc; b.st[1] = nx; }
        const unsigned old = xb_add(&bar[XB_XSUB(b.x)], 1u);
        const unsigned gen = old / nloc;
        if (old + 1u == (gen + 1u) * nloc) {
            __builtin_amdgcn_fence(__ATOMIC_RELEASE, "agent");
            asm volatile("s_waitcnt vmcnt(0)" ::: "memory");
            const unsigned og = xb_add(&bar[XB_TOP], 1u);
            const unsigned tg = og / nx;
            if (og + 1u == (tg + 1u) * nx) xb_add(&bar[XB_TOPGEN], 1u);
            else XB_SPIN(xb_ld(&bar[XB_TOPGEN]) == tg, bar);
            __builtin_amdgcn_fence(__ATOMIC_ACQUIRE, "agent");
            xb_add(&bar[XB_XGEN(b.x)], 1u);
            asm volatile("s_waitcnt vmcnt(0)" ::: "memory");
        } else {
            XB_SPIN(xb_ld(&bar[XB_XGEN(b.x)]) == gen, bar);
            __builtin_amdgcn_fence(__ATOMIC_ACQUIRE, "agent");
            asm volatile("s_waitcnt vmcnt(0)" ::: "memory");
        }
    }
    __syncthreads();
}

constexpr int PARAM_OFF = LDS_BYTES - 256;
static_assert(G2_END <= PARAM_OFF && sizeof(Params) <= 208, "LDS map");
DI const float* ld_uptr(const LAS unsigned long long* s, int i) {
    const unsigned long long v = s[i];
    const unsigned lo = __builtin_amdgcn_readfirstlane((unsigned)v), hi = __builtin_amdgcn_readfirstlane((unsigned)(v >> 32));
    return (const float*)(const __attribute__((address_space(1))) float*)(((unsigned long long)hi << 32) | lo);
}
DI Params load_params(LAS unsigned char* lds) {
    LAS unsigned char* pb = lds + PARAM_OFF; asm volatile("" : "+v"(pb));
    const LAS unsigned long long* s = (const LAS unsigned long long*)pb;
    Params Q;
    Q.x = ld_uptr(s, 0); Q.c = ld_uptr(s, 1); Q.ctx = ld_uptr(s, 2); Q.c_ctx = ld_uptr(s, 3); Q.ada_w = ld_uptr(s, 4); Q.ada_b = ld_uptr(s, 5); Q.norm_w = ld_uptr(s, 6);
    Q.ev_w_in = ld_uptr(s, 7); Q.ev_conv_w = ld_uptr(s, 8); Q.ev_conv_b = ld_uptr(s, 9); Q.ev_rg_wx = ld_uptr(s, 10); Q.ev_rg_bx = ld_uptr(s, 11); Q.ev_rg_wa = ld_uptr(s, 12);
    Q.ev_rg_ba = ld_uptr(s, 13); Q.ev_rg_lambda = ld_uptr(s, 14); Q.ev_sink = ld_uptr(s, 15); Q.ev_w_out = ld_uptr(s, 16); Q.od_w_in = ld_uptr(s, 17); Q.od_lb_raw = ld_uptr(s, 18);
    Q.od_gnorm_w = ld_uptr(s, 19); Q.od_w_out = ld_uptr(s, 20); Q.final_norm_w = ld_uptr(s, 21); Q.out = (float*)ld_uptr(s, 22); Q.ws = (unsigned char*)ld_uptr(s, 23);
    Q.ph_lo = 0; Q.ph_hi = 0;
    return Q;
}
DI void run_phase(LAS unsigned char* lds, int ph, int wv) {
    #ifndef PHMASK
#define PHMASK 0xffff
#endif
    if (ph == 0) { if (PHMASK & 1) { const Params P = load_params(lds); phase_pro(P, lds, wv); } return; }
    if (ph == NPHASE - 1) { if (PHMASK & 2) { const Params P = load_params(lds); phase_final(P, wv); } return; }
    const int layer = (ph - 1) / 5, sub = (ph - 1) % 5, j = layer >> 1;
    const bool even = (layer & 1) == 0;
    if (sub == 0) { if (PHMASK & 4) { const Params P = load_params(lds); phase_norm(P, lds, layer, wv); } return; }
    if (sub == 1) {
        const Params P = load_params(lds); bf16_t* pbuf = (bf16_t*)(P.ws + WS_P);
        const int N = even ? EVEN_IN : ODD_IN;
        pg8::Gemm gm{(const bf16_t*)(P.ws + WS_OV), (const bf16_t*)(P.ws + WS_WIN), MROWS, N, 1024, 1024};
        pg8::StaticOrder S; S.init(MROWS, N, (int)gridDim.x, get_bid());
        EpiStoreBf16 E{pbuf, N};
        if (PHMASK & 8) pg8::gemm_phase<EpiStoreBf16, pg8::StaticOrder, true, true>(lds, gm, S, E, wv);
        return;
    }
    if (sub == 2) {
        const Params P = load_params(lds);
        if (even) {
            constexpr int NRG = NB * NCHUNK * 8;
#if defined(SPLIT_ATTN)
            for (int it = get_bid(); it < NRG; it += gridDim.x) rglru_item(P, lds, j, it, wv);
#else
            for (int it = get_bid(); it < NRG + 576; it += gridDim.x) {
                if (it < NRG) { if (PHMASK & 32) rglru_item(P, lds, j, it, wv); } else { if (PHMASK & 16) attn_item(P, lds, j, it - NRG, wv); }
            }
#endif
        } else {
            for (int it = get_bid(); it < 128; it += gridDim.x) { if (PHMASK & 64) { if (it & 1) gla2_item<1>(P, lds, j, it >> 4, (it >> 1) & 7, wv); else gla2_item<0>(P, lds, j, it >> 4, (it >> 1) & 7, wv); } }
        }
        return;
    }
    if (sub == 3) {
        const Params P = load_params(lds);
        if (!even) { if (PHMASK & 256) phase_readout(P, j, wv); }
#if defined(SPLIT_ATTN)
        else { for (int it = get_bid(); it < 576; it += gridDim.x) attn_item(P, lds, j, it, wv); }
#endif
        return;
    }
    {
        const Params P = load_params(lds); bf16_t* pbuf = (bf16_t*)(P.ws + WS_P);
        const int K = even ? 2048 : 1024, lda = even ? EVEN_IN : ODD_IN;
        pg8::Gemm gm{pbuf + (even ? 1536 : 4096), (const bf16_t*)(P.ws + WS_WOUT), MROWS, 1024, K, lda};
        pg8::StaticOrder S; S.init(MROWS, 1024, (int)gridDim.x, get_bid());
        const float* hl = layer == 0 ? P.x : P.out; const float* hc = layer == 0 ? P.ctx : (const float*)(P.ws + WS_HCTX);
        EpiResid E{hl, hc, P.out, (float*)(P.ws + WS_HCTX), (const float*)(P.ws + WS_MOD) + (size_t)layer * 9 * 3072 + 2048};
        if (PHMASK & 512) pg8::gemm_phase<EpiResid, pg8::StaticOrder, true, true>(lds, gm, S, E, wv);
    }
}

__global__ void __launch_bounds__(512, 2) mega(Params P) {
    extern __shared__ __attribute__((aligned(16))) unsigned char lds_raw[];
    LAS unsigned char* lds = (LAS unsigned char*)lds_raw;
    cg::grid_group grid = cg::this_grid();
    const int wv = __builtin_amdgcn_readfirstlane((int)(threadIdx.x >> 6));
    if (get_tid(wv) == 0) {
        ((LAS unsigned*)(lds + PARAM_OFF + 208))[0] = 0u; ((LAS unsigned*)(lds + PARAM_OFF + 208))[1] = 0u;
        LAS unsigned long long* d = (LAS unsigned long long*)(lds + PARAM_OFF);
        d[0] = (unsigned long long)P.x; d[1] = (unsigned long long)P.c; d[2] = (unsigned long long)P.ctx; d[3] = (unsigned long long)P.c_ctx; d[4] = (unsigned long long)P.ada_w;
        d[5] = (unsigned long long)P.ada_b; d[6] = (unsigned long long)P.norm_w; d[7] = (unsigned long long)P.ev_w_in; d[8] = (unsigned long long)P.ev_conv_w; d[9] = (unsigned long long)P.ev_conv_b;
        d[10] = (unsigned long long)P.ev_rg_wx; d[11] = (unsigned long long)P.ev_rg_bx; d[12] = (unsigned long long)P.ev_rg_wa; d[13] = (unsigned long long)P.ev_rg_ba; d[14] = (unsigned long long)P.ev_rg_lambda;
        d[15] = (unsigned long long)P.ev_sink; d[16] = (unsigned long long)P.ev_w_out; d[17] = (unsigned long long)P.od_w_in; d[18] = (unsigned long long)P.od_lb_raw; d[19] = (unsigned long long)P.od_gnorm_w;
        d[20] = (unsigned long long)P.od_w_out; d[21] = (unsigned long long)P.final_norm_w; d[22] = (unsigned long long)P.out; d[23] = (unsigned long long)P.ws;
    }
    __syncthreads();
    const int ph_lo = P.ph_lo, ph_hi = P.ph_hi;
    (void)xcd_barrier_post((unsigned*)(P.ws + WS_CTL) + 4096, (volatile LAS unsigned*)(lds + PARAM_OFF + 208), wv);
#define GRID_SYNC(first) do { if (first) grid.sync(); else { XcdBarrier xb_; xb_.bar = (unsigned*)(load_params(lds).ws + WS_CTL) + 4096; xb_.x = xb_xcc_id(); xb_.st = (volatile LAS unsigned*)(lds + PARAM_OFF + 208); xcd_barrier(xb_, wv); } } while (0)
#if defined(PROBE_S)
    constexpr int PREP = PROBE_E - PROBE_S + 1;
#pragma unroll 1
    for (int seq = ph_lo; seq < ph_hi + PREP; ++seq) {
        if (seq > ph_lo) GRID_SYNC(seq == ph_lo + 1);
        const int ph = seq <= PROBE_E ? seq : seq - PREP;
        run_phase(lds, ph, wv);
    }
#else
#pragma unroll 1
    for (int ph = ph_lo; ph < ph_hi; ++ph) {
#if !defined(SPLIT_ATTN)
        if (ph >= 1 && ph < NPHASE - 1 && (ph - 1) % 5 == 3 && (((ph - 1) / 5) & 1) == 0) continue;
#endif
        if (ph > ph_lo) GRID_SYNC(ph == ph_lo + 1);
        run_phase(lds, ph, wv);
    }
#endif
}

extern "C" void kernel_launch(void* const* d_in, const int* in_sizes, int n_in, void* d_out, int out_size, void* d_ws, size_t ws_size, hipStream_t stream) {
    static int grid = 0;
    if (grid == 0) {
        if (n_in != 22 || ws_size < WS_END) { fprintf(stderr, "kernel_launch: unexpected inputs (n_in %d, ws %zu)\n", n_in, ws_size); grid = -1; return; }
        int dev = 0, cus = 0, per_cu = 0;
        hipGetDevice(&dev);
        hipDeviceGetAttribute(&cus, hipDeviceAttributeMultiprocessorCount, dev);
        if (hipFuncSetAttribute((const void*)mega, hipFuncAttributeMaxDynamicSharedMemorySize, LDS_BYTES) != hipSuccess) { fprintf(stderr, "kernel_launch: hipFuncSetAttribute failed\n"); grid = -1; return; }
        if (hipOccupancyMaxActiveBlocksPerMultiprocessor(&per_cu, (const void*)mega, 512, LDS_BYTES) != hipSuccess || per_cu < 1) { fprintf(stderr, "kernel_launch: occupancy query gives %d\n", per_cu); per_cu = 1; }
        (void)hipGetLastError();
        grid = cus;
    }
    if (grid < 0) return;
    if (hipMemsetAsync((char*)d_ws + WS_CTL, 0, 65536, stream) != hipSuccess) { fprintf(stderr, "kernel_launch: memset failed\n"); return; }
    Params P{};
    const float** pp = (const float**)&P;
    for (int i = 0; i < 22; ++i) pp[i] = (const float*)d_in[i];
    P.out = (float*)d_out; P.ws = (unsigned char*)d_ws;
#if ONE_LAUNCH
    P.ph_lo = 0; P.ph_hi = NPHASE;
    { void* args[] = {&P}; hipError_t e = hipLaunchCooperativeKernel((const void*)mega, dim3(grid), dim3(512), args, LDS_BYTES, stream);
      if (e != hipSuccess) fprintf(stderr, "cooperative launch failed: %s (grid %d)\n", hipGetErrorString(e), grid); }
#else
    for (int ph = 0; ph < NPHASE; ++ph) {
        P.ph_lo = ph; P.ph_hi = ph + 1;
        void* args[] = {&P}; hipError_t e = hipLaunchCooperativeKernel((const void*)mega, dim3(grid), dim3(512), args, LDS_BYTES, stream);
        if (e != hipSuccess) { fprintf(stderr, "launch %d failed: %s (grid %d)\n", ph, hipGetErrorString(e), grid); break; }
    }
#endif
}
```

```cpp
#include <hip/hip_runtime.h>
#include <hip/hip_cooperative_groups.h>
#include <cstdio>
#include <cstdint>
namespace cg = cooperative_groups;

#ifndef ONE_LAUNCH
#define ONE_LAUNCH 1
#endif

#define DI __device__ __forceinline__
#define LAS __attribute__((address_space(3)))
__device__ __forceinline__ int lane_nh() { int l; asm volatile("v_mbcnt_lo_u32_b32 %0, -1, 0\n\tv_mbcnt_hi_u32_b32 %0, -1, %0" : "=v"(l)); return l; }
__device__ __forceinline__ int get_tid(int wv) { asm volatile("" : "+s"(wv)); return wv * 64 + lane_nh(); }
__device__ __forceinline__ float shfl_xor_f(float v, int o) { return __int_as_float(__builtin_amdgcn_ds_bpermute((lane_nh() ^ o) << 2, __float_as_int(v))); }
__device__ __forceinline__ int get_bid() { int b = blockIdx.x; asm volatile("" : "+s"(b)); return b; }
namespace pg8 {
#define PG8_LAS __attribute__((address_space(3)))
typedef unsigned short bf16_t;
typedef short bf16x8 __attribute__((ext_vector_type(8)));
typedef float f32x4 __attribute__((ext_vector_type(4)));
typedef unsigned u32x4 __attribute__((ext_vector_type(4)));
constexpr int BM = 256, BK = 64, HALF = 128, HTB = HALF * BK * 2  , STAGE_BYTES = 8 * HTB, NXCD = 8, WGM = 8;

__host__ __device__ __forceinline__ int lds_byte(int r, int c) { const int st = (r >> 4) * 2 + (c >> 5), rr = r & 15, cc = c & 31, ob = rr * 64 + cc * 2; return st * 1024 + (ob ^ (((ob >> 9) & 1) << 5)); }
__host__ __device__ __forceinline__ void stage_rc(int b, int& R, int& C) { const int st = b / 1024, sb = b % 1024, swz = sb ^ (((sb >> 9) & 1) << 5); R = (st >> 1) * 16 + swz / 64; C = (st & 1) * 32 + (swz % 64) / 2; }
__host__ __device__ __forceinline__ int perm32(int rho) { const int n = rho >> 4, i = rho & 15; return 8 * (i >> 2) + 4 * n + (i & 3); }

struct Unit { int pm, pn; };
struct Gemm { const bf16_t* A; const bf16_t* Bt; int M, N, K, lda; };

struct StaticOrder {
    int nM, nN, nwg, G, c;
    __host__ __device__ void init(int M, int N, int G_, int c_) { nM = M / BM; nN = N / BM; nwg = nM * nN; G = G_; c = c_; }
    __host__ __device__ bool next(int i, Unit& u) const {
        const long L = (long)i * G + c; if (L >= nwg) return false;
        int wgid = (int)L; { const int q = nwg / NXCD, r = nwg % NXCD, xcd = wgid % NXCD, off = wgid / NXCD; wgid = (xcd < r ? xcd * (q + 1) : r * (q + 1) + (xcd - r) * q) + off; }
        const int nig = WGM * nN, gid = wgid / nig, fm = gid * WGM, gsz = (nM - fm) < WGM ? (nM - fm) : WGM;
        u.pm = fm + ((wgid % nig) % gsz); u.pn = (wgid % nig) / gsz; return true;
    }
    __device__ __forceinline__ void a_ready(const Unit&) const {}
    __device__ __forceinline__ void done(const Unit&) const {}
};

template <class Epi, class Sched, bool ALIGN_EPI = false, bool SP2 = false>
__device__ __forceinline__ void gemm_phase(PG8_LAS unsigned char* lds, const Gemm g, const Sched& S, const Epi& E, int wv) {
    const int tid = get_tid(wv), wid = __builtin_amdgcn_readfirstlane(tid >> 6), lane = tid & 63, wr = wid >> 2, wc = wid & 3, fr = lane & 15, fq = lane >> 4;
    const int K = g.K, nt = K / BK;
    unsigned voffA[2], voffB[2];
#pragma unroll
    for (int i = 0; i < 2; ++i) { int R, C; stage_rc(tid * 16 + i * 8192, R, C); const int Rb = Epi::PERM ? ((R & ~31) + perm32(R & 31)) : R;
        voffA[i] = (unsigned)(R * g.lda + C) * 2u; voffB[i] = (unsigned)(Rb * K + C) * 2u; }
    const size_t kstep = (size_t)(BK * 2);
    const size_t hstepA = (size_t)HALF * g.lda * 2, hstepB = (size_t)HALF * K * 2;
    const size_t tstepA = 2 * hstepA, tstepB = 2 * hstepB;
    const unsigned ldsw = (unsigned)wid * 1024u;
    const int aoff = lds_byte(wr * 64 + fr, fq * 8), boff = lds_byte(wc * 32 + fr, fq * 8);
#define PG8_SA(b, h) (((b) * 2 + (h)) * HTB)
#define PG8_SB(b, h) ((4 + (b) * 2 + (h)) * HTB)
#define PG8_STAGE(bufoff, gbase, voff) do { _Pragma("unroll") for (int _i = 0; _i < 2; ++_i) \
        __builtin_amdgcn_global_load_lds((const unsigned*)((const char*)(gbase) + (voff)[_i]), (PG8_LAS unsigned*)(lds + (bufoff) + ldsw + _i * 8192), 16, 0, 0); } while (0)
#define PG8_LDA(dst, b, h) do { _Pragma("unroll") for (int m = 0; m < 4; ++m) _Pragma("unroll") for (int k = 0; k < 2; ++k) dst[m][k] = *(const PG8_LAS bf16x8*)(lds + PG8_SA(b, h) + aoff + m * 2048 + k * 1024); } while (0)
#define PG8_LDB(dst, b, h) do { _Pragma("unroll") for (int n = 0; n < 2; ++n) _Pragma("unroll") for (int k = 0; k < 2; ++k) dst[n][k] = *(const PG8_LAS bf16x8*)(lds + PG8_SB(b, h) + boff + n * 2048 + k * 1024); } while (0)
#define PG8_MMA(ai, bj, At, Bt) do { __builtin_amdgcn_s_setprio(1); _Pragma("unroll") for (int m = 0; m < 4; ++m) _Pragma("unroll") for (int n = 0; n < 2; ++n) _Pragma("unroll") for (int k = 0; k < 2; ++k) \
        acc[ai][bj][m][n] = __builtin_amdgcn_mfma_f32_16x16x32_bf16(Bt[n][k], At[m][k], acc[ai][bj][m][n], 0, 0, 0); __builtin_amdgcn_s_setprio(0); } while (0)
#define PG8_WAIT_V(n) asm volatile("s_waitcnt vmcnt(" #n ")" ::: "memory")
#define PG8_WAIT_L(n) asm volatile("s_waitcnt lgkmcnt(" #n ")" ::: "memory")
#define PG8_BAR __builtin_amdgcn_s_barrier()
#define PG8_SCHED __builtin_amdgcn_sched_barrier(0)
    Unit cur, nxt; int ui = 0;
    if (!S.next(0, cur)) return;
    f32x4 acc[2][2][4][2];
#pragma unroll
    for (int a = 0; a < 2; ++a)
#pragma unroll
        for (int b = 0; b < 2; ++b)
#pragma unroll
            for (int m = 0; m < 4; ++m)
#pragma unroll
                for (int n = 0; n < 2; ++n) acc[a][b][m][n] = (f32x4){0.f, 0.f, 0.f, 0.f};
    bf16x8 At[4][2], B0[2][2], B1[2][2];
    const char* cA = (const char*)g.A + (size_t)cur.pm * tstepA; const char* cB = (const char*)g.Bt + (size_t)cur.pn * tstepB;
    S.a_ready(cur);
    if constexpr (SP2) {
        PG8_STAGE(PG8_SB(0, 0), cB, voffB); PG8_STAGE(PG8_SB(0, 1), cB + hstepB, voffB); PG8_STAGE(PG8_SA(0, 0), cA, voffA); PG8_STAGE(PG8_SA(0, 1), cA + hstepA, voffA);
        if (wr == 1) PG8_BAR;
        PG8_WAIT_V(2); PG8_BAR;
        PG8_STAGE(PG8_SB(1, 0), cB + kstep, voffB); PG8_STAGE(PG8_SA(1, 0), cA + kstep, voffA); PG8_STAGE(PG8_SB(1, 1), cB + hstepB + kstep, voffB);
        PG8_WAIT_V(6); PG8_BAR;
    } else {
        PG8_STAGE(PG8_SB(0, 0), cB, voffB); PG8_STAGE(PG8_SA(0, 0), cA, voffA); PG8_STAGE(PG8_SB(0, 1), cB + hstepB, voffB); PG8_STAGE(PG8_SA(0, 1), cA + hstepA, voffA);
        if (wr == 1) PG8_BAR;
        PG8_WAIT_V(4); PG8_BAR;
        PG8_STAGE(PG8_SB(1, 0), cB + kstep, voffB); PG8_STAGE(PG8_SA(1, 0), cA + kstep, voffA); PG8_STAGE(PG8_SB(1, 1), cB + hstepB + kstep, voffB);
        PG8_WAIT_V(6); PG8_BAR;
    }
    for (;;) {
        const bool has_next = S.next(ui + 1, nxt);
        const char* nA = has_next ? (const char*)g.A + (size_t)nxt.pm * tstepA : cA; const char* nB = has_next ? (const char*)g.Bt + (size_t)nxt.pn * tstepB : cB;
        for (int t = 0; t < nt; t += 2) {
            const bool last = (t == nt - 2);
            const char* a1 = cA + (size_t)(t + 1) * kstep;
            const char* a2 = last ? nA : cA + (size_t)(t + 2) * kstep; const char* b2 = last ? nB : cB + (size_t)(t + 2) * kstep;
            const char* a3 = a2 + kstep; const char* b3 = b2 + kstep;
            if (last && has_next) S.a_ready(nxt);
            if constexpr (SP2) {
            PG8_LDB(B0, 0, 0); PG8_LDB(B1, 0, 1); PG8_SCHED; PG8_LDA(At, 0, 0); PG8_STAGE(PG8_SA(1, 1), a1 + hstepA, voffA);
            PG8_WAIT_V(8); PG8_WAIT_L(0); PG8_BAR; PG8_MMA(0, 0, At, B0); PG8_MMA(0, 1, At, B1); PG8_BAR; PG8_SCHED;
            PG8_LDA(At, 0, 1); PG8_STAGE(PG8_SB(0, 0), b2, voffB); PG8_STAGE(PG8_SB(0, 1), b2 + hstepB, voffB); PG8_STAGE(PG8_SA(0, 0), a2, voffA);
            PG8_WAIT_V(8); PG8_WAIT_L(0); PG8_BAR; PG8_MMA(1, 0, At, B0); PG8_MMA(1, 1, At, B1); PG8_BAR; PG8_SCHED;
            PG8_LDB(B0, 1, 0); PG8_LDB(B1, 1, 1); PG8_SCHED; PG8_LDA(At, 1, 0); PG8_STAGE(PG8_SA(0, 1), a2 + hstepA, voffA);
            PG8_WAIT_V(8); PG8_WAIT_L(0); PG8_BAR; PG8_MMA(0, 0, At, B0); PG8_MMA(0, 1, At, B1); PG8_BAR; PG8_SCHED;
            PG8_LDA(At, 1, 1); PG8_STAGE(PG8_SB(1, 0), b3, voffB); PG8_STAGE(PG8_SB(1, 1), b3 + hstepB, voffB); PG8_STAGE(PG8_SA(1, 0), a3, voffA);
            PG8_WAIT_V(8); PG8_WAIT_L(0); PG8_BAR; PG8_MMA(1, 0, At, B0); PG8_MMA(1, 1, At, B1); PG8_BAR; PG8_SCHED;
            } else {
            PG8_LDB(B0, 0, 0); PG8_SCHED; PG8_LDA(At, 0, 0); PG8_STAGE(PG8_SA(1, 1), a1 + hstepA, voffA);
            PG8_WAIT_L(8); PG8_BAR; PG8_WAIT_L(0); PG8_MMA(0, 0, At, B0); PG8_BAR; PG8_SCHED;
            PG8_LDB(B1, 0, 1); PG8_STAGE(PG8_SB(0, 0), b2, voffB);
            PG8_BAR; PG8_WAIT_L(0); PG8_MMA(0, 1, At, B1); PG8_BAR;
            PG8_LDA(At, 0, 1); PG8_STAGE(PG8_SA(0, 0), a2, voffA);
            PG8_BAR; PG8_WAIT_L(0); PG8_MMA(1, 0, At, B0); PG8_BAR; PG8_SCHED;
            PG8_STAGE(PG8_SB(0, 1), b2 + hstepB, voffB);
            PG8_WAIT_V(6); PG8_BAR; PG8_MMA(1, 1, At, B1); PG8_BAR;
            PG8_LDB(B0, 1, 0); PG8_SCHED; PG8_LDA(At, 1, 0); PG8_STAGE(PG8_SA(0, 1), a2 + hstepA, voffA);
            PG8_WAIT_L(8); PG8_BAR; PG8_WAIT_L(0); PG8_MMA(0, 0, At, B0); PG8_BAR; PG8_SCHED;
            PG8_LDB(B1, 1, 1); PG8_STAGE(PG8_SB(1, 0), b3, voffB);
            PG8_BAR; PG8_WAIT_L(0); PG8_MMA(0, 1, At, B1); PG8_BAR;
            PG8_LDA(At, 1, 1); PG8_STAGE(PG8_SA(1, 0), a3, voffA);
            PG8_BAR; PG8_WAIT_L(0); PG8_MMA(1, 0, At, B0); PG8_BAR; PG8_SCHED;
            PG8_STAGE(PG8_SB(1, 1), b3 + hstepB, voffB);
            PG8_WAIT_V(6); PG8_BAR; PG8_MMA(1, 1, At, B1); PG8_BAR;
            }
        }
        if constexpr (ALIGN_EPI) { if (wr == 0) PG8_BAR; }
        if constexpr (!Epi::AFTER_DRAIN) { E(acc, cur, wr, wc, fr, fq); S.done(cur); }
        if (!has_next) break;
#pragma unroll
        for (int a = 0; a < 2; ++a)
#pragma unroll
            for (int b = 0; b < 2; ++b)
#pragma unroll
                for (int m = 0; m < 4; ++m)
#pragma unroll
                    for (int n = 0; n < 2; ++n) acc[a][b][m][n] = (f32x4){0.f, 0.f, 0.f, 0.f};
        cur = nxt; cA = nA; cB = nB; ++ui;
        if constexpr (ALIGN_EPI) { if (wr == 1) PG8_BAR; }
    }
    PG8_WAIT_V(0);
    if constexpr (!ALIGN_EPI) { if (wr == 0) PG8_BAR; }
    PG8_BAR;
    if constexpr (Epi::AFTER_DRAIN) { E.fused(acc, cur, wr, wc, fr, fq, lds, wid, lane); S.done(cur); }
#undef PG8_SA
#undef PG8_SB
#undef PG8_STAGE
#undef PG8_LDA
#undef PG8_LDB
#undef PG8_MMA
#undef PG8_WAIT_V
#undef PG8_WAIT_L
#undef PG8_BAR
#undef PG8_SCHED
}
}

typedef unsigned short bf16_t;
typedef short bf16x8 __attribute__((ext_vector_type(8)));
typedef short s16x4 __attribute__((ext_vector_type(4)));
typedef float f32x4 __attribute__((ext_vector_type(4)));
typedef float f32x16 __attribute__((ext_vector_type(16)));
typedef unsigned u32x4 __attribute__((ext_vector_type(4)));
typedef unsigned u32x2 __attribute__((ext_vector_type(2)));
typedef float f32x2 __attribute__((ext_vector_type(2)));

constexpr int DM = 1024, NB = 8, SEQ = 2048, CTXL = 256, LT = SEQ + CTXL  , MROWS = NB * LT  ;
constexpr int EVEN_IN = 4608, ODD_IN = 5120, NCHUNK = LT / 64  ;
constexpr float RMS_EPS = 1e-6f, LOG2E = 1.4426950408889634f;
constexpr int LDS_BYTES = 160 * 1024;
constexpr int NPHASE = 22;

constexpr size_t WS_CTL = 0;
constexpr size_t WS_MOD = 65536;
constexpr size_t WS_ROPE = 524288;
constexpr size_t WS_AGG = 1048576;
constexpr size_t WS_HCTX = WS_AGG + 4718592;
constexpr size_t WS_WIN = WS_HCTX + 8388608;
constexpr size_t WS_WOUT = WS_WIN + 10485760;
constexpr size_t WS_WRG = WS_WOUT + 4194304;
constexpr size_t WS_OV = WS_WRG + 1048576;
constexpr size_t WS_P = WS_OV + 37748736;
constexpr size_t WS_END = WS_P + 188743680;
static_assert(WS_END <= 268435456, "workspace map exceeds 256 MiB");

struct Params {
    const float *x, *c, *ctx, *c_ctx, *ada_w, *ada_b, *norm_w, *ev_w_in, *ev_conv_w, *ev_conv_b, *ev_rg_wx, *ev_rg_bx, *ev_rg_wa, *ev_rg_ba,
        *ev_rg_lambda, *ev_sink, *ev_w_out, *od_w_in, *od_lb_raw, *od_gnorm_w, *od_w_out, *final_norm_w;
    float* out; unsigned char* ws; int ph_lo, ph_hi;
};

DI float bf2f(unsigned short v) { return __uint_as_float((unsigned)v << 16); }
DI unsigned f2bf(float f) { unsigned u = __float_as_uint(f); return (u + 0x7fffu + ((u >> 16) & 1u)) >> 16; }
typedef __bf16 bf16x2_hw __attribute__((ext_vector_type(2)));
DI unsigned pk2(float lo, float hi) { const f32x2 v = {lo, hi}; return __builtin_bit_cast(unsigned, __builtin_convertvector(v, bf16x2_hw)); }
DI float sigm(float x) { return __builtin_amdgcn_rcpf(1.f + __expf(-x)); }
DI float softplus_neg(float lam) {
    const float e = __expf(-lam);
    return e < 0.06f ? e * (1.f + e * (-0.5f + e * (0.33333333f + e * (-0.25f + e * 0.2f)))) : __logf(1.f + e);
}
DI float neg_expm1(float x) {
    return x > -0.25f ? -x * (1.f + x * (0.5f + x * (0.16666667f + x * (0.041666668f + x * (0.0083333338f + x * 0.0013888889f))))) : 1.f - __expf(x);
}
DI float wave_sum(float v) {
#pragma unroll
    for (int o = 1; o < 64; o <<= 1) v += shfl_xor_f(v, o);
    return v;
}
DI int crow(int reg, int h) { return (reg & 3) + 8 * (reg >> 2) + 4 * h; }
#define MFMA16(a, b, c) __builtin_amdgcn_mfma_f32_16x16x32_bf16((a), (b), (c), 0, 0, 0)
#define MFMA32(a, b, c) __builtin_amdgcn_mfma_f32_32x32x16_bf16((a), (b), (c), 0, 0, 0)

struct EpiStoreBf16 {
    static constexpr bool PERM = true, AFTER_DRAIN = false;
    bf16_t* O; int ldc;
    DI void operator()(const f32x4 (&acc)[2][2][4][2], const pg8::Unit& u, int wr, int wc, int fr, int fq) const {
        const int row0 = u.pm * 256 + wr * 64 + fr, col0 = u.pn * 256 + wc * 32 + 8 * fq;
#pragma unroll
        for (int ai = 0; ai < 2; ++ai)
#pragma unroll
            for (int m = 0; m < 4; ++m) { bf16_t* rowp = O + (size_t)(row0 + ai * 128 + m * 16) * ldc + col0;
#pragma unroll
                for (int bj = 0; bj < 2; ++bj) { const f32x4 v0 = acc[ai][bj][m][0], v1 = acc[ai][bj][m][1];
                    u32x4 w; w.x = pk2(v0[0], v0[1]); w.y = pk2(v0[2], v0[3]); w.z = pk2(v1[0], v1[1]); w.w = pk2(v1[2], v1[3]);
                    *(u32x4*)(rowp + bj * 128) = w; } }
    }
};
struct EpiResid {
    static constexpr bool PERM = false, AFTER_DRAIN = false;
    const float* in_lat; const float* in_ctx; float* out_lat; float* out_ctx; const float* gate;
    DI void operator()(const f32x4 (&acc)[2][2][4][2], const pg8::Unit& u, int wr, int wc, int fr, int fq) const {
        const int b = u.pm / 9, jt = u.pm % 9;
        const float* ib; float* ob; const float* g;
        if (jt == 0) { const size_t off = (size_t)b * CTXL * DM; ib = in_ctx + off; ob = out_ctx + off; g = gate + 8 * 3072; }
        else { const size_t off = ((size_t)b * SEQ + (size_t)(jt - 1) * 256) * DM; ib = in_lat + off; ob = out_lat + off; g = gate + b * 3072; }
        const int col0 = u.pn * 256 + wc * 32 + 4 * fq;
#pragma unroll
        for (int bj = 0; bj < 2; ++bj)
#pragma unroll
            for (int n = 0; n < 2; ++n) {
                const f32x4 gvv = *(const f32x4*)(g + col0 + bj * 128 + n * 16);
#pragma unroll
                for (int ai = 0; ai < 2; ++ai) {
#pragma unroll
                    for (int m = 0; m < 4; ++m) { const int r = ai * 128 + wr * 64 + m * 16 + fr;
                        const size_t off = (size_t)r * DM + col0 + bj * 128 + n * 16;
                        const f32x4 o = *(const f32x4*)(ib + off) + gvv * acc[ai][bj][m][n]; *(f32x4*)(ob + off) = o; }
                    asm volatile("" ::: "memory");
                }
            }
    }
};

DI void phase_pro(const Params& P, LAS unsigned char* lds, int wv) {
    const int tid = get_tid(wv);
    LAS float* s = (LAS float*)lds;
    LAS float* red = (LAS float*)(lds + 36864);
    float* mod = (float*)(P.ws + WS_MOD);
    for (int i = tid; i < 9 * 1024; i += 512) { const int r = i >> 10, k = i & 1023; const float v = r < 8 ? P.c[r * 1024 + k] : P.c_ctx[k]; s[i] = v * sigm(v); }
    __syncthreads();
    for (int item = get_bid(); item < 384; item += gridDim.x) {
        const int l = item / 96, n0 = (item % 96) * 32, ks = tid >> 5, col = tid & 31;
        const float* w = P.ada_w + (size_t)l * 1024 * 3072 + n0 + col;
        float acc[9];
#pragma unroll
        for (int r = 0; r < 9; ++r) acc[r] = 0.f;
#pragma unroll 8
        for (int kk = 0; kk < 64; ++kk) { const int k = ks * 64 + kk; const float wv = w[(size_t)k * 3072];
#pragma unroll
            for (int r = 0; r < 9; ++r) acc[r] += s[r * 1024 + k] * wv; }
#pragma unroll
        for (int r = 0; r < 9; ++r) red[(ks * 9 + r) * 32 + col] = acc[r];
        __syncthreads();
        if (tid < 288) { const int r = tid >> 5, cc = tid & 31; float sum = 0.f;
#pragma unroll
            for (int k2 = 0; k2 < 16; ++k2) sum += red[(k2 * 9 + r) * 32 + cc];
            mod[(l * 9 + r) * 3072 + n0 + cc] = sum + P.ada_b[l * 3072 + n0 + cc]; }
        __syncthreads();
    }
    float* cos_t = (float*)(P.ws + WS_ROPE); float* sin_t = cos_t + SEQ * 32;
    for (int i = get_bid() * 512 + tid; i < SEQ * 32; i += gridDim.x * 512) {
        const int pos = i >> 5, jj = i & 31, fi = jj & 15;
        const float inv = __builtin_amdgcn_exp2f(-(float)(2 * fi) * (13.287712379549449f / 32.f));
        const float ang = (float)(jj < 16 ? (pos >> 6) : (pos & 63)) * inv;
        cos_t[i] = __cosf(ang); sin_t[i] = __sinf(ang);
    }
}

DI void transpose_item(const float* W, int K, int N, bf16_t* WT, LAS float* scr, int item, int lane) {
    const int nblk = N / 32, kb = item / nblk, nb = item % nblk, k0 = 64 * kb, n0 = 32 * nb;
#pragma unroll 8
    for (int i = 0; i < 32; ++i) { const int kk = 2 * i + (lane >> 5); scr[kk * 33 + (lane & 31)] = W[(size_t)(k0 + kk) * N + n0 + (lane & 31)]; }
    asm volatile("s_waitcnt lgkmcnt(0)" ::: "memory");
    const int c = lane & 7;
#pragma unroll
    for (int j = 0; j < 4; ++j) { const int n = (lane >> 3) + 8 * j; const LAS float* sp = scr + (8 * c) * 33 + n;
        u32x4 o; o.x = pk2(sp[0 * 33], sp[1 * 33]); o.y = pk2(sp[2 * 33], sp[3 * 33]); o.z = pk2(sp[4 * 33], sp[5 * 33]); o.w = pk2(sp[6 * 33], sp[7 * 33]);
        *(u32x4*)(WT + (size_t)(n0 + n) * K + k0 + 8 * c) = o; }
    asm volatile("s_waitcnt lgkmcnt(0)" ::: "memory");
}

DI void phase_norm(const Params& P, LAS unsigned char* lds, int layer, int wv) {
    const int tid = get_tid(wv), lane = tid & 63, wave = tid >> 6;
    const int gw = get_bid() * 8 + wave, NGW = gridDim.x * 8;
    const int j = layer >> 1;
    LAS float* scr = (LAS float*)(lds + wave * 16384);
    bf16_t* WIN = (bf16_t*)(P.ws + WS_WIN); bf16_t* WOUT = (bf16_t*)(P.ws + WS_WOUT); bf16_t* WRG = (bf16_t*)(P.ws + WS_WRG);
    if ((layer & 1) == 0) {
        constexpr int I_IN = 16 * (EVEN_IN / 32), I_OUT = 32 * 32, I_RG = 32 * 8;
        for (int it = gw; it < I_IN + I_OUT + I_RG; it += NGW) {
            int r = it;
            if (r < I_IN) { transpose_item(P.ev_w_in + (size_t)j * 1024 * EVEN_IN, 1024, EVEN_IN, WIN, scr, r, lane); continue; } r -= I_IN;
            if (r < I_OUT) { transpose_item(P.ev_w_out + (size_t)j * 2048 * 1024, 2048, 1024, WOUT, scr, r, lane); continue; } r -= I_OUT;
            const int mat = r >> 3, sub = r & 7;
            const int dir = mat >> 4, gate = (mat >> 3) & 1, hd = mat & 7;
            const float* src = (gate == 0 ? P.ev_rg_wx : P.ev_rg_wa) + ((size_t)((j * 2 + dir) * 8 + hd)) * 16384;
            transpose_item(src, 128, 128, WRG + (size_t)mat * 16384, scr, sub, lane);
        }
    } else {
        constexpr int I_IN = 16 * (ODD_IN / 32), I_OUT = 16 * 32;
        for (int it = gw; it < I_IN + I_OUT; it += NGW) {
            int r = it;
            if (r < I_IN) { transpose_item(P.od_w_in + (size_t)j * 1024 * ODD_IN, 1024, ODD_IN, WIN, scr, r, lane); continue; } r -= I_IN;
            transpose_item(P.od_w_out + (size_t)j * 1024 * 1024, 1024, 1024, WOUT, scr, r, lane);
        }
    }
    const float* hl = layer == 0 ? P.x : P.out; const float* hc = layer == 0 ? P.ctx : (const float*)(P.ws + WS_HCTX);
    const float* mod = (const float*)(P.ws + WS_MOD) + (size_t)layer * 9 * 3072;
    const float* nw = P.norm_w + layer * 1024;
    bf16_t* U = (bf16_t*)(P.ws + WS_OV);
    for (int R = gw; R < MROWS; R += NGW) {
        const int b = R / LT, jr = R % LT;
        const float* src = jr < CTXL ? hc + ((size_t)b * CTXL + jr) * DM : hl + ((size_t)b * SEQ + (jr - CTXL)) * DM;
        const float* sh = mod + (jr < CTXL ? 8 : b) * 3072; const float* sc = sh + 1024;
        f32x4 v[4]; float ss = 0.f;
#pragma unroll
        for (int q = 0; q < 4; ++q) { v[q] = *(const f32x4*)(src + 4 * lane + 256 * q); ss += (v[q][0] * v[q][0] + v[q][1] * v[q][1]) + (v[q][2] * v[q][2] + v[q][3] * v[q][3]); }
        const float rstd = rsqrtf(wave_sum(ss) * (1.f / DM) + RMS_EPS);
#pragma unroll
        for (int q = 0; q < 4; ++q) { const int k = 4 * lane + 256 * q;
            const f32x4 w4 = *(const f32x4*)(nw + k), s4 = *(const f32x4*)(sc + k), h4 = *(const f32x4*)(sh + k);
            const f32x4 y = (v[q] * rstd) * w4; const f32x4 o = y * (s4 + 1.f) + h4;
            u32x2 w; w.x = pk2(o[0], o[1]); w.y = pk2(o[2], o[3]); *(u32x2*)(U + (size_t)R * DM + k) = w; }
    }
}

typedef _Float16 f16x2_t __attribute__((ext_vector_type(2)));
DI unsigned pkh2(float a, float b) { const f16x2_t v = {(_Float16)a, (_Float16)b}; return __builtin_bit_cast(unsigned, v); }
DI void unpkh2(unsigned u, float& a, float& b) { const f16x2_t v = __builtin_bit_cast(f16x2_t, u); a = (float)v[0]; b = (float)v[1]; }
constexpr int RG_UT = 0, RG_AL = 17408, RG_BL = 50176, RG_HP = 82944, RG_QA = 148480, RG_CAR = 152576, RG_FLAG = 153600, RG_END = 153664;
static_assert(RG_END <= LDS_BYTES - 256, "RG-LRU LDS map");
constexpr int CW_RG = 8192;
DI void rglru_item(const Params& P, LAS unsigned char* lds, int j, int item, int wv) {
    const int tid = get_tid(wv), lane = tid & 63, wave = tid >> 6, r = lane & 15, g = lane >> 4;
    const int grp = item / NCHUNK, ci = item % NCHUNK, b = grp >> 3, hd = grp & 7;
    bf16_t* p = (bf16_t*)(P.ws + WS_P);
    const bf16_t* WRG = (const bf16_t*)(P.ws + WS_WRG);
    unsigned long long* AGG = (unsigned long long*)(P.ws + WS_AGG);
    unsigned* cnt = (unsigned*)(P.ws + WS_CTL) + CW_RG + (j * 64 + grp) * 16;
    const int R0 = b * LT + ci * 64;
    const int seg_lo = b * LT + (ci < 4 ? 0 : CTXL), seg_hi = b * LT + (ci < 4 ? CTXL : LT);
    LAS bf16_t* UT = (LAS bf16_t*)(lds + RG_UT);
    LAS float* AL = (LAS float*)(lds + RG_AL);
    LAS float* BL = (LAS float*)(lds + RG_BL);
    LAS unsigned* HP = (LAS unsigned*)(lds + RG_HP);
    LAS float* QA = (LAS float*)(lds + RG_QA);
    LAS float* CAR = (LAS float*)(lds + RG_CAR);
#pragma unroll
    for (int rep = 0; rep < 2; ++rep) {
        const int idx = tid + rep * 512, t = idx >> 4, c0 = (idx & 15) * 8, cg0 = hd * 128 + c0;
        float acc[8];
        { const f32x4 b0 = *(const f32x4*)(P.ev_conv_b + j * 1024 + cg0), b1 = *(const f32x4*)(P.ev_conv_b + j * 1024 + cg0 + 4);
          acc[0] = b0[0]; acc[1] = b0[1]; acc[2] = b0[2]; acc[3] = b0[3]; acc[4] = b1[0]; acc[5] = b1[1]; acc[6] = b1[2]; acc[7] = b1[3]; }
#pragma unroll
        for (int k = 0; k < 4; ++k) {
            const int Rg = R0 + t + k - 1;
            if (Rg >= seg_lo && Rg < seg_hi) {
                const u32x4 xv = *(const u32x4*)(p + (size_t)Rg * EVEN_IN + cg0);
                const float* wk = P.ev_conv_w + (size_t)(j * 4 + k) * 1024 + cg0;
                const f32x4 w0 = *(const f32x4*)wk, w1 = *(const f32x4*)(wk + 4);
                acc[0] += w0[0] * __uint_as_float(xv.x << 16); acc[1] += w0[1] * __uint_as_float(xv.x & 0xffff0000u);
                acc[2] += w0[2] * __uint_as_float(xv.y << 16); acc[3] += w0[3] * __uint_as_float(xv.y & 0xffff0000u);
                acc[4] += w1[0] * __uint_as_float(xv.z << 16); acc[5] += w1[1] * __uint_as_float(xv.z & 0xffff0000u);
                acc[6] += w1[2] * __uint_as_float(xv.w << 16); acc[7] += w1[3] * __uint_as_float(xv.w & 0xffff0000u);
            }
        }
        u32x4 o; o.x = pk2(acc[0], acc[1]); o.y = pk2(acc[2], acc[3]); o.z = pk2(acc[4], acc[5]); o.w = pk2(acc[6], acc[7]);
        *(LAS u32x4*)(UT + t * 136 + c0) = o;
    }
    __syncthreads();
#pragma unroll 1
    for (int dir = 0; dir < 2; ++dir) {
        f32x4 ax[4], aa[4];
#pragma unroll
        for (int m = 0; m < 4; ++m) { ax[m] = (f32x4){0.f, 0.f, 0.f, 0.f}; aa[m] = (f32x4){0.f, 0.f, 0.f, 0.f}; }
        const bf16_t* Wx = WRG + (size_t)((dir * 2 + 0) * 8 + hd) * 16384 + (16 * wave + r) * 128 + 8 * g;
        const bf16_t* Wa = WRG + (size_t)((dir * 2 + 1) * 8 + hd) * 16384 + (16 * wave + r) * 128 + 8 * g;
#pragma unroll
        for (int ks = 0; ks < 4; ++ks) {
            const bf16x8 bx = *(const bf16x8*)(Wx + 32 * ks), ba = *(const bf16x8*)(Wa + 32 * ks);
#pragma unroll
            for (int m = 0; m < 4; ++m) {
                const bf16x8 a = *(const LAS bf16x8*)(UT + (16 * m + r) * 136 + 32 * ks + 8 * g);
                ax[m] = MFMA16(a, bx, ax[m]); aa[m] = MFMA16(a, ba, aa[m]);
            }
        }
        {
            const int c = 16 * wave + r, idx = (j * 2 + dir) * 1024 + hd * 128 + c;
            const float bxv = P.ev_rg_bx[idx], bav = P.ev_rg_ba[idx], lam = P.ev_rg_lambda[idx];
            const float sp = softplus_neg(lam);
#pragma unroll
            for (int m = 0; m < 4; ++m)
#pragma unroll
                for (int i = 0; i < 4; ++i) {
                    const int t = 16 * m + 4 * g + i;
                    const float gx = sigm(ax[m][i] + bxv), ga = sigm(aa[m][i] + bav);
                    const float la = -8.f * ga * sp;
                    const float a = __expf(la), mult = __builtin_amdgcn_sqrtf(neg_expm1(2.f * la));
                    const float uv = bf2f(UT[t * 136 + c]);
                    AL[t * 128 + c] = a; BL[t * 128 + c] = mult * gx * uv;
                }
        }
        __syncthreads();
        {
            const int c = tid & 127, q = tid >> 7;
            float A = 1.f, B = 0.f;
#pragma unroll
            for (int s = 0; s < 16; ++s) { const int t = dir == 0 ? 16 * q + s : 16 * q + 15 - s; const float a = AL[t * 128 + c], bb = BL[t * 128 + c]; B = a * B + bb; A *= a; }
            QA[(q * 128 + c) * 2] = A; QA[(q * 128 + c) * 2 + 1] = B;
            __syncthreads();
            float h = 0.f, pc = 1.f;
            const int nprev = dir == 0 ? q : 3 - q;
            for (int qq = 0; qq < nprev; ++qq) { const int qi = dir == 0 ? qq : 3 - qq; const float a = QA[(qi * 128 + c) * 2]; h = a * h + QA[(qi * 128 + c) * 2 + 1]; pc *= a; }
#pragma unroll
            for (int s = 0; s < 16; ++s) { const int t = dir == 0 ? 16 * q + s : 16 * q + 15 - s; const float a = AL[t * 128 + c]; h = a * h + BL[t * 128 + c]; pc *= a;
                HP[(dir * 64 + t) * 128 + c] = pkh2(h, pc); }
            if (nprev == 3) {
                const unsigned long long v = ((unsigned long long)__float_as_uint(h) << 32) | __float_as_uint(pc);
                __hip_atomic_store(AGG + ((size_t)(dir * NB + b) * NCHUNK + ci) * 1024 + hd * 128 + c, v, __ATOMIC_RELAXED, __HIP_MEMORY_SCOPE_AGENT);
            }
        }
        __syncthreads();
    }
    asm volatile("s_waitcnt vmcnt(0)" ::: "memory");
    __syncthreads();
    if (tid == 0) {
        __hip_atomic_fetch_add(cnt, 1u, __ATOMIC_RELAXED, __HIP_MEMORY_SCOPE_AGENT);
        unsigned spins = 0;
        while (__hip_atomic_load(cnt, __ATOMIC_RELAXED, __HIP_MEMORY_SCOPE_AGENT) < (unsigned)NCHUNK) { __builtin_amdgcn_s_sleep(2); if (++spins > (1u << 22)) break; }
    }
    __syncthreads();
    if (tid < 256) {
        const int dir = tid >> 7, c = tid & 127;
        const int pos = dir == 0 ? ci : (ci < 4 ? 3 - ci : 39 - ci);
        float h = 0.f;
        const unsigned long long* ag = AGG + (size_t)(dir * NB + b) * NCHUNK * 1024 + hd * 128 + c;
#pragma unroll
        for (int half = 0; half < 2; ++half) {
            unsigned long long v[18];
#pragma unroll
            for (int k = 0; k < 18; ++k) { const int pp = half * 18 + k; const int cc = dir == 0 ? pp : (pp < 4 ? 3 - pp : 39 - pp);
                v[k] = __hip_atomic_load(ag + (size_t)cc * 1024, __ATOMIC_RELAXED, __HIP_MEMORY_SCOPE_AGENT); }
#pragma unroll
            for (int k = 0; k < 18; ++k) if (half * 18 + k < pos) h = __uint_as_float((unsigned)v[k]) * h + __uint_as_float((unsigned)(v[k] >> 32));
        }
        CAR[dir * 128 + c] = h;
    }
    __syncthreads();
#pragma unroll
    for (int rep = 0; rep < 2; ++rep) {
        const int idx = tid + rep * 512, t = idx >> 4, c0 = (idx & 15) * 8;
        bf16_t* gp = p + (size_t)(R0 + t) * EVEN_IN + 1536 + hd * 128 + c0;
        const u32x4 gv = *(const u32x4*)gp;
        float y[8];
#pragma unroll
        for (int e = 0; e < 8; ++e) {
            float h0, p0, h1, p1; unpkh2(HP[t * 128 + c0 + e], h0, p0); unpkh2(HP[(64 + t) * 128 + c0 + e], h1, p1);
            y[e] = (h0 + p0 * CAR[c0 + e]) + (h1 + p1 * CAR[128 + c0 + e]);
        }
        const float gg[8] = {__uint_as_float(gv.x << 16), __uint_as_float(gv.x & 0xffff0000u), __uint_as_float(gv.y << 16), __uint_as_float(gv.y & 0xffff0000u),
                             __uint_as_float(gv.z << 16), __uint_as_float(gv.z & 0xffff0000u), __uint_as_float(gv.w << 16), __uint_as_float(gv.w & 0xffff0000u)};
        u32x4 o;
        o.x = pk2(y[0] * gg[0] * sigm(gg[0]), y[1] * gg[1] * sigm(gg[1])); o.y = pk2(y[2] * gg[2] * sigm(gg[2]), y[3] * gg[3] * sigm(gg[3]));
        o.z = pk2(y[4] * gg[4] * sigm(gg[4]), y[5] * gg[5] * sigm(gg[5])); o.w = pk2(y[6] * gg[6] * sigm(gg[6]), y[7] * gg[7] * sigm(gg[7]));
        *(u32x4*)gp = o;
    }
    __syncthreads();
}

DI void rope8(u32x4& v, const float* cs, const float* sn) {
    unsigned* w = (unsigned*)&v;
#pragma unroll
    for (int i = 0; i < 4; ++i) { const float t1 = __uint_as_float(w[i] << 16), t2 = __uint_as_float(w[i] & 0xffff0000u); w[i] = pk2(t1 * cs[i] - t2 * sn[i], t1 * sn[i] + t2 * cs[i]); }
}
typedef short v4i16_a __attribute__((ext_vector_type(4)));
DI void attn_item(const Params& P, LAS unsigned char* lds, int j, int item, int wv) {
    const int tid = get_tid(wv), lane = tid & 63, wave = tid >> 6, r = lane & 31, h = lane >> 5;
    const bool is_lat = item < 512;
    int b, qb, kvh;
    if (is_lat) { b = item >> 6; qb = (item >> 2) & 15; kvh = item & 3; } else { const int it = item - 512; b = it >> 3; qb = (it >> 2) & 1; kvh = it & 3; }
    bf16_t* p = (bf16_t*)(P.ws + WS_P);
    const float* cos_t = (const float*)(P.ws + WS_ROPE); const float* sin_t = cos_t + SEQ * 32;
    LAS unsigned char* QL = lds + 36864 + wave * 9216;
    const int hq = 4 * kvh + (wave >> 1), ql0 = qb * 128 + 64 * (wave & 1);
    const size_t rowbase = (size_t)b * LT + (is_lat ? CTXL : 0);
#pragma unroll
    for (int qt = 0; qt < 2; ++qt) {
        const int qi = ql0 + 32 * qt + r;
        const bf16_t* qp = p + (rowbase + qi) * EVEN_IN + 2560 + hq * 64 + 8 * h;
#pragma unroll
        for (int ks = 0; ks < 4; ++ks) {
            u32x4 v = *(const u32x4*)(qp + 16 * ks);
            if (is_lat) rope8(v, cos_t + qi * 32 + 8 * ks + 4 * h, sin_t + qi * 32 + 8 * ks + 4 * h);
            *(LAS u32x4*)(QL + (32 * qt + r) * 144 + (16 * ks + 8 * h) * 2) = v;
        }
    }
    const float sink2 = P.ev_sink[j * 16 + hq] * LOG2E;
    float mrun[2] = {sink2, sink2}, lrun[2] = {h == 0 ? 1.f : 0.f, h == 0 ? 1.f : 0.f};
    f32x16 O[2][2];
#pragma unroll
    for (int a = 0; a < 2; ++a)
#pragma unroll
        for (int c = 0; c < 2; ++c)
#pragma unroll
            for (int i = 0; i < 16; ++i) O[a][c][i] = 0.f;
    const int w_lo = (is_lat && qb == 0) ? 2 : 0, w_hi = (is_lat && qb == 15) ? 3 : 5;
    const int nT = is_lat ? 4 + (w_hi - w_lo + 1) : 4;
    const float SC = 0.125f * LOG2E, NEG = -1e30f;
    const int key = tid >> 3, chn = tid & 7;
    u32x4 kreg, vreg;
#define ATT_K0(t) ((t) < 4 ? 64 * (t) : qb * 128 - 128 + 64 * (w_lo + (t) - 4))
#define ATT_LOAD(t) do { const bool win_ = (t) >= 4; const int k0_ = ATT_K0(t); \
        const bf16_t* kp_ = p + ((size_t)b * LT + (win_ ? CTXL : 0) + k0_ + key) * EVEN_IN + 1024 + kvh * 64 + 8 * chn; \
        kreg = *(const u32x4*)kp_; vreg = *(const u32x4*)(kp_ + 256); } while (0)
#define ATT_STORE(t, buf) do { const bool win_ = (t) >= 4; const int k0_ = ATT_K0(t); \
        if (win_) rope8(kreg, cos_t + (k0_ + key) * 32 + 4 * chn, sin_t + (k0_ + key) * 32 + 4 * chn); \
        *(LAS u32x4*)(lds + (buf) * 18432 + key * 144 + chn * 16) = kreg; *(LAS u32x4*)(lds + (buf) * 18432 + 9216 + key * 144 + chn * 16) = vreg; } while (0)
    ATT_LOAD(0); ATT_STORE(0, 0);
    if (nT > 1) ATT_LOAD(1);
#pragma unroll 1
    for (int t = 0; t < nT; ++t) {
        __syncthreads();
        if (t + 1 < nT) { ATT_STORE(t + 1, (t + 1) & 1); if (t + 2 < nT) ATT_LOAD(t + 2); }
        const bool win = t >= 4;
        const int k0 = ATT_K0(t);
        const int dq = k0 - ql0;
        if (win && (dq >= 192 || dq <= -192)) continue;
        const bool need_mask = win && (dq >= 128 || dq <= -128);
        const LAS unsigned char* KL = lds + (t & 1) * 18432;
        const LAS bf16_t* VL = (const LAS bf16_t*)(lds + (t & 1) * 18432 + 9216);
#pragma unroll
        for (int qt = 0; qt < 2; ++qt) {
            f32x16 s0, s1;
#pragma unroll
            for (int i = 0; i < 16; ++i) { s0[i] = 0.f; s1[i] = 0.f; }
#pragma unroll
            for (int ks = 0; ks < 4; ++ks) {
                const bf16x8 qfr = *(const LAS bf16x8*)(QL + (32 * qt + r) * 144 + (16 * ks + 8 * h) * 2);
                const bf16x8 k0f = *(const LAS bf16x8*)(KL + r * 144 + (16 * ks + 8 * h) * 2), k1f = *(const LAS bf16x8*)(KL + (32 + r) * 144 + (16 * ks + 8 * h) * 2);
                s0 = MFMA32(k0f, qfr, s0); s1 = MFMA32(k1f, qfr, s1);
            }
            const int qpos = ql0 + 32 * qt + r;
            float mx = NEG;
            if (need_mask) {
#pragma unroll
                for (int i = 0; i < 16; ++i) {
                    const int d0 = qpos - (k0 + crow(i, h)), d1 = d0 - 32;
                    float v0 = s0[i] * SC, v1 = s1[i] * SC;
                    if (d0 > 128 || d0 < -128) v0 = NEG;
                    if (d1 > 128 || d1 < -128) v1 = NEG;
                    s0[i] = v0; s1[i] = v1; mx = fmaxf(mx, fmaxf(v0, v1));
                }
            } else {
#pragma unroll
                for (int i = 0; i < 16; ++i) { s0[i] *= SC; s1[i] *= SC; mx = fmaxf(mx, fmaxf(s0[i], s1[i])); }
            }
            mx = fmaxf(mx, shfl_xor_f(mx, 32));
            const float mn = fmaxf(mrun[qt], mx), alpha = __builtin_amdgcn_exp2f(mrun[qt] - mn);
            mrun[qt] = mn;
            float ls = 0.f;
#pragma unroll
            for (int i = 0; i < 16; ++i) { s0[i] = __builtin_amdgcn_exp2f(s0[i] - mn); s1[i] = __builtin_amdgcn_exp2f(s1[i] - mn); ls += s0[i] + s1[i]; }
            lrun[qt] = lrun[qt] * alpha + ls;
#pragma unroll
            for (int dt = 0; dt < 2; ++dt)
#pragma unroll
                for (int i = 0; i < 16; ++i) O[dt][qt][i] *= alpha;
            bf16x8 pf[2][2];
#pragma unroll
            for (int s = 0; s < 2; ++s) {
                u32x4 a, c;
                a.x = pk2(s0[8 * s + 0], s0[8 * s + 1]); a.y = pk2(s0[8 * s + 2], s0[8 * s + 3]); a.z = pk2(s0[8 * s + 4], s0[8 * s + 5]); a.w = pk2(s0[8 * s + 6], s0[8 * s + 7]);
                c.x = pk2(s1[8 * s + 0], s1[8 * s + 1]); c.y = pk2(s1[8 * s + 2], s1[8 * s + 3]); c.z = pk2(s1[8 * s + 4], s1[8 * s + 5]); c.w = pk2(s1[8 * s + 6], s1[8 * s + 7]);
                pf[0][s] = __builtin_bit_cast(bf16x8, a); pf[1][s] = __builtin_bit_cast(bf16x8, c);
            }
            const int gq = (lane >> 4) & 1, qq4 = (lane & 15) >> 2, pp4 = lane & 3;
#pragma unroll
            for (int dt = 0; dt < 2; ++dt)
#pragma unroll
                for (int kt = 0; kt < 2; ++kt)
#pragma unroll
                    for (int s = 0; s < 2; ++s) {
                        const LAS bf16_t* vp = VL + (32 * kt + 16 * s + 4 * h + qq4) * 72 + 32 * dt + 16 * gq + 4 * pp4;
                        const v4i16_a lo = __builtin_amdgcn_ds_read_tr16_b64_v4i16((LAS v4i16_a*)vp);
                        const v4i16_a hi = __builtin_amdgcn_ds_read_tr16_b64_v4i16((LAS v4i16_a*)(vp + 8 * 72));
                        const bf16x8 vf = {lo[0], lo[1], lo[2], lo[3], hi[0], hi[1], hi[2], hi[3]};
                        O[dt][qt] = MFMA32(vf, pf[kt][s], O[dt][qt]);
                    }
            __builtin_amdgcn_sched_barrier(0);
        }
    }
#undef ATT_K0
#undef ATT_LOAD
#undef ATT_STORE
#pragma unroll
    for (int qt = 0; qt < 2; ++qt) {
        const float lt = lrun[qt] + shfl_xor_f(lrun[qt], 32), inv = __builtin_amdgcn_rcpf(lt);
        const int qi = ql0 + 32 * qt + r;
        bf16_t* rowp = p + (rowbase + qi) * EVEN_IN;
#pragma unroll
        for (int dt = 0; dt < 2; ++dt)
#pragma unroll
            for (int i4 = 0; i4 < 4; ++i4) {
                const int d0 = 32 * dt + 8 * i4 + 4 * h;
                const u32x2 gv = *(const u32x2*)(rowp + 3584 + hq * 64 + d0);
                const float g0 = __uint_as_float(gv.x << 16), g1 = __uint_as_float(gv.x & 0xffff0000u), g2 = __uint_as_float(gv.y << 16), g3 = __uint_as_float(gv.y & 0xffff0000u);
                u32x2 o;
                o.x = pk2(O[dt][qt][4 * i4 + 0] * inv * g0 * sigm(g0), O[dt][qt][4 * i4 + 1] * inv * g1 * sigm(g1));
                o.y = pk2(O[dt][qt][4 * i4 + 2] * inv * g2 * sigm(g2), O[dt][qt][4 * i4 + 3] * inv * g3 * sigm(g3));
                *(u32x2*)(rowp + 2560 + hq * 64 + d0) = o;
            }
    }
    __syncthreads();
}

constexpr int G2_QX = 0, G2_KF = 17408, G2_K2 = 60928, G2_VS = 79360, G2_AM = 96768, G2_ST = 105984, G2_PS = 140800, G2_BL = 144896, G2_Q1 = 145408, G2_END = 162816;
static_assert(G2_END <= LDS_BYTES - 256, "GLA LDS map");
typedef short v4i16_t __attribute__((ext_vector_type(4)));
DI bf16x8 frag_tr(const LAS bf16_t* M, int stride, int k0, int n0, int lane) {
    const int i = lane & 15, g = lane >> 4, q = i >> 2, pp = i & 3;
    const LAS bf16_t* a0 = M + (k0 + 8 * g + q) * stride + n0 + 4 * pp;
    const v4i16_t lo = __builtin_amdgcn_ds_read_tr16_b64_v4i16((LAS v4i16_t*)a0);
    const v4i16_t hi = __builtin_amdgcn_ds_read_tr16_b64_v4i16((LAS v4i16_t*)(a0 + 4 * stride));
    return (bf16x8){lo[0], lo[1], lo[2], lo[3], hi[0], hi[1], hi[2], hi[3]};
}

template <int DIR>
DI void gla2_item(const Params& P, LAS unsigned char* lds, int layer_j, int b, int hd, int wv) {
    const int tid = get_tid(wv), lane = tid & 63, wave = tid >> 6, r = lane & 15, g = lane >> 4;
    bf16_t* p = (bf16_t*)(P.ws + WS_P);
    LAS bf16_t* QX = (LAS bf16_t*)(lds + G2_QX); LAS bf16_t* KF = (LAS bf16_t*)(lds + G2_KF); LAS bf16_t* K2 = (LAS bf16_t*)(lds + G2_K2);
    LAS bf16_t* VS = (LAS bf16_t*)(lds + G2_VS); LAS bf16_t* AM = (LAS bf16_t*)(lds + G2_AM); LAS bf16_t* ST = (LAS bf16_t*)(lds + G2_ST);
    LAS float* PS8 = (LAS float*)(lds + G2_PS); LAS float* BLAST = (LAS float*)(lds + G2_BL); LAS bf16_t* Q1 = (LAS bf16_t*)(lds + G2_Q1);
    const int d0 = 2 * lane, tg = wave, I = tg >> 1, half = tg & 1;
    float lbv[2] = {0.f, 0.f};
    if (layer_j > 0) { lbv[0] = sigm(P.od_lb_raw[1024 + hd * 128 + d0] - P.od_lb_raw[hd * 128 + d0]); lbv[1] = sigm(P.od_lb_raw[1024 + hd * 128 + d0 + 1] - P.od_lb_raw[hd * 128 + d0 + 1]); }
    for (int i = tid; i < (9216 + 34816) / 4; i += 512) ((LAS unsigned*)(lds + G2_AM))[i] = 0u;
    f32x4 st[8];
#pragma unroll
    for (int e = 0; e < 8; ++e) st[e] = (f32x4){0.f, 0.f, 0.f, 0.f};
    unsigned zn[8], qn[8]; u32x4 vn[2];
#define G2_OFFZ(s) ((unsigned)((DIR == 0 ? 8 * tg + (s) : 63 - 8 * tg - (s)) * ODD_IN + d0) * 2u)
#define G2_OFFV(rep) ((unsigned)((DIR == 0 ? ((tid + (rep) * 512) >> 4) : 63 - ((tid + (rep) * 512) >> 4)) * ODD_IN + 8 * ((tid + (rep) * 512) & 15)) * 2u)
    const size_t colz = (size_t)DIR * 1024 + hd * 128, colq = 3072 + hd * 128, colv = 2048 + hd * 128;
    {
        const int chunk = DIR == 0 ? 0 : 3;
        const char* slab = (const char*)(p + ((size_t)b * LT + (size_t)chunk * 64) * ODD_IN);
#pragma unroll
        for (int s = 0; s < 8; ++s) { zn[s] = *(const unsigned*)(slab + colz * 2 + G2_OFFZ(s)); qn[s] = *(const unsigned*)(slab + colq * 2 + G2_OFFZ(s)); }
#pragma unroll
        for (int rep = 0; rep < 2; ++rep) vn[rep] = *(const u32x4*)(slab + colv * 2 + G2_OFFV(rep));
    }
    __syncthreads();
#pragma unroll 1
    for (int step = 0; step < NCHUNK; ++step) {
        const int chunk = DIR == 0 ? step : (step < 4 ? 3 - step : 39 - step);
        const size_t Rc0 = (size_t)b * LT + (size_t)chunk * 64;
        unsigned zc[8], qc[8]; u32x4 vc[2];
#pragma unroll
        for (int s = 0; s < 8; ++s) { zc[s] = zn[s]; qc[s] = qn[s]; }
        vc[0] = vn[0]; vc[1] = vn[1];
        float el[8][2], kk[8][2], qq[8][2];
        {
            float run0 = 1.f, run1 = 1.f;
#pragma unroll
            for (int s = 0; s < 8; ++s) {
                const float z0 = __uint_as_float(zc[s] << 16), z1 = __uint_as_float(zc[s] & 0xffff0000u);
                const float t0 = __expf(-z0), t1 = __expf(-z1), sg0 = __builtin_amdgcn_rcpf(1.f + t0), sg1 = __builtin_amdgcn_rcpf(1.f + t1);
                const float f0 = fmaxf(lbv[0] + (1.f - lbv[0]) * sg0, 1e-30f), f1 = fmaxf(lbv[1] + (1.f - lbv[1]) * sg1, 1e-30f);
                kk[s][0] = (1.f - lbv[0]) * (t0 * sg0); kk[s][1] = (1.f - lbv[1]) * (t1 * sg1);
                run0 = fmaxf(run0 * f0, 1e-35f); run1 = fmaxf(run1 * f1, 1e-35f); el[s][0] = run0; el[s][1] = run1;
                const float q0 = __uint_as_float(qc[s] << 16), q1 = __uint_as_float(qc[s] & 0xffff0000u);
                qq[s][0] = q0 * __builtin_amdgcn_rcpf(1.f + __expf(-q0)); qq[s][1] = q1 * __builtin_amdgcn_rcpf(1.f + __expf(-q1));
                if ((s & 1) == 1) __builtin_amdgcn_sched_barrier(0);
            }
            *(LAS f32x2*)(PS8 + tg * 128 + d0) = (f32x2){run0, run1};
#pragma unroll
            for (int rep = 0; rep < 2; ++rep) { const int idx = tid + rep * 512, tau = idx >> 4, chn = idx & 15; *(LAS u32x4*)(VS + tau * 136 + 8 * chn) = vc[rep]; }
        }
        __syncthreads();
        float RI[2];
        {
            float T[8][2];
#pragma unroll
            for (int q8 = 0; q8 < 8; ++q8) { const f32x2 t = *(const LAS f32x2*)(PS8 + q8 * 128 + d0); T[q8][0] = t[0]; T[q8][1] = t[1]; }
            float pre[2], fac[4][2], f4[2];
#pragma unroll
            for (int x = 0; x < 2; ++x) {
                const float P0 = T[0][x] * T[1][x], P1 = T[2][x] * T[3][x], P2 = T[4][x] * T[5][x], P3 = T[6][x] * T[7][x];
                pre[x] = half ? (I == 0 ? T[0][x] : (I == 1 ? T[2][x] : (I == 2 ? T[4][x] : T[6][x]))) : 1.f;
                RI[x] = I == 0 ? 1.f : (I == 1 ? P0 : (I == 2 ? P0 * P1 : P0 * P1 * P2));
                float cur = 1.f;
                fac[0][x] = cur; if (I <= 0) cur *= P0;
                fac[1][x] = cur; if (I <= 1) cur *= P1;
                fac[2][x] = cur; if (I <= 2) cur *= P2;
                fac[3][x] = cur; cur *= P3;
                f4[x] = cur;
                if (tg == 0) BLAST[d0 + x] = P0 * P1 * P2 * P3;
            }
            unsigned w0[4], w1[4];
#pragma unroll
            for (int s = 0; s < 8; ++s) {
                const int tau = 8 * tg + s;
                const float e00 = fmaxf(pre[0] * el[s][0], 1e-35f), e01 = fmaxf(pre[1] * el[s][1], 1e-35f);
                const float qi0 = qq[s][0] * e00, qi1 = qq[s][1] * e01;
                const float kd0 = kk[s][0] * __builtin_amdgcn_rcpf(e00), kd1 = kk[s][1] * __builtin_amdgcn_rcpf(e01);
                *(LAS unsigned*)(QX + tau * 136 + d0) = pk2(qi0, qi1);
                *(LAS unsigned*)(Q1 + tau * 136 + d0) = pk2(qi0 * RI[0], qi1 * RI[1]);
                if (I <= 0) *(LAS unsigned*)(KF + (0 + tau) * 136 + d0) = pk2(kd0 * fac[0][0], kd1 * fac[0][1]);
                if (I <= 1) *(LAS unsigned*)(KF + (16 + tau) * 136 + d0) = pk2(kd0 * fac[1][0], kd1 * fac[1][1]);
                if (I <= 2) *(LAS unsigned*)(KF + (48 + tau) * 136 + d0) = pk2(kd0 * fac[2][0], kd1 * fac[2][1]);
                *(LAS unsigned*)(KF + (96 + tau) * 136 + d0) = pk2(kd0 * fac[3][0], kd1 * fac[3][1]);
                const unsigned h0 = f2bf(kd0 * f4[0]), h1 = f2bf(kd1 * f4[1]);
                if (s & 1) { w0[s >> 1] |= h0 << 16; w1[s >> 1] |= h1 << 16; } else { w0[s >> 1] = h0; w1[s >> 1] = h1; }
                if ((s & 1) == 1) __builtin_amdgcn_sched_barrier(0);
            }
            *(LAS u32x4*)(K2 + (d0 + 0) * 72 + 8 * tg) = (u32x4){w0[0], w0[1], w0[2], w0[3]};
            *(LAS u32x4*)(K2 + (d0 + 1) * 72 + 8 * tg) = (u32x4){w1[0], w1[1], w1[2], w1[3]};
        }
        __syncthreads();
        if (step + 1 < NCHUNK) {
            const int nchunk = DIR == 0 ? step + 1 : (step + 1 < 4 ? 2 - step : 38 - step);
            const char* slab = (const char*)(p + ((size_t)b * LT + (size_t)nchunk * 64) * ODD_IN);
#pragma unroll
            for (int s = 0; s < 8; ++s) { zn[s] = *(const unsigned*)(slab + colz * 2 + G2_OFFZ(s)); qn[s] = *(const unsigned*)(slab + colq * 2 + G2_OFFZ(s)); }
#pragma unroll
            for (int rep = 0; rep < 2; ++rep) vn[rep] = *(const u32x4*)(slab + colv * 2 + G2_OFFV(rep));
        }
#pragma unroll 1
        for (int bi = wave; bi < 10; bi += 8) {
            const int Ib = bi < 1 ? 0 : (bi < 3 ? 1 : (bi < 6 ? 2 : 3)), Jb = bi - (Ib * (Ib + 1)) / 2;
            const int foff = Ib == 0 ? 0 : (Ib == 1 ? 16 : (Ib == 2 ? 48 : 96));
            f32x4 acc = {0.f, 0.f, 0.f, 0.f};
#pragma unroll
            for (int ks = 0; ks < 4; ++ks) {
                const bf16x8 a = *(const LAS bf16x8*)(QX + (16 * Ib + r) * 136 + 32 * ks + 8 * g);
                const bf16x8 bb = *(const LAS bf16x8*)(KF + (foff + 16 * Jb + r) * 136 + 32 * ks + 8 * g);
                acc = MFMA16(a, bb, acc);
            }
#pragma unroll
            for (int i = 0; i < 4; ++i) { float v = acc[i]; if (Jb == Ib && r > 4 * g + i) v = 0.f; AM[(16 * Ib + 4 * g + i) * 72 + 16 * Jb + r] = (bf16_t)f2bf(v); }
        }
        __syncthreads();
        {
            const int tt = wave >> 1, eb = 4 * (wave & 1);
            char* oslab = (char*)(p + Rc0 * ODD_IN + colz);
            bf16x8 aq[4], am[2];
#pragma unroll
            for (int ks = 0; ks < 4; ++ks) aq[ks] = *(const LAS bf16x8*)(Q1 + (16 * tt + r) * 136 + 32 * ks + 8 * g);
#pragma unroll
            for (int ks = 0; ks < 2; ++ks) am[ks] = *(const LAS bf16x8*)(AM + (16 * tt + r) * 72 + 32 * ks + 8 * g);
#pragma unroll
            for (int e4 = 0; e4 < 4; ++e4) {
                const int et = eb + e4;
                f32x4 acc = {0.f, 0.f, 0.f, 0.f};
#pragma unroll
                for (int ks = 0; ks < 4; ++ks) { const bf16x8 bb = *(const LAS bf16x8*)(ST + (16 * et + r) * 136 + 32 * ks + 8 * g); acc = MFMA16(aq[ks], bb, acc); }
#pragma unroll
                for (int ks = 0; ks < 2; ++ks) acc = MFMA16(am[ks], frag_tr(VS, 136, 32 * ks, 16 * et, lane), acc);
#pragma unroll
                for (int i = 0; i < 4; ++i) {
                    const int tau = 16 * tt + 4 * g + i;
                    const unsigned off = (unsigned)((DIR == 0 ? tau : 63 - tau) * ODD_IN + 16 * et + r) * 2u;
                    *(bf16_t*)(oslab + off) = (bf16_t)f2bf(acc[i]);
                }
                __builtin_amdgcn_sched_barrier(0);
            }
            float bl[4];
#pragma unroll
            for (int i = 0; i < 4; ++i) bl[i] = BLAST[16 * wave + 4 * g + i];
            bf16x8 ak[2];
#pragma unroll
            for (int ks = 0; ks < 2; ++ks) ak[ks] = *(const LAS bf16x8*)(K2 + (16 * wave + r) * 72 + 32 * ks + 8 * g);
#pragma unroll
            for (int et = 0; et < 8; ++et) {
#pragma unroll
                for (int i = 0; i < 4; ++i) st[et][i] *= bl[i];
#pragma unroll
                for (int ks = 0; ks < 2; ++ks) st[et] = MFMA16(ak[ks], frag_tr(VS, 136, 32 * ks, 16 * et, lane), st[et]);
                if (et & 1) __builtin_amdgcn_sched_barrier(0);
            }
        }
        __syncthreads();
#pragma unroll
        for (int et = 0; et < 8; ++et) { u32x2 w; w.x = pk2(st[et][0], st[et][1]); w.y = pk2(st[et][2], st[et][3]); *(LAS u32x2*)(ST + (16 * et + r) * 136 + 16 * wave + 4 * g) = w; }
    }
    __syncthreads();
}

DI void phase_readout(const Params& P, int layer_j, int wv) {
    const int tid = get_tid(wv), lane = tid & 63, wave = tid >> 6;
    const int gw = get_bid() * 8 + wave, NGW = gridDim.x * 8;
    bf16_t* p = (bf16_t*)(P.ws + WS_P);
    const float* gwt = P.od_gnorm_w + layer_j * 128 + (lane & 7) * 16;
    for (int R = gw; R < MROWS; R += NGW) {
        const bf16_t* op = p + (size_t)R * ODD_IN + 16 * lane; bf16_t* yp = p + (size_t)R * ODD_IN + 4096 + 16 * lane;
        const u32x4 o0 = *(const u32x4*)op, o1 = *(const u32x4*)(op + 8), c0 = *(const u32x4*)(op + 1024), c1 = *(const u32x4*)(op + 1032), g0 = *(const u32x4*)yp, g1 = *(const u32x4*)(yp + 8);
        float ov[16], gv[16];
        const unsigned* ow0 = (const unsigned*)&o0; const unsigned* ow1 = (const unsigned*)&o1; const unsigned* cw0 = (const unsigned*)&c0; const unsigned* cw1 = (const unsigned*)&c1;
        const unsigned* gw0 = (const unsigned*)&g0; const unsigned* gw1 = (const unsigned*)&g1;
#pragma unroll
        for (int i = 0; i < 4; ++i) {
            ov[2 * i] = __uint_as_float(ow0[i] << 16) + __uint_as_float(cw0[i] << 16); ov[2 * i + 1] = __uint_as_float(ow0[i] & 0xffff0000u) + __uint_as_float(cw0[i] & 0xffff0000u);
            ov[8 + 2 * i] = __uint_as_float(ow1[i] << 16) + __uint_as_float(cw1[i] << 16); ov[8 + 2 * i + 1] = __uint_as_float(ow1[i] & 0xffff0000u) + __uint_as_float(cw1[i] & 0xffff0000u);
            gv[2 * i] = __uint_as_float(gw0[i] << 16); gv[2 * i + 1] = __uint_as_float(gw0[i] & 0xffff0000u); gv[8 + 2 * i] = __uint_as_float(gw1[i] << 16); gv[8 + 2 * i + 1] = __uint_as_float(gw1[i] & 0xffff0000u);
        }
        float ss = 0.f;
#pragma unroll
        for (int i = 0; i < 16; ++i) ss += ov[i] * ov[i];
        ss += shfl_xor_f(ss, 1); ss += shfl_xor_f(ss, 2); ss += shfl_xor_f(ss, 4);
        const float rstd = rsqrtf(ss * (1.f / 128.f) + RMS_EPS);
        float y[16];
#pragma unroll
        for (int i = 0; i < 16; ++i) y[i] = ov[i] * rstd * gwt[i] * (gv[i] * sigm(gv[i]));
        u32x4 w0, w1;
        w0.x = pk2(y[0], y[1]); w0.y = pk2(y[2], y[3]); w0.z = pk2(y[4], y[5]); w0.w = pk2(y[6], y[7]);
        w1.x = pk2(y[8], y[9]); w1.y = pk2(y[10], y[11]); w1.z = pk2(y[12], y[13]); w1.w = pk2(y[14], y[15]);
        *(u32x4*)yp = w0; *(u32x4*)(yp + 8) = w1;
    }
}

DI void phase_final(const Params& P, int wv) {
    const int tid = get_tid(wv), lane = tid & 63, wave = tid >> 6;
    const int gw = get_bid() * 8 + wave, NGW = gridDim.x * 8;
    for (int R = gw; R < NB * SEQ; R += NGW) {
        float* row = P.out + (size_t)R * DM;
        f32x4 v[4]; float ss = 0.f;
#pragma unroll
        for (int q = 0; q < 4; ++q) { v[q] = *(const f32x4*)(row + 4 * lane + 256 * q); ss += (v[q][0] * v[q][0] + v[q][1] * v[q][1]) + (v[q][2] * v[q][2] + v[q][3] * v[q][3]); }
        const float rstd = rsqrtf(wave_sum(ss) * (1.f / DM) + RMS_EPS);
#pragma unroll
        for (int q = 0; q < 4; ++q) { const f32x4 w4 = *(const f32x4*)(P.final_norm_w + 4 * lane + 256 * q); *(f32x4*)(row + 4 * lane + 256 * q) = (v[q] * rstd) * w4; }
    }
}

#define XB_TMO      128
#define XB_XCNT(j)  (256  + 64 * (j))
#define XB_XSUB(j)  (1280 + 64 * (j))
#define XB_XGEN(j)  (2304 + 64 * (j))
#define XB_TOP      3328
#define XB_TOPGEN   3392
#define XCD_BAR_WORDS 3456
#define XB_SPIN_CAP (1u << 18)

__device__ __forceinline__ unsigned xb_ld(unsigned* p)              { return __hip_atomic_load(p, __ATOMIC_RELAXED, __HIP_MEMORY_SCOPE_AGENT); }
__device__ __forceinline__ unsigned xb_add(unsigned* p, unsigned v) { return __hip_atomic_fetch_add(p, v, __ATOMIC_RELAXED, __HIP_MEMORY_SCOPE_AGENT); }
__device__ __forceinline__ unsigned xb_xcc_id() { return (unsigned)__builtin_amdgcn_s_getreg((3 << 11) | 20) & 0xFu; }
#define XB_SPIN(cond, bar) do { unsigned _sp = 0; while (cond) { __builtin_amdgcn_s_sleep(1); \
    if ((++_sp & 255u) == 0u) { if (xb_ld(&(bar)[XB_TMO])) break; if (_sp > XB_SPIN_CAP) { atomicAdd(&(bar)[XB_TMO], 1u); break; } } } } while (0)

struct XcdBarrier {
    unsigned* bar; unsigned x;
    volatile LAS unsigned* st;
};

__device__ __forceinline__ XcdBarrier xcd_barrier_post(unsigned* bar, volatile LAS unsigned* st, int wv) {
    XcdBarrier b; b.bar = bar; b.x = xb_xcc_id(); b.st = st;
    if (get_tid(wv) == 0) (void)xb_add(&bar[XB_XCNT(b.x)], 1u);
    return b;
}
__device__ __forceinline__ void xcd_barrier_complete(unsigned* bar, unsigned x, unsigned& nloc, unsigned& nx) {
    const unsigned G = gridDim.x * gridDim.y * gridDim.z;
    unsigned sum, cnt, mine, sp = 0u;
    for (;;) {
        sum = 0u; cnt = 0u; mine = 0u;
#pragma unroll
        for (unsigned j = 0; j < 16; ++j) { const unsigned c = xb_ld(&bar[XB_XCNT(j)]); sum += c; cnt += (c > 0u) ? 1u : 0u; mine = (j == x) ? c : mine; }
        if (sum == G) break;
        __builtin_amdgcn_s_sleep(1);
        if ((++sp & 255u) == 0u) { if (xb_ld(&bar[XB_TMO])) break; if (sp > XB_SPIN_CAP) { atomicAdd(&bar[XB_TMO], 1u); break; } }
    }
    nloc = mine > 0u ? mine : 1u; nx = cnt > 0u ? cnt : 1u;
}

__device__ __forceinline__ void xcd_barrier(const XcdBarrier& b, int wv) {
    asm volatile("s_waitcnt vmcnt(0)" ::: "memory");
    __syncthreads();
    if (get_tid(wv) == 0) {
        unsigned* bar = b.bar;
        __builtin_amdgcn_s_waitcnt(0);
        unsigned nloc = b.st[0], nx = b.st[1];
        if (nloc == 0u) { xcd_barrier_complete(bar, b.x, nloc, nx); b.st[0] = nloc; b.st[1] = nx; }
        const unsigned old = xb_add(&bar[XB_XSUB(b.x)], 1u);
        const unsigned gen = old / nloc;
        if (old + 1u == (gen + 1u) * nloc) {
            __builtin_amdgcn_fence(__ATOMIC_RELEASE, "agent");
            asm volatile("s_waitcnt vmcnt(0)" ::: "memory");
            const unsigned og = xb_add(&bar[XB_TOP], 1u);
            const unsigned tg = og / nx;
            if (og + 1u == (tg + 1u) * nx) xb_add(&bar[XB_TOPGEN], 1u);
            else XB_SPIN(xb_ld(&bar[XB_TOPGEN]) == tg, bar);
            __builtin_amdgcn_fence(__ATOMIC_ACQUIRE, "agent");
            xb_add(&bar[XB_XGEN(b.x)], 1u);
            asm volatile("s_waitcnt vmcnt(0)" ::: "memory");
        } else {
            XB_SPIN(xb_ld(&bar[XB_XGEN(b.x)]) == gen, bar);
            __builtin_amdgcn_fence(__ATOMIC_ACQUIRE, "agent");
            asm volatile("s_waitcnt vmcnt(0)" ::: "memory");
        }
    }
    __syncthreads();
}

constexpr int PARAM_OFF = LDS_BYTES - 256;
static_assert(G2_END <= PARAM_OFF && sizeof(Params) <= 208, "LDS map");
DI const float* ld_uptr(const LAS unsigned long long* s, int i) {
    const unsigned long long v = s[i];
    const unsigned lo = __builtin_amdgcn_readfirstlane((unsigned)v), hi = __builtin_amdgcn_readfirstlane((unsigned)(v >> 32));
    return (const float*)(const __attribute__((address_space(1))) float*)(((unsigned long long)hi << 32) | lo);
}
DI Params load_params(LAS unsigned char* lds) {
    LAS unsigned char* pb = lds + PARAM_OFF; asm volatile("" : "+v"(pb));
    const LAS unsigned long long* s = (const LAS unsigned long long*)pb;
    Params Q;
    Q.x = ld_uptr(s, 0); Q.c = ld_uptr(s, 1); Q.ctx = ld_uptr(s, 2); Q.c_ctx = ld_uptr(s, 3); Q.ada_w = ld_uptr(s, 4); Q.ada_b = ld_uptr(s, 5); Q.norm_w = ld_uptr(s, 6);
    Q.ev_w_in = ld_uptr(s, 7); Q.ev_conv_w = ld_uptr(s, 8); Q.ev_conv_b = ld_uptr(s, 9); Q.ev_rg_wx = ld_uptr(s, 10); Q.ev_rg_bx = ld_uptr(s, 11); Q.ev_rg_wa = ld_uptr(s, 12);
    Q.ev_rg_ba = ld_uptr(s, 13); Q.ev_rg_lambda = ld_uptr(s, 14); Q.ev_sink = ld_uptr(s, 15); Q.ev_w_out = ld_uptr(s, 16); Q.od_w_in = ld_uptr(s, 17); Q.od_lb_raw = ld_uptr(s, 18);
    Q.od_gnorm_w = ld_uptr(s, 19); Q.od_w_out = ld_uptr(s, 20); Q.final_norm_w = ld_uptr(s, 21); Q.out = (float*)ld_uptr(s, 22); Q.ws = (unsigned char*)ld_uptr(s, 23);
    Q.ph_lo = 0; Q.ph_hi = 0;
    return Q;
}
DI void run_phase(LAS unsigned char* lds, int ph, int wv) {
    #ifndef PHMASK
#define PHMASK 0xffff
#endif
    if (ph == 0) { if (PHMASK & 1) { const Params P = load_params(lds); phase_pro(P, lds, wv); } return; }
    if (ph == NPHASE - 1) { if (PHMASK & 2) { const Params P = load_params(lds); phase_final(P, wv); } return; }
    const int layer = (ph - 1) / 5, sub = (ph - 1) % 5, j = layer >> 1;
    const bool even = (layer & 1) == 0;
    if (sub == 0) { if (PHMASK & 4) { const Params P = load_params(lds); phase_norm(P, lds, layer, wv); } return; }
    if (sub == 1) {
        const Params P = load_params(lds); bf16_t* pbuf = (bf16_t*)(P.ws + WS_P);
        const int N = even ? EVEN_IN : ODD_IN;
        pg8::Gemm gm{(const bf16_t*)(P.ws + WS_OV), (const bf16_t*)(P.ws + WS_WIN), MROWS, N, 1024, 1024};
        pg8::StaticOrder S; S.init(MROWS, N, (int)gridDim.x, get_bid());
        EpiStoreBf16 E{pbuf, N};
        if (PHMASK & 8) pg8::gemm_phase<EpiStoreBf16, pg8::StaticOrder, true, true>(lds, gm, S, E, wv);
        return;
    }
    if (sub == 2) {
        const Params P = load_params(lds);
        if (even) {
            constexpr int NRG = NB * NCHUNK * 8;
#if defined(SPLIT_ATTN)
            for (int it = get_bid(); it < NRG; it += gridDim.x) rglru_item(P, lds, j, it, wv);
#else
            for (int it = get_bid(); it < NRG + 576; it += gridDim.x) {
                if (it < NRG) { if (PHMASK & 32) rglru_item(P, lds, j, it, wv); } else { if (PHMASK & 16) attn_item(P, lds, j, it - NRG, wv); }
            }
#endif
        } else {
            for (int it = get_bid(); it < 128; it += gridDim.x) { if (PHMASK & 64) { if (it & 1) gla2_item<1>(P, lds, j, it >> 4, (it >> 1) & 7, wv); else gla2_item<0>(P, lds, j, it >> 4, (it >> 1) & 7, wv); } }
        }
        return;
    }
    if (sub == 3) {
        const Params P = load_params(lds);
        if (!even) { if (PHMASK & 256) phase_readout(P, j, wv); }
#if defined(SPLIT_ATTN)
        else { for (int it = get_bid(); it < 576; it += gridDim.x) attn_item(P, lds, j, it, wv); }
#endif
        return;
    }
    {
        const Params P = load_params(lds); bf16_t* pbuf = (bf16_t*)(P.ws + WS_P);
        const int K = even ? 2048 : 1024, lda = even ? EVEN_IN : ODD_IN;
        pg8::Gemm gm{pbuf + (even ? 1536 : 4096), (const bf16_t*)(P.ws + WS_WOUT), MROWS, 1024, K, lda};
        pg8::StaticOrder S; S.init(MROWS, 1024, (int)gridDim.x, get_bid());
        const float* hl = layer == 0 ? P.x : P.out; const float* hc = layer == 0 ? P.ctx : (const float*)(P.ws + WS_HCTX);
        EpiResid E{hl, hc, P.out, (float*)(P.ws + WS_HCTX), (const float*)(P.ws + WS_MOD) + (size_t)layer * 9 * 3072 + 2048};
        if (PHMASK & 512) pg8::gemm_phase<EpiResid, pg8::StaticOrder, true, true>(lds, gm, S, E, wv);
    }
}

__global__ void __launch_bounds__(512, 2) mega(Params P) {
    extern __shared__ __attribute__((aligned(16))) unsigned char lds_raw[];
    LAS unsigned char* lds = (LAS unsigned char*)lds_raw;
    cg::grid_group grid = cg::this_grid();
    const int wv = __builtin_amdgcn_readfirstlane((int)(threadIdx.x >> 6));
    if (get_tid(wv) == 0) {
        ((LAS unsigned*)(lds + PARAM_OFF + 208))[0] = 0u; ((LAS unsigned*)(lds + PARAM_OFF + 208))[1] = 0u;
        LAS unsigned long long* d = (LAS unsigned long long*)(lds + PARAM_OFF);
        d[0] = (unsigned long long)P.x; d[1] = (unsigned long long)P.c; d[2] = (unsigned long long)P.ctx; d[3] = (unsigned long long)P.c_ctx; d[4] = (unsigned long long)P.ada_w;
        d[5] = (unsigned long long)P.ada_b; d[6] = (unsigned long long)P.norm_w; d[7] = (unsigned long long)P.ev_w_in; d[8] = (unsigned long long)P.ev_conv_w; d[9] = (unsigned long long)P.ev_conv_b;
        d[10] = (unsigned long long)P.ev_rg_wx; d[11] = (unsigned long long)P.ev_rg_bx; d[12] = (unsigned long long)P.ev_rg_wa; d[13] = (unsigned long long)P.ev_rg_ba; d[14] = (unsigned long long)P.ev_rg_lambda;
        d[15] = (unsigned long long)P.ev_sink; d[16] = (unsigned long long)P.ev_w_out; d[17] = (unsigned long long)P.od_w_in; d[18] = (unsigned long long)P.od_lb_raw; d[19] = (unsigned long long)P.od_gnorm_w;
        d[20] = (unsigned long long)P.od_w_out; d[21] = (unsigned long long)P.final_norm_w; d[22] = (unsigned long long)P.out; d[23] = (unsigned long long)P.ws;
    }
    __syncthreads();
    const int ph_lo = P.ph_lo, ph_hi = P.ph_hi;
    (void)xcd_barrier_post((unsigned*)(P.ws + WS_CTL) + 4096, (volatile LAS unsigned*)(lds + PARAM_OFF + 208), wv);
#define GRID_SYNC(first) do { if (first) grid.sync(); else { XcdBarrier xb_; xb_.bar = (unsigned*)(load_params(lds).ws + WS_CTL) + 4096; xb_.x = xb_xcc_id(); xb_.st = (volatile LAS unsigned*)(lds + PARAM_OFF + 208); xcd_barrier(xb_, wv); } } while (0)
#if defined(PROBE_S)
    constexpr int PREP = PROBE_E - PROBE_S + 1;
#pragma unroll 1
    for (int seq = ph_lo; seq < ph_hi + PREP; ++seq) {
        if (seq > ph_lo) GRID_SYNC(seq == ph_lo + 1);
        const int ph = seq <= PROBE_E ? seq : seq - PREP;
        run_phase(lds, ph, wv);
    }
#else
#pragma unroll 1
    for (int ph = ph_lo; ph < ph_hi; ++ph) {
#if !defined(SPLIT_ATTN)
        if (ph >= 1 && ph < NPHASE - 1 && (ph - 1) % 5 == 3 && (((ph - 1) / 5) & 1) == 0) continue;
#endif
        if (ph > ph_lo) GRID_SYNC(ph == ph_lo + 1);
        run_phase(lds, ph, wv);
    }
#endif
}

extern "C" void kernel_launch(void* const* d_in, const int* in_sizes, int n_in, void* d_out, int out_size, void* d_ws, size_t ws_size, hipStream_t stream) {
    static int grid = 0;
    if (grid == 0) {
        if (n_in != 22 || ws_size < WS_END) { fprintf(stderr, "kernel_launch: unexpected inputs (n_in %d, ws %zu)\n", n_in, ws_size); grid = -1; return; }
        int dev = 0, cus = 0, per_cu = 0;
        hipGetDevice(&dev);
        hipDeviceGetAttribute(&cus, hipDeviceAttributeMultiprocessorCount, dev);
        if (hipFuncSetAttribute((const void*)mega, hipFuncAttributeMaxDynamicSharedMemorySize, LDS_BYTES) != hipSuccess) { fprintf(stderr, "kernel_launch: hipFuncSetAttribute failed\n"); grid = -1; return; }
        if (hipOccupancyMaxActiveBlocksPerMultiprocessor(&per_cu, (const void*)mega, 512, LDS_BYTES) != hipSuccess || per_cu < 1) { fprintf(stderr, "kernel_launch: occupancy query gives %d\n", per_cu); per_cu = 1; }
        (void)hipGetLastError();
        grid = cus;
    }
    if (grid < 0) return;
    if (hipMemsetAsync((char*)d_ws + WS_CTL, 0, 65536, stream) != hipSuccess) { fprintf(stderr, "kernel_launch: memset failed\n"); return; }
    Params P{};
    const float** pp = (const float**)&P;
    for (int i = 0; i < 22; ++i) pp[i] = (const float*)d_in[i];
    P.out = (float*)d_out; P.ws = (unsigned char*)d_ws;
#if ONE_LAUNCH
    P.ph_lo = 0; P.ph_hi = NPHASE;
    { void* args[] = {&P}; hipError_t e = hipLaunchCooperativeKernel((const void*)mega, dim3(grid), dim3(512), args, LDS_BYTES, stream);
      if (e != hipSuccess) fprintf(stderr, "cooperative launch failed: %s (grid %d)\n", hipGetErrorString(e), grid); }
#else
    for (int ph = 0; ph < NPHASE; ++ph) {
        P.ph_lo = ph; P.ph_hi = ph + 1;
        void* args[] = {&P}; hipError_t e = hipLaunchCooperativeKernel((const void*)mega, dim3(grid), dim3(512), args, LDS_BYTES, stream);
        if (e != hipSuccess) { fprintf(stderr, "launch %d failed: %s (grid %d)\n", ph, hipGetErrorString(e), grid); break; }
    }
#endif
}
```

```cpp
#include <hip/hip_runtime.h>
#include <hip/hip_cooperative_groups.h>
#include <cstdio>
#include <cstdint>
namespace cg = cooperative_groups;

#ifndef ONE_LAUNCH
#define ONE_LAUNCH 1
#endif

#define DI __device__ __forceinline__
#define LAS __attribute__((address_space(3)))
__device__ __forceinline__ int lane_nh() { int l; asm volatile("v_mbcnt_lo_u32_b32 %0, -1, 0\n\tv_mbcnt_hi_u32_b32 %0, -1, %0" : "=v"(l)); return l; }
__device__ __forceinline__ int get_tid(int wv) { asm volatile("" : "+s"(wv)); return wv * 64 + lane_nh(); }
__device__ __forceinline__ float shfl_xor_f(float v, int o) { return __int_as_float(__builtin_amdgcn_ds_bpermute((lane_nh() ^ o) << 2, __float_as_int(v))); }
__device__ __forceinline__ int get_bid() { int b = blockIdx.x; asm volatile("" : "+s"(b)); return b; }

#if defined(TP_ID)
#ifndef TP_BLOCK
#define TP_BLOCK 5
#endif
#ifndef TP_AMP
#define TP_AMP 16
#endif
#define TP_START(id, lds, tid_) do { if ((id) == TP_ID && (tid_) == 0 && blockIdx.x == TP_BLOCK) { ((LAS unsigned long long*)((lds) + 163840 - 32))[0] = __builtin_amdgcn_s_memrealtime(); } } while (0)
#define TP_STOP(id, lds, tid_) do { if ((id) == TP_ID && (tid_) == 0 && blockIdx.x == TP_BLOCK) { LAS unsigned long long* w_ = (LAS unsigned long long*)((lds) + 163840 - 32); w_[1] += __builtin_amdgcn_s_memrealtime() - w_[0]; } } while (0)
#else
#define TP_START(id, lds, tid_) do { } while (0)
#define TP_STOP(id, lds, tid_) do { } while (0)
#endif
namespace pg8 {
#define PG8_LAS __attribute__((address_space(3)))
typedef unsigned short bf16_t;
typedef short bf16x8 __attribute__((ext_vector_type(8)));
typedef float f32x4 __attribute__((ext_vector_type(4)));
typedef unsigned u32x4 __attribute__((ext_vector_type(4)));
constexpr int BM = 256, BK = 64, HALF = 128, HTB = HALF * BK * 2  , STAGE_BYTES = 8 * HTB, NXCD = 8, WGM = 8;

__host__ __device__ __forceinline__ int lds_byte(int r, int c) { const int st = (r >> 4) * 2 + (c >> 5), rr = r & 15, cc = c & 31, ob = rr * 64 + cc * 2; return st * 1024 + (ob ^ (((ob >> 9) & 1) << 5)); }
__host__ __device__ __forceinline__ void stage_rc(int b, int& R, int& C) { const int st = b / 1024, sb = b % 1024, swz = sb ^ (((sb >> 9) & 1) << 5); R = (st >> 1) * 16 + swz / 64; C = (st & 1) * 32 + (swz % 64) / 2; }
__host__ __device__ __forceinline__ int perm32(int rho) { const int n = rho >> 4, i = rho & 15; return 8 * (i >> 2) + 4 * n + (i & 3); }

struct Unit { int pm, pn; };
struct Gemm { const bf16_t* A; const bf16_t* Bt; int M, N, K, lda; };

struct StaticOrder {
    int nM, nN, nwg, G, c;
    __host__ __device__ void init(int M, int N, int G_, int c_) { nM = M / BM; nN = N / BM; nwg = nM * nN; G = G_; c = c_; }
    __host__ __device__ bool next(int i, Unit& u) const {
        const long L = (long)i * G + c; if (L >= nwg) return false;
        int wgid = (int)L; { const int q = nwg / NXCD, r = nwg % NXCD, xcd = wgid % NXCD, off = wgid / NXCD; wgid = (xcd < r ? xcd * (q + 1) : r * (q + 1) + (xcd - r) * q) + off; }
        const int nig = WGM * nN, gid = wgid / nig, fm = gid * WGM, gsz = (nM - fm) < WGM ? (nM - fm) : WGM;
        u.pm = fm + ((wgid % nig) % gsz); u.pn = (wgid % nig) / gsz; return true;
    }
    __device__ __forceinline__ void a_ready(const Unit&) const {}
    __device__ __forceinline__ void done(const Unit&) const {}
};

template <class Epi, class Sched, bool ALIGN_EPI = false, bool SP2 = false>
__device__ __forceinline__ void gemm_phase(PG8_LAS unsigned char* lds, const Gemm g, const Sched& S, const Epi& E, int wv) {
    const int tid = get_tid(wv), wid = __builtin_amdgcn_readfirstlane(tid >> 6), lane = tid & 63, wr = wid >> 2, wc = wid & 3, fr = lane & 15, fq = lane >> 4;
    const int K = g.K, nt = K / BK;
    unsigned voffA[2], voffB[2];
#pragma unroll
    for (int i = 0; i < 2; ++i) { int R, C; stage_rc(tid * 16 + i * 8192, R, C); const int Rb = Epi::PERM ? ((R & ~31) + perm32(R & 31)) : R;
        voffA[i] = (unsigned)(R * g.lda + C) * 2u; voffB[i] = (unsigned)(Rb * K + C) * 2u; }
    const size_t kstep = (size_t)(BK * 2);
    const size_t hstepA = (size_t)HALF * g.lda * 2, hstepB = (size_t)HALF * K * 2;
    const size_t tstepA = 2 * hstepA, tstepB = 2 * hstepB;
    const unsigned ldsw = (unsigned)wid * 1024u;
    const int aoff = lds_byte(wr * 64 + fr, fq * 8), boff = lds_byte(wc * 32 + fr, fq * 8);
#define PG8_SA(b, h) (((b) * 2 + (h)) * HTB)
#define PG8_SB(b, h) ((4 + (b) * 2 + (h)) * HTB)
#define PG8_STAGE(bufoff, gbase, voff) do { _Pragma("unroll") for (int _i = 0; _i < 2; ++_i) \
        __builtin_amdgcn_global_load_lds((const unsigned*)((const char*)(gbase) + (voff)[_i]), (PG8_LAS unsigned*)(lds + (bufoff) + ldsw + _i * 8192), 16, 0, 0); } while (0)
#define PG8_LDA(dst, b, h) do { _Pragma("unroll") for (int m = 0; m < 4; ++m) _Pragma("unroll") for (int k = 0; k < 2; ++k) dst[m][k] = *(const PG8_LAS bf16x8*)(lds + PG8_SA(b, h) + aoff + m * 2048 + k * 1024); } while (0)
#define PG8_LDB(dst, b, h) do { _Pragma("unroll") for (int n = 0; n < 2; ++n) _Pragma("unroll") for (int k = 0; k < 2; ++k) dst[n][k] = *(const PG8_LAS bf16x8*)(lds + PG8_SB(b, h) + boff + n * 2048 + k * 1024); } while (0)
#define PG8_MMA(ai, bj, At, Bt) do { __builtin_amdgcn_s_setprio(1); _Pragma("unroll") for (int m = 0; m < 4; ++m) _Pragma("unroll") for (int n = 0; n < 2; ++n) _Pragma("unroll") for (int k = 0; k < 2; ++k) \
        acc[ai][bj][m][n] = __builtin_amdgcn_mfma_f32_16x16x32_bf16(Bt[n][k], At[m][k], acc[ai][bj][m][n], 0, 0, 0); __builtin_amdgcn_s_setprio(0); } while (0)
#define PG8_WAIT_V(n) asm volatile("s_waitcnt vmcnt(" #n ")" ::: "memory")
#define PG8_WAIT_L(n) asm volatile("s_waitcnt lgkmcnt(" #n ")" ::: "memory")
#define PG8_BAR __builtin_amdgcn_s_barrier()
#define PG8_SCHED __builtin_amdgcn_sched_barrier(0)
    Unit cur, nxt; int ui = 0;
    if (!S.next(0, cur)) return;
    f32x4 acc[2][2][4][2];
#pragma unroll
    for (int a = 0; a < 2; ++a)
#pragma unroll
        for (int b = 0; b < 2; ++b)
#pragma unroll
            for (int m = 0; m < 4; ++m)
#pragma unroll
                for (int n = 0; n < 2; ++n) acc[a][b][m][n] = (f32x4){0.f, 0.f, 0.f, 0.f};
    bf16x8 At[4][2], B0[2][2], B1[2][2];
    const char* cA = (const char*)g.A + (size_t)cur.pm * tstepA; const char* cB = (const char*)g.Bt + (size_t)cur.pn * tstepB;
    S.a_ready(cur);
    if constexpr (SP2) {
        PG8_STAGE(PG8_SB(0, 0), cB, voffB); PG8_STAGE(PG8_SB(0, 1), cB + hstepB, voffB); PG8_STAGE(PG8_SA(0, 0), cA, voffA); PG8_STAGE(PG8_SA(0, 1), cA + hstepA, voffA);
        if (wr == 1) PG8_BAR;
        PG8_WAIT_V(2); PG8_BAR;
        PG8_STAGE(PG8_SB(1, 0), cB + kstep, voffB); PG8_STAGE(PG8_SA(1, 0), cA + kstep, voffA); PG8_STAGE(PG8_SB(1, 1), cB + hstepB + kstep, voffB);
        PG8_WAIT_V(6); PG8_BAR;
    } else {
        PG8_STAGE(PG8_SB(0, 0), cB, voffB); PG8_STAGE(PG8_SA(0, 0), cA, voffA); PG8_STAGE(PG8_SB(0, 1), cB + hstepB, voffB); PG8_STAGE(PG8_SA(0, 1), cA + hstepA, voffA);
        if (wr == 1) PG8_BAR;
        PG8_WAIT_V(4); PG8_BAR;
        PG8_STAGE(PG8_SB(1, 0), cB + kstep, voffB); PG8_STAGE(PG8_SA(1, 0), cA + kstep, voffA); PG8_STAGE(PG8_SB(1, 1), cB + hstepB + kstep, voffB);
        PG8_WAIT_V(6); PG8_BAR;
    }
    for (;;) {
        const bool has_next = S.next(ui + 1, nxt);
        const char* nA = has_next ? (const char*)g.A + (size_t)nxt.pm * tstepA : cA; const char* nB = has_next ? (const char*)g.Bt + (size_t)nxt.pn * tstepB : cB;
        for (int t = 0; t < nt; t += 2) {
            const bool last = (t == nt - 2);
            const char* a1 = cA + (size_t)(t + 1) * kstep;
            const char* a2 = last ? nA : cA + (size_t)(t + 2) * kstep; const char* b2 = last ? nB : cB + (size_t)(t + 2) * kstep;
            const char* a3 = a2 + kstep; const char* b3 = b2 + kstep;
            if (last && has_next) S.a_ready(nxt);
            if constexpr (SP2) {
            PG8_LDB(B0, 0, 0); PG8_LDB(B1, 0, 1); PG8_SCHED; PG8_LDA(At, 0, 0); PG8_STAGE(PG8_SA(1, 1), a1 + hstepA, voffA);
            PG8_WAIT_V(8); PG8_WAIT_L(0); PG8_BAR; PG8_MMA(0, 0, At, B0); PG8_MMA(0, 1, At, B1); PG8_BAR; PG8_SCHED;
            PG8_LDA(At, 0, 1); PG8_STAGE(PG8_SB(0, 0), b2, voffB); PG8_STAGE(PG8_SB(0, 1), b2 + hstepB, voffB); PG8_STAGE(PG8_SA(0, 0), a2, voffA);
            PG8_WAIT_V(8); PG8_WAIT_L(0); PG8_BAR; PG8_MMA(1, 0, At, B0); PG8_MMA(1, 1, At, B1); PG8_BAR; PG8_SCHED;
            PG8_LDB(B0, 1, 0); PG8_LDB(B1, 1, 1); PG8_SCHED; PG8_LDA(At, 1, 0); PG8_STAGE(PG8_SA(0, 1), a2 + hstepA, voffA);
            PG8_WAIT_V(8); PG8_WAIT_L(0); PG8_BAR; PG8_MMA(0, 0, At, B0); PG8_MMA(0, 1, At, B1); PG8_BAR; PG8_SCHED;
            PG8_LDA(At, 1, 1); PG8_STAGE(PG8_SB(1, 0), b3, voffB); PG8_STAGE(PG8_SB(1, 1), b3 + hstepB, voffB); PG8_STAGE(PG8_SA(1, 0), a3, voffA);
            PG8_WAIT_V(8); PG8_WAIT_L(0); PG8_BAR; PG8_MMA(1, 0, At, B0); PG8_MMA(1, 1, At, B1); PG8_BAR; PG8_SCHED;
            } else {
            PG8_LDB(B0, 0, 0); PG8_SCHED; PG8_LDA(At, 0, 0); PG8_STAGE(PG8_SA(1, 1), a1 + hstepA, voffA);
            PG8_WAIT_L(8); PG8_BAR; PG8_WAIT_L(0); PG8_MMA(0, 0, At, B0); PG8_BAR; PG8_SCHED;
            PG8_LDB(B1, 0, 1); PG8_STAGE(PG8_SB(0, 0), b2, voffB);
            PG8_BAR; PG8_WAIT_L(0); PG8_MMA(0, 1, At, B1); PG8_BAR;
            PG8_LDA(At, 0, 1); PG8_STAGE(PG8_SA(0, 0), a2, voffA);
            PG8_BAR; PG8_WAIT_L(0); PG8_MMA(1, 0, At, B0); PG8_BAR; PG8_SCHED;
            PG8_STAGE(PG8_SB(0, 1), b2 + hstepB, voffB);
            PG8_WAIT_V(6); PG8_BAR; PG8_MMA(1, 1, At, B1); PG8_BAR;
            PG8_LDB(B0, 1, 0); PG8_SCHED; PG8_LDA(At, 1, 0); PG8_STAGE(PG8_SA(0, 1), a2 + hstepA, voffA);
            PG8_WAIT_L(8); PG8_BAR; PG8_WAIT_L(0); PG8_MMA(0, 0, At, B0); PG8_BAR; PG8_SCHED;
            PG8_LDB(B1, 1, 1); PG8_STAGE(PG8_SB(1, 0), b3, voffB);
            PG8_BAR; PG8_WAIT_L(0); PG8_MMA(0, 1, At, B1); PG8_BAR;
            PG8_LDA(At, 1, 1); PG8_STAGE(PG8_SA(1, 0), a3, voffA);
            PG8_BAR; PG8_WAIT_L(0); PG8_MMA(1, 0, At, B0); PG8_BAR; PG8_SCHED;
            PG8_STAGE(PG8_SB(1, 1), b3 + hstepB, voffB);
            PG8_WAIT_V(6); PG8_BAR; PG8_MMA(1, 1, At, B1); PG8_BAR;
            }
        }
        if constexpr (ALIGN_EPI) { if (wr == 0) PG8_BAR; }
        if constexpr (!Epi::AFTER_DRAIN) { E(acc, cur, wr, wc, fr, fq); S.done(cur); }
        if (!has_next) break;
#pragma unroll
        for (int a = 0; a < 2; ++a)
#pragma unroll
            for (int b = 0; b < 2; ++b)
#pragma unroll
                for (int m = 0; m < 4; ++m)
#pragma unroll
                    for (int n = 0; n < 2; ++n) acc[a][b][m][n] = (f32x4){0.f, 0.f, 0.f, 0.f};
        cur = nxt; cA = nA; cB = nB; ++ui;
        if constexpr (ALIGN_EPI) { if (wr == 1) PG8_BAR; }
    }
    PG8_WAIT_V(0);
    if constexpr (!ALIGN_EPI) { if (wr == 0) PG8_BAR; }
    PG8_BAR;
    if constexpr (Epi::AFTER_DRAIN) { E.fused(acc, cur, wr, wc, fr, fq, lds, wid, lane); S.done(cur); }
#undef PG8_SA
#undef PG8_SB
#undef PG8_STAGE
#undef PG8_LDA
#undef PG8_LDB
#undef PG8_MMA
#undef PG8_WAIT_V
#undef PG8_WAIT_L
#undef PG8_BAR
#undef PG8_SCHED
}
}

typedef unsigned short bf16_t;
typedef short bf16x8 __attribute__((ext_vector_type(8)));
typedef short s16x4 __attribute__((ext_vector_type(4)));
typedef float f32x4 __attribute__((ext_vector_type(4)));
typedef float f32x16 __attribute__((ext_vector_type(16)));
typedef unsigned u32x4 __attribute__((ext_vector_type(4)));
typedef unsigned u32x2 __attribute__((ext_vector_type(2)));
typedef float f32x2 __attribute__((ext_vector_type(2)));

constexpr int DM = 1024, NB = 8, SEQ = 2048, CTXL = 256, LT = SEQ + CTXL  , MROWS = NB * LT  ;
constexpr int EVEN_IN = 4608, ODD_IN = 5120, NCHUNK = LT / 64  ;
constexpr float RMS_EPS = 1e-6f, LOG2E = 1.4426950408889634f;
constexpr int LDS_BYTES = 160 * 1024;
constexpr int NPHASE = 22;

constexpr size_t WS_CTL = 0;
constexpr size_t WS_MOD = 65536;
constexpr size_t WS_ROPE = 524288;
constexpr size_t WS_AGG = 1048576;
constexpr size_t WS_HCTX = WS_AGG + 4718592;
constexpr size_t WS_WIN = WS_HCTX + 8388608;
constexpr size_t WS_WOUT = WS_WIN + 10485760;
constexpr size_t WS_WRG = WS_WOUT + 4194304;
constexpr size_t WS_OV = WS_WRG + 1048576;
constexpr size_t WS_P = WS_OV + 37748736;
constexpr size_t WS_END = WS_P + 188743680;
static_assert(WS_END <= 268435456, "workspace map exceeds 256 MiB");

struct Params {
    const float *x, *c, *ctx, *c_ctx, *ada_w, *ada_b, *norm_w, *ev_w_in, *ev_conv_w, *ev_conv_b, *ev_rg_wx, *ev_rg_bx, *ev_rg_wa, *ev_rg_ba,
        *ev_rg_lambda, *ev_sink, *ev_w_out, *od_w_in, *od_lb_raw, *od_gnorm_w, *od_w_out, *final_norm_w;
    float* out; unsigned char* ws; int ph_lo, ph_hi;
};

DI float bf2f(unsigned short v) { return __uint_as_float((unsigned)v << 16); }
DI unsigned f2bf(float f) { unsigned u = __float_as_uint(f); return (u + 0x7fffu + ((u >> 16) & 1u)) >> 16; }
typedef __bf16 bf16x2_hw __attribute__((ext_vector_type(2)));
DI unsigned pk2(float lo, float hi) { const f32x2 v = {lo, hi}; return __builtin_bit_cast(unsigned, __builtin_convertvector(v, bf16x2_hw)); }
DI float sigm(float x) { return __builtin_amdgcn_rcpf(1.f + __expf(-x)); }
DI float softplus_neg(float lam) {
    const float e = __expf(-lam);
    return e < 0.06f ? e * (1.f + e * (-0.5f + e * (0.33333333f + e * (-0.25f + e * 0.2f)))) : __logf(1.f + e);
}
DI float neg_expm1(float x) {
    return x > -0.25f ? -x * (1.f + x * (0.5f + x * (0.16666667f + x * (0.041666668f + x * (0.0083333338f + x * 0.0013888889f))))) : 1.f - __expf(x);
}
DI float wave_sum(float v) {
#pragma unroll
    for (int o = 1; o < 64; o <<= 1) v += shfl_xor_f(v, o);
    return v;
}
DI int crow(int reg, int h) { return (reg & 3) + 8 * (reg >> 2) + 4 * h; }
#define MFMA16(a, b, c) __builtin_amdgcn_mfma_f32_16x16x32_bf16((a), (b), (c), 0, 0, 0)
#define MFMA32(a, b, c) __builtin_amdgcn_mfma_f32_32x32x16_bf16((a), (b), (c), 0, 0, 0)

struct EpiStoreBf16 {
    static constexpr bool PERM = true, AFTER_DRAIN = false;
    bf16_t* O; int ldc;
    DI void operator()(const f32x4 (&acc)[2][2][4][2], const pg8::Unit& u, int wr, int wc, int fr, int fq) const {
        const int row0 = u.pm * 256 + wr * 64 + fr, col0 = u.pn * 256 + wc * 32 + 8 * fq;
#pragma unroll
        for (int ai = 0; ai < 2; ++ai)
#pragma unroll
            for (int m = 0; m < 4; ++m) { bf16_t* rowp = O + (size_t)(row0 + ai * 128 + m * 16) * ldc + col0;
#pragma unroll
                for (int bj = 0; bj < 2; ++bj) { const f32x4 v0 = acc[ai][bj][m][0], v1 = acc[ai][bj][m][1];
                    u32x4 w; w.x = pk2(v0[0], v0[1]); w.y = pk2(v0[2], v0[3]); w.z = pk2(v1[0], v1[1]); w.w = pk2(v1[2], v1[3]);
                    *(u32x4*)(rowp + bj * 128) = w; } }
    }
};
struct EpiResid {
    static constexpr bool PERM = false, AFTER_DRAIN = false;
    const float* in_lat; const float* in_ctx; float* out_lat; float* out_ctx; const float* gate;
    DI void operator()(const f32x4 (&acc)[2][2][4][2], const pg8::Unit& u, int wr, int wc, int fr, int fq) const {
        const int b = u.pm / 9, jt = u.pm % 9;
        const float* ib; float* ob; const float* g;
        if (jt == 0) { const size_t off = (size_t)b * CTXL * DM; ib = in_ctx + off; ob = out_ctx + off; g = gate + 8 * 3072; }
        else { const size_t off = ((size_t)b * SEQ + (size_t)(jt - 1) * 256) * DM; ib = in_lat + off; ob = out_lat + off; g = gate + b * 3072; }
        const int col0 = u.pn * 256 + wc * 32 + 4 * fq;
#pragma unroll
        for (int bj = 0; bj < 2; ++bj)
#pragma unroll
            for (int n = 0; n < 2; ++n) {
                const f32x4 gvv = *(const f32x4*)(g + col0 + bj * 128 + n * 16);
#pragma unroll
                for (int ai = 0; ai < 2; ++ai) {
#pragma unroll
                    for (int m = 0; m < 4; ++m) { const int r = ai * 128 + wr * 64 + m * 16 + fr;
                        const size_t off = (size_t)r * DM + col0 + bj * 128 + n * 16;
                        const f32x4 o = *(const f32x4*)(ib + off) + gvv * acc[ai][bj][m][n]; *(f32x4*)(ob + off) = o; }
                    asm volatile("" ::: "memory");
                }
            }
    }
};

DI void phase_pro(const Params& P, LAS unsigned char* lds, int wv) {
    const int tid = get_tid(wv);
    LAS float* s = (LAS float*)lds;
    LAS float* red = (LAS float*)(lds + 36864);
    float* mod = (float*)(P.ws + WS_MOD);
    for (int i = tid; i < 9 * 1024; i += 512) { const int r = i >> 10, k = i & 1023; const float v = r < 8 ? P.c[r * 1024 + k] : P.c_ctx[k]; s[i] = v * sigm(v); }
    __syncthreads();
    for (int item = get_bid(); item < 384; item += gridDim.x) {
        const int l = item / 96, n0 = (item % 96) * 32, ks = tid >> 5, col = tid & 31;
        const float* w = P.ada_w + (size_t)l * 1024 * 3072 + n0 + col;
        float acc[9];
#pragma unroll
        for (int r = 0; r < 9; ++r) acc[r] = 0.f;
#pragma unroll 8
        for (int kk = 0; kk < 64; ++kk) { const int k = ks * 64 + kk; const float wv = w[(size_t)k * 3072];
#pragma unroll
            for (int r = 0; r < 9; ++r) acc[r] += s[r * 1024 + k] * wv; }
#pragma unroll
        for (int r = 0; r < 9; ++r) red[(ks * 9 + r) * 32 + col] = acc[r];
        __syncthreads();
        if (tid < 288) { const int r = tid >> 5, cc = tid & 31; float sum = 0.f;
#pragma unroll
            for (int k2 = 0; k2 < 16; ++k2) sum += red[(k2 * 9 + r) * 32 + cc];
            mod[(l * 9 + r) * 3072 + n0 + cc] = sum + P.ada_b[l * 3072 + n0 + cc]; }
        __syncthreads();
    }
    float* cos_t = (float*)(P.ws + WS_ROPE); float* sin_t = cos_t + SEQ * 32;
    for (int i = get_bid() * 512 + tid; i < SEQ * 32; i += gridDim.x * 512) {
        const int pos = i >> 5, jj = i & 31, fi = jj & 15;
        const float inv = __builtin_amdgcn_exp2f(-(float)(2 * fi) * (13.287712379549449f / 32.f));
        const float ang = (float)(jj < 16 ? (pos >> 6) : (pos & 63)) * inv;
        cos_t[i] = __cosf(ang); sin_t[i] = __sinf(ang);
    }
}

template <bool FRAG = false>
DI void transpose_item(const float* W, int K, int N, bf16_t* WT, LAS float* scr, int item, int lane) {
    const int nblk = N / 32, kb = item / nblk, nb = item % nblk, k0 = 64 * kb, n0 = 32 * nb;
#pragma unroll 8
    for (int i = 0; i < 32; ++i) { const int kk = 2 * i + (lane >> 5); scr[kk * 33 + (lane & 31)] = W[(size_t)(k0 + kk) * N + n0 + (lane & 31)]; }
    asm volatile("s_waitcnt lgkmcnt(0)" ::: "memory");
    const int c = lane & 7;
#pragma unroll
    for (int j = 0; j < 4; ++j) { const int n = (lane >> 3) + 8 * j; const LAS float* sp = scr + (8 * c) * 33 + n;
        u32x4 o; o.x = pk2(sp[0 * 33], sp[1 * 33]); o.y = pk2(sp[2 * 33], sp[3 * 33]); o.z = pk2(sp[4 * 33], sp[5 * 33]); o.w = pk2(sp[6 * 33], sp[7 * 33]);
        if (FRAG) {
            const int nn = n0 + n, k8 = (k0 >> 3) + c;
            *(u32x4*)(WT + ((((nn >> 4) * 4 + (k8 >> 2)) * 64 + (k8 & 3) * 16 + (nn & 15)) * 8)) = o;
        } else *(u32x4*)(WT + (size_t)(n0 + n) * K + k0 + 8 * c) = o; }
    asm volatile("s_waitcnt lgkmcnt(0)" ::: "memory");
}

DI void phase_norm(const Params& P, LAS unsigned char* lds, int layer, int wv) {
    const int tid = get_tid(wv), lane = tid & 63, wave = tid >> 6;
    const int gw = get_bid() * 8 + wave, NGW = gridDim.x * 8;
    const int j = layer >> 1;
    LAS float* scr = (LAS float*)(lds + wave * 16384);
    bf16_t* WIN = (bf16_t*)(P.ws + WS_WIN); bf16_t* WOUT = (bf16_t*)(P.ws + WS_WOUT); bf16_t* WRG = (bf16_t*)(P.ws + WS_WRG);
    if ((layer & 1) == 0) {
        constexpr int I_IN = 16 * (EVEN_IN / 32), I_OUT = 32 * 32, I_RG = 32 * 8;
        for (int it = gw; it < I_IN + I_OUT + I_RG; it += NGW) {
            int r = it;
            if (r < I_IN) { transpose_item(P.ev_w_in + (size_t)j * 1024 * EVEN_IN, 1024, EVEN_IN, WIN, scr, r, lane); continue; } r -= I_IN;
            if (r < I_OUT) { transpose_item(P.ev_w_out + (size_t)j * 2048 * 1024, 2048, 1024, WOUT, scr, r, lane); continue; } r -= I_OUT;
            const int mat = r >> 3, sub = r & 7;
            const int dir = mat >> 4, gate = (mat >> 3) & 1, hd = mat & 7;
            const float* src = (gate == 0 ? P.ev_rg_wx : P.ev_rg_wa) + ((size_t)((j * 2 + dir) * 8 + hd)) * 16384;
            transpose_item<true>(src, 128, 128, WRG + (size_t)mat * 16384, scr, sub, lane);
        }
    } else {
        constexpr int I_IN = 16 * (ODD_IN / 32), I_OUT = 16 * 32;
        for (int it = gw; it < I_IN + I_OUT; it += NGW) {
            int r = it;
            if (r < I_IN) { transpose_item(P.od_w_in + (size_t)j * 1024 * ODD_IN, 1024, ODD_IN, WIN, scr, r, lane); continue; } r -= I_IN;
            transpose_item(P.od_w_out + (size_t)j * 1024 * 1024, 1024, 1024, WOUT, scr, r, lane);
        }
    }
    const float* hl = layer == 0 ? P.x : P.out; const float* hc = layer == 0 ? P.ctx : (const float*)(P.ws + WS_HCTX);
    const float* mod = (const float*)(P.ws + WS_MOD) + (size_t)layer * 9 * 3072;
    const float* nw = P.norm_w + layer * 1024;
    bf16_t* U = (bf16_t*)(P.ws + WS_OV);
    for (int R = gw; R < MROWS; R += NGW) {
        const int b = R / LT, jr = R % LT;
        const float* src = jr < CTXL ? hc + ((size_t)b * CTXL + jr) * DM : hl + ((size_t)b * SEQ + (jr - CTXL)) * DM;
        const float* sh = mod + (jr < CTXL ? 8 : b) * 3072; const float* sc = sh + 1024;
        f32x4 v[4]; float ss = 0.f;
#pragma unroll
        for (int q = 0; q < 4; ++q) { v[q] = *(const f32x4*)(src + 4 * lane + 256 * q); ss += (v[q][0] * v[q][0] + v[q][1] * v[q][1]) + (v[q][2] * v[q][2] + v[q][3] * v[q][3]); }
        const float rstd = rsqrtf(wave_sum(ss) * (1.f / DM) + RMS_EPS);
#pragma unroll
        for (int q = 0; q < 4; ++q) { const int k = 4 * lane + 256 * q;
            const f32x4 w4 = *(const f32x4*)(nw + k), s4 = *(const f32x4*)(sc + k), h4 = *(const f32x4*)(sh + k);
            const f32x4 y = (v[q] * rstd) * w4; const f32x4 o = y * (s4 + 1.f) + h4;
            u32x2 w; w.x = pk2(o[0], o[1]); w.y = pk2(o[2], o[3]); *(u32x2*)(U + (size_t)R * DM + k) = w; }
    }
}

typedef _Float16 f16x2_t __attribute__((ext_vector_type(2)));
DI unsigned pkh2(float a, float b) { const f16x2_t v = {(_Float16)a, (_Float16)b}; return __builtin_bit_cast(unsigned, v); }
DI void unpkh2(unsigned u, float& a, float& b) { const f16x2_t v = __builtin_bit_cast(f16x2_t, u); a = (float)v[0]; b = (float)v[1]; }
constexpr int RG_UT = 0, RG_AL = 17408, RG_BL = 50176, RG_HP = 82944, RG_QA = 148480, RG_CAR = 152576, RG_FLAG = 153600, RG_END = 153664;
static_assert(RG_END <= LDS_BYTES - 256, "RG-LRU LDS map");
constexpr int CW_RG = 8192;
DI void rglru_item(const Params& P, LAS unsigned char* lds, int j, int item, int wv) {
    const int tid = get_tid(wv), lane = tid & 63, wave = tid >> 6, r = lane & 15, g = lane >> 4;
    const int grp = item / NCHUNK, ci = item % NCHUNK, b = grp >> 3, hd = grp & 7;
    bf16_t* p = (bf16_t*)(P.ws + WS_P);
    const bf16_t* WRG = (const bf16_t*)(P.ws + WS_WRG);
    unsigned long long* AGG = (unsigned long long*)(P.ws + WS_AGG);
    unsigned* cnt = (unsigned*)(P.ws + WS_CTL) + CW_RG + (j * 64 + grp) * 16;
    const int R0 = b * LT + ci * 64;
    const int seg_lo = b * LT + (ci < 4 ? 0 : CTXL), seg_hi = b * LT + (ci < 4 ? CTXL : LT);
    LAS bf16_t* UT = (LAS bf16_t*)(lds + RG_UT);
    LAS float* AL = (LAS float*)(lds + RG_AL);
    LAS float* BL = (LAS float*)(lds + RG_BL);
    LAS unsigned* HP = (LAS unsigned*)(lds + RG_HP);
    LAS float* QA = (LAS float*)(lds + RG_QA);
    LAS float* CAR = (LAS float*)(lds + RG_CAR);
    TP_START(10, lds, tid); TP_START(11, lds, tid);
    bf16x8 wfr[2][2][4];
    float prm[2][3];
#pragma unroll
    for (int dir = 0; dir < 2; ++dir) {
#pragma unroll
        for (int gt = 0; gt < 2; ++gt) {
            const bf16_t* W = WRG + (size_t)((dir * 2 + gt) * 8 + hd) * 16384 + (wave * 4 * 64 + lane) * 8;
#pragma unroll
            for (int ks = 0; ks < 4; ++ks) wfr[dir][gt][ks] = *(const bf16x8*)(W + ks * 512);
        }
        const int idx = (j * 2 + dir) * 1024 + hd * 128 + 16 * wave + r;
        prm[dir][0] = P.ev_rg_bx[idx]; prm[dir][1] = P.ev_rg_ba[idx]; prm[dir][2] = P.ev_rg_lambda[idx];
    }
    {
        LAS bf16_t* XT = (LAS bf16_t*)(lds + RG_HP);
#pragma unroll
        for (int rep = 0; rep < 3; ++rep) {
            const int idx = tid + rep * 512, tr = idx >> 4, c0 = (idx & 15) * 8;
            if (idx < 67 * 16) {
                const int Rg = R0 + tr - 1;
                u32x4 xv = {0u, 0u, 0u, 0u};
                if (Rg >= seg_lo && Rg < seg_hi) xv = *(const u32x4*)(p + (size_t)Rg * EVEN_IN + hd * 128 + c0);
                *(LAS u32x4*)(XT + tr * 128 + c0) = xv;
            }
        }
        const int c0 = (tid & 15) * 8, cg0 = hd * 128 + c0;
        float wv4[4][8], bias[8];
        { const f32x4 b0 = *(const f32x4*)(P.ev_conv_b + j * 1024 + cg0), b1 = *(const f32x4*)(P.ev_conv_b + j * 1024 + cg0 + 4);
          bias[0] = b0[0]; bias[1] = b0[1]; bias[2] = b0[2]; bias[3] = b0[3]; bias[4] = b1[0]; bias[5] = b1[1]; bias[6] = b1[2]; bias[7] = b1[3]; }
#pragma unroll
        for (int k = 0; k < 4; ++k) { const float* wk = P.ev_conv_w + (size_t)(j * 4 + k) * 1024 + cg0; const f32x4 w0 = *(const f32x4*)wk, w1 = *(const f32x4*)(wk + 4);
            wv4[k][0] = w0[0]; wv4[k][1] = w0[1]; wv4[k][2] = w0[2]; wv4[k][3] = w0[3]; wv4[k][4] = w1[0]; wv4[k][5] = w1[1]; wv4[k][6] = w1[2]; wv4[k][7] = w1[3]; }
        __syncthreads();
#pragma unroll
        for (int rep = 0; rep < 2; ++rep) {
            const int t = (tid >> 4) + rep * 32;
            float acc[8];
#pragma unroll
            for (int e = 0; e < 8; ++e) acc[e] = bias[e];
#pragma unroll
            for (int k = 0; k < 4; ++k) {
                const u32x4 xv = *(const LAS u32x4*)(XT + (t + k) * 128 + c0);
                acc[0] += wv4[k][0] * __uint_as_float(xv.x << 16); acc[1] += wv4[k][1] * __uint_as_float(xv.x & 0xffff0000u);
                acc[2] += wv4[k][2] * __uint_as_float(xv.y << 16); acc[3] += wv4[k][3] * __uint_as_float(xv.y & 0xffff0000u);
                acc[4] += wv4[k][4] * __uint_as_float(xv.z << 16); acc[5] += wv4[k][5] * __uint_as_float(xv.z & 0xffff0000u);
                acc[6] += wv4[k][6] * __uint_as_float(xv.w << 16); acc[7] += wv4[k][7] * __uint_as_float(xv.w & 0xffff0000u);
            }
            u32x4 o; o.x = pk2(acc[0], acc[1]); o.y = pk2(acc[2], acc[3]); o.z = pk2(acc[4], acc[5]); o.w = pk2(acc[6], acc[7]);
            *(LAS u32x4*)(UT + t * 136 + c0) = o;
        }
    }
    __syncthreads();
    TP_STOP(11, lds, tid);
#pragma unroll
    for (int dir = 0; dir < 2; ++dir) {
        TP_START(12, lds, tid); TP_START(16, lds, tid);
        f32x4 ax[4], aa[4];
#pragma unroll
        for (int m = 0; m < 4; ++m) { ax[m] = (f32x4){0.f, 0.f, 0.f, 0.f}; aa[m] = (f32x4){0.f, 0.f, 0.f, 0.f}; }
#pragma unroll
        for (int ks = 0; ks < 4; ++ks) {
#pragma unroll
            for (int m = 0; m < 4; ++m) {
                const bf16x8 a = *(const LAS bf16x8*)(UT + (16 * m + r) * 136 + 32 * ks + 8 * g);
                ax[m] = MFMA16(a, wfr[dir][0][ks], ax[m]); aa[m] = MFMA16(a, wfr[dir][1][ks], aa[m]);
            }
        }
        asm volatile("" :: "v"(ax[0]), "v"(ax[1]), "v"(ax[2]), "v"(ax[3]), "v"(aa[0]), "v"(aa[1]), "v"(aa[2]), "v"(aa[3]));
        TP_STOP(16, lds, tid); TP_START(17, lds, tid);
        {
            const int c = 16 * wave + r;
            const float bxv = prm[dir][0], bav = prm[dir][1], lam = prm[dir][2];
            const float sp = softplus_neg(lam);
#pragma unroll
            for (int m = 0; m < 4; ++m)
#pragma unroll
                for (int i = 0; i < 4; ++i) {
                    const int t = 16 * m + 4 * g + i;
                    const float gx = sigm(ax[m][i] + bxv), ga = sigm(aa[m][i] + bav);
                    const float la = -8.f * ga * sp;
                    const float a = __expf(la), mult = __builtin_amdgcn_sqrtf(neg_expm1(2.f * la));
                    const float uv = bf2f(UT[t * 136 + c]);
                    AL[t * 128 + c] = a; BL[t * 128 + c] = mult * gx * uv;
                }
        }
        asm volatile("s_waitcnt lgkmcnt(0)" ::: "memory");
        TP_STOP(17, lds, tid); TP_START(18, lds, tid);
        __syncthreads();
        TP_STOP(18, lds, tid);
        TP_STOP(12, lds, tid); TP_START(13, lds, tid);
        {
            const int c = tid & 127, q = tid >> 7;
            float A = 1.f, B = 0.f;
#pragma unroll
            for (int s = 0; s < 16; ++s) { const int t = dir == 0 ? 16 * q + s : 16 * q + 15 - s; const float a = AL[t * 128 + c], bb = BL[t * 128 + c]; B = a * B + bb; A *= a; }
            QA[(q * 128 + c) * 2] = A; QA[(q * 128 + c) * 2 + 1] = B;
            __syncthreads();
            float h = 0.f, pc = 1.f;
            const int nprev = dir == 0 ? q : 3 - q;
            for (int qq = 0; qq < nprev; ++qq) { const int qi = dir == 0 ? qq : 3 - qq; const float a = QA[(qi * 128 + c) * 2]; h = a * h + QA[(qi * 128 + c) * 2 + 1]; pc *= a; }
#pragma unroll
            for (int s = 0; s < 16; ++s) { const int t = dir == 0 ? 16 * q + s : 16 * q + 15 - s; const float a = AL[t * 128 + c]; h = a * h + BL[t * 128 + c]; pc *= a;
                HP[(dir * 64 + t) * 128 + c] = pkh2(h, pc); }
            if (nprev == 3) {
                const unsigned long long v = ((unsigned long long)__float_as_uint(h) << 32) | __float_as_uint(pc);
                __hip_atomic_store(AGG + ((size_t)(dir * NB + b) * NCHUNK + ci) * 1024 + hd * 128 + c, v, __ATOMIC_RELAXED, __HIP_MEMORY_SCOPE_AGENT);
            }
        }
        __syncthreads();
        TP_STOP(13, lds, tid);
    }
    TP_START(14, lds, tid);
    u32x4 gpre[2];
#pragma unroll
    for (int rep = 0; rep < 2; ++rep) { const int idx = tid + rep * 512; gpre[rep] = *(const u32x4*)(p + (size_t)(R0 + (idx >> 4)) * EVEN_IN + 1536 + hd * 128 + (idx & 15) * 8); }
    asm volatile("s_waitcnt vmcnt(0)" ::: "memory");
    __syncthreads();
    if (tid == 0) {
        __hip_atomic_fetch_add(cnt, 1u, __ATOMIC_RELAXED, __HIP_MEMORY_SCOPE_AGENT);
        unsigned spins = 0;
        while (__hip_atomic_load(cnt, __ATOMIC_RELAXED, __HIP_MEMORY_SCOPE_AGENT) < (unsigned)NCHUNK) { __builtin_amdgcn_s_sleep(2); if (++spins > (1u << 22)) break; }
    }
    __syncthreads();
    TP_STOP(14, lds, tid); TP_START(15, lds, tid);
    if (tid < 256) {
        const int dir = tid >> 7, c = tid & 127;
        const int pos = dir == 0 ? ci : (ci < 4 ? 3 - ci : 39 - ci);
        float h = 0.f;
        const unsigned long long* ag = AGG + (size_t)(dir * NB + b) * NCHUNK * 1024 + hd * 128 + c;
#pragma unroll 1
        for (int base = 0; base < pos; base += 9) {
            unsigned long long v[9];
#pragma unroll
            for (int k = 0; k < 9; ++k) { const int pp = base + k < pos ? base + k : pos - 1; const int cc = dir == 0 ? pp : (pp < 4 ? 3 - pp : 39 - pp);
                v[k] = __hip_atomic_load(ag + (size_t)cc * 1024, __ATOMIC_RELAXED, __HIP_MEMORY_SCOPE_AGENT); }
#pragma unroll
            for (int k = 0; k < 9; ++k) if (base + k < pos) h = __uint_as_float((unsigned)v[k]) * h + __uint_as_float((unsigned)(v[k] >> 32));
        }
        CAR[dir * 128 + c] = h;
    }
    __syncthreads();
#pragma unroll
    for (int rep = 0; rep < 2; ++rep) {
        const int idx = tid + rep * 512, t = idx >> 4, c0 = (idx & 15) * 8;
        bf16_t* gp = p + (size_t)(R0 + t) * EVEN_IN + 1536 + hd * 128 + c0;
        const u32x4 gv = gpre[rep];
        float y[8];
#pragma unroll
        for (int e = 0; e < 8; ++e) {
            float h0, p0, h1, p1; unpkh2(HP[t * 128 + c0 + e], h0, p0); unpkh2(HP[(64 + t) * 128 + c0 + e], h1, p1);
            y[e] = (h0 + p0 * CAR[c0 + e]) + (h1 + p1 * CAR[128 + c0 + e]);
        }
        const float gg[8] = {__uint_as_float(gv.x << 16), __uint_as_float(gv.x & 0xffff0000u), __uint_as_float(gv.y << 16), __uint_as_float(gv.y & 0xffff0000u),
                             __uint_as_float(gv.z << 16), __uint_as_float(gv.z & 0xffff0000u), __uint_as_float(gv.w << 16), __uint_as_float(gv.w & 0xffff0000u)};
        u32x4 o;
        o.x = pk2(y[0] * gg[0] * sigm(gg[0]), y[1] * gg[1] * sigm(gg[1])); o.y = pk2(y[2] * gg[2] * sigm(gg[2]), y[3] * gg[3] * sigm(gg[3]));
        o.z = pk2(y[4] * gg[4] * sigm(gg[4]), y[5] * gg[5] * sigm(gg[5])); o.w = pk2(y[6] * gg[6] * sigm(gg[6]), y[7] * gg[7] * sigm(gg[7]));
        *(u32x4*)gp = o;
    }
    __syncthreads();
    TP_STOP(15, lds, tid); TP_STOP(10, lds, tid);
}

DI void rope8v(u32x4& v, const f32x4 cs, const f32x4 sn) {
    unsigned* w = (unsigned*)&v;
#pragma unroll
    for (int i = 0; i < 4; ++i) { const float t1 = __uint_as_float(w[i] << 16), t2 = __uint_as_float(w[i] & 0xffff0000u); w[i] = pk2(t1 * cs[i] - t2 * sn[i], t1 * sn[i] + t2 * cs[i]); }
}
DI void rope8(u32x4& v, const float* cs, const float* sn) { rope8v(v, *(const f32x4*)cs, *(const f32x4*)sn); }
typedef short v4i16_a __attribute__((ext_vector_type(4)));
DI void attn_item(const Params& P, LAS unsigned char* lds, int j, int item, int wv) {
    const int tid = get_tid(wv), lane = tid & 63, wave = tid >> 6, r = lane & 31, h = lane >> 5;
    const bool is_lat = item < 512;
    int b, qb, kvh;
    if (is_lat) { b = item >> 6; qb = (item >> 2) & 15; kvh = item & 3; } else { const int it = item - 512; b = it >> 3; qb = (it >> 2) & 1; kvh = it & 3; }
    bf16_t* p = (bf16_t*)(P.ws + WS_P);
    const float* cos_t = (const float*)(P.ws + WS_ROPE); const float* sin_t = cos_t + SEQ * 32;
    LAS unsigned char* QL = lds + 36864 + wave * 9216;
    TP_START(1, lds, tid);
    const int hq = 4 * kvh + (wave >> 1), ql0 = qb * 128 + 64 * (wave & 1);
    const size_t rowbase = (size_t)b * LT + (is_lat ? CTXL : 0);
#pragma unroll
    for (int qt = 0; qt < 2; ++qt) {
        const int qi = ql0 + 32 * qt + r;
        const bf16_t* qp = p + (rowbase + qi) * EVEN_IN + 2560 + hq * 64 + 8 * h;
#pragma unroll
        for (int ks = 0; ks < 4; ++ks) {
            u32x4 v = *(const u32x4*)(qp + 16 * ks);
            if (is_lat) rope8(v, cos_t + qi * 32 + 8 * ks + 4 * h, sin_t + qi * 32 + 8 * ks + 4 * h);
            *(LAS u32x4*)(QL + (32 * qt + r) * 144 + (16 * ks + 8 * h) * 2) = v;
        }
    }
    const float sink2 = P.ev_sink[j * 16 + hq] * LOG2E;
    float mrun[2] = {sink2, sink2}, lrun[2] = {h == 0 ? 1.f : 0.f, h == 0 ? 1.f : 0.f};
    f32x16 O[2][2];
#pragma unroll
    for (int a = 0; a < 2; ++a)
#pragma unroll
        for (int c = 0; c < 2; ++c)
#pragma unroll
            for (int i = 0; i < 16; ++i) O[a][c][i] = 0.f;
    const int w_lo = (is_lat && qb == 0) ? 2 : 0, w_hi = (is_lat && qb == 15) ? 3 : 5;
    const int nT = is_lat ? 4 + (w_hi - w_lo + 1) : 4;
    const float SC = 0.125f * LOG2E, NEG = -1e30f;
    const int key = tid >> 3, chn = tid & 7;
    u32x4 kreg, vreg; f32x4 creg, sreg;
#define ATT_K0(t) ((t) < 4 ? 64 * (t) : qb * 128 - 128 + 64 * (w_lo + (t) - 4))
#define ATT_LOAD(t) do { const bool win_ = (t) >= 4; const int k0_ = ATT_K0(t); \
        const bf16_t* kp_ = p + ((size_t)b * LT + (win_ ? CTXL : 0) + k0_ + key) * EVEN_IN + 1024 + kvh * 64 + 8 * chn; \
        kreg = *(const u32x4*)kp_; vreg = *(const u32x4*)(kp_ + 256); \
        if (win_) { creg = *(const f32x4*)(cos_t + (k0_ + key) * 32 + 4 * chn); sreg = *(const f32x4*)(sin_t + (k0_ + key) * 32 + 4 * chn); } } while (0)
#define ATT_STORE(t, buf) do { const bool win_ = (t) >= 4; \
        if (win_) rope8v(kreg, creg, sreg); \
        *(LAS u32x4*)(lds + (buf) * 18432 + key * 144 + chn * 16) = kreg; *(LAS u32x4*)(lds + (buf) * 18432 + 9216 + key * 144 + chn * 16) = vreg; } while (0)
    TP_START(2, lds, tid);
    ATT_LOAD(0); ATT_STORE(0, 0);
    if (nT > 1) ATT_LOAD(1);
#pragma unroll 1
    for (int t = 0; t < nT; ++t) {
        TP_START(4, lds, tid);
        __syncthreads();
        TP_STOP(4, lds, tid);
        if (t + 1 < nT) { ATT_STORE(t + 1, (t + 1) & 1); if (t + 2 < nT) ATT_LOAD(t + 2); }
        TP_START(3, lds, tid);
        const bool win = t >= 4;
        const int k0 = ATT_K0(t);
        const int dq = k0 - ql0;
        if (win && (dq >= 192 || dq <= -192)) continue;
        const bool need_mask = win && (dq >= 128 || dq <= -128);
        const LAS unsigned char* KL = lds + (t & 1) * 18432;
        const LAS bf16_t* VL = (const LAS bf16_t*)(lds + (t & 1) * 18432 + 9216);
#pragma unroll
        for (int qt = 0; qt < 2; ++qt) {
            f32x16 s0, s1;
#pragma unroll
            for (int i = 0; i < 16; ++i) { s0[i] = 0.f; s1[i] = 0.f; }
#pragma unroll
            for (int ks = 0; ks < 4; ++ks) {
                const bf16x8 qfr = *(const LAS bf16x8*)(QL + (32 * qt + r) * 144 + (16 * ks + 8 * h) * 2);
                const bf16x8 k0f = *(const LAS bf16x8*)(KL + r * 144 + (16 * ks + 8 * h) * 2), k1f = *(const LAS bf16x8*)(KL + (32 + r) * 144 + (16 * ks + 8 * h) * 2);
                s0 = MFMA32(k0f, qfr, s0); s1 = MFMA32(k1f, qfr, s1);
            }
            const int qpos = ql0 + 32 * qt + r;
            float mx = NEG;
            if (need_mask) {
#pragma unroll
                for (int i = 0; i < 16; ++i) {
                    const int d0 = qpos - (k0 + crow(i, h)), d1 = d0 - 32;
                    float v0 = s0[i] * SC, v1 = s1[i] * SC;
                    if (d0 > 128 || d0 < -128) v0 = NEG;
                    if (d1 > 128 || d1 < -128) v1 = NEG;
                    s0[i] = v0; s1[i] = v1; mx = fmaxf(mx, fmaxf(v0, v1));
                }
            } else {
#pragma unroll
                for (int i = 0; i < 16; ++i) { s0[i] *= SC; s1[i] *= SC; mx = fmaxf(mx, fmaxf(s0[i], s1[i])); }
            }
            mx = fmaxf(mx, shfl_xor_f(mx, 32));
            const float mn = fmaxf(mrun[qt], mx), alpha = __builtin_amdgcn_exp2f(mrun[qt] - mn);
            mrun[qt] = mn;
            float ls = 0.f;
#pragma unroll
            for (int i = 0; i < 16; ++i) { s0[i] = __builtin_amdgcn_exp2f(s0[i] - mn); s1[i] = __builtin_amdgcn_exp2f(s1[i] - mn); ls += s0[i] + s1[i]; }
            lrun[qt] = lrun[qt] * alpha + ls;
#pragma unroll
            for (int dt = 0; dt < 2; ++dt)
#pragma unroll
                for (int i = 0; i < 16; ++i) O[dt][qt][i] *= alpha;
            bf16x8 pf[2][2];
#pragma unroll
            for (int s = 0; s < 2; ++s) {
                u32x4 a, c;
                a.x = pk2(s0[8 * s + 0], s0[8 * s + 1]); a.y = pk2(s0[8 * s + 2], s0[8 * s + 3]); a.z = pk2(s0[8 * s + 4], s0[8 * s + 5]); a.w = pk2(s0[8 * s + 6], s0[8 * s + 7]);
                c.x = pk2(s1[8 * s + 0], s1[8 * s + 1]); c.y = pk2(s1[8 * s + 2], s1[8 * s + 3]); c.z = pk2(s1[8 * s + 4], s1[8 * s + 5]); c.w = pk2(s1[8 * s + 6], s1[8 * s + 7]);
                pf[0][s] = __builtin_bit_cast(bf16x8, a); pf[1][s] = __builtin_bit_cast(bf16x8, c);
            }
            const int gq = (lane >> 4) & 1, qq4 = (lane & 15) >> 2, pp4 = lane & 3;
#pragma unroll
            for (int dt = 0; dt < 2; ++dt)
#pragma unroll
                for (int kt = 0; kt < 2; ++kt)
#pragma unroll
                    for (int s = 0; s < 2; ++s) {
                        const LAS bf16_t* vp = VL + (32 * kt + 16 * s + 4 * h + qq4) * 72 + 32 * dt + 16 * gq + 4 * pp4;
                        const v4i16_a lo = __builtin_amdgcn_ds_read_tr16_b64_v4i16((LAS v4i16_a*)vp);
                        const v4i16_a hi = __builtin_amdgcn_ds_read_tr16_b64_v4i16((LAS v4i16_a*)(vp + 8 * 72));
                        const bf16x8 vf = {lo[0], lo[1], lo[2], lo[3], hi[0], hi[1], hi[2], hi[3]};
                        O[dt][qt] = MFMA32(vf, pf[kt][s], O[dt][qt]);
                    }
            __builtin_amdgcn_sched_barrier(0);
        }
        TP_STOP(3, lds, tid);
    }
    TP_STOP(2, lds, tid);
#undef ATT_K0
#undef ATT_LOAD
#undef ATT_STORE
#pragma unroll
    for (int qt = 0; qt < 2; ++qt) {
        const float lt = lrun[qt] + shfl_xor_f(lrun[qt], 32), inv = __builtin_amdgcn_rcpf(lt);
        const int qi = ql0 + 32 * qt + r;
        bf16_t* rowp = p + (rowbase + qi) * EVEN_IN;
#pragma unroll
        for (int dt = 0; dt < 2; ++dt)
#pragma unroll
            for (int i4 = 0; i4 < 4; ++i4) {
                const int d0 = 32 * dt + 8 * i4 + 4 * h;
                const u32x2 gv = *(const u32x2*)(rowp + 3584 + hq * 64 + d0);
                const float g0 = __uint_as_float(gv.x << 16), g1 = __uint_as_float(gv.x & 0xffff0000u), g2 = __uint_as_float(gv.y << 16), g3 = __uint_as_float(gv.y & 0xffff0000u);
                u32x2 o;
                o.x = pk2(O[dt][qt][4 * i4 + 0] * inv * g0 * sigm(g0), O[dt][qt][4 * i4 + 1] * inv * g1 * sigm(g1));
                o.y = pk2(O[dt][qt][4 * i4 + 2] * inv * g2 * sigm(g2), O[dt][qt][4 * i4 + 3] * inv * g3 * sigm(g3));
                *(u32x2*)(rowp + 2560 + hq * 64 + d0) = o;
            }
    }
    __syncthreads();
    TP_STOP(1, lds, tid);
}

constexpr int G2_QX = 0, G2_KF = 17408, G2_K2 = 60928, G2_VS = 79360, G2_AM = 96768, G2_ST = 105984, G2_PS = 140800, G2_BL = 144896, G2_Q1 = 145408, G2_END = 162816;
static_assert(G2_END <= LDS_BYTES - 256, "GLA LDS map");
typedef short v4i16_t __attribute__((ext_vector_type(4)));
DI bf16x8 frag_tr(const LAS bf16_t* M, int stride, int k0, int n0, int lane) {
    const int i = lane & 15, g = lane >> 4, q = i >> 2, pp = i & 3;
    const LAS bf16_t* a0 = M + (k0 + 8 * g + q) * stride + n0 + 4 * pp;
    const v4i16_t lo = __builtin_amdgcn_ds_read_tr16_b64_v4i16((LAS v4i16_t*)a0);
    const v4i16_t hi = __builtin_amdgcn_ds_read_tr16_b64_v4i16((LAS v4i16_t*)(a0 + 4 * stride));
    return (bf16x8){lo[0], lo[1], lo[2], lo[3], hi[0], hi[1], hi[2], hi[3]};
}

template <int DIR>
DI void gla2_item(const Params& P, LAS unsigned char* lds, int layer_j, int b, int hd, int wv) {
    const int tid = get_tid(wv), lane = tid & 63, wave = tid >> 6, r = lane & 15, g = lane >> 4;
    bf16_t* p = (bf16_t*)(P.ws + WS_P);
    LAS bf16_t* QX = (LAS bf16_t*)(lds + G2_QX); LAS bf16_t* KF = (LAS bf16_t*)(lds + G2_KF); LAS bf16_t* K2 = (LAS bf16_t*)(lds + G2_K2);
    LAS bf16_t* VS = (LAS bf16_t*)(lds + G2_VS); LAS bf16_t* AM = (LAS bf16_t*)(lds + G2_AM); LAS bf16_t* ST = (LAS bf16_t*)(lds + G2_ST);
    LAS float* PS8 = (LAS float*)(lds + G2_PS); LAS float* BLAST = (LAS float*)(lds + G2_BL); LAS bf16_t* Q1 = (LAS bf16_t*)(lds + G2_Q1);
    const int d0 = 2 * lane, tg = wave, I = tg >> 1, half = tg & 1;
    float lbv[2] = {0.f, 0.f};
    if (layer_j > 0) { lbv[0] = sigm(P.od_lb_raw[1024 + hd * 128 + d0] - P.od_lb_raw[hd * 128 + d0]); lbv[1] = sigm(P.od_lb_raw[1024 + hd * 128 + d0 + 1] - P.od_lb_raw[hd * 128 + d0 + 1]); }
    for (int i = tid; i < (9216 + 34816) / 4; i += 512) ((LAS unsigned*)(lds + G2_AM))[i] = 0u;
    f32x4 st[8];
#pragma unroll
    for (int e = 0; e < 8; ++e) st[e] = (f32x4){0.f, 0.f, 0.f, 0.f};
    unsigned zn[8], qn[8]; u32x4 vn[2];
#define G2_OFFZ(s) ((unsigned)((DIR == 0 ? 8 * tg + (s) : 63 - 8 * tg - (s)) * ODD_IN + d0) * 2u)
#define G2_OFFV(rep) ((unsigned)((DIR == 0 ? ((tid + (rep) * 512) >> 4) : 63 - ((tid + (rep) * 512) >> 4)) * ODD_IN + 8 * ((tid + (rep) * 512) & 15)) * 2u)
    const size_t colz = (size_t)DIR * 1024 + hd * 128, colq = 3072 + hd * 128, colv = 2048 + hd * 128;
    {
        const int chunk = DIR == 0 ? 0 : 3;
        const char* slab = (const char*)(p + ((size_t)b * LT + (size_t)chunk * 64) * ODD_IN);
#pragma unroll
        for (int s = 0; s < 8; ++s) { zn[s] = *(const unsigned*)(slab + colz * 2 + G2_OFFZ(s)); qn[s] = *(const unsigned*)(slab + colq * 2 + G2_OFFZ(s)); }
#pragma unroll
        for (int rep = 0; rep < 2; ++rep) vn[rep] = *(const u32x4*)(slab + colv * 2 + G2_OFFV(rep));
    }
    __syncthreads();
#pragma unroll 1
    for (int step = 0; step < NCHUNK; ++step) {
        const int chunk = DIR == 0 ? step : (step < 4 ? 3 - step : 39 - step);
        const size_t Rc0 = (size_t)b * LT + (size_t)chunk * 64;
        unsigned zc[8], qc[8]; u32x4 vc[2];
#pragma unroll
        for (int s = 0; s < 8; ++s) { zc[s] = zn[s]; qc[s] = qn[s]; }
        vc[0] = vn[0]; vc[1] = vn[1];
        float el[8][2], kk[8][2], qq[8][2];
        {
            float run0 = 1.f, run1 = 1.f;
#pragma unroll
            for (int s = 0; s < 8; ++s) {
                const float z0 = __uint_as_float(zc[s] << 16), z1 = __uint_as_float(zc[s] & 0xffff0000u);
                const float t0 = __expf(-z0), t1 = __expf(-z1), sg0 = __builtin_amdgcn_rcpf(1.f + t0), sg1 = __builtin_amdgcn_rcpf(1.f + t1);
                const float f0 = fmaxf(lbv[0] + (1.f - lbv[0]) * sg0, 1e-30f), f1 = fmaxf(lbv[1] + (1.f - lbv[1]) * sg1, 1e-30f);
                kk[s][0] = (1.f - lbv[0]) * (t0 * sg0); kk[s][1] = (1.f - lbv[1]) * (t1 * sg1);
                run0 = fmaxf(run0 * f0, 1e-35f); run1 = fmaxf(run1 * f1, 1e-35f); el[s][0] = run0; el[s][1] = run1;
                const float q0 = __uint_as_float(qc[s] << 16), q1 = __uint_as_float(qc[s] & 0xffff0000u);
                qq[s][0] = q0 * __builtin_amdgcn_rcpf(1.f + __expf(-q0)); qq[s][1] = q1 * __builtin_amdgcn_rcpf(1.f + __expf(-q1));
                if ((s & 1) == 1) __builtin_amdgcn_sched_barrier(0);
            }
            *(LAS f32x2*)(PS8 + tg * 128 + d0) = (f32x2){run0, run1};
#pragma unroll
            for (int rep = 0; rep < 2; ++rep) { const int idx = tid + rep * 512, tau = idx >> 4, chn = idx & 15; *(LAS u32x4*)(VS + tau * 136 + 8 * chn) = vc[rep]; }
        }
        __syncthreads();
        float RI[2];
        {
            float T[8][2];
#pragma unroll
            for (int q8 = 0; q8 < 8; ++q8) { const f32x2 t = *(const LAS f32x2*)(PS8 + q8 * 128 + d0); T[q8][0] = t[0]; T[q8][1] = t[1]; }
            float pre[2], fac[4][2], f4[2];
#pragma unroll
            for (int x = 0; x < 2; ++x) {
                const float P0 = T[0][x] * T[1][x], P1 = T[2][x] * T[3][x], P2 = T[4][x] * T[5][x], P3 = T[6][x] * T[7][x];
                pre[x] = half ? (I == 0 ? T[0][x] : (I == 1 ? T[2][x] : (I == 2 ? T[4][x] : T[6][x]))) : 1.f;
                RI[x] = I == 0 ? 1.f : (I == 1 ? P0 : (I == 2 ? P0 * P1 : P0 * P1 * P2));
                float cur = 1.f;
                fac[0][x] = cur; if (I <= 0) cur *= P0;
                fac[1][x] = cur; if (I <= 1) cur *= P1;
                fac[2][x] = cur; if (I <= 2) cur *= P2;
                fac[3][x] = cur; cur *= P3;
                f4[x] = cur;
                if (tg == 0) BLAST[d0 + x] = P0 * P1 * P2 * P3;
            }
            unsigned w0[4], w1[4];
#pragma unroll
            for (int s = 0; s < 8; ++s) {
                const int tau = 8 * tg + s;
                const float e00 = fmaxf(pre[0] * el[s][0], 1e-35f), e01 = fmaxf(pre[1] * el[s][1], 1e-35f);
                const float qi0 = qq[s][0] * e00, qi1 = qq[s][1] * e01;
                const float kd0 = kk[s][0] * __builtin_amdgcn_rcpf(e00), kd1 = kk[s][1] * __builtin_amdgcn_rcpf(e01);
                *(LAS unsigned*)(QX + tau * 136 + d0) = pk2(qi0, qi1);
                *(LAS unsigned*)(Q1 + tau * 136 + d0) = pk2(qi0 * RI[0], qi1 * RI[1]);
                if (I <= 0) *(LAS unsigned*)(KF + (0 + tau) * 136 + d0) = pk2(kd0 * fac[0][0], kd1 * fac[0][1]);
                if (I <= 1) *(LAS unsigned*)(KF + (16 + tau) * 136 + d0) = pk2(kd0 * fac[1][0], kd1 * fac[1][1]);
                if (I <= 2) *(LAS unsigned*)(KF + (48 + tau) * 136 + d0) = pk2(kd0 * fac[2][0], kd1 * fac[2][1]);
                *(LAS unsigned*)(KF + (96 + tau) * 136 + d0) = pk2(kd0 * fac[3][0], kd1 * fac[3][1]);
                const unsigned h0 = f2bf(kd0 * f4[0]), h1 = f2bf(kd1 * f4[1]);
                if (s & 1) { w0[s >> 1] |= h0 << 16; w1[s >> 1] |= h1 << 16; } else { w0[s >> 1] = h0; w1[s >> 1] = h1; }
                if ((s & 1) == 1) __builtin_amdgcn_sched_barrier(0);
            }
            *(LAS u32x4*)(K2 + (d0 + 0) * 72 + 8 * tg) = (u32x4){w0[0], w0[1], w0[2], w0[3]};
            *(LAS u32x4*)(K2 + (d0 + 1) * 72 + 8 * tg) = (u32x4){w1[0], w1[1], w1[2], w1[3]};
        }
        __syncthreads();
        if (step + 1 < NCHUNK) {
            const int nchunk = DIR == 0 ? step + 1 : (step + 1 < 4 ? 2 - step : 38 - step);
            const char* slab = (const char*)(p + ((size_t)b * LT + (size_t)nchunk * 64) * ODD_IN);
#pragma unroll
            for (int s = 0; s < 8; ++s) { zn[s] = *(const unsigned*)(slab + colz * 2 + G2_OFFZ(s)); qn[s] = *(const unsigned*)(slab + colq * 2 + G2_OFFZ(s)); }
#pragma unroll
            for (int rep = 0; rep < 2; ++rep) vn[rep] = *(const u32x4*)(slab + colv * 2 + G2_OFFV(rep));
        }
#pragma unroll 1
        for (int bi = wave; bi < 10; bi += 8) {
            const int Ib = bi < 1 ? 0 : (bi < 3 ? 1 : (bi < 6 ? 2 : 3)), Jb = bi - (Ib * (Ib + 1)) / 2;
            const int foff = Ib == 0 ? 0 : (Ib == 1 ? 16 : (Ib == 2 ? 48 : 96));
            f32x4 acc = {0.f, 0.f, 0.f, 0.f};
#pragma unroll
            for (int ks = 0; ks < 4; ++ks) {
                const bf16x8 a = *(const LAS bf16x8*)(QX + (16 * Ib + r) * 136 + 32 * ks + 8 * g);
                const bf16x8 bb = *(const LAS bf16x8*)(KF + (foff + 16 * Jb + r) * 136 + 32 * ks + 8 * g);
                acc = MFMA16(a, bb, acc);
            }
#pragma unroll
            for (int i = 0; i < 4; ++i) { float v = acc[i]; if (Jb == Ib && r > 4 * g + i) v = 0.f; AM[(16 * Ib + 4 * g + i) * 72 + 16 * Jb + r] = (bf16_t)f2bf(v); }
        }
        __syncthreads();
        {
            const int tt = wave >> 1, eb = 4 * (wave & 1);
            char* oslab = (char*)(p + Rc0 * ODD_IN + colz);
            bf16x8 aq[4], am[2];
#pragma unroll
            for (int ks = 0; ks < 4; ++ks) aq[ks] = *(const LAS bf16x8*)(Q1 + (16 * tt + r) * 136 + 32 * ks + 8 * g);
#pragma unroll
            for (int ks = 0; ks < 2; ++ks) am[ks] = *(const LAS bf16x8*)(AM + (16 * tt + r) * 72 + 32 * ks + 8 * g);
#pragma unroll
            for (int e4 = 0; e4 < 4; ++e4) {
                const int et = eb + e4;
                f32x4 acc = {0.f, 0.f, 0.f, 0.f};
#pragma unroll
                for (int ks = 0; ks < 4; ++ks) { const bf16x8 bb = *(const LAS bf16x8*)(ST + (16 * et + r) * 136 + 32 * ks + 8 * g); acc = MFMA16(aq[ks], bb, acc); }
#pragma unroll
                for (int ks = 0; ks < 2; ++ks) acc = MFMA16(am[ks], frag_tr(VS, 136, 32 * ks, 16 * et, lane), acc);
#pragma unroll
                for (int i = 0; i < 4; ++i) {
                    const int tau = 16 * tt + 4 * g + i;
                    const unsigned off = (unsigned)((DIR == 0 ? tau : 63 - tau) * ODD_IN + 16 * et + r) * 2u;
                    *(bf16_t*)(oslab + off) = (bf16_t)f2bf(acc[i]);
                }
                __builtin_amdgcn_sched_barrier(0);
            }
            float bl[4];
#pragma unroll
            for (int i = 0; i < 4; ++i) bl[i] = BLAST[16 * wave + 4 * g + i];
            bf16x8 ak[2];
#pragma unroll
            for (int ks = 0; ks < 2; ++ks) ak[ks] = *(const LAS bf16x8*)(K2 + (16 * wave + r) * 72 + 32 * ks + 8 * g);
#pragma unroll
            for (int et = 0; et < 8; ++et) {
#pragma unroll
                for (int i = 0; i < 4; ++i) st[et][i] *= bl[i];
#pragma unroll
                for (int ks = 0; ks < 2; ++ks) st[et] = MFMA16(ak[ks], frag_tr(VS, 136, 32 * ks, 16 * et, lane), st[et]);
                if (et & 1) __builtin_amdgcn_sched_barrier(0);
            }
        }
        __syncthreads();
#pragma unroll
        for (int et = 0; et < 8; ++et) { u32x2 w; w.x = pk2(st[et][0], st[et][1]); w.y = pk2(st[et][2], st[et][3]); *(LAS u32x2*)(ST + (16 * et + r) * 136 + 16 * wave + 4 * g) = w; }
    }
    __syncthreads();
}

DI void phase_readout(const Params& P, int layer_j, int wv) {
    const int tid = get_tid(wv), lane = tid & 63, wave = tid >> 6;
    const int gw = get_bid() * 8 + wave, NGW = gridDim.x * 8;
    bf16_t* p = (bf16_t*)(P.ws + WS_P);
    const float* gwt = P.od_gnorm_w + layer_j * 128 + (lane & 7) * 16;
    for (int R = gw; R < MROWS; R += NGW) {
        const bf16_t* op = p + (size_t)R * ODD_IN + 16 * lane; bf16_t* yp = p + (size_t)R * ODD_IN + 4096 + 16 * lane;
        const u32x4 o0 = *(const u32x4*)op, o1 = *(const u32x4*)(op + 8), c0 = *(const u32x4*)(op + 1024), c1 = *(const u32x4*)(op + 1032), g0 = *(const u32x4*)yp, g1 = *(const u32x4*)(yp + 8);
        float ov[16], gv[16];
        const unsigned* ow0 = (const unsigned*)&o0; const unsigned* ow1 = (const unsigned*)&o1; const unsigned* cw0 = (const unsigned*)&c0; const unsigned* cw1 = (const unsigned*)&c1;
        const unsigned* gw0 = (const unsigned*)&g0; const unsigned* gw1 = (const unsigned*)&g1;
#pragma unroll
        for (int i = 0; i < 4; ++i) {
            ov[2 * i] = __uint_as_float(ow0[i] << 16) + __uint_as_float(cw0[i] << 16); ov[2 * i + 1] = __uint_as_float(ow0[i] & 0xffff0000u) + __uint_as_float(cw0[i] & 0xffff0000u);
            ov[8 + 2 * i] = __uint_as_float(ow1[i] << 16) + __uint_as_float(cw1[i] << 16); ov[8 + 2 * i + 1] = __uint_as_float(ow1[i] & 0xffff0000u) + __uint_as_float(cw1[i] & 0xffff0000u);
            gv[2 * i] = __uint_as_float(gw0[i] << 16); gv[2 * i + 1] = __uint_as_float(gw0[i] & 0xffff0000u); gv[8 + 2 * i] = __uint_as_float(gw1[i] << 16); gv[8 + 2 * i + 1] = __uint_as_float(gw1[i] & 0xffff0000u);
        }
        float ss = 0.f;
#pragma unroll
        for (int i = 0; i < 16; ++i) ss += ov[i] * ov[i];
        ss += shfl_xor_f(ss, 1); ss += shfl_xor_f(ss, 2); ss += shfl_xor_f(ss, 4);
        const float rstd = rsqrtf(ss * (1.f / 128.f) + RMS_EPS);
        float y[16];
#pragma unroll
        for (int i = 0; i < 16; ++i) y[i] = ov[i] * rstd * gwt[i] * (gv[i] * sigm(gv[i]));
        u32x4 w0, w1;
        w0.x = pk2(y[0], y[1]); w0.y = pk2(y[2], y[3]); w0.z = pk2(y[4], y[5]); w0.w = pk2(y[6], y[7]);
        w1.x = pk2(y[8], y[9]); w1.y = pk2(y[10], y[11]); w1.z = pk2(y[12], y[13]); w1.w = pk2(y[14], y[15]);
        *(u32x4*)yp = w0; *(u32x4*)(yp + 8) = w1;
    }
}

DI void phase_final(const Params& P, int wv) {
    const int tid = get_tid(wv), lane = tid & 63, wave = tid >> 6;
    const int gw = get_bid() * 8 + wave, NGW = gridDim.x * 8;
    for (int R = gw; R < NB * SEQ; R += NGW) {
        float* row = P.out + (size_t)R * DM;
        f32x4 v[4]; float ss = 0.f;
#pragma unroll
        for (int q = 0; q < 4; ++q) { v[q] = *(const f32x4*)(row + 4 * lane + 256 * q); ss += (v[q][0] * v[q][0] + v[q][1] * v[q][1]) + (v[q][2] * v[q][2] + v[q][3] * v[q][3]); }
        const float rstd = rsqrtf(wave_sum(ss) * (1.f / DM) + RMS_EPS);
#pragma unroll
        for (int q = 0; q < 4; ++q) { const f32x4 w4 = *(const f32x4*)(P.final_norm_w + 4 * lane + 256 * q); *(f32x4*)(row + 4 * lane + 256 * q) = (v[q] * rstd) * w4; }
    }
}

#define XB_TMO      128
#define XB_XCNT(j)  (256  + 64 * (j))
#define XB_XSUB(j)  (1280 + 64 * (j))
#define XB_XGEN(j)  (2304 + 64 * (j))
#define XB_TOP      3328
#define XB_TOPGEN   3392
#define XCD_BAR_WORDS 3456
#define XB_SPIN_CAP (1u << 18)

__device__ __forceinline__ unsigned xb_ld(unsigned* p)              { return __hip_atomic_load(p, __ATOMIC_RELAXED, __HIP_MEMORY_SCOPE_AGENT); }
__device__ __forceinline__ unsigned xb_add(unsigned* p, unsigned v) { return __hip_atomic_fetch_add(p, v, __ATOMIC_RELAXED, __HIP_MEMORY_SCOPE_AGENT); }
__device__ __forceinline__ unsigned xb_xcc_id() { return (unsigned)__builtin_amdgcn_s_getreg((3 << 11) | 20) & 0xFu; }
#define XB_SPIN(cond, bar) do { unsigned _sp = 0; while (cond) { __builtin_amdgcn_s_sleep(1); \
    if ((++_sp & 255u) == 0u) { if (xb_ld(&(bar)[XB_TMO])) break; if (_sp > XB_SPIN_CAP) { atomicAdd(&(bar)[XB_TMO], 1u); break; } } } } while (0)

struct XcdBarrier {
    unsigned* bar; unsigned x;
    volatile LAS unsigned* st;
};

__device__ __forceinline__ XcdBarrier xcd_barrier_post(unsigned* bar, volatile LAS unsigned* st, int wv) {
    XcdBarrier b; b.bar = bar; b.x = xb_xcc_id(); b.st = st;
    if (get_tid(wv) == 0) (void)xb_add(&bar[XB_XCNT(b.x)], 1u);
    return b;
}
__device__ __forceinline__ void xcd_barrier_complete(unsigned* bar, unsigned x, unsigned& nloc, unsigned& nx) {
    const unsigned G = gridDim.x * gridDim.y * gridDim.z;
    unsigned sum, cnt, mine, sp = 0u;
    for (;;) {
        sum = 0u; cnt = 0u; mine = 0u;
#pragma unroll
        for (unsigned j = 0; j < 16; ++j) { const unsigned c = xb_ld(&bar[XB_XCNT(j)]); sum += c; cnt += (c > 0u) ? 1u : 0u; mine = (j == x) ? c : mine; }
        if (sum == G) break;
        __builtin_amdgcn_s_sleep(1);
        if ((++sp & 255u) == 0u) { if (xb_ld(&bar[XB_TMO])) break; if (sp > XB_SPIN_CAP) { atomicAdd(&bar[XB_TMO], 1u); break; } }
    }
    nloc = mine > 0u ? mine : 1u; nx = cnt > 0u ? cnt : 1u;
}

__device__ __forceinline__ void xcd_barrier(const XcdBarrier& b, int wv) {
    asm volatile("s_waitcnt vmcnt(0)" ::: "memory");
    __syncthreads();
    if (get_tid(wv) == 0) {
        unsigned* bar = b.bar;
        __builtin_amdgcn_s_waitcnt(0);
        unsigned nloc = b.st[0], nx = b.st[1];
        if (nloc == 0u) { xcd_barrier_complete(bar, b.x, nloc, nx); b.st[0] = nloc; b.st[1] = nx; }
        const unsigned old = xb_add(&bar[XB_XSUB(b.x)], 1u);
        const unsigned gen = old / nloc;
        if (old + 1u == (gen + 1u) * nloc) {
            __builtin_amdgcn_fence(__ATOMIC_RELEASE, "agent");
            asm volatile("s_waitcnt vmcnt(0)" ::: "memory");
            const unsigned og = xb_add(&bar[XB_TOP], 1u);
            const unsigned tg = og / nx;
            if (og + 1u == (tg + 1u) * nx) xb_add(&bar[XB_TOPGEN], 1u);
            else XB_SPIN(xb_ld(&bar[XB_TOPGEN]) == tg, bar);
            __builtin_amdgcn_fence(__ATOMIC_ACQUIRE, "agent");
            xb_add(&bar[XB_XGEN(b.x)], 1u);
            asm volatile("s_waitcnt vmcnt(0)" ::: "memory");
        } else {
            XB_SPIN(xb_ld(&bar[XB_XGEN(b.x)]) == gen, bar);
            __builtin_amdgcn_fence(__ATOMIC_ACQUIRE, "agent");
            asm volatile("s_waitcnt vmcnt(0)" ::: "memory");
        }
    }
    __syncthreads();
}

constexpr int PARAM_OFF = LDS_BYTES - 256;
static_assert(G2_END <= PARAM_OFF && sizeof(Params) <= 208, "LDS map");
DI const float* ld_uptr(const LAS unsigned long long* s, int i) {
    const unsigned long long v = s[i];
    const unsigned lo = __builtin_amdgcn_readfirstlane((unsigned)v), hi = __builtin_amdgcn_readfirstlane((unsigned)(v >> 32));
    return (const float*)(const __attribute__((address_space(1))) float*)(((unsigned long long)hi << 32) | lo);
}
DI Params load_params(LAS unsigned char* lds) {
    LAS unsigned char* pb = lds + PARAM_OFF; asm volatile("" : "+v"(pb));
    const LAS unsigned long long* s = (const LAS unsigned long long*)pb;
    Params Q;
    Q.x = ld_uptr(s, 0); Q.c = ld_uptr(s, 1); Q.ctx = ld_uptr(s, 2); Q.c_ctx = ld_uptr(s, 3); Q.ada_w = ld_uptr(s, 4); Q.ada_b = ld_uptr(s, 5); Q.norm_w = ld_uptr(s, 6);
    Q.ev_w_in = ld_uptr(s, 7); Q.ev_conv_w = ld_uptr(s, 8); Q.ev_conv_b = ld_uptr(s, 9); Q.ev_rg_wx = ld_uptr(s, 10); Q.ev_rg_bx = ld_uptr(s, 11); Q.ev_rg_wa = ld_uptr(s, 12);
    Q.ev_rg_ba = ld_uptr(s, 13); Q.ev_rg_lambda = ld_uptr(s, 14); Q.ev_sink = ld_uptr(s, 15); Q.ev_w_out = ld_uptr(s, 16); Q.od_w_in = ld_uptr(s, 17); Q.od_lb_raw = ld_uptr(s, 18);
    Q.od_gnorm_w = ld_uptr(s, 19); Q.od_w_out = ld_uptr(s, 20); Q.final_norm_w = ld_uptr(s, 21); Q.out = (float*)ld_uptr(s, 22); Q.ws = (unsigned char*)ld_uptr(s, 23);
    Q.ph_lo = 0; Q.ph_hi = 0;
    return Q;
}
DI void run_phase(LAS unsigned char* lds, int ph, int wv) {
    #ifndef PHMASK
#define PHMASK 0xffff
#endif
    if (ph == 0) { if (PHMASK & 1) { const Params P = load_params(lds); phase_pro(P, lds, wv); } return; }
    if (ph == NPHASE - 1) { if (PHMASK & 2) { const Params P = load_params(lds); phase_final(P, wv); } return; }
    const int layer = (ph - 1) / 5, sub = (ph - 1) % 5, j = layer >> 1;
    const bool even = (layer & 1) == 0;
    if (sub == 0) { if (PHMASK & 4) { const Params P = load_params(lds); phase_norm(P, lds, layer, wv); } return; }
    if (sub == 1) {
        const Params P = load_params(lds); bf16_t* pbuf = (bf16_t*)(P.ws + WS_P);
        const int N = even ? EVEN_IN : ODD_IN;
        pg8::Gemm gm{(const bf16_t*)(P.ws + WS_OV), (const bf16_t*)(P.ws + WS_WIN), MROWS, N, 1024, 1024};
        pg8::StaticOrder S; S.init(MROWS, N, (int)gridDim.x, get_bid());
        EpiStoreBf16 E{pbuf, N};
        if (PHMASK & 8) pg8::gemm_phase<EpiStoreBf16, pg8::StaticOrder, true, true>(lds, gm, S, E, wv);
        return;
    }
    if (sub == 2) {
        const Params P = load_params(lds);
        if (even) {
            constexpr int NRG = NB * NCHUNK * 8;
#if defined(SPLIT_ATTN)
            for (int it = get_bid(); it < NRG; it += gridDim.x) rglru_item(P, lds, j, it, wv);
#else
            for (int it = get_bid(); it < NRG + 576; it += gridDim.x) {
                if (it < NRG) { if (PHMASK & 32) rglru_item(P, lds, j, it, wv); } else { if (PHMASK & 16) attn_item(P, lds, j, it - NRG, wv); }
            }
#endif
        } else {
            for (int it = get_bid(); it < 128; it += gridDim.x) { if (PHMASK & 64) { if (it & 1) gla2_item<1>(P, lds, j, it >> 4, (it >> 1) & 7, wv); else gla2_item<0>(P, lds, j, it >> 4, (it >> 1) & 7, wv); } }
        }
        return;
    }
    if (sub == 3) {
        const Params P = load_params(lds);
        if (!even) { if (PHMASK & 256) phase_readout(P, j, wv); }
#if defined(SPLIT_ATTN)
        else { for (int it = get_bid(); it < 576; it += gridDim.x) attn_item(P, lds, j, it, wv); }
#endif
        return;
    }
    {
        const Params P = load_params(lds); bf16_t* pbuf = (bf16_t*)(P.ws + WS_P);
        const int K = even ? 2048 : 1024, lda = even ? EVEN_IN : ODD_IN;
        pg8::Gemm gm{pbuf + (even ? 1536 : 4096), (const bf16_t*)(P.ws + WS_WOUT), MROWS, 1024, K, lda};
        pg8::StaticOrder S; S.init(MROWS, 1024, (int)gridDim.x, get_bid());
        const float* hl = layer == 0 ? P.x : P.out; const float* hc = layer == 0 ? P.ctx : (const float*)(P.ws + WS_HCTX);
        EpiResid E{hl, hc, P.out, (float*)(P.ws + WS_HCTX), (const float*)(P.ws + WS_MOD) + (size_t)layer * 9 * 3072 + 2048};
        if (PHMASK & 512) pg8::gemm_phase<EpiResid, pg8::StaticOrder, true, true>(lds, gm, S, E, wv);
    }
}

__global__ void __launch_bounds__(512, 2) mega(Params P) {
    extern __shared__ __attribute__((aligned(16))) unsigned char lds_raw[];
    LAS unsigned char* lds = (LAS unsigned char*)lds_raw;
    cg::grid_group grid = cg::this_grid();
    const int wv = __builtin_amdgcn_readfirstlane((int)(threadIdx.x >> 6));
    if (get_tid(wv) == 0) {
#if defined(TP_ID)
        ((LAS unsigned long long*)(lds + 163840 - 32))[0] = 0ull; ((LAS unsigned long long*)(lds + 163840 - 32))[1] = 0ull;
#endif
        ((LAS unsigned*)(lds + PARAM_OFF + 208))[0] = 0u; ((LAS unsigned*)(lds + PARAM_OFF + 208))[1] = 0u;
        LAS unsigned long long* d = (LAS unsigned long long*)(lds + PARAM_OFF);
        d[0] = (unsigned long long)P.x; d[1] = (unsigned long long)P.c; d[2] = (unsigned long long)P.ctx; d[3] = (unsigned long long)P.c_ctx; d[4] = (unsigned long long)P.ada_w;
        d[5] = (unsigned long long)P.ada_b; d[6] = (unsigned long long)P.norm_w; d[7] = (unsigned long long)P.ev_w_in; d[8] = (unsigned long long)P.ev_conv_w; d[9] = (unsigned long long)P.ev_conv_b;
        d[10] = (unsigned long long)P.ev_rg_wx; d[11] = (unsigned long long)P.ev_rg_bx; d[12] = (unsigned long long)P.ev_rg_wa; d[13] = (unsigned long long)P.ev_rg_ba; d[14] = (unsigned long long)P.ev_rg_lambda;
        d[15] = (unsigned long long)P.ev_sink; d[16] = (unsigned long long)P.ev_w_out; d[17] = (unsigned long long)P.od_w_in; d[18] = (unsigned long long)P.od_lb_raw; d[19] = (unsigned long long)P.od_gnorm_w;
        d[20] = (unsigned long long)P.od_w_out; d[21] = (unsigned long long)P.final_norm_w; d[22] = (unsigned long long)P.out; d[23] = (unsigned long long)P.ws;
    }
    __syncthreads();
    const int ph_lo = P.ph_lo, ph_hi = P.ph_hi;
    (void)xcd_barrier_post((unsigned*)(P.ws + WS_CTL) + 4096, (volatile LAS unsigned*)(lds + PARAM_OFF + 208), wv);
#define GRID_SYNC(first) do { if (first) grid.sync(); else { XcdBarrier xb_; xb_.bar = (unsigned*)(load_params(lds).ws + WS_CTL) + 4096; xb_.x = xb_xcc_id(); xb_.st = (volatile LAS unsigned*)(lds + PARAM_OFF + 208); xcd_barrier(xb_, wv); } } while (0)
#if defined(PROBE_S)
    constexpr int PREP = PROBE_E - PROBE_S + 1;
#pragma unroll 1
    for (int seq = ph_lo; seq < ph_hi + PREP; ++seq) {
        if (seq > ph_lo) GRID_SYNC(seq == ph_lo + 1);
        const int ph = seq <= PROBE_E ? seq : seq - PREP;
        run_phase(lds, ph, wv);
    }
#else
#pragma unroll 1
    for (int ph = ph_lo; ph < ph_hi; ++ph) {
#if !defined(SPLIT_ATTN)
        if (ph >= 1 && ph < NPHASE - 1 && (ph - 1) % 5 == 3 && (((ph - 1) / 5) & 1) == 0) continue;
#endif
        if (ph > ph_lo) GRID_SYNC(ph == ph_lo + 1);
        run_phase(lds, ph, wv);
    }
#endif
#if defined(TP_ID)
    if (get_tid(wv) == 0 && blockIdx.x == TP_BLOCK) {
        const unsigned long long acc = ((LAS unsigned long long*)(lds + 163840 - 32))[1], t0 = __builtin_amdgcn_s_memrealtime();
        while (__builtin_amdgcn_s_memrealtime() - t0 < (unsigned long long)TP_AMP * acc) __builtin_amdgcn_s_sleep(8);
    }
#endif
}

extern "C" void kernel_launch(void* const* d_in, const int* in_sizes, int n_in, void* d_out, int out_size, void* d_ws, size_t ws_size, hipStream_t stream) {
    static int grid = 0;
    if (grid == 0) {
        if (n_in != 22 || ws_size < WS_END) { fprintf(stderr, "kernel_launch: unexpected inputs (n_in %d, ws %zu)\n", n_in, ws_size); grid = -1; return; }
        int dev = 0, cus = 0, per_cu = 0;
        hipGetDevice(&dev);
        hipDeviceGetAttribute(&cus, hipDeviceAttributeMultiprocessorCount, dev);
        if (hipFuncSetAttribute((const void*)mega, hipFuncAttributeMaxDynamicSharedMemorySize, LDS_BYTES) != hipSuccess) { fprintf(stderr, "kernel_launch: hipFuncSetAttribute failed\n"); grid = -1; return; }
        if (hipOccupancyMaxActiveBlocksPerMultiprocessor(&per_cu, (const void*)mega, 512, LDS_BYTES) != hipSuccess || per_cu < 1) { fprintf(stderr, "kernel_launch: occupancy query gives %d\n", per_cu); per_cu = 1; }
        (void)hipGetLastError();
        grid = cus;
    }
    if (grid < 0) return;
    if (hipMemsetAsync((char*)d_ws + WS_CTL, 0, 65536, stream) != hipSuccess) { fprintf(stderr, "kernel_launch: memset failed\n"); return; }
    Params P{};
    const float** pp = (const float**)&P;
    for (int i = 0; i < 22; ++i) pp[i] = (const float*)d_in[i];
    P.out = (float*)d_out; P.ws = (unsigned char*)d_ws;
#if ONE_LAUNCH
    P.ph_lo = 0; P.ph_hi = NPHASE;
    { void* args[] = {&P}; hipError_t e = hipLaunchCooperativeKernel((const void*)mega, dim3(grid), dim3(512), args, LDS_BYTES, stream);
      if (e != hipSuccess) fprintf(stderr, "cooperative launch failed: %s (grid %d)\n", hipGetErrorString(e), grid); }
#else
    for (int ph = 0; ph < NPHASE; ++ph) {
        P.ph_lo = ph; P.ph_hi = ph + 1;
        void* args[] = {&P}; hipError_t e = hipLaunchCooperativeKernel((const void*)mega, dim3(grid), dim3(512), args, LDS_BYTES, stream);
        if (e != hipSuccess) { fprintf(stderr, "launch %d failed: %s (grid %d)\n", ph, hipGetErrorString(e), grid); break; }
    }
#endif
}
```

```cpp
#include <hip/hip_runtime.h>
#include <hip/hip_cooperative_groups.h>
#include <cstdio>
#include <cstdint>
namespace cg = cooperative_groups;

#ifndef ONE_LAUNCH
#define ONE_LAUNCH 1
#endif

#define DI __device__ __forceinline__
#define LAS __attribute__((address_space(3)))
__device__ __forceinline__ int lane_nh() { int l; asm volatile("v_mbcnt_lo_u32_b32 %0, -1, 0\n\tv_mbcnt_hi_u32_b32 %0, -1, %0" : "=v"(l)); return l; }
__device__ __forceinline__ int get_tid(int wv) { asm volatile("" : "+s"(wv)); return wv * 64 + lane_nh(); }
__device__ __forceinline__ float shfl_xor_f(float v, int o) { return __int_as_float(__builtin_amdgcn_ds_bpermute((lane_nh() ^ o) << 2, __float_as_int(v))); }
__device__ __forceinline__ int get_bid() { int b = blockIdx.x; asm volatile("" : "+s"(b)); return b; }

#if defined(TP_ID)
#ifndef TP_BLOCK
#define TP_BLOCK 5
#endif
#ifndef TP_AMP
#define TP_AMP 16
#endif
#define TP_START(id, lds, tid_) do { if ((id) == TP_ID && (tid_) == 0 && blockIdx.x == TP_BLOCK) { ((LAS unsigned long long*)((lds) + 163840 - 32))[0] = __builtin_amdgcn_s_memrealtime(); } } while (0)
#define TP_STOP(id, lds, tid_) do { if ((id) == TP_ID && (tid_) == 0 && blockIdx.x == TP_BLOCK) { LAS unsigned long long* w_ = (LAS unsigned long long*)((lds) + 163840 - 32); w_[1] += __builtin_amdgcn_s_memrealtime() - w_[0]; } } while (0)
#else
#define TP_START(id, lds, tid_) do { } while (0)
#define TP_STOP(id, lds, tid_) do { } while (0)
#endif
namespace pg8 {
#define PG8_LAS __attribute__((address_space(3)))
typedef unsigned short bf16_t;
typedef short bf16x8 __attribute__((ext_vector_type(8)));
typedef float f32x4 __attribute__((ext_vector_type(4)));
typedef unsigned u32x4 __attribute__((ext_vector_type(4)));
constexpr int BM = 256, BK = 64, HALF = 128, HTB = HALF * BK * 2  , STAGE_BYTES = 8 * HTB, NXCD = 8, WGM = 8;

__host__ __device__ __forceinline__ int lds_byte(int r, int c) { const int st = (r >> 4) * 2 + (c >> 5), rr = r & 15, cc = c & 31, ob = rr * 64 + cc * 2; return st * 1024 + (ob ^ (((ob >> 9) & 1) << 5)); }
__host__ __device__ __forceinline__ void stage_rc(int b, int& R, int& C) { const int st = b / 1024, sb = b % 1024, swz = sb ^ (((sb >> 9) & 1) << 5); R = (st >> 1) * 16 + swz / 64; C = (st & 1) * 32 + (swz % 64) / 2; }
__host__ __device__ __forceinline__ int perm32(int rho) { const int n = rho >> 4, i = rho & 15; return 8 * (i >> 2) + 4 * n + (i & 3); }

struct Unit { int pm, pn; };
struct Gemm { const bf16_t* A; const bf16_t* Bt; int M, N, K, lda; };

struct StaticOrder {
    int nM, nN, nwg, G, c, lat_only;
    __host__ __device__ void init(int M, int N, int G_, int c_, int lat_only_ = 0) { nM = M / BM; nN = N / BM; nwg = nM * nN; G = G_; c = c_; lat_only = lat_only_; }
    __host__ __device__ bool next(int i, Unit& u) const {
        const long L = (long)i * G + c; if (L >= nwg) return false;
        int wgid = (int)L; { const int q = nwg / NXCD, r = nwg % NXCD, xcd = wgid % NXCD, off = wgid / NXCD; wgid = (xcd < r ? xcd * (q + 1) : r * (q + 1) + (xcd - r) * q) + off; }
        const int nig = WGM * nN, gid = wgid / nig, fm = gid * WGM, gsz = (nM - fm) < WGM ? (nM - fm) : WGM;
        u.pm = fm + ((wgid % nig) % gsz); u.pn = (wgid % nig) / gsz; if (lat_only) u.pm = 9 * (u.pm >> 3) + 1 + (u.pm & 7); return true;
    }
    __device__ __forceinline__ void a_ready(const Unit&) const {}
    __device__ __forceinline__ void done(const Unit&) const {}
};

template <class Epi, class Sched, bool ALIGN_EPI = false, bool SP2 = false>
__device__ __forceinline__ void gemm_phase(PG8_LAS unsigned char* lds, const Gemm g, const Sched& S, const Epi& E, int wv) {
    const int tid = get_tid(wv), wid = __builtin_amdgcn_readfirstlane(tid >> 6), lane = tid & 63, wr = wid >> 2, wc = wid & 3, fr = lane & 15, fq = lane >> 4;
    const int K = g.K, nt = K / BK;
    unsigned voffA[2], voffB[2];
#pragma unroll
    for (int i = 0; i < 2; ++i) { int R, C; stage_rc(tid * 16 + i * 8192, R, C); const int Rb = Epi::PERM ? ((R & ~31) + perm32(R & 31)) : R;
        voffA[i] = (unsigned)(R * g.lda + C) * 2u; voffB[i] = (unsigned)(Rb * K + C) * 2u; }
    const size_t kstep = (size_t)(BK * 2);
    const size_t hstepA = (size_t)HALF * g.lda * 2, hstepB = (size_t)HALF * K * 2;
    const size_t tstepA = 2 * hstepA, tstepB = 2 * hstepB;
    const unsigned ldsw = (unsigned)wid * 1024u;
    const int aoff = lds_byte(wr * 64 + fr, fq * 8), boff = lds_byte(wc * 32 + fr, fq * 8);
#define PG8_SA(b, h) (((b) * 2 + (h)) * HTB)
#define PG8_SB(b, h) ((4 + (b) * 2 + (h)) * HTB)
#define PG8_STAGE(bufoff, gbase, voff) do { _Pragma("unroll") for (int _i = 0; _i < 2; ++_i) \
        __builtin_amdgcn_global_load_lds((const unsigned*)((const char*)(gbase) + (voff)[_i]), (PG8_LAS unsigned*)(lds + (bufoff) + ldsw + _i * 8192), 16, 0, 0); } while (0)
#define PG8_LDA(dst, b, h) do { _Pragma("unroll") for (int m = 0; m < 4; ++m) _Pragma("unroll") for (int k = 0; k < 2; ++k) dst[m][k] = *(const PG8_LAS bf16x8*)(lds + PG8_SA(b, h) + aoff + m * 2048 + k * 1024); } while (0)
#define PG8_LDB(dst, b, h) do { _Pragma("unroll") for (int n = 0; n < 2; ++n) _Pragma("unroll") for (int k = 0; k < 2; ++k) dst[n][k] = *(const PG8_LAS bf16x8*)(lds + PG8_SB(b, h) + boff + n * 2048 + k * 1024); } while (0)
#define PG8_MMA(ai, bj, At, Bt) do { __builtin_amdgcn_s_setprio(1); _Pragma("unroll") for (int m = 0; m < 4; ++m) _Pragma("unroll") for (int n = 0; n < 2; ++n) _Pragma("unroll") for (int k = 0; k < 2; ++k) \
        acc[ai][bj][m][n] = __builtin_amdgcn_mfma_f32_16x16x32_bf16(Bt[n][k], At[m][k], acc[ai][bj][m][n], 0, 0, 0); __builtin_amdgcn_s_setprio(0); } while (0)
#define PG8_WAIT_V(n) asm volatile("s_waitcnt vmcnt(" #n ")" ::: "memory")
#define PG8_WAIT_L(n) asm volatile("s_waitcnt lgkmcnt(" #n ")" ::: "memory")
#define PG8_BAR __builtin_amdgcn_s_barrier()
#define PG8_SCHED __builtin_amdgcn_sched_barrier(0)
    Unit cur, nxt; int ui = 0;
    if (!S.next(0, cur)) return;
    f32x4 acc[2][2][4][2];
#pragma unroll
    for (int a = 0; a < 2; ++a)
#pragma unroll
        for (int b = 0; b < 2; ++b)
#pragma unroll
            for (int m = 0; m < 4; ++m)
#pragma unroll
                for (int n = 0; n < 2; ++n) acc[a][b][m][n] = (f32x4){0.f, 0.f, 0.f, 0.f};
    bf16x8 At[4][2], B0[2][2], B1[2][2];
    const char* cA = (const char*)g.A + (size_t)cur.pm * tstepA; const char* cB = (const char*)g.Bt + (size_t)cur.pn * tstepB;
    S.a_ready(cur);
    if constexpr (SP2) {
        PG8_STAGE(PG8_SB(0, 0), cB, voffB); PG8_STAGE(PG8_SB(0, 1), cB + hstepB, voffB); PG8_STAGE(PG8_SA(0, 0), cA, voffA); PG8_STAGE(PG8_SA(0, 1), cA + hstepA, voffA);
        if (wr == 1) PG8_BAR;
        PG8_WAIT_V(2); PG8_BAR;
        PG8_STAGE(PG8_SB(1, 0), cB + kstep, voffB); PG8_STAGE(PG8_SA(1, 0), cA + kstep, voffA); PG8_STAGE(PG8_SB(1, 1), cB + hstepB + kstep, voffB);
        PG8_WAIT_V(6); PG8_BAR;
    } else {
        PG8_STAGE(PG8_SB(0, 0), cB, voffB); PG8_STAGE(PG8_SA(0, 0), cA, voffA); PG8_STAGE(PG8_SB(0, 1), cB + hstepB, voffB); PG8_STAGE(PG8_SA(0, 1), cA + hstepA, voffA);
        if (wr == 1) PG8_BAR;
        PG8_WAIT_V(4); PG8_BAR;
        PG8_STAGE(PG8_SB(1, 0), cB + kstep, voffB); PG8_STAGE(PG8_SA(1, 0), cA + kstep, voffA); PG8_STAGE(PG8_SB(1, 1), cB + hstepB + kstep, voffB);
        PG8_WAIT_V(6); PG8_BAR;
    }
    for (;;) {
        const bool has_next = S.next(ui + 1, nxt);
        const char* nA = has_next ? (const char*)g.A + (size_t)nxt.pm * tstepA : cA; const char* nB = has_next ? (const char*)g.Bt + (size_t)nxt.pn * tstepB : cB;
        for (int t = 0; t < nt; t += 2) {
            const bool last = (t == nt - 2);
            const char* a1 = cA + (size_t)(t + 1) * kstep;
            const char* a2 = last ? nA : cA + (size_t)(t + 2) * kstep; const char* b2 = last ? nB : cB + (size_t)(t + 2) * kstep;
            const char* a3 = a2 + kstep; const char* b3 = b2 + kstep;
            if (last && has_next) S.a_ready(nxt);
            if constexpr (SP2) {
            PG8_LDB(B0, 0, 0); PG8_LDB(B1, 0, 1); PG8_SCHED; PG8_LDA(At, 0, 0); PG8_STAGE(PG8_SA(1, 1), a1 + hstepA, voffA);
            PG8_WAIT_V(8); PG8_WAIT_L(0); PG8_BAR; PG8_MMA(0, 0, At, B0); PG8_MMA(0, 1, At, B1); PG8_BAR; PG8_SCHED;
            PG8_LDA(At, 0, 1); PG8_STAGE(PG8_SB(0, 0), b2, voffB); PG8_STAGE(PG8_SB(0, 1), b2 + hstepB, voffB); PG8_STAGE(PG8_SA(0, 0), a2, voffA);
            PG8_WAIT_V(8); PG8_WAIT_L(0); PG8_BAR; PG8_MMA(1, 0, At, B0); PG8_MMA(1, 1, At, B1); PG8_BAR; PG8_SCHED;
            PG8_LDB(B0, 1, 0); PG8_LDB(B1, 1, 1); PG8_SCHED; PG8_LDA(At, 1, 0); PG8_STAGE(PG8_SA(0, 1), a2 + hstepA, voffA);
            PG8_WAIT_V(8); PG8_WAIT_L(0); PG8_BAR; PG8_MMA(0, 0, At, B0); PG8_MMA(0, 1, At, B1); PG8_BAR; PG8_SCHED;
            PG8_LDA(At, 1, 1); PG8_STAGE(PG8_SB(1, 0), b3, voffB); PG8_STAGE(PG8_SB(1, 1), b3 + hstepB, voffB); PG8_STAGE(PG8_SA(1, 0), a3, voffA);
            PG8_WAIT_V(8); PG8_WAIT_L(0); PG8_BAR; PG8_MMA(1, 0, At, B0); PG8_MMA(1, 1, At, B1); PG8_BAR; PG8_SCHED;
            } else {
            PG8_LDB(B0, 0, 0); PG8_SCHED; PG8_LDA(At, 0, 0); PG8_STAGE(PG8_SA(1, 1), a1 + hstepA, voffA);
            PG8_WAIT_L(8); PG8_BAR; PG8_WAIT_L(0); PG8_MMA(0, 0, At, B0); PG8_BAR; PG8_SCHED;
            PG8_LDB(B1, 0, 1); PG8_STAGE(PG8_SB(0, 0), b2, voffB);
            PG8_BAR; PG8_WAIT_L(0); PG8_MMA(0, 1, At, B1); PG8_BAR;
            PG8_LDA(At, 0, 1); PG8_STAGE(PG8_SA(0, 0), a2, voffA);
            PG8_BAR; PG8_WAIT_L(0); PG8_MMA(1, 0, At, B0); PG8_BAR; PG8_SCHED;
            PG8_STAGE(PG8_SB(0, 1), b2 + hstepB, voffB);
            PG8_WAIT_V(6); PG8_BAR; PG8_MMA(1, 1, At, B1); PG8_BAR;
            PG8_LDB(B0, 1, 0); PG8_SCHED; PG8_LDA(At, 1, 0); PG8_STAGE(PG8_SA(0, 1), a2 + hstepA, voffA);
            PG8_WAIT_L(8); PG8_BAR; PG8_WAIT_L(0); PG8_MMA(0, 0, At, B0); PG8_BAR; PG8_SCHED;
            PG8_LDB(B1, 1, 1); PG8_STAGE(PG8_SB(1, 0), b3, voffB);
            PG8_BAR; PG8_WAIT_L(0); PG8_MMA(0, 1, At, B1); PG8_BAR;
            PG8_LDA(At, 1, 1); PG8_STAGE(PG8_SA(1, 0), a3, voffA);
            PG8_BAR; PG8_WAIT_L(0); PG8_MMA(1, 0, At, B0); PG8_BAR; PG8_SCHED;
            PG8_STAGE(PG8_SB(1, 1), b3 + hstepB, voffB);
            PG8_WAIT_V(6); PG8_BAR; PG8_MMA(1, 1, At, B1); PG8_BAR;
            }
        }
        if constexpr (ALIGN_EPI) { if (wr == 0) PG8_BAR; }
        if constexpr (!Epi::AFTER_DRAIN) { E(acc, cur, wr, wc, fr, fq); S.done(cur); }
        if (!has_next) break;
#pragma unroll
        for (int a = 0; a < 2; ++a)
#pragma unroll
            for (int b = 0; b < 2; ++b)
#pragma unroll
                for (int m = 0; m < 4; ++m)
#pragma unroll
                    for (int n = 0; n < 2; ++n) acc[a][b][m][n] = (f32x4){0.f, 0.f, 0.f, 0.f};
        cur = nxt; cA = nA; cB = nB; ++ui;
        if constexpr (ALIGN_EPI) { if (wr == 1) PG8_BAR; }
    }
    PG8_WAIT_V(0);
    if constexpr (!ALIGN_EPI) { if (wr == 0) PG8_BAR; }
    PG8_BAR;
    if constexpr (Epi::AFTER_DRAIN) { E.fused(acc, cur, wr, wc, fr, fq, lds, wid, lane); S.done(cur); }
#undef PG8_SA
#undef PG8_SB
#undef PG8_STAGE
#undef PG8_LDA
#undef PG8_LDB
#undef PG8_MMA
#undef PG8_WAIT_V
#undef PG8_WAIT_L
#undef PG8_BAR
#undef PG8_SCHED
}
}

typedef unsigned short bf16_t;
typedef short bf16x8 __attribute__((ext_vector_type(8)));
typedef short s16x4 __attribute__((ext_vector_type(4)));
typedef float f32x4 __attribute__((ext_vector_type(4)));
typedef float f32x16 __attribute__((ext_vector_type(16)));
typedef unsigned u32x4 __attribute__((ext_vector_type(4)));
typedef unsigned u32x2 __attribute__((ext_vector_type(2)));
typedef float f32x2 __attribute__((ext_vector_type(2)));

constexpr int DM = 1024, NB = 8, SEQ = 2048, CTXL = 256, LT = SEQ + CTXL  , MROWS = NB * LT  ;
constexpr int EVEN_IN = 4608, ODD_IN = 5120, NCHUNK = LT / 64  ;
constexpr float RMS_EPS = 1e-6f, LOG2E = 1.4426950408889634f;
constexpr int LDS_BYTES = 160 * 1024;
constexpr int NPHASE = 22;

constexpr size_t WS_CTL = 0;
constexpr size_t WS_MOD = 65536;
constexpr size_t WS_ROPE = 524288;
constexpr size_t WS_AGG = 1048576;
constexpr size_t WS_HCTX = WS_AGG + 4718592;
constexpr size_t WS_WIN = WS_HCTX + 8388608;
constexpr size_t WS_WOUT = WS_WIN + 10485760;
constexpr size_t WS_WRG = WS_WOUT + 4194304;
constexpr size_t WS_OV = WS_WRG + 1048576;
constexpr size_t WS_P = WS_OV + 37748736;
constexpr size_t WS_END = WS_P + 188743680;
static_assert(WS_END <= 268435456, "workspace map exceeds 256 MiB");

struct Params {
    const float *x, *c, *ctx, *c_ctx, *ada_w, *ada_b, *norm_w, *ev_w_in, *ev_conv_w, *ev_conv_b, *ev_rg_wx, *ev_rg_bx, *ev_rg_wa, *ev_rg_ba,
        *ev_rg_lambda, *ev_sink, *ev_w_out, *od_w_in, *od_lb_raw, *od_gnorm_w, *od_w_out, *final_norm_w;
    float* out; unsigned char* ws; int ph_lo, ph_hi;
};

DI float bf2f(unsigned short v) { return __uint_as_float((unsigned)v << 16); }
DI unsigned f2bf(float f) { unsigned u = __float_as_uint(f); return (u + 0x7fffu + ((u >> 16) & 1u)) >> 16; }
typedef __bf16 bf16x2_hw __attribute__((ext_vector_type(2)));
DI unsigned pk2(float lo, float hi) { const f32x2 v = {lo, hi}; return __builtin_bit_cast(unsigned, __builtin_convertvector(v, bf16x2_hw)); }
DI float sigm(float x) { return __builtin_amdgcn_rcpf(1.f + __expf(-x)); }
DI float softplus_neg(float lam) {
    const float e = __expf(-lam);
    return e < 0.06f ? e * (1.f + e * (-0.5f + e * (0.33333333f + e * (-0.25f + e * 0.2f)))) : __logf(1.f + e);
}
DI float neg_expm1(float x) {
    return x > -0.25f ? -x * (1.f + x * (0.5f + x * (0.16666667f + x * (0.041666668f + x * (0.0083333338f + x * 0.0013888889f))))) : 1.f - __expf(x);
}
DI float wave_sum(float v) {
#pragma unroll
    for (int o = 1; o < 64; o <<= 1) v += shfl_xor_f(v, o);
    return v;
}
DI int crow(int reg, int h) { return (reg & 3) + 8 * (reg >> 2) + 4 * h; }
#define MFMA16(a, b, c) __builtin_amdgcn_mfma_f32_16x16x32_bf16((a), (b), (c), 0, 0, 0)
#define MFMA32(a, b, c) __builtin_amdgcn_mfma_f32_32x32x16_bf16((a), (b), (c), 0, 0, 0)

struct EpiStoreBf16 {
    static constexpr bool PERM = true, AFTER_DRAIN = false;
    bf16_t* O; int ldc;
    DI void operator()(const f32x4 (&acc)[2][2][4][2], const pg8::Unit& u, int wr, int wc, int fr, int fq) const {
        const int row0 = u.pm * 256 + wr * 64 + fr, col0 = u.pn * 256 + wc * 32 + 8 * fq;
#pragma unroll
        for (int ai = 0; ai < 2; ++ai)
#pragma unroll
            for (int m = 0; m < 4; ++m) { bf16_t* rowp = O + (size_t)(row0 + ai * 128 + m * 16) * ldc + col0;
#pragma unroll
                for (int bj = 0; bj < 2; ++bj) { const f32x4 v0 = acc[ai][bj][m][0], v1 = acc[ai][bj][m][1];
                    u32x4 w; w.x = pk2(v0[0], v0[1]); w.y = pk2(v0[2], v0[3]); w.z = pk2(v1[0], v1[1]); w.w = pk2(v1[2], v1[3]);
                    *(u32x4*)(rowp + bj * 128) = w; } }
    }
};
struct EpiResid {
    static constexpr bool PERM = false, AFTER_DRAIN = false;
    const float* in_lat; const float* in_ctx; float* out_lat; float* out_ctx; const float* gate;
    DI void operator()(const f32x4 (&acc)[2][2][4][2], const pg8::Unit& u, int wr, int wc, int fr, int fq) const {
        const int b = u.pm / 9, jt = u.pm % 9;
        const float* ib; float* ob; const float* g;
        if (jt == 0) { const size_t off = (size_t)b * CTXL * DM; ib = in_ctx + off; ob = out_ctx + off; g = gate + 8 * 3072; }
        else { const size_t off = ((size_t)b * SEQ + (size_t)(jt - 1) * 256) * DM; ib = in_lat + off; ob = out_lat + off; g = gate + b * 3072; }
        const int col0 = u.pn * 256 + wc * 32 + 4 * fq;
#pragma unroll
        for (int bj = 0; bj < 2; ++bj)
#pragma unroll
            for (int n = 0; n < 2; ++n) {
                const f32x4 gvv = *(const f32x4*)(g + col0 + bj * 128 + n * 16);
#pragma unroll
                for (int ai = 0; ai < 2; ++ai) {
#pragma unroll
                    for (int m = 0; m < 4; ++m) { const int r = ai * 128 + wr * 64 + m * 16 + fr;
                        const size_t off = (size_t)r * DM + col0 + bj * 128 + n * 16;
                        const f32x4 o = *(const f32x4*)(ib + off) + gvv * acc[ai][bj][m][n]; *(f32x4*)(ob + off) = o; }
                    asm volatile("" ::: "memory");
                }
            }
    }
};

DI void phase_pro(const Params& P, LAS unsigned char* lds, int wv) {
    const int tid = get_tid(wv);
    LAS float* s = (LAS float*)lds;
    LAS float* red = (LAS float*)(lds + 36864);
    float* mod = (float*)(P.ws + WS_MOD);
    for (int i = tid; i < 9 * 1024; i += 512) { const int r = i >> 10, k = i & 1023; const float v = r < 8 ? P.c[r * 1024 + k] : P.c_ctx[k]; s[i] = v * sigm(v); }
    __syncthreads();
    for (int item = get_bid(); item < 384; item += gridDim.x) {
        const int l = item / 96, n0 = (item % 96) * 32, ks = tid >> 5, col = tid & 31;
        const float* w = P.ada_w + (size_t)l * 1024 * 3072 + n0 + col;
        float acc[9];
#pragma unroll
        for (int r = 0; r < 9; ++r) acc[r] = 0.f;
#pragma unroll 8
        for (int kk = 0; kk < 64; ++kk) { const int k = ks * 64 + kk; const float wv = w[(size_t)k * 3072];
#pragma unroll
            for (int r = 0; r < 9; ++r) acc[r] += s[r * 1024 + k] * wv; }
#pragma unroll
        for (int r = 0; r < 9; ++r) red[(ks * 9 + r) * 32 + col] = acc[r];
        __syncthreads();
        if (tid < 288) { const int r = tid >> 5, cc = tid & 31; float sum = 0.f;
#pragma unroll
            for (int k2 = 0; k2 < 16; ++k2) sum += red[(k2 * 9 + r) * 32 + cc];
            mod[(l * 9 + r) * 3072 + n0 + cc] = sum + P.ada_b[l * 3072 + n0 + cc]; }
        __syncthreads();
    }
    float* cos_t = (float*)(P.ws + WS_ROPE); float* sin_t = cos_t + SEQ * 32;
    for (int i = get_bid() * 512 + tid; i < SEQ * 32; i += gridDim.x * 512) {
        const int pos = i >> 5, jj = i & 31, fi = jj & 15;
        const float inv = __builtin_amdgcn_exp2f(-(float)(2 * fi) * (13.287712379549449f / 32.f));
        const float ang = (float)(jj < 16 ? (pos >> 6) : (pos & 63)) * inv;
        cos_t[i] = __cosf(ang); sin_t[i] = __sinf(ang);
    }
}

template <bool FRAG = false>
DI void transpose_item(const float* W, int K, int N, bf16_t* WT, LAS float* scr, int item, int lane) {
    const int nblk = N / 32, kb = item / nblk, nb = item % nblk, k0 = 64 * kb, n0 = 32 * nb;
#pragma unroll 8
    for (int i = 0; i < 32; ++i) { const int kk = 2 * i + (lane >> 5); scr[kk * 33 + (lane & 31)] = W[(size_t)(k0 + kk) * N + n0 + (lane & 31)]; }
    asm volatile("s_waitcnt lgkmcnt(0)" ::: "memory");
    const int c = lane & 7;
#pragma unroll
    for (int j = 0; j < 4; ++j) { const int n = (lane >> 3) + 8 * j; const LAS float* sp = scr + (8 * c) * 33 + n;
        u32x4 o; o.x = pk2(sp[0 * 33], sp[1 * 33]); o.y = pk2(sp[2 * 33], sp[3 * 33]); o.z = pk2(sp[4 * 33], sp[5 * 33]); o.w = pk2(sp[6 * 33], sp[7 * 33]);
        if (FRAG) {
            const int nn = n0 + n, k8 = (k0 >> 3) + c;
            *(u32x4*)(WT + ((((nn >> 4) * 4 + (k8 >> 2)) * 64 + (k8 & 3) * 16 + (nn & 15)) * 8)) = o;
        } else *(u32x4*)(WT + (size_t)(n0 + n) * K + k0 + 8 * c) = o; }
    asm volatile("s_waitcnt lgkmcnt(0)" ::: "memory");
}

DI void phase_norm(const Params& P, LAS unsigned char* lds, int layer, int wv) {
    const int tid = get_tid(wv), lane = tid & 63, wave = tid >> 6;
    const int gw = get_bid() * 8 + wave, NGW = gridDim.x * 8;
    const int j = layer >> 1;
    LAS float* scr = (LAS float*)(lds + wave * 16384);
    bf16_t* WIN = (bf16_t*)(P.ws + WS_WIN); bf16_t* WOUT = (bf16_t*)(P.ws + WS_WOUT); bf16_t* WRG = (bf16_t*)(P.ws + WS_WRG);
    if ((layer & 1) == 0) {
        constexpr int I_IN = 16 * (EVEN_IN / 32), I_OUT = 32 * 32, I_RG = 32 * 8;
        for (int it = gw; it < I_IN + I_OUT + I_RG; it += NGW) {
            int r = it;
            if (r < I_IN) { transpose_item(P.ev_w_in + (size_t)j * 1024 * EVEN_IN, 1024, EVEN_IN, WIN, scr, r, lane); continue; } r -= I_IN;
            if (r < I_OUT) { transpose_item(P.ev_w_out + (size_t)j * 2048 * 1024, 2048, 1024, WOUT, scr, r, lane); continue; } r -= I_OUT;
            const int mat = r >> 3, sub = r & 7;
            const int dir = mat >> 4, gate = (mat >> 3) & 1, hd = mat & 7;
            const float* src = (gate == 0 ? P.ev_rg_wx : P.ev_rg_wa) + ((size_t)((j * 2 + dir) * 8 + hd)) * 16384;
            transpose_item<true>(src, 128, 128, WRG + (size_t)mat * 16384, scr, sub, lane);
        }
    } else {
        constexpr int I_IN = 16 * (ODD_IN / 32), I_OUT = 16 * 32;
        for (int it = gw; it < I_IN + I_OUT; it += NGW) {
            int r = it;
            if (r < I_IN) { transpose_item(P.od_w_in + (size_t)j * 1024 * ODD_IN, 1024, ODD_IN, WIN, scr, r, lane); continue; } r -= I_IN;
            transpose_item(P.od_w_out + (size_t)j * 1024 * 1024, 1024, 1024, WOUT, scr, r, lane);
        }
    }
    const float* hl = layer == 0 ? P.x : P.out; const float* hc = layer == 0 ? P.ctx : (const float*)(P.ws + WS_HCTX);
    const float* mod = (const float*)(P.ws + WS_MOD) + (size_t)layer * 9 * 3072;
    const float* nw = P.norm_w + layer * 1024;
    bf16_t* U = (bf16_t*)(P.ws + WS_OV);
    for (int R = gw; R < MROWS; R += NGW) {
        const int b = R / LT, jr = R % LT;
        const float* src = jr < CTXL ? hc + ((size_t)b * CTXL + jr) * DM : hl + ((size_t)b * SEQ + (jr - CTXL)) * DM;
        const float* sh = mod + (jr < CTXL ? 8 : b) * 3072; const float* sc = sh + 1024;
        f32x4 v[4]; float ss = 0.f;
#pragma unroll
        for (int q = 0; q < 4; ++q) { v[q] = *(const f32x4*)(src + 4 * lane + 256 * q); ss += (v[q][0] * v[q][0] + v[q][1] * v[q][1]) + (v[q][2] * v[q][2] + v[q][3] * v[q][3]); }
        const float rstd = rsqrtf(wave_sum(ss) * (1.f / DM) + RMS_EPS);
#pragma unroll
        for (int q = 0; q < 4; ++q) { const int k = 4 * lane + 256 * q;
            const f32x4 w4 = *(const f32x4*)(nw + k), s4 = *(const f32x4*)(sc + k), h4 = *(const f32x4*)(sh + k);
            const f32x4 y = (v[q] * rstd) * w4; const f32x4 o = y * (s4 + 1.f) + h4;
            u32x2 w; w.x = pk2(o[0], o[1]); w.y = pk2(o[2], o[3]); *(u32x2*)(U + (size_t)R * DM + k) = w; }
    }
}

typedef _Float16 f16x2_t __attribute__((ext_vector_type(2)));
DI unsigned pkh2(float a, float b) { const f16x2_t v = {(_Float16)a, (_Float16)b}; return __builtin_bit_cast(unsigned, v); }
DI void unpkh2(unsigned u, float& a, float& b) { const f16x2_t v = __builtin_bit_cast(f16x2_t, u); a = (float)v[0]; b = (float)v[1]; }
constexpr int RG_UT = 0, RG_AL = 17408, RG_BL = 50176, RG_HP = 82944, RG_QA = 148480, RG_CAR = 152576, RG_FLAG = 153600, RG_END = 153664;
static_assert(RG_END <= LDS_BYTES - 256, "RG-LRU LDS map");
constexpr int CW_RG = 8192;
DI void rglru_item(const Params& P, LAS unsigned char* lds, int j, int item, int wv) {
    const int tid = get_tid(wv), lane = tid & 63, wave = tid >> 6, r = lane & 15, g = lane >> 4;
    const int grp = item / NCHUNK, ci = item % NCHUNK, b = grp >> 3, hd = grp & 7;
    bf16_t* p = (bf16_t*)(P.ws + WS_P);
    const bf16_t* WRG = (const bf16_t*)(P.ws + WS_WRG);
    unsigned long long* AGG = (unsigned long long*)(P.ws + WS_AGG);
    unsigned* cnt = (unsigned*)(P.ws + WS_CTL) + CW_RG + (j * 64 + grp) * 16;
    const int R0 = b * LT + ci * 64;
    const int seg_lo = b * LT + (ci < 4 ? 0 : CTXL), seg_hi = b * LT + (ci < 4 ? CTXL : LT);
    LAS bf16_t* UT = (LAS bf16_t*)(lds + RG_UT);
    LAS float* AL = (LAS float*)(lds + RG_AL);
    LAS float* BL = (LAS float*)(lds + RG_BL);
    LAS unsigned* HP = (LAS unsigned*)(lds + RG_HP);
    LAS float* QA = (LAS float*)(lds + RG_QA);
    LAS float* CAR = (LAS float*)(lds + RG_CAR);
    TP_START(10, lds, tid); TP_START(11, lds, tid);
    bf16x8 wfr[2][2][4];
    float prm[2][3];
#pragma unroll
    for (int dir = 0; dir < 2; ++dir) {
#pragma unroll
        for (int gt = 0; gt < 2; ++gt) {
            const bf16_t* W = WRG + (size_t)((dir * 2 + gt) * 8 + hd) * 16384 + (wave * 4 * 64 + lane) * 8;
#pragma unroll
            for (int ks = 0; ks < 4; ++ks) wfr[dir][gt][ks] = *(const bf16x8*)(W + ks * 512);
        }
        const int idx = (j * 2 + dir) * 1024 + hd * 128 + 16 * wave + r;
        prm[dir][0] = P.ev_rg_bx[idx]; prm[dir][1] = P.ev_rg_ba[idx]; prm[dir][2] = P.ev_rg_lambda[idx];
    }
    {
        LAS bf16_t* XT = (LAS bf16_t*)(lds + RG_HP);
#pragma unroll
        for (int rep = 0; rep < 3; ++rep) {
            const int idx = tid + rep * 512, tr = idx >> 4, c0 = (idx & 15) * 8;
            if (idx < 67 * 16) {
                const int Rg = R0 + tr - 1;
                u32x4 xv = {0u, 0u, 0u, 0u};
                if (Rg >= seg_lo && Rg < seg_hi) xv = *(const u32x4*)(p + (size_t)Rg * EVEN_IN + hd * 128 + c0);
                *(LAS u32x4*)(XT + tr * 128 + c0) = xv;
            }
        }
        const int c0 = (tid & 15) * 8, cg0 = hd * 128 + c0;
        float wv4[4][8], bias[8];
        { const f32x4 b0 = *(const f32x4*)(P.ev_conv_b + j * 1024 + cg0), b1 = *(const f32x4*)(P.ev_conv_b + j * 1024 + cg0 + 4);
          bias[0] = b0[0]; bias[1] = b0[1]; bias[2] = b0[2]; bias[3] = b0[3]; bias[4] = b1[0]; bias[5] = b1[1]; bias[6] = b1[2]; bias[7] = b1[3]; }
#pragma unroll
        for (int k = 0; k < 4; ++k) { const float* wk = P.ev_conv_w + (size_t)(j * 4 + k) * 1024 + cg0; const f32x4 w0 = *(const f32x4*)wk, w1 = *(const f32x4*)(wk + 4);
            wv4[k][0] = w0[0]; wv4[k][1] = w0[1]; wv4[k][2] = w0[2]; wv4[k][3] = w0[3]; wv4[k][4] = w1[0]; wv4[k][5] = w1[1]; wv4[k][6] = w1[2]; wv4[k][7] = w1[3]; }
        __syncthreads();
#pragma unroll
        for (int rep = 0; rep < 2; ++rep) {
            const int t = (tid >> 4) + rep * 32;
            float acc[8];
#pragma unroll
            for (int e = 0; e < 8; ++e) acc[e] = bias[e];
#pragma unroll
            for (int k = 0; k < 4; ++k) {
                const u32x4 xv = *(const LAS u32x4*)(XT + (t + k) * 128 + c0);
                acc[0] += wv4[k][0] * __uint_as_float(xv.x << 16); acc[1] += wv4[k][1] * __uint_as_float(xv.x & 0xffff0000u);
                acc[2] += wv4[k][2] * __uint_as_float(xv.y << 16); acc[3] += wv4[k][3] * __uint_as_float(xv.y & 0xffff0000u);
                acc[4] += wv4[k][4] * __uint_as_float(xv.z << 16); acc[5] += wv4[k][5] * __uint_as_float(xv.z & 0xffff0000u);
                acc[6] += wv4[k][6] * __uint_as_float(xv.w << 16); acc[7] += wv4[k][7] * __uint_as_float(xv.w & 0xffff0000u);
            }
            u32x4 o; o.x = pk2(acc[0], acc[1]); o.y = pk2(acc[2], acc[3]); o.z = pk2(acc[4], acc[5]); o.w = pk2(acc[6], acc[7]);
            *(LAS u32x4*)(UT + t * 136 + c0) = o;
        }
    }
    __syncthreads();
    TP_STOP(11, lds, tid);
#pragma unroll
    for (int dir = 0; dir < 2; ++dir) {
        TP_START(12, lds, tid); TP_START(16, lds, tid);
        f32x4 ax[4], aa[4];
#pragma unroll
        for (int m = 0; m < 4; ++m) { ax[m] = (f32x4){0.f, 0.f, 0.f, 0.f}; aa[m] = (f32x4){0.f, 0.f, 0.f, 0.f}; }
#pragma unroll
        for (int ks = 0; ks < 4; ++ks) {
#pragma unroll
            for (int m = 0; m < 4; ++m) {
                const bf16x8 a = *(const LAS bf16x8*)(UT + (16 * m + r) * 136 + 32 * ks + 8 * g);
                ax[m] = MFMA16(a, wfr[dir][0][ks], ax[m]); aa[m] = MFMA16(a, wfr[dir][1][ks], aa[m]);
            }
        }
        asm volatile("" :: "v"(ax[0]), "v"(ax[1]), "v"(ax[2]), "v"(ax[3]), "v"(aa[0]), "v"(aa[1]), "v"(aa[2]), "v"(aa[3]));
        TP_STOP(16, lds, tid); TP_START(17, lds, tid);
        {
            const int c = 16 * wave + r;
            const float bxv = prm[dir][0], bav = prm[dir][1], lam = prm[dir][2];
            const float sp = softplus_neg(lam);
#pragma unroll
            for (int m = 0; m < 4; ++m)
#pragma unroll
                for (int i = 0; i < 4; ++i) {
                    const int t = 16 * m + 4 * g + i;
                    const float gx = sigm(ax[m][i] + bxv), ga = sigm(aa[m][i] + bav);
                    const float la = -8.f * ga * sp;
                    const float a = __expf(la), mult = __builtin_amdgcn_sqrtf(neg_expm1(2.f * la));
                    const float uv = bf2f(UT[t * 136 + c]);
                    AL[t * 128 + c] = a; BL[t * 128 + c] = mult * gx * uv;
                }
        }
        asm volatile("s_waitcnt lgkmcnt(0)" ::: "memory");
        TP_STOP(17, lds, tid); TP_START(18, lds, tid);
        __syncthreads();
        TP_STOP(18, lds, tid);
        TP_STOP(12, lds, tid); TP_START(13, lds, tid);
        {
            const int c = tid & 127, q = tid >> 7;
            float A = 1.f, B = 0.f;
#pragma unroll
            for (int s = 0; s < 16; ++s) { const int t = dir == 0 ? 16 * q + s : 16 * q + 15 - s; const float a = AL[t * 128 + c], bb = BL[t * 128 + c]; B = a * B + bb; A *= a; }
            QA[(q * 128 + c) * 2] = A; QA[(q * 128 + c) * 2 + 1] = B;
            __syncthreads();
            float h = 0.f, pc = 1.f;
            const int nprev = dir == 0 ? q : 3 - q;
            for (int qq = 0; qq < nprev; ++qq) { const int qi = dir == 0 ? qq : 3 - qq; const float a = QA[(qi * 128 + c) * 2]; h = a * h + QA[(qi * 128 + c) * 2 + 1]; pc *= a; }
#pragma unroll
            for (int s = 0; s < 16; ++s) { const int t = dir == 0 ? 16 * q + s : 16 * q + 15 - s; const float a = AL[t * 128 + c]; h = a * h + BL[t * 128 + c]; pc *= a;
                HP[(dir * 64 + t) * 128 + c] = pkh2(h, pc); }
            if (nprev == 3) {
                const unsigned long long v = ((unsigned long long)__float_as_uint(h) << 32) | __float_as_uint(pc);
                __hip_atomic_store(AGG + ((size_t)(dir * NB + b) * NCHUNK + ci) * 1024 + hd * 128 + c, v, __ATOMIC_RELAXED, __HIP_MEMORY_SCOPE_AGENT);
            }
        }
        __syncthreads();
        TP_STOP(13, lds, tid);
    }
    TP_START(14, lds, tid);
    u32x4 gpre[2];
#pragma unroll
    for (int rep = 0; rep < 2; ++rep) { const int idx = tid + rep * 512; gpre[rep] = *(const u32x4*)(p + (size_t)(R0 + (idx >> 4)) * EVEN_IN + 1536 + hd * 128 + (idx & 15) * 8); }
    asm volatile("s_waitcnt vmcnt(0)" ::: "memory");
    __syncthreads();
    if (tid == 0) {
        __hip_atomic_fetch_add(cnt, 1u, __ATOMIC_RELAXED, __HIP_MEMORY_SCOPE_AGENT);
        unsigned spins = 0;
        while (__hip_atomic_load(cnt, __ATOMIC_RELAXED, __HIP_MEMORY_SCOPE_AGENT) < (unsigned)NCHUNK) { __builtin_amdgcn_s_sleep(2); if (++spins > (1u << 22)) break; }
    }
    __syncthreads();
    TP_STOP(14, lds, tid); TP_START(15, lds, tid);
    if (tid < 256) {
        const int dir = tid >> 7, c = tid & 127;
        const int pos = dir == 0 ? ci : (ci < 4 ? 3 - ci : 39 - ci);
        float h = 0.f;
        const unsigned long long* ag = AGG + (size_t)(dir * NB + b) * NCHUNK * 1024 + hd * 128 + c;
#pragma unroll 1
        for (int base = 0; base < pos; base += 9) {
            unsigned long long v[9];
#pragma unroll
            for (int k = 0; k < 9; ++k) { const int pp = base + k < pos ? base + k : pos - 1; const int cc = dir == 0 ? pp : (pp < 4 ? 3 - pp : 39 - pp);
                v[k] = __hip_atomic_load(ag + (size_t)cc * 1024, __ATOMIC_RELAXED, __HIP_MEMORY_SCOPE_AGENT); }
#pragma unroll
            for (int k = 0; k < 9; ++k) if (base + k < pos) h = __uint_as_float((unsigned)v[k]) * h + __uint_as_float((unsigned)(v[k] >> 32));
        }
        CAR[dir * 128 + c] = h;
    }
    __syncthreads();
#pragma unroll
    for (int rep = 0; rep < 2; ++rep) {
        const int idx = tid + rep * 512, t = idx >> 4, c0 = (idx & 15) * 8;
        bf16_t* gp = p + (size_t)(R0 + t) * EVEN_IN + 1536 + hd * 128 + c0;
        const u32x4 gv = gpre[rep];
        float y[8];
#pragma unroll
        for (int e = 0; e < 8; ++e) {
            float h0, p0, h1, p1; unpkh2(HP[t * 128 + c0 + e], h0, p0); unpkh2(HP[(64 + t) * 128 + c0 + e], h1, p1);
            y[e] = (h0 + p0 * CAR[c0 + e]) + (h1 + p1 * CAR[128 + c0 + e]);
        }
        const float gg[8] = {__uint_as_float(gv.x << 16), __uint_as_float(gv.x & 0xffff0000u), __uint_as_float(gv.y << 16), __uint_as_float(gv.y & 0xffff0000u),
                             __uint_as_float(gv.z << 16), __uint_as_float(gv.z & 0xffff0000u), __uint_as_float(gv.w << 16), __uint_as_float(gv.w & 0xffff0000u)};
        u32x4 o;
        o.x = pk2(y[0] * gg[0] * sigm(gg[0]), y[1] * gg[1] * sigm(gg[1])); o.y = pk2(y[2] * gg[2] * sigm(gg[2]), y[3] * gg[3] * sigm(gg[3]));
        o.z = pk2(y[4] * gg[4] * sigm(gg[4]), y[5] * gg[5] * sigm(gg[5])); o.w = pk2(y[6] * gg[6] * sigm(gg[6]), y[7] * gg[7] * sigm(gg[7]));
        *(u32x4*)gp = o;
    }
    __syncthreads();
    TP_STOP(15, lds, tid); TP_STOP(10, lds, tid);
}

DI void rope8v(u32x4& v, const f32x4 cs, const f32x4 sn) {
    unsigned* w = (unsigned*)&v;
#pragma unroll
    for (int i = 0; i < 4; ++i) { const float t1 = __uint_as_float(w[i] << 16), t2 = __uint_as_float(w[i] & 0xffff0000u); w[i] = pk2(t1 * cs[i] - t2 * sn[i], t1 * sn[i] + t2 * cs[i]); }
}
DI void rope8(u32x4& v, const float* cs, const float* sn) { rope8v(v, *(const f32x4*)cs, *(const f32x4*)sn); }
typedef short v4i16_a __attribute__((ext_vector_type(4)));
DI void attn_item(const Params& P, LAS unsigned char* lds, int j, int item, int wv) {
    const int tid = get_tid(wv), lane = tid & 63, wave = tid >> 6, r = lane & 31, h = lane >> 5;
    const bool is_lat = item < 512;
    int b, qb, kvh;
    if (is_lat) { b = item >> 6; qb = (item >> 2) & 15; kvh = item & 3; } else { const int it = item - 512; b = it >> 3; qb = (it >> 2) & 1; kvh = it & 3; }
    bf16_t* p = (bf16_t*)(P.ws + WS_P);
    const float* cos_t = (const float*)(P.ws + WS_ROPE); const float* sin_t = cos_t + SEQ * 32;
    LAS unsigned char* QL = lds + 36864 + wave * 9216;
    TP_START(1, lds, tid);
    const int hq = 4 * kvh + (wave >> 1), ql0 = qb * 128 + 64 * (wave & 1);
    const size_t rowbase = (size_t)b * LT + (is_lat ? CTXL : 0);
#pragma unroll
    for (int qt = 0; qt < 2; ++qt) {
        const int qi = ql0 + 32 * qt + r;
        const bf16_t* qp = p + (rowbase + qi) * EVEN_IN + 2560 + hq * 64 + 8 * h;
#pragma unroll
        for (int ks = 0; ks < 4; ++ks) {
            u32x4 v = *(const u32x4*)(qp + 16 * ks);
            if (is_lat) rope8(v, cos_t + qi * 32 + 8 * ks + 4 * h, sin_t + qi * 32 + 8 * ks + 4 * h);
            *(LAS u32x4*)(QL + (32 * qt + r) * 144 + (16 * ks + 8 * h) * 2) = v;
        }
    }
    const float sink2 = P.ev_sink[j * 16 + hq] * LOG2E;
    float mrun[2] = {sink2, sink2}, lrun[2] = {h == 0 ? 1.f : 0.f, h == 0 ? 1.f : 0.f};
    f32x16 O[2][2];
#pragma unroll
    for (int a = 0; a < 2; ++a)
#pragma unroll
        for (int c = 0; c < 2; ++c)
#pragma unroll
            for (int i = 0; i < 16; ++i) O[a][c][i] = 0.f;
    const int w_lo = (is_lat && qb == 0) ? 2 : 0, w_hi = (is_lat && qb == 15) ? 3 : 5;
    const int nT = is_lat ? 4 + (w_hi - w_lo + 1) : 4;
    const float SC = 0.125f * LOG2E, NEG = -1e30f;
    const int key = tid >> 3, chn = tid & 7;
    u32x4 kreg, vreg; f32x4 creg, sreg;
#define ATT_K0(t) ((t) < 4 ? 64 * (t) : qb * 128 - 128 + 64 * (w_lo + (t) - 4))
#define ATT_LOAD(t) do { const bool win_ = (t) >= 4; const int k0_ = ATT_K0(t); \
        const bf16_t* kp_ = p + ((size_t)b * LT + (win_ ? CTXL : 0) + k0_ + key) * EVEN_IN + 1024 + kvh * 64 + 8 * chn; \
        kreg = *(const u32x4*)kp_; vreg = *(const u32x4*)(kp_ + 256); \
        if (win_) { creg = *(const f32x4*)(cos_t + (k0_ + key) * 32 + 4 * chn); sreg = *(const f32x4*)(sin_t + (k0_ + key) * 32 + 4 * chn); } } while (0)
#define ATT_STORE(t, buf) do { const bool win_ = (t) >= 4; \
        if (win_) rope8v(kreg, creg, sreg); \
        *(LAS u32x4*)(lds + (buf) * 18432 + key * 144 + chn * 16) = kreg; *(LAS u32x4*)(lds + (buf) * 18432 + 9216 + key * 144 + chn * 16) = vreg; } while (0)
    TP_START(2, lds, tid);
    ATT_LOAD(0); ATT_STORE(0, 0);
    if (nT > 1) ATT_LOAD(1);
#pragma unroll 1
    for (int t = 0; t < nT; ++t) {
        TP_START(4, lds, tid);
        __syncthreads();
        TP_STOP(4, lds, tid);
        if (t + 1 < nT) { ATT_STORE(t + 1, (t + 1) & 1); if (t + 2 < nT) ATT_LOAD(t + 2); }
        TP_START(3, lds, tid);
        const bool win = t >= 4;
        const int k0 = ATT_K0(t);
        const int dq = k0 - ql0;
        if (win && (dq >= 192 || dq <= -192)) continue;
        const bool need_mask = win && (dq >= 128 || dq <= -128);
        const LAS unsigned char* KL = lds + (t & 1) * 18432;
        const LAS bf16_t* VL = (const LAS bf16_t*)(lds + (t & 1) * 18432 + 9216);
#pragma unroll
        for (int qt = 0; qt < 2; ++qt) {
            f32x16 s0, s1;
#pragma unroll
            for (int i = 0; i < 16; ++i) { s0[i] = 0.f; s1[i] = 0.f; }
#pragma unroll
            for (int ks = 0; ks < 4; ++ks) {
                const bf16x8 qfr = *(const LAS bf16x8*)(QL + (32 * qt + r) * 144 + (16 * ks + 8 * h) * 2);
                const bf16x8 k0f = *(const LAS bf16x8*)(KL + r * 144 + (16 * ks + 8 * h) * 2), k1f = *(const LAS bf16x8*)(KL + (32 + r) * 144 + (16 * ks + 8 * h) * 2);
                s0 = MFMA32(k0f, qfr, s0); s1 = MFMA32(k1f, qfr, s1);
            }
            const int qpos = ql0 + 32 * qt + r;
            float mx = NEG;
            if (need_mask) {
#pragma unroll
                for (int i = 0; i < 16; ++i) {
                    const int d0 = qpos - (k0 + crow(i, h)), d1 = d0 - 32;
                    float v0 = s0[i] * SC, v1 = s1[i] * SC;
                    if (d0 > 128 || d0 < -128) v0 = NEG;
                    if (d1 > 128 || d1 < -128) v1 = NEG;
                    s0[i] = v0; s1[i] = v1; mx = fmaxf(mx, fmaxf(v0, v1));
                }
            } else {
#pragma unroll
                for (int i = 0; i < 16; ++i) { s0[i] *= SC; s1[i] *= SC; mx = fmaxf(mx, fmaxf(s0[i], s1[i])); }
            }
            mx = fmaxf(mx, shfl_xor_f(mx, 32));
            const float mn = fmaxf(mrun[qt], mx), alpha = __builtin_amdgcn_exp2f(mrun[qt] - mn);
            mrun[qt] = mn;
            float ls = 0.f;
#pragma unroll
            for (int i = 0; i < 16; ++i) { s0[i] = __builtin_amdgcn_exp2f(s0[i] - mn); s1[i] = __builtin_amdgcn_exp2f(s1[i] - mn); ls += s0[i] + s1[i]; }
            lrun[qt] = lrun[qt] * alpha + ls;
#pragma unroll
            for (int dt = 0; dt < 2; ++dt)
#pragma unroll
                for (int i = 0; i < 16; ++i) O[dt][qt][i] *= alpha;
            bf16x8 pf[2][2];
#pragma unroll
            for (int s = 0; s < 2; ++s) {
                u32x4 a, c;
                a.x = pk2(s0[8 * s + 0], s0[8 * s + 1]); a.y = pk2(s0[8 * s + 2], s0[8 * s + 3]); a.z = pk2(s0[8 * s + 4], s0[8 * s + 5]); a.w = pk2(s0[8 * s + 6], s0[8 * s + 7]);
                c.x = pk2(s1[8 * s + 0], s1[8 * s + 1]); c.y = pk2(s1[8 * s + 2], s1[8 * s + 3]); c.z = pk2(s1[8 * s + 4], s1[8 * s + 5]); c.w = pk2(s1[8 * s + 6], s1[8 * s + 7]);
                pf[0][s] = __builtin_bit_cast(bf16x8, a); pf[1][s] = __builtin_bit_cast(bf16x8, c);
            }
            const int gq = (lane >> 4) & 1, qq4 = (lane & 15) >> 2, pp4 = lane & 3;
#pragma unroll
            for (int dt = 0; dt < 2; ++dt)
#pragma unroll
                for (int kt = 0; kt < 2; ++kt)
#pragma unroll
                    for (int s = 0; s < 2; ++s) {
                        const LAS bf16_t* vp = VL + (32 * kt + 16 * s + 4 * h + qq4) * 72 + 32 * dt + 16 * gq + 4 * pp4;
                        const v4i16_a lo = __builtin_amdgcn_ds_read_tr16_b64_v4i16((LAS v4i16_a*)vp);
                        const v4i16_a hi = __builtin_amdgcn_ds_read_tr16_b64_v4i16((LAS v4i16_a*)(vp + 8 * 72));
                        const bf16x8 vf = {lo[0], lo[1], lo[2], lo[3], hi[0], hi[1], hi[2], hi[3]};
                        O[dt][qt] = MFMA32(vf, pf[kt][s], O[dt][qt]);
                    }
            __builtin_amdgcn_sched_barrier(0);
        }
        TP_STOP(3, lds, tid);
    }
    TP_STOP(2, lds, tid);
#undef ATT_K0
#undef ATT_LOAD
#undef ATT_STORE
#pragma unroll
    for (int qt = 0; qt < 2; ++qt) {
        const float lt = lrun[qt] + shfl_xor_f(lrun[qt], 32), inv = __builtin_amdgcn_rcpf(lt);
        const int qi = ql0 + 32 * qt + r;
        bf16_t* rowp = p + (rowbase + qi) * EVEN_IN;
#pragma unroll
        for (int dt = 0; dt < 2; ++dt)
#pragma unroll
            for (int i4 = 0; i4 < 4; ++i4) {
                const int d0 = 32 * dt + 8 * i4 + 4 * h;
                const u32x2 gv = *(const u32x2*)(rowp + 3584 + hq * 64 + d0);
                const float g0 = __uint_as_float(gv.x << 16), g1 = __uint_as_float(gv.x & 0xffff0000u), g2 = __uint_as_float(gv.y << 16), g3 = __uint_as_float(gv.y & 0xffff0000u);
                u32x2 o;
                o.x = pk2(O[dt][qt][4 * i4 + 0] * inv * g0 * sigm(g0), O[dt][qt][4 * i4 + 1] * inv * g1 * sigm(g1));
                o.y = pk2(O[dt][qt][4 * i4 + 2] * inv * g2 * sigm(g2), O[dt][qt][4 * i4 + 3] * inv * g3 * sigm(g3));
                *(u32x2*)(rowp + 2560 + hq * 64 + d0) = o;
            }
    }
    __syncthreads();
    TP_STOP(1, lds, tid);
}

constexpr int G2_QX = 0, G2_KF = 17408, G2_K2 = 60928, G2_VS = 79360, G2_AM = 96768, G2_ST = 105984, G2_PS = 140800, G2_BL = 144896, G2_Q1 = 145408, G2_END = 162816;
static_assert(G2_END <= LDS_BYTES - 256, "GLA LDS map");
typedef short v4i16_t __attribute__((ext_vector_type(4)));
DI bf16x8 frag_tr(const LAS bf16_t* M, int stride, int k0, int n0, int lane) {
    const int i = lane & 15, g = lane >> 4, q = i >> 2, pp = i & 3;
    const LAS bf16_t* a0 = M + (k0 + 8 * g + q) * stride + n0 + 4 * pp;
    const v4i16_t lo = __builtin_amdgcn_ds_read_tr16_b64_v4i16((LAS v4i16_t*)a0);
    const v4i16_t hi = __builtin_amdgcn_ds_read_tr16_b64_v4i16((LAS v4i16_t*)(a0 + 4 * stride));
    return (bf16x8){lo[0], lo[1], lo[2], lo[3], hi[0], hi[1], hi[2], hi[3]};
}

template <int DIR>
DI void gla2_item(const Params& P, LAS unsigned char* lds, int layer_j, int b, int hd, int wv) {
    const int tid = get_tid(wv), lane = tid & 63, wave = tid >> 6, r = lane & 15, g = lane >> 4;
    bf16_t* p = (bf16_t*)(P.ws + WS_P);
    LAS bf16_t* QX = (LAS bf16_t*)(lds + G2_QX); LAS bf16_t* KF = (LAS bf16_t*)(lds + G2_KF); LAS bf16_t* K2 = (LAS bf16_t*)(lds + G2_K2);
    LAS bf16_t* VS = (LAS bf16_t*)(lds + G2_VS); LAS bf16_t* AM = (LAS bf16_t*)(lds + G2_AM); LAS bf16_t* ST = (LAS bf16_t*)(lds + G2_ST);
    LAS float* PS8 = (LAS float*)(lds + G2_PS); LAS float* BLAST = (LAS float*)(lds + G2_BL); LAS bf16_t* Q1 = (LAS bf16_t*)(lds + G2_Q1);
    const int d0 = 2 * lane, tg = wave, I = tg >> 1, half = tg & 1;
    float lbv[2] = {0.f, 0.f};
    if (layer_j > 0) { lbv[0] = sigm(P.od_lb_raw[1024 + hd * 128 + d0] - P.od_lb_raw[hd * 128 + d0]); lbv[1] = sigm(P.od_lb_raw[1024 + hd * 128 + d0 + 1] - P.od_lb_raw[hd * 128 + d0 + 1]); }
    TP_START(20, lds, tid);
    for (int i = tid; i < (9216 + 34816) / 4; i += 512) ((LAS unsigned*)(lds + G2_AM))[i] = 0u;
    f32x4 st[8];
#pragma unroll
    for (int e = 0; e < 8; ++e) st[e] = (f32x4){0.f, 0.f, 0.f, 0.f};
    unsigned zn[8], qn[8]; u32x4 vn[2];
#define G2_OFFZ(s) ((unsigned)((DIR == 0 ? 8 * tg + (s) : 63 - 8 * tg - (s)) * ODD_IN + d0) * 2u)
#define G2_OFFV(rep) ((unsigned)((DIR == 0 ? ((tid + (rep) * 512) >> 4) : 63 - ((tid + (rep) * 512) >> 4)) * ODD_IN + 8 * ((tid + (rep) * 512) & 15)) * 2u)
    const size_t colz = (size_t)DIR * 1024 + hd * 128, colq = 3072 + hd * 128, colv = 2048 + hd * 128;
    {
        const int chunk = DIR == 0 ? 0 : 3;
        const char* slab = (const char*)(p + ((size_t)b * LT + (size_t)chunk * 64) * ODD_IN);
#pragma unroll
        for (int s = 0; s < 8; ++s) { zn[s] = *(const unsigned*)(slab + colz * 2 + G2_OFFZ(s)); qn[s] = *(const unsigned*)(slab + colq * 2 + G2_OFFZ(s)); }
#pragma unroll
        for (int rep = 0; rep < 2; ++rep) vn[rep] = *(const u32x4*)(slab + colv * 2 + G2_OFFV(rep));
    }
    __syncthreads();
#pragma unroll 1
    for (int step = 0; step < NCHUNK; ++step) {
        const int chunk = DIR == 0 ? step : (step < 4 ? 3 - step : 39 - step);
        const size_t Rc0 = (size_t)b * LT + (size_t)chunk * 64;
        unsigned zc[8], qc[8]; u32x4 vc[2];
#pragma unroll
        for (int s = 0; s < 8; ++s) { zc[s] = zn[s]; qc[s] = qn[s]; }
        vc[0] = vn[0]; vc[1] = vn[1];
        TP_START(21, lds, tid);
        float el[8][2], kk[8][2], qq[8][2];
        {
            float run0 = 1.f, run1 = 1.f;
#pragma unroll
            for (int s = 0; s < 8; ++s) {
                const float z0 = __uint_as_float(zc[s] << 16), z1 = __uint_as_float(zc[s] & 0xffff0000u);
                const float t0 = __expf(-z0), t1 = __expf(-z1), sg0 = __builtin_amdgcn_rcpf(1.f + t0), sg1 = __builtin_amdgcn_rcpf(1.f + t1);
                const float f0 = fmaxf(lbv[0] + (1.f - lbv[0]) * sg0, 1e-30f), f1 = fmaxf(lbv[1] + (1.f - lbv[1]) * sg1, 1e-30f);
                kk[s][0] = (1.f - lbv[0]) * (t0 * sg0); kk[s][1] = (1.f - lbv[1]) * (t1 * sg1);
                run0 = fmaxf(run0 * f0, 1e-35f); run1 = fmaxf(run1 * f1, 1e-35f); el[s][0] = run0; el[s][1] = run1;
                const float q0 = __uint_as_float(qc[s] << 16), q1 = __uint_as_float(qc[s] & 0xffff0000u);
                qq[s][0] = q0 * __builtin_amdgcn_rcpf(1.f + __expf(-q0)); qq[s][1] = q1 * __builtin_amdgcn_rcpf(1.f + __expf(-q1));
                if ((s & 1) == 1) __builtin_amdgcn_sched_barrier(0);
            }
            *(LAS f32x2*)(PS8 + tg * 128 + d0) = (f32x2){run0, run1};
#pragma unroll
            for (int rep = 0; rep < 2; ++rep) { const int idx = tid + rep * 512, tau = idx >> 4, chn = idx & 15; *(LAS u32x4*)(VS + tau * 136 + 8 * chn) = vc[rep]; }
        }
        __syncthreads();
        TP_STOP(21, lds, tid); TP_START(22, lds, tid);
        float RI[2];
        {
            float T[8][2];
#pragma unroll
            for (int q8 = 0; q8 < 8; ++q8) { const f32x2 t = *(const LAS f32x2*)(PS8 + q8 * 128 + d0); T[q8][0] = t[0]; T[q8][1] = t[1]; }
            float pre[2], fac[4][2], f4[2];
#pragma unroll
            for (int x = 0; x < 2; ++x) {
                const float P0 = T[0][x] * T[1][x], P1 = T[2][x] * T[3][x], P2 = T[4][x] * T[5][x], P3 = T[6][x] * T[7][x];
                pre[x] = half ? (I == 0 ? T[0][x] : (I == 1 ? T[2][x] : (I == 2 ? T[4][x] : T[6][x]))) : 1.f;
                RI[x] = I == 0 ? 1.f : (I == 1 ? P0 : (I == 2 ? P0 * P1 : P0 * P1 * P2));
                float cur = 1.f;
                fac[0][x] = cur; if (I <= 0) cur *= P0;
                fac[1][x] = cur; if (I <= 1) cur *= P1;
                fac[2][x] = cur; if (I <= 2) cur *= P2;
                fac[3][x] = cur; cur *= P3;
                f4[x] = cur;
                if (tg == 0) BLAST[d0 + x] = P0 * P1 * P2 * P3;
            }
            unsigned w0[4], w1[4];
#pragma unroll
            for (int s = 0; s < 8; ++s) {
                const int tau = 8 * tg + s;
                const float e00 = fmaxf(pre[0] * el[s][0], 1e-35f), e01 = fmaxf(pre[1] * el[s][1], 1e-35f);
                const float qi0 = qq[s][0] * e00, qi1 = qq[s][1] * e01;
                const float kd0 = kk[s][0] * __builtin_amdgcn_rcpf(e00), kd1 = kk[s][1] * __builtin_amdgcn_rcpf(e01);
                *(LAS unsigned*)(QX + tau * 136 + d0) = pk2(qi0, qi1);
                *(LAS unsigned*)(Q1 + tau * 136 + d0) = pk2(qi0 * RI[0], qi1 * RI[1]);
                if (I <= 0) *(LAS unsigned*)(KF + (0 + tau) * 136 + d0) = pk2(kd0 * fac[0][0], kd1 * fac[0][1]);
                if (I <= 1) *(LAS unsigned*)(KF + (16 + tau) * 136 + d0) = pk2(kd0 * fac[1][0], kd1 * fac[1][1]);
                if (I <= 2) *(LAS unsigned*)(KF + (48 + tau) * 136 + d0) = pk2(kd0 * fac[2][0], kd1 * fac[2][1]);
                *(LAS unsigned*)(KF + (96 + tau) * 136 + d0) = pk2(kd0 * fac[3][0], kd1 * fac[3][1]);
                const unsigned h0 = f2bf(kd0 * f4[0]), h1 = f2bf(kd1 * f4[1]);
                if (s & 1) { w0[s >> 1] |= h0 << 16; w1[s >> 1] |= h1 << 16; } else { w0[s >> 1] = h0; w1[s >> 1] = h1; }
                if ((s & 1) == 1) __builtin_amdgcn_sched_barrier(0);
            }
            *(LAS u32x4*)(K2 + (d0 + 0) * 72 + 8 * tg) = (u32x4){w0[0], w0[1], w0[2], w0[3]};
            *(LAS u32x4*)(K2 + (d0 + 1) * 72 + 8 * tg) = (u32x4){w1[0], w1[1], w1[2], w1[3]};
        }
        __syncthreads();
        TP_STOP(22, lds, tid); TP_START(23, lds, tid);
        if (step + 1 < NCHUNK) {
            const int nchunk = DIR == 0 ? step + 1 : (step + 1 < 4 ? 2 - step : 38 - step);
            const char* slab = (const char*)(p + ((size_t)b * LT + (size_t)nchunk * 64) * ODD_IN);
#pragma unroll
            for (int s = 0; s < 8; ++s) { zn[s] = *(const unsigned*)(slab + colz * 2 + G2_OFFZ(s)); qn[s] = *(const unsigned*)(slab + colq * 2 + G2_OFFZ(s)); }
#pragma unroll
            for (int rep = 0; rep < 2; ++rep) vn[rep] = *(const u32x4*)(slab + colv * 2 + G2_OFFV(rep));
        }
#pragma unroll 1
        for (int bi = wave; bi < 10; bi += 8) {
            const int Ib = bi < 1 ? 0 : (bi < 3 ? 1 : (bi < 6 ? 2 : 3)), Jb = bi - (Ib * (Ib + 1)) / 2;
            const int foff = Ib == 0 ? 0 : (Ib == 1 ? 16 : (Ib == 2 ? 48 : 96));
            f32x4 acc = {0.f, 0.f, 0.f, 0.f};
#pragma unroll
            for (int ks = 0; ks < 4; ++ks) {
                const bf16x8 a = *(const LAS bf16x8*)(QX + (16 * Ib + r) * 136 + 32 * ks + 8 * g);
                const bf16x8 bb = *(const LAS bf16x8*)(KF + (foff + 16 * Jb + r) * 136 + 32 * ks + 8 * g);
                acc = MFMA16(a, bb, acc);
            }
#pragma unroll
            for (int i = 0; i < 4; ++i) { float v = acc[i]; if (Jb == Ib && r > 4 * g + i) v = 0.f; AM[(16 * Ib + 4 * g + i) * 72 + 16 * Jb + r] = (bf16_t)f2bf(v); }
        }
        __syncthreads();
        TP_STOP(23, lds, tid); TP_START(24, lds, tid);
        {
            const int tt = wave >> 1, eb = 4 * (wave & 1);
            char* oslab = (char*)(p + Rc0 * ODD_IN + colz);
            bf16x8 aq[4], am[2];
#pragma unroll
            for (int ks = 0; ks < 4; ++ks) aq[ks] = *(const LAS bf16x8*)(Q1 + (16 * tt + r) * 136 + 32 * ks + 8 * g);
#pragma unroll
            for (int ks = 0; ks < 2; ++ks) am[ks] = *(const LAS bf16x8*)(AM + (16 * tt + r) * 72 + 32 * ks + 8 * g);
#pragma unroll
            for (int e4 = 0; e4 < 4; ++e4) {
                const int et = eb + e4;
                f32x4 acc = {0.f, 0.f, 0.f, 0.f};
#pragma unroll
                for (int ks = 0; ks < 4; ++ks) { const bf16x8 bb = *(const LAS bf16x8*)(ST + (16 * et + r) * 136 + 32 * ks + 8 * g); acc = MFMA16(aq[ks], bb, acc); }
#pragma unroll
                for (int ks = 0; ks < 2; ++ks) acc = MFMA16(am[ks], frag_tr(VS, 136, 32 * ks, 16 * et, lane), acc);
#pragma unroll
                for (int i = 0; i < 4; ++i) {
                    const int tau = 16 * tt + 4 * g + i;
                    const unsigned off = (unsigned)((DIR == 0 ? tau : 63 - tau) * ODD_IN + 16 * et + r) * 2u;
                    *(bf16_t*)(oslab + off) = (bf16_t)f2bf(acc[i]);
                }
                __builtin_amdgcn_sched_barrier(0);
            }
            float bl[4];
#pragma unroll
            for (int i = 0; i < 4; ++i) bl[i] = BLAST[16 * wave + 4 * g + i];
            bf16x8 ak[2];
#pragma unroll
            for (int ks = 0; ks < 2; ++ks) ak[ks] = *(const LAS bf16x8*)(K2 + (16 * wave + r) * 72 + 32 * ks + 8 * g);
#pragma unroll
            for (int et = 0; et < 8; ++et) {
#pragma unroll
                for (int i = 0; i < 4; ++i) st[et][i] *= bl[i];
#pragma unroll
                for (int ks = 0; ks < 2; ++ks) st[et] = MFMA16(ak[ks], frag_tr(VS, 136, 32 * ks, 16 * et, lane), st[et]);
                if (et & 1) __builtin_amdgcn_sched_barrier(0);
            }
        }
        __syncthreads();
        TP_STOP(24, lds, tid); TP_START(25, lds, tid);
#pragma unroll
        for (int et = 0; et < 8; ++et) { u32x2 w; w.x = pk2(st[et][0], st[et][1]); w.y = pk2(st[et][2], st[et][3]); *(LAS u32x2*)(ST + (16 * et + r) * 136 + 16 * wave + 4 * g) = w; }
        TP_STOP(25, lds, tid);
    }
    __syncthreads();
    TP_STOP(20, lds, tid);
}

DI void phase_readout(const Params& P, int layer_j, int wv) {
    const int tid = get_tid(wv), lane = tid & 63, wave = tid >> 6;
    const int gw = get_bid() * 8 + wave, NGW = gridDim.x * 8;
    bf16_t* p = (bf16_t*)(P.ws + WS_P);
    const float* gwt = P.od_gnorm_w + layer_j * 128 + (lane & 7) * 16;
    for (int R = gw; R < MROWS; R += NGW) {
        const bf16_t* op = p + (size_t)R * ODD_IN + 16 * lane; bf16_t* yp = p + (size_t)R * ODD_IN + 4096 + 16 * lane;
        const u32x4 o0 = *(const u32x4*)op, o1 = *(const u32x4*)(op + 8), c0 = *(const u32x4*)(op + 1024), c1 = *(const u32x4*)(op + 1032), g0 = *(const u32x4*)yp, g1 = *(const u32x4*)(yp + 8);
        float ov[16], gv[16];
        const unsigned* ow0 = (const unsigned*)&o0; const unsigned* ow1 = (const unsigned*)&o1; const unsigned* cw0 = (const unsigned*)&c0; const unsigned* cw1 = (const unsigned*)&c1;
        const unsigned* gw0 = (const unsigned*)&g0; const unsigned* gw1 = (const unsigned*)&g1;
#pragma unroll
        for (int i = 0; i < 4; ++i) {
            ov[2 * i] = __uint_as_float(ow0[i] << 16) + __uint_as_float(cw0[i] << 16); ov[2 * i + 1] = __uint_as_float(ow0[i] & 0xffff0000u) + __uint_as_float(cw0[i] & 0xffff0000u);
            ov[8 + 2 * i] = __uint_as_float(ow1[i] << 16) + __uint_as_float(cw1[i] << 16); ov[8 + 2 * i + 1] = __uint_as_float(ow1[i] & 0xffff0000u) + __uint_as_float(cw1[i] & 0xffff0000u);
            gv[2 * i] = __uint_as_float(gw0[i] << 16); gv[2 * i + 1] = __uint_as_float(gw0[i] & 0xffff0000u); gv[8 + 2 * i] = __uint_as_float(gw1[i] << 16); gv[8 + 2 * i + 1] = __uint_as_float(gw1[i] & 0xffff0000u);
        }
        float ss = 0.f;
#pragma unroll
        for (int i = 0; i < 16; ++i) ss += ov[i] * ov[i];
        ss += shfl_xor_f(ss, 1); ss += shfl_xor_f(ss, 2); ss += shfl_xor_f(ss, 4);
        const float rstd = rsqrtf(ss * (1.f / 128.f) + RMS_EPS);
        float y[16];
#pragma unroll
        for (int i = 0; i < 16; ++i) y[i] = ov[i] * rstd * gwt[i] * (gv[i] * sigm(gv[i]));
        u32x4 w0, w1;
        w0.x = pk2(y[0], y[1]); w0.y = pk2(y[2], y[3]); w0.z = pk2(y[4], y[5]); w0.w = pk2(y[6], y[7]);
        w1.x = pk2(y[8], y[9]); w1.y = pk2(y[10], y[11]); w1.z = pk2(y[12], y[13]); w1.w = pk2(y[14], y[15]);
        *(u32x4*)yp = w0; *(u32x4*)(yp + 8) = w1;
    }
}

DI void phase_final(const Params& P, int wv) {
    const int tid = get_tid(wv), lane = tid & 63, wave = tid >> 6;
    const int gw = get_bid() * 8 + wave, NGW = gridDim.x * 8;
    for (int R = gw; R < NB * SEQ; R += NGW) {
        float* row = P.out + (size_t)R * DM;
        f32x4 v[4]; float ss = 0.f;
#pragma unroll
        for (int q = 0; q < 4; ++q) { v[q] = *(const f32x4*)(row + 4 * lane + 256 * q); ss += (v[q][0] * v[q][0] + v[q][1] * v[q][1]) + (v[q][2] * v[q][2] + v[q][3] * v[q][3]); }
        const float rstd = rsqrtf(wave_sum(ss) * (1.f / DM) + RMS_EPS);
#pragma unroll
        for (int q = 0; q < 4; ++q) { const f32x4 w4 = *(const f32x4*)(P.final_norm_w + 4 * lane + 256 * q); *(f32x4*)(row + 4 * lane + 256 * q) = (v[q] * rstd) * w4; }
    }
}

#define XB_TMO      128
#define XB_XCNT(j)  (256  + 64 * (j))
#define XB_XSUB(j)  (1280 + 64 * (j))
#define XB_XGEN(j)  (2304 + 64 * (j))
#define XB_TOP      3328
#define XB_TOPGEN   3392
#define XCD_BAR_WORDS 3456
#define XB_SPIN_CAP (1u << 18)

__device__ __forceinline__ unsigned xb_ld(unsigned* p)              { return __hip_atomic_load(p, __ATOMIC_RELAXED, __HIP_MEMORY_SCOPE_AGENT); }
__device__ __forceinline__ unsigned xb_add(unsigned* p, unsigned v) { return __hip_atomic_fetch_add(p, v, __ATOMIC_RELAXED, __HIP_MEMORY_SCOPE_AGENT); }
__device__ __forceinline__ unsigned xb_xcc_id() { return (unsigned)__builtin_amdgcn_s_getreg((3 << 11) | 20) & 0xFu; }
#define XB_SPIN(cond, bar) do { unsigned _sp = 0; while (cond) { __builtin_amdgcn_s_sleep(1); \
    if ((++_sp & 255u) == 0u) { if (xb_ld(&(bar)[XB_TMO])) break; if (_sp > XB_SPIN_CAP) { atomicAdd(&(bar)[XB_TMO], 1u); break; } } } } while (0)

struct XcdBarrier {
    unsigned* bar; unsigned x;
    volatile LAS unsigned* st;
};

__device__ __forceinline__ XcdBarrier xcd_barrier_post(unsigned* bar, volatile LAS unsigned* st, int wv) {
    XcdBarrier b; b.bar = bar; b.x = xb_xcc_id(); b.st = st;
    if (get_tid(wv) == 0) (void)xb_add(&bar[XB_XCNT(b.x)], 1u);
    return b;
}
__device__ __forceinline__ void xcd_barrier_complete(unsigned* bar, unsigned x, unsigned& nloc, unsigned& nx) {
    const unsigned G = gridDim.x * gridDim.y * gridDim.z;
    unsigned sum, cnt, mine, sp = 0u;
    for (;;) {
        sum = 0u; cnt = 0u; mine = 0u;
#pragma unroll
        for (unsigned j = 0; j < 16; ++j) { const unsigned c = xb_ld(&bar[XB_XCNT(j)]); sum += c; cnt += (c > 0u) ? 1u : 0u; mine = (j == x) ? c : mine; }
        if (sum == G) break;
        __builtin_amdgcn_s_sleep(1);
        if ((++sp & 255u) == 0u) { if (xb_ld(&bar[XB_TMO])) break; if (sp > XB_SPIN_CAP) { atomicAdd(&bar[XB_TMO], 1u); break; } }
    }
    nloc = mine > 0u ? mine : 1u; nx = cnt > 0u ? cnt : 1u;
}

__device__ __forceinline__ void xcd_barrier(const XcdBarrier& b, int wv) {
    asm volatile("s_waitcnt vmcnt(0)" ::: "memory");
    __syncthreads();
    if (get_tid(wv) == 0) {
        unsigned* bar = b.bar;
        __builtin_amdgcn_s_waitcnt(0);
        unsigned nloc = b.st[0], nx = b.st[1];
        if (nloc == 0u) { xcd_barrier_complete(bar, b.x, nloc, nx); b.st[0] = nloc; b.st[1] = nx; }
        const unsigned old = xb_add(&bar[XB_XSUB(b.x)], 1u);
        const unsigned gen = old / nloc;
        if (old + 1u == (gen + 1u) * nloc) {
            __builtin_amdgcn_fence(__ATOMIC_RELEASE, "agent");
            asm volatile("s_waitcnt vmcnt(0)" ::: "memory");
            const unsigned og = xb_add(&bar[XB_TOP], 1u);
            const unsigned tg = og / nx;
            if (og + 1u == (tg + 1u) * nx) xb_add(&bar[XB_TOPGEN], 1u);
            else XB_SPIN(xb_ld(&bar[XB_TOPGEN]) == tg, bar);
            __builtin_amdgcn_fence(__ATOMIC_ACQUIRE, "agent");
            xb_add(&bar[XB_XGEN(b.x)], 1u);
            asm volatile("s_waitcnt vmcnt(0)" ::: "memory");
        } else {
            XB_SPIN(xb_ld(&bar[XB_XGEN(b.x)]) == gen, bar);
            __builtin_amdgcn_fence(__ATOMIC_ACQUIRE, "agent");
            asm volatile("s_waitcnt vmcnt(0)" ::: "memory");
        }
    }
    __syncthreads();
}

constexpr int PARAM_OFF = LDS_BYTES - 256;
static_assert(G2_END <= PARAM_OFF && sizeof(Params) <= 208, "LDS map");
DI const float* ld_uptr(const LAS unsigned long long* s, int i) {
    const unsigned long long v = s[i];
    const unsigned lo = __builtin_amdgcn_readfirstlane((unsigned)v), hi = __builtin_amdgcn_readfirstlane((unsigned)(v >> 32));
    return (const float*)(const __attribute__((address_space(1))) float*)(((unsigned long long)hi << 32) | lo);
}
DI Params load_params(LAS unsigned char* lds) {
    LAS unsigned char* pb = lds + PARAM_OFF; asm volatile("" : "+v"(pb));
    const LAS unsigned long long* s = (const LAS unsigned long long*)pb;
    Params Q;
    Q.x = ld_uptr(s, 0); Q.c = ld_uptr(s, 1); Q.ctx = ld_uptr(s, 2); Q.c_ctx = ld_uptr(s, 3); Q.ada_w = ld_uptr(s, 4); Q.ada_b = ld_uptr(s, 5); Q.norm_w = ld_uptr(s, 6);
    Q.ev_w_in = ld_uptr(s, 7); Q.ev_conv_w = ld_uptr(s, 8); Q.ev_conv_b = ld_uptr(s, 9); Q.ev_rg_wx = ld_uptr(s, 10); Q.ev_rg_bx = ld_uptr(s, 11); Q.ev_rg_wa = ld_uptr(s, 12);
    Q.ev_rg_ba = ld_uptr(s, 13); Q.ev_rg_lambda = ld_uptr(s, 14); Q.ev_sink = ld_uptr(s, 15); Q.ev_w_out = ld_uptr(s, 16); Q.od_w_in = ld_uptr(s, 17); Q.od_lb_raw = ld_uptr(s, 18);
    Q.od_gnorm_w = ld_uptr(s, 19); Q.od_w_out = ld_uptr(s, 20); Q.final_norm_w = ld_uptr(s, 21); Q.out = (float*)ld_uptr(s, 22); Q.ws = (unsigned char*)ld_uptr(s, 23);
    Q.ph_lo = 0; Q.ph_hi = 0;
    return Q;
}
DI void run_phase(LAS unsigned char* lds, int ph, int wv) {
    #ifndef PHMASK
#define PHMASK 0xffff
#endif
    if (ph == 0) { if (PHMASK & 1) { const Params P = load_params(lds); phase_pro(P, lds, wv); } return; }
    if (ph == NPHASE - 1) { if (PHMASK & 2) { const Params P = load_params(lds); phase_final(P, wv); } return; }
    const int layer = (ph - 1) / 5, sub = (ph - 1) % 5, j = layer >> 1;
    const bool even = (layer & 1) == 0;
    if (sub == 0) { if (PHMASK & 4) { const Params P = load_params(lds); phase_norm(P, lds, layer, wv); } return; }
    if (sub == 1) {
        const Params P = load_params(lds); bf16_t* pbuf = (bf16_t*)(P.ws + WS_P);
        const int N = even ? EVEN_IN : ODD_IN;
        pg8::Gemm gm{(const bf16_t*)(P.ws + WS_OV), (const bf16_t*)(P.ws + WS_WIN), MROWS, N, 1024, 1024};
        pg8::StaticOrder S; S.init(MROWS, N, (int)gridDim.x, get_bid());
        EpiStoreBf16 E{pbuf, N};
        if (PHMASK & 8) pg8::gemm_phase<EpiStoreBf16, pg8::StaticOrder, true, true>(lds, gm, S, E, wv);
        return;
    }
    if (sub == 2) {
        const Params P = load_params(lds);
        if (even) {
            constexpr int NRG = NB * NCHUNK * 8;
#if defined(SPLIT_ATTN)
            for (int it = get_bid(); it < NRG; it += gridDim.x) rglru_item(P, lds, j, it, wv);
#else
            for (int it = get_bid(); it < NRG + 576; it += gridDim.x) {
                if (it < NRG) { if (PHMASK & 32) rglru_item(P, lds, j, it, wv); } else { if (PHMASK & 16) attn_item(P, lds, j, it - NRG, wv); }
            }
#endif
        } else {
            for (int it = get_bid(); it < 128; it += gridDim.x) { if (PHMASK & 64) { if (it & 1) gla2_item<1>(P, lds, j, it >> 4, (it >> 1) & 7, wv); else gla2_item<0>(P, lds, j, it >> 4, (it >> 1) & 7, wv); } }
        }
        return;
    }
    if (sub == 3) {
        const Params P = load_params(lds);
        if (!even) { if (PHMASK & 256) phase_readout(P, j, wv); }
#if defined(SPLIT_ATTN)
        else { for (int it = get_bid(); it < 576; it += gridDim.x) attn_item(P, lds, j, it, wv); }
#endif
        return;
    }
    {
        const Params P = load_params(lds); bf16_t* pbuf = (bf16_t*)(P.ws + WS_P);
        const int K = even ? 2048 : 1024, lda = even ? EVEN_IN : ODD_IN;
        pg8::Gemm gm{pbuf + (even ? 1536 : 4096), (const bf16_t*)(P.ws + WS_WOUT), MROWS, 1024, K, lda};
        pg8::StaticOrder S;
        if (layer == 3) S.init(NB * SEQ, 1024, (int)gridDim.x, get_bid(), 1);
        else S.init(MROWS, 1024, (int)gridDim.x, get_bid());
        const float* hl = layer == 0 ? P.x : P.out; const float* hc = layer == 0 ? P.ctx : (const float*)(P.ws + WS_HCTX);
        EpiResid E{hl, hc, P.out, (float*)(P.ws + WS_HCTX), (const float*)(P.ws + WS_MOD) + (size_t)layer * 9 * 3072 + 2048};
        if (PHMASK & 512) pg8::gemm_phase<EpiResid, pg8::StaticOrder, true, true>(lds, gm, S, E, wv);
    }
}

__global__ void __launch_bounds__(512, 2) mega(Params P) {
    extern __shared__ __attribute__((aligned(16))) unsigned char lds_raw[];
    LAS unsigned char* lds = (LAS unsigned char*)lds_raw;
    cg::grid_group grid = cg::this_grid();
    const int wv = __builtin_amdgcn_readfirstlane((int)(threadIdx.x >> 6));
    if (get_tid(wv) == 0) {
#if defined(TP_ID)
        ((LAS unsigned long long*)(lds + 163840 - 32))[0] = 0ull; ((LAS unsigned long long*)(lds + 163840 - 32))[1] = 0ull;
#endif
        ((LAS unsigned*)(lds + PARAM_OFF + 208))[0] = 0u; ((LAS unsigned*)(lds + PARAM_OFF + 208))[1] = 0u;
        LAS unsigned long long* d = (LAS unsigned long long*)(lds + PARAM_OFF);
        d[0] = (unsigned long long)P.x; d[1] = (unsigned long long)P.c; d[2] = (unsigned long long)P.ctx; d[3] = (unsigned long long)P.c_ctx; d[4] = (unsigned long long)P.ada_w;
        d[5] = (unsigned long long)P.ada_b; d[6] = (unsigned long long)P.norm_w; d[7] = (unsigned long long)P.ev_w_in; d[8] = (unsigned long long)P.ev_conv_w; d[9] = (unsigned long long)P.ev_conv_b;
        d[10] = (unsigned long long)P.ev_rg_wx; d[11] = (unsigned long long)P.ev_rg_bx; d[12] = (unsigned long long)P.ev_rg_wa; d[13] = (unsigned long long)P.ev_rg_ba; d[14] = (unsigned long long)P.ev_rg_lambda;
        d[15] = (unsigned long long)P.ev_sink; d[16] = (unsigned long long)P.ev_w_out; d[17] = (unsigned long long)P.od_w_in; d[18] = (unsigned long long)P.od_lb_raw; d[19] = (unsigned long long)P.od_gnorm_w;
        d[20] = (unsigned long long)P.od_w_out; d[21] = (unsigned long long)P.final_norm_w; d[22] = (unsigned long long)P.out; d[23] = (unsigned long long)P.ws;
    }
    __syncthreads();
    const int ph_lo = P.ph_lo, ph_hi = P.ph_hi;
    (void)xcd_barrier_post((unsigned*)(P.ws + WS_CTL) + 4096, (volatile LAS unsigned*)(lds + PARAM_OFF + 208), wv);
#define GRID_SYNC(first) do { if (first) grid.sync(); else { XcdBarrier xb_; xb_.bar = (unsigned*)(load_params(lds).ws + WS_CTL) + 4096; xb_.x = xb_xcc_id(); xb_.st = (volatile LAS unsigned*)(lds + PARAM_OFF + 208); xcd_barrier(xb_, wv); } } while (0)
#if defined(PROBE_S)
    constexpr int PREP = PROBE_E - PROBE_S + 1;
#pragma unroll 1
    for (int seq = ph_lo; seq < ph_hi + PREP; ++seq) {
        if (seq > ph_lo) GRID_SYNC(seq == ph_lo + 1);
        const int ph = seq <= PROBE_E ? seq : seq - PREP;
        run_phase(lds, ph, wv);
    }
#else
#pragma unroll 1
    for (int ph = ph_lo; ph < ph_hi; ++ph) {
#if !defined(SPLIT_ATTN)
        if (ph >= 1 && ph < NPHASE - 1 && (ph - 1) % 5 == 3 && (((ph - 1) / 5) & 1) == 0) continue;
#endif
        if (ph > ph_lo) GRID_SYNC(ph == ph_lo + 1);
        run_phase(lds, ph, wv);
    }
#endif
#if defined(TP_ID)
    if (get_tid(wv) == 0 && blockIdx.x == TP_BLOCK) {
        const unsigned long long acc = ((LAS unsigned long long*)(lds + 163840 - 32))[1], t0 = __builtin_amdgcn_s_memrealtime();
        while (__builtin_amdgcn_s_memrealtime() - t0 < (unsigned long long)TP_AMP * acc) __builtin_amdgcn_s_sleep(8);
    }
#endif
}

extern "C" void kernel_launch(void* const* d_in, const int* in_sizes, int n_in, void* d_out, int out_size, void* d_ws, size_t ws_size, hipStream_t stream) {
    static int grid = 0;
    if (grid == 0) {
        if (n_in != 22 || ws_size < WS_END) { fprintf(stderr, "kernel_launch: unexpected inputs (n_in %d, ws %zu)\n", n_in, ws_size); grid = -1; return; }
        int dev = 0, cus = 0, per_cu = 0;
        hipGetDevice(&dev);
        hipDeviceGetAttribute(&cus, hipDeviceAttributeMultiprocessorCount, dev);
        if (hipFuncSetAttribute((const void*)mega, hipFuncAttributeMaxDynamicSharedMemorySize, LDS_BYTES) != hipSuccess) { fprintf(stderr, "kernel_launch: hipFuncSetAttribute failed\n"); grid = -1; return; }
        if (hipOccupancyMaxActiveBlocksPerMultiprocessor(&per_cu, (const void*)mega, 512, LDS_BYTES) != hipSuccess || per_cu < 1) { fprintf(stderr, "kernel_launch: occupancy query gives %d\n", per_cu); per_cu = 1; }
        (void)hipGetLastError();
        grid = cus;
    }
    if (grid < 0) return;
    if (hipMemsetAsync((char*)d_ws + WS_CTL, 0, 65536, stream) != hipSuccess) { fprintf(stderr, "kernel_launch: memset failed\n"); return; }
    Params P{};
    const float** pp = (const float**)&P;
    for (int i = 0; i < 22; ++i) pp[i] = (const float*)d_in[i];
    P.out = (float*)d_out; P.ws = (unsigned char*)d_ws;
#if ONE_LAUNCH
    P.ph_lo = 0; P.ph_hi = NPHASE;
    { void* args[] = {&P}; hipError_t e = hipLaunchCooperativeKernel((const void*)mega, dim3(grid), dim3(512), args, LDS_BYTES, stream);
      if (e != hipSuccess) fprintf(stderr, "cooperative launch failed: %s (grid %d)\n", hipGetErrorString(e), grid); }
#else
    for (int ph = 0; ph < NPHASE; ++ph) {
        P.ph_lo = ph; P.ph_hi = ph + 1;
        void* args[] = {&P}; hipError_t e = hipLaunchCooperativeKernel((const void*)mega, dim3(grid), dim3(512), args, LDS_BYTES, stream);
        if (e != hipSuccess) { fprintf(stderr, "launch %d failed: %s (grid %d)\n", ph, hipGetErrorString(e), grid); break; }
    }
#endif
}
```

```cpp
#include <hip/hip_runtime.h>
#include <hip/hip_cooperative_groups.h>
#include <cstdio>
#include <cstdint>
namespace cg = cooperative_groups;

#ifndef ONE_LAUNCH
#define ONE_LAUNCH 1
#endif

#define DI __device__ __forceinline__
#define LAS __attribute__((address_space(3)))
__device__ __forceinline__ int lane_nh() { int l; asm volatile("v_mbcnt_lo_u32_b32 %0, -1, 0\n\tv_mbcnt_hi_u32_b32 %0, -1, %0" : "=v"(l)); return l; }
__device__ __forceinline__ int get_tid(int wv) { asm volatile("" : "+s"(wv)); return wv * 64 + lane_nh(); }
__device__ __forceinline__ float shfl_xor_f(float v, int o) { return __int_as_float(__builtin_amdgcn_ds_bpermute((lane_nh() ^ o) << 2, __float_as_int(v))); }
__device__ __forceinline__ int get_bid() { int b = blockIdx.x; asm volatile("" : "+s"(b)); return b; }

#if defined(TP_ID)
#ifndef TP_BLOCK
#define TP_BLOCK 5
#endif
#ifndef TP_AMP
#define TP_AMP 16
#endif
#define TP_START(id, lds, tid_) do { if ((id) == TP_ID && (tid_) == 0 && blockIdx.x == TP_BLOCK) { ((LAS unsigned long long*)((lds) + 163840 - 32))[0] = __builtin_amdgcn_s_memrealtime(); } } while (0)
#define TP_STOP(id, lds, tid_) do { if ((id) == TP_ID && (tid_) == 0 && blockIdx.x == TP_BLOCK) { LAS unsigned long long* w_ = (LAS unsigned long long*)((lds) + 163840 - 32); w_[1] += __builtin_amdgcn_s_memrealtime() - w_[0]; } } while (0)
#else
#define TP_START(id, lds, tid_) do { } while (0)
#define TP_STOP(id, lds, tid_) do { } while (0)
#endif
namespace pg8 {
#define PG8_LAS __attribute__((address_space(3)))
typedef unsigned short bf16_t;
typedef short bf16x8 __attribute__((ext_vector_type(8)));
typedef float f32x4 __attribute__((ext_vector_type(4)));
typedef unsigned u32x4 __attribute__((ext_vector_type(4)));
constexpr int BM = 256, BK = 64, HALF = 128, HTB = HALF * BK * 2  , STAGE_BYTES = 8 * HTB, NXCD = 8, WGM = 8;

__host__ __device__ __forceinline__ int lds_byte(int r, int c) { const int st = (r >> 4) * 2 + (c >> 5), rr = r & 15, cc = c & 31, ob = rr * 64 + cc * 2; return st * 1024 + (ob ^ (((ob >> 9) & 1) << 5)); }
__host__ __device__ __forceinline__ void stage_rc(int b, int& R, int& C) { const int st = b / 1024, sb = b % 1024, swz = sb ^ (((sb >> 9) & 1) << 5); R = (st >> 1) * 16 + swz / 64; C = (st & 1) * 32 + (swz % 64) / 2; }
__host__ __device__ __forceinline__ int perm32(int rho) { const int n = rho >> 4, i = rho & 15; return 8 * (i >> 2) + 4 * n + (i & 3); }

struct Unit { int pm, pn; };
struct Gemm { const bf16_t* A; const bf16_t* Bt; int M, N, K, lda; };

struct StaticOrder {
    int nM, nN, nwg, G, c, lat_only;
    __host__ __device__ void init(int M, int N, int G_, int c_, int lat_only_ = 0) { nM = M / BM; nN = N / BM; nwg = nM * nN; G = G_; c = c_; lat_only = lat_only_; }
    __host__ __device__ bool next(int i, Unit& u) const {
        const long L = (long)i * G + c; if (L >= nwg) return false;
        int wgid = (int)L; { const int q = nwg / NXCD, r = nwg % NXCD, xcd = wgid % NXCD, off = wgid / NXCD; wgid = (xcd < r ? xcd * (q + 1) : r * (q + 1) + (xcd - r) * q) + off; }
        const int nig = WGM * nN, gid = wgid / nig, fm = gid * WGM, gsz = (nM - fm) < WGM ? (nM - fm) : WGM;
        u.pm = fm + ((wgid % nig) % gsz); u.pn = (wgid % nig) / gsz; if (lat_only) u.pm = 9 * (u.pm >> 3) + 1 + (u.pm & 7); return true;
    }
    __device__ __forceinline__ void a_ready(const Unit&) const {}
    __device__ __forceinline__ void done(const Unit&) const {}
};

template <class Epi, class Sched, bool ALIGN_EPI = false, bool SP2 = false>
__device__ __forceinline__ void gemm_phase(PG8_LAS unsigned char* lds, const Gemm g, const Sched& S, const Epi& E, int wv) {
    const int tid = get_tid(wv), wid = __builtin_amdgcn_readfirstlane(tid >> 6), lane = tid & 63, wr = wid >> 2, wc = wid & 3, fr = lane & 15, fq = lane >> 4;
    const int K = g.K, nt = K / BK;
    unsigned voffA[2], voffB[2];
#pragma unroll
    for (int i = 0; i < 2; ++i) { int R, C; stage_rc(tid * 16 + i * 8192, R, C); const int Rb = Epi::PERM ? ((R & ~31) + perm32(R & 31)) : R;
        voffA[i] = (unsigned)(R * g.lda + C) * 2u; voffB[i] = (unsigned)(Rb * K + C) * 2u; }
    const size_t kstep = (size_t)(BK * 2);
    const size_t hstepA = (size_t)HALF * g.lda * 2, hstepB = (size_t)HALF * K * 2;
    const size_t tstepA = 2 * hstepA, tstepB = 2 * hstepB;
    const unsigned ldsw = (unsigned)wid * 1024u;
    const int aoff = lds_byte(wr * 64 + fr, fq * 8), boff = lds_byte(wc * 32 + fr, fq * 8);
#define PG8_SA(b, h) (((b) * 2 + (h)) * HTB)
#define PG8_SB(b, h) ((4 + (b) * 2 + (h)) * HTB)
#define PG8_STAGE(bufoff, gbase, voff) do { _Pragma("unroll") for (int _i = 0; _i < 2; ++_i) \
        __builtin_amdgcn_global_load_lds((const unsigned*)((const char*)(gbase) + (voff)[_i]), (PG8_LAS unsigned*)(lds + (bufoff) + ldsw + _i * 8192), 16, 0, 0); } while (0)
#define PG8_LDA(dst, b, h) do { _Pragma("unroll") for (int m = 0; m < 4; ++m) _Pragma("unroll") for (int k = 0; k < 2; ++k) dst[m][k] = *(const PG8_LAS bf16x8*)(lds + PG8_SA(b, h) + aoff + m * 2048 + k * 1024); } while (0)
#define PG8_LDB(dst, b, h) do { _Pragma("unroll") for (int n = 0; n < 2; ++n) _Pragma("unroll") for (int k = 0; k < 2; ++k) dst[n][k] = *(const PG8_LAS bf16x8*)(lds + PG8_SB(b, h) + boff + n * 2048 + k * 1024); } while (0)
#define PG8_MMA(ai, bj, At, Bt) do { __builtin_amdgcn_s_setprio(1); _Pragma("unroll") for (int m = 0; m < 4; ++m) _Pragma("unroll") for (int n = 0; n < 2; ++n) _Pragma("unroll") for (int k = 0; k < 2; ++k) \
        acc[ai][bj][m][n] = __builtin_amdgcn_mfma_f32_16x16x32_bf16(Bt[n][k], At[m][k], acc[ai][bj][m][n], 0, 0, 0); __builtin_amdgcn_s_setprio(0); } while (0)
#define PG8_WAIT_V(n) asm volatile("s_waitcnt vmcnt(" #n ")" ::: "memory")
#define PG8_WAIT_L(n) asm volatile("s_waitcnt lgkmcnt(" #n ")" ::: "memory")
#define PG8_BAR __builtin_amdgcn_s_barrier()
#define PG8_SCHED __builtin_amdgcn_sched_barrier(0)
    Unit cur, nxt; int ui = 0;
    if (!S.next(0, cur)) return;
    f32x4 acc[2][2][4][2];
#pragma unroll
    for (int a = 0; a < 2; ++a)
#pragma unroll
        for (int b = 0; b < 2; ++b)
#pragma unroll
            for (int m = 0; m < 4; ++m)
#pragma unroll
                for (int n = 0; n < 2; ++n) acc[a][b][m][n] = (f32x4){0.f, 0.f, 0.f, 0.f};
    bf16x8 At[4][2], B0[2][2], B1[2][2];
    const char* cA = (const char*)g.A + (size_t)cur.pm * tstepA; const char* cB = (const char*)g.Bt + (size_t)cur.pn * tstepB;
    S.a_ready(cur);
    if constexpr (SP2) {
        PG8_STAGE(PG8_SB(0, 0), cB, voffB); PG8_STAGE(PG8_SB(0, 1), cB + hstepB, voffB); PG8_STAGE(PG8_SA(0, 0), cA, voffA); PG8_STAGE(PG8_SA(0, 1), cA + hstepA, voffA);
        if (wr == 1) PG8_BAR;
        PG8_WAIT_V(2); PG8_BAR;
        PG8_STAGE(PG8_SB(1, 0), cB + kstep, voffB); PG8_STAGE(PG8_SA(1, 0), cA + kstep, voffA); PG8_STAGE(PG8_SB(1, 1), cB + hstepB + kstep, voffB);
        PG8_WAIT_V(6); PG8_BAR;
    } else {
        PG8_STAGE(PG8_SB(0, 0), cB, voffB); PG8_STAGE(PG8_SA(0, 0), cA, voffA); PG8_STAGE(PG8_SB(0, 1), cB + hstepB, voffB); PG8_STAGE(PG8_SA(0, 1), cA + hstepA, voffA);
        if (wr == 1) PG8_BAR;
        PG8_WAIT_V(4); PG8_BAR;
        PG8_STAGE(PG8_SB(1, 0), cB + kstep, voffB); PG8_STAGE(PG8_SA(1, 0), cA + kstep, voffA); PG8_STAGE(PG8_SB(1, 1), cB + hstepB + kstep, voffB);
        PG8_WAIT_V(6); PG8_BAR;
    }
    for (;;) {
        const bool has_next = S.next(ui + 1, nxt);
        const char* nA = has_next ? (const char*)g.A + (size_t)nxt.pm * tstepA : cA; const char* nB = has_next ? (const char*)g.Bt + (size_t)nxt.pn * tstepB : cB;
        for (int t = 0; t < nt; t += 2) {
            const bool last = (t == nt - 2);
            const char* a1 = cA + (size_t)(t + 1) * kstep;
            const char* a2 = last ? nA : cA + (size_t)(t + 2) * kstep; const char* b2 = last ? nB : cB + (size_t)(t + 2) * kstep;
            const char* a3 = a2 + kstep; const char* b3 = b2 + kstep;
            if (last && has_next) S.a_ready(nxt);
            if constexpr (SP2) {
            PG8_LDB(B0, 0, 0); PG8_LDB(B1, 0, 1); PG8_SCHED; PG8_LDA(At, 0, 0); PG8_STAGE(PG8_SA(1, 1), a1 + hstepA, voffA);
            PG8_WAIT_V(8); PG8_WAIT_L(0); PG8_BAR; PG8_MMA(0, 0, At, B0); PG8_MMA(0, 1, At, B1); PG8_BAR; PG8_SCHED;
            PG8_LDA(At, 0, 1); PG8_STAGE(PG8_SB(0, 0), b2, voffB); PG8_STAGE(PG8_SB(0, 1), b2 + hstepB, voffB); PG8_STAGE(PG8_SA(0, 0), a2, voffA);
            PG8_WAIT_V(8); PG8_WAIT_L(0); PG8_BAR; PG8_MMA(1, 0, At, B0); PG8_MMA(1, 1, At, B1); PG8_BAR; PG8_SCHED;
            PG8_LDB(B0, 1, 0); PG8_LDB(B1, 1, 1); PG8_SCHED; PG8_LDA(At, 1, 0); PG8_STAGE(PG8_SA(0, 1), a2 + hstepA, voffA);
            PG8_WAIT_V(8); PG8_WAIT_L(0); PG8_BAR; PG8_MMA(0, 0, At, B0); PG8_MMA(0, 1, At, B1); PG8_BAR; PG8_SCHED;
            PG8_LDA(At, 1, 1); PG8_STAGE(PG8_SB(1, 0), b3, voffB); PG8_STAGE(PG8_SB(1, 1), b3 + hstepB, voffB); PG8_STAGE(PG8_SA(1, 0), a3, voffA);
            PG8_WAIT_V(8); PG8_WAIT_L(0); PG8_BAR; PG8_MMA(1, 0, At, B0); PG8_MMA(1, 1, At, B1); PG8_BAR; PG8_SCHED;
            } else {
            PG8_LDB(B0, 0, 0); PG8_SCHED; PG8_LDA(At, 0, 0); PG8_STAGE(PG8_SA(1, 1), a1 + hstepA, voffA);
            PG8_WAIT_L(8); PG8_BAR; PG8_WAIT_L(0); PG8_MMA(0, 0, At, B0); PG8_BAR; PG8_SCHED;
            PG8_LDB(B1, 0, 1); PG8_STAGE(PG8_SB(0, 0), b2, voffB);
            PG8_BAR; PG8_WAIT_L(0); PG8_MMA(0, 1, At, B1); PG8_BAR;
            PG8_LDA(At, 0, 1); PG8_STAGE(PG8_SA(0, 0), a2, voffA);
            PG8_BAR; PG8_WAIT_L(0); PG8_MMA(1, 0, At, B0); PG8_BAR; PG8_SCHED;
            PG8_STAGE(PG8_SB(0, 1), b2 + hstepB, voffB);
            PG8_WAIT_V(6); PG8_BAR; PG8_MMA(1, 1, At, B1); PG8_BAR;
            PG8_LDB(B0, 1, 0); PG8_SCHED; PG8_LDA(At, 1, 0); PG8_STAGE(PG8_SA(0, 1), a2 + hstepA, voffA);
            PG8_WAIT_L(8); PG8_BAR; PG8_WAIT_L(0); PG8_MMA(0, 0, At, B0); PG8_BAR; PG8_SCHED;
            PG8_LDB(B1, 1, 1); PG8_STAGE(PG8_SB(1, 0), b3, voffB);
            PG8_BAR; PG8_WAIT_L(0); PG8_MMA(0, 1, At, B1); PG8_BAR;
            PG8_LDA(At, 1, 1); PG8_STAGE(PG8_SA(1, 0), a3, voffA);
            PG8_BAR; PG8_WAIT_L(0); PG8_MMA(1, 0, At, B0); PG8_BAR; PG8_SCHED;
            PG8_STAGE(PG8_SB(1, 1), b3 + hstepB, voffB);
            PG8_WAIT_V(6); PG8_BAR; PG8_MMA(1, 1, At, B1); PG8_BAR;
            }
        }
        if constexpr (ALIGN_EPI) { if (wr == 0) PG8_BAR; }
        if constexpr (!Epi::AFTER_DRAIN) { E(acc, cur, wr, wc, fr, fq); S.done(cur); }
        if (!has_next) break;
#pragma unroll
        for (int a = 0; a < 2; ++a)
#pragma unroll
            for (int b = 0; b < 2; ++b)
#pragma unroll
                for (int m = 0; m < 4; ++m)
#pragma unroll
                    for (int n = 0; n < 2; ++n) acc[a][b][m][n] = (f32x4){0.f, 0.f, 0.f, 0.f};
        cur = nxt; cA = nA; cB = nB; ++ui;
        if constexpr (ALIGN_EPI) { if (wr == 1) PG8_BAR; }
    }
    PG8_WAIT_V(0);
    if constexpr (!ALIGN_EPI) { if (wr == 0) PG8_BAR; }
    PG8_BAR;
    if constexpr (Epi::AFTER_DRAIN) { E.fused(acc, cur, wr, wc, fr, fq, lds, wid, lane); S.done(cur); }
#undef PG8_SA
#undef PG8_SB
#undef PG8_STAGE
#undef PG8_LDA
#undef PG8_LDB
#undef PG8_MMA
#undef PG8_WAIT_V
#undef PG8_WAIT_L
#undef PG8_BAR
#undef PG8_SCHED
}
}

typedef unsigned short bf16_t;
typedef short bf16x8 __attribute__((ext_vector_type(8)));
typedef short s16x4 __attribute__((ext_vector_type(4)));
typedef float f32x4 __attribute__((ext_vector_type(4)));
typedef float f32x16 __attribute__((ext_vector_type(16)));
typedef unsigned u32x4 __attribute__((ext_vector_type(4)));
typedef unsigned u32x2 __attribute__((ext_vector_type(2)));
typedef float f32x2 __attribute__((ext_vector_type(2)));

constexpr int DM = 1024, NB = 8, SEQ = 2048, CTXL = 256, LT = SEQ + CTXL  , MROWS = NB * LT  ;
constexpr int EVEN_IN = 4608, ODD_IN = 5120, NCHUNK = LT / 64  ;
constexpr float RMS_EPS = 1e-6f, LOG2E = 1.4426950408889634f;
constexpr int LDS_BYTES = 160 * 1024;
constexpr int NPHASE = 22;

constexpr size_t WS_CTL = 0;
constexpr size_t WS_MOD = 65536;
constexpr size_t WS_ROPE = 524288;
constexpr size_t WS_AGG = 1048576;
constexpr size_t WS_HCTX = WS_AGG + 4718592;
constexpr size_t WS_WIN = WS_HCTX + 8388608;
constexpr size_t WS_WOUT = WS_WIN + 10485760;
constexpr size_t WS_WRG = WS_WOUT + 4194304;
constexpr size_t WS_OV = WS_WRG + 1048576;
constexpr size_t WS_P = WS_OV + 37748736;
constexpr size_t WS_END = WS_P + 188743680;
static_assert(WS_END <= 268435456, "workspace map exceeds 256 MiB");

struct Params {
    const float *x, *c, *ctx, *c_ctx, *ada_w, *ada_b, *norm_w, *ev_w_in, *ev_conv_w, *ev_conv_b, *ev_rg_wx, *ev_rg_bx, *ev_rg_wa, *ev_rg_ba,
        *ev_rg_lambda, *ev_sink, *ev_w_out, *od_w_in, *od_lb_raw, *od_gnorm_w, *od_w_out, *final_norm_w;
    float* out; unsigned char* ws; int ph_lo, ph_hi;
};

DI float bf2f(unsigned short v) { return __uint_as_float((unsigned)v << 16); }
DI unsigned f2bf(float f) { unsigned u = __float_as_uint(f); return (u + 0x7fffu + ((u >> 16) & 1u)) >> 16; }
typedef __bf16 bf16x2_hw __attribute__((ext_vector_type(2)));
DI unsigned pk2(float lo, float hi) { const f32x2 v = {lo, hi}; return __builtin_bit_cast(unsigned, __builtin_convertvector(v, bf16x2_hw)); }
DI float sigm(float x) { return __builtin_amdgcn_rcpf(1.f + __expf(-x)); }
DI float softplus_neg(float lam) {
    const float e = __expf(-lam);
    return e < 0.06f ? e * (1.f + e * (-0.5f + e * (0.33333333f + e * (-0.25f + e * 0.2f)))) : __logf(1.f + e);
}
DI float neg_expm1(float x) {
    return x > -0.25f ? -x * (1.f + x * (0.5f + x * (0.16666667f + x * (0.041666668f + x * (0.0083333338f + x * 0.0013888889f))))) : 1.f - __expf(x);
}
DI float wave_sum(float v) {
#pragma unroll
    for (int o = 1; o < 64; o <<= 1) v += shfl_xor_f(v, o);
    return v;
}
DI int crow(int reg, int h) { return (reg & 3) + 8 * (reg >> 2) + 4 * h; }
#define MFMA16(a, b, c) __builtin_amdgcn_mfma_f32_16x16x32_bf16((a), (b), (c), 0, 0, 0)
#define MFMA32(a, b, c) __builtin_amdgcn_mfma_f32_32x32x16_bf16((a), (b), (c), 0, 0, 0)

struct EpiStoreBf16 {
    static constexpr bool PERM = true, AFTER_DRAIN = false;
    bf16_t* O; int ldc;
    DI void operator()(const f32x4 (&acc)[2][2][4][2], const pg8::Unit& u, int wr, int wc, int fr, int fq) const {
        const int row0 = u.pm * 256 + wr * 64 + fr, col0 = u.pn * 256 + wc * 32 + 8 * fq;
#pragma unroll
        for (int ai = 0; ai < 2; ++ai)
#pragma unroll
            for (int m = 0; m < 4; ++m) { bf16_t* rowp = O + (size_t)(row0 + ai * 128 + m * 16) * ldc + col0;
#pragma unroll
                for (int bj = 0; bj < 2; ++bj) { const f32x4 v0 = acc[ai][bj][m][0], v1 = acc[ai][bj][m][1];
                    u32x4 w; w.x = pk2(v0[0], v0[1]); w.y = pk2(v0[2], v0[3]); w.z = pk2(v1[0], v1[1]); w.w = pk2(v1[2], v1[3]);
                    *(u32x4*)(rowp + bj * 128) = w; } }
    }
};
struct EpiResid {
    static constexpr bool PERM = false, AFTER_DRAIN = false;
    const float* in_lat; const float* in_ctx; float* out_lat; float* out_ctx; const float* gate;
    DI void operator()(const f32x4 (&acc)[2][2][4][2], const pg8::Unit& u, int wr, int wc, int fr, int fq) const {
        const int b = u.pm / 9, jt = u.pm % 9;
        const float* ib; float* ob; const float* g;
        if (jt == 0) { const size_t off = (size_t)b * CTXL * DM; ib = in_ctx + off; ob = out_ctx + off; g = gate + 8 * 3072; }
        else { const size_t off = ((size_t)b * SEQ + (size_t)(jt - 1) * 256) * DM; ib = in_lat + off; ob = out_lat + off; g = gate + b * 3072; }
        const int col0 = u.pn * 256 + wc * 32 + 4 * fq;
#pragma unroll
        for (int bj = 0; bj < 2; ++bj)
#pragma unroll
            for (int n = 0; n < 2; ++n) {
                const f32x4 gvv = *(const f32x4*)(g + col0 + bj * 128 + n * 16);
#pragma unroll
                for (int ai = 0; ai < 2; ++ai) {
#pragma unroll
                    for (int m = 0; m < 4; ++m) { const int r = ai * 128 + wr * 64 + m * 16 + fr;
                        const size_t off = (size_t)r * DM + col0 + bj * 128 + n * 16;
                        const f32x4 o = *(const f32x4*)(ib + off) + gvv * acc[ai][bj][m][n]; *(f32x4*)(ob + off) = o; }
                    asm volatile("" ::: "memory");
                }
            }
    }
};

DI void phase_pro(const Params& P, LAS unsigned char* lds, int wv) {
    const int tid = get_tid(wv);
    LAS float* s = (LAS float*)lds;
    LAS float* red = (LAS float*)(lds + 36864);
    float* mod = (float*)(P.ws + WS_MOD);
    for (int i = tid; i < 9 * 1024; i += 512) { const int r = i >> 10, k = i & 1023; const float v = r < 8 ? P.c[r * 1024 + k] : P.c_ctx[k]; s[i] = v * sigm(v); }
    __syncthreads();
    for (int item = get_bid(); item < 384; item += gridDim.x) {
        const int l = item / 96, n0 = (item % 96) * 32, ks = tid >> 5, col = tid & 31;
        const float* w = P.ada_w + (size_t)l * 1024 * 3072 + n0 + col;
        float acc[9];
#pragma unroll
        for (int r = 0; r < 9; ++r) acc[r] = 0.f;
#pragma unroll 8
        for (int kk = 0; kk < 64; ++kk) { const int k = ks * 64 + kk; const float wv = w[(size_t)k * 3072];
#pragma unroll
            for (int r = 0; r < 9; ++r) acc[r] += s[r * 1024 + k] * wv; }
#pragma unroll
        for (int r = 0; r < 9; ++r) red[(ks * 9 + r) * 32 + col] = acc[r];
        __syncthreads();
        if (tid < 288) { const int r = tid >> 5, cc = tid & 31; float sum = 0.f;
#pragma unroll
            for (int k2 = 0; k2 < 16; ++k2) sum += red[(k2 * 9 + r) * 32 + cc];
            mod[(l * 9 + r) * 3072 + n0 + cc] = sum + P.ada_b[l * 3072 + n0 + cc]; }
        __syncthreads();
    }
    float* cos_t = (float*)(P.ws + WS_ROPE); float* sin_t = cos_t + SEQ * 32;
    for (int i = get_bid() * 512 + tid; i < SEQ * 32; i += gridDim.x * 512) {
        const int pos = i >> 5, jj = i & 31, fi = jj & 15;
        const float inv = __builtin_amdgcn_exp2f(-(float)(2 * fi) * (13.287712379549449f / 32.f));
        const float ang = (float)(jj < 16 ? (pos >> 6) : (pos & 63)) * inv;
        cos_t[i] = __cosf(ang); sin_t[i] = __sinf(ang);
    }
}

template <bool FRAG = false>
DI void transpose_item(const float* W, int K, int N, bf16_t* WT, LAS float* scr, int item, int lane) {
    const int nblk = N / 32, kb = item / nblk, nb = item % nblk, k0 = 64 * kb, n0 = 32 * nb;
#pragma unroll 8
    for (int i = 0; i < 32; ++i) { const int kk = 2 * i + (lane >> 5); scr[kk * 33 + (lane & 31)] = W[(size_t)(k0 + kk) * N + n0 + (lane & 31)]; }
    asm volatile("s_waitcnt lgkmcnt(0)" ::: "memory");
    const int c = lane & 7;
#pragma unroll
    for (int j = 0; j < 4; ++j) { const int n = (lane >> 3) + 8 * j; const LAS float* sp = scr + (8 * c) * 33 + n;
        u32x4 o; o.x = pk2(sp[0 * 33], sp[1 * 33]); o.y = pk2(sp[2 * 33], sp[3 * 33]); o.z = pk2(sp[4 * 33], sp[5 * 33]); o.w = pk2(sp[6 * 33], sp[7 * 33]);
        if (FRAG) {
            const int nn = n0 + n, k8 = (k0 >> 3) + c;
            *(u32x4*)(WT + ((((nn >> 4) * 4 + (k8 >> 2)) * 64 + (k8 & 3) * 16 + (nn & 15)) * 8)) = o;
        } else *(u32x4*)(WT + (size_t)(n0 + n) * K + k0 + 8 * c) = o; }
    asm volatile("s_waitcnt lgkmcnt(0)" ::: "memory");
}

DI void phase_norm(const Params& P, LAS unsigned char* lds, int layer, int wv) {
    const int tid = get_tid(wv), lane = tid & 63, wave = tid >> 6;
    const int gw = get_bid() * 8 + wave, NGW = gridDim.x * 8;
    const int j = layer >> 1;
    LAS float* scr = (LAS float*)(lds + wave * 16384);
    bf16_t* WIN = (bf16_t*)(P.ws + WS_WIN); bf16_t* WOUT = (bf16_t*)(P.ws + WS_WOUT); bf16_t* WRG = (bf16_t*)(P.ws + WS_WRG);
    if ((layer & 1) == 0) {
        constexpr int I_IN = 16 * (EVEN_IN / 32), I_OUT = 32 * 32, I_RG = 32 * 8;
        for (int it = gw; it < I_IN + I_OUT + I_RG; it += NGW) {
            int r = it;
            if (r < I_IN) { transpose_item(P.ev_w_in + (size_t)j * 1024 * EVEN_IN, 1024, EVEN_IN, WIN, scr, r, lane); continue; } r -= I_IN;
            if (r < I_OUT) { transpose_item(P.ev_w_out + (size_t)j * 2048 * 1024, 2048, 1024, WOUT, scr, r, lane); continue; } r -= I_OUT;
            const int mat = r >> 3, sub = r & 7;
            const int dir = mat >> 4, gate = (mat >> 3) & 1, hd = mat & 7;
            const float* src = (gate == 0 ? P.ev_rg_wx : P.ev_rg_wa) + ((size_t)((j * 2 + dir) * 8 + hd)) * 16384;
            transpose_item<true>(src, 128, 128, WRG + (size_t)mat * 16384, scr, sub, lane);
        }
    } else {
        constexpr int I_IN = 16 * (ODD_IN / 32), I_OUT = 16 * 32;
        for (int it = gw; it < I_IN + I_OUT; it += NGW) {
            int r = it;
            if (r < I_IN) { transpose_item(P.od_w_in + (size_t)j * 1024 * ODD_IN, 1024, ODD_IN, WIN, scr, r, lane); continue; } r -= I_IN;
            transpose_item(P.od_w_out + (size_t)j * 1024 * 1024, 1024, 1024, WOUT, scr, r, lane);
        }
    }
    const float* hl = layer == 0 ? P.x : P.out; const float* hc = layer == 0 ? P.ctx : (const float*)(P.ws + WS_HCTX);
    const float* mod = (const float*)(P.ws + WS_MOD) + (size_t)layer * 9 * 3072;
    const float* nw = P.norm_w + layer * 1024;
    bf16_t* U = (bf16_t*)(P.ws + WS_OV);
    f32x4 w4[4], s4[4], h4[4];
#pragma unroll
    for (int q = 0; q < 4; ++q) w4[q] = *(const f32x4*)(nw + 4 * lane + 256 * q);
    int cur_m = -1;
    const int rpw = (MROWS + NGW - 1) / NGW;
    for (int R = gw * rpw; R < gw * rpw + rpw && R < MROWS; ++R) {
        const int b = R / LT, jr = R % LT;
        const float* src = jr < CTXL ? hc + ((size_t)b * CTXL + jr) * DM : hl + ((size_t)b * SEQ + (jr - CTXL)) * DM;
        const int mrow = jr < CTXL ? 8 : b;
        if (mrow != cur_m) {
            cur_m = mrow;
            const float* sh = mod + mrow * 3072; const float* sc = sh + 1024;
#pragma unroll
            for (int q = 0; q < 4; ++q) { s4[q] = *(const f32x4*)(sc + 4 * lane + 256 * q) + 1.f; h4[q] = *(const f32x4*)(sh + 4 * lane + 256 * q); }
        }
        f32x4 v[4]; float ss = 0.f;
#pragma unroll
        for (int q = 0; q < 4; ++q) { v[q] = *(const f32x4*)(src + 4 * lane + 256 * q); ss += (v[q][0] * v[q][0] + v[q][1] * v[q][1]) + (v[q][2] * v[q][2] + v[q][3] * v[q][3]); }
        const float rstd = rsqrtf(wave_sum(ss) * (1.f / DM) + RMS_EPS);
#pragma unroll
        for (int q = 0; q < 4; ++q) { const int k = 4 * lane + 256 * q;
            const f32x4 y = (v[q] * rstd) * w4[q]; const f32x4 o = y * s4[q] + h4[q];
            u32x2 w; w.x = pk2(o[0], o[1]); w.y = pk2(o[2], o[3]); *(u32x2*)(U + (size_t)R * DM + k) = w; }
    }
}

typedef _Float16 f16x2_t __attribute__((ext_vector_type(2)));
DI unsigned pkh2(float a, float b) { const f16x2_t v = {(_Float16)a, (_Float16)b}; return __builtin_bit_cast(unsigned, v); }
DI void unpkh2(unsigned u, float& a, float& b) { const f16x2_t v = __builtin_bit_cast(f16x2_t, u); a = (float)v[0]; b = (float)v[1]; }
constexpr int RG_UT = 0, RG_AL = 17408, RG_BL = 50176, RG_HP = 82944, RG_QA = 148480, RG_CAR = 152576, RG_FLAG = 153600, RG_END = 153664;
static_assert(RG_END <= LDS_BYTES - 256, "RG-LRU LDS map");
constexpr int CW_RG = 8192;
DI void rglru_item(const Params& P, LAS unsigned char* lds, int j, int item, int wv) {
    const int tid = get_tid(wv), lane = tid & 63, wave = tid >> 6, r = lane & 15, g = lane >> 4;
    const int grp = item / NCHUNK, ci = item % NCHUNK, b = grp >> 3, hd = grp & 7;
    bf16_t* p = (bf16_t*)(P.ws + WS_P);
    const bf16_t* WRG = (const bf16_t*)(P.ws + WS_WRG);
    unsigned long long* AGG = (unsigned long long*)(P.ws + WS_AGG);
    unsigned* cnt = (unsigned*)(P.ws + WS_CTL) + CW_RG + (j * 64 + grp) * 16;
    const int R0 = b * LT + ci * 64;
    const int seg_lo = b * LT + (ci < 4 ? 0 : CTXL), seg_hi = b * LT + (ci < 4 ? CTXL : LT);
    LAS bf16_t* UT = (LAS bf16_t*)(lds + RG_UT);
    LAS float* AL = (LAS float*)(lds + RG_AL);
    LAS float* BL = (LAS float*)(lds + RG_BL);
    LAS unsigned* HP = (LAS unsigned*)(lds + RG_HP);
    LAS float* QA = (LAS float*)(lds + RG_QA);
    LAS float* CAR = (LAS float*)(lds + RG_CAR);
    TP_START(10, lds, tid); TP_START(11, lds, tid);
    bf16x8 wfr[2][2][4];
    float prm[2][3];
#pragma unroll
    for (int dir = 0; dir < 2; ++dir) {
#pragma unroll
        for (int gt = 0; gt < 2; ++gt) {
            const bf16_t* W = WRG + (size_t)((dir * 2 + gt) * 8 + hd) * 16384 + (wave * 4 * 64 + lane) * 8;
#pragma unroll
            for (int ks = 0; ks < 4; ++ks) wfr[dir][gt][ks] = *(const bf16x8*)(W + ks * 512);
        }
        const int idx = (j * 2 + dir) * 1024 + hd * 128 + 16 * wave + r;
        prm[dir][0] = P.ev_rg_bx[idx]; prm[dir][1] = P.ev_rg_ba[idx]; prm[dir][2] = P.ev_rg_lambda[idx];
    }
    {
        LAS bf16_t* XT = (LAS bf16_t*)(lds + RG_HP);
#pragma unroll
        for (int rep = 0; rep < 3; ++rep) {
            const int idx = tid + rep * 512, tr = idx >> 4, c0 = (idx & 15) * 8;
            if (idx < 67 * 16) {
                const int Rg = R0 + tr - 1;
                u32x4 xv = {0u, 0u, 0u, 0u};
                if (Rg >= seg_lo && Rg < seg_hi) xv = *(const u32x4*)(p + (size_t)Rg * EVEN_IN + hd * 128 + c0);
                *(LAS u32x4*)(XT + tr * 128 + c0) = xv;
            }
        }
        const int c0 = (tid & 15) * 8, cg0 = hd * 128 + c0;
        float wv4[4][8], bias[8];
        { const f32x4 b0 = *(const f32x4*)(P.ev_conv_b + j * 1024 + cg0), b1 = *(const f32x4*)(P.ev_conv_b + j * 1024 + cg0 + 4);
          bias[0] = b0[0]; bias[1] = b0[1]; bias[2] = b0[2]; bias[3] = b0[3]; bias[4] = b1[0]; bias[5] = b1[1]; bias[6] = b1[2]; bias[7] = b1[3]; }
#pragma unroll
        for (int k = 0; k < 4; ++k) { const float* wk = P.ev_conv_w + (size_t)(j * 4 + k) * 1024 + cg0; const f32x4 w0 = *(const f32x4*)wk, w1 = *(const f32x4*)(wk + 4);
            wv4[k][0] = w0[0]; wv4[k][1] = w0[1]; wv4[k][2] = w0[2]; wv4[k][3] = w0[3]; wv4[k][4] = w1[0]; wv4[k][5] = w1[1]; wv4[k][6] = w1[2]; wv4[k][7] = w1[3]; }
        __syncthreads();
#pragma unroll
        for (int rep = 0; rep < 2; ++rep) {
            const int t = (tid >> 4) + rep * 32;
            float acc[8];
#pragma unroll
            for (int e = 0; e < 8; ++e) acc[e] = bias[e];
#pragma unroll
            for (int k = 0; k < 4; ++k) {
                const u32x4 xv = *(const LAS u32x4*)(XT + (t + k) * 128 + c0);
                acc[0] += wv4[k][0] * __uint_as_float(xv.x << 16); acc[1] += wv4[k][1] * __uint_as_float(xv.x & 0xffff0000u);
                acc[2] += wv4[k][2] * __uint_as_float(xv.y << 16); acc[3] += wv4[k][3] * __uint_as_float(xv.y & 0xffff0000u);
                acc[4] += wv4[k][4] * __uint_as_float(xv.z << 16); acc[5] += wv4[k][5] * __uint_as_float(xv.z & 0xffff0000u);
                acc[6] += wv4[k][6] * __uint_as_float(xv.w << 16); acc[7] += wv4[k][7] * __uint_as_float(xv.w & 0xffff0000u);
            }
            u32x4 o; o.x = pk2(acc[0], acc[1]); o.y = pk2(acc[2], acc[3]); o.z = pk2(acc[4], acc[5]); o.w = pk2(acc[6], acc[7]);
            *(LAS u32x4*)(UT + t * 136 + c0) = o;
        }
    }
    __syncthreads();
    TP_STOP(11, lds, tid);
#pragma unroll
    for (int dir = 0; dir < 2; ++dir) {
        TP_START(12, lds, tid); TP_START(16, lds, tid);
        f32x4 ax[4], aa[4];
#pragma unroll
        for (int m = 0; m < 4; ++m) { ax[m] = (f32x4){0.f, 0.f, 0.f, 0.f}; aa[m] = (f32x4){0.f, 0.f, 0.f, 0.f}; }
#pragma unroll
        for (int ks = 0; ks < 4; ++ks) {
#pragma unroll
            for (int m = 0; m < 4; ++m) {
                const bf16x8 a = *(const LAS bf16x8*)(UT + (16 * m + r) * 136 + 32 * ks + 8 * g);
                ax[m] = MFMA16(a, wfr[dir][0][ks], ax[m]); aa[m] = MFMA16(a, wfr[dir][1][ks], aa[m]);
            }
        }
        asm volatile("" :: "v"(ax[0]), "v"(ax[1]), "v"(ax[2]), "v"(ax[3]), "v"(aa[0]), "v"(aa[1]), "v"(aa[2]), "v"(aa[3]));
        TP_STOP(16, lds, tid); TP_START(17, lds, tid);
        {
            const int c = 16 * wave + r;
            const float bxv = prm[dir][0], bav = prm[dir][1], lam = prm[dir][2];
            const float sp = softplus_neg(lam);
#pragma unroll
            for (int m = 0; m < 4; ++m)
#pragma unroll
                for (int i = 0; i < 4; ++i) {
                    const int t = 16 * m + 4 * g + i;
                    const float gx = sigm(ax[m][i] + bxv), ga = sigm(aa[m][i] + bav);
                    const float la = -8.f * ga * sp;
                    const float a = __expf(la), mult = __builtin_amdgcn_sqrtf(neg_expm1(2.f * la));
                    const float uv = bf2f(UT[t * 136 + c]);
                    AL[t * 128 + c] = a; BL[t * 128 + c] = mult * gx * uv;
                }
        }
        asm volatile("s_waitcnt lgkmcnt(0)" ::: "memory");
        TP_STOP(17, lds, tid); TP_START(18, lds, tid);
        __syncthreads();
        TP_STOP(18, lds, tid);
        TP_STOP(12, lds, tid); TP_START(13, lds, tid);
        {
            const int c = tid & 127, q = tid >> 7;
            float A = 1.f, B = 0.f;
#pragma unroll
            for (int s = 0; s < 16; ++s) { const int t = dir == 0 ? 16 * q + s : 16 * q + 15 - s; const float a = AL[t * 128 + c], bb = BL[t * 128 + c]; B = a * B + bb; A *= a; }
            QA[(q * 128 + c) * 2] = A; QA[(q * 128 + c) * 2 + 1] = B;
            __syncthreads();
            float h = 0.f, pc = 1.f;
            const int nprev = dir == 0 ? q : 3 - q;
            for (int qq = 0; qq < nprev; ++qq) { const int qi = dir == 0 ? qq : 3 - qq; const float a = QA[(qi * 128 + c) * 2]; h = a * h + QA[(qi * 128 + c) * 2 + 1]; pc *= a; }
#pragma unroll
            for (int s = 0; s < 16; ++s) { const int t = dir == 0 ? 16 * q + s : 16 * q + 15 - s; const float a = AL[t * 128 + c]; h = a * h + BL[t * 128 + c]; pc *= a;
                HP[(dir * 64 + t) * 128 + c] = pkh2(h, pc); }
            if (nprev == 3) {
                const unsigned long long v = ((unsigned long long)__float_as_uint(h) << 32) | __float_as_uint(pc);
                __hip_atomic_store(AGG + ((size_t)(dir * NB + b) * NCHUNK + ci) * 1024 + hd * 128 + c, v, __ATOMIC_RELAXED, __HIP_MEMORY_SCOPE_AGENT);
            }
        }
        __syncthreads();
        TP_STOP(13, lds, tid);
    }
    TP_START(14, lds, tid);
    u32x4 gpre[2];
#pragma unroll
    for (int rep = 0; rep < 2; ++rep) { const int idx = tid + rep * 512; gpre[rep] = *(const u32x4*)(p + (size_t)(R0 + (idx >> 4)) * EVEN_IN + 1536 + hd * 128 + (idx & 15) * 8); }
    asm volatile("s_waitcnt vmcnt(0)" ::: "memory");
    __syncthreads();
    if (tid == 0) {
        __hip_atomic_fetch_add(cnt, 1u, __ATOMIC_RELAXED, __HIP_MEMORY_SCOPE_AGENT);
        unsigned spins = 0;
        while (__hip_atomic_load(cnt, __ATOMIC_RELAXED, __HIP_MEMORY_SCOPE_AGENT) < (unsigned)NCHUNK) { __builtin_amdgcn_s_sleep(2); if (++spins > (1u << 22)) break; }
    }
    __syncthreads();
    TP_STOP(14, lds, tid); TP_START(15, lds, tid);
    if (tid < 256) {
        const int dir = tid >> 7, c = tid & 127;
        const int pos = dir == 0 ? ci : (ci < 4 ? 3 - ci : 39 - ci);
        float h = 0.f;
        const unsigned long long* ag = AGG + (size_t)(dir * NB + b) * NCHUNK * 1024 + hd * 128 + c;
#pragma unroll 1
        for (int base = 0; base < pos; base += 18) {
            unsigned long long v[18];
#pragma unroll
            for (int k = 0; k < 18; ++k) { const int pp = base + k < pos ? base + k : pos - 1; const int cc = dir == 0 ? pp : (pp < 4 ? 3 - pp : 39 - pp);
                v[k] = __hip_atomic_load(ag + (size_t)cc * 1024, __ATOMIC_RELAXED, __HIP_MEMORY_SCOPE_AGENT); }
#pragma unroll
            for (int k = 0; k < 18; ++k) if (base + k < pos) h = __uint_as_float((unsigned)v[k]) * h + __uint_as_float((unsigned)(v[k] >> 32));
        }
        CAR[dir * 128 + c] = h;
    }
    __syncthreads();
#pragma unroll
    for (int rep = 0; rep < 2; ++rep) {
        const int idx = tid + rep * 512, t = idx >> 4, c0 = (idx & 15) * 8;
        bf16_t* gp = p + (size_t)(R0 + t) * EVEN_IN + 1536 + hd * 128 + c0;
        const u32x4 gv = gpre[rep];
        float y[8];
#pragma unroll
        for (int e = 0; e < 8; ++e) {
            float h0, p0, h1, p1; unpkh2(HP[t * 128 + c0 + e], h0, p0); unpkh2(HP[(64 + t) * 128 + c0 + e], h1, p1);
            y[e] = (h0 + p0 * CAR[c0 + e]) + (h1 + p1 * CAR[128 + c0 + e]);
        }
        const float gg[8] = {__uint_as_float(gv.x << 16), __uint_as_float(gv.x & 0xffff0000u), __uint_as_float(gv.y << 16), __uint_as_float(gv.y & 0xffff0000u),
                             __uint_as_float(gv.z << 16), __uint_as_float(gv.z & 0xffff0000u), __uint_as_float(gv.w << 16), __uint_as_float(gv.w & 0xffff0000u)};
        u32x4 o;
        o.x = pk2(y[0] * gg[0] * sigm(gg[0]), y[1] * gg[1] * sigm(gg[1])); o.y = pk2(y[2] * gg[2] * sigm(gg[2]), y[3] * gg[3] * sigm(gg[3]));
        o.z = pk2(y[4] * gg[4] * sigm(gg[4]), y[5] * gg[5] * sigm(gg[5])); o.w = pk2(y[6] * gg[6] * sigm(gg[6]), y[7] * gg[7] * sigm(gg[7]));
        *(u32x4*)gp = o;
    }
    __syncthreads();
    TP_STOP(15, lds, tid); TP_STOP(10, lds, tid);
}

DI void rope8v(u32x4& v, const f32x4 cs, const f32x4 sn) {
    unsigned* w = (unsigned*)&v;
#pragma unroll
    for (int i = 0; i < 4; ++i) { const float t1 = __uint_as_float(w[i] << 16), t2 = __uint_as_float(w[i] & 0xffff0000u); w[i] = pk2(t1 * cs[i] - t2 * sn[i], t1 * sn[i] + t2 * cs[i]); }
}
DI void rope8(u32x4& v, const float* cs, const float* sn) { rope8v(v, *(const f32x4*)cs, *(const f32x4*)sn); }
typedef short v4i16_a __attribute__((ext_vector_type(4)));
DI void attn_item(const Params& P, LAS unsigned char* lds, int j, int item, int wv) {
    const int tid = get_tid(wv), lane = tid & 63, wave = tid >> 6, r = lane & 31, h = lane >> 5;
    const bool is_lat = item < 512;
    int b, qb, kvh;
    if (is_lat) { b = item >> 6; qb = (item >> 2) & 15; kvh = item & 3; } else { const int it = item - 512; b = it >> 3; qb = (it >> 2) & 1; kvh = it & 3; }
    bf16_t* p = (bf16_t*)(P.ws + WS_P);
    const float* cos_t = (const float*)(P.ws + WS_ROPE); const float* sin_t = cos_t + SEQ * 32;
    LAS unsigned char* QL = lds + 36864 + wave * 9216;
    TP_START(1, lds, tid);
    const int hq = 4 * kvh + (wave >> 1), ql0 = qb * 128 + 64 * (wave & 1);
    const size_t rowbase = (size_t)b * LT + (is_lat ? CTXL : 0);
    {
        const int chq = lane & 7;
#pragma unroll
        for (int k = 0; k < 8; ++k) {
            const int row = (lane >> 3) + 8 * k, qi = ql0 + row;
            u32x4 v = *(const u32x4*)(p + (rowbase + qi) * EVEN_IN + 2560 + hq * 64 + 8 * chq);
            if (is_lat) rope8(v, cos_t + qi * 32 + 4 * chq, sin_t + qi * 32 + 4 * chq);
            *(LAS u32x4*)(QL + row * 144 + chq * 16) = v;
        }
    }
    const float sink2 = P.ev_sink[j * 16 + hq] * LOG2E;
    float mrun[2] = {sink2, sink2}, lrun[2] = {h == 0 ? 1.f : 0.f, h == 0 ? 1.f : 0.f};
    f32x16 O[2][2];
#pragma unroll
    for (int a = 0; a < 2; ++a)
#pragma unroll
        for (int c = 0; c < 2; ++c)
#pragma unroll
            for (int i = 0; i < 16; ++i) O[a][c][i] = 0.f;
    const int w_lo = (is_lat && qb == 0) ? 2 : 0, w_hi = (is_lat && qb == 15) ? 3 : 5;
    const int nT = is_lat ? 4 + (w_hi - w_lo + 1) : 4;
    const float SC = 0.125f * LOG2E, NEG = -1e30f;
    const int key = tid >> 3, chn = tid & 7;
    u32x4 kreg, vreg; f32x4 creg, sreg;
#define ATT_K0(t) ((t) < 4 ? 64 * (t) : qb * 128 - 128 + 64 * (w_lo + (t) - 4))
#define ATT_LOAD(t) do { const bool win_ = (t) >= 4; const int k0_ = ATT_K0(t); \
        const bf16_t* kp_ = p + ((size_t)b * LT + (win_ ? CTXL : 0) + k0_ + key) * EVEN_IN + 1024 + kvh * 64 + 8 * chn; \
        kreg = *(const u32x4*)kp_; vreg = *(const u32x4*)(kp_ + 256); \
        if (win_) { creg = *(const f32x4*)(cos_t + (k0_ + key) * 32 + 4 * chn); sreg = *(const f32x4*)(sin_t + (k0_ + key) * 32 + 4 * chn); } } while (0)
#define ATT_STORE(t, buf) do { const bool win_ = (t) >= 4; \
        if (win_) rope8v(kreg, creg, sreg); \
        *(LAS u32x4*)(lds + (buf) * 18432 + key * 144 + chn * 16) = kreg; *(LAS u32x4*)(lds + (buf) * 18432 + 9216 + key * 144 + chn * 16) = vreg; } while (0)
    TP_START(2, lds, tid);
    ATT_LOAD(0); ATT_STORE(0, 0);
    if (nT > 1) ATT_LOAD(1);
#pragma unroll 1
    for (int t = 0; t < nT; ++t) {
        TP_START(4, lds, tid);
        __syncthreads();
        TP_STOP(4, lds, tid);
        if (t + 1 < nT) { ATT_STORE(t + 1, (t + 1) & 1); if (t + 2 < nT) ATT_LOAD(t + 2); }
        TP_START(3, lds, tid);
        const bool win = t >= 4;
        const int k0 = ATT_K0(t);
        const int dq = k0 - ql0;
        if (win && (dq >= 192 || dq <= -192)) continue;
        const bool need_mask = win && (dq >= 128 || dq <= -128);
        const LAS unsigned char* KL = lds + (t & 1) * 18432;
        const LAS bf16_t* VL = (const LAS bf16_t*)(lds + (t & 1) * 18432 + 9216);
#pragma unroll
        for (int qt = 0; qt < 2; ++qt) {
            f32x16 s0, s1;
#pragma unroll
            for (int i = 0; i < 16; ++i) { s0[i] = 0.f; s1[i] = 0.f; }
#pragma unroll
            for (int ks = 0; ks < 4; ++ks) {
                const bf16x8 qfr = *(const LAS bf16x8*)(QL + (32 * qt + r) * 144 + (16 * ks + 8 * h) * 2);
                const bf16x8 k0f = *(const LAS bf16x8*)(KL + r * 144 + (16 * ks + 8 * h) * 2), k1f = *(const LAS bf16x8*)(KL + (32 + r) * 144 + (16 * ks + 8 * h) * 2);
                s0 = MFMA32(k0f, qfr, s0); s1 = MFMA32(k1f, qfr, s1);
            }
            const int qpos = ql0 + 32 * qt + r;
            float mx = NEG;
            if (need_mask) {
#pragma unroll
                for (int i = 0; i < 16; ++i) {
                    const int d0 = qpos - (k0 + crow(i, h)), d1 = d0 - 32;
                    float v0 = s0[i] * SC, v1 = s1[i] * SC;
                    if (d0 > 128 || d0 < -128) v0 = NEG;
                    if (d1 > 128 || d1 < -128) v1 = NEG;
                    s0[i] = v0; s1[i] = v1; mx = fmaxf(mx, fmaxf(v0, v1));
                }
            } else {
#pragma unroll
                for (int i = 0; i < 16; ++i) { s0[i] *= SC; s1[i] *= SC; mx = fmaxf(mx, fmaxf(s0[i], s1[i])); }
            }
            mx = fmaxf(mx, shfl_xor_f(mx, 32));
            const float mn = fmaxf(mrun[qt], mx), alpha = __builtin_amdgcn_exp2f(mrun[qt] - mn);
            mrun[qt] = mn;
            float ls = 0.f;
#pragma unroll
            for (int i = 0; i < 16; ++i) { s0[i] = __builtin_amdgcn_exp2f(s0[i] - mn); s1[i] = __builtin_amdgcn_exp2f(s1[i] - mn); ls += s0[i] + s1[i]; }
            lrun[qt] = lrun[qt] * alpha + ls;
#pragma unroll
            for (int dt = 0; dt < 2; ++dt)
#pragma unroll
                for (int i = 0; i < 16; ++i) O[dt][qt][i] *= alpha;
            bf16x8 pf[2][2];
#pragma unroll
            for (int s = 0; s < 2; ++s) {
                u32x4 a, c;
                a.x = pk2(s0[8 * s + 0], s0[8 * s + 1]); a.y = pk2(s0[8 * s + 2], s0[8 * s + 3]); a.z = pk2(s0[8 * s + 4], s0[8 * s + 5]); a.w = pk2(s0[8 * s + 6], s0[8 * s + 7]);
                c.x = pk2(s1[8 * s + 0], s1[8 * s + 1]); c.y = pk2(s1[8 * s + 2], s1[8 * s + 3]); c.z = pk2(s1[8 * s + 4], s1[8 * s + 5]); c.w = pk2(s1[8 * s + 6], s1[8 * s + 7]);
                pf[0][s] = __builtin_bit_cast(bf16x8, a); pf[1][s] = __builtin_bit_cast(bf16x8, c);
            }
            const int gq = (lane >> 4) & 1, qq4 = (lane & 15) >> 2, pp4 = lane & 3;
#pragma unroll
            for (int dt = 0; dt < 2; ++dt)
#pragma unroll
                for (int kt = 0; kt < 2; ++kt)
#pragma unroll
                    for (int s = 0; s < 2; ++s) {
                        const LAS bf16_t* vp = VL + (32 * kt + 16 * s + 4 * h + qq4) * 72 + 32 * dt + 16 * gq + 4 * pp4;
                        const v4i16_a lo = __builtin_amdgcn_ds_read_tr16_b64_v4i16((LAS v4i16_a*)vp);
                        const v4i16_a hi = __builtin_amdgcn_ds_read_tr16_b64_v4i16((LAS v4i16_a*)(vp + 8 * 72));
                        const bf16x8 vf = {lo[0], lo[1], lo[2], lo[3], hi[0], hi[1], hi[2], hi[3]};
                        O[dt][qt] = MFMA32(vf, pf[kt][s], O[dt][qt]);
                    }
            __builtin_amdgcn_sched_barrier(0);
        }
        TP_STOP(3, lds, tid);
    }
    TP_STOP(2, lds, tid);
#undef ATT_K0
#undef ATT_LOAD
#undef ATT_STORE
    {
        const int chq = lane & 7;
        u32x4 gate[8];
#pragma unroll
        for (int k = 0; k < 8; ++k) gate[k] = *(const u32x4*)(p + (rowbase + ql0 + (lane >> 3) + 8 * k) * EVEN_IN + 3584 + hq * 64 + 8 * chq);
#pragma unroll
        for (int qt = 0; qt < 2; ++qt) {
            const float lt = lrun[qt] + shfl_xor_f(lrun[qt], 32), inv = __builtin_amdgcn_rcpf(lt);
#pragma unroll
            for (int dt = 0; dt < 2; ++dt)
#pragma unroll
                for (int i4 = 0; i4 < 4; ++i4) {
                    u32x2 o; o.x = pk2(O[dt][qt][4 * i4 + 0] * inv, O[dt][qt][4 * i4 + 1] * inv); o.y = pk2(O[dt][qt][4 * i4 + 2] * inv, O[dt][qt][4 * i4 + 3] * inv);
                    *(LAS u32x2*)(QL + (32 * qt + r) * 144 + (32 * dt + 8 * i4 + 4 * h) * 2) = o;
                }
        }
#pragma unroll
        for (int k = 0; k < 8; ++k) {
            const int row = (lane >> 3) + 8 * k;
            const u32x4 ov = *(const LAS u32x4*)(QL + row * 144 + chq * 16);
            const unsigned* ow = (const unsigned*)&ov; const unsigned* gw = (const unsigned*)&gate[k];
            u32x4 res; unsigned* rw = (unsigned*)&res;
#pragma unroll
            for (int e = 0; e < 4; ++e) {
                const float g0 = __uint_as_float(gw[e] << 16), g1 = __uint_as_float(gw[e] & 0xffff0000u);
                rw[e] = pk2(__uint_as_float(ow[e] << 16) * g0 * sigm(g0), __uint_as_float(ow[e] & 0xffff0000u) * g1 * sigm(g1));
            }
            *(u32x4*)(p + (rowbase + ql0 + row) * EVEN_IN + 2560 + hq * 64 + 8 * chq) = res;
        }
    }
    __syncthreads();
    TP_STOP(1, lds, tid);
}

constexpr int G2_QX = 0, G2_KF = 17408, G2_K2 = 60928, G2_VS = 79360, G2_AM = 96768, G2_ST = 105984, G2_PS = 140800, G2_BL = 144896, G2_Q1 = 145408, G2_END = 162816;
static_assert(G2_END <= LDS_BYTES - 256, "GLA LDS map");
typedef short v4i16_t __attribute__((ext_vector_type(4)));
DI bf16x8 frag_tr(const LAS bf16_t* M, int stride, int k0, int n0, int lane) {
    const int i = lane & 15, g = lane >> 4, q = i >> 2, pp = i & 3;
    const LAS bf16_t* a0 = M + (k0 + 8 * g + q) * stride + n0 + 4 * pp;
    const v4i16_t lo = __builtin_amdgcn_ds_read_tr16_b64_v4i16((LAS v4i16_t*)a0);
    const v4i16_t hi = __builtin_amdgcn_ds_read_tr16_b64_v4i16((LAS v4i16_t*)(a0 + 4 * stride));
    return (bf16x8){lo[0], lo[1], lo[2], lo[3], hi[0], hi[1], hi[2], hi[3]};
}

template <int DIR>
DI void gla2_item(const Params& P, LAS unsigned char* lds, int layer_j, int b, int hd, int wv) {
    const int tid = get_tid(wv), lane = tid & 63, wave = tid >> 6, r = lane & 15, g = lane >> 4;
    bf16_t* p = (bf16_t*)(P.ws + WS_P);
    LAS bf16_t* QX = (LAS bf16_t*)(lds + G2_QX); LAS bf16_t* KF = (LAS bf16_t*)(lds + G2_KF); LAS bf16_t* K2 = (LAS bf16_t*)(lds + G2_K2);
    LAS bf16_t* VS = (LAS bf16_t*)(lds + G2_VS); LAS bf16_t* AM = (LAS bf16_t*)(lds + G2_AM); LAS bf16_t* ST = (LAS bf16_t*)(lds + G2_ST);
    LAS float* PS8 = (LAS float*)(lds + G2_PS); LAS float* BLAST = (LAS float*)(lds + G2_BL); LAS bf16_t* Q1 = (LAS bf16_t*)(lds + G2_Q1);
    const int d0 = 2 * lane, tg = wave, I = tg >> 1, half = tg & 1;
    float lbv[2] = {0.f, 0.f};
    if (layer_j > 0) { lbv[0] = sigm(P.od_lb_raw[1024 + hd * 128 + d0] - P.od_lb_raw[hd * 128 + d0]); lbv[1] = sigm(P.od_lb_raw[1024 + hd * 128 + d0 + 1] - P.od_lb_raw[hd * 128 + d0 + 1]); }
    TP_START(20, lds, tid);
    for (int i = tid; i < (9216 + 34816) / 4; i += 512) ((LAS unsigned*)(lds + G2_AM))[i] = 0u;
    f32x4 st[8];
#pragma unroll
    for (int e = 0; e < 8; ++e) st[e] = (f32x4){0.f, 0.f, 0.f, 0.f};
    unsigned zn[8], qn[8]; u32x4 vn[2];
#define G2_OFFZ(s) ((unsigned)((DIR == 0 ? 8 * tg + (s) : 63 - 8 * tg - (s)) * ODD_IN + d0) * 2u)
#define G2_OFFV(rep) ((unsigned)((DIR == 0 ? ((tid + (rep) * 512) >> 4) : 63 - ((tid + (rep) * 512) >> 4)) * ODD_IN + 8 * ((tid + (rep) * 512) & 15)) * 2u)
    const size_t colz = (size_t)DIR * 1024 + hd * 128, colq = 3072 + hd * 128, colv = 2048 + hd * 128;
    {
        const int chunk = DIR == 0 ? 0 : 3;
        const char* slab = (const char*)(p + ((size_t)b * LT + (size_t)chunk * 64) * ODD_IN);
#pragma unroll
        for (int s = 0; s < 8; ++s) { zn[s] = *(const unsigned*)(slab + colz * 2 + G2_OFFZ(s)); qn[s] = *(const unsigned*)(slab + colq * 2 + G2_OFFZ(s)); }
#pragma unroll
        for (int rep = 0; rep < 2; ++rep) vn[rep] = *(const u32x4*)(slab + colv * 2 + G2_OFFV(rep));
    }
    __syncthreads();
#pragma unroll 1
    for (int step = 0; step < NCHUNK; ++step) {
        const int chunk = DIR == 0 ? step : (step < 4 ? 3 - step : 39 - step);
        const size_t Rc0 = (size_t)b * LT + (size_t)chunk * 64;
        unsigned zc[8], qc[8]; u32x4 vc[2];
#pragma unroll
        for (int s = 0; s < 8; ++s) { zc[s] = zn[s]; qc[s] = qn[s]; }
        vc[0] = vn[0]; vc[1] = vn[1];
        TP_START(21, lds, tid);
        float el[8][2], kk[8][2], qq[8][2];
        {
            float run0 = 1.f, run1 = 1.f;
#pragma unroll
            for (int s = 0; s < 8; ++s) {
                const float z0 = __uint_as_float(zc[s] << 16), z1 = __uint_as_float(zc[s] & 0xffff0000u);
                const float t0 = __expf(-z0), t1 = __expf(-z1), sg0 = __builtin_amdgcn_rcpf(1.f + t0), sg1 = __builtin_amdgcn_rcpf(1.f + t1);
                const float f0 = fmaxf(lbv[0] + (1.f - lbv[0]) * sg0, 1e-30f), f1 = fmaxf(lbv[1] + (1.f - lbv[1]) * sg1, 1e-30f);
                kk[s][0] = (1.f - lbv[0]) * (t0 * sg0); kk[s][1] = (1.f - lbv[1]) * (t1 * sg1);
                run0 = fmaxf(run0 * f0, 1e-35f); run1 = fmaxf(run1 * f1, 1e-35f); el[s][0] = run0; el[s][1] = run1;
                const float q0 = __uint_as_float(qc[s] << 16), q1 = __uint_as_float(qc[s] & 0xffff0000u);
                qq[s][0] = q0 * __builtin_amdgcn_rcpf(1.f + __expf(-q0)); qq[s][1] = q1 * __builtin_amdgcn_rcpf(1.f + __expf(-q1));
                if ((s & 1) == 1) __builtin_amdgcn_sched_barrier(0);
            }
            *(LAS f32x2*)(PS8 + tg * 128 + d0) = (f32x2){run0, run1};
#pragma unroll
            for (int rep = 0; rep < 2; ++rep) { const int idx = tid + rep * 512, tau = idx >> 4, chn = idx & 15; *(LAS u32x4*)(VS + tau * 136 + 8 * chn) = vc[rep]; }
        }
        __syncthreads();
        TP_STOP(21, lds, tid); TP_START(22, lds, tid);
        float RI[2];
        {
            float T[8][2];
#pragma unroll
            for (int q8 = 0; q8 < 8; ++q8) { const f32x2 t = *(const LAS f32x2*)(PS8 + q8 * 128 + d0); T[q8][0] = t[0]; T[q8][1] = t[1]; }
            float pre[2], fac[4][2], f4[2];
#pragma unroll
            for (int x = 0; x < 2; ++x) {
                const float P0 = T[0][x] * T[1][x], P1 = T[2][x] * T[3][x], P2 = T[4][x] * T[5][x], P3 = T[6][x] * T[7][x];
                pre[x] = half ? (I == 0 ? T[0][x] : (I == 1 ? T[2][x] : (I == 2 ? T[4][x] : T[6][x]))) : 1.f;
                RI[x] = I == 0 ? 1.f : (I == 1 ? P0 : (I == 2 ? P0 * P1 : P0 * P1 * P2));
                float cur = 1.f;
                fac[0][x] = cur; if (I <= 0) cur *= P0;
                fac[1][x] = cur; if (I <= 1) cur *= P1;
                fac[2][x] = cur; if (I <= 2) cur *= P2;
                fac[3][x] = cur; cur *= P3;
                f4[x] = cur;
                if (tg == 0) BLAST[d0 + x] = P0 * P1 * P2 * P3;
            }
            unsigned w0[4], w1[4];
#pragma unroll
            for (int s = 0; s < 8; ++s) {
                const int tau = 8 * tg + s;
                const float e00 = fmaxf(pre[0] * el[s][0], 1e-35f), e01 = fmaxf(pre[1] * el[s][1], 1e-35f);
                const float qi0 = qq[s][0] * e00, qi1 = qq[s][1] * e01;
                const float kd0 = kk[s][0] * __builtin_amdgcn_rcpf(e00), kd1 = kk[s][1] * __builtin_amdgcn_rcpf(e01);
                *(LAS unsigned*)(QX + tau * 136 + d0) = pk2(qi0, qi1);
                *(LAS unsigned*)(Q1 + tau * 136 + d0) = pk2(qi0 * RI[0], qi1 * RI[1]);
                if (I <= 0) *(LAS unsigned*)(KF + (0 + tau) * 136 + d0) = pk2(kd0 * fac[0][0], kd1 * fac[0][1]);
                if (I <= 1) *(LAS unsigned*)(KF + (16 + tau) * 136 + d0) = pk2(kd0 * fac[1][0], kd1 * fac[1][1]);
                if (I <= 2) *(LAS unsigned*)(KF + (48 + tau) * 136 + d0) = pk2(kd0 * fac[2][0], kd1 * fac[2][1]);
                *(LAS unsigned*)(KF + (96 + tau) * 136 + d0) = pk2(kd0 * fac[3][0], kd1 * fac[3][1]);
                const unsigned h0 = f2bf(kd0 * f4[0]), h1 = f2bf(kd1 * f4[1]);
                if (s & 1) { w0[s >> 1] |= h0 << 16; w1[s >> 1] |= h1 << 16; } else { w0[s >> 1] = h0; w1[s >> 1] = h1; }
                if ((s & 1) == 1) __builtin_amdgcn_sched_barrier(0);
            }
            *(LAS u32x4*)(K2 + (d0 + 0) * 72 + 8 * tg) = (u32x4){w0[0], w0[1], w0[2], w0[3]};
            *(LAS u32x4*)(K2 + (d0 + 1) * 72 + 8 * tg) = (u32x4){w1[0], w1[1], w1[2], w1[3]};
        }
        __syncthreads();
        TP_STOP(22, lds, tid); TP_START(23, lds, tid);
        if (step + 1 < NCHUNK) {
            const int nchunk = DIR == 0 ? step + 1 : (step + 1 < 4 ? 2 - step : 38 - step);
            const char* slab = (const char*)(p + ((size_t)b * LT + (size_t)nchunk * 64) * ODD_IN);
#pragma unroll
            for (int s = 0; s < 8; ++s) { zn[s] = *(const unsigned*)(slab + colz * 2 + G2_OFFZ(s)); qn[s] = *(const unsigned*)(slab + colq * 2 + G2_OFFZ(s)); }
#pragma unroll
            for (int rep = 0; rep < 2; ++rep) vn[rep] = *(const u32x4*)(slab + colv * 2 + G2_OFFV(rep));
        }
#pragma unroll 1
        for (int bi = wave; bi < 10; bi += 8) {
            const int Ib = bi < 1 ? 0 : (bi < 3 ? 1 : (bi < 6 ? 2 : 3)), Jb = bi - (Ib * (Ib + 1)) / 2;
            const int foff = Ib == 0 ? 0 : (Ib == 1 ? 16 : (Ib == 2 ? 48 : 96));
            f32x4 acc = {0.f, 0.f, 0.f, 0.f};
#pragma unroll
            for (int ks = 0; ks < 4; ++ks) {
                const bf16x8 a = *(const LAS bf16x8*)(QX + (16 * Ib + r) * 136 + 32 * ks + 8 * g);
                const bf16x8 bb = *(const LAS bf16x8*)(KF + (foff + 16 * Jb + r) * 136 + 32 * ks + 8 * g);
                acc = MFMA16(a, bb, acc);
            }
#pragma unroll
            for (int i = 0; i < 4; ++i) { float v = acc[i]; if (Jb == Ib && r > 4 * g + i) v = 0.f; AM[(16 * Ib + 4 * g + i) * 72 + 16 * Jb + r] = (bf16_t)f2bf(v); }
        }
        __syncthreads();
        TP_STOP(23, lds, tid); TP_START(24, lds, tid);
        {
            const int tt = wave >> 1, eb = 4 * (wave & 1);
            char* oslab = (char*)(p + Rc0 * ODD_IN + colz);
            bf16x8 aq[4], am[2];
#pragma unroll
            for (int ks = 0; ks < 4; ++ks) aq[ks] = *(const LAS bf16x8*)(Q1 + (16 * tt + r) * 136 + 32 * ks + 8 * g);
#pragma unroll
            for (int ks = 0; ks < 2; ++ks) am[ks] = *(const LAS bf16x8*)(AM + (16 * tt + r) * 72 + 32 * ks + 8 * g);
#pragma unroll
            for (int e4 = 0; e4 < 4; ++e4) {
                const int et = eb + e4;
                f32x4 acc = {0.f, 0.f, 0.f, 0.f};
#pragma unroll
                for (int ks = 0; ks < 4; ++ks) { const bf16x8 bb = *(const LAS bf16x8*)(ST + (16 * et + r) * 136 + 32 * ks + 8 * g); acc = MFMA16(aq[ks], bb, acc); }
#pragma unroll
                for (int ks = 0; ks < 2; ++ks) acc = MFMA16(am[ks], frag_tr(VS, 136, 32 * ks, 16 * et, lane), acc);
#pragma unroll
                for (int i = 0; i < 4; ++i) {
                    const int tau = 16 * tt + 4 * g + i;
                    const unsigned off = (unsigned)((DIR == 0 ? tau : 63 - tau) * ODD_IN + 16 * et + r) * 2u;
                    *(bf16_t*)(oslab + off) = (bf16_t)f2bf(acc[i]);
                }
                __builtin_amdgcn_sched_barrier(0);
            }
            float bl[4];
#pragma unroll
            for (int i = 0; i < 4; ++i) bl[i] = BLAST[16 * wave + 4 * g + i];
            bf16x8 ak[2];
#pragma unroll
            for (int ks = 0; ks < 2; ++ks) ak[ks] = *(const LAS bf16x8*)(K2 + (16 * wave + r) * 72 + 32 * ks + 8 * g);
#pragma unroll
            for (int et = 0; et < 8; ++et) {
#pragma unroll
                for (int i = 0; i < 4; ++i) st[et][i] *= bl[i];
#pragma unroll
                for (int ks = 0; ks < 2; ++ks) st[et] = MFMA16(ak[ks], frag_tr(VS, 136, 32 * ks, 16 * et, lane), st[et]);
                if (et & 1) __builtin_amdgcn_sched_barrier(0);
            }
        }
        __syncthreads();
        TP_STOP(24, lds, tid); TP_START(25, lds, tid);
#pragma unroll
        for (int et = 0; et < 8; ++et) { u32x2 w; w.x = pk2(st[et][0], st[et][1]); w.y = pk2(st[et][2], st[et][3]); *(LAS u32x2*)(ST + (16 * et + r) * 136 + 16 * wave + 4 * g) = w; }
        TP_STOP(25, lds, tid);
    }
    __syncthreads();
    TP_STOP(20, lds, tid);
}

DI void phase_readout(const Params& P, int layer_j, int wv) {
    const int tid = get_tid(wv), lane = tid & 63, wave = tid >> 6;
    const int gw = get_bid() * 8 + wave, NGW = gridDim.x * 8;
    bf16_t* p = (bf16_t*)(P.ws + WS_P);
    const float* gwt = P.od_gnorm_w + layer_j * 128 + (lane & 7) * 16;
    for (int R = gw; R < MROWS; R += NGW) {
        const bf16_t* op = p + (size_t)R * ODD_IN + 16 * lane; bf16_t* yp = p + (size_t)R * ODD_IN + 4096 + 16 * lane;
        const u32x4 o0 = *(const u32x4*)op, o1 = *(const u32x4*)(op + 8), c0 = *(const u32x4*)(op + 1024), c1 = *(const u32x4*)(op + 1032), g0 = *(const u32x4*)yp, g1 = *(const u32x4*)(yp + 8);
        float ov[16], gv[16];
        const unsigned* ow0 = (const unsigned*)&o0; const unsigned* ow1 = (const unsigned*)&o1; const unsigned* cw0 = (const unsigned*)&c0; const unsigned* cw1 = (const unsigned*)&c1;
        const unsigned* gw0 = (const unsigned*)&g0; const unsigned* gw1 = (const unsigned*)&g1;
#pragma unroll
        for (int i = 0; i < 4; ++i) {
            ov[2 * i] = __uint_as_float(ow0[i] << 16) + __uint_as_float(cw0[i] << 16); ov[2 * i + 1] = __uint_as_float(ow0[i] & 0xffff0000u) + __uint_as_float(cw0[i] & 0xffff0000u);
            ov[8 + 2 * i] = __uint_as_float(ow1[i] << 16) + __uint_as_float(cw1[i] << 16); ov[8 + 2 * i + 1] = __uint_as_float(ow1[i] & 0xffff0000u) + __uint_as_float(cw1[i] & 0xffff0000u);
            gv[2 * i] = __uint_as_float(gw0[i] << 16); gv[2 * i + 1] = __uint_as_float(gw0[i] & 0xffff0000u); gv[8 + 2 * i] = __uint_as_float(gw1[i] << 16); gv[8 + 2 * i + 1] = __uint_as_float(gw1[i] & 0xffff0000u);
        }
        float ss = 0.f;
#pragma unroll
        for (int i = 0; i < 16; ++i) ss += ov[i] * ov[i];
        ss += shfl_xor_f(ss, 1); ss += shfl_xor_f(ss, 2); ss += shfl_xor_f(ss, 4);
        const float rstd = rsqrtf(ss * (1.f / 128.f) + RMS_EPS);
        float y[16];
#pragma unroll
        for (int i = 0; i < 16; ++i) y[i] = ov[i] * rstd * gwt[i] * (gv[i] * sigm(gv[i]));
        u32x4 w0, w1;
        w0.x = pk2(y[0], y[1]); w0.y = pk2(y[2], y[3]); w0.z = pk2(y[4], y[5]); w0.w = pk2(y[6], y[7]);
        w1.x = pk2(y[8], y[9]); w1.y = pk2(y[10], y[11]); w1.z = pk2(y[12], y[13]); w1.w = pk2(y[14], y[15]);
        *(u32x4*)yp = w0; *(u32x4*)(yp + 8) = w1;
    }
}

DI void phase_final(const Params& P, int wv) {
    const int tid = get_tid(wv), lane = tid & 63, wave = tid >> 6;
    const int gw = get_bid() * 8 + wave, NGW = gridDim.x * 8;
    for (int R = gw; R < NB * SEQ; R += NGW) {
        float* row = P.out + (size_t)R * DM;
        f32x4 v[4]; float ss = 0.f;
#pragma unroll
        for (int q = 0; q < 4; ++q) { v[q] = *(const f32x4*)(row + 4 * lane + 256 * q); ss += (v[q][0] * v[q][0] + v[q][1] * v[q][1]) + (v[q][2] * v[q][2] + v[q][3] * v[q][3]); }
        const float rstd = rsqrtf(wave_sum(ss) * (1.f / DM) + RMS_EPS);
#pragma unroll
        for (int q = 0; q < 4; ++q) { const f32x4 w4 = *(const f32x4*)(P.final_norm_w + 4 * lane + 256 * q); *(f32x4*)(row + 4 * lane + 256 * q) = (v[q] * rstd) * w4; }
    }
}

#define XB_TMO      128
#define XB_XCNT(j)  (256  + 64 * (j))
#define XB_XSUB(j)  (1280 + 64 * (j))
#define XB_XGEN(j)  (2304 + 64 * (j))
#define XB_TOP      3328
#define XB_TOPGEN   3392
#define XCD_BAR_WORDS 3456
#define XB_SPIN_CAP (1u << 18)

__device__ __forceinline__ unsigned xb_ld(unsigned* p)              { return __hip_atomic_load(p, __ATOMIC_RELAXED, __HIP_MEMORY_SCOPE_AGENT); }
__device__ __forceinline__ unsigned xb_add(unsigned* p, unsigned v) { return __hip_atomic_fetch_add(p, v, __ATOMIC_RELAXED, __HIP_MEMORY_SCOPE_AGENT); }
__device__ __forceinline__ unsigned xb_xcc_id() { return (unsigned)__builtin_amdgcn_s_getreg((3 << 11) | 20) & 0xFu; }
#define XB_SPIN(cond, bar) do { unsigned _sp = 0; while (cond) { __builtin_amdgcn_s_sleep(1); \
    if ((++_sp & 255u) == 0u) { if (xb_ld(&(bar)[XB_TMO])) break; if (_sp > XB_SPIN_CAP) { atomicAdd(&(bar)[XB_TMO], 1u); break; } } } } while (0)

struct XcdBarrier {
    unsigned* bar; unsigned x;
    volatile LAS unsigned* st;
};

__device__ __forceinline__ XcdBarrier xcd_barrier_post(unsigned* bar, volatile LAS unsigned* st, int wv) {
    XcdBarrier b; b.bar = bar; b.x = xb_xcc_id(); b.st = st;
    if (get_tid(wv) == 0) (void)xb_add(&bar[XB_XCNT(b.x)], 1u);
    return b;
}
__device__ __forceinline__ void xcd_barrier_complete(unsigned* bar, unsigned x, unsigned& nloc, unsigned& nx) {
    const unsigned G = gridDim.x * gridDim.y * gridDim.z;
    unsigned sum, cnt, mine, sp = 0u;
    for (;;) {
        sum = 0u; cnt = 0u; mine = 0u;
#pragma unroll
        for (unsigned j = 0; j < 16; ++j) { const unsigned c = xb_ld(&bar[XB_XCNT(j)]); sum += c; cnt += (c > 0u) ? 1u : 0u; mine = (j == x) ? c : mine; }
        if (sum == G) break;
        __builtin_amdgcn_s_sleep(1);
        if ((++sp & 255u) == 0u) { if (xb_ld(&bar[XB_TMO])) break; if (sp > XB_SPIN_CAP) { atomicAdd(&bar[XB_TMO], 1u); break; } }
    }
    nloc = mine > 0u ? mine : 1u; nx = cnt > 0u ? cnt : 1u;
}

__device__ __forceinline__ void xcd_barrier(const XcdBarrier& b, int wv) {
    asm volatile("s_waitcnt vmcnt(0)" ::: "memory");
    __syncthreads();
    if (get_tid(wv) == 0) {
        unsigned* bar = b.bar;
        __builtin_amdgcn_s_waitcnt(0);
        unsigned nloc = b.st[0], nx = b.st[1];
        if (nloc == 0u) { xcd_barrier_complete(bar, b.x, nloc, nx); b.st[0] = nloc; b.st[1] = nx; }
        const unsigned old = xb_add(&bar[XB_XSUB(b.x)], 1u);
        const unsigned gen = old / nloc;
        if (old + 1u == (gen + 1u) * nloc) {
            __builtin_amdgcn_fence(__ATOMIC_RELEASE, "agent");
            asm volatile("s_waitcnt vmcnt(0)" ::: "memory");
            const unsigned og = xb_add(&bar[XB_TOP], 1u);
            const unsigned tg = og / nx;
            if (og + 1u == (tg + 1u) * nx) xb_add(&bar[XB_TOPGEN], 1u);
            else XB_SPIN(xb_ld(&bar[XB_TOPGEN]) == tg, bar);
            __builtin_amdgcn_fence(__ATOMIC_ACQUIRE, "agent");
            xb_add(&bar[XB_XGEN(b.x)], 1u);
            asm volatile("s_waitcnt vmcnt(0)" ::: "memory");
        } else {
            XB_SPIN(xb_ld(&bar[XB_XGEN(b.x)]) == gen, bar);
            __builtin_amdgcn_fence(__ATOMIC_ACQUIRE, "agent");
            asm volatile("s_waitcnt vmcnt(0)" ::: "memory");
        }
    }
    __syncthreads();
}

constexpr int PARAM_OFF = LDS_BYTES - 256;
static_assert(G2_END <= PARAM_OFF && sizeof(Params) <= 208, "LDS map");
DI const float* ld_uptr(const LAS unsigned long long* s, int i) {
    const unsigned long long v = s[i];
    const unsigned lo = __builtin_amdgcn_readfirstlane((unsigned)v), hi = __builtin_amdgcn_readfirstlane((unsigned)(v >> 32));
    return (const float*)(const __attribute__((address_space(1))) float*)(((unsigned long long)hi << 32) | lo);
}
DI Params load_params(LAS unsigned char* lds) {
    LAS unsigned char* pb = lds + PARAM_OFF; asm volatile("" : "+v"(pb));
    const LAS unsigned long long* s = (const LAS unsigned long long*)pb;
    Params Q;
    Q.x = ld_uptr(s, 0); Q.c = ld_uptr(s, 1); Q.ctx = ld_uptr(s, 2); Q.c_ctx = ld_uptr(s, 3); Q.ada_w = ld_uptr(s, 4); Q.ada_b = ld_uptr(s, 5); Q.norm_w = ld_uptr(s, 6);
    Q.ev_w_in = ld_uptr(s, 7); Q.ev_conv_w = ld_uptr(s, 8); Q.ev_conv_b = ld_uptr(s, 9); Q.ev_rg_wx = ld_uptr(s, 10); Q.ev_rg_bx = ld_uptr(s, 11); Q.ev_rg_wa = ld_uptr(s, 12);
    Q.ev_rg_ba = ld_uptr(s, 13); Q.ev_rg_lambda = ld_uptr(s, 14); Q.ev_sink = ld_uptr(s, 15); Q.ev_w_out = ld_uptr(s, 16); Q.od_w_in = ld_uptr(s, 17); Q.od_lb_raw = ld_uptr(s, 18);
    Q.od_gnorm_w = ld_uptr(s, 19); Q.od_w_out = ld_uptr(s, 20); Q.final_norm_w = ld_uptr(s, 21); Q.out = (float*)ld_uptr(s, 22); Q.ws = (unsigned char*)ld_uptr(s, 23);
    Q.ph_lo = 0; Q.ph_hi = 0;
    return Q;
}
DI void run_phase(LAS unsigned char* lds, int ph, int wv) {
    #ifndef PHMASK
#define PHMASK 0xffff
#endif
    if (ph == 0) { if (PHMASK & 1) { const Params P = load_params(lds); phase_pro(P, lds, wv); } return; }
    if (ph == NPHASE - 1) { if (PHMASK & 2) { const Params P = load_params(lds); phase_final(P, wv); } return; }
    const int layer = (ph - 1) / 5, sub = (ph - 1) % 5, j = layer >> 1;
    const bool even = (layer & 1) == 0;
    if (sub == 0) { if (PHMASK & 4) { const Params P = load_params(lds); phase_norm(P, lds, layer, wv); } return; }
    if (sub == 1) {
        const Params P = load_params(lds); bf16_t* pbuf = (bf16_t*)(P.ws + WS_P);
        const int N = even ? EVEN_IN : ODD_IN;
        pg8::Gemm gm{(const bf16_t*)(P.ws + WS_OV), (const bf16_t*)(P.ws + WS_WIN), MROWS, N, 1024, 1024};
        pg8::StaticOrder S; S.init(MROWS, N, (int)gridDim.x, get_bid());
        EpiStoreBf16 E{pbuf, N};
        if (PHMASK & 8) pg8::gemm_phase<EpiStoreBf16, pg8::StaticOrder, true, true>(lds, gm, S, E, wv);
        return;
    }
    if (sub == 2) {
        const Params P = load_params(lds);
        if (even) {
            constexpr int NRG = NB * NCHUNK * 8;
#if defined(SPLIT_ATTN)
            for (int it = get_bid(); it < NRG; it += gridDim.x) rglru_item(P, lds, j, it, wv);
#else
            for (int it = get_bid(); it < NRG + 576; it += gridDim.x) {
                if (it < NRG) { if (PHMASK & 32) rglru_item(P, lds, j, it, wv); } else { if (PHMASK & 16) attn_item(P, lds, j, it - NRG, wv); }
            }
#endif
        } else {
            for (int it = get_bid(); it < 128; it += gridDim.x) { if (PHMASK & 64) { if (it & 1) gla2_item<1>(P, lds, j, it >> 4, (it >> 1) & 7, wv); else gla2_item<0>(P, lds, j, it >> 4, (it >> 1) & 7, wv); } }
        }
        return;
    }
    if (sub == 3) {
        const Params P = load_params(lds);
        if (!even) { if (PHMASK & 256) phase_readout(P, j, wv); }
#if defined(SPLIT_ATTN)
        else { for (int it = get_bid(); it < 576; it += gridDim.x) attn_item(P, lds, j, it, wv); }
#endif
        return;
    }
    {
        const Params P = load_params(lds); bf16_t* pbuf = (bf16_t*)(P.ws + WS_P);
        const int K = even ? 2048 : 1024, lda = even ? EVEN_IN : ODD_IN;
        pg8::Gemm gm{pbuf + (even ? 1536 : 4096), (const bf16_t*)(P.ws + WS_WOUT), MROWS, 1024, K, lda};
        pg8::StaticOrder S;
        if (layer == 3) S.init(NB * SEQ, 1024, (int)gridDim.x, get_bid(), 1);
        else S.init(MROWS, 1024, (int)gridDim.x, get_bid());
        const float* hl = layer == 0 ? P.x : P.out; const float* hc = layer == 0 ? P.ctx : (const float*)(P.ws + WS_HCTX);
        EpiResid E{hl, hc, P.out, (float*)(P.ws + WS_HCTX), (const float*)(P.ws + WS_MOD) + (size_t)layer * 9 * 3072 + 2048};
        if (PHMASK & 512) pg8::gemm_phase<EpiResid, pg8::StaticOrder, true, true>(lds, gm, S, E, wv);
    }
}

__global__ void __launch_bounds__(512, 2) mega(Params P) {
    extern __shared__ __attribute__((aligned(16))) unsigned char lds_raw[];
    LAS unsigned char* lds = (LAS unsigned char*)lds_raw;
    cg::grid_group grid = cg::this_grid();
    const int wv = __builtin_amdgcn_readfirstlane((int)(threadIdx.x >> 6));
    if (get_tid(wv) == 0) {
#if defined(TP_ID)
        ((LAS unsigned long long*)(lds + 163840 - 32))[0] = 0ull; ((LAS unsigned long long*)(lds + 163840 - 32))[1] = 0ull;
#endif
        ((LAS unsigned*)(lds + PARAM_OFF + 208))[0] = 0u; ((LAS unsigned*)(lds + PARAM_OFF + 208))[1] = 0u;
        LAS unsigned long long* d = (LAS unsigned long long*)(lds + PARAM_OFF);
        d[0] = (unsigned long long)P.x; d[1] = (unsigned long long)P.c; d[2] = (unsigned long long)P.ctx; d[3] = (unsigned long long)P.c_ctx; d[4] = (unsigned long long)P.ada_w;
        d[5] = (unsigned long long)P.ada_b; d[6] = (unsigned long long)P.norm_w; d[7] = (unsigned long long)P.ev_w_in; d[8] = (unsigned long long)P.ev_conv_w; d[9] = (unsigned long long)P.ev_conv_b;
        d[10] = (unsigned long long)P.ev_rg_wx; d[11] = (unsigned long long)P.ev_rg_bx; d[12] = (unsigned long long)P.ev_rg_wa; d[13] = (unsigned long long)P.ev_rg_ba; d[14] = (unsigned long long)P.ev_rg_lambda;
        d[15] = (unsigned long long)P.ev_sink; d[16] = (unsigned long long)P.ev_w_out; d[17] = (unsigned long long)P.od_w_in; d[18] = (unsigned long long)P.od_lb_raw; d[19] = (unsigned long long)P.od_gnorm_w;
        d[20] = (unsigned long long)P.od_w_out; d[21] = (unsigned long long)P.final_norm_w; d[22] = (unsigned long long)P.out; d[23] = (unsigned long long)P.ws;
    }
    __syncthreads();
    const int ph_lo = P.ph_lo, ph_hi = P.ph_hi;
    (void)xcd_barrier_post((unsigned*)(P.ws + WS_CTL) + 4096, (volatile LAS unsigned*)(lds + PARAM_OFF + 208), wv);
#define GRID_SYNC(first) do { if (first) grid.sync(); else { XcdBarrier xb_; xb_.bar = (unsigned*)(load_params(lds).ws + WS_CTL) + 4096; xb_.x = xb_xcc_id(); xb_.st = (volatile LAS unsigned*)(lds + PARAM_OFF + 208); xcd_barrier(xb_, wv); } } while (0)
#if defined(PROBE_S)
    constexpr int PREP = PROBE_E - PROBE_S + 1;
#pragma unroll 1
    for (int seq = ph_lo; seq < ph_hi + PREP; ++seq) {
        if (seq > ph_lo) GRID_SYNC(seq == ph_lo + 1);
        const int ph = seq <= PROBE_E ? seq : seq - PREP;
        run_phase(lds, ph, wv);
    }
#else
#pragma unroll 1
    for (int ph = ph_lo; ph < ph_hi; ++ph) {
#if !defined(SPLIT_ATTN)
        if (ph >= 1 && ph < NPHASE - 1 && (ph - 1) % 5 == 3 && (((ph - 1) / 5) & 1) == 0) continue;
#endif
        if (ph > ph_lo) GRID_SYNC(ph == ph_lo + 1);
        run_phase(lds, ph, wv);
    }
#endif
#if defined(TP_ID)
    if (get_tid(wv) == 0 && blockIdx.x == TP_BLOCK) {
        const unsigned long long acc = ((LAS unsigned long long*)(lds + 163840 - 32))[1], t0 = __builtin_amdgcn_s_memrealtime();
        while (__builtin_amdgcn_s_memrealtime() - t0 < (unsigned long long)TP_AMP * acc) __builtin_amdgcn_s_sleep(8);
    }
#endif
}

extern "C" void kernel_launch(void* const* d_in, const int* in_sizes, int n_in, void* d_out, int out_size, void* d_ws, size_t ws_size, hipStream_t stream) {
    static int grid = 0;
    if (grid == 0) {
        if (n_in != 22 || ws_size < WS_END) { fprintf(stderr, "kernel_launch: unexpected inputs (n_in %d, ws %zu)\n", n_in, ws_size); grid = -1; return; }
        int dev = 0, cus = 0, per_cu = 0;
        hipGetDevice(&dev);
        hipDeviceGetAttribute(&cus, hipDeviceAttributeMultiprocessorCount, dev);
        if (hipFuncSetAttribute((const void*)mega, hipFuncAttributeMaxDynamicSharedMemorySize, LDS_BYTES) != hipSuccess) { fprintf(stderr, "kernel_launch: hipFuncSetAttribute failed\n"); grid = -1; return; }
        if (hipOccupancyMaxActiveBlocksPerMultiprocessor(&per_cu, (const void*)mega, 512, LDS_BYTES) != hipSuccess || per_cu < 1) { fprintf(stderr, "kernel_launch: occupancy query gives %d\n", per_cu); per_cu = 1; }
        (void)hipGetLastError();
        grid = cus;
    }
    if (grid < 0) return;
    if (hipMemsetAsync((char*)d_ws + WS_CTL, 0, 65536, stream) != hipSuccess) { fprintf(stderr, "kernel_launch: memset failed\n"); return; }
    Params P{};
    const float** pp = (const float**)&P;
    for (int i = 0; i < 22; ++i) pp[i] = (const float*)d_in[i];
    P.out = (float*)d_out; P.ws = (unsigned char*)d_ws;
#if ONE_LAUNCH
    P.ph_lo = 0; P.ph_hi = NPHASE;
    { void* args[] = {&P}; hipError_t e = hipLaunchCooperativeKernel((const void*)mega, dim3(grid), dim3(512), args, LDS_BYTES, stream);
      if (e != hipSuccess) fprintf(stderr, "cooperative launch failed: %s (grid %d)\n", hipGetErrorString(e), grid); }
#else
    for (int ph = 0; ph < NPHASE; ++ph) {
        P.ph_lo = ph; P.ph_hi = ph + 1;
        void* args[] = {&P}; hipError_t e = hipLaunchCooperativeKernel((const void*)mega, dim3(grid), dim3(512), args, LDS_BYTES, stream);
        if (e != hipSuccess) { fprintf(stderr, "launch %d failed: %s (grid %d)\n", ph, hipGetErrorString(e), grid); break; }
    }
#endif
}
```

```cpp
#include <hip/hip_runtime.h>
#include <hip/hip_cooperative_groups.h>
#include <cstdio>
#include <cstdint>
namespace cg = cooperative_groups;

#ifndef ONE_LAUNCH
#define ONE_LAUNCH 1
#endif

#define DI __device__ __forceinline__
#define LAS __attribute__((address_space(3)))
__device__ __forceinline__ int lane_nh() { int l; asm volatile("v_mbcnt_lo_u32_b32 %0, -1, 0\n\tv_mbcnt_hi_u32_b32 %0, -1, %0" : "=v"(l)); return l; }
__device__ __forceinline__ int get_tid(int wv) { asm volatile("" : "+s"(wv)); return wv * 64 + lane_nh(); }
__device__ __forceinline__ float shfl_xor_f(float v, int o) { return __int_as_float(__builtin_amdgcn_ds_bpermute((lane_nh() ^ o) << 2, __float_as_int(v))); }
__device__ __forceinline__ int get_bid() { int b = blockIdx.x; asm volatile("" : "+s"(b)); return b; }

#if defined(TP_ID)
#ifndef TP_BLOCK
#define TP_BLOCK 5
#endif
#ifndef TP_AMP
#define TP_AMP 16
#endif
#define TP_START(id, lds, tid_) do { if ((id) == TP_ID && (tid_) == 0 && blockIdx.x == TP_BLOCK) { ((LAS unsigned long long*)((lds) + 163840 - 32))[0] = __builtin_amdgcn_s_memrealtime(); } } while (0)
#define TP_STOP(id, lds, tid_) do { if ((id) == TP_ID && (tid_) == 0 && blockIdx.x == TP_BLOCK) { LAS unsigned long long* w_ = (LAS unsigned long long*)((lds) + 163840 - 32); w_[1] += __builtin_amdgcn_s_memrealtime() - w_[0]; } } while (0)
#else
#define TP_START(id, lds, tid_) do { } while (0)
#define TP_STOP(id, lds, tid_) do { } while (0)
#endif
namespace pg8 {
#define PG8_LAS __attribute__((address_space(3)))
typedef unsigned short bf16_t;
typedef short bf16x8 __attribute__((ext_vector_type(8)));
typedef float f32x4 __attribute__((ext_vector_type(4)));
typedef unsigned u32x4 __attribute__((ext_vector_type(4)));
constexpr int BM = 256, BK = 64, HALF = 128, HTB = HALF * BK * 2  , STAGE_BYTES = 8 * HTB, NXCD = 8, WGM = 8;

__host__ __device__ __forceinline__ int lds_byte(int r, int c) { const int st = (r >> 4) * 2 + (c >> 5), rr = r & 15, cc = c & 31, ob = rr * 64 + cc * 2; return st * 1024 + (ob ^ (((ob >> 9) & 1) << 5)); }
__host__ __device__ __forceinline__ void stage_rc(int b, int& R, int& C) { const int st = b / 1024, sb = b % 1024, swz = sb ^ (((sb >> 9) & 1) << 5); R = (st >> 1) * 16 + swz / 64; C = (st & 1) * 32 + (swz % 64) / 2; }
__host__ __device__ __forceinline__ int perm32(int rho) { const int n = rho >> 4, i = rho & 15; return 8 * (i >> 2) + 4 * n + (i & 3); }

struct Unit { int pm, pn; };
struct Gemm { const bf16_t* A; const bf16_t* Bt; int M, N, K, lda; };

struct StaticOrder {
    int nM, nN, nwg, G, c, lat_only;
    __host__ __device__ void init(int M, int N, int G_, int c_, int lat_only_ = 0) { nM = M / BM; nN = N / BM; nwg = nM * nN; G = G_; c = c_; lat_only = lat_only_; }
    __host__ __device__ bool next(int i, Unit& u) const {
        const long L = (long)i * G + c; if (L >= nwg) return false;
        int wgid = (int)L; { const int q = nwg / NXCD, r = nwg % NXCD, xcd = wgid % NXCD, off = wgid / NXCD; wgid = (xcd < r ? xcd * (q + 1) : r * (q + 1) + (xcd - r) * q) + off; }
        const int nig = WGM * nN, gid = wgid / nig, fm = gid * WGM, gsz = (nM - fm) < WGM ? (nM - fm) : WGM;
        u.pm = fm + ((wgid % nig) % gsz); u.pn = (wgid % nig) / gsz; if (lat_only) u.pm = 9 * (u.pm >> 3) + 1 + (u.pm & 7); return true;
    }
    __device__ __forceinline__ void a_ready(const Unit&) const {}
    __device__ __forceinline__ void done(const Unit&) const {}
};

template <class Epi, class Sched, bool ALIGN_EPI = false, bool SP2 = false>
__device__ __forceinline__ void gemm_phase(PG8_LAS unsigned char* lds, const Gemm g, const Sched& S, const Epi& E, int wv) {
    const int tid = get_tid(wv), wid = __builtin_amdgcn_readfirstlane(tid >> 6), lane = tid & 63, wr = wid >> 2, wc = wid & 3, fr = lane & 15, fq = lane >> 4;
    const int K = g.K, nt = K / BK;
    unsigned voffA[2], voffB[2];
#pragma unroll
    for (int i = 0; i < 2; ++i) { int R, C; stage_rc(tid * 16 + i * 8192, R, C); const int Rb = Epi::PERM ? ((R & ~31) + perm32(R & 31)) : R;
        voffA[i] = (unsigned)(R * g.lda + C) * 2u; voffB[i] = (unsigned)(Rb * K + C) * 2u; }
    const size_t kstep = (size_t)(BK * 2);
    const size_t hstepA = (size_t)HALF * g.lda * 2, hstepB = (size_t)HALF * K * 2;
    const size_t tstepA = 2 * hstepA, tstepB = 2 * hstepB;
    const unsigned ldsw = (unsigned)wid * 1024u;
    const int aoff = lds_byte(wr * 64 + fr, fq * 8), boff = lds_byte(wc * 32 + fr, fq * 8);
#define PG8_SA(b, h) (((b) * 2 + (h)) * HTB)
#define PG8_SB(b, h) ((4 + (b) * 2 + (h)) * HTB)
#define PG8_STAGE(bufoff, gbase, voff) do { _Pragma("unroll") for (int _i = 0; _i < 2; ++_i) \
        __builtin_amdgcn_global_load_lds((const unsigned*)((const char*)(gbase) + (voff)[_i]), (PG8_LAS unsigned*)(lds + (bufoff) + ldsw + _i * 8192), 16, 0, 0); } while (0)
#define PG8_LDA(dst, b, h) do { _Pragma("unroll") for (int m = 0; m < 4; ++m) _Pragma("unroll") for (int k = 0; k < 2; ++k) dst[m][k] = *(const PG8_LAS bf16x8*)(lds + PG8_SA(b, h) + aoff + m * 2048 + k * 1024); } while (0)
#define PG8_LDB(dst, b, h) do { _Pragma("unroll") for (int n = 0; n < 2; ++n) _Pragma("unroll") for (int k = 0; k < 2; ++k) dst[n][k] = *(const PG8_LAS bf16x8*)(lds + PG8_SB(b, h) + boff + n * 2048 + k * 1024); } while (0)
#define PG8_MMA(ai, bj, At, Bt) do { __builtin_amdgcn_s_setprio(1); _Pragma("unroll") for (int m = 0; m < 4; ++m) _Pragma("unroll") for (int n = 0; n < 2; ++n) _Pragma("unroll") for (int k = 0; k < 2; ++k) \
        acc[ai][bj][m][n] = __builtin_amdgcn_mfma_f32_16x16x32_bf16(Bt[n][k], At[m][k], acc[ai][bj][m][n], 0, 0, 0); __builtin_amdgcn_s_setprio(0); } while (0)
#define PG8_WAIT_V(n) asm volatile("s_waitcnt vmcnt(" #n ")" ::: "memory")
#define PG8_WAIT_L(n) asm volatile("s_waitcnt lgkmcnt(" #n ")" ::: "memory")
#define PG8_BAR __builtin_amdgcn_s_barrier()
#define PG8_SCHED __builtin_amdgcn_sched_barrier(0)
    Unit cur, nxt; int ui = 0;
    if (!S.next(0, cur)) return;
    f32x4 acc[2][2][4][2];
#pragma unroll
    for (int a = 0; a < 2; ++a)
#pragma unroll
        for (int b = 0; b < 2; ++b)
#pragma unroll
            for (int m = 0; m < 4; ++m)
#pragma unroll
                for (int n = 0; n < 2; ++n) acc[a][b][m][n] = (f32x4){0.f, 0.f, 0.f, 0.f};
    bf16x8 At[4][2], B0[2][2], B1[2][2];
    const char* cA = (const char*)g.A + (size_t)cur.pm * tstepA; const char* cB = (const char*)g.Bt + (size_t)cur.pn * tstepB;
    S.a_ready(cur);
    if constexpr (SP2) {
        PG8_STAGE(PG8_SB(0, 0), cB, voffB); PG8_STAGE(PG8_SB(0, 1), cB + hstepB, voffB); PG8_STAGE(PG8_SA(0, 0), cA, voffA); PG8_STAGE(PG8_SA(0, 1), cA + hstepA, voffA);
        if (wr == 1) PG8_BAR;
        PG8_WAIT_V(2); PG8_BAR;
        PG8_STAGE(PG8_SB(1, 0), cB + kstep, voffB); PG8_STAGE(PG8_SA(1, 0), cA + kstep, voffA); PG8_STAGE(PG8_SB(1, 1), cB + hstepB + kstep, voffB);
        PG8_WAIT_V(6); PG8_BAR;
    } else {
        PG8_STAGE(PG8_SB(0, 0), cB, voffB); PG8_STAGE(PG8_SA(0, 0), cA, voffA); PG8_STAGE(PG8_SB(0, 1), cB + hstepB, voffB); PG8_STAGE(PG8_SA(0, 1), cA + hstepA, voffA);
        if (wr == 1) PG8_BAR;
        PG8_WAIT_V(4); PG8_BAR;
        PG8_STAGE(PG8_SB(1, 0), cB + kstep, voffB); PG8_STAGE(PG8_SA(1, 0), cA + kstep, voffA); PG8_STAGE(PG8_SB(1, 1), cB + hstepB + kstep, voffB);
        PG8_WAIT_V(6); PG8_BAR;
    }
    for (;;) {
        const bool has_next = S.next(ui + 1, nxt);
        const char* nA = has_next ? (const char*)g.A + (size_t)nxt.pm * tstepA : cA; const char* nB = has_next ? (const char*)g.Bt + (size_t)nxt.pn * tstepB : cB;
        for (int t = 0; t < nt; t += 2) {
            const bool last = (t == nt - 2);
            const char* a1 = cA + (size_t)(t + 1) * kstep;
            const char* a2 = last ? nA : cA + (size_t)(t + 2) * kstep; const char* b2 = last ? nB : cB + (size_t)(t + 2) * kstep;
            const char* a3 = a2 + kstep; const char* b3 = b2 + kstep;
            if (last && has_next) S.a_ready(nxt);
            if constexpr (SP2) {
            PG8_LDB(B0, 0, 0); PG8_LDB(B1, 0, 1); PG8_SCHED; PG8_LDA(At, 0, 0); PG8_STAGE(PG8_SA(1, 1), a1 + hstepA, voffA);
            PG8_WAIT_V(8); PG8_WAIT_L(0); PG8_BAR; PG8_MMA(0, 0, At, B0); PG8_MMA(0, 1, At, B1); PG8_BAR; PG8_SCHED;
            PG8_LDA(At, 0, 1); PG8_STAGE(PG8_SB(0, 0), b2, voffB); PG8_STAGE(PG8_SB(0, 1), b2 + hstepB, voffB); PG8_STAGE(PG8_SA(0, 0), a2, voffA);
            PG8_WAIT_V(8); PG8_WAIT_L(0); PG8_BAR; PG8_MMA(1, 0, At, B0); PG8_MMA(1, 1, At, B1); PG8_BAR; PG8_SCHED;
            PG8_LDB(B0, 1, 0); PG8_LDB(B1, 1, 1); PG8_SCHED; PG8_LDA(At, 1, 0); PG8_STAGE(PG8_SA(0, 1), a2 + hstepA, voffA);
            PG8_WAIT_V(8); PG8_WAIT_L(0); PG8_BAR; PG8_MMA(0, 0, At, B0); PG8_MMA(0, 1, At, B1); PG8_BAR; PG8_SCHED;
            PG8_LDA(At, 1, 1); PG8_STAGE(PG8_SB(1, 0), b3, voffB); PG8_STAGE(PG8_SB(1, 1), b3 + hstepB, voffB); PG8_STAGE(PG8_SA(1, 0), a3, voffA);
            PG8_WAIT_V(8); PG8_WAIT_L(0); PG8_BAR; PG8_MMA(1, 0, At, B0); PG8_MMA(1, 1, At, B1); PG8_BAR; PG8_SCHED;
            } else {
            PG8_LDB(B0, 0, 0); PG8_SCHED; PG8_LDA(At, 0, 0); PG8_STAGE(PG8_SA(1, 1), a1 + hstepA, voffA);
            PG8_WAIT_L(8); PG8_BAR; PG8_WAIT_L(0); PG8_MMA(0, 0, At, B0); PG8_BAR; PG8_SCHED;
            PG8_LDB(B1, 0, 1); PG8_STAGE(PG8_SB(0, 0), b2, voffB);
            PG8_BAR; PG8_WAIT_L(0); PG8_MMA(0, 1, At, B1); PG8_BAR;
            PG8_LDA(At, 0, 1); PG8_STAGE(PG8_SA(0, 0), a2, voffA);
            PG8_BAR; PG8_WAIT_L(0); PG8_MMA(1, 0, At, B0); PG8_BAR; PG8_SCHED;
            PG8_STAGE(PG8_SB(0, 1), b2 + hstepB, voffB);
            PG8_WAIT_V(6); PG8_BAR; PG8_MMA(1, 1, At, B1); PG8_BAR;
            PG8_LDB(B0, 1, 0); PG8_SCHED; PG8_LDA(At, 1, 0); PG8_STAGE(PG8_SA(0, 1), a2 + hstepA, voffA);
            PG8_WAIT_L(8); PG8_BAR; PG8_WAIT_L(0); PG8_MMA(0, 0, At, B0); PG8_BAR; PG8_SCHED;
            PG8_LDB(B1, 1, 1); PG8_STAGE(PG8_SB(1, 0), b3, voffB);
            PG8_BAR; PG8_WAIT_L(0); PG8_MMA(0, 1, At, B1); PG8_BAR;
            PG8_LDA(At, 1, 1); PG8_STAGE(PG8_SA(1, 0), a3, voffA);
            PG8_BAR; PG8_WAIT_L(0); PG8_MMA(1, 0, At, B0); PG8_BAR; PG8_SCHED;
            PG8_STAGE(PG8_SB(1, 1), b3 + hstepB, voffB);
            PG8_WAIT_V(6); PG8_BAR; PG8_MMA(1, 1, At, B1); PG8_BAR;
            }
        }
        if constexpr (ALIGN_EPI) { if (wr == 0) PG8_BAR; }
        if constexpr (!Epi::AFTER_DRAIN) { E(acc, cur, wr, wc, fr, fq); S.done(cur); }
        if (!has_next) break;
#pragma unroll
        for (int a = 0; a < 2; ++a)
#pragma unroll
            for (int b = 0; b < 2; ++b)
#pragma unroll
                for (int m = 0; m < 4; ++m)
#pragma unroll
                    for (int n = 0; n < 2; ++n) acc[a][b][m][n] = (f32x4){0.f, 0.f, 0.f, 0.f};
        cur = nxt; cA = nA; cB = nB; ++ui;
        if constexpr (ALIGN_EPI) { if (wr == 1) PG8_BAR; }
    }
    PG8_WAIT_V(0);
    if constexpr (!ALIGN_EPI) { if (wr == 0) PG8_BAR; }
    PG8_BAR;
    if constexpr (Epi::AFTER_DRAIN) { E.fused(acc, cur, wr, wc, fr, fq, lds, wid, lane); S.done(cur); }
#undef PG8_SA
#undef PG8_SB
#undef PG8_STAGE
#undef PG8_LDA
#undef PG8_LDB
#undef PG8_MMA
#undef PG8_WAIT_V
#undef PG8_WAIT_L
#undef PG8_BAR
#undef PG8_SCHED
}
}

typedef unsigned short bf16_t;
typedef short bf16x8 __attribute__((ext_vector_type(8)));
typedef short s16x4 __attribute__((ext_vector_type(4)));
typedef float f32x4 __attribute__((ext_vector_type(4)));
typedef float f32x16 __attribute__((ext_vector_type(16)));
typedef unsigned u32x4 __attribute__((ext_vector_type(4)));
typedef unsigned u32x2 __attribute__((ext_vector_type(2)));
typedef float f32x2 __attribute__((ext_vector_type(2)));

constexpr int DM = 1024, NB = 8, SEQ = 2048, CTXL = 256, LT = SEQ + CTXL  , MROWS = NB * LT  ;
constexpr int EVEN_IN = 4608, ODD_IN = 5120, NCHUNK = LT / 64  ;
constexpr float RMS_EPS = 1e-6f, LOG2E = 1.4426950408889634f;
constexpr int LDS_BYTES = 160 * 1024;
constexpr int NPHASE = 22;

constexpr size_t WS_CTL = 0;
constexpr size_t WS_MOD = 65536;
constexpr size_t WS_ROPE = 524288;
constexpr size_t WS_AGG = 1048576;
constexpr size_t WS_HCTX = WS_AGG + 4718592;
constexpr size_t WS_WIN = WS_HCTX + 8388608;
constexpr size_t WS_WOUT = WS_WIN + 10485760;
constexpr size_t WS_WRG = WS_WOUT + 4194304;
constexpr size_t WS_OV = WS_WRG + 1048576;
constexpr size_t WS_P = WS_OV + 37748736;
constexpr size_t WS_END = WS_P + 188743680;
static_assert(WS_END <= 268435456, "workspace map exceeds 256 MiB");

struct Params {
    const float *x, *c, *ctx, *c_ctx, *ada_w, *ada_b, *norm_w, *ev_w_in, *ev_conv_w, *ev_conv_b, *ev_rg_wx, *ev_rg_bx, *ev_rg_wa, *ev_rg_ba,
        *ev_rg_lambda, *ev_sink, *ev_w_out, *od_w_in, *od_lb_raw, *od_gnorm_w, *od_w_out, *final_norm_w;
    float* out; unsigned char* ws; int ph_lo, ph_hi;
};

DI float bf2f(unsigned short v) { return __uint_as_float((unsigned)v << 16); }
DI unsigned f2bf(float f) { unsigned u = __float_as_uint(f); return (u + 0x7fffu + ((u >> 16) & 1u)) >> 16; }
typedef __bf16 bf16x2_hw __attribute__((ext_vector_type(2)));
DI unsigned pk2(float lo, float hi) { const f32x2 v = {lo, hi}; return __builtin_bit_cast(unsigned, __builtin_convertvector(v, bf16x2_hw)); }
DI float sigm(float x) { return __builtin_amdgcn_rcpf(1.f + __expf(-x)); }
DI float softplus_neg(float lam) {
    const float e = __expf(-lam);
    return e < 0.06f ? e * (1.f + e * (-0.5f + e * (0.33333333f + e * (-0.25f + e * 0.2f)))) : __logf(1.f + e);
}
DI float neg_expm1(float x) {
    return x > -0.25f ? -x * (1.f + x * (0.5f + x * (0.16666667f + x * (0.041666668f + x * (0.0083333338f + x * 0.0013888889f))))) : 1.f - __expf(x);
}
DI float wave_sum(float v) {
#pragma unroll
    for (int o = 1; o < 64; o <<= 1) v += shfl_xor_f(v, o);
    return v;
}
DI int crow(int reg, int h) { return (reg & 3) + 8 * (reg >> 2) + 4 * h; }
#define MFMA16(a, b, c) __builtin_amdgcn_mfma_f32_16x16x32_bf16((a), (b), (c), 0, 0, 0)
#define MFMA32(a, b, c) __builtin_amdgcn_mfma_f32_32x32x16_bf16((a), (b), (c), 0, 0, 0)

struct EpiStoreBf16 {
    static constexpr bool PERM = true, AFTER_DRAIN = false;
    bf16_t* O; int ldc;
    DI void operator()(const f32x4 (&acc)[2][2][4][2], const pg8::Unit& u, int wr, int wc, int fr, int fq) const {
        const int row0 = u.pm * 256 + wr * 64 + fr, col0 = u.pn * 256 + wc * 32 + 8 * fq;
#pragma unroll
        for (int ai = 0; ai < 2; ++ai)
#pragma unroll
            for (int m = 0; m < 4; ++m) { bf16_t* rowp = O + (size_t)(row0 + ai * 128 + m * 16) * ldc + col0;
#pragma unroll
                for (int bj = 0; bj < 2; ++bj) { const f32x4 v0 = acc[ai][bj][m][0], v1 = acc[ai][bj][m][1];
                    u32x4 w; w.x = pk2(v0[0], v0[1]); w.y = pk2(v0[2], v0[3]); w.z = pk2(v1[0], v1[1]); w.w = pk2(v1[2], v1[3]);
                    *(u32x4*)(rowp + bj * 128) = w; } }
    }
};
struct EpiResid {
    static constexpr bool PERM = false, AFTER_DRAIN = false;
    const float* in_lat; const float* in_ctx; float* out_lat; float* out_ctx; const float* gate;
    DI void operator()(const f32x4 (&acc)[2][2][4][2], const pg8::Unit& u, int wr, int wc, int fr, int fq) const {
        const int b = u.pm / 9, jt = u.pm % 9;
        const float* ib; float* ob; const float* g;
        if (jt == 0) { const size_t off = (size_t)b * CTXL * DM; ib = in_ctx + off; ob = out_ctx + off; g = gate + 8 * 3072; }
        else { const size_t off = ((size_t)b * SEQ + (size_t)(jt - 1) * 256) * DM; ib = in_lat + off; ob = out_lat + off; g = gate + b * 3072; }
        const int col0 = u.pn * 256 + wc * 32 + 4 * fq;
#pragma unroll
        for (int bj = 0; bj < 2; ++bj)
#pragma unroll
            for (int n = 0; n < 2; ++n) {
                const f32x4 gvv = *(const f32x4*)(g + col0 + bj * 128 + n * 16);
#pragma unroll
                for (int ai = 0; ai < 2; ++ai) {
#pragma unroll
                    for (int m = 0; m < 4; ++m) { const int r = ai * 128 + wr * 64 + m * 16 + fr;
                        const size_t off = (size_t)r * DM + col0 + bj * 128 + n * 16;
                        const f32x4 o = *(const f32x4*)(ib + off) + gvv * acc[ai][bj][m][n]; *(f32x4*)(ob + off) = o; }
                    asm volatile("" ::: "memory");
                }
            }
    }
};

constexpr int MG_STAGE = 27648;
template <class EpiF>
DI void mini_gemm_tile(LAS unsigned char* lds, const bf16_t* A, int lda, const bf16_t* Bt, int K, const EpiF& epi, int wv) {
    const int tid = get_tid(wv), lane = tid & 63, wave = tid >> 6, r = lane & 31, h = lane >> 5, wm = wave >> 2, wn = wave & 3;
    const int lrow = tid >> 3, lch = tid & 7, nS = K / 64;
    const bf16_t* ap = A + (size_t)lrow * lda + 8 * lch;
    const bf16_t* bp0 = Bt + (size_t)lrow * K + 8 * lch; const bf16_t* bp1 = Bt + (size_t)(64 + lrow) * K + 8 * lch;
    u32x4 s0[3], s1[3];
    f32x16 acc;
#pragma unroll
    for (int i = 0; i < 16; ++i) acc[i] = 0.f;
#define MG_LOAD(set, s) do { (set)[0] = *(const u32x4*)(ap + (s) * 64); (set)[1] = *(const u32x4*)(bp0 + (s) * 64); (set)[2] = *(const u32x4*)(bp1 + (s) * 64); } while (0)
#define MG_STORE(set, buf) do { LAS unsigned char* b_ = lds + (buf) * MG_STAGE; *(LAS u32x4*)(b_ + lrow * 144 + lch * 16) = (set)[0]; \
        *(LAS u32x4*)(b_ + 9216 + lrow * 144 + lch * 16) = (set)[1]; *(LAS u32x4*)(b_ + 9216 + (64 + lrow) * 144 + lch * 16) = (set)[2]; } while (0)
#define MG_COMPUTE(buf) do { const LAS unsigned char* b_ = lds + (buf) * MG_STAGE; \
        _Pragma("unroll") for (int ks = 0; ks < 4; ++ks) { \
            const bf16x8 af = *(const LAS bf16x8*)(b_ + (32 * wm + r) * 144 + (16 * ks + 8 * h) * 2); \
            const bf16x8 bf = *(const LAS bf16x8*)(b_ + 9216 + (32 * wn + r) * 144 + (16 * ks + 8 * h) * 2); \
            acc = MFMA32(af, bf, acc); } } while (0)
    MG_LOAD(s0, 0); MG_LOAD(s1, 1);
    MG_STORE(s0, 0);
    if (nS > 2) MG_LOAD(s0, 2);
#pragma unroll 1
    for (int s = 0; s < nS; s += 2) {
        __syncthreads();
        if (s + 1 < nS) { MG_STORE(s1, 1); if (s + 3 < nS) MG_LOAD(s1, s + 3); }
        MG_COMPUTE(0);
        __syncthreads();
        if (s + 2 < nS) { MG_STORE(s0, 0); if (s + 4 < nS) MG_LOAD(s0, s + 4); }
        if (s + 1 < nS) MG_COMPUTE(1);
    }
#undef MG_LOAD
#undef MG_STORE
#undef MG_COMPUTE
    epi(acc, 32 * wm, 32 * wn + r, h);
    __syncthreads();
}

DI void phase_pro(const Params& P, LAS unsigned char* lds, int wv) {
    const int tid = get_tid(wv);
    LAS float* s = (LAS float*)lds;
    LAS float* red = (LAS float*)(lds + 36864);
    float* mod = (float*)(P.ws + WS_MOD);
    for (int i = tid; i < 9 * 1024; i += 512) { const int r = i >> 10, k = i & 1023; const float v = r < 8 ? P.c[r * 1024 + k] : P.c_ctx[k]; s[i] = v * sigm(v); }
    __syncthreads();
    for (int item = get_bid(); item < 384; item += gridDim.x) {
        const int l = item / 96, n0 = (item % 96) * 32, ks = tid >> 5, col = tid & 31;
        const float* w = P.ada_w + (size_t)l * 1024 * 3072 + n0 + col;
        float acc[9];
#pragma unroll
        for (int r = 0; r < 9; ++r) acc[r] = 0.f;
#pragma unroll 8
        for (int kk = 0; kk < 64; ++kk) { const int k = ks * 64 + kk; const float wv = w[(size_t)k * 3072];
#pragma unroll
            for (int r = 0; r < 9; ++r) acc[r] += s[r * 1024 + k] * wv; }
#pragma unroll
        for (int r = 0; r < 9; ++r) red[(ks * 9 + r) * 32 + col] = acc[r];
        __syncthreads();
        if (tid < 288) { const int r = tid >> 5, cc = tid & 31; float sum = 0.f;
#pragma unroll
            for (int k2 = 0; k2 < 16; ++k2) sum += red[(k2 * 9 + r) * 32 + cc];
            mod[(l * 9 + r) * 3072 + n0 + cc] = sum + P.ada_b[l * 3072 + n0 + cc]; }
        __syncthreads();
    }
    float* cos_t = (float*)(P.ws + WS_ROPE); float* sin_t = cos_t + SEQ * 32;
    for (int i = get_bid() * 512 + tid; i < SEQ * 32; i += gridDim.x * 512) {
        const int pos = i >> 5, jj = i & 31, fi = jj & 15;
        const float inv = __builtin_amdgcn_exp2f(-(float)(2 * fi) * (13.287712379549449f / 32.f));
        const float ang = (float)(jj < 16 ? (pos >> 6) : (pos & 63)) * inv;
        cos_t[i] = __cosf(ang); sin_t[i] = __sinf(ang);
    }
}

template <bool FRAG = false>
DI void transpose_item(const float* W, int K, int N, bf16_t* WT, LAS float* scr, int item, int lane) {
    const int nblk = N / 32, kb = item / nblk, nb = item % nblk, k0 = 64 * kb, n0 = 32 * nb;
#pragma unroll 8
    for (int i = 0; i < 32; ++i) { const int kk = 2 * i + (lane >> 5); scr[kk * 33 + (lane & 31)] = W[(size_t)(k0 + kk) * N + n0 + (lane & 31)]; }
    asm volatile("s_waitcnt lgkmcnt(0)" ::: "memory");
    const int c = lane & 7;
#pragma unroll
    for (int j = 0; j < 4; ++j) { const int n = (lane >> 3) + 8 * j; const LAS float* sp = scr + (8 * c) * 33 + n;
        u32x4 o; o.x = pk2(sp[0 * 33], sp[1 * 33]); o.y = pk2(sp[2 * 33], sp[3 * 33]); o.z = pk2(sp[4 * 33], sp[5 * 33]); o.w = pk2(sp[6 * 33], sp[7 * 33]);
        if (FRAG) {
            const int nn = n0 + n, k8 = (k0 >> 3) + c;
            *(u32x4*)(WT + ((((nn >> 4) * 4 + (k8 >> 2)) * 64 + (k8 & 3) * 16 + (nn & 15)) * 8)) = o;
        } else *(u32x4*)(WT + (size_t)(n0 + n) * K + k0 + 8 * c) = o; }
    asm volatile("s_waitcnt lgkmcnt(0)" ::: "memory");
}

DI void phase_norm(const Params& P, LAS unsigned char* lds, int layer, int wv) {
    const int tid = get_tid(wv), lane = tid & 63, wave = tid >> 6;
    const int gw = get_bid() * 8 + wave, NGW = gridDim.x * 8;
    const int j = layer >> 1;
    LAS float* scr = (LAS float*)(lds + wave * 16384);
    bf16_t* WIN = (bf16_t*)(P.ws + WS_WIN); bf16_t* WOUT = (bf16_t*)(P.ws + WS_WOUT); bf16_t* WRG = (bf16_t*)(P.ws + WS_WRG);
    if ((layer & 1) == 0) {
        constexpr int I_IN = 16 * (EVEN_IN / 32), I_OUT = 32 * 32, I_RG = 32 * 8;
        for (int it = gw; it < I_IN + I_OUT + I_RG; it += NGW) {
            int r = it;
            if (r < I_IN) { transpose_item(P.ev_w_in + (size_t)j * 1024 * EVEN_IN, 1024, EVEN_IN, WIN, scr, r, lane); continue; } r -= I_IN;
            if (r < I_OUT) { transpose_item(P.ev_w_out + (size_t)j * 2048 * 1024, 2048, 1024, WOUT, scr, r, lane); continue; } r -= I_OUT;
            const int mat = r >> 3, sub = r & 7;
            const int dir = mat >> 4, gate = (mat >> 3) & 1, hd = mat & 7;
            const float* src = (gate == 0 ? P.ev_rg_wx : P.ev_rg_wa) + ((size_t)((j * 2 + dir) * 8 + hd)) * 16384;
            transpose_item<true>(src, 128, 128, WRG + (size_t)mat * 16384, scr, sub, lane);
        }
    } else {
        constexpr int I_IN = 16 * (ODD_IN / 32), I_OUT = 16 * 32;
        for (int it = gw; it < I_IN + I_OUT; it += NGW) {
            int r = it;
            if (r < I_IN) { transpose_item(P.od_w_in + (size_t)j * 1024 * ODD_IN, 1024, ODD_IN, WIN, scr, r, lane); continue; } r -= I_IN;
            transpose_item(P.od_w_out + (size_t)j * 1024 * 1024, 1024, 1024, WOUT, scr, r, lane);
        }
    }
    const float* hl = layer == 0 ? P.x : P.out; const float* hc = layer == 0 ? P.ctx : (const float*)(P.ws + WS_HCTX);
    const float* mod = (const float*)(P.ws + WS_MOD) + (size_t)layer * 9 * 3072;
    const float* nw = P.norm_w + layer * 1024;
    bf16_t* U = (bf16_t*)(P.ws + WS_OV);
    f32x4 w4[4], s4[4], h4[4];
#pragma unroll
    for (int q = 0; q < 4; ++q) w4[q] = *(const f32x4*)(nw + 4 * lane + 256 * q);
    int cur_m = -1;
    const int rpw = (MROWS + NGW - 1) / NGW;
    for (int R = gw * rpw; R < gw * rpw + rpw && R < MROWS; ++R) {
        const int b = R / LT, jr = R % LT;
        const float* src = jr < CTXL ? hc + ((size_t)b * CTXL + jr) * DM : hl + ((size_t)b * SEQ + (jr - CTXL)) * DM;
        const int mrow = jr < CTXL ? 8 : b;
        if (mrow != cur_m) {
            cur_m = mrow;
            const float* sh = mod + mrow * 3072; const float* sc = sh + 1024;
#pragma unroll
            for (int q = 0; q < 4; ++q) { s4[q] = *(const f32x4*)(sc + 4 * lane + 256 * q) + 1.f; h4[q] = *(const f32x4*)(sh + 4 * lane + 256 * q); }
        }
        f32x4 v[4]; float ss = 0.f;
#pragma unroll
        for (int q = 0; q < 4; ++q) { v[q] = *(const f32x4*)(src + 4 * lane + 256 * q); ss += (v[q][0] * v[q][0] + v[q][1] * v[q][1]) + (v[q][2] * v[q][2] + v[q][3] * v[q][3]); }
        const float rstd = rsqrtf(wave_sum(ss) * (1.f / DM) + RMS_EPS);
#pragma unroll
        for (int q = 0; q < 4; ++q) { const int k = 4 * lane + 256 * q;
            const f32x4 y = (v[q] * rstd) * w4[q]; const f32x4 o = y * s4[q] + h4[q];
            u32x2 w; w.x = pk2(o[0], o[1]); w.y = pk2(o[2], o[3]); *(u32x2*)(U + (size_t)R * DM + k) = w; }
    }
}

typedef _Float16 f16x2_t __attribute__((ext_vector_type(2)));
DI unsigned pkh2(float a, float b) { const f16x2_t v = {(_Float16)a, (_Float16)b}; return __builtin_bit_cast(unsigned, v); }
DI void unpkh2(unsigned u, float& a, float& b) { const f16x2_t v = __builtin_bit_cast(f16x2_t, u); a = (float)v[0]; b = (float)v[1]; }
constexpr int RG_UT = 0, RG_AL = 17408, RG_BL = 50176, RG_HP = 82944, RG_QA = 148480, RG_CAR = 152576, RG_FLAG = 153600, RG_END = 153664;
static_assert(RG_END <= LDS_BYTES - 256, "RG-LRU LDS map");
constexpr int CW_RG = 8192;
DI void rglru_item(const Params& P, LAS unsigned char* lds, int j, int item, int wv) {
    const int tid = get_tid(wv), lane = tid & 63, wave = tid >> 6, r = lane & 15, g = lane >> 4;
    const int grp = item / NCHUNK, ci = item % NCHUNK, b = grp >> 3, hd = grp & 7;
    bf16_t* p = (bf16_t*)(P.ws + WS_P);
    const bf16_t* WRG = (const bf16_t*)(P.ws + WS_WRG);
    unsigned long long* AGG = (unsigned long long*)(P.ws + WS_AGG);
    unsigned* cnt = (unsigned*)(P.ws + WS_CTL) + CW_RG + (j * 64 + grp) * 16;
    const int R0 = b * LT + ci * 64;
    const int seg_lo = b * LT + (ci < 4 ? 0 : CTXL), seg_hi = b * LT + (ci < 4 ? CTXL : LT);
    LAS bf16_t* UT = (LAS bf16_t*)(lds + RG_UT);
    LAS float* AL = (LAS float*)(lds + RG_AL);
    LAS float* BL = (LAS float*)(lds + RG_BL);
    LAS unsigned* HP = (LAS unsigned*)(lds + RG_HP);
    LAS float* QA = (LAS float*)(lds + RG_QA);
    LAS float* CAR = (LAS float*)(lds + RG_CAR);
    TP_START(10, lds, tid); TP_START(11, lds, tid);
    bf16x8 wfr[2][2][4];
    float prm[2][3];
#pragma unroll
    for (int dir = 0; dir < 2; ++dir) {
#pragma unroll
        for (int gt = 0; gt < 2; ++gt) {
            const bf16_t* W = WRG + (size_t)((dir * 2 + gt) * 8 + hd) * 16384 + (wave * 4 * 64 + lane) * 8;
#pragma unroll
            for (int ks = 0; ks < 4; ++ks) wfr[dir][gt][ks] = *(const bf16x8*)(W + ks * 512);
        }
        const int idx = (j * 2 + dir) * 1024 + hd * 128 + 16 * wave + r;
        prm[dir][0] = P.ev_rg_bx[idx]; prm[dir][1] = P.ev_rg_ba[idx]; prm[dir][2] = P.ev_rg_lambda[idx];
    }
    {
        LAS bf16_t* XT = (LAS bf16_t*)(lds + RG_HP);
#pragma unroll
        for (int rep = 0; rep < 3; ++rep) {
            const int idx = tid + rep * 512, tr = idx >> 4, c0 = (idx & 15) * 8;
            if (idx < 67 * 16) {
                const int Rg = R0 + tr - 1;
                u32x4 xv = {0u, 0u, 0u, 0u};
                if (Rg >= seg_lo && Rg < seg_hi) xv = *(const u32x4*)(p + (size_t)Rg * EVEN_IN + hd * 128 + c0);
                *(LAS u32x4*)(XT + tr * 128 + c0) = xv;
            }
        }
        const int c0 = (tid & 15) * 8, cg0 = hd * 128 + c0;
        float wv4[4][8], bias[8];
        { const f32x4 b0 = *(const f32x4*)(P.ev_conv_b + j * 1024 + cg0), b1 = *(const f32x4*)(P.ev_conv_b + j * 1024 + cg0 + 4);
          bias[0] = b0[0]; bias[1] = b0[1]; bias[2] = b0[2]; bias[3] = b0[3]; bias[4] = b1[0]; bias[5] = b1[1]; bias[6] = b1[2]; bias[7] = b1[3]; }
#pragma unroll
        for (int k = 0; k < 4; ++k) { const float* wk = P.ev_conv_w + (size_t)(j * 4 + k) * 1024 + cg0; const f32x4 w0 = *(const f32x4*)wk, w1 = *(const f32x4*)(wk + 4);
            wv4[k][0] = w0[0]; wv4[k][1] = w0[1]; wv4[k][2] = w0[2]; wv4[k][3] = w0[3]; wv4[k][4] = w1[0]; wv4[k][5] = w1[1]; wv4[k][6] = w1[2]; wv4[k][7] = w1[3]; }
        __syncthreads();
#pragma unroll
        for (int rep = 0; rep < 2; ++rep) {
            const int t = (tid >> 4) + rep * 32;
            float acc[8];
#pragma unroll
            for (int e = 0; e < 8; ++e) acc[e] = bias[e];
#pragma unroll
            for (int k = 0; k < 4; ++k) {
                const u32x4 xv = *(const LAS u32x4*)(XT + (t + k) * 128 + c0);
                acc[0] += wv4[k][0] * __uint_as_float(xv.x << 16); acc[1] += wv4[k][1] * __uint_as_float(xv.x & 0xffff0000u);
                acc[2] += wv4[k][2] * __uint_as_float(xv.y << 16); acc[3] += wv4[k][3] * __uint_as_float(xv.y & 0xffff0000u);
                acc[4] += wv4[k][4] * __uint_as_float(xv.z << 16); acc[5] += wv4[k][5] * __uint_as_float(xv.z & 0xffff0000u);
                acc[6] += wv4[k][6] * __uint_as_float(xv.w << 16); acc[7] += wv4[k][7] * __uint_as_float(xv.w & 0xffff0000u);
            }
            u32x4 o; o.x = pk2(acc[0], acc[1]); o.y = pk2(acc[2], acc[3]); o.z = pk2(acc[4], acc[5]); o.w = pk2(acc[6], acc[7]);
            *(LAS u32x4*)(UT + t * 136 + c0) = o;
        }
    }
    __syncthreads();
    TP_STOP(11, lds, tid);
#pragma unroll
    for (int dir = 0; dir < 2; ++dir) {
        TP_START(12, lds, tid); TP_START(16, lds, tid);
        f32x4 ax[4], aa[4];
#pragma unroll
        for (int m = 0; m < 4; ++m) { ax[m] = (f32x4){0.f, 0.f, 0.f, 0.f}; aa[m] = (f32x4){0.f, 0.f, 0.f, 0.f}; }
#pragma unroll
        for (int ks = 0; ks < 4; ++ks) {
#pragma unroll
            for (int m = 0; m < 4; ++m) {
                const bf16x8 a = *(const LAS bf16x8*)(UT + (16 * m + r) * 136 + 32 * ks + 8 * g);
                ax[m] = MFMA16(a, wfr[dir][0][ks], ax[m]); aa[m] = MFMA16(a, wfr[dir][1][ks], aa[m]);
            }
        }
        asm volatile("" :: "v"(ax[0]), "v"(ax[1]), "v"(ax[2]), "v"(ax[3]), "v"(aa[0]), "v"(aa[1]), "v"(aa[2]), "v"(aa[3]));
        TP_STOP(16, lds, tid); TP_START(17, lds, tid);
        {
            const int c = 16 * wave + r;
            const float bxv = prm[dir][0], bav = prm[dir][1], lam = prm[dir][2];
            const float sp = softplus_neg(lam);
#pragma unroll
            for (int m = 0; m < 4; ++m)
#pragma unroll
                for (int i = 0; i < 4; ++i) {
                    const int t = 16 * m + 4 * g + i;
                    const float gx = sigm(ax[m][i] + bxv), ga = sigm(aa[m][i] + bav);
                    const float la = -8.f * ga * sp;
                    const float a = __expf(la), mult = __builtin_amdgcn_sqrtf(neg_expm1(2.f * la));
                    const float uv = bf2f(UT[t * 136 + c]);
                    AL[t * 128 + c] = a; BL[t * 128 + c] = mult * gx * uv;
                }
        }
        asm volatile("s_waitcnt lgkmcnt(0)" ::: "memory");
        TP_STOP(17, lds, tid); TP_START(18, lds, tid);
        __syncthreads();
        TP_STOP(18, lds, tid);
        TP_STOP(12, lds, tid); TP_START(13, lds, tid);
        {
            const int c = tid & 127, q = tid >> 7;
            float A = 1.f, B = 0.f;
#pragma unroll
            for (int s = 0; s < 16; ++s) { const int t = dir == 0 ? 16 * q + s : 16 * q + 15 - s; const float a = AL[t * 128 + c], bb = BL[t * 128 + c]; B = a * B + bb; A *= a; }
            QA[(q * 128 + c) * 2] = A; QA[(q * 128 + c) * 2 + 1] = B;
            __syncthreads();
            float h = 0.f, pc = 1.f;
            const int nprev = dir == 0 ? q : 3 - q;
            for (int qq = 0; qq < nprev; ++qq) { const int qi = dir == 0 ? qq : 3 - qq; const float a = QA[(qi * 128 + c) * 2]; h = a * h + QA[(qi * 128 + c) * 2 + 1]; pc *= a; }
#pragma unroll
            for (int s = 0; s < 16; ++s) { const int t = dir == 0 ? 16 * q + s : 16 * q + 15 - s; const float a = AL[t * 128 + c]; h = a * h + BL[t * 128 + c]; pc *= a;
                HP[(dir * 64 + t) * 128 + c] = pkh2(h, pc); }
            if (nprev == 3) {
                const unsigned long long v = ((unsigned long long)__float_as_uint(h) << 32) | __float_as_uint(pc);
                __hip_atomic_store(AGG + ((size_t)(dir * NB + b) * NCHUNK + ci) * 1024 + hd * 128 + c, v, __ATOMIC_RELAXED, __HIP_MEMORY_SCOPE_AGENT);
            }
        }
        __syncthreads();
        TP_STOP(13, lds, tid);
    }
    TP_START(14, lds, tid);
    u32x4 gpre[2];
#pragma unroll
    for (int rep = 0; rep < 2; ++rep) { const int idx = tid + rep * 512; gpre[rep] = *(const u32x4*)(p + (size_t)(R0 + (idx >> 4)) * EVEN_IN + 1536 + hd * 128 + (idx & 15) * 8); }
    asm volatile("s_waitcnt vmcnt(0)" ::: "memory");
    __syncthreads();
    if (tid == 0) {
        __hip_atomic_fetch_add(cnt, 1u, __ATOMIC_RELAXED, __HIP_MEMORY_SCOPE_AGENT);
        unsigned spins = 0;
        while (__hip_atomic_load(cnt, __ATOMIC_RELAXED, __HIP_MEMORY_SCOPE_AGENT) < (unsigned)NCHUNK) { __builtin_amdgcn_s_sleep(2); if (++spins > (1u << 22)) break; }
    }
    __syncthreads();
    TP_STOP(14, lds, tid); TP_START(15, lds, tid);
    if (tid < 256) {
        const int dir = tid >> 7, c = tid & 127;
        const int pos = dir == 0 ? ci : (ci < 4 ? 3 - ci : 39 - ci);
        float h = 0.f;
        const unsigned long long* ag = AGG + (size_t)(dir * NB + b) * NCHUNK * 1024 + hd * 128 + c;
#pragma unroll 1
        for (int base = 0; base < pos; base += 18) {
            unsigned long long v[18];
#pragma unroll
            for (int k = 0; k < 18; ++k) { const int pp = base + k < pos ? base + k : pos - 1; const int cc = dir == 0 ? pp : (pp < 4 ? 3 - pp : 39 - pp);
                v[k] = __hip_atomic_load(ag + (size_t)cc * 1024, __ATOMIC_RELAXED, __HIP_MEMORY_SCOPE_AGENT); }
#pragma unroll
            for (int k = 0; k < 18; ++k) if (base + k < pos) h = __uint_as_float((unsigned)v[k]) * h + __uint_as_float((unsigned)(v[k] >> 32));
        }
        CAR[dir * 128 + c] = h;
    }
    __syncthreads();
#pragma unroll
    for (int rep = 0; rep < 2; ++rep) {
        const int idx = tid + rep * 512, t = idx >> 4, c0 = (idx & 15) * 8;
        bf16_t* gp = p + (size_t)(R0 + t) * EVEN_IN + 1536 + hd * 128 + c0;
        const u32x4 gv = gpre[rep];
        float y[8];
#pragma unroll
        for (int e = 0; e < 8; ++e) {
            float h0, p0, h1, p1; unpkh2(HP[t * 128 + c0 + e], h0, p0); unpkh2(HP[(64 + t) * 128 + c0 + e], h1, p1);
            y[e] = (h0 + p0 * CAR[c0 + e]) + (h1 + p1 * CAR[128 + c0 + e]);
        }
        const float gg[8] = {__uint_as_float(gv.x << 16), __uint_as_float(gv.x & 0xffff0000u), __uint_as_float(gv.y << 16), __uint_as_float(gv.y & 0xffff0000u),
                             __uint_as_float(gv.z << 16), __uint_as_float(gv.z & 0xffff0000u), __uint_as_float(gv.w << 16), __uint_as_float(gv.w & 0xffff0000u)};
        u32x4 o;
        o.x = pk2(y[0] * gg[0] * sigm(gg[0]), y[1] * gg[1] * sigm(gg[1])); o.y = pk2(y[2] * gg[2] * sigm(gg[2]), y[3] * gg[3] * sigm(gg[3]));
        o.z = pk2(y[4] * gg[4] * sigm(gg[4]), y[5] * gg[5] * sigm(gg[5])); o.w = pk2(y[6] * gg[6] * sigm(gg[6]), y[7] * gg[7] * sigm(gg[7]));
        *(u32x4*)gp = o;
    }
    __syncthreads();
    TP_STOP(15, lds, tid); TP_STOP(10, lds, tid);
}

DI void rope8v(u32x4& v, const f32x4 cs, const f32x4 sn) {
    unsigned* w = (unsigned*)&v;
#pragma unroll
    for (int i = 0; i < 4; ++i) { const float t1 = __uint_as_float(w[i] << 16), t2 = __uint_as_float(w[i] & 0xffff0000u); w[i] = pk2(t1 * cs[i] - t2 * sn[i], t1 * sn[i] + t2 * cs[i]); }
}
DI void rope8(u32x4& v, const float* cs, const float* sn) { rope8v(v, *(const f32x4*)cs, *(const f32x4*)sn); }
typedef short v4i16_a __attribute__((ext_vector_type(4)));
DI void attn_item(const Params& P, LAS unsigned char* lds, int j, int item, int wv) {
    const int tid = get_tid(wv), lane = tid & 63, wave = tid >> 6, r = lane & 31, h = lane >> 5;
    const bool is_lat = item < 512;
    int b, qb, kvh;
    if (is_lat) { b = item >> 6; qb = (item >> 2) & 15; kvh = item & 3; } else { const int it = item - 512; b = it >> 3; qb = (it >> 2) & 1; kvh = it & 3; }
    bf16_t* p = (bf16_t*)(P.ws + WS_P);
    const float* cos_t = (const float*)(P.ws + WS_ROPE); const float* sin_t = cos_t + SEQ * 32;
    LAS unsigned char* QL = lds + 36864 + wave * 9216;
    TP_START(1, lds, tid);
    const int hq = 4 * kvh + (wave >> 1), ql0 = qb * 128 + 64 * (wave & 1);
    const size_t rowbase = (size_t)b * LT + (is_lat ? CTXL : 0);
    {
        const int chq = lane & 7;
#pragma unroll
        for (int k = 0; k < 8; ++k) {
            const int row = (lane >> 3) + 8 * k, qi = ql0 + row;
            u32x4 v = *(const u32x4*)(p + (rowbase + qi) * EVEN_IN + 2560 + hq * 64 + 8 * chq);
            if (is_lat) rope8(v, cos_t + qi * 32 + 4 * chq, sin_t + qi * 32 + 4 * chq);
            *(LAS u32x4*)(QL + row * 144 + chq * 16) = v;
        }
    }
    const float sink2 = P.ev_sink[j * 16 + hq] * LOG2E;
    float mrun[2] = {sink2, sink2}, lrun[2] = {h == 0 ? 1.f : 0.f, h == 0 ? 1.f : 0.f};
    f32x16 O[2][2];
#pragma unroll
    for (int a = 0; a < 2; ++a)
#pragma unroll
        for (int c = 0; c < 2; ++c)
#pragma unroll
            for (int i = 0; i < 16; ++i) O[a][c][i] = 0.f;
    const int w_lo = (is_lat && qb == 0) ? 2 : 0, w_hi = (is_lat && qb == 15) ? 3 : 5;
    const int nT = is_lat ? 4 + (w_hi - w_lo + 1) : 4;
    const float SC = 0.125f * LOG2E, NEG = -1e30f;
    const int key = tid >> 3, chn = tid & 7;
    u32x4 kreg, vreg; f32x4 creg, sreg;
#define ATT_K0(t) ((t) < 4 ? 64 * (t) : qb * 128 - 128 + 64 * (w_lo + (t) - 4))
#define ATT_LOAD(t) do { const bool win_ = (t) >= 4; const int k0_ = ATT_K0(t); \
        const bf16_t* kp_ = p + ((size_t)b * LT + (win_ ? CTXL : 0) + k0_ + key) * EVEN_IN + 1024 + kvh * 64 + 8 * chn; \
        kreg = *(const u32x4*)kp_; vreg = *(const u32x4*)(kp_ + 256); \
        if (win_) { creg = *(const f32x4*)(cos_t + (k0_ + key) * 32 + 4 * chn); sreg = *(const f32x4*)(sin_t + (k0_ + key) * 32 + 4 * chn); } } while (0)
#define ATT_STORE(t, buf) do { const bool win_ = (t) >= 4; \
        if (win_) rope8v(kreg, creg, sreg); \
        *(LAS u32x4*)(lds + (buf) * 18432 + key * 144 + chn * 16) = kreg; *(LAS u32x4*)(lds + (buf) * 18432 + 9216 + key * 144 + chn * 16) = vreg; } while (0)
    TP_START(2, lds, tid);
    ATT_LOAD(0); ATT_STORE(0, 0);
    if (nT > 1) ATT_LOAD(1);
#pragma unroll 1
    for (int t = 0; t < nT; ++t) {
        TP_START(4, lds, tid);
        __syncthreads();
        TP_STOP(4, lds, tid);
        if (t + 1 < nT) { ATT_STORE(t + 1, (t + 1) & 1); if (t + 2 < nT) ATT_LOAD(t + 2); }
        TP_START(3, lds, tid);
        const bool win = t >= 4;
        const int k0 = ATT_K0(t);
        const int dq = k0 - ql0;
        if (win && (dq >= 192 || dq <= -192)) continue;
        const bool need_mask = win && (dq >= 128 || dq <= -128);
        const LAS unsigned char* KL = lds + (t & 1) * 18432;
        const LAS bf16_t* VL = (const LAS bf16_t*)(lds + (t & 1) * 18432 + 9216);
#pragma unroll
        for (int qt = 0; qt < 2; ++qt) {
            f32x16 s0, s1;
#pragma unroll
            for (int i = 0; i < 16; ++i) { s0[i] = 0.f; s1[i] = 0.f; }
#pragma unroll
            for (int ks = 0; ks < 4; ++ks) {
                const bf16x8 qfr = *(const LAS bf16x8*)(QL + (32 * qt + r) * 144 + (16 * ks + 8 * h) * 2);
                const bf16x8 k0f = *(const LAS bf16x8*)(KL + r * 144 + (16 * ks + 8 * h) * 2), k1f = *(const LAS bf16x8*)(KL + (32 + r) * 144 + (16 * ks + 8 * h) * 2);
                s0 = MFMA32(k0f, qfr, s0); s1 = MFMA32(k1f, qfr, s1);
            }
            const int qpos = ql0 + 32 * qt + r;
            float mx = NEG;
            if (need_mask) {
#pragma unroll
                for (int i = 0; i < 16; ++i) {
                    const int d0 = qpos - (k0 + crow(i, h)), d1 = d0 - 32;
                    float v0 = s0[i] * SC, v1 = s1[i] * SC;
                    if (d0 > 128 || d0 < -128) v0 = NEG;
                    if (d1 > 128 || d1 < -128) v1 = NEG;
                    s0[i] = v0; s1[i] = v1; mx = fmaxf(mx, fmaxf(v0, v1));
                }
            } else {
#pragma unroll
                for (int i = 0; i < 16; ++i) { s0[i] *= SC; s1[i] *= SC; mx = fmaxf(mx, fmaxf(s0[i], s1[i])); }
            }
            mx = fmaxf(mx, shfl_xor_f(mx, 32));
            const float mn = fmaxf(mrun[qt], mx), alpha = __builtin_amdgcn_exp2f(mrun[qt] - mn);
            mrun[qt] = mn;
            float ls = 0.f;
#pragma unroll
            for (int i = 0; i < 16; ++i) { s0[i] = __builtin_amdgcn_exp2f(s0[i] - mn); s1[i] = __builtin_amdgcn_exp2f(s1[i] - mn); ls += s0[i] + s1[i]; }
            lrun[qt] = lrun[qt] * alpha + ls;
#pragma unroll
            for (int dt = 0; dt < 2; ++dt)
#pragma unroll
                for (int i = 0; i < 16; ++i) O[dt][qt][i] *= alpha;
            bf16x8 pf[2][2];
#pragma unroll
            for (int s = 0; s < 2; ++s) {
                u32x4 a, c;
                a.x = pk2(s0[8 * s + 0], s0[8 * s + 1]); a.y = pk2(s0[8 * s + 2], s0[8 * s + 3]); a.z = pk2(s0[8 * s + 4], s0[8 * s + 5]); a.w = pk2(s0[8 * s + 6], s0[8 * s + 7]);
                c.x = pk2(s1[8 * s + 0], s1[8 * s + 1]); c.y = pk2(s1[8 * s + 2], s1[8 * s + 3]); c.z = pk2(s1[8 * s + 4], s1[8 * s + 5]); c.w = pk2(s1[8 * s + 6], s1[8 * s + 7]);
                pf[0][s] = __builtin_bit_cast(bf16x8, a); pf[1][s] = __builtin_bit_cast(bf16x8, c);
            }
            const int gq = (lane >> 4) & 1, qq4 = (lane & 15) >> 2, pp4 = lane & 3;
#pragma unroll
            for (int dt = 0; dt < 2; ++dt)
#pragma unroll
                for (int kt = 0; kt < 2; ++kt)
#pragma unroll
                    for (int s = 0; s < 2; ++s) {
                        const LAS bf16_t* vp = VL + (32 * kt + 16 * s + 4 * h + qq4) * 72 + 32 * dt + 16 * gq + 4 * pp4;
                        const v4i16_a lo = __builtin_amdgcn_ds_read_tr16_b64_v4i16((LAS v4i16_a*)vp);
                        const v4i16_a hi = __builtin_amdgcn_ds_read_tr16_b64_v4i16((LAS v4i16_a*)(vp + 8 * 72));
                        const bf16x8 vf = {lo[0], lo[1], lo[2], lo[3], hi[0], hi[1], hi[2], hi[3]};
                        O[dt][qt] = MFMA32(vf, pf[kt][s], O[dt][qt]);
                    }
            __builtin_amdgcn_sched_barrier(0);
        }
        TP_STOP(3, lds, tid);
    }
    TP_STOP(2, lds, tid);
#undef ATT_K0
#undef ATT_LOAD
#undef ATT_STORE
    {
        const int chq = lane & 7;
        u32x4 gate[8];
#pragma unroll
        for (int k = 0; k < 8; ++k) gate[k] = *(const u32x4*)(p + (rowbase + ql0 + (lane >> 3) + 8 * k) * EVEN_IN + 3584 + hq * 64 + 8 * chq);
#pragma unroll
        for (int qt = 0; qt < 2; ++qt) {
            const float lt = lrun[qt] + shfl_xor_f(lrun[qt], 32), inv = __builtin_amdgcn_rcpf(lt);
#pragma unroll
            for (int dt = 0; dt < 2; ++dt)
#pragma unroll
                for (int i4 = 0; i4 < 4; ++i4) {
                    u32x2 o; o.x = pk2(O[dt][qt][4 * i4 + 0] * inv, O[dt][qt][4 * i4 + 1] * inv); o.y = pk2(O[dt][qt][4 * i4 + 2] * inv, O[dt][qt][4 * i4 + 3] * inv);
                    *(LAS u32x2*)(QL + (32 * qt + r) * 144 + (32 * dt + 8 * i4 + 4 * h) * 2) = o;
                }
        }
#pragma unroll
        for (int k = 0; k < 8; ++k) {
            const int row = (lane >> 3) + 8 * k;
            const u32x4 ov = *(const LAS u32x4*)(QL + row * 144 + chq * 16);
            const unsigned* ow = (const unsigned*)&ov; const unsigned* gw = (const unsigned*)&gate[k];
            u32x4 res; unsigned* rw = (unsigned*)&res;
#pragma unroll
            for (int e = 0; e < 4; ++e) {
                const float g0 = __uint_as_float(gw[e] << 16), g1 = __uint_as_float(gw[e] & 0xffff0000u);
                rw[e] = pk2(__uint_as_float(ow[e] << 16) * g0 * sigm(g0), __uint_as_float(ow[e] & 0xffff0000u) * g1 * sigm(g1));
            }
            *(u32x4*)(p + (rowbase + ql0 + row) * EVEN_IN + 2560 + hq * 64 + 8 * chq) = res;
        }
    }
    __syncthreads();
    TP_STOP(1, lds, tid);
}

constexpr int G2_QX = 0, G2_KF = 17408, G2_K2 = 60928, G2_VS = 79360, G2_AM = 96768, G2_ST = 105984, G2_PS = 140800, G2_BL = 144896, G2_Q1 = 145408, G2_END = 162816;
static_assert(G2_END <= LDS_BYTES - 256, "GLA LDS map");
typedef short v4i16_t __attribute__((ext_vector_type(4)));
DI bf16x8 frag_tr(const LAS bf16_t* M, int stride, int k0, int n0, int lane) {
    const int i = lane & 15, g = lane >> 4, q = i >> 2, pp = i & 3;
    const LAS bf16_t* a0 = M + (k0 + 8 * g + q) * stride + n0 + 4 * pp;
    const v4i16_t lo = __builtin_amdgcn_ds_read_tr16_b64_v4i16((LAS v4i16_t*)a0);
    const v4i16_t hi = __builtin_amdgcn_ds_read_tr16_b64_v4i16((LAS v4i16_t*)(a0 + 4 * stride));
    return (bf16x8){lo[0], lo[1], lo[2], lo[3], hi[0], hi[1], hi[2], hi[3]};
}

template <int DIR>
DI void gla2_item(const Params& P, LAS unsigned char* lds, int layer_j, int b, int hd, int wv) {
    const int tid = get_tid(wv), lane = tid & 63, wave = tid >> 6, r = lane & 15, g = lane >> 4;
    bf16_t* p = (bf16_t*)(P.ws + WS_P);
    LAS bf16_t* QX = (LAS bf16_t*)(lds + G2_QX); LAS bf16_t* KF = (LAS bf16_t*)(lds + G2_KF); LAS bf16_t* K2 = (LAS bf16_t*)(lds + G2_K2);
    LAS bf16_t* VS = (LAS bf16_t*)(lds + G2_VS); LAS bf16_t* AM = (LAS bf16_t*)(lds + G2_AM); LAS bf16_t* ST = (LAS bf16_t*)(lds + G2_ST);
    LAS float* PS8 = (LAS float*)(lds + G2_PS); LAS float* BLAST = (LAS float*)(lds + G2_BL); LAS bf16_t* Q1 = (LAS bf16_t*)(lds + G2_Q1);
    const int d0 = 2 * lane, tg = wave, I = tg >> 1, half = tg & 1;
    float lbv[2] = {0.f, 0.f};
    if (layer_j > 0) { lbv[0] = sigm(P.od_lb_raw[1024 + hd * 128 + d0] - P.od_lb_raw[hd * 128 + d0]); lbv[1] = sigm(P.od_lb_raw[1024 + hd * 128 + d0 + 1] - P.od_lb_raw[hd * 128 + d0 + 1]); }
    TP_START(20, lds, tid);
    for (int i = tid; i < (9216 + 34816) / 4; i += 512) ((LAS unsigned*)(lds + G2_AM))[i] = 0u;
    f32x4 st[8];
#pragma unroll
    for (int e = 0; e < 8; ++e) st[e] = (f32x4){0.f, 0.f, 0.f, 0.f};
    unsigned zn[8], qn[8]; u32x4 vn[2];
#define G2_OFFZ(s) ((unsigned)((DIR == 0 ? 8 * tg + (s) : 63 - 8 * tg - (s)) * ODD_IN + d0) * 2u)
#define G2_OFFV(rep) ((unsigned)((DIR == 0 ? ((tid + (rep) * 512) >> 4) : 63 - ((tid + (rep) * 512) >> 4)) * ODD_IN + 8 * ((tid + (rep) * 512) & 15)) * 2u)
    const size_t colz = (size_t)DIR * 1024 + hd * 128, colq = 3072 + hd * 128, colv = 2048 + hd * 128;
    {
        const int chunk = DIR == 0 ? 0 : 3;
        const char* slab = (const char*)(p + ((size_t)b * LT + (size_t)chunk * 64) * ODD_IN);
#pragma unroll
        for (int s = 0; s < 8; ++s) { zn[s] = *(const unsigned*)(slab + colz * 2 + G2_OFFZ(s)); qn[s] = *(const unsigned*)(slab + colq * 2 + G2_OFFZ(s)); }
#pragma unroll
        for (int rep = 0; rep < 2; ++rep) vn[rep] = *(const u32x4*)(slab + colv * 2 + G2_OFFV(rep));
    }
    __syncthreads();
#pragma unroll 1
    for (int step = 0; step < NCHUNK; ++step) {
        const int chunk = DIR == 0 ? step : (step < 4 ? 3 - step : 39 - step);
        const size_t Rc0 = (size_t)b * LT + (size_t)chunk * 64;
        unsigned zc[8], qc[8]; u32x4 vc[2];
#pragma unroll
        for (int s = 0; s < 8; ++s) { zc[s] = zn[s]; qc[s] = qn[s]; }
        vc[0] = vn[0]; vc[1] = vn[1];
        TP_START(21, lds, tid);
        float el[8][2], kk[8][2], qq[8][2];
        {
            float run0 = 1.f, run1 = 1.f;
#pragma unroll
            for (int s = 0; s < 8; ++s) {
                const float z0 = __uint_as_float(zc[s] << 16), z1 = __uint_as_float(zc[s] & 0xffff0000u);
                const float t0 = __expf(-z0), t1 = __expf(-z1), sg0 = __builtin_amdgcn_rcpf(1.f + t0), sg1 = __builtin_amdgcn_rcpf(1.f + t1);
                const float f0 = fmaxf(lbv[0] + (1.f - lbv[0]) * sg0, 1e-30f), f1 = fmaxf(lbv[1] + (1.f - lbv[1]) * sg1, 1e-30f);
                kk[s][0] = (1.f - lbv[0]) * (t0 * sg0); kk[s][1] = (1.f - lbv[1]) * (t1 * sg1);
                run0 = fmaxf(run0 * f0, 1e-35f); run1 = fmaxf(run1 * f1, 1e-35f); el[s][0] = run0; el[s][1] = run1;
                const float q0 = __uint_as_float(qc[s] << 16), q1 = __uint_as_float(qc[s] & 0xffff0000u);
                qq[s][0] = q0 * __builtin_amdgcn_rcpf(1.f + __expf(-q0)); qq[s][1] = q1 * __builtin_amdgcn_rcpf(1.f + __expf(-q1));
                if ((s & 1) == 1) __builtin_amdgcn_sched_barrier(0);
            }
            *(LAS f32x2*)(PS8 + tg * 128 + d0) = (f32x2){run0, run1};
#pragma unroll
            for (int rep = 0; rep < 2; ++rep) { const int idx = tid + rep * 512, tau = idx >> 4, chn = idx & 15; *(LAS u32x4*)(VS + tau * 136 + 8 * chn) = vc[rep]; }
        }
        __syncthreads();
        TP_STOP(21, lds, tid); TP_START(22, lds, tid);
        float RI[2];
        {
            float T[8][2];
#pragma unroll
            for (int q8 = 0; q8 < 8; ++q8) { const f32x2 t = *(const LAS f32x2*)(PS8 + q8 * 128 + d0); T[q8][0] = t[0]; T[q8][1] = t[1]; }
            float pre[2], fac[4][2], f4[2];
#pragma unroll
            for (int x = 0; x < 2; ++x) {
                const float P0 = T[0][x] * T[1][x], P1 = T[2][x] * T[3][x], P2 = T[4][x] * T[5][x], P3 = T[6][x] * T[7][x];
                pre[x] = half ? (I == 0 ? T[0][x] : (I == 1 ? T[2][x] : (I == 2 ? T[4][x] : T[6][x]))) : 1.f;
                RI[x] = I == 0 ? 1.f : (I == 1 ? P0 : (I == 2 ? P0 * P1 : P0 * P1 * P2));
                float cur = 1.f;
                fac[0][x] = cur; if (I <= 0) cur *= P0;
                fac[1][x] = cur; if (I <= 1) cur *= P1;
                fac[2][x] = cur; if (I <= 2) cur *= P2;
                fac[3][x] = cur; cur *= P3;
                f4[x] = cur;
                if (tg == 0) BLAST[d0 + x] = P0 * P1 * P2 * P3;
            }
            unsigned w0[4], w1[4];
#pragma unroll
            for (int s = 0; s < 8; ++s) {
                const int tau = 8 * tg + s;
                const float e00 = fmaxf(pre[0] * el[s][0], 1e-35f), e01 = fmaxf(pre[1] * el[s][1], 1e-35f);
                const float qi0 = qq[s][0] * e00, qi1 = qq[s][1] * e01;
                const float kd0 = kk[s][0] * __builtin_amdgcn_rcpf(e00), kd1 = kk[s][1] * __builtin_amdgcn_rcpf(e01);
                *(LAS unsigned*)(QX + tau * 136 + d0) = pk2(qi0, qi1);
                *(LAS unsigned*)(Q1 + tau * 136 + d0) = pk2(qi0 * RI[0], qi1 * RI[1]);
                if (I <= 0) *(LAS unsigned*)(KF + (0 + tau) * 136 + d0) = pk2(kd0 * fac[0][0], kd1 * fac[0][1]);
                if (I <= 1) *(LAS unsigned*)(KF + (16 + tau) * 136 + d0) = pk2(kd0 * fac[1][0], kd1 * fac[1][1]);
                if (I <= 2) *(LAS unsigned*)(KF + (48 + tau) * 136 + d0) = pk2(kd0 * fac[2][0], kd1 * fac[2][1]);
                *(LAS unsigned*)(KF + (96 + tau) * 136 + d0) = pk2(kd0 * fac[3][0], kd1 * fac[3][1]);
                const unsigned h0 = f2bf(kd0 * f4[0]), h1 = f2bf(kd1 * f4[1]);
                if (s & 1) { w0[s >> 1] |= h0 << 16; w1[s >> 1] |= h1 << 16; } else { w0[s >> 1] = h0; w1[s >> 1] = h1; }
                if ((s & 1) == 1) __builtin_amdgcn_sched_barrier(0);
            }
            *(LAS u32x4*)(K2 + (d0 + 0) * 72 + 8 * tg) = (u32x4){w0[0], w0[1], w0[2], w0[3]};
            *(LAS u32x4*)(K2 + (d0 + 1) * 72 + 8 * tg) = (u32x4){w1[0], w1[1], w1[2], w1[3]};
        }
        __syncthreads();
        TP_STOP(22, lds, tid); TP_START(23, lds, tid);
        if (step + 1 < NCHUNK) {
            const int nchunk = DIR == 0 ? step + 1 : (step + 1 < 4 ? 2 - step : 38 - step);
            const char* slab = (const char*)(p + ((size_t)b * LT + (size_t)nchunk * 64) * ODD_IN);
#pragma unroll
            for (int s = 0; s < 8; ++s) { zn[s] = *(const unsigned*)(slab + colz * 2 + G2_OFFZ(s)); qn[s] = *(const unsigned*)(slab + colq * 2 + G2_OFFZ(s)); }
#pragma unroll
            for (int rep = 0; rep < 2; ++rep) vn[rep] = *(const u32x4*)(slab + colv * 2 + G2_OFFV(rep));
        }
#pragma unroll 1
        for (int bi = wave; bi < 10; bi += 8) {
            const int Ib = bi < 1 ? 0 : (bi < 3 ? 1 : (bi < 6 ? 2 : 3)), Jb = bi - (Ib * (Ib + 1)) / 2;
            const int foff = Ib == 0 ? 0 : (Ib == 1 ? 16 : (Ib == 2 ? 48 : 96));
            f32x4 acc = {0.f, 0.f, 0.f, 0.f};
#pragma unroll
            for (int ks = 0; ks < 4; ++ks) {
                const bf16x8 a = *(const LAS bf16x8*)(QX + (16 * Ib + r) * 136 + 32 * ks + 8 * g);
                const bf16x8 bb = *(const LAS bf16x8*)(KF + (foff + 16 * Jb + r) * 136 + 32 * ks + 8 * g);
                acc = MFMA16(a, bb, acc);
            }
#pragma unroll
            for (int i = 0; i < 4; ++i) { float v = acc[i]; if (Jb == Ib && r > 4 * g + i) v = 0.f; AM[(16 * Ib + 4 * g + i) * 72 + 16 * Jb + r] = (bf16_t)f2bf(v); }
        }
        __syncthreads();
        TP_STOP(23, lds, tid); TP_START(24, lds, tid);
        {
            const int tt = wave >> 1, eb = 4 * (wave & 1);
            bf16x8 aq[4], am[2];
#pragma unroll
            for (int ks = 0; ks < 4; ++ks) aq[ks] = *(const LAS bf16x8*)(Q1 + (16 * tt + r) * 136 + 32 * ks + 8 * g);
#pragma unroll
            for (int ks = 0; ks < 2; ++ks) am[ks] = *(const LAS bf16x8*)(AM + (16 * tt + r) * 72 + 32 * ks + 8 * g);
#pragma unroll
            for (int e4 = 0; e4 < 4; ++e4) {
                const int et = eb + e4;
                f32x4 acc = {0.f, 0.f, 0.f, 0.f};
#pragma unroll
                for (int ks = 0; ks < 4; ++ks) { const bf16x8 bb = *(const LAS bf16x8*)(ST + (16 * et + r) * 136 + 32 * ks + 8 * g); acc = MFMA16(aq[ks], bb, acc); }
#pragma unroll
                for (int ks = 0; ks < 2; ++ks) acc = MFMA16(am[ks], frag_tr(VS, 136, 32 * ks, 16 * et, lane), acc);
#pragma unroll
                for (int i = 0; i < 4; ++i) KF[(16 * tt + 4 * g + i) * 136 + 16 * et + r] = (bf16_t)f2bf(acc[i]);
                __builtin_amdgcn_sched_barrier(0);
            }
            float bl[4];
#pragma unroll
            for (int i = 0; i < 4; ++i) bl[i] = BLAST[16 * wave + 4 * g + i];
            bf16x8 ak[2];
#pragma unroll
            for (int ks = 0; ks < 2; ++ks) ak[ks] = *(const LAS bf16x8*)(K2 + (16 * wave + r) * 72 + 32 * ks + 8 * g);
#pragma unroll
            for (int et = 0; et < 8; ++et) {
#pragma unroll
                for (int i = 0; i < 4; ++i) st[et][i] *= bl[i];
#pragma unroll
                for (int ks = 0; ks < 2; ++ks) st[et] = MFMA16(ak[ks], frag_tr(VS, 136, 32 * ks, 16 * et, lane), st[et]);
                if (et & 1) __builtin_amdgcn_sched_barrier(0);
            }
        }
        __syncthreads();
        TP_STOP(24, lds, tid); TP_START(25, lds, tid);
        {
            char* oslab = (char*)(p + Rc0 * ODD_IN + colz);
#pragma unroll
            for (int rep = 0; rep < 2; ++rep) {
                const int idx = tid + rep * 512, tau = idx >> 4, chn = idx & 15;
                const u32x4 ov = *(const LAS u32x4*)(KF + tau * 136 + 8 * chn);
                *(u32x4*)(oslab + (unsigned)((DIR == 0 ? tau : 63 - tau) * ODD_IN + 8 * chn) * 2u) = ov;
            }
        }
#pragma unroll
        for (int et = 0; et < 8; ++et) { u32x2 w; w.x = pk2(st[et][0], st[et][1]); w.y = pk2(st[et][2], st[et][3]); *(LAS u32x2*)(ST + (16 * et + r) * 136 + 16 * wave + 4 * g) = w; }
        TP_STOP(25, lds, tid);
    }
    __syncthreads();
    TP_STOP(20, lds, tid);
}

DI void phase_readout(const Params& P, int layer_j, int wv) {
    const int tid = get_tid(wv), lane = tid & 63, wave = tid >> 6;
    const int gw = get_bid() * 8 + wave, NGW = gridDim.x * 8;
    bf16_t* p = (bf16_t*)(P.ws + WS_P);
    const float* gwt = P.od_gnorm_w + layer_j * 128 + (lane & 7) * 16;
    for (int R = gw; R < MROWS; R += NGW) {
        const bf16_t* op = p + (size_t)R * ODD_IN + 16 * lane; bf16_t* yp = p + (size_t)R * ODD_IN + 4096 + 16 * lane;
        const u32x4 o0 = *(const u32x4*)op, o1 = *(const u32x4*)(op + 8), c0 = *(const u32x4*)(op + 1024), c1 = *(const u32x4*)(op + 1032), g0 = *(const u32x4*)yp, g1 = *(const u32x4*)(yp + 8);
        float ov[16], gv[16];
        const unsigned* ow0 = (const unsigned*)&o0; const unsigned* ow1 = (const unsigned*)&o1; const unsigned* cw0 = (const unsigned*)&c0; const unsigned* cw1 = (const unsigned*)&c1;
        const unsigned* gw0 = (const unsigned*)&g0; const unsigned* gw1 = (const unsigned*)&g1;
#pragma unroll
        for (int i = 0; i < 4; ++i) {
            ov[2 * i] = __uint_as_float(ow0[i] << 16) + __uint_as_float(cw0[i] << 16); ov[2 * i + 1] = __uint_as_float(ow0[i] & 0xffff0000u) + __uint_as_float(cw0[i] & 0xffff0000u);
            ov[8 + 2 * i] = __uint_as_float(ow1[i] << 16) + __uint_as_float(cw1[i] << 16); ov[8 + 2 * i + 1] = __uint_as_float(ow1[i] & 0xffff0000u) + __uint_as_float(cw1[i] & 0xffff0000u);
            gv[2 * i] = __uint_as_float(gw0[i] << 16); gv[2 * i + 1] = __uint_as_float(gw0[i] & 0xffff0000u); gv[8 + 2 * i] = __uint_as_float(gw1[i] << 16); gv[8 + 2 * i + 1] = __uint_as_float(gw1[i] & 0xffff0000u);
        }
        float ss = 0.f;
#pragma unroll
        for (int i = 0; i < 16; ++i) ss += ov[i] * ov[i];
        ss += shfl_xor_f(ss, 1); ss += shfl_xor_f(ss, 2); ss += shfl_xor_f(ss, 4);
        const float rstd = rsqrtf(ss * (1.f / 128.f) + RMS_EPS);
        float y[16];
#pragma unroll
        for (int i = 0; i < 16; ++i) y[i] = ov[i] * rstd * gwt[i] * (gv[i] * sigm(gv[i]));
        u32x4 w0, w1;
        w0.x = pk2(y[0], y[1]); w0.y = pk2(y[2], y[3]); w0.z = pk2(y[4], y[5]); w0.w = pk2(y[6], y[7]);
        w1.x = pk2(y[8], y[9]); w1.y = pk2(y[10], y[11]); w1.z = pk2(y[12], y[13]); w1.w = pk2(y[14], y[15]);
        *(u32x4*)yp = w0; *(u32x4*)(yp + 8) = w1;
    }
}

DI void phase_final(const Params& P, int wv) {
    const int tid = get_tid(wv), lane = tid & 63, wave = tid >> 6;
    const int gw = get_bid() * 8 + wave, NGW = gridDim.x * 8;
    for (int R = gw; R < NB * SEQ; R += NGW) {
        float* row = P.out + (size_t)R * DM;
        f32x4 v[4]; float ss = 0.f;
#pragma unroll
        for (int q = 0; q < 4; ++q) { v[q] = *(const f32x4*)(row + 4 * lane + 256 * q); ss += (v[q][0] * v[q][0] + v[q][1] * v[q][1]) + (v[q][2] * v[q][2] + v[q][3] * v[q][3]); }
        const float rstd = rsqrtf(wave_sum(ss) * (1.f / DM) + RMS_EPS);
#pragma unroll
        for (int q = 0; q < 4; ++q) { const f32x4 w4 = *(const f32x4*)(P.final_norm_w + 4 * lane + 256 * q); *(f32x4*)(row + 4 * lane + 256 * q) = (v[q] * rstd) * w4; }
    }
}

#define XB_TMO      128
#define XB_XCNT(j)  (256  + 64 * (j))
#define XB_XSUB(j)  (1280 + 64 * (j))
#define XB_XGEN(j)  (2304 + 64 * (j))
#define XB_TOP      3328
#define XB_TOPGEN   3392
#define XCD_BAR_WORDS 3456
#define XB_SPIN_CAP (1u << 18)

__device__ __forceinline__ unsigned xb_ld(unsigned* p)              { return __hip_atomic_load(p, __ATOMIC_RELAXED, __HIP_MEMORY_SCOPE_AGENT); }
__device__ __forceinline__ unsigned xb_add(unsigned* p, unsigned v) { return __hip_atomic_fetch_add(p, v, __ATOMIC_RELAXED, __HIP_MEMORY_SCOPE_AGENT); }
__device__ __forceinline__ unsigned xb_xcc_id() { return (unsigned)__builtin_amdgcn_s_getreg((3 << 11) | 20) & 0xFu; }
#define XB_SPIN(cond, bar) do { unsigned _sp = 0; while (cond) { __builtin_amdgcn_s_sleep(1); \
    if ((++_sp & 255u) == 0u) { if (xb_ld(&(bar)[XB_TMO])) break; if (_sp > XB_SPIN_CAP) { atomicAdd(&(bar)[XB_TMO], 1u); break; } } } } while (0)

struct XcdBarrier {
    unsigned* bar; unsigned x;
    volatile LAS unsigned* st;
};

__device__ __forceinline__ XcdBarrier xcd_barrier_post(unsigned* bar, volatile LAS unsigned* st, int wv) {
    XcdBarrier b; b.bar = bar; b.x = xb_xcc_id(); b.st = st;
    if (get_tid(wv) == 0) (void)xb_add(&bar[XB_XCNT(b.x)], 1u);
    return b;
}
__device__ __forceinline__ void xcd_barrier_complete(unsigned* bar, unsigned x, unsigned& nloc, unsigned& nx) {
    const unsigned G = gridDim.x * gridDim.y * gridDim.z;
    unsigned sum, cnt, mine, sp = 0u;
    for (;;) {
        sum = 0u; cnt = 0u; mine = 0u;
#pragma unroll
        for (unsigned j = 0; j < 16; ++j) { const unsigned c = xb_ld(&bar[XB_XCNT(j)]); sum += c; cnt += (c > 0u) ? 1u : 0u; mine = (j == x) ? c : mine; }
        if (sum == G) break;
        __builtin_amdgcn_s_sleep(1);
        if ((++sp & 255u) == 0u) { if (xb_ld(&bar[XB_TMO])) break; if (sp > XB_SPIN_CAP) { atomicAdd(&bar[XB_TMO], 1u); break; } }
    }
    nloc = mine > 0u ? mine : 1u; nx = cnt > 0u ? cnt : 1u;
}

__device__ __forceinline__ void xcd_barrier(const XcdBarrier& b, int wv) {
    asm volatile("s_waitcnt vmcnt(0)" ::: "memory");
    __syncthreads();
    if (get_tid(wv) == 0) {
        unsigned* bar = b.bar;
        __builtin_amdgcn_s_waitcnt(0);
        unsigned nloc = b.st[0], nx = b.st[1];
        if (nloc == 0u) { xcd_barrier_complete(bar, b.x, nloc, nx); b.st[0] = nloc; b.st[1] = nx; }
        const unsigned old = xb_add(&bar[XB_XSUB(b.x)], 1u);
        const unsigned gen = old / nloc;
        if (old + 1u == (gen + 1u) * nloc) {
            __builtin_amdgcn_fence(__ATOMIC_RELEASE, "agent");
            asm volatile("s_waitcnt vmcnt(0)" ::: "memory");
            const unsigned og = xb_add(&bar[XB_TOP], 1u);
            const unsigned tg = og / nx;
            if (og + 1u == (tg + 1u) * nx) xb_add(&bar[XB_TOPGEN], 1u);
            else XB_SPIN(xb_ld(&bar[XB_TOPGEN]) == tg, bar);
            __builtin_amdgcn_fence(__ATOMIC_ACQUIRE, "agent");
            xb_add(&bar[XB_XGEN(b.x)], 1u);
            asm volatile("s_waitcnt vmcnt(0)" ::: "memory");
        } else {
            XB_SPIN(xb_ld(&bar[XB_XGEN(b.x)]) == gen, bar);
            __builtin_amdgcn_fence(__ATOMIC_ACQUIRE, "agent");
            asm volatile("s_waitcnt vmcnt(0)" ::: "memory");
        }
    }
    __syncthreads();
}

constexpr int PARAM_OFF = LDS_BYTES - 256;
static_assert(G2_END <= PARAM_OFF && sizeof(Params) <= 208, "LDS map");
DI const float* ld_uptr(const LAS unsigned long long* s, int i) {
    const unsigned long long v = s[i];
    const unsigned lo = __builtin_amdgcn_readfirstlane((unsigned)v), hi = __builtin_amdgcn_readfirstlane((unsigned)(v >> 32));
    return (const float*)(const __attribute__((address_space(1))) float*)(((unsigned long long)hi << 32) | lo);
}
DI Params load_params(LAS unsigned char* lds) {
    LAS unsigned char* pb = lds + PARAM_OFF; asm volatile("" : "+v"(pb));
    const LAS unsigned long long* s = (const LAS unsigned long long*)pb;
    Params Q;
    Q.x = ld_uptr(s, 0); Q.c = ld_uptr(s, 1); Q.ctx = ld_uptr(s, 2); Q.c_ctx = ld_uptr(s, 3); Q.ada_w = ld_uptr(s, 4); Q.ada_b = ld_uptr(s, 5); Q.norm_w = ld_uptr(s, 6);
    Q.ev_w_in = ld_uptr(s, 7); Q.ev_conv_w = ld_uptr(s, 8); Q.ev_conv_b = ld_uptr(s, 9); Q.ev_rg_wx = ld_uptr(s, 10); Q.ev_rg_bx = ld_uptr(s, 11); Q.ev_rg_wa = ld_uptr(s, 12);
    Q.ev_rg_ba = ld_uptr(s, 13); Q.ev_rg_lambda = ld_uptr(s, 14); Q.ev_sink = ld_uptr(s, 15); Q.ev_w_out = ld_uptr(s, 16); Q.od_w_in = ld_uptr(s, 17); Q.od_lb_raw = ld_uptr(s, 18);
    Q.od_gnorm_w = ld_uptr(s, 19); Q.od_w_out = ld_uptr(s, 20); Q.final_norm_w = ld_uptr(s, 21); Q.out = (float*)ld_uptr(s, 22); Q.ws = (unsigned char*)ld_uptr(s, 23);
    Q.ph_lo = 0; Q.ph_hi = 0;
    return Q;
}
DI void run_phase(LAS unsigned char* lds, int ph, int wv) {
    #ifndef PHMASK
#define PHMASK 0xffff
#endif
    if (ph == 0) { if (PHMASK & 1) { const Params P = load_params(lds); phase_pro(P, lds, wv); } return; }
    if (ph == NPHASE - 1) { if (PHMASK & 2) { const Params P = load_params(lds); phase_final(P, wv); } return; }
    const int layer = (ph - 1) / 5, sub = (ph - 1) % 5, j = layer >> 1;
    const bool even = (layer & 1) == 0;
    if (sub == 0) { if (PHMASK & 4) { const Params P = load_params(lds); phase_norm(P, lds, layer, wv); } return; }
    if (sub == 1) {
        const Params P = load_params(lds); bf16_t* pbuf = (bf16_t*)(P.ws + WS_P);
        const int N = even ? EVEN_IN : ODD_IN;
        pg8::Gemm gm{(const bf16_t*)(P.ws + WS_OV), (const bf16_t*)(P.ws + WS_WIN), MROWS, N, 1024, 1024};
        pg8::StaticOrder S; S.init(MROWS, N, (int)gridDim.x, get_bid());
        EpiStoreBf16 E{pbuf, N};
        if (PHMASK & 8) pg8::gemm_phase<EpiStoreBf16, pg8::StaticOrder, true, true>(lds, gm, S, E, wv);
        return;
    }
    if (sub == 2) {
        const Params P = load_params(lds);
        if (even) {
            constexpr int NRG = NB * NCHUNK * 8;
#if defined(SPLIT_ATTN)
            for (int it = get_bid(); it < NRG; it += gridDim.x) rglru_item(P, lds, j, it, wv);
#else
            for (int it = get_bid(); it < NRG + 576; it += gridDim.x) {
                if (it < NRG) { if (PHMASK & 32) rglru_item(P, lds, j, it, wv); } else { if (PHMASK & 16) attn_item(P, lds, j, it - NRG, wv); }
            }
#endif
        } else {
            for (int it = get_bid(); it < 128; it += gridDim.x) { if (PHMASK & 64) { if (it & 1) gla2_item<1>(P, lds, j, it >> 4, (it >> 1) & 7, wv); else gla2_item<0>(P, lds, j, it >> 4, (it >> 1) & 7, wv); } }
        }
        return;
    }
    if (sub == 3) {
        const Params P = load_params(lds);
        if (!even) { if (PHMASK & 256) phase_readout(P, j, wv); }
#if defined(SPLIT_ATTN)
        else { for (int it = get_bid(); it < 576; it += gridDim.x) attn_item(P, lds, j, it, wv); }
#endif
        return;
    }
    {
        const Params P = load_params(lds); bf16_t* pbuf = (bf16_t*)(P.ws + WS_P);
        const int K = even ? 2048 : 1024, lda = even ? EVEN_IN : ODD_IN;
        pg8::Gemm gm{pbuf + (even ? 1536 : 4096), (const bf16_t*)(P.ws + WS_WOUT), MROWS, 1024, K, lda};
        pg8::StaticOrder S; S.init(NB * SEQ, 1024, (int)gridDim.x, get_bid(), 1);
        const float* hl = layer == 0 ? P.x : P.out; const float* hc = layer == 0 ? P.ctx : (const float*)(P.ws + WS_HCTX);
        EpiResid E{hl, hc, P.out, (float*)(P.ws + WS_HCTX), (const float*)(P.ws + WS_MOD) + (size_t)layer * 9 * 3072 + 2048};
        if (PHMASK & 512) pg8::gemm_phase<EpiResid, pg8::StaticOrder, true, true>(lds, gm, S, E, wv);
        if (layer < 3) {
            for (int t = get_bid(); t < 256; t += gridDim.x) {
                const int mt = t >> 3, nt = t & 7, mc0 = 64 * mt, bctx = mc0 >> 8, n0 = 128 * nt;
                const bf16_t* At = pbuf + ((size_t)bctx * LT + (mc0 & 255)) * lda + (even ? 1536 : 4096);
                const float* gctx = (const float*)(P.ws + WS_MOD) + (size_t)layer * 9 * 3072 + 2048 + 8 * 3072;
                float* hco = (float*)(P.ws + WS_HCTX);
                auto epi = [&](const f32x16& acc, int row0, int col, int hh) {
                    const float gate = gctx[n0 + col];
#pragma unroll
                    for (int i = 0; i < 16; ++i) { const size_t off = (size_t)(mc0 + row0 + crow(i, hh)) * DM + n0 + col; hco[off] = hc[off] + gate * acc[i]; }
                };
                mini_gemm_tile(lds, At, lda, (const bf16_t*)(P.ws + WS_WOUT) + (size_t)n0 * K, K, epi, wv);
            }
        }
    }
}

__global__ void __launch_bounds__(512, 2) mega(Params P) {
    extern __shared__ __attribute__((aligned(16))) unsigned char lds_raw[];
    LAS unsigned char* lds = (LAS unsigned char*)lds_raw;
    cg::grid_group grid = cg::this_grid();
    const int wv = __builtin_amdgcn_readfirstlane((int)(threadIdx.x >> 6));
    if (get_tid(wv) == 0) {
#if defined(TP_ID)
        ((LAS unsigned long long*)(lds + 163840 - 32))[0] = 0ull; ((LAS unsigned long long*)(lds + 163840 - 32))[1] = 0ull;
#endif
        ((LAS unsigned*)(lds + PARAM_OFF + 208))[0] = 0u; ((LAS unsigned*)(lds + PARAM_OFF + 208))[1] = 0u;
        LAS unsigned long long* d = (LAS unsigned long long*)(lds + PARAM_OFF);
        d[0] = (unsigned long long)P.x; d[1] = (unsigned long long)P.c; d[2] = (unsigned long long)P.ctx; d[3] = (unsigned long long)P.c_ctx; d[4] = (unsigned long long)P.ada_w;
        d[5] = (unsigned long long)P.ada_b; d[6] = (unsigned long long)P.norm_w; d[7] = (unsigned long long)P.ev_w_in; d[8] = (unsigned long long)P.ev_conv_w; d[9] = (unsigned long long)P.ev_conv_b;
        d[10] = (unsigned long long)P.ev_rg_wx; d[11] = (unsigned long long)P.ev_rg_bx; d[12] = (unsigned long long)P.ev_rg_wa; d[13] = (unsigned long long)P.ev_rg_ba; d[14] = (unsigned long long)P.ev_rg_lambda;
        d[15] = (unsigned long long)P.ev_sink; d[16] = (unsigned long long)P.ev_w_out; d[17] = (unsigned long long)P.od_w_in; d[18] = (unsigned long long)P.od_lb_raw; d[19] = (unsigned long long)P.od_gnorm_w;
        d[20] = (unsigned long long)P.od_w_out; d[21] = (unsigned long long)P.final_norm_w; d[22] = (unsigned long long)P.out; d[23] = (unsigned long long)P.ws;
    }
    __syncthreads();
    const int ph_lo = P.ph_lo, ph_hi = P.ph_hi;
    (void)xcd_barrier_post((unsigned*)(P.ws + WS_CTL) + 4096, (volatile LAS unsigned*)(lds + PARAM_OFF + 208), wv);
#define GRID_SYNC(first) do { if (first) grid.sync(); else { XcdBarrier xb_; xb_.bar = (unsigned*)(load_params(lds).ws + WS_CTL) + 4096; xb_.x = xb_xcc_id(); xb_.st = (volatile LAS unsigned*)(lds + PARAM_OFF + 208); xcd_barrier(xb_, wv); } } while (0)
#if defined(PROBE_S)
    constexpr int PREP = PROBE_E - PROBE_S + 1;
#pragma unroll 1
    for (int seq = ph_lo; seq < ph_hi + PREP; ++seq) {
        if (seq > ph_lo) GRID_SYNC(seq == ph_lo + 1);
        const int ph = seq <= PROBE_E ? seq : seq - PREP;
        run_phase(lds, ph, wv);
    }
#else
#pragma unroll 1
    for (int ph = ph_lo; ph < ph_hi; ++ph) {
#if !defined(SPLIT_ATTN)
        if (ph >= 1 && ph < NPHASE - 1 && (ph - 1) % 5 == 3 && (((ph - 1) / 5) & 1) == 0) continue;
#endif
        if (ph > ph_lo) GRID_SYNC(ph == ph_lo + 1);
        run_phase(lds, ph, wv);
    }
#endif
#if defined(TP_ID)
    if (get_tid(wv) == 0 && blockIdx.x == TP_BLOCK) {
        const unsigned long long acc = ((LAS unsigned long long*)(lds + 163840 - 32))[1], t0 = __builtin_amdgcn_s_memrealtime();
        while (__builtin_amdgcn_s_memrealtime() - t0 < (unsigned long long)TP_AMP * acc) __builtin_amdgcn_s_sleep(8);
    }
#endif
}

extern "C" void kernel_launch(void* const* d_in, const int* in_sizes, int n_in, void* d_out, int out_size, void* d_ws, size_t ws_size, hipStream_t stream) {
    static int grid = 0;
    if (grid == 0) {
        if (n_in != 22 || ws_size < WS_END) { fprintf(stderr, "kernel_launch: unexpected inputs (n_in %d, ws %zu)\n", n_in, ws_size); grid = -1; return; }
        int dev = 0, cus = 0, per_cu = 0;
        hipGetDevice(&dev);
        hipDeviceGetAttribute(&cus, hipDeviceAttributeMultiprocessorCount, dev);
        if (hipFuncSetAttribute((const void*)mega, hipFuncAttributeMaxDynamicSharedMemorySize, LDS_BYTES) != hipSuccess) { fprintf(stderr, "kernel_launch: hipFuncSetAttribute failed\n"); grid = -1; return; }
        if (hipOccupancyMaxActiveBlocksPerMultiprocessor(&per_cu, (const void*)mega, 512, LDS_BYTES) != hipSuccess || per_cu < 1) { fprintf(stderr, "kernel_launch: occupancy query gives %d\n", per_cu); per_cu = 1; }
        (void)hipGetLastError();
        grid = cus;
    }
    if (grid < 0) return;
    if (hipMemsetAsync((char*)d_ws + WS_CTL, 0, 65536, stream) != hipSuccess) { fprintf(stderr, "kernel_launch: memset failed\n"); return; }
    Params P{};
    const float** pp = (const float**)&P;
    for (int i = 0; i < 22; ++i) pp[i] = (const float*)d_in[i];
    P.out = (float*)d_out; P.ws = (unsigned char*)d_ws;
#if ONE_LAUNCH
    P.ph_lo = 0; P.ph_hi = NPHASE;
    { void* args[] = {&P}; hipError_t e = hipLaunchCooperativeKernel((const void*)mega, dim3(grid), dim3(512), args, LDS_BYTES, stream);
      if (e != hipSuccess) fprintf(stderr, "cooperative launch failed: %s (grid %d)\n", hipGetErrorString(e), grid); }
#else
    for (int ph = 0; ph < NPHASE; ++ph) {
        P.ph_lo = ph; P.ph_hi = ph + 1;
        void* args[] = {&P}; hipError_t e = hipLaunchCooperativeKernel((const void*)mega, dim3(grid), dim3(512), args, LDS_BYTES, stream);
        if (e != hipSuccess) { fprintf(stderr, "launch %d failed: %s (grid %d)\n", ph, hipGetErrorString(e), grid); break; }
    }
#endif
}
```

```cpp
#include <hip/hip_runtime.h>
#include <hip/hip_cooperative_groups.h>
#include <cstdio>
#include <cstdint>
namespace cg = cooperative_groups;

#ifndef ONE_LAUNCH
#define ONE_LAUNCH 1
#endif

#define DI __device__ __forceinline__
#define LAS __attribute__((address_space(3)))
__device__ __forceinline__ int lane_nh() { int l; asm volatile("v_mbcnt_lo_u32_b32 %0, -1, 0\n\tv_mbcnt_hi_u32_b32 %0, -1, %0" : "=v"(l)); return l; }
__device__ __forceinline__ int get_tid(int wv) { asm volatile("" : "+s"(wv)); return wv * 64 + lane_nh(); }
__device__ __forceinline__ float shfl_xor_f(float v, int o) { return __int_as_float(__builtin_amdgcn_ds_bpermute((lane_nh() ^ o) << 2, __float_as_int(v))); }
__device__ __forceinline__ int get_bid() { int b = blockIdx.x; asm volatile("" : "+s"(b)); return b; }

#if defined(TP_ID)
#ifndef TP_BLOCK
#define TP_BLOCK 5
#endif
#ifndef TP_AMP
#define TP_AMP 16
#endif
#define TP_START(id, lds, tid_) do { if ((id) == TP_ID && (tid_) == 0 && blockIdx.x == TP_BLOCK) { ((LAS unsigned long long*)((lds) + 163840 - 32))[0] = __builtin_amdgcn_s_memrealtime(); } } while (0)
#define TP_STOP(id, lds, tid_) do { if ((id) == TP_ID && (tid_) == 0 && blockIdx.x == TP_BLOCK) { LAS unsigned long long* w_ = (LAS unsigned long long*)((lds) + 163840 - 32); w_[1] += __builtin_amdgcn_s_memrealtime() - w_[0]; } } while (0)
#else
#define TP_START(id, lds, tid_) do { } while (0)
#define TP_STOP(id, lds, tid_) do { } while (0)
#endif
namespace pg8 {
#define PG8_LAS __attribute__((address_space(3)))
typedef unsigned short bf16_t;
typedef short bf16x8 __attribute__((ext_vector_type(8)));
typedef float f32x4 __attribute__((ext_vector_type(4)));
typedef unsigned u32x4 __attribute__((ext_vector_type(4)));
constexpr int BM = 256, BK = 64, HALF = 128, HTB = HALF * BK * 2  , STAGE_BYTES = 8 * HTB, NXCD = 8, WGM = 8;

__host__ __device__ __forceinline__ int lds_byte(int r, int c) { const int st = (r >> 4) * 2 + (c >> 5), rr = r & 15, cc = c & 31, ob = rr * 64 + cc * 2; return st * 1024 + (ob ^ (((ob >> 9) & 1) << 5)); }
__host__ __device__ __forceinline__ void stage_rc(int b, int& R, int& C) { const int st = b / 1024, sb = b % 1024, swz = sb ^ (((sb >> 9) & 1) << 5); R = (st >> 1) * 16 + swz / 64; C = (st & 1) * 32 + (swz % 64) / 2; }
__host__ __device__ __forceinline__ int perm32(int rho) { const int n = rho >> 4, i = rho & 15; return 8 * (i >> 2) + 4 * n + (i & 3); }

struct Unit { int pm, pn; };
struct Gemm { const bf16_t* A; const bf16_t* Bt; int M, N, K, lda; };

struct StaticOrder {
    int nM, nN, nwg, G, c, lat_only, limit;
    __host__ __device__ void init(int M, int N, int G_, int c_, int lat_only_ = 0) { nM = M / BM; nN = N / BM; nwg = nM * nN; G = G_; c = c_; lat_only = lat_only_; limit = nwg; }
    __host__ __device__ bool next(int i, Unit& u) const {
        const long L = (long)i * G + c; if (L >= limit) return false;
        tile_of((int)L, u); return true;
    }
    __host__ __device__ void tile_of(int L, Unit& u) const {
        int wgid = L; { const int q = nwg / NXCD, r = nwg % NXCD, xcd = wgid % NXCD, off = wgid / NXCD; wgid = (xcd < r ? xcd * (q + 1) : r * (q + 1) + (xcd - r) * q) + off; }
        const int nig = WGM * nN, gid = wgid / nig, fm = gid * WGM, gsz = (nM - fm) < WGM ? (nM - fm) : WGM;
        u.pm = fm + ((wgid % nig) % gsz); u.pn = (wgid % nig) / gsz; if (lat_only) u.pm = 9 * (u.pm >> 3) + 1 + (u.pm & 7);
    }
    __device__ __forceinline__ void a_ready(const Unit&) const {}
    __device__ __forceinline__ void done(const Unit&) const {}
};

template <class Epi, class Sched, bool ALIGN_EPI = false, bool SP2 = false>
__device__ __forceinline__ void gemm_phase(PG8_LAS unsigned char* lds, const Gemm g, const Sched& S, const Epi& E, int wv) {
    const int tid = get_tid(wv), wid = __builtin_amdgcn_readfirstlane(tid >> 6), lane = tid & 63, wr = wid >> 2, wc = wid & 3, fr = lane & 15, fq = lane >> 4;
    const int K = g.K, nt = K / BK;
    unsigned voffA[2], voffB[2];
#pragma unroll
    for (int i = 0; i < 2; ++i) { int R, C; stage_rc(tid * 16 + i * 8192, R, C); const int Rb = Epi::PERM ? ((R & ~31) + perm32(R & 31)) : R;
        voffA[i] = (unsigned)(R * g.lda + C) * 2u; voffB[i] = (unsigned)(Rb * K + C) * 2u; }
    const size_t kstep = (size_t)(BK * 2);
    const size_t hstepA = (size_t)HALF * g.lda * 2, hstepB = (size_t)HALF * K * 2;
    const size_t tstepA = 2 * hstepA, tstepB = 2 * hstepB;
    const unsigned ldsw = (unsigned)wid * 1024u;
    const int aoff = lds_byte(wr * 64 + fr, fq * 8), boff = lds_byte(wc * 32 + fr, fq * 8);
#define PG8_SA(b, h) (((b) * 2 + (h)) * HTB)
#define PG8_SB(b, h) ((4 + (b) * 2 + (h)) * HTB)
#define PG8_STAGE(bufoff, gbase, voff) do { _Pragma("unroll") for (int _i = 0; _i < 2; ++_i) \
        __builtin_amdgcn_global_load_lds((const unsigned*)((const char*)(gbase) + (voff)[_i]), (PG8_LAS unsigned*)(lds + (bufoff) + ldsw + _i * 8192), 16, 0, 0); } while (0)
#define PG8_LDA(dst, b, h) do { _Pragma("unroll") for (int m = 0; m < 4; ++m) _Pragma("unroll") for (int k = 0; k < 2; ++k) dst[m][k] = *(const PG8_LAS bf16x8*)(lds + PG8_SA(b, h) + aoff + m * 2048 + k * 1024); } while (0)
#define PG8_LDB(dst, b, h) do { _Pragma("unroll") for (int n = 0; n < 2; ++n) _Pragma("unroll") for (int k = 0; k < 2; ++k) dst[n][k] = *(const PG8_LAS bf16x8*)(lds + PG8_SB(b, h) + boff + n * 2048 + k * 1024); } while (0)
#define PG8_MMA(ai, bj, At, Bt) do { __builtin_amdgcn_s_setprio(1); _Pragma("unroll") for (int m = 0; m < 4; ++m) _Pragma("unroll") for (int n = 0; n < 2; ++n) _Pragma("unroll") for (int k = 0; k < 2; ++k) \
        acc[ai][bj][m][n] = __builtin_amdgcn_mfma_f32_16x16x32_bf16(Bt[n][k], At[m][k], acc[ai][bj][m][n], 0, 0, 0); __builtin_amdgcn_s_setprio(0); } while (0)
#define PG8_WAIT_V(n) asm volatile("s_waitcnt vmcnt(" #n ")" ::: "memory")
#define PG8_WAIT_L(n) asm volatile("s_waitcnt lgkmcnt(" #n ")" ::: "memory")
#define PG8_BAR __builtin_amdgcn_s_barrier()
#define PG8_SCHED __builtin_amdgcn_sched_barrier(0)
    Unit cur, nxt; int ui = 0;
    if (!S.next(0, cur)) return;
    f32x4 acc[2][2][4][2];
#pragma unroll
    for (int a = 0; a < 2; ++a)
#pragma unroll
        for (int b = 0; b < 2; ++b)
#pragma unroll
            for (int m = 0; m < 4; ++m)
#pragma unroll
                for (int n = 0; n < 2; ++n) acc[a][b][m][n] = (f32x4){0.f, 0.f, 0.f, 0.f};
    bf16x8 At[4][2], B0[2][2], B1[2][2];
    const char* cA = (const char*)g.A + (size_t)cur.pm * tstepA; const char* cB = (const char*)g.Bt + (size_t)cur.pn * tstepB;
    S.a_ready(cur);
    if constexpr (SP2) {
        PG8_STAGE(PG8_SB(0, 0), cB, voffB); PG8_STAGE(PG8_SB(0, 1), cB + hstepB, voffB); PG8_STAGE(PG8_SA(0, 0), cA, voffA); PG8_STAGE(PG8_SA(0, 1), cA + hstepA, voffA);
        if (wr == 1) PG8_BAR;
        PG8_WAIT_V(2); PG8_BAR;
        PG8_STAGE(PG8_SB(1, 0), cB + kstep, voffB); PG8_STAGE(PG8_SA(1, 0), cA + kstep, voffA); PG8_STAGE(PG8_SB(1, 1), cB + hstepB + kstep, voffB);
        PG8_WAIT_V(6); PG8_BAR;
    } else {
        PG8_STAGE(PG8_SB(0, 0), cB, voffB); PG8_STAGE(PG8_SA(0, 0), cA, voffA); PG8_STAGE(PG8_SB(0, 1), cB + hstepB, voffB); PG8_STAGE(PG8_SA(0, 1), cA + hstepA, voffA);
        if (wr == 1) PG8_BAR;
        PG8_WAIT_V(4); PG8_BAR;
        PG8_STAGE(PG8_SB(1, 0), cB + kstep, voffB); PG8_STAGE(PG8_SA(1, 0), cA + kstep, voffA); PG8_STAGE(PG8_SB(1, 1), cB + hstepB + kstep, voffB);
        PG8_WAIT_V(6); PG8_BAR;
    }
    for (;;) {
        const bool has_next = S.next(ui + 1, nxt);
        const char* nA = has_next ? (const char*)g.A + (size_t)nxt.pm * tstepA : cA; const char* nB = has_next ? (const char*)g.Bt + (size_t)nxt.pn * tstepB : cB;
        for (int t = 0; t < nt; t += 2) {
            const bool last = (t == nt - 2);
            const char* a1 = cA + (size_t)(t + 1) * kstep;
            const char* a2 = last ? nA : cA + (size_t)(t + 2) * kstep; const char* b2 = last ? nB : cB + (size_t)(t + 2) * kstep;
            const char* a3 = a2 + kstep; const char* b3 = b2 + kstep;
            if (last && has_next) S.a_ready(nxt);
            if constexpr (SP2) {
            PG8_LDB(B0, 0, 0); PG8_LDB(B1, 0, 1); PG8_SCHED; PG8_LDA(At, 0, 0); PG8_STAGE(PG8_SA(1, 1), a1 + hstepA, voffA);
            PG8_WAIT_V(8); PG8_WAIT_L(0); PG8_BAR; PG8_MMA(0, 0, At, B0); PG8_MMA(0, 1, At, B1); PG8_BAR; PG8_SCHED;
            PG8_LDA(At, 0, 1); PG8_STAGE(PG8_SB(0, 0), b2, voffB); PG8_STAGE(PG8_SB(0, 1), b2 + hstepB, voffB); PG8_STAGE(PG8_SA(0, 0), a2, voffA);
            PG8_WAIT_V(8); PG8_WAIT_L(0); PG8_BAR; PG8_MMA(1, 0, At, B0); PG8_MMA(1, 1, At, B1); PG8_BAR; PG8_SCHED;
            PG8_LDB(B0, 1, 0); PG8_LDB(B1, 1, 1); PG8_SCHED; PG8_LDA(At, 1, 0); PG8_STAGE(PG8_SA(0, 1), a2 + hstepA, voffA);
            PG8_WAIT_V(8); PG8_WAIT_L(0); PG8_BAR; PG8_MMA(0, 0, At, B0); PG8_MMA(0, 1, At, B1); PG8_BAR; PG8_SCHED;
            PG8_LDA(At, 1, 1); PG8_STAGE(PG8_SB(1, 0), b3, voffB); PG8_STAGE(PG8_SB(1, 1), b3 + hstepB, voffB); PG8_STAGE(PG8_SA(1, 0), a3, voffA);
            PG8_WAIT_V(8); PG8_WAIT_L(0); PG8_BAR; PG8_MMA(1, 0, At, B0); PG8_MMA(1, 1, At, B1); PG8_BAR; PG8_SCHED;
            } else {
            PG8_LDB(B0, 0, 0); PG8_SCHED; PG8_LDA(At, 0, 0); PG8_STAGE(PG8_SA(1, 1), a1 + hstepA, voffA);
            PG8_WAIT_L(8); PG8_BAR; PG8_WAIT_L(0); PG8_MMA(0, 0, At, B0); PG8_BAR; PG8_SCHED;
            PG8_LDB(B1, 0, 1); PG8_STAGE(PG8_SB(0, 0), b2, voffB);
            PG8_BAR; PG8_WAIT_L(0); PG8_MMA(0, 1, At, B1); PG8_BAR;
            PG8_LDA(At, 0, 1); PG8_STAGE(PG8_SA(0, 0), a2, voffA);
            PG8_BAR; PG8_WAIT_L(0); PG8_MMA(1, 0, At, B0); PG8_BAR; PG8_SCHED;
            PG8_STAGE(PG8_SB(0, 1), b2 + hstepB, voffB);
            PG8_WAIT_V(6); PG8_BAR; PG8_MMA(1, 1, At, B1); PG8_BAR;
            PG8_LDB(B0, 1, 0); PG8_SCHED; PG8_LDA(At, 1, 0); PG8_STAGE(PG8_SA(0, 1), a2 + hstepA, voffA);
            PG8_WAIT_L(8); PG8_BAR; PG8_WAIT_L(0); PG8_MMA(0, 0, At, B0); PG8_BAR; PG8_SCHED;
            PG8_LDB(B1, 1, 1); PG8_STAGE(PG8_SB(1, 0), b3, voffB);
            PG8_BAR; PG8_WAIT_L(0); PG8_MMA(0, 1, At, B1); PG8_BAR;
            PG8_LDA(At, 1, 1); PG8_STAGE(PG8_SA(1, 0), a3, voffA);
            PG8_BAR; PG8_WAIT_L(0); PG8_MMA(1, 0, At, B0); PG8_BAR; PG8_SCHED;
            PG8_STAGE(PG8_SB(1, 1), b3 + hstepB, voffB);
            PG8_WAIT_V(6); PG8_BAR; PG8_MMA(1, 1, At, B1); PG8_BAR;
            }
        }
        if constexpr (ALIGN_EPI) { if (wr == 0) PG8_BAR; }
        if constexpr (!Epi::AFTER_DRAIN) { E(acc, cur, wr, wc, fr, fq); S.done(cur); }
        if (!has_next) break;
#pragma unroll
        for (int a = 0; a < 2; ++a)
#pragma unroll
            for (int b = 0; b < 2; ++b)
#pragma unroll
                for (int m = 0; m < 4; ++m)
#pragma unroll
                    for (int n = 0; n < 2; ++n) acc[a][b][m][n] = (f32x4){0.f, 0.f, 0.f, 0.f};
        cur = nxt; cA = nA; cB = nB; ++ui;
        if constexpr (ALIGN_EPI) { if (wr == 1) PG8_BAR; }
    }
    PG8_WAIT_V(0);
    if constexpr (!ALIGN_EPI) { if (wr == 0) PG8_BAR; }
    PG8_BAR;
    if constexpr (Epi::AFTER_DRAIN) { E.fused(acc, cur, wr, wc, fr, fq, lds, wid, lane); S.done(cur); }
#undef PG8_SA
#undef PG8_SB
#undef PG8_STAGE
#undef PG8_LDA
#undef PG8_LDB
#undef PG8_MMA
#undef PG8_WAIT_V
#undef PG8_WAIT_L
#undef PG8_BAR
#undef PG8_SCHED
}
}

typedef unsigned short bf16_t;
typedef short bf16x8 __attribute__((ext_vector_type(8)));
typedef short s16x4 __attribute__((ext_vector_type(4)));
typedef float f32x4 __attribute__((ext_vector_type(4)));
typedef float f32x16 __attribute__((ext_vector_type(16)));
typedef unsigned u32x4 __attribute__((ext_vector_type(4)));
typedef unsigned u32x2 __attribute__((ext_vector_type(2)));
typedef float f32x2 __attribute__((ext_vector_type(2)));

constexpr int DM = 1024, NB = 8, SEQ = 2048, CTXL = 256, LT = SEQ + CTXL  , MROWS = NB * LT  ;
constexpr int EVEN_IN = 4608, ODD_IN = 5120, NCHUNK = LT / 64  ;
constexpr float RMS_EPS = 1e-6f, LOG2E = 1.4426950408889634f;
constexpr int LDS_BYTES = 160 * 1024;
constexpr int NPHASE = 22;

constexpr size_t WS_CTL = 0;
constexpr size_t WS_MOD = 65536;
constexpr size_t WS_ROPE = 524288;
constexpr size_t WS_AGG = 1048576;
constexpr size_t WS_HCTX = WS_AGG + 4718592;
constexpr size_t WS_WIN = WS_HCTX + 8388608;
constexpr size_t WS_WOUT = WS_WIN + 10485760;
constexpr size_t WS_WRG = WS_WOUT + 4194304;
constexpr size_t WS_OV = WS_WRG + 1048576;
constexpr size_t WS_P = WS_OV + 37748736;
constexpr size_t WS_END = WS_P + 188743680;
static_assert(WS_END <= 268435456, "workspace map exceeds 256 MiB");

struct Params {
    const float *x, *c, *ctx, *c_ctx, *ada_w, *ada_b, *norm_w, *ev_w_in, *ev_conv_w, *ev_conv_b, *ev_rg_wx, *ev_rg_bx, *ev_rg_wa, *ev_rg_ba,
        *ev_rg_lambda, *ev_sink, *ev_w_out, *od_w_in, *od_lb_raw, *od_gnorm_w, *od_w_out, *final_norm_w;
    float* out; unsigned char* ws; int ph_lo, ph_hi;
};

DI float bf2f(unsigned short v) { return __uint_as_float((unsigned)v << 16); }
DI unsigned f2bf(float f) { unsigned u = __float_as_uint(f); return (u + 0x7fffu + ((u >> 16) & 1u)) >> 16; }
typedef __bf16 bf16x2_hw __attribute__((ext_vector_type(2)));
DI unsigned pk2(float lo, float hi) { const f32x2 v = {lo, hi}; return __builtin_bit_cast(unsigned, __builtin_convertvector(v, bf16x2_hw)); }
DI float sigm(float x) { return __builtin_amdgcn_rcpf(1.f + __expf(-x)); }
DI float softplus_neg(float lam) {
    const float e = __expf(-lam);
    return e < 0.06f ? e * (1.f + e * (-0.5f + e * (0.33333333f + e * (-0.25f + e * 0.2f)))) : __logf(1.f + e);
}
DI float neg_expm1(float x) {
    return x > -0.25f ? -x * (1.f + x * (0.5f + x * (0.16666667f + x * (0.041666668f + x * (0.0083333338f + x * 0.0013888889f))))) : 1.f - __expf(x);
}
DI float wave_sum(float v) {
#pragma unroll
    for (int o = 1; o < 64; o <<= 1) v += shfl_xor_f(v, o);
    return v;
}
DI int crow(int reg, int h) { return (reg & 3) + 8 * (reg >> 2) + 4 * h; }
#define MFMA16(a, b, c) __builtin_amdgcn_mfma_f32_16x16x32_bf16((a), (b), (c), 0, 0, 0)
#define MFMA32(a, b, c) __builtin_amdgcn_mfma_f32_32x32x16_bf16((a), (b), (c), 0, 0, 0)

struct EpiStoreBf16 {
    static constexpr bool PERM = true, AFTER_DRAIN = false;
    bf16_t* O; int ldc;
    DI void operator()(const f32x4 (&acc)[2][2][4][2], const pg8::Unit& u, int wr, int wc, int fr, int fq) const {
        const int row0 = u.pm * 256 + wr * 64 + fr, col0 = u.pn * 256 + wc * 32 + 8 * fq;
#pragma unroll
        for (int ai = 0; ai < 2; ++ai)
#pragma unroll
            for (int m = 0; m < 4; ++m) { bf16_t* rowp = O + (size_t)(row0 + ai * 128 + m * 16) * ldc + col0;
#pragma unroll
                for (int bj = 0; bj < 2; ++bj) { const f32x4 v0 = acc[ai][bj][m][0], v1 = acc[ai][bj][m][1];
                    u32x4 w; w.x = pk2(v0[0], v0[1]); w.y = pk2(v0[2], v0[3]); w.z = pk2(v1[0], v1[1]); w.w = pk2(v1[2], v1[3]);
                    *(u32x4*)(rowp + bj * 128) = w; } }
    }
};
struct EpiResid {
    static constexpr bool PERM = false, AFTER_DRAIN = false;
    const float* in_lat; const float* in_ctx; float* out_lat; float* out_ctx; const float* gate;
    DI void operator()(const f32x4 (&acc)[2][2][4][2], const pg8::Unit& u, int wr, int wc, int fr, int fq) const {
        const int b = u.pm / 9, jt = u.pm % 9;
        const float* ib; float* ob; const float* g;
        if (jt == 0) { const size_t off = (size_t)b * CTXL * DM; ib = in_ctx + off; ob = out_ctx + off; g = gate + 8 * 3072; }
        else { const size_t off = ((size_t)b * SEQ + (size_t)(jt - 1) * 256) * DM; ib = in_lat + off; ob = out_lat + off; g = gate + b * 3072; }
        const int col0 = u.pn * 256 + wc * 32 + 4 * fq;
#pragma unroll
        for (int bj = 0; bj < 2; ++bj)
#pragma unroll
            for (int n = 0; n < 2; ++n) {
                const f32x4 gvv = *(const f32x4*)(g + col0 + bj * 128 + n * 16);
#pragma unroll
                for (int ai = 0; ai < 2; ++ai) {
#pragma unroll
                    for (int m = 0; m < 4; ++m) { const int r = ai * 128 + wr * 64 + m * 16 + fr;
                        const size_t off = (size_t)r * DM + col0 + bj * 128 + n * 16;
                        const f32x4 o = *(const f32x4*)(ib + off) + gvv * acc[ai][bj][m][n]; *(f32x4*)(ob + off) = o; }
                    asm volatile("" ::: "memory");
                }
            }
    }
};

constexpr int MG_STAGE = 27648;
template <class EpiF>
DI void mini_gemm_tile(LAS unsigned char* lds, const bf16_t* A, int lda, const bf16_t* Bt, int K, const EpiF& epi, int wv) {
    const int tid = get_tid(wv), lane = tid & 63, wave = tid >> 6, r = lane & 31, h = lane >> 5, wm = wave >> 2, wn = wave & 3;
    const int lrow = tid >> 3, lch = tid & 7, nS = K / 64;
    const bf16_t* ap = A + (size_t)lrow * lda + 8 * lch;
    const bf16_t* bp0 = Bt + (size_t)lrow * K + 8 * lch; const bf16_t* bp1 = Bt + (size_t)(64 + lrow) * K + 8 * lch;
    u32x4 s0[3], s1[3];
    f32x16 acc;
#pragma unroll
    for (int i = 0; i < 16; ++i) acc[i] = 0.f;
#define MG_LOAD(set, s) do { (set)[0] = *(const u32x4*)(ap + (s) * 64); (set)[1] = *(const u32x4*)(bp0 + (s) * 64); (set)[2] = *(const u32x4*)(bp1 + (s) * 64); } while (0)
#define MG_STORE(set, buf) do { LAS unsigned char* b_ = lds + (buf) * MG_STAGE; *(LAS u32x4*)(b_ + lrow * 144 + lch * 16) = (set)[0]; \
        *(LAS u32x4*)(b_ + 9216 + lrow * 144 + lch * 16) = (set)[1]; *(LAS u32x4*)(b_ + 9216 + (64 + lrow) * 144 + lch * 16) = (set)[2]; } while (0)
#define MG_COMPUTE(buf) do { const LAS unsigned char* b_ = lds + (buf) * MG_STAGE; \
        _Pragma("unroll") for (int ks = 0; ks < 4; ++ks) { \
            const bf16x8 af = *(const LAS bf16x8*)(b_ + (32 * wm + r) * 144 + (16 * ks + 8 * h) * 2); \
            const bf16x8 bf = *(const LAS bf16x8*)(b_ + 9216 + (32 * wn + r) * 144 + (16 * ks + 8 * h) * 2); \
            acc = MFMA32(af, bf, acc); } } while (0)
    MG_LOAD(s0, 0); MG_LOAD(s1, 1);
    MG_STORE(s0, 0);
    if (nS > 2) MG_LOAD(s0, 2);
#pragma unroll 1
    for (int s = 0; s < nS; s += 2) {
        __syncthreads();
        if (s + 1 < nS) { MG_STORE(s1, 1); if (s + 3 < nS) MG_LOAD(s1, s + 3); }
        MG_COMPUTE(0);
        __syncthreads();
        if (s + 2 < nS) { MG_STORE(s0, 0); if (s + 4 < nS) MG_LOAD(s0, s + 4); }
        if (s + 1 < nS) MG_COMPUTE(1);
    }
#undef MG_LOAD
#undef MG_STORE
#undef MG_COMPUTE
    epi(acc, 32 * wm, 32 * wn + r, h);
    __syncthreads();
}

DI void phase_pro(const Params& P, LAS unsigned char* lds, int wv) {
    const int tid = get_tid(wv);
    LAS float* s = (LAS float*)lds;
    LAS float* red = (LAS float*)(lds + 36864);
    float* mod = (float*)(P.ws + WS_MOD);
    for (int i = tid; i < 9 * 1024; i += 512) { const int r = i >> 10, k = i & 1023; const float v = r < 8 ? P.c[r * 1024 + k] : P.c_ctx[k]; s[i] = v * sigm(v); }
    __syncthreads();
    for (int item = get_bid(); item < 384; item += gridDim.x) {
        const int l = item / 96, n0 = (item % 96) * 32, ks = tid >> 5, col = tid & 31;
        const float* w = P.ada_w + (size_t)l * 1024 * 3072 + n0 + col;
        float acc[9];
#pragma unroll
        for (int r = 0; r < 9; ++r) acc[r] = 0.f;
#pragma unroll 8
        for (int kk = 0; kk < 64; ++kk) { const int k = ks * 64 + kk; const float wv = w[(size_t)k * 3072];
#pragma unroll
            for (int r = 0; r < 9; ++r) acc[r] += s[r * 1024 + k] * wv; }
#pragma unroll
        for (int r = 0; r < 9; ++r) red[(ks * 9 + r) * 32 + col] = acc[r];
        __syncthreads();
        if (tid < 288) { const int r = tid >> 5, cc = tid & 31; float sum = 0.f;
#pragma unroll
            for (int k2 = 0; k2 < 16; ++k2) sum += red[(k2 * 9 + r) * 32 + cc];
            mod[(l * 9 + r) * 3072 + n0 + cc] = sum + P.ada_b[l * 3072 + n0 + cc]; }
        __syncthreads();
    }
    float* cos_t = (float*)(P.ws + WS_ROPE); float* sin_t = cos_t + SEQ * 32;
    for (int i = get_bid() * 512 + tid; i < SEQ * 32; i += gridDim.x * 512) {
        const int pos = i >> 5, jj = i & 31, fi = jj & 15;
        const float inv = __builtin_amdgcn_exp2f(-(float)(2 * fi) * (13.287712379549449f / 32.f));
        const float ang = (float)(jj < 16 ? (pos >> 6) : (pos & 63)) * inv;
        cos_t[i] = __cosf(ang); sin_t[i] = __sinf(ang);
    }
}

template <bool FRAG = false>
DI void transpose_item(const float* W, int K, int N, bf16_t* WT, LAS float* scr, int item, int lane) {
    const int nblk = N / 32, kb = item / nblk, nb = item % nblk, k0 = 64 * kb, n0 = 32 * nb;
#pragma unroll 8
    for (int i = 0; i < 32; ++i) { const int kk = 2 * i + (lane >> 5); scr[kk * 33 + (lane & 31)] = W[(size_t)(k0 + kk) * N + n0 + (lane & 31)]; }
    asm volatile("s_waitcnt lgkmcnt(0)" ::: "memory");
    const int c = lane & 7;
#pragma unroll
    for (int j = 0; j < 4; ++j) { const int n = (lane >> 3) + 8 * j; const LAS float* sp = scr + (8 * c) * 33 + n;
        u32x4 o; o.x = pk2(sp[0 * 33], sp[1 * 33]); o.y = pk2(sp[2 * 33], sp[3 * 33]); o.z = pk2(sp[4 * 33], sp[5 * 33]); o.w = pk2(sp[6 * 33], sp[7 * 33]);
        if (FRAG) {
            const int nn = n0 + n, k8 = (k0 >> 3) + c;
            *(u32x4*)(WT + ((((nn >> 4) * 4 + (k8 >> 2)) * 64 + (k8 & 3) * 16 + (nn & 15)) * 8)) = o;
        } else *(u32x4*)(WT + (size_t)(n0 + n) * K + k0 + 8 * c) = o; }
    asm volatile("s_waitcnt lgkmcnt(0)" ::: "memory");
}

DI void phase_norm(const Params& P, LAS unsigned char* lds, int layer, int wv) {
    const int tid = get_tid(wv), lane = tid & 63, wave = tid >> 6;
    const int gw = get_bid() * 8 + wave, NGW = gridDim.x * 8;
    const int j = layer >> 1;
    LAS float* scr = (LAS float*)(lds + wave * 16384);
    bf16_t* WIN = (bf16_t*)(P.ws + WS_WIN); bf16_t* WOUT = (bf16_t*)(P.ws + WS_WOUT); bf16_t* WRG = (bf16_t*)(P.ws + WS_WRG);
    if ((layer & 1) == 0) {
        constexpr int I_IN = 16 * (EVEN_IN / 32), I_OUT = 32 * 32, I_RG = 32 * 8;
        for (int it = gw; it < I_IN + I_OUT + I_RG; it += NGW) {
            int r = it;
            if (r < I_IN) { transpose_item(P.ev_w_in + (size_t)j * 1024 * EVEN_IN, 1024, EVEN_IN, WIN, scr, r, lane); continue; } r -= I_IN;
            if (r < I_OUT) { transpose_item(P.ev_w_out + (size_t)j * 2048 * 1024, 2048, 1024, WOUT, scr, r, lane); continue; } r -= I_OUT;
            const int mat = r >> 3, sub = r & 7;
            const int dir = mat >> 4, gate = (mat >> 3) & 1, hd = mat & 7;
            const float* src = (gate == 0 ? P.ev_rg_wx : P.ev_rg_wa) + ((size_t)((j * 2 + dir) * 8 + hd)) * 16384;
            transpose_item<true>(src, 128, 128, WRG + (size_t)mat * 16384, scr, sub, lane);
        }
    } else {
        constexpr int I_IN = 16 * (ODD_IN / 32), I_OUT = 16 * 32;
        for (int it = gw; it < I_IN + I_OUT; it += NGW) {
            int r = it;
            if (r < I_IN) { transpose_item(P.od_w_in + (size_t)j * 1024 * ODD_IN, 1024, ODD_IN, WIN, scr, r, lane); continue; } r -= I_IN;
            transpose_item(P.od_w_out + (size_t)j * 1024 * 1024, 1024, 1024, WOUT, scr, r, lane);
        }
    }
    const float* hl = layer == 0 ? P.x : P.out; const float* hc = layer == 0 ? P.ctx : (const float*)(P.ws + WS_HCTX);
    const float* mod = (const float*)(P.ws + WS_MOD) + (size_t)layer * 9 * 3072;
    const float* nw = P.norm_w + layer * 1024;
    bf16_t* U = (bf16_t*)(P.ws + WS_OV);
    f32x4 w4[4], s4[4], h4[4];
#pragma unroll
    for (int q = 0; q < 4; ++q) w4[q] = *(const f32x4*)(nw + 4 * lane + 256 * q);
    int cur_m = -1;
    const int rpw = (MROWS + NGW - 1) / NGW;
    for (int R = gw * rpw; R < gw * rpw + rpw && R < MROWS; ++R) {
        const int b = R / LT, jr = R % LT;
        const float* src = jr < CTXL ? hc + ((size_t)b * CTXL + jr) * DM : hl + ((size_t)b * SEQ + (jr - CTXL)) * DM;
        const int mrow = jr < CTXL ? 8 : b;
        if (mrow != cur_m) {
            cur_m = mrow;
            const float* sh = mod + mrow * 3072; const float* sc = sh + 1024;
#pragma unroll
            for (int q = 0; q < 4; ++q) { s4[q] = *(const f32x4*)(sc + 4 * lane + 256 * q) + 1.f; h4[q] = *(const f32x4*)(sh + 4 * lane + 256 * q); }
        }
        f32x4 v[4]; float ss = 0.f;
#pragma unroll
        for (int q = 0; q < 4; ++q) { v[q] = *(const f32x4*)(src + 4 * lane + 256 * q); ss += (v[q][0] * v[q][0] + v[q][1] * v[q][1]) + (v[q][2] * v[q][2] + v[q][3] * v[q][3]); }
        const float rstd = rsqrtf(wave_sum(ss) * (1.f / DM) + RMS_EPS);
#pragma unroll
        for (int q = 0; q < 4; ++q) { const int k = 4 * lane + 256 * q;
            const f32x4 y = (v[q] * rstd) * w4[q]; const f32x4 o = y * s4[q] + h4[q];
            u32x2 w; w.x = pk2(o[0], o[1]); w.y = pk2(o[2], o[3]); *(u32x2*)(U + (size_t)R * DM + k) = w; }
    }
}

typedef _Float16 f16x2_t __attribute__((ext_vector_type(2)));
DI unsigned pkh2(float a, float b) { const f16x2_t v = {(_Float16)a, (_Float16)b}; return __builtin_bit_cast(unsigned, v); }
DI void unpkh2(unsigned u, float& a, float& b) { const f16x2_t v = __builtin_bit_cast(f16x2_t, u); a = (float)v[0]; b = (float)v[1]; }
constexpr int RG_UT = 0, RG_AL = 17408, RG_BL = 50176, RG_HP = 82944, RG_QA = 148480, RG_CAR = 152576, RG_FLAG = 153600, RG_END = 153664;
static_assert(RG_END <= LDS_BYTES - 256, "RG-LRU LDS map");
constexpr int CW_RG = 8192;
DI void rglru_item(const Params& P, LAS unsigned char* lds, int j, int item, int wv) {
    const int tid = get_tid(wv), lane = tid & 63, wave = tid >> 6, r = lane & 15, g = lane >> 4;
    const int grp = item / NCHUNK, ci = item % NCHUNK, b = grp >> 3, hd = grp & 7;
    bf16_t* p = (bf16_t*)(P.ws + WS_P);
    const bf16_t* WRG = (const bf16_t*)(P.ws + WS_WRG);
    unsigned long long* AGG = (unsigned long long*)(P.ws + WS_AGG);
    unsigned* cnt = (unsigned*)(P.ws + WS_CTL) + CW_RG + (j * 64 + grp) * 16;
    const int R0 = b * LT + ci * 64;
    const int seg_lo = b * LT + (ci < 4 ? 0 : CTXL), seg_hi = b * LT + (ci < 4 ? CTXL : LT);
    LAS bf16_t* UT = (LAS bf16_t*)(lds + RG_UT);
    LAS float* AL = (LAS float*)(lds + RG_AL);
    LAS float* BL = (LAS float*)(lds + RG_BL);
    LAS unsigned* HP = (LAS unsigned*)(lds + RG_HP);
    LAS float* QA = (LAS float*)(lds + RG_QA);
    LAS float* CAR = (LAS float*)(lds + RG_CAR);
    TP_START(10, lds, tid); TP_START(11, lds, tid);
    bf16x8 wfr[2][2][4];
    float prm[2][3];
#pragma unroll
    for (int dir = 0; dir < 2; ++dir) {
#pragma unroll
        for (int gt = 0; gt < 2; ++gt) {
            const bf16_t* W = WRG + (size_t)((dir * 2 + gt) * 8 + hd) * 16384 + (wave * 4 * 64 + lane) * 8;
#pragma unroll
            for (int ks = 0; ks < 4; ++ks) wfr[dir][gt][ks] = *(const bf16x8*)(W + ks * 512);
        }
        const int idx = (j * 2 + dir) * 1024 + hd * 128 + 16 * wave + r;
        prm[dir][0] = P.ev_rg_bx[idx]; prm[dir][1] = P.ev_rg_ba[idx]; prm[dir][2] = P.ev_rg_lambda[idx];
    }
    {
        LAS bf16_t* XT = (LAS bf16_t*)(lds + RG_HP);
#pragma unroll
        for (int rep = 0; rep < 3; ++rep) {
            const int idx = tid + rep * 512, tr = idx >> 4, c0 = (idx & 15) * 8;
            if (idx < 67 * 16) {
                const int Rg = R0 + tr - 1;
                u32x4 xv = {0u, 0u, 0u, 0u};
                if (Rg >= seg_lo && Rg < seg_hi) xv = *(const u32x4*)(p + (size_t)Rg * EVEN_IN + hd * 128 + c0);
                *(LAS u32x4*)(XT + tr * 128 + c0) = xv;
            }
        }
        const int c0 = (tid & 15) * 8, cg0 = hd * 128 + c0;
        float wv4[4][8], bias[8];
        { const f32x4 b0 = *(const f32x4*)(P.ev_conv_b + j * 1024 + cg0), b1 = *(const f32x4*)(P.ev_conv_b + j * 1024 + cg0 + 4);
          bias[0] = b0[0]; bias[1] = b0[1]; bias[2] = b0[2]; bias[3] = b0[3]; bias[4] = b1[0]; bias[5] = b1[1]; bias[6] = b1[2]; bias[7] = b1[3]; }
#pragma unroll
        for (int k = 0; k < 4; ++k) { const float* wk = P.ev_conv_w + (size_t)(j * 4 + k) * 1024 + cg0; const f32x4 w0 = *(const f32x4*)wk, w1 = *(const f32x4*)(wk + 4);
            wv4[k][0] = w0[0]; wv4[k][1] = w0[1]; wv4[k][2] = w0[2]; wv4[k][3] = w0[3]; wv4[k][4] = w1[0]; wv4[k][5] = w1[1]; wv4[k][6] = w1[2]; wv4[k][7] = w1[3]; }
        __syncthreads();
#pragma unroll
        for (int rep = 0; rep < 2; ++rep) {
            const int t = (tid >> 4) + rep * 32;
            float acc[8];
#pragma unroll
            for (int e = 0; e < 8; ++e) acc[e] = bias[e];
#pragma unroll
            for (int k = 0; k < 4; ++k) {
                const u32x4 xv = *(const LAS u32x4*)(XT + (t + k) * 128 + c0);
                acc[0] += wv4[k][0] * __uint_as_float(xv.x << 16); acc[1] += wv4[k][1] * __uint_as_float(xv.x & 0xffff0000u);
                acc[2] += wv4[k][2] * __uint_as_float(xv.y << 16); acc[3] += wv4[k][3] * __uint_as_float(xv.y & 0xffff0000u);
                acc[4] += wv4[k][4] * __uint_as_float(xv.z << 16); acc[5] += wv4[k][5] * __uint_as_float(xv.z & 0xffff0000u);
                acc[6] += wv4[k][6] * __uint_as_float(xv.w << 16); acc[7] += wv4[k][7] * __uint_as_float(xv.w & 0xffff0000u);
            }
            u32x4 o; o.x = pk2(acc[0], acc[1]); o.y = pk2(acc[2], acc[3]); o.z = pk2(acc[4], acc[5]); o.w = pk2(acc[6], acc[7]);
            *(LAS u32x4*)(UT + t * 136 + c0) = o;
        }
    }
    __syncthreads();
    TP_STOP(11, lds, tid);
#pragma unroll
    for (int dir = 0; dir < 2; ++dir) {
        TP_START(12, lds, tid); TP_START(16, lds, tid);
        f32x4 ax[4], aa[4];
#pragma unroll
        for (int m = 0; m < 4; ++m) { ax[m] = (f32x4){0.f, 0.f, 0.f, 0.f}; aa[m] = (f32x4){0.f, 0.f, 0.f, 0.f}; }
#pragma unroll
        for (int ks = 0; ks < 4; ++ks) {
#pragma unroll
            for (int m = 0; m < 4; ++m) {
                const bf16x8 a = *(const LAS bf16x8*)(UT + (16 * m + r) * 136 + 32 * ks + 8 * g);
                ax[m] = MFMA16(a, wfr[dir][0][ks], ax[m]); aa[m] = MFMA16(a, wfr[dir][1][ks], aa[m]);
            }
        }
        asm volatile("" :: "v"(ax[0]), "v"(ax[1]), "v"(ax[2]), "v"(ax[3]), "v"(aa[0]), "v"(aa[1]), "v"(aa[2]), "v"(aa[3]));
        TP_STOP(16, lds, tid); TP_START(17, lds, tid);
        {
            const int c = 16 * wave + r;
            const float bxv = prm[dir][0], bav = prm[dir][1], lam = prm[dir][2];
            const float sp = softplus_neg(lam);
#pragma unroll
            for (int m = 0; m < 4; ++m)
#pragma unroll
                for (int i = 0; i < 4; ++i) {
                    const int t = 16 * m + 4 * g + i;
                    const float gx = sigm(ax[m][i] + bxv), ga = sigm(aa[m][i] + bav);
                    const float la = -8.f * ga * sp;
                    const float a = __expf(la), mult = __builtin_amdgcn_sqrtf(neg_expm1(2.f * la));
                    const float uv = bf2f(UT[t * 136 + c]);
                    AL[t * 128 + c] = a; BL[t * 128 + c] = mult * gx * uv;
                }
        }
        asm volatile("s_waitcnt lgkmcnt(0)" ::: "memory");
        TP_STOP(17, lds, tid); TP_START(18, lds, tid);
        __syncthreads();
        TP_STOP(18, lds, tid);
        TP_STOP(12, lds, tid); TP_START(13, lds, tid);
        {
            const int c = tid & 127, q = tid >> 7;
            float A = 1.f, B = 0.f;
#pragma unroll
            for (int s = 0; s < 16; ++s) { const int t = dir == 0 ? 16 * q + s : 16 * q + 15 - s; const float a = AL[t * 128 + c], bb = BL[t * 128 + c]; B = a * B + bb; A *= a; }
            QA[(q * 128 + c) * 2] = A; QA[(q * 128 + c) * 2 + 1] = B;
            __syncthreads();
            float h = 0.f, pc = 1.f;
            const int nprev = dir == 0 ? q : 3 - q;
            for (int qq = 0; qq < nprev; ++qq) { const int qi = dir == 0 ? qq : 3 - qq; const float a = QA[(qi * 128 + c) * 2]; h = a * h + QA[(qi * 128 + c) * 2 + 1]; pc *= a; }
#pragma unroll
            for (int s = 0; s < 16; ++s) { const int t = dir == 0 ? 16 * q + s : 16 * q + 15 - s; const float a = AL[t * 128 + c]; h = a * h + BL[t * 128 + c]; pc *= a;
                HP[(dir * 64 + t) * 128 + c] = pkh2(h, pc); }
            if (nprev == 3) {
                const unsigned long long v = ((unsigned long long)__float_as_uint(h) << 32) | __float_as_uint(pc);
                __hip_atomic_store(AGG + ((size_t)(dir * NB + b) * NCHUNK + ci) * 1024 + hd * 128 + c, v, __ATOMIC_RELAXED, __HIP_MEMORY_SCOPE_AGENT);
            }
        }
        __syncthreads();
        TP_STOP(13, lds, tid);
    }
    TP_START(14, lds, tid);
    u32x4 gpre[2];
#pragma unroll
    for (int rep = 0; rep < 2; ++rep) { const int idx = tid + rep * 512; gpre[rep] = *(const u32x4*)(p + (size_t)(R0 + (idx >> 4)) * EVEN_IN + 1536 + hd * 128 + (idx & 15) * 8); }
    asm volatile("s_waitcnt vmcnt(0)" ::: "memory");
    __syncthreads();
    if (tid == 0) {
        __hip_atomic_fetch_add(cnt, 1u, __ATOMIC_RELAXED, __HIP_MEMORY_SCOPE_AGENT);
        unsigned spins = 0;
        while (__hip_atomic_load(cnt, __ATOMIC_RELAXED, __HIP_MEMORY_SCOPE_AGENT) < (unsigned)NCHUNK) { __builtin_amdgcn_s_sleep(2); if (++spins > (1u << 22)) break; }
    }
    __syncthreads();
    TP_STOP(14, lds, tid); TP_START(15, lds, tid);
    if (tid < 256) {
        const int dir = tid >> 7, c = tid & 127;
        const int pos = dir == 0 ? ci : (ci < 4 ? 3 - ci : 39 - ci);
        float h = 0.f;
        const unsigned long long* ag = AGG + (size_t)(dir * NB + b) * NCHUNK * 1024 + hd * 128 + c;
#pragma unroll 1
        for (int base = 0; base < pos; base += 18) {
            unsigned long long v[18];
#pragma unroll
            for (int k = 0; k < 18; ++k) { const int pp = base + k < pos ? base + k : pos - 1; const int cc = dir == 0 ? pp : (pp < 4 ? 3 - pp : 39 - pp);
                v[k] = __hip_atomic_load(ag + (size_t)cc * 1024, __ATOMIC_RELAXED, __HIP_MEMORY_SCOPE_AGENT); }
#pragma unroll
            for (int k = 0; k < 18; ++k) if (base + k < pos) h = __uint_as_float((unsigned)v[k]) * h + __uint_as_float((unsigned)(v[k] >> 32));
        }
        CAR[dir * 128 + c] = h;
    }
    __syncthreads();
#pragma unroll
    for (int rep = 0; rep < 2; ++rep) {
        const int idx = tid + rep * 512, t = idx >> 4, c0 = (idx & 15) * 8;
        bf16_t* gp = p + (size_t)(R0 + t) * EVEN_IN + 1536 + hd * 128 + c0;
        const u32x4 gv = gpre[rep];
        float y[8];
#pragma unroll
        for (int e = 0; e < 8; ++e) {
            float h0, p0, h1, p1; unpkh2(HP[t * 128 + c0 + e], h0, p0); unpkh2(HP[(64 + t) * 128 + c0 + e], h1, p1);
            y[e] = (h0 + p0 * CAR[c0 + e]) + (h1 + p1 * CAR[128 + c0 + e]);
        }
        const float gg[8] = {__uint_as_float(gv.x << 16), __uint_as_float(gv.x & 0xffff0000u), __uint_as_float(gv.y << 16), __uint_as_float(gv.y & 0xffff0000u),
                             __uint_as_float(gv.z << 16), __uint_as_float(gv.z & 0xffff0000u), __uint_as_float(gv.w << 16), __uint_as_float(gv.w & 0xffff0000u)};
        u32x4 o;
        o.x = pk2(y[0] * gg[0] * sigm(gg[0]), y[1] * gg[1] * sigm(gg[1])); o.y = pk2(y[2] * gg[2] * sigm(gg[2]), y[3] * gg[3] * sigm(gg[3]));
        o.z = pk2(y[4] * gg[4] * sigm(gg[4]), y[5] * gg[5] * sigm(gg[5])); o.w = pk2(y[6] * gg[6] * sigm(gg[6]), y[7] * gg[7] * sigm(gg[7]));
        *(u32x4*)gp = o;
    }
    __syncthreads();
    TP_STOP(15, lds, tid); TP_STOP(10, lds, tid);
}

DI void rope8v(u32x4& v, const f32x4 cs, const f32x4 sn) {
    unsigned* w = (unsigned*)&v;
#pragma unroll
    for (int i = 0; i < 4; ++i) { const float t1 = __uint_as_float(w[i] << 16), t2 = __uint_as_float(w[i] & 0xffff0000u); w[i] = pk2(t1 * cs[i] - t2 * sn[i], t1 * sn[i] + t2 * cs[i]); }
}
DI void rope8(u32x4& v, const float* cs, const float* sn) { rope8v(v, *(const f32x4*)cs, *(const f32x4*)sn); }
typedef short v4i16_a __attribute__((ext_vector_type(4)));
DI void attn_item(const Params& P, LAS unsigned char* lds, int j, int item, int wv) {
    const int tid = get_tid(wv), lane = tid & 63, wave = tid >> 6, r = lane & 31, h = lane >> 5;
    const bool is_lat = item < 512;
    int b, qb, kvh;
    if (is_lat) { b = item >> 6; qb = (item >> 2) & 15; kvh = item & 3; } else { const int it = item - 512; b = it >> 3; qb = (it >> 2) & 1; kvh = it & 3; }
    bf16_t* p = (bf16_t*)(P.ws + WS_P);
    const float* cos_t = (const float*)(P.ws + WS_ROPE); const float* sin_t = cos_t + SEQ * 32;
    LAS unsigned char* QL = lds + 36864 + wave * 9216;
    TP_START(1, lds, tid);
    const int hq = 4 * kvh + (wave >> 1), ql0 = qb * 128 + 64 * (wave & 1);
    const size_t rowbase = (size_t)b * LT + (is_lat ? CTXL : 0);
    {
        const int chq = lane & 7;
#pragma unroll
        for (int k = 0; k < 8; ++k) {
            const int row = (lane >> 3) + 8 * k, qi = ql0 + row;
            u32x4 v = *(const u32x4*)(p + (rowbase + qi) * EVEN_IN + 2560 + hq * 64 + 8 * chq);
            if (is_lat) rope8(v, cos_t + qi * 32 + 4 * chq, sin_t + qi * 32 + 4 * chq);
            *(LAS u32x4*)(QL + row * 144 + chq * 16) = v;
        }
    }
    const float sink2 = P.ev_sink[j * 16 + hq] * LOG2E;
    float mrun[2] = {sink2, sink2}, lrun[2] = {h == 0 ? 1.f : 0.f, h == 0 ? 1.f : 0.f};
    f32x16 O[2][2];
#pragma unroll
    for (int a = 0; a < 2; ++a)
#pragma unroll
        for (int c = 0; c < 2; ++c)
#pragma unroll
            for (int i = 0; i < 16; ++i) O[a][c][i] = 0.f;
    const int w_lo = (is_lat && qb == 0) ? 2 : 0, w_hi = (is_lat && qb == 15) ? 3 : 5;
    const int nT = is_lat ? 4 + (w_hi - w_lo + 1) : 4;
    const float SC = 0.125f * LOG2E, NEG = -1e30f;
    const int key = tid >> 3, chn = tid & 7;
    u32x4 kreg, vreg; f32x4 creg, sreg;
#define ATT_K0(t) ((t) < 4 ? 64 * (t) : qb * 128 - 128 + 64 * (w_lo + (t) - 4))
#define ATT_LOAD(t) do { const bool win_ = (t) >= 4; const int k0_ = ATT_K0(t); \
        const bf16_t* kp_ = p + ((size_t)b * LT + (win_ ? CTXL : 0) + k0_ + key) * EVEN_IN + 1024 + kvh * 64 + 8 * chn; \
        kreg = *(const u32x4*)kp_; vreg = *(const u32x4*)(kp_ + 256); \
        if (win_) { creg = *(const f32x4*)(cos_t + (k0_ + key) * 32 + 4 * chn); sreg = *(const f32x4*)(sin_t + (k0_ + key) * 32 + 4 * chn); } } while (0)
#define ATT_STORE(t, buf) do { const bool win_ = (t) >= 4; \
        if (win_) rope8v(kreg, creg, sreg); \
        *(LAS u32x4*)(lds + (buf) * 18432 + key * 144 + chn * 16) = kreg; *(LAS u32x4*)(lds + (buf) * 18432 + 9216 + key * 144 + chn * 16) = vreg; } while (0)
    TP_START(2, lds, tid);
    ATT_LOAD(0); ATT_STORE(0, 0);
    if (nT > 1) ATT_LOAD(1);
#pragma unroll 1
    for (int t = 0; t < nT; ++t) {
        TP_START(4, lds, tid);
        __syncthreads();
        TP_STOP(4, lds, tid);
        if (t + 1 < nT) { ATT_STORE(t + 1, (t + 1) & 1); if (t + 2 < nT) ATT_LOAD(t + 2); }
        TP_START(3, lds, tid);
        const bool win = t >= 4;
        const int k0 = ATT_K0(t);
        const int dq = k0 - ql0;
        if (win && (dq >= 192 || dq <= -192)) continue;
        const bool need_mask = win && (dq >= 128 || dq <= -128);
        const LAS unsigned char* KL = lds + (t & 1) * 18432;
        const LAS bf16_t* VL = (const LAS bf16_t*)(lds + (t & 1) * 18432 + 9216);
#pragma unroll
        for (int qt = 0; qt < 2; ++qt) {
            f32x16 s0, s1;
#pragma unroll
            for (int i = 0; i < 16; ++i) { s0[i] = 0.f; s1[i] = 0.f; }
#pragma unroll
            for (int ks = 0; ks < 4; ++ks) {
                const bf16x8 qfr = *(const LAS bf16x8*)(QL + (32 * qt + r) * 144 + (16 * ks + 8 * h) * 2);
                const bf16x8 k0f = *(const LAS bf16x8*)(KL + r * 144 + (16 * ks + 8 * h) * 2), k1f = *(const LAS bf16x8*)(KL + (32 + r) * 144 + (16 * ks + 8 * h) * 2);
                s0 = MFMA32(k0f, qfr, s0); s1 = MFMA32(k1f, qfr, s1);
            }
            const int qpos = ql0 + 32 * qt + r;
            float mx = NEG;
            if (need_mask) {
#pragma unroll
                for (int i = 0; i < 16; ++i) {
                    const int d0 = qpos - (k0 + crow(i, h)), d1 = d0 - 32;
                    float v0 = s0[i] * SC, v1 = s1[i] * SC;
                    if (d0 > 128 || d0 < -128) v0 = NEG;
                    if (d1 > 128 || d1 < -128) v1 = NEG;
                    s0[i] = v0; s1[i] = v1; mx = fmaxf(mx, fmaxf(v0, v1));
                }
            } else {
#pragma unroll
                for (int i = 0; i < 16; ++i) { s0[i] *= SC; s1[i] *= SC; mx = fmaxf(mx, fmaxf(s0[i], s1[i])); }
            }
            mx = fmaxf(mx, shfl_xor_f(mx, 32));
            const float mn = fmaxf(mrun[qt], mx), alpha = __builtin_amdgcn_exp2f(mrun[qt] - mn);
            mrun[qt] = mn;
            float ls = 0.f;
#pragma unroll
            for (int i = 0; i < 16; ++i) { s0[i] = __builtin_amdgcn_exp2f(s0[i] - mn); s1[i] = __builtin_amdgcn_exp2f(s1[i] - mn); ls += s0[i] + s1[i]; }
            lrun[qt] = lrun[qt] * alpha + ls;
#pragma unroll
            for (int dt = 0; dt < 2; ++dt)
#pragma unroll
                for (int i = 0; i < 16; ++i) O[dt][qt][i] *= alpha;
            bf16x8 pf[2][2];
#pragma unroll
            for (int s = 0; s < 2; ++s) {
                u32x4 a, c;
                a.x = pk2(s0[8 * s + 0], s0[8 * s + 1]); a.y = pk2(s0[8 * s + 2], s0[8 * s + 3]); a.z = pk2(s0[8 * s + 4], s0[8 * s + 5]); a.w = pk2(s0[8 * s + 6], s0[8 * s + 7]);
                c.x = pk2(s1[8 * s + 0], s1[8 * s + 1]); c.y = pk2(s1[8 * s + 2], s1[8 * s + 3]); c.z = pk2(s1[8 * s + 4], s1[8 * s + 5]); c.w = pk2(s1[8 * s + 6], s1[8 * s + 7]);
                pf[0][s] = __builtin_bit_cast(bf16x8, a); pf[1][s] = __builtin_bit_cast(bf16x8, c);
            }
            const int gq = (lane >> 4) & 1, qq4 = (lane & 15) >> 2, pp4 = lane & 3;
#pragma unroll
            for (int dt = 0; dt < 2; ++dt)
#pragma unroll
                for (int kt = 0; kt < 2; ++kt)
#pragma unroll
                    for (int s = 0; s < 2; ++s) {
                        const LAS bf16_t* vp = VL + (32 * kt + 16 * s + 4 * h + qq4) * 72 + 32 * dt + 16 * gq + 4 * pp4;
                        const v4i16_a lo = __builtin_amdgcn_ds_read_tr16_b64_v4i16((LAS v4i16_a*)vp);
                        const v4i16_a hi = __builtin_amdgcn_ds_read_tr16_b64_v4i16((LAS v4i16_a*)(vp + 8 * 72));
                        const bf16x8 vf = {lo[0], lo[1], lo[2], lo[3], hi[0], hi[1], hi[2], hi[3]};
                        O[dt][qt] = MFMA32(vf, pf[kt][s], O[dt][qt]);
                    }
            __builtin_amdgcn_sched_barrier(0);
        }
        TP_STOP(3, lds, tid);
    }
    TP_STOP(2, lds, tid);
#undef ATT_K0
#undef ATT_LOAD
#undef ATT_STORE
    {
        const int chq = lane & 7;
        u32x4 gate[8];
#pragma unroll
        for (int k = 0; k < 8; ++k) gate[k] = *(const u32x4*)(p + (rowbase + ql0 + (lane >> 3) + 8 * k) * EVEN_IN + 3584 + hq * 64 + 8 * chq);
#pragma unroll
        for (int qt = 0; qt < 2; ++qt) {
            const float lt = lrun[qt] + shfl_xor_f(lrun[qt], 32), inv = __builtin_amdgcn_rcpf(lt);
#pragma unroll
            for (int dt = 0; dt < 2; ++dt)
#pragma unroll
                for (int i4 = 0; i4 < 4; ++i4) {
                    u32x2 o; o.x = pk2(O[dt][qt][4 * i4 + 0] * inv, O[dt][qt][4 * i4 + 1] * inv); o.y = pk2(O[dt][qt][4 * i4 + 2] * inv, O[dt][qt][4 * i4 + 3] * inv);
                    *(LAS u32x2*)(QL + (32 * qt + r) * 144 + (32 * dt + 8 * i4 + 4 * h) * 2) = o;
                }
        }
#pragma unroll
        for (int k = 0; k < 8; ++k) {
            const int row = (lane >> 3) + 8 * k;
            const u32x4 ov = *(const LAS u32x4*)(QL + row * 144 + chq * 16);
            const unsigned* ow = (const unsigned*)&ov; const unsigned* gw = (const unsigned*)&gate[k];
            u32x4 res; unsigned* rw = (unsigned*)&res;
#pragma unroll
            for (int e = 0; e < 4; ++e) {
                const float g0 = __uint_as_float(gw[e] << 16), g1 = __uint_as_float(gw[e] & 0xffff0000u);
                rw[e] = pk2(__uint_as_float(ow[e] << 16) * g0 * sigm(g0), __uint_as_float(ow[e] & 0xffff0000u) * g1 * sigm(g1));
            }
            *(u32x4*)(p + (rowbase + ql0 + row) * EVEN_IN + 2560 + hq * 64 + 8 * chq) = res;
        }
    }
    __syncthreads();
    TP_STOP(1, lds, tid);
}

constexpr int G2_QX = 0, G2_KF = 17408, G2_K2 = 60928, G2_VS = 79360, G2_AM = 96768, G2_ST = 105984, G2_PS = 140800, G2_BL = 144896, G2_Q1 = 145408, G2_END = 162816;
static_assert(G2_END <= LDS_BYTES - 256, "GLA LDS map");
typedef short v4i16_t __attribute__((ext_vector_type(4)));
DI bf16x8 frag_tr(const LAS bf16_t* M, int stride, int k0, int n0, int lane) {
    const int i = lane & 15, g = lane >> 4, q = i >> 2, pp = i & 3;
    const LAS bf16_t* a0 = M + (k0 + 8 * g + q) * stride + n0 + 4 * pp;
    const v4i16_t lo = __builtin_amdgcn_ds_read_tr16_b64_v4i16((LAS v4i16_t*)a0);
    const v4i16_t hi = __builtin_amdgcn_ds_read_tr16_b64_v4i16((LAS v4i16_t*)(a0 + 4 * stride));
    return (bf16x8){lo[0], lo[1], lo[2], lo[3], hi[0], hi[1], hi[2], hi[3]};
}

template <int DIR>
DI void gla2_item(const Params& P, LAS unsigned char* lds, int layer_j, int b, int hd, int wv) {
    const int tid = get_tid(wv), lane = tid & 63, wave = tid >> 6, r = lane & 15, g = lane >> 4;
    bf16_t* p = (bf16_t*)(P.ws + WS_P);
    LAS bf16_t* QX = (LAS bf16_t*)(lds + G2_QX); LAS bf16_t* KF = (LAS bf16_t*)(lds + G2_KF); LAS bf16_t* K2 = (LAS bf16_t*)(lds + G2_K2);
    LAS bf16_t* VS = (LAS bf16_t*)(lds + G2_VS); LAS bf16_t* AM = (LAS bf16_t*)(lds + G2_AM); LAS bf16_t* ST = (LAS bf16_t*)(lds + G2_ST);
    LAS float* PS8 = (LAS float*)(lds + G2_PS); LAS float* BLAST = (LAS float*)(lds + G2_BL); LAS bf16_t* Q1 = (LAS bf16_t*)(lds + G2_Q1);
    const int d0 = 2 * lane, tg = wave, I = tg >> 1, half = tg & 1;
    float lbv[2] = {0.f, 0.f};
    if (layer_j > 0) { lbv[0] = sigm(P.od_lb_raw[1024 + hd * 128 + d0] - P.od_lb_raw[hd * 128 + d0]); lbv[1] = sigm(P.od_lb_raw[1024 + hd * 128 + d0 + 1] - P.od_lb_raw[hd * 128 + d0 + 1]); }
    TP_START(20, lds, tid);
    for (int i = tid; i < (9216 + 34816) / 4; i += 512) ((LAS unsigned*)(lds + G2_AM))[i] = 0u;
    f32x4 st[8];
#pragma unroll
    for (int e = 0; e < 8; ++e) st[e] = (f32x4){0.f, 0.f, 0.f, 0.f};
    unsigned zn[8], qn[8]; u32x4 vn[2];
#define G2_OFFZ(s) ((unsigned)((DIR == 0 ? 8 * tg + (s) : 63 - 8 * tg - (s)) * ODD_IN + d0) * 2u)
#define G2_OFFV(rep) ((unsigned)((DIR == 0 ? ((tid + (rep) * 512) >> 4) : 63 - ((tid + (rep) * 512) >> 4)) * ODD_IN + 8 * ((tid + (rep) * 512) & 15)) * 2u)
    const size_t colz = (size_t)DIR * 1024 + hd * 128, colq = 3072 + hd * 128, colv = 2048 + hd * 128;
    {
        const int chunk = DIR == 0 ? 0 : 3;
        const char* slab = (const char*)(p + ((size_t)b * LT + (size_t)chunk * 64) * ODD_IN);
#pragma unroll
        for (int s = 0; s < 8; ++s) { zn[s] = *(const unsigned*)(slab + colz * 2 + G2_OFFZ(s)); qn[s] = *(const unsigned*)(slab + colq * 2 + G2_OFFZ(s)); }
#pragma unroll
        for (int rep = 0; rep < 2; ++rep) vn[rep] = *(const u32x4*)(slab + colv * 2 + G2_OFFV(rep));
    }
    __syncthreads();
#pragma unroll 1
    for (int step = 0; step < NCHUNK; ++step) {
        const int chunk = DIR == 0 ? step : (step < 4 ? 3 - step : 39 - step);
        const size_t Rc0 = (size_t)b * LT + (size_t)chunk * 64;
        unsigned zc[8], qc[8]; u32x4 vc[2];
#pragma unroll
        for (int s = 0; s < 8; ++s) { zc[s] = zn[s]; qc[s] = qn[s]; }
        vc[0] = vn[0]; vc[1] = vn[1];
        TP_START(21, lds, tid);
        float el[8][2], kk[8][2], qq[8][2];
        {
            float run0 = 1.f, run1 = 1.f;
#pragma unroll
            for (int s = 0; s < 8; ++s) {
                const float z0 = __uint_as_float(zc[s] << 16), z1 = __uint_as_float(zc[s] & 0xffff0000u);
                const float t0 = __expf(-z0), t1 = __expf(-z1), sg0 = __builtin_amdgcn_rcpf(1.f + t0), sg1 = __builtin_amdgcn_rcpf(1.f + t1);
                const float f0 = fmaxf(lbv[0] + (1.f - lbv[0]) * sg0, 1e-30f), f1 = fmaxf(lbv[1] + (1.f - lbv[1]) * sg1, 1e-30f);
                kk[s][0] = (1.f - lbv[0]) * (t0 * sg0); kk[s][1] = (1.f - lbv[1]) * (t1 * sg1);
                run0 = fmaxf(run0 * f0, 1e-35f); run1 = fmaxf(run1 * f1, 1e-35f); el[s][0] = run0; el[s][1] = run1;
                const float q0 = __uint_as_float(qc[s] << 16), q1 = __uint_as_float(qc[s] & 0xffff0000u);
                qq[s][0] = q0 * __builtin_amdgcn_rcpf(1.f + __expf(-q0)); qq[s][1] = q1 * __builtin_amdgcn_rcpf(1.f + __expf(-q1));
                if ((s & 1) == 1) __builtin_amdgcn_sched_barrier(0);
            }
            *(LAS f32x2*)(PS8 + tg * 128 + d0) = (f32x2){run0, run1};
#pragma unroll
            for (int rep = 0; rep < 2; ++rep) { const int idx = tid + rep * 512, tau = idx >> 4, chn = idx & 15; *(LAS u32x4*)(VS + tau * 136 + 8 * chn) = vc[rep]; }
        }
        __syncthreads();
        TP_STOP(21, lds, tid); TP_START(22, lds, tid);
        float RI[2];
        {
            float T[8][2];
#pragma unroll
            for (int q8 = 0; q8 < 8; ++q8) { const f32x2 t = *(const LAS f32x2*)(PS8 + q8 * 128 + d0); T[q8][0] = t[0]; T[q8][1] = t[1]; }
            float pre[2], fac[4][2], f4[2];
#pragma unroll
            for (int x = 0; x < 2; ++x) {
                const float P0 = T[0][x] * T[1][x], P1 = T[2][x] * T[3][x], P2 = T[4][x] * T[5][x], P3 = T[6][x] * T[7][x];
                pre[x] = half ? (I == 0 ? T[0][x] : (I == 1 ? T[2][x] : (I == 2 ? T[4][x] : T[6][x]))) : 1.f;
                RI[x] = I == 0 ? 1.f : (I == 1 ? P0 : (I == 2 ? P0 * P1 : P0 * P1 * P2));
                float cur = 1.f;
                fac[0][x] = cur; if (I <= 0) cur *= P0;
                fac[1][x] = cur; if (I <= 1) cur *= P1;
                fac[2][x] = cur; if (I <= 2) cur *= P2;
                fac[3][x] = cur; cur *= P3;
                f4[x] = cur;
                if (tg == 0) BLAST[d0 + x] = P0 * P1 * P2 * P3;
            }
            unsigned w0[4], w1[4];
#pragma unroll
            for (int s = 0; s < 8; ++s) {
                const int tau = 8 * tg + s;
                const float e00 = fmaxf(pre[0] * el[s][0], 1e-35f), e01 = fmaxf(pre[1] * el[s][1], 1e-35f);
                const float qi0 = qq[s][0] * e00, qi1 = qq[s][1] * e01;
                const float kd0 = kk[s][0] * __builtin_amdgcn_rcpf(e00), kd1 = kk[s][1] * __builtin_amdgcn_rcpf(e01);
                *(LAS unsigned*)(QX + tau * 136 + d0) = pk2(qi0, qi1);
                *(LAS unsigned*)(Q1 + tau * 136 + d0) = pk2(qi0 * RI[0], qi1 * RI[1]);
                if (I <= 0) *(LAS unsigned*)(KF + (0 + tau) * 136 + d0) = pk2(kd0 * fac[0][0], kd1 * fac[0][1]);
                if (I <= 1) *(LAS unsigned*)(KF + (16 + tau) * 136 + d0) = pk2(kd0 * fac[1][0], kd1 * fac[1][1]);
                if (I <= 2) *(LAS unsigned*)(KF + (48 + tau) * 136 + d0) = pk2(kd0 * fac[2][0], kd1 * fac[2][1]);
                *(LAS unsigned*)(KF + (96 + tau) * 136 + d0) = pk2(kd0 * fac[3][0], kd1 * fac[3][1]);
                const unsigned h0 = f2bf(kd0 * f4[0]), h1 = f2bf(kd1 * f4[1]);
                if (s & 1) { w0[s >> 1] |= h0 << 16; w1[s >> 1] |= h1 << 16; } else { w0[s >> 1] = h0; w1[s >> 1] = h1; }
                if ((s & 1) == 1) __builtin_amdgcn_sched_barrier(0);
            }
            *(LAS u32x4*)(K2 + (d0 + 0) * 72 + 8 * tg) = (u32x4){w0[0], w0[1], w0[2], w0[3]};
            *(LAS u32x4*)(K2 + (d0 + 1) * 72 + 8 * tg) = (u32x4){w1[0], w1[1], w1[2], w1[3]};
        }
        __syncthreads();
        TP_STOP(22, lds, tid); TP_START(23, lds, tid);
        if (step + 1 < NCHUNK) {
            const int nchunk = DIR == 0 ? step + 1 : (step + 1 < 4 ? 2 - step : 38 - step);
            const char* slab = (const char*)(p + ((size_t)b * LT + (size_t)nchunk * 64) * ODD_IN);
#pragma unroll
            for (int s = 0; s < 8; ++s) { zn[s] = *(const unsigned*)(slab + colz * 2 + G2_OFFZ(s)); qn[s] = *(const unsigned*)(slab + colq * 2 + G2_OFFZ(s)); }
#pragma unroll
            for (int rep = 0; rep < 2; ++rep) vn[rep] = *(const u32x4*)(slab + colv * 2 + G2_OFFV(rep));
        }
#pragma unroll 1
        for (int bi = wave; bi < 10; bi += 8) {
            const int Ib = bi < 1 ? 0 : (bi < 3 ? 1 : (bi < 6 ? 2 : 3)), Jb = bi - (Ib * (Ib + 1)) / 2;
            const int foff = Ib == 0 ? 0 : (Ib == 1 ? 16 : (Ib == 2 ? 48 : 96));
            f32x4 acc = {0.f, 0.f, 0.f, 0.f};
#pragma unroll
            for (int ks = 0; ks < 4; ++ks) {
                const bf16x8 a = *(const LAS bf16x8*)(QX + (16 * Ib + r) * 136 + 32 * ks + 8 * g);
                const bf16x8 bb = *(const LAS bf16x8*)(KF + (foff + 16 * Jb + r) * 136 + 32 * ks + 8 * g);
                acc = MFMA16(a, bb, acc);
            }
#pragma unroll
            for (int i = 0; i < 4; ++i) { float v = acc[i]; if (Jb == Ib && r > 4 * g + i) v = 0.f; AM[(16 * Ib + 4 * g + i) * 72 + 16 * Jb + r] = (bf16_t)f2bf(v); }
        }
        __syncthreads();
        TP_STOP(23, lds, tid); TP_START(24, lds, tid);
        {
            const int tt = wave >> 1, eb = 4 * (wave & 1);
            bf16x8 aq[4], am[2];
#pragma unroll
            for (int ks = 0; ks < 4; ++ks) aq[ks] = *(const LAS bf16x8*)(Q1 + (16 * tt + r) * 136 + 32 * ks + 8 * g);
#pragma unroll
            for (int ks = 0; ks < 2; ++ks) am[ks] = *(const LAS bf16x8*)(AM + (16 * tt + r) * 72 + 32 * ks + 8 * g);
#pragma unroll
            for (int e4 = 0; e4 < 4; ++e4) {
                const int et = eb + e4;
                f32x4 acc = {0.f, 0.f, 0.f, 0.f};
#pragma unroll
                for (int ks = 0; ks < 4; ++ks) { const bf16x8 bb = *(const LAS bf16x8*)(ST + (16 * et + r) * 136 + 32 * ks + 8 * g); acc = MFMA16(aq[ks], bb, acc); }
#pragma unroll
                for (int ks = 0; ks < 2; ++ks) acc = MFMA16(am[ks], frag_tr(VS, 136, 32 * ks, 16 * et, lane), acc);
#pragma unroll
                for (int i = 0; i < 4; ++i) KF[(16 * tt + 4 * g + i) * 136 + 16 * et + r] = (bf16_t)f2bf(acc[i]);
                __builtin_amdgcn_sched_barrier(0);
            }
            float bl[4];
#pragma unroll
            for (int i = 0; i < 4; ++i) bl[i] = BLAST[16 * wave + 4 * g + i];
            bf16x8 ak[2];
#pragma unroll
            for (int ks = 0; ks < 2; ++ks) ak[ks] = *(const LAS bf16x8*)(K2 + (16 * wave + r) * 72 + 32 * ks + 8 * g);
#pragma unroll
            for (int et = 0; et < 8; ++et) {
#pragma unroll
                for (int i = 0; i < 4; ++i) st[et][i] *= bl[i];
#pragma unroll
                for (int ks = 0; ks < 2; ++ks) st[et] = MFMA16(ak[ks], frag_tr(VS, 136, 32 * ks, 16 * et, lane), st[et]);
                if (et & 1) __builtin_amdgcn_sched_barrier(0);
            }
        }
        __syncthreads();
        TP_STOP(24, lds, tid); TP_START(25, lds, tid);
        {
            char* oslab = (char*)(p + Rc0 * ODD_IN + colz);
#pragma unroll
            for (int rep = 0; rep < 2; ++rep) {
                const int idx = tid + rep * 512, tau = idx >> 4, chn = idx & 15;
                const u32x4 ov = *(const LAS u32x4*)(KF + tau * 136 + 8 * chn);
                *(u32x4*)(oslab + (unsigned)((DIR == 0 ? tau : 63 - tau) * ODD_IN + 8 * chn) * 2u) = ov;
            }
        }
#pragma unroll
        for (int et = 0; et < 8; ++et) { u32x2 w; w.x = pk2(st[et][0], st[et][1]); w.y = pk2(st[et][2], st[et][3]); *(LAS u32x2*)(ST + (16 * et + r) * 136 + 16 * wave + 4 * g) = w; }
        TP_STOP(25, lds, tid);
    }
    __syncthreads();
    TP_STOP(20, lds, tid);
}

DI void phase_readout(const Params& P, int layer_j, int wv) {
    const int tid = get_tid(wv), lane = tid & 63, wave = tid >> 6;
    const int gw = get_bid() * 8 + wave, NGW = gridDim.x * 8;
    bf16_t* p = (bf16_t*)(P.ws + WS_P);
    const float* gwt = P.od_gnorm_w + layer_j * 128 + (lane & 7) * 16;
    for (int R = gw; R < MROWS; R += NGW) {
        const bf16_t* op = p + (size_t)R * ODD_IN + 16 * lane; bf16_t* yp = p + (size_t)R * ODD_IN + 4096 + 16 * lane;
        const u32x4 o0 = *(const u32x4*)op, o1 = *(const u32x4*)(op + 8), c0 = *(const u32x4*)(op + 1024), c1 = *(const u32x4*)(op + 1032), g0 = *(const u32x4*)yp, g1 = *(const u32x4*)(yp + 8);
        float ov[16], gv[16];
        const unsigned* ow0 = (const unsigned*)&o0; const unsigned* ow1 = (const unsigned*)&o1; const unsigned* cw0 = (const unsigned*)&c0; const unsigned* cw1 = (const unsigned*)&c1;
        const unsigned* gw0 = (const unsigned*)&g0; const unsigned* gw1 = (const unsigned*)&g1;
#pragma unroll
        for (int i = 0; i < 4; ++i) {
            ov[2 * i] = __uint_as_float(ow0[i] << 16) + __uint_as_float(cw0[i] << 16); ov[2 * i + 1] = __uint_as_float(ow0[i] & 0xffff0000u) + __uint_as_float(cw0[i] & 0xffff0000u);
            ov[8 + 2 * i] = __uint_as_float(ow1[i] << 16) + __uint_as_float(cw1[i] << 16); ov[8 + 2 * i + 1] = __uint_as_float(ow1[i] & 0xffff0000u) + __uint_as_float(cw1[i] & 0xffff0000u);
            gv[2 * i] = __uint_as_float(gw0[i] << 16); gv[2 * i + 1] = __uint_as_float(gw0[i] & 0xffff0000u); gv[8 + 2 * i] = __uint_as_float(gw1[i] << 16); gv[8 + 2 * i + 1] = __uint_as_float(gw1[i] & 0xffff0000u);
        }
        float ss = 0.f;
#pragma unroll
        for (int i = 0; i < 16; ++i) ss += ov[i] * ov[i];
        ss += shfl_xor_f(ss, 1); ss += shfl_xor_f(ss, 2); ss += shfl_xor_f(ss, 4);
        const float rstd = rsqrtf(ss * (1.f / 128.f) + RMS_EPS);
        float y[16];
#pragma unroll
        for (int i = 0; i < 16; ++i) y[i] = ov[i] * rstd * gwt[i] * (gv[i] * sigm(gv[i]));
        u32x4 w0, w1;
        w0.x = pk2(y[0], y[1]); w0.y = pk2(y[2], y[3]); w0.z = pk2(y[4], y[5]); w0.w = pk2(y[6], y[7]);
        w1.x = pk2(y[8], y[9]); w1.y = pk2(y[10], y[11]); w1.z = pk2(y[12], y[13]); w1.w = pk2(y[14], y[15]);
        *(u32x4*)yp = w0; *(u32x4*)(yp + 8) = w1;
    }
}

DI void phase_final(const Params& P, int wv) {
    const int tid = get_tid(wv), lane = tid & 63, wave = tid >> 6;
    const int gw = get_bid() * 8 + wave, NGW = gridDim.x * 8;
    for (int R = gw; R < NB * SEQ; R += NGW) {
        float* row = P.out + (size_t)R * DM;
        f32x4 v[4]; float ss = 0.f;
#pragma unroll
        for (int q = 0; q < 4; ++q) { v[q] = *(const f32x4*)(row + 4 * lane + 256 * q); ss += (v[q][0] * v[q][0] + v[q][1] * v[q][1]) + (v[q][2] * v[q][2] + v[q][3] * v[q][3]); }
        const float rstd = rsqrtf(wave_sum(ss) * (1.f / DM) + RMS_EPS);
#pragma unroll
        for (int q = 0; q < 4; ++q) { const f32x4 w4 = *(const f32x4*)(P.final_norm_w + 4 * lane + 256 * q); *(f32x4*)(row + 4 * lane + 256 * q) = (v[q] * rstd) * w4; }
    }
}

#define XB_TMO      128
#define XB_XCNT(j)  (256  + 64 * (j))
#define XB_XSUB(j)  (1280 + 64 * (j))
#define XB_XGEN(j)  (2304 + 64 * (j))
#define XB_TOP      3328
#define XB_TOPGEN   3392
#define XCD_BAR_WORDS 3456
#define XB_SPIN_CAP (1u << 18)

__device__ __forceinline__ unsigned xb_ld(unsigned* p)              { return __hip_atomic_load(p, __ATOMIC_RELAXED, __HIP_MEMORY_SCOPE_AGENT); }
__device__ __forceinline__ unsigned xb_add(unsigned* p, unsigned v) { return __hip_atomic_fetch_add(p, v, __ATOMIC_RELAXED, __HIP_MEMORY_SCOPE_AGENT); }
__device__ __forceinline__ unsigned xb_xcc_id() { return (unsigned)__builtin_amdgcn_s_getreg((3 << 11) | 20) & 0xFu; }
#define XB_SPIN(cond, bar) do { unsigned _sp = 0; while (cond) { __builtin_amdgcn_s_sleep(1); \
    if ((++_sp & 255u) == 0u) { if (xb_ld(&(bar)[XB_TMO])) break; if (_sp > XB_SPIN_CAP) { atomicAdd(&(bar)[XB_TMO], 1u); break; } } } } while (0)

struct XcdBarrier {
    unsigned* bar; unsigned x;
    volatile LAS unsigned* st;
};

__device__ __forceinline__ XcdBarrier xcd_barrier_post(unsigned* bar, volatile LAS unsigned* st, int wv) {
    XcdBarrier b; b.bar = bar; b.x = xb_xcc_id(); b.st = st;
    if (get_tid(wv) == 0) (void)xb_add(&bar[XB_XCNT(b.x)], 1u);
    return b;
}
__device__ __forceinline__ void xcd_barrier_complete(unsigned* bar, unsigned x, unsigned& nloc, unsigned& nx) {
    const unsigned G = gridDim.x * gridDim.y * gridDim.z;
    unsigned sum, cnt, mine, sp = 0u;
    for (;;) {
        sum = 0u; cnt = 0u; mine = 0u;
#pragma unroll
        for (unsigned j = 0; j < 16; ++j) { const unsigned c = xb_ld(&bar[XB_XCNT(j)]); sum += c; cnt += (c > 0u) ? 1u : 0u; mine = (j == x) ? c : mine; }
        if (sum == G) break;
        __builtin_amdgcn_s_sleep(1);
        if ((++sp & 255u) == 0u) { if (xb_ld(&bar[XB_TMO])) break; if (sp > XB_SPIN_CAP) { atomicAdd(&bar[XB_TMO], 1u); break; } }
    }
    nloc = mine > 0u ? mine : 1u; nx = cnt > 0u ? cnt : 1u;
}

__device__ __forceinline__ void xcd_barrier(const XcdBarrier& b, int wv) {
    asm volatile("s_waitcnt vmcnt(0)" ::: "memory");
    __syncthreads();
    if (get_tid(wv) == 0) {
        unsigned* bar = b.bar;
        __builtin_amdgcn_s_waitcnt(0);
        unsigned nloc = b.st[0], nx = b.st[1];
        if (nloc == 0u) { xcd_barrier_complete(bar, b.x, nloc, nx); b.st[0] = nloc; b.st[1] = nx; }
        const unsigned old = xb_add(&bar[XB_XSUB(b.x)], 1u);
        const unsigned gen = old / nloc;
        if (old + 1u == (gen + 1u) * nloc) {
            __builtin_amdgcn_fence(__ATOMIC_RELEASE, "agent");
            asm volatile("s_waitcnt vmcnt(0)" ::: "memory");
            const unsigned og = xb_add(&bar[XB_TOP], 1u);
            const unsigned tg = og / nx;
            if (og + 1u == (tg + 1u) * nx) xb_add(&bar[XB_TOPGEN], 1u);
            else XB_SPIN(xb_ld(&bar[XB_TOPGEN]) == tg, bar);
            __builtin_amdgcn_fence(__ATOMIC_ACQUIRE, "agent");
            xb_add(&bar[XB_XGEN(b.x)], 1u);
            asm volatile("s_waitcnt vmcnt(0)" ::: "memory");
        } else {
            XB_SPIN(xb_ld(&bar[XB_XGEN(b.x)]) == gen, bar);
            __builtin_amdgcn_fence(__ATOMIC_ACQUIRE, "agent");
            asm volatile("s_waitcnt vmcnt(0)" ::: "memory");
        }
    }
    __syncthreads();
}

constexpr int PARAM_OFF = LDS_BYTES - 256;
static_assert(G2_END <= PARAM_OFF && sizeof(Params) <= 208, "LDS map");
DI const float* ld_uptr(const LAS unsigned long long* s, int i) {
    const unsigned long long v = s[i];
    const unsigned lo = __builtin_amdgcn_readfirstlane((unsigned)v), hi = __builtin_amdgcn_readfirstlane((unsigned)(v >> 32));
    return (const float*)(const __attribute__((address_space(1))) float*)(((unsigned long long)hi << 32) | lo);
}
DI Params load_params(LAS unsigned char* lds) {
    LAS unsigned char* pb = lds + PARAM_OFF; asm volatile("" : "+v"(pb));
    const LAS unsigned long long* s = (const LAS unsigned long long*)pb;
    Params Q;
    Q.x = ld_uptr(s, 0); Q.c = ld_uptr(s, 1); Q.ctx = ld_uptr(s, 2); Q.c_ctx = ld_uptr(s, 3); Q.ada_w = ld_uptr(s, 4); Q.ada_b = ld_uptr(s, 5); Q.norm_w = ld_uptr(s, 6);
    Q.ev_w_in = ld_uptr(s, 7); Q.ev_conv_w = ld_uptr(s, 8); Q.ev_conv_b = ld_uptr(s, 9); Q.ev_rg_wx = ld_uptr(s, 10); Q.ev_rg_bx = ld_uptr(s, 11); Q.ev_rg_wa = ld_uptr(s, 12);
    Q.ev_rg_ba = ld_uptr(s, 13); Q.ev_rg_lambda = ld_uptr(s, 14); Q.ev_sink = ld_uptr(s, 15); Q.ev_w_out = ld_uptr(s, 16); Q.od_w_in = ld_uptr(s, 17); Q.od_lb_raw = ld_uptr(s, 18);
    Q.od_gnorm_w = ld_uptr(s, 19); Q.od_w_out = ld_uptr(s, 20); Q.final_norm_w = ld_uptr(s, 21); Q.out = (float*)ld_uptr(s, 22); Q.ws = (unsigned char*)ld_uptr(s, 23);
    Q.ph_lo = 0; Q.ph_hi = 0;
    return Q;
}
DI void run_phase(LAS unsigned char* lds, int ph, int wv) {
    #ifndef PHMASK
#define PHMASK 0xffff
#endif
    if (ph == 0) { if (PHMASK & 1) { const Params P = load_params(lds); phase_pro(P, lds, wv); } return; }
    if (ph == NPHASE - 1) { if (PHMASK & 2) { const Params P = load_params(lds); phase_final(P, wv); } return; }
    const int layer = (ph - 1) / 5, sub = (ph - 1) % 5, j = layer >> 1;
    const bool even = (layer & 1) == 0;
    if (sub == 0) { if (PHMASK & 4) { const Params P = load_params(lds); phase_norm(P, lds, layer, wv); } return; }
    if (sub == 1) {
        const Params P = load_params(lds); bf16_t* pbuf = (bf16_t*)(P.ws + WS_P);
        const int N = even ? EVEN_IN : ODD_IN;
        pg8::Gemm gm{(const bf16_t*)(P.ws + WS_OV), (const bf16_t*)(P.ws + WS_WIN), MROWS, N, 1024, 1024};
        pg8::StaticOrder S; S.init(MROWS, N, (int)gridDim.x, get_bid());
        EpiStoreBf16 E{pbuf, N};
        if (even) S.limit = 1280;
        if (PHMASK & 8) pg8::gemm_phase<EpiStoreBf16, pg8::StaticOrder, true, true>(lds, gm, S, E, wv);
        if (even) {
            for (int t = get_bid(); t < 128; t += gridDim.x) {
                pg8::Unit u; S.tile_of(1280 + (t >> 3), u);
                const int m0 = 256 * u.pm + 64 * ((t & 7) >> 1), n0 = 256 * u.pn + 128 * (t & 1);
                auto epi = [&](const f32x16& acc, int row0, int col, int hh) {
#pragma unroll
                    for (int i = 0; i < 16; ++i) pbuf[(size_t)(m0 + row0 + crow(i, hh)) * N + n0 + col] = (bf16_t)f2bf(acc[i]);
                };
                mini_gemm_tile(lds, (const bf16_t*)(P.ws + WS_OV) + (size_t)m0 * 1024, 1024, (const bf16_t*)(P.ws + WS_WIN) + (size_t)n0 * 1024, 1024, epi, wv);
            }
        }
        return;
    }
    if (sub == 2) {
        const Params P = load_params(lds);
        if (even) {
            constexpr int NRG = NB * NCHUNK * 8;
#if defined(SPLIT_ATTN)
            for (int it = get_bid(); it < NRG; it += gridDim.x) rglru_item(P, lds, j, it, wv);
#else
            for (int it = get_bid(); it < NRG + 576; it += gridDim.x) {
                if (it < NRG) { if (PHMASK & 32) rglru_item(P, lds, j, it, wv); } else { if (PHMASK & 16) attn_item(P, lds, j, it - NRG, wv); }
            }
#endif
        } else {
            for (int it = get_bid(); it < 128; it += gridDim.x) { if (PHMASK & 64) { if (it & 1) gla2_item<1>(P, lds, j, it >> 4, (it >> 1) & 7, wv); else gla2_item<0>(P, lds, j, it >> 4, (it >> 1) & 7, wv); } }
        }
        return;
    }
    if (sub == 3) {
        const Params P = load_params(lds);
        if (!even) { if (PHMASK & 256) phase_readout(P, j, wv); }
#if defined(SPLIT_ATTN)
        else { for (int it = get_bid(); it < 576; it += gridDim.x) attn_item(P, lds, j, it, wv); }
#endif
        return;
    }
    {
        const Params P = load_params(lds); bf16_t* pbuf = (bf16_t*)(P.ws + WS_P);
        const int K = even ? 2048 : 1024, lda = even ? EVEN_IN : ODD_IN;
        pg8::Gemm gm{pbuf + (even ? 1536 : 4096), (const bf16_t*)(P.ws + WS_WOUT), MROWS, 1024, K, lda};
        pg8::StaticOrder S; S.init(NB * SEQ, 1024, (int)gridDim.x, get_bid(), 1);
        const float* hl = layer == 0 ? P.x : P.out; const float* hc = layer == 0 ? P.ctx : (const float*)(P.ws + WS_HCTX);
        EpiResid E{hl, hc, P.out, (float*)(P.ws + WS_HCTX), (const float*)(P.ws + WS_MOD) + (size_t)layer * 9 * 3072 + 2048};
        if (PHMASK & 512) pg8::gemm_phase<EpiResid, pg8::StaticOrder, true, true>(lds, gm, S, E, wv);
        if (layer < 3) {
            for (int t = get_bid(); t < 256; t += gridDim.x) {
                const int mt = t >> 3, nt = t & 7, mc0 = 64 * mt, bctx = mc0 >> 8, n0 = 128 * nt;
                const bf16_t* At = pbuf + ((size_t)bctx * LT + (mc0 & 255)) * lda + (even ? 1536 : 4096);
                const float* gctx = (const float*)(P.ws + WS_MOD) + (size_t)layer * 9 * 3072 + 2048 + 8 * 3072;
                float* hco = (float*)(P.ws + WS_HCTX);
                auto epi = [&](const f32x16& acc, int row0, int col, int hh) {
                    const float gate = gctx[n0 + col];
#pragma unroll
                    for (int i = 0; i < 16; ++i) { const size_t off = (size_t)(mc0 + row0 + crow(i, hh)) * DM + n0 + col; hco[off] = hc[off] + gate * acc[i]; }
                };
                mini_gemm_tile(lds, At, lda, (const bf16_t*)(P.ws + WS_WOUT) + (size_t)n0 * K, K, epi, wv);
            }
        }
    }
}

__global__ void __launch_bounds__(512, 2) mega(Params P) {
    extern __shared__ __attribute__((aligned(16))) unsigned char lds_raw[];
    LAS unsigned char* lds = (LAS unsigned char*)lds_raw;
    cg::grid_group grid = cg::this_grid();
    const int wv = __builtin_amdgcn_readfirstlane((int)(threadIdx.x >> 6));
    if (get_tid(wv) == 0) {
#if defined(TP_ID)
        ((LAS unsigned long long*)(lds + 163840 - 32))[0] = 0ull; ((LAS unsigned long long*)(lds + 163840 - 32))[1] = 0ull;
#endif
        ((LAS unsigned*)(lds + PARAM_OFF + 208))[0] = 0u; ((LAS unsigned*)(lds + PARAM_OFF + 208))[1] = 0u;
        LAS unsigned long long* d = (LAS unsigned long long*)(lds + PARAM_OFF);
        d[0] = (unsigned long long)P.x; d[1] = (unsigned long long)P.c; d[2] = (unsigned long long)P.ctx; d[3] = (unsigned long long)P.c_ctx; d[4] = (unsigned long long)P.ada_w;
        d[5] = (unsigned long long)P.ada_b; d[6] = (unsigned long long)P.norm_w; d[7] = (unsigned long long)P.ev_w_in; d[8] = (unsigned long long)P.ev_conv_w; d[9] = (unsigned long long)P.ev_conv_b;
        d[10] = (unsigned long long)P.ev_rg_wx; d[11] = (unsigned long long)P.ev_rg_bx; d[12] = (unsigned long long)P.ev_rg_wa; d[13] = (unsigned long long)P.ev_rg_ba; d[14] = (unsigned long long)P.ev_rg_lambda;
        d[15] = (unsigned long long)P.ev_sink; d[16] = (unsigned long long)P.ev_w_out; d[17] = (unsigned long long)P.od_w_in; d[18] = (unsigned long long)P.od_lb_raw; d[19] = (unsigned long long)P.od_gnorm_w;
        d[20] = (unsigned long long)P.od_w_out; d[21] = (unsigned long long)P.final_norm_w; d[22] = (unsigned long long)P.out; d[23] = (unsigned long long)P.ws;
    }
    __syncthreads();
    const int ph_lo = P.ph_lo, ph_hi = P.ph_hi;
    (void)xcd_barrier_post((unsigned*)(P.ws + WS_CTL) + 4096, (volatile LAS unsigned*)(lds + PARAM_OFF + 208), wv);
#define GRID_SYNC(first) do { if (first) grid.sync(); else { XcdBarrier xb_; xb_.bar = (unsigned*)(load_params(lds).ws + WS_CTL) + 4096; xb_.x = xb_xcc_id(); xb_.st = (volatile LAS unsigned*)(lds + PARAM_OFF + 208); xcd_barrier(xb_, wv); } } while (0)
#if defined(PROBE_S)
    constexpr int PREP = PROBE_E - PROBE_S + 1;
#pragma unroll 1
    for (int seq = ph_lo; seq < ph_hi + PREP; ++seq) {
        if (seq > ph_lo) GRID_SYNC(seq == ph_lo + 1);
        const int ph = seq <= PROBE_E ? seq : seq - PREP;
        run_phase(lds, ph, wv);
    }
#else
#pragma unroll 1
    for (int ph = ph_lo; ph < ph_hi; ++ph) {
#if !defined(SPLIT_ATTN)
        if (ph >= 1 && ph < NPHASE - 1 && (ph - 1) % 5 == 3 && (((ph - 1) / 5) & 1) == 0) continue;
#endif
        if (ph > ph_lo) GRID_SYNC(ph == ph_lo + 1);
        run_phase(lds, ph, wv);
    }
#endif
#if defined(TP_ID)
    if (get_tid(wv) == 0 && blockIdx.x == TP_BLOCK) {
        const unsigned long long acc = ((LAS unsigned long long*)(lds + 163840 - 32))[1], t0 = __builtin_amdgcn_s_memrealtime();
        while (__builtin_amdgcn_s_memrealtime() - t0 < (unsigned long long)TP_AMP * acc) __builtin_amdgcn_s_sleep(8);
    }
#endif
}

extern "C" void kernel_launch(void* const* d_in, const int* in_sizes, int n_in, void* d_out, int out_size, void* d_ws, size_t ws_size, hipStream_t stream) {
    static int grid = 0;
    if (grid == 0) {
        if (n_in != 22 || ws_size < WS_END) { fprintf(stderr, "kernel_launch: unexpected inputs (n_in %d, ws %zu)\n", n_in, ws_size); grid = -1; return; }
        int dev = 0, cus = 0, per_cu = 0;
        hipGetDevice(&dev);
        hipDeviceGetAttribute(&cus, hipDeviceAttributeMultiprocessorCount, dev);
        if (hipFuncSetAttribute((const void*)mega, hipFuncAttributeMaxDynamicSharedMemorySize, LDS_BYTES) != hipSuccess) { fprintf(stderr, "kernel_launch: hipFuncSetAttribute failed\n"); grid = -1; return; }
        if (hipOccupancyMaxActiveBlocksPerMultiprocessor(&per_cu, (const void*)mega, 512, LDS_BYTES) != hipSuccess || per_cu < 1) { fprintf(stderr, "kernel_launch: occupancy query gives %d\n", per_cu); per_cu = 1; }
        (void)hipGetLastError();
        grid = cus;
    }
    if (grid < 0) return;
    if (hipMemsetAsync((char*)d_ws + WS_CTL, 0, 65536, stream) != hipSuccess) { fprintf(stderr, "kernel_launch: memset failed\n"); return; }
    Params P{};
    const float** pp = (const float**)&P;
    for (int i = 0; i < 22; ++i) pp[i] = (const float*)d_in[i];
    P.out = (float*)d_out; P.ws = (unsigned char*)d_ws;
#if ONE_LAUNCH
    P.ph_lo = 0; P.ph_hi = NPHASE;
    { void* args[] = {&P}; hipError_t e = hipLaunchCooperativeKernel((const void*)mega, dim3(grid), dim3(512), args, LDS_BYTES, stream);
      if (e != hipSuccess) fprintf(stderr, "cooperative launch failed: %s (grid %d)\n", hipGetErrorString(e), grid); }
#else
    for (int ph = 0; ph < NPHASE; ++ph) {
        P.ph_lo = ph; P.ph_hi = ph + 1;
        void* args[] = {&P}; hipError_t e = hipLaunchCooperativeKernel((const void*)mega, dim3(grid), dim3(512), args, LDS_BYTES, stream);
        if (e != hipSuccess) { fprintf(stderr, "launch %d failed: %s (grid %d)\n", ph, hipGetErrorString(e), grid); break; }
    }
#endif
}
```

```cpp
#include <hip/hip_runtime.h>
#include <hip/hip_cooperative_groups.h>
#include <cstdio>
#include <cstdint>
namespace cg = cooperative_groups;

#ifndef ONE_LAUNCH
#define ONE_LAUNCH 1
#endif

#define DI __device__ __forceinline__
#define LAS __attribute__((address_space(3)))
__device__ __forceinline__ int lane_nh() { int l; asm volatile("v_mbcnt_lo_u32_b32 %0, -1, 0\n\tv_mbcnt_hi_u32_b32 %0, -1, %0" : "=v"(l)); return l; }
__device__ __forceinline__ int get_tid(int wv) { asm volatile("" : "+s"(wv)); return wv * 64 + lane_nh(); }
__device__ __forceinline__ float shfl_xor_f(float v, int o) { return __int_as_float(__builtin_amdgcn_ds_bpermute((lane_nh() ^ o) << 2, __float_as_int(v))); }
__device__ __forceinline__ int get_bid() { int b = blockIdx.x; asm volatile("" : "+s"(b)); return b; }

#if defined(TP_ID)
#ifndef TP_BLOCK
#define TP_BLOCK 5
#endif
#ifndef TP_AMP
#define TP_AMP 16
#endif
#define TP_START(id, lds, tid_) do { if ((id) == TP_ID && (tid_) == 0 && blockIdx.x == TP_BLOCK) { ((LAS unsigned long long*)((lds) + 163840 - 32))[0] = __builtin_amdgcn_s_memrealtime(); } } while (0)
#define TP_STOP(id, lds, tid_) do { if ((id) == TP_ID && (tid_) == 0 && blockIdx.x == TP_BLOCK) { LAS unsigned long long* w_ = (LAS unsigned long long*)((lds) + 163840 - 32); w_[1] += __builtin_amdgcn_s_memrealtime() - w_[0]; } } while (0)
#else
#define TP_START(id, lds, tid_) do { } while (0)
#define TP_STOP(id, lds, tid_) do { } while (0)
#endif
namespace pg8 {
#define PG8_LAS __attribute__((address_space(3)))
typedef unsigned short bf16_t;
typedef short bf16x8 __attribute__((ext_vector_type(8)));
typedef float f32x4 __attribute__((ext_vector_type(4)));
typedef unsigned u32x4 __attribute__((ext_vector_type(4)));
constexpr int BM = 256, BK = 64, HALF = 128, HTB = HALF * BK * 2  , STAGE_BYTES = 8 * HTB, NXCD = 8, WGM = 8;

__host__ __device__ __forceinline__ int lds_byte(int r, int c) { const int st = (r >> 4) * 2 + (c >> 5), rr = r & 15, cc = c & 31, ob = rr * 64 + cc * 2; return st * 1024 + (ob ^ (((ob >> 9) & 1) << 5)); }
__host__ __device__ __forceinline__ void stage_rc(int b, int& R, int& C) { const int st = b / 1024, sb = b % 1024, swz = sb ^ (((sb >> 9) & 1) << 5); R = (st >> 1) * 16 + swz / 64; C = (st & 1) * 32 + (swz % 64) / 2; }
__host__ __device__ __forceinline__ int perm32(int rho) { const int n = rho >> 4, i = rho & 15; return 8 * (i >> 2) + 4 * n + (i & 3); }

struct Unit { int pm, pn; };
struct Gemm { const bf16_t* A; const bf16_t* Bt; int M, N, K, lda; };

struct StaticOrder {
    int nM, nN, nwg, G, c, lat_only, limit;
    __host__ __device__ void init(int M, int N, int G_, int c_, int lat_only_ = 0) { nM = M / BM; nN = N / BM; nwg = nM * nN; G = G_; c = c_; lat_only = lat_only_; limit = nwg; }
    __host__ __device__ bool next(int i, Unit& u) const {
        const long L = (long)i * G + c; if (L >= limit) return false;
        tile_of((int)L, u); return true;
    }
    __host__ __device__ void tile_of(int L, Unit& u) const {
        int wgid = L; { const int q = nwg / NXCD, r = nwg % NXCD, xcd = wgid % NXCD, off = wgid / NXCD; wgid = (xcd < r ? xcd * (q + 1) : r * (q + 1) + (xcd - r) * q) + off; }
        const int nig = WGM * nN, gid = wgid / nig, fm = gid * WGM, gsz = (nM - fm) < WGM ? (nM - fm) : WGM;
        u.pm = fm + ((wgid % nig) % gsz); u.pn = (wgid % nig) / gsz; if (lat_only) u.pm = 9 * (u.pm >> 3) + 1 + (u.pm & 7);
    }
    __device__ __forceinline__ void a_ready(const Unit&) const {}
    __device__ __forceinline__ void done(const Unit&) const {}
};

template <class Epi, class Sched, bool ALIGN_EPI = false, bool SP2 = false>
__device__ __forceinline__ void gemm_phase(PG8_LAS unsigned char* lds, const Gemm g, const Sched& S, const Epi& E, int wv) {
    const int tid = get_tid(wv), wid = __builtin_amdgcn_readfirstlane(tid >> 6), lane = tid & 63, wr = wid >> 2, wc = wid & 3, fr = lane & 15, fq = lane >> 4;
    const int K = g.K, nt = K / BK;
    unsigned voffA[2], voffB[2];
#pragma unroll
    for (int i = 0; i < 2; ++i) { int R, C; stage_rc(tid * 16 + i * 8192, R, C); const int Rb = Epi::PERM ? ((R & ~31) + perm32(R & 31)) : R;
        voffA[i] = (unsigned)(R * g.lda + C) * 2u; voffB[i] = (unsigned)(Rb * K + C) * 2u; }
    const size_t kstep = (size_t)(BK * 2);
    const size_t hstepA = (size_t)HALF * g.lda * 2, hstepB = (size_t)HALF * K * 2;
    const size_t tstepA = 2 * hstepA, tstepB = 2 * hstepB;
    const unsigned ldsw = (unsigned)wid * 1024u;
    const int aoff = lds_byte(wr * 64 + fr, fq * 8), boff = lds_byte(wc * 32 + fr, fq * 8);
#define PG8_SA(b, h) (((b) * 2 + (h)) * HTB)
#define PG8_SB(b, h) ((4 + (b) * 2 + (h)) * HTB)
#define PG8_STAGE(bufoff, gbase, voff) do { _Pragma("unroll") for (int _i = 0; _i < 2; ++_i) \
        __builtin_amdgcn_global_load_lds((const unsigned*)((const char*)(gbase) + (voff)[_i]), (PG8_LAS unsigned*)(lds + (bufoff) + ldsw + _i * 8192), 16, 0, 0); } while (0)
#define PG8_LDA(dst, b, h) do { _Pragma("unroll") for (int m = 0; m < 4; ++m) _Pragma("unroll") for (int k = 0; k < 2; ++k) dst[m][k] = *(const PG8_LAS bf16x8*)(lds + PG8_SA(b, h) + aoff + m * 2048 + k * 1024); } while (0)
#define PG8_LDB(dst, b, h) do { _Pragma("unroll") for (int n = 0; n < 2; ++n) _Pragma("unroll") for (int k = 0; k < 2; ++k) dst[n][k] = *(const PG8_LAS bf16x8*)(lds + PG8_SB(b, h) + boff + n * 2048 + k * 1024); } while (0)
#define PG8_MMA(ai, bj, At, Bt) do { __builtin_amdgcn_s_setprio(1); _Pragma("unroll") for (int m = 0; m < 4; ++m) _Pragma("unroll") for (int n = 0; n < 2; ++n) _Pragma("unroll") for (int k = 0; k < 2; ++k) \
        acc[ai][bj][m][n] = __builtin_amdgcn_mfma_f32_16x16x32_bf16(Bt[n][k], At[m][k], acc[ai][bj][m][n], 0, 0, 0); __builtin_amdgcn_s_setprio(0); } while (0)
#define PG8_WAIT_V(n) asm volatile("s_waitcnt vmcnt(" #n ")" ::: "memory")
#define PG8_WAIT_L(n) asm volatile("s_waitcnt lgkmcnt(" #n ")" ::: "memory")
#define PG8_BAR __builtin_amdgcn_s_barrier()
#define PG8_SCHED __builtin_amdgcn_sched_barrier(0)
    Unit cur, nxt; int ui = 0;
    if (!S.next(0, cur)) return;
    f32x4 acc[2][2][4][2];
#pragma unroll
    for (int a = 0; a < 2; ++a)
#pragma unroll
        for (int b = 0; b < 2; ++b)
#pragma unroll
            for (int m = 0; m < 4; ++m)
#pragma unroll
                for (int n = 0; n < 2; ++n) acc[a][b][m][n] = (f32x4){0.f, 0.f, 0.f, 0.f};
    bf16x8 At[4][2], B0[2][2], B1[2][2];
    const char* cA = (const char*)g.A + (size_t)cur.pm * tstepA; const char* cB = (const char*)g.Bt + (size_t)cur.pn * tstepB;
    S.a_ready(cur);
    if constexpr (SP2) {
        PG8_STAGE(PG8_SB(0, 0), cB, voffB); PG8_STAGE(PG8_SB(0, 1), cB + hstepB, voffB); PG8_STAGE(PG8_SA(0, 0), cA, voffA); PG8_STAGE(PG8_SA(0, 1), cA + hstepA, voffA);
        if (wr == 1) PG8_BAR;
        PG8_WAIT_V(2); PG8_BAR;
        PG8_STAGE(PG8_SB(1, 0), cB + kstep, voffB); PG8_STAGE(PG8_SA(1, 0), cA + kstep, voffA); PG8_STAGE(PG8_SB(1, 1), cB + hstepB + kstep, voffB);
        PG8_WAIT_V(6); PG8_BAR;
    } else {
        PG8_STAGE(PG8_SB(0, 0), cB, voffB); PG8_STAGE(PG8_SA(0, 0), cA, voffA); PG8_STAGE(PG8_SB(0, 1), cB + hstepB, voffB); PG8_STAGE(PG8_SA(0, 1), cA + hstepA, voffA);
        if (wr == 1) PG8_BAR;
        PG8_WAIT_V(4); PG8_BAR;
        PG8_STAGE(PG8_SB(1, 0), cB + kstep, voffB); PG8_STAGE(PG8_SA(1, 0), cA + kstep, voffA); PG8_STAGE(PG8_SB(1, 1), cB + hstepB + kstep, voffB);
        PG8_WAIT_V(6); PG8_BAR;
    }
    for (;;) {
        const bool has_next = S.next(ui + 1, nxt);
        const char* nA = has_next ? (const char*)g.A + (size_t)nxt.pm * tstepA : cA; const char* nB = has_next ? (const char*)g.Bt + (size_t)nxt.pn * tstepB : cB;
        for (int t = 0; t < nt; t += 2) {
            const bool last = (t == nt - 2);
            const char* a1 = cA + (size_t)(t + 1) * kstep;
            const char* a2 = last ? nA : cA + (size_t)(t + 2) * kstep; const char* b2 = last ? nB : cB + (size_t)(t + 2) * kstep;
            const char* a3 = a2 + kstep; const char* b3 = b2 + kstep;
            if (last && has_next) S.a_ready(nxt);
            if constexpr (SP2) {
            PG8_LDB(B0, 0, 0); PG8_LDB(B1, 0, 1); PG8_SCHED; PG8_LDA(At, 0, 0); PG8_STAGE(PG8_SA(1, 1), a1 + hstepA, voffA);
            PG8_WAIT_V(8); PG8_WAIT_L(0); PG8_BAR; PG8_MMA(0, 0, At, B0); PG8_MMA(0, 1, At, B1); PG8_BAR; PG8_SCHED;
            PG8_LDA(At, 0, 1); PG8_STAGE(PG8_SB(0, 0), b2, voffB); PG8_STAGE(PG8_SB(0, 1), b2 + hstepB, voffB); PG8_STAGE(PG8_SA(0, 0), a2, voffA);
            PG8_WAIT_V(8); PG8_WAIT_L(0); PG8_BAR; PG8_MMA(1, 0, At, B0); PG8_MMA(1, 1, At, B1); PG8_BAR; PG8_SCHED;
            PG8_LDB(B0, 1, 0); PG8_LDB(B1, 1, 1); PG8_SCHED; PG8_LDA(At, 1, 0); PG8_STAGE(PG8_SA(0, 1), a2 + hstepA, voffA);
            PG8_WAIT_V(8); PG8_WAIT_L(0); PG8_BAR; PG8_MMA(0, 0, At, B0); PG8_MMA(0, 1, At, B1); PG8_BAR; PG8_SCHED;
            PG8_LDA(At, 1, 1); PG8_STAGE(PG8_SB(1, 0), b3, voffB); PG8_STAGE(PG8_SB(1, 1), b3 + hstepB, voffB); PG8_STAGE(PG8_SA(1, 0), a3, voffA);
            PG8_WAIT_V(8); PG8_WAIT_L(0); PG8_BAR; PG8_MMA(1, 0, At, B0); PG8_MMA(1, 1, At, B1); PG8_BAR; PG8_SCHED;
            } else {
            PG8_LDB(B0, 0, 0); PG8_SCHED; PG8_LDA(At, 0, 0); PG8_STAGE(PG8_SA(1, 1), a1 + hstepA, voffA);
            PG8_WAIT_L(8); PG8_BAR; PG8_WAIT_L(0); PG8_MMA(0, 0, At, B0); PG8_BAR; PG8_SCHED;
            PG8_LDB(B1, 0, 1); PG8_STAGE(PG8_SB(0, 0), b2, voffB);
            PG8_BAR; PG8_WAIT_L(0); PG8_MMA(0, 1, At, B1); PG8_BAR;
            PG8_LDA(At, 0, 1); PG8_STAGE(PG8_SA(0, 0), a2, voffA);
            PG8_BAR; PG8_WAIT_L(0); PG8_MMA(1, 0, At, B0); PG8_BAR; PG8_SCHED;
            PG8_STAGE(PG8_SB(0, 1), b2 + hstepB, voffB);
            PG8_WAIT_V(6); PG8_BAR; PG8_MMA(1, 1, At, B1); PG8_BAR;
            PG8_LDB(B0, 1, 0); PG8_SCHED; PG8_LDA(At, 1, 0); PG8_STAGE(PG8_SA(0, 1), a2 + hstepA, voffA);
            PG8_WAIT_L(8); PG8_BAR; PG8_WAIT_L(0); PG8_MMA(0, 0, At, B0); PG8_BAR; PG8_SCHED;
            PG8_LDB(B1, 1, 1); PG8_STAGE(PG8_SB(1, 0), b3, voffB);
            PG8_BAR; PG8_WAIT_L(0); PG8_MMA(0, 1, At, B1); PG8_BAR;
            PG8_LDA(At, 1, 1); PG8_STAGE(PG8_SA(1, 0), a3, voffA);
            PG8_BAR; PG8_WAIT_L(0); PG8_MMA(1, 0, At, B0); PG8_BAR; PG8_SCHED;
            PG8_STAGE(PG8_SB(1, 1), b3 + hstepB, voffB);
            PG8_WAIT_V(6); PG8_BAR; PG8_MMA(1, 1, At, B1); PG8_BAR;
            }
        }
        if constexpr (ALIGN_EPI) { if (wr == 0) PG8_BAR; }
        if constexpr (!Epi::AFTER_DRAIN) { E(acc, cur, wr, wc, fr, fq); S.done(cur); }
        if (!has_next) break;
#pragma unroll
        for (int a = 0; a < 2; ++a)
#pragma unroll
            for (int b = 0; b < 2; ++b)
#pragma unroll
                for (int m = 0; m < 4; ++m)
#pragma unroll
                    for (int n = 0; n < 2; ++n) acc[a][b][m][n] = (f32x4){0.f, 0.f, 0.f, 0.f};
        cur = nxt; cA = nA; cB = nB; ++ui;
        if constexpr (ALIGN_EPI) { if (wr == 1) PG8_BAR; }
    }
    PG8_WAIT_V(0);
    if constexpr (!ALIGN_EPI) { if (wr == 0) PG8_BAR; }
    PG8_BAR;
    if constexpr (Epi::AFTER_DRAIN) { E.fused(acc, cur, wr, wc, fr, fq, lds, wid, lane); S.done(cur); }
#undef PG8_SA
#undef PG8_SB
#undef PG8_STAGE
#undef PG8_LDA
#undef PG8_LDB
#undef PG8_MMA
#undef PG8_WAIT_V
#undef PG8_WAIT_L
#undef PG8_BAR
#undef PG8_SCHED
}
}

typedef unsigned short bf16_t;
typedef short bf16x8 __attribute__((ext_vector_type(8)));
typedef short s16x4 __attribute__((ext_vector_type(4)));
typedef float f32x4 __attribute__((ext_vector_type(4)));
typedef float f32x16 __attribute__((ext_vector_type(16)));
typedef unsigned u32x4 __attribute__((ext_vector_type(4)));
typedef unsigned u32x2 __attribute__((ext_vector_type(2)));
typedef float f32x2 __attribute__((ext_vector_type(2)));

constexpr int DM = 1024, NB = 8, SEQ = 2048, CTXL = 256, LT = SEQ + CTXL  , MROWS = NB * LT  ;
constexpr int EVEN_IN = 4608, ODD_IN = 5120, NCHUNK = LT / 64  ;
constexpr float RMS_EPS = 1e-6f, LOG2E = 1.4426950408889634f;
constexpr int LDS_BYTES = 160 * 1024;
constexpr int NPHASE = 21;

constexpr size_t WS_CTL = 0;
constexpr size_t WS_MOD = 65536;
constexpr size_t WS_ROPE = 524288;
constexpr size_t WS_AGG = 1048576;
constexpr size_t WS_HCTX = WS_AGG + 4718592;
constexpr size_t WS_WIN = WS_HCTX + 8388608;
constexpr size_t WS_WOUT = WS_WIN + 10485760;
constexpr size_t WS_WRG = WS_WOUT + 4194304;
constexpr size_t WS_OV = WS_WRG + 1048576;
constexpr size_t WS_P = WS_OV + 37748736;
constexpr size_t WS_END = WS_P + 188743680;
static_assert(WS_END <= 268435456, "workspace map exceeds 256 MiB");

struct Params {
    const float *x, *c, *ctx, *c_ctx, *ada_w, *ada_b, *norm_w, *ev_w_in, *ev_conv_w, *ev_conv_b, *ev_rg_wx, *ev_rg_bx, *ev_rg_wa, *ev_rg_ba,
        *ev_rg_lambda, *ev_sink, *ev_w_out, *od_w_in, *od_lb_raw, *od_gnorm_w, *od_w_out, *final_norm_w;
    float* out; unsigned char* ws; int ph_lo, ph_hi;
};

DI float bf2f(unsigned short v) { return __uint_as_float((unsigned)v << 16); }
DI unsigned f2bf(float f) { unsigned u = __float_as_uint(f); return (u + 0x7fffu + ((u >> 16) & 1u)) >> 16; }
typedef __bf16 bf16x2_hw __attribute__((ext_vector_type(2)));
DI unsigned pk2(float lo, float hi) { const f32x2 v = {lo, hi}; return __builtin_bit_cast(unsigned, __builtin_convertvector(v, bf16x2_hw)); }
DI float sigm(float x) { return __builtin_amdgcn_rcpf(1.f + __expf(-x)); }
DI float softplus_neg(float lam) {
    const float e = __expf(-lam);
    return e < 0.06f ? e * (1.f + e * (-0.5f + e * (0.33333333f + e * (-0.25f + e * 0.2f)))) : __logf(1.f + e);
}
DI float neg_expm1(float x) {
    return x > -0.25f ? -x * (1.f + x * (0.5f + x * (0.16666667f + x * (0.041666668f + x * (0.0083333338f + x * 0.0013888889f))))) : 1.f - __expf(x);
}
DI float wave_sum(float v) {
#pragma unroll
    for (int o = 1; o < 64; o <<= 1) v += shfl_xor_f(v, o);
    return v;
}
DI int crow(int reg, int h) { return (reg & 3) + 8 * (reg >> 2) + 4 * h; }
#define MFMA16(a, b, c) __builtin_amdgcn_mfma_f32_16x16x32_bf16((a), (b), (c), 0, 0, 0)
#define MFMA32(a, b, c) __builtin_amdgcn_mfma_f32_32x32x16_bf16((a), (b), (c), 0, 0, 0)

struct EpiStoreBf16 {
    static constexpr bool PERM = true, AFTER_DRAIN = false;
    bf16_t* O; int ldc;
    DI void operator()(const f32x4 (&acc)[2][2][4][2], const pg8::Unit& u, int wr, int wc, int fr, int fq) const {
        const int row0 = u.pm * 256 + wr * 64 + fr, col0 = u.pn * 256 + wc * 32 + 8 * fq;
#pragma unroll
        for (int ai = 0; ai < 2; ++ai)
#pragma unroll
            for (int m = 0; m < 4; ++m) { bf16_t* rowp = O + (size_t)(row0 + ai * 128 + m * 16) * ldc + col0;
#pragma unroll
                for (int bj = 0; bj < 2; ++bj) { const f32x4 v0 = acc[ai][bj][m][0], v1 = acc[ai][bj][m][1];
                    u32x4 w; w.x = pk2(v0[0], v0[1]); w.y = pk2(v0[2], v0[3]); w.z = pk2(v1[0], v1[1]); w.w = pk2(v1[2], v1[3]);
                    *(u32x4*)(rowp + bj * 128) = w; } }
    }
};
struct EpiResid {
    static constexpr bool PERM = false, AFTER_DRAIN = false;
    const float* in_lat; const float* in_ctx; float* out_lat; float* out_ctx; const float* gate;
    DI void operator()(const f32x4 (&acc)[2][2][4][2], const pg8::Unit& u, int wr, int wc, int fr, int fq) const {
        const int b = u.pm / 9, jt = u.pm % 9;
        const float* ib; float* ob; const float* g;
        if (jt == 0) { const size_t off = (size_t)b * CTXL * DM; ib = in_ctx + off; ob = out_ctx + off; g = gate + 8 * 3072; }
        else { const size_t off = ((size_t)b * SEQ + (size_t)(jt - 1) * 256) * DM; ib = in_lat + off; ob = out_lat + off; g = gate + b * 3072; }
        const int col0 = u.pn * 256 + wc * 32 + 4 * fq;
#pragma unroll
        for (int bj = 0; bj < 2; ++bj)
#pragma unroll
            for (int n = 0; n < 2; ++n) {
                const f32x4 gvv = *(const f32x4*)(g + col0 + bj * 128 + n * 16);
#pragma unroll
                for (int ai = 0; ai < 2; ++ai) {
#pragma unroll
                    for (int m = 0; m < 4; ++m) { const int r = ai * 128 + wr * 64 + m * 16 + fr;
                        const size_t off = (size_t)r * DM + col0 + bj * 128 + n * 16;
                        const f32x4 o = *(const f32x4*)(ib + off) + gvv * acc[ai][bj][m][n]; *(f32x4*)(ob + off) = o; }
                    asm volatile("" ::: "memory");
                }
            }
    }
};

struct EpiResidNorm {
    static constexpr bool PERM = false, AFTER_DRAIN = true;
    const float* in_lat; float* out_lat; const float* gate;
    const float* nw; const float* mod_next;
    bf16_t* U; float* xbuf; unsigned* cnt;
    DI void fused(f32x4 (&acc)[2][2][4][2], const pg8::Unit& u, int wr, int wc, int fr, int fq, LAS unsigned char* lds, int wid, int lane) const {
        const int b = u.pm / 9, jt = u.pm % 9, panel = b * 8 + jt - 1;
        const size_t roff = ((size_t)b * SEQ + (size_t)(jt - 1) * 256) * DM;
        const float* ib = in_lat + roff; float* ob = out_lat + roff; const float* g = gate + b * 3072;
        const int col0 = u.pn * 256 + wc * 32 + 4 * fq;
        LAS float* Pw = (LAS float*)lds;
        LAS float* Sr = (LAS float*)(lds + 4096);
        LAS unsigned* flag = (LAS unsigned*)(lds + 5120);
#pragma unroll
        for (int bj = 0; bj < 2; ++bj)
#pragma unroll
            for (int n = 0; n < 2; ++n) {
                const f32x4 gvv = *(const f32x4*)(g + col0 + bj * 128 + n * 16);
#pragma unroll
                for (int ai = 0; ai < 2; ++ai) {
#pragma unroll
                    for (int m = 0; m < 4; ++m) { const int r = ai * 128 + wr * 64 + m * 16 + fr;
                        const size_t off = (size_t)r * DM + col0 + bj * 128 + n * 16;
                        const f32x4 o = *(const f32x4*)(ib + off) + gvv * acc[ai][bj][m][n]; acc[ai][bj][m][n] = o;
                        if (mod_next) *(f32x4*)(ob + off) = o; }
                    asm volatile("" ::: "memory");
                }
            }
#pragma unroll
        for (int ai = 0; ai < 2; ++ai)
#pragma unroll
            for (int m = 0; m < 4; ++m) {
                float s = 0.f;
#pragma unroll
                for (int bj = 0; bj < 2; ++bj)
#pragma unroll
                    for (int n = 0; n < 2; ++n) { const f32x4 x = acc[ai][bj][m][n]; s += (x[0] * x[0] + x[1] * x[1]) + (x[2] * x[2] + x[3] * x[3]); }
                s += shfl_xor_f(s, 16); s += shfl_xor_f(s, 32);
                if (fq == 0) Pw[(ai * 128 + wr * 64 + m * 16 + fr) * 4 + wc] = s;
            }
        asm volatile("s_waitcnt lgkmcnt(0)" ::: "memory"); __builtin_amdgcn_s_barrier(); asm volatile("" ::: "memory");
        const int row = wid * 32 + (lane & 31);
        if (lane < 32) {
            const float t = (Pw[row * 4 + 0] + Pw[row * 4 + 1]) + (Pw[row * 4 + 2] + Pw[row * 4 + 3]);
            __hip_atomic_store((unsigned*)xbuf + ((size_t)panel * 256 + row) * 4 + u.pn, __float_as_uint(t), __ATOMIC_RELAXED, __HIP_MEMORY_SCOPE_AGENT);
        }
        asm volatile("s_waitcnt vmcnt(0)" ::: "memory");
        if (lane == 0) __hip_atomic_fetch_add(cnt + 16 * panel, 1u, __ATOMIC_RELAXED, __HIP_MEMORY_SCOPE_AGENT);
        if (wid == 0) {
            unsigned spins = 0;
            while ((unsigned)__builtin_amdgcn_readfirstlane(__hip_atomic_load(cnt + 16 * panel, __ATOMIC_RELAXED, __HIP_MEMORY_SCOPE_AGENT)) < 32u) { __builtin_amdgcn_s_sleep(2); if (++spins > (1u << 22)) break; }
            if (lane == 0) flag[0] = 1u;
        }
        asm volatile("s_waitcnt vmcnt(0) lgkmcnt(0)" ::: "memory"); __builtin_amdgcn_s_barrier(); asm volatile("" ::: "memory");
        if (lane < 32) {
            const unsigned* slot = (const unsigned*)xbuf + ((size_t)panel * 256 + row) * 4;
            const float t = (__uint_as_float(__hip_atomic_load(slot + 0, __ATOMIC_RELAXED, __HIP_MEMORY_SCOPE_AGENT)) + __uint_as_float(__hip_atomic_load(slot + 1, __ATOMIC_RELAXED, __HIP_MEMORY_SCOPE_AGENT)))
                          + (__uint_as_float(__hip_atomic_load(slot + 2, __ATOMIC_RELAXED, __HIP_MEMORY_SCOPE_AGENT)) + __uint_as_float(__hip_atomic_load(slot + 3, __ATOMIC_RELAXED, __HIP_MEMORY_SCOPE_AGENT)));
            Sr[row] = rsqrtf(t * (1.f / DM) + RMS_EPS);
        }
        asm volatile("s_waitcnt lgkmcnt(0)" ::: "memory"); __builtin_amdgcn_s_barrier(); asm volatile("" ::: "memory");
        const float* sh = mod_next ? mod_next + b * 3072 : nullptr;
#pragma unroll
        for (int bj = 0; bj < 2; ++bj)
#pragma unroll
            for (int n = 0; n < 2; ++n) {
                const int cc = col0 + bj * 128 + n * 16;
                const f32x4 w4 = *(const f32x4*)(nw + cc);
                f32x4 s4 = {1.f, 1.f, 1.f, 1.f}, h4 = {0.f, 0.f, 0.f, 0.f};
                if (mod_next) { s4 = *(const f32x4*)(sh + 1024 + cc) + 1.f; h4 = *(const f32x4*)(sh + cc); }
#pragma unroll
                for (int ai = 0; ai < 2; ++ai)
#pragma unroll
                    for (int m = 0; m < 4; ++m) { const int r = ai * 128 + wr * 64 + m * 16 + fr;
                        const f32x4 y = (acc[ai][bj][m][n] * Sr[r]) * w4;
                        if (mod_next) { const f32x4 o = y * s4 + h4; u32x2 w; w.x = pk2(o[0], o[1]); w.y = pk2(o[2], o[3]); *(u32x2*)(U + ((size_t)u.pm * 256 + r) * DM + cc) = w; }
                        else *(f32x4*)(ob + (size_t)r * DM + cc) = y; }
            }
    }
};

constexpr int MG_STAGE = 27648;
template <class EpiF>
DI void mini_gemm_tile(LAS unsigned char* lds, const bf16_t* A, int lda, const bf16_t* Bt, int K, const EpiF& epi, int wv) {
    const int tid = get_tid(wv), lane = tid & 63, wave = tid >> 6, r = lane & 31, h = lane >> 5, wm = wave >> 2, wn = wave & 3;
    const int lrow = tid >> 3, lch = tid & 7, nS = K / 64;
    const bf16_t* ap = A + (size_t)lrow * lda + 8 * lch;
    const bf16_t* bp0 = Bt + (size_t)lrow * K + 8 * lch; const bf16_t* bp1 = Bt + (size_t)(64 + lrow) * K + 8 * lch;
    u32x4 s0[3], s1[3];
    f32x16 acc;
#pragma unroll
    for (int i = 0; i < 16; ++i) acc[i] = 0.f;
#define MG_LOAD(set, s) do { (set)[0] = *(const u32x4*)(ap + (s) * 64); (set)[1] = *(const u32x4*)(bp0 + (s) * 64); (set)[2] = *(const u32x4*)(bp1 + (s) * 64); } while (0)
#define MG_STORE(set, buf) do { LAS unsigned char* b_ = lds + (buf) * MG_STAGE; *(LAS u32x4*)(b_ + lrow * 144 + lch * 16) = (set)[0]; \
        *(LAS u32x4*)(b_ + 9216 + lrow * 144 + lch * 16) = (set)[1]; *(LAS u32x4*)(b_ + 9216 + (64 + lrow) * 144 + lch * 16) = (set)[2]; } while (0)
#define MG_COMPUTE(buf) do { const LAS unsigned char* b_ = lds + (buf) * MG_STAGE; \
        _Pragma("unroll") for (int ks = 0; ks < 4; ++ks) { \
            const bf16x8 af = *(const LAS bf16x8*)(b_ + (32 * wm + r) * 144 + (16 * ks + 8 * h) * 2); \
            const bf16x8 bf = *(const LAS bf16x8*)(b_ + 9216 + (32 * wn + r) * 144 + (16 * ks + 8 * h) * 2); \
            acc = MFMA32(af, bf, acc); } } while (0)
    MG_LOAD(s0, 0); MG_LOAD(s1, 1);
    __syncthreads();
    MG_STORE(s0, 0);
    if (nS > 2) MG_LOAD(s0, 2);
#pragma unroll 1
    for (int s = 0; s < nS; s += 2) {
        __syncthreads();
        if (s + 1 < nS) { MG_STORE(s1, 1); if (s + 3 < nS) MG_LOAD(s1, s + 3); }
        MG_COMPUTE(0);
        __syncthreads();
        if (s + 2 < nS) { MG_STORE(s0, 0); if (s + 4 < nS) MG_LOAD(s0, s + 4); }
        if (s + 1 < nS) MG_COMPUTE(1);
    }
#undef MG_LOAD
#undef MG_STORE
#undef MG_COMPUTE
    epi(acc, 32 * wm, 32 * wn + r, h);
    __syncthreads();
}

DI void phase_pro(const Params& P, LAS unsigned char* lds, int wv) {
    const int tid = get_tid(wv);
    LAS float* s = (LAS float*)lds;
    LAS float* red = (LAS float*)(lds + 36864);
    float* mod = (float*)(P.ws + WS_MOD);
    for (int i = tid; i < 9 * 1024; i += 512) { const int r = i >> 10, k = i & 1023; const float v = r < 8 ? P.c[r * 1024 + k] : P.c_ctx[k]; s[i] = v * sigm(v); }
    __syncthreads();
    for (int item = get_bid(); item < 384; item += gridDim.x) {
        const int l = item / 96, n0 = (item % 96) * 32, ks = tid >> 5, col = tid & 31;
        const float* w = P.ada_w + (size_t)l * 1024 * 3072 + n0 + col;
        float acc[9];
#pragma unroll
        for (int r = 0; r < 9; ++r) acc[r] = 0.f;
#pragma unroll 8
        for (int kk = 0; kk < 64; ++kk) { const int k = ks * 64 + kk; const float wv = w[(size_t)k * 3072];
#pragma unroll
            for (int r = 0; r < 9; ++r) acc[r] += s[r * 1024 + k] * wv; }
#pragma unroll
        for (int r = 0; r < 9; ++r) red[(ks * 9 + r) * 32 + col] = acc[r];
        __syncthreads();
        if (tid < 288) { const int r = tid >> 5, cc = tid & 31; float sum = 0.f;
#pragma unroll
            for (int k2 = 0; k2 < 16; ++k2) sum += red[(k2 * 9 + r) * 32 + cc];
            mod[(l * 9 + r) * 3072 + n0 + cc] = sum + P.ada_b[l * 3072 + n0 + cc]; }
        __syncthreads();
    }
    float* cos_t = (float*)(P.ws + WS_ROPE); float* sin_t = cos_t + SEQ * 32;
    for (int i = get_bid() * 512 + tid; i < SEQ * 32; i += gridDim.x * 512) {
        const int pos = i >> 5, jj = i & 31, fi = jj & 15;
        const float inv = __builtin_amdgcn_exp2f(-(float)(2 * fi) * (13.287712379549449f / 32.f));
        const float ang = (float)(jj < 16 ? (pos >> 6) : (pos & 63)) * inv;
        cos_t[i] = __cosf(ang); sin_t[i] = __sinf(ang);
    }
}

template <bool FRAG = false>
DI void transpose_item(const float* W, int K, int N, bf16_t* WT, LAS float* scr, int item, int lane) {
    const int nblk = N / 32, kb = item / nblk, nb = item % nblk, k0 = 64 * kb, n0 = 32 * nb;
#pragma unroll 8
    for (int i = 0; i < 32; ++i) { const int kk = 2 * i + (lane >> 5); scr[kk * 33 + (lane & 31)] = W[(size_t)(k0 + kk) * N + n0 + (lane & 31)]; }
    asm volatile("s_waitcnt lgkmcnt(0)" ::: "memory");
    const int c = lane & 7;
#pragma unroll
    for (int j = 0; j < 4; ++j) { const int n = (lane >> 3) + 8 * j; const LAS float* sp = scr + (8 * c) * 33 + n;
        u32x4 o; o.x = pk2(sp[0 * 33], sp[1 * 33]); o.y = pk2(sp[2 * 33], sp[3 * 33]); o.z = pk2(sp[4 * 33], sp[5 * 33]); o.w = pk2(sp[6 * 33], sp[7 * 33]);
        if (FRAG) {
            const int nn = n0 + n, k8 = (k0 >> 3) + c;
            *(u32x4*)(WT + ((((nn >> 4) * 4 + (k8 >> 2)) * 64 + (k8 & 3) * 16 + (nn & 15)) * 8)) = o;
        } else *(u32x4*)(WT + (size_t)(n0 + n) * K + k0 + 8 * c) = o; }
    asm volatile("s_waitcnt lgkmcnt(0)" ::: "memory");
}

DI void phase_norm(const Params& P, LAS unsigned char* lds, int layer, int wv) {
    const int tid = get_tid(wv), lane = tid & 63, wave = tid >> 6;
    const int gw = get_bid() * 8 + wave, NGW = gridDim.x * 8;
    const int j = layer >> 1;
    LAS float* scr = (LAS float*)(lds + wave * 16384);
    bf16_t* WIN = (bf16_t*)(P.ws + WS_WIN); bf16_t* WOUT = (bf16_t*)(P.ws + WS_WOUT); bf16_t* WRG = (bf16_t*)(P.ws + WS_WRG);
    if ((layer & 1) == 0) {
        constexpr int I_IN = 16 * (EVEN_IN / 32), I_OUT = 32 * 32, I_RG = 32 * 8;
        for (int it = gw; it < I_IN + I_OUT + I_RG; it += NGW) {
            int r = it;
            if (r < I_IN) { transpose_item(P.ev_w_in + (size_t)j * 1024 * EVEN_IN, 1024, EVEN_IN, WIN, scr, r, lane); continue; } r -= I_IN;
            if (r < I_OUT) { transpose_item(P.ev_w_out + (size_t)j * 2048 * 1024, 2048, 1024, WOUT, scr, r, lane); continue; } r -= I_OUT;
            const int mat = r >> 3, sub = r & 7;
            const int dir = mat >> 4, gate = (mat >> 3) & 1, hd = mat & 7;
            const float* src = (gate == 0 ? P.ev_rg_wx : P.ev_rg_wa) + ((size_t)((j * 2 + dir) * 8 + hd)) * 16384;
            transpose_item<true>(src, 128, 128, WRG + (size_t)mat * 16384, scr, sub, lane);
        }
    } else {
        constexpr int I_IN = 16 * (ODD_IN / 32), I_OUT = 16 * 32;
        for (int it = gw; it < I_IN + I_OUT; it += NGW) {
            int r = it;
            if (r < I_IN) { transpose_item(P.od_w_in + (size_t)j * 1024 * ODD_IN, 1024, ODD_IN, WIN, scr, r, lane); continue; } r -= I_IN;
            transpose_item(P.od_w_out + (size_t)j * 1024 * 1024, 1024, 1024, WOUT, scr, r, lane);
        }
    }
    const float* hl = layer == 0 ? P.x : P.out; const float* hc = layer == 0 ? P.ctx : (const float*)(P.ws + WS_HCTX);
    const float* mod = (const float*)(P.ws + WS_MOD) + (size_t)layer * 9 * 3072;
    const float* nw = P.norm_w + layer * 1024;
    bf16_t* U = (bf16_t*)(P.ws + WS_OV);
    f32x4 w4[4], s4[4], h4[4];
#pragma unroll
    for (int q = 0; q < 4; ++q) w4[q] = *(const f32x4*)(nw + 4 * lane + 256 * q);
    int cur_m = -1;
    const int nrows = layer == 0 ? MROWS : NB * CTXL;
    const int rpw = (nrows + NGW - 1) / NGW;
    for (int idx = gw * rpw; idx < gw * rpw + rpw && idx < nrows; ++idx) {
        const int b = layer == 0 ? idx / LT : idx >> 8, jr = layer == 0 ? idx % LT : idx & 255;
        const int R = b * LT + jr;
        const float* src = jr < CTXL ? hc + ((size_t)b * CTXL + jr) * DM : hl + ((size_t)b * SEQ + (jr - CTXL)) * DM;
        const int mrow = jr < CTXL ? 8 : b;
        if (mrow != cur_m) {
            cur_m = mrow;
            const float* sh = mod + mrow * 3072; const float* sc = sh + 1024;
#pragma unroll
            for (int q = 0; q < 4; ++q) { s4[q] = *(const f32x4*)(sc + 4 * lane + 256 * q) + 1.f; h4[q] = *(const f32x4*)(sh + 4 * lane + 256 * q); }
        }
        f32x4 v[4]; float ss = 0.f;
#pragma unroll
        for (int q = 0; q < 4; ++q) { v[q] = *(const f32x4*)(src + 4 * lane + 256 * q); ss += (v[q][0] * v[q][0] + v[q][1] * v[q][1]) + (v[q][2] * v[q][2] + v[q][3] * v[q][3]); }
        const float rstd = rsqrtf(wave_sum(ss) * (1.f / DM) + RMS_EPS);
#pragma unroll
        for (int q = 0; q < 4; ++q) { const int k = 4 * lane + 256 * q;
            const f32x4 y = (v[q] * rstd) * w4[q]; const f32x4 o = y * s4[q] + h4[q];
            u32x2 w; w.x = pk2(o[0], o[1]); w.y = pk2(o[2], o[3]); *(u32x2*)(U + (size_t)R * DM + k) = w; }
    }
}

typedef _Float16 f16x2_t __attribute__((ext_vector_type(2)));
DI unsigned pkh2(float a, float b) { const f16x2_t v = {(_Float16)a, (_Float16)b}; return __builtin_bit_cast(unsigned, v); }
DI void unpkh2(unsigned u, float& a, float& b) { const f16x2_t v = __builtin_bit_cast(f16x2_t, u); a = (float)v[0]; b = (float)v[1]; }
constexpr int RG_UT = 0, RG_AL = 17408, RG_BL = 50176, RG_HP = 82944, RG_QA = 148480, RG_CAR = 152576, RG_FLAG = 153600, RG_END = 153664;
static_assert(RG_END <= LDS_BYTES - 256, "RG-LRU LDS map");
constexpr int CW_RG = 8192;
DI void rglru_item(const Params& P, LAS unsigned char* lds, int j, int item, int wv) {
    const int tid = get_tid(wv), lane = tid & 63, wave = tid >> 6, r = lane & 15, g = lane >> 4;
    const int grp = item / NCHUNK, ci = item % NCHUNK, b = grp >> 3, hd = grp & 7;
    bf16_t* p = (bf16_t*)(P.ws + WS_P);
    const bf16_t* WRG = (const bf16_t*)(P.ws + WS_WRG);
    unsigned long long* AGG = (unsigned long long*)(P.ws + WS_AGG);
    unsigned* cnt = (unsigned*)(P.ws + WS_CTL) + CW_RG + (j * 64 + grp) * 16;
    const int R0 = b * LT + ci * 64;
    const int seg_lo = b * LT + (ci < 4 ? 0 : CTXL), seg_hi = b * LT + (ci < 4 ? CTXL : LT);
    LAS bf16_t* UT = (LAS bf16_t*)(lds + RG_UT);
    LAS float* AL = (LAS float*)(lds + RG_AL);
    LAS float* BL = (LAS float*)(lds + RG_BL);
    LAS unsigned* HP = (LAS unsigned*)(lds + RG_HP);
    LAS float* QA = (LAS float*)(lds + RG_QA);
    LAS float* CAR = (LAS float*)(lds + RG_CAR);
    TP_START(10, lds, tid); TP_START(11, lds, tid);
    bf16x8 wfr[2][2][4];
    float prm[2][3];
#pragma unroll
    for (int dir = 0; dir < 2; ++dir) {
#pragma unroll
        for (int gt = 0; gt < 2; ++gt) {
            const bf16_t* W = WRG + (size_t)((dir * 2 + gt) * 8 + hd) * 16384 + (wave * 4 * 64 + lane) * 8;
#pragma unroll
            for (int ks = 0; ks < 4; ++ks) wfr[dir][gt][ks] = *(const bf16x8*)(W + ks * 512);
        }
        const int idx = (j * 2 + dir) * 1024 + hd * 128 + 16 * wave + r;
        prm[dir][0] = P.ev_rg_bx[idx]; prm[dir][1] = P.ev_rg_ba[idx]; prm[dir][2] = P.ev_rg_lambda[idx];
    }
    {
        LAS bf16_t* XT = (LAS bf16_t*)(lds + RG_HP);
#pragma unroll
        for (int rep = 0; rep < 3; ++rep) {
            const int idx = tid + rep * 512, tr = idx >> 4, c0 = (idx & 15) * 8;
            if (idx < 67 * 16) {
                const int Rg = R0 + tr - 1;
                u32x4 xv = {0u, 0u, 0u, 0u};
                if (Rg >= seg_lo && Rg < seg_hi) xv = *(const u32x4*)(p + (size_t)Rg * EVEN_IN + hd * 128 + c0);
                *(LAS u32x4*)(XT + tr * 128 + c0) = xv;
            }
        }
        const int c0 = (tid & 15) * 8, cg0 = hd * 128 + c0;
        float wv4[4][8], bias[8];
        { const f32x4 b0 = *(const f32x4*)(P.ev_conv_b + j * 1024 + cg0), b1 = *(const f32x4*)(P.ev_conv_b + j * 1024 + cg0 + 4);
          bias[0] = b0[0]; bias[1] = b0[1]; bias[2] = b0[2]; bias[3] = b0[3]; bias[4] = b1[0]; bias[5] = b1[1]; bias[6] = b1[2]; bias[7] = b1[3]; }
#pragma unroll
        for (int k = 0; k < 4; ++k) { const float* wk = P.ev_conv_w + (size_t)(j * 4 + k) * 1024 + cg0; const f32x4 w0 = *(const f32x4*)wk, w1 = *(const f32x4*)(wk + 4);
            wv4[k][0] = w0[0]; wv4[k][1] = w0[1]; wv4[k][2] = w0[2]; wv4[k][3] = w0[3]; wv4[k][4] = w1[0]; wv4[k][5] = w1[1]; wv4[k][6] = w1[2]; wv4[k][7] = w1[3]; }
        __syncthreads();
#pragma unroll
        for (int rep = 0; rep < 2; ++rep) {
            const int t = (tid >> 4) + rep * 32;
            float acc[8];
#pragma unroll
            for (int e = 0; e < 8; ++e) acc[e] = bias[e];
#pragma unroll
            for (int k = 0; k < 4; ++k) {
                const u32x4 xv = *(const LAS u32x4*)(XT + (t + k) * 128 + c0);
                acc[0] += wv4[k][0] * __uint_as_float(xv.x << 16); acc[1] += wv4[k][1] * __uint_as_float(xv.x & 0xffff0000u);
                acc[2] += wv4[k][2] * __uint_as_float(xv.y << 16); acc[3] += wv4[k][3] * __uint_as_float(xv.y & 0xffff0000u);
                acc[4] += wv4[k][4] * __uint_as_float(xv.z << 16); acc[5] += wv4[k][5] * __uint_as_float(xv.z & 0xffff0000u);
                acc[6] += wv4[k][6] * __uint_as_float(xv.w << 16); acc[7] += wv4[k][7] * __uint_as_float(xv.w & 0xffff0000u);
            }
            u32x4 o; o.x = pk2(acc[0], acc[1]); o.y = pk2(acc[2], acc[3]); o.z = pk2(acc[4], acc[5]); o.w = pk2(acc[6], acc[7]);
            *(LAS u32x4*)(UT + t * 136 + c0) = o;
        }
    }
    __syncthreads();
    TP_STOP(11, lds, tid);
#pragma unroll
    for (int dir = 0; dir < 2; ++dir) {
        TP_START(12, lds, tid); TP_START(16, lds, tid);
        f32x4 ax[4], aa[4];
#pragma unroll
        for (int m = 0; m < 4; ++m) { ax[m] = (f32x4){0.f, 0.f, 0.f, 0.f}; aa[m] = (f32x4){0.f, 0.f, 0.f, 0.f}; }
#pragma unroll
        for (int ks = 0; ks < 4; ++ks) {
#pragma unroll
            for (int m = 0; m < 4; ++m) {
                const bf16x8 a = *(const LAS bf16x8*)(UT + (16 * m + r) * 136 + 32 * ks + 8 * g);
                ax[m] = MFMA16(a, wfr[dir][0][ks], ax[m]); aa[m] = MFMA16(a, wfr[dir][1][ks], aa[m]);
            }
        }
        asm volatile("" :: "v"(ax[0]), "v"(ax[1]), "v"(ax[2]), "v"(ax[3]), "v"(aa[0]), "v"(aa[1]), "v"(aa[2]), "v"(aa[3]));
        TP_STOP(16, lds, tid); TP_START(17, lds, tid);
        {
            const int c = 16 * wave + r;
            const float bxv = prm[dir][0], bav = prm[dir][1], lam = prm[dir][2];
            const float sp = softplus_neg(lam);
#pragma unroll
            for (int m = 0; m < 4; ++m)
#pragma unroll
                for (int i = 0; i < 4; ++i) {
                    const int t = 16 * m + 4 * g + i;
                    const float gx = sigm(ax[m][i] + bxv), ga = sigm(aa[m][i] + bav);
                    const float la = -8.f * ga * sp;
                    const float a = __expf(la), mult = __builtin_amdgcn_sqrtf(neg_expm1(2.f * la));
                    const float uv = bf2f(UT[t * 136 + c]);
                    AL[t * 128 + c] = a; BL[t * 128 + c] = mult * gx * uv;
                }
        }
        asm volatile("s_waitcnt lgkmcnt(0)" ::: "memory");
        TP_STOP(17, lds, tid); TP_START(18, lds, tid);
        __syncthreads();
        TP_STOP(18, lds, tid);
        TP_STOP(12, lds, tid); TP_START(13, lds, tid);
        {
            const int c = tid & 127, q = tid >> 7;
            float A = 1.f, B = 0.f;
#pragma unroll
            for (int s = 0; s < 16; ++s) { const int t = dir == 0 ? 16 * q + s : 16 * q + 15 - s; const float a = AL[t * 128 + c], bb = BL[t * 128 + c]; B = a * B + bb; A *= a; }
            QA[(q * 128 + c) * 2] = A; QA[(q * 128 + c) * 2 + 1] = B;
            __syncthreads();
            float h = 0.f, pc = 1.f;
            const int nprev = dir == 0 ? q : 3 - q;
            for (int qq = 0; qq < nprev; ++qq) { const int qi = dir == 0 ? qq : 3 - qq; const float a = QA[(qi * 128 + c) * 2]; h = a * h + QA[(qi * 128 + c) * 2 + 1]; pc *= a; }
#pragma unroll
            for (int s = 0; s < 16; ++s) { const int t = dir == 0 ? 16 * q + s : 16 * q + 15 - s; const float a = AL[t * 128 + c]; h = a * h + BL[t * 128 + c]; pc *= a;
                HP[(dir * 64 + t) * 128 + c] = pkh2(h, pc); }
            if (nprev == 3) {
                const unsigned long long v = ((unsigned long long)__float_as_uint(h) << 32) | __float_as_uint(pc);
                __hip_atomic_store(AGG + ((size_t)(dir * NB + b) * NCHUNK + ci) * 1024 + hd * 128 + c, v, __ATOMIC_RELAXED, __HIP_MEMORY_SCOPE_AGENT);
            }
        }
        __syncthreads();
        TP_STOP(13, lds, tid);
    }
    TP_START(14, lds, tid);
    u32x4 gpre[2];
#pragma unroll
    for (int rep = 0; rep < 2; ++rep) { const int idx = tid + rep * 512; gpre[rep] = *(const u32x4*)(p + (size_t)(R0 + (idx >> 4)) * EVEN_IN + 1536 + hd * 128 + (idx & 15) * 8); }
    asm volatile("s_waitcnt vmcnt(0)" ::: "memory");
    __syncthreads();
    if (tid == 0) {
        __hip_atomic_fetch_add(cnt, 1u, __ATOMIC_RELAXED, __HIP_MEMORY_SCOPE_AGENT);
        unsigned spins = 0;
        while (__hip_atomic_load(cnt, __ATOMIC_RELAXED, __HIP_MEMORY_SCOPE_AGENT) < (unsigned)NCHUNK) { __builtin_amdgcn_s_sleep(2); if (++spins > (1u << 22)) break; }
    }
    __syncthreads();
    TP_STOP(14, lds, tid); TP_START(15, lds, tid);
    if (tid < 256) {
        const int dir = tid >> 7, c = tid & 127;
        const int pos = dir == 0 ? ci : (ci < 4 ? 3 - ci : 39 - ci);
        float h = 0.f;
        const unsigned long long* ag = AGG + (size_t)(dir * NB + b) * NCHUNK * 1024 + hd * 128 + c;
#pragma unroll 1
        for (int base = 0; base < pos; base += 18) {
            unsigned long long v[18];
#pragma unroll
            for (int k = 0; k < 18; ++k) { const int pp = base + k < pos ? base + k : pos - 1; const int cc = dir == 0 ? pp : (pp < 4 ? 3 - pp : 39 - pp);
                v[k] = __hip_atomic_load(ag + (size_t)cc * 1024, __ATOMIC_RELAXED, __HIP_MEMORY_SCOPE_AGENT); }
#pragma unroll
            for (int k = 0; k < 18; ++k) if (base + k < pos) h = __uint_as_float((unsigned)v[k]) * h + __uint_as_float((unsigned)(v[k] >> 32));
        }
        CAR[dir * 128 + c] = h;
    }
    __syncthreads();
#pragma unroll
    for (int rep = 0; rep < 2; ++rep) {
        const int idx = tid + rep * 512, t = idx >> 4, c0 = (idx & 15) * 8;
        bf16_t* gp = p + (size_t)(R0 + t) * EVEN_IN + 1536 + hd * 128 + c0;
        const u32x4 gv = gpre[rep];
        float y[8];
#pragma unroll
        for (int e = 0; e < 8; ++e) {
            float h0, p0, h1, p1; unpkh2(HP[t * 128 + c0 + e], h0, p0); unpkh2(HP[(64 + t) * 128 + c0 + e], h1, p1);
            y[e] = (h0 + p0 * CAR[c0 + e]) + (h1 + p1 * CAR[128 + c0 + e]);
        }
        const float gg[8] = {__uint_as_float(gv.x << 16), __uint_as_float(gv.x & 0xffff0000u), __uint_as_float(gv.y << 16), __uint_as_float(gv.y & 0xffff0000u),
                             __uint_as_float(gv.z << 16), __uint_as_float(gv.z & 0xffff0000u), __uint_as_float(gv.w << 16), __uint_as_float(gv.w & 0xffff0000u)};
        u32x4 o;
        o.x = pk2(y[0] * gg[0] * sigm(gg[0]), y[1] * gg[1] * sigm(gg[1])); o.y = pk2(y[2] * gg[2] * sigm(gg[2]), y[3] * gg[3] * sigm(gg[3]));
        o.z = pk2(y[4] * gg[4] * sigm(gg[4]), y[5] * gg[5] * sigm(gg[5])); o.w = pk2(y[6] * gg[6] * sigm(gg[6]), y[7] * gg[7] * sigm(gg[7]));
        *(u32x4*)gp = o;
    }
    __syncthreads();
    TP_STOP(15, lds, tid); TP_STOP(10, lds, tid);
}

DI void rope8v(u32x4& v, const f32x4 cs, const f32x4 sn) {
    unsigned* w = (unsigned*)&v;
#pragma unroll
    for (int i = 0; i < 4; ++i) { const float t1 = __uint_as_float(w[i] << 16), t2 = __uint_as_float(w[i] & 0xffff0000u); w[i] = pk2(t1 * cs[i] - t2 * sn[i], t1 * sn[i] + t2 * cs[i]); }
}
DI void rope8(u32x4& v, const float* cs, const float* sn) { rope8v(v, *(const f32x4*)cs, *(const f32x4*)sn); }
typedef short v4i16_a __attribute__((ext_vector_type(4)));
DI void attn_item(const Params& P, LAS unsigned char* lds, int j, int item, int wv) {
    const int tid = get_tid(wv), lane = tid & 63, wave = tid >> 6, r = lane & 31, h = lane >> 5;
    const bool is_lat = item < 512;
    int b, qb, kvh;
    if (is_lat) { b = item >> 6; qb = (item >> 2) & 15; kvh = item & 3; } else { const int it = item - 512; b = it >> 3; qb = (it >> 2) & 1; kvh = it & 3; }
    bf16_t* p = (bf16_t*)(P.ws + WS_P);
    const float* cos_t = (const float*)(P.ws + WS_ROPE); const float* sin_t = cos_t + SEQ * 32;
    LAS unsigned char* QL = lds + 36864 + wave * 9216;
    TP_START(1, lds, tid);
    const int hq = 4 * kvh + (wave >> 1), ql0 = qb * 128 + 64 * (wave & 1);
    const size_t rowbase = (size_t)b * LT + (is_lat ? CTXL : 0);
    {
        const int chq = lane & 7;
#pragma unroll
        for (int k = 0; k < 8; ++k) {
            const int row = (lane >> 3) + 8 * k, qi = ql0 + row;
            u32x4 v = *(const u32x4*)(p + (rowbase + qi) * EVEN_IN + 2560 + hq * 64 + 8 * chq);
            if (is_lat) rope8(v, cos_t + qi * 32 + 4 * chq, sin_t + qi * 32 + 4 * chq);
            *(LAS u32x4*)(QL + row * 144 + chq * 16) = v;
        }
    }
    const float sink2 = P.ev_sink[j * 16 + hq] * LOG2E;
    float mrun[2] = {sink2, sink2}, lrun[2] = {h == 0 ? 1.f : 0.f, h == 0 ? 1.f : 0.f};
    f32x16 O[2][2];
#pragma unroll
    for (int a = 0; a < 2; ++a)
#pragma unroll
        for (int c = 0; c < 2; ++c)
#pragma unroll
            for (int i = 0; i < 16; ++i) O[a][c][i] = 0.f;
    const int w_lo = (is_lat && qb == 0) ? 2 : 0, w_hi = (is_lat && qb == 15) ? 3 : 5;
    const int nT = is_lat ? 4 + (w_hi - w_lo + 1) : 4;
    const float SC = 0.125f * LOG2E, NEG = -1e30f;
    const int key = tid >> 3, chn = tid & 7;
    u32x4 kreg, vreg; f32x4 creg, sreg;
#define ATT_K0(t) ((t) < 4 ? 64 * (t) : qb * 128 - 128 + 64 * (w_lo + (t) - 4))
#define ATT_LOAD(t) do { const bool win_ = (t) >= 4; const int k0_ = ATT_K0(t); \
        const bf16_t* kp_ = p + ((size_t)b * LT + (win_ ? CTXL : 0) + k0_ + key) * EVEN_IN + 1024 + kvh * 64 + 8 * chn; \
        kreg = *(const u32x4*)kp_; vreg = *(const u32x4*)(kp_ + 256); \
        if (win_) { creg = *(const f32x4*)(cos_t + (k0_ + key) * 32 + 4 * chn); sreg = *(const f32x4*)(sin_t + (k0_ + key) * 32 + 4 * chn); } } while (0)
#define ATT_STORE(t, buf) do { const bool win_ = (t) >= 4; \
        if (win_) rope8v(kreg, creg, sreg); \
        *(LAS u32x4*)(lds + (buf) * 18432 + key * 144 + chn * 16) = kreg; *(LAS u32x4*)(lds + (buf) * 18432 + 9216 + key * 144 + chn * 16) = vreg; } while (0)
    TP_START(2, lds, tid);
    ATT_LOAD(0); ATT_STORE(0, 0);
    if (nT > 1) ATT_LOAD(1);
#pragma unroll 1
    for (int t = 0; t < nT; ++t) {
        TP_START(4, lds, tid);
        __syncthreads();
        TP_STOP(4, lds, tid);
        if (t + 1 < nT) { ATT_STORE(t + 1, (t + 1) & 1); if (t + 2 < nT) ATT_LOAD(t + 2); }
        TP_START(3, lds, tid);
        const bool win = t >= 4;
        const int k0 = ATT_K0(t);
        const int dq = k0 - ql0;
        if (win && (dq >= 192 || dq <= -192)) continue;
        const bool need_mask = win && (dq >= 128 || dq <= -128);
        const LAS unsigned char* KL = lds + (t & 1) * 18432;
        const LAS bf16_t* VL = (const LAS bf16_t*)(lds + (t & 1) * 18432 + 9216);
#pragma unroll
        for (int qt = 0; qt < 2; ++qt) {
            f32x16 s0, s1;
#pragma unroll
            for (int i = 0; i < 16; ++i) { s0[i] = 0.f; s1[i] = 0.f; }
#pragma unroll
            for (int ks = 0; ks < 4; ++ks) {
                const bf16x8 qfr = *(const LAS bf16x8*)(QL + (32 * qt + r) * 144 + (16 * ks + 8 * h) * 2);
                const bf16x8 k0f = *(const LAS bf16x8*)(KL + r * 144 + (16 * ks + 8 * h) * 2), k1f = *(const LAS bf16x8*)(KL + (32 + r) * 144 + (16 * ks + 8 * h) * 2);
                s0 = MFMA32(k0f, qfr, s0); s1 = MFMA32(k1f, qfr, s1);
            }
            const int qpos = ql0 + 32 * qt + r;
            float mx = NEG;
            if (need_mask) {
#pragma unroll
                for (int i = 0; i < 16; ++i) {
                    const int d0 = qpos - (k0 + crow(i, h)), d1 = d0 - 32;
                    float v0 = s0[i] * SC, v1 = s1[i] * SC;
                    if (d0 > 128 || d0 < -128) v0 = NEG;
                    if (d1 > 128 || d1 < -128) v1 = NEG;
                    s0[i] = v0; s1[i] = v1; mx = fmaxf(mx, fmaxf(v0, v1));
                }
            } else {
#pragma unroll
                for (int i = 0; i < 16; ++i) { s0[i] *= SC; s1[i] *= SC; mx = fmaxf(mx, fmaxf(s0[i], s1[i])); }
            }
            mx = fmaxf(mx, shfl_xor_f(mx, 32));
            const float mn = fmaxf(mrun[qt], mx), alpha = __builtin_amdgcn_exp2f(mrun[qt] - mn);
            mrun[qt] = mn;
            float ls = 0.f;
#pragma unroll
            for (int i = 0; i < 16; ++i) { s0[i] = __builtin_amdgcn_exp2f(s0[i] - mn); s1[i] = __builtin_amdgcn_exp2f(s1[i] - mn); ls += s0[i] + s1[i]; }
            lrun[qt] = lrun[qt] * alpha + ls;
#pragma unroll
            for (int dt = 0; dt < 2; ++dt)
#pragma unroll
                for (int i = 0; i < 16; ++i) O[dt][qt][i] *= alpha;
            bf16x8 pf[2][2];
#pragma unroll
            for (int s = 0; s < 2; ++s) {
                u32x4 a, c;
                a.x = pk2(s0[8 * s + 0], s0[8 * s + 1]); a.y = pk2(s0[8 * s + 2], s0[8 * s + 3]); a.z = pk2(s0[8 * s + 4], s0[8 * s + 5]); a.w = pk2(s0[8 * s + 6], s0[8 * s + 7]);
                c.x = pk2(s1[8 * s + 0], s1[8 * s + 1]); c.y = pk2(s1[8 * s + 2], s1[8 * s + 3]); c.z = pk2(s1[8 * s + 4], s1[8 * s + 5]); c.w = pk2(s1[8 * s + 6], s1[8 * s + 7]);
                pf[0][s] = __builtin_bit_cast(bf16x8, a); pf[1][s] = __builtin_bit_cast(bf16x8, c);
            }
            const int gq = (lane >> 4) & 1, qq4 = (lane & 15) >> 2, pp4 = lane & 3;
#pragma unroll
            for (int dt = 0; dt < 2; ++dt)
#pragma unroll
                for (int kt = 0; kt < 2; ++kt)
#pragma unroll
                    for (int s = 0; s < 2; ++s) {
                        const LAS bf16_t* vp = VL + (32 * kt + 16 * s + 4 * h + qq4) * 72 + 32 * dt + 16 * gq + 4 * pp4;
                        const v4i16_a lo = __builtin_amdgcn_ds_read_tr16_b64_v4i16((LAS v4i16_a*)vp);
                        const v4i16_a hi = __builtin_amdgcn_ds_read_tr16_b64_v4i16((LAS v4i16_a*)(vp + 8 * 72));
                        const bf16x8 vf = {lo[0], lo[1], lo[2], lo[3], hi[0], hi[1], hi[2], hi[3]};
                        O[dt][qt] = MFMA32(vf, pf[kt][s], O[dt][qt]);
                    }
            __builtin_amdgcn_sched_barrier(0);
        }
        TP_STOP(3, lds, tid);
    }
    TP_STOP(2, lds, tid);
#undef ATT_K0
#undef ATT_LOAD
#undef ATT_STORE
    {
        const int chq = lane & 7;
        u32x4 gate[8];
#pragma unroll
        for (int k = 0; k < 8; ++k) gate[k] = *(const u32x4*)(p + (rowbase + ql0 + (lane >> 3) + 8 * k) * EVEN_IN + 3584 + hq * 64 + 8 * chq);
#pragma unroll
        for (int qt = 0; qt < 2; ++qt) {
            const float lt = lrun[qt] + shfl_xor_f(lrun[qt], 32), inv = __builtin_amdgcn_rcpf(lt);
#pragma unroll
            for (int dt = 0; dt < 2; ++dt)
#pragma unroll
                for (int i4 = 0; i4 < 4; ++i4) {
                    u32x2 o; o.x = pk2(O[dt][qt][4 * i4 + 0] * inv, O[dt][qt][4 * i4 + 1] * inv); o.y = pk2(O[dt][qt][4 * i4 + 2] * inv, O[dt][qt][4 * i4 + 3] * inv);
                    *(LAS u32x2*)(QL + (32 * qt + r) * 144 + (32 * dt + 8 * i4 + 4 * h) * 2) = o;
                }
        }
#pragma unroll
        for (int k = 0; k < 8; ++k) {
            const int row = (lane >> 3) + 8 * k;
            const u32x4 ov = *(const LAS u32x4*)(QL + row * 144 + chq * 16);
            const unsigned* ow = (const unsigned*)&ov; const unsigned* gw = (const unsigned*)&gate[k];
            u32x4 res; unsigned* rw = (unsigned*)&res;
#pragma unroll
            for (int e = 0; e < 4; ++e) {
                const float g0 = __uint_as_float(gw[e] << 16), g1 = __uint_as_float(gw[e] & 0xffff0000u);
                rw[e] = pk2(__uint_as_float(ow[e] << 16) * g0 * sigm(g0), __uint_as_float(ow[e] & 0xffff0000u) * g1 * sigm(g1));
            }
            *(u32x4*)(p + (rowbase + ql0 + row) * EVEN_IN + 2560 + hq * 64 + 8 * chq) = res;
        }
    }
    __syncthreads();
    TP_STOP(1, lds, tid);
}

constexpr int G2_QX = 0, G2_KF = 17408, G2_K2 = 60928, G2_VS = 79360, G2_AM = 96768, G2_ST = 105984, G2_PS = 140800, G2_BL = 144896, G2_Q1 = 145408, G2_END = 162816;
static_assert(G2_END <= LDS_BYTES - 256, "GLA LDS map");
typedef short v4i16_t __attribute__((ext_vector_type(4)));
DI bf16x8 frag_tr(const LAS bf16_t* M, int stride, int k0, int n0, int lane) {
    const int i = lane & 15, g = lane >> 4, q = i >> 2, pp = i & 3;
    const LAS bf16_t* a0 = M + (k0 + 8 * g + q) * stride + n0 + 4 * pp;
    const v4i16_t lo = __builtin_amdgcn_ds_read_tr16_b64_v4i16((LAS v4i16_t*)a0);
    const v4i16_t hi = __builtin_amdgcn_ds_read_tr16_b64_v4i16((LAS v4i16_t*)(a0 + 4 * stride));
    return (bf16x8){lo[0], lo[1], lo[2], lo[3], hi[0], hi[1], hi[2], hi[3]};
}

template <int DIR>
DI void gla2_item(const Params& P, LAS unsigned char* lds, int layer_j, int b, int hd, int wv) {
    const int tid = get_tid(wv), lane = tid & 63, wave = tid >> 6, r = lane & 15, g = lane >> 4;
    bf16_t* p = (bf16_t*)(P.ws + WS_P);
    LAS bf16_t* QX = (LAS bf16_t*)(lds + G2_QX); LAS bf16_t* KF = (LAS bf16_t*)(lds + G2_KF); LAS bf16_t* K2 = (LAS bf16_t*)(lds + G2_K2);
    LAS bf16_t* VS = (LAS bf16_t*)(lds + G2_VS); LAS bf16_t* AM = (LAS bf16_t*)(lds + G2_AM); LAS bf16_t* ST = (LAS bf16_t*)(lds + G2_ST);
    LAS float* PS8 = (LAS float*)(lds + G2_PS); LAS float* BLAST = (LAS float*)(lds + G2_BL); LAS bf16_t* Q1 = (LAS bf16_t*)(lds + G2_Q1);
    const int d0 = 2 * lane, tg = wave, I = tg >> 1, half = tg & 1;
    float lbv[2] = {0.f, 0.f};
    if (layer_j > 0) { lbv[0] = sigm(P.od_lb_raw[1024 + hd * 128 + d0] - P.od_lb_raw[hd * 128 + d0]); lbv[1] = sigm(P.od_lb_raw[1024 + hd * 128 + d0 + 1] - P.od_lb_raw[hd * 128 + d0 + 1]); }
    TP_START(20, lds, tid);
    for (int i = tid; i < (9216 + 34816) / 4; i += 512) ((LAS unsigned*)(lds + G2_AM))[i] = 0u;
    f32x4 st[8];
#pragma unroll
    for (int e = 0; e < 8; ++e) st[e] = (f32x4){0.f, 0.f, 0.f, 0.f};
    unsigned zn[8], qn[8]; u32x4 vn[2];
#define G2_OFFZ(s) ((unsigned)((DIR == 0 ? 8 * tg + (s) : 63 - 8 * tg - (s)) * ODD_IN + d0) * 2u)
#define G2_OFFV(rep) ((unsigned)((DIR == 0 ? ((tid + (rep) * 512) >> 4) : 63 - ((tid + (rep) * 512) >> 4)) * ODD_IN + 8 * ((tid + (rep) * 512) & 15)) * 2u)
    const size_t colz = (size_t)DIR * 1024 + hd * 128, colq = 3072 + hd * 128, colv = 2048 + hd * 128;
    {
        const int chunk = DIR == 0 ? 0 : 3;
        const char* slab = (const char*)(p + ((size_t)b * LT + (size_t)chunk * 64) * ODD_IN);
#pragma unroll
        for (int s = 0; s < 8; ++s) { zn[s] = *(const unsigned*)(slab + colz * 2 + G2_OFFZ(s)); qn[s] = *(const unsigned*)(slab + colq * 2 + G2_OFFZ(s)); }
#pragma unroll
        for (int rep = 0; rep < 2; ++rep) vn[rep] = *(const u32x4*)(slab + colv * 2 + G2_OFFV(rep));
    }
    __syncthreads();
#pragma unroll 1
    for (int step = 0; step < NCHUNK; ++step) {
        const int chunk = DIR == 0 ? step : (step < 4 ? 3 - step : 39 - step);
        const size_t Rc0 = (size_t)b * LT + (size_t)chunk * 64;
        unsigned zc[8], qc[8]; u32x4 vc[2];
#pragma unroll
        for (int s = 0; s < 8; ++s) { zc[s] = zn[s]; qc[s] = qn[s]; }
        vc[0] = vn[0]; vc[1] = vn[1];
        TP_START(21, lds, tid);
        float el[8][2], kk[8][2], qq[8][2];
        {
            float run0 = 1.f, run1 = 1.f;
#pragma unroll
            for (int s = 0; s < 8; ++s) {
                const float z0 = __uint_as_float(zc[s] << 16), z1 = __uint_as_float(zc[s] & 0xffff0000u);
                const float t0 = __expf(-z0), t1 = __expf(-z1), sg0 = __builtin_amdgcn_rcpf(1.f + t0), sg1 = __builtin_amdgcn_rcpf(1.f + t1);
                const float f0 = fmaxf(lbv[0] + (1.f - lbv[0]) * sg0, 1e-30f), f1 = fmaxf(lbv[1] + (1.f - lbv[1]) * sg1, 1e-30f);
                kk[s][0] = (1.f - lbv[0]) * (t0 * sg0); kk[s][1] = (1.f - lbv[1]) * (t1 * sg1);
                run0 = fmaxf(run0 * f0, 1e-35f); run1 = fmaxf(run1 * f1, 1e-35f); el[s][0] = run0; el[s][1] = run1;
                const float q0 = __uint_as_float(qc[s] << 16), q1 = __uint_as_float(qc[s] & 0xffff0000u);
                qq[s][0] = q0 * __builtin_amdgcn_rcpf(1.f + __expf(-q0)); qq[s][1] = q1 * __builtin_amdgcn_rcpf(1.f + __expf(-q1));
                if ((s & 1) == 1) __builtin_amdgcn_sched_barrier(0);
            }
            *(LAS f32x2*)(PS8 + tg * 128 + d0) = (f32x2){run0, run1};
#pragma unroll
            for (int rep = 0; rep < 2; ++rep) { const int idx = tid + rep * 512, tau = idx >> 4, chn = idx & 15; *(LAS u32x4*)(VS + tau * 136 + 8 * chn) = vc[rep]; }
        }
        __syncthreads();
        TP_STOP(21, lds, tid); TP_START(22, lds, tid);
        float RI[2];
        {
            float T[8][2];
#pragma unroll
            for (int q8 = 0; q8 < 8; ++q8) { const f32x2 t = *(const LAS f32x2*)(PS8 + q8 * 128 + d0); T[q8][0] = t[0]; T[q8][1] = t[1]; }
            float pre[2], fac[4][2], f4[2];
#pragma unroll
            for (int x = 0; x < 2; ++x) {
                const float P0 = T[0][x] * T[1][x], P1 = T[2][x] * T[3][x], P2 = T[4][x] * T[5][x], P3 = T[6][x] * T[7][x];
                pre[x] = half ? (I == 0 ? T[0][x] : (I == 1 ? T[2][x] : (I == 2 ? T[4][x] : T[6][x]))) : 1.f;
                RI[x] = I == 0 ? 1.f : (I == 1 ? P0 : (I == 2 ? P0 * P1 : P0 * P1 * P2));
                float cur = 1.f;
                fac[0][x] = cur; if (I <= 0) cur *= P0;
                fac[1][x] = cur; if (I <= 1) cur *= P1;
                fac[2][x] = cur; if (I <= 2) cur *= P2;
                fac[3][x] = cur; cur *= P3;
                f4[x] = cur;
                if (tg == 0) BLAST[d0 + x] = P0 * P1 * P2 * P3;
            }
            unsigned w0[4], w1[4];
#pragma unroll
            for (int s = 0; s < 8; ++s) {
                const int tau = 8 * tg + s;
                const float e00 = fmaxf(pre[0] * el[s][0], 1e-35f), e01 = fmaxf(pre[1] * el[s][1], 1e-35f);
                const float qi0 = qq[s][0] * e00, qi1 = qq[s][1] * e01;
                const float kd0 = kk[s][0] * __builtin_amdgcn_rcpf(e00), kd1 = kk[s][1] * __builtin_amdgcn_rcpf(e01);
                *(LAS unsigned*)(QX + tau * 136 + d0) = pk2(qi0, qi1);
                *(LAS unsigned*)(Q1 + tau * 136 + d0) = pk2(qi0 * RI[0], qi1 * RI[1]);
                if (I <= 0) *(LAS unsigned*)(KF + (0 + tau) * 136 + d0) = pk2(kd0 * fac[0][0], kd1 * fac[0][1]);
                if (I <= 1) *(LAS unsigned*)(KF + (16 + tau) * 136 + d0) = pk2(kd0 * fac[1][0], kd1 * fac[1][1]);
                if (I <= 2) *(LAS unsigned*)(KF + (48 + tau) * 136 + d0) = pk2(kd0 * fac[2][0], kd1 * fac[2][1]);
                *(LAS unsigned*)(KF + (96 + tau) * 136 + d0) = pk2(kd0 * fac[3][0], kd1 * fac[3][1]);
                const unsigned h0 = f2bf(kd0 * f4[0]), h1 = f2bf(kd1 * f4[1]);
                if (s & 1) { w0[s >> 1] |= h0 << 16; w1[s >> 1] |= h1 << 16; } else { w0[s >> 1] = h0; w1[s >> 1] = h1; }
                if ((s & 1) == 1) __builtin_amdgcn_sched_barrier(0);
            }
            *(LAS u32x4*)(K2 + (d0 + 0) * 72 + 8 * tg) = (u32x4){w0[0], w0[1], w0[2], w0[3]};
            *(LAS u32x4*)(K2 + (d0 + 1) * 72 + 8 * tg) = (u32x4){w1[0], w1[1], w1[2], w1[3]};
        }
        __syncthreads();
        TP_STOP(22, lds, tid); TP_START(23, lds, tid);
        if (step + 1 < NCHUNK) {
            const int nchunk = DIR == 0 ? step + 1 : (step + 1 < 4 ? 2 - step : 38 - step);
            const char* slab = (const char*)(p + ((size_t)b * LT + (size_t)nchunk * 64) * ODD_IN);
#pragma unroll
            for (int s = 0; s < 8; ++s) { zn[s] = *(const unsigned*)(slab + colz * 2 + G2_OFFZ(s)); qn[s] = *(const unsigned*)(slab + colq * 2 + G2_OFFZ(s)); }
#pragma unroll
            for (int rep = 0; rep < 2; ++rep) vn[rep] = *(const u32x4*)(slab + colv * 2 + G2_OFFV(rep));
        }
#pragma unroll 1
        for (int bi = wave; bi < 10; bi += 8) {
            const int Ib = bi < 1 ? 0 : (bi < 3 ? 1 : (bi < 6 ? 2 : 3)), Jb = bi - (Ib * (Ib + 1)) / 2;
            const int foff = Ib == 0 ? 0 : (Ib == 1 ? 16 : (Ib == 2 ? 48 : 96));
            f32x4 acc = {0.f, 0.f, 0.f, 0.f};
#pragma unroll
            for (int ks = 0; ks < 4; ++ks) {
                const bf16x8 a = *(const LAS bf16x8*)(QX + (16 * Ib + r) * 136 + 32 * ks + 8 * g);
                const bf16x8 bb = *(const LAS bf16x8*)(KF + (foff + 16 * Jb + r) * 136 + 32 * ks + 8 * g);
                acc = MFMA16(a, bb, acc);
            }
#pragma unroll
            for (int i = 0; i < 4; ++i) { float v = acc[i]; if (Jb == Ib && r > 4 * g + i) v = 0.f; AM[(16 * Ib + 4 * g + i) * 72 + 16 * Jb + r] = (bf16_t)f2bf(v); }
        }
        __syncthreads();
        TP_STOP(23, lds, tid); TP_START(24, lds, tid);
        {
            const int tt = wave >> 1, eb = 4 * (wave & 1);
            bf16x8 aq[4], am[2];
#pragma unroll
            for (int ks = 0; ks < 4; ++ks) aq[ks] = *(const LAS bf16x8*)(Q1 + (16 * tt + r) * 136 + 32 * ks + 8 * g);
#pragma unroll
            for (int ks = 0; ks < 2; ++ks) am[ks] = *(const LAS bf16x8*)(AM + (16 * tt + r) * 72 + 32 * ks + 8 * g);
#pragma unroll
            for (int e4 = 0; e4 < 4; ++e4) {
                const int et = eb + e4;
                f32x4 acc = {0.f, 0.f, 0.f, 0.f};
#pragma unroll
                for (int ks = 0; ks < 4; ++ks) { const bf16x8 bb = *(const LAS bf16x8*)(ST + (16 * et + r) * 136 + 32 * ks + 8 * g); acc = MFMA16(aq[ks], bb, acc); }
#pragma unroll
                for (int ks = 0; ks < 2; ++ks) acc = MFMA16(am[ks], frag_tr(VS, 136, 32 * ks, 16 * et, lane), acc);
#pragma unroll
                for (int i = 0; i < 4; ++i) KF[(16 * tt + 4 * g + i) * 136 + 16 * et + r] = (bf16_t)f2bf(acc[i]);
                __builtin_amdgcn_sched_barrier(0);
            }
            float bl[4];
#pragma unroll
            for (int i = 0; i < 4; ++i) bl[i] = BLAST[16 * wave + 4 * g + i];
            bf16x8 ak[2];
#pragma unroll
            for (int ks = 0; ks < 2; ++ks) ak[ks] = *(const LAS bf16x8*)(K2 + (16 * wave + r) * 72 + 32 * ks + 8 * g);
#pragma unroll
            for (int et = 0; et < 8; ++et) {
#pragma unroll
                for (int i = 0; i < 4; ++i) st[et][i] *= bl[i];
#pragma unroll
                for (int ks = 0; ks < 2; ++ks) st[et] = MFMA16(ak[ks], frag_tr(VS, 136, 32 * ks, 16 * et, lane), st[et]);
                if (et & 1) __builtin_amdgcn_sched_barrier(0);
            }
        }
        __syncthreads();
        TP_STOP(24, lds, tid); TP_START(25, lds, tid);
        {
            char* oslab = (char*)(p + Rc0 * ODD_IN + colz);
#pragma unroll
            for (int rep = 0; rep < 2; ++rep) {
                const int idx = tid + rep * 512, tau = idx >> 4, chn = idx & 15;
                const u32x4 ov = *(const LAS u32x4*)(KF + tau * 136 + 8 * chn);
                *(u32x4*)(oslab + (unsigned)((DIR == 0 ? tau : 63 - tau) * ODD_IN + 8 * chn) * 2u) = ov;
            }
        }
#pragma unroll
        for (int et = 0; et < 8; ++et) { u32x2 w; w.x = pk2(st[et][0], st[et][1]); w.y = pk2(st[et][2], st[et][3]); *(LAS u32x2*)(ST + (16 * et + r) * 136 + 16 * wave + 4 * g) = w; }
        TP_STOP(25, lds, tid);
    }
    __syncthreads();
    TP_STOP(20, lds, tid);
}

DI void phase_readout(const Params& P, int layer_j, int wv) {
    const int tid = get_tid(wv), lane = tid & 63, wave = tid >> 6;
    const int gw = get_bid() * 8 + wave, NGW = gridDim.x * 8;
    bf16_t* p = (bf16_t*)(P.ws + WS_P);
    const float* gwt = P.od_gnorm_w + layer_j * 128 + (lane & 7) * 16;
    for (int R = gw; R < MROWS; R += NGW) {
        const bf16_t* op = p + (size_t)R * ODD_IN + 16 * lane; bf16_t* yp = p + (size_t)R * ODD_IN + 4096 + 16 * lane;
        const u32x4 o0 = *(const u32x4*)op, o1 = *(const u32x4*)(op + 8), c0 = *(const u32x4*)(op + 1024), c1 = *(const u32x4*)(op + 1032), g0 = *(const u32x4*)yp, g1 = *(const u32x4*)(yp + 8);
        float ov[16], gv[16];
        const unsigned* ow0 = (const unsigned*)&o0; const unsigned* ow1 = (const unsigned*)&o1; const unsigned* cw0 = (const unsigned*)&c0; const unsigned* cw1 = (const unsigned*)&c1;
        const unsigned* gw0 = (const unsigned*)&g0; const unsigned* gw1 = (const unsigned*)&g1;
#pragma unroll
        for (int i = 0; i < 4; ++i) {
            ov[2 * i] = __uint_as_float(ow0[i] << 16) + __uint_as_float(cw0[i] << 16); ov[2 * i + 1] = __uint_as_float(ow0[i] & 0xffff0000u) + __uint_as_float(cw0[i] & 0xffff0000u);
            ov[8 + 2 * i] = __uint_as_float(ow1[i] << 16) + __uint_as_float(cw1[i] << 16); ov[8 + 2 * i + 1] = __uint_as_float(ow1[i] & 0xffff0000u) + __uint_as_float(cw1[i] & 0xffff0000u);
            gv[2 * i] = __uint_as_float(gw0[i] << 16); gv[2 * i + 1] = __uint_as_float(gw0[i] & 0xffff0000u); gv[8 + 2 * i] = __uint_as_float(gw1[i] << 16); gv[8 + 2 * i + 1] = __uint_as_float(gw1[i] & 0xffff0000u);
        }
        float ss = 0.f;
#pragma unroll
        for (int i = 0; i < 16; ++i) ss += ov[i] * ov[i];
        ss += shfl_xor_f(ss, 1); ss += shfl_xor_f(ss, 2); ss += shfl_xor_f(ss, 4);
        const float rstd = rsqrtf(ss * (1.f / 128.f) + RMS_EPS);
        float y[16];
#pragma unroll
        for (int i = 0; i < 16; ++i) y[i] = ov[i] * rstd * gwt[i] * (gv[i] * sigm(gv[i]));
        u32x4 w0, w1;
        w0.x = pk2(y[0], y[1]); w0.y = pk2(y[2], y[3]); w0.z = pk2(y[4], y[5]); w0.w = pk2(y[6], y[7]);
        w1.x = pk2(y[8], y[9]); w1.y = pk2(y[10], y[11]); w1.z = pk2(y[12], y[13]); w1.w = pk2(y[14], y[15]);
        *(u32x4*)yp = w0; *(u32x4*)(yp + 8) = w1;
    }
}

DI void phase_final(const Params& P, int wv) {
    const int tid = get_tid(wv), lane = tid & 63, wave = tid >> 6;
    const int gw = get_bid() * 8 + wave, NGW = gridDim.x * 8;
    for (int R = gw; R < NB * SEQ; R += NGW) {
        float* row = P.out + (size_t)R * DM;
        f32x4 v[4]; float ss = 0.f;
#pragma unroll
        for (int q = 0; q < 4; ++q) { v[q] = *(const f32x4*)(row + 4 * lane + 256 * q); ss += (v[q][0] * v[q][0] + v[q][1] * v[q][1]) + (v[q][2] * v[q][2] + v[q][3] * v[q][3]); }
        const float rstd = rsqrtf(wave_sum(ss) * (1.f / DM) + RMS_EPS);
#pragma unroll
        for (int q = 0; q < 4; ++q) { const f32x4 w4 = *(const f32x4*)(P.final_norm_w + 4 * lane + 256 * q); *(f32x4*)(row + 4 * lane + 256 * q) = (v[q] * rstd) * w4; }
    }
}

#define XB_TMO      128
#define XB_XCNT(j)  (256  + 64 * (j))
#define XB_XSUB(j)  (1280 + 64 * (j))
#define XB_XGEN(j)  (2304 + 64 * (j))
#define XB_TOP      3328
#define XB_TOPGEN   3392
#define XCD_BAR_WORDS 3456
#define XB_SPIN_CAP (1u << 18)

__device__ __forceinline__ unsigned xb_ld(unsigned* p)              { return __hip_atomic_load(p, __ATOMIC_RELAXED, __HIP_MEMORY_SCOPE_AGENT); }
__device__ __forceinline__ unsigned xb_add(unsigned* p, unsigned v) { return __hip_atomic_fetch_add(p, v, __ATOMIC_RELAXED, __HIP_MEMORY_SCOPE_AGENT); }
__device__ __forceinline__ unsigned xb_xcc_id() { return (unsigned)__builtin_amdgcn_s_getreg((3 << 11) | 20) & 0xFu; }
#define XB_SPIN(cond, bar) do { unsigned _sp = 0; while (cond) { __builtin_amdgcn_s_sleep(1); \
    if ((++_sp & 255u) == 0u) { if (xb_ld(&(bar)[XB_TMO])) break; if (_sp > XB_SPIN_CAP) { atomicAdd(&(bar)[XB_TMO], 1u); break; } } } } while (0)

struct XcdBarrier {
    unsigned* bar; unsigned x;
    volatile LAS unsigned* st;
};

__device__ __forceinline__ XcdBarrier xcd_barrier_post(unsigned* bar, volatile LAS unsigned* st, int wv) {
    XcdBarrier b; b.bar = bar; b.x = xb_xcc_id(); b.st = st;
    if (get_tid(wv) == 0) (void)xb_add(&bar[XB_XCNT(b.x)], 1u);
    return b;
}
__device__ __forceinline__ void xcd_barrier_complete(unsigned* bar, unsigned x, unsigned& nloc, unsigned& nx) {
    const unsigned G = gridDim.x * gridDim.y * gridDim.z;
    unsigned sum, cnt, mine, sp = 0u;
    for (;;) {
        sum = 0u; cnt = 0u; mine = 0u;
#pragma unroll
        for (unsigned j = 0; j < 16; ++j) { const unsigned c = xb_ld(&bar[XB_XCNT(j)]); sum += c; cnt += (c > 0u) ? 1u : 0u; mine = (j == x) ? c : mine; }
        if (sum == G) break;
        __builtin_amdgcn_s_sleep(1);
        if ((++sp & 255u) == 0u) { if (xb_ld(&bar[XB_TMO])) break; if (sp > XB_SPIN_CAP) { atomicAdd(&bar[XB_TMO], 1u); break; } }
    }
    nloc = mine > 0u ? mine : 1u; nx = cnt > 0u ? cnt : 1u;
}

__device__ __forceinline__ void xcd_barrier(const XcdBarrier& b, int wv) {
    asm volatile("s_waitcnt vmcnt(0)" ::: "memory");
    __syncthreads();
    if (get_tid(wv) == 0) {
        unsigned* bar = b.bar;
        __builtin_amdgcn_s_waitcnt(0);
        unsigned nloc = b.st[0], nx = b.st[1];
        if (nloc == 0u) { xcd_barrier_complete(bar, b.x, nloc, nx); b.st[0] = nloc; b.st[1] = nx; }
        const unsigned old = xb_add(&bar[XB_XSUB(b.x)], 1u);
        const unsigned gen = old / nloc;
        if (old + 1u == (gen + 1u) * nloc) {
            __builtin_amdgcn_fence(__ATOMIC_RELEASE, "agent");
            asm volatile("s_waitcnt vmcnt(0)" ::: "memory");
            const unsigned og = xb_add(&bar[XB_TOP], 1u);
            const unsigned tg = og / nx;
            if (og + 1u == (tg + 1u) * nx) xb_add(&bar[XB_TOPGEN], 1u);
            else XB_SPIN(xb_ld(&bar[XB_TOPGEN]) == tg, bar);
            __builtin_amdgcn_fence(__ATOMIC_ACQUIRE, "agent");
            xb_add(&bar[XB_XGEN(b.x)], 1u);
            asm volatile("s_waitcnt vmcnt(0)" ::: "memory");
        } else {
            XB_SPIN(xb_ld(&bar[XB_XGEN(b.x)]) == gen, bar);
            __builtin_amdgcn_fence(__ATOMIC_ACQUIRE, "agent");
            asm volatile("s_waitcnt vmcnt(0)" ::: "memory");
        }
    }
    __syncthreads();
}

constexpr int PARAM_OFF = LDS_BYTES - 256;
static_assert(G2_END <= PARAM_OFF && sizeof(Params) <= 208, "LDS map");
DI const float* ld_uptr(const LAS unsigned long long* s, int i) {
    const unsigned long long v = s[i];
    const unsigned lo = __builtin_amdgcn_readfirstlane((unsigned)v), hi = __builtin_amdgcn_readfirstlane((unsigned)(v >> 32));
    return (const float*)(const __attribute__((address_space(1))) float*)(((unsigned long long)hi << 32) | lo);
}
DI Params load_params(LAS unsigned char* lds) {
    LAS unsigned char* pb = lds + PARAM_OFF; asm volatile("" : "+v"(pb));
    const LAS unsigned long long* s = (const LAS unsigned long long*)pb;
    Params Q;
    Q.x = ld_uptr(s, 0); Q.c = ld_uptr(s, 1); Q.ctx = ld_uptr(s, 2); Q.c_ctx = ld_uptr(s, 3); Q.ada_w = ld_uptr(s, 4); Q.ada_b = ld_uptr(s, 5); Q.norm_w = ld_uptr(s, 6);
    Q.ev_w_in = ld_uptr(s, 7); Q.ev_conv_w = ld_uptr(s, 8); Q.ev_conv_b = ld_uptr(s, 9); Q.ev_rg_wx = ld_uptr(s, 10); Q.ev_rg_bx = ld_uptr(s, 11); Q.ev_rg_wa = ld_uptr(s, 12);
    Q.ev_rg_ba = ld_uptr(s, 13); Q.ev_rg_lambda = ld_uptr(s, 14); Q.ev_sink = ld_uptr(s, 15); Q.ev_w_out = ld_uptr(s, 16); Q.od_w_in = ld_uptr(s, 17); Q.od_lb_raw = ld_uptr(s, 18);
    Q.od_gnorm_w = ld_uptr(s, 19); Q.od_w_out = ld_uptr(s, 20); Q.final_norm_w = ld_uptr(s, 21); Q.out = (float*)ld_uptr(s, 22); Q.ws = (unsigned char*)ld_uptr(s, 23);
    Q.ph_lo = 0; Q.ph_hi = 0;
    return Q;
}
DI void run_phase(LAS unsigned char* lds, int ph, int wv) {
    #ifndef PHMASK
#define PHMASK 0xffff
#endif
    if (ph == 0) { if (PHMASK & 1) { const Params P = load_params(lds); phase_pro(P, lds, wv); } return; }
    const int layer = (ph - 1) / 5, sub = (ph - 1) % 5, j = layer >> 1;
    const bool even = (layer & 1) == 0;
    if (sub == 0) { if (PHMASK & 4) { const Params P = load_params(lds); phase_norm(P, lds, layer, wv); } return; }
    if (sub == 1) {
        const Params P = load_params(lds); bf16_t* pbuf = (bf16_t*)(P.ws + WS_P);
        const int N = even ? EVEN_IN : ODD_IN;
        pg8::Gemm gm{(const bf16_t*)(P.ws + WS_OV), (const bf16_t*)(P.ws + WS_WIN), MROWS, N, 1024, 1024};
        pg8::StaticOrder S; S.init(MROWS, N, (int)gridDim.x, get_bid());
        EpiStoreBf16 E{pbuf, N};
        if (even) S.limit = 1280;
        if (PHMASK & 8) pg8::gemm_phase<EpiStoreBf16, pg8::StaticOrder, true, true>(lds, gm, S, E, wv);
        if (even) {
            for (int t = get_bid(); t < 128; t += gridDim.x) {
                pg8::Unit u; S.tile_of(1280 + (t >> 3), u);
                const int m0 = 256 * u.pm + 64 * ((t & 7) >> 1), n0 = 256 * u.pn + 128 * (t & 1);
                auto epi = [&](const f32x16& acc, int row0, int col, int hh) {
#pragma unroll
                    for (int i = 0; i < 16; ++i) pbuf[(size_t)(m0 + row0 + crow(i, hh)) * N + n0 + col] = (bf16_t)f2bf(acc[i]);
                };
                mini_gemm_tile(lds, (const bf16_t*)(P.ws + WS_OV) + (size_t)m0 * 1024, 1024, (const bf16_t*)(P.ws + WS_WIN) + (size_t)n0 * 1024, 1024, epi, wv);
            }
        }
        return;
    }
    if (sub == 2) {
        const Params P = load_params(lds);
        if (even) {
            constexpr int NRG = NB * NCHUNK * 8;
#if defined(SPLIT_ATTN)
            for (int it = get_bid(); it < NRG; it += gridDim.x) rglru_item(P, lds, j, it, wv);
#else
            for (int it = get_bid(); it < NRG + 576; it += gridDim.x) {
                if (it < NRG) { if (PHMASK & 32) rglru_item(P, lds, j, it, wv); } else { if (PHMASK & 16) attn_item(P, lds, j, it - NRG, wv); }
            }
#endif
        } else {
            for (int it = get_bid(); it < 128; it += gridDim.x) { if (PHMASK & 64) { if (it & 1) gla2_item<1>(P, lds, j, it >> 4, (it >> 1) & 7, wv); else gla2_item<0>(P, lds, j, it >> 4, (it >> 1) & 7, wv); } }
        }
        return;
    }
    if (sub == 3) {
        const Params P = load_params(lds);
        if (!even) { if (PHMASK & 256) phase_readout(P, j, wv); }
#if defined(SPLIT_ATTN)
        else { for (int it = get_bid(); it < 576; it += gridDim.x) attn_item(P, lds, j, it, wv); }
#endif
        return;
    }
    {
        const Params P = load_params(lds); bf16_t* pbuf = (bf16_t*)(P.ws + WS_P);
        const int K = even ? 2048 : 1024, lda = even ? EVEN_IN : ODD_IN;
        pg8::Gemm gm{pbuf + (even ? 1536 : 4096), (const bf16_t*)(P.ws + WS_WOUT), MROWS, 1024, K, lda};
        pg8::StaticOrder S; S.init(NB * SEQ, 1024, (int)gridDim.x, get_bid(), 1);
        const float* hl = layer == 0 ? P.x : P.out; const float* hc = layer == 0 ? P.ctx : (const float*)(P.ws + WS_HCTX);
        const float* modb = (const float*)(P.ws + WS_MOD);
        EpiResidNorm E{hl, P.out, modb + (size_t)layer * 9 * 3072 + 2048, layer < 3 ? P.norm_w + (layer + 1) * 1024 : P.final_norm_w,
                       layer < 3 ? modb + (size_t)(layer + 1) * 9 * 3072 : nullptr, (bf16_t*)(P.ws + WS_OV), (float*)(P.ws + WS_AGG), (unsigned*)(P.ws + WS_CTL) + 12288 + layer * 1024};
        if (PHMASK & 512) pg8::gemm_phase<EpiResidNorm, pg8::StaticOrder, false, true>(lds, gm, S, E, wv);
        if (layer < 3) {
            for (int t = get_bid(); t < 256; t += gridDim.x) {
                const int mt = t >> 3, nt = t & 7, mc0 = 64 * mt, bctx = mc0 >> 8, n0 = 128 * nt;
                const bf16_t* At = pbuf + ((size_t)bctx * LT + (mc0 & 255)) * lda + (even ? 1536 : 4096);
                const float* gctx = (const float*)(P.ws + WS_MOD) + (size_t)layer * 9 * 3072 + 2048 + 8 * 3072;
                float* hco = (float*)(P.ws + WS_HCTX);
                auto epi = [&](const f32x16& acc, int row0, int col, int hh) {
                    const float gate = gctx[n0 + col];
#pragma unroll
                    for (int i = 0; i < 16; ++i) { const size_t off = (size_t)(mc0 + row0 + crow(i, hh)) * DM + n0 + col; hco[off] = hc[off] + gate * acc[i]; }
                };
                mini_gemm_tile(lds, At, lda, (const bf16_t*)(P.ws + WS_WOUT) + (size_t)n0 * K, K, epi, wv);
            }
        }
    }
}

__global__ void __launch_bounds__(512, 2) mega(Params P) {
    extern __shared__ __attribute__((aligned(16))) unsigned char lds_raw[];
    LAS unsigned char* lds = (LAS unsigned char*)lds_raw;
    cg::grid_group grid = cg::this_grid();
    const int wv = __builtin_amdgcn_readfirstlane((int)(threadIdx.x >> 6));
    if (get_tid(wv) == 0) {
#if defined(TP_ID)
        ((LAS unsigned long long*)(lds + 163840 - 32))[0] = 0ull; ((LAS unsigned long long*)(lds + 163840 - 32))[1] = 0ull;
#endif
        ((LAS unsigned*)(lds + PARAM_OFF + 208))[0] = 0u; ((LAS unsigned*)(lds + PARAM_OFF + 208))[1] = 0u;
        LAS unsigned long long* d = (LAS unsigned long long*)(lds + PARAM_OFF);
        d[0] = (unsigned long long)P.x; d[1] = (unsigned long long)P.c; d[2] = (unsigned long long)P.ctx; d[3] = (unsigned long long)P.c_ctx; d[4] = (unsigned long long)P.ada_w;
        d[5] = (unsigned long long)P.ada_b; d[6] = (unsigned long long)P.norm_w; d[7] = (unsigned long long)P.ev_w_in; d[8] = (unsigned long long)P.ev_conv_w; d[9] = (unsigned long long)P.ev_conv_b;
        d[10] = (unsigned long long)P.ev_rg_wx; d[11] = (unsigned long long)P.ev_rg_bx; d[12] = (unsigned long long)P.ev_rg_wa; d[13] = (unsigned long long)P.ev_rg_ba; d[14] = (unsigned long long)P.ev_rg_lambda;
        d[15] = (unsigned long long)P.ev_sink; d[16] = (unsigned long long)P.ev_w_out; d[17] = (unsigned long long)P.od_w_in; d[18] = (unsigned long long)P.od_lb_raw; d[19] = (unsigned long long)P.od_gnorm_w;
        d[20] = (unsigned long long)P.od_w_out; d[21] = (unsigned long long)P.final_norm_w; d[22] = (unsigned long long)P.out; d[23] = (unsigned long long)P.ws;
    }
    __syncthreads();
    const int ph_lo = P.ph_lo, ph_hi = P.ph_hi;
    (void)xcd_barrier_post((unsigned*)(P.ws + WS_CTL) + 4096, (volatile LAS unsigned*)(lds + PARAM_OFF + 208), wv);
#define GRID_SYNC(first) do { if (first) grid.sync(); else { XcdBarrier xb_; xb_.bar = (unsigned*)(load_params(lds).ws + WS_CTL) + 4096; xb_.x = xb_xcc_id(); xb_.st = (volatile LAS unsigned*)(lds + PARAM_OFF + 208); xcd_barrier(xb_, wv); } } while (0)
#if defined(PROBE_S)
    constexpr int PREP = PROBE_E - PROBE_S + 1;
#pragma unroll 1
    for (int seq = ph_lo; seq < ph_hi + PREP; ++seq) {
        if (seq > ph_lo) GRID_SYNC(seq == ph_lo + 1);
        const int ph = seq <= PROBE_E ? seq : seq - PREP;
        run_phase(lds, ph, wv);
    }
#else
#pragma unroll 1
    for (int ph = ph_lo; ph < ph_hi; ++ph) {
#if !defined(SPLIT_ATTN)
        if (ph >= 1 && ph < NPHASE - 1 && (ph - 1) % 5 == 3 && (((ph - 1) / 5) & 1) == 0) continue;
#endif
        if (ph > ph_lo) GRID_SYNC(ph == ph_lo + 1);
        run_phase(lds, ph, wv);
    }
#endif
#if defined(TP_ID)
    if (get_tid(wv) == 0 && blockIdx.x == TP_BLOCK) {
        const unsigned long long acc = ((LAS unsigned long long*)(lds + 163840 - 32))[1], t0 = __builtin_amdgcn_s_memrealtime();
        while (__builtin_amdgcn_s_memrealtime() - t0 < (unsigned long long)TP_AMP * acc) __builtin_amdgcn_s_sleep(8);
    }
#endif
}

extern "C" void kernel_launch(void* const* d_in, const int* in_sizes, int n_in, void* d_out, int out_size, void* d_ws, size_t ws_size, hipStream_t stream) {
    static int grid = 0;
    if (grid == 0) {
        if (n_in != 22 || ws_size < WS_END) { fprintf(stderr, "kernel_launch: unexpected inputs (n_in %d, ws %zu)\n", n_in, ws_size); grid = -1; return; }
        int dev = 0, cus = 0, per_cu = 0;
        hipGetDevice(&dev);
        hipDeviceGetAttribute(&cus, hipDeviceAttributeMultiprocessorCount, dev);
        if (hipFuncSetAttribute((const void*)mega, hipFuncAttributeMaxDynamicSharedMemorySize, LDS_BYTES) != hipSuccess) { fprintf(stderr, "kernel_launch: hipFuncSetAttribute failed\n"); grid = -1; return; }
        if (hipOccupancyMaxActiveBlocksPerMultiprocessor(&per_cu, (const void*)mega, 512, LDS_BYTES) != hipSuccess || per_cu < 1) { fprintf(stderr, "kernel_launch: occupancy query gives %d\n", per_cu); per_cu = 1; }
        (void)hipGetLastError();
        grid = cus;
    }
    if (grid < 0) return;
    if (hipMemsetAsync((char*)d_ws + WS_CTL, 0, 65536, stream) != hipSuccess) { fprintf(stderr, "kernel_launch: memset failed\n"); return; }
    Params P{};
    const float** pp = (const float**)&P;
    for (int i = 0; i < 22; ++i) pp[i] = (const float*)d_in[i];
    P.out = (float*)d_out; P.ws = (unsigned char*)d_ws;
#if ONE_LAUNCH
    P.ph_lo = 0; P.ph_hi = NPHASE;
    { void* args[] = {&P}; hipError_t e = hipLaunchCooperativeKernel((const void*)mega, dim3(grid), dim3(512), args, LDS_BYTES, stream);
      if (e != hipSuccess) fprintf(stderr, "cooperative launch failed: %s (grid %d)\n", hipGetErrorString(e), grid); }
#else
    for (int ph = 0; ph < NPHASE; ++ph) {
        P.ph_lo = ph; P.ph_hi = ph + 1;
        void* args[] = {&P}; hipError_t e = hipLaunchCooperativeKernel((const void*)mega, dim3(grid), dim3(512), args, LDS_BYTES, stream);
        if (e != hipSuccess) { fprintf(stderr, "launch %d failed: %s (grid %d)\n", ph, hipGetErrorString(e), grid); break; }
    }
#endif
}
```

```cpp
#include <hip/hip_runtime.h>
#include <hip/hip_cooperative_groups.h>
#include <cstdio>
#include <cstdint>
namespace cg = cooperative_groups;

#ifndef ONE_LAUNCH
#define ONE_LAUNCH 1
#endif

#define DI __device__ __forceinline__
#define LAS __attribute__((address_space(3)))
__device__ __forceinline__ int lane_nh() { int l; asm volatile("v_mbcnt_lo_u32_b32 %0, -1, 0\n\tv_mbcnt_hi_u32_b32 %0, -1, %0" : "=v"(l)); return l; }
__device__ __forceinline__ int get_tid(int wv) { asm volatile("" : "+s"(wv)); return wv * 64 + lane_nh(); }
__device__ __forceinline__ float shfl_xor_f(float v, int o) { return __int_as_float(__builtin_amdgcn_ds_bpermute((lane_nh() ^ o) << 2, __float_as_int(v))); }
__device__ __forceinline__ int get_bid() { int b = blockIdx.x; asm volatile("" : "+s"(b)); return b; }

#if defined(TP_ID)
#ifndef TP_BLOCK
#define TP_BLOCK 5
#endif
#ifndef TP_AMP
#define TP_AMP 16
#endif
#define TP_START(id, lds, tid_) do { if ((id) == TP_ID && (tid_) == 0 && blockIdx.x == TP_BLOCK) { ((LAS unsigned long long*)((lds) + 163840 - 32))[0] = __builtin_amdgcn_s_memrealtime(); } } while (0)
#define TP_STOP(id, lds, tid_) do { if ((id) == TP_ID && (tid_) == 0 && blockIdx.x == TP_BLOCK) { LAS unsigned long long* w_ = (LAS unsigned long long*)((lds) + 163840 - 32); w_[1] += __builtin_amdgcn_s_memrealtime() - w_[0]; } } while (0)
#else
#define TP_START(id, lds, tid_) do { } while (0)
#define TP_STOP(id, lds, tid_) do { } while (0)
#endif
namespace pg8 {
#define PG8_LAS __attribute__((address_space(3)))
typedef unsigned short bf16_t;
typedef short bf16x8 __attribute__((ext_vector_type(8)));
typedef float f32x4 __attribute__((ext_vector_type(4)));
typedef unsigned u32x4 __attribute__((ext_vector_type(4)));
constexpr int BM = 256, BK = 64, HALF = 128, HTB = HALF * BK * 2  , STAGE_BYTES = 8 * HTB, NXCD = 8, WGM = 8;

__host__ __device__ __forceinline__ int lds_byte(int r, int c) { const int st = (r >> 4) * 2 + (c >> 5), rr = r & 15, cc = c & 31, ob = rr * 64 + cc * 2; return st * 1024 + (ob ^ (((ob >> 9) & 1) << 5)); }
__host__ __device__ __forceinline__ void stage_rc(int b, int& R, int& C) { const int st = b / 1024, sb = b % 1024, swz = sb ^ (((sb >> 9) & 1) << 5); R = (st >> 1) * 16 + swz / 64; C = (st & 1) * 32 + (swz % 64) / 2; }
__host__ __device__ __forceinline__ int perm32(int rho) { const int n = rho >> 4, i = rho & 15; return 8 * (i >> 2) + 4 * n + (i & 3); }

struct Unit { int pm, pn; };
struct Gemm { const bf16_t* A; const bf16_t* Bt; int M, N, K, lda; };

struct StaticOrder {
    int nM, nN, nwg, G, c, lat_only, limit;
    __host__ __device__ void init(int M, int N, int G_, int c_, int lat_only_ = 0) { nM = M / BM; nN = N / BM; nwg = nM * nN; G = G_; c = c_; lat_only = lat_only_; limit = nwg; }
    __host__ __device__ bool next(int i, Unit& u) const {
        const long L = (long)i * G + c; if (L >= limit) return false;
        tile_of((int)L, u); return true;
    }
    __host__ __device__ void tile_of(int L, Unit& u) const {
        int wgid = L; { const int q = nwg / NXCD, r = nwg % NXCD, xcd = wgid % NXCD, off = wgid / NXCD; wgid = (xcd < r ? xcd * (q + 1) : r * (q + 1) + (xcd - r) * q) + off; }
        const int nig = WGM * nN, gid = wgid / nig, fm = gid * WGM, gsz = (nM - fm) < WGM ? (nM - fm) : WGM;
        u.pm = fm + ((wgid % nig) % gsz); u.pn = (wgid % nig) / gsz; if (lat_only) u.pm = 9 * (u.pm >> 3) + 1 + (u.pm & 7);
    }
    __device__ __forceinline__ void a_ready(const Unit&) const {}
    __device__ __forceinline__ void done(const Unit&) const {}
};

template <class Epi, class Sched, bool ALIGN_EPI = false, bool SP2 = false>
__device__ __forceinline__ void gemm_phase(PG8_LAS unsigned char* lds, const Gemm g, const Sched& S, const Epi& E, int wv) {
    const int tid = get_tid(wv), wid = __builtin_amdgcn_readfirstlane(tid >> 6), lane = tid & 63, wr = wid >> 2, wc = wid & 3, fr = lane & 15, fq = lane >> 4;
    const int K = g.K, nt = K / BK;
    unsigned voffA[2], voffB[2];
#pragma unroll
    for (int i = 0; i < 2; ++i) { int R, C; stage_rc(tid * 16 + i * 8192, R, C); const int Rb = Epi::PERM ? ((R & ~31) + perm32(R & 31)) : R;
        voffA[i] = (unsigned)(R * g.lda + C) * 2u; voffB[i] = (unsigned)(Rb * K + C) * 2u; }
    const size_t kstep = (size_t)(BK * 2);
    const size_t hstepA = (size_t)HALF * g.lda * 2, hstepB = (size_t)HALF * K * 2;
    const size_t tstepA = 2 * hstepA, tstepB = 2 * hstepB;
    const unsigned ldsw = (unsigned)wid * 1024u;
    const int aoff = lds_byte(wr * 64 + fr, fq * 8), boff = lds_byte(wc * 32 + fr, fq * 8);
#define PG8_SA(b, h) (((b) * 2 + (h)) * HTB)
#define PG8_SB(b, h) ((4 + (b) * 2 + (h)) * HTB)
#define PG8_STAGE(bufoff, gbase, voff) do { _Pragma("unroll") for (int _i = 0; _i < 2; ++_i) \
        __builtin_amdgcn_global_load_lds((const unsigned*)((const char*)(gbase) + (voff)[_i]), (PG8_LAS unsigned*)(lds + (bufoff) + ldsw + _i * 8192), 16, 0, 0); } while (0)
#define PG8_LDA(dst, b, h) do { _Pragma("unroll") for (int m = 0; m < 4; ++m) _Pragma("unroll") for (int k = 0; k < 2; ++k) dst[m][k] = *(const PG8_LAS bf16x8*)(lds + PG8_SA(b, h) + aoff + m * 2048 + k * 1024); } while (0)
#define PG8_LDB(dst, b, h) do { _Pragma("unroll") for (int n = 0; n < 2; ++n) _Pragma("unroll") for (int k = 0; k < 2; ++k) dst[n][k] = *(const PG8_LAS bf16x8*)(lds + PG8_SB(b, h) + boff + n * 2048 + k * 1024); } while (0)
#define PG8_MMA(ai, bj, At, Bt) do { __builtin_amdgcn_s_setprio(1); _Pragma("unroll") for (int m = 0; m < 4; ++m) _Pragma("unroll") for (int n = 0; n < 2; ++n) _Pragma("unroll") for (int k = 0; k < 2; ++k) \
        acc[ai][bj][m][n] = __builtin_amdgcn_mfma_f32_16x16x32_bf16(Bt[n][k], At[m][k], acc[ai][bj][m][n], 0, 0, 0); __builtin_amdgcn_s_setprio(0); } while (0)
#define PG8_WAIT_V(n) asm volatile("s_waitcnt vmcnt(" #n ")" ::: "memory")
#define PG8_WAIT_L(n) asm volatile("s_waitcnt lgkmcnt(" #n ")" ::: "memory")
#define PG8_BAR __builtin_amdgcn_s_barrier()
#define PG8_SCHED __builtin_amdgcn_sched_barrier(0)
    Unit cur, nxt; int ui = 0;
    if (!S.next(0, cur)) return;
    f32x4 acc[2][2][4][2];
#pragma unroll
    for (int a = 0; a < 2; ++a)
#pragma unroll
        for (int b = 0; b < 2; ++b)
#pragma unroll
            for (int m = 0; m < 4; ++m)
#pragma unroll
                for (int n = 0; n < 2; ++n) acc[a][b][m][n] = (f32x4){0.f, 0.f, 0.f, 0.f};
    bf16x8 At[4][2], B0[2][2], B1[2][2];
    const char* cA = (const char*)g.A + (size_t)cur.pm * tstepA; const char* cB = (const char*)g.Bt + (size_t)cur.pn * tstepB;
    S.a_ready(cur);
    if constexpr (SP2) {
        PG8_STAGE(PG8_SB(0, 0), cB, voffB); PG8_STAGE(PG8_SB(0, 1), cB + hstepB, voffB); PG8_STAGE(PG8_SA(0, 0), cA, voffA); PG8_STAGE(PG8_SA(0, 1), cA + hstepA, voffA);
        if (wr == 1) PG8_BAR;
        PG8_WAIT_V(2); PG8_BAR;
        PG8_STAGE(PG8_SB(1, 0), cB + kstep, voffB); PG8_STAGE(PG8_SA(1, 0), cA + kstep, voffA); PG8_STAGE(PG8_SB(1, 1), cB + hstepB + kstep, voffB);
        PG8_WAIT_V(6); PG8_BAR;
    } else {
        PG8_STAGE(PG8_SB(0, 0), cB, voffB); PG8_STAGE(PG8_SA(0, 0), cA, voffA); PG8_STAGE(PG8_SB(0, 1), cB + hstepB, voffB); PG8_STAGE(PG8_SA(0, 1), cA + hstepA, voffA);
        if (wr == 1) PG8_BAR;
        PG8_WAIT_V(4); PG8_BAR;
        PG8_STAGE(PG8_SB(1, 0), cB + kstep, voffB); PG8_STAGE(PG8_SA(1, 0), cA + kstep, voffA); PG8_STAGE(PG8_SB(1, 1), cB + hstepB + kstep, voffB);
        PG8_WAIT_V(6); PG8_BAR;
    }
    for (;;) {
        const bool has_next = S.next(ui + 1, nxt);
        const char* nA = has_next ? (const char*)g.A + (size_t)nxt.pm * tstepA : cA; const char* nB = has_next ? (const char*)g.Bt + (size_t)nxt.pn * tstepB : cB;
        for (int t = 0; t < nt; t += 2) {
            const bool last = (t == nt - 2);
            const char* a1 = cA + (size_t)(t + 1) * kstep;
            const char* a2 = last ? nA : cA + (size_t)(t + 2) * kstep; const char* b2 = last ? nB : cB + (size_t)(t + 2) * kstep;
            const char* a3 = a2 + kstep; const char* b3 = b2 + kstep;
            if (last && has_next) S.a_ready(nxt);
            if constexpr (SP2) {
            PG8_LDB(B0, 0, 0); PG8_LDB(B1, 0, 1); PG8_SCHED; PG8_LDA(At, 0, 0); PG8_STAGE(PG8_SA(1, 1), a1 + hstepA, voffA);
            PG8_WAIT_V(8); PG8_WAIT_L(0); PG8_BAR; PG8_MMA(0, 0, At, B0); PG8_MMA(0, 1, At, B1); PG8_BAR; PG8_SCHED;
            PG8_LDA(At, 0, 1); PG8_STAGE(PG8_SB(0, 0), b2, voffB); PG8_STAGE(PG8_SB(0, 1), b2 + hstepB, voffB); PG8_STAGE(PG8_SA(0, 0), a2, voffA);
            PG8_WAIT_V(8); PG8_WAIT_L(0); PG8_BAR; PG8_MMA(1, 0, At, B0); PG8_MMA(1, 1, At, B1); PG8_BAR; PG8_SCHED;
            PG8_LDB(B0, 1, 0); PG8_LDB(B1, 1, 1); PG8_SCHED; PG8_LDA(At, 1, 0); PG8_STAGE(PG8_SA(0, 1), a2 + hstepA, voffA);
            PG8_WAIT_V(8); PG8_WAIT_L(0); PG8_BAR; PG8_MMA(0, 0, At, B0); PG8_MMA(0, 1, At, B1); PG8_BAR; PG8_SCHED;
            PG8_LDA(At, 1, 1); PG8_STAGE(PG8_SB(1, 0), b3, voffB); PG8_STAGE(PG8_SB(1, 1), b3 + hstepB, voffB); PG8_STAGE(PG8_SA(1, 0), a3, voffA);
            PG8_WAIT_V(8); PG8_WAIT_L(0); PG8_BAR; PG8_MMA(1, 0, At, B0); PG8_MMA(1, 1, At, B1); PG8_BAR; PG8_SCHED;
            } else {
            PG8_LDB(B0, 0, 0); PG8_SCHED; PG8_LDA(At, 0, 0); PG8_STAGE(PG8_SA(1, 1), a1 + hstepA, voffA);
            PG8_WAIT_L(8); PG8_BAR; PG8_WAIT_L(0); PG8_MMA(0, 0, At, B0); PG8_BAR; PG8_SCHED;
            PG8_LDB(B1, 0, 1); PG8_STAGE(PG8_SB(0, 0), b2, voffB);
            PG8_BAR; PG8_WAIT_L(0); PG8_MMA(0, 1, At, B1); PG8_BAR;
            PG8_LDA(At, 0, 1); PG8_STAGE(PG8_SA(0, 0), a2, voffA);
            PG8_BAR; PG8_WAIT_L(0); PG8_MMA(1, 0, At, B0); PG8_BAR; PG8_SCHED;
            PG8_STAGE(PG8_SB(0, 1), b2 + hstepB, voffB);
            PG8_WAIT_V(6); PG8_BAR; PG8_MMA(1, 1, At, B1); PG8_BAR;
            PG8_LDB(B0, 1, 0); PG8_SCHED; PG8_LDA(At, 1, 0); PG8_STAGE(PG8_SA(0, 1), a2 + hstepA, voffA);
            PG8_WAIT_L(8); PG8_BAR; PG8_WAIT_L(0); PG8_MMA(0, 0, At, B0); PG8_BAR; PG8_SCHED;
            PG8_LDB(B1, 1, 1); PG8_STAGE(PG8_SB(1, 0), b3, voffB);
            PG8_BAR; PG8_WAIT_L(0); PG8_MMA(0, 1, At, B1); PG8_BAR;
            PG8_LDA(At, 1, 1); PG8_STAGE(PG8_SA(1, 0), a3, voffA);
            PG8_BAR; PG8_WAIT_L(0); PG8_MMA(1, 0, At, B0); PG8_BAR; PG8_SCHED;
            PG8_STAGE(PG8_SB(1, 1), b3 + hstepB, voffB);
            PG8_WAIT_V(6); PG8_BAR; PG8_MMA(1, 1, At, B1); PG8_BAR;
            }
        }
        if constexpr (ALIGN_EPI) { if (wr == 0) PG8_BAR; }
        if constexpr (!Epi::AFTER_DRAIN) { E(acc, cur, wr, wc, fr, fq); S.done(cur); }
        if (!has_next) break;
#pragma unroll
        for (int a = 0; a < 2; ++a)
#pragma unroll
            for (int b = 0; b < 2; ++b)
#pragma unroll
                for (int m = 0; m < 4; ++m)
#pragma unroll
                    for (int n = 0; n < 2; ++n) acc[a][b][m][n] = (f32x4){0.f, 0.f, 0.f, 0.f};
        cur = nxt; cA = nA; cB = nB; ++ui;
        if constexpr (ALIGN_EPI) { if (wr == 1) PG8_BAR; }
    }
    PG8_WAIT_V(0);
    if constexpr (!ALIGN_EPI) { if (wr == 0) PG8_BAR; }
    PG8_BAR;
    if constexpr (Epi::AFTER_DRAIN) { E.fused(acc, cur, wr, wc, fr, fq, lds, wid, lane); S.done(cur); }
#undef PG8_SA
#undef PG8_SB
#undef PG8_STAGE
#undef PG8_LDA
#undef PG8_LDB
#undef PG8_MMA
#undef PG8_WAIT_V
#undef PG8_WAIT_L
#undef PG8_BAR
#undef PG8_SCHED
}
}

typedef unsigned short bf16_t;
typedef short bf16x8 __attribute__((ext_vector_type(8)));
typedef short s16x4 __attribute__((ext_vector_type(4)));
typedef float f32x4 __attribute__((ext_vector_type(4)));
typedef float f32x16 __attribute__((ext_vector_type(16)));
typedef unsigned u32x4 __attribute__((ext_vector_type(4)));
typedef unsigned u32x2 __attribute__((ext_vector_type(2)));
typedef float f32x2 __attribute__((ext_vector_type(2)));

constexpr int DM = 1024, NB = 8, SEQ = 2048, CTXL = 256, LT = SEQ + CTXL  , MROWS = NB * LT  ;
constexpr int EVEN_IN = 4608, ODD_IN = 5120, NCHUNK = LT / 64  ;
constexpr float RMS_EPS = 1e-6f, LOG2E = 1.4426950408889634f;
constexpr int LDS_BYTES = 160 * 1024;
constexpr int NPHASE = 21;

constexpr size_t WS_CTL = 0;
constexpr size_t WS_MOD = 65536;
constexpr size_t WS_ROPE = 524288;
constexpr size_t WS_AGG = 1048576;
constexpr size_t WS_HCTX = WS_AGG + 4718592;
constexpr size_t WS_WIN = WS_HCTX + 8388608;
constexpr size_t WS_WOUT = WS_WIN + 10485760;
constexpr size_t WS_WRG = WS_WOUT + 4194304;
constexpr size_t WS_OV = WS_WRG + 1048576;
constexpr size_t WS_P = WS_OV + 37748736;
constexpr size_t WS_END = WS_P + 188743680;
static_assert(WS_END <= 268435456, "workspace map exceeds 256 MiB");

struct Params {
    const float *x, *c, *ctx, *c_ctx, *ada_w, *ada_b, *norm_w, *ev_w_in, *ev_conv_w, *ev_conv_b, *ev_rg_wx, *ev_rg_bx, *ev_rg_wa, *ev_rg_ba,
        *ev_rg_lambda, *ev_sink, *ev_w_out, *od_w_in, *od_lb_raw, *od_gnorm_w, *od_w_out, *final_norm_w;
    float* out; unsigned char* ws; int ph_lo, ph_hi;
};

DI float bf2f(unsigned short v) { return __uint_as_float((unsigned)v << 16); }
DI unsigned f2bf(float f) { unsigned u = __float_as_uint(f); return (u + 0x7fffu + ((u >> 16) & 1u)) >> 16; }
typedef __bf16 bf16x2_hw __attribute__((ext_vector_type(2)));
DI unsigned pk2(float lo, float hi) { const f32x2 v = {lo, hi}; return __builtin_bit_cast(unsigned, __builtin_convertvector(v, bf16x2_hw)); }
DI float sigm(float x) { return __builtin_amdgcn_rcpf(1.f + __expf(-x)); }
DI float softplus_neg(float lam) {
    const float e = __expf(-lam);
    return e < 0.06f ? e * (1.f + e * (-0.5f + e * (0.33333333f + e * (-0.25f + e * 0.2f)))) : __logf(1.f + e);
}
DI float neg_expm1(float x) {
    return x > -0.25f ? -x * (1.f + x * (0.5f + x * (0.16666667f + x * (0.041666668f + x * (0.0083333338f + x * 0.0013888889f))))) : 1.f - __expf(x);
}
DI float wave_sum(float v) {
#pragma unroll
    for (int o = 1; o < 64; o <<= 1) v += shfl_xor_f(v, o);
    return v;
}
DI int crow(int reg, int h) { return (reg & 3) + 8 * (reg >> 2) + 4 * h; }
#define MFMA16(a, b, c) __builtin_amdgcn_mfma_f32_16x16x32_bf16((a), (b), (c), 0, 0, 0)
#define MFMA32(a, b, c) __builtin_amdgcn_mfma_f32_32x32x16_bf16((a), (b), (c), 0, 0, 0)

struct EpiStoreBf16 {
    static constexpr bool PERM = true, AFTER_DRAIN = false;
    bf16_t* O; int ldc;
    DI void operator()(const f32x4 (&acc)[2][2][4][2], const pg8::Unit& u, int wr, int wc, int fr, int fq) const {
        const int row0 = u.pm * 256 + wr * 64 + fr, col0 = u.pn * 256 + wc * 32 + 8 * fq;
#pragma unroll
        for (int ai = 0; ai < 2; ++ai)
#pragma unroll
            for (int m = 0; m < 4; ++m) { bf16_t* rowp = O + (size_t)(row0 + ai * 128 + m * 16) * ldc + col0;
#pragma unroll
                for (int bj = 0; bj < 2; ++bj) { const f32x4 v0 = acc[ai][bj][m][0], v1 = acc[ai][bj][m][1];
                    u32x4 w; w.x = pk2(v0[0], v0[1]); w.y = pk2(v0[2], v0[3]); w.z = pk2(v1[0], v1[1]); w.w = pk2(v1[2], v1[3]);
                    *(u32x4*)(rowp + bj * 128) = w; } }
    }
};
struct EpiResid {
    static constexpr bool PERM = false, AFTER_DRAIN = false;
    const float* in_lat; const float* in_ctx; float* out_lat; float* out_ctx; const float* gate;
    DI void operator()(const f32x4 (&acc)[2][2][4][2], const pg8::Unit& u, int wr, int wc, int fr, int fq) const {
        const int b = u.pm / 9, jt = u.pm % 9;
        const float* ib; float* ob; const float* g;
        if (jt == 0) { const size_t off = (size_t)b * CTXL * DM; ib = in_ctx + off; ob = out_ctx + off; g = gate + 8 * 3072; }
        else { const size_t off = ((size_t)b * SEQ + (size_t)(jt - 1) * 256) * DM; ib = in_lat + off; ob = out_lat + off; g = gate + b * 3072; }
        const int col0 = u.pn * 256 + wc * 32 + 4 * fq;
#pragma unroll
        for (int bj = 0; bj < 2; ++bj)
#pragma unroll
            for (int n = 0; n < 2; ++n) {
                const f32x4 gvv = *(const f32x4*)(g + col0 + bj * 128 + n * 16);
#pragma unroll
                for (int ai = 0; ai < 2; ++ai) {
#pragma unroll
                    for (int m = 0; m < 4; ++m) { const int r = ai * 128 + wr * 64 + m * 16 + fr;
                        const size_t off = (size_t)r * DM + col0 + bj * 128 + n * 16;
                        const f32x4 o = *(const f32x4*)(ib + off) + gvv * acc[ai][bj][m][n]; *(f32x4*)(ob + off) = o; }
                    asm volatile("" ::: "memory");
                }
            }
    }
};

struct EpiResidNorm {
    static constexpr bool PERM = false, AFTER_DRAIN = true;
    const float* in_lat; float* out_lat; const float* gate;
    const float* nw; const float* mod_next;
    bf16_t* U; float* xbuf; unsigned* cnt;
    DI void fused(f32x4 (&acc)[2][2][4][2], const pg8::Unit& u, int wr, int wc, int fr, int fq, LAS unsigned char* lds, int wid, int lane) const {
        const int b = u.pm / 9, jt = u.pm % 9, panel = b * 8 + jt - 1;
        const size_t roff = ((size_t)b * SEQ + (size_t)(jt - 1) * 256) * DM;
        const float* ib = in_lat + roff; float* ob = out_lat + roff; const float* g = gate + b * 3072;
        const int col0 = u.pn * 256 + wc * 32 + 4 * fq;
        LAS float* Pw = (LAS float*)lds;
        LAS float* Sr = (LAS float*)(lds + 4096);
        LAS unsigned* flag = (LAS unsigned*)(lds + 5120);
#pragma unroll
        for (int bj = 0; bj < 2; ++bj)
#pragma unroll
            for (int n = 0; n < 2; ++n) {
                const f32x4 gvv = *(const f32x4*)(g + col0 + bj * 128 + n * 16);
#pragma unroll
                for (int ai = 0; ai < 2; ++ai) {
#pragma unroll
                    for (int m = 0; m < 4; ++m) { const int r = ai * 128 + wr * 64 + m * 16 + fr;
                        const size_t off = (size_t)r * DM + col0 + bj * 128 + n * 16;
                        const f32x4 o = *(const f32x4*)(ib + off) + gvv * acc[ai][bj][m][n]; acc[ai][bj][m][n] = o;
                        if (mod_next) *(f32x4*)(ob + off) = o; }
                    asm volatile("" ::: "memory");
                }
            }
#pragma unroll
        for (int ai = 0; ai < 2; ++ai)
#pragma unroll
            for (int m = 0; m < 4; ++m) {
                float s = 0.f;
#pragma unroll
                for (int bj = 0; bj < 2; ++bj)
#pragma unroll
                    for (int n = 0; n < 2; ++n) { const f32x4 x = acc[ai][bj][m][n]; s += (x[0] * x[0] + x[1] * x[1]) + (x[2] * x[2] + x[3] * x[3]); }
                s += shfl_xor_f(s, 16); s += shfl_xor_f(s, 32);
                if (fq == 0) Pw[(ai * 128 + wr * 64 + m * 16 + fr) * 4 + wc] = s;
            }
        asm volatile("s_waitcnt lgkmcnt(0)" ::: "memory"); __builtin_amdgcn_s_barrier(); asm volatile("" ::: "memory");
        const int row = wid * 32 + (lane & 31);
        if (lane < 32) {
            const float t = (Pw[row * 4 + 0] + Pw[row * 4 + 1]) + (Pw[row * 4 + 2] + Pw[row * 4 + 3]);
            __hip_atomic_store((unsigned*)xbuf + ((size_t)panel * 256 + row) * 4 + u.pn, __float_as_uint(t), __ATOMIC_RELAXED, __HIP_MEMORY_SCOPE_AGENT);
        }
        asm volatile("s_waitcnt vmcnt(0)" ::: "memory");
        if (lane == 0) __hip_atomic_fetch_add(cnt + 16 * panel, 1u, __ATOMIC_RELAXED, __HIP_MEMORY_SCOPE_AGENT);
        if (wid == 0) {
            unsigned spins = 0;
            while ((unsigned)__builtin_amdgcn_readfirstlane(__hip_atomic_load(cnt + 16 * panel, __ATOMIC_RELAXED, __HIP_MEMORY_SCOPE_AGENT)) < 32u) { __builtin_amdgcn_s_sleep(2); if (++spins > (1u << 22)) break; }
            if (lane == 0) flag[0] = 1u;
        }
        asm volatile("s_waitcnt vmcnt(0) lgkmcnt(0)" ::: "memory"); __builtin_amdgcn_s_barrier(); asm volatile("" ::: "memory");
        if (lane < 32) {
            const unsigned* slot = (const unsigned*)xbuf + ((size_t)panel * 256 + row) * 4;
            const float t = (__uint_as_float(__hip_atomic_load(slot + 0, __ATOMIC_RELAXED, __HIP_MEMORY_SCOPE_AGENT)) + __uint_as_float(__hip_atomic_load(slot + 1, __ATOMIC_RELAXED, __HIP_MEMORY_SCOPE_AGENT)))
                          + (__uint_as_float(__hip_atomic_load(slot + 2, __ATOMIC_RELAXED, __HIP_MEMORY_SCOPE_AGENT)) + __uint_as_float(__hip_atomic_load(slot + 3, __ATOMIC_RELAXED, __HIP_MEMORY_SCOPE_AGENT)));
            Sr[row] = rsqrtf(t * (1.f / DM) + RMS_EPS);
        }
        asm volatile("s_waitcnt lgkmcnt(0)" ::: "memory"); __builtin_amdgcn_s_barrier(); asm volatile("" ::: "memory");
        const float* sh = mod_next ? mod_next + b * 3072 : nullptr;
#pragma unroll
        for (int bj = 0; bj < 2; ++bj)
#pragma unroll
            for (int n = 0; n < 2; ++n) {
                const int cc = col0 + bj * 128 + n * 16;
                const f32x4 w4 = *(const f32x4*)(nw + cc);
                f32x4 s4 = {1.f, 1.f, 1.f, 1.f}, h4 = {0.f, 0.f, 0.f, 0.f};
                if (mod_next) { s4 = *(const f32x4*)(sh + 1024 + cc) + 1.f; h4 = *(const f32x4*)(sh + cc); }
#pragma unroll
                for (int ai = 0; ai < 2; ++ai)
#pragma unroll
                    for (int m = 0; m < 4; ++m) { const int r = ai * 128 + wr * 64 + m * 16 + fr;
                        const f32x4 y = (acc[ai][bj][m][n] * Sr[r]) * w4;
                        if (mod_next) { const f32x4 o = y * s4 + h4; u32x2 w; w.x = pk2(o[0], o[1]); w.y = pk2(o[2], o[3]); *(u32x2*)(U + ((size_t)u.pm * 256 + r) * DM + cc) = w; }
                        else *(f32x4*)(ob + (size_t)r * DM + cc) = y; }
            }
    }
};

constexpr int MG_STAGE = 27648;
template <class EpiF>
DI void mini_gemm_tile(LAS unsigned char* lds, const bf16_t* A, int lda, const bf16_t* Bt, int K, const EpiF& epi, int wv) {
    const int tid = get_tid(wv), lane = tid & 63, wave = tid >> 6, r = lane & 31, h = lane >> 5, wm = wave >> 2, wn = wave & 3;
    const int lrow = tid >> 3, lch = tid & 7, nS = K / 64;
    const bf16_t* ap = A + (size_t)lrow * lda + 8 * lch;
    const bf16_t* bp0 = Bt + (size_t)lrow * K + 8 * lch; const bf16_t* bp1 = Bt + (size_t)(64 + lrow) * K + 8 * lch;
    u32x4 s0[3], s1[3];
    f32x16 acc;
#pragma unroll
    for (int i = 0; i < 16; ++i) acc[i] = 0.f;
#define MG_LOAD(set, s) do { (set)[0] = *(const u32x4*)(ap + (s) * 64); (set)[1] = *(const u32x4*)(bp0 + (s) * 64); (set)[2] = *(const u32x4*)(bp1 + (s) * 64); } while (0)
#define MG_STORE(set, buf) do { LAS unsigned char* b_ = lds + (buf) * MG_STAGE; *(LAS u32x4*)(b_ + lrow * 144 + lch * 16) = (set)[0]; \
        *(LAS u32x4*)(b_ + 9216 + lrow * 144 + lch * 16) = (set)[1]; *(LAS u32x4*)(b_ + 9216 + (64 + lrow) * 144 + lch * 16) = (set)[2]; } while (0)
#define MG_COMPUTE(buf) do { const LAS unsigned char* b_ = lds + (buf) * MG_STAGE; \
        _Pragma("unroll") for (int ks = 0; ks < 4; ++ks) { \
            const bf16x8 af = *(const LAS bf16x8*)(b_ + (32 * wm + r) * 144 + (16 * ks + 8 * h) * 2); \
            const bf16x8 bf = *(const LAS bf16x8*)(b_ + 9216 + (32 * wn + r) * 144 + (16 * ks + 8 * h) * 2); \
            acc = MFMA32(af, bf, acc); } } while (0)
    MG_LOAD(s0, 0); MG_LOAD(s1, 1);
    __syncthreads();
    MG_STORE(s0, 0);
    if (nS > 2) MG_LOAD(s0, 2);
#pragma unroll 1
    for (int s = 0; s < nS; s += 2) {
        __syncthreads();
        if (s + 1 < nS) { MG_STORE(s1, 1); if (s + 3 < nS) MG_LOAD(s1, s + 3); }
        MG_COMPUTE(0);
        __syncthreads();
        if (s + 2 < nS) { MG_STORE(s0, 0); if (s + 4 < nS) MG_LOAD(s0, s + 4); }
        if (s + 1 < nS) MG_COMPUTE(1);
    }
#undef MG_LOAD
#undef MG_STORE
#undef MG_COMPUTE
    epi(acc, 32 * wm, 32 * wn + r, h);
    __syncthreads();
}

DI void phase_pro(const Params& P, LAS unsigned char* lds, int wv) {
    const int tid = get_tid(wv);
    LAS float* s = (LAS float*)lds;
    LAS float* red = (LAS float*)(lds + 36864);
    float* mod = (float*)(P.ws + WS_MOD);
    for (int i = tid; i < 9 * 1024; i += 512) { const int r = i >> 10, k = i & 1023; const float v = r < 8 ? P.c[r * 1024 + k] : P.c_ctx[k]; s[i] = v * sigm(v); }
    __syncthreads();
    for (int item = get_bid(); item < 384; item += gridDim.x) {
        const int l = item / 96, n0 = (item % 96) * 32, ks = tid >> 5, col = tid & 31;
        const float* w = P.ada_w + (size_t)l * 1024 * 3072 + n0 + col;
        float acc[9];
#pragma unroll
        for (int r = 0; r < 9; ++r) acc[r] = 0.f;
#pragma unroll 8
        for (int kk = 0; kk < 64; ++kk) { const int k = ks * 64 + kk; const float wv = w[(size_t)k * 3072];
#pragma unroll
            for (int r = 0; r < 9; ++r) acc[r] += s[r * 1024 + k] * wv; }
#pragma unroll
        for (int r = 0; r < 9; ++r) red[(ks * 9 + r) * 32 + col] = acc[r];
        __syncthreads();
        if (tid < 288) { const int r = tid >> 5, cc = tid & 31; float sum = 0.f;
#pragma unroll
            for (int k2 = 0; k2 < 16; ++k2) sum += red[(k2 * 9 + r) * 32 + cc];
            mod[(l * 9 + r) * 3072 + n0 + cc] = sum + P.ada_b[l * 3072 + n0 + cc]; }
        __syncthreads();
    }
    float* cos_t = (float*)(P.ws + WS_ROPE); float* sin_t = cos_t + SEQ * 32;
    for (int i = get_bid() * 512 + tid; i < SEQ * 32; i += gridDim.x * 512) {
        const int pos = i >> 5, jj = i & 31, fi = jj & 15;
        const float inv = __builtin_amdgcn_exp2f(-(float)(2 * fi) * (13.287712379549449f / 32.f));
        const float ang = (float)(jj < 16 ? (pos >> 6) : (pos & 63)) * inv;
        cos_t[i] = __cosf(ang); sin_t[i] = __sinf(ang);
    }
}

template <bool FRAG = false>
DI void transpose_item(const float* W, int K, int N, bf16_t* WT, LAS float* scr, int item, int lane) {
    const int nblk = N / 32, kb = item / nblk, nb = item % nblk, k0 = 64 * kb, n0 = 32 * nb;
#pragma unroll 8
    for (int i = 0; i < 32; ++i) { const int kk = 2 * i + (lane >> 5); scr[kk * 33 + (lane & 31)] = W[(size_t)(k0 + kk) * N + n0 + (lane & 31)]; }
    asm volatile("s_waitcnt lgkmcnt(0)" ::: "memory");
    const int c = lane & 7;
#pragma unroll
    for (int j = 0; j < 4; ++j) { const int n = (lane >> 3) + 8 * j; const LAS float* sp = scr + (8 * c) * 33 + n;
        u32x4 o; o.x = pk2(sp[0 * 33], sp[1 * 33]); o.y = pk2(sp[2 * 33], sp[3 * 33]); o.z = pk2(sp[4 * 33], sp[5 * 33]); o.w = pk2(sp[6 * 33], sp[7 * 33]);
        if (FRAG) {
            const int nn = n0 + n, k8 = (k0 >> 3) + c;
            *(u32x4*)(WT + ((((nn >> 4) * 4 + (k8 >> 2)) * 64 + (k8 & 3) * 16 + (nn & 15)) * 8)) = o;
        } else *(u32x4*)(WT + (size_t)(n0 + n) * K + k0 + 8 * c) = o; }
    asm volatile("s_waitcnt lgkmcnt(0)" ::: "memory");
}

DI void phase_norm(const Params& P, LAS unsigned char* lds, int layer, int wv) {
    const int tid = get_tid(wv), lane = tid & 63, wave = tid >> 6;
    const int gw = get_bid() * 8 + wave, NGW = gridDim.x * 8;
    const int j = layer >> 1;
    LAS float* scr = (LAS float*)(lds + wave * 16384);
    bf16_t* WIN = (bf16_t*)(P.ws + WS_WIN); bf16_t* WOUT = (bf16_t*)(P.ws + WS_WOUT); bf16_t* WRG = (bf16_t*)(P.ws + WS_WRG);
    if ((layer & 1) == 0) {
        constexpr int I_IN = 16 * (EVEN_IN / 32), I_OUT = 32 * 32, I_RG = 32 * 8;
        for (int it = gw; it < I_IN + I_OUT + I_RG; it += NGW) {
            int r = it;
            if (r < I_IN) { transpose_item(P.ev_w_in + (size_t)j * 1024 * EVEN_IN, 1024, EVEN_IN, WIN, scr, r, lane); continue; } r -= I_IN;
            if (r < I_OUT) { transpose_item(P.ev_w_out + (size_t)j * 2048 * 1024, 2048, 1024, WOUT, scr, r, lane); continue; } r -= I_OUT;
            const int mat = r >> 3, sub = r & 7;
            const int dir = mat >> 4, gate = (mat >> 3) & 1, hd = mat & 7;
            const float* src = (gate == 0 ? P.ev_rg_wx : P.ev_rg_wa) + ((size_t)((j * 2 + dir) * 8 + hd)) * 16384;
            transpose_item<true>(src, 128, 128, WRG + (size_t)mat * 16384, scr, sub, lane);
        }
    } else {
        constexpr int I_IN = 16 * (ODD_IN / 32), I_OUT = 16 * 32;
        for (int it = gw; it < I_IN + I_OUT; it += NGW) {
            int r = it;
            if (r < I_IN) { transpose_item(P.od_w_in + (size_t)j * 1024 * ODD_IN, 1024, ODD_IN, WIN, scr, r, lane); continue; } r -= I_IN;
            transpose_item(P.od_w_out + (size_t)j * 1024 * 1024, 1024, 1024, WOUT, scr, r, lane);
        }
    }
    const float* hl = layer == 0 ? P.x : P.out; const float* hc = layer == 0 ? P.ctx : (const float*)(P.ws + WS_HCTX);
    const float* mod = (const float*)(P.ws + WS_MOD) + (size_t)layer * 9 * 3072;
    const float* nw = P.norm_w + layer * 1024;
    bf16_t* U = (bf16_t*)(P.ws + WS_OV);
    f32x4 w4[4], s4[4], h4[4];
#pragma unroll
    for (int q = 0; q < 4; ++q) w4[q] = *(const f32x4*)(nw + 4 * lane + 256 * q);
    int cur_m = -1;
    const int nrows = layer == 0 ? MROWS : NB * CTXL;
    const int rpw = (nrows + NGW - 1) / NGW;
    for (int idx = gw * rpw; idx < gw * rpw + rpw && idx < nrows; ++idx) {
        const int b = layer == 0 ? idx / LT : idx >> 8, jr = layer == 0 ? idx % LT : idx & 255;
        const int R = b * LT + jr;
        const float* src = jr < CTXL ? hc + ((size_t)b * CTXL + jr) * DM : hl + ((size_t)b * SEQ + (jr - CTXL)) * DM;
        const int mrow = jr < CTXL ? 8 : b;
        if (mrow != cur_m) {
            cur_m = mrow;
            const float* sh = mod + mrow * 3072; const float* sc = sh + 1024;
#pragma unroll
            for (int q = 0; q < 4; ++q) { s4[q] = *(const f32x4*)(sc + 4 * lane + 256 * q) + 1.f; h4[q] = *(const f32x4*)(sh + 4 * lane + 256 * q); }
        }
        f32x4 v[4]; float ss = 0.f;
#pragma unroll
        for (int q = 0; q < 4; ++q) { v[q] = *(const f32x4*)(src + 4 * lane + 256 * q); ss += (v[q][0] * v[q][0] + v[q][1] * v[q][1]) + (v[q][2] * v[q][2] + v[q][3] * v[q][3]); }
        const float rstd = rsqrtf(wave_sum(ss) * (1.f / DM) + RMS_EPS);
#pragma unroll
        for (int q = 0; q < 4; ++q) { const int k = 4 * lane + 256 * q;
            const f32x4 y = (v[q] * rstd) * w4[q]; const f32x4 o = y * s4[q] + h4[q];
            u32x2 w; w.x = pk2(o[0], o[1]); w.y = pk2(o[2], o[3]); *(u32x2*)(U + (size_t)R * DM + k) = w; }
    }
}

typedef _Float16 f16x2_t __attribute__((ext_vector_type(2)));
DI unsigned pkh2(float a, float b) { const f16x2_t v = {(_Float16)a, (_Float16)b}; return __builtin_bit_cast(unsigned, v); }
DI void unpkh2(unsigned u, float& a, float& b) { const f16x2_t v = __builtin_bit_cast(f16x2_t, u); a = (float)v[0]; b = (float)v[1]; }
constexpr int RG_UT = 0, RG_AL = 17408, RG_BL = 50176, RG_HP = 82944, RG_QA = 148480, RG_CAR = 152576, RG_FLAG = 153600, RG_END = 153664;
static_assert(RG_END <= LDS_BYTES - 256, "RG-LRU LDS map");
constexpr int CW_RG = 8192;
DI void rglru_item(const Params& P, LAS unsigned char* lds, int j, int item, int wv) {
    const int tid = get_tid(wv), lane = tid & 63, wave = tid >> 6, r = lane & 15, g = lane >> 4;
    const int grp = item / NCHUNK, ci = item % NCHUNK, b = grp >> 3, hd = grp & 7;
    bf16_t* p = (bf16_t*)(P.ws + WS_P);
    const bf16_t* WRG = (const bf16_t*)(P.ws + WS_WRG);
    unsigned long long* AGG = (unsigned long long*)(P.ws + WS_AGG);
    unsigned* cnt = (unsigned*)(P.ws + WS_CTL) + CW_RG + (j * 64 + grp) * 16;
    const int R0 = b * LT + ci * 64;
    const int seg_lo = b * LT + (ci < 4 ? 0 : CTXL), seg_hi = b * LT + (ci < 4 ? CTXL : LT);
    LAS bf16_t* UT = (LAS bf16_t*)(lds + RG_UT);
    LAS float* AL = (LAS float*)(lds + RG_AL);
    LAS float* BL = (LAS float*)(lds + RG_BL);
    LAS unsigned* HP = (LAS unsigned*)(lds + RG_HP);
    LAS float* QA = (LAS float*)(lds + RG_QA);
    LAS float* CAR = (LAS float*)(lds + RG_CAR);
    TP_START(10, lds, tid); TP_START(11, lds, tid);
    bf16x8 wfr[2][2][4];
    float prm[2][3];
#pragma unroll
    for (int dir = 0; dir < 2; ++dir) {
#pragma unroll
        for (int gt = 0; gt < 2; ++gt) {
            const bf16_t* W = WRG + (size_t)((dir * 2 + gt) * 8 + hd) * 16384 + (wave * 4 * 64 + lane) * 8;
#pragma unroll
            for (int ks = 0; ks < 4; ++ks) wfr[dir][gt][ks] = *(const bf16x8*)(W + ks * 512);
        }
        const int idx = (j * 2 + dir) * 1024 + hd * 128 + 16 * wave + r;
        prm[dir][0] = P.ev_rg_bx[idx]; prm[dir][1] = P.ev_rg_ba[idx]; prm[dir][2] = P.ev_rg_lambda[idx];
    }
    {
        LAS bf16_t* XT = (LAS bf16_t*)(lds + RG_HP);
#pragma unroll
        for (int rep = 0; rep < 3; ++rep) {
            const int idx = tid + rep * 512, tr = idx >> 4, c0 = (idx & 15) * 8;
            if (idx < 67 * 16) {
                const int Rg = R0 + tr - 1;
                u32x4 xv = {0u, 0u, 0u, 0u};
                if (Rg >= seg_lo && Rg < seg_hi) xv = *(const u32x4*)(p + (size_t)Rg * EVEN_IN + hd * 128 + c0);
                *(LAS u32x4*)(XT + tr * 128 + c0) = xv;
            }
        }
        const int c0 = (tid & 15) * 8, cg0 = hd * 128 + c0;
        float wv4[4][8], bias[8];
        { const f32x4 b0 = *(const f32x4*)(P.ev_conv_b + j * 1024 + cg0), b1 = *(const f32x4*)(P.ev_conv_b + j * 1024 + cg0 + 4);
          bias[0] = b0[0]; bias[1] = b0[1]; bias[2] = b0[2]; bias[3] = b0[3]; bias[4] = b1[0]; bias[5] = b1[1]; bias[6] = b1[2]; bias[7] = b1[3]; }
#pragma unroll
        for (int k = 0; k < 4; ++k) { const float* wk = P.ev_conv_w + (size_t)(j * 4 + k) * 1024 + cg0; const f32x4 w0 = *(const f32x4*)wk, w1 = *(const f32x4*)(wk + 4);
            wv4[k][0] = w0[0]; wv4[k][1] = w0[1]; wv4[k][2] = w0[2]; wv4[k][3] = w0[3]; wv4[k][4] = w1[0]; wv4[k][5] = w1[1]; wv4[k][6] = w1[2]; wv4[k][7] = w1[3]; }
        __syncthreads();
#pragma unroll
        for (int rep = 0; rep < 2; ++rep) {
            const int t = (tid >> 4) + rep * 32;
            float acc[8];
#pragma unroll
            for (int e = 0; e < 8; ++e) acc[e] = bias[e];
#pragma unroll
            for (int k = 0; k < 4; ++k) {
                const u32x4 xv = *(const LAS u32x4*)(XT + (t + k) * 128 + c0);
                acc[0] += wv4[k][0] * __uint_as_float(xv.x << 16); acc[1] += wv4[k][1] * __uint_as_float(xv.x & 0xffff0000u);
                acc[2] += wv4[k][2] * __uint_as_float(xv.y << 16); acc[3] += wv4[k][3] * __uint_as_float(xv.y & 0xffff0000u);
                acc[4] += wv4[k][4] * __uint_as_float(xv.z << 16); acc[5] += wv4[k][5] * __uint_as_float(xv.z & 0xffff0000u);
                acc[6] += wv4[k][6] * __uint_as_float(xv.w << 16); acc[7] += wv4[k][7] * __uint_as_float(xv.w & 0xffff0000u);
            }
            u32x4 o; o.x = pk2(acc[0], acc[1]); o.y = pk2(acc[2], acc[3]); o.z = pk2(acc[4], acc[5]); o.w = pk2(acc[6], acc[7]);
            *(LAS u32x4*)(UT + t * 136 + c0) = o;
        }
    }
    __syncthreads();
    TP_STOP(11, lds, tid);
#pragma unroll
    for (int dir = 0; dir < 2; ++dir) {
        TP_START(12, lds, tid); TP_START(16, lds, tid);
        f32x4 ax[4], aa[4];
#pragma unroll
        for (int m = 0; m < 4; ++m) { ax[m] = (f32x4){0.f, 0.f, 0.f, 0.f}; aa[m] = (f32x4){0.f, 0.f, 0.f, 0.f}; }
#pragma unroll
        for (int ks = 0; ks < 4; ++ks) {
#pragma unroll
            for (int m = 0; m < 4; ++m) {
                const bf16x8 a = *(const LAS bf16x8*)(UT + (16 * m + r) * 136 + 32 * ks + 8 * g);
                ax[m] = MFMA16(a, wfr[dir][0][ks], ax[m]); aa[m] = MFMA16(a, wfr[dir][1][ks], aa[m]);
            }
        }
        asm volatile("" :: "v"(ax[0]), "v"(ax[1]), "v"(ax[2]), "v"(ax[3]), "v"(aa[0]), "v"(aa[1]), "v"(aa[2]), "v"(aa[3]));
        TP_STOP(16, lds, tid); TP_START(17, lds, tid);
        {
            const int c = 16 * wave + r;
            const float bxv = prm[dir][0], bav = prm[dir][1], lam = prm[dir][2];
            const float sp = softplus_neg(lam);
#pragma unroll
            for (int m = 0; m < 4; ++m)
#pragma unroll
                for (int i = 0; i < 4; ++i) {
                    const int t = 16 * m + 4 * g + i;
                    const float gx = sigm(ax[m][i] + bxv), ga = sigm(aa[m][i] + bav);
                    const float la = -8.f * ga * sp;
                    const float a = __expf(la), mult = __builtin_amdgcn_sqrtf(neg_expm1(2.f * la));
                    const float uv = bf2f(UT[t * 136 + c]);
                    AL[t * 128 + c] = a; BL[t * 128 + c] = mult * gx * uv;
                }
        }
        asm volatile("s_waitcnt lgkmcnt(0)" ::: "memory");
        TP_STOP(17, lds, tid); TP_START(18, lds, tid);
        __syncthreads();
        TP_STOP(18, lds, tid);
        TP_STOP(12, lds, tid); TP_START(13, lds, tid);
        {
            const int c = tid & 127, q = tid >> 7;
            float A = 1.f, B = 0.f;
#pragma unroll
            for (int s = 0; s < 16; ++s) { const int t = dir == 0 ? 16 * q + s : 16 * q + 15 - s; const float a = AL[t * 128 + c], bb = BL[t * 128 + c]; B = a * B + bb; A *= a; }
            QA[(q * 128 + c) * 2] = A; QA[(q * 128 + c) * 2 + 1] = B;
            __syncthreads();
            float h = 0.f, pc = 1.f;
            const int nprev = dir == 0 ? q : 3 - q;
            for (int qq = 0; qq < nprev; ++qq) { const int qi = dir == 0 ? qq : 3 - qq; const float a = QA[(qi * 128 + c) * 2]; h = a * h + QA[(qi * 128 + c) * 2 + 1]; pc *= a; }
#pragma unroll
            for (int s = 0; s < 16; ++s) { const int t = dir == 0 ? 16 * q + s : 16 * q + 15 - s; const float a = AL[t * 128 + c]; h = a * h + BL[t * 128 + c]; pc *= a;
                HP[(dir * 64 + t) * 128 + c] = pkh2(h, pc); }
            if (nprev == 3) {
                const unsigned long long v = ((unsigned long long)__float_as_uint(h) << 32) | __float_as_uint(pc);
                __hip_atomic_store(AGG + ((size_t)(dir * NB + b) * NCHUNK + ci) * 1024 + hd * 128 + c, v, __ATOMIC_RELAXED, __HIP_MEMORY_SCOPE_AGENT);
            }
        }
        __syncthreads();
        TP_STOP(13, lds, tid);
    }
    TP_START(14, lds, tid);
    u32x4 gpre[2];
#pragma unroll
    for (int rep = 0; rep < 2; ++rep) { const int idx = tid + rep * 512; gpre[rep] = *(const u32x4*)(p + (size_t)(R0 + (idx >> 4)) * EVEN_IN + 1536 + hd * 128 + (idx & 15) * 8); }
    asm volatile("s_waitcnt vmcnt(0)" ::: "memory");
    __syncthreads();
    if (tid == 0) {
        __hip_atomic_fetch_add(cnt, 1u, __ATOMIC_RELAXED, __HIP_MEMORY_SCOPE_AGENT);
        unsigned spins = 0;
        while (__hip_atomic_load(cnt, __ATOMIC_RELAXED, __HIP_MEMORY_SCOPE_AGENT) < (unsigned)NCHUNK) { __builtin_amdgcn_s_sleep(2); if (++spins > (1u << 22)) break; }
    }
    __syncthreads();
    TP_STOP(14, lds, tid); TP_START(15, lds, tid);
    if (tid < 256) {
        const int dir = tid >> 7, c = tid & 127;
        const int pos = dir == 0 ? ci : (ci < 4 ? 3 - ci : 39 - ci);
        float h = 0.f;
        const unsigned long long* ag = AGG + (size_t)(dir * NB + b) * NCHUNK * 1024 + hd * 128 + c;
#pragma unroll 1
        for (int base = 0; base < pos; base += 18) {
            unsigned long long v[18];
#pragma unroll
            for (int k = 0; k < 18; ++k) { const int pp = base + k < pos ? base + k : pos - 1; const int cc = dir == 0 ? pp : (pp < 4 ? 3 - pp : 39 - pp);
                v[k] = __hip_atomic_load(ag + (size_t)cc * 1024, __ATOMIC_RELAXED, __HIP_MEMORY_SCOPE_AGENT); }
#pragma unroll
            for (int k = 0; k < 18; ++k) if (base + k < pos) h = __uint_as_float((unsigned)v[k]) * h + __uint_as_float((unsigned)(v[k] >> 32));
        }
        CAR[dir * 128 + c] = h;
    }
    __syncthreads();
#pragma unroll
    for (int rep = 0; rep < 2; ++rep) {
        const int idx = tid + rep * 512, t = idx >> 4, c0 = (idx & 15) * 8;
        bf16_t* gp = p + (size_t)(R0 + t) * EVEN_IN + 1536 + hd * 128 + c0;
        const u32x4 gv = gpre[rep];
        float y[8];
#pragma unroll
        for (int e = 0; e < 8; ++e) {
            float h0, p0, h1, p1; unpkh2(HP[t * 128 + c0 + e], h0, p0); unpkh2(HP[(64 + t) * 128 + c0 + e], h1, p1);
            y[e] = (h0 + p0 * CAR[c0 + e]) + (h1 + p1 * CAR[128 + c0 + e]);
        }
        const float gg[8] = {__uint_as_float(gv.x << 16), __uint_as_float(gv.x & 0xffff0000u), __uint_as_float(gv.y << 16), __uint_as_float(gv.y & 0xffff0000u),
                             __uint_as_float(gv.z << 16), __uint_as_float(gv.z & 0xffff0000u), __uint_as_float(gv.w << 16), __uint_as_float(gv.w & 0xffff0000u)};
        u32x4 o;
        o.x = pk2(y[0] * gg[0] * sigm(gg[0]), y[1] * gg[1] * sigm(gg[1])); o.y = pk2(y[2] * gg[2] * sigm(gg[2]), y[3] * gg[3] * sigm(gg[3]));
        o.z = pk2(y[4] * gg[4] * sigm(gg[4]), y[5] * gg[5] * sigm(gg[5])); o.w = pk2(y[6] * gg[6] * sigm(gg[6]), y[7] * gg[7] * sigm(gg[7]));
        *(u32x4*)gp = o;
    }
    __syncthreads();
    TP_STOP(15, lds, tid); TP_STOP(10, lds, tid);
}

DI void rope8v(u32x4& v, const f32x4 cs, const f32x4 sn) {
    unsigned* w = (unsigned*)&v;
#pragma unroll
    for (int i = 0; i < 4; ++i) { const float t1 = __uint_as_float(w[i] << 16), t2 = __uint_as_float(w[i] & 0xffff0000u); w[i] = pk2(t1 * cs[i] - t2 * sn[i], t1 * sn[i] + t2 * cs[i]); }
}
DI void rope8(u32x4& v, const float* cs, const float* sn) { rope8v(v, *(const f32x4*)cs, *(const f32x4*)sn); }
typedef short v4i16_a __attribute__((ext_vector_type(4)));
DI void attn_item(const Params& P, LAS unsigned char* lds, int j, int item, int wv) {
    const int tid = get_tid(wv), lane = tid & 63, wave = tid >> 6, r = lane & 31, h = lane >> 5;
    const bool is_lat = item < 512;
    int b, qb, kvh;
    if (is_lat) { b = item >> 6; qb = (item >> 2) & 15; kvh = item & 3; } else { const int it = item - 512; b = it >> 3; qb = (it >> 2) & 1; kvh = it & 3; }
    bf16_t* p = (bf16_t*)(P.ws + WS_P);
    const float* cos_t = (const float*)(P.ws + WS_ROPE); const float* sin_t = cos_t + SEQ * 32;
    LAS unsigned char* QL = lds + 36864 + wave * 9216;
    TP_START(1, lds, tid);
    const int hq = 4 * kvh + (wave >> 1), ql0 = qb * 128 + 64 * (wave & 1);
    const size_t rowbase = (size_t)b * LT + (is_lat ? CTXL : 0);
    {
        const int chq = lane & 7;
#pragma unroll
        for (int k = 0; k < 8; ++k) {
            const int row = (lane >> 3) + 8 * k, qi = ql0 + row;
            u32x4 v = *(const u32x4*)(p + (rowbase + qi) * EVEN_IN + 2560 + hq * 64 + 8 * chq);
            if (is_lat) rope8(v, cos_t + qi * 32 + 4 * chq, sin_t + qi * 32 + 4 * chq);
            *(LAS u32x4*)(QL + row * 144 + chq * 16) = v;
        }
    }
    const float sink2 = P.ev_sink[j * 16 + hq] * LOG2E;
    float mrun[2] = {sink2, sink2}, lrun[2] = {h == 0 ? 1.f : 0.f, h == 0 ? 1.f : 0.f};
    f32x16 O[2][2];
#pragma unroll
    for (int a = 0; a < 2; ++a)
#pragma unroll
        for (int c = 0; c < 2; ++c)
#pragma unroll
            for (int i = 0; i < 16; ++i) O[a][c][i] = 0.f;
    const int w_lo = (is_lat && qb == 0) ? 2 : 0, w_hi = (is_lat && qb == 15) ? 3 : 5;
    const int nT = is_lat ? 4 + (w_hi - w_lo + 1) : 4;
    const float SC = 0.125f * LOG2E, NEG = -1e30f;
    const int key = tid >> 3, chn = tid & 7;
    u32x4 kreg, vreg; f32x4 creg, sreg;
#define ATT_K0(t) ((t) < 4 ? 64 * (t) : qb * 128 - 128 + 64 * (w_lo + (t) - 4))
#define ATT_LOAD(t) do { const bool win_ = (t) >= 4; const int k0_ = ATT_K0(t); \
        const bf16_t* kp_ = p + ((size_t)b * LT + (win_ ? CTXL : 0) + k0_ + key) * EVEN_IN + 1024 + kvh * 64 + 8 * chn; \
        kreg = *(const u32x4*)kp_; vreg = *(const u32x4*)(kp_ + 256); \
        if (win_) { creg = *(const f32x4*)(cos_t + (k0_ + key) * 32 + 4 * chn); sreg = *(const f32x4*)(sin_t + (k0_ + key) * 32 + 4 * chn); } } while (0)
#define ATT_STORE(t, buf) do { const bool win_ = (t) >= 4; \
        if (win_) rope8v(kreg, creg, sreg); \
        *(LAS u32x4*)(lds + (buf) * 18432 + key * 144 + chn * 16) = kreg; *(LAS u32x4*)(lds + (buf) * 18432 + 9216 + key * 144 + chn * 16) = vreg; } while (0)
    TP_START(2, lds, tid);
    ATT_LOAD(0); ATT_STORE(0, 0);
    if (nT > 1) ATT_LOAD(1);
#pragma unroll 1
    for (int t = 0; t < nT; ++t) {
        TP_START(4, lds, tid);
        __syncthreads();
        TP_STOP(4, lds, tid);
        if (t + 1 < nT) { ATT_STORE(t + 1, (t + 1) & 1); if (t + 2 < nT) ATT_LOAD(t + 2); }
        TP_START(3, lds, tid);
        const bool win = t >= 4;
        const int k0 = ATT_K0(t);
        const int dq = k0 - ql0;
        if (win && (dq >= 192 || dq <= -192)) continue;
        const bool need_mask = win && (dq >= 128 || dq <= -128);
        const LAS unsigned char* KL = lds + (t & 1) * 18432;
        const LAS bf16_t* VL = (const LAS bf16_t*)(lds + (t & 1) * 18432 + 9216);
#pragma unroll
        for (int qt = 0; qt < 2; ++qt) {
            f32x16 s0, s1;
#pragma unroll
            for (int i = 0; i < 16; ++i) { s0[i] = 0.f; s1[i] = 0.f; }
#pragma unroll
            for (int ks = 0; ks < 4; ++ks) {
                const bf16x8 qfr = *(const LAS bf16x8*)(QL + (32 * qt + r) * 144 + (16 * ks + 8 * h) * 2);
                const bf16x8 k0f = *(const LAS bf16x8*)(KL + r * 144 + (16 * ks + 8 * h) * 2), k1f = *(const LAS bf16x8*)(KL + (32 + r) * 144 + (16 * ks + 8 * h) * 2);
                s0 = MFMA32(k0f, qfr, s0); s1 = MFMA32(k1f, qfr, s1);
            }
            const int qpos = ql0 + 32 * qt + r;
            float mx = NEG;
            if (need_mask) {
#pragma unroll
                for (int i = 0; i < 16; ++i) {
                    const int d0 = qpos - (k0 + crow(i, h)), d1 = d0 - 32;
                    float v0 = s0[i] * SC, v1 = s1[i] * SC;
                    if (d0 > 128 || d0 < -128) v0 = NEG;
                    if (d1 > 128 || d1 < -128) v1 = NEG;
                    s0[i] = v0; s1[i] = v1; mx = fmaxf(mx, fmaxf(v0, v1));
                }
            } else {
#pragma unroll
                for (int i = 0; i < 16; ++i) { s0[i] *= SC; s1[i] *= SC; mx = fmaxf(mx, fmaxf(s0[i], s1[i])); }
            }
            mx = fmaxf(mx, shfl_xor_f(mx, 32));
            const float mn = fmaxf(mrun[qt], mx), alpha = __builtin_amdgcn_exp2f(mrun[qt] - mn);
            mrun[qt] = mn;
            float ls = 0.f;
#pragma unroll
            for (int i = 0; i < 16; ++i) { s0[i] = __builtin_amdgcn_exp2f(s0[i] - mn); s1[i] = __builtin_amdgcn_exp2f(s1[i] - mn); ls += s0[i] + s1[i]; }
            lrun[qt] = lrun[qt] * alpha + ls;
#pragma unroll
            for (int dt = 0; dt < 2; ++dt)
#pragma unroll
                for (int i = 0; i < 16; ++i) O[dt][qt][i] *= alpha;
            bf16x8 pf[2][2];
#pragma unroll
            for (int s = 0; s < 2; ++s) {
                u32x4 a, c;
                a.x = pk2(s0[8 * s + 0], s0[8 * s + 1]); a.y = pk2(s0[8 * s + 2], s0[8 * s + 3]); a.z = pk2(s0[8 * s + 4], s0[8 * s + 5]); a.w = pk2(s0[8 * s + 6], s0[8 * s + 7]);
                c.x = pk2(s1[8 * s + 0], s1[8 * s + 1]); c.y = pk2(s1[8 * s + 2], s1[8 * s + 3]); c.z = pk2(s1[8 * s + 4], s1[8 * s + 5]); c.w = pk2(s1[8 * s + 6], s1[8 * s + 7]);
                pf[0][s] = __builtin_bit_cast(bf16x8, a); pf[1][s] = __builtin_bit_cast(bf16x8, c);
            }
            const int gq = (lane >> 4) & 1, qq4 = (lane & 15) >> 2, pp4 = lane & 3;
#pragma unroll
            for (int dt = 0; dt < 2; ++dt)
#pragma unroll
                for (int kt = 0; kt < 2; ++kt)
#pragma unroll
                    for (int s = 0; s < 2; ++s) {
                        const LAS bf16_t* vp = VL + (32 * kt + 16 * s + 4 * h + qq4) * 72 + 32 * dt + 16 * gq + 4 * pp4;
                        const v4i16_a lo = __builtin_amdgcn_ds_read_tr16_b64_v4i16((LAS v4i16_a*)vp);
                        const v4i16_a hi = __builtin_amdgcn_ds_read_tr16_b64_v4i16((LAS v4i16_a*)(vp + 8 * 72));
                        const bf16x8 vf = {lo[0], lo[1], lo[2], lo[3], hi[0], hi[1], hi[2], hi[3]};
                        O[dt][qt] = MFMA32(vf, pf[kt][s], O[dt][qt]);
                    }
            __builtin_amdgcn_sched_barrier(0);
        }
        TP_STOP(3, lds, tid);
    }
    TP_STOP(2, lds, tid);
#undef ATT_K0
#undef ATT_LOAD
#undef ATT_STORE
    {
        const int chq = lane & 7;
        u32x4 gate[8];
#pragma unroll
        for (int k = 0; k < 8; ++k) gate[k] = *(const u32x4*)(p + (rowbase + ql0 + (lane >> 3) + 8 * k) * EVEN_IN + 3584 + hq * 64 + 8 * chq);
#pragma unroll
        for (int qt = 0; qt < 2; ++qt) {
            const float lt = lrun[qt] + shfl_xor_f(lrun[qt], 32), inv = __builtin_amdgcn_rcpf(lt);
#pragma unroll
            for (int dt = 0; dt < 2; ++dt)
#pragma unroll
                for (int i4 = 0; i4 < 4; ++i4) {
                    u32x2 o; o.x = pk2(O[dt][qt][4 * i4 + 0] * inv, O[dt][qt][4 * i4 + 1] * inv); o.y = pk2(O[dt][qt][4 * i4 + 2] * inv, O[dt][qt][4 * i4 + 3] * inv);
                    *(LAS u32x2*)(QL + (32 * qt + r) * 144 + (32 * dt + 8 * i4 + 4 * h) * 2) = o;
                }
        }
#pragma unroll
        for (int k = 0; k < 8; ++k) {
            const int row = (lane >> 3) + 8 * k;
            const u32x4 ov = *(const LAS u32x4*)(QL + row * 144 + chq * 16);
            const unsigned* ow = (const unsigned*)&ov; const unsigned* gw = (const unsigned*)&gate[k];
            u32x4 res; unsigned* rw = (unsigned*)&res;
#pragma unroll
            for (int e = 0; e < 4; ++e) {
                const float g0 = __uint_as_float(gw[e] << 16), g1 = __uint_as_float(gw[e] & 0xffff0000u);
                rw[e] = pk2(__uint_as_float(ow[e] << 16) * g0 * sigm(g0), __uint_as_float(ow[e] & 0xffff0000u) * g1 * sigm(g1));
            }
            *(u32x4*)(p + (rowbase + ql0 + row) * EVEN_IN + 2560 + hq * 64 + 8 * chq) = res;
        }
    }
    __syncthreads();
    TP_STOP(1, lds, tid);
}

constexpr int G2_QX = 0, G2_KF = 17408, G2_K2 = 60928, G2_VS = 79360, G2_AM = 96768, G2_ST = 105984, G2_PS = 140800, G2_BL = 144896, G2_Q1 = 145408, G2_END = 162816;
static_assert(G2_END <= LDS_BYTES - 256, "GLA LDS map");
typedef short v4i16_t __attribute__((ext_vector_type(4)));
DI bf16x8 frag_tr(const LAS bf16_t* M, int stride, int k0, int n0, int lane) {
    const int i = lane & 15, g = lane >> 4, q = i >> 2, pp = i & 3;
    const LAS bf16_t* a0 = M + (k0 + 8 * g + q) * stride + n0 + 4 * pp;
    const v4i16_t lo = __builtin_amdgcn_ds_read_tr16_b64_v4i16((LAS v4i16_t*)a0);
    const v4i16_t hi = __builtin_amdgcn_ds_read_tr16_b64_v4i16((LAS v4i16_t*)(a0 + 4 * stride));
    return (bf16x8){lo[0], lo[1], lo[2], lo[3], hi[0], hi[1], hi[2], hi[3]};
}

#ifndef GLA_SPLIT
#define GLA_SPLIT 22
#endif
template <int DIR>
DI void gla2_item(const Params& P, LAS unsigned char* lds, int layer_j, int b, int hd, int part, int wv) {
    const int tid = get_tid(wv), lane = tid & 63, wave = tid >> 6, r = lane & 15, g = lane >> 4;
    bf16_t* p = (bf16_t*)(P.ws + WS_P);
    LAS bf16_t* QX = (LAS bf16_t*)(lds + G2_QX); LAS bf16_t* KF = (LAS bf16_t*)(lds + G2_KF); LAS bf16_t* K2 = (LAS bf16_t*)(lds + G2_K2);
    LAS bf16_t* VS = (LAS bf16_t*)(lds + G2_VS); LAS bf16_t* AM = (LAS bf16_t*)(lds + G2_AM); LAS bf16_t* ST = (LAS bf16_t*)(lds + G2_ST);
    LAS float* PS8 = (LAS float*)(lds + G2_PS); LAS float* BLAST = (LAS float*)(lds + G2_BL); LAS bf16_t* Q1 = (LAS bf16_t*)(lds + G2_Q1);
    const int d0 = 2 * lane, tg = wave, I = tg >> 1, half = tg & 1;
    float lbv[2] = {0.f, 0.f};
    if (layer_j > 0) { lbv[0] = sigm(P.od_lb_raw[1024 + hd * 128 + d0] - P.od_lb_raw[hd * 128 + d0]); lbv[1] = sigm(P.od_lb_raw[1024 + hd * 128 + d0 + 1] - P.od_lb_raw[hd * 128 + d0 + 1]); }
    unsigned* prog = (unsigned*)(P.ws + WS_CTL) + 10240 + ((layer_j * 128 + b * 16 + hd * 2 + DIR) * 8);
    const int step_end = part == 0 ? GLA_SPLIT : NCHUNK;
    TP_START(20, lds, tid);
    for (int i = tid; i < (9216 + 34816) / 4; i += 512) ((LAS unsigned*)(lds + G2_AM))[i] = 0u;
    f32x4 st[8];
#pragma unroll
    for (int e = 0; e < 8; ++e) st[e] = (f32x4){0.f, 0.f, 0.f, 0.f};
    unsigned zn[8], qn[8]; u32x4 vn[2];
#define G2_OFFZ(s) ((unsigned)((DIR == 0 ? 8 * tg + (s) : 63 - 8 * tg - (s)) * ODD_IN + d0) * 2u)
#define G2_OFFV(rep) ((unsigned)((DIR == 0 ? ((tid + (rep) * 512) >> 4) : 63 - ((tid + (rep) * 512) >> 4)) * ODD_IN + 8 * ((tid + (rep) * 512) & 15)) * 2u)
    const size_t colz = (size_t)DIR * 1024 + hd * 128, colq = 3072 + hd * 128, colv = 2048 + hd * 128;
    {
        const int chunk = DIR == 0 ? 0 : 3;
        const char* slab = (const char*)(p + ((size_t)b * LT + (size_t)chunk * 64) * ODD_IN);
#pragma unroll
        for (int s = 0; s < 8; ++s) { zn[s] = *(const unsigned*)(slab + colz * 2 + G2_OFFZ(s)); qn[s] = *(const unsigned*)(slab + colq * 2 + G2_OFFZ(s)); }
#pragma unroll
        for (int rep = 0; rep < 2; ++rep) vn[rep] = *(const u32x4*)(slab + colv * 2 + G2_OFFV(rep));
    }
    __syncthreads();
#pragma unroll 1
    for (int step = 0; step < step_end; ++step) {
        const bool sonly = part == 1 && step < GLA_SPLIT;
        const int chunk = DIR == 0 ? step : (step < 4 ? 3 - step : 39 - step);
        const size_t Rc0 = (size_t)b * LT + (size_t)chunk * 64;
        unsigned zc[8], qc[8]; u32x4 vc[2];
#pragma unroll
        for (int s = 0; s < 8; ++s) { zc[s] = zn[s]; qc[s] = qn[s]; }
        vc[0] = vn[0]; vc[1] = vn[1];
        TP_START(21, lds, tid);
        float el[8][2], kk[8][2], qq[8][2];
        {
            float run0 = 1.f, run1 = 1.f;
#pragma unroll
            for (int s = 0; s < 8; ++s) {
                const float z0 = __uint_as_float(zc[s] << 16), z1 = __uint_as_float(zc[s] & 0xffff0000u);
                const float t0 = __expf(-z0), t1 = __expf(-z1), sg0 = __builtin_amdgcn_rcpf(1.f + t0), sg1 = __builtin_amdgcn_rcpf(1.f + t1);
                const float f0 = fmaxf(lbv[0] + (1.f - lbv[0]) * sg0, 1e-30f), f1 = fmaxf(lbv[1] + (1.f - lbv[1]) * sg1, 1e-30f);
                kk[s][0] = (1.f - lbv[0]) * (t0 * sg0); kk[s][1] = (1.f - lbv[1]) * (t1 * sg1);
                run0 = fmaxf(run0 * f0, 1e-35f); run1 = fmaxf(run1 * f1, 1e-35f); el[s][0] = run0; el[s][1] = run1;
                const float q0 = __uint_as_float(qc[s] << 16), q1 = __uint_as_float(qc[s] & 0xffff0000u);
                qq[s][0] = q0 * __builtin_amdgcn_rcpf(1.f + __expf(-q0)); qq[s][1] = q1 * __builtin_amdgcn_rcpf(1.f + __expf(-q1));
                if ((s & 1) == 1) __builtin_amdgcn_sched_barrier(0);
            }
            *(LAS f32x2*)(PS8 + tg * 128 + d0) = (f32x2){run0, run1};
#pragma unroll
            for (int rep = 0; rep < 2; ++rep) { const int idx = tid + rep * 512, tau = idx >> 4, chn = idx & 15; *(LAS u32x4*)(VS + tau * 136 + 8 * chn) = vc[rep]; }
        }
        __syncthreads();
        if (part == 1 && step < GLA_SPLIT && tid == 0) __hip_atomic_store(prog, (unsigned)(step + 1), __ATOMIC_RELAXED, __HIP_MEMORY_SCOPE_AGENT);
        TP_STOP(21, lds, tid); TP_START(22, lds, tid);
        float RI[2];
        {
            float T[8][2];
#pragma unroll
            for (int q8 = 0; q8 < 8; ++q8) { const f32x2 t = *(const LAS f32x2*)(PS8 + q8 * 128 + d0); T[q8][0] = t[0]; T[q8][1] = t[1]; }
            float pre[2], fac[4][2], f4[2];
#pragma unroll
            for (int x = 0; x < 2; ++x) {
                const float P0 = T[0][x] * T[1][x], P1 = T[2][x] * T[3][x], P2 = T[4][x] * T[5][x], P3 = T[6][x] * T[7][x];
                pre[x] = half ? (I == 0 ? T[0][x] : (I == 1 ? T[2][x] : (I == 2 ? T[4][x] : T[6][x]))) : 1.f;
                RI[x] = I == 0 ? 1.f : (I == 1 ? P0 : (I == 2 ? P0 * P1 : P0 * P1 * P2));
                float cur = 1.f;
                fac[0][x] = cur; if (I <= 0) cur *= P0;
                fac[1][x] = cur; if (I <= 1) cur *= P1;
                fac[2][x] = cur; if (I <= 2) cur *= P2;
                fac[3][x] = cur; cur *= P3;
                f4[x] = cur;
                if (tg == 0) BLAST[d0 + x] = P0 * P1 * P2 * P3;
            }
            unsigned w0[4], w1[4];
#pragma unroll
            for (int s = 0; s < 8; ++s) {
                const int tau = 8 * tg + s;
                const float e00 = fmaxf(pre[0] * el[s][0], 1e-35f), e01 = fmaxf(pre[1] * el[s][1], 1e-35f);
                const float qi0 = qq[s][0] * e00, qi1 = qq[s][1] * e01;
                const float kd0 = kk[s][0] * __builtin_amdgcn_rcpf(e00), kd1 = kk[s][1] * __builtin_amdgcn_rcpf(e01);
                if (!sonly) {
                *(LAS unsigned*)(QX + tau * 136 + d0) = pk2(qi0, qi1);
                *(LAS unsigned*)(Q1 + tau * 136 + d0) = pk2(qi0 * RI[0], qi1 * RI[1]);
                if (I <= 0) *(LAS unsigned*)(KF + (0 + tau) * 136 + d0) = pk2(kd0 * fac[0][0], kd1 * fac[0][1]);
                if (I <= 1) *(LAS unsigned*)(KF + (16 + tau) * 136 + d0) = pk2(kd0 * fac[1][0], kd1 * fac[1][1]);
                if (I <= 2) *(LAS unsigned*)(KF + (48 + tau) * 136 + d0) = pk2(kd0 * fac[2][0], kd1 * fac[2][1]);
                *(LAS unsigned*)(KF + (96 + tau) * 136 + d0) = pk2(kd0 * fac[3][0], kd1 * fac[3][1]);
                }
                const unsigned h0 = f2bf(kd0 * f4[0]), h1 = f2bf(kd1 * f4[1]);
                if (s & 1) { w0[s >> 1] |= h0 << 16; w1[s >> 1] |= h1 << 16; } else { w0[s >> 1] = h0; w1[s >> 1] = h1; }
                if ((s & 1) == 1) __builtin_amdgcn_sched_barrier(0);
            }
            *(LAS u32x4*)(K2 + (d0 + 0) * 72 + 8 * tg) = (u32x4){w0[0], w0[1], w0[2], w0[3]};
            *(LAS u32x4*)(K2 + (d0 + 1) * 72 + 8 * tg) = (u32x4){w1[0], w1[1], w1[2], w1[3]};
        }
        __syncthreads();
        TP_STOP(22, lds, tid); TP_START(23, lds, tid);
        if (step + 1 < step_end) {
            const int nchunk = DIR == 0 ? step + 1 : (step + 1 < 4 ? 2 - step : 38 - step);
            const char* slab = (const char*)(p + ((size_t)b * LT + (size_t)nchunk * 64) * ODD_IN);
#pragma unroll
            for (int s = 0; s < 8; ++s) { zn[s] = *(const unsigned*)(slab + colz * 2 + G2_OFFZ(s)); qn[s] = *(const unsigned*)(slab + colq * 2 + G2_OFFZ(s)); }
#pragma unroll
            for (int rep = 0; rep < 2; ++rep) vn[rep] = *(const u32x4*)(slab + colv * 2 + G2_OFFV(rep));
        }
#pragma unroll 1
        for (int bi = sonly ? 10 : wave; bi < 10; bi += 8) {
            const int Ib = bi < 1 ? 0 : (bi < 3 ? 1 : (bi < 6 ? 2 : 3)), Jb = bi - (Ib * (Ib + 1)) / 2;
            const int foff = Ib == 0 ? 0 : (Ib == 1 ? 16 : (Ib == 2 ? 48 : 96));
            f32x4 acc = {0.f, 0.f, 0.f, 0.f};
#pragma unroll
            for (int ks = 0; ks < 4; ++ks) {
                const bf16x8 a = *(const LAS bf16x8*)(QX + (16 * Ib + r) * 136 + 32 * ks + 8 * g);
                const bf16x8 bb = *(const LAS bf16x8*)(KF + (foff + 16 * Jb + r) * 136 + 32 * ks + 8 * g);
                acc = MFMA16(a, bb, acc);
            }
#pragma unroll
            for (int i = 0; i < 4; ++i) { float v = acc[i]; if (Jb == Ib && r > 4 * g + i) v = 0.f; AM[(16 * Ib + 4 * g + i) * 72 + 16 * Jb + r] = (bf16_t)f2bf(v); }
        }
        if (!sonly) __syncthreads();
        TP_STOP(23, lds, tid); TP_START(24, lds, tid);
        {
            if (!sonly) {
            const int tt = wave >> 1, eb = 4 * (wave & 1);
            bf16x8 aq[4], am[2];
#pragma unroll
            for (int ks = 0; ks < 4; ++ks) aq[ks] = *(const LAS bf16x8*)(Q1 + (16 * tt + r) * 136 + 32 * ks + 8 * g);
#pragma unroll
            for (int ks = 0; ks < 2; ++ks) am[ks] = *(const LAS bf16x8*)(AM + (16 * tt + r) * 72 + 32 * ks + 8 * g);
#pragma unroll
            for (int e4 = 0; e4 < 4; ++e4) {
                const int et = eb + e4;
                f32x4 acc = {0.f, 0.f, 0.f, 0.f};
#pragma unroll
                for (int ks = 0; ks < 4; ++ks) { const bf16x8 bb = *(const LAS bf16x8*)(ST + (16 * et + r) * 136 + 32 * ks + 8 * g); acc = MFMA16(aq[ks], bb, acc); }
#pragma unroll
                for (int ks = 0; ks < 2; ++ks) acc = MFMA16(am[ks], frag_tr(VS, 136, 32 * ks, 16 * et, lane), acc);
#pragma unroll
                for (int i = 0; i < 4; ++i) KF[(16 * tt + 4 * g + i) * 136 + 16 * et + r] = (bf16_t)f2bf(acc[i]);
                __builtin_amdgcn_sched_barrier(0);
            }
            }
            float bl[4];
#pragma unroll
            for (int i = 0; i < 4; ++i) bl[i] = BLAST[16 * wave + 4 * g + i];
            bf16x8 ak[2];
#pragma unroll
            for (int ks = 0; ks < 2; ++ks) ak[ks] = *(const LAS bf16x8*)(K2 + (16 * wave + r) * 72 + 32 * ks + 8 * g);
#pragma unroll
            for (int et = 0; et < 8; ++et) {
#pragma unroll
                for (int i = 0; i < 4; ++i) st[et][i] *= bl[i];
#pragma unroll
                for (int ks = 0; ks < 2; ++ks) st[et] = MFMA16(ak[ks], frag_tr(VS, 136, 32 * ks, 16 * et, lane), st[et]);
                if (et & 1) __builtin_amdgcn_sched_barrier(0);
            }
        }
        if (part == 0 && tid == 0) { unsigned spins = 0; while (__hip_atomic_load(prog, __ATOMIC_RELAXED, __HIP_MEMORY_SCOPE_AGENT) < (unsigned)(step + 1)) { __builtin_amdgcn_s_sleep(2); if (++spins > (1u << 22)) break; } }
        __syncthreads();
        TP_STOP(24, lds, tid); TP_START(25, lds, tid);
        if (!sonly) {
            char* oslab = (char*)(p + Rc0 * ODD_IN + colz);
#pragma unroll
            for (int rep = 0; rep < 2; ++rep) {
                const int idx = tid + rep * 512, tau = idx >> 4, chn = idx & 15;
                const u32x4 ov = *(const LAS u32x4*)(KF + tau * 136 + 8 * chn);
                *(u32x4*)(oslab + (unsigned)((DIR == 0 ? tau : 63 - tau) * ODD_IN + 8 * chn) * 2u) = ov;
            }
        }
        if (!sonly || step == GLA_SPLIT - 1) {
#pragma unroll
        for (int et = 0; et < 8; ++et) { u32x2 w; w.x = pk2(st[et][0], st[et][1]); w.y = pk2(st[et][2], st[et][3]); *(LAS u32x2*)(ST + (16 * et + r) * 136 + 16 * wave + 4 * g) = w; }
        }
        TP_STOP(25, lds, tid);
    }
    __syncthreads();
    TP_STOP(20, lds, tid);
}

DI void phase_readout(const Params& P, int layer_j, int wv) {
    const int tid = get_tid(wv), lane = tid & 63, wave = tid >> 6;
    const int gw = get_bid() * 8 + wave, NGW = gridDim.x * 8;
    bf16_t* p = (bf16_t*)(P.ws + WS_P);
    const float* gwt = P.od_gnorm_w + layer_j * 128 + (lane & 7) * 16;
    for (int R = gw; R < MROWS; R += NGW) {
        const bf16_t* op = p + (size_t)R * ODD_IN + 16 * lane; bf16_t* yp = p + (size_t)R * ODD_IN + 4096 + 16 * lane;
        const u32x4 o0 = *(const u32x4*)op, o1 = *(const u32x4*)(op + 8), c0 = *(const u32x4*)(op + 1024), c1 = *(const u32x4*)(op + 1032), g0 = *(const u32x4*)yp, g1 = *(const u32x4*)(yp + 8);
        float ov[16], gv[16];
        const unsigned* ow0 = (const unsigned*)&o0; const unsigned* ow1 = (const unsigned*)&o1; const unsigned* cw0 = (const unsigned*)&c0; const unsigned* cw1 = (const unsigned*)&c1;
        const unsigned* gw0 = (const unsigned*)&g0; const unsigned* gw1 = (const unsigned*)&g1;
#pragma unroll
        for (int i = 0; i < 4; ++i) {
            ov[2 * i] = __uint_as_float(ow0[i] << 16) + __uint_as_float(cw0[i] << 16); ov[2 * i + 1] = __uint_as_float(ow0[i] & 0xffff0000u) + __uint_as_float(cw0[i] & 0xffff0000u);
            ov[8 + 2 * i] = __uint_as_float(ow1[i] << 16) + __uint_as_float(cw1[i] << 16); ov[8 + 2 * i + 1] = __uint_as_float(ow1[i] & 0xffff0000u) + __uint_as_float(cw1[i] & 0xffff0000u);
            gv[2 * i] = __uint_as_float(gw0[i] << 16); gv[2 * i + 1] = __uint_as_float(gw0[i] & 0xffff0000u); gv[8 + 2 * i] = __uint_as_float(gw1[i] << 16); gv[8 + 2 * i + 1] = __uint_as_float(gw1[i] & 0xffff0000u);
        }
        float ss = 0.f;
#pragma unroll
        for (int i = 0; i < 16; ++i) ss += ov[i] * ov[i];
        ss += shfl_xor_f(ss, 1); ss += shfl_xor_f(ss, 2); ss += shfl_xor_f(ss, 4);
        const float rstd = rsqrtf(ss * (1.f / 128.f) + RMS_EPS);
        float y[16];
#pragma unroll
        for (int i = 0; i < 16; ++i) y[i] = ov[i] * rstd * gwt[i] * (gv[i] * sigm(gv[i]));
        u32x4 w0, w1;
        w0.x = pk2(y[0], y[1]); w0.y = pk2(y[2], y[3]); w0.z = pk2(y[4], y[5]); w0.w = pk2(y[6], y[7]);
        w1.x = pk2(y[8], y[9]); w1.y = pk2(y[10], y[11]); w1.z = pk2(y[12], y[13]); w1.w = pk2(y[14], y[15]);
        *(u32x4*)yp = w0; *(u32x4*)(yp + 8) = w1;
    }
}

DI void phase_final(const Params& P, int wv) {
    const int tid = get_tid(wv), lane = tid & 63, wave = tid >> 6;
    const int gw = get_bid() * 8 + wave, NGW = gridDim.x * 8;
    for (int R = gw; R < NB * SEQ; R += NGW) {
        float* row = P.out + (size_t)R * DM;
        f32x4 v[4]; float ss = 0.f;
#pragma unroll
        for (int q = 0; q < 4; ++q) { v[q] = *(const f32x4*)(row + 4 * lane + 256 * q); ss += (v[q][0] * v[q][0] + v[q][1] * v[q][1]) + (v[q][2] * v[q][2] + v[q][3] * v[q][3]); }
        const float rstd = rsqrtf(wave_sum(ss) * (1.f / DM) + RMS_EPS);
#pragma unroll
        for (int q = 0; q < 4; ++q) { const f32x4 w4 = *(const f32x4*)(P.final_norm_w + 4 * lane + 256 * q); *(f32x4*)(row + 4 * lane + 256 * q) = (v[q] * rstd) * w4; }
    }
}

#define XB_TMO      128
#define XB_XCNT(j)  (256  + 64 * (j))
#define XB_XSUB(j)  (1280 + 64 * (j))
#define XB_XGEN(j)  (2304 + 64 * (j))
#define XB_TOP      3328
#define XB_TOPGEN   3392
#define XCD_BAR_WORDS 3456
#define XB_SPIN_CAP (1u << 18)

__device__ __forceinline__ unsigned xb_ld(unsigned* p)              { return __hip_atomic_load(p, __ATOMIC_RELAXED, __HIP_MEMORY_SCOPE_AGENT); }
__device__ __forceinline__ unsigned xb_add(unsigned* p, unsigned v) { return __hip_atomic_fetch_add(p, v, __ATOMIC_RELAXED, __HIP_MEMORY_SCOPE_AGENT); }
__device__ __forceinline__ unsigned xb_xcc_id() { return (unsigned)__builtin_amdgcn_s_getreg((3 << 11) | 20) & 0xFu; }
#define XB_SPIN(cond, bar) do { unsigned _sp = 0; while (cond) { __builtin_amdgcn_s_sleep(1); \
    if ((++_sp & 255u) == 0u) { if (xb_ld(&(bar)[XB_TMO])) break; if (_sp > XB_SPIN_CAP) { atomicAdd(&(bar)[XB_TMO], 1u); break; } } } } while (0)

struct XcdBarrier {
    unsigned* bar; unsigned x;
    volatile LAS unsigned* st;
};

__device__ __forceinline__ XcdBarrier xcd_barrier_post(unsigned* bar, volatile LAS unsigned* st, int wv) {
    XcdBarrier b; b.bar = bar; b.x = xb_xcc_id(); b.st = st;
    if (get_tid(wv) == 0) (void)xb_add(&bar[XB_XCNT(b.x)], 1u);
    return b;
}
__device__ __forceinline__ void xcd_barrier_complete(unsigned* bar, unsigned x, unsigned& nloc, unsigned& nx) {
    const unsigned G = gridDim.x * gridDim.y * gridDim.z;
    unsigned sum, cnt, mine, sp = 0u;
    for (;;) {
        sum = 0u; cnt = 0u; mine = 0u;
#pragma unroll
        for (unsigned j = 0; j < 16; ++j) { const unsigned c = xb_ld(&bar[XB_XCNT(j)]); sum += c; cnt += (c > 0u) ? 1u : 0u; mine = (j == x) ? c : mine; }
        if (sum == G) break;
        __builtin_amdgcn_s_sleep(1);
        if ((++sp & 255u) == 0u) { if (xb_ld(&bar[XB_TMO])) break; if (sp > XB_SPIN_CAP) { atomicAdd(&bar[XB_TMO], 1u); break; } }
    }
    nloc = mine > 0u ? mine : 1u; nx = cnt > 0u ? cnt : 1u;
}

__device__ __forceinline__ void xcd_barrier(const XcdBarrier& b, int wv) {
    asm volatile("s_waitcnt vmcnt(0)" ::: "memory");
    __syncthreads();
    if (get_tid(wv) == 0) {
        unsigned* bar = b.bar;
        __builtin_amdgcn_s_waitcnt(0);
        unsigned nloc = b.st[0], nx = b.st[1];
        if (nloc == 0u) { xcd_barrier_complete(bar, b.x, nloc, nx); b.st[0] = nloc; b.st[1] = nx; }
        const unsigned old = xb_add(&bar[XB_XSUB(b.x)], 1u);
        const unsigned gen = old / nloc;
        if (old + 1u == (gen + 1u) * nloc) {
            __builtin_amdgcn_fence(__ATOMIC_RELEASE, "agent");
            asm volatile("s_waitcnt vmcnt(0)" ::: "memory");
            const unsigned og = xb_add(&bar[XB_TOP], 1u);
            const unsigned tg = og / nx;
            if (og + 1u == (tg + 1u) * nx) xb_add(&bar[XB_TOPGEN], 1u);
            else XB_SPIN(xb_ld(&bar[XB_TOPGEN]) == tg, bar);
            __builtin_amdgcn_fence(__ATOMIC_ACQUIRE, "agent");
            xb_add(&bar[XB_XGEN(b.x)], 1u);
            asm volatile("s_waitcnt vmcnt(0)" ::: "memory");
        } else {
            XB_SPIN(xb_ld(&bar[XB_XGEN(b.x)]) == gen, bar);
            __builtin_amdgcn_fence(__ATOMIC_ACQUIRE, "agent");
            asm volatile("s_waitcnt vmcnt(0)" ::: "memory");
        }
    }
    __syncthreads();
}

constexpr int PARAM_OFF = LDS_BYTES - 256;
static_assert(G2_END <= PARAM_OFF && sizeof(Params) <= 208, "LDS map");
DI const float* ld_uptr(const LAS unsigned long long* s, int i) {
    const unsigned long long v = s[i];
    const unsigned lo = __builtin_amdgcn_readfirstlane((unsigned)v), hi = __builtin_amdgcn_readfirstlane((unsigned)(v >> 32));
    return (const float*)(const __attribute__((address_space(1))) float*)(((unsigned long long)hi << 32) | lo);
}
DI Params load_params(LAS unsigned char* lds) {
    LAS unsigned char* pb = lds + PARAM_OFF; asm volatile("" : "+v"(pb));
    const LAS unsigned long long* s = (const LAS unsigned long long*)pb;
    Params Q;
    Q.x = ld_uptr(s, 0); Q.c = ld_uptr(s, 1); Q.ctx = ld_uptr(s, 2); Q.c_ctx = ld_uptr(s, 3); Q.ada_w = ld_uptr(s, 4); Q.ada_b = ld_uptr(s, 5); Q.norm_w = ld_uptr(s, 6);
    Q.ev_w_in = ld_uptr(s, 7); Q.ev_conv_w = ld_uptr(s, 8); Q.ev_conv_b = ld_uptr(s, 9); Q.ev_rg_wx = ld_uptr(s, 10); Q.ev_rg_bx = ld_uptr(s, 11); Q.ev_rg_wa = ld_uptr(s, 12);
    Q.ev_rg_ba = ld_uptr(s, 13); Q.ev_rg_lambda = ld_uptr(s, 14); Q.ev_sink = ld_uptr(s, 15); Q.ev_w_out = ld_uptr(s, 16); Q.od_w_in = ld_uptr(s, 17); Q.od_lb_raw = ld_uptr(s, 18);
    Q.od_gnorm_w = ld_uptr(s, 19); Q.od_w_out = ld_uptr(s, 20); Q.final_norm_w = ld_uptr(s, 21); Q.out = (float*)ld_uptr(s, 22); Q.ws = (unsigned char*)ld_uptr(s, 23);
    Q.ph_lo = 0; Q.ph_hi = 0;
    return Q;
}
DI void run_phase(LAS unsigned char* lds, int ph, int wv) {
    #ifndef PHMASK
#define PHMASK 0xffff
#endif
    if (ph == 0) { if (PHMASK & 1) { const Params P = load_params(lds); phase_pro(P, lds, wv); } return; }
    const int layer = (ph - 1) / 5, sub = (ph - 1) % 5, j = layer >> 1;
    const bool even = (layer & 1) == 0;
    if (sub == 0) { if (PHMASK & 4) { const Params P = load_params(lds); phase_norm(P, lds, layer, wv); } return; }
    if (sub == 1) {
        const Params P = load_params(lds); bf16_t* pbuf = (bf16_t*)(P.ws + WS_P);
        const int N = even ? EVEN_IN : ODD_IN;
        pg8::Gemm gm{(const bf16_t*)(P.ws + WS_OV), (const bf16_t*)(P.ws + WS_WIN), MROWS, N, 1024, 1024};
        pg8::StaticOrder S; S.init(MROWS, N, (int)gridDim.x, get_bid());
        EpiStoreBf16 E{pbuf, N};
        if (even) S.limit = 1280;
        if (PHMASK & 8) pg8::gemm_phase<EpiStoreBf16, pg8::StaticOrder, true, true>(lds, gm, S, E, wv);
        if (even) {
            for (int t = get_bid(); t < 128; t += gridDim.x) {
                pg8::Unit u; S.tile_of(1280 + (t >> 3), u);
                const int m0 = 256 * u.pm + 64 * ((t & 7) >> 1), n0 = 256 * u.pn + 128 * (t & 1);
                auto epi = [&](const f32x16& acc, int row0, int col, int hh) {
#pragma unroll
                    for (int i = 0; i < 16; ++i) pbuf[(size_t)(m0 + row0 + crow(i, hh)) * N + n0 + col] = (bf16_t)f2bf(acc[i]);
                };
                mini_gemm_tile(lds, (const bf16_t*)(P.ws + WS_OV) + (size_t)m0 * 1024, 1024, (const bf16_t*)(P.ws + WS_WIN) + (size_t)n0 * 1024, 1024, epi, wv);
            }
        }
        return;
    }
    if (sub == 2) {
        const Params P = load_params(lds);
        if (even) {
            constexpr int NRG = NB * NCHUNK * 8;
#if defined(SPLIT_ATTN)
            for (int it = get_bid(); it < NRG; it += gridDim.x) rglru_item(P, lds, j, it, wv);
#else
            for (int it = get_bid(); it < NRG + 576; it += gridDim.x) {
                if (it < NRG) { if (PHMASK & 32) rglru_item(P, lds, j, it, wv); } else { if (PHMASK & 16) attn_item(P, lds, j, it - NRG, wv); }
            }
#endif
        } else {
            for (int it = get_bid(); it < 256; it += gridDim.x) { if (PHMASK & 64) { if (it & 2) gla2_item<1>(P, lds, j, it >> 5, (it >> 2) & 7, it & 1, wv); else gla2_item<0>(P, lds, j, it >> 5, (it >> 2) & 7, it & 1, wv); } }
        }
        return;
    }
    if (sub == 3) {
        const Params P = load_params(lds);
        if (!even) { if (PHMASK & 256) phase_readout(P, j, wv); }
#if defined(SPLIT_ATTN)
        else { for (int it = get_bid(); it < 576; it += gridDim.x) attn_item(P, lds, j, it, wv); }
#endif
        return;
    }
    {
        const Params P = load_params(lds); bf16_t* pbuf = (bf16_t*)(P.ws + WS_P);
        const int K = even ? 2048 : 1024, lda = even ? EVEN_IN : ODD_IN;
        pg8::Gemm gm{pbuf + (even ? 1536 : 4096), (const bf16_t*)(P.ws + WS_WOUT), MROWS, 1024, K, lda};
        pg8::StaticOrder S; S.init(NB * SEQ, 1024, (int)gridDim.x, get_bid(), 1);
        const float* hl = layer == 0 ? P.x : P.out; const float* hc = layer == 0 ? P.ctx : (const float*)(P.ws + WS_HCTX);
        const float* modb = (const float*)(P.ws + WS_MOD);
        EpiResidNorm E{hl, P.out, modb + (size_t)layer * 9 * 3072 + 2048, layer < 3 ? P.norm_w + (layer + 1) * 1024 : P.final_norm_w,
                       layer < 3 ? modb + (size_t)(layer + 1) * 9 * 3072 : nullptr, (bf16_t*)(P.ws + WS_OV), (float*)(P.ws + WS_AGG), (unsigned*)(P.ws + WS_CTL) + 12288 + layer * 1024};
        if (PHMASK & 512) pg8::gemm_phase<EpiResidNorm, pg8::StaticOrder, false, true>(lds, gm, S, E, wv);
        if (layer < 3) {
            for (int t = get_bid(); t < 256; t += gridDim.x) {
                const int mt = t >> 3, nt = t & 7, mc0 = 64 * mt, bctx = mc0 >> 8, n0 = 128 * nt;
                const bf16_t* At = pbuf + ((size_t)bctx * LT + (mc0 & 255)) * lda + (even ? 1536 : 4096);
                const float* gctx = (const float*)(P.ws + WS_MOD) + (size_t)layer * 9 * 3072 + 2048 + 8 * 3072;
                float* hco = (float*)(P.ws + WS_HCTX);
                auto epi = [&](const f32x16& acc, int row0, int col, int hh) {
                    const float gate = gctx[n0 + col];
#pragma unroll
                    for (int i = 0; i < 16; ++i) { const size_t off = (size_t)(mc0 + row0 + crow(i, hh)) * DM + n0 + col; hco[off] = hc[off] + gate * acc[i]; }
                };
                mini_gemm_tile(lds, At, lda, (const bf16_t*)(P.ws + WS_WOUT) + (size_t)n0 * K, K, epi, wv);
            }
        }
    }
}

__global__ void __launch_bounds__(512, 2) mega(Params P) {
    extern __shared__ __attribute__((aligned(16))) unsigned char lds_raw[];
    LAS unsigned char* lds = (LAS unsigned char*)lds_raw;
    cg::grid_group grid = cg::this_grid();
    const int wv = __builtin_amdgcn_readfirstlane((int)(threadIdx.x >> 6));
    if (get_tid(wv) == 0) {
#if defined(TP_ID)
        ((LAS unsigned long long*)(lds + 163840 - 32))[0] = 0ull; ((LAS unsigned long long*)(lds + 163840 - 32))[1] = 0ull;
#endif
        ((LAS unsigned*)(lds + PARAM_OFF + 208))[0] = 0u; ((LAS unsigned*)(lds + PARAM_OFF + 208))[1] = 0u;
        LAS unsigned long long* d = (LAS unsigned long long*)(lds + PARAM_OFF);
        d[0] = (unsigned long long)P.x; d[1] = (unsigned long long)P.c; d[2] = (unsigned long long)P.ctx; d[3] = (unsigned long long)P.c_ctx; d[4] = (unsigned long long)P.ada_w;
        d[5] = (unsigned long long)P.ada_b; d[6] = (unsigned long long)P.norm_w; d[7] = (unsigned long long)P.ev_w_in; d[8] = (unsigned long long)P.ev_conv_w; d[9] = (unsigned long long)P.ev_conv_b;
        d[10] = (unsigned long long)P.ev_rg_wx; d[11] = (unsigned long long)P.ev_rg_bx; d[12] = (unsigned long long)P.ev_rg_wa; d[13] = (unsigned long long)P.ev_rg_ba; d[14] = (unsigned long long)P.ev_rg_lambda;
        d[15] = (unsigned long long)P.ev_sink; d[16] = (unsigned long long)P.ev_w_out; d[17] = (unsigned long long)P.od_w_in; d[18] = (unsigned long long)P.od_lb_raw; d[19] = (unsigned long long)P.od_gnorm_w;
        d[20] = (unsigned long long)P.od_w_out; d[21] = (unsigned long long)P.final_norm_w; d[22] = (unsigned long long)P.out; d[23] = (unsigned long long)P.ws;
    }
    __syncthreads();
    const int ph_lo = P.ph_lo, ph_hi = P.ph_hi;
    (void)xcd_barrier_post((unsigned*)(P.ws + WS_CTL) + 4096, (volatile LAS unsigned*)(lds + PARAM_OFF + 208), wv);
#define GRID_SYNC(first) do { if (first) grid.sync(); else { XcdBarrier xb_; xb_.bar = (unsigned*)(load_params(lds).ws + WS_CTL) + 4096; xb_.x = xb_xcc_id(); xb_.st = (volatile LAS unsigned*)(lds + PARAM_OFF + 208); xcd_barrier(xb_, wv); } } while (0)
#if defined(PROBE_S)
    constexpr int PREP = PROBE_E - PROBE_S + 1;
#pragma unroll 1
    for (int seq = ph_lo; seq < ph_hi + PREP; ++seq) {
        if (seq > ph_lo) GRID_SYNC(seq == ph_lo + 1);
        const int ph = seq <= PROBE_E ? seq : seq - PREP;
        run_phase(lds, ph, wv);
    }
#else
#pragma unroll 1
    for (int ph = ph_lo; ph < ph_hi; ++ph) {
#if !defined(SPLIT_ATTN)
        if (ph >= 1 && ph < NPHASE - 1 && (ph - 1) % 5 == 3 && (((ph - 1) / 5) & 1) == 0) continue;
#endif
        TP_START(200, lds, get_tid(wv));
        if (ph > ph_lo) GRID_SYNC(ph == ph_lo + 1);
        TP_STOP(200, lds, get_tid(wv));
#if defined(TP_ID)
        const int kid_ = ph == 0 ? 207 : ((ph - 1) % 5 == 0 ? 205 : ((ph - 1) % 5 == 1 ? 201 : ((ph - 1) % 5 == 2 ? ((((ph - 1) / 5) & 1) ? 203 : 202) : ((ph - 1) % 5 == 3 ? 206 : 204))));
        if (kid_ == TP_ID) TP_START(TP_ID, lds, get_tid(wv));
#endif
        run_phase(lds, ph, wv);
#if defined(TP_ID)
        if (kid_ == TP_ID) TP_STOP(TP_ID, lds, get_tid(wv));
#endif
    }
#endif
#if defined(TP_ID)
    if (get_tid(wv) == 0 && blockIdx.x == TP_BLOCK) {
        const unsigned long long acc = ((LAS unsigned long long*)(lds + 163840 - 32))[1], t0 = __builtin_amdgcn_s_memrealtime();
        while (__builtin_amdgcn_s_memrealtime() - t0 < (unsigned long long)TP_AMP * acc) __builtin_amdgcn_s_sleep(8);
    }
#endif
}

extern "C" void kernel_launch(void* const* d_in, const int* in_sizes, int n_in, void* d_out, int out_size, void* d_ws, size_t ws_size, hipStream_t stream) {
    static int grid = 0;
    if (grid == 0) {
        if (n_in != 22 || ws_size < WS_END) { fprintf(stderr, "kernel_launch: unexpected inputs (n_in %d, ws %zu)\n", n_in, ws_size); grid = -1; return; }
        int dev = 0, cus = 0, per_cu = 0;
        hipGetDevice(&dev);
        hipDeviceGetAttribute(&cus, hipDeviceAttributeMultiprocessorCount, dev);
        if (hipFuncSetAttribute((const void*)mega, hipFuncAttributeMaxDynamicSharedMemorySize, LDS_BYTES) != hipSuccess) { fprintf(stderr, "kernel_launch: hipFuncSetAttribute failed\n"); grid = -1; return; }
        if (hipOccupancyMaxActiveBlocksPerMultiprocessor(&per_cu, (const void*)mega, 512, LDS_BYTES) != hipSuccess || per_cu < 1) { fprintf(stderr, "kernel_launch: occupancy query gives %d\n", per_cu); per_cu = 1; }
        (void)hipGetLastError();
        grid = cus;
    }
    if (grid < 0) return;
    if (hipMemsetAsync((char*)d_ws + WS_CTL, 0, 65536, stream) != hipSuccess) { fprintf(stderr, "kernel_launch: memset failed\n"); return; }
    Params P{};
    const float** pp = (const float**)&P;
    for (int i = 0; i < 22; ++i) pp[i] = (const float*)d_in[i];
    P.out = (float*)d_out; P.ws = (unsigned char*)d_ws;
#if ONE_LAUNCH
    P.ph_lo = 0; P.ph_hi = NPHASE;
    { void* args[] = {&P}; hipError_t e = hipLaunchCooperativeKernel((const void*)mega, dim3(grid), dim3(512), args, LDS_BYTES, stream);
      if (e != hipSuccess) fprintf(stderr, "cooperative launch failed: %s (grid %d)\n", hipGetErrorString(e), grid); }
#else
    for (int ph = 0; ph < NPHASE; ++ph) {
        P.ph_lo = ph; P.ph_hi = ph + 1;
        void* args[] = {&P}; hipError_t e = hipLaunchCooperativeKernel((const void*)mega, dim3(grid), dim3(512), args, LDS_BYTES, stream);
        if (e != hipSuccess) { fprintf(stderr, "launch %d failed: %s (grid %d)\n", ph, hipGetErrorString(e), grid); break; }
    }
#endif
}
```

```cpp
#include <hip/hip_runtime.h>
#include <hip/hip_cooperative_groups.h>
#include <cstdio>
#include <cstdint>
namespace cg = cooperative_groups;

#ifndef ONE_LAUNCH
#define ONE_LAUNCH 1
#endif

#define DI __device__ __forceinline__
#define LAS __attribute__((address_space(3)))
__device__ __forceinline__ int lane_nh() { int l; asm volatile("v_mbcnt_lo_u32_b32 %0, -1, 0\n\tv_mbcnt_hi_u32_b32 %0, -1, %0" : "=v"(l)); return l; }
__device__ __forceinline__ int get_tid(int wv) { asm volatile("" : "+s"(wv)); return wv * 64 + lane_nh(); }
__device__ __forceinline__ float shfl_xor_f(float v, int o) { return __int_as_float(__builtin_amdgcn_ds_bpermute((lane_nh() ^ o) << 2, __float_as_int(v))); }
__device__ __forceinline__ int get_bid() { int b = blockIdx.x; asm volatile("" : "+s"(b)); return b; }

#if defined(TP_ID)
#ifndef TP_BLOCK
#define TP_BLOCK 5
#endif
#ifndef TP_AMP
#define TP_AMP 16
#endif
#define TP_START(id, lds, tid_) do { if ((id) == TP_ID && (tid_) == 0 && blockIdx.x == TP_BLOCK) { ((LAS unsigned long long*)((lds) + 163840 - 32))[0] = __builtin_amdgcn_s_memrealtime(); } } while (0)
#define TP_STOP(id, lds, tid_) do { if ((id) == TP_ID && (tid_) == 0 && blockIdx.x == TP_BLOCK) { LAS unsigned long long* w_ = (LAS unsigned long long*)((lds) + 163840 - 32); w_[1] += __builtin_amdgcn_s_memrealtime() - w_[0]; } } while (0)
#else
#define TP_START(id, lds, tid_) do { } while (0)
#define TP_STOP(id, lds, tid_) do { } while (0)
#endif
namespace pg8 {
#define PG8_LAS __attribute__((address_space(3)))
typedef unsigned short bf16_t;
typedef short bf16x8 __attribute__((ext_vector_type(8)));
typedef float f32x4 __attribute__((ext_vector_type(4)));
typedef unsigned u32x4 __attribute__((ext_vector_type(4)));
constexpr int BM = 256, BK = 64, HALF = 128, HTB = HALF * BK * 2  , STAGE_BYTES = 8 * HTB, NXCD = 8, WGM = 8;

__host__ __device__ __forceinline__ int lds_byte(int r, int c) { const int st = (r >> 4) * 2 + (c >> 5), rr = r & 15, cc = c & 31, ob = rr * 64 + cc * 2; return st * 1024 + (ob ^ (((ob >> 9) & 1) << 5)); }
__host__ __device__ __forceinline__ void stage_rc(int b, int& R, int& C) { const int st = b / 1024, sb = b % 1024, swz = sb ^ (((sb >> 9) & 1) << 5); R = (st >> 1) * 16 + swz / 64; C = (st & 1) * 32 + (swz % 64) / 2; }
__host__ __device__ __forceinline__ int perm32(int rho) { const int n = rho >> 4, i = rho & 15; return 8 * (i >> 2) + 4 * n + (i & 3); }

struct Unit { int pm, pn; };
struct Gemm { const bf16_t* A; const bf16_t* Bt; int M, N, K, lda; };

struct StaticOrder {
    int nM, nN, nwg, G, c, lat_only, limit;
    __host__ __device__ void init(int M, int N, int G_, int c_, int lat_only_ = 0) { nM = M / BM; nN = N / BM; nwg = nM * nN; G = G_; c = c_; lat_only = lat_only_; limit = nwg; }
    __host__ __device__ bool next(int i, Unit& u) const {
        const long L = (long)i * G + c; if (L >= limit) return false;
        tile_of((int)L, u); return true;
    }
    __host__ __device__ void tile_of(int L, Unit& u) const {
        int wgid = L; { const int q = nwg / NXCD, r = nwg % NXCD, xcd = wgid % NXCD, off = wgid / NXCD; wgid = (xcd < r ? xcd * (q + 1) : r * (q + 1) + (xcd - r) * q) + off; }
        const int nig = WGM * nN, gid = wgid / nig, fm = gid * WGM, gsz = (nM - fm) < WGM ? (nM - fm) : WGM;
        u.pm = fm + ((wgid % nig) % gsz); u.pn = (wgid % nig) / gsz; if (lat_only) u.pm = 9 * (u.pm >> 3) + 1 + (u.pm & 7);
    }
    __device__ __forceinline__ void a_ready(const Unit&) const {}
    __device__ __forceinline__ void done(const Unit&) const {}
};

template <class Epi, class Sched, bool ALIGN_EPI = false, bool SP2 = false>
__device__ __forceinline__ void gemm_phase(PG8_LAS unsigned char* lds, const Gemm g, const Sched& S, const Epi& E, int wv) {
    const int tid = get_tid(wv), wid = __builtin_amdgcn_readfirstlane(tid >> 6), lane = tid & 63, wr = wid >> 2, wc = wid & 3, fr = lane & 15, fq = lane >> 4;
    const int K = g.K, nt = K / BK;
    unsigned voffA[2], voffB[2];
#pragma unroll
    for (int i = 0; i < 2; ++i) { int R, C; stage_rc(tid * 16 + i * 8192, R, C); const int Rb = Epi::PERM ? ((R & ~31) + perm32(R & 31)) : R;
        voffA[i] = (unsigned)(R * g.lda + C) * 2u; voffB[i] = (unsigned)(Rb * K + C) * 2u; }
    const size_t kstep = (size_t)(BK * 2);
    const size_t hstepA = (size_t)HALF * g.lda * 2, hstepB = (size_t)HALF * K * 2;
    const size_t tstepA = 2 * hstepA, tstepB = 2 * hstepB;
    const unsigned ldsw = (unsigned)wid * 1024u;
    const int aoff = lds_byte(wr * 64 + fr, fq * 8), boff = lds_byte(wc * 32 + fr, fq * 8);
#define PG8_SA(b, h) (((b) * 2 + (h)) * HTB)
#define PG8_SB(b, h) ((4 + (b) * 2 + (h)) * HTB)
#define PG8_STAGE(bufoff, gbase, voff) do { _Pragma("unroll") for (int _i = 0; _i < 2; ++_i) \
        __builtin_amdgcn_global_load_lds((const unsigned*)((const char*)(gbase) + (voff)[_i]), (PG8_LAS unsigned*)(lds + (bufoff) + ldsw + _i * 8192), 16, 0, 0); } while (0)
#define PG8_LDA(dst, b, h) do { _Pragma("unroll") for (int m = 0; m < 4; ++m) _Pragma("unroll") for (int k = 0; k < 2; ++k) dst[m][k] = *(const PG8_LAS bf16x8*)(lds + PG8_SA(b, h) + aoff + m * 2048 + k * 1024); } while (0)
#define PG8_LDB(dst, b, h) do { _Pragma("unroll") for (int n = 0; n < 2; ++n) _Pragma("unroll") for (int k = 0; k < 2; ++k) dst[n][k] = *(const PG8_LAS bf16x8*)(lds + PG8_SB(b, h) + boff + n * 2048 + k * 1024); } while (0)
#define PG8_MMA(ai, bj, At, Bt) do { __builtin_amdgcn_s_setprio(1); _Pragma("unroll") for (int m = 0; m < 4; ++m) _Pragma("unroll") for (int n = 0; n < 2; ++n) _Pragma("unroll") for (int k = 0; k < 2; ++k) \
        acc[ai][bj][m][n] = __builtin_amdgcn_mfma_f32_16x16x32_bf16(Bt[n][k], At[m][k], acc[ai][bj][m][n], 0, 0, 0); __builtin_amdgcn_s_setprio(0); } while (0)
#define PG8_WAIT_V(n) asm volatile("s_waitcnt vmcnt(" #n ")" ::: "memory")
#define PG8_WAIT_L(n) asm volatile("s_waitcnt lgkmcnt(" #n ")" ::: "memory")
#define PG8_BAR __builtin_amdgcn_s_barrier()
#define PG8_SCHED __builtin_amdgcn_sched_barrier(0)
    Unit cur, nxt; int ui = 0;
    if (!S.next(0, cur)) return;
    f32x4 acc[2][2][4][2];
#pragma unroll
    for (int a = 0; a < 2; ++a)
#pragma unroll
        for (int b = 0; b < 2; ++b)
#pragma unroll
            for (int m = 0; m < 4; ++m)
#pragma unroll
                for (int n = 0; n < 2; ++n) acc[a][b][m][n] = (f32x4){0.f, 0.f, 0.f, 0.f};
    bf16x8 At[4][2], B0[2][2], B1[2][2];
    const char* cA = (const char*)g.A + (size_t)cur.pm * tstepA; const char* cB = (const char*)g.Bt + (size_t)cur.pn * tstepB;
    S.a_ready(cur);
    if constexpr (SP2) {
        PG8_STAGE(PG8_SB(0, 0), cB, voffB); PG8_STAGE(PG8_SB(0, 1), cB + hstepB, voffB); PG8_STAGE(PG8_SA(0, 0), cA, voffA); PG8_STAGE(PG8_SA(0, 1), cA + hstepA, voffA);
        if (wr == 1) PG8_BAR;
        PG8_WAIT_V(2); PG8_BAR;
        PG8_STAGE(PG8_SB(1, 0), cB + kstep, voffB); PG8_STAGE(PG8_SA(1, 0), cA + kstep, voffA); PG8_STAGE(PG8_SB(1, 1), cB + hstepB + kstep, voffB);
        PG8_WAIT_V(6); PG8_BAR;
    } else {
        PG8_STAGE(PG8_SB(0, 0), cB, voffB); PG8_STAGE(PG8_SA(0, 0), cA, voffA); PG8_STAGE(PG8_SB(0, 1), cB + hstepB, voffB); PG8_STAGE(PG8_SA(0, 1), cA + hstepA, voffA);
        if (wr == 1) PG8_BAR;
        PG8_WAIT_V(4); PG8_BAR;
        PG8_STAGE(PG8_SB(1, 0), cB + kstep, voffB); PG8_STAGE(PG8_SA(1, 0), cA + kstep, voffA); PG8_STAGE(PG8_SB(1, 1), cB + hstepB + kstep, voffB);
        PG8_WAIT_V(6); PG8_BAR;
    }
    for (;;) {
        const bool has_next = S.next(ui + 1, nxt);
        const char* nA = has_next ? (const char*)g.A + (size_t)nxt.pm * tstepA : cA; const char* nB = has_next ? (const char*)g.Bt + (size_t)nxt.pn * tstepB : cB;
        for (int t = 0; t < nt; t += 2) {
            const bool last = (t == nt - 2);
            const char* a1 = cA + (size_t)(t + 1) * kstep;
            const char* a2 = last ? nA : cA + (size_t)(t + 2) * kstep; const char* b2 = last ? nB : cB + (size_t)(t + 2) * kstep;
            const char* a3 = a2 + kstep; const char* b3 = b2 + kstep;
            if (last && has_next) S.a_ready(nxt);
            if constexpr (SP2) {
            PG8_LDB(B0, 0, 0); PG8_LDB(B1, 0, 1); PG8_SCHED; PG8_LDA(At, 0, 0); PG8_STAGE(PG8_SA(1, 1), a1 + hstepA, voffA);
            PG8_WAIT_V(8); PG8_WAIT_L(0); PG8_BAR; PG8_MMA(0, 0, At, B0); PG8_MMA(0, 1, At, B1); PG8_BAR; PG8_SCHED;
            PG8_LDA(At, 0, 1); PG8_STAGE(PG8_SB(0, 0), b2, voffB); PG8_STAGE(PG8_SB(0, 1), b2 + hstepB, voffB); PG8_STAGE(PG8_SA(0, 0), a2, voffA);
            PG8_WAIT_V(8); PG8_WAIT_L(0); PG8_BAR; PG8_MMA(1, 0, At, B0); PG8_MMA(1, 1, At, B1); PG8_BAR; PG8_SCHED;
            PG8_LDB(B0, 1, 0); PG8_LDB(B1, 1, 1); PG8_SCHED; PG8_LDA(At, 1, 0); PG8_STAGE(PG8_SA(0, 1), a2 + hstepA, voffA);
            PG8_WAIT_V(8); PG8_WAIT_L(0); PG8_BAR; PG8_MMA(0, 0, At, B0); PG8_MMA(0, 1, At, B1); PG8_BAR; PG8_SCHED;
            PG8_LDA(At, 1, 1); PG8_STAGE(PG8_SB(1, 0), b3, voffB); PG8_STAGE(PG8_SB(1, 1), b3 + hstepB, voffB); PG8_STAGE(PG8_SA(1, 0), a3, voffA);
            PG8_WAIT_V(8); PG8_WAIT_L(0); PG8_BAR; PG8_MMA(1, 0, At, B0); PG8_MMA(1, 1, At, B1); PG8_BAR; PG8_SCHED;
            } else {
            PG8_LDB(B0, 0, 0); PG8_SCHED; PG8_LDA(At, 0, 0); PG8_STAGE(PG8_SA(1, 1), a1 + hstepA, voffA);
            PG8_WAIT_L(8); PG8_BAR; PG8_WAIT_L(0); PG8_MMA(0, 0, At, B0); PG8_BAR; PG8_SCHED;
            PG8_LDB(B1, 0, 1); PG8_STAGE(PG8_SB(0, 0), b2, voffB);
            PG8_BAR; PG8_WAIT_L(0); PG8_MMA(0, 1, At, B1); PG8_BAR;
            PG8_LDA(At, 0, 1); PG8_STAGE(PG8_SA(0, 0), a2, voffA);
            PG8_BAR; PG8_WAIT_L(0); PG8_MMA(1, 0, At, B0); PG8_BAR; PG8_SCHED;
            PG8_STAGE(PG8_SB(0, 1), b2 + hstepB, voffB);
            PG8_WAIT_V(6); PG8_BAR; PG8_MMA(1, 1, At, B1); PG8_BAR;
            PG8_LDB(B0, 1, 0); PG8_SCHED; PG8_LDA(At, 1, 0); PG8_STAGE(PG8_SA(0, 1), a2 + hstepA, voffA);
            PG8_WAIT_L(8); PG8_BAR; PG8_WAIT_L(0); PG8_MMA(0, 0, At, B0); PG8_BAR; PG8_SCHED;
            PG8_LDB(B1, 1, 1); PG8_STAGE(PG8_SB(1, 0), b3, voffB);
            PG8_BAR; PG8_WAIT_L(0); PG8_MMA(0, 1, At, B1); PG8_BAR;
            PG8_LDA(At, 1, 1); PG8_STAGE(PG8_SA(1, 0), a3, voffA);
            PG8_BAR; PG8_WAIT_L(0); PG8_MMA(1, 0, At, B0); PG8_BAR; PG8_SCHED;
            PG8_STAGE(PG8_SB(1, 1), b3 + hstepB, voffB);
            PG8_WAIT_V(6); PG8_BAR; PG8_MMA(1, 1, At, B1); PG8_BAR;
            }
        }
        if constexpr (ALIGN_EPI) { if (wr == 0) PG8_BAR; }
        if constexpr (!Epi::AFTER_DRAIN) { E(acc, cur, wr, wc, fr, fq); S.done(cur); }
        if (!has_next) break;
#pragma unroll
        for (int a = 0; a < 2; ++a)
#pragma unroll
            for (int b = 0; b < 2; ++b)
#pragma unroll
                for (int m = 0; m < 4; ++m)
#pragma unroll
                    for (int n = 0; n < 2; ++n) acc[a][b][m][n] = (f32x4){0.f, 0.f, 0.f, 0.f};
        cur = nxt; cA = nA; cB = nB; ++ui;
        if constexpr (ALIGN_EPI) { if (wr == 1) PG8_BAR; }
    }
    PG8_WAIT_V(0);
    if constexpr (!ALIGN_EPI) { if (wr == 0) PG8_BAR; }
    PG8_BAR;
    if constexpr (Epi::AFTER_DRAIN) { E.fused(acc, cur, wr, wc, fr, fq, lds, wid, lane); S.done(cur); }
#undef PG8_SA
#undef PG8_SB
#undef PG8_STAGE
#undef PG8_LDA
#undef PG8_LDB
#undef PG8_MMA
#undef PG8_WAIT_V
#undef PG8_WAIT_L
#undef PG8_BAR
#undef PG8_SCHED
}
}

typedef unsigned short bf16_t;
typedef short bf16x8 __attribute__((ext_vector_type(8)));
typedef short s16x4 __attribute__((ext_vector_type(4)));
typedef float f32x4 __attribute__((ext_vector_type(4)));
typedef float f32x16 __attribute__((ext_vector_type(16)));
typedef unsigned u32x4 __attribute__((ext_vector_type(4)));
typedef unsigned u32x2 __attribute__((ext_vector_type(2)));
typedef float f32x2 __attribute__((ext_vector_type(2)));

constexpr int DM = 1024, NB = 8, SEQ = 2048, CTXL = 256, LT = SEQ + CTXL  , MROWS = NB * LT  ;
constexpr int EVEN_IN = 4608, ODD_IN = 5120, NCHUNK = LT / 64  ;
constexpr float RMS_EPS = 1e-6f, LOG2E = 1.4426950408889634f;
constexpr int LDS_BYTES = 160 * 1024;
constexpr int NPHASE = 21;

constexpr size_t WS_CTL = 0;
constexpr size_t WS_MOD = 65536;
constexpr size_t WS_ROPE = 524288;
constexpr size_t WS_AGG = 1048576;
constexpr size_t WS_HCTX = WS_AGG + 4718592;
constexpr size_t WS_WIN = WS_HCTX + 8388608;
constexpr size_t WS_WOUT = WS_WIN + 10485760;
constexpr size_t WS_WRG = WS_WOUT + 4194304;
constexpr size_t WS_OV = WS_WRG + 1048576;
constexpr size_t WS_P = WS_OV + 37748736;
constexpr size_t WS_END = WS_P + 188743680;
static_assert(WS_END <= 268435456, "workspace map exceeds 256 MiB");

struct Params {
    const float *x, *c, *ctx, *c_ctx, *ada_w, *ada_b, *norm_w, *ev_w_in, *ev_conv_w, *ev_conv_b, *ev_rg_wx, *ev_rg_bx, *ev_rg_wa, *ev_rg_ba,
        *ev_rg_lambda, *ev_sink, *ev_w_out, *od_w_in, *od_lb_raw, *od_gnorm_w, *od_w_out, *final_norm_w;
    float* out; unsigned char* ws; int ph_lo, ph_hi;
};

DI float bf2f(unsigned short v) { return __uint_as_float((unsigned)v << 16); }
DI unsigned f2bf(float f) { unsigned u = __float_as_uint(f); return (u + 0x7fffu + ((u >> 16) & 1u)) >> 16; }
typedef __bf16 bf16x2_hw __attribute__((ext_vector_type(2)));
DI unsigned pk2(float lo, float hi) { const f32x2 v = {lo, hi}; return __builtin_bit_cast(unsigned, __builtin_convertvector(v, bf16x2_hw)); }
DI float sigm(float x) { return __builtin_amdgcn_rcpf(1.f + __expf(-x)); }
DI float softplus_neg(float lam) {
    const float e = __expf(-lam);
    return e < 0.06f ? e * (1.f + e * (-0.5f + e * (0.33333333f + e * (-0.25f + e * 0.2f)))) : __logf(1.f + e);
}
DI float neg_expm1(float x) {
    return x > -0.25f ? -x * (1.f + x * (0.5f + x * (0.16666667f + x * (0.041666668f + x * (0.0083333338f + x * 0.0013888889f))))) : 1.f - __expf(x);
}
DI float wave_sum(float v) {
#pragma unroll
    for (int o = 1; o < 64; o <<= 1) v += shfl_xor_f(v, o);
    return v;
}
DI int crow(int reg, int h) { return (reg & 3) + 8 * (reg >> 2) + 4 * h; }
#define MFMA16(a, b, c) __builtin_amdgcn_mfma_f32_16x16x32_bf16((a), (b), (c), 0, 0, 0)
#define MFMA32(a, b, c) __builtin_amdgcn_mfma_f32_32x32x16_bf16((a), (b), (c), 0, 0, 0)

struct EpiStoreBf16 {
    static constexpr bool PERM = true, AFTER_DRAIN = false;
    bf16_t* O; int ldc;
    DI void operator()(const f32x4 (&acc)[2][2][4][2], const pg8::Unit& u, int wr, int wc, int fr, int fq) const {
        const int row0 = u.pm * 256 + wr * 64 + fr, col0 = u.pn * 256 + wc * 32 + 8 * fq;
#pragma unroll
        for (int ai = 0; ai < 2; ++ai)
#pragma unroll
            for (int m = 0; m < 4; ++m) { bf16_t* rowp = O + (size_t)(row0 + ai * 128 + m * 16) * ldc + col0;
#pragma unroll
                for (int bj = 0; bj < 2; ++bj) { const f32x4 v0 = acc[ai][bj][m][0], v1 = acc[ai][bj][m][1];
                    u32x4 w; w.x = pk2(v0[0], v0[1]); w.y = pk2(v0[2], v0[3]); w.z = pk2(v1[0], v1[1]); w.w = pk2(v1[2], v1[3]);
                    *(u32x4*)(rowp + bj * 128) = w; } }
    }
};
struct EpiResid {
    static constexpr bool PERM = false, AFTER_DRAIN = false;
    const float* in_lat; const float* in_ctx; float* out_lat; float* out_ctx; const float* gate;
    DI void operator()(const f32x4 (&acc)[2][2][4][2], const pg8::Unit& u, int wr, int wc, int fr, int fq) const {
        const int b = u.pm / 9, jt = u.pm % 9;
        const float* ib; float* ob; const float* g;
        if (jt == 0) { const size_t off = (size_t)b * CTXL * DM; ib = in_ctx + off; ob = out_ctx + off; g = gate + 8 * 3072; }
        else { const size_t off = ((size_t)b * SEQ + (size_t)(jt - 1) * 256) * DM; ib = in_lat + off; ob = out_lat + off; g = gate + b * 3072; }
        const int col0 = u.pn * 256 + wc * 32 + 4 * fq;
#pragma unroll
        for (int bj = 0; bj < 2; ++bj)
#pragma unroll
            for (int n = 0; n < 2; ++n) {
                const f32x4 gvv = *(const f32x4*)(g + col0 + bj * 128 + n * 16);
#pragma unroll
                for (int ai = 0; ai < 2; ++ai) {
#pragma unroll
                    for (int m = 0; m < 4; ++m) { const int r = ai * 128 + wr * 64 + m * 16 + fr;
                        const size_t off = (size_t)r * DM + col0 + bj * 128 + n * 16;
                        const f32x4 o = *(const f32x4*)(ib + off) + gvv * acc[ai][bj][m][n]; *(f32x4*)(ob + off) = o; }
                    asm volatile("" ::: "memory");
                }
            }
    }
};

struct EpiResidNorm {
    static constexpr bool PERM = false, AFTER_DRAIN = true;
    const float* in_lat; float* out_lat; const float* gate;
    const float* nw; const float* mod_next;
    bf16_t* U; float* xbuf; unsigned* cnt;
    DI void fused(f32x4 (&acc)[2][2][4][2], const pg8::Unit& u, int wr, int wc, int fr, int fq, LAS unsigned char* lds, int wid, int lane) const {
        const int b = u.pm / 9, jt = u.pm % 9, panel = b * 8 + jt - 1;
        const size_t roff = ((size_t)b * SEQ + (size_t)(jt - 1) * 256) * DM;
        const float* ib = in_lat + roff; float* ob = out_lat + roff; const float* g = gate + b * 3072;
        const int col0 = u.pn * 256 + wc * 32 + 4 * fq;
        LAS float* Pw = (LAS float*)lds;
        LAS float* Sr = (LAS float*)(lds + 4096);
        LAS unsigned* flag = (LAS unsigned*)(lds + 5120);
#pragma unroll
        for (int bj = 0; bj < 2; ++bj)
#pragma unroll
            for (int n = 0; n < 2; ++n) {
                const f32x4 gvv = *(const f32x4*)(g + col0 + bj * 128 + n * 16);
#pragma unroll
                for (int ai = 0; ai < 2; ++ai) {
#pragma unroll
                    for (int m = 0; m < 4; ++m) { const int r = ai * 128 + wr * 64 + m * 16 + fr;
                        const size_t off = (size_t)r * DM + col0 + bj * 128 + n * 16;
                        const f32x4 o = *(const f32x4*)(ib + off) + gvv * acc[ai][bj][m][n]; acc[ai][bj][m][n] = o;
                        if (mod_next) *(f32x4*)(ob + off) = o; }
                    asm volatile("" ::: "memory");
                }
            }
#pragma unroll
        for (int ai = 0; ai < 2; ++ai)
#pragma unroll
            for (int m = 0; m < 4; ++m) {
                float s = 0.f;
#pragma unroll
                for (int bj = 0; bj < 2; ++bj)
#pragma unroll
                    for (int n = 0; n < 2; ++n) { const f32x4 x = acc[ai][bj][m][n]; s += (x[0] * x[0] + x[1] * x[1]) + (x[2] * x[2] + x[3] * x[3]); }
                s += shfl_xor_f(s, 16); s += shfl_xor_f(s, 32);
                if (fq == 0) Pw[(ai * 128 + wr * 64 + m * 16 + fr) * 4 + wc] = s;
            }
        asm volatile("s_waitcnt lgkmcnt(0)" ::: "memory"); __builtin_amdgcn_s_barrier(); asm volatile("" ::: "memory");
        const int row = wid * 32 + (lane & 31);
        if (lane < 32) {
            const float t = (Pw[row * 4 + 0] + Pw[row * 4 + 1]) + (Pw[row * 4 + 2] + Pw[row * 4 + 3]);
            __hip_atomic_store((unsigned*)xbuf + ((size_t)panel * 256 + row) * 4 + u.pn, __float_as_uint(t), __ATOMIC_RELAXED, __HIP_MEMORY_SCOPE_AGENT);
        }
        asm volatile("s_waitcnt vmcnt(0)" ::: "memory");
        if (lane == 0) __hip_atomic_fetch_add(cnt + 16 * panel, 1u, __ATOMIC_RELAXED, __HIP_MEMORY_SCOPE_AGENT);
        if (wid == 0) {
            unsigned spins = 0;
            while ((unsigned)__builtin_amdgcn_readfirstlane(__hip_atomic_load(cnt + 16 * panel, __ATOMIC_RELAXED, __HIP_MEMORY_SCOPE_AGENT)) < 32u) { __builtin_amdgcn_s_sleep(2); if (++spins > (1u << 22)) break; }
            if (lane == 0) flag[0] = 1u;
        }
        asm volatile("s_waitcnt vmcnt(0) lgkmcnt(0)" ::: "memory"); __builtin_amdgcn_s_barrier(); asm volatile("" ::: "memory");
        if (lane < 32) {
            const unsigned* slot = (const unsigned*)xbuf + ((size_t)panel * 256 + row) * 4;
            const float t = (__uint_as_float(__hip_atomic_load(slot + 0, __ATOMIC_RELAXED, __HIP_MEMORY_SCOPE_AGENT)) + __uint_as_float(__hip_atomic_load(slot + 1, __ATOMIC_RELAXED, __HIP_MEMORY_SCOPE_AGENT)))
                          + (__uint_as_float(__hip_atomic_load(slot + 2, __ATOMIC_RELAXED, __HIP_MEMORY_SCOPE_AGENT)) + __uint_as_float(__hip_atomic_load(slot + 3, __ATOMIC_RELAXED, __HIP_MEMORY_SCOPE_AGENT)));
            Sr[row] = rsqrtf(t * (1.f / DM) + RMS_EPS);
        }
        asm volatile("s_waitcnt lgkmcnt(0)" ::: "memory"); __builtin_amdgcn_s_barrier(); asm volatile("" ::: "memory");
        const float* sh = mod_next ? mod_next + b * 3072 : nullptr;
#pragma unroll
        for (int bj = 0; bj < 2; ++bj)
#pragma unroll
            for (int n = 0; n < 2; ++n) {
                const int cc = col0 + bj * 128 + n * 16;
                const f32x4 w4 = *(const f32x4*)(nw + cc);
                f32x4 s4 = {1.f, 1.f, 1.f, 1.f}, h4 = {0.f, 0.f, 0.f, 0.f};
                if (mod_next) { s4 = *(const f32x4*)(sh + 1024 + cc) + 1.f; h4 = *(const f32x4*)(sh + cc); }
#pragma unroll
                for (int ai = 0; ai < 2; ++ai)
#pragma unroll
                    for (int m = 0; m < 4; ++m) { const int r = ai * 128 + wr * 64 + m * 16 + fr;
                        const f32x4 y = (acc[ai][bj][m][n] * Sr[r]) * w4;
                        if (mod_next) { const f32x4 o = y * s4 + h4; u32x2 w; w.x = pk2(o[0], o[1]); w.y = pk2(o[2], o[3]); *(u32x2*)(U + ((size_t)u.pm * 256 + r) * DM + cc) = w; }
                        else *(f32x4*)(ob + (size_t)r * DM + cc) = y; }
            }
    }
};

constexpr int MG_STAGE = 27648;
template <class EpiF>
DI void mini_gemm_tile(LAS unsigned char* lds, const bf16_t* A, int lda, const bf16_t* Bt, int K, const EpiF& epi, int wv) {
    const int tid = get_tid(wv), lane = tid & 63, wave = tid >> 6, r = lane & 31, h = lane >> 5, wm = wave >> 2, wn = wave & 3;
    const int lrow = tid >> 3, lch = tid & 7, nS = K / 64;
    const bf16_t* ap = A + (size_t)lrow * lda + 8 * lch;
    const bf16_t* bp0 = Bt + (size_t)lrow * K + 8 * lch; const bf16_t* bp1 = Bt + (size_t)(64 + lrow) * K + 8 * lch;
    u32x4 s0[3], s1[3];
    f32x16 acc;
#pragma unroll
    for (int i = 0; i < 16; ++i) acc[i] = 0.f;
#define MG_LOAD(set, s) do { (set)[0] = *(const u32x4*)(ap + (s) * 64); (set)[1] = *(const u32x4*)(bp0 + (s) * 64); (set)[2] = *(const u32x4*)(bp1 + (s) * 64); } while (0)
#define MG_STORE(set, buf) do { LAS unsigned char* b_ = lds + (buf) * MG_STAGE; *(LAS u32x4*)(b_ + lrow * 144 + lch * 16) = (set)[0]; \
        *(LAS u32x4*)(b_ + 9216 + lrow * 144 + lch * 16) = (set)[1]; *(LAS u32x4*)(b_ + 9216 + (64 + lrow) * 144 + lch * 16) = (set)[2]; } while (0)
#define MG_COMPUTE(buf) do { const LAS unsigned char* b_ = lds + (buf) * MG_STAGE; \
        _Pragma("unroll") for (int ks = 0; ks < 4; ++ks) { \
            const bf16x8 af = *(const LAS bf16x8*)(b_ + (32 * wm + r) * 144 + (16 * ks + 8 * h) * 2); \
            const bf16x8 bf = *(const LAS bf16x8*)(b_ + 9216 + (32 * wn + r) * 144 + (16 * ks + 8 * h) * 2); \
            acc = MFMA32(af, bf, acc); } } while (0)
    MG_LOAD(s0, 0); MG_LOAD(s1, 1);
    __syncthreads();
    MG_STORE(s0, 0);
    if (nS > 2) MG_LOAD(s0, 2);
#pragma unroll 1
    for (int s = 0; s < nS; s += 2) {
        __syncthreads();
        if (s + 1 < nS) { MG_STORE(s1, 1); if (s + 3 < nS) MG_LOAD(s1, s + 3); }
        MG_COMPUTE(0);
        __syncthreads();
        if (s + 2 < nS) { MG_STORE(s0, 0); if (s + 4 < nS) MG_LOAD(s0, s + 4); }
        if (s + 1 < nS) MG_COMPUTE(1);
    }
#undef MG_LOAD
#undef MG_STORE
#undef MG_COMPUTE
    epi(acc, 32 * wm, 32 * wn + r, h);
    __syncthreads();
}

DI void phase_pro(const Params& P, LAS unsigned char* lds, int wv) {
    const int tid = get_tid(wv);
    LAS float* s = (LAS float*)lds;
    LAS float* red = (LAS float*)(lds + 36864);
    float* mod = (float*)(P.ws + WS_MOD);
    for (int i = tid; i < 9 * 1024; i += 512) { const int r = i >> 10, k = i & 1023; const float v = r < 8 ? P.c[r * 1024 + k] : P.c_ctx[k]; s[i] = v * sigm(v); }
    __syncthreads();
    for (int item = get_bid(); item < 384; item += gridDim.x) {
        const int l = item / 96, n0 = (item % 96) * 32, ks = tid >> 5, col = tid & 31;
        const float* w = P.ada_w + (size_t)l * 1024 * 3072 + n0 + col;
        float acc[9];
#pragma unroll
        for (int r = 0; r < 9; ++r) acc[r] = 0.f;
#pragma unroll 8
        for (int kk = 0; kk < 64; ++kk) { const int k = ks * 64 + kk; const float wv = w[(size_t)k * 3072];
#pragma unroll
            for (int r = 0; r < 9; ++r) acc[r] += s[r * 1024 + k] * wv; }
#pragma unroll
        for (int r = 0; r < 9; ++r) red[(ks * 9 + r) * 32 + col] = acc[r];
        __syncthreads();
        if (tid < 288) { const int r = tid >> 5, cc = tid & 31; float sum = 0.f;
#pragma unroll
            for (int k2 = 0; k2 < 16; ++k2) sum += red[(k2 * 9 + r) * 32 + cc];
            mod[(l * 9 + r) * 3072 + n0 + cc] = sum + P.ada_b[l * 3072 + n0 + cc]; }
        __syncthreads();
    }
    float* cos_t = (float*)(P.ws + WS_ROPE); float* sin_t = cos_t + SEQ * 32;
    for (int i = get_bid() * 512 + tid; i < SEQ * 32; i += gridDim.x * 512) {
        const int pos = i >> 5, jj = i & 31, fi = jj & 15;
        const float inv = __builtin_amdgcn_exp2f(-(float)(2 * fi) * (13.287712379549449f / 32.f));
        const float ang = (float)(jj < 16 ? (pos >> 6) : (pos & 63)) * inv;
        cos_t[i] = __cosf(ang); sin_t[i] = __sinf(ang);
    }
}

template <bool FRAG = false>
DI void transpose_item(const float* W, int K, int N, bf16_t* WT, LAS float* scr, int item, int lane) {
    const int nblk = N / 32, kb = item / nblk, nb = item % nblk, k0 = 64 * kb, n0 = 32 * nb;
#pragma unroll 8
    for (int i = 0; i < 32; ++i) { const int kk = 2 * i + (lane >> 5); scr[kk * 33 + (lane & 31)] = W[(size_t)(k0 + kk) * N + n0 + (lane & 31)]; }
    asm volatile("s_waitcnt lgkmcnt(0)" ::: "memory");
    const int c = lane & 7;
#pragma unroll
    for (int j = 0; j < 4; ++j) { const int n = (lane >> 3) + 8 * j; const LAS float* sp = scr + (8 * c) * 33 + n;
        u32x4 o; o.x = pk2(sp[0 * 33], sp[1 * 33]); o.y = pk2(sp[2 * 33], sp[3 * 33]); o.z = pk2(sp[4 * 33], sp[5 * 33]); o.w = pk2(sp[6 * 33], sp[7 * 33]);
        if (FRAG) {
            const int nn = n0 + n, k8 = (k0 >> 3) + c;
            *(u32x4*)(WT + ((((nn >> 4) * 4 + (k8 >> 2)) * 64 + (k8 & 3) * 16 + (nn & 15)) * 8)) = o;
        } else *(u32x4*)(WT + (size_t)(n0 + n) * K + k0 + 8 * c) = o; }
    asm volatile("s_waitcnt lgkmcnt(0)" ::: "memory");
}

DI void phase_norm(const Params& P, LAS unsigned char* lds, int layer, int wv) {
    const int tid = get_tid(wv), lane = tid & 63, wave = tid >> 6;
    const int gw = get_bid() * 8 + wave, NGW = gridDim.x * 8;
    const int j = layer >> 1;
    LAS float* scr = (LAS float*)(lds + wave * 16384);
    bf16_t* WIN = (bf16_t*)(P.ws + WS_WIN); bf16_t* WOUT = (bf16_t*)(P.ws + WS_WOUT); bf16_t* WRG = (bf16_t*)(P.ws + WS_WRG);
    if ((layer & 1) == 0) {
        constexpr int I_IN = 16 * (EVEN_IN / 32), I_OUT = 32 * 32, I_RG = 32 * 8;
        for (int it = gw; it < I_IN + I_OUT + I_RG; it += NGW) {
            int r = it;
            if (r < I_IN) { transpose_item(P.ev_w_in + (size_t)j * 1024 * EVEN_IN, 1024, EVEN_IN, WIN, scr, r, lane); continue; } r -= I_IN;
            if (r < I_OUT) { transpose_item(P.ev_w_out + (size_t)j * 2048 * 1024, 2048, 1024, WOUT, scr, r, lane); continue; } r -= I_OUT;
            const int mat = r >> 3, sub = r & 7;
            const int dir = mat >> 4, gate = (mat >> 3) & 1, hd = mat & 7;
            const float* src = (gate == 0 ? P.ev_rg_wx : P.ev_rg_wa) + ((size_t)((j * 2 + dir) * 8 + hd)) * 16384;
            transpose_item<true>(src, 128, 128, WRG + (size_t)mat * 16384, scr, sub, lane);
        }
    } else {
        constexpr int I_IN = 16 * (ODD_IN / 32), I_OUT = 16 * 32;
        for (int it = gw; it < I_IN + I_OUT; it += NGW) {
            int r = it;
            if (r < I_IN) { transpose_item(P.od_w_in + (size_t)j * 1024 * ODD_IN, 1024, ODD_IN, WIN, scr, r, lane); continue; } r -= I_IN;
            transpose_item(P.od_w_out + (size_t)j * 1024 * 1024, 1024, 1024, WOUT, scr, r, lane);
        }
    }
    const float* hl = layer == 0 ? P.x : P.out; const float* hc = layer == 0 ? P.ctx : (const float*)(P.ws + WS_HCTX);
    const float* mod = (const float*)(P.ws + WS_MOD) + (size_t)layer * 9 * 3072;
    const float* nw = P.norm_w + layer * 1024;
    bf16_t* U = (bf16_t*)(P.ws + WS_OV);
    f32x4 w4[4], s4[4], h4[4];
#pragma unroll
    for (int q = 0; q < 4; ++q) w4[q] = *(const f32x4*)(nw + 4 * lane + 256 * q);
    int cur_m = -1;
    const int nrows = layer == 0 ? MROWS : NB * CTXL;
    const int rpw = (nrows + NGW - 1) / NGW;
    for (int idx = gw * rpw; idx < gw * rpw + rpw && idx < nrows; ++idx) {
        const int b = layer == 0 ? idx / LT : idx >> 8, jr = layer == 0 ? idx % LT : idx & 255;
        const int R = b * LT + jr;
        const float* src = jr < CTXL ? hc + ((size_t)b * CTXL + jr) * DM : hl + ((size_t)b * SEQ + (jr - CTXL)) * DM;
        const int mrow = jr < CTXL ? 8 : b;
        if (mrow != cur_m) {
            cur_m = mrow;
            const float* sh = mod + mrow * 3072; const float* sc = sh + 1024;
#pragma unroll
            for (int q = 0; q < 4; ++q) { s4[q] = *(const f32x4*)(sc + 4 * lane + 256 * q) + 1.f; h4[q] = *(const f32x4*)(sh + 4 * lane + 256 * q); }
        }
        f32x4 v[4]; float ss = 0.f;
#pragma unroll
        for (int q = 0; q < 4; ++q) { v[q] = *(const f32x4*)(src + 4 * lane + 256 * q); ss += (v[q][0] * v[q][0] + v[q][1] * v[q][1]) + (v[q][2] * v[q][2] + v[q][3] * v[q][3]); }
        const float rstd = rsqrtf(wave_sum(ss) * (1.f / DM) + RMS_EPS);
#pragma unroll
        for (int q = 0; q < 4; ++q) { const int k = 4 * lane + 256 * q;
            const f32x4 y = (v[q] * rstd) * w4[q]; const f32x4 o = y * s4[q] + h4[q];
            u32x2 w; w.x = pk2(o[0], o[1]); w.y = pk2(o[2], o[3]); *(u32x2*)(U + (size_t)R * DM + k) = w; }
    }
}

typedef _Float16 f16x2_t __attribute__((ext_vector_type(2)));
DI unsigned pkh2(float a, float b) { const f16x2_t v = {(_Float16)a, (_Float16)b}; return __builtin_bit_cast(unsigned, v); }
DI void unpkh2(unsigned u, float& a, float& b) { const f16x2_t v = __builtin_bit_cast(f16x2_t, u); a = (float)v[0]; b = (float)v[1]; }
constexpr int RG_UT = 0, RG_AL = 17408, RG_BL = 50176, RG_HP = 82944, RG_QA = 148480, RG_CAR = 152576, RG_FLAG = 153600, RG_END = 153664;
static_assert(RG_END <= LDS_BYTES - 256, "RG-LRU LDS map");
constexpr int CW_RG = 8192;
DI void rglru_item(const Params& P, LAS unsigned char* lds, int j, int item, int wv) {
    const int tid = get_tid(wv), lane = tid & 63, wave = tid >> 6, r = lane & 15, g = lane >> 4;
    const int grp = item / NCHUNK, ci = item % NCHUNK, b = grp >> 3, hd = grp & 7;
    bf16_t* p = (bf16_t*)(P.ws + WS_P);
    const bf16_t* WRG = (const bf16_t*)(P.ws + WS_WRG);
    unsigned long long* AGG = (unsigned long long*)(P.ws + WS_AGG);
    unsigned* cnt = (unsigned*)(P.ws + WS_CTL) + CW_RG + (j * 64 + grp) * 16;
    const int R0 = b * LT + ci * 64;
    const int seg_lo = b * LT + (ci < 4 ? 0 : CTXL), seg_hi = b * LT + (ci < 4 ? CTXL : LT);
    LAS bf16_t* UT = (LAS bf16_t*)(lds + RG_UT);
    LAS float* AL = (LAS float*)(lds + RG_AL);
    LAS float* BL = (LAS float*)(lds + RG_BL);
    LAS unsigned* HP = (LAS unsigned*)(lds + RG_HP);
    LAS float* QA = (LAS float*)(lds + RG_QA);
    LAS float* CAR = (LAS float*)(lds + RG_CAR);
    TP_START(10, lds, tid); TP_START(11, lds, tid);
    bf16x8 wfr[2][2][4];
    float prm[2][3];
#pragma unroll
    for (int dir = 0; dir < 2; ++dir) {
#pragma unroll
        for (int gt = 0; gt < 2; ++gt) {
            const bf16_t* W = WRG + (size_t)((dir * 2 + gt) * 8 + hd) * 16384 + (wave * 4 * 64 + lane) * 8;
#pragma unroll
            for (int ks = 0; ks < 4; ++ks) wfr[dir][gt][ks] = *(const bf16x8*)(W + ks * 512);
        }
        const int idx = (j * 2 + dir) * 1024 + hd * 128 + 16 * wave + r;
        prm[dir][0] = P.ev_rg_bx[idx]; prm[dir][1] = P.ev_rg_ba[idx]; prm[dir][2] = P.ev_rg_lambda[idx];
    }
    {
        LAS bf16_t* XT = (LAS bf16_t*)(lds + RG_HP);
#pragma unroll
        for (int rep = 0; rep < 3; ++rep) {
            const int idx = tid + rep * 512, tr = idx >> 4, c0 = (idx & 15) * 8;
            if (idx < 67 * 16) {
                const int Rg = R0 + tr - 1;
                u32x4 xv = {0u, 0u, 0u, 0u};
                if (Rg >= seg_lo && Rg < seg_hi) xv = *(const u32x4*)(p + (size_t)Rg * EVEN_IN + hd * 128 + c0);
                *(LAS u32x4*)(XT + tr * 128 + c0) = xv;
            }
        }
        const int c0 = (tid & 15) * 8, cg0 = hd * 128 + c0;
        float wv4[4][8], bias[8];
        { const f32x4 b0 = *(const f32x4*)(P.ev_conv_b + j * 1024 + cg0), b1 = *(const f32x4*)(P.ev_conv_b + j * 1024 + cg0 + 4);
          bias[0] = b0[0]; bias[1] = b0[1]; bias[2] = b0[2]; bias[3] = b0[3]; bias[4] = b1[0]; bias[5] = b1[1]; bias[6] = b1[2]; bias[7] = b1[3]; }
#pragma unroll
        for (int k = 0; k < 4; ++k) { const float* wk = P.ev_conv_w + (size_t)(j * 4 + k) * 1024 + cg0; const f32x4 w0 = *(const f32x4*)wk, w1 = *(const f32x4*)(wk + 4);
            wv4[k][0] = w0[0]; wv4[k][1] = w0[1]; wv4[k][2] = w0[2]; wv4[k][3] = w0[3]; wv4[k][4] = w1[0]; wv4[k][5] = w1[1]; wv4[k][6] = w1[2]; wv4[k][7] = w1[3]; }
        __syncthreads();
#pragma unroll
        for (int rep = 0; rep < 2; ++rep) {
            const int t = (tid >> 4) + rep * 32;
            float acc[8];
#pragma unroll
            for (int e = 0; e < 8; ++e) acc[e] = bias[e];
#pragma unroll
            for (int k = 0; k < 4; ++k) {
                const u32x4 xv = *(const LAS u32x4*)(XT + (t + k) * 128 + c0);
                acc[0] += wv4[k][0] * __uint_as_float(xv.x << 16); acc[1] += wv4[k][1] * __uint_as_float(xv.x & 0xffff0000u);
                acc[2] += wv4[k][2] * __uint_as_float(xv.y << 16); acc[3] += wv4[k][3] * __uint_as_float(xv.y & 0xffff0000u);
                acc[4] += wv4[k][4] * __uint_as_float(xv.z << 16); acc[5] += wv4[k][5] * __uint_as_float(xv.z & 0xffff0000u);
                acc[6] += wv4[k][6] * __uint_as_float(xv.w << 16); acc[7] += wv4[k][7] * __uint_as_float(xv.w & 0xffff0000u);
            }
            u32x4 o; o.x = pk2(acc[0], acc[1]); o.y = pk2(acc[2], acc[3]); o.z = pk2(acc[4], acc[5]); o.w = pk2(acc[6], acc[7]);
            *(LAS u32x4*)(UT + t * 136 + c0) = o;
        }
    }
    __syncthreads();
    TP_STOP(11, lds, tid);
#pragma unroll
    for (int dir = 0; dir < 2; ++dir) {
        TP_START(12, lds, tid); TP_START(16, lds, tid);
        f32x4 ax[4], aa[4];
#pragma unroll
        for (int m = 0; m < 4; ++m) { ax[m] = (f32x4){0.f, 0.f, 0.f, 0.f}; aa[m] = (f32x4){0.f, 0.f, 0.f, 0.f}; }
#pragma unroll
        for (int ks = 0; ks < 4; ++ks) {
#pragma unroll
            for (int m = 0; m < 4; ++m) {
                const bf16x8 a = *(const LAS bf16x8*)(UT + (16 * m + r) * 136 + 32 * ks + 8 * g);
                ax[m] = MFMA16(a, wfr[dir][0][ks], ax[m]); aa[m] = MFMA16(a, wfr[dir][1][ks], aa[m]);
            }
        }
        asm volatile("" :: "v"(ax[0]), "v"(ax[1]), "v"(ax[2]), "v"(ax[3]), "v"(aa[0]), "v"(aa[1]), "v"(aa[2]), "v"(aa[3]));
        TP_STOP(16, lds, tid); TP_START(17, lds, tid);
        {
            const int c = 16 * wave + r;
            const float bxv = prm[dir][0], bav = prm[dir][1], lam = prm[dir][2];
            const float sp = softplus_neg(lam);
#pragma unroll
            for (int m = 0; m < 4; ++m)
#pragma unroll
                for (int i = 0; i < 4; ++i) {
                    const int t = 16 * m + 4 * g + i;
                    const float gx = sigm(ax[m][i] + bxv), ga = sigm(aa[m][i] + bav);
                    const float la = -8.f * ga * sp;
                    const float a = __expf(la), mult = __builtin_amdgcn_sqrtf(neg_expm1(2.f * la));
                    const float uv = bf2f(UT[t * 136 + c]);
                    AL[t * 128 + c] = a; BL[t * 128 + c] = mult * gx * uv;
                }
        }
        asm volatile("s_waitcnt lgkmcnt(0)" ::: "memory");
        TP_STOP(17, lds, tid); TP_START(18, lds, tid);
        __syncthreads();
        TP_STOP(18, lds, tid);
        TP_STOP(12, lds, tid); TP_START(13, lds, tid);
        {
            const int c = tid & 127, q = tid >> 7;
            float A = 1.f, B = 0.f;
#pragma unroll
            for (int s = 0; s < 16; ++s) { const int t = dir == 0 ? 16 * q + s : 16 * q + 15 - s; const float a = AL[t * 128 + c], bb = BL[t * 128 + c]; B = a * B + bb; A *= a; }
            QA[(q * 128 + c) * 2] = A; QA[(q * 128 + c) * 2 + 1] = B;
            __syncthreads();
            float h = 0.f, pc = 1.f;
            const int nprev = dir == 0 ? q : 3 - q;
            for (int qq = 0; qq < nprev; ++qq) { const int qi = dir == 0 ? qq : 3 - qq; const float a = QA[(qi * 128 + c) * 2]; h = a * h + QA[(qi * 128 + c) * 2 + 1]; pc *= a; }
#pragma unroll
            for (int s = 0; s < 16; ++s) { const int t = dir == 0 ? 16 * q + s : 16 * q + 15 - s; const float a = AL[t * 128 + c]; h = a * h + BL[t * 128 + c]; pc *= a;
                HP[(dir * 64 + t) * 128 + c] = pkh2(h, pc); }
            if (nprev == 3) {
                const unsigned long long v = ((unsigned long long)__float_as_uint(h) << 32) | __float_as_uint(pc);
                __hip_atomic_store(AGG + ((size_t)(dir * NB + b) * NCHUNK + ci) * 1024 + hd * 128 + c, v, __ATOMIC_RELAXED, __HIP_MEMORY_SCOPE_AGENT);
            }
        }
        __syncthreads();
        TP_STOP(13, lds, tid);
    }
    TP_START(14, lds, tid);
    u32x4 gpre[2];
#pragma unroll
    for (int rep = 0; rep < 2; ++rep) { const int idx = tid + rep * 512; gpre[rep] = *(const u32x4*)(p + (size_t)(R0 + (idx >> 4)) * EVEN_IN + 1536 + hd * 128 + (idx & 15) * 8); }
    asm volatile("s_waitcnt vmcnt(0)" ::: "memory");
    __syncthreads();
    if (tid == 0) {
        __hip_atomic_fetch_add(cnt, 1u, __ATOMIC_RELAXED, __HIP_MEMORY_SCOPE_AGENT);
        unsigned spins = 0;
        while (__hip_atomic_load(cnt, __ATOMIC_RELAXED, __HIP_MEMORY_SCOPE_AGENT) < (unsigned)NCHUNK) { __builtin_amdgcn_s_sleep(2); if (++spins > (1u << 22)) break; }
    }
    __syncthreads();
    TP_STOP(14, lds, tid); TP_START(15, lds, tid);
    if (tid < 256) {
        const int dir = tid >> 7, c = tid & 127;
        const int pos = dir == 0 ? ci : (ci < 4 ? 3 - ci : 39 - ci);
        float h = 0.f;
        const unsigned long long* ag = AGG + (size_t)(dir * NB + b) * NCHUNK * 1024 + hd * 128 + c;
#pragma unroll 1
        for (int base = 0; base < pos; base += 18) {
            unsigned long long v[18];
#pragma unroll
            for (int k = 0; k < 18; ++k) { const int pp = base + k < pos ? base + k : pos - 1; const int cc = dir == 0 ? pp : (pp < 4 ? 3 - pp : 39 - pp);
                v[k] = __hip_atomic_load(ag + (size_t)cc * 1024, __ATOMIC_RELAXED, __HIP_MEMORY_SCOPE_AGENT); }
#pragma unroll
            for (int k = 0; k < 18; ++k) if (base + k < pos) h = __uint_as_float((unsigned)v[k]) * h + __uint_as_float((unsigned)(v[k] >> 32));
        }
        CAR[dir * 128 + c] = h;
    }
    __syncthreads();
#pragma unroll
    for (int rep = 0; rep < 2; ++rep) {
        const int idx = tid + rep * 512, t = idx >> 4, c0 = (idx & 15) * 8;
        bf16_t* gp = p + (size_t)(R0 + t) * EVEN_IN + 1536 + hd * 128 + c0;
        const u32x4 gv = gpre[rep];
        float y[8];
#pragma unroll
        for (int e = 0; e < 8; ++e) {
            float h0, p0, h1, p1; unpkh2(HP[t * 128 + c0 + e], h0, p0); unpkh2(HP[(64 + t) * 128 + c0 + e], h1, p1);
            y[e] = (h0 + p0 * CAR[c0 + e]) + (h1 + p1 * CAR[128 + c0 + e]);
        }
        const float gg[8] = {__uint_as_float(gv.x << 16), __uint_as_float(gv.x & 0xffff0000u), __uint_as_float(gv.y << 16), __uint_as_float(gv.y & 0xffff0000u),
                             __uint_as_float(gv.z << 16), __uint_as_float(gv.z & 0xffff0000u), __uint_as_float(gv.w << 16), __uint_as_float(gv.w & 0xffff0000u)};
        u32x4 o;
        o.x = pk2(y[0] * gg[0] * sigm(gg[0]), y[1] * gg[1] * sigm(gg[1])); o.y = pk2(y[2] * gg[2] * sigm(gg[2]), y[3] * gg[3] * sigm(gg[3]));
        o.z = pk2(y[4] * gg[4] * sigm(gg[4]), y[5] * gg[5] * sigm(gg[5])); o.w = pk2(y[6] * gg[6] * sigm(gg[6]), y[7] * gg[7] * sigm(gg[7]));
        *(u32x4*)gp = o;
    }
    __syncthreads();
    TP_STOP(15, lds, tid); TP_STOP(10, lds, tid);
}

DI void rope8v(u32x4& v, const f32x4 cs, const f32x4 sn) {
    unsigned* w = (unsigned*)&v;
#pragma unroll
    for (int i = 0; i < 4; ++i) { const float t1 = __uint_as_float(w[i] << 16), t2 = __uint_as_float(w[i] & 0xffff0000u); w[i] = pk2(t1 * cs[i] - t2 * sn[i], t1 * sn[i] + t2 * cs[i]); }
}
DI void rope8(u32x4& v, const float* cs, const float* sn) { rope8v(v, *(const f32x4*)cs, *(const f32x4*)sn); }
typedef short v4i16_a __attribute__((ext_vector_type(4)));
DI void attn_item(const Params& P, LAS unsigned char* lds, int j, int item, int wv) {
    const int tid = get_tid(wv), lane = tid & 63, wave = tid >> 6, r = lane & 31, h = lane >> 5;
    const bool is_lat = item < 512;
    int b, qb, kvh;
    if (is_lat) { b = item >> 6; qb = (item >> 2) & 15; kvh = item & 3; } else { const int it = item - 512; b = it >> 3; qb = (it >> 2) & 1; kvh = it & 3; }
    bf16_t* p = (bf16_t*)(P.ws + WS_P);
    const float* cos_t = (const float*)(P.ws + WS_ROPE); const float* sin_t = cos_t + SEQ * 32;
    LAS unsigned char* QL = lds + 36864 + wave * 9216;
    TP_START(1, lds, tid);
    const int hq = 4 * kvh + (wave >> 1), ql0 = qb * 128 + 64 * (wave & 1);
    const size_t rowbase = (size_t)b * LT + (is_lat ? CTXL : 0);
    {
        const int chq = lane & 7;
#pragma unroll
        for (int k = 0; k < 8; ++k) {
            const int row = (lane >> 3) + 8 * k, qi = ql0 + row;
            u32x4 v = *(const u32x4*)(p + (rowbase + qi) * EVEN_IN + 2560 + hq * 64 + 8 * chq);
            if (is_lat) rope8(v, cos_t + qi * 32 + 4 * chq, sin_t + qi * 32 + 4 * chq);
            *(LAS u32x4*)(QL + row * 144 + chq * 16) = v;
        }
    }
    const float sink2 = P.ev_sink[j * 16 + hq] * LOG2E;
    float mrun[2] = {sink2, sink2}, lrun[2] = {h == 0 ? 1.f : 0.f, h == 0 ? 1.f : 0.f};
    f32x16 O[2][2];
#pragma unroll
    for (int a = 0; a < 2; ++a)
#pragma unroll
        for (int c = 0; c < 2; ++c)
#pragma unroll
            for (int i = 0; i < 16; ++i) O[a][c][i] = 0.f;
    const int w_lo = (is_lat && qb == 0) ? 2 : 0, w_hi = (is_lat && qb == 15) ? 3 : 5;
    const int nT = is_lat ? 4 + (w_hi - w_lo + 1) : 4;
    const float SC = 0.125f * LOG2E, NEG = -1e30f;
    const int key = tid >> 3, chn = tid & 7;
    u32x4 kreg, vreg; f32x4 creg, sreg;
#define ATT_K0(t) ((t) < 4 ? 64 * (t) : qb * 128 - 128 + 64 * (w_lo + (t) - 4))
#define ATT_LOAD(t) do { const bool win_ = (t) >= 4; const int k0_ = ATT_K0(t); \
        const bf16_t* kp_ = p + ((size_t)b * LT + (win_ ? CTXL : 0) + k0_ + key) * EVEN_IN + 1024 + kvh * 64 + 8 * chn; \
        kreg = *(const u32x4*)kp_; vreg = *(const u32x4*)(kp_ + 256); \
        if (win_) { creg = *(const f32x4*)(cos_t + (k0_ + key) * 32 + 4 * chn); sreg = *(const f32x4*)(sin_t + (k0_ + key) * 32 + 4 * chn); } } while (0)
#define ATT_STORE(t, buf) do { const bool win_ = (t) >= 4; \
        if (win_) rope8v(kreg, creg, sreg); \
        *(LAS u32x4*)(lds + (buf) * 18432 + key * 144 + chn * 16) = kreg; *(LAS u32x4*)(lds + (buf) * 18432 + 9216 + key * 144 + chn * 16) = vreg; } while (0)
    TP_START(2, lds, tid);
    ATT_LOAD(0); ATT_STORE(0, 0);
    if (nT > 1) ATT_LOAD(1);
#pragma unroll 1
    for (int t = 0; t < nT; ++t) {
        TP_START(4, lds, tid);
        __syncthreads();
        TP_STOP(4, lds, tid);
        if (t + 1 < nT) { ATT_STORE(t + 1, (t + 1) & 1); if (t + 2 < nT) ATT_LOAD(t + 2); }
        TP_START(3, lds, tid);
        const bool win = t >= 4;
        const int k0 = ATT_K0(t);
        const int dq = k0 - ql0;
        if (win && (dq >= 192 || dq <= -192)) continue;
        const bool need_mask = win && (dq >= 128 || dq <= -128);
        const LAS unsigned char* KL = lds + (t & 1) * 18432;
        const LAS bf16_t* VL = (const LAS bf16_t*)(lds + (t & 1) * 18432 + 9216);
#pragma unroll
        for (int qt = 0; qt < 2; ++qt) {
            f32x16 s0, s1;
#pragma unroll
            for (int i = 0; i < 16; ++i) { s0[i] = 0.f; s1[i] = 0.f; }
#pragma unroll
            for (int ks = 0; ks < 4; ++ks) {
                const bf16x8 qfr = *(const LAS bf16x8*)(QL + (32 * qt + r) * 144 + (16 * ks + 8 * h) * 2);
                const bf16x8 k0f = *(const LAS bf16x8*)(KL + r * 144 + (16 * ks + 8 * h) * 2), k1f = *(const LAS bf16x8*)(KL + (32 + r) * 144 + (16 * ks + 8 * h) * 2);
                s0 = MFMA32(k0f, qfr, s0); s1 = MFMA32(k1f, qfr, s1);
            }
            const int qpos = ql0 + 32 * qt + r;
            float mx = NEG;
            if (need_mask) {
#pragma unroll
                for (int i = 0; i < 16; ++i) {
                    const int d0 = qpos - (k0 + crow(i, h)), d1 = d0 - 32;
                    float v0 = s0[i] * SC, v1 = s1[i] * SC;
                    if (d0 > 128 || d0 < -128) v0 = NEG;
                    if (d1 > 128 || d1 < -128) v1 = NEG;
                    s0[i] = v0; s1[i] = v1; mx = fmaxf(mx, fmaxf(v0, v1));
                }
            } else {
#pragma unroll
                for (int i = 0; i < 16; ++i) { s0[i] *= SC; s1[i] *= SC; mx = fmaxf(mx, fmaxf(s0[i], s1[i])); }
            }
            mx = fmaxf(mx, shfl_xor_f(mx, 32));
            const float mn = fmaxf(mrun[qt], mx), alpha = __builtin_amdgcn_exp2f(mrun[qt] - mn);
            mrun[qt] = mn;
            float ls = 0.f;
#pragma unroll
            for (int i = 0; i < 16; ++i) { s0[i] = __builtin_amdgcn_exp2f(s0[i] - mn); s1[i] = __builtin_amdgcn_exp2f(s1[i] - mn); ls += s0[i] + s1[i]; }
            lrun[qt] = lrun[qt] * alpha + ls;
#pragma unroll
            for (int dt = 0; dt < 2; ++dt)
#pragma unroll
                for (int i = 0; i < 16; ++i) O[dt][qt][i] *= alpha;
            bf16x8 pf[2][2];
#pragma unroll
            for (int s = 0; s < 2; ++s) {
                u32x4 a, c;
                a.x = pk2(s0[8 * s + 0], s0[8 * s + 1]); a.y = pk2(s0[8 * s + 2], s0[8 * s + 3]); a.z = pk2(s0[8 * s + 4], s0[8 * s + 5]); a.w = pk2(s0[8 * s + 6], s0[8 * s + 7]);
                c.x = pk2(s1[8 * s + 0], s1[8 * s + 1]); c.y = pk2(s1[8 * s + 2], s1[8 * s + 3]); c.z = pk2(s1[8 * s + 4], s1[8 * s + 5]); c.w = pk2(s1[8 * s + 6], s1[8 * s + 7]);
                pf[0][s] = __builtin_bit_cast(bf16x8, a); pf[1][s] = __builtin_bit_cast(bf16x8, c);
            }
            const int gq = (lane >> 4) & 1, qq4 = (lane & 15) >> 2, pp4 = lane & 3;
#pragma unroll
            for (int dt = 0; dt < 2; ++dt)
#pragma unroll
                for (int kt = 0; kt < 2; ++kt)
#pragma unroll
                    for (int s = 0; s < 2; ++s) {
                        const LAS bf16_t* vp = VL + (32 * kt + 16 * s + 4 * h + qq4) * 72 + 32 * dt + 16 * gq + 4 * pp4;
                        const v4i16_a lo = __builtin_amdgcn_ds_read_tr16_b64_v4i16((LAS v4i16_a*)vp);
                        const v4i16_a hi = __builtin_amdgcn_ds_read_tr16_b64_v4i16((LAS v4i16_a*)(vp + 8 * 72));
                        const bf16x8 vf = {lo[0], lo[1], lo[2], lo[3], hi[0], hi[1], hi[2], hi[3]};
                        O[dt][qt] = MFMA32(vf, pf[kt][s], O[dt][qt]);
                    }
            __builtin_amdgcn_sched_barrier(0);
        }
        TP_STOP(3, lds, tid);
    }
    TP_STOP(2, lds, tid);
#undef ATT_K0
#undef ATT_LOAD
#undef ATT_STORE
    {
        const int chq = lane & 7;
        u32x4 gate[8];
#pragma unroll
        for (int k = 0; k < 8; ++k) gate[k] = *(const u32x4*)(p + (rowbase + ql0 + (lane >> 3) + 8 * k) * EVEN_IN + 3584 + hq * 64 + 8 * chq);
#pragma unroll
        for (int qt = 0; qt < 2; ++qt) {
            const float lt = lrun[qt] + shfl_xor_f(lrun[qt], 32), inv = __builtin_amdgcn_rcpf(lt);
#pragma unroll
            for (int dt = 0; dt < 2; ++dt)
#pragma unroll
                for (int i4 = 0; i4 < 4; ++i4) {
                    u32x2 o; o.x = pk2(O[dt][qt][4 * i4 + 0] * inv, O[dt][qt][4 * i4 + 1] * inv); o.y = pk2(O[dt][qt][4 * i4 + 2] * inv, O[dt][qt][4 * i4 + 3] * inv);
                    *(LAS u32x2*)(QL + (32 * qt + r) * 144 + (32 * dt + 8 * i4 + 4 * h) * 2) = o;
                }
        }
#pragma unroll
        for (int k = 0; k < 8; ++k) {
            const int row = (lane >> 3) + 8 * k;
            const u32x4 ov = *(const LAS u32x4*)(QL + row * 144 + chq * 16);
            const unsigned* ow = (const unsigned*)&ov; const unsigned* gw = (const unsigned*)&gate[k];
            u32x4 res; unsigned* rw = (unsigned*)&res;
#pragma unroll
            for (int e = 0; e < 4; ++e) {
                const float g0 = __uint_as_float(gw[e] << 16), g1 = __uint_as_float(gw[e] & 0xffff0000u);
                rw[e] = pk2(__uint_as_float(ow[e] << 16) * g0 * sigm(g0), __uint_as_float(ow[e] & 0xffff0000u) * g1 * sigm(g1));
            }
            *(u32x4*)(p + (rowbase + ql0 + row) * EVEN_IN + 2560 + hq * 64 + 8 * chq) = res;
        }
    }
    __syncthreads();
    TP_STOP(1, lds, tid);
}

constexpr int G2_QX = 0, G2_KF = 17408, G2_K2 = 60928, G2_VS = 79360, G2_AM = 96768, G2_ST = 105984, G2_PS = 140800, G2_BL = 144896, G2_Q1 = 145408, G2_END = 162816;
static_assert(G2_END <= LDS_BYTES - 256, "GLA LDS map");
typedef short v4i16_t __attribute__((ext_vector_type(4)));
DI bf16x8 frag_tr(const LAS bf16_t* M, int stride, int k0, int n0, int lane) {
    const int i = lane & 15, g = lane >> 4, q = i >> 2, pp = i & 3;
    const LAS bf16_t* a0 = M + (k0 + 8 * g + q) * stride + n0 + 4 * pp;
    const v4i16_t lo = __builtin_amdgcn_ds_read_tr16_b64_v4i16((LAS v4i16_t*)a0);
    const v4i16_t hi = __builtin_amdgcn_ds_read_tr16_b64_v4i16((LAS v4i16_t*)(a0 + 4 * stride));
    return (bf16x8){lo[0], lo[1], lo[2], lo[3], hi[0], hi[1], hi[2], hi[3]};
}

#ifndef GLA_SPLIT
#define GLA_SPLIT 24
#endif
template <int DIR>
DI void gla2_item(const Params& P, LAS unsigned char* lds, int layer_j, int b, int hd, int part, int wv) {
    const int tid = get_tid(wv), lane = tid & 63, wave = tid >> 6, r = lane & 15, g = lane >> 4;
    bf16_t* p = (bf16_t*)(P.ws + WS_P);
    LAS bf16_t* QX = (LAS bf16_t*)(lds + G2_QX); LAS bf16_t* KF = (LAS bf16_t*)(lds + G2_KF); LAS bf16_t* K2 = (LAS bf16_t*)(lds + G2_K2);
    LAS bf16_t* VS = (LAS bf16_t*)(lds + G2_VS); LAS bf16_t* AM = (LAS bf16_t*)(lds + G2_AM); LAS bf16_t* ST = (LAS bf16_t*)(lds + G2_ST);
    LAS float* PS8 = (LAS float*)(lds + G2_PS); LAS float* BLAST = (LAS float*)(lds + G2_BL); LAS bf16_t* Q1 = (LAS bf16_t*)(lds + G2_Q1);
    const int d0 = 2 * lane, tg = wave, I = tg >> 1, half = tg & 1;
    float lbv[2] = {0.f, 0.f};
    if (layer_j > 0) { lbv[0] = sigm(P.od_lb_raw[1024 + hd * 128 + d0] - P.od_lb_raw[hd * 128 + d0]); lbv[1] = sigm(P.od_lb_raw[1024 + hd * 128 + d0 + 1] - P.od_lb_raw[hd * 128 + d0 + 1]); }
    unsigned* prog = (unsigned*)(P.ws + WS_CTL) + 10240 + ((layer_j * 128 + b * 16 + hd * 2 + DIR) * 8);
    const int step_end = part == 0 ? GLA_SPLIT : NCHUNK;
    TP_START(20, lds, tid);
    for (int i = tid; i < (9216 + 34816) / 4; i += 512) ((LAS unsigned*)(lds + G2_AM))[i] = 0u;
    f32x4 st[8];
#pragma unroll
    for (int e = 0; e < 8; ++e) st[e] = (f32x4){0.f, 0.f, 0.f, 0.f};
    unsigned zn[8], qn[8]; u32x4 vn[2];
#define G2_OFFZ(s) ((unsigned)((DIR == 0 ? 8 * tg + (s) : 63 - 8 * tg - (s)) * ODD_IN + d0) * 2u)
#define G2_OFFV(rep) ((unsigned)((DIR == 0 ? ((tid + (rep) * 512) >> 4) : 63 - ((tid + (rep) * 512) >> 4)) * ODD_IN + 8 * ((tid + (rep) * 512) & 15)) * 2u)
    const size_t colz = (size_t)DIR * 1024 + hd * 128, colq = 3072 + hd * 128, colv = 2048 + hd * 128;
    {
        const int chunk = DIR == 0 ? 0 : 3;
        const char* slab = (const char*)(p + ((size_t)b * LT + (size_t)chunk * 64) * ODD_IN);
#pragma unroll
        for (int s = 0; s < 8; ++s) { zn[s] = *(const unsigned*)(slab + colz * 2 + G2_OFFZ(s)); qn[s] = *(const unsigned*)(slab + colq * 2 + G2_OFFZ(s)); }
#pragma unroll
        for (int rep = 0; rep < 2; ++rep) vn[rep] = *(const u32x4*)(slab + colv * 2 + G2_OFFV(rep));
    }
    __syncthreads();
#pragma unroll 1
    for (int step = 0; step < step_end; ++step) {
        const bool sonly = part == 1 && step < GLA_SPLIT;
        const int chunk = DIR == 0 ? step : (step < 4 ? 3 - step : 39 - step);
        const size_t Rc0 = (size_t)b * LT + (size_t)chunk * 64;
        unsigned zc[8], qc[8]; u32x4 vc[2];
#pragma unroll
        for (int s = 0; s < 8; ++s) { zc[s] = zn[s]; qc[s] = qn[s]; }
        vc[0] = vn[0]; vc[1] = vn[1];
        TP_START(21, lds, tid);
        float el[8][2], kk[8][2], qq[8][2];
        {
            float run0 = 1.f, run1 = 1.f;
#pragma unroll
            for (int s = 0; s < 8; ++s) {
                const float z0 = __uint_as_float(zc[s] << 16), z1 = __uint_as_float(zc[s] & 0xffff0000u);
                const float t0 = __expf(-z0), t1 = __expf(-z1), sg0 = __builtin_amdgcn_rcpf(1.f + t0), sg1 = __builtin_amdgcn_rcpf(1.f + t1);
                const float f0 = fmaxf(lbv[0] + (1.f - lbv[0]) * sg0, 1e-30f), f1 = fmaxf(lbv[1] + (1.f - lbv[1]) * sg1, 1e-30f);
                kk[s][0] = (1.f - lbv[0]) * (t0 * sg0); kk[s][1] = (1.f - lbv[1]) * (t1 * sg1);
                run0 = fmaxf(run0 * f0, 1e-35f); run1 = fmaxf(run1 * f1, 1e-35f); el[s][0] = run0; el[s][1] = run1;
                if (!sonly) {
                const float q0 = __uint_as_float(qc[s] << 16), q1 = __uint_as_float(qc[s] & 0xffff0000u);
                qq[s][0] = q0 * __builtin_amdgcn_rcpf(1.f + __expf(-q0)); qq[s][1] = q1 * __builtin_amdgcn_rcpf(1.f + __expf(-q1));
                } else { qq[s][0] = 0.f; qq[s][1] = 0.f; }
                if ((s & 1) == 1) __builtin_amdgcn_sched_barrier(0);
            }
            *(LAS f32x2*)(PS8 + tg * 128 + d0) = (f32x2){run0, run1};
#pragma unroll
            for (int rep = 0; rep < 2; ++rep) { const int idx = tid + rep * 512, tau = idx >> 4, chn = idx & 15; *(LAS u32x4*)(VS + tau * 136 + 8 * chn) = vc[rep]; }
        }
        __syncthreads();
        if (part == 1 && step < GLA_SPLIT && tid == 0) __hip_atomic_store(prog, (unsigned)(step + 1), __ATOMIC_RELAXED, __HIP_MEMORY_SCOPE_AGENT);
        TP_STOP(21, lds, tid); TP_START(22, lds, tid);
        float RI[2];
        {
            float T[8][2];
#pragma unroll
            for (int q8 = 0; q8 < 8; ++q8) { const f32x2 t = *(const LAS f32x2*)(PS8 + q8 * 128 + d0); T[q8][0] = t[0]; T[q8][1] = t[1]; }
            float pre[2], fac[4][2], f4[2];
#pragma unroll
            for (int x = 0; x < 2; ++x) {
                const float P0 = T[0][x] * T[1][x], P1 = T[2][x] * T[3][x], P2 = T[4][x] * T[5][x], P3 = T[6][x] * T[7][x];
                pre[x] = half ? (I == 0 ? T[0][x] : (I == 1 ? T[2][x] : (I == 2 ? T[4][x] : T[6][x]))) : 1.f;
                RI[x] = I == 0 ? 1.f : (I == 1 ? P0 : (I == 2 ? P0 * P1 : P0 * P1 * P2));
                float cur = 1.f;
                fac[0][x] = cur; if (I <= 0) cur *= P0;
                fac[1][x] = cur; if (I <= 1) cur *= P1;
                fac[2][x] = cur; if (I <= 2) cur *= P2;
                fac[3][x] = cur; cur *= P3;
                f4[x] = cur;
                if (tg == 0) BLAST[d0 + x] = P0 * P1 * P2 * P3;
            }
            unsigned w0[4], w1[4];
#pragma unroll
            for (int s = 0; s < 8; ++s) {
                const int tau = 8 * tg + s;
                const float e00 = fmaxf(pre[0] * el[s][0], 1e-35f), e01 = fmaxf(pre[1] * el[s][1], 1e-35f);
                const float qi0 = qq[s][0] * e00, qi1 = qq[s][1] * e01;
                const float kd0 = kk[s][0] * __builtin_amdgcn_rcpf(e00), kd1 = kk[s][1] * __builtin_amdgcn_rcpf(e01);
                if (!sonly) {
                *(LAS unsigned*)(QX + tau * 136 + d0) = pk2(qi0, qi1);
                *(LAS unsigned*)(Q1 + tau * 136 + d0) = pk2(qi0 * RI[0], qi1 * RI[1]);
                if (I <= 0) *(LAS unsigned*)(KF + (0 + tau) * 136 + d0) = pk2(kd0 * fac[0][0], kd1 * fac[0][1]);
                if (I <= 1) *(LAS unsigned*)(KF + (16 + tau) * 136 + d0) = pk2(kd0 * fac[1][0], kd1 * fac[1][1]);
                if (I <= 2) *(LAS unsigned*)(KF + (48 + tau) * 136 + d0) = pk2(kd0 * fac[2][0], kd1 * fac[2][1]);
                *(LAS unsigned*)(KF + (96 + tau) * 136 + d0) = pk2(kd0 * fac[3][0], kd1 * fac[3][1]);
                }
                const unsigned h0 = f2bf(kd0 * f4[0]), h1 = f2bf(kd1 * f4[1]);
                if (s & 1) { w0[s >> 1] |= h0 << 16; w1[s >> 1] |= h1 << 16; } else { w0[s >> 1] = h0; w1[s >> 1] = h1; }
                if ((s & 1) == 1) __builtin_amdgcn_sched_barrier(0);
            }
            *(LAS u32x4*)(K2 + (d0 + 0) * 72 + 8 * tg) = (u32x4){w0[0], w0[1], w0[2], w0[3]};
            *(LAS u32x4*)(K2 + (d0 + 1) * 72 + 8 * tg) = (u32x4){w1[0], w1[1], w1[2], w1[3]};
        }
        __syncthreads();
        TP_STOP(22, lds, tid); TP_START(23, lds, tid);
        if (step + 1 < step_end) {
            const int nchunk = DIR == 0 ? step + 1 : (step + 1 < 4 ? 2 - step : 38 - step);
            const char* slab = (const char*)(p + ((size_t)b * LT + (size_t)nchunk * 64) * ODD_IN);
#pragma unroll
            for (int s = 0; s < 8; ++s) { zn[s] = *(const unsigned*)(slab + colz * 2 + G2_OFFZ(s)); qn[s] = *(const unsigned*)(slab + colq * 2 + G2_OFFZ(s)); }
#pragma unroll
            for (int rep = 0; rep < 2; ++rep) vn[rep] = *(const u32x4*)(slab + colv * 2 + G2_OFFV(rep));
        }
#pragma unroll 1
        for (int bi = sonly ? 10 : wave; bi < 10; bi += 8) {
            const int Ib = bi < 1 ? 0 : (bi < 3 ? 1 : (bi < 6 ? 2 : 3)), Jb = bi - (Ib * (Ib + 1)) / 2;
            const int foff = Ib == 0 ? 0 : (Ib == 1 ? 16 : (Ib == 2 ? 48 : 96));
            f32x4 acc = {0.f, 0.f, 0.f, 0.f};
#pragma unroll
            for (int ks = 0; ks < 4; ++ks) {
                const bf16x8 a = *(const LAS bf16x8*)(QX + (16 * Ib + r) * 136 + 32 * ks + 8 * g);
                const bf16x8 bb = *(const LAS bf16x8*)(KF + (foff + 16 * Jb + r) * 136 + 32 * ks + 8 * g);
                acc = MFMA16(a, bb, acc);
            }
#pragma unroll
            for (int i = 0; i < 4; ++i) { float v = acc[i]; if (Jb == Ib && r > 4 * g + i) v = 0.f; AM[(16 * Ib + 4 * g + i) * 72 + 16 * Jb + r] = (bf16_t)f2bf(v); }
        }
        if (!sonly) __syncthreads();
        TP_STOP(23, lds, tid); TP_START(24, lds, tid);
        {
            if (!sonly) {
            const int tt = wave >> 1, eb = 4 * (wave & 1);
            bf16x8 aq[4], am[2];
#pragma unroll
            for (int ks = 0; ks < 4; ++ks) aq[ks] = *(const LAS bf16x8*)(Q1 + (16 * tt + r) * 136 + 32 * ks + 8 * g);
#pragma unroll
            for (int ks = 0; ks < 2; ++ks) am[ks] = *(const LAS bf16x8*)(AM + (16 * tt + r) * 72 + 32 * ks + 8 * g);
#pragma unroll
            for (int e4 = 0; e4 < 4; ++e4) {
                const int et = eb + e4;
                f32x4 acc = {0.f, 0.f, 0.f, 0.f};
#pragma unroll
                for (int ks = 0; ks < 4; ++ks) { const bf16x8 bb = *(const LAS bf16x8*)(ST + (16 * et + r) * 136 + 32 * ks + 8 * g); acc = MFMA16(aq[ks], bb, acc); }
#pragma unroll
                for (int ks = 0; ks < 2; ++ks) acc = MFMA16(am[ks], frag_tr(VS, 136, 32 * ks, 16 * et, lane), acc);
#pragma unroll
                for (int i = 0; i < 4; ++i) KF[(16 * tt + 4 * g + i) * 136 + 16 * et + r] = (bf16_t)f2bf(acc[i]);
                __builtin_amdgcn_sched_barrier(0);
            }
            }
            float bl[4];
#pragma unroll
            for (int i = 0; i < 4; ++i) bl[i] = BLAST[16 * wave + 4 * g + i];
            bf16x8 ak[2];
#pragma unroll
            for (int ks = 0; ks < 2; ++ks) ak[ks] = *(const LAS bf16x8*)(K2 + (16 * wave + r) * 72 + 32 * ks + 8 * g);
#pragma unroll
            for (int et = 0; et < 8; ++et) {
#pragma unroll
                for (int i = 0; i < 4; ++i) st[et][i] *= bl[i];
#pragma unroll
                for (int ks = 0; ks < 2; ++ks) st[et] = MFMA16(ak[ks], frag_tr(VS, 136, 32 * ks, 16 * et, lane), st[et]);
                if (et & 1) __builtin_amdgcn_sched_barrier(0);
            }
        }
        if (part == 0 && tid == 0) { unsigned spins = 0; while (__hip_atomic_load(prog, __ATOMIC_RELAXED, __HIP_MEMORY_SCOPE_AGENT) < (unsigned)(step + 1)) { __builtin_amdgcn_s_sleep(2); if (++spins > (1u << 22)) break; } }
        __syncthreads();
        TP_STOP(24, lds, tid); TP_START(25, lds, tid);
        if (!sonly) {
            char* oslab = (char*)(p + Rc0 * ODD_IN + colz);
#pragma unroll
            for (int rep = 0; rep < 2; ++rep) {
                const int idx = tid + rep * 512, tau = idx >> 4, chn = idx & 15;
                const u32x4 ov = *(const LAS u32x4*)(KF + tau * 136 + 8 * chn);
                *(u32x4*)(oslab + (unsigned)((DIR == 0 ? tau : 63 - tau) * ODD_IN + 8 * chn) * 2u) = ov;
            }
        }
        if (!sonly || step == GLA_SPLIT - 1) {
#pragma unroll
        for (int et = 0; et < 8; ++et) { u32x2 w; w.x = pk2(st[et][0], st[et][1]); w.y = pk2(st[et][2], st[et][3]); *(LAS u32x2*)(ST + (16 * et + r) * 136 + 16 * wave + 4 * g) = w; }
        }
        TP_STOP(25, lds, tid);
    }
    __syncthreads();
    TP_STOP(20, lds, tid);
}

DI void phase_readout(const Params& P, int layer_j, int wv) {
    const int tid = get_tid(wv), lane = tid & 63, wave = tid >> 6;
    const int gw = get_bid() * 8 + wave, NGW = gridDim.x * 8;
    bf16_t* p = (bf16_t*)(P.ws + WS_P);
    const float* gwt = P.od_gnorm_w + layer_j * 128 + (lane & 7) * 16;
    for (int R = gw; R < MROWS; R += NGW) {
        const bf16_t* op = p + (size_t)R * ODD_IN + 16 * lane; bf16_t* yp = p + (size_t)R * ODD_IN + 4096 + 16 * lane;
        const u32x4 o0 = *(const u32x4*)op, o1 = *(const u32x4*)(op + 8), c0 = *(const u32x4*)(op + 1024), c1 = *(const u32x4*)(op + 1032), g0 = *(const u32x4*)yp, g1 = *(const u32x4*)(yp + 8);
        float ov[16], gv[16];
        const unsigned* ow0 = (const unsigned*)&o0; const unsigned* ow1 = (const unsigned*)&o1; const unsigned* cw0 = (const unsigned*)&c0; const unsigned* cw1 = (const unsigned*)&c1;
        const unsigned* gw0 = (const unsigned*)&g0; const unsigned* gw1 = (const unsigned*)&g1;
#pragma unroll
        for (int i = 0; i < 4; ++i) {
            ov[2 * i] = __uint_as_float(ow0[i] << 16) + __uint_as_float(cw0[i] << 16); ov[2 * i + 1] = __uint_as_float(ow0[i] & 0xffff0000u) + __uint_as_float(cw0[i] & 0xffff0000u);
            ov[8 + 2 * i] = __uint_as_float(ow1[i] << 16) + __uint_as_float(cw1[i] << 16); ov[8 + 2 * i + 1] = __uint_as_float(ow1[i] & 0xffff0000u) + __uint_as_float(cw1[i] & 0xffff0000u);
            gv[2 * i] = __uint_as_float(gw0[i] << 16); gv[2 * i + 1] = __uint_as_float(gw0[i] & 0xffff0000u); gv[8 + 2 * i] = __uint_as_float(gw1[i] << 16); gv[8 + 2 * i + 1] = __uint_as_float(gw1[i] & 0xffff0000u);
        }
        float ss = 0.f;
#pragma unroll
        for (int i = 0; i < 16; ++i) ss += ov[i] * ov[i];
        ss += shfl_xor_f(ss, 1); ss += shfl_xor_f(ss, 2); ss += shfl_xor_f(ss, 4);
        const float rstd = rsqrtf(ss * (1.f / 128.f) + RMS_EPS);
        float y[16];
#pragma unroll
        for (int i = 0; i < 16; ++i) y[i] = ov[i] * rstd * gwt[i] * (gv[i] * sigm(gv[i]));
        u32x4 w0, w1;
        w0.x = pk2(y[0], y[1]); w0.y = pk2(y[2], y[3]); w0.z = pk2(y[4], y[5]); w0.w = pk2(y[6], y[7]);
        w1.x = pk2(y[8], y[9]); w1.y = pk2(y[10], y[11]); w1.z = pk2(y[12], y[13]); w1.w = pk2(y[14], y[15]);
        *(u32x4*)yp = w0; *(u32x4*)(yp + 8) = w1;
    }
}

DI void phase_final(const Params& P, int wv) {
    const int tid = get_tid(wv), lane = tid & 63, wave = tid >> 6;
    const int gw = get_bid() * 8 + wave, NGW = gridDim.x * 8;
    for (int R = gw; R < NB * SEQ; R += NGW) {
        float* row = P.out + (size_t)R * DM;
        f32x4 v[4]; float ss = 0.f;
#pragma unroll
        for (int q = 0; q < 4; ++q) { v[q] = *(const f32x4*)(row + 4 * lane + 256 * q); ss += (v[q][0] * v[q][0] + v[q][1] * v[q][1]) + (v[q][2] * v[q][2] + v[q][3] * v[q][3]); }
        const float rstd = rsqrtf(wave_sum(ss) * (1.f / DM) + RMS_EPS);
#pragma unroll
        for (int q = 0; q < 4; ++q) { const f32x4 w4 = *(const f32x4*)(P.final_norm_w + 4 * lane + 256 * q); *(f32x4*)(row + 4 * lane + 256 * q) = (v[q] * rstd) * w4; }
    }
}

#define XB_TMO      128
#define XB_XCNT(j)  (256  + 64 * (j))
#define XB_XSUB(j)  (1280 + 64 * (j))
#define XB_XGEN(j)  (2304 + 64 * (j))
#define XB_TOP      3328
#define XB_TOPGEN   3392
#define XCD_BAR_WORDS 3456
#define XB_SPIN_CAP (1u << 18)

__device__ __forceinline__ unsigned xb_ld(unsigned* p)              { return __hip_atomic_load(p, __ATOMIC_RELAXED, __HIP_MEMORY_SCOPE_AGENT); }
__device__ __forceinline__ unsigned xb_add(unsigned* p, unsigned v) { return __hip_atomic_fetch_add(p, v, __ATOMIC_RELAXED, __HIP_MEMORY_SCOPE_AGENT); }
__device__ __forceinline__ unsigned xb_xcc_id() { return (unsigned)__builtin_amdgcn_s_getreg((3 << 11) | 20) & 0xFu; }
#define XB_SPIN(cond, bar) do { unsigned _sp = 0; while (cond) { __builtin_amdgcn_s_sleep(1); \
    if ((++_sp & 255u) == 0u) { if (xb_ld(&(bar)[XB_TMO])) break; if (_sp > XB_SPIN_CAP) { atomicAdd(&(bar)[XB_TMO], 1u); break; } } } } while (0)

struct XcdBarrier {
    unsigned* bar; unsigned x;
    volatile LAS unsigned* st;
};

__device__ __forceinline__ XcdBarrier xcd_barrier_post(unsigned* bar, volatile LAS unsigned* st, int wv) {
    XcdBarrier b; b.bar = bar; b.x = xb_xcc_id(); b.st = st;
    if (get_tid(wv) == 0) (void)xb_add(&bar[XB_XCNT(b.x)], 1u);
    return b;
}
__device__ __forceinline__ void xcd_barrier_complete(unsigned* bar, unsigned x, unsigned& nloc, unsigned& nx) {
    const unsigned G = gridDim.x * gridDim.y * gridDim.z;
    unsigned sum, cnt, mine, sp = 0u;
    for (;;) {
        sum = 0u; cnt = 0u; mine = 0u;
#pragma unroll
        for (unsigned j = 0; j < 16; ++j) { const unsigned c = xb_ld(&bar[XB_XCNT(j)]); sum += c; cnt += (c > 0u) ? 1u : 0u; mine = (j == x) ? c : mine; }
        if (sum == G) break;
        __builtin_amdgcn_s_sleep(1);
        if ((++sp & 255u) == 0u) { if (xb_ld(&bar[XB_TMO])) break; if (sp > XB_SPIN_CAP) { atomicAdd(&bar[XB_TMO], 1u); break; } }
    }
    nloc = mine > 0u ? mine : 1u; nx = cnt > 0u ? cnt : 1u;
}

__device__ __forceinline__ void xcd_barrier(const XcdBarrier& b, int wv) {
    asm volatile("s_waitcnt vmcnt(0)" ::: "memory");
    __syncthreads();
    if (get_tid(wv) == 0) {
        unsigned* bar = b.bar;
        __builtin_amdgcn_s_waitcnt(0);
        unsigned nloc = b.st[0], nx = b.st[1];
        if (nloc == 0u) { xcd_barrier_complete(bar, b.x, nloc, nx); b.st[0] = nloc; b.st[1] = nx; }
        const unsigned old = xb_add(&bar[XB_XSUB(b.x)], 1u);
        const unsigned gen = old / nloc;
        if (old + 1u == (gen + 1u) * nloc) {
            __builtin_amdgcn_fence(__ATOMIC_RELEASE, "agent");
            asm volatile("s_waitcnt vmcnt(0)" ::: "memory");
            const unsigned og = xb_add(&bar[XB_TOP], 1u);
            const unsigned tg = og / nx;
            if (og + 1u == (tg + 1u) * nx) xb_add(&bar[XB_TOPGEN], 1u);
            else XB_SPIN(xb_ld(&bar[XB_TOPGEN]) == tg, bar);
            __builtin_amdgcn_fence(__ATOMIC_ACQUIRE, "agent");
            xb_add(&bar[XB_XGEN(b.x)], 1u);
            asm volatile("s_waitcnt vmcnt(0)" ::: "memory");
        } else {
            XB_SPIN(xb_ld(&bar[XB_XGEN(b.x)]) == gen, bar);
            __builtin_amdgcn_fence(__ATOMIC_ACQUIRE, "agent");
            asm volatile("s_waitcnt vmcnt(0)" ::: "memory");
        }
    }
    __syncthreads();
}

constexpr int PARAM_OFF = LDS_BYTES - 256;
static_assert(G2_END <= PARAM_OFF && sizeof(Params) <= 208, "LDS map");
DI const float* ld_uptr(const LAS unsigned long long* s, int i) {
    const unsigned long long v = s[i];
    const unsigned lo = __builtin_amdgcn_readfirstlane((unsigned)v), hi = __builtin_amdgcn_readfirstlane((unsigned)(v >> 32));
    return (const float*)(const __attribute__((address_space(1))) float*)(((unsigned long long)hi << 32) | lo);
}
DI Params load_params(LAS unsigned char* lds) {
    LAS unsigned char* pb = lds + PARAM_OFF; asm volatile("" : "+v"(pb));
    const LAS unsigned long long* s = (const LAS unsigned long long*)pb;
    Params Q;
    Q.x = ld_uptr(s, 0); Q.c = ld_uptr(s, 1); Q.ctx = ld_uptr(s, 2); Q.c_ctx = ld_uptr(s, 3); Q.ada_w = ld_uptr(s, 4); Q.ada_b = ld_uptr(s, 5); Q.norm_w = ld_uptr(s, 6);
    Q.ev_w_in = ld_uptr(s, 7); Q.ev_conv_w = ld_uptr(s, 8); Q.ev_conv_b = ld_uptr(s, 9); Q.ev_rg_wx = ld_uptr(s, 10); Q.ev_rg_bx = ld_uptr(s, 11); Q.ev_rg_wa = ld_uptr(s, 12);
    Q.ev_rg_ba = ld_uptr(s, 13); Q.ev_rg_lambda = ld_uptr(s, 14); Q.ev_sink = ld_uptr(s, 15); Q.ev_w_out = ld_uptr(s, 16); Q.od_w_in = ld_uptr(s, 17); Q.od_lb_raw = ld_uptr(s, 18);
    Q.od_gnorm_w = ld_uptr(s, 19); Q.od_w_out = ld_uptr(s, 20); Q.final_norm_w = ld_uptr(s, 21); Q.out = (float*)ld_uptr(s, 22); Q.ws = (unsigned char*)ld_uptr(s, 23);
    Q.ph_lo = 0; Q.ph_hi = 0;
    return Q;
}
DI void run_phase(LAS unsigned char* lds, int ph, int wv) {
    #ifndef PHMASK
#define PHMASK 0xffff
#endif
    if (ph == 0) { if (PHMASK & 1) { const Params P = load_params(lds); phase_pro(P, lds, wv); } return; }
    const int layer = (ph - 1) / 5, sub = (ph - 1) % 5, j = layer >> 1;
    const bool even = (layer & 1) == 0;
    if (sub == 0) { if (PHMASK & 4) { const Params P = load_params(lds); phase_norm(P, lds, layer, wv); } return; }
    if (sub == 1) {
        const Params P = load_params(lds); bf16_t* pbuf = (bf16_t*)(P.ws + WS_P);
        const int N = even ? EVEN_IN : ODD_IN;
        pg8::Gemm gm{(const bf16_t*)(P.ws + WS_OV), (const bf16_t*)(P.ws + WS_WIN), MROWS, N, 1024, 1024};
        pg8::StaticOrder S; S.init(MROWS, N, (int)gridDim.x, get_bid());
        EpiStoreBf16 E{pbuf, N};
        if (even) S.limit = 1280;
        if (PHMASK & 8) pg8::gemm_phase<EpiStoreBf16, pg8::StaticOrder, true, true>(lds, gm, S, E, wv);
        if (even) {
            for (int t = get_bid(); t < 128; t += gridDim.x) {
                pg8::Unit u; S.tile_of(1280 + (t >> 3), u);
                const int m0 = 256 * u.pm + 64 * ((t & 7) >> 1), n0 = 256 * u.pn + 128 * (t & 1);
                auto epi = [&](const f32x16& acc, int row0, int col, int hh) {
#pragma unroll
                    for (int i = 0; i < 16; ++i) pbuf[(size_t)(m0 + row0 + crow(i, hh)) * N + n0 + col] = (bf16_t)f2bf(acc[i]);
                };
                mini_gemm_tile(lds, (const bf16_t*)(P.ws + WS_OV) + (size_t)m0 * 1024, 1024, (const bf16_t*)(P.ws + WS_WIN) + (size_t)n0 * 1024, 1024, epi, wv);
            }
        }
        return;
    }
    if (sub == 2) {
        const Params P = load_params(lds);
        if (even) {
            constexpr int NRG = NB * NCHUNK * 8;
#if defined(SPLIT_ATTN)
            for (int it = get_bid(); it < NRG; it += gridDim.x) rglru_item(P, lds, j, it, wv);
#else
            for (int it = get_bid(); it < NRG + 576; it += gridDim.x) {
                if (it < NRG) { if (PHMASK & 32) rglru_item(P, lds, j, it, wv); } else { if (PHMASK & 16) attn_item(P, lds, j, it - NRG, wv); }
            }
#endif
        } else {
            for (int it = get_bid(); it < 256; it += gridDim.x) { if (PHMASK & 64) { if (it & 2) gla2_item<1>(P, lds, j, it >> 5, (it >> 2) & 7, it & 1, wv); else gla2_item<0>(P, lds, j, it >> 5, (it >> 2) & 7, it & 1, wv); } }
        }
        return;
    }
    if (sub == 3) {
        const Params P = load_params(lds);
        if (!even) { if (PHMASK & 256) phase_readout(P, j, wv); }
#if defined(SPLIT_ATTN)
        else { for (int it = get_bid(); it < 576; it += gridDim.x) attn_item(P, lds, j, it, wv); }
#endif
        return;
    }
    {
        const Params P = load_params(lds); bf16_t* pbuf = (bf16_t*)(P.ws + WS_P);
        const int K = even ? 2048 : 1024, lda = even ? EVEN_IN : ODD_IN;
        pg8::Gemm gm{pbuf + (even ? 1536 : 4096), (const bf16_t*)(P.ws + WS_WOUT), MROWS, 1024, K, lda};
        pg8::StaticOrder S; S.init(NB * SEQ, 1024, (int)gridDim.x, get_bid(), 1);
        const float* hl = layer == 0 ? P.x : P.out; const float* hc = layer == 0 ? P.ctx : (const float*)(P.ws + WS_HCTX);
        const float* modb = (const float*)(P.ws + WS_MOD);
        EpiResidNorm E{hl, P.out, modb + (size_t)layer * 9 * 3072 + 2048, layer < 3 ? P.norm_w + (layer + 1) * 1024 : P.final_norm_w,
                       layer < 3 ? modb + (size_t)(layer + 1) * 9 * 3072 : nullptr, (bf16_t*)(P.ws + WS_OV), (float*)(P.ws + WS_AGG), (unsigned*)(P.ws + WS_CTL) + 12288 + layer * 1024};
        if (PHMASK & 512) pg8::gemm_phase<EpiResidNorm, pg8::StaticOrder, false, true>(lds, gm, S, E, wv);
        if (layer < 3) {
            for (int t = get_bid(); t < 256; t += gridDim.x) {
                const int mt = t >> 3, nt = t & 7, mc0 = 64 * mt, bctx = mc0 >> 8, n0 = 128 * nt;
                const bf16_t* At = pbuf + ((size_t)bctx * LT + (mc0 & 255)) * lda + (even ? 1536 : 4096);
                const float* gctx = (const float*)(P.ws + WS_MOD) + (size_t)layer * 9 * 3072 + 2048 + 8 * 3072;
                float* hco = (float*)(P.ws + WS_HCTX);
                auto epi = [&](const f32x16& acc, int row0, int col, int hh) {
                    const float gate = gctx[n0 + col];
#pragma unroll
                    for (int i = 0; i < 16; ++i) { const size_t off = (size_t)(mc0 + row0 + crow(i, hh)) * DM + n0 + col; hco[off] = hc[off] + gate * acc[i]; }
                };
                mini_gemm_tile(lds, At, lda, (const bf16_t*)(P.ws + WS_WOUT) + (size_t)n0 * K, K, epi, wv);
            }
        }
    }
}

__global__ void __launch_bounds__(512, 2) mega(Params P) {
    extern __shared__ __attribute__((aligned(16))) unsigned char lds_raw[];
    LAS unsigned char* lds = (LAS unsigned char*)lds_raw;
    cg::grid_group grid = cg::this_grid();
    const int wv = __builtin_amdgcn_readfirstlane((int)(threadIdx.x >> 6));
    if (get_tid(wv) == 0) {
#if defined(TP_ID)
        ((LAS unsigned long long*)(lds + 163840 - 32))[0] = 0ull; ((LAS unsigned long long*)(lds + 163840 - 32))[1] = 0ull;
#endif
        ((LAS unsigned*)(lds + PARAM_OFF + 208))[0] = 0u; ((LAS unsigned*)(lds + PARAM_OFF + 208))[1] = 0u;
        LAS unsigned long long* d = (LAS unsigned long long*)(lds + PARAM_OFF);
        d[0] = (unsigned long long)P.x; d[1] = (unsigned long long)P.c; d[2] = (unsigned long long)P.ctx; d[3] = (unsigned long long)P.c_ctx; d[4] = (unsigned long long)P.ada_w;
        d[5] = (unsigned long long)P.ada_b; d[6] = (unsigned long long)P.norm_w; d[7] = (unsigned long long)P.ev_w_in; d[8] = (unsigned long long)P.ev_conv_w; d[9] = (unsigned long long)P.ev_conv_b;
        d[10] = (unsigned long long)P.ev_rg_wx; d[11] = (unsigned long long)P.ev_rg_bx; d[12] = (unsigned long long)P.ev_rg_wa; d[13] = (unsigned long long)P.ev_rg_ba; d[14] = (unsigned long long)P.ev_rg_lambda;
        d[15] = (unsigned long long)P.ev_sink; d[16] = (unsigned long long)P.ev_w_out; d[17] = (unsigned long long)P.od_w_in; d[18] = (unsigned long long)P.od_lb_raw; d[19] = (unsigned long long)P.od_gnorm_w;
        d[20] = (unsigned long long)P.od_w_out; d[21] = (unsigned long long)P.final_norm_w; d[22] = (unsigned long long)P.out; d[23] = (unsigned long long)P.ws;
    }
    __syncthreads();
    const int ph_lo = P.ph_lo, ph_hi = P.ph_hi;
    (void)xcd_barrier_post((unsigned*)(P.ws + WS_CTL) + 4096, (volatile LAS unsigned*)(lds + PARAM_OFF + 208), wv);
#define GRID_SYNC(first) do { if (first) grid.sync(); else { XcdBarrier xb_; xb_.bar = (unsigned*)(load_params(lds).ws + WS_CTL) + 4096; xb_.x = xb_xcc_id(); xb_.st = (volatile LAS unsigned*)(lds + PARAM_OFF + 208); xcd_barrier(xb_, wv); } } while (0)
#if defined(PROBE_S)
    constexpr int PREP = PROBE_E - PROBE_S + 1;
#pragma unroll 1
    for (int seq = ph_lo; seq < ph_hi + PREP; ++seq) {
        if (seq > ph_lo) GRID_SYNC(seq == ph_lo + 1);
        const int ph = seq <= PROBE_E ? seq : seq - PREP;
        run_phase(lds, ph, wv);
    }
#else
#pragma unroll 1
    for (int ph = ph_lo; ph < ph_hi; ++ph) {
#if !defined(SPLIT_ATTN)
        if (ph >= 1 && ph < NPHASE - 1 && (ph - 1) % 5 == 3 && (((ph - 1) / 5) & 1) == 0) continue;
#endif
        TP_START(200, lds, get_tid(wv));
        if (ph > ph_lo) GRID_SYNC(ph == ph_lo + 1);
        TP_STOP(200, lds, get_tid(wv));
#if defined(TP_ID)
        const int kid_ = ph == 0 ? 207 : ((ph - 1) % 5 == 0 ? 205 : ((ph - 1) % 5 == 1 ? 201 : ((ph - 1) % 5 == 2 ? ((((ph - 1) / 5) & 1) ? 203 : 202) : ((ph - 1) % 5 == 3 ? 206 : 204))));
        if (kid_ == TP_ID) TP_START(TP_ID, lds, get_tid(wv));
#endif
        run_phase(lds, ph, wv);
#if defined(TP_ID)
        if (kid_ == TP_ID) TP_STOP(TP_ID, lds, get_tid(wv));
#endif
    }
#endif
#if defined(TP_ID)
    if (get_tid(wv) == 0 && blockIdx.x == TP_BLOCK) {
        const unsigned long long acc = ((LAS unsigned long long*)(lds + 163840 - 32))[1], t0 = __builtin_amdgcn_s_memrealtime();
        while (__builtin_amdgcn_s_memrealtime() - t0 < (unsigned long long)TP_AMP * acc) __builtin_amdgcn_s_sleep(8);
    }
#endif
}

extern "C" void kernel_launch(void* const* d_in, const int* in_sizes, int n_in, void* d_out, int out_size, void* d_ws, size_t ws_size, hipStream_t stream) {
    static int grid = 0;
    if (grid == 0) {
        if (n_in != 22 || ws_size < WS_END) { fprintf(stderr, "kernel_launch: unexpected inputs (n_in %d, ws %zu)\n", n_in, ws_size); grid = -1; return; }
        int dev = 0, cus = 0, per_cu = 0;
        hipGetDevice(&dev);
        hipDeviceGetAttribute(&cus, hipDeviceAttributeMultiprocessorCount, dev);
        if (hipFuncSetAttribute((const void*)mega, hipFuncAttributeMaxDynamicSharedMemorySize, LDS_BYTES) != hipSuccess) { fprintf(stderr, "kernel_launch: hipFuncSetAttribute failed\n"); grid = -1; return; }
        if (hipOccupancyMaxActiveBlocksPerMultiprocessor(&per_cu, (const void*)mega, 512, LDS_BYTES) != hipSuccess || per_cu < 1) { fprintf(stderr, "kernel_launch: occupancy query gives %d\n", per_cu); per_cu = 1; }
        (void)hipGetLastError();
        grid = cus;
    }
    if (grid < 0) return;
    if (hipMemsetAsync((char*)d_ws + WS_CTL, 0, 65536, stream) != hipSuccess) { fprintf(stderr, "kernel_launch: memset failed\n"); return; }
    Params P{};
    const float** pp = (const float**)&P;
    for (int i = 0; i < 22; ++i) pp[i] = (const float*)d_in[i];
    P.out = (float*)d_out; P.ws = (unsigned char*)d_ws;
#if ONE_LAUNCH
    P.ph_lo = 0; P.ph_hi = NPHASE;
    { void* args[] = {&P}; hipError_t e = hipLaunchCooperativeKernel((const void*)mega, dim3(grid), dim3(512), args, LDS_BYTES, stream);
      if (e != hipSuccess) fprintf(stderr, "cooperative launch failed: %s (grid %d)\n", hipGetErrorString(e), grid); }
#else
    for (int ph = 0; ph < NPHASE; ++ph) {
        P.ph_lo = ph; P.ph_hi = ph + 1;
        void* args[] = {&P}; hipError_t e = hipLaunchCooperativeKernel((const void*)mega, dim3(grid), dim3(512), args, LDS_BYTES, stream);
        if (e != hipSuccess) { fprintf(stderr, "launch %d failed: %s (grid %d)\n", ph, hipGetErrorString(e), grid); break; }
    }
#endif
}
```

```cpp
#include <hip/hip_runtime.h>
#include <hip/hip_cooperative_groups.h>
#include <cstdio>
#include <cstdint>
namespace cg = cooperative_groups;

#ifndef ONE_LAUNCH
#define ONE_LAUNCH 1
#endif

#define DI __device__ __forceinline__
#define LAS __attribute__((address_space(3)))
__device__ __forceinline__ int lane_nh() { int l; asm volatile("v_mbcnt_lo_u32_b32 %0, -1, 0\n\tv_mbcnt_hi_u32_b32 %0, -1, %0" : "=v"(l)); return l; }
__device__ __forceinline__ int get_tid(int wv) { asm volatile("" : "+s"(wv)); return wv * 64 + lane_nh(); }
__device__ __forceinline__ float shfl_xor_f(float v, int o) { return __int_as_float(__builtin_amdgcn_ds_bpermute((lane_nh() ^ o) << 2, __float_as_int(v))); }
__device__ __forceinline__ int get_bid() { int b = blockIdx.x; asm volatile("" : "+s"(b)); return b; }

#if defined(TP_ID)
#ifndef TP_BLOCK
#define TP_BLOCK 5
#endif
#ifndef TP_AMP
#define TP_AMP 16
#endif
#define TP_START(id, lds, tid_) do { if ((id) == TP_ID && (tid_) == 0 && blockIdx.x == TP_BLOCK) { ((LAS unsigned long long*)((lds) + 163840 - 32))[0] = __builtin_amdgcn_s_memrealtime(); } } while (0)
#define TP_STOP(id, lds, tid_) do { if ((id) == TP_ID && (tid_) == 0 && blockIdx.x == TP_BLOCK) { LAS unsigned long long* w_ = (LAS unsigned long long*)((lds) + 163840 - 32); w_[1] += __builtin_amdgcn_s_memrealtime() - w_[0]; } } while (0)
#else
#define TP_START(id, lds, tid_) do { } while (0)
#define TP_STOP(id, lds, tid_) do { } while (0)
#endif
namespace pg8 {
#define PG8_LAS __attribute__((address_space(3)))
typedef unsigned short bf16_t;
typedef short bf16x8 __attribute__((ext_vector_type(8)));
typedef float f32x4 __attribute__((ext_vector_type(4)));
typedef unsigned u32x4 __attribute__((ext_vector_type(4)));
constexpr int BM = 256, BK = 64, HALF = 128, HTB = HALF * BK * 2  , STAGE_BYTES = 8 * HTB, NXCD = 8, WGM = 8;

__host__ __device__ __forceinline__ int lds_byte(int r, int c) { const int st = (r >> 4) * 2 + (c >> 5), rr = r & 15, cc = c & 31, ob = rr * 64 + cc * 2; return st * 1024 + (ob ^ (((ob >> 9) & 1) << 5)); }
__host__ __device__ __forceinline__ void stage_rc(int b, int& R, int& C) { const int st = b / 1024, sb = b % 1024, swz = sb ^ (((sb >> 9) & 1) << 5); R = (st >> 1) * 16 + swz / 64; C = (st & 1) * 32 + (swz % 64) / 2; }
__host__ __device__ __forceinline__ int perm32(int rho) { const int n = rho >> 4, i = rho & 15; return 8 * (i >> 2) + 4 * n + (i & 3); }

struct Unit { int pm, pn; };
struct Gemm { const bf16_t* A; const bf16_t* Bt; int M, N, K, lda; };

struct StaticOrder {
    int nM, nN, nwg, G, c, lat_only, limit;
    __host__ __device__ void init(int M, int N, int G_, int c_, int lat_only_ = 0) { nM = M / BM; nN = N / BM; nwg = nM * nN; G = G_; c = c_; lat_only = lat_only_; limit = nwg; }
    __host__ __device__ bool next(int i, Unit& u) const {
        const long L = (long)i * G + c; if (L >= limit) return false;
        tile_of((int)L, u); return true;
    }
    __host__ __device__ void tile_of(int L, Unit& u) const {
        int wgid = L; { const int q = nwg / NXCD, r = nwg % NXCD, xcd = wgid % NXCD, off = wgid / NXCD; wgid = (xcd < r ? xcd * (q + 1) : r * (q + 1) + (xcd - r) * q) + off; }
        const int nig = WGM * nN, gid = wgid / nig, fm = gid * WGM, gsz = (nM - fm) < WGM ? (nM - fm) : WGM;
        u.pm = fm + ((wgid % nig) % gsz); u.pn = (wgid % nig) / gsz; if (lat_only) u.pm = 9 * (u.pm >> 3) + 1 + (u.pm & 7);
    }
    __device__ __forceinline__ void a_ready(const Unit&) const {}
    __device__ __forceinline__ void done(const Unit&) const {}
};

template <class Epi, class Sched, bool ALIGN_EPI = false, bool SP2 = false>
__device__ __forceinline__ void gemm_phase(PG8_LAS unsigned char* lds, const Gemm g, const Sched& S, const Epi& E, int wv) {
    const int tid = get_tid(wv), wid = __builtin_amdgcn_readfirstlane(tid >> 6), lane = tid & 63, wr = wid >> 2, wc = wid & 3, fr = lane & 15, fq = lane >> 4;
    const int K = g.K, nt = K / BK;
    unsigned voffA[2], voffB[2];
#pragma unroll
    for (int i = 0; i < 2; ++i) { int R, C; stage_rc(tid * 16 + i * 8192, R, C); const int Rb = Epi::PERM ? ((R & ~31) + perm32(R & 31)) : R;
        voffA[i] = (unsigned)(R * g.lda + C) * 2u; voffB[i] = (unsigned)(Rb * K + C) * 2u; }
    const size_t kstep = (size_t)(BK * 2);
    const size_t hstepA = (size_t)HALF * g.lda * 2, hstepB = (size_t)HALF * K * 2;
    const size_t tstepA = 2 * hstepA, tstepB = 2 * hstepB;
    const unsigned ldsw = (unsigned)wid * 1024u;
    const int aoff = lds_byte(wr * 64 + fr, fq * 8), boff = lds_byte(wc * 32 + fr, fq * 8);
#define PG8_SA(b, h) (((b) * 2 + (h)) * HTB)
#define PG8_SB(b, h) ((4 + (b) * 2 + (h)) * HTB)
#define PG8_STAGE(bufoff, gbase, voff) do { _Pragma("unroll") for (int _i = 0; _i < 2; ++_i) \
        __builtin_amdgcn_global_load_lds((const unsigned*)((const char*)(gbase) + (voff)[_i]), (PG8_LAS unsigned*)(lds + (bufoff) + ldsw + _i * 8192), 16, 0, 0); } while (0)
#define PG8_LDA(dst, b, h) do { _Pragma("unroll") for (int m = 0; m < 4; ++m) _Pragma("unroll") for (int k = 0; k < 2; ++k) dst[m][k] = *(const PG8_LAS bf16x8*)(lds + PG8_SA(b, h) + aoff + m * 2048 + k * 1024); } while (0)
#define PG8_LDB(dst, b, h) do { _Pragma("unroll") for (int n = 0; n < 2; ++n) _Pragma("unroll") for (int k = 0; k < 2; ++k) dst[n][k] = *(const PG8_LAS bf16x8*)(lds + PG8_SB(b, h) + boff + n * 2048 + k * 1024); } while (0)
#define PG8_MMA(ai, bj, At, Bt) do { __builtin_amdgcn_s_setprio(1); _Pragma("unroll") for (int m = 0; m < 4; ++m) _Pragma("unroll") for (int n = 0; n < 2; ++n) _Pragma("unroll") for (int k = 0; k < 2; ++k) \
        acc[ai][bj][m][n] = __builtin_amdgcn_mfma_f32_16x16x32_bf16(Bt[n][k], At[m][k], acc[ai][bj][m][n], 0, 0, 0); __builtin_amdgcn_s_setprio(0); } while (0)
#define PG8_WAIT_V(n) asm volatile("s_waitcnt vmcnt(" #n ")" ::: "memory")
#define PG8_WAIT_L(n) asm volatile("s_waitcnt lgkmcnt(" #n ")" ::: "memory")
#define PG8_BAR __builtin_amdgcn_s_barrier()
#define PG8_SCHED __builtin_amdgcn_sched_barrier(0)
    Unit cur, nxt; int ui = 0;
    if (!S.next(0, cur)) return;
    f32x4 acc[2][2][4][2];
#pragma unroll
    for (int a = 0; a < 2; ++a)
#pragma unroll
        for (int b = 0; b < 2; ++b)
#pragma unroll
            for (int m = 0; m < 4; ++m)
#pragma unroll
                for (int n = 0; n < 2; ++n) acc[a][b][m][n] = (f32x4){0.f, 0.f, 0.f, 0.f};
    bf16x8 At[4][2], B0[2][2], B1[2][2];
    const char* cA = (const char*)g.A + (size_t)cur.pm * tstepA; const char* cB = (const char*)g.Bt + (size_t)cur.pn * tstepB;
    S.a_ready(cur);
    if constexpr (SP2) {
        PG8_STAGE(PG8_SB(0, 0), cB, voffB); PG8_STAGE(PG8_SB(0, 1), cB + hstepB, voffB); PG8_STAGE(PG8_SA(0, 0), cA, voffA); PG8_STAGE(PG8_SA(0, 1), cA + hstepA, voffA);
        if (wr == 1) PG8_BAR;
        PG8_WAIT_V(2); PG8_BAR;
        PG8_STAGE(PG8_SB(1, 0), cB + kstep, voffB); PG8_STAGE(PG8_SA(1, 0), cA + kstep, voffA); PG8_STAGE(PG8_SB(1, 1), cB + hstepB + kstep, voffB);
        PG8_WAIT_V(6); PG8_BAR;
    } else {
        PG8_STAGE(PG8_SB(0, 0), cB, voffB); PG8_STAGE(PG8_SA(0, 0), cA, voffA); PG8_STAGE(PG8_SB(0, 1), cB + hstepB, voffB); PG8_STAGE(PG8_SA(0, 1), cA + hstepA, voffA);
        if (wr == 1) PG8_BAR;
        PG8_WAIT_V(4); PG8_BAR;
        PG8_STAGE(PG8_SB(1, 0), cB + kstep, voffB); PG8_STAGE(PG8_SA(1, 0), cA + kstep, voffA); PG8_STAGE(PG8_SB(1, 1), cB + hstepB + kstep, voffB);
        PG8_WAIT_V(6); PG8_BAR;
    }
    for (;;) {
        const bool has_next = S.next(ui + 1, nxt);
        const char* nA = has_next ? (const char*)g.A + (size_t)nxt.pm * tstepA : cA; const char* nB = has_next ? (const char*)g.Bt + (size_t)nxt.pn * tstepB : cB;
        for (int t = 0; t < nt; t += 2) {
            const bool last = (t == nt - 2);
            const char* a1 = cA + (size_t)(t + 1) * kstep;
            const char* a2 = last ? nA : cA + (size_t)(t + 2) * kstep; const char* b2 = last ? nB : cB + (size_t)(t + 2) * kstep;
            const char* a3 = a2 + kstep; const char* b3 = b2 + kstep;
            if (last && has_next) S.a_ready(nxt);
            if constexpr (SP2) {
            PG8_LDB(B0, 0, 0); PG8_LDB(B1, 0, 1); PG8_SCHED; PG8_LDA(At, 0, 0); PG8_STAGE(PG8_SA(1, 1), a1 + hstepA, voffA);
            PG8_WAIT_V(8); PG8_WAIT_L(0); PG8_BAR; PG8_MMA(0, 0, At, B0); PG8_MMA(0, 1, At, B1); PG8_BAR; PG8_SCHED;
            PG8_LDA(At, 0, 1); PG8_STAGE(PG8_SB(0, 0), b2, voffB); PG8_STAGE(PG8_SB(0, 1), b2 + hstepB, voffB); PG8_STAGE(PG8_SA(0, 0), a2, voffA);
            PG8_WAIT_V(8); PG8_WAIT_L(0); PG8_BAR; PG8_MMA(1, 0, At, B0); PG8_MMA(1, 1, At, B1); PG8_BAR; PG8_SCHED;
            PG8_LDB(B0, 1, 0); PG8_LDB(B1, 1, 1); PG8_SCHED; PG8_LDA(At, 1, 0); PG8_STAGE(PG8_SA(0, 1), a2 + hstepA, voffA);
            PG8_WAIT_V(8); PG8_WAIT_L(0); PG8_BAR; PG8_MMA(0, 0, At, B0); PG8_MMA(0, 1, At, B1); PG8_BAR; PG8_SCHED;
            PG8_LDA(At, 1, 1); PG8_STAGE(PG8_SB(1, 0), b3, voffB); PG8_STAGE(PG8_SB(1, 1), b3 + hstepB, voffB); PG8_STAGE(PG8_SA(1, 0), a3, voffA);
            PG8_WAIT_V(8); PG8_WAIT_L(0); PG8_BAR; PG8_MMA(1, 0, At, B0); PG8_MMA(1, 1, At, B1); PG8_BAR; PG8_SCHED;
            } else {
            PG8_LDB(B0, 0, 0); PG8_SCHED; PG8_LDA(At, 0, 0); PG8_STAGE(PG8_SA(1, 1), a1 + hstepA, voffA);
            PG8_WAIT_L(8); PG8_BAR; PG8_WAIT_L(0); PG8_MMA(0, 0, At, B0); PG8_BAR; PG8_SCHED;
            PG8_LDB(B1, 0, 1); PG8_STAGE(PG8_SB(0, 0), b2, voffB);
            PG8_BAR; PG8_WAIT_L(0); PG8_MMA(0, 1, At, B1); PG8_BAR;
            PG8_LDA(At, 0, 1); PG8_STAGE(PG8_SA(0, 0), a2, voffA);
            PG8_BAR; PG8_WAIT_L(0); PG8_MMA(1, 0, At, B0); PG8_BAR; PG8_SCHED;
            PG8_STAGE(PG8_SB(0, 1), b2 + hstepB, voffB);
            PG8_WAIT_V(6); PG8_BAR; PG8_MMA(1, 1, At, B1); PG8_BAR;
            PG8_LDB(B0, 1, 0); PG8_SCHED; PG8_LDA(At, 1, 0); PG8_STAGE(PG8_SA(0, 1), a2 + hstepA, voffA);
            PG8_WAIT_L(8); PG8_BAR; PG8_WAIT_L(0); PG8_MMA(0, 0, At, B0); PG8_BAR; PG8_SCHED;
            PG8_LDB(B1, 1, 1); PG8_STAGE(PG8_SB(1, 0), b3, voffB);
            PG8_BAR; PG8_WAIT_L(0); PG8_MMA(0, 1, At, B1); PG8_BAR;
            PG8_LDA(At, 1, 1); PG8_STAGE(PG8_SA(1, 0), a3, voffA);
            PG8_BAR; PG8_WAIT_L(0); PG8_MMA(1, 0, At, B0); PG8_BAR; PG8_SCHED;
            PG8_STAGE(PG8_SB(1, 1), b3 + hstepB, voffB);
            PG8_WAIT_V(6); PG8_BAR; PG8_MMA(1, 1, At, B1); PG8_BAR;
            }
        }
        if constexpr (ALIGN_EPI) { if (wr == 0) PG8_BAR; }
        if constexpr (!Epi::AFTER_DRAIN) { E(acc, cur, wr, wc, fr, fq); S.done(cur); }
        if (!has_next) break;
#pragma unroll
        for (int a = 0; a < 2; ++a)
#pragma unroll
            for (int b = 0; b < 2; ++b)
#pragma unroll
                for (int m = 0; m < 4; ++m)
#pragma unroll
                    for (int n = 0; n < 2; ++n) acc[a][b][m][n] = (f32x4){0.f, 0.f, 0.f, 0.f};
        cur = nxt; cA = nA; cB = nB; ++ui;
        if constexpr (ALIGN_EPI) { if (wr == 1) PG8_BAR; }
    }
    PG8_WAIT_V(0);
    if constexpr (!ALIGN_EPI) { if (wr == 0) PG8_BAR; }
    PG8_BAR;
    if constexpr (Epi::AFTER_DRAIN) { E.fused(acc, cur, wr, wc, fr, fq, lds, wid, lane); S.done(cur); }
#undef PG8_SA
#undef PG8_SB
#undef PG8_STAGE
#undef PG8_LDA
#undef PG8_LDB
#undef PG8_MMA
#undef PG8_WAIT_V
#undef PG8_WAIT_L
#undef PG8_BAR
#undef PG8_SCHED
}
}

typedef unsigned short bf16_t;
typedef short bf16x8 __attribute__((ext_vector_type(8)));
typedef short s16x4 __attribute__((ext_vector_type(4)));
typedef float f32x4 __attribute__((ext_vector_type(4)));
typedef float f32x16 __attribute__((ext_vector_type(16)));
typedef unsigned u32x4 __attribute__((ext_vector_type(4)));
typedef unsigned u32x2 __attribute__((ext_vector_type(2)));
typedef float f32x2 __attribute__((ext_vector_type(2)));

constexpr int DM = 1024, NB = 8, SEQ = 2048, CTXL = 256, LT = SEQ + CTXL  , MROWS = NB * LT  ;
constexpr int EVEN_IN = 4608, ODD_IN = 5120, NCHUNK = LT / 64  ;
constexpr float RMS_EPS = 1e-6f, LOG2E = 1.4426950408889634f;
constexpr int LDS_BYTES = 160 * 1024;
constexpr int NPHASE = 21;

constexpr size_t WS_CTL = 0;
constexpr size_t WS_MOD = 65536;
constexpr size_t WS_ROPE = 524288;
constexpr size_t WS_AGG = 1048576;
constexpr size_t WS_HCTX = WS_AGG + 4718592;
constexpr size_t WS_WIN = WS_HCTX + 8388608;
constexpr size_t WS_WOUT = WS_WIN + 10485760;
constexpr size_t WS_WRG = WS_WOUT + 4194304;
constexpr size_t WS_OV = WS_WRG + 1048576;
constexpr size_t WS_P = WS_OV + 37748736;
constexpr size_t WS_END = WS_P + 188743680;
static_assert(WS_END <= 268435456, "workspace map exceeds 256 MiB");

struct Params {
    const float *x, *c, *ctx, *c_ctx, *ada_w, *ada_b, *norm_w, *ev_w_in, *ev_conv_w, *ev_conv_b, *ev_rg_wx, *ev_rg_bx, *ev_rg_wa, *ev_rg_ba,
        *ev_rg_lambda, *ev_sink, *ev_w_out, *od_w_in, *od_lb_raw, *od_gnorm_w, *od_w_out, *final_norm_w;
    float* out; unsigned char* ws; int ph_lo, ph_hi;
};

DI float bf2f(unsigned short v) { return __uint_as_float((unsigned)v << 16); }
DI unsigned f2bf(float f) { unsigned u = __float_as_uint(f); return (u + 0x7fffu + ((u >> 16) & 1u)) >> 16; }
typedef __bf16 bf16x2_hw __attribute__((ext_vector_type(2)));
DI unsigned pk2(float lo, float hi) { const f32x2 v = {lo, hi}; return __builtin_bit_cast(unsigned, __builtin_convertvector(v, bf16x2_hw)); }
DI float sigm(float x) { return __builtin_amdgcn_rcpf(1.f + __expf(-x)); }
DI float softplus_neg(float lam) {
    const float e = __expf(-lam);
    return e < 0.06f ? e * (1.f + e * (-0.5f + e * (0.33333333f + e * (-0.25f + e * 0.2f)))) : __logf(1.f + e);
}
DI float neg_expm1(float x) {
    return x > -0.25f ? -x * (1.f + x * (0.5f + x * (0.16666667f + x * (0.041666668f + x * (0.0083333338f + x * 0.0013888889f))))) : 1.f - __expf(x);
}
DI float wave_sum(float v) {
#pragma unroll
    for (int o = 1; o < 64; o <<= 1) v += shfl_xor_f(v, o);
    return v;
}
DI int crow(int reg, int h) { return (reg & 3) + 8 * (reg >> 2) + 4 * h; }
#define MFMA16(a, b, c) __builtin_amdgcn_mfma_f32_16x16x32_bf16((a), (b), (c), 0, 0, 0)
#define MFMA32(a, b, c) __builtin_amdgcn_mfma_f32_32x32x16_bf16((a), (b), (c), 0, 0, 0)

struct EpiStoreBf16 {
    static constexpr bool PERM = true, AFTER_DRAIN = false;
    bf16_t* O; int ldc;
    DI void operator()(const f32x4 (&acc)[2][2][4][2], const pg8::Unit& u, int wr, int wc, int fr, int fq) const {
        const int row0 = u.pm * 256 + wr * 64 + fr, col0 = u.pn * 256 + wc * 32 + 8 * fq;
#pragma unroll
        for (int ai = 0; ai < 2; ++ai)
#pragma unroll
            for (int m = 0; m < 4; ++m) { bf16_t* rowp = O + (size_t)(row0 + ai * 128 + m * 16) * ldc + col0;
#pragma unroll
                for (int bj = 0; bj < 2; ++bj) { const f32x4 v0 = acc[ai][bj][m][0], v1 = acc[ai][bj][m][1];
                    u32x4 w; w.x = pk2(v0[0], v0[1]); w.y = pk2(v0[2], v0[3]); w.z = pk2(v1[0], v1[1]); w.w = pk2(v1[2], v1[3]);
                    *(u32x4*)(rowp + bj * 128) = w; } }
    }
};
struct EpiResid {
    static constexpr bool PERM = false, AFTER_DRAIN = false;
    const float* in_lat; const float* in_ctx; float* out_lat; float* out_ctx; const float* gate;
    DI void operator()(const f32x4 (&acc)[2][2][4][2], const pg8::Unit& u, int wr, int wc, int fr, int fq) const {
        const int b = u.pm / 9, jt = u.pm % 9;
        const float* ib; float* ob; const float* g;
        if (jt == 0) { const size_t off = (size_t)b * CTXL * DM; ib = in_ctx + off; ob = out_ctx + off; g = gate + 8 * 3072; }
        else { const size_t off = ((size_t)b * SEQ + (size_t)(jt - 1) * 256) * DM; ib = in_lat + off; ob = out_lat + off; g = gate + b * 3072; }
        const int col0 = u.pn * 256 + wc * 32 + 4 * fq;
#pragma unroll
        for (int bj = 0; bj < 2; ++bj)
#pragma unroll
            for (int n = 0; n < 2; ++n) {
                const f32x4 gvv = *(const f32x4*)(g + col0 + bj * 128 + n * 16);
#pragma unroll
                for (int ai = 0; ai < 2; ++ai) {
#pragma unroll
                    for (int m = 0; m < 4; ++m) { const int r = ai * 128 + wr * 64 + m * 16 + fr;
                        const size_t off = (size_t)r * DM + col0 + bj * 128 + n * 16;
                        const f32x4 o = *(const f32x4*)(ib + off) + gvv * acc[ai][bj][m][n]; *(f32x4*)(ob + off) = o; }
                    asm volatile("" ::: "memory");
                }
            }
    }
};

struct EpiResidNorm {
    static constexpr bool PERM = false, AFTER_DRAIN = true;
    const float* in_lat; float* out_lat; const float* gate;
    const float* nw; const float* mod_next;
    bf16_t* U; float* xbuf; unsigned* cnt;
    DI void fused(f32x4 (&acc)[2][2][4][2], const pg8::Unit& u, int wr, int wc, int fr, int fq, LAS unsigned char* lds, int wid, int lane) const {
        const int b = u.pm / 9, jt = u.pm % 9, panel = b * 8 + jt - 1;
        const size_t roff = ((size_t)b * SEQ + (size_t)(jt - 1) * 256) * DM;
        const float* ib = in_lat + roff; float* ob = out_lat + roff; const float* g = gate + b * 3072;
        const int col0 = u.pn * 256 + wc * 32 + 4 * fq;
        LAS float* Pw = (LAS float*)lds;
        LAS float* Sr = (LAS float*)(lds + 4096);
        LAS unsigned* flag = (LAS unsigned*)(lds + 5120);
#pragma unroll
        for (int bj = 0; bj < 2; ++bj)
#pragma unroll
            for (int n = 0; n < 2; ++n) {
                const f32x4 gvv = *(const f32x4*)(g + col0 + bj * 128 + n * 16);
#pragma unroll
                for (int ai = 0; ai < 2; ++ai) {
#pragma unroll
                    for (int m = 0; m < 4; ++m) { const int r = ai * 128 + wr * 64 + m * 16 + fr;
                        const size_t off = (size_t)r * DM + col0 + bj * 128 + n * 16;
                        const f32x4 o = *(const f32x4*)(ib + off) + gvv * acc[ai][bj][m][n]; acc[ai][bj][m][n] = o;
                        if (mod_next) *(f32x4*)(ob + off) = o; }
                    asm volatile("" ::: "memory");
                }
            }
#pragma unroll
        for (int ai = 0; ai < 2; ++ai)
#pragma unroll
            for (int m = 0; m < 4; ++m) {
                float s = 0.f;
#pragma unroll
                for (int bj = 0; bj < 2; ++bj)
#pragma unroll
                    for (int n = 0; n < 2; ++n) { const f32x4 x = acc[ai][bj][m][n]; s += (x[0] * x[0] + x[1] * x[1]) + (x[2] * x[2] + x[3] * x[3]); }
                s += shfl_xor_f(s, 16); s += shfl_xor_f(s, 32);
                if (fq == 0) Pw[(ai * 128 + wr * 64 + m * 16 + fr) * 4 + wc] = s;
            }
        asm volatile("s_waitcnt lgkmcnt(0)" ::: "memory"); __builtin_amdgcn_s_barrier(); asm volatile("" ::: "memory");
        const int row = wid * 32 + (lane & 31);
        if (lane < 32) {
            const float t = (Pw[row * 4 + 0] + Pw[row * 4 + 1]) + (Pw[row * 4 + 2] + Pw[row * 4 + 3]);
            __hip_atomic_store((unsigned*)xbuf + ((size_t)panel * 256 + row) * 4 + u.pn, __float_as_uint(t), __ATOMIC_RELAXED, __HIP_MEMORY_SCOPE_AGENT);
        }
        asm volatile("s_waitcnt vmcnt(0)" ::: "memory");
        if (lane == 0) __hip_atomic_fetch_add(cnt + 16 * panel, 1u, __ATOMIC_RELAXED, __HIP_MEMORY_SCOPE_AGENT);
        if (wid == 0) {
            unsigned spins = 0;
            while ((unsigned)__builtin_amdgcn_readfirstlane(__hip_atomic_load(cnt + 16 * panel, __ATOMIC_RELAXED, __HIP_MEMORY_SCOPE_AGENT)) < 32u) { __builtin_amdgcn_s_sleep(2); if (++spins > (1u << 22)) break; }
            if (lane == 0) flag[0] = 1u;
        }
        asm volatile("s_waitcnt vmcnt(0) lgkmcnt(0)" ::: "memory"); __builtin_amdgcn_s_barrier(); asm volatile("" ::: "memory");
        if (lane < 32) {
            const unsigned* slot = (const unsigned*)xbuf + ((size_t)panel * 256 + row) * 4;
            const float t = (__uint_as_float(__hip_atomic_load(slot + 0, __ATOMIC_RELAXED, __HIP_MEMORY_SCOPE_AGENT)) + __uint_as_float(__hip_atomic_load(slot + 1, __ATOMIC_RELAXED, __HIP_MEMORY_SCOPE_AGENT)))
                          + (__uint_as_float(__hip_atomic_load(slot + 2, __ATOMIC_RELAXED, __HIP_MEMORY_SCOPE_AGENT)) + __uint_as_float(__hip_atomic_load(slot + 3, __ATOMIC_RELAXED, __HIP_MEMORY_SCOPE_AGENT)));
            Sr[row] = rsqrtf(t * (1.f / DM) + RMS_EPS);
        }
        asm volatile("s_waitcnt lgkmcnt(0)" ::: "memory"); __builtin_amdgcn_s_barrier(); asm volatile("" ::: "memory");
        const float* sh = mod_next ? mod_next + b * 3072 : nullptr;
#pragma unroll
        for (int bj = 0; bj < 2; ++bj)
#pragma unroll
            for (int n = 0; n < 2; ++n) {
                const int cc = col0 + bj * 128 + n * 16;
                const f32x4 w4 = *(const f32x4*)(nw + cc);
                f32x4 s4 = {1.f, 1.f, 1.f, 1.f}, h4 = {0.f, 0.f, 0.f, 0.f};
                if (mod_next) { s4 = *(const f32x4*)(sh + 1024 + cc) + 1.f; h4 = *(const f32x4*)(sh + cc); }
#pragma unroll
                for (int ai = 0; ai < 2; ++ai)
#pragma unroll
                    for (int m = 0; m < 4; ++m) { const int r = ai * 128 + wr * 64 + m * 16 + fr;
                        const f32x4 y = (acc[ai][bj][m][n] * Sr[r]) * w4;
                        if (mod_next) { const f32x4 o = y * s4 + h4; u32x2 w; w.x = pk2(o[0], o[1]); w.y = pk2(o[2], o[3]); *(u32x2*)(U + ((size_t)u.pm * 256 + r) * DM + cc) = w; }
                        else *(f32x4*)(ob + (size_t)r * DM + cc) = y; }
            }
    }
};

constexpr int MG_STAGE = 52224;
template <class EpiF>
DI void mini_gemm_tile(LAS unsigned char* lds, const bf16_t* A, int lda, const bf16_t* Bt, int K, const EpiF& epi, int wv) {
    const int tid = get_tid(wv), lane = tid & 63, wave = tid >> 6, r = lane & 31, h = lane >> 5, wm = wave >> 2, wn = wave & 3;
    const int lrow = tid >> 4, lch = tid & 15, nS = K / 128;
    const bf16_t* ap = A + (size_t)lrow * lda + 8 * lch;
    const bf16_t* bp = Bt + (size_t)lrow * K + 8 * lch;
    u32x4 s0[6], s1[6];
    f32x16 acc;
#pragma unroll
    for (int i = 0; i < 16; ++i) acc[i] = 0.f;
#define MG_LOAD(set, s) do { (set)[0] = *(const u32x4*)(ap + (s) * 128); (set)[1] = *(const u32x4*)(ap + (size_t)32 * lda + (s) * 128); \
        _Pragma("unroll") for (int q_ = 0; q_ < 4; ++q_) (set)[2 + q_] = *(const u32x4*)(bp + (size_t)(32 * q_) * K + (s) * 128); } while (0)
#define MG_STORE(set, buf) do { LAS unsigned char* b_ = lds + (buf) * MG_STAGE; *(LAS u32x4*)(b_ + lrow * 272 + lch * 16) = (set)[0]; *(LAS u32x4*)(b_ + (32 + lrow) * 272 + lch * 16) = (set)[1]; \
        _Pragma("unroll") for (int q_ = 0; q_ < 4; ++q_) *(LAS u32x4*)(b_ + 17408 + (32 * q_ + lrow) * 272 + lch * 16) = (set)[2 + q_]; } while (0)
#define MG_COMPUTE(buf) do { const LAS unsigned char* b_ = lds + (buf) * MG_STAGE; \
        _Pragma("unroll") for (int ks = 0; ks < 8; ++ks) { \
            const bf16x8 af = *(const LAS bf16x8*)(b_ + (32 * wm + r) * 272 + (16 * ks + 8 * h) * 2); \
            const bf16x8 bf = *(const LAS bf16x8*)(b_ + 17408 + (32 * wn + r) * 272 + (16 * ks + 8 * h) * 2); \
            acc = MFMA32(af, bf, acc); } } while (0)
    MG_LOAD(s0, 0); MG_LOAD(s1, 1);
    __syncthreads();
    MG_STORE(s0, 0);
    if (nS > 2) MG_LOAD(s0, 2);
#pragma unroll 1
    for (int s = 0; s < nS; s += 2) {
        __syncthreads();
        if (s + 1 < nS) { MG_STORE(s1, 1); if (s + 3 < nS) MG_LOAD(s1, s + 3); }
        MG_COMPUTE(0);
        __syncthreads();
        if (s + 2 < nS) { MG_STORE(s0, 0); if (s + 4 < nS) MG_LOAD(s0, s + 4); }
        if (s + 1 < nS) MG_COMPUTE(1);
    }
#undef MG_LOAD
#undef MG_STORE
#undef MG_COMPUTE
    epi(acc, 32 * wm, 32 * wn + r, h);
    __syncthreads();
}

DI void phase_pro(const Params& P, LAS unsigned char* lds, int wv) {
    const int tid = get_tid(wv);
    LAS float* s = (LAS float*)lds;
    LAS float* red = (LAS float*)(lds + 36864);
    float* mod = (float*)(P.ws + WS_MOD);
    for (int i = tid; i < 9 * 1024; i += 512) { const int r = i >> 10, k = i & 1023; const float v = r < 8 ? P.c[r * 1024 + k] : P.c_ctx[k]; s[i] = v * sigm(v); }
    __syncthreads();
    {
        const int ks = tid >> 4, col = tid & 15;
        float wv[3][32];
#pragma unroll
        for (int q = 0; q < 3; ++q) {
            const int item = get_bid() + q * (int)gridDim.x;
            if (item < 768) {
                const int l = item / 192, n0 = (item % 192) * 16;
                const float* w = P.ada_w + (size_t)l * 1024 * 3072 + (size_t)(ks * 32) * 3072 + n0 + col;
#pragma unroll
                for (int kk = 0; kk < 32; ++kk) wv[q][kk] = w[(size_t)kk * 3072];
            }
        }
#pragma unroll
        for (int q = 0; q < 3; ++q) {
            const int item = get_bid() + q * (int)gridDim.x;
            if (item < 768) {
                const int l = item / 192, n0 = (item % 192) * 16;
                float acc[9];
#pragma unroll
                for (int r = 0; r < 9; ++r) acc[r] = 0.f;
#pragma unroll
                for (int kk = 0; kk < 32; ++kk) {
#pragma unroll
                    for (int r = 0; r < 9; ++r) acc[r] += s[r * 1024 + ks * 32 + kk] * wv[q][kk]; }
#pragma unroll
                for (int r = 0; r < 9; ++r) red[(ks * 9 + r) * 16 + col] = acc[r];
                __syncthreads();
                if (tid < 144) { const int r = tid >> 4, cc = tid & 15; float sum = 0.f;
#pragma unroll
                    for (int k2 = 0; k2 < 32; ++k2) sum += red[(k2 * 9 + r) * 16 + cc];
                    mod[(l * 9 + r) * 3072 + n0 + cc] = sum + P.ada_b[l * 3072 + n0 + cc]; }
                __syncthreads();
            }
        }
    }
    float* cos_t = (float*)(P.ws + WS_ROPE); float* sin_t = cos_t + SEQ * 32;
    for (int i = get_bid() * 512 + tid; i < SEQ * 32; i += gridDim.x * 512) {
        const int pos = i >> 5, jj = i & 31, fi = jj & 15;
        const float inv = __builtin_amdgcn_exp2f(-(float)(2 * fi) * (13.287712379549449f / 32.f));
        const float ang = (float)(jj < 16 ? (pos >> 6) : (pos & 63)) * inv;
        cos_t[i] = __cosf(ang); sin_t[i] = __sinf(ang);
    }
}

template <bool FRAG = false>
DI void transpose_item(const float* W, int K, int N, bf16_t* WT, LAS float* scr, int item, int lane) {
    const int nblk = N / 32, kb = item / nblk, nb = item % nblk, k0 = 64 * kb, n0 = 32 * nb;
#pragma unroll 8
    for (int i = 0; i < 32; ++i) { const int kk = 2 * i + (lane >> 5); scr[kk * 33 + (lane & 31)] = W[(size_t)(k0 + kk) * N + n0 + (lane & 31)]; }
    asm volatile("s_waitcnt lgkmcnt(0)" ::: "memory");
    const int c = lane & 7;
#pragma unroll
    for (int j = 0; j < 4; ++j) { const int n = (lane >> 3) + 8 * j; const LAS float* sp = scr + (8 * c) * 33 + n;
        u32x4 o; o.x = pk2(sp[0 * 33], sp[1 * 33]); o.y = pk2(sp[2 * 33], sp[3 * 33]); o.z = pk2(sp[4 * 33], sp[5 * 33]); o.w = pk2(sp[6 * 33], sp[7 * 33]);
        if (FRAG) {
            const int nn = n0 + n, k8 = (k0 >> 3) + c;
            *(u32x4*)(WT + ((((nn >> 4) * 4 + (k8 >> 2)) * 64 + (k8 & 3) * 16 + (nn & 15)) * 8)) = o;
        } else *(u32x4*)(WT + (size_t)(n0 + n) * K + k0 + 8 * c) = o; }
    asm volatile("s_waitcnt lgkmcnt(0)" ::: "memory");
}

DI void phase_convert(const Params& P, LAS unsigned char* lds, int layer, int wv) {
    const int tid = get_tid(wv), lane = tid & 63, wave = tid >> 6;
    const int gw = get_bid() * 8 + wave, NGW = gridDim.x * 8;
    const int j = layer >> 1;
    LAS float* scr = (LAS float*)(lds + wave * 16384);
    bf16_t* WIN = (bf16_t*)(P.ws + WS_WIN); bf16_t* WOUT = (bf16_t*)(P.ws + WS_WOUT); bf16_t* WRG = (bf16_t*)(P.ws + WS_WRG);
    if ((layer & 1) == 0) {
        constexpr int I_IN = 16 * (EVEN_IN / 32), I_OUT = 32 * 32, I_RG = 32 * 8;
        for (int it = gw; it < I_IN + I_OUT + I_RG; it += NGW) {
            int r = it;
            if (r < I_IN) { transpose_item(P.ev_w_in + (size_t)j * 1024 * EVEN_IN, 1024, EVEN_IN, WIN, scr, r, lane); continue; } r -= I_IN;
            if (r < I_OUT) { transpose_item(P.ev_w_out + (size_t)j * 2048 * 1024, 2048, 1024, WOUT, scr, r, lane); continue; } r -= I_OUT;
            const int mat = r >> 3, sub = r & 7;
            const int dir = mat >> 4, gate = (mat >> 3) & 1, hd = mat & 7;
            const float* src = (gate == 0 ? P.ev_rg_wx : P.ev_rg_wa) + ((size_t)((j * 2 + dir) * 8 + hd)) * 16384;
            transpose_item<true>(src, 128, 128, WRG + (size_t)mat * 16384, scr, sub, lane);
        }
    } else {
        constexpr int I_IN = 16 * (ODD_IN / 32), I_OUT = 16 * 32;
        for (int it = gw; it < I_IN + I_OUT; it += NGW) {
            int r = it;
            if (r < I_IN) { transpose_item(P.od_w_in + (size_t)j * 1024 * ODD_IN, 1024, ODD_IN, WIN, scr, r, lane); continue; } r -= I_IN;
            transpose_item(P.od_w_out + (size_t)j * 1024 * 1024, 1024, 1024, WOUT, scr, r, lane);
        }
    }
}
DI void phase_norm(const Params& P, LAS unsigned char* lds, int layer, int wv) {
    const int tid = get_tid(wv), lane = tid & 63, wave = tid >> 6;
    const int gw = get_bid() * 8 + wave, NGW = gridDim.x * 8;
    if (layer > 0) phase_convert(P, lds, layer, wv);
    const float* hl = layer == 0 ? P.x : P.out; const float* hc = layer == 0 ? P.ctx : (const float*)(P.ws + WS_HCTX);
    const float* mod = (const float*)(P.ws + WS_MOD) + (size_t)layer * 9 * 3072;
    const float* nw = P.norm_w + layer * 1024;
    bf16_t* U = (bf16_t*)(P.ws + WS_OV);
    f32x4 w4[4], s4[4], h4[4];
#pragma unroll
    for (int q = 0; q < 4; ++q) w4[q] = *(const f32x4*)(nw + 4 * lane + 256 * q);
    int cur_m = -1;
    const int nrows = layer == 0 ? MROWS : NB * CTXL;
    const int rpw = (nrows + NGW - 1) / NGW;
    for (int idx = gw * rpw; idx < gw * rpw + rpw && idx < nrows; ++idx) {
        const int b = layer == 0 ? idx / LT : idx >> 8, jr = layer == 0 ? idx % LT : idx & 255;
        const int R = b * LT + jr;
        const float* src = jr < CTXL ? hc + ((size_t)b * CTXL + jr) * DM : hl + ((size_t)b * SEQ + (jr - CTXL)) * DM;
        const int mrow = jr < CTXL ? 8 : b;
        if (mrow != cur_m) {
            cur_m = mrow;
            const float* sh = mod + mrow * 3072; const float* sc = sh + 1024;
#pragma unroll
            for (int q = 0; q < 4; ++q) { s4[q] = *(const f32x4*)(sc + 4 * lane + 256 * q) + 1.f; h4[q] = *(const f32x4*)(sh + 4 * lane + 256 * q); }
        }
        f32x4 v[4]; float ss = 0.f;
#pragma unroll
        for (int q = 0; q < 4; ++q) { v[q] = *(const f32x4*)(src + 4 * lane + 256 * q); ss += (v[q][0] * v[q][0] + v[q][1] * v[q][1]) + (v[q][2] * v[q][2] + v[q][3] * v[q][3]); }
        const float rstd = rsqrtf(wave_sum(ss) * (1.f / DM) + RMS_EPS);
#pragma unroll
        for (int q = 0; q < 4; ++q) { const int k = 4 * lane + 256 * q;
            const f32x4 y = (v[q] * rstd) * w4[q]; const f32x4 o = y * s4[q] + h4[q];
            u32x2 w; w.x = pk2(o[0], o[1]); w.y = pk2(o[2], o[3]); *(u32x2*)(U + (size_t)R * DM + k) = w; }
    }
}

typedef _Float16 f16x2_t __attribute__((ext_vector_type(2)));
DI unsigned pkh2(float a, float b) { const f16x2_t v = {(_Float16)a, (_Float16)b}; return __builtin_bit_cast(unsigned, v); }
DI void unpkh2(unsigned u, float& a, float& b) { const f16x2_t v = __builtin_bit_cast(f16x2_t, u); a = (float)v[0]; b = (float)v[1]; }
constexpr int RG_UT = 0, RG_AL = 17408, RG_BL = 50176, RG_HP = 82944, RG_QA = 148480, RG_CAR = 152576, RG_FLAG = 153600, RG_END = 153664;
static_assert(RG_END <= LDS_BYTES - 256, "RG-LRU LDS map");
constexpr int CW_RG = 8192;
DI void rglru_item(const Params& P, LAS unsigned char* lds, int j, int item, int wv) {
    const int tid = get_tid(wv), lane = tid & 63, wave = tid >> 6, r = lane & 15, g = lane >> 4;
    const int grp = item / NCHUNK, ci = item % NCHUNK, b = grp >> 3, hd = grp & 7;
    bf16_t* p = (bf16_t*)(P.ws + WS_P);
    const bf16_t* WRG = (const bf16_t*)(P.ws + WS_WRG);
    unsigned long long* AGG = (unsigned long long*)(P.ws + WS_AGG);
    unsigned* cnt = (unsigned*)(P.ws + WS_CTL) + CW_RG + (j * 64 + grp) * 16;
    const int R0 = b * LT + ci * 64;
    const int seg_lo = b * LT + (ci < 4 ? 0 : CTXL), seg_hi = b * LT + (ci < 4 ? CTXL : LT);
    LAS bf16_t* UT = (LAS bf16_t*)(lds + RG_UT);
    LAS float* AL = (LAS float*)(lds + RG_AL);
    LAS float* BL = (LAS float*)(lds + RG_BL);
    LAS unsigned* HP = (LAS unsigned*)(lds + RG_HP);
    LAS float* QA = (LAS float*)(lds + RG_QA);
    LAS float* CAR = (LAS float*)(lds + RG_CAR);
    TP_START(10, lds, tid); TP_START(11, lds, tid);
    bf16x8 wfr[2][2][4];
    float prm[2][3];
#pragma unroll
    for (int dir = 0; dir < 2; ++dir) {
#pragma unroll
        for (int gt = 0; gt < 2; ++gt) {
            const bf16_t* W = WRG + (size_t)((dir * 2 + gt) * 8 + hd) * 16384 + (wave * 4 * 64 + lane) * 8;
#pragma unroll
            for (int ks = 0; ks < 4; ++ks) wfr[dir][gt][ks] = *(const bf16x8*)(W + ks * 512);
        }
        const int idx = (j * 2 + dir) * 1024 + hd * 128 + 16 * wave + r;
        prm[dir][0] = P.ev_rg_bx[idx]; prm[dir][1] = P.ev_rg_ba[idx]; prm[dir][2] = P.ev_rg_lambda[idx];
    }
    {
        LAS bf16_t* XT = (LAS bf16_t*)(lds + RG_HP);
#pragma unroll
        for (int rep = 0; rep < 3; ++rep) {
            const int idx = tid + rep * 512, tr = idx >> 4, c0 = (idx & 15) * 8;
            if (idx < 67 * 16) {
                const int Rg = R0 + tr - 1;
                u32x4 xv = {0u, 0u, 0u, 0u};
                if (Rg >= seg_lo && Rg < seg_hi) xv = *(const u32x4*)(p + (size_t)Rg * EVEN_IN + hd * 128 + c0);
                *(LAS u32x4*)(XT + tr * 128 + c0) = xv;
            }
        }
        const int c0 = (tid & 15) * 8, cg0 = hd * 128 + c0;
        float wv4[4][8], bias[8];
        { const f32x4 b0 = *(const f32x4*)(P.ev_conv_b + j * 1024 + cg0), b1 = *(const f32x4*)(P.ev_conv_b + j * 1024 + cg0 + 4);
          bias[0] = b0[0]; bias[1] = b0[1]; bias[2] = b0[2]; bias[3] = b0[3]; bias[4] = b1[0]; bias[5] = b1[1]; bias[6] = b1[2]; bias[7] = b1[3]; }
#pragma unroll
        for (int k = 0; k < 4; ++k) { const float* wk = P.ev_conv_w + (size_t)(j * 4 + k) * 1024 + cg0; const f32x4 w0 = *(const f32x4*)wk, w1 = *(const f32x4*)(wk + 4);
            wv4[k][0] = w0[0]; wv4[k][1] = w0[1]; wv4[k][2] = w0[2]; wv4[k][3] = w0[3]; wv4[k][4] = w1[0]; wv4[k][5] = w1[1]; wv4[k][6] = w1[2]; wv4[k][7] = w1[3]; }
        __syncthreads();
#pragma unroll
        for (int rep = 0; rep < 2; ++rep) {
            const int t = (tid >> 4) + rep * 32;
            float acc[8];
#pragma unroll
            for (int e = 0; e < 8; ++e) acc[e] = bias[e];
#pragma unroll
            for (int k = 0; k < 4; ++k) {
                const u32x4 xv = *(const LAS u32x4*)(XT + (t + k) * 128 + c0);
                acc[0] += wv4[k][0] * __uint_as_float(xv.x << 16); acc[1] += wv4[k][1] * __uint_as_float(xv.x & 0xffff0000u);
                acc[2] += wv4[k][2] * __uint_as_float(xv.y << 16); acc[3] += wv4[k][3] * __uint_as_float(xv.y & 0xffff0000u);
                acc[4] += wv4[k][4] * __uint_as_float(xv.z << 16); acc[5] += wv4[k][5] * __uint_as_float(xv.z & 0xffff0000u);
                acc[6] += wv4[k][6] * __uint_as_float(xv.w << 16); acc[7] += wv4[k][7] * __uint_as_float(xv.w & 0xffff0000u);
            }
            u32x4 o; o.x = pk2(acc[0], acc[1]); o.y = pk2(acc[2], acc[3]); o.z = pk2(acc[4], acc[5]); o.w = pk2(acc[6], acc[7]);
            *(LAS u32x4*)(UT + t * 136 + c0) = o;
        }
    }
    __syncthreads();
    TP_STOP(11, lds, tid);
#pragma unroll
    for (int dir = 0; dir < 2; ++dir) {
        TP_START(12, lds, tid); TP_START(16, lds, tid);
        f32x4 ax[4], aa[4];
#pragma unroll
        for (int m = 0; m < 4; ++m) { ax[m] = (f32x4){0.f, 0.f, 0.f, 0.f}; aa[m] = (f32x4){0.f, 0.f, 0.f, 0.f}; }
#pragma unroll
        for (int ks = 0; ks < 4; ++ks) {
#pragma unroll
            for (int m = 0; m < 4; ++m) {
                const bf16x8 a = *(const LAS bf16x8*)(UT + (16 * m + r) * 136 + 32 * ks + 8 * g);
                ax[m] = MFMA16(a, wfr[dir][0][ks], ax[m]); aa[m] = MFMA16(a, wfr[dir][1][ks], aa[m]);
            }
        }
        asm volatile("" :: "v"(ax[0]), "v"(ax[1]), "v"(ax[2]), "v"(ax[3]), "v"(aa[0]), "v"(aa[1]), "v"(aa[2]), "v"(aa[3]));
        TP_STOP(16, lds, tid); TP_START(17, lds, tid);
        {
            const int c = 16 * wave + r;
            const float bxv = prm[dir][0], bav = prm[dir][1], lam = prm[dir][2];
            const float sp = softplus_neg(lam);
#pragma unroll
            for (int m = 0; m < 4; ++m)
#pragma unroll
                for (int i = 0; i < 4; ++i) {
                    const int t = 16 * m + 4 * g + i;
                    const float gx = sigm(ax[m][i] + bxv), ga = sigm(aa[m][i] + bav);
                    const float la = -8.f * ga * sp;
                    const float a = __expf(la), mult = __builtin_amdgcn_sqrtf((1.f - a) * (1.f + a));
                    const float uv = bf2f(UT[t * 136 + c]);
                    AL[t * 128 + c] = a; BL[t * 128 + c] = mult * gx * uv;
                }
        }
        asm volatile("s_waitcnt lgkmcnt(0)" ::: "memory");
        TP_STOP(17, lds, tid); TP_START(18, lds, tid);
        __syncthreads();
        TP_STOP(18, lds, tid);
        TP_STOP(12, lds, tid); TP_START(13, lds, tid);
        {
            const int c = tid & 127, q = tid >> 7;
            float A = 1.f, B = 0.f;
#pragma unroll
            for (int s = 0; s < 16; ++s) { const int t = dir == 0 ? 16 * q + s : 16 * q + 15 - s; const float a = AL[t * 128 + c], bb = BL[t * 128 + c]; B = a * B + bb; A *= a; }
            QA[(q * 128 + c) * 2] = A; QA[(q * 128 + c) * 2 + 1] = B;
            __syncthreads();
            float h = 0.f, pc = 1.f;
            const int nprev = dir == 0 ? q : 3 - q;
            for (int qq = 0; qq < nprev; ++qq) { const int qi = dir == 0 ? qq : 3 - qq; const float a = QA[(qi * 128 + c) * 2]; h = a * h + QA[(qi * 128 + c) * 2 + 1]; pc *= a; }
#pragma unroll
            for (int s = 0; s < 16; ++s) { const int t = dir == 0 ? 16 * q + s : 16 * q + 15 - s; const float a = AL[t * 128 + c]; h = a * h + BL[t * 128 + c]; pc *= a;
                HP[(dir * 64 + t) * 128 + c] = pkh2(h, pc); }
            if (nprev == 3) {
                const unsigned long long v = ((unsigned long long)__float_as_uint(h) << 32) | __float_as_uint(pc);
                __hip_atomic_store(AGG + ((size_t)(dir * NB + b) * NCHUNK + ci) * 1024 + hd * 128 + c, v, __ATOMIC_RELAXED, __HIP_MEMORY_SCOPE_AGENT);
            }
        }
        __syncthreads();
        TP_STOP(13, lds, tid);
    }
    TP_START(14, lds, tid);
    u32x4 gpre[2];
#pragma unroll
    for (int rep = 0; rep < 2; ++rep) { const int idx = tid + rep * 512; gpre[rep] = *(const u32x4*)(p + (size_t)(R0 + (idx >> 4)) * EVEN_IN + 1536 + hd * 128 + (idx & 15) * 8); }
    asm volatile("s_waitcnt vmcnt(0)" ::: "memory");
    __syncthreads();
    if (tid == 0) {
        __hip_atomic_fetch_add(cnt, 1u, __ATOMIC_RELAXED, __HIP_MEMORY_SCOPE_AGENT);
        unsigned spins = 0;
        while (__hip_atomic_load(cnt, __ATOMIC_RELAXED, __HIP_MEMORY_SCOPE_AGENT) < (unsigned)NCHUNK) { __builtin_amdgcn_s_sleep(2); if (++spins > (1u << 22)) break; }
    }
    __syncthreads();
    TP_STOP(14, lds, tid); TP_START(15, lds, tid);
    if (tid < 256) {
        const int dir = tid >> 7, c = tid & 127;
        const int pos = dir == 0 ? ci : (ci < 4 ? 3 - ci : 39 - ci);
        float h = 0.f;
        const unsigned long long* ag = AGG + (size_t)(dir * NB + b) * NCHUNK * 1024 + hd * 128 + c;
#pragma unroll 1
        for (int base = 0; base < pos; base += 18) {
            unsigned long long v[18];
#pragma unroll
            for (int k = 0; k < 18; ++k) { const int pp = base + k < pos ? base + k : pos - 1; const int cc = dir == 0 ? pp : (pp < 4 ? 3 - pp : 39 - pp);
                v[k] = __hip_atomic_load(ag + (size_t)cc * 1024, __ATOMIC_RELAXED, __HIP_MEMORY_SCOPE_AGENT); }
#pragma unroll
            for (int k = 0; k < 18; ++k) if (base + k < pos) h = __uint_as_float((unsigned)v[k]) * h + __uint_as_float((unsigned)(v[k] >> 32));
        }
        CAR[dir * 128 + c] = h;
    }
    __syncthreads();
#pragma unroll
    for (int rep = 0; rep < 2; ++rep) {
        const int idx = tid + rep * 512, t = idx >> 4, c0 = (idx & 15) * 8;
        bf16_t* gp = p + (size_t)(R0 + t) * EVEN_IN + 1536 + hd * 128 + c0;
        const u32x4 gv = gpre[rep];
        float y[8];
#pragma unroll
        for (int e = 0; e < 8; ++e) {
            float h0, p0, h1, p1; unpkh2(HP[t * 128 + c0 + e], h0, p0); unpkh2(HP[(64 + t) * 128 + c0 + e], h1, p1);
            y[e] = (h0 + p0 * CAR[c0 + e]) + (h1 + p1 * CAR[128 + c0 + e]);
        }
        const float gg[8] = {__uint_as_float(gv.x << 16), __uint_as_float(gv.x & 0xffff0000u), __uint_as_float(gv.y << 16), __uint_as_float(gv.y & 0xffff0000u),
                             __uint_as_float(gv.z << 16), __uint_as_float(gv.z & 0xffff0000u), __uint_as_float(gv.w << 16), __uint_as_float(gv.w & 0xffff0000u)};
        u32x4 o;
        o.x = pk2(y[0] * gg[0] * sigm(gg[0]), y[1] * gg[1] * sigm(gg[1])); o.y = pk2(y[2] * gg[2] * sigm(gg[2]), y[3] * gg[3] * sigm(gg[3]));
        o.z = pk2(y[4] * gg[4] * sigm(gg[4]), y[5] * gg[5] * sigm(gg[5])); o.w = pk2(y[6] * gg[6] * sigm(gg[6]), y[7] * gg[7] * sigm(gg[7]));
        *(u32x4*)gp = o;
    }
    __syncthreads();
    TP_STOP(15, lds, tid); TP_STOP(10, lds, tid);
}

DI void rope8v(u32x4& v, const f32x4 cs, const f32x4 sn) {
    unsigned* w = (unsigned*)&v;
#pragma unroll
    for (int i = 0; i < 4; ++i) { const float t1 = __uint_as_float(w[i] << 16), t2 = __uint_as_float(w[i] & 0xffff0000u); w[i] = pk2(t1 * cs[i] - t2 * sn[i], t1 * sn[i] + t2 * cs[i]); }
}
DI void rope8(u32x4& v, const float* cs, const float* sn) { rope8v(v, *(const f32x4*)cs, *(const f32x4*)sn); }
DI void rope8s(u32x4& v, const float* cs, const float* sn, float sc) { rope8v(v, *(const f32x4*)cs * sc, *(const f32x4*)sn * sc); }
DI void scale8(u32x4& v, float sc) {
    unsigned* w = (unsigned*)&v;
#pragma unroll
    for (int i = 0; i < 4; ++i) w[i] = pk2(__uint_as_float(w[i] << 16) * sc, __uint_as_float(w[i] & 0xffff0000u) * sc);
}
typedef short v4i16_a __attribute__((ext_vector_type(4)));
DI void attn_item(const Params& P, LAS unsigned char* lds, int j, int item, int wv) {
    const int tid = get_tid(wv), lane = tid & 63, wave = tid >> 6, r = lane & 31, h = lane >> 5;
    const bool is_lat = item < 512;
    int b, qb, kvh;
    if (is_lat) { b = item >> 6; qb = (item >> 2) & 15; kvh = item & 3; } else { const int it = item - 512; b = it >> 3; qb = (it >> 2) & 1; kvh = it & 3; }
    bf16_t* p = (bf16_t*)(P.ws + WS_P);
    const float* cos_t = (const float*)(P.ws + WS_ROPE); const float* sin_t = cos_t + SEQ * 32;
    LAS unsigned char* QL = lds + 36864 + wave * 9216;
    TP_START(1, lds, tid);
    const int hq = 4 * kvh + (wave >> 1), ql0 = qb * 128 + 64 * (wave & 1);
    const size_t rowbase = (size_t)b * LT + (is_lat ? CTXL : 0);
    {
        const int chq = lane & 7;
#pragma unroll
        for (int k = 0; k < 8; ++k) {
            const int row = (lane >> 3) + 8 * k, qi = ql0 + row;
            u32x4 v = *(const u32x4*)(p + (rowbase + qi) * EVEN_IN + 2560 + hq * 64 + 8 * chq);
            if (is_lat) rope8s(v, cos_t + qi * 32 + 4 * chq, sin_t + qi * 32 + 4 * chq, 0.125f * LOG2E); else scale8(v, 0.125f * LOG2E);
            *(LAS u32x4*)(QL + row * 144 + chq * 16) = v;
        }
    }
    const float sink2 = P.ev_sink[j * 16 + hq] * LOG2E;
    float mrun[2] = {sink2, sink2}, lrun[2] = {h == 0 ? 1.f : 0.f, h == 0 ? 1.f : 0.f};
    f32x16 O[2][2];
#pragma unroll
    for (int a = 0; a < 2; ++a)
#pragma unroll
        for (int c = 0; c < 2; ++c)
#pragma unroll
            for (int i = 0; i < 16; ++i) O[a][c][i] = 0.f;
    const int w_lo = (is_lat && qb == 0) ? 2 : 0, w_hi = (is_lat && qb == 15) ? 3 : 5;
    const int nT = is_lat ? 4 + (w_hi - w_lo + 1) : 4;
    const float SC = 0.125f * LOG2E, NEG = -1e30f;
    const int key = tid >> 3, chn = tid & 7;
    u32x4 kreg, vreg; f32x4 creg, sreg;
#define ATT_K0(t) ((t) < 4 ? 64 * (t) : qb * 128 - 128 + 64 * (w_lo + (t) - 4))
#define ATT_LOAD(t) do { const bool win_ = (t) >= 4; const int k0_ = ATT_K0(t); \
        const bf16_t* kp_ = p + ((size_t)b * LT + (win_ ? CTXL : 0) + k0_ + key) * EVEN_IN + 1024 + kvh * 64 + 8 * chn; \
        kreg = *(const u32x4*)kp_; vreg = *(const u32x4*)(kp_ + 256); \
        if (win_) { creg = *(const f32x4*)(cos_t + (k0_ + key) * 32 + 4 * chn); sreg = *(const f32x4*)(sin_t + (k0_ + key) * 32 + 4 * chn); } } while (0)
#define ATT_STORE(t, buf) do { const bool win_ = (t) >= 4; \
        if (win_) rope8v(kreg, creg, sreg); \
        *(LAS u32x4*)(lds + (buf) * 18432 + key * 144 + chn * 16) = kreg; *(LAS u32x4*)(lds + (buf) * 18432 + 9216 + key * 144 + chn * 16) = vreg; } while (0)
    TP_START(2, lds, tid);
    ATT_LOAD(0); ATT_STORE(0, 0);
    if (nT > 1) ATT_LOAD(1);
#pragma unroll 1
    for (int t = 0; t < nT; ++t) {
        TP_START(4, lds, tid);
        __syncthreads();
        TP_STOP(4, lds, tid);
        if (t + 1 < nT) { ATT_STORE(t + 1, (t + 1) & 1); if (t + 2 < nT) ATT_LOAD(t + 2); }
        TP_START(3, lds, tid);
        const bool win = t >= 4;
        const int k0 = ATT_K0(t);
        const int dq = k0 - ql0;
        if (win && (dq >= 192 || dq <= -192)) continue;
        const bool need_mask = win && (dq >= 128 || dq <= -128);
        const LAS unsigned char* KL = lds + (t & 1) * 18432;
        const LAS bf16_t* VL = (const LAS bf16_t*)(lds + (t & 1) * 18432 + 9216);
#pragma unroll
        for (int qt = 0; qt < 2; ++qt) {
            f32x16 s0, s1;
            { const float nm = -mrun[qt];
#pragma unroll
              for (int i = 0; i < 16; ++i) { s0[i] = nm; s1[i] = nm; } }
#pragma unroll
            for (int ks = 0; ks < 4; ++ks) {
                const bf16x8 qfr = *(const LAS bf16x8*)(QL + (32 * qt + r) * 144 + (16 * ks + 8 * h) * 2);
                const bf16x8 k0f = *(const LAS bf16x8*)(KL + r * 144 + (16 * ks + 8 * h) * 2), k1f = *(const LAS bf16x8*)(KL + (32 + r) * 144 + (16 * ks + 8 * h) * 2);
                s0 = MFMA32(k0f, qfr, s0); s1 = MFMA32(k1f, qfr, s1);
            }
            const int qpos = ql0 + 32 * qt + r;
            if (need_mask) {
#pragma unroll
                for (int i = 0; i < 16; ++i) {
                    const int d0 = qpos - (k0 + crow(i, h)), d1 = d0 - 32;
                    if (d0 > 128 || d0 < -128) s0[i] = NEG;
                    if (d1 > 128 || d1 < -128) s1[i] = NEG;
                }
            }
            float mx = NEG;
#pragma unroll
            for (int i = 0; i < 16; ++i) mx = fmaxf(mx, fmaxf(s0[i], s1[i]));
            mx = fmaxf(mx, shfl_xor_f(mx, 32));
            if (__any(mx > 6.0f)) {
                const float shift = fmaxf(mx, 0.f), alpha = __builtin_amdgcn_exp2f(-shift);
                mrun[qt] += shift; lrun[qt] *= alpha;
#pragma unroll
                for (int i = 0; i < 16; ++i) { s0[i] -= shift; s1[i] -= shift; }
#pragma unroll
                for (int dt = 0; dt < 2; ++dt)
#pragma unroll
                    for (int i = 0; i < 16; ++i) O[dt][qt][i] *= alpha;
            }
            float ls = 0.f;
#pragma unroll
            for (int i = 0; i < 16; ++i) { s0[i] = __builtin_amdgcn_exp2f(s0[i]); s1[i] = __builtin_amdgcn_exp2f(s1[i]); ls += s0[i] + s1[i]; }
            lrun[qt] += ls;
            bf16x8 pf[2][2];
#pragma unroll
            for (int s = 0; s < 2; ++s) {
                u32x4 a, c;
                a.x = pk2(s0[8 * s + 0], s0[8 * s + 1]); a.y = pk2(s0[8 * s + 2], s0[8 * s + 3]); a.z = pk2(s0[8 * s + 4], s0[8 * s + 5]); a.w = pk2(s0[8 * s + 6], s0[8 * s + 7]);
                c.x = pk2(s1[8 * s + 0], s1[8 * s + 1]); c.y = pk2(s1[8 * s + 2], s1[8 * s + 3]); c.z = pk2(s1[8 * s + 4], s1[8 * s + 5]); c.w = pk2(s1[8 * s + 6], s1[8 * s + 7]);
                pf[0][s] = __builtin_bit_cast(bf16x8, a); pf[1][s] = __builtin_bit_cast(bf16x8, c);
            }
            const int gq = (lane >> 4) & 1, qq4 = (lane & 15) >> 2, pp4 = lane & 3;
#pragma unroll
            for (int dt = 0; dt < 2; ++dt)
#pragma unroll
                for (int kt = 0; kt < 2; ++kt)
#pragma unroll
                    for (int s = 0; s < 2; ++s) {
                        const LAS bf16_t* vp = VL + (32 * kt + 16 * s + 4 * h + qq4) * 72 + 32 * dt + 16 * gq + 4 * pp4;
                        const v4i16_a lo = __builtin_amdgcn_ds_read_tr16_b64_v4i16((LAS v4i16_a*)vp);
                        const v4i16_a hi = __builtin_amdgcn_ds_read_tr16_b64_v4i16((LAS v4i16_a*)(vp + 8 * 72));
                        const bf16x8 vf = {lo[0], lo[1], lo[2], lo[3], hi[0], hi[1], hi[2], hi[3]};
                        O[dt][qt] = MFMA32(vf, pf[kt][s], O[dt][qt]);
                    }
            __builtin_amdgcn_sched_barrier(0);
        }
        TP_STOP(3, lds, tid);
    }
    TP_STOP(2, lds, tid);
#undef ATT_K0
#undef ATT_LOAD
#undef ATT_STORE
    {
        const int chq = lane & 7;
        u32x4 gate[8];
#pragma unroll
        for (int k = 0; k < 8; ++k) gate[k] = *(const u32x4*)(p + (rowbase + ql0 + (lane >> 3) + 8 * k) * EVEN_IN + 3584 + hq * 64 + 8 * chq);
#pragma unroll
        for (int qt = 0; qt < 2; ++qt) {
            const float lt = lrun[qt] + shfl_xor_f(lrun[qt], 32), inv = __builtin_amdgcn_rcpf(lt);
#pragma unroll
            for (int dt = 0; dt < 2; ++dt)
#pragma unroll
                for (int i4 = 0; i4 < 4; ++i4) {
                    u32x2 o; o.x = pk2(O[dt][qt][4 * i4 + 0] * inv, O[dt][qt][4 * i4 + 1] * inv); o.y = pk2(O[dt][qt][4 * i4 + 2] * inv, O[dt][qt][4 * i4 + 3] * inv);
                    *(LAS u32x2*)(QL + (32 * qt + r) * 144 + (32 * dt + 8 * i4 + 4 * h) * 2) = o;
                }
        }
#pragma unroll
        for (int k = 0; k < 8; ++k) {
            const int row = (lane >> 3) + 8 * k;
            const u32x4 ov = *(const LAS u32x4*)(QL + row * 144 + chq * 16);
            const unsigned* ow = (const unsigned*)&ov; const unsigned* gw = (const unsigned*)&gate[k];
            u32x4 res; unsigned* rw = (unsigned*)&res;
#pragma unroll
            for (int e = 0; e < 4; ++e) {
                const float g0 = __uint_as_float(gw[e] << 16), g1 = __uint_as_float(gw[e] & 0xffff0000u);
                rw[e] = pk2(__uint_as_float(ow[e] << 16) * g0 * sigm(g0), __uint_as_float(ow[e] & 0xffff0000u) * g1 * sigm(g1));
            }
            *(u32x4*)(p + (rowbase + ql0 + row) * EVEN_IN + 2560 + hq * 64 + 8 * chq) = res;
        }
    }
    __syncthreads();
    TP_STOP(1, lds, tid);
}

constexpr int G2_QX = 0, G2_KF = 17408, G2_K2 = 60928, G2_VS = 79360, G2_AM = 96768, G2_ST = 105984, G2_PS = 140800, G2_BL = 144896, G2_Q1 = 145408, G2_END = 162816;
static_assert(G2_END <= LDS_BYTES - 256, "GLA LDS map");
typedef short v4i16_t __attribute__((ext_vector_type(4)));
DI bf16x8 frag_tr(const LAS bf16_t* M, int stride, int k0, int n0, int lane) {
    const int i = lane & 15, g = lane >> 4, q = i >> 2, pp = i & 3;
    const LAS bf16_t* a0 = M + (k0 + 8 * g + q) * stride + n0 + 4 * pp;
    const v4i16_t lo = __builtin_amdgcn_ds_read_tr16_b64_v4i16((LAS v4i16_t*)a0);
    const v4i16_t hi = __builtin_amdgcn_ds_read_tr16_b64_v4i16((LAS v4i16_t*)(a0 + 4 * stride));
    return (bf16x8){lo[0], lo[1], lo[2], lo[3], hi[0], hi[1], hi[2], hi[3]};
}

#ifndef GLA_SPLIT
#define GLA_SPLIT 24
#endif
template <int DIR>
DI void gla2_item(const Params& P, LAS unsigned char* lds, int layer_j, int b, int hd, int part, int wv) {
    const int tid = get_tid(wv), lane = tid & 63, wave = tid >> 6, r = lane & 15, g = lane >> 4;
    bf16_t* p = (bf16_t*)(P.ws + WS_P);
    LAS bf16_t* QX = (LAS bf16_t*)(lds + G2_QX); LAS bf16_t* KF = (LAS bf16_t*)(lds + G2_KF); LAS bf16_t* K2 = (LAS bf16_t*)(lds + G2_K2);
    LAS bf16_t* VS = (LAS bf16_t*)(lds + G2_VS); LAS bf16_t* AM = (LAS bf16_t*)(lds + G2_AM); LAS bf16_t* ST = (LAS bf16_t*)(lds + G2_ST);
    LAS float* PS8 = (LAS float*)(lds + G2_PS); LAS float* BLAST = (LAS float*)(lds + G2_BL); LAS bf16_t* Q1 = (LAS bf16_t*)(lds + G2_Q1);
    const int d0 = 2 * lane, tg = wave, I = tg >> 1, half = tg & 1;
    float lbv[2] = {0.f, 0.f};
    if (layer_j > 0) { lbv[0] = sigm(P.od_lb_raw[1024 + hd * 128 + d0] - P.od_lb_raw[hd * 128 + d0]); lbv[1] = sigm(P.od_lb_raw[1024 + hd * 128 + d0 + 1] - P.od_lb_raw[hd * 128 + d0 + 1]); }
    unsigned* prog = (unsigned*)(P.ws + WS_CTL) + 10240 + ((layer_j * 128 + b * 16 + hd * 2 + DIR) * 8);
    const int step_end = part == 0 ? GLA_SPLIT : NCHUNK;
    TP_START(20, lds, tid);
    for (int i = tid; i < (9216 + 34816) / 4; i += 512) ((LAS unsigned*)(lds + G2_AM))[i] = 0u;
    f32x4 st[8];
#pragma unroll
    for (int e = 0; e < 8; ++e) st[e] = (f32x4){0.f, 0.f, 0.f, 0.f};
    unsigned zn[8], qn[8]; u32x4 vn[2];
#define G2_OFFZ(s) ((unsigned)((DIR == 0 ? 8 * tg + (s) : 63 - 8 * tg - (s)) * ODD_IN + d0) * 2u)
#define G2_OFFV(rep) ((unsigned)((DIR == 0 ? ((tid + (rep) * 512) >> 4) : 63 - ((tid + (rep) * 512) >> 4)) * ODD_IN + 8 * ((tid + (rep) * 512) & 15)) * 2u)
    const size_t colz = (size_t)DIR * 1024 + hd * 128, colq = 3072 + hd * 128, colv = 2048 + hd * 128;
    {
        const int chunk = DIR == 0 ? 0 : 3;
        const char* slab = (const char*)(p + ((size_t)b * LT + (size_t)chunk * 64) * ODD_IN);
#pragma unroll
        for (int s = 0; s < 8; ++s) { zn[s] = *(const unsigned*)(slab + colz * 2 + G2_OFFZ(s)); qn[s] = *(const unsigned*)(slab + colq * 2 + G2_OFFZ(s)); }
#pragma unroll
        for (int rep = 0; rep < 2; ++rep) vn[rep] = *(const u32x4*)(slab + colv * 2 + G2_OFFV(rep));
    }
    __syncthreads();
#pragma unroll 1
    for (int step = 0; step < step_end; ++step) {
        const bool sonly = part == 1 && step < GLA_SPLIT;
        const int chunk = DIR == 0 ? step : (step < 4 ? 3 - step : 39 - step);
        const size_t Rc0 = (size_t)b * LT + (size_t)chunk * 64;
        unsigned zc[8], qc[8]; u32x4 vc[2];
#pragma unroll
        for (int s = 0; s < 8; ++s) { zc[s] = zn[s]; qc[s] = qn[s]; }
        vc[0] = vn[0]; vc[1] = vn[1];
        TP_START(21, lds, tid);
        float el[8][2], kk[8][2], qq[8][2];
        {
            float run0 = 1.f, run1 = 1.f;
#pragma unroll
            for (int s = 0; s < 8; ++s) {
                const float z0 = __uint_as_float(zc[s] << 16), z1 = __uint_as_float(zc[s] & 0xffff0000u);
                const float t0 = __expf(-z0), t1 = __expf(-z1), sg0 = __builtin_amdgcn_rcpf(1.f + t0), sg1 = __builtin_amdgcn_rcpf(1.f + t1);
                const float f0 = fmaxf(lbv[0] + (1.f - lbv[0]) * sg0, 1e-30f), f1 = fmaxf(lbv[1] + (1.f - lbv[1]) * sg1, 1e-30f);
                kk[s][0] = (1.f - lbv[0]) * (t0 * sg0); kk[s][1] = (1.f - lbv[1]) * (t1 * sg1);
                run0 = fmaxf(run0 * f0, 1e-35f); run1 = fmaxf(run1 * f1, 1e-35f); el[s][0] = run0; el[s][1] = run1;
                if (!sonly) {
                const float q0 = __uint_as_float(qc[s] << 16), q1 = __uint_as_float(qc[s] & 0xffff0000u);
                qq[s][0] = q0 * __builtin_amdgcn_rcpf(1.f + __expf(-q0)); qq[s][1] = q1 * __builtin_amdgcn_rcpf(1.f + __expf(-q1));
                } else { qq[s][0] = 0.f; qq[s][1] = 0.f; }
                if ((s & 1) == 1) __builtin_amdgcn_sched_barrier(0);
            }
            *(LAS f32x2*)(PS8 + tg * 128 + d0) = (f32x2){run0, run1};
#pragma unroll
            for (int rep = 0; rep < 2; ++rep) { const int idx = tid + rep * 512, tau = idx >> 4, chn = idx & 15; *(LAS u32x4*)(VS + tau * 136 + 8 * chn) = vc[rep]; }
        }
        __syncthreads();
        if (part == 1 && step < GLA_SPLIT && tid == 0) __hip_atomic_store(prog, (unsigned)(step + 1), __ATOMIC_RELAXED, __HIP_MEMORY_SCOPE_AGENT);
        TP_STOP(21, lds, tid); TP_START(22, lds, tid);
        float RI[2];
        {
            float T[8][2];
#pragma unroll
            for (int q8 = 0; q8 < 8; ++q8) { const f32x2 t = *(const LAS f32x2*)(PS8 + q8 * 128 + d0); T[q8][0] = t[0]; T[q8][1] = t[1]; }
            float pre[2], fac[4][2], f4[2];
#pragma unroll
            for (int x = 0; x < 2; ++x) {
                const float P0 = T[0][x] * T[1][x], P1 = T[2][x] * T[3][x], P2 = T[4][x] * T[5][x], P3 = T[6][x] * T[7][x];
                pre[x] = half ? (I == 0 ? T[0][x] : (I == 1 ? T[2][x] : (I == 2 ? T[4][x] : T[6][x]))) : 1.f;
                RI[x] = I == 0 ? 1.f : (I == 1 ? P0 : (I == 2 ? P0 * P1 : P0 * P1 * P2));
                float cur = 1.f;
                fac[0][x] = cur; if (I <= 0) cur *= P0;
                fac[1][x] = cur; if (I <= 1) cur *= P1;
                fac[2][x] = cur; if (I <= 2) cur *= P2;
                fac[3][x] = cur; cur *= P3;
                f4[x] = cur;
                if (tg == 0) BLAST[d0 + x] = P0 * P1 * P2 * P3;
            }
            unsigned w0[4], w1[4];
#pragma unroll
            for (int s = 0; s < 8; ++s) {
                const int tau = 8 * tg + s;
                const float e00 = fmaxf(pre[0] * el[s][0], 1e-35f), e01 = fmaxf(pre[1] * el[s][1], 1e-35f);
                const float qi0 = qq[s][0] * e00, qi1 = qq[s][1] * e01;
                const float kd0 = kk[s][0] * __builtin_amdgcn_rcpf(e00), kd1 = kk[s][1] * __builtin_amdgcn_rcpf(e01);
                if (!sonly) {
                *(LAS unsigned*)(QX + tau * 136 + d0) = pk2(qi0, qi1);
                *(LAS unsigned*)(Q1 + tau * 136 + d0) = pk2(qi0 * RI[0], qi1 * RI[1]);
                if (I <= 0) *(LAS unsigned*)(KF + (0 + tau) * 136 + d0) = pk2(kd0 * fac[0][0], kd1 * fac[0][1]);
                if (I <= 1) *(LAS unsigned*)(KF + (16 + tau) * 136 + d0) = pk2(kd0 * fac[1][0], kd1 * fac[1][1]);
                if (I <= 2) *(LAS unsigned*)(KF + (48 + tau) * 136 + d0) = pk2(kd0 * fac[2][0], kd1 * fac[2][1]);
                *(LAS unsigned*)(KF + (96 + tau) * 136 + d0) = pk2(kd0 * fac[3][0], kd1 * fac[3][1]);
                }
                const unsigned h0 = f2bf(kd0 * f4[0]), h1 = f2bf(kd1 * f4[1]);
                if (s & 1) { w0[s >> 1] |= h0 << 16; w1[s >> 1] |= h1 << 16; } else { w0[s >> 1] = h0; w1[s >> 1] = h1; }
                if ((s & 1) == 1) __builtin_amdgcn_sched_barrier(0);
            }
            *(LAS u32x4*)(K2 + (d0 + 0) * 72 + 8 * tg) = (u32x4){w0[0], w0[1], w0[2], w0[3]};
            *(LAS u32x4*)(K2 + (d0 + 1) * 72 + 8 * tg) = (u32x4){w1[0], w1[1], w1[2], w1[3]};
        }
        __syncthreads();
        TP_STOP(22, lds, tid); TP_START(23, lds, tid);
        if (step + 1 < step_end) {
            const int nchunk = DIR == 0 ? step + 1 : (step + 1 < 4 ? 2 - step : 38 - step);
            const char* slab = (const char*)(p + ((size_t)b * LT + (size_t)nchunk * 64) * ODD_IN);
#pragma unroll
            for (int s = 0; s < 8; ++s) { zn[s] = *(const unsigned*)(slab + colz * 2 + G2_OFFZ(s)); qn[s] = *(const unsigned*)(slab + colq * 2 + G2_OFFZ(s)); }
#pragma unroll
            for (int rep = 0; rep < 2; ++rep) vn[rep] = *(const u32x4*)(slab + colv * 2 + G2_OFFV(rep));
        }
#pragma unroll 1
        for (int bi = sonly ? 10 : wave; bi < 10; bi += 8) {
            const int Ib = bi < 1 ? 0 : (bi < 3 ? 1 : (bi < 6 ? 2 : 3)), Jb = bi - (Ib * (Ib + 1)) / 2;
            const int foff = Ib == 0 ? 0 : (Ib == 1 ? 16 : (Ib == 2 ? 48 : 96));
            f32x4 acc = {0.f, 0.f, 0.f, 0.f};
#pragma unroll
            for (int ks = 0; ks < 4; ++ks) {
                const bf16x8 a = *(const LAS bf16x8*)(QX + (16 * Ib + r) * 136 + 32 * ks + 8 * g);
                const bf16x8 bb = *(const LAS bf16x8*)(KF + (foff + 16 * Jb + r) * 136 + 32 * ks + 8 * g);
                acc = MFMA16(a, bb, acc);
            }
#pragma unroll
            for (int i = 0; i < 4; ++i) { float v = acc[i]; if (Jb == Ib && r > 4 * g + i) v = 0.f; AM[(16 * Ib + 4 * g + i) * 72 + 16 * Jb + r] = (bf16_t)f2bf(v); }
        }
        if (!sonly) __syncthreads();
        TP_STOP(23, lds, tid); TP_START(24, lds, tid);
        {
            if (!sonly) {
            const int tt = wave >> 1, eb = 4 * (wave & 1);
            bf16x8 aq[4], am[2];
#pragma unroll
            for (int ks = 0; ks < 4; ++ks) aq[ks] = *(const LAS bf16x8*)(Q1 + (16 * tt + r) * 136 + 32 * ks + 8 * g);
#pragma unroll
            for (int ks = 0; ks < 2; ++ks) am[ks] = *(const LAS bf16x8*)(AM + (16 * tt + r) * 72 + 32 * ks + 8 * g);
#pragma unroll
            for (int e4 = 0; e4 < 4; ++e4) {
                const int et = eb + e4;
                f32x4 acc = {0.f, 0.f, 0.f, 0.f};
#pragma unroll
                for (int ks = 0; ks < 4; ++ks) { const bf16x8 bb = *(const LAS bf16x8*)(ST + (16 * et + r) * 136 + 32 * ks + 8 * g); acc = MFMA16(aq[ks], bb, acc); }
#pragma unroll
                for (int ks = 0; ks < 2; ++ks) acc = MFMA16(am[ks], frag_tr(VS, 136, 32 * ks, 16 * et, lane), acc);
#pragma unroll
                for (int i = 0; i < 4; ++i) KF[(16 * tt + 4 * g + i) * 136 + 16 * et + r] = (bf16_t)f2bf(acc[i]);
                __builtin_amdgcn_sched_barrier(0);
            }
            }
            float bl[4];
#pragma unroll
            for (int i = 0; i < 4; ++i) bl[i] = BLAST[16 * wave + 4 * g + i];
            bf16x8 ak[2];
#pragma unroll
            for (int ks = 0; ks < 2; ++ks) ak[ks] = *(const LAS bf16x8*)(K2 + (16 * wave + r) * 72 + 32 * ks + 8 * g);
#pragma unroll
            for (int et = 0; et < 8; ++et) {
#pragma unroll
                for (int i = 0; i < 4; ++i) st[et][i] *= bl[i];
#pragma unroll
                for (int ks = 0; ks < 2; ++ks) st[et] = MFMA16(ak[ks], frag_tr(VS, 136, 32 * ks, 16 * et, lane), st[et]);
                if (et & 1) __builtin_amdgcn_sched_barrier(0);
            }
        }
        if (part == 0 && tid == 0) { unsigned spins = 0; while (__hip_atomic_load(prog, __ATOMIC_RELAXED, __HIP_MEMORY_SCOPE_AGENT) < (unsigned)(step + 1)) { __builtin_amdgcn_s_sleep(2); if (++spins > (1u << 22)) break; } }
        __syncthreads();
        TP_STOP(24, lds, tid); TP_START(25, lds, tid);
        if (!sonly) {
            char* oslab = (char*)(p + Rc0 * ODD_IN + colz);
#pragma unroll
            for (int rep = 0; rep < 2; ++rep) {
                const int idx = tid + rep * 512, tau = idx >> 4, chn = idx & 15;
                const u32x4 ov = *(const LAS u32x4*)(KF + tau * 136 + 8 * chn);
                *(u32x4*)(oslab + (unsigned)((DIR == 0 ? tau : 63 - tau) * ODD_IN + 8 * chn) * 2u) = ov;
            }
        }
        if (!sonly || step == GLA_SPLIT - 1) {
#pragma unroll
        for (int et = 0; et < 8; ++et) { u32x2 w; w.x = pk2(st[et][0], st[et][1]); w.y = pk2(st[et][2], st[et][3]); *(LAS u32x2*)(ST + (16 * et + r) * 136 + 16 * wave + 4 * g) = w; }
        }
        TP_STOP(25, lds, tid);
    }
    __syncthreads();
    TP_STOP(20, lds, tid);
}

DI void phase_readout(const Params& P, int layer_j, int wv) {
    const int tid = get_tid(wv), lane = tid & 63, wave = tid >> 6;
    const int gw = get_bid() * 8 + wave, NGW = gridDim.x * 8;
    bf16_t* p = (bf16_t*)(P.ws + WS_P);
    const float* gwt = P.od_gnorm_w + layer_j * 128 + (lane & 7) * 16;
    for (int R = gw; R < MROWS; R += NGW) {
        const bf16_t* op = p + (size_t)R * ODD_IN + 16 * lane; bf16_t* yp = p + (size_t)R * ODD_IN + 4096 + 16 * lane;
        const u32x4 o0 = *(const u32x4*)op, o1 = *(const u32x4*)(op + 8), c0 = *(const u32x4*)(op + 1024), c1 = *(const u32x4*)(op + 1032), g0 = *(const u32x4*)yp, g1 = *(const u32x4*)(yp + 8);
        float ov[16], gv[16];
        const unsigned* ow0 = (const unsigned*)&o0; const unsigned* ow1 = (const unsigned*)&o1; const unsigned* cw0 = (const unsigned*)&c0; const unsigned* cw1 = (const unsigned*)&c1;
        const unsigned* gw0 = (const unsigned*)&g0; const unsigned* gw1 = (const unsigned*)&g1;
#pragma unroll
        for (int i = 0; i < 4; ++i) {
            ov[2 * i] = __uint_as_float(ow0[i] << 16) + __uint_as_float(cw0[i] << 16); ov[2 * i + 1] = __uint_as_float(ow0[i] & 0xffff0000u) + __uint_as_float(cw0[i] & 0xffff0000u);
            ov[8 + 2 * i] = __uint_as_float(ow1[i] << 16) + __uint_as_float(cw1[i] << 16); ov[8 + 2 * i + 1] = __uint_as_float(ow1[i] & 0xffff0000u) + __uint_as_float(cw1[i] & 0xffff0000u);
            gv[2 * i] = __uint_as_float(gw0[i] << 16); gv[2 * i + 1] = __uint_as_float(gw0[i] & 0xffff0000u); gv[8 + 2 * i] = __uint_as_float(gw1[i] << 16); gv[8 + 2 * i + 1] = __uint_as_float(gw1[i] & 0xffff0000u);
        }
        float ss = 0.f;
#pragma unroll
        for (int i = 0; i < 16; ++i) ss += ov[i] * ov[i];
        ss += shfl_xor_f(ss, 1); ss += shfl_xor_f(ss, 2); ss += shfl_xor_f(ss, 4);
        const float rstd = rsqrtf(ss * (1.f / 128.f) + RMS_EPS);
        float y[16];
#pragma unroll
        for (int i = 0; i < 16; ++i) y[i] = ov[i] * rstd * gwt[i] * (gv[i] * sigm(gv[i]));
        u32x4 w0, w1;
        w0.x = pk2(y[0], y[1]); w0.y = pk2(y[2], y[3]); w0.z = pk2(y[4], y[5]); w0.w = pk2(y[6], y[7]);
        w1.x = pk2(y[8], y[9]); w1.y = pk2(y[10], y[11]); w1.z = pk2(y[12], y[13]); w1.w = pk2(y[14], y[15]);
        *(u32x4*)yp = w0; *(u32x4*)(yp + 8) = w1;
    }
}

DI void phase_final(const Params& P, int wv) {
    const int tid = get_tid(wv), lane = tid & 63, wave = tid >> 6;
    const int gw = get_bid() * 8 + wave, NGW = gridDim.x * 8;
    for (int R = gw; R < NB * SEQ; R += NGW) {
        float* row = P.out + (size_t)R * DM;
        f32x4 v[4]; float ss = 0.f;
#pragma unroll
        for (int q = 0; q < 4; ++q) { v[q] = *(const f32x4*)(row + 4 * lane + 256 * q); ss += (v[q][0] * v[q][0] + v[q][1] * v[q][1]) + (v[q][2] * v[q][2] + v[q][3] * v[q][3]); }
        const float rstd = rsqrtf(wave_sum(ss) * (1.f / DM) + RMS_EPS);
#pragma unroll
        for (int q = 0; q < 4; ++q) { const f32x4 w4 = *(const f32x4*)(P.final_norm_w + 4 * lane + 256 * q); *(f32x4*)(row + 4 * lane + 256 * q) = (v[q] * rstd) * w4; }
    }
}

#define XB_TMO      128
#define XB_XCNT(j)  (256  + 64 * (j))
#define XB_XSUB(j)  (1280 + 64 * (j))
#define XB_XGEN(j)  (2304 + 64 * (j))
#define XB_TOP      3328
#define XB_TOPGEN   3392
#define XCD_BAR_WORDS 3456
#define XB_SPIN_CAP (1u << 18)

__device__ __forceinline__ unsigned xb_ld(unsigned* p)              { return __hip_atomic_load(p, __ATOMIC_RELAXED, __HIP_MEMORY_SCOPE_AGENT); }
__device__ __forceinline__ unsigned xb_add(unsigned* p, unsigned v) { return __hip_atomic_fetch_add(p, v, __ATOMIC_RELAXED, __HIP_MEMORY_SCOPE_AGENT); }
__device__ __forceinline__ unsigned xb_xcc_id() { return (unsigned)__builtin_amdgcn_s_getreg((3 << 11) | 20) & 0xFu; }
#define XB_SPIN(cond, bar) do { unsigned _sp = 0; while (cond) { __builtin_amdgcn_s_sleep(1); \
    if ((++_sp & 255u) == 0u) { if (xb_ld(&(bar)[XB_TMO])) break; if (_sp > XB_SPIN_CAP) { atomicAdd(&(bar)[XB_TMO], 1u); break; } } } } while (0)

struct XcdBarrier {
    unsigned* bar; unsigned x;
    volatile LAS unsigned* st;
};

__device__ __forceinline__ XcdBarrier xcd_barrier_post(unsigned* bar, volatile LAS unsigned* st, int wv) {
    XcdBarrier b; b.bar = bar; b.x = xb_xcc_id(); b.st = st;
    if (get_tid(wv) == 0) (void)xb_add(&bar[XB_XCNT(b.x)], 1u);
    return b;
}
__device__ __forceinline__ void xcd_barrier_complete(unsigned* bar, unsigned x, unsigned& nloc, unsigned& nx) {
    const unsigned G = gridDim.x * gridDim.y * gridDim.z;
    unsigned sum, cnt, mine, sp = 0u;
    for (;;) {
        sum = 0u; cnt = 0u; mine = 0u;
#pragma unroll
        for (unsigned j = 0; j < 16; ++j) { const unsigned c = xb_ld(&bar[XB_XCNT(j)]); sum += c; cnt += (c > 0u) ? 1u : 0u; mine = (j == x) ? c : mine; }
        if (sum == G) break;
        __builtin_amdgcn_s_sleep(1);
        if ((++sp & 255u) == 0u) { if (xb_ld(&bar[XB_TMO])) break; if (sp > XB_SPIN_CAP) { atomicAdd(&bar[XB_TMO], 1u); break; } }
    }
    nloc = mine > 0u ? mine : 1u; nx = cnt > 0u ? cnt : 1u;
}

__device__ __forceinline__ void xcd_barrier(const XcdBarrier& b, int wv) {
    asm volatile("s_waitcnt vmcnt(0)" ::: "memory");
    __syncthreads();
    if (get_tid(wv) == 0) {
        unsigned* bar = b.bar;
        __builtin_amdgcn_s_waitcnt(0);
        unsigned nloc = b.st[0], nx = b.st[1];
        if (nloc == 0u) { xcd_barrier_complete(bar, b.x, nloc, nx); b.st[0] = nloc; b.st[1] = nx; }
        const unsigned old = xb_add(&bar[XB_XSUB(b.x)], 1u);
        const unsigned gen = old / nloc;
        if (old + 1u == (gen + 1u) * nloc) {
            __builtin_amdgcn_fence(__ATOMIC_RELEASE, "agent");
            asm volatile("s_waitcnt vmcnt(0)" ::: "memory");
            const unsigned og = xb_add(&bar[XB_TOP], 1u);
            const unsigned tg = og / nx;
            if (og + 1u == (tg + 1u) * nx) xb_add(&bar[XB_TOPGEN], 1u);
            else XB_SPIN(xb_ld(&bar[XB_TOPGEN]) == tg, bar);
            __builtin_amdgcn_fence(__ATOMIC_ACQUIRE, "agent");
            xb_add(&bar[XB_XGEN(b.x)], 1u);
            asm volatile("s_waitcnt vmcnt(0)" ::: "memory");
        } else {
            XB_SPIN(xb_ld(&bar[XB_XGEN(b.x)]) == gen, bar);
            __builtin_amdgcn_fence(__ATOMIC_ACQUIRE, "agent");
            asm volatile("s_waitcnt vmcnt(0)" ::: "memory");
        }
    }
    __syncthreads();
}

constexpr int PARAM_OFF = LDS_BYTES - 256;
static_assert(G2_END <= PARAM_OFF && sizeof(Params) <= 208, "LDS map");
DI const float* ld_uptr(const LAS unsigned long long* s, int i) {
    const unsigned long long v = s[i];
    const unsigned lo = __builtin_amdgcn_readfirstlane((unsigned)v), hi = __builtin_amdgcn_readfirstlane((unsigned)(v >> 32));
    return (const float*)(const __attribute__((address_space(1))) float*)(((unsigned long long)hi << 32) | lo);
}
DI Params load_params(LAS unsigned char* lds) {
    LAS unsigned char* pb = lds + PARAM_OFF; asm volatile("" : "+v"(pb));
    const LAS unsigned long long* s = (const LAS unsigned long long*)pb;
    Params Q;
    Q.x = ld_uptr(s, 0); Q.c = ld_uptr(s, 1); Q.ctx = ld_uptr(s, 2); Q.c_ctx = ld_uptr(s, 3); Q.ada_w = ld_uptr(s, 4); Q.ada_b = ld_uptr(s, 5); Q.norm_w = ld_uptr(s, 6);
    Q.ev_w_in = ld_uptr(s, 7); Q.ev_conv_w = ld_uptr(s, 8); Q.ev_conv_b = ld_uptr(s, 9); Q.ev_rg_wx = ld_uptr(s, 10); Q.ev_rg_bx = ld_uptr(s, 11); Q.ev_rg_wa = ld_uptr(s, 12);
    Q.ev_rg_ba = ld_uptr(s, 13); Q.ev_rg_lambda = ld_uptr(s, 14); Q.ev_sink = ld_uptr(s, 15); Q.ev_w_out = ld_uptr(s, 16); Q.od_w_in = ld_uptr(s, 17); Q.od_lb_raw = ld_uptr(s, 18);
    Q.od_gnorm_w = ld_uptr(s, 19); Q.od_w_out = ld_uptr(s, 20); Q.final_norm_w = ld_uptr(s, 21); Q.out = (float*)ld_uptr(s, 22); Q.ws = (unsigned char*)ld_uptr(s, 23);
    Q.ph_lo = 0; Q.ph_hi = 0;
    return Q;
}
DI void run_phase(LAS unsigned char* lds, int ph, int wv) {
    #ifndef PHMASK
#define PHMASK 0xffff
#endif
    if (ph == 0) { if (PHMASK & 1) { const Params P = load_params(lds); phase_pro(P, lds, wv); __syncthreads(); phase_convert(P, lds, 0, wv); } return; }
    const int layer = (ph - 1) / 5, sub = (ph - 1) % 5, j = layer >> 1;
    const bool even = (layer & 1) == 0;
    if (sub == 0) { if (PHMASK & 4) { const Params P = load_params(lds); phase_norm(P, lds, layer, wv); } return; }
    if (sub == 1) {
        const Params P = load_params(lds); bf16_t* pbuf = (bf16_t*)(P.ws + WS_P);
        const int N = even ? EVEN_IN : ODD_IN;
        pg8::Gemm gm{(const bf16_t*)(P.ws + WS_OV), (const bf16_t*)(P.ws + WS_WIN), MROWS, N, 1024, 1024};
        pg8::StaticOrder S; S.init(MROWS, N, (int)gridDim.x, get_bid());
        EpiStoreBf16 E{pbuf, N};
        if (even) S.limit = 1280;
        if (PHMASK & 8) pg8::gemm_phase<EpiStoreBf16, pg8::StaticOrder, true, true>(lds, gm, S, E, wv);
        if (even) {
            for (int t = get_bid(); t < 128; t += gridDim.x) {
                pg8::Unit u; S.tile_of(1280 + (t >> 3), u);
                const int m0 = 256 * u.pm + 64 * ((t & 7) >> 1), n0 = 256 * u.pn + 128 * (t & 1);
                auto epi = [&](const f32x16& acc, int row0, int col, int hh) {
#pragma unroll
                    for (int i = 0; i < 16; ++i) pbuf[(size_t)(m0 + row0 + crow(i, hh)) * N + n0 + col] = (bf16_t)f2bf(acc[i]);
                };
                mini_gemm_tile(lds, (const bf16_t*)(P.ws + WS_OV) + (size_t)m0 * 1024, 1024, (const bf16_t*)(P.ws + WS_WIN) + (size_t)n0 * 1024, 1024, epi, wv);
            }
        }
        return;
    }
    if (sub == 2) {
        const Params P = load_params(lds);
        if (even) {
            constexpr int NRG = NB * NCHUNK * 8;
#if defined(SPLIT_ATTN)
            for (int it = get_bid(); it < NRG; it += gridDim.x) rglru_item(P, lds, j, it, wv);
#else
            for (int it = get_bid(); it < NRG + 576; it += gridDim.x) {
                if (it < NRG) { if (PHMASK & 32) rglru_item(P, lds, j, it, wv); } else { if (PHMASK & 16) attn_item(P, lds, j, it - NRG, wv); }
            }
#endif
        } else {
            for (int it = get_bid(); it < 256; it += gridDim.x) { if (PHMASK & 64) { if (it & 2) gla2_item<1>(P, lds, j, it >> 5, (it >> 2) & 7, it & 1, wv); else gla2_item<0>(P, lds, j, it >> 5, (it >> 2) & 7, it & 1, wv); } }
        }
        return;
    }
    if (sub == 3) {
        const Params P = load_params(lds);
        if (!even) { if (PHMASK & 256) phase_readout(P, j, wv); }
#if defined(SPLIT_ATTN)
        else { for (int it = get_bid(); it < 576; it += gridDim.x) attn_item(P, lds, j, it, wv); }
#endif
        return;
    }
    {
        const Params P = load_params(lds); bf16_t* pbuf = (bf16_t*)(P.ws + WS_P);
        const int K = even ? 2048 : 1024, lda = even ? EVEN_IN : ODD_IN;
        pg8::Gemm gm{pbuf + (even ? 1536 : 4096), (const bf16_t*)(P.ws + WS_WOUT), MROWS, 1024, K, lda};
        pg8::StaticOrder S; S.init(NB * SEQ, 1024, (int)gridDim.x, get_bid(), 1);
        const float* hl = layer == 0 ? P.x : P.out; const float* hc = layer == 0 ? P.ctx : (const float*)(P.ws + WS_HCTX);
        const float* modb = (const float*)(P.ws + WS_MOD);
        EpiResidNorm E{hl, P.out, modb + (size_t)layer * 9 * 3072 + 2048, layer < 3 ? P.norm_w + (layer + 1) * 1024 : P.final_norm_w,
                       layer < 3 ? modb + (size_t)(layer + 1) * 9 * 3072 : nullptr, (bf16_t*)(P.ws + WS_OV), (float*)(P.ws + WS_AGG), (unsigned*)(P.ws + WS_CTL) + 12288 + layer * 1024};
        if (PHMASK & 512) pg8::gemm_phase<EpiResidNorm, pg8::StaticOrder, false, true>(lds, gm, S, E, wv);
        if (layer < 3) {
            for (int t = get_bid(); t < 256; t += gridDim.x) {
                const int mt = t >> 3, nt = t & 7, mc0 = 64 * mt, bctx = mc0 >> 8, n0 = 128 * nt;
                const bf16_t* At = pbuf + ((size_t)bctx * LT + (mc0 & 255)) * lda + (even ? 1536 : 4096);
                const float* gctx = (const float*)(P.ws + WS_MOD) + (size_t)layer * 9 * 3072 + 2048 + 8 * 3072;
                float* hco = (float*)(P.ws + WS_HCTX);
                auto epi = [&](const f32x16& acc, int row0, int col, int hh) {
                    const float gate = gctx[n0 + col];
#pragma unroll
                    for (int i = 0; i < 16; ++i) { const size_t off = (size_t)(mc0 + row0 + crow(i, hh)) * DM + n0 + col; hco[off] = hc[off] + gate * acc[i]; }
                };
                mini_gemm_tile(lds, At, lda, (const bf16_t*)(P.ws + WS_WOUT) + (size_t)n0 * K, K, epi, wv);
            }
        }
    }
}

__global__ void __launch_bounds__(512, 2) mega(Params P) {
    extern __shared__ __attribute__((aligned(16))) unsigned char lds_raw[];
    LAS unsigned char* lds = (LAS unsigned char*)lds_raw;
    cg::grid_group grid = cg::this_grid();
    const int wv = __builtin_amdgcn_readfirstlane((int)(threadIdx.x >> 6));
    if (get_tid(wv) == 0) {
#if defined(TP_ID)
        ((LAS unsigned long long*)(lds + 163840 - 32))[0] = 0ull; ((LAS unsigned long long*)(lds + 163840 - 32))[1] = 0ull;
#endif
        ((LAS unsigned*)(lds + PARAM_OFF + 208))[0] = 0u; ((LAS unsigned*)(lds + PARAM_OFF + 208))[1] = 0u;
        LAS unsigned long long* d = (LAS unsigned long long*)(lds + PARAM_OFF);
        d[0] = (unsigned long long)P.x; d[1] = (unsigned long long)P.c; d[2] = (unsigned long long)P.ctx; d[3] = (unsigned long long)P.c_ctx; d[4] = (unsigned long long)P.ada_w;
        d[5] = (unsigned long long)P.ada_b; d[6] = (unsigned long long)P.norm_w; d[7] = (unsigned long long)P.ev_w_in; d[8] = (unsigned long long)P.ev_conv_w; d[9] = (unsigned long long)P.ev_conv_b;
        d[10] = (unsigned long long)P.ev_rg_wx; d[11] = (unsigned long long)P.ev_rg_bx; d[12] = (unsigned long long)P.ev_rg_wa; d[13] = (unsigned long long)P.ev_rg_ba; d[14] = (unsigned long long)P.ev_rg_lambda;
        d[15] = (unsigned long long)P.ev_sink; d[16] = (unsigned long long)P.ev_w_out; d[17] = (unsigned long long)P.od_w_in; d[18] = (unsigned long long)P.od_lb_raw; d[19] = (unsigned long long)P.od_gnorm_w;
        d[20] = (unsigned long long)P.od_w_out; d[21] = (unsigned long long)P.final_norm_w; d[22] = (unsigned long long)P.out; d[23] = (unsigned long long)P.ws;
    }
    __syncthreads();
    const int ph_lo = P.ph_lo, ph_hi = P.ph_hi;
    (void)xcd_barrier_post((unsigned*)(P.ws + WS_CTL) + 4096, (volatile LAS unsigned*)(lds + PARAM_OFF + 208), wv);
#define GRID_SYNC(first) do { if (first) grid.sync(); else { XcdBarrier xb_; xb_.bar = (unsigned*)(load_params(lds).ws + WS_CTL) + 4096; xb_.x = xb_xcc_id(); xb_.st = (volatile LAS unsigned*)(lds + PARAM_OFF + 208); xcd_barrier(xb_, wv); } } while (0)
#if defined(PROBE_S)
    constexpr int PREP = PROBE_E - PROBE_S + 1;
#pragma unroll 1
    for (int seq = ph_lo; seq < ph_hi + PREP; ++seq) {
        if (seq > ph_lo) GRID_SYNC(seq == ph_lo + 1);
        const int ph = seq <= PROBE_E ? seq : seq - PREP;
        run_phase(lds, ph, wv);
    }
#else
#pragma unroll 1
    for (int ph = ph_lo; ph < ph_hi; ++ph) {
#if !defined(SPLIT_ATTN)
        if (ph >= 1 && ph < NPHASE - 1 && (ph - 1) % 5 == 3 && (((ph - 1) / 5) & 1) == 0) continue;
#endif
        TP_START(200, lds, get_tid(wv));
        if (ph > ph_lo) GRID_SYNC(ph == ph_lo + 1);
        TP_STOP(200, lds, get_tid(wv));
#if defined(TP_ID)
        const int kid_ = ph == 0 ? 207 : ((ph - 1) % 5 == 0 ? 205 : ((ph - 1) % 5 == 1 ? 201 : ((ph - 1) % 5 == 2 ? ((((ph - 1) / 5) & 1) ? 203 : 202) : ((ph - 1) % 5 == 3 ? 206 : 204))));
        if (kid_ == TP_ID) TP_START(TP_ID, lds, get_tid(wv));
#endif
        run_phase(lds, ph, wv);
#if defined(TP_ID)
        if (kid_ == TP_ID) TP_STOP(TP_ID, lds, get_tid(wv));
#endif
    }
#endif
#if defined(TP_ID)
    if (get_tid(wv) == 0 && blockIdx.x == TP_BLOCK) {
        const unsigned long long acc = ((LAS unsigned long long*)(lds + 163840 - 32))[1], t0 = __builtin_amdgcn_s_memrealtime();
        while (__builtin_amdgcn_s_memrealtime() - t0 < (unsigned long long)TP_AMP * acc) __builtin_amdgcn_s_sleep(8);
    }
#endif
}

extern "C" void kernel_launch(void* const* d_in, const int* in_sizes, int n_in, void* d_out, int out_size, void* d_ws, size_t ws_size, hipStream_t stream) {
    static int grid = 0;
    if (grid == 0) {
        if (n_in != 22 || ws_size < WS_END) { fprintf(stderr, "kernel_launch: unexpected inputs (n_in %d, ws %zu)\n", n_in, ws_size); grid = -1; return; }
        int dev = 0, cus = 0, per_cu = 0;
        hipGetDevice(&dev);
        hipDeviceGetAttribute(&cus, hipDeviceAttributeMultiprocessorCount, dev);
        if (hipFuncSetAttribute((const void*)mega, hipFuncAttributeMaxDynamicSharedMemorySize, LDS_BYTES) != hipSuccess) { fprintf(stderr, "kernel_launch: hipFuncSetAttribute failed\n"); grid = -1; return; }
        if (hipOccupancyMaxActiveBlocksPerMultiprocessor(&per_cu, (const void*)mega, 512, LDS_BYTES) != hipSuccess || per_cu < 1) { fprintf(stderr, "kernel_launch: occupancy query gives %d\n", per_cu); per_cu = 1; }
        (void)hipGetLastError();
        if (cus < 256) { fprintf(stderr, "kernel_launch: this kernel needs 256 co-resident workgroups (device reports %d CUs)\n", cus); grid = -1; return; }
        grid = 256;
    }
    if (grid < 0) return;
    if (hipMemsetAsync((char*)d_ws + WS_CTL, 0, 65536, stream) != hipSuccess) { fprintf(stderr, "kernel_launch: memset failed\n"); return; }
    Params P{};
    const float** pp = (const float**)&P;
    for (int i = 0; i < 22; ++i) pp[i] = (const float*)d_in[i];
    P.out = (float*)d_out; P.ws = (unsigned char*)d_ws;
#if ONE_LAUNCH
    P.ph_lo = 0; P.ph_hi = NPHASE;
    { void* args[] = {&P}; hipError_t e = hipLaunchCooperativeKernel((const void*)mega, dim3(grid), dim3(512), args, LDS_BYTES, stream);
      if (e != hipSuccess) fprintf(stderr, "cooperative launch failed: %s (grid %d)\n", hipGetErrorString(e), grid); }
#else
    for (int ph = 0; ph < NPHASE; ++ph) {
        P.ph_lo = ph; P.ph_hi = ph + 1;
        void* args[] = {&P}; hipError_t e = hipLaunchCooperativeKernel((const void*)mega, dim3(grid), dim3(512), args, LDS_BYTES, stream);
        if (e != hipSuccess) { fprintf(stderr, "launch %d failed: %s (grid %d)\n", ph, hipGetErrorString(e), grid); break; }
    }
#endif
}
```

```cpp
#include <hip/hip_runtime.h>
#include <hip/hip_cooperative_groups.h>
#include <cstdio>
#include <cstdint>
namespace cg = cooperative_groups;

#ifndef ONE_LAUNCH
#define ONE_LAUNCH 1
#endif

#define DI __device__ __forceinline__
#define LAS __attribute__((address_space(3)))
__device__ __forceinline__ int lane_nh() { int l; asm volatile("v_mbcnt_lo_u32_b32 %0, -1, 0\n\tv_mbcnt_hi_u32_b32 %0, -1, %0" : "=v"(l)); return l; }
__device__ __forceinline__ int get_tid(int wv) { asm volatile("" : "+s"(wv)); return wv * 64 + lane_nh(); }
__device__ __forceinline__ float shfl_xor_f(float v, int o) { return __int_as_float(__builtin_amdgcn_ds_bpermute((lane_nh() ^ o) << 2, __float_as_int(v))); }
__device__ __forceinline__ int get_bid() { int b = blockIdx.x; asm volatile("" : "+s"(b)); return b; }

#if defined(TP_ID)
#ifndef TP_BLOCK
#define TP_BLOCK 5
#endif
#ifndef TP_AMP
#define TP_AMP 16
#endif
#define TP_START(id, lds, tid_) do { if ((id) == TP_ID) { __builtin_amdgcn_sched_barrier(0); if ((tid_) == 0 && blockIdx.x == TP_BLOCK) { ((LAS unsigned long long*)((lds) + 163840 - 32))[0] = __builtin_amdgcn_s_memrealtime(); } __builtin_amdgcn_sched_barrier(0); } } while (0)
#define TP_STOP(id, lds, tid_) do { if ((id) == TP_ID) { __builtin_amdgcn_sched_barrier(0); if ((tid_) == 0 && blockIdx.x == TP_BLOCK) { LAS unsigned long long* w_ = (LAS unsigned long long*)((lds) + 163840 - 32); w_[1] += __builtin_amdgcn_s_memrealtime() - w_[0]; } __builtin_amdgcn_sched_barrier(0); } } while (0)
#else
#define TP_START(id, lds, tid_) do { } while (0)
#define TP_STOP(id, lds, tid_) do { } while (0)
#endif
namespace pg8 {
#define PG8_LAS __attribute__((address_space(3)))
typedef unsigned short bf16_t;
typedef short bf16x8 __attribute__((ext_vector_type(8)));
typedef float f32x4 __attribute__((ext_vector_type(4)));
typedef unsigned u32x4 __attribute__((ext_vector_type(4)));
constexpr int BM = 256, BK = 64, HALF = 128, HTB = HALF * BK * 2  , STAGE_BYTES = 8 * HTB, NXCD = 8, WGM = 8;

__host__ __device__ __forceinline__ int lds_byte(int r, int c) { const int st = (r >> 4) * 2 + (c >> 5), rr = r & 15, cc = c & 31, ob = rr * 64 + cc * 2; return st * 1024 + (ob ^ (((ob >> 9) & 1) << 5)); }
__host__ __device__ __forceinline__ void stage_rc(int b, int& R, int& C) { const int st = b / 1024, sb = b % 1024, swz = sb ^ (((sb >> 9) & 1) << 5); R = (st >> 1) * 16 + swz / 64; C = (st & 1) * 32 + (swz % 64) / 2; }
__host__ __device__ __forceinline__ int perm32(int rho) { const int n = rho >> 4, i = rho & 15; return 8 * (i >> 2) + 4 * n + (i & 3); }

struct Unit { int pm, pn; };
struct Gemm { const bf16_t* A; const bf16_t* Bt; int M, N, K, lda; };

struct StaticOrder {
    int nM, nN, nwg, G, c, lat_only, limit;
    __host__ __device__ void init(int M, int N, int G_, int c_, int lat_only_ = 0) { nM = M / BM; nN = N / BM; nwg = nM * nN; G = G_; c = c_; lat_only = lat_only_; limit = nwg; }
    __host__ __device__ bool next(int i, Unit& u) const {
        const long L = (long)i * G + c; if (L >= limit) return false;
        tile_of((int)L, u); return true;
    }
    __host__ __device__ void tile_of(int L, Unit& u) const {
        int wgid = L; { const int q = nwg / NXCD, r = nwg % NXCD, xcd = wgid % NXCD, off = wgid / NXCD; wgid = (xcd < r ? xcd * (q + 1) : r * (q + 1) + (xcd - r) * q) + off; }
        const int nig = WGM * nN, gid = wgid / nig, fm = gid * WGM, gsz = (nM - fm) < WGM ? (nM - fm) : WGM;
        u.pm = fm + ((wgid % nig) % gsz); u.pn = (wgid % nig) / gsz; if (lat_only) u.pm = 9 * (u.pm >> 3) + 1 + (u.pm & 7);
    }
    __device__ __forceinline__ void a_ready(const Unit&) const {}
    __device__ __forceinline__ void done(const Unit&) const {}
};

template <class Epi, class Sched, bool ALIGN_EPI = false, bool SP2 = false>
__device__ __forceinline__ void gemm_phase(PG8_LAS unsigned char* lds, const Gemm g, const Sched& S, const Epi& E, int wv) {
    const int tid = get_tid(wv), wid = __builtin_amdgcn_readfirstlane(tid >> 6), lane = tid & 63, wr = wid >> 2, wc = wid & 3, fr = lane & 15, fq = lane >> 4;
    const int K = g.K, nt = K / BK;
    unsigned voffA[2], voffB[2];
#pragma unroll
    for (int i = 0; i < 2; ++i) { int R, C; stage_rc(tid * 16 + i * 8192, R, C); const int Rb = Epi::PERM ? ((R & ~31) + perm32(R & 31)) : R;
        voffA[i] = (unsigned)(R * g.lda + C) * 2u; voffB[i] = (unsigned)(Rb * K + C) * 2u; }
    const size_t kstep = (size_t)(BK * 2);
    const size_t hstepA = (size_t)HALF * g.lda * 2, hstepB = (size_t)HALF * K * 2;
    const size_t tstepA = 2 * hstepA, tstepB = 2 * hstepB;
    const unsigned ldsw = (unsigned)wid * 1024u;
    const int aoff = lds_byte(wr * 64 + fr, fq * 8), boff = lds_byte(wc * 32 + fr, fq * 8);
#define PG8_SA(b, h) (((b) * 2 + (h)) * HTB)
#define PG8_SB(b, h) ((4 + (b) * 2 + (h)) * HTB)
#define PG8_STAGE(bufoff, gbase, voff) do { _Pragma("unroll") for (int _i = 0; _i < 2; ++_i) \
        __builtin_amdgcn_global_load_lds((const unsigned*)((const char*)(gbase) + (voff)[_i]), (PG8_LAS unsigned*)(lds + (bufoff) + ldsw + _i * 8192), 16, 0, 0); } while (0)
#define PG8_LDA(dst, b, h) do { _Pragma("unroll") for (int m = 0; m < 4; ++m) _Pragma("unroll") for (int k = 0; k < 2; ++k) dst[m][k] = *(const PG8_LAS bf16x8*)(lds + PG8_SA(b, h) + aoff + m * 2048 + k * 1024); } while (0)
#define PG8_LDB(dst, b, h) do { _Pragma("unroll") for (int n = 0; n < 2; ++n) _Pragma("unroll") for (int k = 0; k < 2; ++k) dst[n][k] = *(const PG8_LAS bf16x8*)(lds + PG8_SB(b, h) + boff + n * 2048 + k * 1024); } while (0)
#define PG8_MMA(ai, bj, At, Bt) do { __builtin_amdgcn_s_setprio(1); _Pragma("unroll") for (int m = 0; m < 4; ++m) _Pragma("unroll") for (int n = 0; n < 2; ++n) _Pragma("unroll") for (int k = 0; k < 2; ++k) \
        acc[ai][bj][m][n] = __builtin_amdgcn_mfma_f32_16x16x32_bf16(Bt[n][k], At[m][k], acc[ai][bj][m][n], 0, 0, 0); __builtin_amdgcn_s_setprio(0); } while (0)
#define PG8_WAIT_V(n) asm volatile("s_waitcnt vmcnt(" #n ")" ::: "memory")
#define PG8_WAIT_L(n) asm volatile("s_waitcnt lgkmcnt(" #n ")" ::: "memory")
#define PG8_BAR __builtin_amdgcn_s_barrier()
#define PG8_SCHED __builtin_amdgcn_sched_barrier(0)
    Unit cur, nxt; int ui = 0;
    if (!S.next(0, cur)) return;
    f32x4 acc[2][2][4][2];
#pragma unroll
    for (int a = 0; a < 2; ++a)
#pragma unroll
        for (int b = 0; b < 2; ++b)
#pragma unroll
            for (int m = 0; m < 4; ++m)
#pragma unroll
                for (int n = 0; n < 2; ++n) acc[a][b][m][n] = (f32x4){0.f, 0.f, 0.f, 0.f};
    bf16x8 At[4][2], B0[2][2], B1[2][2];
    const char* cA = (const char*)g.A + (size_t)cur.pm * tstepA; const char* cB = (const char*)g.Bt + (size_t)cur.pn * tstepB;
    S.a_ready(cur);
    if constexpr (SP2) {
        PG8_STAGE(PG8_SB(0, 0), cB, voffB); PG8_STAGE(PG8_SB(0, 1), cB + hstepB, voffB); PG8_STAGE(PG8_SA(0, 0), cA, voffA); PG8_STAGE(PG8_SA(0, 1), cA + hstepA, voffA);
        if (wr == 1) PG8_BAR;
        PG8_WAIT_V(2); PG8_BAR;
        PG8_STAGE(PG8_SB(1, 0), cB + kstep, voffB); PG8_STAGE(PG8_SA(1, 0), cA + kstep, voffA); PG8_STAGE(PG8_SB(1, 1), cB + hstepB + kstep, voffB);
        PG8_WAIT_V(6); PG8_BAR;
    } else {
        PG8_STAGE(PG8_SB(0, 0), cB, voffB); PG8_STAGE(PG8_SA(0, 0), cA, voffA); PG8_STAGE(PG8_SB(0, 1), cB + hstepB, voffB); PG8_STAGE(PG8_SA(0, 1), cA + hstepA, voffA);
        if (wr == 1) PG8_BAR;
        PG8_WAIT_V(4); PG8_BAR;
        PG8_STAGE(PG8_SB(1, 0), cB + kstep, voffB); PG8_STAGE(PG8_SA(1, 0), cA + kstep, voffA); PG8_STAGE(PG8_SB(1, 1), cB + hstepB + kstep, voffB);
        PG8_WAIT_V(6); PG8_BAR;
    }
    for (;;) {
        const bool has_next = S.next(ui + 1, nxt);
        const char* nA = has_next ? (const char*)g.A + (size_t)nxt.pm * tstepA : cA; const char* nB = has_next ? (const char*)g.Bt + (size_t)nxt.pn * tstepB : cB;
        for (int t = 0; t < nt; t += 2) {
            const bool last = (t == nt - 2);
            const char* a1 = cA + (size_t)(t + 1) * kstep;
            const char* a2 = last ? nA : cA + (size_t)(t + 2) * kstep; const char* b2 = last ? nB : cB + (size_t)(t + 2) * kstep;
            const char* a3 = a2 + kstep; const char* b3 = b2 + kstep;
            if (last && has_next) S.a_ready(nxt);
            if constexpr (SP2) {
            PG8_LDB(B0, 0, 0); PG8_LDB(B1, 0, 1); PG8_SCHED; PG8_LDA(At, 0, 0); PG8_STAGE(PG8_SA(1, 1), a1 + hstepA, voffA);
            PG8_WAIT_V(8); PG8_WAIT_L(0); PG8_BAR; PG8_MMA(0, 0, At, B0); PG8_MMA(0, 1, At, B1); PG8_BAR; PG8_SCHED;
            PG8_LDA(At, 0, 1); PG8_STAGE(PG8_SB(0, 0), b2, voffB); PG8_STAGE(PG8_SB(0, 1), b2 + hstepB, voffB); PG8_STAGE(PG8_SA(0, 0), a2, voffA);
            PG8_WAIT_V(8); PG8_WAIT_L(0); PG8_BAR; PG8_MMA(1, 0, At, B0); PG8_MMA(1, 1, At, B1); PG8_BAR; PG8_SCHED;
            PG8_LDB(B0, 1, 0); PG8_LDB(B1, 1, 1); PG8_SCHED; PG8_LDA(At, 1, 0); PG8_STAGE(PG8_SA(0, 1), a2 + hstepA, voffA);
            PG8_WAIT_V(8); PG8_WAIT_L(0); PG8_BAR; PG8_MMA(0, 0, At, B0); PG8_MMA(0, 1, At, B1); PG8_BAR; PG8_SCHED;
            PG8_LDA(At, 1, 1); PG8_STAGE(PG8_SB(1, 0), b3, voffB); PG8_STAGE(PG8_SB(1, 1), b3 + hstepB, voffB); PG8_STAGE(PG8_SA(1, 0), a3, voffA);
            PG8_WAIT_V(8); PG8_WAIT_L(0); PG8_BAR; PG8_MMA(1, 0, At, B0); PG8_MMA(1, 1, At, B1); PG8_BAR; PG8_SCHED;
            } else {
            PG8_LDB(B0, 0, 0); PG8_SCHED; PG8_LDA(At, 0, 0); PG8_STAGE(PG8_SA(1, 1), a1 + hstepA, voffA);
            PG8_WAIT_L(8); PG8_BAR; PG8_WAIT_L(0); PG8_MMA(0, 0, At, B0); PG8_BAR; PG8_SCHED;
            PG8_LDB(B1, 0, 1); PG8_STAGE(PG8_SB(0, 0), b2, voffB);
            PG8_BAR; PG8_WAIT_L(0); PG8_MMA(0, 1, At, B1); PG8_BAR;
            PG8_LDA(At, 0, 1); PG8_STAGE(PG8_SA(0, 0), a2, voffA);
            PG8_BAR; PG8_WAIT_L(0); PG8_MMA(1, 0, At, B0); PG8_BAR; PG8_SCHED;
            PG8_STAGE(PG8_SB(0, 1), b2 + hstepB, voffB);
            PG8_WAIT_V(6); PG8_BAR; PG8_MMA(1, 1, At, B1); PG8_BAR;
            PG8_LDB(B0, 1, 0); PG8_SCHED; PG8_LDA(At, 1, 0); PG8_STAGE(PG8_SA(0, 1), a2 + hstepA, voffA);
            PG8_WAIT_L(8); PG8_BAR; PG8_WAIT_L(0); PG8_MMA(0, 0, At, B0); PG8_BAR; PG8_SCHED;
            PG8_LDB(B1, 1, 1); PG8_STAGE(PG8_SB(1, 0), b3, voffB);
            PG8_BAR; PG8_WAIT_L(0); PG8_MMA(0, 1, At, B1); PG8_BAR;
            PG8_LDA(At, 1, 1); PG8_STAGE(PG8_SA(1, 0), a3, voffA);
            PG8_BAR; PG8_WAIT_L(0); PG8_MMA(1, 0, At, B0); PG8_BAR; PG8_SCHED;
            PG8_STAGE(PG8_SB(1, 1), b3 + hstepB, voffB);
            PG8_WAIT_V(6); PG8_BAR; PG8_MMA(1, 1, At, B1); PG8_BAR;
            }
        }
        if constexpr (ALIGN_EPI) { if (wr == 0) PG8_BAR; }
        if constexpr (!Epi::AFTER_DRAIN) { E(acc, cur, wr, wc, fr, fq); S.done(cur); }
        if (!has_next) break;
#pragma unroll
        for (int a = 0; a < 2; ++a)
#pragma unroll
            for (int b = 0; b < 2; ++b)
#pragma unroll
                for (int m = 0; m < 4; ++m)
#pragma unroll
                    for (int n = 0; n < 2; ++n) acc[a][b][m][n] = (f32x4){0.f, 0.f, 0.f, 0.f};
        cur = nxt; cA = nA; cB = nB; ++ui;
        if constexpr (ALIGN_EPI) { if (wr == 1) PG8_BAR; }
    }
    PG8_WAIT_V(0);
    if constexpr (!ALIGN_EPI) { if (wr == 0) PG8_BAR; }
    PG8_BAR;
    if constexpr (Epi::AFTER_DRAIN) { E.fused(acc, cur, wr, wc, fr, fq, lds, wid, lane); S.done(cur); }
#undef PG8_SA
#undef PG8_SB
#undef PG8_STAGE
#undef PG8_LDA
#undef PG8_LDB
#undef PG8_MMA
#undef PG8_WAIT_V
#undef PG8_WAIT_L
#undef PG8_BAR
#undef PG8_SCHED
}
}

typedef unsigned short bf16_t;
typedef short bf16x8 __attribute__((ext_vector_type(8)));
typedef short s16x4 __attribute__((ext_vector_type(4)));
typedef float f32x4 __attribute__((ext_vector_type(4)));
typedef float f32x16 __attribute__((ext_vector_type(16)));
typedef unsigned u32x4 __attribute__((ext_vector_type(4)));
typedef unsigned u32x2 __attribute__((ext_vector_type(2)));
typedef float f32x2 __attribute__((ext_vector_type(2)));

constexpr int DM = 1024, NB = 8, SEQ = 2048, CTXL = 256, LT = SEQ + CTXL  , MROWS = NB * LT  ;
constexpr int EVEN_IN = 4608, ODD_IN = 5120, NCHUNK = LT / 64  ;
constexpr float RMS_EPS = 1e-6f, LOG2E = 1.4426950408889634f;
constexpr int LDS_BYTES = 160 * 1024;
constexpr int NPHASE = 21;

constexpr size_t WS_CTL = 0;
constexpr size_t WS_MOD = 65536;
constexpr size_t WS_ROPE = 524288;
constexpr size_t WS_AGG = 1048576;
constexpr size_t WS_HCTX = WS_AGG + 4718592;
constexpr size_t WS_WIN = WS_HCTX + 8388608;
constexpr size_t WS_WOUT = WS_WIN + 10485760;
constexpr size_t WS_WRG = WS_WOUT + 4194304;
constexpr size_t WS_OV = WS_WRG + 1048576;
constexpr size_t WS_P = WS_OV + 37748736;
constexpr size_t WS_END = WS_P + 188743680;
static_assert(WS_END <= 268435456, "workspace map exceeds 256 MiB");

struct Params {
    const float *x, *c, *ctx, *c_ctx, *ada_w, *ada_b, *norm_w, *ev_w_in, *ev_conv_w, *ev_conv_b, *ev_rg_wx, *ev_rg_bx, *ev_rg_wa, *ev_rg_ba,
        *ev_rg_lambda, *ev_sink, *ev_w_out, *od_w_in, *od_lb_raw, *od_gnorm_w, *od_w_out, *final_norm_w;
    float* out; unsigned char* ws; int ph_lo, ph_hi;
};

DI float bf2f(unsigned short v) { return __uint_as_float((unsigned)v << 16); }
DI unsigned f2bf(float f) { unsigned u = __float_as_uint(f); return (u + 0x7fffu + ((u >> 16) & 1u)) >> 16; }
typedef __bf16 bf16x2_hw __attribute__((ext_vector_type(2)));
DI unsigned pk2(float lo, float hi) { const f32x2 v = {lo, hi}; return __builtin_bit_cast(unsigned, __builtin_convertvector(v, bf16x2_hw)); }
DI float sigm(float x) { return __builtin_amdgcn_rcpf(1.f + __expf(-x)); }
DI float softplus_neg(float lam) {
    const float e = __expf(-lam);
    return e < 0.06f ? e * (1.f + e * (-0.5f + e * (0.33333333f + e * (-0.25f + e * 0.2f)))) : __logf(1.f + e);
}
DI float neg_expm1(float x) {
    return x > -0.25f ? -x * (1.f + x * (0.5f + x * (0.16666667f + x * (0.041666668f + x * (0.0083333338f + x * 0.0013888889f))))) : 1.f - __expf(x);
}
DI float wave_sum(float v) {
#pragma unroll
    for (int o = 1; o < 64; o <<= 1) v += shfl_xor_f(v, o);
    return v;
}
DI int crow(int reg, int h) { return (reg & 3) + 8 * (reg >> 2) + 4 * h; }
#define MFMA16(a, b, c) __builtin_amdgcn_mfma_f32_16x16x32_bf16((a), (b), (c), 0, 0, 0)
#define MFMA32(a, b, c) __builtin_amdgcn_mfma_f32_32x32x16_bf16((a), (b), (c), 0, 0, 0)

struct EpiStoreBf16 {
    static constexpr bool PERM = true, AFTER_DRAIN = false;
    bf16_t* O; int ldc;
    DI void operator()(const f32x4 (&acc)[2][2][4][2], const pg8::Unit& u, int wr, int wc, int fr, int fq) const {
        const int row0 = u.pm * 256 + wr * 64 + fr, col0 = u.pn * 256 + wc * 32 + 8 * fq;
#pragma unroll
        for (int ai = 0; ai < 2; ++ai)
#pragma unroll
            for (int m = 0; m < 4; ++m) { bf16_t* rowp = O + (size_t)(row0 + ai * 128 + m * 16) * ldc + col0;
#pragma unroll
                for (int bj = 0; bj < 2; ++bj) { const f32x4 v0 = acc[ai][bj][m][0], v1 = acc[ai][bj][m][1];
                    u32x4 w; w.x = pk2(v0[0], v0[1]); w.y = pk2(v0[2], v0[3]); w.z = pk2(v1[0], v1[1]); w.w = pk2(v1[2], v1[3]);
                    *(u32x4*)(rowp + bj * 128) = w; } }
    }
};
struct EpiResid {
    static constexpr bool PERM = false, AFTER_DRAIN = false;
    const float* in_lat; const float* in_ctx; float* out_lat; float* out_ctx; const float* gate;
    DI void operator()(const f32x4 (&acc)[2][2][4][2], const pg8::Unit& u, int wr, int wc, int fr, int fq) const {
        const int b = u.pm / 9, jt = u.pm % 9;
        const float* ib; float* ob; const float* g;
        if (jt == 0) { const size_t off = (size_t)b * CTXL * DM; ib = in_ctx + off; ob = out_ctx + off; g = gate + 8 * 3072; }
        else { const size_t off = ((size_t)b * SEQ + (size_t)(jt - 1) * 256) * DM; ib = in_lat + off; ob = out_lat + off; g = gate + b * 3072; }
        const int col0 = u.pn * 256 + wc * 32 + 4 * fq;
#pragma unroll
        for (int bj = 0; bj < 2; ++bj)
#pragma unroll
            for (int n = 0; n < 2; ++n) {
                const f32x4 gvv = *(const f32x4*)(g + col0 + bj * 128 + n * 16);
#pragma unroll
                for (int ai = 0; ai < 2; ++ai) {
#pragma unroll
                    for (int m = 0; m < 4; ++m) { const int r = ai * 128 + wr * 64 + m * 16 + fr;
                        const size_t off = (size_t)r * DM + col0 + bj * 128 + n * 16;
                        const f32x4 o = *(const f32x4*)(ib + off) + gvv * acc[ai][bj][m][n]; *(f32x4*)(ob + off) = o; }
                    asm volatile("" ::: "memory");
                }
            }
    }
};

struct EpiResidNorm {
    static constexpr bool PERM = false, AFTER_DRAIN = true;
    const float* in_lat; float* out_lat; const float* gate;
    const float* nw; const float* mod_next;
    bf16_t* U; float* xbuf; unsigned* cnt;
    DI void fused(f32x4 (&acc)[2][2][4][2], const pg8::Unit& u, int wr, int wc, int fr, int fq, LAS unsigned char* lds, int wid, int lane) const {
        const int b = u.pm / 9, jt = u.pm % 9, panel = b * 8 + jt - 1;
        const size_t roff = ((size_t)b * SEQ + (size_t)(jt - 1) * 256) * DM;
        const float* ib = in_lat + roff; float* ob = out_lat + roff; const float* g = gate + b * 3072;
        const int col0 = u.pn * 256 + wc * 32 + 4 * fq;
        LAS float* Pw = (LAS float*)lds;
        LAS float* Sr = (LAS float*)(lds + 4096);
        LAS unsigned* flag = (LAS unsigned*)(lds + 5120);
#pragma unroll
        for (int bj = 0; bj < 2; ++bj)
#pragma unroll
            for (int n = 0; n < 2; ++n) {
                const f32x4 gvv = *(const f32x4*)(g + col0 + bj * 128 + n * 16);
#pragma unroll
                for (int ai = 0; ai < 2; ++ai) {
#pragma unroll
                    for (int m = 0; m < 4; ++m) { const int r = ai * 128 + wr * 64 + m * 16 + fr;
                        const size_t off = (size_t)r * DM + col0 + bj * 128 + n * 16;
                        const f32x4 o = *(const f32x4*)(ib + off) + gvv * acc[ai][bj][m][n]; acc[ai][bj][m][n] = o;
                        if (mod_next) *(f32x4*)(ob + off) = o; }
                    asm volatile("" ::: "memory");
                }
            }
#pragma unroll
        for (int ai = 0; ai < 2; ++ai)
#pragma unroll
            for (int m = 0; m < 4; ++m) {
                float s = 0.f;
#pragma unroll
                for (int bj = 0; bj < 2; ++bj)
#pragma unroll
                    for (int n = 0; n < 2; ++n) { const f32x4 x = acc[ai][bj][m][n]; s += (x[0] * x[0] + x[1] * x[1]) + (x[2] * x[2] + x[3] * x[3]); }
                s += shfl_xor_f(s, 16); s += shfl_xor_f(s, 32);
                if (fq == 0) Pw[(ai * 128 + wr * 64 + m * 16 + fr) * 4 + wc] = s;
            }
        asm volatile("s_waitcnt lgkmcnt(0)" ::: "memory"); __builtin_amdgcn_s_barrier(); asm volatile("" ::: "memory");
        const int row = wid * 32 + (lane & 31);
        if (lane < 32) {
            const float t = (Pw[row * 4 + 0] + Pw[row * 4 + 1]) + (Pw[row * 4 + 2] + Pw[row * 4 + 3]);
            __hip_atomic_store((unsigned*)xbuf + ((size_t)panel * 256 + row) * 4 + u.pn, __float_as_uint(t), __ATOMIC_RELAXED, __HIP_MEMORY_SCOPE_AGENT);
        }
        asm volatile("s_waitcnt vmcnt(0)" ::: "memory");
        if (lane == 0) __hip_atomic_fetch_add(cnt + 16 * panel, 1u, __ATOMIC_RELAXED, __HIP_MEMORY_SCOPE_AGENT);
        if (wid == 0) {
            unsigned spins = 0;
            while ((unsigned)__builtin_amdgcn_readfirstlane(__hip_atomic_load(cnt + 16 * panel, __ATOMIC_RELAXED, __HIP_MEMORY_SCOPE_AGENT)) < 32u) { __builtin_amdgcn_s_sleep(2); if (++spins > (1u << 22)) break; }
            if (lane == 0) flag[0] = 1u;
        }
        asm volatile("s_waitcnt vmcnt(0) lgkmcnt(0)" ::: "memory"); __builtin_amdgcn_s_barrier(); asm volatile("" ::: "memory");
        if (lane < 32) {
            const unsigned* slot = (const unsigned*)xbuf + ((size_t)panel * 256 + row) * 4;
            const float t = (__uint_as_float(__hip_atomic_load(slot + 0, __ATOMIC_RELAXED, __HIP_MEMORY_SCOPE_AGENT)) + __uint_as_float(__hip_atomic_load(slot + 1, __ATOMIC_RELAXED, __HIP_MEMORY_SCOPE_AGENT)))
                          + (__uint_as_float(__hip_atomic_load(slot + 2, __ATOMIC_RELAXED, __HIP_MEMORY_SCOPE_AGENT)) + __uint_as_float(__hip_atomic_load(slot + 3, __ATOMIC_RELAXED, __HIP_MEMORY_SCOPE_AGENT)));
            Sr[row] = rsqrtf(t * (1.f / DM) + RMS_EPS);
        }
        asm volatile("s_waitcnt lgkmcnt(0)" ::: "memory"); __builtin_amdgcn_s_barrier(); asm volatile("" ::: "memory");
        const float* sh = mod_next ? mod_next + b * 3072 : nullptr;
#pragma unroll
        for (int bj = 0; bj < 2; ++bj)
#pragma unroll
            for (int n = 0; n < 2; ++n) {
                const int cc = col0 + bj * 128 + n * 16;
                const f32x4 w4 = *(const f32x4*)(nw + cc);
                f32x4 s4 = {1.f, 1.f, 1.f, 1.f}, h4 = {0.f, 0.f, 0.f, 0.f};
                if (mod_next) { s4 = *(const f32x4*)(sh + 1024 + cc) + 1.f; h4 = *(const f32x4*)(sh + cc); }
#pragma unroll
                for (int ai = 0; ai < 2; ++ai)
#pragma unroll
                    for (int m = 0; m < 4; ++m) { const int r = ai * 128 + wr * 64 + m * 16 + fr;
                        const f32x4 y = (acc[ai][bj][m][n] * Sr[r]) * w4;
                        if (mod_next) { const f32x4 o = y * s4 + h4; u32x2 w; w.x = pk2(o[0], o[1]); w.y = pk2(o[2], o[3]); *(u32x2*)(U + ((size_t)u.pm * 256 + r) * DM + cc) = w; }
                        else *(f32x4*)(ob + (size_t)r * DM + cc) = y; }
            }
    }
};

constexpr int MG_STAGE = 52224;
template <class EpiF>
DI void mini_gemm_tile(LAS unsigned char* lds, const bf16_t* A, int lda, const bf16_t* Bt, int K, const EpiF& epi, int wv) {
    const int tid = get_tid(wv), lane = tid & 63, wave = tid >> 6, r = lane & 31, h = lane >> 5, wm = wave >> 2, wn = wave & 3;
    const int lrow = tid >> 4, lch = tid & 15, nS = K / 128;
    const bf16_t* ap = A + (size_t)lrow * lda + 8 * lch;
    const bf16_t* bp = Bt + (size_t)lrow * K + 8 * lch;
    u32x4 s0[6], s1[6];
    f32x16 acc;
#pragma unroll
    for (int i = 0; i < 16; ++i) acc[i] = 0.f;
#define MG_LOAD(set, s) do { (set)[0] = *(const u32x4*)(ap + (s) * 128); (set)[1] = *(const u32x4*)(ap + (size_t)32 * lda + (s) * 128); \
        _Pragma("unroll") for (int q_ = 0; q_ < 4; ++q_) (set)[2 + q_] = *(const u32x4*)(bp + (size_t)(32 * q_) * K + (s) * 128); } while (0)
#define MG_STORE(set, buf) do { LAS unsigned char* b_ = lds + (buf) * MG_STAGE; *(LAS u32x4*)(b_ + lrow * 272 + lch * 16) = (set)[0]; *(LAS u32x4*)(b_ + (32 + lrow) * 272 + lch * 16) = (set)[1]; \
        _Pragma("unroll") for (int q_ = 0; q_ < 4; ++q_) *(LAS u32x4*)(b_ + 17408 + (32 * q_ + lrow) * 272 + lch * 16) = (set)[2 + q_]; } while (0)
#define MG_COMPUTE(buf) do { const LAS unsigned char* b_ = lds + (buf) * MG_STAGE; \
        _Pragma("unroll") for (int ks = 0; ks < 8; ++ks) { \
            const bf16x8 af = *(const LAS bf16x8*)(b_ + (32 * wm + r) * 272 + (16 * ks + 8 * h) * 2); \
            const bf16x8 bf = *(const LAS bf16x8*)(b_ + 17408 + (32 * wn + r) * 272 + (16 * ks + 8 * h) * 2); \
            acc = MFMA32(af, bf, acc); } } while (0)
    MG_LOAD(s0, 0); MG_LOAD(s1, 1);
    __syncthreads();
    MG_STORE(s0, 0);
    if (nS > 2) MG_LOAD(s0, 2);
#pragma unroll 1
    for (int s = 0; s < nS; s += 2) {
        __syncthreads();
        if (s + 1 < nS) { MG_STORE(s1, 1); if (s + 3 < nS) MG_LOAD(s1, s + 3); }
        MG_COMPUTE(0);
        __syncthreads();
        if (s + 2 < nS) { MG_STORE(s0, 0); if (s + 4 < nS) MG_LOAD(s0, s + 4); }
        if (s + 1 < nS) MG_COMPUTE(1);
    }
#undef MG_LOAD
#undef MG_STORE
#undef MG_COMPUTE
    epi(acc, 32 * wm, 32 * wn + r, h);
    __syncthreads();
}

DI void phase_pro(const Params& P, LAS unsigned char* lds, int wv) {
    const int tid = get_tid(wv);
    LAS float* s = (LAS float*)lds;
    LAS float* red = (LAS float*)(lds + 36864);
    float* mod = (float*)(P.ws + WS_MOD);
    for (int i = tid; i < 9 * 1024; i += 512) { const int r = i >> 10, k = i & 1023; const float v = r < 8 ? P.c[r * 1024 + k] : P.c_ctx[k]; s[i] = v * sigm(v); }
    __syncthreads();
    {
        const int ks = tid >> 4, col = tid & 15;
        float wv[3][32];
#pragma unroll
        for (int q = 0; q < 3; ++q) {
            const int item = get_bid() + q * (int)gridDim.x;
            if (item < 768) {
                const int l = item / 192, n0 = (item % 192) * 16;
                const float* w = P.ada_w + (size_t)l * 1024 * 3072 + (size_t)(ks * 32) * 3072 + n0 + col;
#pragma unroll
                for (int kk = 0; kk < 32; ++kk) wv[q][kk] = w[(size_t)kk * 3072];
            }
        }
#pragma unroll
        for (int q = 0; q < 3; ++q) {
            const int item = get_bid() + q * (int)gridDim.x;
            if (item < 768) {
                const int l = item / 192, n0 = (item % 192) * 16;
                float acc[9];
#pragma unroll
                for (int r = 0; r < 9; ++r) acc[r] = 0.f;
#pragma unroll
                for (int kk = 0; kk < 32; ++kk) {
#pragma unroll
                    for (int r = 0; r < 9; ++r) acc[r] += s[r * 1024 + ks * 32 + kk] * wv[q][kk]; }
#pragma unroll
                for (int r = 0; r < 9; ++r) red[(ks * 9 + r) * 16 + col] = acc[r];
                __syncthreads();
                if (tid < 144) { const int r = tid >> 4, cc = tid & 15; float sum = 0.f;
#pragma unroll
                    for (int k2 = 0; k2 < 32; ++k2) sum += red[(k2 * 9 + r) * 16 + cc];
                    mod[(l * 9 + r) * 3072 + n0 + cc] = sum + P.ada_b[l * 3072 + n0 + cc]; }
                __syncthreads();
            }
        }
    }
    float* cos_t = (float*)(P.ws + WS_ROPE); float* sin_t = cos_t + SEQ * 32;
    for (int i = get_bid() * 512 + tid; i < SEQ * 32; i += gridDim.x * 512) {
        const int pos = i >> 5, jj = i & 31, fi = jj & 15;
        const float inv = __builtin_amdgcn_exp2f(-(float)(2 * fi) * (13.287712379549449f / 32.f));
        const float ang = (float)(jj < 16 ? (pos >> 6) : (pos & 63)) * inv;
        cos_t[i] = __cosf(ang); sin_t[i] = __sinf(ang);
    }
}

template <bool FRAG = false>
DI void transpose_item(const float* W, int K, int N, bf16_t* WT, LAS float* scr, int item, int lane) {
    const int nblk = N / 32, kb = item / nblk, nb = item % nblk, k0 = 64 * kb, n0 = 32 * nb;
#pragma unroll 8
    for (int i = 0; i < 32; ++i) { const int kk = 2 * i + (lane >> 5); scr[kk * 33 + (lane & 31)] = W[(size_t)(k0 + kk) * N + n0 + (lane & 31)]; }
    asm volatile("s_waitcnt lgkmcnt(0)" ::: "memory");
    const int c = lane & 7;
#pragma unroll
    for (int j = 0; j < 4; ++j) { const int n = (lane >> 3) + 8 * j; const LAS float* sp = scr + (8 * c) * 33 + n;
        u32x4 o; o.x = pk2(sp[0 * 33], sp[1 * 33]); o.y = pk2(sp[2 * 33], sp[3 * 33]); o.z = pk2(sp[4 * 33], sp[5 * 33]); o.w = pk2(sp[6 * 33], sp[7 * 33]);
        if (FRAG) {
            const int nn = n0 + n, k8 = (k0 >> 3) + c;
            *(u32x4*)(WT + ((((nn >> 4) * 4 + (k8 >> 2)) * 64 + (k8 & 3) * 16 + (nn & 15)) * 8)) = o;
        } else *(u32x4*)(WT + (size_t)(n0 + n) * K + k0 + 8 * c) = o; }
    asm volatile("s_waitcnt lgkmcnt(0)" ::: "memory");
}

DI void phase_convert(const Params& P, LAS unsigned char* lds, int layer, int wv) {
    const int tid = get_tid(wv), lane = tid & 63, wave = tid >> 6;
    const int gw = get_bid() * 8 + wave, NGW = gridDim.x * 8;
    const int j = layer >> 1;
    LAS float* scr = (LAS float*)(lds + wave * 16384);
    bf16_t* WIN = (bf16_t*)(P.ws + WS_WIN); bf16_t* WOUT = (bf16_t*)(P.ws + WS_WOUT); bf16_t* WRG = (bf16_t*)(P.ws + WS_WRG);
    if ((layer & 1) == 0) {
        constexpr int I_IN = 16 * (EVEN_IN / 32), I_OUT = 32 * 32, I_RG = 32 * 8;
        for (int it = gw; it < I_IN + I_OUT + I_RG; it += NGW) {
            int r = it;
            if (r < I_IN) { transpose_item(P.ev_w_in + (size_t)j * 1024 * EVEN_IN, 1024, EVEN_IN, WIN, scr, r, lane); continue; } r -= I_IN;
            if (r < I_OUT) { transpose_item(P.ev_w_out + (size_t)j * 2048 * 1024, 2048, 1024, WOUT, scr, r, lane); continue; } r -= I_OUT;
            const int mat = r >> 3, sub = r & 7;
            const int dir = mat >> 4, gate = (mat >> 3) & 1, hd = mat & 7;
            const float* src = (gate == 0 ? P.ev_rg_wx : P.ev_rg_wa) + ((size_t)((j * 2 + dir) * 8 + hd)) * 16384;
            transpose_item<true>(src, 128, 128, WRG + (size_t)mat * 16384, scr, sub, lane);
        }
    } else {
        constexpr int I_IN = 16 * (ODD_IN / 32), I_OUT = 16 * 32;
        for (int it = gw; it < I_IN + I_OUT; it += NGW) {
            int r = it;
            if (r < I_IN) { transpose_item(P.od_w_in + (size_t)j * 1024 * ODD_IN, 1024, ODD_IN, WIN, scr, r, lane); continue; } r -= I_IN;
            transpose_item(P.od_w_out + (size_t)j * 1024 * 1024, 1024, 1024, WOUT, scr, r, lane);
        }
    }
}
DI void phase_norm(const Params& P, LAS unsigned char* lds, int layer, int wv) {
    const int tid = get_tid(wv), lane = tid & 63, wave = tid >> 6;
    const int gw = get_bid() * 8 + wave, NGW = gridDim.x * 8;
    if (layer > 0) phase_convert(P, lds, layer, wv);
    const float* hl = layer == 0 ? P.x : P.out; const float* hc = layer == 0 ? P.ctx : (const float*)(P.ws + WS_HCTX);
    const float* mod = (const float*)(P.ws + WS_MOD) + (size_t)layer * 9 * 3072;
    const float* nw = P.norm_w + layer * 1024;
    bf16_t* U = (bf16_t*)(P.ws + WS_OV);
    f32x4 w4[4], s4[4], h4[4];
#pragma unroll
    for (int q = 0; q < 4; ++q) w4[q] = *(const f32x4*)(nw + 4 * lane + 256 * q);
    int cur_m = -1;
    const int nrows = layer == 0 ? MROWS : NB * CTXL;
    const int rpw = (nrows + NGW - 1) / NGW;
    for (int idx = gw * rpw; idx < gw * rpw + rpw && idx < nrows; ++idx) {
        const int b = layer == 0 ? idx / LT : idx >> 8, jr = layer == 0 ? idx % LT : idx & 255;
        const int R = b * LT + jr;
        const float* src = jr < CTXL ? hc + ((size_t)b * CTXL + jr) * DM : hl + ((size_t)b * SEQ + (jr - CTXL)) * DM;
        const int mrow = jr < CTXL ? 8 : b;
        if (mrow != cur_m) {
            cur_m = mrow;
            const float* sh = mod + mrow * 3072; const float* sc = sh + 1024;
#pragma unroll
            for (int q = 0; q < 4; ++q) { s4[q] = *(const f32x4*)(sc + 4 * lane + 256 * q) + 1.f; h4[q] = *(const f32x4*)(sh + 4 * lane + 256 * q); }
        }
        f32x4 v[4]; float ss = 0.f;
#pragma unroll
        for (int q = 0; q < 4; ++q) { v[q] = *(const f32x4*)(src + 4 * lane + 256 * q); ss += (v[q][0] * v[q][0] + v[q][1] * v[q][1]) + (v[q][2] * v[q][2] + v[q][3] * v[q][3]); }
        const float rstd = rsqrtf(wave_sum(ss) * (1.f / DM) + RMS_EPS);
#pragma unroll
        for (int q = 0; q < 4; ++q) { const int k = 4 * lane + 256 * q;
            const f32x4 y = (v[q] * rstd) * w4[q]; const f32x4 o = y * s4[q] + h4[q];
            u32x2 w; w.x = pk2(o[0], o[1]); w.y = pk2(o[2], o[3]); *(u32x2*)(U + (size_t)R * DM + k) = w; }
    }
}

typedef _Float16 f16x2_t __attribute__((ext_vector_type(2)));
DI unsigned pkh2(float a, float b) { const f16x2_t v = {(_Float16)a, (_Float16)b}; return __builtin_bit_cast(unsigned, v); }
DI void unpkh2(unsigned u, float& a, float& b) { const f16x2_t v = __builtin_bit_cast(f16x2_t, u); a = (float)v[0]; b = (float)v[1]; }
constexpr int RG_UT = 0, RG_AL = 17408, RG_BL = 50176, RG_HP = 82944, RG_QA = 148480, RG_CAR = 152576, RG_FLAG = 153600, RG_END = 153664;
static_assert(RG_END <= LDS_BYTES - 256, "RG-LRU LDS map");
constexpr int CW_RG = 8192;
DI void rglru_item(const Params& P, LAS unsigned char* lds, int j, int item, int wv) {
    const int tid = get_tid(wv), lane = tid & 63, wave = tid >> 6, r = lane & 15, g = lane >> 4;
    const int grp = item / NCHUNK, ci = item % NCHUNK, b = grp >> 3, hd = grp & 7;
    bf16_t* p = (bf16_t*)(P.ws + WS_P);
    const bf16_t* WRG = (const bf16_t*)(P.ws + WS_WRG);
    unsigned long long* AGG = (unsigned long long*)(P.ws + WS_AGG);
    unsigned* cnt = (unsigned*)(P.ws + WS_CTL) + CW_RG + (j * 64 + grp) * 16;
    const int R0 = b * LT + ci * 64;
    const int seg_lo = b * LT + (ci < 4 ? 0 : CTXL), seg_hi = b * LT + (ci < 4 ? CTXL : LT);
    LAS bf16_t* UT = (LAS bf16_t*)(lds + RG_UT);
    LAS float* AL = (LAS float*)(lds + RG_AL);
    LAS float* BL = (LAS float*)(lds + RG_BL);
    LAS unsigned* HP = (LAS unsigned*)(lds + RG_HP);
    LAS float* QA = (LAS float*)(lds + RG_QA);
    LAS float* CAR = (LAS float*)(lds + RG_CAR);
    TP_START(10, lds, tid); TP_START(11, lds, tid);
    bf16x8 wfr[2][2][4];
    float prm[2][3];
#pragma unroll
    for (int dir = 0; dir < 2; ++dir) {
#pragma unroll
        for (int gt = 0; gt < 2; ++gt) {
            const bf16_t* W = WRG + (size_t)((dir * 2 + gt) * 8 + hd) * 16384 + (wave * 4 * 64 + lane) * 8;
#pragma unroll
            for (int ks = 0; ks < 4; ++ks) wfr[dir][gt][ks] = *(const bf16x8*)(W + ks * 512);
        }
        const int idx = (j * 2 + dir) * 1024 + hd * 128 + 16 * wave + r;
        prm[dir][0] = P.ev_rg_bx[idx]; prm[dir][1] = P.ev_rg_ba[idx]; prm[dir][2] = P.ev_rg_lambda[idx];
    }
    {
        LAS bf16_t* XT = (LAS bf16_t*)(lds + RG_HP);
#pragma unroll
        for (int rep = 0; rep < 3; ++rep) {
            const int idx = tid + rep * 512, tr = idx >> 4, c0 = (idx & 15) * 8;
            if (idx < 67 * 16) {
                const int Rg = R0 + tr - 1;
                u32x4 xv = {0u, 0u, 0u, 0u};
                if (Rg >= seg_lo && Rg < seg_hi) xv = *(const u32x4*)(p + (size_t)Rg * EVEN_IN + hd * 128 + c0);
                *(LAS u32x4*)(XT + tr * 128 + c0) = xv;
            }
        }
        const int c0 = (tid & 15) * 8, cg0 = hd * 128 + c0;
        float wv4[4][8], bias[8];
        { const f32x4 b0 = *(const f32x4*)(P.ev_conv_b + j * 1024 + cg0), b1 = *(const f32x4*)(P.ev_conv_b + j * 1024 + cg0 + 4);
          bias[0] = b0[0]; bias[1] = b0[1]; bias[2] = b0[2]; bias[3] = b0[3]; bias[4] = b1[0]; bias[5] = b1[1]; bias[6] = b1[2]; bias[7] = b1[3]; }
#pragma unroll
        for (int k = 0; k < 4; ++k) { const float* wk = P.ev_conv_w + (size_t)(j * 4 + k) * 1024 + cg0; const f32x4 w0 = *(const f32x4*)wk, w1 = *(const f32x4*)(wk + 4);
            wv4[k][0] = w0[0]; wv4[k][1] = w0[1]; wv4[k][2] = w0[2]; wv4[k][3] = w0[3]; wv4[k][4] = w1[0]; wv4[k][5] = w1[1]; wv4[k][6] = w1[2]; wv4[k][7] = w1[3]; }
        __syncthreads();
#pragma unroll
        for (int rep = 0; rep < 2; ++rep) {
            const int t = (tid >> 4) + rep * 32;
            float acc[8];
#pragma unroll
            for (int e = 0; e < 8; ++e) acc[e] = bias[e];
#pragma unroll
            for (int k = 0; k < 4; ++k) {
                const u32x4 xv = *(const LAS u32x4*)(XT + (t + k) * 128 + c0);
                acc[0] += wv4[k][0] * __uint_as_float(xv.x << 16); acc[1] += wv4[k][1] * __uint_as_float(xv.x & 0xffff0000u);
                acc[2] += wv4[k][2] * __uint_as_float(xv.y << 16); acc[3] += wv4[k][3] * __uint_as_float(xv.y & 0xffff0000u);
                acc[4] += wv4[k][4] * __uint_as_float(xv.z << 16); acc[5] += wv4[k][5] * __uint_as_float(xv.z & 0xffff0000u);
                acc[6] += wv4[k][6] * __uint_as_float(xv.w << 16); acc[7] += wv4[k][7] * __uint_as_float(xv.w & 0xffff0000u);
            }
            u32x4 o; o.x = pk2(acc[0], acc[1]); o.y = pk2(acc[2], acc[3]); o.z = pk2(acc[4], acc[5]); o.w = pk2(acc[6], acc[7]);
            *(LAS u32x4*)(UT + t * 136 + c0) = o;
        }
    }
    __syncthreads();
    TP_STOP(11, lds, tid);
#pragma unroll
    for (int dir = 0; dir < 2; ++dir) {
        TP_START(12, lds, tid); TP_START(16, lds, tid);
        f32x4 ax[4], aa[4];
#pragma unroll
        for (int m = 0; m < 4; ++m) { ax[m] = (f32x4){0.f, 0.f, 0.f, 0.f}; aa[m] = (f32x4){0.f, 0.f, 0.f, 0.f}; }
#pragma unroll
        for (int ks = 0; ks < 4; ++ks) {
#pragma unroll
            for (int m = 0; m < 4; ++m) {
                const bf16x8 a = *(const LAS bf16x8*)(UT + (16 * m + r) * 136 + 32 * ks + 8 * g);
                ax[m] = MFMA16(a, wfr[dir][0][ks], ax[m]); aa[m] = MFMA16(a, wfr[dir][1][ks], aa[m]);
            }
        }
        asm volatile("" :: "v"(ax[0]), "v"(ax[1]), "v"(ax[2]), "v"(ax[3]), "v"(aa[0]), "v"(aa[1]), "v"(aa[2]), "v"(aa[3]));
        TP_STOP(16, lds, tid); TP_START(17, lds, tid);
        float av[4][4], bv[4][4];
        {
            const int c = 16 * wave + r;
            const float bxv = prm[dir][0], bav = prm[dir][1], lam = prm[dir][2];
            const float sp = softplus_neg(lam);
#pragma unroll
            for (int m = 0; m < 4; ++m)
#pragma unroll
                for (int i = 0; i < 4; ++i) {
                    const int t = 16 * m + 4 * g + i;
                    const float gx = sigm(ax[m][i] + bxv), ga = sigm(aa[m][i] + bav);
                    const float la = -8.f * ga * sp;
                    const float a = __expf(la), mult = __builtin_amdgcn_sqrtf((1.f - a) * (1.f + a));
                    const float uv = bf2f(UT[t * 136 + c]);
                    av[m][i] = a; bv[m][i] = mult * gx * uv;
                }
        }
        TP_STOP(17, lds, tid);
        TP_STOP(12, lds, tid); TP_START(13, lds, tid);
        {
            const int c = 16 * wave + r;
            float hl[4][4], pl[4][4], sa[4], sb[4];
#pragma unroll
            for (int m = 0; m < 4; ++m) {
                float h = 0.f, pc = 1.f;
#pragma unroll
                for (int ii = 0; ii < 4; ++ii) { const int i = dir == 0 ? ii : 3 - ii; h = av[m][i] * h + bv[m][i]; pc *= av[m][i]; hl[m][i] = h; pl[m][i] = pc; }
                sa[m] = pc; sb[m] = h;
            }
            float hin[4], pin[4];
            {
                float ca[4][4], cb[4][4];
#pragma unroll
                for (int m = 0; m < 4; ++m)
#pragma unroll
                    for (int gg = 0; gg < 4; ++gg) {
                        const int src = (16 * gg + r) << 2;
                        ca[m][gg] = __int_as_float(__builtin_amdgcn_ds_bpermute(src, __float_as_int(sa[m])));
                        cb[m][gg] = __int_as_float(__builtin_amdgcn_ds_bpermute(src, __float_as_int(sb[m])));
                    }
                float H = 0.f, Pc = 1.f;
#pragma unroll
                for (int ss = 0; ss < 16; ++ss) {
                    const int s = dir == 0 ? ss : 15 - ss, m = s >> 2, gg = s & 3;
                    if (gg == g) { hin[m] = H; pin[m] = Pc; }
                    H = ca[m][gg] * H + cb[m][gg]; Pc *= ca[m][gg];
                }
                if (g == 0) {
                    const unsigned long long v = ((unsigned long long)__float_as_uint(H) << 32) | __float_as_uint(Pc);
                    __hip_atomic_store(AGG + ((size_t)(dir * NB + b) * NCHUNK + ci) * 1024 + hd * 128 + c, v, __ATOMIC_RELAXED, __HIP_MEMORY_SCOPE_AGENT);
                }
            }
#pragma unroll
            for (int m = 0; m < 4; ++m)
#pragma unroll
                for (int i = 0; i < 4; ++i) HP[(dir * 64 + 16 * m + 4 * g + i) * 128 + c] = pkh2(hl[m][i] + pl[m][i] * hin[m], pl[m][i] * pin[m]);
        }
        TP_STOP(13, lds, tid);
    }
    TP_START(14, lds, tid);
    u32x4 gpre[2];
#pragma unroll
    for (int rep = 0; rep < 2; ++rep) { const int idx = tid + rep * 512; gpre[rep] = *(const u32x4*)(p + (size_t)(R0 + (idx >> 4)) * EVEN_IN + 1536 + hd * 128 + (idx & 15) * 8); }
    asm volatile("s_waitcnt vmcnt(0)" ::: "memory");
    __syncthreads();
    if (tid == 0) {
        __hip_atomic_fetch_add(cnt, 1u, __ATOMIC_RELAXED, __HIP_MEMORY_SCOPE_AGENT);
        unsigned spins = 0;
        while (__hip_atomic_load(cnt, __ATOMIC_RELAXED, __HIP_MEMORY_SCOPE_AGENT) < (unsigned)NCHUNK) { __builtin_amdgcn_s_sleep(2); if (++spins > (1u << 22)) break; }
    }
    __syncthreads();
    TP_STOP(14, lds, tid); TP_START(15, lds, tid);
    if (tid < 256) {
        const int dir = tid >> 7, c = tid & 127;
        const int pos = dir == 0 ? ci : (ci < 4 ? 3 - ci : 39 - ci);
        float h = 0.f;
        const unsigned long long* ag = AGG + (size_t)(dir * NB + b) * NCHUNK * 1024 + hd * 128 + c;
#pragma unroll 1
        for (int base = 0; base < pos; base += 18) {
            unsigned long long v[18];
#pragma unroll
            for (int k = 0; k < 18; ++k) { const int pp = base + k < pos ? base + k : pos - 1; const int cc = dir == 0 ? pp : (pp < 4 ? 3 - pp : 39 - pp);
                v[k] = __hip_atomic_load(ag + (size_t)cc * 1024, __ATOMIC_RELAXED, __HIP_MEMORY_SCOPE_AGENT); }
#pragma unroll
            for (int k = 0; k < 18; ++k) if (base + k < pos) h = __uint_as_float((unsigned)v[k]) * h + __uint_as_float((unsigned)(v[k] >> 32));
        }
        CAR[dir * 128 + c] = h;
    }
    __syncthreads();
#pragma unroll
    for (int rep = 0; rep < 2; ++rep) {
        const int idx = tid + rep * 512, t = idx >> 4, c0 = (idx & 15) * 8;
        bf16_t* gp = p + (size_t)(R0 + t) * EVEN_IN + 1536 + hd * 128 + c0;
        const u32x4 gv = gpre[rep];
        float y[8];
#pragma unroll
        for (int e = 0; e < 8; ++e) {
            float h0, p0, h1, p1; unpkh2(HP[t * 128 + c0 + e], h0, p0); unpkh2(HP[(64 + t) * 128 + c0 + e], h1, p1);
            y[e] = (h0 + p0 * CAR[c0 + e]) + (h1 + p1 * CAR[128 + c0 + e]);
        }
        const float gg[8] = {__uint_as_float(gv.x << 16), __uint_as_float(gv.x & 0xffff0000u), __uint_as_float(gv.y << 16), __uint_as_float(gv.y & 0xffff0000u),
                             __uint_as_float(gv.z << 16), __uint_as_float(gv.z & 0xffff0000u), __uint_as_float(gv.w << 16), __uint_as_float(gv.w & 0xffff0000u)};
        u32x4 o;
        o.x = pk2(y[0] * gg[0] * sigm(gg[0]), y[1] * gg[1] * sigm(gg[1])); o.y = pk2(y[2] * gg[2] * sigm(gg[2]), y[3] * gg[3] * sigm(gg[3]));
        o.z = pk2(y[4] * gg[4] * sigm(gg[4]), y[5] * gg[5] * sigm(gg[5])); o.w = pk2(y[6] * gg[6] * sigm(gg[6]), y[7] * gg[7] * sigm(gg[7]));
        *(u32x4*)gp = o;
    }
    __syncthreads();
    TP_STOP(15, lds, tid); TP_STOP(10, lds, tid);
}

DI void rope8v(u32x4& v, const f32x4 cs, const f32x4 sn) {
    unsigned* w = (unsigned*)&v;
#pragma unroll
    for (int i = 0; i < 4; ++i) { const float t1 = __uint_as_float(w[i] << 16), t2 = __uint_as_float(w[i] & 0xffff0000u); w[i] = pk2(t1 * cs[i] - t2 * sn[i], t1 * sn[i] + t2 * cs[i]); }
}
DI void rope8(u32x4& v, const float* cs, const float* sn) { rope8v(v, *(const f32x4*)cs, *(const f32x4*)sn); }
DI void rope8s(u32x4& v, const float* cs, const float* sn, float sc) { rope8v(v, *(const f32x4*)cs * sc, *(const f32x4*)sn * sc); }
DI void scale8(u32x4& v, float sc) {
    unsigned* w = (unsigned*)&v;
#pragma unroll
    for (int i = 0; i < 4; ++i) w[i] = pk2(__uint_as_float(w[i] << 16) * sc, __uint_as_float(w[i] & 0xffff0000u) * sc);
}
typedef short v4i16_a __attribute__((ext_vector_type(4)));
DI void attn_item(const Params& P, LAS unsigned char* lds, int j, int item, int wv) {
    const int tid = get_tid(wv), lane = tid & 63, wave = tid >> 6, r = lane & 31, h = lane >> 5;
    const bool is_lat = item < 512;
    int b, qb, kvh;
    if (is_lat) { b = item >> 6; qb = (item >> 2) & 15; kvh = item & 3; } else { const int it = item - 512; b = it >> 3; qb = (it >> 2) & 1; kvh = it & 3; }
    bf16_t* p = (bf16_t*)(P.ws + WS_P);
    const float* cos_t = (const float*)(P.ws + WS_ROPE); const float* sin_t = cos_t + SEQ * 32;
    LAS unsigned char* QL = lds + 36864 + wave * 9216;
    TP_START(1, lds, tid);
    const int hq = 4 * kvh + (wave >> 1), ql0 = qb * 128 + 64 * (wave & 1);
    const size_t rowbase = (size_t)b * LT + (is_lat ? CTXL : 0);
    {
        const int chq = lane & 7;
#pragma unroll
        for (int k = 0; k < 8; ++k) {
            const int row = (lane >> 3) + 8 * k, qi = ql0 + row;
            u32x4 v = *(const u32x4*)(p + (rowbase + qi) * EVEN_IN + 2560 + hq * 64 + 8 * chq);
            if (is_lat) rope8s(v, cos_t + qi * 32 + 4 * chq, sin_t + qi * 32 + 4 * chq, 0.125f * LOG2E); else scale8(v, 0.125f * LOG2E);
            *(LAS u32x4*)(QL + row * 144 + chq * 16) = v;
        }
    }
    const float sink2 = P.ev_sink[j * 16 + hq] * LOG2E;
    float mrun[2] = {sink2, sink2}, lrun[2] = {h == 0 ? 1.f : 0.f, h == 0 ? 1.f : 0.f};
    f32x16 O[2][2];
#pragma unroll
    for (int a = 0; a < 2; ++a)
#pragma unroll
        for (int c = 0; c < 2; ++c)
#pragma unroll
            for (int i = 0; i < 16; ++i) O[a][c][i] = 0.f;
    const int w_lo = (is_lat && qb == 0) ? 2 : 0, w_hi = (is_lat && qb == 15) ? 3 : 5;
    const int nT = is_lat ? 4 + (w_hi - w_lo + 1) : 4;
    const float SC = 0.125f * LOG2E, NEG = -1e30f;
    const int key = tid >> 3, chn = tid & 7;
    u32x4 kreg, vreg; f32x4 creg, sreg;
#define ATT_K0(t) ((t) < 4 ? 64 * (t) : qb * 128 - 128 + 64 * (w_lo + (t) - 4))
#define ATT_LOAD(t) do { const bool win_ = (t) >= 4; const int k0_ = ATT_K0(t); \
        const bf16_t* kp_ = p + ((size_t)b * LT + (win_ ? CTXL : 0) + k0_ + key) * EVEN_IN + 1024 + kvh * 64 + 8 * chn; \
        kreg = *(const u32x4*)kp_; vreg = *(const u32x4*)(kp_ + 256); \
        if (win_) { creg = *(const f32x4*)(cos_t + (k0_ + key) * 32 + 4 * chn); sreg = *(const f32x4*)(sin_t + (k0_ + key) * 32 + 4 * chn); } } while (0)
#define ATT_STORE(t, buf) do { const bool win_ = (t) >= 4; \
        if (win_) rope8v(kreg, creg, sreg); \
        *(LAS u32x4*)(lds + (buf) * 18432 + key * 144 + chn * 16) = kreg; *(LAS u32x4*)(lds + (buf) * 18432 + 9216 + key * 144 + chn * 16) = vreg; } while (0)
    TP_START(2, lds, tid);
    ATT_LOAD(0); ATT_STORE(0, 0);
    if (nT > 1) ATT_LOAD(1);
#pragma unroll 1
    for (int t = 0; t < nT; ++t) {
        TP_START(4, lds, tid);
        __syncthreads();
        TP_STOP(4, lds, tid);
        if (t + 1 < nT) { ATT_STORE(t + 1, (t + 1) & 1); if (t + 2 < nT) ATT_LOAD(t + 2); }
        TP_START(3, lds, tid);
        const bool win = t >= 4;
        const int k0 = ATT_K0(t);
        const int dq = k0 - ql0;
        if (win && (dq >= 192 || dq <= -192)) continue;
        const bool need_mask = win && (dq >= 128 || dq <= -128);
        const LAS unsigned char* KL = lds + (t & 1) * 18432;
        const LAS bf16_t* VL = (const LAS bf16_t*)(lds + (t & 1) * 18432 + 9216);
#pragma unroll
        for (int qt = 0; qt < 2; ++qt) {
            f32x16 s0, s1;
            { const float nm = -mrun[qt];
#pragma unroll
              for (int i = 0; i < 16; ++i) { s0[i] = nm; s1[i] = nm; } }
#pragma unroll
            for (int ks = 0; ks < 4; ++ks) {
                const bf16x8 qfr = *(const LAS bf16x8*)(QL + (32 * qt + r) * 144 + (16 * ks + 8 * h) * 2);
                const bf16x8 k0f = *(const LAS bf16x8*)(KL + r * 144 + (16 * ks + 8 * h) * 2), k1f = *(const LAS bf16x8*)(KL + (32 + r) * 144 + (16 * ks + 8 * h) * 2);
                s0 = MFMA32(k0f, qfr, s0); s1 = MFMA32(k1f, qfr, s1);
            }
            const int qpos = ql0 + 32 * qt + r;
            if (need_mask) {
#pragma unroll
                for (int i = 0; i < 16; ++i) {
                    const int d0 = qpos - (k0 + crow(i, h)), d1 = d0 - 32;
                    if (d0 > 128 || d0 < -128) s0[i] = NEG;
                    if (d1 > 128 || d1 < -128) s1[i] = NEG;
                }
            }
            float mx = NEG;
#pragma unroll
            for (int i = 0; i < 16; ++i) mx = fmaxf(mx, fmaxf(s0[i], s1[i]));
            mx = fmaxf(mx, shfl_xor_f(mx, 32));
            if (__any(mx > 6.0f)) {
                const float shift = fmaxf(mx, 0.f), alpha = __builtin_amdgcn_exp2f(-shift);
                mrun[qt] += shift; lrun[qt] *= alpha;
#pragma unroll
                for (int i = 0; i < 16; ++i) { s0[i] -= shift; s1[i] -= shift; }
#pragma unroll
                for (int dt = 0; dt < 2; ++dt)
#pragma unroll
                    for (int i = 0; i < 16; ++i) O[dt][qt][i] *= alpha;
            }
            float ls = 0.f;
#pragma unroll
            for (int i = 0; i < 16; ++i) { s0[i] = __builtin_amdgcn_exp2f(s0[i]); s1[i] = __builtin_amdgcn_exp2f(s1[i]); ls += s0[i] + s1[i]; }
            lrun[qt] += ls;
            bf16x8 pf[2][2];
#pragma unroll
            for (int s = 0; s < 2; ++s) {
                u32x4 a, c;
                a.x = pk2(s0[8 * s + 0], s0[8 * s + 1]); a.y = pk2(s0[8 * s + 2], s0[8 * s + 3]); a.z = pk2(s0[8 * s + 4], s0[8 * s + 5]); a.w = pk2(s0[8 * s + 6], s0[8 * s + 7]);
                c.x = pk2(s1[8 * s + 0], s1[8 * s + 1]); c.y = pk2(s1[8 * s + 2], s1[8 * s + 3]); c.z = pk2(s1[8 * s + 4], s1[8 * s + 5]); c.w = pk2(s1[8 * s + 6], s1[8 * s + 7]);
                pf[0][s] = __builtin_bit_cast(bf16x8, a); pf[1][s] = __builtin_bit_cast(bf16x8, c);
            }
            const int gq = (lane >> 4) & 1, qq4 = (lane & 15) >> 2, pp4 = lane & 3;
#pragma unroll
            for (int dt = 0; dt < 2; ++dt)
#pragma unroll
                for (int kt = 0; kt < 2; ++kt)
#pragma unroll
                    for (int s = 0; s < 2; ++s) {
                        const LAS bf16_t* vp = VL + (32 * kt + 16 * s + 4 * h + qq4) * 72 + 32 * dt + 16 * gq + 4 * pp4;
                        const v4i16_a lo = __builtin_amdgcn_ds_read_tr16_b64_v4i16((LAS v4i16_a*)vp);
                        const v4i16_a hi = __builtin_amdgcn_ds_read_tr16_b64_v4i16((LAS v4i16_a*)(vp + 8 * 72));
                        const bf16x8 vf = {lo[0], lo[1], lo[2], lo[3], hi[0], hi[1], hi[2], hi[3]};
                        O[dt][qt] = MFMA32(vf, pf[kt][s], O[dt][qt]);
                    }
            __builtin_amdgcn_sched_barrier(0);
        }
        TP_STOP(3, lds, tid);
    }
    TP_STOP(2, lds, tid);
#undef ATT_K0
#undef ATT_LOAD
#undef ATT_STORE
    {
        const int chq = lane & 7;
        u32x4 gate[8];
#pragma unroll
        for (int k = 0; k < 8; ++k) gate[k] = *(const u32x4*)(p + (rowbase + ql0 + (lane >> 3) + 8 * k) * EVEN_IN + 3584 + hq * 64 + 8 * chq);
#pragma unroll
        for (int qt = 0; qt < 2; ++qt) {
            const float lt = lrun[qt] + shfl_xor_f(lrun[qt], 32), inv = __builtin_amdgcn_rcpf(lt);
#pragma unroll
            for (int dt = 0; dt < 2; ++dt)
#pragma unroll
                for (int i4 = 0; i4 < 4; ++i4) {
                    u32x2 o; o.x = pk2(O[dt][qt][4 * i4 + 0] * inv, O[dt][qt][4 * i4 + 1] * inv); o.y = pk2(O[dt][qt][4 * i4 + 2] * inv, O[dt][qt][4 * i4 + 3] * inv);
                    *(LAS u32x2*)(QL + (32 * qt + r) * 144 + (32 * dt + 8 * i4 + 4 * h) * 2) = o;
                }
        }
#pragma unroll
        for (int k = 0; k < 8; ++k) {
            const int row = (lane >> 3) + 8 * k;
            const u32x4 ov = *(const LAS u32x4*)(QL + row * 144 + chq * 16);
            const unsigned* ow = (const unsigned*)&ov; const unsigned* gw = (const unsigned*)&gate[k];
            u32x4 res; unsigned* rw = (unsigned*)&res;
#pragma unroll
            for (int e = 0; e < 4; ++e) {
                const float g0 = __uint_as_float(gw[e] << 16), g1 = __uint_as_float(gw[e] & 0xffff0000u);
                rw[e] = pk2(__uint_as_float(ow[e] << 16) * g0 * sigm(g0), __uint_as_float(ow[e] & 0xffff0000u) * g1 * sigm(g1));
            }
            *(u32x4*)(p + (rowbase + ql0 + row) * EVEN_IN + 2560 + hq * 64 + 8 * chq) = res;
        }
    }
    __syncthreads();
    TP_STOP(1, lds, tid);
}

constexpr int G2_QX = 0, G2_KF = 17408, G2_K2 = 60928, G2_VS = 79360, G2_AM = 96768, G2_ST = 105984, G2_PS = 140800, G2_BL = 144896, G2_Q1 = 145408, G2_END = 162816;
static_assert(G2_END <= LDS_BYTES - 256, "GLA LDS map");
typedef short v4i16_t __attribute__((ext_vector_type(4)));
DI bf16x8 frag_tr(const LAS bf16_t* M, int stride, int k0, int n0, int lane) {
    const int i = lane & 15, g = lane >> 4, q = i >> 2, pp = i & 3;
    const LAS bf16_t* a0 = M + (k0 + 8 * g + q) * stride + n0 + 4 * pp;
    const v4i16_t lo = __builtin_amdgcn_ds_read_tr16_b64_v4i16((LAS v4i16_t*)a0);
    const v4i16_t hi = __builtin_amdgcn_ds_read_tr16_b64_v4i16((LAS v4i16_t*)(a0 + 4 * stride));
    return (bf16x8){lo[0], lo[1], lo[2], lo[3], hi[0], hi[1], hi[2], hi[3]};
}

#ifndef GLA_SPLIT
#define GLA_SPLIT 24
#endif
template <int DIR>
DI void gla2_item(const Params& P, LAS unsigned char* lds, int layer_j, int b, int hd, int part, int wv) {
    const int tid = get_tid(wv), lane = tid & 63, wave = tid >> 6, r = lane & 15, g = lane >> 4;
    bf16_t* p = (bf16_t*)(P.ws + WS_P);
    LAS bf16_t* QX = (LAS bf16_t*)(lds + G2_QX); LAS bf16_t* KF = (LAS bf16_t*)(lds + G2_KF); LAS bf16_t* K2 = (LAS bf16_t*)(lds + G2_K2);
    LAS bf16_t* VS = (LAS bf16_t*)(lds + G2_VS); LAS bf16_t* AM = (LAS bf16_t*)(lds + G2_AM); LAS bf16_t* ST = (LAS bf16_t*)(lds + G2_ST);
    LAS float* PS8 = (LAS float*)(lds + G2_PS); LAS float* BLAST = (LAS float*)(lds + G2_BL); LAS bf16_t* Q1 = (LAS bf16_t*)(lds + G2_Q1);
    const int d0 = 2 * lane, tg = wave, I = tg >> 1, half = tg & 1;
    float lbv[2] = {0.f, 0.f};
    if (layer_j > 0) { lbv[0] = sigm(P.od_lb_raw[1024 + hd * 128 + d0] - P.od_lb_raw[hd * 128 + d0]); lbv[1] = sigm(P.od_lb_raw[1024 + hd * 128 + d0 + 1] - P.od_lb_raw[hd * 128 + d0 + 1]); }
    unsigned* prog = (unsigned*)(P.ws + WS_CTL) + 10240 + ((layer_j * 128 + b * 16 + hd * 2 + DIR) * 8);
    const int step_end = part == 0 ? GLA_SPLIT : NCHUNK;
    TP_START(20, lds, tid);
    for (int i = tid; i < (9216 + 34816) / 4; i += 512) ((LAS unsigned*)(lds + G2_AM))[i] = 0u;
    f32x4 st[8];
#pragma unroll
    for (int e = 0; e < 8; ++e) st[e] = (f32x4){0.f, 0.f, 0.f, 0.f};
    unsigned zn[8], qn[8]; u32x4 vn[2];
#define G2_OFFZ(s) ((unsigned)((DIR == 0 ? 8 * tg + (s) : 63 - 8 * tg - (s)) * ODD_IN + d0) * 2u)
#define G2_OFFV(rep) ((unsigned)((DIR == 0 ? ((tid + (rep) * 512) >> 4) : 63 - ((tid + (rep) * 512) >> 4)) * ODD_IN + 8 * ((tid + (rep) * 512) & 15)) * 2u)
    const size_t colz = (size_t)DIR * 1024 + hd * 128, colq = 3072 + hd * 128, colv = 2048 + hd * 128;
    {
        const int chunk = DIR == 0 ? 0 : 3;
        const char* slab = (const char*)(p + ((size_t)b * LT + (size_t)chunk * 64) * ODD_IN);
#pragma unroll
        for (int s = 0; s < 8; ++s) { zn[s] = *(const unsigned*)(slab + colz * 2 + G2_OFFZ(s)); qn[s] = *(const unsigned*)(slab + colq * 2 + G2_OFFZ(s)); }
#pragma unroll
        for (int rep = 0; rep < 2; ++rep) vn[rep] = *(const u32x4*)(slab + colv * 2 + G2_OFFV(rep));
    }
    __syncthreads();
#pragma unroll 1
    for (int step = 0; step < step_end; ++step) {
        const bool sonly = part == 1 && step < GLA_SPLIT;
        const int chunk = DIR == 0 ? step : (step < 4 ? 3 - step : 39 - step);
        const size_t Rc0 = (size_t)b * LT + (size_t)chunk * 64;
        unsigned zc[8], qc[8]; u32x4 vc[2];
#pragma unroll
        for (int s = 0; s < 8; ++s) { zc[s] = zn[s]; qc[s] = qn[s]; }
        vc[0] = vn[0]; vc[1] = vn[1];
        TP_START(21, lds, tid);
        float el[8][2], kk[8][2], qq[8][2];
        {
            float run0 = 1.f, run1 = 1.f;
#pragma unroll
            for (int s = 0; s < 8; ++s) {
                const float z0 = __uint_as_float(zc[s] << 16), z1 = __uint_as_float(zc[s] & 0xffff0000u);
                const float t0 = __expf(-z0), t1 = __expf(-z1), sg0 = __builtin_amdgcn_rcpf(1.f + t0), sg1 = __builtin_amdgcn_rcpf(1.f + t1);
                const float f0 = fmaxf(lbv[0] + (1.f - lbv[0]) * sg0, 1e-30f), f1 = fmaxf(lbv[1] + (1.f - lbv[1]) * sg1, 1e-30f);
                kk[s][0] = (1.f - lbv[0]) * (t0 * sg0); kk[s][1] = (1.f - lbv[1]) * (t1 * sg1);
                run0 = fmaxf(run0 * f0, 1e-35f); run1 = fmaxf(run1 * f1, 1e-35f); el[s][0] = run0; el[s][1] = run1;
                if (!sonly) {
                const float q0 = __uint_as_float(qc[s] << 16), q1 = __uint_as_float(qc[s] & 0xffff0000u);
                qq[s][0] = q0 * __builtin_amdgcn_rcpf(1.f + __expf(-q0)); qq[s][1] = q1 * __builtin_amdgcn_rcpf(1.f + __expf(-q1));
                } else { qq[s][0] = 0.f; qq[s][1] = 0.f; }
                if ((s & 1) == 1) __builtin_amdgcn_sched_barrier(0);
            }
            *(LAS f32x2*)(PS8 + tg * 128 + d0) = (f32x2){run0, run1};
#pragma unroll
            for (int rep = 0; rep < 2; ++rep) { const int idx = tid + rep * 512, tau = idx >> 4, chn = idx & 15; *(LAS u32x4*)(VS + tau * 136 + 8 * chn) = vc[rep]; }
        }
        __syncthreads();
        if (part == 1 && step < GLA_SPLIT && tid == 0) __hip_atomic_store(prog, (unsigned)(step + 1), __ATOMIC_RELAXED, __HIP_MEMORY_SCOPE_AGENT);
        TP_STOP(21, lds, tid); TP_START(22, lds, tid);
        float RI[2];
        {
            float T[8][2];
#pragma unroll
            for (int q8 = 0; q8 < 8; ++q8) { const f32x2 t = *(const LAS f32x2*)(PS8 + q8 * 128 + d0); T[q8][0] = t[0]; T[q8][1] = t[1]; }
            float pre[2], fac[4][2], f4[2];
#pragma unroll
            for (int x = 0; x < 2; ++x) {
                const float P0 = T[0][x] * T[1][x], P1 = T[2][x] * T[3][x], P2 = T[4][x] * T[5][x], P3 = T[6][x] * T[7][x];
                pre[x] = half ? (I == 0 ? T[0][x] : (I == 1 ? T[2][x] : (I == 2 ? T[4][x] : T[6][x]))) : 1.f;
                RI[x] = I == 0 ? 1.f : (I == 1 ? P0 : (I == 2 ? P0 * P1 : P0 * P1 * P2));
                float cur = 1.f;
                fac[0][x] = cur; if (I <= 0) cur *= P0;
                fac[1][x] = cur; if (I <= 1) cur *= P1;
                fac[2][x] = cur; if (I <= 2) cur *= P2;
                fac[3][x] = cur; cur *= P3;
                f4[x] = cur;
                if (tg == 0) BLAST[d0 + x] = P0 * P1 * P2 * P3;
            }
            unsigned w0[4], w1[4];
#pragma unroll
            for (int s = 0; s < 8; ++s) {
                const int tau = 8 * tg + s;
                const float e00 = fmaxf(pre[0] * el[s][0], 1e-35f), e01 = fmaxf(pre[1] * el[s][1], 1e-35f);
                const float qi0 = qq[s][0] * e00, qi1 = qq[s][1] * e01;
                const float kd0 = kk[s][0] * __builtin_amdgcn_rcpf(e00), kd1 = kk[s][1] * __builtin_amdgcn_rcpf(e01);
                if (!sonly) {
                *(LAS unsigned*)(QX + tau * 136 + d0) = pk2(qi0, qi1);
                *(LAS unsigned*)(Q1 + tau * 136 + d0) = pk2(qi0 * RI[0], qi1 * RI[1]);
                if (I <= 0) *(LAS unsigned*)(KF + (0 + tau) * 136 + d0) = pk2(kd0 * fac[0][0], kd1 * fac[0][1]);
                if (I <= 1) *(LAS unsigned*)(KF + (16 + tau) * 136 + d0) = pk2(kd0 * fac[1][0], kd1 * fac[1][1]);
                if (I <= 2) *(LAS unsigned*)(KF + (48 + tau) * 136 + d0) = pk2(kd0 * fac[2][0], kd1 * fac[2][1]);
                *(LAS unsigned*)(KF + (96 + tau) * 136 + d0) = pk2(kd0 * fac[3][0], kd1 * fac[3][1]);
                }
                const unsigned h0 = f2bf(kd0 * f4[0]), h1 = f2bf(kd1 * f4[1]);
                if (s & 1) { w0[s >> 1] |= h0 << 16; w1[s >> 1] |= h1 << 16; } else { w0[s >> 1] = h0; w1[s >> 1] = h1; }
                if ((s & 1) == 1) __builtin_amdgcn_sched_barrier(0);
            }
            *(LAS u32x4*)(K2 + (d0 + 0) * 72 + 8 * tg) = (u32x4){w0[0], w0[1], w0[2], w0[3]};
            *(LAS u32x4*)(K2 + (d0 + 1) * 72 + 8 * tg) = (u32x4){w1[0], w1[1], w1[2], w1[3]};
        }
        __syncthreads();
        TP_STOP(22, lds, tid); TP_START(23, lds, tid);
        if (step + 1 < step_end) {
            const int nchunk = DIR == 0 ? step + 1 : (step + 1 < 4 ? 2 - step : 38 - step);
            const char* slab = (const char*)(p + ((size_t)b * LT + (size_t)nchunk * 64) * ODD_IN);
#pragma unroll
            for (int s = 0; s < 8; ++s) { zn[s] = *(const unsigned*)(slab + colz * 2 + G2_OFFZ(s)); qn[s] = *(const unsigned*)(slab + colq * 2 + G2_OFFZ(s)); }
#pragma unroll
            for (int rep = 0; rep < 2; ++rep) vn[rep] = *(const u32x4*)(slab + colv * 2 + G2_OFFV(rep));
        }
#pragma unroll 1
        for (int bi = sonly ? 10 : wave; bi < 10; bi += 8) {
            const int Ib = bi < 1 ? 0 : (bi < 3 ? 1 : (bi < 6 ? 2 : 3)), Jb = bi - (Ib * (Ib + 1)) / 2;
            const int foff = Ib == 0 ? 0 : (Ib == 1 ? 16 : (Ib == 2 ? 48 : 96));
            f32x4 acc = {0.f, 0.f, 0.f, 0.f};
#pragma unroll
            for (int ks = 0; ks < 4; ++ks) {
                const bf16x8 a = *(const LAS bf16x8*)(QX + (16 * Ib + r) * 136 + 32 * ks + 8 * g);
                const bf16x8 bb = *(const LAS bf16x8*)(KF + (foff + 16 * Jb + r) * 136 + 32 * ks + 8 * g);
                acc = MFMA16(a, bb, acc);
            }
#pragma unroll
            for (int i = 0; i < 4; ++i) { float v = acc[i]; if (Jb == Ib && r > 4 * g + i) v = 0.f; AM[(16 * Ib + 4 * g + i) * 72 + 16 * Jb + r] = (bf16_t)f2bf(v); }
        }
        if (!sonly) __syncthreads();
        TP_STOP(23, lds, tid); TP_START(24, lds, tid);
        {
            if (!sonly) {
            const int tt = wave >> 1, eb = 4 * (wave & 1);
            bf16x8 aq[4], am[2];
#pragma unroll
            for (int ks = 0; ks < 4; ++ks) aq[ks] = *(const LAS bf16x8*)(Q1 + (16 * tt + r) * 136 + 32 * ks + 8 * g);
#pragma unroll
            for (int ks = 0; ks < 2; ++ks) am[ks] = *(const LAS bf16x8*)(AM + (16 * tt + r) * 72 + 32 * ks + 8 * g);
#pragma unroll
            for (int e4 = 0; e4 < 4; ++e4) {
                const int et = eb + e4;
                f32x4 acc = {0.f, 0.f, 0.f, 0.f};
#pragma unroll
                for (int ks = 0; ks < 4; ++ks) { const bf16x8 bb = *(const LAS bf16x8*)(ST + (16 * et + r) * 136 + 32 * ks + 8 * g); acc = MFMA16(aq[ks], bb, acc); }
#pragma unroll
                for (int ks = 0; ks < 2; ++ks) acc = MFMA16(am[ks], frag_tr(VS, 136, 32 * ks, 16 * et, lane), acc);
#pragma unroll
                for (int i = 0; i < 4; ++i) KF[(16 * tt + 4 * g + i) * 136 + 16 * et + r] = (bf16_t)f2bf(acc[i]);
                __builtin_amdgcn_sched_barrier(0);
            }
            }
            float bl[4];
#pragma unroll
            for (int i = 0; i < 4; ++i) bl[i] = BLAST[16 * wave + 4 * g + i];
            bf16x8 ak[2];
#pragma unroll
            for (int ks = 0; ks < 2; ++ks) ak[ks] = *(const LAS bf16x8*)(K2 + (16 * wave + r) * 72 + 32 * ks + 8 * g);
#pragma unroll
            for (int et = 0; et < 8; ++et) {
#pragma unroll
                for (int i = 0; i < 4; ++i) st[et][i] *= bl[i];
#pragma unroll
                for (int ks = 0; ks < 2; ++ks) st[et] = MFMA16(ak[ks], frag_tr(VS, 136, 32 * ks, 16 * et, lane), st[et]);
                if (et & 1) __builtin_amdgcn_sched_barrier(0);
            }
        }
        if (part == 0 && tid == 0) { unsigned spins = 0; while (__hip_atomic_load(prog, __ATOMIC_RELAXED, __HIP_MEMORY_SCOPE_AGENT) < (unsigned)(step + 1)) { __builtin_amdgcn_s_sleep(2); if (++spins > (1u << 22)) break; } }
        __syncthreads();
        TP_STOP(24, lds, tid); TP_START(25, lds, tid);
        if (!sonly) {
            char* oslab = (char*)(p + Rc0 * ODD_IN + colz);
#pragma unroll
            for (int rep = 0; rep < 2; ++rep) {
                const int idx = tid + rep * 512, tau = idx >> 4, chn = idx & 15;
                const u32x4 ov = *(const LAS u32x4*)(KF + tau * 136 + 8 * chn);
                *(u32x4*)(oslab + (unsigned)((DIR == 0 ? tau : 63 - tau) * ODD_IN + 8 * chn) * 2u) = ov;
            }
        }
        if (!sonly || step == GLA_SPLIT - 1) {
#pragma unroll
        for (int et = 0; et < 8; ++et) { u32x2 w; w.x = pk2(st[et][0], st[et][1]); w.y = pk2(st[et][2], st[et][3]); *(LAS u32x2*)(ST + (16 * et + r) * 136 + 16 * wave + 4 * g) = w; }
        }
        TP_STOP(25, lds, tid);
    }
    __syncthreads();
    TP_STOP(20, lds, tid);
}

DI void phase_readout(const Params& P, int layer_j, int wv) {
    const int tid = get_tid(wv), lane = tid & 63, wave = tid >> 6;
    const int gw = get_bid() * 8 + wave, NGW = gridDim.x * 8;
    bf16_t* p = (bf16_t*)(P.ws + WS_P);
    const float* gwt = P.od_gnorm_w + layer_j * 128 + (lane & 7) * 16;
    for (int R = gw; R < MROWS; R += NGW) {
        const bf16_t* op = p + (size_t)R * ODD_IN + 16 * lane; bf16_t* yp = p + (size_t)R * ODD_IN + 4096 + 16 * lane;
        const u32x4 o0 = *(const u32x4*)op, o1 = *(const u32x4*)(op + 8), c0 = *(const u32x4*)(op + 1024), c1 = *(const u32x4*)(op + 1032), g0 = *(const u32x4*)yp, g1 = *(const u32x4*)(yp + 8);
        float ov[16], gv[16];
        const unsigned* ow0 = (const unsigned*)&o0; const unsigned* ow1 = (const unsigned*)&o1; const unsigned* cw0 = (const unsigned*)&c0; const unsigned* cw1 = (const unsigned*)&c1;
        const unsigned* gw0 = (const unsigned*)&g0; const unsigned* gw1 = (const unsigned*)&g1;
#pragma unroll
        for (int i = 0; i < 4; ++i) {
            ov[2 * i] = __uint_as_float(ow0[i] << 16) + __uint_as_float(cw0[i] << 16); ov[2 * i + 1] = __uint_as_float(ow0[i] & 0xffff0000u) + __uint_as_float(cw0[i] & 0xffff0000u);
            ov[8 + 2 * i] = __uint_as_float(ow1[i] << 16) + __uint_as_float(cw1[i] << 16); ov[8 + 2 * i + 1] = __uint_as_float(ow1[i] & 0xffff0000u) + __uint_as_float(cw1[i] & 0xffff0000u);
            gv[2 * i] = __uint_as_float(gw0[i] << 16); gv[2 * i + 1] = __uint_as_float(gw0[i] & 0xffff0000u); gv[8 + 2 * i] = __uint_as_float(gw1[i] << 16); gv[8 + 2 * i + 1] = __uint_as_float(gw1[i] & 0xffff0000u);
        }
        float ss = 0.f;
#pragma unroll
        for (int i = 0; i < 16; ++i) ss += ov[i] * ov[i];
        ss += shfl_xor_f(ss, 1); ss += shfl_xor_f(ss, 2); ss += shfl_xor_f(ss, 4);
        const float rstd = rsqrtf(ss * (1.f / 128.f) + RMS_EPS);
        float y[16];
#pragma unroll
        for (int i = 0; i < 16; ++i) y[i] = ov[i] * rstd * gwt[i] * (gv[i] * sigm(gv[i]));
        u32x4 w0, w1;
        w0.x = pk2(y[0], y[1]); w0.y = pk2(y[2], y[3]); w0.z = pk2(y[4], y[5]); w0.w = pk2(y[6], y[7]);
        w1.x = pk2(y[8], y[9]); w1.y = pk2(y[10], y[11]); w1.z = pk2(y[12], y[13]); w1.w = pk2(y[14], y[15]);
        *(u32x4*)yp = w0; *(u32x4*)(yp + 8) = w1;
    }
}

DI void phase_final(const Params& P, int wv) {
    const int tid = get_tid(wv), lane = tid & 63, wave = tid >> 6;
    const int gw = get_bid() * 8 + wave, NGW = gridDim.x * 8;
    for (int R = gw; R < NB * SEQ; R += NGW) {
        float* row = P.out + (size_t)R * DM;
        f32x4 v[4]; float ss = 0.f;
#pragma unroll
        for (int q = 0; q < 4; ++q) { v[q] = *(const f32x4*)(row + 4 * lane + 256 * q); ss += (v[q][0] * v[q][0] + v[q][1] * v[q][1]) + (v[q][2] * v[q][2] + v[q][3] * v[q][3]); }
        const float rstd = rsqrtf(wave_sum(ss) * (1.f / DM) + RMS_EPS);
#pragma unroll
        for (int q = 0; q < 4; ++q) { const f32x4 w4 = *(const f32x4*)(P.final_norm_w + 4 * lane + 256 * q); *(f32x4*)(row + 4 * lane + 256 * q) = (v[q] * rstd) * w4; }
    }
}

#define XB_TMO      128
#define XB_XCNT(j)  (256  + 64 * (j))
#define XB_XSUB(j)  (1280 + 64 * (j))
#define XB_XGEN(j)  (2304 + 64 * (j))
#define XB_TOP      3328
#define XB_TOPGEN   3392
#define XCD_BAR_WORDS 3456
#define XB_SPIN_CAP (1u << 18)

__device__ __forceinline__ unsigned xb_ld(unsigned* p)              { return __hip_atomic_load(p, __ATOMIC_RELAXED, __HIP_MEMORY_SCOPE_AGENT); }
__device__ __forceinline__ unsigned xb_add(unsigned* p, unsigned v) { return __hip_atomic_fetch_add(p, v, __ATOMIC_RELAXED, __HIP_MEMORY_SCOPE_AGENT); }
__device__ __forceinline__ unsigned xb_xcc_id() { return (unsigned)__builtin_amdgcn_s_getreg((3 << 11) | 20) & 0xFu; }
#define XB_SPIN(cond, bar) do { unsigned _sp = 0; while (cond) { __builtin_amdgcn_s_sleep(1); \
    if ((++_sp & 255u) == 0u) { if (xb_ld(&(bar)[XB_TMO])) break; if (_sp > XB_SPIN_CAP) { atomicAdd(&(bar)[XB_TMO], 1u); break; } } } } while (0)

struct XcdBarrier {
    unsigned* bar; unsigned x;
    volatile LAS unsigned* st;
};

__device__ __forceinline__ XcdBarrier xcd_barrier_post(unsigned* bar, volatile LAS unsigned* st, int wv) {
    XcdBarrier b; b.bar = bar; b.x = xb_xcc_id(); b.st = st;
    if (get_tid(wv) == 0) (void)xb_add(&bar[XB_XCNT(b.x)], 1u);
    return b;
}
__device__ __forceinline__ void xcd_barrier_complete(unsigned* bar, unsigned x, unsigned& nloc, unsigned& nx) {
    const unsigned G = gridDim.x * gridDim.y * gridDim.z;
    unsigned sum, cnt, mine, sp = 0u;
    for (;;) {
        sum = 0u; cnt = 0u; mine = 0u;
#pragma unroll
        for (unsigned j = 0; j < 16; ++j) { const unsigned c = xb_ld(&bar[XB_XCNT(j)]); sum += c; cnt += (c > 0u) ? 1u : 0u; mine = (j == x) ? c : mine; }
        if (sum == G) break;
        __builtin_amdgcn_s_sleep(1);
        if ((++sp & 255u) == 0u) { if (xb_ld(&bar[XB_TMO])) break; if (sp > XB_SPIN_CAP) { atomicAdd(&bar[XB_TMO], 1u); break; } }
    }
    nloc = mine > 0u ? mine : 1u; nx = cnt > 0u ? cnt : 1u;
}

__device__ __forceinline__ void xcd_barrier(const XcdBarrier& b, int wv) {
    asm volatile("s_waitcnt vmcnt(0)" ::: "memory");
    __syncthreads();
    if (get_tid(wv) == 0) {
        unsigned* bar = b.bar;
        __builtin_amdgcn_s_waitcnt(0);
        unsigned nloc = b.st[0], nx = b.st[1];
        if (nloc == 0u) { xcd_barrier_complete(bar, b.x, nloc, nx); b.st[0] = nloc; b.st[1] = nx; }
        const unsigned old = xb_add(&bar[XB_XSUB(b.x)], 1u);
        const unsigned gen = old / nloc;
        if (old + 1u == (gen + 1u) * nloc) {
            __builtin_amdgcn_fence(__ATOMIC_RELEASE, "agent");
            asm volatile("s_waitcnt vmcnt(0)" ::: "memory");
            const unsigned og = xb_add(&bar[XB_TOP], 1u);
            const unsigned tg = og / nx;
            if (og + 1u == (tg + 1u) * nx) xb_add(&bar[XB_TOPGEN], 1u);
            else XB_SPIN(xb_ld(&bar[XB_TOPGEN]) == tg, bar);
            __builtin_amdgcn_fence(__ATOMIC_ACQUIRE, "agent");
            xb_add(&bar[XB_XGEN(b.x)], 1u);
            asm volatile("s_waitcnt vmcnt(0)" ::: "memory");
        } else {
            XB_SPIN(xb_ld(&bar[XB_XGEN(b.x)]) == gen, bar);
            __builtin_amdgcn_fence(__ATOMIC_ACQUIRE, "agent");
            asm volatile("s_waitcnt vmcnt(0)" ::: "memory");
        }
    }
    __syncthreads();
}

constexpr int PARAM_OFF = LDS_BYTES - 256;
static_assert(G2_END <= PARAM_OFF && sizeof(Params) <= 208, "LDS map");
DI const float* ld_uptr(const LAS unsigned long long* s, int i) {
    const unsigned long long v = s[i];
    const unsigned lo = __builtin_amdgcn_readfirstlane((unsigned)v), hi = __builtin_amdgcn_readfirstlane((unsigned)(v >> 32));
    return (const float*)(const __attribute__((address_space(1))) float*)(((unsigned long long)hi << 32) | lo);
}
DI Params load_params(LAS unsigned char* lds) {
    LAS unsigned char* pb = lds + PARAM_OFF; asm volatile("" : "+v"(pb));
    const LAS unsigned long long* s = (const LAS unsigned long long*)pb;
    Params Q;
    Q.x = ld_uptr(s, 0); Q.c = ld_uptr(s, 1); Q.ctx = ld_uptr(s, 2); Q.c_ctx = ld_uptr(s, 3); Q.ada_w = ld_uptr(s, 4); Q.ada_b = ld_uptr(s, 5); Q.norm_w = ld_uptr(s, 6);
    Q.ev_w_in = ld_uptr(s, 7); Q.ev_conv_w = ld_uptr(s, 8); Q.ev_conv_b = ld_uptr(s, 9); Q.ev_rg_wx = ld_uptr(s, 10); Q.ev_rg_bx = ld_uptr(s, 11); Q.ev_rg_wa = ld_uptr(s, 12);
    Q.ev_rg_ba = ld_uptr(s, 13); Q.ev_rg_lambda = ld_uptr(s, 14); Q.ev_sink = ld_uptr(s, 15); Q.ev_w_out = ld_uptr(s, 16); Q.od_w_in = ld_uptr(s, 17); Q.od_lb_raw = ld_uptr(s, 18);
    Q.od_gnorm_w = ld_uptr(s, 19); Q.od_w_out = ld_uptr(s, 20); Q.final_norm_w = ld_uptr(s, 21); Q.out = (float*)ld_uptr(s, 22); Q.ws = (unsigned char*)ld_uptr(s, 23);
    Q.ph_lo = 0; Q.ph_hi = 0;
    return Q;
}
DI void run_phase(LAS unsigned char* lds, int ph, int wv) {
    #ifndef PHMASK
#define PHMASK 0xffff
#endif
    if (ph == 0) { if (PHMASK & 1) { const Params P = load_params(lds); phase_pro(P, lds, wv); __syncthreads(); phase_convert(P, lds, 0, wv); } return; }
    const int layer = (ph - 1) / 5, sub = (ph - 1) % 5, j = layer >> 1;
    const bool even = (layer & 1) == 0;
    if (sub == 0) { if (PHMASK & 4) { const Params P = load_params(lds); phase_norm(P, lds, layer, wv); } return; }
    if (sub == 1) {
        const Params P = load_params(lds); bf16_t* pbuf = (bf16_t*)(P.ws + WS_P);
        const int N = even ? EVEN_IN : ODD_IN;
        pg8::Gemm gm{(const bf16_t*)(P.ws + WS_OV), (const bf16_t*)(P.ws + WS_WIN), MROWS, N, 1024, 1024};
        pg8::StaticOrder S; S.init(MROWS, N, (int)gridDim.x, get_bid());
        EpiStoreBf16 E{pbuf, N};
        if (even) S.limit = 1280;
        if (PHMASK & 8) pg8::gemm_phase<EpiStoreBf16, pg8::StaticOrder, true, true>(lds, gm, S, E, wv);
        if (even) {
            for (int t = get_bid(); t < 128; t += gridDim.x) {
                pg8::Unit u; S.tile_of(1280 + (t >> 3), u);
                const int m0 = 256 * u.pm + 64 * ((t & 7) >> 1), n0 = 256 * u.pn + 128 * (t & 1);
                auto epi = [&](const f32x16& acc, int row0, int col, int hh) {
#pragma unroll
                    for (int i = 0; i < 16; ++i) pbuf[(size_t)(m0 + row0 + crow(i, hh)) * N + n0 + col] = (bf16_t)f2bf(acc[i]);
                };
                mini_gemm_tile(lds, (const bf16_t*)(P.ws + WS_OV) + (size_t)m0 * 1024, 1024, (const bf16_t*)(P.ws + WS_WIN) + (size_t)n0 * 1024, 1024, epi, wv);
            }
        }
        return;
    }
    if (sub == 2) {
        const Params P = load_params(lds);
        if (even) {
            constexpr int NRG = NB * NCHUNK * 8;
#if defined(SPLIT_ATTN)
            for (int it = get_bid(); it < NRG; it += gridDim.x) rglru_item(P, lds, j, it, wv);
#else
            for (int it = get_bid(); it < NRG + 576; it += gridDim.x) {
                if (it < NRG) { if (PHMASK & 32) rglru_item(P, lds, j, it, wv); } else { if (PHMASK & 16) attn_item(P, lds, j, it - NRG, wv); }
            }
#endif
        } else {
            for (int it = get_bid(); it < 256; it += gridDim.x) { if (PHMASK & 64) { if (it & 2) gla2_item<1>(P, lds, j, it >> 5, (it >> 2) & 7, it & 1, wv); else gla2_item<0>(P, lds, j, it >> 5, (it >> 2) & 7, it & 1, wv); } }
        }
        return;
    }
    if (sub == 3) {
        const Params P = load_params(lds);
        if (!even) { if (PHMASK & 256) phase_readout(P, j, wv); }
#if defined(SPLIT_ATTN)
        else { for (int it = get_bid(); it < 576; it += gridDim.x) attn_item(P, lds, j, it, wv); }
#endif
        return;
    }
    {
        const Params P = load_params(lds); bf16_t* pbuf = (bf16_t*)(P.ws + WS_P);
        const int K = even ? 2048 : 1024, lda = even ? EVEN_IN : ODD_IN;
        pg8::Gemm gm{pbuf + (even ? 1536 : 4096), (const bf16_t*)(P.ws + WS_WOUT), MROWS, 1024, K, lda};
        pg8::StaticOrder S; S.init(NB * SEQ, 1024, (int)gridDim.x, get_bid(), 1);
        const float* hl = layer == 0 ? P.x : P.out; const float* hc = layer == 0 ? P.ctx : (const float*)(P.ws + WS_HCTX);
        const float* modb = (const float*)(P.ws + WS_MOD);
        EpiResidNorm E{hl, P.out, modb + (size_t)layer * 9 * 3072 + 2048, layer < 3 ? P.norm_w + (layer + 1) * 1024 : P.final_norm_w,
                       layer < 3 ? modb + (size_t)(layer + 1) * 9 * 3072 : nullptr, (bf16_t*)(P.ws + WS_OV), (float*)(P.ws + WS_AGG), (unsigned*)(P.ws + WS_CTL) + 12288 + layer * 1024};
        if (PHMASK & 512) pg8::gemm_phase<EpiResidNorm, pg8::StaticOrder, false, true>(lds, gm, S, E, wv);
        if (layer < 3) {
            for (int t = get_bid(); t < 256; t += gridDim.x) {
                const int mt = t >> 3, nt = t & 7, mc0 = 64 * mt, bctx = mc0 >> 8, n0 = 128 * nt;
                const bf16_t* At = pbuf + ((size_t)bctx * LT + (mc0 & 255)) * lda + (even ? 1536 : 4096);
                const float* gctx = (const float*)(P.ws + WS_MOD) + (size_t)layer * 9 * 3072 + 2048 + 8 * 3072;
                float* hco = (float*)(P.ws + WS_HCTX);
                auto epi = [&](const f32x16& acc, int row0, int col, int hh) {
                    const float gate = gctx[n0 + col];
#pragma unroll
                    for (int i = 0; i < 16; ++i) { const size_t off = (size_t)(mc0 + row0 + crow(i, hh)) * DM + n0 + col; hco[off] = hc[off] + gate * acc[i]; }
                };
                mini_gemm_tile(lds, At, lda, (const bf16_t*)(P.ws + WS_WOUT) + (size_t)n0 * K, K, epi, wv);
            }
        }
    }
}

__global__ void __launch_bounds__(512, 2) mega(Params P) {
    extern __shared__ __attribute__((aligned(16))) unsigned char lds_raw[];
    LAS unsigned char* lds = (LAS unsigned char*)lds_raw;
    cg::grid_group grid = cg::this_grid();
    const int wv = __builtin_amdgcn_readfirstlane((int)(threadIdx.x >> 6));
    if (get_tid(wv) == 0) {
#if defined(TP_ID)
        ((LAS unsigned long long*)(lds + 163840 - 32))[0] = 0ull; ((LAS unsigned long long*)(lds + 163840 - 32))[1] = 0ull;
#endif
        ((LAS unsigned*)(lds + PARAM_OFF + 208))[0] = 0u; ((LAS unsigned*)(lds + PARAM_OFF + 208))[1] = 0u;
        LAS unsigned long long* d = (LAS unsigned long long*)(lds + PARAM_OFF);
        d[0] = (unsigned long long)P.x; d[1] = (unsigned long long)P.c; d[2] = (unsigned long long)P.ctx; d[3] = (unsigned long long)P.c_ctx; d[4] = (unsigned long long)P.ada_w;
        d[5] = (unsigned long long)P.ada_b; d[6] = (unsigned long long)P.norm_w; d[7] = (unsigned long long)P.ev_w_in; d[8] = (unsigned long long)P.ev_conv_w; d[9] = (unsigned long long)P.ev_conv_b;
        d[10] = (unsigned long long)P.ev_rg_wx; d[11] = (unsigned long long)P.ev_rg_bx; d[12] = (unsigned long long)P.ev_rg_wa; d[13] = (unsigned long long)P.ev_rg_ba; d[14] = (unsigned long long)P.ev_rg_lambda;
        d[15] = (unsigned long long)P.ev_sink; d[16] = (unsigned long long)P.ev_w_out; d[17] = (unsigned long long)P.od_w_in; d[18] = (unsigned long long)P.od_lb_raw; d[19] = (unsigned long long)P.od_gnorm_w;
        d[20] = (unsigned long long)P.od_w_out; d[21] = (unsigned long long)P.final_norm_w; d[22] = (unsigned long long)P.out; d[23] = (unsigned long long)P.ws;
    }
    __syncthreads();
    const int ph_lo = P.ph_lo, ph_hi = P.ph_hi;
    (void)xcd_barrier_post((unsigned*)(P.ws + WS_CTL) + 4096, (volatile LAS unsigned*)(lds + PARAM_OFF + 208), wv);
#define GRID_SYNC(first) do { if (first) grid.sync(); else { XcdBarrier xb_; xb_.bar = (unsigned*)(load_params(lds).ws + WS_CTL) + 4096; xb_.x = xb_xcc_id(); xb_.st = (volatile LAS unsigned*)(lds + PARAM_OFF + 208); xcd_barrier(xb_, wv); } } while (0)
#if defined(PROBE_S)
    constexpr int PREP = PROBE_E - PROBE_S + 1;
#pragma unroll 1
    for (int seq = ph_lo; seq < ph_hi + PREP; ++seq) {
        if (seq > ph_lo) GRID_SYNC(seq == ph_lo + 1);
        const int ph = seq <= PROBE_E ? seq : seq - PREP;
        run_phase(lds, ph, wv);
    }
#else
#pragma unroll 1
    for (int ph = ph_lo; ph < ph_hi; ++ph) {
#if !defined(SPLIT_ATTN)
        if (ph >= 1 && ph < NPHASE - 1 && (ph - 1) % 5 == 3 && (((ph - 1) / 5) & 1) == 0) continue;
#endif
        TP_START(200, lds, get_tid(wv));
        if (ph > ph_lo) GRID_SYNC(ph == ph_lo + 1);
        TP_STOP(200, lds, get_tid(wv));
#if defined(TP_ID)
        const int kid_ = ph == 0 ? 207 : ((ph - 1) % 5 == 0 ? 205 : ((ph - 1) % 5 == 1 ? 201 : ((ph - 1) % 5 == 2 ? ((((ph - 1) / 5) & 1) ? 203 : 202) : ((ph - 1) % 5 == 3 ? 206 : 204))));
        if (kid_ == TP_ID) TP_START(TP_ID, lds, get_tid(wv));
#endif
        run_phase(lds, ph, wv);
#if defined(TP_ID)
        if (kid_ == TP_ID) TP_STOP(TP_ID, lds, get_tid(wv));
#endif
    }
#endif
#if defined(TP_ID)
    if (get_tid(wv) == 0 && blockIdx.x == TP_BLOCK) {
        const unsigned long long acc = ((LAS unsigned long long*)(lds + 163840 - 32))[1], t0 = __builtin_amdgcn_s_memrealtime();
        while (__builtin_amdgcn_s_memrealtime() - t0 < (unsigned long long)TP_AMP * acc) __builtin_amdgcn_s_sleep(8);
    }
#endif
}

extern "C" void kernel_launch(void* const* d_in, const int* in_sizes, int n_in, void* d_out, int out_size, void* d_ws, size_t ws_size, hipStream_t stream) {
    static int grid = 0;
    if (grid == 0) {
        if (n_in != 22 || ws_size < WS_END) { fprintf(stderr, "kernel_launch: unexpected inputs (n_in %d, ws %zu)\n", n_in, ws_size); grid = -1; return; }
        int dev = 0, cus = 0, per_cu = 0;
        hipGetDevice(&dev);
        hipDeviceGetAttribute(&cus, hipDeviceAttributeMultiprocessorCount, dev);
        if (hipFuncSetAttribute((const void*)mega, hipFuncAttributeMaxDynamicSharedMemorySize, LDS_BYTES) != hipSuccess) { fprintf(stderr, "kernel_launch: hipFuncSetAttribute failed\n"); grid = -1; return; }
        if (hipOccupancyMaxActiveBlocksPerMultiprocessor(&per_cu, (const void*)mega, 512, LDS_BYTES) != hipSuccess || per_cu < 1) { fprintf(stderr, "kernel_launch: occupancy query gives %d\n", per_cu); per_cu = 1; }
        (void)hipGetLastError();
        if (cus < 256) { fprintf(stderr, "kernel_launch: this kernel needs 256 co-resident workgroups (device reports %d CUs)\n", cus); grid = -1; return; }
        grid = 256;
    }
    if (grid < 0) return;
    if (hipMemsetAsync((char*)d_ws + WS_CTL, 0, 65536, stream) != hipSuccess) { fprintf(stderr, "kernel_launch: memset failed\n"); return; }
    Params P{};
    const float** pp = (const float**)&P;
    for (int i = 0; i < 22; ++i) pp[i] = (const float*)d_in[i];
    P.out = (float*)d_out; P.ws = (unsigned char*)d_ws;
#if ONE_LAUNCH
    P.ph_lo = 0; P.ph_hi = NPHASE;
    { void* args[] = {&P}; hipError_t e = hipLaunchCooperativeKernel((const void*)mega, dim3(grid), dim3(512), args, LDS_BYTES, stream);
      if (e != hipSuccess) fprintf(stderr, "cooperative launch failed: %s (grid %d)\n", hipGetErrorString(e), grid); }
#else
    for (int ph = 0; ph < NPHASE; ++ph) {
        P.ph_lo = ph; P.ph_hi = ph + 1;
        void* args[] = {&P}; hipError_t e = hipLaunchCooperativeKernel((const void*)mega, dim3(grid), dim3(512), args, LDS_BYTES, stream);
        if (e != hipSuccess) { fprintf(stderr, "launch %d failed: %s (grid %d)\n", ph, hipGetErrorString(e), grid); break; }
    }
#endif
}
```

```cpp
#include <hip/hip_runtime.h>
#include <hip/hip_cooperative_groups.h>
#include <cstdio>
#include <cstdint>
namespace cg = cooperative_groups;

#ifndef ONE_LAUNCH
#define ONE_LAUNCH 1
#endif

#define DI __device__ __forceinline__
#define LAS __attribute__((address_space(3)))
__device__ __forceinline__ int lane_nh() { int l; asm volatile("v_mbcnt_lo_u32_b32 %0, -1, 0\n\tv_mbcnt_hi_u32_b32 %0, -1, %0" : "=v"(l)); return l; }
__device__ __forceinline__ int get_tid(int wv) { asm volatile("" : "+s"(wv)); return wv * 64 + lane_nh(); }
__device__ __forceinline__ float shfl_xor_f(float v, int o) { return __int_as_float(__builtin_amdgcn_ds_bpermute((lane_nh() ^ o) << 2, __float_as_int(v))); }
__device__ __forceinline__ int get_bid() { int b = blockIdx.x; asm volatile("" : "+s"(b)); return b; }

#if defined(TP_ID)
#ifndef TP_BLOCK
#define TP_BLOCK 5
#endif
#ifndef TP_AMP
#define TP_AMP 16
#endif
#define TP_START(id, lds, tid_) do { if ((id) == TP_ID) { __builtin_amdgcn_sched_barrier(0); if ((tid_) == 0 && blockIdx.x == TP_BLOCK) { ((LAS unsigned long long*)((lds) + 163840 - 32))[0] = __builtin_amdgcn_s_memrealtime(); } __builtin_amdgcn_sched_barrier(0); } } while (0)
#define TP_STOP(id, lds, tid_) do { if ((id) == TP_ID) { __builtin_amdgcn_sched_barrier(0); if ((tid_) == 0 && blockIdx.x == TP_BLOCK) { LAS unsigned long long* w_ = (LAS unsigned long long*)((lds) + 163840 - 32); w_[1] += __builtin_amdgcn_s_memrealtime() - w_[0]; } __builtin_amdgcn_sched_barrier(0); } } while (0)
#else
#define TP_START(id, lds, tid_) do { } while (0)
#define TP_STOP(id, lds, tid_) do { } while (0)
#endif
namespace pg8 {
#define PG8_LAS __attribute__((address_space(3)))
typedef unsigned short bf16_t;
typedef short bf16x8 __attribute__((ext_vector_type(8)));
typedef float f32x4 __attribute__((ext_vector_type(4)));
typedef unsigned u32x4 __attribute__((ext_vector_type(4)));
constexpr int BM = 256, BK = 64, HALF = 128, HTB = HALF * BK * 2  , STAGE_BYTES = 8 * HTB, NXCD = 8, WGM = 8;

__host__ __device__ __forceinline__ int lds_byte(int r, int c) { const int st = (r >> 4) * 2 + (c >> 5), rr = r & 15, cc = c & 31, ob = rr * 64 + cc * 2; return st * 1024 + (ob ^ (((ob >> 9) & 1) << 5)); }
__host__ __device__ __forceinline__ void stage_rc(int b, int& R, int& C) { const int st = b / 1024, sb = b % 1024, swz = sb ^ (((sb >> 9) & 1) << 5); R = (st >> 1) * 16 + swz / 64; C = (st & 1) * 32 + (swz % 64) / 2; }
__host__ __device__ __forceinline__ int perm32(int rho) { const int n = rho >> 4, i = rho & 15; return 8 * (i >> 2) + 4 * n + (i & 3); }

struct Unit { int pm, pn; };
struct Gemm { const bf16_t* A; const bf16_t* Bt; int M, N, K, lda; };

struct StaticOrder {
    int nM, nN, nwg, G, c, lat_only, limit;
    __host__ __device__ void init(int M, int N, int G_, int c_, int lat_only_ = 0) { nM = M / BM; nN = N / BM; nwg = nM * nN; G = G_; c = c_; lat_only = lat_only_; limit = nwg; }
    __host__ __device__ bool next(int i, Unit& u) const {
        const long L = (long)i * G + c; if (L >= limit) return false;
        tile_of((int)L, u); return true;
    }
    __host__ __device__ void tile_of(int L, Unit& u) const {
        int wgid = L; { const int q = nwg / NXCD, r = nwg % NXCD, xcd = wgid % NXCD, off = wgid / NXCD; wgid = (xcd < r ? xcd * (q + 1) : r * (q + 1) + (xcd - r) * q) + off; }
        const int nig = WGM * nN, gid = wgid / nig, fm = gid * WGM, gsz = (nM - fm) < WGM ? (nM - fm) : WGM;
        u.pm = fm + ((wgid % nig) % gsz); u.pn = (wgid % nig) / gsz; if (lat_only) u.pm = 9 * (u.pm >> 3) + 1 + (u.pm & 7);
    }
    __device__ __forceinline__ void a_ready(const Unit&) const {}
    __device__ __forceinline__ void done(const Unit&) const {}
};

template <class Epi, class Sched, bool ALIGN_EPI = false, bool SP2 = false>
__device__ __forceinline__ void gemm_phase(PG8_LAS unsigned char* lds, const Gemm g, const Sched& S, const Epi& E, int wv) {
    const int tid = get_tid(wv), wid = __builtin_amdgcn_readfirstlane(tid >> 6), lane = tid & 63, wr = wid >> 2, wc = wid & 3, fr = lane & 15, fq = lane >> 4;
    const int K = g.K, nt = K / BK;
    unsigned voffA[2], voffB[2];
#pragma unroll
    for (int i = 0; i < 2; ++i) { int R, C; stage_rc(tid * 16 + i * 8192, R, C); const int Rb = Epi::PERM ? ((R & ~31) + perm32(R & 31)) : R;
        voffA[i] = (unsigned)(R * g.lda + C) * 2u; voffB[i] = (unsigned)(Rb * K + C) * 2u; }
    const size_t kstep = (size_t)(BK * 2);
    const size_t hstepA = (size_t)HALF * g.lda * 2, hstepB = (size_t)HALF * K * 2;
    const size_t tstepA = 2 * hstepA, tstepB = 2 * hstepB;
    const unsigned ldsw = (unsigned)wid * 1024u;
    const int aoff = lds_byte(wr * 64 + fr, fq * 8), boff = lds_byte(wc * 32 + fr, fq * 8);
#define PG8_SA(b, h) (((b) * 2 + (h)) * HTB)
#define PG8_SB(b, h) ((4 + (b) * 2 + (h)) * HTB)
#define PG8_STAGE(bufoff, gbase, voff) do { _Pragma("unroll") for (int _i = 0; _i < 2; ++_i) \
        __builtin_amdgcn_global_load_lds((const unsigned*)((const char*)(gbase) + (voff)[_i]), (PG8_LAS unsigned*)(lds + (bufoff) + ldsw + _i * 8192), 16, 0, 0); } while (0)
#define PG8_LDA(dst, b, h) do { _Pragma("unroll") for (int m = 0; m < 4; ++m) _Pragma("unroll") for (int k = 0; k < 2; ++k) dst[m][k] = *(const PG8_LAS bf16x8*)(lds + PG8_SA(b, h) + aoff + m * 2048 + k * 1024); } while (0)
#define PG8_LDB(dst, b, h) do { _Pragma("unroll") for (int n = 0; n < 2; ++n) _Pragma("unroll") for (int k = 0; k < 2; ++k) dst[n][k] = *(const PG8_LAS bf16x8*)(lds + PG8_SB(b, h) + boff + n * 2048 + k * 1024); } while (0)
#define PG8_MMA(ai, bj, At, Bt) do { __builtin_amdgcn_s_setprio(1); _Pragma("unroll") for (int m = 0; m < 4; ++m) _Pragma("unroll") for (int n = 0; n < 2; ++n) _Pragma("unroll") for (int k = 0; k < 2; ++k) \
        acc[ai][bj][m][n] = __builtin_amdgcn_mfma_f32_16x16x32_bf16(Bt[n][k], At[m][k], acc[ai][bj][m][n], 0, 0, 0); __builtin_amdgcn_s_setprio(0); } while (0)
#define PG8_WAIT_V(n) asm volatile("s_waitcnt vmcnt(" #n ")" ::: "memory")
#define PG8_WAIT_L(n) asm volatile("s_waitcnt lgkmcnt(" #n ")" ::: "memory")
#define PG8_BAR __builtin_amdgcn_s_barrier()
#define PG8_SCHED __builtin_amdgcn_sched_barrier(0)
    Unit cur, nxt; int ui = 0;
    if (!S.next(0, cur)) return;
    f32x4 acc[2][2][4][2];
#pragma unroll
    for (int a = 0; a < 2; ++a)
#pragma unroll
        for (int b = 0; b < 2; ++b)
#pragma unroll
            for (int m = 0; m < 4; ++m)
#pragma unroll
                for (int n = 0; n < 2; ++n) acc[a][b][m][n] = (f32x4){0.f, 0.f, 0.f, 0.f};
    bf16x8 At[4][2], B0[2][2], B1[2][2];
    const char* cA = (const char*)g.A + (size_t)cur.pm * tstepA; const char* cB = (const char*)g.Bt + (size_t)cur.pn * tstepB;
    S.a_ready(cur);
    if constexpr (SP2) {
        PG8_STAGE(PG8_SB(0, 0), cB, voffB); PG8_STAGE(PG8_SB(0, 1), cB + hstepB, voffB); PG8_STAGE(PG8_SA(0, 0), cA, voffA); PG8_STAGE(PG8_SA(0, 1), cA + hstepA, voffA);
        if (wr == 1) PG8_BAR;
        PG8_WAIT_V(2); PG8_BAR;
        PG8_STAGE(PG8_SB(1, 0), cB + kstep, voffB); PG8_STAGE(PG8_SA(1, 0), cA + kstep, voffA); PG8_STAGE(PG8_SB(1, 1), cB + hstepB + kstep, voffB);
        PG8_WAIT_V(6); PG8_BAR;
    } else {
        PG8_STAGE(PG8_SB(0, 0), cB, voffB); PG8_STAGE(PG8_SA(0, 0), cA, voffA); PG8_STAGE(PG8_SB(0, 1), cB + hstepB, voffB); PG8_STAGE(PG8_SA(0, 1), cA + hstepA, voffA);
        if (wr == 1) PG8_BAR;
        PG8_WAIT_V(4); PG8_BAR;
        PG8_STAGE(PG8_SB(1, 0), cB + kstep, voffB); PG8_STAGE(PG8_SA(1, 0), cA + kstep, voffA); PG8_STAGE(PG8_SB(1, 1), cB + hstepB + kstep, voffB);
        PG8_WAIT_V(6); PG8_BAR;
    }
    for (;;) {
        const bool has_next = S.next(ui + 1, nxt);
        const char* nA = has_next ? (const char*)g.A + (size_t)nxt.pm * tstepA : cA; const char* nB = has_next ? (const char*)g.Bt + (size_t)nxt.pn * tstepB : cB;
        for (int t = 0; t < nt; t += 2) {
            const bool last = (t == nt - 2);
            const char* a1 = cA + (size_t)(t + 1) * kstep;
            const char* a2 = last ? nA : cA + (size_t)(t + 2) * kstep; const char* b2 = last ? nB : cB + (size_t)(t + 2) * kstep;
            const char* a3 = a2 + kstep; const char* b3 = b2 + kstep;
            if (last && has_next) S.a_ready(nxt);
            if constexpr (SP2) {
            PG8_LDB(B0, 0, 0); PG8_LDB(B1, 0, 1); PG8_SCHED; PG8_LDA(At, 0, 0); PG8_STAGE(PG8_SA(1, 1), a1 + hstepA, voffA);
            PG8_WAIT_V(8); PG8_WAIT_L(0); PG8_BAR; PG8_MMA(0, 0, At, B0); PG8_MMA(0, 1, At, B1); PG8_BAR; PG8_SCHED;
            PG8_LDA(At, 0, 1); PG8_STAGE(PG8_SB(0, 0), b2, voffB); PG8_STAGE(PG8_SB(0, 1), b2 + hstepB, voffB); PG8_STAGE(PG8_SA(0, 0), a2, voffA);
            PG8_WAIT_V(8); PG8_WAIT_L(0); PG8_BAR; PG8_MMA(1, 0, At, B0); PG8_MMA(1, 1, At, B1); PG8_BAR; PG8_SCHED;
            PG8_LDB(B0, 1, 0); PG8_LDB(B1, 1, 1); PG8_SCHED; PG8_LDA(At, 1, 0); PG8_STAGE(PG8_SA(0, 1), a2 + hstepA, voffA);
            PG8_WAIT_V(8); PG8_WAIT_L(0); PG8_BAR; PG8_MMA(0, 0, At, B0); PG8_MMA(0, 1, At, B1); PG8_BAR; PG8_SCHED;
            PG8_LDA(At, 1, 1); PG8_STAGE(PG8_SB(1, 0), b3, voffB); PG8_STAGE(PG8_SB(1, 1), b3 + hstepB, voffB); PG8_STAGE(PG8_SA(1, 0), a3, voffA);
            PG8_WAIT_V(8); PG8_WAIT_L(0); PG8_BAR; PG8_MMA(1, 0, At, B0); PG8_MMA(1, 1, At, B1); PG8_BAR; PG8_SCHED;
            } else {
            PG8_LDB(B0, 0, 0); PG8_SCHED; PG8_LDA(At, 0, 0); PG8_STAGE(PG8_SA(1, 1), a1 + hstepA, voffA);
            PG8_WAIT_L(8); PG8_BAR; PG8_WAIT_L(0); PG8_MMA(0, 0, At, B0); PG8_BAR; PG8_SCHED;
            PG8_LDB(B1, 0, 1); PG8_STAGE(PG8_SB(0, 0), b2, voffB);
            PG8_BAR; PG8_WAIT_L(0); PG8_MMA(0, 1, At, B1); PG8_BAR;
            PG8_LDA(At, 0, 1); PG8_STAGE(PG8_SA(0, 0), a2, voffA);
            PG8_BAR; PG8_WAIT_L(0); PG8_MMA(1, 0, At, B0); PG8_BAR; PG8_SCHED;
            PG8_STAGE(PG8_SB(0, 1), b2 + hstepB, voffB);
            PG8_WAIT_V(6); PG8_BAR; PG8_MMA(1, 1, At, B1); PG8_BAR;
            PG8_LDB(B0, 1, 0); PG8_SCHED; PG8_LDA(At, 1, 0); PG8_STAGE(PG8_SA(0, 1), a2 + hstepA, voffA);
            PG8_WAIT_L(8); PG8_BAR; PG8_WAIT_L(0); PG8_MMA(0, 0, At, B0); PG8_BAR; PG8_SCHED;
            PG8_LDB(B1, 1, 1); PG8_STAGE(PG8_SB(1, 0), b3, voffB);
            PG8_BAR; PG8_WAIT_L(0); PG8_MMA(0, 1, At, B1); PG8_BAR;
            PG8_LDA(At, 1, 1); PG8_STAGE(PG8_SA(1, 0), a3, voffA);
            PG8_BAR; PG8_WAIT_L(0); PG8_MMA(1, 0, At, B0); PG8_BAR; PG8_SCHED;
            PG8_STAGE(PG8_SB(1, 1), b3 + hstepB, voffB);
            PG8_WAIT_V(6); PG8_BAR; PG8_MMA(1, 1, At, B1); PG8_BAR;
            }
        }
        if constexpr (ALIGN_EPI) { if (wr == 0) PG8_BAR; }
        if constexpr (!Epi::AFTER_DRAIN) { E(acc, cur, wr, wc, fr, fq); S.done(cur); }
        if (!has_next) break;
#pragma unroll
        for (int a = 0; a < 2; ++a)
#pragma unroll
            for (int b = 0; b < 2; ++b)
#pragma unroll
                for (int m = 0; m < 4; ++m)
#pragma unroll
                    for (int n = 0; n < 2; ++n) acc[a][b][m][n] = (f32x4){0.f, 0.f, 0.f, 0.f};
        cur = nxt; cA = nA; cB = nB; ++ui;
        if constexpr (ALIGN_EPI) { if (wr == 1) PG8_BAR; }
    }
    PG8_WAIT_V(0);
    if constexpr (!ALIGN_EPI) { if (wr == 0) PG8_BAR; }
    PG8_BAR;
    if constexpr (Epi::AFTER_DRAIN) { E.fused(acc, cur, wr, wc, fr, fq, lds, wid, lane); S.done(cur); }
#undef PG8_SA
#undef PG8_SB
#undef PG8_STAGE
#undef PG8_LDA
#undef PG8_LDB
#undef PG8_MMA
#undef PG8_WAIT_V
#undef PG8_WAIT_L
#undef PG8_BAR
#undef PG8_SCHED
}
}

typedef unsigned short bf16_t;
typedef short bf16x8 __attribute__((ext_vector_type(8)));
typedef short s16x4 __attribute__((ext_vector_type(4)));
typedef float f32x4 __attribute__((ext_vector_type(4)));
typedef float f32x16 __attribute__((ext_vector_type(16)));
typedef unsigned u32x4 __attribute__((ext_vector_type(4)));
typedef unsigned u32x2 __attribute__((ext_vector_type(2)));
typedef float f32x2 __attribute__((ext_vector_type(2)));

constexpr int DM = 1024, NB = 8, SEQ = 2048, CTXL = 256, LT = SEQ + CTXL  , MROWS = NB * LT  ;
constexpr int EVEN_IN = 4608, ODD_IN = 5120, NCHUNK = LT / 64  ;
constexpr float RMS_EPS = 1e-6f, LOG2E = 1.4426950408889634f;
constexpr int LDS_BYTES = 160 * 1024;
constexpr int NPHASE = 21;

constexpr size_t WS_CTL = 0;
constexpr size_t WS_MOD = 65536;
constexpr size_t WS_ROPE = 524288;
constexpr size_t WS_AGG = 1048576;
constexpr size_t WS_HCTX = WS_AGG + 4718592;
constexpr size_t WS_WIN = WS_HCTX + 8388608;
constexpr size_t WS_WOUT = WS_WIN + 10485760;
constexpr size_t WS_WRG = WS_WOUT + 4194304;
constexpr size_t WS_OV = WS_WRG + 1048576;
constexpr size_t WS_P = WS_OV + 37748736;
constexpr size_t WS_END = WS_P + 188743680;
static_assert(WS_END <= 268435456, "workspace map exceeds 256 MiB");

struct Params {
    const float *x, *c, *ctx, *c_ctx, *ada_w, *ada_b, *norm_w, *ev_w_in, *ev_conv_w, *ev_conv_b, *ev_rg_wx, *ev_rg_bx, *ev_rg_wa, *ev_rg_ba,
        *ev_rg_lambda, *ev_sink, *ev_w_out, *od_w_in, *od_lb_raw, *od_gnorm_w, *od_w_out, *final_norm_w;
    float* out; unsigned char* ws; int ph_lo, ph_hi;
};

DI float bf2f(unsigned short v) { return __uint_as_float((unsigned)v << 16); }
DI unsigned f2bf(float f) { unsigned u = __float_as_uint(f); return (u + 0x7fffu + ((u >> 16) & 1u)) >> 16; }
typedef __bf16 bf16x2_hw __attribute__((ext_vector_type(2)));
DI unsigned pk2(float lo, float hi) { const f32x2 v = {lo, hi}; return __builtin_bit_cast(unsigned, __builtin_convertvector(v, bf16x2_hw)); }
DI float sigm(float x) { return __builtin_amdgcn_rcpf(1.f + __expf(-x)); }
DI float softplus_neg(float lam) {
    const float e = __expf(-lam);
    return e < 0.06f ? e * (1.f + e * (-0.5f + e * (0.33333333f + e * (-0.25f + e * 0.2f)))) : __logf(1.f + e);
}
DI float neg_expm1(float x) {
    return x > -0.25f ? -x * (1.f + x * (0.5f + x * (0.16666667f + x * (0.041666668f + x * (0.0083333338f + x * 0.0013888889f))))) : 1.f - __expf(x);
}
DI float wave_sum(float v) {
#pragma unroll
    for (int o = 1; o < 64; o <<= 1) v += shfl_xor_f(v, o);
    return v;
}
DI int crow(int reg, int h) { return (reg & 3) + 8 * (reg >> 2) + 4 * h; }
#define MFMA16(a, b, c) __builtin_amdgcn_mfma_f32_16x16x32_bf16((a), (b), (c), 0, 0, 0)
#define MFMA32(a, b, c) __builtin_amdgcn_mfma_f32_32x32x16_bf16((a), (b), (c), 0, 0, 0)

struct EpiStoreBf16 {
    static constexpr bool PERM = true, AFTER_DRAIN = false;
    bf16_t* O; int ldc;
    DI void operator()(const f32x4 (&acc)[2][2][4][2], const pg8::Unit& u, int wr, int wc, int fr, int fq) const {
        const int row0 = u.pm * 256 + wr * 64 + fr, col0 = u.pn * 256 + wc * 32 + 8 * fq;
#pragma unroll
        for (int ai = 0; ai < 2; ++ai)
#pragma unroll
            for (int m = 0; m < 4; ++m) { bf16_t* rowp = O + (size_t)(row0 + ai * 128 + m * 16) * ldc + col0;
#pragma unroll
                for (int bj = 0; bj < 2; ++bj) { const f32x4 v0 = acc[ai][bj][m][0], v1 = acc[ai][bj][m][1];
                    u32x4 w; w.x = pk2(v0[0], v0[1]); w.y = pk2(v0[2], v0[3]); w.z = pk2(v1[0], v1[1]); w.w = pk2(v1[2], v1[3]);
                    *(u32x4*)(rowp + bj * 128) = w; } }
    }
};
struct EpiResid {
    static constexpr bool PERM = false, AFTER_DRAIN = false;
    const float* in_lat; const float* in_ctx; float* out_lat; float* out_ctx; const float* gate;
    DI void operator()(const f32x4 (&acc)[2][2][4][2], const pg8::Unit& u, int wr, int wc, int fr, int fq) const {
        const int b = u.pm / 9, jt = u.pm % 9;
        const float* ib; float* ob; const float* g;
        if (jt == 0) { const size_t off = (size_t)b * CTXL * DM; ib = in_ctx + off; ob = out_ctx + off; g = gate + 8 * 3072; }
        else { const size_t off = ((size_t)b * SEQ + (size_t)(jt - 1) * 256) * DM; ib = in_lat + off; ob = out_lat + off; g = gate + b * 3072; }
        const int col0 = u.pn * 256 + wc * 32 + 4 * fq;
#pragma unroll
        for (int bj = 0; bj < 2; ++bj)
#pragma unroll
            for (int n = 0; n < 2; ++n) {
                const f32x4 gvv = *(const f32x4*)(g + col0 + bj * 128 + n * 16);
#pragma unroll
                for (int ai = 0; ai < 2; ++ai) {
#pragma unroll
                    for (int m = 0; m < 4; ++m) { const int r = ai * 128 + wr * 64 + m * 16 + fr;
                        const size_t off = (size_t)r * DM + col0 + bj * 128 + n * 16;
                        const f32x4 o = *(const f32x4*)(ib + off) + gvv * acc[ai][bj][m][n]; *(f32x4*)(ob + off) = o; }
                    asm volatile("" ::: "memory");
                }
            }
    }
};

struct EpiResidNorm {
    static constexpr bool PERM = false, AFTER_DRAIN = true;
    const float* in_lat; float* out_lat; const float* gate;
    const float* nw; const float* mod_next;
    bf16_t* U; float* xbuf; unsigned* cnt;
    DI void fused(f32x4 (&acc)[2][2][4][2], const pg8::Unit& u, int wr, int wc, int fr, int fq, LAS unsigned char* lds, int wid, int lane) const {
        const int b = u.pm / 9, jt = u.pm % 9, panel = b * 8 + jt - 1;
        const size_t roff = ((size_t)b * SEQ + (size_t)(jt - 1) * 256) * DM;
        const float* ib = in_lat + roff; float* ob = out_lat + roff; const float* g = gate + b * 3072;
        const int col0 = u.pn * 256 + wc * 32 + 4 * fq;
        LAS float* Pw = (LAS float*)lds;
        LAS float* Sr = (LAS float*)(lds + 4096);
        LAS unsigned* flag = (LAS unsigned*)(lds + 5120);
#pragma unroll
        for (int bj = 0; bj < 2; ++bj)
#pragma unroll
            for (int n = 0; n < 2; ++n) {
                const f32x4 gvv = *(const f32x4*)(g + col0 + bj * 128 + n * 16);
#pragma unroll
                for (int ai = 0; ai < 2; ++ai) {
#pragma unroll
                    for (int m = 0; m < 4; ++m) { const int r = ai * 128 + wr * 64 + m * 16 + fr;
                        const size_t off = (size_t)r * DM + col0 + bj * 128 + n * 16;
                        const f32x4 o = *(const f32x4*)(ib + off) + gvv * acc[ai][bj][m][n]; acc[ai][bj][m][n] = o;
                        if (mod_next) *(f32x4*)(ob + off) = o; }
                    asm volatile("" ::: "memory");
                }
            }
#pragma unroll
        for (int ai = 0; ai < 2; ++ai)
#pragma unroll
            for (int m = 0; m < 4; ++m) {
                float s = 0.f;
#pragma unroll
                for (int bj = 0; bj < 2; ++bj)
#pragma unroll
                    for (int n = 0; n < 2; ++n) { const f32x4 x = acc[ai][bj][m][n]; s += (x[0] * x[0] + x[1] * x[1]) + (x[2] * x[2] + x[3] * x[3]); }
                s += shfl_xor_f(s, 16); s += shfl_xor_f(s, 32);
                if (fq == 0) Pw[(ai * 128 + wr * 64 + m * 16 + fr) * 4 + wc] = s;
            }
        asm volatile("s_waitcnt lgkmcnt(0)" ::: "memory"); __builtin_amdgcn_s_barrier(); asm volatile("" ::: "memory");
        const int row = wid * 32 + (lane & 31);
        if (lane < 32) {
            const float t = (Pw[row * 4 + 0] + Pw[row * 4 + 1]) + (Pw[row * 4 + 2] + Pw[row * 4 + 3]);
            __hip_atomic_store((unsigned*)xbuf + ((size_t)panel * 256 + row) * 4 + u.pn, __float_as_uint(t), __ATOMIC_RELAXED, __HIP_MEMORY_SCOPE_AGENT);
        }
        asm volatile("s_waitcnt vmcnt(0)" ::: "memory");
        if (lane == 0) __hip_atomic_fetch_add(cnt + 16 * panel, 1u, __ATOMIC_RELAXED, __HIP_MEMORY_SCOPE_AGENT);
        if (wid == 0) {
            unsigned spins = 0;
            while ((unsigned)__builtin_amdgcn_readfirstlane(__hip_atomic_load(cnt + 16 * panel, __ATOMIC_RELAXED, __HIP_MEMORY_SCOPE_AGENT)) < 32u) { __builtin_amdgcn_s_sleep(2); if (++spins > (1u << 22)) break; }
            if (lane == 0) flag[0] = 1u;
        }
        asm volatile("s_waitcnt vmcnt(0) lgkmcnt(0)" ::: "memory"); __builtin_amdgcn_s_barrier(); asm volatile("" ::: "memory");
        if (lane < 32) {
            const unsigned* slot = (const unsigned*)xbuf + ((size_t)panel * 256 + row) * 4;
            const float t = (__uint_as_float(__hip_atomic_load(slot + 0, __ATOMIC_RELAXED, __HIP_MEMORY_SCOPE_AGENT)) + __uint_as_float(__hip_atomic_load(slot + 1, __ATOMIC_RELAXED, __HIP_MEMORY_SCOPE_AGENT)))
                          + (__uint_as_float(__hip_atomic_load(slot + 2, __ATOMIC_RELAXED, __HIP_MEMORY_SCOPE_AGENT)) + __uint_as_float(__hip_atomic_load(slot + 3, __ATOMIC_RELAXED, __HIP_MEMORY_SCOPE_AGENT)));
            Sr[row] = rsqrtf(t * (1.f / DM) + RMS_EPS);
        }
        asm volatile("s_waitcnt lgkmcnt(0)" ::: "memory"); __builtin_amdgcn_s_barrier(); asm volatile("" ::: "memory");
        const float* sh = mod_next ? mod_next + b * 3072 : nullptr;
#pragma unroll
        for (int bj = 0; bj < 2; ++bj)
#pragma unroll
            for (int n = 0; n < 2; ++n) {
                const int cc = col0 + bj * 128 + n * 16;
                const f32x4 w4 = *(const f32x4*)(nw + cc);
                f32x4 s4 = {1.f, 1.f, 1.f, 1.f}, h4 = {0.f, 0.f, 0.f, 0.f};
                if (mod_next) { s4 = *(const f32x4*)(sh + 1024 + cc) + 1.f; h4 = *(const f32x4*)(sh + cc); }
#pragma unroll
                for (int ai = 0; ai < 2; ++ai)
#pragma unroll
                    for (int m = 0; m < 4; ++m) { const int r = ai * 128 + wr * 64 + m * 16 + fr;
                        const f32x4 y = (acc[ai][bj][m][n] * Sr[r]) * w4;
                        if (mod_next) { const f32x4 o = y * s4 + h4; u32x2 w; w.x = pk2(o[0], o[1]); w.y = pk2(o[2], o[3]); *(u32x2*)(U + ((size_t)u.pm * 256 + r) * DM + cc) = w; }
                        else *(f32x4*)(ob + (size_t)r * DM + cc) = y; }
            }
    }
};

constexpr int MG_STAGE = 52224;
template <class EpiF>
DI void mini_gemm_tile(LAS unsigned char* lds, const bf16_t* A, int lda, const bf16_t* Bt, int K, const EpiF& epi, int wv) {
    const int tid = get_tid(wv), lane = tid & 63, wave = tid >> 6, r = lane & 31, h = lane >> 5, wm = wave >> 2, wn = wave & 3;
    const int lrow = tid >> 4, lch = tid & 15, nS = K / 128;
    const bf16_t* ap = A + (size_t)lrow * lda + 8 * lch;
    const bf16_t* bp = Bt + (size_t)lrow * K + 8 * lch;
    u32x4 s0[6], s1[6];
    f32x16 acc;
#pragma unroll
    for (int i = 0; i < 16; ++i) acc[i] = 0.f;
#define MG_LOAD(set, s) do { (set)[0] = *(const u32x4*)(ap + (s) * 128); (set)[1] = *(const u32x4*)(ap + (size_t)32 * lda + (s) * 128); \
        _Pragma("unroll") for (int q_ = 0; q_ < 4; ++q_) (set)[2 + q_] = *(const u32x4*)(bp + (size_t)(32 * q_) * K + (s) * 128); } while (0)
#define MG_STORE(set, buf) do { LAS unsigned char* b_ = lds + (buf) * MG_STAGE; *(LAS u32x4*)(b_ + lrow * 272 + lch * 16) = (set)[0]; *(LAS u32x4*)(b_ + (32 + lrow) * 272 + lch * 16) = (set)[1]; \
        _Pragma("unroll") for (int q_ = 0; q_ < 4; ++q_) *(LAS u32x4*)(b_ + 17408 + (32 * q_ + lrow) * 272 + lch * 16) = (set)[2 + q_]; } while (0)
#define MG_COMPUTE(buf) do { const LAS unsigned char* b_ = lds + (buf) * MG_STAGE; \
        _Pragma("unroll") for (int ks = 0; ks < 8; ++ks) { \
            const bf16x8 af = *(const LAS bf16x8*)(b_ + (32 * wm + r) * 272 + (16 * ks + 8 * h) * 2); \
            const bf16x8 bf = *(const LAS bf16x8*)(b_ + 17408 + (32 * wn + r) * 272 + (16 * ks + 8 * h) * 2); \
            acc = MFMA32(af, bf, acc); } } while (0)
    MG_LOAD(s0, 0); MG_LOAD(s1, 1);
    __syncthreads();
    MG_STORE(s0, 0);
    if (nS > 2) MG_LOAD(s0, 2);
#pragma unroll 1
    for (int s = 0; s < nS; s += 2) {
        __syncthreads();
        if (s + 1 < nS) { MG_STORE(s1, 1); if (s + 3 < nS) MG_LOAD(s1, s + 3); }
        MG_COMPUTE(0);
        __syncthreads();
        if (s + 2 < nS) { MG_STORE(s0, 0); if (s + 4 < nS) MG_LOAD(s0, s + 4); }
        if (s + 1 < nS) MG_COMPUTE(1);
    }
#undef MG_LOAD
#undef MG_STORE
#undef MG_COMPUTE
    epi(acc, 32 * wm, 32 * wn + r, h);
    __syncthreads();
}

DI void phase_pro(const Params& P, LAS unsigned char* lds, int wv) {
    const int tid = get_tid(wv);
    LAS float* s = (LAS float*)lds;
    LAS float* red = (LAS float*)(lds + 36864);
    float* mod = (float*)(P.ws + WS_MOD);
    for (int i = tid; i < 9 * 1024; i += 512) { const int r = i >> 10, k = i & 1023; const float v = r < 8 ? P.c[r * 1024 + k] : P.c_ctx[k]; s[i] = v * sigm(v); }
    __syncthreads();
    {
        const int ks = tid >> 4, col = tid & 15;
        float wv[3][32];
#pragma unroll
        for (int q = 0; q < 3; ++q) {
            const int item = get_bid() + q * (int)gridDim.x;
            if (item < 768) {
                const int l = item / 192, n0 = (item % 192) * 16;
                const float* w = P.ada_w + (size_t)l * 1024 * 3072 + (size_t)(ks * 32) * 3072 + n0 + col;
#pragma unroll
                for (int kk = 0; kk < 32; ++kk) wv[q][kk] = w[(size_t)kk * 3072];
            }
        }
#pragma unroll
        for (int q = 0; q < 3; ++q) {
            const int item = get_bid() + q * (int)gridDim.x;
            if (item < 768) {
                const int l = item / 192, n0 = (item % 192) * 16;
                float acc[9];
#pragma unroll
                for (int r = 0; r < 9; ++r) acc[r] = 0.f;
#pragma unroll
                for (int kk = 0; kk < 32; ++kk) {
#pragma unroll
                    for (int r = 0; r < 9; ++r) acc[r] += s[r * 1024 + ks * 32 + kk] * wv[q][kk]; }
#pragma unroll
                for (int r = 0; r < 9; ++r) red[(ks * 9 + r) * 16 + col] = acc[r];
                __syncthreads();
                if (tid < 144) { const int r = tid >> 4, cc = tid & 15; float sum = 0.f;
#pragma unroll
                    for (int k2 = 0; k2 < 32; ++k2) sum += red[(k2 * 9 + r) * 16 + cc];
                    mod[(l * 9 + r) * 3072 + n0 + cc] = sum + P.ada_b[l * 3072 + n0 + cc]; }
                __syncthreads();
            }
        }
    }
    float* cos_t = (float*)(P.ws + WS_ROPE); float* sin_t = cos_t + SEQ * 32;
    for (int i = get_bid() * 512 + tid; i < SEQ * 32; i += gridDim.x * 512) {
        const int pos = i >> 5, jj = i & 31, fi = jj & 15;
        const float inv = __builtin_amdgcn_exp2f(-(float)(2 * fi) * (13.287712379549449f / 32.f));
        const float ang = (float)(jj < 16 ? (pos >> 6) : (pos & 63)) * inv;
        cos_t[i] = __cosf(ang); sin_t[i] = __sinf(ang);
    }
}

template <bool FRAG = false>
DI void transpose_item(const float* W, int K, int N, bf16_t* WT, LAS float* scr, int item, int lane) {
    const int nblk = N / 32, kb = item / nblk, nb = item % nblk, k0 = 64 * kb, n0 = 32 * nb;
#pragma unroll 8
    for (int i = 0; i < 32; ++i) { const int kk = 2 * i + (lane >> 5); scr[kk * 33 + (lane & 31)] = W[(size_t)(k0 + kk) * N + n0 + (lane & 31)]; }
    asm volatile("s_waitcnt lgkmcnt(0)" ::: "memory");
    const int c = lane & 7;
#pragma unroll
    for (int j = 0; j < 4; ++j) { const int n = (lane >> 3) + 8 * j; const LAS float* sp = scr + (8 * c) * 33 + n;
        u32x4 o; o.x = pk2(sp[0 * 33], sp[1 * 33]); o.y = pk2(sp[2 * 33], sp[3 * 33]); o.z = pk2(sp[4 * 33], sp[5 * 33]); o.w = pk2(sp[6 * 33], sp[7 * 33]);
        if (FRAG) {
            const int nn = n0 + n, k8 = (k0 >> 3) + c;
            *(u32x4*)(WT + ((((nn >> 4) * 4 + (k8 >> 2)) * 64 + (k8 & 3) * 16 + (nn & 15)) * 8)) = o;
        } else *(u32x4*)(WT + (size_t)(n0 + n) * K + k0 + 8 * c) = o; }
    asm volatile("s_waitcnt lgkmcnt(0)" ::: "memory");
}

DI void phase_convert(const Params& P, LAS unsigned char* lds, int layer, int wv) {
    const int tid = get_tid(wv), lane = tid & 63, wave = tid >> 6;
    const int gw = get_bid() * 8 + wave, NGW = gridDim.x * 8;
    const int j = layer >> 1;
    LAS float* scr = (LAS float*)(lds + wave * 16384);
    bf16_t* WIN = (bf16_t*)(P.ws + WS_WIN); bf16_t* WOUT = (bf16_t*)(P.ws + WS_WOUT); bf16_t* WRG = (bf16_t*)(P.ws + WS_WRG);
    if ((layer & 1) == 0) {
        constexpr int I_IN = 16 * (EVEN_IN / 32), I_OUT = 32 * 32, I_RG = 32 * 8;
        for (int it = gw; it < I_IN + I_OUT + I_RG; it += NGW) {
            int r = it;
            if (r < I_IN) { transpose_item(P.ev_w_in + (size_t)j * 1024 * EVEN_IN, 1024, EVEN_IN, WIN, scr, r, lane); continue; } r -= I_IN;
            if (r < I_OUT) { transpose_item(P.ev_w_out + (size_t)j * 2048 * 1024, 2048, 1024, WOUT, scr, r, lane); continue; } r -= I_OUT;
            const int mat = r >> 3, sub = r & 7;
            const int dir = mat >> 4, gate = (mat >> 3) & 1, hd = mat & 7;
            const float* src = (gate == 0 ? P.ev_rg_wx : P.ev_rg_wa) + ((size_t)((j * 2 + dir) * 8 + hd)) * 16384;
            transpose_item<true>(src, 128, 128, WRG + (size_t)mat * 16384, scr, sub, lane);
        }
    } else {
        constexpr int I_IN = 16 * (ODD_IN / 32), I_OUT = 16 * 32;
        for (int it = gw; it < I_IN + I_OUT; it += NGW) {
            int r = it;
            if (r < I_IN) { transpose_item(P.od_w_in + (size_t)j * 1024 * ODD_IN, 1024, ODD_IN, WIN, scr, r, lane); continue; } r -= I_IN;
            transpose_item(P.od_w_out + (size_t)j * 1024 * 1024, 1024, 1024, WOUT, scr, r, lane);
        }
    }
}
DI void phase_norm(const Params& P, LAS unsigned char* lds, int layer, int wv) {
    const int tid = get_tid(wv), lane = tid & 63, wave = tid >> 6;
    const int gw = get_bid() * 8 + wave, NGW = gridDim.x * 8;
    if (layer > 0) phase_convert(P, lds, layer, wv);
    const float* hl = layer == 0 ? P.x : P.out; const float* hc = layer == 0 ? P.ctx : (const float*)(P.ws + WS_HCTX);
    const float* mod = (const float*)(P.ws + WS_MOD) + (size_t)layer * 9 * 3072;
    const float* nw = P.norm_w + layer * 1024;
    bf16_t* U = (bf16_t*)(P.ws + WS_OV);
    f32x4 w4[4], s4[4], h4[4];
#pragma unroll
    for (int q = 0; q < 4; ++q) w4[q] = *(const f32x4*)(nw + 4 * lane + 256 * q);
    int cur_m = -1;
    const int nrows = layer == 0 ? MROWS : NB * CTXL;
    const int rpw = (nrows + NGW - 1) / NGW;
    for (int idx = gw * rpw; idx < gw * rpw + rpw && idx < nrows; ++idx) {
        const int b = layer == 0 ? idx / LT : idx >> 8, jr = layer == 0 ? idx % LT : idx & 255;
        const int R = b * LT + jr;
        const float* src = jr < CTXL ? hc + ((size_t)b * CTXL + jr) * DM : hl + ((size_t)b * SEQ + (jr - CTXL)) * DM;
        const int mrow = jr < CTXL ? 8 : b;
        if (mrow != cur_m) {
            cur_m = mrow;
            const float* sh = mod + mrow * 3072; const float* sc = sh + 1024;
#pragma unroll
            for (int q = 0; q < 4; ++q) { s4[q] = *(const f32x4*)(sc + 4 * lane + 256 * q) + 1.f; h4[q] = *(const f32x4*)(sh + 4 * lane + 256 * q); }
        }
        f32x4 v[4]; float ss = 0.f;
#pragma unroll
        for (int q = 0; q < 4; ++q) { v[q] = *(const f32x4*)(src + 4 * lane + 256 * q); ss += (v[q][0] * v[q][0] + v[q][1] * v[q][1]) + (v[q][2] * v[q][2] + v[q][3] * v[q][3]); }
        const float rstd = rsqrtf(wave_sum(ss) * (1.f / DM) + RMS_EPS);
#pragma unroll
        for (int q = 0; q < 4; ++q) { const int k = 4 * lane + 256 * q;
            const f32x4 y = (v[q] * rstd) * w4[q]; const f32x4 o = y * s4[q] + h4[q];
            u32x2 w; w.x = pk2(o[0], o[1]); w.y = pk2(o[2], o[3]); *(u32x2*)(U + (size_t)R * DM + k) = w; }
    }
}

typedef _Float16 f16x2_t __attribute__((ext_vector_type(2)));
DI unsigned pkh2(float a, float b) { const f16x2_t v = {(_Float16)a, (_Float16)b}; return __builtin_bit_cast(unsigned, v); }
DI void unpkh2(unsigned u, float& a, float& b) { const f16x2_t v = __builtin_bit_cast(f16x2_t, u); a = (float)v[0]; b = (float)v[1]; }
constexpr int RG_UT = 0, RG_AL = 17408, RG_BL = 50176, RG_HP = 82944, RG_QA = 148480, RG_CAR = 152576, RG_FLAG = 153600, RG_END = 153664;
static_assert(RG_END <= LDS_BYTES - 256, "RG-LRU LDS map");
constexpr int CW_RG = 8192;
DI void rglru_item(const Params& P, LAS unsigned char* lds, int j, int item, int mode, int buf, int wv) {
    const int tid = get_tid(wv), lane = tid & 63, wave = tid >> 6, r = lane & 15, g = lane >> 4;
    const int grp = item / NCHUNK, ci = item % NCHUNK, b = grp >> 3, hd = grp & 7;
    bf16_t* p = (bf16_t*)(P.ws + WS_P);
    const bf16_t* WRG = (const bf16_t*)(P.ws + WS_WRG);
    unsigned long long* AGG = (unsigned long long*)(P.ws + WS_AGG);
    unsigned* cnt = (unsigned*)(P.ws + WS_CTL) + CW_RG + (j * 64 + grp) * 16;
    const int R0 = b * LT + ci * 64;
    const int seg_lo = b * LT + (ci < 4 ? 0 : CTXL), seg_hi = b * LT + (ci < 4 ? CTXL : LT);
    LAS bf16_t* UT = (LAS bf16_t*)(lds + RG_UT);
    LAS float* AL = (LAS float*)(lds + RG_AL);
    LAS float* BL = (LAS float*)(lds + RG_BL);
    LAS unsigned* HP = (LAS unsigned*)(lds + 17408 + buf * 65536);
    LAS float* QA = (LAS float*)(lds + RG_QA);
    LAS float* CAR = (LAS float*)(lds + 148480);
    if (mode == 0) {
    TP_START(10, lds, tid); TP_START(11, lds, tid);
    bf16x8 wfr[2][2][4];
    float prm[2][3];
#pragma unroll
    for (int dir = 0; dir < 2; ++dir) {
#pragma unroll
        for (int gt = 0; gt < 2; ++gt) {
            const bf16_t* W = WRG + (size_t)((dir * 2 + gt) * 8 + hd) * 16384 + (wave * 4 * 64 + lane) * 8;
#pragma unroll
            for (int ks = 0; ks < 4; ++ks) wfr[dir][gt][ks] = *(const bf16x8*)(W + ks * 512);
        }
        const int idx = (j * 2 + dir) * 1024 + hd * 128 + 16 * wave + r;
        prm[dir][0] = P.ev_rg_bx[idx]; prm[dir][1] = P.ev_rg_ba[idx]; prm[dir][2] = P.ev_rg_lambda[idx];
    }
    {
        LAS bf16_t* XT = (LAS bf16_t*)HP;
#pragma unroll
        for (int rep = 0; rep < 3; ++rep) {
            const int idx = tid + rep * 512, tr = idx >> 4, c0 = (idx & 15) * 8;
            if (idx < 67 * 16) {
                const int Rg = R0 + tr - 1;
                u32x4 xv = {0u, 0u, 0u, 0u};
                if (Rg >= seg_lo && Rg < seg_hi) xv = *(const u32x4*)(p + (size_t)Rg * EVEN_IN + hd * 128 + c0);
                *(LAS u32x4*)(XT + tr * 128 + c0) = xv;
            }
        }
        const int c0 = (tid & 15) * 8, cg0 = hd * 128 + c0;
        float wv4[4][8], bias[8];
        { const f32x4 b0 = *(const f32x4*)(P.ev_conv_b + j * 1024 + cg0), b1 = *(const f32x4*)(P.ev_conv_b + j * 1024 + cg0 + 4);
          bias[0] = b0[0]; bias[1] = b0[1]; bias[2] = b0[2]; bias[3] = b0[3]; bias[4] = b1[0]; bias[5] = b1[1]; bias[6] = b1[2]; bias[7] = b1[3]; }
#pragma unroll
        for (int k = 0; k < 4; ++k) { const float* wk = P.ev_conv_w + (size_t)(j * 4 + k) * 1024 + cg0; const f32x4 w0 = *(const f32x4*)wk, w1 = *(const f32x4*)(wk + 4);
            wv4[k][0] = w0[0]; wv4[k][1] = w0[1]; wv4[k][2] = w0[2]; wv4[k][3] = w0[3]; wv4[k][4] = w1[0]; wv4[k][5] = w1[1]; wv4[k][6] = w1[2]; wv4[k][7] = w1[3]; }
        __syncthreads();
#pragma unroll
        for (int rep = 0; rep < 2; ++rep) {
            const int t = (tid >> 4) + rep * 32;
            float acc[8];
#pragma unroll
            for (int e = 0; e < 8; ++e) acc[e] = bias[e];
#pragma unroll
            for (int k = 0; k < 4; ++k) {
                const u32x4 xv = *(const LAS u32x4*)(XT + (t + k) * 128 + c0);
                acc[0] += wv4[k][0] * __uint_as_float(xv.x << 16); acc[1] += wv4[k][1] * __uint_as_float(xv.x & 0xffff0000u);
                acc[2] += wv4[k][2] * __uint_as_float(xv.y << 16); acc[3] += wv4[k][3] * __uint_as_float(xv.y & 0xffff0000u);
                acc[4] += wv4[k][4] * __uint_as_float(xv.z << 16); acc[5] += wv4[k][5] * __uint_as_float(xv.z & 0xffff0000u);
                acc[6] += wv4[k][6] * __uint_as_float(xv.w << 16); acc[7] += wv4[k][7] * __uint_as_float(xv.w & 0xffff0000u);
            }
            u32x4 o; o.x = pk2(acc[0], acc[1]); o.y = pk2(acc[2], acc[3]); o.z = pk2(acc[4], acc[5]); o.w = pk2(acc[6], acc[7]);
            *(LAS u32x4*)(UT + t * 136 + c0) = o;
        }
    }
    __syncthreads();
    TP_STOP(11, lds, tid);
#pragma unroll
    for (int dir = 0; dir < 2; ++dir) {
        TP_START(12, lds, tid); TP_START(16, lds, tid);
        f32x4 ax[4], aa[4];
#pragma unroll
        for (int m = 0; m < 4; ++m) { ax[m] = (f32x4){0.f, 0.f, 0.f, 0.f}; aa[m] = (f32x4){0.f, 0.f, 0.f, 0.f}; }
#pragma unroll
        for (int ks = 0; ks < 4; ++ks) {
#pragma unroll
            for (int m = 0; m < 4; ++m) {
                const bf16x8 a = *(const LAS bf16x8*)(UT + (16 * m + r) * 136 + 32 * ks + 8 * g);
                ax[m] = MFMA16(a, wfr[dir][0][ks], ax[m]); aa[m] = MFMA16(a, wfr[dir][1][ks], aa[m]);
            }
        }
        asm volatile("" :: "v"(ax[0]), "v"(ax[1]), "v"(ax[2]), "v"(ax[3]), "v"(aa[0]), "v"(aa[1]), "v"(aa[2]), "v"(aa[3]));
        TP_STOP(16, lds, tid); TP_START(17, lds, tid);
        float av[4][4], bv[4][4];
        {
            const int c = 16 * wave + r;
            const float bxv = prm[dir][0], bav = prm[dir][1], lam = prm[dir][2];
            const float sp = softplus_neg(lam);
#pragma unroll
            for (int m = 0; m < 4; ++m)
#pragma unroll
                for (int i = 0; i < 4; ++i) {
                    const int t = 16 * m + 4 * g + i;
                    const float gx = sigm(ax[m][i] + bxv), ga = sigm(aa[m][i] + bav);
                    const float la = -8.f * ga * sp;
                    const float a = __expf(la), mult = __builtin_amdgcn_sqrtf((1.f - a) * (1.f + a));
                    const float uv = bf2f(UT[t * 136 + c]);
                    av[m][i] = a; bv[m][i] = mult * gx * uv;
                }
        }
        TP_STOP(17, lds, tid);
        TP_STOP(12, lds, tid); TP_START(13, lds, tid);
        {
            const int c = 16 * wave + r;
            float hl[4][4], pl[4][4], sa[4], sb[4];
#pragma unroll
            for (int m = 0; m < 4; ++m) {
                float h = 0.f, pc = 1.f;
#pragma unroll
                for (int ii = 0; ii < 4; ++ii) { const int i = dir == 0 ? ii : 3 - ii; h = av[m][i] * h + bv[m][i]; pc *= av[m][i]; hl[m][i] = h; pl[m][i] = pc; }
                sa[m] = pc; sb[m] = h;
            }
            float hin[4], pin[4];
            {
                float ca[4][4], cb[4][4];
#pragma unroll
                for (int m = 0; m < 4; ++m)
#pragma unroll
                    for (int gg = 0; gg < 4; ++gg) {
                        const int src = (16 * gg + r) << 2;
                        ca[m][gg] = __int_as_float(__builtin_amdgcn_ds_bpermute(src, __float_as_int(sa[m])));
                        cb[m][gg] = __int_as_float(__builtin_amdgcn_ds_bpermute(src, __float_as_int(sb[m])));
                    }
                float H = 0.f, Pc = 1.f;
#pragma unroll
                for (int ss = 0; ss < 16; ++ss) {
                    const int s = dir == 0 ? ss : 15 - ss, m = s >> 2, gg = s & 3;
                    if (gg == g) { hin[m] = H; pin[m] = Pc; }
                    H = ca[m][gg] * H + cb[m][gg]; Pc *= ca[m][gg];
                }
                if (g == 0) {
                    const unsigned long long v = ((unsigned long long)__float_as_uint(H) << 32) | __float_as_uint(Pc);
                    __hip_atomic_store(AGG + ((size_t)(dir * NB + b) * NCHUNK + ci) * 1024 + hd * 128 + c, v, __ATOMIC_RELAXED, __HIP_MEMORY_SCOPE_AGENT);
                }
            }
#pragma unroll
            for (int m = 0; m < 4; ++m)
#pragma unroll
                for (int i = 0; i < 4; ++i) HP[(dir * 64 + 16 * m + 4 * g + i) * 128 + c] = pkh2(hl[m][i] + pl[m][i] * hin[m], pl[m][i] * pin[m]);
        }
        TP_STOP(13, lds, tid);
    }
    asm volatile("s_waitcnt vmcnt(0)" ::: "memory");
    __syncthreads();
    if (tid == 0) __hip_atomic_fetch_add(cnt, 1u, __ATOMIC_RELAXED, __HIP_MEMORY_SCOPE_AGENT);
    TP_STOP(10, lds, tid);
    return;
    }
    TP_START(14, lds, tid);
    u32x4 gpre[2];
#pragma unroll
    for (int rep = 0; rep < 2; ++rep) { const int idx = tid + rep * 512; gpre[rep] = *(const u32x4*)(p + (size_t)(R0 + (idx >> 4)) * EVEN_IN + 1536 + hd * 128 + (idx & 15) * 8); }
    if (tid == 0) {
        unsigned spins = 0;
        while (__hip_atomic_load(cnt, __ATOMIC_RELAXED, __HIP_MEMORY_SCOPE_AGENT) < (unsigned)NCHUNK) { __builtin_amdgcn_s_sleep(2); if (++spins > (1u << 22)) break; }
    }
    __syncthreads();
    TP_STOP(14, lds, tid); TP_START(15, lds, tid);
    if (tid < 256) {
        const int dir = tid >> 7, c = tid & 127;
        const int pos = dir == 0 ? ci : (ci < 4 ? 3 - ci : 39 - ci);
        float h = 0.f;
        const unsigned long long* ag = AGG + (size_t)(dir * NB + b) * NCHUNK * 1024 + hd * 128 + c;
#pragma unroll 1
        for (int base = 0; base < pos; base += 18) {
            unsigned long long v[18];
#pragma unroll
            for (int k = 0; k < 18; ++k) { const int pp = base + k < pos ? base + k : pos - 1; const int cc = dir == 0 ? pp : (pp < 4 ? 3 - pp : 39 - pp);
                v[k] = __hip_atomic_load(ag + (size_t)cc * 1024, __ATOMIC_RELAXED, __HIP_MEMORY_SCOPE_AGENT); }
#pragma unroll
            for (int k = 0; k < 18; ++k) if (base + k < pos) h = __uint_as_float((unsigned)v[k]) * h + __uint_as_float((unsigned)(v[k] >> 32));
        }
        CAR[dir * 128 + c] = h;
    }
    __syncthreads();
#pragma unroll
    for (int rep = 0; rep < 2; ++rep) {
        const int idx = tid + rep * 512, t = idx >> 4, c0 = (idx & 15) * 8;
        bf16_t* gp = p + (size_t)(R0 + t) * EVEN_IN + 1536 + hd * 128 + c0;
        const u32x4 gv = gpre[rep];
        float y[8];
#pragma unroll
        for (int e = 0; e < 8; ++e) {
            float h0, p0, h1, p1; unpkh2(HP[t * 128 + c0 + e], h0, p0); unpkh2(HP[(64 + t) * 128 + c0 + e], h1, p1);
            y[e] = (h0 + p0 * CAR[c0 + e]) + (h1 + p1 * CAR[128 + c0 + e]);
        }
        const float gg[8] = {__uint_as_float(gv.x << 16), __uint_as_float(gv.x & 0xffff0000u), __uint_as_float(gv.y << 16), __uint_as_float(gv.y & 0xffff0000u),
                             __uint_as_float(gv.z << 16), __uint_as_float(gv.z & 0xffff0000u), __uint_as_float(gv.w << 16), __uint_as_float(gv.w & 0xffff0000u)};
        u32x4 o;
        o.x = pk2(y[0] * gg[0] * sigm(gg[0]), y[1] * gg[1] * sigm(gg[1])); o.y = pk2(y[2] * gg[2] * sigm(gg[2]), y[3] * gg[3] * sigm(gg[3]));
        o.z = pk2(y[4] * gg[4] * sigm(gg[4]), y[5] * gg[5] * sigm(gg[5])); o.w = pk2(y[6] * gg[6] * sigm(gg[6]), y[7] * gg[7] * sigm(gg[7]));
        *(u32x4*)gp = o;
    }
    __syncthreads();
    TP_STOP(15, lds, tid);
}

DI void rope8v(u32x4& v, const f32x4 cs, const f32x4 sn) {
    unsigned* w = (unsigned*)&v;
#pragma unroll
    for (int i = 0; i < 4; ++i) { const float t1 = __uint_as_float(w[i] << 16), t2 = __uint_as_float(w[i] & 0xffff0000u); w[i] = pk2(t1 * cs[i] - t2 * sn[i], t1 * sn[i] + t2 * cs[i]); }
}
DI void rope8(u32x4& v, const float* cs, const float* sn) { rope8v(v, *(const f32x4*)cs, *(const f32x4*)sn); }
DI void rope8s(u32x4& v, const float* cs, const float* sn, float sc) { rope8v(v, *(const f32x4*)cs * sc, *(const f32x4*)sn * sc); }
DI void scale8(u32x4& v, float sc) {
    unsigned* w = (unsigned*)&v;
#pragma unroll
    for (int i = 0; i < 4; ++i) w[i] = pk2(__uint_as_float(w[i] << 16) * sc, __uint_as_float(w[i] & 0xffff0000u) * sc);
}
typedef short v4i16_a __attribute__((ext_vector_type(4)));
DI void attn_item(const Params& P, LAS unsigned char* lds, int j, int item, int wv) {
    const int tid = get_tid(wv), lane = tid & 63, wave = tid >> 6, r = lane & 31, h = lane >> 5;
    const bool is_lat = item < 512;
    int b, qb, kvh;
    if (is_lat) { b = item >> 6; qb = (item >> 2) & 15; kvh = item & 3; } else { const int it = item - 512; b = it >> 3; qb = (it >> 2) & 1; kvh = it & 3; }
    bf16_t* p = (bf16_t*)(P.ws + WS_P);
    const float* cos_t = (const float*)(P.ws + WS_ROPE); const float* sin_t = cos_t + SEQ * 32;
    LAS unsigned char* QL = lds + 36864 + wave * 9216;
    TP_START(1, lds, tid);
    const int hq = 4 * kvh + (wave >> 1), ql0 = qb * 128 + 64 * (wave & 1);
    const size_t rowbase = (size_t)b * LT + (is_lat ? CTXL : 0);
    {
        const int chq = lane & 7;
#pragma unroll
        for (int k = 0; k < 8; ++k) {
            const int row = (lane >> 3) + 8 * k, qi = ql0 + row;
            u32x4 v = *(const u32x4*)(p + (rowbase + qi) * EVEN_IN + 2560 + hq * 64 + 8 * chq);
            if (is_lat) rope8s(v, cos_t + qi * 32 + 4 * chq, sin_t + qi * 32 + 4 * chq, 0.125f * LOG2E); else scale8(v, 0.125f * LOG2E);
            *(LAS u32x4*)(QL + row * 144 + chq * 16) = v;
        }
    }
    const float sink2 = P.ev_sink[j * 16 + hq] * LOG2E;
    float mrun[2] = {sink2, sink2}, lrun[2] = {h == 0 ? 1.f : 0.f, h == 0 ? 1.f : 0.f};
    f32x16 O[2][2];
#pragma unroll
    for (int a = 0; a < 2; ++a)
#pragma unroll
        for (int c = 0; c < 2; ++c)
#pragma unroll
            for (int i = 0; i < 16; ++i) O[a][c][i] = 0.f;
    const int w_lo = (is_lat && qb == 0) ? 2 : 0, w_hi = (is_lat && qb == 15) ? 3 : 5;
    const int nT = is_lat ? 4 + (w_hi - w_lo + 1) : 4;
    const float SC = 0.125f * LOG2E, NEG = -1e30f;
    const int key = tid >> 3, chn = tid & 7;
    u32x4 kreg, vreg; f32x4 creg, sreg;
#define ATT_K0(t) ((t) < 4 ? 64 * (t) : qb * 128 - 128 + 64 * (w_lo + (t) - 4))
#define ATT_LOAD(t) do { const bool win_ = (t) >= 4; const int k0_ = ATT_K0(t); \
        const bf16_t* kp_ = p + ((size_t)b * LT + (win_ ? CTXL : 0) + k0_ + key) * EVEN_IN + 1024 + kvh * 64 + 8 * chn; \
        kreg = *(const u32x4*)kp_; vreg = *(const u32x4*)(kp_ + 256); \
        if (win_) { creg = *(const f32x4*)(cos_t + (k0_ + key) * 32 + 4 * chn); sreg = *(const f32x4*)(sin_t + (k0_ + key) * 32 + 4 * chn); } } while (0)
#define ATT_STORE(t, buf) do { const bool win_ = (t) >= 4; \
        if (win_) rope8v(kreg, creg, sreg); \
        *(LAS u32x4*)(lds + (buf) * 18432 + key * 144 + chn * 16) = kreg; *(LAS u32x4*)(lds + (buf) * 18432 + 9216 + key * 144 + chn * 16) = vreg; } while (0)
    TP_START(2, lds, tid);
    ATT_LOAD(0); ATT_STORE(0, 0);
    if (nT > 1) ATT_LOAD(1);
#pragma unroll 1
    for (int t = 0; t < nT; ++t) {
        TP_START(4, lds, tid);
        __syncthreads();
        TP_STOP(4, lds, tid);
        if (t + 1 < nT) { ATT_STORE(t + 1, (t + 1) & 1); if (t + 2 < nT) ATT_LOAD(t + 2); }
        TP_START(3, lds, tid);
        const bool win = t >= 4;
        const int k0 = ATT_K0(t);
        const int dq = k0 - ql0;
        if (win && (dq >= 192 || dq <= -192)) continue;
        const bool need_mask = win && (dq >= 128 || dq <= -128);
        const LAS unsigned char* KL = lds + (t & 1) * 18432;
        const LAS bf16_t* VL = (const LAS bf16_t*)(lds + (t & 1) * 18432 + 9216);
#pragma unroll
        for (int qt = 0; qt < 2; ++qt) {
            f32x16 s0, s1;
            { const float nm = -mrun[qt];
#pragma unroll
              for (int i = 0; i < 16; ++i) { s0[i] = nm; s1[i] = nm; } }
#pragma unroll
            for (int ks = 0; ks < 4; ++ks) {
                const bf16x8 qfr = *(const LAS bf16x8*)(QL + (32 * qt + r) * 144 + (16 * ks + 8 * h) * 2);
                const bf16x8 k0f = *(const LAS bf16x8*)(KL + r * 144 + (16 * ks + 8 * h) * 2), k1f = *(const LAS bf16x8*)(KL + (32 + r) * 144 + (16 * ks + 8 * h) * 2);
                s0 = MFMA32(k0f, qfr, s0); s1 = MFMA32(k1f, qfr, s1);
            }
            const int qpos = ql0 + 32 * qt + r;
            if (need_mask) {
#pragma unroll
                for (int i = 0; i < 16; ++i) {
                    const int d0 = qpos - (k0 + crow(i, h)), d1 = d0 - 32;
                    if (d0 > 128 || d0 < -128) s0[i] = NEG;
                    if (d1 > 128 || d1 < -128) s1[i] = NEG;
                }
            }
            float mx = NEG;
#pragma unroll
            for (int i = 0; i < 16; ++i) mx = fmaxf(mx, fmaxf(s0[i], s1[i]));
            mx = fmaxf(mx, shfl_xor_f(mx, 32));
            if (__any(mx > 6.0f)) {
                const float shift = fmaxf(mx, 0.f), alpha = __builtin_amdgcn_exp2f(-shift);
                mrun[qt] += shift; lrun[qt] *= alpha;
#pragma unroll
                for (int i = 0; i < 16; ++i) { s0[i] -= shift; s1[i] -= shift; }
#pragma unroll
                for (int dt = 0; dt < 2; ++dt)
#pragma unroll
                    for (int i = 0; i < 16; ++i) O[dt][qt][i] *= alpha;
            }
            float ls = 0.f;
#pragma unroll
            for (int i = 0; i < 16; ++i) { s0[i] = __builtin_amdgcn_exp2f(s0[i]); s1[i] = __builtin_amdgcn_exp2f(s1[i]); ls += s0[i] + s1[i]; }
            lrun[qt] += ls;
            bf16x8 pf[2][2];
#pragma unroll
            for (int s = 0; s < 2; ++s) {
                u32x4 a, c;
                a.x = pk2(s0[8 * s + 0], s0[8 * s + 1]); a.y = pk2(s0[8 * s + 2], s0[8 * s + 3]); a.z = pk2(s0[8 * s + 4], s0[8 * s + 5]); a.w = pk2(s0[8 * s + 6], s0[8 * s + 7]);
                c.x = pk2(s1[8 * s + 0], s1[8 * s + 1]); c.y = pk2(s1[8 * s + 2], s1[8 * s + 3]); c.z = pk2(s1[8 * s + 4], s1[8 * s + 5]); c.w = pk2(s1[8 * s + 6], s1[8 * s + 7]);
                pf[0][s] = __builtin_bit_cast(bf16x8, a); pf[1][s] = __builtin_bit_cast(bf16x8, c);
            }
            const int gq = (lane >> 4) & 1, qq4 = (lane & 15) >> 2, pp4 = lane & 3;
#pragma unroll
            for (int dt = 0; dt < 2; ++dt)
#pragma unroll
                for (int kt = 0; kt < 2; ++kt)
#pragma unroll
                    for (int s = 0; s < 2; ++s) {
                        const LAS bf16_t* vp = VL + (32 * kt + 16 * s + 4 * h + qq4) * 72 + 32 * dt + 16 * gq + 4 * pp4;
                        const v4i16_a lo = __builtin_amdgcn_ds_read_tr16_b64_v4i16((LAS v4i16_a*)vp);
                        const v4i16_a hi = __builtin_amdgcn_ds_read_tr16_b64_v4i16((LAS v4i16_a*)(vp + 8 * 72));
                        const bf16x8 vf = {lo[0], lo[1], lo[2], lo[3], hi[0], hi[1], hi[2], hi[3]};
                        O[dt][qt] = MFMA32(vf, pf[kt][s], O[dt][qt]);
                    }
            __builtin_amdgcn_sched_barrier(0);
        }
        TP_STOP(3, lds, tid);
    }
    TP_STOP(2, lds, tid);
#undef ATT_K0
#undef ATT_LOAD
#undef ATT_STORE
    {
        const int chq = lane & 7;
        u32x4 gate[8];
#pragma unroll
        for (int k = 0; k < 8; ++k) gate[k] = *(const u32x4*)(p + (rowbase + ql0 + (lane >> 3) + 8 * k) * EVEN_IN + 3584 + hq * 64 + 8 * chq);
#pragma unroll
        for (int qt = 0; qt < 2; ++qt) {
            const float lt = lrun[qt] + shfl_xor_f(lrun[qt], 32), inv = __builtin_amdgcn_rcpf(lt);
#pragma unroll
            for (int dt = 0; dt < 2; ++dt)
#pragma unroll
                for (int i4 = 0; i4 < 4; ++i4) {
                    u32x2 o; o.x = pk2(O[dt][qt][4 * i4 + 0] * inv, O[dt][qt][4 * i4 + 1] * inv); o.y = pk2(O[dt][qt][4 * i4 + 2] * inv, O[dt][qt][4 * i4 + 3] * inv);
                    *(LAS u32x2*)(QL + (32 * qt + r) * 144 + (32 * dt + 8 * i4 + 4 * h) * 2) = o;
                }
        }
#pragma unroll
        for (int k = 0; k < 8; ++k) {
            const int row = (lane >> 3) + 8 * k;
            const u32x4 ov = *(const LAS u32x4*)(QL + row * 144 + chq * 16);
            const unsigned* ow = (const unsigned*)&ov; const unsigned* gw = (const unsigned*)&gate[k];
            u32x4 res; unsigned* rw = (unsigned*)&res;
#pragma unroll
            for (int e = 0; e < 4; ++e) {
                const float g0 = __uint_as_float(gw[e] << 16), g1 = __uint_as_float(gw[e] & 0xffff0000u);
                rw[e] = pk2(__uint_as_float(ow[e] << 16) * g0 * sigm(g0), __uint_as_float(ow[e] & 0xffff0000u) * g1 * sigm(g1));
            }
            *(u32x4*)(p + (rowbase + ql0 + row) * EVEN_IN + 2560 + hq * 64 + 8 * chq) = res;
        }
    }
    __syncthreads();
    TP_STOP(1, lds, tid);
}

constexpr int G2_QX = 0, G2_KF = 17408, G2_K2 = 60928, G2_VS = 79360, G2_AM = 96768, G2_ST = 105984, G2_PS = 140800, G2_BL = 144896, G2_Q1 = 145408, G2_END = 162816;
static_assert(G2_END <= LDS_BYTES - 256, "GLA LDS map");
typedef short v4i16_t __attribute__((ext_vector_type(4)));
DI bf16x8 frag_tr(const LAS bf16_t* M, int stride, int k0, int n0, int lane) {
    const int i = lane & 15, g = lane >> 4, q = i >> 2, pp = i & 3;
    const LAS bf16_t* a0 = M + (k0 + 8 * g + q) * stride + n0 + 4 * pp;
    const v4i16_t lo = __builtin_amdgcn_ds_read_tr16_b64_v4i16((LAS v4i16_t*)a0);
    const v4i16_t hi = __builtin_amdgcn_ds_read_tr16_b64_v4i16((LAS v4i16_t*)(a0 + 4 * stride));
    return (bf16x8){lo[0], lo[1], lo[2], lo[3], hi[0], hi[1], hi[2], hi[3]};
}

#ifndef GLA_SPLIT
#define GLA_SPLIT 24
#endif
template <int DIR>
DI void gla2_item(const Params& P, LAS unsigned char* lds, int layer_j, int b, int hd, int part, int wv) {
    const int tid = get_tid(wv), lane = tid & 63, wave = tid >> 6, r = lane & 15, g = lane >> 4;
    bf16_t* p = (bf16_t*)(P.ws + WS_P);
    LAS bf16_t* QX = (LAS bf16_t*)(lds + G2_QX); LAS bf16_t* KF = (LAS bf16_t*)(lds + G2_KF); LAS bf16_t* K2 = (LAS bf16_t*)(lds + G2_K2);
    LAS bf16_t* VS = (LAS bf16_t*)(lds + G2_VS); LAS bf16_t* AM = (LAS bf16_t*)(lds + G2_AM); LAS bf16_t* ST = (LAS bf16_t*)(lds + G2_ST);
    LAS float* PS8 = (LAS float*)(lds + G2_PS); LAS float* BLAST = (LAS float*)(lds + G2_BL); LAS bf16_t* Q1 = (LAS bf16_t*)(lds + G2_Q1);
    const int d0 = 2 * lane, tg = wave, I = tg >> 1, half = tg & 1;
    float lbv[2] = {0.f, 0.f};
    if (layer_j > 0) { lbv[0] = sigm(P.od_lb_raw[1024 + hd * 128 + d0] - P.od_lb_raw[hd * 128 + d0]); lbv[1] = sigm(P.od_lb_raw[1024 + hd * 128 + d0 + 1] - P.od_lb_raw[hd * 128 + d0 + 1]); }
    unsigned* prog = (unsigned*)(P.ws + WS_CTL) + 10240 + ((layer_j * 128 + b * 16 + hd * 2 + DIR) * 8);
    const int step_end = part == 0 ? GLA_SPLIT : NCHUNK;
    TP_START(20, lds, tid);
    for (int i = tid; i < (9216 + 34816) / 4; i += 512) ((LAS unsigned*)(lds + G2_AM))[i] = 0u;
    f32x4 st[8];
#pragma unroll
    for (int e = 0; e < 8; ++e) st[e] = (f32x4){0.f, 0.f, 0.f, 0.f};
    unsigned zn[8], qn[8]; u32x4 vn[2];
#define G2_OFFZ(s) ((unsigned)((DIR == 0 ? 8 * tg + (s) : 63 - 8 * tg - (s)) * ODD_IN + d0) * 2u)
#define G2_OFFV(rep) ((unsigned)((DIR == 0 ? ((tid + (rep) * 512) >> 4) : 63 - ((tid + (rep) * 512) >> 4)) * ODD_IN + 8 * ((tid + (rep) * 512) & 15)) * 2u)
    const size_t colz = (size_t)DIR * 1024 + hd * 128, colq = 3072 + hd * 128, colv = 2048 + hd * 128;
    {
        const int chunk = DIR == 0 ? 0 : 3;
        const char* slab = (const char*)(p + ((size_t)b * LT + (size_t)chunk * 64) * ODD_IN);
#pragma unroll
        for (int s = 0; s < 8; ++s) { zn[s] = *(const unsigned*)(slab + colz * 2 + G2_OFFZ(s)); qn[s] = *(const unsigned*)(slab + colq * 2 + G2_OFFZ(s)); }
#pragma unroll
        for (int rep = 0; rep < 2; ++rep) vn[rep] = *(const u32x4*)(slab + colv * 2 + G2_OFFV(rep));
    }
    __syncthreads();
#pragma unroll 1
    for (int step = 0; step < step_end; ++step) {
        const bool sonly = part == 1 && step < GLA_SPLIT;
        const int chunk = DIR == 0 ? step : (step < 4 ? 3 - step : 39 - step);
        const size_t Rc0 = (size_t)b * LT + (size_t)chunk * 64;
        unsigned zc[8], qc[8]; u32x4 vc[2];
#pragma unroll
        for (int s = 0; s < 8; ++s) { zc[s] = zn[s]; qc[s] = qn[s]; }
        vc[0] = vn[0]; vc[1] = vn[1];
        TP_START(21, lds, tid);
        float el[8][2], kk[8][2], qq[8][2];
        {
            float run0 = 1.f, run1 = 1.f;
#pragma unroll
            for (int s = 0; s < 8; ++s) {
                const float z0 = __uint_as_float(zc[s] << 16), z1 = __uint_as_float(zc[s] & 0xffff0000u);
                const float t0 = __expf(-z0), t1 = __expf(-z1), sg0 = __builtin_amdgcn_rcpf(1.f + t0), sg1 = __builtin_amdgcn_rcpf(1.f + t1);
                const float f0 = fmaxf(lbv[0] + (1.f - lbv[0]) * sg0, 1e-30f), f1 = fmaxf(lbv[1] + (1.f - lbv[1]) * sg1, 1e-30f);
                kk[s][0] = (1.f - lbv[0]) * (t0 * sg0); kk[s][1] = (1.f - lbv[1]) * (t1 * sg1);
                run0 = fmaxf(run0 * f0, 1e-35f); run1 = fmaxf(run1 * f1, 1e-35f); el[s][0] = run0; el[s][1] = run1;
                if (!sonly) {
                const float q0 = __uint_as_float(qc[s] << 16), q1 = __uint_as_float(qc[s] & 0xffff0000u);
                qq[s][0] = q0 * __builtin_amdgcn_rcpf(1.f + __expf(-q0)); qq[s][1] = q1 * __builtin_amdgcn_rcpf(1.f + __expf(-q1));
                } else { qq[s][0] = 0.f; qq[s][1] = 0.f; }
                if ((s & 1) == 1) __builtin_amdgcn_sched_barrier(0);
            }
            *(LAS f32x2*)(PS8 + tg * 128 + d0) = (f32x2){run0, run1};
#pragma unroll
            for (int rep = 0; rep < 2; ++rep) { const int idx = tid + rep * 512, tau = idx >> 4, chn = idx & 15; *(LAS u32x4*)(VS + tau * 136 + 8 * chn) = vc[rep]; }
        }
        __syncthreads();
        if (part == 1 && step < GLA_SPLIT && tid == 0) __hip_atomic_store(prog, (unsigned)(step + 1), __ATOMIC_RELAXED, __HIP_MEMORY_SCOPE_AGENT);
        TP_STOP(21, lds, tid); TP_START(22, lds, tid);
        float RI[2];
        {
            float T[8][2];
#pragma unroll
            for (int q8 = 0; q8 < 8; ++q8) { const f32x2 t = *(const LAS f32x2*)(PS8 + q8 * 128 + d0); T[q8][0] = t[0]; T[q8][1] = t[1]; }
            float pre[2], fac[4][2], f4[2];
#pragma unroll
            for (int x = 0; x < 2; ++x) {
                const float P0 = T[0][x] * T[1][x], P1 = T[2][x] * T[3][x], P2 = T[4][x] * T[5][x], P3 = T[6][x] * T[7][x];
                pre[x] = half ? (I == 0 ? T[0][x] : (I == 1 ? T[2][x] : (I == 2 ? T[4][x] : T[6][x]))) : 1.f;
                RI[x] = I == 0 ? 1.f : (I == 1 ? P0 : (I == 2 ? P0 * P1 : P0 * P1 * P2));
                float cur = 1.f;
                fac[0][x] = cur; if (I <= 0) cur *= P0;
                fac[1][x] = cur; if (I <= 1) cur *= P1;
                fac[2][x] = cur; if (I <= 2) cur *= P2;
                fac[3][x] = cur; cur *= P3;
                f4[x] = cur;
                if (tg == 0) BLAST[d0 + x] = P0 * P1 * P2 * P3;
            }
            unsigned w0[4], w1[4];
#pragma unroll
            for (int s = 0; s < 8; ++s) {
                const int tau = 8 * tg + s;
                const float e00 = fmaxf(pre[0] * el[s][0], 1e-35f), e01 = fmaxf(pre[1] * el[s][1], 1e-35f);
                const float qi0 = qq[s][0] * e00, qi1 = qq[s][1] * e01;
                const float kd0 = kk[s][0] * __builtin_amdgcn_rcpf(e00), kd1 = kk[s][1] * __builtin_amdgcn_rcpf(e01);
                if (!sonly) {
                *(LAS unsigned*)(QX + tau * 136 + d0) = pk2(qi0, qi1);
                *(LAS unsigned*)(Q1 + tau * 136 + d0) = pk2(qi0 * RI[0], qi1 * RI[1]);
                if (I <= 0) *(LAS unsigned*)(KF + (0 + tau) * 136 + d0) = pk2(kd0 * fac[0][0], kd1 * fac[0][1]);
                if (I <= 1) *(LAS unsigned*)(KF + (16 + tau) * 136 + d0) = pk2(kd0 * fac[1][0], kd1 * fac[1][1]);
                if (I <= 2) *(LAS unsigned*)(KF + (48 + tau) * 136 + d0) = pk2(kd0 * fac[2][0], kd1 * fac[2][1]);
                *(LAS unsigned*)(KF + (96 + tau) * 136 + d0) = pk2(kd0 * fac[3][0], kd1 * fac[3][1]);
                }
                const unsigned h0 = f2bf(kd0 * f4[0]), h1 = f2bf(kd1 * f4[1]);
                if (s & 1) { w0[s >> 1] |= h0 << 16; w1[s >> 1] |= h1 << 16; } else { w0[s >> 1] = h0; w1[s >> 1] = h1; }
                if ((s & 1) == 1) __builtin_amdgcn_sched_barrier(0);
            }
            *(LAS u32x4*)(K2 + (d0 + 0) * 72 + 8 * tg) = (u32x4){w0[0], w0[1], w0[2], w0[3]};
            *(LAS u32x4*)(K2 + (d0 + 1) * 72 + 8 * tg) = (u32x4){w1[0], w1[1], w1[2], w1[3]};
        }
        __syncthreads();
        TP_STOP(22, lds, tid); TP_START(23, lds, tid);
        if (step + 1 < step_end) {
            const int nchunk = DIR == 0 ? step + 1 : (step + 1 < 4 ? 2 - step : 38 - step);
            const char* slab = (const char*)(p + ((size_t)b * LT + (size_t)nchunk * 64) * ODD_IN);
#pragma unroll
            for (int s = 0; s < 8; ++s) { zn[s] = *(const unsigned*)(slab + colz * 2 + G2_OFFZ(s)); qn[s] = *(const unsigned*)(slab + colq * 2 + G2_OFFZ(s)); }
#pragma unroll
            for (int rep = 0; rep < 2; ++rep) vn[rep] = *(const u32x4*)(slab + colv * 2 + G2_OFFV(rep));
        }
#pragma unroll 1
        for (int bi = sonly ? 10 : wave; bi < 10; bi += 8) {
            const int Ib = bi < 1 ? 0 : (bi < 3 ? 1 : (bi < 6 ? 2 : 3)), Jb = bi - (Ib * (Ib + 1)) / 2;
            const int foff = Ib == 0 ? 0 : (Ib == 1 ? 16 : (Ib == 2 ? 48 : 96));
            f32x4 acc = {0.f, 0.f, 0.f, 0.f};
#pragma unroll
            for (int ks = 0; ks < 4; ++ks) {
                const bf16x8 a = *(const LAS bf16x8*)(QX + (16 * Ib + r) * 136 + 32 * ks + 8 * g);
                const bf16x8 bb = *(const LAS bf16x8*)(KF + (foff + 16 * Jb + r) * 136 + 32 * ks + 8 * g);
                acc = MFMA16(a, bb, acc);
            }
#pragma unroll
            for (int i = 0; i < 4; ++i) { float v = acc[i]; if (Jb == Ib && r > 4 * g + i) v = 0.f; AM[(16 * Ib + 4 * g + i) * 72 + 16 * Jb + r] = (bf16_t)f2bf(v); }
        }
        if (!sonly) __syncthreads();
        TP_STOP(23, lds, tid); TP_START(24, lds, tid);
        {
            if (!sonly) {
            const int tt = wave >> 1, eb = 4 * (wave & 1);
            bf16x8 aq[4], am[2];
#pragma unroll
            for (int ks = 0; ks < 4; ++ks) aq[ks] = *(const LAS bf16x8*)(Q1 + (16 * tt + r) * 136 + 32 * ks + 8 * g);
#pragma unroll
            for (int ks = 0; ks < 2; ++ks) am[ks] = *(const LAS bf16x8*)(AM + (16 * tt + r) * 72 + 32 * ks + 8 * g);
#pragma unroll
            for (int e4 = 0; e4 < 4; ++e4) {
                const int et = eb + e4;
                f32x4 acc = {0.f, 0.f, 0.f, 0.f};
#pragma unroll
                for (int ks = 0; ks < 4; ++ks) { const bf16x8 bb = *(const LAS bf16x8*)(ST + (16 * et + r) * 136 + 32 * ks + 8 * g); acc = MFMA16(aq[ks], bb, acc); }
#pragma unroll
                for (int ks = 0; ks < 2; ++ks) acc = MFMA16(am[ks], frag_tr(VS, 136, 32 * ks, 16 * et, lane), acc);
#pragma unroll
                for (int i = 0; i < 4; ++i) KF[(16 * tt + 4 * g + i) * 136 + 16 * et + r] = (bf16_t)f2bf(acc[i]);
                __builtin_amdgcn_sched_barrier(0);
            }
            }
            float bl[4];
#pragma unroll
            for (int i = 0; i < 4; ++i) bl[i] = BLAST[16 * wave + 4 * g + i];
            bf16x8 ak[2];
#pragma unroll
            for (int ks = 0; ks < 2; ++ks) ak[ks] = *(const LAS bf16x8*)(K2 + (16 * wave + r) * 72 + 32 * ks + 8 * g);
#pragma unroll
            for (int et = 0; et < 8; ++et) {
#pragma unroll
                for (int i = 0; i < 4; ++i) st[et][i] *= bl[i];
#pragma unroll
                for (int ks = 0; ks < 2; ++ks) st[et] = MFMA16(ak[ks], frag_tr(VS, 136, 32 * ks, 16 * et, lane), st[et]);
                if (et & 1) __builtin_amdgcn_sched_barrier(0);
            }
        }
        if (part == 0 && tid == 0) { unsigned spins = 0; while (__hip_atomic_load(prog, __ATOMIC_RELAXED, __HIP_MEMORY_SCOPE_AGENT) < (unsigned)(step + 1)) { __builtin_amdgcn_s_sleep(2); if (++spins > (1u << 22)) break; } }
        __syncthreads();
        TP_STOP(24, lds, tid); TP_START(25, lds, tid);
        if (!sonly) {
            char* oslab = (char*)(p + Rc0 * ODD_IN + colz);
#pragma unroll
            for (int rep = 0; rep < 2; ++rep) {
                const int idx = tid + rep * 512, tau = idx >> 4, chn = idx & 15;
                const u32x4 ov = *(const LAS u32x4*)(KF + tau * 136 + 8 * chn);
                *(u32x4*)(oslab + (unsigned)((DIR == 0 ? tau : 63 - tau) * ODD_IN + 8 * chn) * 2u) = ov;
            }
        }
        if (!sonly || step == GLA_SPLIT - 1) {
#pragma unroll
        for (int et = 0; et < 8; ++et) { u32x2 w; w.x = pk2(st[et][0], st[et][1]); w.y = pk2(st[et][2], st[et][3]); *(LAS u32x2*)(ST + (16 * et + r) * 136 + 16 * wave + 4 * g) = w; }
        }
        TP_STOP(25, lds, tid);
    }
    __syncthreads();
    TP_STOP(20, lds, tid);
}

DI void phase_readout(const Params& P, int layer_j, int wv) {
    const int tid = get_tid(wv), lane = tid & 63, wave = tid >> 6;
    const int gw = get_bid() * 8 + wave, NGW = gridDim.x * 8;
    bf16_t* p = (bf16_t*)(P.ws + WS_P);
    const float* gwt = P.od_gnorm_w + layer_j * 128 + (lane & 7) * 16;
    for (int R = gw; R < MROWS; R += NGW) {
        const bf16_t* op = p + (size_t)R * ODD_IN + 16 * lane; bf16_t* yp = p + (size_t)R * ODD_IN + 4096 + 16 * lane;
        const u32x4 o0 = *(const u32x4*)op, o1 = *(const u32x4*)(op + 8), c0 = *(const u32x4*)(op + 1024), c1 = *(const u32x4*)(op + 1032), g0 = *(const u32x4*)yp, g1 = *(const u32x4*)(yp + 8);
        float ov[16], gv[16];
        const unsigned* ow0 = (const unsigned*)&o0; const unsigned* ow1 = (const unsigned*)&o1; const unsigned* cw0 = (const unsigned*)&c0; const unsigned* cw1 = (const unsigned*)&c1;
        const unsigned* gw0 = (const unsigned*)&g0; const unsigned* gw1 = (const unsigned*)&g1;
#pragma unroll
        for (int i = 0; i < 4; ++i) {
            ov[2 * i] = __uint_as_float(ow0[i] << 16) + __uint_as_float(cw0[i] << 16); ov[2 * i + 1] = __uint_as_float(ow0[i] & 0xffff0000u) + __uint_as_float(cw0[i] & 0xffff0000u);
            ov[8 + 2 * i] = __uint_as_float(ow1[i] << 16) + __uint_as_float(cw1[i] << 16); ov[8 + 2 * i + 1] = __uint_as_float(ow1[i] & 0xffff0000u) + __uint_as_float(cw1[i] & 0xffff0000u);
            gv[2 * i] = __uint_as_float(gw0[i] << 16); gv[2 * i + 1] = __uint_as_float(gw0[i] & 0xffff0000u); gv[8 + 2 * i] = __uint_as_float(gw1[i] << 16); gv[8 + 2 * i + 1] = __uint_as_float(gw1[i] & 0xffff0000u);
        }
        float ss = 0.f;
#pragma unroll
        for (int i = 0; i < 16; ++i) ss += ov[i] * ov[i];
        ss += shfl_xor_f(ss, 1); ss += shfl_xor_f(ss, 2); ss += shfl_xor_f(ss, 4);
        const float rstd = rsqrtf(ss * (1.f / 128.f) + RMS_EPS);
        float y[16];
#pragma unroll
        for (int i = 0; i < 16; ++i) y[i] = ov[i] * rstd * gwt[i] * (gv[i] * sigm(gv[i]));
        u32x4 w0, w1;
        w0.x = pk2(y[0], y[1]); w0.y = pk2(y[2], y[3]); w0.z = pk2(y[4], y[5]); w0.w = pk2(y[6], y[7]);
        w1.x = pk2(y[8], y[9]); w1.y = pk2(y[10], y[11]); w1.z = pk2(y[12], y[13]); w1.w = pk2(y[14], y[15]);
        *(u32x4*)yp = w0; *(u32x4*)(yp + 8) = w1;
    }
}

DI void phase_final(const Params& P, int wv) {
    const int tid = get_tid(wv), lane = tid & 63, wave = tid >> 6;
    const int gw = get_bid() * 8 + wave, NGW = gridDim.x * 8;
    for (int R = gw; R < NB * SEQ; R += NGW) {
        float* row = P.out + (size_t)R * DM;
        f32x4 v[4]; float ss = 0.f;
#pragma unroll
        for (int q = 0; q < 4; ++q) { v[q] = *(const f32x4*)(row + 4 * lane + 256 * q); ss += (v[q][0] * v[q][0] + v[q][1] * v[q][1]) + (v[q][2] * v[q][2] + v[q][3] * v[q][3]); }
        const float rstd = rsqrtf(wave_sum(ss) * (1.f / DM) + RMS_EPS);
#pragma unroll
        for (int q = 0; q < 4; ++q) { const f32x4 w4 = *(const f32x4*)(P.final_norm_w + 4 * lane + 256 * q); *(f32x4*)(row + 4 * lane + 256 * q) = (v[q] * rstd) * w4; }
    }
}

#define XB_TMO      128
#define XB_XCNT(j)  (256  + 64 * (j))
#define XB_XSUB(j)  (1280 + 64 * (j))
#define XB_XGEN(j)  (2304 + 64 * (j))
#define XB_TOP      3328
#define XB_TOPGEN   3392
#define XCD_BAR_WORDS 3456
#define XB_SPIN_CAP (1u << 18)

__device__ __forceinline__ unsigned xb_ld(unsigned* p)              { return __hip_atomic_load(p, __ATOMIC_RELAXED, __HIP_MEMORY_SCOPE_AGENT); }
__device__ __forceinline__ unsigned xb_add(unsigned* p, unsigned v) { return __hip_atomic_fetch_add(p, v, __ATOMIC_RELAXED, __HIP_MEMORY_SCOPE_AGENT); }
__device__ __forceinline__ unsigned xb_xcc_id() { return (unsigned)__builtin_amdgcn_s_getreg((3 << 11) | 20) & 0xFu; }
#define XB_SPIN(cond, bar) do { unsigned _sp = 0; while (cond) { __builtin_amdgcn_s_sleep(1); \
    if ((++_sp & 255u) == 0u) { if (xb_ld(&(bar)[XB_TMO])) break; if (_sp > XB_SPIN_CAP) { atomicAdd(&(bar)[XB_TMO], 1u); break; } } } } while (0)

struct XcdBarrier {
    unsigned* bar; unsigned x;
    volatile LAS unsigned* st;
};

__device__ __forceinline__ XcdBarrier xcd_barrier_post(unsigned* bar, volatile LAS unsigned* st, int wv) {
    XcdBarrier b; b.bar = bar; b.x = xb_xcc_id(); b.st = st;
    if (get_tid(wv) == 0) (void)xb_add(&bar[XB_XCNT(b.x)], 1u);
    return b;
}
__device__ __forceinline__ void xcd_barrier_complete(unsigned* bar, unsigned x, unsigned& nloc, unsigned& nx) {
    const unsigned G = gridDim.x * gridDim.y * gridDim.z;
    unsigned sum, cnt, mine, sp = 0u;
    for (;;) {
        sum = 0u; cnt = 0u; mine = 0u;
#pragma unroll
        for (unsigned j = 0; j < 16; ++j) { const unsigned c = xb_ld(&bar[XB_XCNT(j)]); sum += c; cnt += (c > 0u) ? 1u : 0u; mine = (j == x) ? c : mine; }
        if (sum == G) break;
        __builtin_amdgcn_s_sleep(1);
        if ((++sp & 255u) == 0u) { if (xb_ld(&bar[XB_TMO])) break; if (sp > XB_SPIN_CAP) { atomicAdd(&bar[XB_TMO], 1u); break; } }
    }
    nloc = mine > 0u ? mine : 1u; nx = cnt > 0u ? cnt : 1u;
}

__device__ __forceinline__ void xcd_barrier(const XcdBarrier& b, int wv) {
    asm volatile("s_waitcnt vmcnt(0)" ::: "memory");
    __syncthreads();
    if (get_tid(wv) == 0) {
        unsigned* bar = b.bar;
        __builtin_amdgcn_s_waitcnt(0);
        unsigned nloc = b.st[0], nx = b.st[1];
        if (nloc == 0u) { xcd_barrier_complete(bar, b.x, nloc, nx); b.st[0] = nloc; b.st[1] = nx; }
        const unsigned old = xb_add(&bar[XB_XSUB(b.x)], 1u);
        const unsigned gen = old / nloc;
        if (old + 1u == (gen + 1u) * nloc) {
            __builtin_amdgcn_fence(__ATOMIC_RELEASE, "agent");
            asm volatile("s_waitcnt vmcnt(0)" ::: "memory");
            const unsigned og = xb_add(&bar[XB_TOP], 1u);
            const unsigned tg = og / nx;
            if (og + 1u == (tg + 1u) * nx) xb_add(&bar[XB_TOPGEN], 1u);
            else XB_SPIN(xb_ld(&bar[XB_TOPGEN]) == tg, bar);
            __builtin_amdgcn_fence(__ATOMIC_ACQUIRE, "agent");
            xb_add(&bar[XB_XGEN(b.x)], 1u);
            asm volatile("s_waitcnt vmcnt(0)" ::: "memory");
        } else {
            XB_SPIN(xb_ld(&bar[XB_XGEN(b.x)]) == gen, bar);
            __builtin_amdgcn_fence(__ATOMIC_ACQUIRE, "agent");
            asm volatile("s_waitcnt vmcnt(0)" ::: "memory");
        }
    }
    __syncthreads();
}

constexpr int PARAM_OFF = LDS_BYTES - 256;
static_assert(G2_END <= PARAM_OFF && sizeof(Params) <= 208, "LDS map");
DI const float* ld_uptr(const LAS unsigned long long* s, int i) {
    const unsigned long long v = s[i];
    const unsigned lo = __builtin_amdgcn_readfirstlane((unsigned)v), hi = __builtin_amdgcn_readfirstlane((unsigned)(v >> 32));
    return (const float*)(const __attribute__((address_space(1))) float*)(((unsigned long long)hi << 32) | lo);
}
DI Params load_params(LAS unsigned char* lds) {
    LAS unsigned char* pb = lds + PARAM_OFF; asm volatile("" : "+v"(pb));
    const LAS unsigned long long* s = (const LAS unsigned long long*)pb;
    Params Q;
    Q.x = ld_uptr(s, 0); Q.c = ld_uptr(s, 1); Q.ctx = ld_uptr(s, 2); Q.c_ctx = ld_uptr(s, 3); Q.ada_w = ld_uptr(s, 4); Q.ada_b = ld_uptr(s, 5); Q.norm_w = ld_uptr(s, 6);
    Q.ev_w_in = ld_uptr(s, 7); Q.ev_conv_w = ld_uptr(s, 8); Q.ev_conv_b = ld_uptr(s, 9); Q.ev_rg_wx = ld_uptr(s, 10); Q.ev_rg_bx = ld_uptr(s, 11); Q.ev_rg_wa = ld_uptr(s, 12);
    Q.ev_rg_ba = ld_uptr(s, 13); Q.ev_rg_lambda = ld_uptr(s, 14); Q.ev_sink = ld_uptr(s, 15); Q.ev_w_out = ld_uptr(s, 16); Q.od_w_in = ld_uptr(s, 17); Q.od_lb_raw = ld_uptr(s, 18);
    Q.od_gnorm_w = ld_uptr(s, 19); Q.od_w_out = ld_uptr(s, 20); Q.final_norm_w = ld_uptr(s, 21); Q.out = (float*)ld_uptr(s, 22); Q.ws = (unsigned char*)ld_uptr(s, 23);
    Q.ph_lo = 0; Q.ph_hi = 0;
    return Q;
}
DI void run_phase(LAS unsigned char* lds, int ph, int wv) {
    #ifndef PHMASK
#define PHMASK 0xffff
#endif
    if (ph == 0) { if (PHMASK & 1) { const Params P = load_params(lds); phase_pro(P, lds, wv); __syncthreads(); phase_convert(P, lds, 0, wv); } return; }
    const int layer = (ph - 1) / 5, sub = (ph - 1) % 5, j = layer >> 1;
    const bool even = (layer & 1) == 0;
    if (sub == 0) { if (PHMASK & 4) { const Params P = load_params(lds); phase_norm(P, lds, layer, wv); } return; }
    if (sub == 1) {
        const Params P = load_params(lds); bf16_t* pbuf = (bf16_t*)(P.ws + WS_P);
        const int N = even ? EVEN_IN : ODD_IN;
        pg8::Gemm gm{(const bf16_t*)(P.ws + WS_OV), (const bf16_t*)(P.ws + WS_WIN), MROWS, N, 1024, 1024};
        pg8::StaticOrder S; S.init(MROWS, N, (int)gridDim.x, get_bid());
        EpiStoreBf16 E{pbuf, N};
        if (even) S.limit = 1280;
        if (PHMASK & 8) pg8::gemm_phase<EpiStoreBf16, pg8::StaticOrder, true, true>(lds, gm, S, E, wv);
        if (even) {
            for (int t = get_bid(); t < 128; t += gridDim.x) {
                pg8::Unit u; S.tile_of(1280 + (t >> 3), u);
                const int m0 = 256 * u.pm + 64 * ((t & 7) >> 1), n0 = 256 * u.pn + 128 * (t & 1);
                auto epi = [&](const f32x16& acc, int row0, int col, int hh) {
#pragma unroll
                    for (int i = 0; i < 16; ++i) pbuf[(size_t)(m0 + row0 + crow(i, hh)) * N + n0 + col] = (bf16_t)f2bf(acc[i]);
                };
                mini_gemm_tile(lds, (const bf16_t*)(P.ws + WS_OV) + (size_t)m0 * 1024, 1024, (const bf16_t*)(P.ws + WS_WIN) + (size_t)n0 * 1024, 1024, epi, wv);
            }
        }
        return;
    }
    if (sub == 2) {
        const Params P = load_params(lds);
        if (even) {
            constexpr int NRG = NB * NCHUNK * 8;
#if defined(SPLIT_ATTN)
            for (int it = get_bid(); it < NRG; it += gridDim.x) rglru_item(P, lds, j, it, wv);
#else
            {
                int it = get_bid(), k = 0;
                if (it < NRG) rglru_item(P, lds, j, it, 0, 0, wv);
                for (; it < NRG; it += gridDim.x, ++k) {
                    if (it + (int)gridDim.x < NRG) rglru_item(P, lds, j, it + (int)gridDim.x, 0, (k + 1) & 1, wv);
                    rglru_item(P, lds, j, it, 1, k & 1, wv);
                }
                for (it -= NRG; it < 576; it += gridDim.x) attn_item(P, lds, j, it, wv);
            }
#endif
        } else {
            for (int it = get_bid(); it < 256; it += gridDim.x) { if (PHMASK & 64) { if (it & 2) gla2_item<1>(P, lds, j, it >> 5, (it >> 2) & 7, it & 1, wv); else gla2_item<0>(P, lds, j, it >> 5, (it >> 2) & 7, it & 1, wv); } }
        }
        return;
    }
    if (sub == 3) {
        const Params P = load_params(lds);
        if (!even) { if (PHMASK & 256) phase_readout(P, j, wv); }
#if defined(SPLIT_ATTN)
        else { for (int it = get_bid(); it < 576; it += gridDim.x) attn_item(P, lds, j, it, wv); }
#endif
        return;
    }
    {
        const Params P = load_params(lds); bf16_t* pbuf = (bf16_t*)(P.ws + WS_P);
        const int K = even ? 2048 : 1024, lda = even ? EVEN_IN : ODD_IN;
        pg8::Gemm gm{pbuf + (even ? 1536 : 4096), (const bf16_t*)(P.ws + WS_WOUT), MROWS, 1024, K, lda};
        pg8::StaticOrder S; S.init(NB * SEQ, 1024, (int)gridDim.x, get_bid(), 1);
        const float* hl = layer == 0 ? P.x : P.out; const float* hc = layer == 0 ? P.ctx : (const float*)(P.ws + WS_HCTX);
        const float* modb = (const float*)(P.ws + WS_MOD);
        EpiResidNorm E{hl, P.out, modb + (size_t)layer * 9 * 3072 + 2048, layer < 3 ? P.norm_w + (layer + 1) * 1024 : P.final_norm_w,
                       layer < 3 ? modb + (size_t)(layer + 1) * 9 * 3072 : nullptr, (bf16_t*)(P.ws + WS_OV), (float*)(P.ws + WS_AGG), (unsigned*)(P.ws + WS_CTL) + 12288 + layer * 1024};
        if (PHMASK & 512) pg8::gemm_phase<EpiResidNorm, pg8::StaticOrder, false, true>(lds, gm, S, E, wv);
        if (layer < 3) {
            for (int t = get_bid(); t < 256; t += gridDim.x) {
                const int mt = t >> 3, nt = t & 7, mc0 = 64 * mt, bctx = mc0 >> 8, n0 = 128 * nt;
                const bf16_t* At = pbuf + ((size_t)bctx * LT + (mc0 & 255)) * lda + (even ? 1536 : 4096);
                const float* gctx = (const float*)(P.ws + WS_MOD) + (size_t)layer * 9 * 3072 + 2048 + 8 * 3072;
                float* hco = (float*)(P.ws + WS_HCTX);
                auto epi = [&](const f32x16& acc, int row0, int col, int hh) {
                    const float gate = gctx[n0 + col];
#pragma unroll
                    for (int i = 0; i < 16; ++i) { const size_t off = (size_t)(mc0 + row0 + crow(i, hh)) * DM + n0 + col; hco[off] = hc[off] + gate * acc[i]; }
                };
                mini_gemm_tile(lds, At, lda, (const bf16_t*)(P.ws + WS_WOUT) + (size_t)n0 * K, K, epi, wv);
            }
        }
    }
}

__global__ void __launch_bounds__(512, 2) mega(Params P) {
    extern __shared__ __attribute__((aligned(16))) unsigned char lds_raw[];
    LAS unsigned char* lds = (LAS unsigned char*)lds_raw;
    cg::grid_group grid = cg::this_grid();
    const int wv = __builtin_amdgcn_readfirstlane((int)(threadIdx.x >> 6));
    if (get_tid(wv) == 0) {
#if defined(TP_ID)
        ((LAS unsigned long long*)(lds + 163840 - 32))[0] = 0ull; ((LAS unsigned long long*)(lds + 163840 - 32))[1] = 0ull;
#endif
        ((LAS unsigned*)(lds + PARAM_OFF + 208))[0] = 0u; ((LAS unsigned*)(lds + PARAM_OFF + 208))[1] = 0u;
        LAS unsigned long long* d = (LAS unsigned long long*)(lds + PARAM_OFF);
        d[0] = (unsigned long long)P.x; d[1] = (unsigned long long)P.c; d[2] = (unsigned long long)P.ctx; d[3] = (unsigned long long)P.c_ctx; d[4] = (unsigned long long)P.ada_w;
        d[5] = (unsigned long long)P.ada_b; d[6] = (unsigned long long)P.norm_w; d[7] = (unsigned long long)P.ev_w_in; d[8] = (unsigned long long)P.ev_conv_w; d[9] = (unsigned long long)P.ev_conv_b;
        d[10] = (unsigned long long)P.ev_rg_wx; d[11] = (unsigned long long)P.ev_rg_bx; d[12] = (unsigned long long)P.ev_rg_wa; d[13] = (unsigned long long)P.ev_rg_ba; d[14] = (unsigned long long)P.ev_rg_lambda;
        d[15] = (unsigned long long)P.ev_sink; d[16] = (unsigned long long)P.ev_w_out; d[17] = (unsigned long long)P.od_w_in; d[18] = (unsigned long long)P.od_lb_raw; d[19] = (unsigned long long)P.od_gnorm_w;
        d[20] = (unsigned long long)P.od_w_out; d[21] = (unsigned long long)P.final_norm_w; d[22] = (unsigned long long)P.out; d[23] = (unsigned long long)P.ws;
    }
    __syncthreads();
    const int ph_lo = P.ph_lo, ph_hi = P.ph_hi;
    (void)xcd_barrier_post((unsigned*)(P.ws + WS_CTL) + 4096, (volatile LAS unsigned*)(lds + PARAM_OFF + 208), wv);
#define GRID_SYNC(first) do { if (first) grid.sync(); else { XcdBarrier xb_; xb_.bar = (unsigned*)(load_params(lds).ws + WS_CTL) + 4096; xb_.x = xb_xcc_id(); xb_.st = (volatile LAS unsigned*)(lds + PARAM_OFF + 208); xcd_barrier(xb_, wv); } } while (0)
#if defined(PROBE_S)
    constexpr int PREP = PROBE_E - PROBE_S + 1;
#pragma unroll 1
    for (int seq = ph_lo; seq < ph_hi + PREP; ++seq) {
        if (seq > ph_lo) GRID_SYNC(seq == ph_lo + 1);
        const int ph = seq <= PROBE_E ? seq : seq - PREP;
        run_phase(lds, ph, wv);
    }
#else
#pragma unroll 1
    for (int ph = ph_lo; ph < ph_hi; ++ph) {
#if !defined(SPLIT_ATTN)
        if (ph >= 1 && ph < NPHASE - 1 && (ph - 1) % 5 == 3 && (((ph - 1) / 5) & 1) == 0) continue;
#endif
        TP_START(200, lds, get_tid(wv));
        if (ph > ph_lo) GRID_SYNC(ph == ph_lo + 1);
        TP_STOP(200, lds, get_tid(wv));
#if defined(TP_ID)
        const int kid_ = ph == 0 ? 207 : ((ph - 1) % 5 == 0 ? 205 : ((ph - 1) % 5 == 1 ? 201 : ((ph - 1) % 5 == 2 ? ((((ph - 1) / 5) & 1) ? 203 : 202) : ((ph - 1) % 5 == 3 ? 206 : 204))));
        if (kid_ == TP_ID) TP_START(TP_ID, lds, get_tid(wv));
#endif
        run_phase(lds, ph, wv);
#if defined(TP_ID)
        if (kid_ == TP_ID) TP_STOP(TP_ID, lds, get_tid(wv));
#endif
    }
#endif
#if defined(TP_ID)
    if (get_tid(wv) == 0 && blockIdx.x == TP_BLOCK) {
        const unsigned long long acc = ((LAS unsigned long long*)(lds + 163840 - 32))[1], t0 = __builtin_amdgcn_s_memrealtime();
        while (__builtin_amdgcn_s_memrealtime() - t0 < (unsigned long long)TP_AMP * acc) __builtin_amdgcn_s_sleep(8);
    }
#endif
}

extern "C" void kernel_launch(void* const* d_in, const int* in_sizes, int n_in, void* d_out, int out_size, void* d_ws, size_t ws_size, hipStream_t stream) {
    static int grid = 0;
    if (grid == 0) {
        if (n_in != 22 || ws_size < WS_END) { fprintf(stderr, "kernel_launch: unexpected inputs (n_in %d, ws %zu)\n", n_in, ws_size); grid = -1; return; }
        int dev = 0, cus = 0, per_cu = 0;
        hipGetDevice(&dev);
        hipDeviceGetAttribute(&cus, hipDeviceAttributeMultiprocessorCount, dev);
        if (hipFuncSetAttribute((const void*)mega, hipFuncAttributeMaxDynamicSharedMemorySize, LDS_BYTES) != hipSuccess) { fprintf(stderr, "kernel_launch: hipFuncSetAttribute failed\n"); grid = -1; return; }
        if (hipOccupancyMaxActiveBlocksPerMultiprocessor(&per_cu, (const void*)mega, 512, LDS_BYTES) != hipSuccess || per_cu < 1) { fprintf(stderr, "kernel_launch: occupancy query gives %d\n", per_cu); per_cu = 1; }
        (void)hipGetLastError();
        if (cus < 256) { fprintf(stderr, "kernel_launch: this kernel needs 256 co-resident workgroups (device reports %d CUs)\n", cus); grid = -1; return; }
        grid = 256;
    }
    if (grid < 0) return;
    if (hipMemsetAsync((char*)d_ws + WS_CTL, 0, 65536, stream) != hipSuccess) { fprintf(stderr, "kernel_launch: memset failed\n"); return; }
    Params P{};
    const float** pp = (const float**)&P;
    for (int i = 0; i < 22; ++i) pp[i] = (const float*)d_in[i];
    P.out = (float*)d_out; P.ws = (unsigned char*)d_ws;
#if ONE_LAUNCH
    P.ph_lo = 0; P.ph_hi = NPHASE;
    { void* args[] = {&P}; hipError_t e = hipLaunchCooperativeKernel((const void*)mega, dim3(grid), dim3(512), args, LDS_BYTES, stream);
      if (e != hipSuccess) fprintf(stderr, "cooperative launch failed: %s (grid %d)\n", hipGetErrorString(e), grid); }
#else
    for (int ph = 0; ph < NPHASE; ++ph) {
        P.ph_lo = ph; P.ph_hi = ph + 1;
        void* args[] = {&P}; hipError_t e = hipLaunchCooperativeKernel((const void*)mega, dim3(grid), dim3(512), args, LDS_BYTES, stream);
        if (e != hipSuccess) { fprintf(stderr, "launch %d failed: %s (grid %d)\n", ph, hipGetErrorString(e), grid); break; }
    }
#endif
}
```

```cpp
#include <hip/hip_runtime.h>
#include <hip/hip_cooperative_groups.h>
#include <cstdio>
#include <cstdint>
namespace cg = cooperative_groups;

#ifndef ONE_LAUNCH
#define ONE_LAUNCH 1
#endif

#define DI __device__ __forceinline__
#define LAS __attribute__((address_space(3)))
__device__ __forceinline__ int lane_nh() { int l; asm volatile("v_mbcnt_lo_u32_b32 %0, -1, 0\n\tv_mbcnt_hi_u32_b32 %0, -1, %0" : "=v"(l)); return l; }
__device__ __forceinline__ int get_tid(int wv) { asm volatile("" : "+s"(wv)); return wv * 64 + lane_nh(); }
__device__ __forceinline__ float shfl_xor_f(float v, int o) { return __int_as_float(__builtin_amdgcn_ds_bpermute((lane_nh() ^ o) << 2, __float_as_int(v))); }
__device__ __forceinline__ int get_bid() { int b = blockIdx.x; asm volatile("" : "+s"(b)); return b; }

#if defined(TP_ID)
#ifndef TP_BLOCK
#define TP_BLOCK 5
#endif
#ifndef TP_AMP
#define TP_AMP 16
#endif
#define TP_START(id, lds, tid_) do { if ((id) == TP_ID) { __builtin_amdgcn_sched_barrier(0); if ((tid_) == 0 && blockIdx.x == TP_BLOCK) { ((LAS unsigned long long*)((lds) + 163840 - 32))[0] = __builtin_amdgcn_s_memrealtime(); } __builtin_amdgcn_sched_barrier(0); } } while (0)
#define TP_STOP(id, lds, tid_) do { if ((id) == TP_ID) { __builtin_amdgcn_sched_barrier(0); if ((tid_) == 0 && blockIdx.x == TP_BLOCK) { LAS unsigned long long* w_ = (LAS unsigned long long*)((lds) + 163840 - 32); w_[1] += __builtin_amdgcn_s_memrealtime() - w_[0]; } __builtin_amdgcn_sched_barrier(0); } } while (0)
#else
#define TP_START(id, lds, tid_) do { } while (0)
#define TP_STOP(id, lds, tid_) do { } while (0)
#endif
namespace pg8 {
#define PG8_LAS __attribute__((address_space(3)))
typedef unsigned short bf16_t;
typedef short bf16x8 __attribute__((ext_vector_type(8)));
typedef float f32x4 __attribute__((ext_vector_type(4)));
typedef unsigned u32x4 __attribute__((ext_vector_type(4)));
constexpr int BM = 256, BK = 64, HALF = 128, HTB = HALF * BK * 2  , STAGE_BYTES = 8 * HTB, NXCD = 8, WGM = 8;

__host__ __device__ __forceinline__ int lds_byte(int r, int c) { const int st = (r >> 4) * 2 + (c >> 5), rr = r & 15, cc = c & 31, ob = rr * 64 + cc * 2; return st * 1024 + (ob ^ (((ob >> 9) & 1) << 5)); }
__host__ __device__ __forceinline__ void stage_rc(int b, int& R, int& C) { const int st = b / 1024, sb = b % 1024, swz = sb ^ (((sb >> 9) & 1) << 5); R = (st >> 1) * 16 + swz / 64; C = (st & 1) * 32 + (swz % 64) / 2; }
__host__ __device__ __forceinline__ int perm32(int rho) { const int n = rho >> 4, i = rho & 15; return 8 * (i >> 2) + 4 * n + (i & 3); }

struct Unit { int pm, pn; };
struct Gemm { const bf16_t* A; const bf16_t* Bt; int M, N, K, lda; };

struct StaticOrder {
    int nM, nN, nwg, G, c, lat_only, limit;
    __host__ __device__ void init(int M, int N, int G_, int c_, int lat_only_ = 0) { nM = M / BM; nN = N / BM; nwg = nM * nN; G = G_; c = c_; lat_only = lat_only_; limit = nwg; }
    __host__ __device__ bool next(int i, Unit& u) const {
        const long L = (long)i * G + c; if (L >= limit) return false;
        tile_of((int)L, u); return true;
    }
    __host__ __device__ void tile_of(int L, Unit& u) const {
        int wgid = L; { const int q = nwg / NXCD, r = nwg % NXCD, xcd = wgid % NXCD, off = wgid / NXCD; wgid = (xcd < r ? xcd * (q + 1) : r * (q + 1) + (xcd - r) * q) + off; }
        const int nig = WGM * nN, gid = wgid / nig, fm = gid * WGM, gsz = (nM - fm) < WGM ? (nM - fm) : WGM;
        u.pm = fm + ((wgid % nig) % gsz); u.pn = (wgid % nig) / gsz; if (lat_only) u.pm = 9 * (u.pm >> 3) + 1 + (u.pm & 7);
    }
    __device__ __forceinline__ void a_ready(const Unit&) const {}
    __device__ __forceinline__ void done(const Unit&) const {}
};

template <class Epi, class Sched, bool ALIGN_EPI = false, bool SP2 = false>
__device__ __forceinline__ void gemm_phase(PG8_LAS unsigned char* lds, const Gemm g, const Sched& S, const Epi& E, int wv) {
    const int tid = get_tid(wv), wid = __builtin_amdgcn_readfirstlane(tid >> 6), lane = tid & 63, wr = wid >> 2, wc = wid & 3, fr = lane & 15, fq = lane >> 4;
    const int K = g.K, nt = K / BK;
    unsigned voffA[2], voffB[2];
#pragma unroll
    for (int i = 0; i < 2; ++i) { int R, C; stage_rc(tid * 16 + i * 8192, R, C); const int Rb = Epi::PERM ? ((R & ~31) + perm32(R & 31)) : R;
        voffA[i] = (unsigned)(R * g.lda + C) * 2u; voffB[i] = (unsigned)(Rb * K + C) * 2u; }
    const size_t kstep = (size_t)(BK * 2);
    const size_t hstepA = (size_t)HALF * g.lda * 2, hstepB = (size_t)HALF * K * 2;
    const size_t tstepA = 2 * hstepA, tstepB = 2 * hstepB;
    const unsigned ldsw = (unsigned)wid * 1024u;
    const int aoff = lds_byte(wr * 64 + fr, fq * 8), boff = lds_byte(wc * 32 + fr, fq * 8);
#define PG8_SA(b, h) (((b) * 2 + (h)) * HTB)
#define PG8_SB(b, h) ((4 + (b) * 2 + (h)) * HTB)
#define PG8_STAGE(bufoff, gbase, voff) do { _Pragma("unroll") for (int _i = 0; _i < 2; ++_i) \
        __builtin_amdgcn_global_load_lds((const unsigned*)((const char*)(gbase) + (voff)[_i]), (PG8_LAS unsigned*)(lds + (bufoff) + ldsw + _i * 8192), 16, 0, 0); } while (0)
#define PG8_LDA(dst, b, h) do { _Pragma("unroll") for (int m = 0; m < 4; ++m) _Pragma("unroll") for (int k = 0; k < 2; ++k) dst[m][k] = *(const PG8_LAS bf16x8*)(lds + PG8_SA(b, h) + aoff + m * 2048 + k * 1024); } while (0)
#define PG8_LDB(dst, b, h) do { _Pragma("unroll") for (int n = 0; n < 2; ++n) _Pragma("unroll") for (int k = 0; k < 2; ++k) dst[n][k] = *(const PG8_LAS bf16x8*)(lds + PG8_SB(b, h) + boff + n * 2048 + k * 1024); } while (0)
#define PG8_MMA(ai, bj, At, Bt) do { __builtin_amdgcn_s_setprio(1); _Pragma("unroll") for (int m = 0; m < 4; ++m) _Pragma("unroll") for (int n = 0; n < 2; ++n) _Pragma("unroll") for (int k = 0; k < 2; ++k) \
        acc[ai][bj][m][n] = __builtin_amdgcn_mfma_f32_16x16x32_bf16(Bt[n][k], At[m][k], acc[ai][bj][m][n], 0, 0, 0); __builtin_amdgcn_s_setprio(0); } while (0)
#define PG8_WAIT_V(n) asm volatile("s_waitcnt vmcnt(" #n ")" ::: "memory")
#define PG8_WAIT_L(n) asm volatile("s_waitcnt lgkmcnt(" #n ")" ::: "memory")
#define PG8_BAR __builtin_amdgcn_s_barrier()
#define PG8_SCHED __builtin_amdgcn_sched_barrier(0)
    Unit cur, nxt; int ui = 0;
    if (!S.next(0, cur)) return;
    f32x4 acc[2][2][4][2];
#pragma unroll
    for (int a = 0; a < 2; ++a)
#pragma unroll
        for (int b = 0; b < 2; ++b)
#pragma unroll
            for (int m = 0; m < 4; ++m)
#pragma unroll
                for (int n = 0; n < 2; ++n) acc[a][b][m][n] = (f32x4){0.f, 0.f, 0.f, 0.f};
    bf16x8 At[4][2], B0[2][2], B1[2][2];
    const char* cA = (const char*)g.A + (size_t)cur.pm * tstepA; const char* cB = (const char*)g.Bt + (size_t)cur.pn * tstepB;
    S.a_ready(cur);
    if constexpr (SP2) {
        PG8_STAGE(PG8_SB(0, 0), cB, voffB); PG8_STAGE(PG8_SB(0, 1), cB + hstepB, voffB); PG8_STAGE(PG8_SA(0, 0), cA, voffA); PG8_STAGE(PG8_SA(0, 1), cA + hstepA, voffA);
        if (wr == 1) PG8_BAR;
        PG8_WAIT_V(2); PG8_BAR;
        PG8_STAGE(PG8_SB(1, 0), cB + kstep, voffB); PG8_STAGE(PG8_SA(1, 0), cA + kstep, voffA); PG8_STAGE(PG8_SB(1, 1), cB + hstepB + kstep, voffB);
        PG8_WAIT_V(6); PG8_BAR;
    } else {
        PG8_STAGE(PG8_SB(0, 0), cB, voffB); PG8_STAGE(PG8_SA(0, 0), cA, voffA); PG8_STAGE(PG8_SB(0, 1), cB + hstepB, voffB); PG8_STAGE(PG8_SA(0, 1), cA + hstepA, voffA);
        if (wr == 1) PG8_BAR;
        PG8_WAIT_V(4); PG8_BAR;
        PG8_STAGE(PG8_SB(1, 0), cB + kstep, voffB); PG8_STAGE(PG8_SA(1, 0), cA + kstep, voffA); PG8_STAGE(PG8_SB(1, 1), cB + hstepB + kstep, voffB);
        PG8_WAIT_V(6); PG8_BAR;
    }
    for (;;) {
        const bool has_next = S.next(ui + 1, nxt);
        const char* nA = has_next ? (const char*)g.A + (size_t)nxt.pm * tstepA : cA; const char* nB = has_next ? (const char*)g.Bt + (size_t)nxt.pn * tstepB : cB;
        for (int t = 0; t < nt; t += 2) {
            const bool last = (t == nt - 2);
            const char* a1 = cA + (size_t)(t + 1) * kstep;
            const char* a2 = last ? nA : cA + (size_t)(t + 2) * kstep; const char* b2 = last ? nB : cB + (size_t)(t + 2) * kstep;
            const char* a3 = a2 + kstep; const char* b3 = b2 + kstep;
            if (last && has_next) S.a_ready(nxt);
            if constexpr (SP2) {
            PG8_LDB(B0, 0, 0); PG8_LDB(B1, 0, 1); PG8_SCHED; PG8_LDA(At, 0, 0); PG8_STAGE(PG8_SA(1, 1), a1 + hstepA, voffA);
            PG8_WAIT_V(8); PG8_WAIT_L(0); PG8_BAR; PG8_MMA(0, 0, At, B0); PG8_MMA(0, 1, At, B1); PG8_BAR; PG8_SCHED;
            PG8_LDA(At, 0, 1); PG8_STAGE(PG8_SB(0, 0), b2, voffB); PG8_STAGE(PG8_SB(0, 1), b2 + hstepB, voffB); PG8_STAGE(PG8_SA(0, 0), a2, voffA);
            PG8_WAIT_V(8); PG8_WAIT_L(0); PG8_BAR; PG8_MMA(1, 0, At, B0); PG8_MMA(1, 1, At, B1); PG8_BAR; PG8_SCHED;
            PG8_LDB(B0, 1, 0); PG8_LDB(B1, 1, 1); PG8_SCHED; PG8_LDA(At, 1, 0); PG8_STAGE(PG8_SA(0, 1), a2 + hstepA, voffA);
            PG8_WAIT_V(8); PG8_WAIT_L(0); PG8_BAR; PG8_MMA(0, 0, At, B0); PG8_MMA(0, 1, At, B1); PG8_BAR; PG8_SCHED;
            PG8_LDA(At, 1, 1); PG8_STAGE(PG8_SB(1, 0), b3, voffB); PG8_STAGE(PG8_SB(1, 1), b3 + hstepB, voffB); PG8_STAGE(PG8_SA(1, 0), a3, voffA);
            PG8_WAIT_V(8); PG8_WAIT_L(0); PG8_BAR; PG8_MMA(1, 0, At, B0); PG8_MMA(1, 1, At, B1); PG8_BAR; PG8_SCHED;
            } else {
            PG8_LDB(B0, 0, 0); PG8_SCHED; PG8_LDA(At, 0, 0); PG8_STAGE(PG8_SA(1, 1), a1 + hstepA, voffA);
            PG8_WAIT_L(8); PG8_BAR; PG8_WAIT_L(0); PG8_MMA(0, 0, At, B0); PG8_BAR; PG8_SCHED;
            PG8_LDB(B1, 0, 1); PG8_STAGE(PG8_SB(0, 0), b2, voffB);
            PG8_BAR; PG8_WAIT_L(0); PG8_MMA(0, 1, At, B1); PG8_BAR;
            PG8_LDA(At, 0, 1); PG8_STAGE(PG8_SA(0, 0), a2, voffA);
            PG8_BAR; PG8_WAIT_L(0); PG8_MMA(1, 0, At, B0); PG8_BAR; PG8_SCHED;
            PG8_STAGE(PG8_SB(0, 1), b2 + hstepB, voffB);
            PG8_WAIT_V(6); PG8_BAR; PG8_MMA(1, 1, At, B1); PG8_BAR;
            PG8_LDB(B0, 1, 0); PG8_SCHED; PG8_LDA(At, 1, 0); PG8_STAGE(PG8_SA(0, 1), a2 + hstepA, voffA);
            PG8_WAIT_L(8); PG8_BAR; PG8_WAIT_L(0); PG8_MMA(0, 0, At, B0); PG8_BAR; PG8_SCHED;
            PG8_LDB(B1, 1, 1); PG8_STAGE(PG8_SB(1, 0), b3, voffB);
            PG8_BAR; PG8_WAIT_L(0); PG8_MMA(0, 1, At, B1); PG8_BAR;
            PG8_LDA(At, 1, 1); PG8_STAGE(PG8_SA(1, 0), a3, voffA);
            PG8_BAR; PG8_WAIT_L(0); PG8_MMA(1, 0, At, B0); PG8_BAR; PG8_SCHED;
            PG8_STAGE(PG8_SB(1, 1), b3 + hstepB, voffB);
            PG8_WAIT_V(6); PG8_BAR; PG8_MMA(1, 1, At, B1); PG8_BAR;
            }
        }
        if constexpr (ALIGN_EPI) { if (wr == 0) PG8_BAR; }
        if constexpr (!Epi::AFTER_DRAIN) { E(acc, cur, wr, wc, fr, fq); S.done(cur); }
        if (!has_next) break;
#pragma unroll
        for (int a = 0; a < 2; ++a)
#pragma unroll
            for (int b = 0; b < 2; ++b)
#pragma unroll
                for (int m = 0; m < 4; ++m)
#pragma unroll
                    for (int n = 0; n < 2; ++n) acc[a][b][m][n] = (f32x4){0.f, 0.f, 0.f, 0.f};
        cur = nxt; cA = nA; cB = nB; ++ui;
        if constexpr (ALIGN_EPI) { if (wr == 1) PG8_BAR; }
    }
    PG8_WAIT_V(0);
    if constexpr (!ALIGN_EPI) { if (wr == 0) PG8_BAR; }
    PG8_BAR;
    if constexpr (Epi::AFTER_DRAIN) { E.fused(acc, cur, wr, wc, fr, fq, lds, wid, lane); S.done(cur); }
#undef PG8_SA
#undef PG8_SB
#undef PG8_STAGE
#undef PG8_LDA
#undef PG8_LDB
#undef PG8_MMA
#undef PG8_WAIT_V
#undef PG8_WAIT_L
#undef PG8_BAR
#undef PG8_SCHED
}
}

typedef unsigned short bf16_t;
typedef short bf16x8 __attribute__((ext_vector_type(8)));
typedef short s16x4 __attribute__((ext_vector_type(4)));
typedef float f32x4 __attribute__((ext_vector_type(4)));
typedef float f32x16 __attribute__((ext_vector_type(16)));
typedef unsigned u32x4 __attribute__((ext_vector_type(4)));
typedef unsigned u32x2 __attribute__((ext_vector_type(2)));
typedef float f32x2 __attribute__((ext_vector_type(2)));

constexpr int DM = 1024, NB = 8, SEQ = 2048, CTXL = 256, LT = SEQ + CTXL  , MROWS = NB * LT  ;
constexpr int EVEN_IN = 4608, ODD_IN = 5120, NCHUNK = LT / 64  ;
constexpr float RMS_EPS = 1e-6f, LOG2E = 1.4426950408889634f;
constexpr int LDS_BYTES = 160 * 1024;
constexpr int NPHASE = 21;

constexpr size_t WS_CTL = 0;
constexpr size_t WS_MOD = 65536;
constexpr size_t WS_ROPE = 524288;
constexpr size_t WS_AGG = 1048576;
constexpr size_t WS_HCTX = WS_AGG + 4718592;
constexpr size_t WS_WIN = WS_HCTX + 8388608;
constexpr size_t WS_WOUT = WS_WIN + 10485760;
constexpr size_t WS_WRG = WS_WOUT + 4194304;
constexpr size_t WS_OV = WS_WRG + 1048576;
constexpr size_t WS_P = WS_OV + 37748736;
constexpr size_t WS_END = WS_P + 188743680;
static_assert(WS_END <= 268435456, "workspace map exceeds 256 MiB");

struct Params {
    const float *x, *c, *ctx, *c_ctx, *ada_w, *ada_b, *norm_w, *ev_w_in, *ev_conv_w, *ev_conv_b, *ev_rg_wx, *ev_rg_bx, *ev_rg_wa, *ev_rg_ba,
        *ev_rg_lambda, *ev_sink, *ev_w_out, *od_w_in, *od_lb_raw, *od_gnorm_w, *od_w_out, *final_norm_w;
    float* out; unsigned char* ws; int ph_lo, ph_hi;
};

DI float bf2f(unsigned short v) { return __uint_as_float((unsigned)v << 16); }
DI unsigned f2bf(float f) { unsigned u = __float_as_uint(f); return (u + 0x7fffu + ((u >> 16) & 1u)) >> 16; }
typedef __bf16 bf16x2_hw __attribute__((ext_vector_type(2)));
DI unsigned pk2(float lo, float hi) { const f32x2 v = {lo, hi}; return __builtin_bit_cast(unsigned, __builtin_convertvector(v, bf16x2_hw)); }
DI float sigm(float x) { return __builtin_amdgcn_rcpf(1.f + __expf(-x)); }
DI float softplus_neg(float lam) {
    const float e = __expf(-lam);
    return e < 0.06f ? e * (1.f + e * (-0.5f + e * (0.33333333f + e * (-0.25f + e * 0.2f)))) : __logf(1.f + e);
}
DI float neg_expm1(float x) {
    return x > -0.25f ? -x * (1.f + x * (0.5f + x * (0.16666667f + x * (0.041666668f + x * (0.0083333338f + x * 0.0013888889f))))) : 1.f - __expf(x);
}
DI float wave_sum(float v) {
#pragma unroll
    for (int o = 1; o < 64; o <<= 1) v += shfl_xor_f(v, o);
    return v;
}
DI int crow(int reg, int h) { return (reg & 3) + 8 * (reg >> 2) + 4 * h; }
#define MFMA16(a, b, c) __builtin_amdgcn_mfma_f32_16x16x32_bf16((a), (b), (c), 0, 0, 0)
#define MFMA32(a, b, c) __builtin_amdgcn_mfma_f32_32x32x16_bf16((a), (b), (c), 0, 0, 0)

struct EpiStoreBf16 {
    static constexpr bool PERM = true, AFTER_DRAIN = false;
    bf16_t* O; int ldc;
    DI void operator()(const f32x4 (&acc)[2][2][4][2], const pg8::Unit& u, int wr, int wc, int fr, int fq) const {
        const int row0 = u.pm * 256 + wr * 64 + fr, col0 = u.pn * 256 + wc * 32 + 8 * fq;
#pragma unroll
        for (int ai = 0; ai < 2; ++ai)
#pragma unroll
            for (int m = 0; m < 4; ++m) { bf16_t* rowp = O + (size_t)(row0 + ai * 128 + m * 16) * ldc + col0;
#pragma unroll
                for (int bj = 0; bj < 2; ++bj) { const f32x4 v0 = acc[ai][bj][m][0], v1 = acc[ai][bj][m][1];
                    u32x4 w; w.x = pk2(v0[0], v0[1]); w.y = pk2(v0[2], v0[3]); w.z = pk2(v1[0], v1[1]); w.w = pk2(v1[2], v1[3]);
                    *(u32x4*)(rowp + bj * 128) = w; } }
    }
};
struct EpiResid {
    static constexpr bool PERM = false, AFTER_DRAIN = false;
    const float* in_lat; const float* in_ctx; float* out_lat; float* out_ctx; const float* gate;
    DI void operator()(const f32x4 (&acc)[2][2][4][2], const pg8::Unit& u, int wr, int wc, int fr, int fq) const {
        const int b = u.pm / 9, jt = u.pm % 9;
        const float* ib; float* ob; const float* g;
        if (jt == 0) { const size_t off = (size_t)b * CTXL * DM; ib = in_ctx + off; ob = out_ctx + off; g = gate + 8 * 3072; }
        else { const size_t off = ((size_t)b * SEQ + (size_t)(jt - 1) * 256) * DM; ib = in_lat + off; ob = out_lat + off; g = gate + b * 3072; }
        const int col0 = u.pn * 256 + wc * 32 + 4 * fq;
#pragma unroll
        for (int bj = 0; bj < 2; ++bj)
#pragma unroll
            for (int n = 0; n < 2; ++n) {
                const f32x4 gvv = *(const f32x4*)(g + col0 + bj * 128 + n * 16);
#pragma unroll
                for (int ai = 0; ai < 2; ++ai) {
#pragma unroll
                    for (int m = 0; m < 4; ++m) { const int r = ai * 128 + wr * 64 + m * 16 + fr;
                        const size_t off = (size_t)r * DM + col0 + bj * 128 + n * 16;
                        const f32x4 o = *(const f32x4*)(ib + off) + gvv * acc[ai][bj][m][n]; *(f32x4*)(ob + off) = o; }
                    asm volatile("" ::: "memory");
                }
            }
    }
};

struct EpiResidNorm {
    static constexpr bool PERM = false, AFTER_DRAIN = true;
    const float* in_lat; float* out_lat; const float* gate;
    const float* nw; const float* mod_next;
    bf16_t* U; float* xbuf; unsigned* cnt;
    DI void fused(f32x4 (&acc)[2][2][4][2], const pg8::Unit& u, int wr, int wc, int fr, int fq, LAS unsigned char* lds, int wid, int lane) const {
        const int b = u.pm / 9, jt = u.pm % 9, panel = b * 8 + jt - 1;
        const size_t roff = ((size_t)b * SEQ + (size_t)(jt - 1) * 256) * DM;
        const float* ib = in_lat + roff; float* ob = out_lat + roff; const float* g = gate + b * 3072;
        const int col0 = u.pn * 256 + wc * 32 + 4 * fq;
        LAS float* Pw = (LAS float*)lds;
        LAS float* Sr = (LAS float*)(lds + 4096);
        LAS unsigned* flag = (LAS unsigned*)(lds + 5120);
        TP_START(32, lds, wid * 64 + lane);
#pragma unroll
        for (int bj = 0; bj < 2; ++bj)
#pragma unroll
            for (int n = 0; n < 2; ++n) {
                const f32x4 gvv = *(const f32x4*)(g + col0 + bj * 128 + n * 16);
                f32x4 hv[2][4];
#pragma unroll
                for (int ai = 0; ai < 2; ++ai)
#pragma unroll
                    for (int m = 0; m < 4; ++m) hv[ai][m] = *(const f32x4*)(ib + (size_t)(ai * 128 + wr * 64 + m * 16 + fr) * DM + col0 + bj * 128 + n * 16);
#pragma unroll
                for (int ai = 0; ai < 2; ++ai)
#pragma unroll
                    for (int m = 0; m < 4; ++m) { const int r = ai * 128 + wr * 64 + m * 16 + fr;
                        const size_t off = (size_t)r * DM + col0 + bj * 128 + n * 16;
                        const f32x4 o = hv[ai][m] + gvv * acc[ai][bj][m][n]; acc[ai][bj][m][n] = o;
                        if (mod_next) *(f32x4*)(ob + off) = o; }
                asm volatile("" ::: "memory");
            }
        TP_STOP(32, lds, wid * 64 + lane); TP_START(33, lds, wid * 64 + lane);
#pragma unroll
        for (int ai = 0; ai < 2; ++ai)
#pragma unroll
            for (int m = 0; m < 4; ++m) {
                float s = 0.f;
#pragma unroll
                for (int bj = 0; bj < 2; ++bj)
#pragma unroll
                    for (int n = 0; n < 2; ++n) { const f32x4 x = acc[ai][bj][m][n]; s += (x[0] * x[0] + x[1] * x[1]) + (x[2] * x[2] + x[3] * x[3]); }
                s += shfl_xor_f(s, 16); s += shfl_xor_f(s, 32);
                if (fq == 0) Pw[(ai * 128 + wr * 64 + m * 16 + fr) * 4 + wc] = s;
            }
        asm volatile("s_waitcnt lgkmcnt(0)" ::: "memory"); __builtin_amdgcn_s_barrier(); asm volatile("" ::: "memory");
        const int row = wid * 32 + (lane & 31);
        if (lane < 32) {
            const float t = (Pw[row * 4 + 0] + Pw[row * 4 + 1]) + (Pw[row * 4 + 2] + Pw[row * 4 + 3]);
            __hip_atomic_store((unsigned*)xbuf + ((size_t)panel * 256 + row) * 4 + u.pn, __float_as_uint(t), __ATOMIC_RELAXED, __HIP_MEMORY_SCOPE_AGENT);
        }
        asm volatile("s_waitcnt vmcnt(0)" ::: "memory");
        if (lane == 0) __hip_atomic_fetch_add(cnt + 16 * panel, 1u, __ATOMIC_RELAXED, __HIP_MEMORY_SCOPE_AGENT);
        if (wid == 0) {
            unsigned spins = 0;
            while ((unsigned)__builtin_amdgcn_readfirstlane(__hip_atomic_load(cnt + 16 * panel, __ATOMIC_RELAXED, __HIP_MEMORY_SCOPE_AGENT)) < 32u) { __builtin_amdgcn_s_sleep(2); if (++spins > (1u << 22)) break; }
            if (lane == 0) flag[0] = 1u;
        }
        asm volatile("s_waitcnt vmcnt(0) lgkmcnt(0)" ::: "memory"); __builtin_amdgcn_s_barrier(); asm volatile("" ::: "memory");
        if (lane < 32) {
            const unsigned* slot = (const unsigned*)xbuf + ((size_t)panel * 256 + row) * 4;
            const float t = (__uint_as_float(__hip_atomic_load(slot + 0, __ATOMIC_RELAXED, __HIP_MEMORY_SCOPE_AGENT)) + __uint_as_float(__hip_atomic_load(slot + 1, __ATOMIC_RELAXED, __HIP_MEMORY_SCOPE_AGENT)))
                          + (__uint_as_float(__hip_atomic_load(slot + 2, __ATOMIC_RELAXED, __HIP_MEMORY_SCOPE_AGENT)) + __uint_as_float(__hip_atomic_load(slot + 3, __ATOMIC_RELAXED, __HIP_MEMORY_SCOPE_AGENT)));
            Sr[row] = rsqrtf(t * (1.f / DM) + RMS_EPS);
        }
        asm volatile("s_waitcnt lgkmcnt(0)" ::: "memory"); __builtin_amdgcn_s_barrier(); asm volatile("" ::: "memory");
        TP_STOP(33, lds, wid * 64 + lane); TP_START(34, lds, wid * 64 + lane);
        const float* sh = mod_next ? mod_next + b * 3072 : nullptr;
#pragma unroll
        for (int bj = 0; bj < 2; ++bj)
#pragma unroll
            for (int n = 0; n < 2; ++n) {
                const int cc = col0 + bj * 128 + n * 16;
                const f32x4 w4 = *(const f32x4*)(nw + cc);
                f32x4 s4 = {1.f, 1.f, 1.f, 1.f}, h4 = {0.f, 0.f, 0.f, 0.f};
                if (mod_next) { s4 = *(const f32x4*)(sh + 1024 + cc) + 1.f; h4 = *(const f32x4*)(sh + cc); }
#pragma unroll
                for (int ai = 0; ai < 2; ++ai)
#pragma unroll
                    for (int m = 0; m < 4; ++m) { const int r = ai * 128 + wr * 64 + m * 16 + fr;
                        const f32x4 y = (acc[ai][bj][m][n] * Sr[r]) * w4;
                        if (mod_next) { const f32x4 o = y * s4 + h4; u32x2 w; w.x = pk2(o[0], o[1]); w.y = pk2(o[2], o[3]); *(u32x2*)(U + ((size_t)u.pm * 256 + r) * DM + cc) = w; }
                        else *(f32x4*)(ob + (size_t)r * DM + cc) = y; }
            }
        TP_STOP(34, lds, wid * 64 + lane);
    }
};

constexpr int MG_STAGE = 52224;
template <class EpiF>
DI void mini_gemm_tile(LAS unsigned char* lds, const bf16_t* A, int lda, const bf16_t* Bt, int K, const EpiF& epi, int wv) {
    const int tid = get_tid(wv), lane = tid & 63, wave = tid >> 6, r = lane & 31, h = lane >> 5, wm = wave >> 2, wn = wave & 3;
    const int lrow = tid >> 4, lch = tid & 15, nS = K / 128;
    const bf16_t* ap = A + (size_t)lrow * lda + 8 * lch;
    const bf16_t* bp = Bt + (size_t)lrow * K + 8 * lch;
    u32x4 s0[6], s1[6];
    f32x16 acc;
#pragma unroll
    for (int i = 0; i < 16; ++i) acc[i] = 0.f;
#define MG_LOAD(set, s) do { (set)[0] = *(const u32x4*)(ap + (s) * 128); (set)[1] = *(const u32x4*)(ap + (size_t)32 * lda + (s) * 128); \
        _Pragma("unroll") for (int q_ = 0; q_ < 4; ++q_) (set)[2 + q_] = *(const u32x4*)(bp + (size_t)(32 * q_) * K + (s) * 128); } while (0)
#define MG_STORE(set, buf) do { LAS unsigned char* b_ = lds + (buf) * MG_STAGE; *(LAS u32x4*)(b_ + lrow * 272 + lch * 16) = (set)[0]; *(LAS u32x4*)(b_ + (32 + lrow) * 272 + lch * 16) = (set)[1]; \
        _Pragma("unroll") for (int q_ = 0; q_ < 4; ++q_) *(LAS u32x4*)(b_ + 17408 + (32 * q_ + lrow) * 272 + lch * 16) = (set)[2 + q_]; } while (0)
#define MG_COMPUTE(buf) do { const LAS unsigned char* b_ = lds + (buf) * MG_STAGE; \
        _Pragma("unroll") for (int ks = 0; ks < 8; ++ks) { \
            const bf16x8 af = *(const LAS bf16x8*)(b_ + (32 * wm + r) * 272 + (16 * ks + 8 * h) * 2); \
            const bf16x8 bf = *(const LAS bf16x8*)(b_ + 17408 + (32 * wn + r) * 272 + (16 * ks + 8 * h) * 2); \
            acc = MFMA32(af, bf, acc); } } while (0)
    MG_LOAD(s0, 0); MG_LOAD(s1, 1);
    __syncthreads();
    MG_STORE(s0, 0);
    if (nS > 2) MG_LOAD(s0, 2);
#pragma unroll 1
    for (int s = 0; s < nS; s += 2) {
        __syncthreads();
        if (s + 1 < nS) { MG_STORE(s1, 1); if (s + 3 < nS) MG_LOAD(s1, s + 3); }
        MG_COMPUTE(0);
        __syncthreads();
        if (s + 2 < nS) { MG_STORE(s0, 0); if (s + 4 < nS) MG_LOAD(s0, s + 4); }
        if (s + 1 < nS) MG_COMPUTE(1);
    }
#undef MG_LOAD
#undef MG_STORE
#undef MG_COMPUTE
    epi(acc, 32 * wm, 32 * wn + r, h);
    __syncthreads();
}

DI void phase_pro(const Params& P, LAS unsigned char* lds, int wv) {
    const int tid = get_tid(wv);
    LAS float* s = (LAS float*)lds;
    LAS float* red = (LAS float*)(lds + 36864);
    float* mod = (float*)(P.ws + WS_MOD);
    for (int i = tid; i < 9 * 1024; i += 512) { const int r = i >> 10, k = i & 1023; const float v = r < 8 ? P.c[r * 1024 + k] : P.c_ctx[k]; s[i] = v * sigm(v); }
    __syncthreads();
    {
        const int ks = tid >> 4, col = tid & 15;
        float wv[3][32];
#pragma unroll
        for (int q = 0; q < 3; ++q) {
            const int item = get_bid() + q * (int)gridDim.x;
            if (item < 768) {
                const int l = item / 192, n0 = (item % 192) * 16;
                const float* w = P.ada_w + (size_t)l * 1024 * 3072 + (size_t)(ks * 32) * 3072 + n0 + col;
#pragma unroll
                for (int kk = 0; kk < 32; ++kk) wv[q][kk] = w[(size_t)kk * 3072];
            }
        }
#pragma unroll
        for (int q = 0; q < 3; ++q) {
            const int item = get_bid() + q * (int)gridDim.x;
            if (item < 768) {
                const int l = item / 192, n0 = (item % 192) * 16;
                float acc[9];
#pragma unroll
                for (int r = 0; r < 9; ++r) acc[r] = 0.f;
#pragma unroll
                for (int kk = 0; kk < 32; ++kk) {
#pragma unroll
                    for (int r = 0; r < 9; ++r) acc[r] += s[r * 1024 + ks * 32 + kk] * wv[q][kk]; }
#pragma unroll
                for (int r = 0; r < 9; ++r) red[(ks * 9 + r) * 16 + col] = acc[r];
                __syncthreads();
                if (tid < 144) { const int r = tid >> 4, cc = tid & 15; float sum = 0.f;
#pragma unroll
                    for (int k2 = 0; k2 < 32; ++k2) sum += red[(k2 * 9 + r) * 16 + cc];
                    mod[(l * 9 + r) * 3072 + n0 + cc] = sum + P.ada_b[l * 3072 + n0 + cc]; }
                __syncthreads();
            }
        }
    }
    float* cos_t = (float*)(P.ws + WS_ROPE); float* sin_t = cos_t + SEQ * 32;
    for (int i = get_bid() * 512 + tid; i < SEQ * 32; i += gridDim.x * 512) {
        const int pos = i >> 5, jj = i & 31, fi = jj & 15;
        const float inv = __builtin_amdgcn_exp2f(-(float)(2 * fi) * (13.287712379549449f / 32.f));
        const float ang = (float)(jj < 16 ? (pos >> 6) : (pos & 63)) * inv;
        cos_t[i] = __cosf(ang); sin_t[i] = __sinf(ang);
    }
}

template <bool FRAG = false>
DI void transpose_item(const float* W, int K, int N, bf16_t* WT, LAS float* scr, int item, int lane) {
    const int nblk = N / 32, kb = item / nblk, nb = item % nblk, k0 = 64 * kb, n0 = 32 * nb;
#pragma unroll 8
    for (int i = 0; i < 32; ++i) { const int kk = 2 * i + (lane >> 5); scr[kk * 33 + (lane & 31)] = W[(size_t)(k0 + kk) * N + n0 + (lane & 31)]; }
    asm volatile("s_waitcnt lgkmcnt(0)" ::: "memory");
    const int c = lane & 7;
#pragma unroll
    for (int j = 0; j < 4; ++j) { const int n = (lane >> 3) + 8 * j; const LAS float* sp = scr + (8 * c) * 33 + n;
        u32x4 o; o.x = pk2(sp[0 * 33], sp[1 * 33]); o.y = pk2(sp[2 * 33], sp[3 * 33]); o.z = pk2(sp[4 * 33], sp[5 * 33]); o.w = pk2(sp[6 * 33], sp[7 * 33]);
        if (FRAG) {
            const int nn = n0 + n, k8 = (k0 >> 3) + c;
            *(u32x4*)(WT + ((((nn >> 4) * 4 + (k8 >> 2)) * 64 + (k8 & 3) * 16 + (nn & 15)) * 8)) = o;
        } else *(u32x4*)(WT + (size_t)(n0 + n) * K + k0 + 8 * c) = o; }
    asm volatile("s_waitcnt lgkmcnt(0)" ::: "memory");
}

DI void phase_convert(const Params& P, LAS unsigned char* lds, int layer, int wv) {
    const int tid = get_tid(wv), lane = tid & 63, wave = tid >> 6;
    const int gw = get_bid() * 8 + wave, NGW = gridDim.x * 8;
    const int j = layer >> 1;
    LAS float* scr = (LAS float*)(lds + wave * 16384);
    bf16_t* WIN = (bf16_t*)(P.ws + WS_WIN); bf16_t* WOUT = (bf16_t*)(P.ws + WS_WOUT); bf16_t* WRG = (bf16_t*)(P.ws + WS_WRG);
    if ((layer & 1) == 0) {
        constexpr int I_IN = 16 * (EVEN_IN / 32), I_OUT = 32 * 32, I_RG = 32 * 8;
        for (int it = gw; it < I_IN + I_OUT + I_RG; it += NGW) {
            int r = it;
            if (r < I_IN) { transpose_item(P.ev_w_in + (size_t)j * 1024 * EVEN_IN, 1024, EVEN_IN, WIN, scr, r, lane); continue; } r -= I_IN;
            if (r < I_OUT) { transpose_item(P.ev_w_out + (size_t)j * 2048 * 1024, 2048, 1024, WOUT, scr, r, lane); continue; } r -= I_OUT;
            const int mat = r >> 3, sub = r & 7;
            const int dir = mat >> 4, gate = (mat >> 3) & 1, hd = mat & 7;
            const float* src = (gate == 0 ? P.ev_rg_wx : P.ev_rg_wa) + ((size_t)((j * 2 + dir) * 8 + hd)) * 16384;
            transpose_item<true>(src, 128, 128, WRG + (size_t)mat * 16384, scr, sub, lane);
        }
    } else {
        constexpr int I_IN = 16 * (ODD_IN / 32), I_OUT = 16 * 32;
        for (int it = gw; it < I_IN + I_OUT; it += NGW) {
            int r = it;
            if (r < I_IN) { transpose_item(P.od_w_in + (size_t)j * 1024 * ODD_IN, 1024, ODD_IN, WIN, scr, r, lane); continue; } r -= I_IN;
            transpose_item(P.od_w_out + (size_t)j * 1024 * 1024, 1024, 1024, WOUT, scr, r, lane);
        }
    }
}
DI void phase_norm(const Params& P, LAS unsigned char* lds, int layer, int wv) {
    const int tid = get_tid(wv), lane = tid & 63, wave = tid >> 6;
    const int gw = get_bid() * 8 + wave, NGW = gridDim.x * 8;
    if (layer > 0) phase_convert(P, lds, layer, wv);
    const float* hl = layer == 0 ? P.x : P.out; const float* hc = layer == 0 ? P.ctx : (const float*)(P.ws + WS_HCTX);
    const float* mod = (const float*)(P.ws + WS_MOD) + (size_t)layer * 9 * 3072;
    const float* nw = P.norm_w + layer * 1024;
    bf16_t* U = (bf16_t*)(P.ws + WS_OV);
    f32x4 w4[4], s4[4], h4[4];
#pragma unroll
    for (int q = 0; q < 4; ++q) w4[q] = *(const f32x4*)(nw + 4 * lane + 256 * q);
    int cur_m = -1;
    const int nrows = layer == 0 ? MROWS : NB * CTXL;
    const int rpw = (nrows + NGW - 1) / NGW;
    for (int idx = gw * rpw; idx < gw * rpw + rpw && idx < nrows; ++idx) {
        const int b = layer == 0 ? idx / LT : idx >> 8, jr = layer == 0 ? idx % LT : idx & 255;
        const int R = b * LT + jr;
        const float* src = jr < CTXL ? hc + ((size_t)b * CTXL + jr) * DM : hl + ((size_t)b * SEQ + (jr - CTXL)) * DM;
        const int mrow = jr < CTXL ? 8 : b;
        if (mrow != cur_m) {
            cur_m = mrow;
            const float* sh = mod + mrow * 3072; const float* sc = sh + 1024;
#pragma unroll
            for (int q = 0; q < 4; ++q) { s4[q] = *(const f32x4*)(sc + 4 * lane + 256 * q) + 1.f; h4[q] = *(const f32x4*)(sh + 4 * lane + 256 * q); }
        }
        f32x4 v[4]; float ss = 0.f;
#pragma unroll
        for (int q = 0; q < 4; ++q) { v[q] = *(const f32x4*)(src + 4 * lane + 256 * q); ss += (v[q][0] * v[q][0] + v[q][1] * v[q][1]) + (v[q][2] * v[q][2] + v[q][3] * v[q][3]); }
        const float rstd = rsqrtf(wave_sum(ss) * (1.f / DM) + RMS_EPS);
#pragma unroll
        for (int q = 0; q < 4; ++q) { const int k = 4 * lane + 256 * q;
            const f32x4 y = (v[q] * rstd) * w4[q]; const f32x4 o = y * s4[q] + h4[q];
            u32x2 w; w.x = pk2(o[0], o[1]); w.y = pk2(o[2], o[3]); *(u32x2*)(U + (size_t)R * DM + k) = w; }
    }
}

typedef _Float16 f16x2_t __attribute__((ext_vector_type(2)));
DI unsigned pkh2(float a, float b) { const f16x2_t v = {(_Float16)a, (_Float16)b}; return __builtin_bit_cast(unsigned, v); }
DI void unpkh2(unsigned u, float& a, float& b) { const f16x2_t v = __builtin_bit_cast(f16x2_t, u); a = (float)v[0]; b = (float)v[1]; }
constexpr int RG_UT = 0, RG_AL = 17408, RG_BL = 50176, RG_HP = 82944, RG_QA = 148480, RG_CAR = 152576, RG_FLAG = 153600, RG_END = 153664;
static_assert(RG_END <= LDS_BYTES - 256, "RG-LRU LDS map");
constexpr int CW_RG = 8192;
DI void rglru_item(const Params& P, LAS unsigned char* lds, int j, int item, int mode, int buf, int wv) {
    const int tid = get_tid(wv), lane = tid & 63, wave = tid >> 6, r = lane & 15, g = lane >> 4;
    const int grp = item / NCHUNK, ci = item % NCHUNK, b = grp >> 3, hd = grp & 7;
    bf16_t* p = (bf16_t*)(P.ws + WS_P);
    const bf16_t* WRG = (const bf16_t*)(P.ws + WS_WRG);
    unsigned long long* AGG = (unsigned long long*)(P.ws + WS_AGG);
    unsigned* cnt = (unsigned*)(P.ws + WS_CTL) + CW_RG + (j * 64 + grp) * 16;
    const int R0 = b * LT + ci * 64;
    const int seg_lo = b * LT + (ci < 4 ? 0 : CTXL), seg_hi = b * LT + (ci < 4 ? CTXL : LT);
    LAS bf16_t* UT = (LAS bf16_t*)(lds + RG_UT);
    LAS float* AL = (LAS float*)(lds + RG_AL);
    LAS float* BL = (LAS float*)(lds + RG_BL);
    LAS unsigned* HP = (LAS unsigned*)(lds + 17408 + buf * 65536);
    LAS float* QA = (LAS float*)(lds + RG_QA);
    LAS float* CAR = (LAS float*)(lds + 148480);
    if (mode == 0) {
    TP_START(10, lds, tid); TP_START(11, lds, tid);
    bf16x8 wfr[2][2][4];
    float prm[2][3];
#pragma unroll
    for (int dir = 0; dir < 2; ++dir) {
#pragma unroll
        for (int gt = 0; gt < 2; ++gt) {
            const bf16_t* W = WRG + (size_t)((dir * 2 + gt) * 8 + hd) * 16384 + (wave * 4 * 64 + lane) * 8;
#pragma unroll
            for (int ks = 0; ks < 4; ++ks) wfr[dir][gt][ks] = *(const bf16x8*)(W + ks * 512);
        }
        const int idx = (j * 2 + dir) * 1024 + hd * 128 + 16 * wave + r;
        prm[dir][0] = P.ev_rg_bx[idx]; prm[dir][1] = P.ev_rg_ba[idx]; prm[dir][2] = P.ev_rg_lambda[idx];
    }
    {
        LAS bf16_t* XT = (LAS bf16_t*)HP;
#pragma unroll
        for (int rep = 0; rep < 3; ++rep) {
            const int idx = tid + rep * 512, tr = idx >> 4, c0 = (idx & 15) * 8;
            if (idx < 67 * 16) {
                const int Rg = R0 + tr - 1;
                u32x4 xv = {0u, 0u, 0u, 0u};
                if (Rg >= seg_lo && Rg < seg_hi) xv = *(const u32x4*)(p + (size_t)Rg * EVEN_IN + hd * 128 + c0);
                *(LAS u32x4*)(XT + tr * 128 + c0) = xv;
            }
        }
        const int c0 = (tid & 15) * 8, cg0 = hd * 128 + c0;
        float wv4[4][8], bias[8];
        { const f32x4 b0 = *(const f32x4*)(P.ev_conv_b + j * 1024 + cg0), b1 = *(const f32x4*)(P.ev_conv_b + j * 1024 + cg0 + 4);
          bias[0] = b0[0]; bias[1] = b0[1]; bias[2] = b0[2]; bias[3] = b0[3]; bias[4] = b1[0]; bias[5] = b1[1]; bias[6] = b1[2]; bias[7] = b1[3]; }
#pragma unroll
        for (int k = 0; k < 4; ++k) { const float* wk = P.ev_conv_w + (size_t)(j * 4 + k) * 1024 + cg0; const f32x4 w0 = *(const f32x4*)wk, w1 = *(const f32x4*)(wk + 4);
            wv4[k][0] = w0[0]; wv4[k][1] = w0[1]; wv4[k][2] = w0[2]; wv4[k][3] = w0[3]; wv4[k][4] = w1[0]; wv4[k][5] = w1[1]; wv4[k][6] = w1[2]; wv4[k][7] = w1[3]; }
        __syncthreads();
#pragma unroll
        for (int rep = 0; rep < 2; ++rep) {
            const int t = (tid >> 4) + rep * 32;
            float acc[8];
#pragma unroll
            for (int e = 0; e < 8; ++e) acc[e] = bias[e];
#pragma unroll
            for (int k = 0; k < 4; ++k) {
                const u32x4 xv = *(const LAS u32x4*)(XT + (t + k) * 128 + c0);
                acc[0] += wv4[k][0] * __uint_as_float(xv.x << 16); acc[1] += wv4[k][1] * __uint_as_float(xv.x & 0xffff0000u);
                acc[2] += wv4[k][2] * __uint_as_float(xv.y << 16); acc[3] += wv4[k][3] * __uint_as_float(xv.y & 0xffff0000u);
                acc[4] += wv4[k][4] * __uint_as_float(xv.z << 16); acc[5] += wv4[k][5] * __uint_as_float(xv.z & 0xffff0000u);
                acc[6] += wv4[k][6] * __uint_as_float(xv.w << 16); acc[7] += wv4[k][7] * __uint_as_float(xv.w & 0xffff0000u);
            }
            u32x4 o; o.x = pk2(acc[0], acc[1]); o.y = pk2(acc[2], acc[3]); o.z = pk2(acc[4], acc[5]); o.w = pk2(acc[6], acc[7]);
            *(LAS u32x4*)(UT + t * 136 + c0) = o;
        }
    }
    __syncthreads();
    TP_STOP(11, lds, tid);
#pragma unroll
    for (int dir = 0; dir < 2; ++dir) {
        TP_START(12, lds, tid); TP_START(16, lds, tid);
        f32x4 ax[4], aa[4];
#pragma unroll
        for (int m = 0; m < 4; ++m) { ax[m] = (f32x4){0.f, 0.f, 0.f, 0.f}; aa[m] = (f32x4){0.f, 0.f, 0.f, 0.f}; }
#pragma unroll
        for (int ks = 0; ks < 4; ++ks) {
#pragma unroll
            for (int m = 0; m < 4; ++m) {
                const bf16x8 a = *(const LAS bf16x8*)(UT + (16 * m + r) * 136 + 32 * ks + 8 * g);
                ax[m] = MFMA16(a, wfr[dir][0][ks], ax[m]); aa[m] = MFMA16(a, wfr[dir][1][ks], aa[m]);
            }
        }
        asm volatile("" :: "v"(ax[0]), "v"(ax[1]), "v"(ax[2]), "v"(ax[3]), "v"(aa[0]), "v"(aa[1]), "v"(aa[2]), "v"(aa[3]));
        TP_STOP(16, lds, tid); TP_START(17, lds, tid);
        float av[4][4], bv[4][4];
        {
            const int c = 16 * wave + r;
            const float bxv = prm[dir][0], bav = prm[dir][1], lam = prm[dir][2];
            const float sp = softplus_neg(lam);
#pragma unroll
            for (int m = 0; m < 4; ++m)
#pragma unroll
                for (int i = 0; i < 4; ++i) {
                    const int t = 16 * m + 4 * g + i;
                    const float gx = sigm(ax[m][i] + bxv), ga = sigm(aa[m][i] + bav);
                    const float la = -8.f * ga * sp;
                    const float a = __expf(la), mult = __builtin_amdgcn_sqrtf((1.f - a) * (1.f + a));
                    const float uv = bf2f(UT[t * 136 + c]);
                    av[m][i] = a; bv[m][i] = mult * gx * uv;
                }
        }
        TP_STOP(17, lds, tid);
        TP_STOP(12, lds, tid); TP_START(13, lds, tid);
        {
            const int c = 16 * wave + r;
            float hl[4][4], pl[4][4], sa[4], sb[4];
#pragma unroll
            for (int m = 0; m < 4; ++m) {
                float h = 0.f, pc = 1.f;
#pragma unroll
                for (int ii = 0; ii < 4; ++ii) { const int i = dir == 0 ? ii : 3 - ii; h = av[m][i] * h + bv[m][i]; pc *= av[m][i]; hl[m][i] = h; pl[m][i] = pc; }
                sa[m] = pc; sb[m] = h;
            }
            float hin[4], pin[4];
            {
                float ca[4][4], cb[4][4];
#pragma unroll
                for (int m = 0; m < 4; ++m)
#pragma unroll
                    for (int gg = 0; gg < 4; ++gg) {
                        const int src = (16 * gg + r) << 2;
                        ca[m][gg] = __int_as_float(__builtin_amdgcn_ds_bpermute(src, __float_as_int(sa[m])));
                        cb[m][gg] = __int_as_float(__builtin_amdgcn_ds_bpermute(src, __float_as_int(sb[m])));
                    }
                float H = 0.f, Pc = 1.f;
#pragma unroll
                for (int ss = 0; ss < 16; ++ss) {
                    const int s = dir == 0 ? ss : 15 - ss, m = s >> 2, gg = s & 3;
                    if (gg == g) { hin[m] = H; pin[m] = Pc; }
                    H = ca[m][gg] * H + cb[m][gg]; Pc *= ca[m][gg];
                }
                if (g == 0) {
                    const unsigned long long v = ((unsigned long long)__float_as_uint(H) << 32) | __float_as_uint(Pc);
                    __hip_atomic_store(AGG + ((size_t)(dir * NB + b) * NCHUNK + ci) * 1024 + hd * 128 + c, v, __ATOMIC_RELAXED, __HIP_MEMORY_SCOPE_AGENT);
                }
            }
#pragma unroll
            for (int m = 0; m < 4; ++m)
#pragma unroll
                for (int i = 0; i < 4; ++i) HP[(dir * 64 + 16 * m + 4 * g + i) * 128 + c] = pkh2(hl[m][i] + pl[m][i] * hin[m], pl[m][i] * pin[m]);
        }
        TP_STOP(13, lds, tid);
    }
    asm volatile("s_waitcnt vmcnt(0)" ::: "memory");
    __syncthreads();
    if (tid == 0) __hip_atomic_fetch_add(cnt, 1u, __ATOMIC_RELAXED, __HIP_MEMORY_SCOPE_AGENT);
    TP_STOP(10, lds, tid);
    return;
    }
    TP_START(14, lds, tid);
    u32x4 gpre[2];
#pragma unroll
    for (int rep = 0; rep < 2; ++rep) { const int idx = tid + rep * 512; gpre[rep] = *(const u32x4*)(p + (size_t)(R0 + (idx >> 4)) * EVEN_IN + 1536 + hd * 128 + (idx & 15) * 8); }
    if (tid == 0) {
        unsigned spins = 0;
        while (__hip_atomic_load(cnt, __ATOMIC_RELAXED, __HIP_MEMORY_SCOPE_AGENT) < (unsigned)NCHUNK) { __builtin_amdgcn_s_sleep(2); if (++spins > (1u << 22)) break; }
    }
    __syncthreads();
    TP_STOP(14, lds, tid); TP_START(15, lds, tid);
    if (tid < 256) {
        const int dir = tid >> 7, c = tid & 127;
        const int pos = dir == 0 ? ci : (ci < 4 ? 3 - ci : 39 - ci);
        float h = 0.f;
        const unsigned long long* ag = AGG + (size_t)(dir * NB + b) * NCHUNK * 1024 + hd * 128 + c;
#pragma unroll 1
        for (int base = 0; base < pos; base += 18) {
            unsigned long long v[18];
#pragma unroll
            for (int k = 0; k < 18; ++k) { const int pp = base + k < pos ? base + k : pos - 1; const int cc = dir == 0 ? pp : (pp < 4 ? 3 - pp : 39 - pp);
                v[k] = __hip_atomic_load(ag + (size_t)cc * 1024, __ATOMIC_RELAXED, __HIP_MEMORY_SCOPE_AGENT); }
#pragma unroll
            for (int k = 0; k < 18; ++k) if (base + k < pos) h = __uint_as_float((unsigned)v[k]) * h + __uint_as_float((unsigned)(v[k] >> 32));
        }
        CAR[dir * 128 + c] = h;
    }
    __syncthreads();
#pragma unroll
    for (int rep = 0; rep < 2; ++rep) {
        const int idx = tid + rep * 512, t = idx >> 4, c0 = (idx & 15) * 8;
        bf16_t* gp = p + (size_t)(R0 + t) * EVEN_IN + 1536 + hd * 128 + c0;
        const u32x4 gv = gpre[rep];
        float y[8];
#pragma unroll
        for (int e = 0; e < 8; ++e) {
            float h0, p0, h1, p1; unpkh2(HP[t * 128 + c0 + e], h0, p0); unpkh2(HP[(64 + t) * 128 + c0 + e], h1, p1);
            y[e] = (h0 + p0 * CAR[c0 + e]) + (h1 + p1 * CAR[128 + c0 + e]);
        }
        const float gg[8] = {__uint_as_float(gv.x << 16), __uint_as_float(gv.x & 0xffff0000u), __uint_as_float(gv.y << 16), __uint_as_float(gv.y & 0xffff0000u),
                             __uint_as_float(gv.z << 16), __uint_as_float(gv.z & 0xffff0000u), __uint_as_float(gv.w << 16), __uint_as_float(gv.w & 0xffff0000u)};
        u32x4 o;
        o.x = pk2(y[0] * gg[0] * sigm(gg[0]), y[1] * gg[1] * sigm(gg[1])); o.y = pk2(y[2] * gg[2] * sigm(gg[2]), y[3] * gg[3] * sigm(gg[3]));
        o.z = pk2(y[4] * gg[4] * sigm(gg[4]), y[5] * gg[5] * sigm(gg[5])); o.w = pk2(y[6] * gg[6] * sigm(gg[6]), y[7] * gg[7] * sigm(gg[7]));
        *(u32x4*)gp = o;
    }
    __syncthreads();
    TP_STOP(15, lds, tid);
}

DI void rope8v(u32x4& v, const f32x4 cs, const f32x4 sn) {
    unsigned* w = (unsigned*)&v;
#pragma unroll
    for (int i = 0; i < 4; ++i) { const float t1 = __uint_as_float(w[i] << 16), t2 = __uint_as_float(w[i] & 0xffff0000u); w[i] = pk2(t1 * cs[i] - t2 * sn[i], t1 * sn[i] + t2 * cs[i]); }
}
DI void rope8(u32x4& v, const float* cs, const float* sn) { rope8v(v, *(const f32x4*)cs, *(const f32x4*)sn); }
DI void rope8s(u32x4& v, const float* cs, const float* sn, float sc) { rope8v(v, *(const f32x4*)cs * sc, *(const f32x4*)sn * sc); }
DI void scale8(u32x4& v, float sc) {
    unsigned* w = (unsigned*)&v;
#pragma unroll
    for (int i = 0; i < 4; ++i) w[i] = pk2(__uint_as_float(w[i] << 16) * sc, __uint_as_float(w[i] & 0xffff0000u) * sc);
}
typedef short v4i16_a __attribute__((ext_vector_type(4)));
DI void attn_item(const Params& P, LAS unsigned char* lds, int j, int item, int wv) {
    const int tid = get_tid(wv), lane = tid & 63, wave = tid >> 6, r = lane & 31, h = lane >> 5;
    const bool is_lat = item < 512;
    int b, qb, kvh;
    if (is_lat) { b = item >> 6; qb = (item >> 2) & 15; kvh = item & 3; } else { const int it = item - 512; b = it >> 3; qb = (it >> 2) & 1; kvh = it & 3; }
    bf16_t* p = (bf16_t*)(P.ws + WS_P);
    const float* cos_t = (const float*)(P.ws + WS_ROPE); const float* sin_t = cos_t + SEQ * 32;
    LAS unsigned char* QL = lds + 36864 + wave * 9216;
    TP_START(1, lds, tid);
    const int hq = 4 * kvh + (wave >> 1), ql0 = qb * 128 + 64 * (wave & 1);
    const size_t rowbase = (size_t)b * LT + (is_lat ? CTXL : 0);
    {
        const int chq = lane & 7;
#pragma unroll
        for (int k = 0; k < 8; ++k) {
            const int row = (lane >> 3) + 8 * k, qi = ql0 + row;
            u32x4 v = *(const u32x4*)(p + (rowbase + qi) * EVEN_IN + 2560 + hq * 64 + 8 * chq);
            if (is_lat) rope8s(v, cos_t + qi * 32 + 4 * chq, sin_t + qi * 32 + 4 * chq, 0.125f * LOG2E); else scale8(v, 0.125f * LOG2E);
            *(LAS u32x4*)(QL + row * 144 + chq * 16) = v;
        }
    }
    const float sink2 = P.ev_sink[j * 16 + hq] * LOG2E;
    float mrun[2] = {sink2, sink2}, lrun[2] = {h == 0 ? 1.f : 0.f, h == 0 ? 1.f : 0.f};
    f32x16 O[2][2];
#pragma unroll
    for (int a = 0; a < 2; ++a)
#pragma unroll
        for (int c = 0; c < 2; ++c)
#pragma unroll
            for (int i = 0; i < 16; ++i) O[a][c][i] = 0.f;
    const int w_lo = (is_lat && qb == 0) ? 2 : 0, w_hi = (is_lat && qb == 15) ? 3 : 5;
    const int nT = is_lat ? 4 + (w_hi - w_lo + 1) : 4;
    const float SC = 0.125f * LOG2E, NEG = -1e30f;
    const int key = tid >> 3, chn = tid & 7;
    u32x4 kreg, vreg; f32x4 creg, sreg;
#define ATT_K0(t) ((t) < 4 ? 64 * (t) : qb * 128 - 128 + 64 * (w_lo + (t) - 4))
#define ATT_LOAD(t) do { const bool win_ = (t) >= 4; const int k0_ = ATT_K0(t); \
        const bf16_t* kp_ = p + ((size_t)b * LT + (win_ ? CTXL : 0) + k0_ + key) * EVEN_IN + 1024 + kvh * 64 + 8 * chn; \
        kreg = *(const u32x4*)kp_; vreg = *(const u32x4*)(kp_ + 256); \
        if (win_) { creg = *(const f32x4*)(cos_t + (k0_ + key) * 32 + 4 * chn); sreg = *(const f32x4*)(sin_t + (k0_ + key) * 32 + 4 * chn); } } while (0)
#define ATT_STORE(t, buf) do { const bool win_ = (t) >= 4; \
        if (win_) rope8v(kreg, creg, sreg); \
        *(LAS u32x4*)(lds + (buf) * 18432 + key * 144 + chn * 16) = kreg; *(LAS u32x4*)(lds + (buf) * 18432 + 9216 + key * 144 + chn * 16) = vreg; } while (0)
    TP_START(2, lds, tid);
    ATT_LOAD(0); ATT_STORE(0, 0);
    if (nT > 1) ATT_LOAD(1);
#pragma unroll 1
    for (int t = 0; t < nT; ++t) {
        TP_START(4, lds, tid);
        __syncthreads();
        TP_STOP(4, lds, tid);
        if (t + 1 < nT) { ATT_STORE(t + 1, (t + 1) & 1); if (t + 2 < nT) ATT_LOAD(t + 2); }
        TP_START(3, lds, tid);
        const bool win = t >= 4;
        const int k0 = ATT_K0(t);
        const int dq = k0 - ql0;
        if (win && (dq >= 192 || dq <= -192)) continue;
        const bool need_mask = win && (dq >= 128 || dq <= -128);
        const LAS unsigned char* KL = lds + (t & 1) * 18432;
        const LAS bf16_t* VL = (const LAS bf16_t*)(lds + (t & 1) * 18432 + 9216);
#pragma unroll
        for (int qt = 0; qt < 2; ++qt) {
            f32x16 s0, s1;
            { const float nm = -mrun[qt];
#pragma unroll
              for (int i = 0; i < 16; ++i) { s0[i] = nm; s1[i] = nm; } }
#pragma unroll
            for (int ks = 0; ks < 4; ++ks) {
                const bf16x8 qfr = *(const LAS bf16x8*)(QL + (32 * qt + r) * 144 + (16 * ks + 8 * h) * 2);
                const bf16x8 k0f = *(const LAS bf16x8*)(KL + r * 144 + (16 * ks + 8 * h) * 2), k1f = *(const LAS bf16x8*)(KL + (32 + r) * 144 + (16 * ks + 8 * h) * 2);
                s0 = MFMA32(k0f, qfr, s0); s1 = MFMA32(k1f, qfr, s1);
            }
            const int qpos = ql0 + 32 * qt + r;
            if (need_mask) {
#pragma unroll
                for (int i = 0; i < 16; ++i) {
                    const int d0 = qpos - (k0 + crow(i, h)), d1 = d0 - 32;
                    if (d0 > 128 || d0 < -128) s0[i] = NEG;
                    if (d1 > 128 || d1 < -128) s1[i] = NEG;
                }
            }
            float mx = NEG;
#pragma unroll
            for (int i = 0; i < 16; ++i) mx = fmaxf(mx, fmaxf(s0[i], s1[i]));
            mx = fmaxf(mx, shfl_xor_f(mx, 32));
            if (__any(mx > 6.0f)) {
                const float shift = fmaxf(mx, 0.f), alpha = __builtin_amdgcn_exp2f(-shift);
                mrun[qt] += shift; lrun[qt] *= alpha;
#pragma unroll
                for (int i = 0; i < 16; ++i) { s0[i] -= shift; s1[i] -= shift; }
#pragma unroll
                for (int dt = 0; dt < 2; ++dt)
#pragma unroll
                    for (int i = 0; i < 16; ++i) O[dt][qt][i] *= alpha;
            }
            float ls = 0.f;
#pragma unroll
            for (int i = 0; i < 16; ++i) { s0[i] = __builtin_amdgcn_exp2f(s0[i]); s1[i] = __builtin_amdgcn_exp2f(s1[i]); ls += s0[i] + s1[i]; }
            lrun[qt] += ls;
            bf16x8 pf[2][2];
#pragma unroll
            for (int s = 0; s < 2; ++s) {
                u32x4 a, c;
                a.x = pk2(s0[8 * s + 0], s0[8 * s + 1]); a.y = pk2(s0[8 * s + 2], s0[8 * s + 3]); a.z = pk2(s0[8 * s + 4], s0[8 * s + 5]); a.w = pk2(s0[8 * s + 6], s0[8 * s + 7]);
                c.x = pk2(s1[8 * s + 0], s1[8 * s + 1]); c.y = pk2(s1[8 * s + 2], s1[8 * s + 3]); c.z = pk2(s1[8 * s + 4], s1[8 * s + 5]); c.w = pk2(s1[8 * s + 6], s1[8 * s + 7]);
                pf[0][s] = __builtin_bit_cast(bf16x8, a); pf[1][s] = __builtin_bit_cast(bf16x8, c);
            }
            const int gq = (lane >> 4) & 1, qq4 = (lane & 15) >> 2, pp4 = lane & 3;
#pragma unroll
            for (int dt = 0; dt < 2; ++dt)
#pragma unroll
                for (int kt = 0; kt < 2; ++kt)
#pragma unroll
                    for (int s = 0; s < 2; ++s) {
                        const LAS bf16_t* vp = VL + (32 * kt + 16 * s + 4 * h + qq4) * 72 + 32 * dt + 16 * gq + 4 * pp4;
                        const v4i16_a lo = __builtin_amdgcn_ds_read_tr16_b64_v4i16((LAS v4i16_a*)vp);
                        const v4i16_a hi = __builtin_amdgcn_ds_read_tr16_b64_v4i16((LAS v4i16_a*)(vp + 8 * 72));
                        const bf16x8 vf = {lo[0], lo[1], lo[2], lo[3], hi[0], hi[1], hi[2], hi[3]};
                        O[dt][qt] = MFMA32(vf, pf[kt][s], O[dt][qt]);
                    }
            __builtin_amdgcn_sched_barrier(0);
        }
        TP_STOP(3, lds, tid);
    }
    TP_STOP(2, lds, tid);
#undef ATT_K0
#undef ATT_LOAD
#undef ATT_STORE
    {
        const int chq = lane & 7;
        u32x4 gate[8];
#pragma unroll
        for (int k = 0; k < 8; ++k) gate[k] = *(const u32x4*)(p + (rowbase + ql0 + (lane >> 3) + 8 * k) * EVEN_IN + 3584 + hq * 64 + 8 * chq);
#pragma unroll
        for (int qt = 0; qt < 2; ++qt) {
            const float lt = lrun[qt] + shfl_xor_f(lrun[qt], 32), inv = __builtin_amdgcn_rcpf(lt);
#pragma unroll
            for (int dt = 0; dt < 2; ++dt)
#pragma unroll
                for (int i4 = 0; i4 < 4; ++i4) {
                    u32x2 o; o.x = pk2(O[dt][qt][4 * i4 + 0] * inv, O[dt][qt][4 * i4 + 1] * inv); o.y = pk2(O[dt][qt][4 * i4 + 2] * inv, O[dt][qt][4 * i4 + 3] * inv);
                    *(LAS u32x2*)(QL + (32 * qt + r) * 144 + (32 * dt + 8 * i4 + 4 * h) * 2) = o;
                }
        }
#pragma unroll
        for (int k = 0; k < 8; ++k) {
            const int row = (lane >> 3) + 8 * k;
            const u32x4 ov = *(const LAS u32x4*)(QL + row * 144 + chq * 16);
            const unsigned* ow = (const unsigned*)&ov; const unsigned* gw = (const unsigned*)&gate[k];
            u32x4 res; unsigned* rw = (unsigned*)&res;
#pragma unroll
            for (int e = 0; e < 4; ++e) {
                const float g0 = __uint_as_float(gw[e] << 16), g1 = __uint_as_float(gw[e] & 0xffff0000u);
                rw[e] = pk2(__uint_as_float(ow[e] << 16) * g0 * sigm(g0), __uint_as_float(ow[e] & 0xffff0000u) * g1 * sigm(g1));
            }
            *(u32x4*)(p + (rowbase + ql0 + row) * EVEN_IN + 2560 + hq * 64 + 8 * chq) = res;
        }
    }
    __syncthreads();
    TP_STOP(1, lds, tid);
}

constexpr int G2_QX = 0, G2_KF = 17408, G2_K2 = 60928, G2_VS = 79360, G2_AM = 96768, G2_ST = 105984, G2_PS = 140800, G2_BL = 144896, G2_Q1 = 145408, G2_END = 162816;
static_assert(G2_END <= LDS_BYTES - 256, "GLA LDS map");
typedef short v4i16_t __attribute__((ext_vector_type(4)));
DI bf16x8 frag_tr(const LAS bf16_t* M, int stride, int k0, int n0, int lane) {
    const int i = lane & 15, g = lane >> 4, q = i >> 2, pp = i & 3;
    const LAS bf16_t* a0 = M + (k0 + 8 * g + q) * stride + n0 + 4 * pp;
    const v4i16_t lo = __builtin_amdgcn_ds_read_tr16_b64_v4i16((LAS v4i16_t*)a0);
    const v4i16_t hi = __builtin_amdgcn_ds_read_tr16_b64_v4i16((LAS v4i16_t*)(a0 + 4 * stride));
    return (bf16x8){lo[0], lo[1], lo[2], lo[3], hi[0], hi[1], hi[2], hi[3]};
}

#ifndef GLA_SPLIT
#define GLA_SPLIT 24
#endif
template <int DIR>
DI void gla2_item(const Params& P, LAS unsigned char* lds, int layer_j, int b, int hd, int part, int wv) {
    const int tid = get_tid(wv), lane = tid & 63, wave = tid >> 6, r = lane & 15, g = lane >> 4;
    bf16_t* p = (bf16_t*)(P.ws + WS_P);
    LAS bf16_t* QX = (LAS bf16_t*)(lds + G2_QX); LAS bf16_t* KF = (LAS bf16_t*)(lds + G2_KF); LAS bf16_t* K2 = (LAS bf16_t*)(lds + G2_K2);
    LAS bf16_t* VS = (LAS bf16_t*)(lds + G2_VS); LAS bf16_t* AM = (LAS bf16_t*)(lds + G2_AM); LAS bf16_t* ST = (LAS bf16_t*)(lds + G2_ST);
    LAS float* PS8 = (LAS float*)(lds + G2_PS); LAS float* BLAST = (LAS float*)(lds + G2_BL); LAS bf16_t* Q1 = (LAS bf16_t*)(lds + G2_Q1);
    const int d0 = 2 * lane, tg = wave, I = tg >> 1, half = tg & 1;
    float lbv[2] = {0.f, 0.f};
    if (layer_j > 0) { lbv[0] = sigm(P.od_lb_raw[1024 + hd * 128 + d0] - P.od_lb_raw[hd * 128 + d0]); lbv[1] = sigm(P.od_lb_raw[1024 + hd * 128 + d0 + 1] - P.od_lb_raw[hd * 128 + d0 + 1]); }
    unsigned* prog = (unsigned*)(P.ws + WS_CTL) + 10240 + ((layer_j * 128 + b * 16 + hd * 2 + DIR) * 8);
    const int step_end = part == 0 ? GLA_SPLIT : NCHUNK;
    TP_START(20, lds, tid);
    for (int i = tid; i < (9216 + 34816) / 4; i += 512) ((LAS unsigned*)(lds + G2_AM))[i] = 0u;
    f32x4 st[8];
#pragma unroll
    for (int e = 0; e < 8; ++e) st[e] = (f32x4){0.f, 0.f, 0.f, 0.f};
    unsigned zn[8], qn[8]; u32x4 vn[2];
#define G2_OFFZ(s) ((unsigned)((DIR == 0 ? 8 * tg + (s) : 63 - 8 * tg - (s)) * ODD_IN + d0) * 2u)
#define G2_OFFV(rep) ((unsigned)((DIR == 0 ? ((tid + (rep) * 512) >> 4) : 63 - ((tid + (rep) * 512) >> 4)) * ODD_IN + 8 * ((tid + (rep) * 512) & 15)) * 2u)
    const size_t colz = (size_t)DIR * 1024 + hd * 128, colq = 3072 + hd * 128, colv = 2048 + hd * 128;
    {
        const int chunk = DIR == 0 ? 0 : 3;
        const char* slab = (const char*)(p + ((size_t)b * LT + (size_t)chunk * 64) * ODD_IN);
#pragma unroll
        for (int s = 0; s < 8; ++s) { zn[s] = *(const unsigned*)(slab + colz * 2 + G2_OFFZ(s)); qn[s] = *(const unsigned*)(slab + colq * 2 + G2_OFFZ(s)); }
#pragma unroll
        for (int rep = 0; rep < 2; ++rep) vn[rep] = *(const u32x4*)(slab + colv * 2 + G2_OFFV(rep));
    }
    __syncthreads();
#pragma unroll 1
    for (int step = 0; step < step_end; ++step) {
        const bool sonly = part == 1 && step < GLA_SPLIT;
        const int chunk = DIR == 0 ? step : (step < 4 ? 3 - step : 39 - step);
        const size_t Rc0 = (size_t)b * LT + (size_t)chunk * 64;
        unsigned zc[8], qc[8]; u32x4 vc[2];
#pragma unroll
        for (int s = 0; s < 8; ++s) { zc[s] = zn[s]; qc[s] = qn[s]; }
        vc[0] = vn[0]; vc[1] = vn[1];
        TP_START(21, lds, tid);
        float el[8][2], kk[8][2], qq[8][2];
        {
            float run0 = 1.f, run1 = 1.f;
#pragma unroll
            for (int s = 0; s < 8; ++s) {
                const float z0 = __uint_as_float(zc[s] << 16), z1 = __uint_as_float(zc[s] & 0xffff0000u);
                const float t0 = __expf(-z0), t1 = __expf(-z1), sg0 = __builtin_amdgcn_rcpf(1.f + t0), sg1 = __builtin_amdgcn_rcpf(1.f + t1);
                const float f0 = fmaxf(lbv[0] + (1.f - lbv[0]) * sg0, 1e-30f), f1 = fmaxf(lbv[1] + (1.f - lbv[1]) * sg1, 1e-30f);
                kk[s][0] = (1.f - lbv[0]) * (t0 * sg0); kk[s][1] = (1.f - lbv[1]) * (t1 * sg1);
                run0 = fmaxf(run0 * f0, 1e-35f); run1 = fmaxf(run1 * f1, 1e-35f); el[s][0] = run0; el[s][1] = run1;
                if (!sonly) {
                const float q0 = __uint_as_float(qc[s] << 16), q1 = __uint_as_float(qc[s] & 0xffff0000u);
                qq[s][0] = q0 * __builtin_amdgcn_rcpf(1.f + __expf(-q0)); qq[s][1] = q1 * __builtin_amdgcn_rcpf(1.f + __expf(-q1));
                } else { qq[s][0] = 0.f; qq[s][1] = 0.f; }
                if ((s & 1) == 1) __builtin_amdgcn_sched_barrier(0);
            }
            *(LAS f32x2*)(PS8 + tg * 128 + d0) = (f32x2){run0, run1};
#pragma unroll
            for (int rep = 0; rep < 2; ++rep) { const int idx = tid + rep * 512, tau = idx >> 4, chn = idx & 15; *(LAS u32x4*)(VS + tau * 136 + 8 * chn) = vc[rep]; }
        }
        __syncthreads();
        if (part == 1 && step < GLA_SPLIT && tid == 0) __hip_atomic_store(prog, (unsigned)(step + 1), __ATOMIC_RELAXED, __HIP_MEMORY_SCOPE_AGENT);
        TP_STOP(21, lds, tid); TP_START(22, lds, tid);
        float RI[2];
        {
            float T[8][2];
#pragma unroll
            for (int q8 = 0; q8 < 8; ++q8) { const f32x2 t = *(const LAS f32x2*)(PS8 + q8 * 128 + d0); T[q8][0] = t[0]; T[q8][1] = t[1]; }
            float pre[2], fac[4][2], f4[2];
#pragma unroll
            for (int x = 0; x < 2; ++x) {
                const float P0 = T[0][x] * T[1][x], P1 = T[2][x] * T[3][x], P2 = T[4][x] * T[5][x], P3 = T[6][x] * T[7][x];
                pre[x] = half ? (I == 0 ? T[0][x] : (I == 1 ? T[2][x] : (I == 2 ? T[4][x] : T[6][x]))) : 1.f;
                RI[x] = I == 0 ? 1.f : (I == 1 ? P0 : (I == 2 ? P0 * P1 : P0 * P1 * P2));
                float cur = 1.f;
                fac[0][x] = cur; if (I <= 0) cur *= P0;
                fac[1][x] = cur; if (I <= 1) cur *= P1;
                fac[2][x] = cur; if (I <= 2) cur *= P2;
                fac[3][x] = cur; cur *= P3;
                f4[x] = cur;
                if (tg == 0) BLAST[d0 + x] = P0 * P1 * P2 * P3;
            }
            unsigned w0[4], w1[4];
#pragma unroll
            for (int s = 0; s < 8; ++s) {
                const int tau = 8 * tg + s;
                const float e00 = fmaxf(pre[0] * el[s][0], 1e-35f), e01 = fmaxf(pre[1] * el[s][1], 1e-35f);
                const float qi0 = qq[s][0] * e00, qi1 = qq[s][1] * e01;
                const float kd0 = kk[s][0] * __builtin_amdgcn_rcpf(e00), kd1 = kk[s][1] * __builtin_amdgcn_rcpf(e01);
                if (!sonly) {
                *(LAS unsigned*)(QX + tau * 136 + d0) = pk2(qi0, qi1);
                *(LAS unsigned*)(Q1 + tau * 136 + d0) = pk2(qi0 * RI[0], qi1 * RI[1]);
                if (I <= 0) *(LAS unsigned*)(KF + (0 + tau) * 136 + d0) = pk2(kd0 * fac[0][0], kd1 * fac[0][1]);
                if (I <= 1) *(LAS unsigned*)(KF + (16 + tau) * 136 + d0) = pk2(kd0 * fac[1][0], kd1 * fac[1][1]);
                if (I <= 2) *(LAS unsigned*)(KF + (48 + tau) * 136 + d0) = pk2(kd0 * fac[2][0], kd1 * fac[2][1]);
                *(LAS unsigned*)(KF + (96 + tau) * 136 + d0) = pk2(kd0 * fac[3][0], kd1 * fac[3][1]);
                }
                const unsigned h0 = f2bf(kd0 * f4[0]), h1 = f2bf(kd1 * f4[1]);
                if (s & 1) { w0[s >> 1] |= h0 << 16; w1[s >> 1] |= h1 << 16; } else { w0[s >> 1] = h0; w1[s >> 1] = h1; }
                if ((s & 1) == 1) __builtin_amdgcn_sched_barrier(0);
            }
            *(LAS u32x4*)(K2 + (d0 + 0) * 72 + 8 * tg) = (u32x4){w0[0], w0[1], w0[2], w0[3]};
            *(LAS u32x4*)(K2 + (d0 + 1) * 72 + 8 * tg) = (u32x4){w1[0], w1[1], w1[2], w1[3]};
        }
        __syncthreads();
        TP_STOP(22, lds, tid); TP_START(23, lds, tid);
        if (step + 1 < step_end) {
            const int nchunk = DIR == 0 ? step + 1 : (step + 1 < 4 ? 2 - step : 38 - step);
            const char* slab = (const char*)(p + ((size_t)b * LT + (size_t)nchunk * 64) * ODD_IN);
#pragma unroll
            for (int s = 0; s < 8; ++s) { zn[s] = *(const unsigned*)(slab + colz * 2 + G2_OFFZ(s)); qn[s] = *(const unsigned*)(slab + colq * 2 + G2_OFFZ(s)); }
#pragma unroll
            for (int rep = 0; rep < 2; ++rep) vn[rep] = *(const u32x4*)(slab + colv * 2 + G2_OFFV(rep));
        }
#pragma unroll 1
        for (int bi = sonly ? 10 : wave; bi < 10; bi += 8) {
            const int Ib = bi < 1 ? 0 : (bi < 3 ? 1 : (bi < 6 ? 2 : 3)), Jb = bi - (Ib * (Ib + 1)) / 2;
            const int foff = Ib == 0 ? 0 : (Ib == 1 ? 16 : (Ib == 2 ? 48 : 96));
            f32x4 acc = {0.f, 0.f, 0.f, 0.f};
#pragma unroll
            for (int ks = 0; ks < 4; ++ks) {
                const bf16x8 a = *(const LAS bf16x8*)(QX + (16 * Ib + r) * 136 + 32 * ks + 8 * g);
                const bf16x8 bb = *(const LAS bf16x8*)(KF + (foff + 16 * Jb + r) * 136 + 32 * ks + 8 * g);
                acc = MFMA16(a, bb, acc);
            }
#pragma unroll
            for (int i = 0; i < 4; ++i) { float v = acc[i]; if (Jb == Ib && r > 4 * g + i) v = 0.f; AM[(16 * Ib + 4 * g + i) * 72 + 16 * Jb + r] = (bf16_t)f2bf(v); }
        }
        if (!sonly) __syncthreads();
        TP_STOP(23, lds, tid); TP_START(24, lds, tid);
        {
            if (!sonly) {
            const int tt = wave >> 1, eb = 4 * (wave & 1);
            bf16x8 aq[4], am[2];
#pragma unroll
            for (int ks = 0; ks < 4; ++ks) aq[ks] = *(const LAS bf16x8*)(Q1 + (16 * tt + r) * 136 + 32 * ks + 8 * g);
#pragma unroll
            for (int ks = 0; ks < 2; ++ks) am[ks] = *(const LAS bf16x8*)(AM + (16 * tt + r) * 72 + 32 * ks + 8 * g);
#pragma unroll
            for (int e4 = 0; e4 < 4; ++e4) {
                const int et = eb + e4;
                f32x4 acc = {0.f, 0.f, 0.f, 0.f};
#pragma unroll
                for (int ks = 0; ks < 4; ++ks) { const bf16x8 bb = *(const LAS bf16x8*)(ST + (16 * et + r) * 136 + 32 * ks + 8 * g); acc = MFMA16(aq[ks], bb, acc); }
#pragma unroll
                for (int ks = 0; ks < 2; ++ks) acc = MFMA16(am[ks], frag_tr(VS, 136, 32 * ks, 16 * et, lane), acc);
#pragma unroll
                for (int i = 0; i < 4; ++i) KF[(16 * tt + 4 * g + i) * 136 + 16 * et + r] = (bf16_t)f2bf(acc[i]);
                __builtin_amdgcn_sched_barrier(0);
            }
            }
            float bl[4];
#pragma unroll
            for (int i = 0; i < 4; ++i) bl[i] = BLAST[16 * wave + 4 * g + i];
            bf16x8 ak[2];
#pragma unroll
            for (int ks = 0; ks < 2; ++ks) ak[ks] = *(const LAS bf16x8*)(K2 + (16 * wave + r) * 72 + 32 * ks + 8 * g);
#pragma unroll
            for (int et = 0; et < 8; ++et) {
#pragma unroll
                for (int i = 0; i < 4; ++i) st[et][i] *= bl[i];
#pragma unroll
                for (int ks = 0; ks < 2; ++ks) st[et] = MFMA16(ak[ks], frag_tr(VS, 136, 32 * ks, 16 * et, lane), st[et]);
                if (et & 1) __builtin_amdgcn_sched_barrier(0);
            }
        }
        if (part == 0 && tid == 0) { unsigned spins = 0; while (__hip_atomic_load(prog, __ATOMIC_RELAXED, __HIP_MEMORY_SCOPE_AGENT) < (unsigned)(step + 1)) { __builtin_amdgcn_s_sleep(2); if (++spins > (1u << 22)) break; } }
        __syncthreads();
        TP_STOP(24, lds, tid); TP_START(25, lds, tid);
        if (!sonly) {
            char* oslab = (char*)(p + Rc0 * ODD_IN + colz);
#pragma unroll
            for (int rep = 0; rep < 2; ++rep) {
                const int idx = tid + rep * 512, tau = idx >> 4, chn = idx & 15;
                const u32x4 ov = *(const LAS u32x4*)(KF + tau * 136 + 8 * chn);
                *(u32x4*)(oslab + (unsigned)((DIR == 0 ? tau : 63 - tau) * ODD_IN + 8 * chn) * 2u) = ov;
            }
        }
        if (!sonly || step == GLA_SPLIT - 1) {
#pragma unroll
        for (int et = 0; et < 8; ++et) { u32x2 w; w.x = pk2(st[et][0], st[et][1]); w.y = pk2(st[et][2], st[et][3]); *(LAS u32x2*)(ST + (16 * et + r) * 136 + 16 * wave + 4 * g) = w; }
        }
        TP_STOP(25, lds, tid);
    }
    __syncthreads();
    TP_STOP(20, lds, tid);
}

DI void phase_readout(const Params& P, int layer_j, int wv) {
    const int tid = get_tid(wv), lane = tid & 63, wave = tid >> 6;
    const int gw = get_bid() * 8 + wave, NGW = gridDim.x * 8;
    bf16_t* p = (bf16_t*)(P.ws + WS_P);
    const float* gwt = P.od_gnorm_w + layer_j * 128 + (lane & 7) * 16;
    for (int R = gw; R < MROWS; R += NGW) {
        const bf16_t* op = p + (size_t)R * ODD_IN + 16 * lane; bf16_t* yp = p + (size_t)R * ODD_IN + 4096 + 16 * lane;
        const u32x4 o0 = *(const u32x4*)op, o1 = *(const u32x4*)(op + 8), c0 = *(const u32x4*)(op + 1024), c1 = *(const u32x4*)(op + 1032), g0 = *(const u32x4*)yp, g1 = *(const u32x4*)(yp + 8);
        float ov[16], gv[16];
        const unsigned* ow0 = (const unsigned*)&o0; const unsigned* ow1 = (const unsigned*)&o1; const unsigned* cw0 = (const unsigned*)&c0; const unsigned* cw1 = (const unsigned*)&c1;
        const unsigned* gw0 = (const unsigned*)&g0; const unsigned* gw1 = (const unsigned*)&g1;
#pragma unroll
        for (int i = 0; i < 4; ++i) {
            ov[2 * i] = __uint_as_float(ow0[i] << 16) + __uint_as_float(cw0[i] << 16); ov[2 * i + 1] = __uint_as_float(ow0[i] & 0xffff0000u) + __uint_as_float(cw0[i] & 0xffff0000u);
            ov[8 + 2 * i] = __uint_as_float(ow1[i] << 16) + __uint_as_float(cw1[i] << 16); ov[8 + 2 * i + 1] = __uint_as_float(ow1[i] & 0xffff0000u) + __uint_as_float(cw1[i] & 0xffff0000u);
            gv[2 * i] = __uint_as_float(gw0[i] << 16); gv[2 * i + 1] = __uint_as_float(gw0[i] & 0xffff0000u); gv[8 + 2 * i] = __uint_as_float(gw1[i] << 16); gv[8 + 2 * i + 1] = __uint_as_float(gw1[i] & 0xffff0000u);
        }
        float ss = 0.f;
#pragma unroll
        for (int i = 0; i < 16; ++i) ss += ov[i] * ov[i];
        ss += shfl_xor_f(ss, 1); ss += shfl_xor_f(ss, 2); ss += shfl_xor_f(ss, 4);
        const float rstd = rsqrtf(ss * (1.f / 128.f) + RMS_EPS);
        float y[16];
#pragma unroll
        for (int i = 0; i < 16; ++i) y[i] = ov[i] * rstd * gwt[i] * (gv[i] * sigm(gv[i]));
        u32x4 w0, w1;
        w0.x = pk2(y[0], y[1]); w0.y = pk2(y[2], y[3]); w0.z = pk2(y[4], y[5]); w0.w = pk2(y[6], y[7]);
        w1.x = pk2(y[8], y[9]); w1.y = pk2(y[10], y[11]); w1.z = pk2(y[12], y[13]); w1.w = pk2(y[14], y[15]);
        *(u32x4*)yp = w0; *(u32x4*)(yp + 8) = w1;
    }
}

DI void phase_final(const Params& P, int wv) {
    const int tid = get_tid(wv), lane = tid & 63, wave = tid >> 6;
    const int gw = get_bid() * 8 + wave, NGW = gridDim.x * 8;
    for (int R = gw; R < NB * SEQ; R += NGW) {
        float* row = P.out + (size_t)R * DM;
        f32x4 v[4]; float ss = 0.f;
#pragma unroll
        for (int q = 0; q < 4; ++q) { v[q] = *(const f32x4*)(row + 4 * lane + 256 * q); ss += (v[q][0] * v[q][0] + v[q][1] * v[q][1]) + (v[q][2] * v[q][2] + v[q][3] * v[q][3]); }
        const float rstd = rsqrtf(wave_sum(ss) * (1.f / DM) + RMS_EPS);
#pragma unroll
        for (int q = 0; q < 4; ++q) { const f32x4 w4 = *(const f32x4*)(P.final_norm_w + 4 * lane + 256 * q); *(f32x4*)(row + 4 * lane + 256 * q) = (v[q] * rstd) * w4; }
    }
}

#define XB_TMO      128
#define XB_XCNT(j)  (256  + 64 * (j))
#define XB_XSUB(j)  (1280 + 64 * (j))
#define XB_XGEN(j)  (2304 + 64 * (j))
#define XB_TOP      3328
#define XB_TOPGEN   3392
#define XCD_BAR_WORDS 3456
#define XB_SPIN_CAP (1u << 18)

__device__ __forceinline__ unsigned xb_ld(unsigned* p)              { return __hip_atomic_load(p, __ATOMIC_RELAXED, __HIP_MEMORY_SCOPE_AGENT); }
__device__ __forceinline__ unsigned xb_add(unsigned* p, unsigned v) { return __hip_atomic_fetch_add(p, v, __ATOMIC_RELAXED, __HIP_MEMORY_SCOPE_AGENT); }
__device__ __forceinline__ unsigned xb_xcc_id() { return (unsigned)__builtin_amdgcn_s_getreg((3 << 11) | 20) & 0xFu; }
#define XB_SPIN(cond, bar) do { unsigned _sp = 0; while (cond) { __builtin_amdgcn_s_sleep(1); \
    if ((++_sp & 255u) == 0u) { if (xb_ld(&(bar)[XB_TMO])) break; if (_sp > XB_SPIN_CAP) { atomicAdd(&(bar)[XB_TMO], 1u); break; } } } } while (0)

struct XcdBarrier {
    unsigned* bar; unsigned x;
    volatile LAS unsigned* st;
};

__device__ __forceinline__ XcdBarrier xcd_barrier_post(unsigned* bar, volatile LAS unsigned* st, int wv) {
    XcdBarrier b; b.bar = bar; b.x = xb_xcc_id(); b.st = st;
    if (get_tid(wv) == 0) (void)xb_add(&bar[XB_XCNT(b.x)], 1u);
    return b;
}
__device__ __forceinline__ void xcd_barrier_complete(unsigned* bar, unsigned x, unsigned& nloc, unsigned& nx) {
    const unsigned G = gridDim.x * gridDim.y * gridDim.z;
    unsigned sum, cnt, mine, sp = 0u;
    for (;;) {
        sum = 0u; cnt = 0u; mine = 0u;
#pragma unroll
        for (unsigned j = 0; j < 16; ++j) { const unsigned c = xb_ld(&bar[XB_XCNT(j)]); sum += c; cnt += (c > 0u) ? 1u : 0u; mine = (j == x) ? c : mine; }
        if (sum == G) break;
        __builtin_amdgcn_s_sleep(1);
        if ((++sp & 255u) == 0u) { if (xb_ld(&bar[XB_TMO])) break; if (sp > XB_SPIN_CAP) { atomicAdd(&bar[XB_TMO], 1u); break; } }
    }
    nloc = mine > 0u ? mine : 1u; nx = cnt > 0u ? cnt : 1u;
}

__device__ __forceinline__ void xcd_barrier(const XcdBarrier& b, int wv) {
    asm volatile("s_waitcnt vmcnt(0)" ::: "memory");
    __syncthreads();
    if (get_tid(wv) == 0) {
        unsigned* bar = b.bar;
        __builtin_amdgcn_s_waitcnt(0);
        unsigned nloc = b.st[0], nx = b.st[1];
        if (nloc == 0u) { xcd_barrier_complete(bar, b.x, nloc, nx); b.st[0] = nloc; b.st[1] = nx; }
        const unsigned old = xb_add(&bar[XB_XSUB(b.x)], 1u);
        const unsigned gen = old / nloc;
        if (old + 1u == (gen + 1u) * nloc) {
            __builtin_amdgcn_fence(__ATOMIC_RELEASE, "agent");
            asm volatile("s_waitcnt vmcnt(0)" ::: "memory");
            const unsigned og = xb_add(&bar[XB_TOP], 1u);
            const unsigned tg = og / nx;
            if (og + 1u == (tg + 1u) * nx) xb_add(&bar[XB_TOPGEN], 1u);
            else XB_SPIN(xb_ld(&bar[XB_TOPGEN]) == tg, bar);
            __builtin_amdgcn_fence(__ATOMIC_ACQUIRE, "agent");
            xb_add(&bar[XB_XGEN(b.x)], 1u);
            asm volatile("s_waitcnt vmcnt(0)" ::: "memory");
        } else {
            XB_SPIN(xb_ld(&bar[XB_XGEN(b.x)]) == gen, bar);
            __builtin_amdgcn_fence(__ATOMIC_ACQUIRE, "agent");
            asm volatile("s_waitcnt vmcnt(0)" ::: "memory");
        }
    }
    __syncthreads();
}

constexpr int PARAM_OFF = LDS_BYTES - 256;
static_assert(G2_END <= PARAM_OFF && sizeof(Params) <= 208, "LDS map");
DI const float* ld_uptr(const LAS unsigned long long* s, int i) {
    const unsigned long long v = s[i];
    const unsigned lo = __builtin_amdgcn_readfirstlane((unsigned)v), hi = __builtin_amdgcn_readfirstlane((unsigned)(v >> 32));
    return (const float*)(const __attribute__((address_space(1))) float*)(((unsigned long long)hi << 32) | lo);
}
DI Params load_params(LAS unsigned char* lds) {
    LAS unsigned char* pb = lds + PARAM_OFF; asm volatile("" : "+v"(pb));
    const LAS unsigned long long* s = (const LAS unsigned long long*)pb;
    Params Q;
    Q.x = ld_uptr(s, 0); Q.c = ld_uptr(s, 1); Q.ctx = ld_uptr(s, 2); Q.c_ctx = ld_uptr(s, 3); Q.ada_w = ld_uptr(s, 4); Q.ada_b = ld_uptr(s, 5); Q.norm_w = ld_uptr(s, 6);
    Q.ev_w_in = ld_uptr(s, 7); Q.ev_conv_w = ld_uptr(s, 8); Q.ev_conv_b = ld_uptr(s, 9); Q.ev_rg_wx = ld_uptr(s, 10); Q.ev_rg_bx = ld_uptr(s, 11); Q.ev_rg_wa = ld_uptr(s, 12);
    Q.ev_rg_ba = ld_uptr(s, 13); Q.ev_rg_lambda = ld_uptr(s, 14); Q.ev_sink = ld_uptr(s, 15); Q.ev_w_out = ld_uptr(s, 16); Q.od_w_in = ld_uptr(s, 17); Q.od_lb_raw = ld_uptr(s, 18);
    Q.od_gnorm_w = ld_uptr(s, 19); Q.od_w_out = ld_uptr(s, 20); Q.final_norm_w = ld_uptr(s, 21); Q.out = (float*)ld_uptr(s, 22); Q.ws = (unsigned char*)ld_uptr(s, 23);
    Q.ph_lo = 0; Q.ph_hi = 0;
    return Q;
}
DI void run_phase(LAS unsigned char* lds, int ph, int wv) {
    #ifndef PHMASK
#define PHMASK 0xffff
#endif
    if (ph == 0) { if (PHMASK & 1) { const Params P = load_params(lds); phase_pro(P, lds, wv); __syncthreads(); phase_convert(P, lds, 0, wv); } return; }
    const int layer = (ph - 1) / 5, sub = (ph - 1) % 5, j = layer >> 1;
    const bool even = (layer & 1) == 0;
    if (sub == 0) { if (PHMASK & 4) { const Params P = load_params(lds); phase_norm(P, lds, layer, wv); } return; }
    if (sub == 1) {
        const Params P = load_params(lds); bf16_t* pbuf = (bf16_t*)(P.ws + WS_P);
        const int N = even ? EVEN_IN : ODD_IN;
        pg8::Gemm gm{(const bf16_t*)(P.ws + WS_OV), (const bf16_t*)(P.ws + WS_WIN), MROWS, N, 1024, 1024};
        pg8::StaticOrder S; S.init(MROWS, N, (int)gridDim.x, get_bid());
        EpiStoreBf16 E{pbuf, N};
        if (even) S.limit = 1280;
        if (PHMASK & 8) pg8::gemm_phase<EpiStoreBf16, pg8::StaticOrder, true, true>(lds, gm, S, E, wv);
        if (even) {
            for (int t = get_bid(); t < 128; t += gridDim.x) {
                pg8::Unit u; S.tile_of(1280 + (t >> 3), u);
                const int m0 = 256 * u.pm + 64 * ((t & 7) >> 1), n0 = 256 * u.pn + 128 * (t & 1);
                auto epi = [&](const f32x16& acc, int row0, int col, int hh) {
#pragma unroll
                    for (int i = 0; i < 16; ++i) pbuf[(size_t)(m0 + row0 + crow(i, hh)) * N + n0 + col] = (bf16_t)f2bf(acc[i]);
                };
                mini_gemm_tile(lds, (const bf16_t*)(P.ws + WS_OV) + (size_t)m0 * 1024, 1024, (const bf16_t*)(P.ws + WS_WIN) + (size_t)n0 * 1024, 1024, epi, wv);
            }
        }
        return;
    }
    if (sub == 2) {
        const Params P = load_params(lds);
        if (even) {
            constexpr int NRG = NB * NCHUNK * 8;
#if defined(SPLIT_ATTN)
            for (int it = get_bid(); it < NRG; it += gridDim.x) rglru_item(P, lds, j, it, wv);
#else
            {
                int it = get_bid(), k = 0;
                if (it < NRG) rglru_item(P, lds, j, it, 0, 0, wv);
                for (; it < NRG; it += gridDim.x, ++k) {
                    if (it + (int)gridDim.x < NRG) rglru_item(P, lds, j, it + (int)gridDim.x, 0, (k + 1) & 1, wv);
                    rglru_item(P, lds, j, it, 1, k & 1, wv);
                }
                for (it -= NRG; it < 576; it += gridDim.x) attn_item(P, lds, j, it, wv);
            }
#endif
        } else {
            for (int it = get_bid(); it < 256; it += gridDim.x) { if (PHMASK & 64) { if (it & 2) gla2_item<1>(P, lds, j, it >> 5, (it >> 2) & 7, it & 1, wv); else gla2_item<0>(P, lds, j, it >> 5, (it >> 2) & 7, it & 1, wv); } }
        }
        return;
    }
    if (sub == 3) {
        const Params P = load_params(lds);
        if (!even) { if (PHMASK & 256) phase_readout(P, j, wv); }
#if defined(SPLIT_ATTN)
        else { for (int it = get_bid(); it < 576; it += gridDim.x) attn_item(P, lds, j, it, wv); }
#endif
        return;
    }
    {
        const Params P = load_params(lds); bf16_t* pbuf = (bf16_t*)(P.ws + WS_P);
        const int K = even ? 2048 : 1024, lda = even ? EVEN_IN : ODD_IN;
        pg8::Gemm gm{pbuf + (even ? 1536 : 4096), (const bf16_t*)(P.ws + WS_WOUT), MROWS, 1024, K, lda};
        pg8::StaticOrder S; S.init(NB * SEQ, 1024, (int)gridDim.x, get_bid(), 1);
        const float* hl = layer == 0 ? P.x : P.out; const float* hc = layer == 0 ? P.ctx : (const float*)(P.ws + WS_HCTX);
        const float* modb = (const float*)(P.ws + WS_MOD);
        EpiResidNorm E{hl, P.out, modb + (size_t)layer * 9 * 3072 + 2048, layer < 3 ? P.norm_w + (layer + 1) * 1024 : P.final_norm_w,
                       layer < 3 ? modb + (size_t)(layer + 1) * 9 * 3072 : nullptr, (bf16_t*)(P.ws + WS_OV), (float*)(P.ws + WS_AGG), (unsigned*)(P.ws + WS_CTL) + 12288 + layer * 1024};
        TP_START(30, lds, get_tid(wv));
        if (PHMASK & 512) pg8::gemm_phase<EpiResidNorm, pg8::StaticOrder, false, true>(lds, gm, S, E, wv);
        TP_STOP(30, lds, get_tid(wv)); TP_START(31, lds, get_tid(wv));
        if (layer < 3) {
            for (int t = get_bid(); t < 256; t += gridDim.x) {
                const int mt = t >> 3, nt = t & 7, mc0 = 64 * mt, bctx = mc0 >> 8, n0 = 128 * nt;
                const bf16_t* At = pbuf + ((size_t)bctx * LT + (mc0 & 255)) * lda + (even ? 1536 : 4096);
                const float* gctx = (const float*)(P.ws + WS_MOD) + (size_t)layer * 9 * 3072 + 2048 + 8 * 3072;
                float* hco = (float*)(P.ws + WS_HCTX);
                auto epi = [&](const f32x16& acc, int row0, int col, int hh) {
                    const float gate = gctx[n0 + col];
#pragma unroll
                    for (int i = 0; i < 16; ++i) { const size_t off = (size_t)(mc0 + row0 + crow(i, hh)) * DM + n0 + col; hco[off] = hc[off] + gate * acc[i]; }
                };
                mini_gemm_tile(lds, At, lda, (const bf16_t*)(P.ws + WS_WOUT) + (size_t)n0 * K, K, epi, wv);
            }
        }
        TP_STOP(31, lds, get_tid(wv));
    }
}

__global__ void __launch_bounds__(512, 2) mega(Params P) {
    extern __shared__ __attribute__((aligned(16))) unsigned char lds_raw[];
    LAS unsigned char* lds = (LAS unsigned char*)lds_raw;
    cg::grid_group grid = cg::this_grid();
    const int wv = __builtin_amdgcn_readfirstlane((int)(threadIdx.x >> 6));
    if (get_tid(wv) == 0) {
#if defined(TP_ID)
        ((LAS unsigned long long*)(lds + 163840 - 32))[0] = 0ull; ((LAS unsigned long long*)(lds + 163840 - 32))[1] = 0ull;
#endif
        ((LAS unsigned*)(lds + PARAM_OFF + 208))[0] = 0u; ((LAS unsigned*)(lds + PARAM_OFF + 208))[1] = 0u;
        LAS unsigned long long* d = (LAS unsigned long long*)(lds + PARAM_OFF);
        d[0] = (unsigned long long)P.x; d[1] = (unsigned long long)P.c; d[2] = (unsigned long long)P.ctx; d[3] = (unsigned long long)P.c_ctx; d[4] = (unsigned long long)P.ada_w;
        d[5] = (unsigned long long)P.ada_b; d[6] = (unsigned long long)P.norm_w; d[7] = (unsigned long long)P.ev_w_in; d[8] = (unsigned long long)P.ev_conv_w; d[9] = (unsigned long long)P.ev_conv_b;
        d[10] = (unsigned long long)P.ev_rg_wx; d[11] = (unsigned long long)P.ev_rg_bx; d[12] = (unsigned long long)P.ev_rg_wa; d[13] = (unsigned long long)P.ev_rg_ba; d[14] = (unsigned long long)P.ev_rg_lambda;
        d[15] = (unsigned long long)P.ev_sink; d[16] = (unsigned long long)P.ev_w_out; d[17] = (unsigned long long)P.od_w_in; d[18] = (unsigned long long)P.od_lb_raw; d[19] = (unsigned long long)P.od_gnorm_w;
        d[20] = (unsigned long long)P.od_w_out; d[21] = (unsigned long long)P.final_norm_w; d[22] = (unsigned long long)P.out; d[23] = (unsigned long long)P.ws;
    }
    __syncthreads();
    const int ph_lo = P.ph_lo, ph_hi = P.ph_hi;
    (void)xcd_barrier_post((unsigned*)(P.ws + WS_CTL) + 4096, (volatile LAS unsigned*)(lds + PARAM_OFF + 208), wv);
#define GRID_SYNC(first) do { if (first) grid.sync(); else { XcdBarrier xb_; xb_.bar = (unsigned*)(load_params(lds).ws + WS_CTL) + 4096; xb_.x = xb_xcc_id(); xb_.st = (volatile LAS unsigned*)(lds + PARAM_OFF + 208); xcd_barrier(xb_, wv); } } while (0)
#if defined(PROBE_S)
    constexpr int PREP = PROBE_E - PROBE_S + 1;
#pragma unroll 1
    for (int seq = ph_lo; seq < ph_hi + PREP; ++seq) {
        if (seq > ph_lo) GRID_SYNC(seq == ph_lo + 1);
        const int ph = seq <= PROBE_E ? seq : seq - PREP;
        run_phase(lds, ph, wv);
    }
#else
#pragma unroll 1
    for (int ph = ph_lo; ph < ph_hi; ++ph) {
#if !defined(SPLIT_ATTN)
        if (ph >= 1 && ph < NPHASE - 1 && (ph - 1) % 5 == 3 && (((ph - 1) / 5) & 1) == 0) continue;
#endif
        TP_START(200, lds, get_tid(wv));
        if (ph > ph_lo) GRID_SYNC(ph == ph_lo + 1);
        TP_STOP(200, lds, get_tid(wv));
#if defined(TP_ID)
        const int kid_ = ph == 0 ? 207 : ((ph - 1) % 5 == 0 ? 205 : ((ph - 1) % 5 == 1 ? 201 : ((ph - 1) % 5 == 2 ? ((((ph - 1) / 5) & 1) ? 203 : 202) : ((ph - 1) % 5 == 3 ? 206 : 204))));
        if (kid_ == TP_ID) TP_START(TP_ID, lds, get_tid(wv));
#endif
        run_phase(lds, ph, wv);
#if defined(TP_ID)
        if (kid_ == TP_ID) TP_STOP(TP_ID, lds, get_tid(wv));
#endif
    }
#endif
#if defined(TP_ID)
    if (get_tid(wv) == 0 && blockIdx.x == TP_BLOCK) {
        const unsigned long long acc = ((LAS unsigned long long*)(lds + 163840 - 32))[1], t0 = __builtin_amdgcn_s_memrealtime();
        while (__builtin_amdgcn_s_memrealtime() - t0 < (unsigned long long)TP_AMP * acc) __builtin_amdgcn_s_sleep(8);
    }
#endif
}

extern "C" void kernel_launch(void* const* d_in, const int* in_sizes, int n_in, void* d_out, int out_size, void* d_ws, size_t ws_size, hipStream_t stream) {
    static int grid = 0;
    if (grid == 0) {
        if (n_in != 22 || ws_size < WS_END) { fprintf(stderr, "kernel_launch: unexpected inputs (n_in %d, ws %zu)\n", n_in, ws_size); grid = -1; return; }
        int dev = 0, cus = 0, per_cu = 0;
        hipGetDevice(&dev);
        hipDeviceGetAttribute(&cus, hipDeviceAttributeMultiprocessorCount, dev);
        if (hipFuncSetAttribute((const void*)mega, hipFuncAttributeMaxDynamicSharedMemorySize, LDS_BYTES) != hipSuccess) { fprintf(stderr, "kernel_launch: hipFuncSetAttribute failed\n"); grid = -1; return; }
        if (hipOccupancyMaxActiveBlocksPerMultiprocessor(&per_cu, (const void*)mega, 512, LDS_BYTES) != hipSuccess || per_cu < 1) { fprintf(stderr, "kernel_launch: occupancy query gives %d\n", per_cu); per_cu = 1; }
        (void)hipGetLastError();
        if (cus < 256) { fprintf(stderr, "kernel_launch: this kernel needs 256 co-resident workgroups (device reports %d CUs)\n", cus); grid = -1; return; }
        grid = 256;
    }
    if (grid < 0) return;
    if (hipMemsetAsync((char*)d_ws + WS_CTL, 0, 65536, stream) != hipSuccess) { fprintf(stderr, "kernel_launch: memset failed\n"); return; }
    Params P{};
    const float** pp = (const float**)&P;
    for (int i = 0; i < 22; ++i) pp[i] = (const float*)d_in[i];
    P.out = (float*)d_out; P.ws = (unsigned char*)d_ws;
#if ONE_LAUNCH
    P.ph_lo = 0; P.ph_hi = NPHASE;
    { void* args[] = {&P}; hipError_t e = hipLaunchCooperativeKernel((const void*)mega, dim3(grid), dim3(512), args, LDS_BYTES, stream);
      if (e != hipSuccess) fprintf(stderr, "cooperative launch failed: %s (grid %d)\n", hipGetErrorString(e), grid); }
#else
    for (int ph = 0; ph < NPHASE; ++ph) {
        P.ph_lo = ph; P.ph_hi = ph + 1;
        void* args[] = {&P}; hipError_t e = hipLaunchCooperativeKernel((const void*)mega, dim3(grid), dim3(512), args, LDS_BYTES, stream);
        if (e != hipSuccess) { fprintf(stderr, "launch %d failed: %s (grid %d)\n", ph, hipGetErrorString(e), grid); break; }
    }
#endif
}
```

```cpp
#include <hip/hip_runtime.h>
#include <hip/hip_cooperative_groups.h>
#include <cstdio>
#include <cstdint>
namespace cg = cooperative_groups;

#ifndef ONE_LAUNCH
#define ONE_LAUNCH 1
#endif

#define DI __device__ __forceinline__
#define LAS __attribute__((address_space(3)))
__device__ __forceinline__ int lane_nh() { int l; asm volatile("v_mbcnt_lo_u32_b32 %0, -1, 0\n\tv_mbcnt_hi_u32_b32 %0, -1, %0" : "=v"(l)); return l; }
__device__ __forceinline__ int get_tid(int wv) { asm volatile("" : "+s"(wv)); return wv * 64 + lane_nh(); }
__device__ __forceinline__ float shfl_xor_f(float v, int o) { return __int_as_float(__builtin_amdgcn_ds_bpermute((lane_nh() ^ o) << 2, __float_as_int(v))); }
__device__ __forceinline__ int get_bid() { int b = blockIdx.x; asm volatile("" : "+s"(b)); return b; }

#if defined(TP_ID)
#ifndef TP_BLOCK
#define TP_BLOCK 5
#endif
#ifndef TP_AMP
#define TP_AMP 16
#endif
#define TP_START(id, lds, tid_) do { if ((id) == TP_ID) { __builtin_amdgcn_sched_barrier(0); if ((tid_) == 0 && blockIdx.x == TP_BLOCK) { ((LAS unsigned long long*)((lds) + 163840 - 32))[0] = __builtin_amdgcn_s_memrealtime(); } __builtin_amdgcn_sched_barrier(0); } } while (0)
#define TP_STOP(id, lds, tid_) do { if ((id) == TP_ID) { __builtin_amdgcn_sched_barrier(0); if ((tid_) == 0 && blockIdx.x == TP_BLOCK) { LAS unsigned long long* w_ = (LAS unsigned long long*)((lds) + 163840 - 32); w_[1] += __builtin_amdgcn_s_memrealtime() - w_[0]; } __builtin_amdgcn_sched_barrier(0); } } while (0)
#else
#define TP_START(id, lds, tid_) do { } while (0)
#define TP_STOP(id, lds, tid_) do { } while (0)
#endif
namespace pg8 {
#define PG8_LAS __attribute__((address_space(3)))
typedef unsigned short bf16_t;
typedef short bf16x8 __attribute__((ext_vector_type(8)));
typedef float f32x4 __attribute__((ext_vector_type(4)));
typedef unsigned u32x4 __attribute__((ext_vector_type(4)));
constexpr int BM = 256, BK = 64, HALF = 128, HTB = HALF * BK * 2  , STAGE_BYTES = 8 * HTB, NXCD = 8, WGM = 8;

__host__ __device__ __forceinline__ int lds_byte(int r, int c) { const int st = (r >> 4) * 2 + (c >> 5), rr = r & 15, cc = c & 31, ob = rr * 64 + cc * 2; return st * 1024 + (ob ^ (((ob >> 9) & 1) << 5)); }
__host__ __device__ __forceinline__ void stage_rc(int b, int& R, int& C) { const int st = b / 1024, sb = b % 1024, swz = sb ^ (((sb >> 9) & 1) << 5); R = (st >> 1) * 16 + swz / 64; C = (st & 1) * 32 + (swz % 64) / 2; }
__host__ __device__ __forceinline__ int perm32(int rho) { const int n = rho >> 4, i = rho & 15; return 8 * (i >> 2) + 4 * n + (i & 3); }

struct Unit { int pm, pn; };
struct Gemm { const bf16_t* A; const bf16_t* Bt; int M, N, K, lda; };

struct StaticOrder {
    int nM, nN, nwg, G, c, lat_only, limit;
    __host__ __device__ void init(int M, int N, int G_, int c_, int lat_only_ = 0) { nM = M / BM; nN = N / BM; nwg = nM * nN; G = G_; c = c_; lat_only = lat_only_; limit = nwg; }
    __host__ __device__ bool next(int i, Unit& u) const {
        const long L = (long)i * G + c; if (L >= limit) return false;
        tile_of((int)L, u); return true;
    }
    __host__ __device__ void tile_of(int L, Unit& u) const {
        int wgid = L; { const int q = nwg / NXCD, r = nwg % NXCD, xcd = wgid % NXCD, off = wgid / NXCD; wgid = (xcd < r ? xcd * (q + 1) : r * (q + 1) + (xcd - r) * q) + off; }
        const int nig = WGM * nN, gid = wgid / nig, fm = gid * WGM, gsz = (nM - fm) < WGM ? (nM - fm) : WGM;
        u.pm = fm + ((wgid % nig) % gsz); u.pn = (wgid % nig) / gsz; if (lat_only) u.pm = 9 * (u.pm >> 3) + 1 + (u.pm & 7);
    }
    __device__ __forceinline__ void a_ready(const Unit&) const {}
    __device__ __forceinline__ void done(const Unit&) const {}
};

template <class Epi, class Sched, bool ALIGN_EPI = false, bool SP2 = false>
__device__ __forceinline__ void gemm_phase(PG8_LAS unsigned char* lds, const Gemm g, const Sched& S, const Epi& E, int wv) {
    const int tid = get_tid(wv), wid = __builtin_amdgcn_readfirstlane(tid >> 6), lane = tid & 63, wr = wid >> 2, wc = wid & 3, fr = lane & 15, fq = lane >> 4;
    const int K = g.K, nt = K / BK;
    unsigned voffA[2], voffB[2];
#pragma unroll
    for (int i = 0; i < 2; ++i) { int R, C; stage_rc(tid * 16 + i * 8192, R, C); const int Rb = Epi::PERM ? ((R & ~31) + perm32(R & 31)) : R;
        voffA[i] = (unsigned)(R * g.lda + C) * 2u; voffB[i] = (unsigned)(Rb * K + C) * 2u; }
    const size_t kstep = (size_t)(BK * 2);
    const size_t hstepA = (size_t)HALF * g.lda * 2, hstepB = (size_t)HALF * K * 2;
    const size_t tstepA = 2 * hstepA, tstepB = 2 * hstepB;
    const unsigned ldsw = (unsigned)wid * 1024u;
    const int aoff = lds_byte(wr * 64 + fr, fq * 8), boff = lds_byte(wc * 32 + fr, fq * 8);
#define PG8_SA(b, h) (((b) * 2 + (h)) * HTB)
#define PG8_SB(b, h) ((4 + (b) * 2 + (h)) * HTB)
#define PG8_STAGE(bufoff, gbase, voff) do { _Pragma("unroll") for (int _i = 0; _i < 2; ++_i) \
        __builtin_amdgcn_global_load_lds((const unsigned*)((const char*)(gbase) + (voff)[_i]), (PG8_LAS unsigned*)(lds + (bufoff) + ldsw + _i * 8192), 16, 0, 0); } while (0)
#define PG8_LDA(dst, b, h) do { _Pragma("unroll") for (int m = 0; m < 4; ++m) _Pragma("unroll") for (int k = 0; k < 2; ++k) dst[m][k] = *(const PG8_LAS bf16x8*)(lds + PG8_SA(b, h) + aoff + m * 2048 + k * 1024); } while (0)
#define PG8_LDB(dst, b, h) do { _Pragma("unroll") for (int n = 0; n < 2; ++n) _Pragma("unroll") for (int k = 0; k < 2; ++k) dst[n][k] = *(const PG8_LAS bf16x8*)(lds + PG8_SB(b, h) + boff + n * 2048 + k * 1024); } while (0)
#define PG8_MMA(ai, bj, At, Bt) do { __builtin_amdgcn_s_setprio(1); _Pragma("unroll") for (int m = 0; m < 4; ++m) _Pragma("unroll") for (int n = 0; n < 2; ++n) _Pragma("unroll") for (int k = 0; k < 2; ++k) \
        acc[ai][bj][m][n] = __builtin_amdgcn_mfma_f32_16x16x32_bf16(Bt[n][k], At[m][k], acc[ai][bj][m][n], 0, 0, 0); __builtin_amdgcn_s_setprio(0); } while (0)
#define PG8_WAIT_V(n) asm volatile("s_waitcnt vmcnt(" #n ")" ::: "memory")
#define PG8_WAIT_L(n) asm volatile("s_waitcnt lgkmcnt(" #n ")" ::: "memory")
#define PG8_BAR __builtin_amdgcn_s_barrier()
#define PG8_SCHED __builtin_amdgcn_sched_barrier(0)
    Unit cur, nxt; int ui = 0;
    if (!S.next(0, cur)) return;
    f32x4 acc[2][2][4][2];
#pragma unroll
    for (int a = 0; a < 2; ++a)
#pragma unroll
        for (int b = 0; b < 2; ++b)
#pragma unroll
            for (int m = 0; m < 4; ++m)
#pragma unroll
                for (int n = 0; n < 2; ++n) acc[a][b][m][n] = (f32x4){0.f, 0.f, 0.f, 0.f};
    bf16x8 At[4][2], B0[2][2], B1[2][2];
    const char* cA = (const char*)g.A + (size_t)cur.pm * tstepA; const char* cB = (const char*)g.Bt + (size_t)cur.pn * tstepB;
    S.a_ready(cur);
    if constexpr (SP2) {
        PG8_STAGE(PG8_SB(0, 0), cB, voffB); PG8_STAGE(PG8_SB(0, 1), cB + hstepB, voffB); PG8_STAGE(PG8_SA(0, 0), cA, voffA); PG8_STAGE(PG8_SA(0, 1), cA + hstepA, voffA);
        if (wr == 1) PG8_BAR;
        PG8_WAIT_V(2); PG8_BAR;
        PG8_STAGE(PG8_SB(1, 0), cB + kstep, voffB); PG8_STAGE(PG8_SA(1, 0), cA + kstep, voffA); PG8_STAGE(PG8_SB(1, 1), cB + hstepB + kstep, voffB);
        PG8_WAIT_V(6); PG8_BAR;
    } else {
        PG8_STAGE(PG8_SB(0, 0), cB, voffB); PG8_STAGE(PG8_SA(0, 0), cA, voffA); PG8_STAGE(PG8_SB(0, 1), cB + hstepB, voffB); PG8_STAGE(PG8_SA(0, 1), cA + hstepA, voffA);
        if (wr == 1) PG8_BAR;
        PG8_WAIT_V(4); PG8_BAR;
        PG8_STAGE(PG8_SB(1, 0), cB + kstep, voffB); PG8_STAGE(PG8_SA(1, 0), cA + kstep, voffA); PG8_STAGE(PG8_SB(1, 1), cB + hstepB + kstep, voffB);
        PG8_WAIT_V(6); PG8_BAR;
    }
    for (;;) {
        const bool has_next = S.next(ui + 1, nxt);
        const char* nA = has_next ? (const char*)g.A + (size_t)nxt.pm * tstepA : cA; const char* nB = has_next ? (const char*)g.Bt + (size_t)nxt.pn * tstepB : cB;
        for (int t = 0; t < nt; t += 2) {
            const bool last = (t == nt - 2);
            const char* a1 = cA + (size_t)(t + 1) * kstep;
            const char* a2 = last ? nA : cA + (size_t)(t + 2) * kstep; const char* b2 = last ? nB : cB + (size_t)(t + 2) * kstep;
            const char* a3 = a2 + kstep; const char* b3 = b2 + kstep;
            if (last && has_next) S.a_ready(nxt);
            if constexpr (SP2) {
            PG8_LDB(B0, 0, 0); PG8_LDB(B1, 0, 1); PG8_SCHED; PG8_LDA(At, 0, 0); PG8_STAGE(PG8_SA(1, 1), a1 + hstepA, voffA);
            PG8_WAIT_V(8); PG8_WAIT_L(0); PG8_BAR; PG8_MMA(0, 0, At, B0); PG8_MMA(0, 1, At, B1); PG8_BAR; PG8_SCHED;
            PG8_LDA(At, 0, 1); PG8_STAGE(PG8_SB(0, 0), b2, voffB); PG8_STAGE(PG8_SB(0, 1), b2 + hstepB, voffB); PG8_STAGE(PG8_SA(0, 0), a2, voffA);
            PG8_WAIT_V(8); PG8_WAIT_L(0); PG8_BAR; PG8_MMA(1, 0, At, B0); PG8_MMA(1, 1, At, B1); PG8_BAR; PG8_SCHED;
            PG8_LDB(B0, 1, 0); PG8_LDB(B1, 1, 1); PG8_SCHED; PG8_LDA(At, 1, 0); PG8_STAGE(PG8_SA(0, 1), a2 + hstepA, voffA);
            PG8_WAIT_V(8); PG8_WAIT_L(0); PG8_BAR; PG8_MMA(0, 0, At, B0); PG8_MMA(0, 1, At, B1); PG8_BAR; PG8_SCHED;
            PG8_LDA(At, 1, 1); PG8_STAGE(PG8_SB(1, 0), b3, voffB); PG8_STAGE(PG8_SB(1, 1), b3 + hstepB, voffB); PG8_STAGE(PG8_SA(1, 0), a3, voffA);
            PG8_WAIT_V(8); PG8_WAIT_L(0); PG8_BAR; PG8_MMA(1, 0, At, B0); PG8_MMA(1, 1, At, B1); PG8_BAR; PG8_SCHED;
            } else {
            PG8_LDB(B0, 0, 0); PG8_SCHED; PG8_LDA(At, 0, 0); PG8_STAGE(PG8_SA(1, 1), a1 + hstepA, voffA);
            PG8_WAIT_L(8); PG8_BAR; PG8_WAIT_L(0); PG8_MMA(0, 0, At, B0); PG8_BAR; PG8_SCHED;
            PG8_LDB(B1, 0, 1); PG8_STAGE(PG8_SB(0, 0), b2, voffB);
            PG8_BAR; PG8_WAIT_L(0); PG8_MMA(0, 1, At, B1); PG8_BAR;
            PG8_LDA(At, 0, 1); PG8_STAGE(PG8_SA(0, 0), a2, voffA);
            PG8_BAR; PG8_WAIT_L(0); PG8_MMA(1, 0, At, B0); PG8_BAR; PG8_SCHED;
            PG8_STAGE(PG8_SB(0, 1), b2 + hstepB, voffB);
            PG8_WAIT_V(6); PG8_BAR; PG8_MMA(1, 1, At, B1); PG8_BAR;
            PG8_LDB(B0, 1, 0); PG8_SCHED; PG8_LDA(At, 1, 0); PG8_STAGE(PG8_SA(0, 1), a2 + hstepA, voffA);
            PG8_WAIT_L(8); PG8_BAR; PG8_WAIT_L(0); PG8_MMA(0, 0, At, B0); PG8_BAR; PG8_SCHED;
            PG8_LDB(B1, 1, 1); PG8_STAGE(PG8_SB(1, 0), b3, voffB);
            PG8_BAR; PG8_WAIT_L(0); PG8_MMA(0, 1, At, B1); PG8_BAR;
            PG8_LDA(At, 1, 1); PG8_STAGE(PG8_SA(1, 0), a3, voffA);
            PG8_BAR; PG8_WAIT_L(0); PG8_MMA(1, 0, At, B0); PG8_BAR; PG8_SCHED;
            PG8_STAGE(PG8_SB(1, 1), b3 + hstepB, voffB);
            PG8_WAIT_V(6); PG8_BAR; PG8_MMA(1, 1, At, B1); PG8_BAR;
            }
        }
        if constexpr (ALIGN_EPI) { if (wr == 0) PG8_BAR; }
        if constexpr (!Epi::AFTER_DRAIN) { E(acc, cur, wr, wc, fr, fq); S.done(cur); }
        if (!has_next) break;
#pragma unroll
        for (int a = 0; a < 2; ++a)
#pragma unroll
            for (int b = 0; b < 2; ++b)
#pragma unroll
                for (int m = 0; m < 4; ++m)
#pragma unroll
                    for (int n = 0; n < 2; ++n) acc[a][b][m][n] = (f32x4){0.f, 0.f, 0.f, 0.f};
        cur = nxt; cA = nA; cB = nB; ++ui;
        if constexpr (ALIGN_EPI) { if (wr == 1) PG8_BAR; }
    }
    PG8_WAIT_V(0);
    if constexpr (!ALIGN_EPI) { if (wr == 0) PG8_BAR; }
    PG8_BAR;
    if constexpr (Epi::AFTER_DRAIN) { E.fused(acc, cur, wr, wc, fr, fq, lds, wid, lane); S.done(cur); }
#undef PG8_SA
#undef PG8_SB
#undef PG8_STAGE
#undef PG8_LDA
#undef PG8_LDB
#undef PG8_MMA
#undef PG8_WAIT_V
#undef PG8_WAIT_L
#undef PG8_BAR
#undef PG8_SCHED
}
}

typedef unsigned short bf16_t;
typedef short bf16x8 __attribute__((ext_vector_type(8)));
typedef short s16x4 __attribute__((ext_vector_type(4)));
typedef float f32x4 __attribute__((ext_vector_type(4)));
typedef float f32x16 __attribute__((ext_vector_type(16)));
typedef unsigned u32x4 __attribute__((ext_vector_type(4)));
typedef unsigned u32x2 __attribute__((ext_vector_type(2)));
typedef float f32x2 __attribute__((ext_vector_type(2)));

constexpr int DM = 1024, NB = 8, SEQ = 2048, CTXL = 256, LT = SEQ + CTXL  , MROWS = NB * LT  ;
constexpr int EVEN_IN = 4608, ODD_IN = 5120, NCHUNK = LT / 64  ;
constexpr float RMS_EPS = 1e-6f, LOG2E = 1.4426950408889634f;
constexpr int LDS_BYTES = 160 * 1024;
constexpr int NPHASE = 21;

constexpr size_t WS_CTL = 0;
constexpr size_t WS_MOD = 65536;
constexpr size_t WS_ROPE = 524288;
constexpr size_t WS_AGG = 1048576;
constexpr size_t WS_HCTX = WS_AGG + 4718592;
constexpr size_t WS_WIN = WS_HCTX + 8388608;
constexpr size_t WS_WOUT = WS_WIN + 10485760;
constexpr size_t WS_WRG = WS_WOUT + 4194304;
constexpr size_t WS_OV = WS_WRG + 1048576;
constexpr size_t WS_P = WS_OV + 37748736;
constexpr size_t WS_END = WS_P + 188743680;
static_assert(WS_END <= 268435456, "workspace map exceeds 256 MiB");

struct Params {
    const float *x, *c, *ctx, *c_ctx, *ada_w, *ada_b, *norm_w, *ev_w_in, *ev_conv_w, *ev_conv_b, *ev_rg_wx, *ev_rg_bx, *ev_rg_wa, *ev_rg_ba,
        *ev_rg_lambda, *ev_sink, *ev_w_out, *od_w_in, *od_lb_raw, *od_gnorm_w, *od_w_out, *final_norm_w;
    float* out; unsigned char* ws; int ph_lo, ph_hi;
};

DI float bf2f(unsigned short v) { return __uint_as_float((unsigned)v << 16); }
DI unsigned f2bf(float f) { unsigned u = __float_as_uint(f); return (u + 0x7fffu + ((u >> 16) & 1u)) >> 16; }
typedef __bf16 bf16x2_hw __attribute__((ext_vector_type(2)));
DI unsigned pk2(float lo, float hi) { const f32x2 v = {lo, hi}; return __builtin_bit_cast(unsigned, __builtin_convertvector(v, bf16x2_hw)); }
DI bf16_t bf1(float v) { return (bf16_t)pk2(v, 0.f); }
DI float sigm(float x) { return __builtin_amdgcn_rcpf(1.f + __expf(-x)); }
DI float softplus_neg(float lam) {
    const float e = __expf(-lam);
    return e < 0.06f ? e * (1.f + e * (-0.5f + e * (0.33333333f + e * (-0.25f + e * 0.2f)))) : __logf(1.f + e);
}
DI float neg_expm1(float x) {
    return x > -0.25f ? -x * (1.f + x * (0.5f + x * (0.16666667f + x * (0.041666668f + x * (0.0083333338f + x * 0.0013888889f))))) : 1.f - __expf(x);
}
DI float wave_sum(float v) {
#pragma unroll
    for (int o = 1; o < 64; o <<= 1) v += shfl_xor_f(v, o);
    return v;
}
DI int crow(int reg, int h) { return (reg & 3) + 8 * (reg >> 2) + 4 * h; }
#define MFMA16(a, b, c) __builtin_amdgcn_mfma_f32_16x16x32_bf16((a), (b), (c), 0, 0, 0)
#define MFMA32(a, b, c) __builtin_amdgcn_mfma_f32_32x32x16_bf16((a), (b), (c), 0, 0, 0)

struct EpiStoreBf16 {
    static constexpr bool PERM = true, AFTER_DRAIN = false;
    bf16_t* O; int ldc;
    DI void operator()(const f32x4 (&acc)[2][2][4][2], const pg8::Unit& u, int wr, int wc, int fr, int fq) const {
        const int row0 = u.pm * 256 + wr * 64 + fr, col0 = u.pn * 256 + wc * 32 + 8 * fq;
#pragma unroll
        for (int ai = 0; ai < 2; ++ai)
#pragma unroll
            for (int m = 0; m < 4; ++m) { bf16_t* rowp = O + (size_t)(row0 + ai * 128 + m * 16) * ldc + col0;
#pragma unroll
                for (int bj = 0; bj < 2; ++bj) { const f32x4 v0 = acc[ai][bj][m][0], v1 = acc[ai][bj][m][1];
                    u32x4 w; w.x = pk2(v0[0], v0[1]); w.y = pk2(v0[2], v0[3]); w.z = pk2(v1[0], v1[1]); w.w = pk2(v1[2], v1[3]);
                    *(u32x4*)(rowp + bj * 128) = w; } }
    }
};
struct EpiResid {
    static constexpr bool PERM = false, AFTER_DRAIN = false;
    const float* in_lat; const float* in_ctx; float* out_lat; float* out_ctx; const float* gate;
    DI void operator()(const f32x4 (&acc)[2][2][4][2], const pg8::Unit& u, int wr, int wc, int fr, int fq) const {
        const int b = u.pm / 9, jt = u.pm % 9;
        const float* ib; float* ob; const float* g;
        if (jt == 0) { const size_t off = (size_t)b * CTXL * DM; ib = in_ctx + off; ob = out_ctx + off; g = gate + 8 * 3072; }
        else { const size_t off = ((size_t)b * SEQ + (size_t)(jt - 1) * 256) * DM; ib = in_lat + off; ob = out_lat + off; g = gate + b * 3072; }
        const int col0 = u.pn * 256 + wc * 32 + 4 * fq;
#pragma unroll
        for (int bj = 0; bj < 2; ++bj)
#pragma unroll
            for (int n = 0; n < 2; ++n) {
                const f32x4 gvv = *(const f32x4*)(g + col0 + bj * 128 + n * 16);
#pragma unroll
                for (int ai = 0; ai < 2; ++ai) {
#pragma unroll
                    for (int m = 0; m < 4; ++m) { const int r = ai * 128 + wr * 64 + m * 16 + fr;
                        const size_t off = (size_t)r * DM + col0 + bj * 128 + n * 16;
                        const f32x4 o = *(const f32x4*)(ib + off) + gvv * acc[ai][bj][m][n]; *(f32x4*)(ob + off) = o; }
                    asm volatile("" ::: "memory");
                }
            }
    }
};

struct EpiResidNorm {
    static constexpr bool PERM = true, AFTER_DRAIN = true;
    const float* xin; float* out; const float* gate;
    const float* nw; const float* mod_next;
    bf16_t* U; float* xbuf; unsigned* cnt;
    DI void fused(f32x4 (&acc)[2][2][4][2], const pg8::Unit& u, int wr, int wc, int fr, int fq, LAS unsigned char* lds, int wid, int lane) const {
        const int b = u.pm / 9, jt = u.pm % 9, panel = b * 8 + jt - 1;
        const size_t r0 = (size_t)b * SEQ + (size_t)(jt - 1) * 256;
        const float* g = gate + b * 3072;
        const int col0 = u.pn * 256 + wc * 32 + 8 * fq;
        char* hb = (char*)out + r0 * 4096 + (size_t)(u.pn * 1024 + (wc * 32 + 8 * fq) * 2);
        float* ob = out + r0 * DM;
        LAS float* Pw = (LAS float*)lds;
        LAS float* Sr = (LAS float*)(lds + 4096);
        LAS unsigned* flag = (LAS unsigned*)(lds + 5120);
        TP_START(32, lds, wid * 64 + lane);
#pragma unroll
        for (int bj = 0; bj < 2; ++bj) {
            const f32x4 g0 = *(const f32x4*)(g + col0 + bj * 128), g1 = *(const f32x4*)(g + col0 + bj * 128 + 4);
            if (xin) {
                const float* ib = xin + r0 * DM + col0 + bj * 128;
#pragma unroll
                for (int ai = 0; ai < 2; ++ai) {
                    f32x4 hv[4][2];
#pragma unroll
                    for (int m = 0; m < 4; ++m)
#pragma unroll
                        for (int n = 0; n < 2; ++n) hv[m][n] = *(const f32x4*)(ib + (size_t)(ai * 128 + wr * 64 + m * 16 + fr) * DM + 4 * n);
#pragma unroll
                    for (int m = 0; m < 4; ++m) { acc[ai][bj][m][0] = hv[m][0] + g0 * acc[ai][bj][m][0]; acc[ai][bj][m][1] = hv[m][1] + g1 * acc[ai][bj][m][1]; }
                    asm volatile("" ::: "memory");
                }
            } else {
                u32x4 hv[2][4];
#pragma unroll
                for (int ai = 0; ai < 2; ++ai)
#pragma unroll
                    for (int m = 0; m < 4; ++m) hv[ai][m] = *(const u32x4*)(hb + (size_t)(ai * 128 + wr * 64 + m * 16 + fr) * 4096 + bj * 256);
#pragma unroll
                for (int ai = 0; ai < 2; ++ai)
#pragma unroll
                    for (int m = 0; m < 4; ++m) { const u32x4 w = hv[ai][m];
                        const f32x4 h0 = {__uint_as_float(w.x << 16), __uint_as_float(w.x & 0xffff0000u), __uint_as_float(w.y << 16), __uint_as_float(w.y & 0xffff0000u)};
                        const f32x4 h1 = {__uint_as_float(w.z << 16), __uint_as_float(w.z & 0xffff0000u), __uint_as_float(w.w << 16), __uint_as_float(w.w & 0xffff0000u)};
                        acc[ai][bj][m][0] = h0 + g0 * acc[ai][bj][m][0]; acc[ai][bj][m][1] = h1 + g1 * acc[ai][bj][m][1]; }
            }
            asm volatile("" ::: "memory");
        }
        TP_STOP(32, lds, wid * 64 + lane); TP_START(33, lds, wid * 64 + lane);
#pragma unroll
        for (int ai = 0; ai < 2; ++ai)
#pragma unroll
            for (int m = 0; m < 4; ++m) {
                float s = 0.f;
#pragma unroll
                for (int bj = 0; bj < 2; ++bj)
#pragma unroll
                    for (int n = 0; n < 2; ++n) { const f32x4 x = acc[ai][bj][m][n]; s += (x[0] * x[0] + x[1] * x[1]) + (x[2] * x[2] + x[3] * x[3]); }
                s += shfl_xor_f(s, 16); s += shfl_xor_f(s, 32);
                if (fq == 0) Pw[(ai * 128 + wr * 64 + m * 16 + fr) * 4 + wc] = s;
            }
        asm volatile("s_waitcnt lgkmcnt(0)" ::: "memory"); __builtin_amdgcn_s_barrier(); asm volatile("" ::: "memory");
        const int row = wid * 32 + (lane & 31);
        if (lane < 32) {
            const float t = (Pw[row * 4 + 0] + Pw[row * 4 + 1]) + (Pw[row * 4 + 2] + Pw[row * 4 + 3]);
            __hip_atomic_store((unsigned*)xbuf + ((size_t)panel * 256 + row) * 4 + u.pn, __float_as_uint(t), __ATOMIC_RELAXED, __HIP_MEMORY_SCOPE_AGENT);
        }
        asm volatile("s_waitcnt vmcnt(0)" ::: "memory");
        if (lane == 0) __hip_atomic_fetch_add(cnt + 16 * panel, 1u, __ATOMIC_RELAXED, __HIP_MEMORY_SCOPE_AGENT);
        const float* sh = mod_next ? mod_next + b * 3072 : nullptr;
        f32x4 W4[2][2], S4[2][2], H4[2][2];
#pragma unroll
        for (int bj = 0; bj < 2; ++bj)
#pragma unroll
            for (int n = 0; n < 2; ++n) { const int cc = col0 + bj * 128 + 4 * n;
                W4[bj][n] = *(const f32x4*)(nw + cc); S4[bj][n] = (f32x4){0.f, 0.f, 0.f, 0.f}; H4[bj][n] = (f32x4){0.f, 0.f, 0.f, 0.f};
                if (mod_next) { S4[bj][n] = *(const f32x4*)(sh + 1024 + cc); H4[bj][n] = *(const f32x4*)(sh + cc); } }
        if (mod_next) {
#pragma unroll
            for (int bj = 0; bj < 2; ++bj)
#pragma unroll
                for (int ai = 0; ai < 2; ++ai)
#pragma unroll
                    for (int m = 0; m < 4; ++m) { const f32x4 o0 = acc[ai][bj][m][0], o1 = acc[ai][bj][m][1];
                        u32x4 w; w.x = pk2(o0[0], o0[1]); w.y = pk2(o0[2], o0[3]); w.z = pk2(o1[0], o1[1]); w.w = pk2(o1[2], o1[3]);
                        *(u32x4*)(hb + (size_t)(ai * 128 + wr * 64 + m * 16 + fr) * 4096 + bj * 256) = w; }
        }
        if (wid == 0) {
            unsigned spins = 0;
            while ((unsigned)__builtin_amdgcn_readfirstlane(__hip_atomic_load(cnt + 16 * panel, __ATOMIC_RELAXED, __HIP_MEMORY_SCOPE_AGENT)) < 32u) { __builtin_amdgcn_s_sleep(2); if (++spins > (1u << 22)) break; }
            if (lane == 0) flag[0] = 1u;
        }
        asm volatile("s_waitcnt vmcnt(0) lgkmcnt(0)" ::: "memory"); __builtin_amdgcn_s_barrier(); asm volatile("" ::: "memory");
        if (lane < 32) {
            const unsigned* slot = (const unsigned*)xbuf + ((size_t)panel * 256 + row) * 4;
            const float t = (__uint_as_float(__hip_atomic_load(slot + 0, __ATOMIC_RELAXED, __HIP_MEMORY_SCOPE_AGENT)) + __uint_as_float(__hip_atomic_load(slot + 1, __ATOMIC_RELAXED, __HIP_MEMORY_SCOPE_AGENT)))
                          + (__uint_as_float(__hip_atomic_load(slot + 2, __ATOMIC_RELAXED, __HIP_MEMORY_SCOPE_AGENT)) + __uint_as_float(__hip_atomic_load(slot + 3, __ATOMIC_RELAXED, __HIP_MEMORY_SCOPE_AGENT)));
            Sr[row] = rsqrtf(t * (1.f / DM) + RMS_EPS);
        }
        asm volatile("s_waitcnt lgkmcnt(0)" ::: "memory"); __builtin_amdgcn_s_barrier(); asm volatile("" ::: "memory");
        TP_STOP(33, lds, wid * 64 + lane); TP_START(34, lds, wid * 64 + lane);
#pragma unroll
        for (int bj = 0; bj < 2; ++bj) {
            const int cc = col0 + bj * 128;
            const f32x4 w40 = W4[bj][0], w41 = W4[bj][1];
            const f32x4 s40 = S4[bj][0] + 1.f, s41 = S4[bj][1] + 1.f, h40 = H4[bj][0], h41 = H4[bj][1];
#pragma unroll
            for (int ai = 0; ai < 2; ++ai)
#pragma unroll
                for (int m = 0; m < 4; ++m) { const int r = ai * 128 + wr * 64 + m * 16 + fr; const float sr = Sr[r];
                    const f32x4 y0 = (acc[ai][bj][m][0] * sr) * w40, y1 = (acc[ai][bj][m][1] * sr) * w41;
                    if (mod_next) { const f32x4 o0 = y0 * s40 + h40, o1 = y1 * s41 + h41;
                        u32x4 w; w.x = pk2(o0[0], o0[1]); w.y = pk2(o0[2], o0[3]); w.z = pk2(o1[0], o1[1]); w.w = pk2(o1[2], o1[3]);
                        *(u32x4*)(U + ((size_t)u.pm * 256 + r) * DM + cc) = w; }
                    else { *(f32x4*)(ob + (size_t)r * DM + cc) = y0; *(f32x4*)(ob + (size_t)r * DM + cc + 4) = y1; } }
        }
        TP_STOP(34, lds, wid * 64 + lane);
    }
};

constexpr int MG_STAGE = 52224;
struct MgNoPre { DI void operator()(int, int, int) const {} };
template <class EpiF, class PreF = MgNoPre>
DI void mini_gemm_tile(LAS unsigned char* lds, const bf16_t* A, int lda, const bf16_t* Bt, int K, const EpiF& epi, int wv, const PreF& pre = PreF()) {
    const int tid = get_tid(wv), lane = tid & 63, wave = tid >> 6, r = lane & 31, h = lane >> 5, wm = wave >> 2, wn = wave & 3;
    const int lrow = tid >> 4, lch = tid & 15, nS = K / 128;
    const bf16_t* ap = A + (size_t)lrow * lda + 8 * lch;
    const bf16_t* bp = Bt + (size_t)lrow * K + 8 * lch;
    u32x4 s0[6], s1[6], s2[6], s3[6];
    f32x16 acc;
#pragma unroll
    for (int i = 0; i < 16; ++i) acc[i] = 0.f;
#define MG_LOAD(set, s) do { (set)[0] = *(const u32x4*)(ap + (s) * 128); (set)[1] = *(const u32x4*)(ap + (size_t)32 * lda + (s) * 128); \
        _Pragma("unroll") for (int q_ = 0; q_ < 4; ++q_) (set)[2 + q_] = *(const u32x4*)(bp + (size_t)(32 * q_) * K + (s) * 128); } while (0)
#define MG_STORE(set, buf) do { LAS unsigned char* b_ = lds + (buf) * MG_STAGE; *(LAS u32x4*)(b_ + lrow * 272 + lch * 16) = (set)[0]; *(LAS u32x4*)(b_ + (32 + lrow) * 272 + lch * 16) = (set)[1]; \
        _Pragma("unroll") for (int q_ = 0; q_ < 4; ++q_) *(LAS u32x4*)(b_ + 17408 + (32 * q_ + lrow) * 272 + lch * 16) = (set)[2 + q_]; } while (0)
#define MG_COMPUTE(buf) do { const LAS unsigned char* b_ = lds + (buf) * MG_STAGE; \
        _Pragma("unroll") for (int ks = 0; ks < 8; ++ks) { \
            const bf16x8 af = *(const LAS bf16x8*)(b_ + (32 * wm + r) * 272 + (16 * ks + 8 * h) * 2); \
            const bf16x8 bf = *(const LAS bf16x8*)(b_ + 17408 + (32 * wn + r) * 272 + (16 * ks + 8 * h) * 2); \
            acc = MFMA32(af, bf, acc); } } while (0)
    MG_LOAD(s0, 0); if (1 < nS) MG_LOAD(s1, 1); if (2 < nS) MG_LOAD(s2, 2); if (3 < nS) MG_LOAD(s3, 3);
    pre(32 * wm, 32 * wn + r, h);
    __syncthreads();
    MG_STORE(s0, 0);
    if (4 < nS) MG_LOAD(s0, 4);
#pragma unroll 1
    for (int s = 0; s < nS; s += 4) {
        __syncthreads();
        if (s + 1 < nS) { MG_STORE(s1, 1); if (s + 5 < nS) MG_LOAD(s1, s + 5); }
        MG_COMPUTE(0);
        __syncthreads();
        if (s + 2 < nS) { MG_STORE(s2, 0); if (s + 6 < nS) MG_LOAD(s2, s + 6); }
        if (s + 1 < nS) MG_COMPUTE(1);
        __syncthreads();
        if (s + 3 < nS) { MG_STORE(s3, 1); if (s + 7 < nS) MG_LOAD(s3, s + 7); }
        if (s + 2 < nS) MG_COMPUTE(0);
        __syncthreads();
        if (s + 4 < nS) { MG_STORE(s0, 0); if (s + 8 < nS) MG_LOAD(s0, s + 8); }
        if (s + 3 < nS) MG_COMPUTE(1);
    }
#undef MG_LOAD
#undef MG_STORE
#undef MG_COMPUTE
    epi(acc, 32 * wm, 32 * wn + r, h);
    __syncthreads();
}

DI void phase_convert(const Params& P, LAS unsigned char* lds, int layer, int wv);
DI void phase_pro(const Params& P, LAS unsigned char* lds, int wv, int item_lo, int item_hi, bool do_rope) {
    const int tid = get_tid(wv);
    LAS float* s = (LAS float*)lds;
    LAS float* red = (LAS float*)(lds + 36864);
    float* mod = (float*)(P.ws + WS_MOD);
    TP_START(41, lds, tid);
    const int ks = tid >> 4, col = tid & 15;
    float cv[18];
#pragma unroll
    for (int q = 0; q < 18; ++q) { const int i = tid + 512 * q, r = i >> 10, k = i & 1023; cv[q] = r < 8 ? P.c[r * 1024 + k] : P.c_ctx[k]; }
    float wv_[3][32];
#pragma unroll
    for (int q = 0; q < 3; ++q) {
        const int item = item_lo + 3 * get_bid() + q;
        if (item < item_hi) {
            const int l = item / 192, n0 = (item % 192) * 16;
            const float* w = P.ada_w + (size_t)l * 1024 * 3072 + (size_t)(ks * 32) * 3072 + n0 + col;
#pragma unroll
            for (int kk = 0; kk < 32; ++kk) wv_[q][kk] = w[(size_t)kk * 3072];
        }
    }
    const int qf = tid / 144, rf = (tid - 144 * qf) >> 4, ccf = tid & 15, itemf = item_lo + 3 * get_bid() + qf;
    const bool finf = tid < 432 && itemf < item_hi;
    const int lf = itemf / 192, nf = (itemf % 192) * 16 + ccf;
    float biasf = 0.f;
    if (finf) biasf = P.ada_b[lf * 3072 + nf];
    TP_STOP(41, lds, tid);
    TP_START(43, lds, tid);
    if (do_rope) { phase_convert(P, lds, 0, wv); __syncthreads(); }
    TP_STOP(43, lds, tid);
    TP_START(40, lds, tid);
#pragma unroll
    for (int q = 0; q < 18; ++q) s[tid + 512 * q] = cv[q] * sigm(cv[q]);
    __syncthreads();
    TP_STOP(40, lds, tid); TP_START(41, lds, tid);
    {
#pragma unroll
        for (int q = 0; q < 3; ++q) {
            const int item = item_lo + 3 * get_bid() + q;
            if (item < item_hi) {
                float acc[9];
#pragma unroll
                for (int r = 0; r < 9; ++r) acc[r] = 0.f;
#pragma unroll
                for (int k4 = 0; k4 < 8; ++k4) {
#pragma unroll
                    for (int r = 0; r < 9; ++r) { const f32x4 sv = *(const LAS f32x4*)(s + r * 1024 + ks * 32 + 4 * k4);
                        acc[r] += sv[0] * wv_[q][4 * k4]; acc[r] += sv[1] * wv_[q][4 * k4 + 1]; acc[r] += sv[2] * wv_[q][4 * k4 + 2]; acc[r] += sv[3] * wv_[q][4 * k4 + 3]; } }
#pragma unroll
                for (int r = 0; r < 9; ++r) red[q * 4608 + (ks * 9 + r) * 16 + col] = acc[r];
            }
        }
        __syncthreads();
        if (finf) { float sum = 0.f;
#pragma unroll
            for (int k2 = 0; k2 < 32; ++k2) sum += red[qf * 4608 + (k2 * 9 + rf) * 16 + ccf];
            mod[(lf * 9 + rf) * 3072 + nf] = sum + biasf; }
        __syncthreads();
    }
    TP_STOP(41, lds, tid);
    if (!do_rope) return;
    TP_START(42, lds, tid);
    float* cos_t = (float*)(P.ws + WS_ROPE); float* sin_t = cos_t + SEQ * 32;
    for (int i = get_bid() * 512 + tid; i < SEQ * 32; i += gridDim.x * 512) {
        const int pos = i >> 5, jj = i & 31, fi = jj & 15;
        const float inv = __builtin_amdgcn_exp2f(-(float)(2 * fi) * (13.287712379549449f / 32.f));
        const float ang = (float)(jj < 16 ? (pos >> 6) : (pos & 63)) * inv;
        cos_t[i] = __cosf(ang); sin_t[i] = __sinf(ang);
    }
    TP_STOP(42, lds, tid);
}

template <bool FRAG = false>
DI void transpose_item(const float* W, int K, int N, bf16_t* WT, LAS float* scr, int item, int lane) {
    const int nblk = N / 64, kb = item / nblk, nb = item % nblk, k0 = 64 * kb, n0 = 64 * nb;
    const int l16 = lane & 15, kr = lane >> 4;
    f32x4 v[16];
#pragma unroll
    for (int i = 0; i < 16; ++i) v[i] = *(const f32x4*)(W + (size_t)(k0 + 4 * i + kr) * N + n0 + 4 * l16);
#pragma unroll
    for (int i = 0; i < 16; ++i) { LAS float* d = scr + (4 * i + kr) * 65 + 4 * l16; d[0] = v[i][0]; d[1] = v[i][1]; d[2] = v[i][2]; d[3] = v[i][3]; }
    asm volatile("s_waitcnt lgkmcnt(0)" ::: "memory");
    const int c = lane & 7;
#pragma unroll
    for (int j = 0; j < 8; ++j) { const int n = (lane >> 3) + 8 * j; const LAS float* sp = scr + (8 * c) * 65 + n;
        u32x4 o; o.x = pk2(sp[0 * 65], sp[1 * 65]); o.y = pk2(sp[2 * 65], sp[3 * 65]); o.z = pk2(sp[4 * 65], sp[5 * 65]); o.w = pk2(sp[6 * 65], sp[7 * 65]);
        if (FRAG) {
            const int nn = n0 + n, k8 = (k0 >> 3) + c;
            *(u32x4*)(WT + ((((nn >> 4) * 4 + (k8 >> 2)) * 64 + (k8 & 3) * 16 + (nn & 15)) * 8)) = o;
        } else *(u32x4*)(WT + (size_t)(n0 + n) * K + k0 + 8 * c) = o; }
    asm volatile("s_waitcnt lgkmcnt(0)" ::: "memory");
}

DI void phase_convert(const Params& P, LAS unsigned char* lds, int layer, int wv) {
    const int tid = get_tid(wv), lane = tid & 63, wave = tid >> 6;
    const int gw = get_bid() * 8 + wave, NGW = gridDim.x * 8;
    const int j = layer >> 1;
    LAS float* scr = (LAS float*)(lds + wave * 16640);
    bf16_t* WIN = (bf16_t*)(P.ws + WS_WIN); bf16_t* WOUT = (bf16_t*)(P.ws + WS_WOUT); bf16_t* WRG = (bf16_t*)(P.ws + WS_WRG);
    if ((layer & 1) == 0) {
        constexpr int I_IN = 16 * (EVEN_IN / 64), I_OUT = 32 * 16, I_RG = 32 * 4;
        for (int it = gw; it < I_IN + I_OUT + I_RG; it += NGW) {
            int r = it;
            if (r < I_IN) { transpose_item(P.ev_w_in + (size_t)j * 1024 * EVEN_IN, 1024, EVEN_IN, WIN, scr, r, lane); continue; } r -= I_IN;
            if (r < I_OUT) { transpose_item(P.ev_w_out + (size_t)j * 2048 * 1024, 2048, 1024, WOUT, scr, r, lane); continue; } r -= I_OUT;
            const int mat = r >> 2, sub = r & 3;
            const int dir = mat >> 4, gate = (mat >> 3) & 1, hd = mat & 7;
            const float* src = (gate == 0 ? P.ev_rg_wx : P.ev_rg_wa) + ((size_t)((j * 2 + dir) * 8 + hd)) * 16384;
            transpose_item<true>(src, 128, 128, WRG + (size_t)mat * 16384, scr, sub, lane);
        }
    } else {
        constexpr int I_IN = 16 * (ODD_IN / 64), I_OUT = 16 * 16;
        for (int it = gw; it < I_IN + I_OUT; it += NGW) {
            int r = it;
            if (r < I_IN) { transpose_item(P.od_w_in + (size_t)j * 1024 * ODD_IN, 1024, ODD_IN, WIN, scr, r, lane); continue; } r -= I_IN;
            transpose_item(P.od_w_out + (size_t)j * 1024 * 1024, 1024, 1024, WOUT, scr, r, lane);
        }
    }
}
DI void phase_norm(const Params& P, LAS unsigned char* lds, int layer, int wv) {
    const int tid = get_tid(wv), lane = tid & 63, wave = tid >> 6;
    const int gw = get_bid() * 8 + wave, NGW = gridDim.x * 8;
    const float* hl = layer == 0 ? P.x : P.out; const float* hc = layer == 0 ? P.ctx : (const float*)(P.ws + WS_HCTX);
    const float* mod = (const float*)(P.ws + WS_MOD) + (size_t)layer * 9 * 3072;
    const float* nw = P.norm_w + layer * 1024;
    bf16_t* U = (bf16_t*)(P.ws + WS_OV);
    f32x4 w4[4], s4[4], h4[4];
#pragma unroll
    for (int q = 0; q < 4; ++q) w4[q] = *(const f32x4*)(nw + 4 * lane + 256 * q);
    int cur_m = -1;
    const int nrows = layer == 0 ? MROWS : NB * CTXL;
    const int rpw = (nrows + NGW - 1) / NGW;
    auto rsrc = [&](int idx) -> const float* {
        const int b = layer == 0 ? idx / LT : idx >> 8, jr = layer == 0 ? idx % LT : idx & 255;
        return jr < CTXL ? hc + ((size_t)b * CTXL + jr) * DM : hl + ((size_t)b * SEQ + (jr - CTXL)) * DM; };
    auto proc = [&](const f32x4 (&v)[4], int idx) {
        const int b = layer == 0 ? idx / LT : idx >> 8, jr = layer == 0 ? idx % LT : idx & 255;
        const int R = b * LT + jr;
        const int mrow = jr < CTXL ? 8 : b;
        if (mrow != cur_m) {
            cur_m = mrow;
            const float* sh = mod + mrow * 3072; const float* sc = sh + 1024;
#pragma unroll
            for (int q = 0; q < 4; ++q) { s4[q] = *(const f32x4*)(sc + 4 * lane + 256 * q) + 1.f; h4[q] = *(const f32x4*)(sh + 4 * lane + 256 * q); }
        }
        float ss = 0.f;
#pragma unroll
        for (int q = 0; q < 4; ++q) ss += (v[q][0] * v[q][0] + v[q][1] * v[q][1]) + (v[q][2] * v[q][2] + v[q][3] * v[q][3]);
        const float rstd = rsqrtf(wave_sum(ss) * (1.f / DM) + RMS_EPS);
#pragma unroll
        for (int q = 0; q < 4; ++q) { const int k = 4 * lane + 256 * q;
            const f32x4 y = (v[q] * rstd) * w4[q]; const f32x4 o = y * s4[q] + h4[q];
            u32x2 w; w.x = pk2(o[0], o[1]); w.y = pk2(o[2], o[3]); *(u32x2*)(U + (size_t)R * DM + k) = w; }
    };
    const int i0 = gw * rpw, i1 = (i0 + rpw < nrows) ? i0 + rpw : nrows;
    f32x4 va[4], vb[4];
    int i = i0;
    if (i < i1) { const float* src = rsrc(i);
#pragma unroll
        for (int q = 0; q < 4; ++q) va[q] = *(const f32x4*)(src + 4 * lane + 256 * q);
        const int b0 = layer == 0 ? i / LT : i >> 8, jr0 = layer == 0 ? i % LT : i & 255;
        cur_m = jr0 < CTXL ? 8 : b0;
        const float* sh = mod + cur_m * 3072; const float* sc = sh + 1024;
#pragma unroll
        for (int q = 0; q < 4; ++q) { s4[q] = *(const f32x4*)(sc + 4 * lane + 256 * q) + 1.f; h4[q] = *(const f32x4*)(sh + 4 * lane + 256 * q); } }
    if (layer > 0) phase_convert(P, lds, layer, wv);
    while (i < i1) {
        if (i + 1 < i1) { const float* src = rsrc(i + 1);
#pragma unroll
            for (int q = 0; q < 4; ++q) vb[q] = *(const f32x4*)(src + 4 * lane + 256 * q); }
        proc(va, i);
        if (i + 1 >= i1) break;
        if (i + 2 < i1) { const float* src = rsrc(i + 2);
#pragma unroll
            for (int q = 0; q < 4; ++q) va[q] = *(const f32x4*)(src + 4 * lane + 256 * q); }
        proc(vb, i + 1);
        i += 2;
    }
}

typedef _Float16 f16x2_t __attribute__((ext_vector_type(2)));
DI unsigned pkh2(float a, float b) { const f16x2_t v = {(_Float16)a, (_Float16)b}; return __builtin_bit_cast(unsigned, v); }
DI void unpkh2(unsigned u, float& a, float& b) { const f16x2_t v = __builtin_bit_cast(f16x2_t, u); a = (float)v[0]; b = (float)v[1]; }
constexpr int RG_UT = 0, RG_AL = 17408, RG_BL = 50176, RG_HP = 82944, RG_QA = 148480, RG_CAR = 152576, RG_FLAG = 153600, RG_END = 153664;
static_assert(RG_END <= LDS_BYTES - 256, "RG-LRU LDS map");
constexpr int CW_RG = 8192;
struct RgPre { bf16x8 wfr[2][2][4]; float prm[2][3]; float wv4[4][8], bias[8]; u32x4 xt[3]; };
DI void rg_prefetch(const Params& P, int j, int item, int tid, RgPre& R) {
    const int lane = tid & 63, wave = tid >> 6, r = lane & 15;
    const int grp = item / NCHUNK, ci = item % NCHUNK, b = grp >> 3, hd = grp & 7;
    const bf16_t* p = (const bf16_t*)(P.ws + WS_P);
    const bf16_t* WRG = (const bf16_t*)(P.ws + WS_WRG);
    const int R0 = b * LT + ci * 64;
    const int seg_lo = b * LT + (ci < 4 ? 0 : CTXL), seg_hi = b * LT + (ci < 4 ? CTXL : LT);
#pragma unroll
    for (int rep = 0; rep < 3; ++rep) {
        const int idx = tid + rep * 512, tr = idx >> 4, c0 = (idx & 15) * 8;
        const int Rg = R0 + tr - 1;
        u32x4 xv = {0u, 0u, 0u, 0u};
        if (idx < 67 * 16 && Rg >= seg_lo && Rg < seg_hi) xv = *(const u32x4*)(p + (size_t)Rg * EVEN_IN + hd * 128 + c0);
        R.xt[rep] = xv;
    }
#pragma unroll
    for (int dir = 0; dir < 2; ++dir) {
#pragma unroll
        for (int gt = 0; gt < 2; ++gt) {
            const bf16_t* W = WRG + (size_t)((dir * 2 + gt) * 8 + hd) * 16384 + (wave * 4 * 64 + lane) * 8;
#pragma unroll
            for (int ks = 0; ks < 4; ++ks) R.wfr[dir][gt][ks] = *(const bf16x8*)(W + ks * 512);
        }
        const int idx = (j * 2 + dir) * 1024 + hd * 128 + 16 * wave + r;
        R.prm[dir][0] = P.ev_rg_bx[idx]; R.prm[dir][1] = P.ev_rg_ba[idx]; R.prm[dir][2] = P.ev_rg_lambda[idx];
    }
    const int c0 = (tid & 15) * 8, cg0 = hd * 128 + c0;
    { const f32x4 b0 = *(const f32x4*)(P.ev_conv_b + j * 1024 + cg0), b1 = *(const f32x4*)(P.ev_conv_b + j * 1024 + cg0 + 4);
      R.bias[0] = b0[0]; R.bias[1] = b0[1]; R.bias[2] = b0[2]; R.bias[3] = b0[3]; R.bias[4] = b1[0]; R.bias[5] = b1[1]; R.bias[6] = b1[2]; R.bias[7] = b1[3]; }
#pragma unroll
    for (int k = 0; k < 4; ++k) { const float* wk = P.ev_conv_w + (size_t)(j * 4 + k) * 1024 + cg0; const f32x4 w0 = *(const f32x4*)wk, w1 = *(const f32x4*)(wk + 4);
        R.wv4[k][0] = w0[0]; R.wv4[k][1] = w0[1]; R.wv4[k][2] = w0[2]; R.wv4[k][3] = w0[3]; R.wv4[k][4] = w1[0]; R.wv4[k][5] = w1[1]; R.wv4[k][6] = w1[2]; R.wv4[k][7] = w1[3]; }
}
DI void rglru_item(const Params& P, LAS unsigned char* lds, int j, int item, int mode, int buf, RgPre& R, int wv, int aux) {
    const int tid = get_tid(wv), lane = tid & 63, wave = tid >> 6, r = lane & 15, g = lane >> 4;
    const int grp = item / NCHUNK, ci = item % NCHUNK, b = grp >> 3, hd = grp & 7;
    bf16_t* p = (bf16_t*)(P.ws + WS_P);
    const bf16_t* WRG = (const bf16_t*)(P.ws + WS_WRG);
    unsigned long long* AGG = (unsigned long long*)(P.ws + WS_AGG);
    unsigned* cnt = (unsigned*)(P.ws + WS_CTL) + CW_RG + (j * 64 + grp) * 16;
    const int R0 = b * LT + ci * 64;
    const int seg_lo = b * LT + (ci < 4 ? 0 : CTXL), seg_hi = b * LT + (ci < 4 ? CTXL : LT);
    LAS bf16_t* UT = (LAS bf16_t*)(lds + RG_UT);
    LAS float* AL = (LAS float*)(lds + RG_AL);
    LAS float* BL = (LAS float*)(lds + RG_BL);
    LAS unsigned* HP = (LAS unsigned*)(lds + 17408 + buf * 67584);
    LAS float* QA = (LAS float*)(lds + RG_QA);
    LAS float* CAR = (LAS float*)(lds + 17408 + 2 * 67584);
    if (mode == 0) {
    TP_START(10, lds, tid); TP_START(11, lds, tid);
    {
        LAS bf16_t* XT = (LAS bf16_t*)HP;
#pragma unroll
        for (int rep = 0; rep < 3; ++rep) {
            const int idx = tid + rep * 512, tr = idx >> 4, c0 = (idx & 15) * 8;
            if (idx < 67 * 16) *(LAS u32x4*)(XT + tr * 128 + c0) = R.xt[rep];
        }
        const int c0 = (tid & 15) * 8;
        __syncthreads();
#pragma unroll
        for (int rep = 0; rep < 2; ++rep) {
            const int t = (tid >> 4) + rep * 32;
            float acc[8];
#pragma unroll
            for (int e = 0; e < 8; ++e) acc[e] = R.bias[e];
#pragma unroll
            for (int k = 0; k < 4; ++k) {
                const u32x4 xv = *(const LAS u32x4*)(XT + (t + k) * 128 + c0);
                acc[0] += R.wv4[k][0] * __uint_as_float(xv.x << 16); acc[1] += R.wv4[k][1] * __uint_as_float(xv.x & 0xffff0000u);
                acc[2] += R.wv4[k][2] * __uint_as_float(xv.y << 16); acc[3] += R.wv4[k][3] * __uint_as_float(xv.y & 0xffff0000u);
                acc[4] += R.wv4[k][4] * __uint_as_float(xv.z << 16); acc[5] += R.wv4[k][5] * __uint_as_float(xv.z & 0xffff0000u);
                acc[6] += R.wv4[k][6] * __uint_as_float(xv.w << 16); acc[7] += R.wv4[k][7] * __uint_as_float(xv.w & 0xffff0000u);
            }
            u32x4 o; o.x = pk2(acc[0], acc[1]); o.y = pk2(acc[2], acc[3]); o.z = pk2(acc[4], acc[5]); o.w = pk2(acc[6], acc[7]);
            *(LAS u32x4*)(UT + t * 136 + c0) = o;
        }
    }
    __syncthreads();
    TP_STOP(11, lds, tid);
#pragma unroll
    for (int dir = 0; dir < 2; ++dir) {
        TP_START(12, lds, tid); TP_START(16, lds, tid);
        f32x4 ax[4], aa[4];
#pragma unroll
        for (int m = 0; m < 4; ++m) { ax[m] = (f32x4){0.f, 0.f, 0.f, 0.f}; aa[m] = (f32x4){0.f, 0.f, 0.f, 0.f}; }
#pragma unroll
        for (int ks = 0; ks < 4; ++ks) {
#pragma unroll
            for (int m = 0; m < 4; ++m) {
                const bf16x8 a = *(const LAS bf16x8*)(UT + (16 * m + r) * 136 + 32 * ks + 8 * g);
                ax[m] = MFMA16(a, R.wfr[dir][0][ks], ax[m]); aa[m] = MFMA16(a, R.wfr[dir][1][ks], aa[m]);
            }
        }
        asm volatile("" :: "v"(ax[0]), "v"(ax[1]), "v"(ax[2]), "v"(ax[3]), "v"(aa[0]), "v"(aa[1]), "v"(aa[2]), "v"(aa[3]));
        TP_STOP(16, lds, tid); TP_START(17, lds, tid);
        float av[4][4], bv[4][4];
        {
            const int c = 16 * wave + r;
            const float bxv = R.prm[dir][0], bav = R.prm[dir][1], lam = R.prm[dir][2];
            const float sp = softplus_neg(lam);
#pragma unroll
            for (int m = 0; m < 4; ++m)
#pragma unroll
                for (int i = 0; i < 4; ++i) {
                    const int t = 16 * m + 4 * g + i;
                    const float gx = sigm(ax[m][i] + bxv), ga = sigm(aa[m][i] + bav);
                    const float la = -8.f * ga * sp;
                    const float a = __expf(la), mult = __builtin_amdgcn_sqrtf((1.f - a) * (1.f + a));
                    const float uv = bf2f(UT[t * 136 + c]);
                    av[m][i] = a; bv[m][i] = mult * gx * uv;
                }
        }
        TP_STOP(17, lds, tid);
        TP_STOP(12, lds, tid); TP_START(13, lds, tid);
        {
            const int c = 16 * wave + r;
            float hl[4][4], pl[4][4], sa[4], sb[4];
#pragma unroll
            for (int m = 0; m < 4; ++m) {
                float h = 0.f, pc = 1.f;
#pragma unroll
                for (int ii = 0; ii < 4; ++ii) { const int i = dir == 0 ? ii : 3 - ii; h = av[m][i] * h + bv[m][i]; pc *= av[m][i]; hl[m][i] = h; pl[m][i] = pc; }
                sa[m] = pc; sb[m] = h;
            }
            float hin[4], pin[4];
            {
                float ca[4][4], cb[4][4];
#pragma unroll
                for (int m = 0; m < 4; ++m)
#pragma unroll
                    for (int gg = 0; gg < 4; ++gg) {
                        const int src = (16 * gg + r) << 2;
                        ca[m][gg] = __int_as_float(__builtin_amdgcn_ds_bpermute(src, __float_as_int(sa[m])));
                        cb[m][gg] = __int_as_float(__builtin_amdgcn_ds_bpermute(src, __float_as_int(sb[m])));
                    }
                float H = 0.f, Pc = 1.f;
#pragma unroll
                for (int ss = 0; ss < 16; ++ss) {
                    const int s = dir == 0 ? ss : 15 - ss, m = s >> 2, gg = s & 3;
                    if (gg == g) { hin[m] = H; pin[m] = Pc; }
                    H = ca[m][gg] * H + cb[m][gg]; Pc *= ca[m][gg];
                }
                if (g == 0) {
                    const unsigned long long v = ((unsigned long long)__float_as_uint(H) << 32) | __float_as_uint(Pc);
                    __hip_atomic_store(AGG + ((size_t)(dir * NB + b) * NCHUNK + ci) * 1024 + hd * 128 + c, v, __ATOMIC_RELAXED, __HIP_MEMORY_SCOPE_AGENT);
                }
            }
#pragma unroll
            for (int m = 0; m < 4; ++m)
#pragma unroll
                for (int i = 0; i < 4; ++i) HP[(dir * 64 + 16 * m + 4 * g + i) * 132 + c] = pkh2(hl[m][i] + pl[m][i] * hin[m], pl[m][i] * pin[m]);
        }
        TP_STOP(13, lds, tid);
    }
    if (aux == 0) {
        asm volatile("s_waitcnt vmcnt(0)" ::: "memory");
        __syncthreads();
        if (tid == 0) __hip_atomic_fetch_add(cnt, 1u, __ATOMIC_RELAXED, __HIP_MEMORY_SCOPE_AGENT);
    }
    TP_STOP(10, lds, tid);
    return;
    }
    TP_START(14, lds, tid);
    u32x4 gpre[2];
#pragma unroll
    for (int rep = 0; rep < 2; ++rep) { const int idx = tid + rep * 512; gpre[rep] = *(const u32x4*)(p + (size_t)(R0 + (idx >> 4)) * EVEN_IN + 1536 + hd * 128 + (idx & 15) * 8); }
    if (tid == 0) {
        unsigned spins = 0;
        while (__hip_atomic_load(cnt, __ATOMIC_RELAXED, __HIP_MEMORY_SCOPE_AGENT) < (unsigned)NCHUNK) { __builtin_amdgcn_s_sleep(2); if (++spins > (1u << 22)) break; }
    }
    __syncthreads();
    TP_STOP(14, lds, tid); TP_START(15, lds, tid);
    LAS float* CARA = (LAS float*)(lds + 153600); LAS float* CARB = (LAS float*)(lds + 154624);
    {
        const int part = tid >> 8, dir = (tid >> 7) & 1, c = tid & 127;
        const int pos = dir == 0 ? ci : (ci < 4 ? 3 - ci : 39 - ci);
        const int lo = part == 0 ? 0 : 18, hi = part == 0 ? (pos < 18 ? pos : 18) : pos;
        float h = 0.f, a = 1.f;
        const unsigned long long* ag = AGG + (size_t)(dir * NB + b) * NCHUNK * 1024 + hd * 128 + c;
        if (lo < hi) {
            unsigned long long v[18];
#pragma unroll
            for (int k = 0; k < 18; ++k) { const int pp = lo + k < hi ? lo + k : hi - 1; const int cc = dir == 0 ? pp : (pp < 4 ? 3 - pp : 39 - pp);
                v[k] = __hip_atomic_load(ag + (size_t)cc * 1024, __ATOMIC_RELAXED, __HIP_MEMORY_SCOPE_AGENT); }
#pragma unroll
            for (int k = 0; k < 18; ++k) if (lo + k < hi) { const float av = __uint_as_float((unsigned)v[k]); h = av * h + __uint_as_float((unsigned)(v[k] >> 32)); a *= av; }
        }
        if (part == 0) CAR[dir * 128 + c] = h; else { CARA[dir * 128 + c] = a; CARB[dir * 128 + c] = h; }
    }
    __syncthreads();
#pragma unroll
    for (int rep = 0; rep < 2; ++rep) {
        const int idx = tid + rep * 512, t = idx >> 4, c0 = (idx & 15) * 8;
        bf16_t* gp = p + (size_t)(R0 + t) * EVEN_IN + 1536 + hd * 128 + c0;
        const u32x4 gv = gpre[rep];
        float y[8];
        {
            const u32x4 f0 = *(const LAS u32x4*)(HP + t * 132 + c0), f1 = *(const LAS u32x4*)(HP + t * 132 + c0 + 4);
            const u32x4 b0 = *(const LAS u32x4*)(HP + (64 + t) * 132 + c0), b1 = *(const LAS u32x4*)(HP + (64 + t) * 132 + c0 + 4);
            const f32x4 cf0 = *(const LAS f32x4*)(CARA + c0) * *(const LAS f32x4*)(CAR + c0) + *(const LAS f32x4*)(CARB + c0);
            const f32x4 cf1 = *(const LAS f32x4*)(CARA + c0 + 4) * *(const LAS f32x4*)(CAR + c0 + 4) + *(const LAS f32x4*)(CARB + c0 + 4);
            const f32x4 cb0 = *(const LAS f32x4*)(CARA + 128 + c0) * *(const LAS f32x4*)(CAR + 128 + c0) + *(const LAS f32x4*)(CARB + 128 + c0);
            const f32x4 cb1 = *(const LAS f32x4*)(CARA + 128 + c0 + 4) * *(const LAS f32x4*)(CAR + 128 + c0 + 4) + *(const LAS f32x4*)(CARB + 128 + c0 + 4);
#pragma unroll
            for (int e = 0; e < 4; ++e) {
                float h0, p0, h1, p1;
                unpkh2(f0[e], h0, p0); unpkh2(b0[e], h1, p1); y[e] = (h0 + p0 * cf0[e]) + (h1 + p1 * cb0[e]);
                unpkh2(f1[e], h0, p0); unpkh2(b1[e], h1, p1); y[4 + e] = (h0 + p0 * cf1[e]) + (h1 + p1 * cb1[e]);
            }
        }
        const float gg[8] = {__uint_as_float(gv.x << 16), __uint_as_float(gv.x & 0xffff0000u), __uint_as_float(gv.y << 16), __uint_as_float(gv.y & 0xffff0000u),
                             __uint_as_float(gv.z << 16), __uint_as_float(gv.z & 0xffff0000u), __uint_as_float(gv.w << 16), __uint_as_float(gv.w & 0xffff0000u)};
        u32x4 o;
        o.x = pk2(y[0] * gg[0] * sigm(gg[0]), y[1] * gg[1] * sigm(gg[1])); o.y = pk2(y[2] * gg[2] * sigm(gg[2]), y[3] * gg[3] * sigm(gg[3]));
        o.z = pk2(y[4] * gg[4] * sigm(gg[4]), y[5] * gg[5] * sigm(gg[5])); o.w = pk2(y[6] * gg[6] * sigm(gg[6]), y[7] * gg[7] * sigm(gg[7]));
        *(u32x4*)gp = o;
    }
    if (aux >= 0) asm volatile("s_waitcnt vmcnt(2)" ::: "memory");
    __syncthreads();
    if (aux >= 0 && tid == 0) __hip_atomic_fetch_add((unsigned*)(P.ws + WS_CTL) + CW_RG + (j * 64 + aux / NCHUNK) * 16, 1u, __ATOMIC_RELAXED, __HIP_MEMORY_SCOPE_AGENT);
    TP_STOP(15, lds, tid);
}

DI void rope8v(u32x4& v, const f32x4 cs, const f32x4 sn) {
    unsigned* w = (unsigned*)&v;
#pragma unroll
    for (int i = 0; i < 4; ++i) { const float t1 = __uint_as_float(w[i] << 16), t2 = __uint_as_float(w[i] & 0xffff0000u); w[i] = pk2(t1 * cs[i] - t2 * sn[i], t1 * sn[i] + t2 * cs[i]); }
}
DI void rope8(u32x4& v, const float* cs, const float* sn) { rope8v(v, *(const f32x4*)cs, *(const f32x4*)sn); }
DI void rope8s(u32x4& v, const float* cs, const float* sn, float sc) { rope8v(v, *(const f32x4*)cs * sc, *(const f32x4*)sn * sc); }
DI void scale8(u32x4& v, float sc) {
    unsigned* w = (unsigned*)&v;
#pragma unroll
    for (int i = 0; i < 4; ++i) w[i] = pk2(__uint_as_float(w[i] << 16) * sc, __uint_as_float(w[i] & 0xffff0000u) * sc);
}
typedef short v4i16_a __attribute__((ext_vector_type(4)));
DI void attn_item(const Params& P, LAS unsigned char* lds, int j, int item, int wv) {
    const int tid = get_tid(wv), lane = tid & 63, wave = tid >> 6, r = lane & 31, h = lane >> 5;
    const bool is_lat = item < 512;
    int b, qb, kvh;
    if (is_lat) { if (item < 64) { b = item >> 3; qb = ((item >> 2) & 1) ? 15 : 0; kvh = item & 3; } else { const int s2 = item - 64, rem = s2 % 56; b = s2 / 56; qb = 1 + (rem >> 2); kvh = rem & 3; } }
    else { const int it = item - 512; b = it >> 3; qb = (it >> 2) & 1; kvh = it & 3; }
    bf16_t* p = (bf16_t*)(P.ws + WS_P);
    const float* cos_t = (const float*)(P.ws + WS_ROPE); const float* sin_t = cos_t + SEQ * 32;
    LAS unsigned char* QL = lds + 36864 + wave * 9216;
    TP_START(1, lds, tid);
    const int hq = 4 * kvh + (wave & 3), ql0 = qb * 128 + 64 * (wave >> 2);
    const size_t rowbase = (size_t)b * LT + (is_lat ? CTXL : 0);
    const int w_lo = (is_lat && qb == 0) ? 2 : 0, w_hi = (is_lat && qb == 15) ? 3 : 5;
    const int nT = is_lat ? 4 + (w_hi - w_lo + 1) : 4;
    const float SC = 0.125f * LOG2E, NEG = -1e30f;
    const int key = tid >> 3, chn = tid & 7;
    u32x4 kA, vA, kB, vB; f32x4 cA, sA, cB, sB;
#define ATT_K0(t) ((t) < 4 ? 64 * (t) : qb * 128 - 128 + 64 * (w_lo + (t) - 4))
#define ATT_LOAD(t, kreg, vreg, creg, sreg) do { const bool win_ = (t) >= 4; const int k0_ = ATT_K0(t); \
        const bf16_t* kp_ = p + ((size_t)b * LT + (win_ ? CTXL : 0) + k0_ + key) * EVEN_IN + 1024 + kvh * 64 + 8 * chn; \
        kreg = *(const u32x4*)kp_; vreg = *(const u32x4*)(kp_ + 256); \
        if (win_) { creg = *(const f32x4*)(cos_t + (k0_ + key) * 32 + 4 * chn); sreg = *(const f32x4*)(sin_t + (k0_ + key) * 32 + 4 * chn); } } while (0)
#define ATT_STORE(t, buf, kreg, vreg, creg, sreg) do { const bool win_ = (t) >= 4; \
        if (win_) rope8v(kreg, creg, sreg); \
        *(LAS u32x4*)(lds + (buf) * 18432 + key * 144 + chn * 16) = kreg; *(LAS u32x4*)(lds + (buf) * 18432 + 9216 + key * 144 + chn * 16) = vreg; } while (0)
    ATT_LOAD(0, kA, vA, cA, sA);
    if (1 < nT) ATT_LOAD(1, kB, vB, cB, sB);
    const float sink2 = P.ev_sink[j * 16 + hq] * LOG2E;
    {
        const int chq = lane & 7;
#pragma unroll
        for (int hf = 0; hf < 2; ++hf) {
            u32x4 qv[4]; f32x4 qc[4], qs[4];
#pragma unroll
            for (int k = 0; k < 4; ++k) {
                const int row = (lane >> 3) + 8 * (4 * hf + k), qi = ql0 + row;
                qv[k] = *(const u32x4*)(p + (rowbase + qi) * EVEN_IN + 2560 + hq * 64 + 8 * chq);
                if (is_lat) { qc[k] = *(const f32x4*)(cos_t + qi * 32 + 4 * chq); qs[k] = *(const f32x4*)(sin_t + qi * 32 + 4 * chq); }
            }
            asm volatile("" ::: "memory");
#pragma unroll
            for (int k = 0; k < 4; ++k) {
                const int row = (lane >> 3) + 8 * (4 * hf + k);
                if (is_lat) rope8v(qv[k], qc[k] * (0.125f * LOG2E), qs[k] * (0.125f * LOG2E)); else scale8(qv[k], 0.125f * LOG2E);
                *(LAS u32x4*)(QL + row * 144 + chq * 16) = qv[k];
            }
        }
    }
    float mrun[2] = {sink2, sink2}, lrun[2] = {h == 0 ? 1.f : 0.f, h == 0 ? 1.f : 0.f};
    f32x16 O[2][2];
#pragma unroll
    for (int a = 0; a < 2; ++a)
#pragma unroll
        for (int c = 0; c < 2; ++c)
#pragma unroll
            for (int i = 0; i < 16; ++i) O[a][c][i] = 0.f;
    TP_START(2, lds, tid);
    auto tile = [&](const int t) {
        TP_START(3, lds, tid);
        const bool win = t >= 4;
        const int k0 = ATT_K0(t);
        const int dq = k0 - ql0;
        if (win && (dq >= 192 || dq <= -192)) { TP_STOP(3, lds, tid); return; }
        const bool need_mask = win && (dq >= 128 || dq <= -128);
        const LAS unsigned char* KL = lds + (t & 1) * 18432;
        const LAS bf16_t* VL = (const LAS bf16_t*)(lds + (t & 1) * 18432 + 9216);
        f32x16 sq0[2], sq1[2];
#pragma unroll
        for (int qt = 0; qt < 2; ++qt) {
            f32x16 s0, s1;
            { const float nm = -mrun[qt];
#pragma unroll
              for (int i = 0; i < 16; ++i) { s0[i] = nm; s1[i] = nm; } }
#pragma unroll
            for (int ks = 0; ks < 4; ++ks) {
                const bf16x8 qfr = *(const LAS bf16x8*)(QL + (32 * qt + r) * 144 + (16 * ks + 8 * h) * 2);
                const bf16x8 k0f = *(const LAS bf16x8*)(KL + r * 144 + (16 * ks + 8 * h) * 2), k1f = *(const LAS bf16x8*)(KL + (32 + r) * 144 + (16 * ks + 8 * h) * 2);
                s0 = MFMA32(k0f, qfr, s0); s1 = MFMA32(k1f, qfr, s1);
            }
            sq0[qt] = s0; sq1[qt] = s1;
        }
        __builtin_amdgcn_sched_barrier(0);
#pragma unroll
        for (int qt = 0; qt < 2; ++qt) {
            f32x16 s0 = sq0[qt], s1 = sq1[qt];
            const int qpos = ql0 + 32 * qt + r;
            if (need_mask) {
#pragma unroll
                for (int i = 0; i < 16; ++i) {
                    const int d0 = qpos - (k0 + crow(i, h)), d1 = d0 - 32;
                    if (d0 > 128 || d0 < -128) s0[i] = NEG;
                    if (d1 > 128 || d1 < -128) s1[i] = NEG;
                }
            }
            float mx = NEG;
#pragma unroll
            for (int i = 0; i < 16; ++i) mx = fmaxf(mx, fmaxf(s0[i], s1[i]));
            mx = fmaxf(mx, shfl_xor_f(mx, 32));
            if (__any(mx > 6.0f)) {
                const float shift = fmaxf(mx, 0.f), alpha = __builtin_amdgcn_exp2f(-shift);
                mrun[qt] += shift; lrun[qt] *= alpha;
#pragma unroll
                for (int i = 0; i < 16; ++i) { s0[i] -= shift; s1[i] -= shift; }
#pragma unroll
                for (int dt = 0; dt < 2; ++dt)
#pragma unroll
                    for (int i = 0; i < 16; ++i) O[dt][qt][i] *= alpha;
            }
            float ls = 0.f;
#pragma unroll
            for (int i = 0; i < 16; ++i) { s0[i] = __builtin_amdgcn_exp2f(s0[i]); s1[i] = __builtin_amdgcn_exp2f(s1[i]); ls += s0[i] + s1[i]; }
            lrun[qt] += ls;
            bf16x8 pf[2][2];
#pragma unroll
            for (int s = 0; s < 2; ++s) {
                u32x4 a, c;
                a.x = pk2(s0[8 * s + 0], s0[8 * s + 1]); a.y = pk2(s0[8 * s + 2], s0[8 * s + 3]); a.z = pk2(s0[8 * s + 4], s0[8 * s + 5]); a.w = pk2(s0[8 * s + 6], s0[8 * s + 7]);
                c.x = pk2(s1[8 * s + 0], s1[8 * s + 1]); c.y = pk2(s1[8 * s + 2], s1[8 * s + 3]); c.z = pk2(s1[8 * s + 4], s1[8 * s + 5]); c.w = pk2(s1[8 * s + 6], s1[8 * s + 7]);
                pf[0][s] = __builtin_bit_cast(bf16x8, a); pf[1][s] = __builtin_bit_cast(bf16x8, c);
            }
            const int gq = (lane >> 4) & 1, qq4 = (lane & 15) >> 2, pp4 = lane & 3;
#pragma unroll
            for (int dt = 0; dt < 2; ++dt)
#pragma unroll
                for (int kt = 0; kt < 2; ++kt)
#pragma unroll
                    for (int s = 0; s < 2; ++s) {
                        const LAS bf16_t* vp = VL + (32 * kt + 16 * s + 4 * h + qq4) * 72 + 32 * dt + 16 * gq + 4 * pp4;
                        const v4i16_a lo = __builtin_amdgcn_ds_read_tr16_b64_v4i16((LAS v4i16_a*)vp);
                        const v4i16_a hi = __builtin_amdgcn_ds_read_tr16_b64_v4i16((LAS v4i16_a*)(vp + 8 * 72));
                        const bf16x8 vf = {lo[0], lo[1], lo[2], lo[3], hi[0], hi[1], hi[2], hi[3]};
                        O[dt][qt] = MFMA32(vf, pf[kt][s], O[dt][qt]);
                    }
            __builtin_amdgcn_sched_barrier(0);
        }
        TP_STOP(3, lds, tid);
    };
    ATT_STORE(0, 0, kA, vA, cA, sA);
    if (2 < nT) ATT_LOAD(2, kA, vA, cA, sA);
#pragma unroll 1
    for (int t = 0; t < nT; t += 2) {
        TP_START(4, lds, tid);
        __syncthreads();
        TP_STOP(4, lds, tid);
        if (t + 1 < nT) { ATT_STORE(t + 1, 1, kB, vB, cB, sB); if (t + 3 < nT) ATT_LOAD(t + 3, kB, vB, cB, sB); }
        tile(t);
        if (t + 1 < nT) {
            TP_START(4, lds, tid);
            __syncthreads();
            TP_STOP(4, lds, tid);
            if (t + 2 < nT) { ATT_STORE(t + 2, 0, kA, vA, cA, sA); if (t + 4 < nT) ATT_LOAD(t + 4, kA, vA, cA, sA); }
            tile(t + 1);
        }
    }
    TP_STOP(2, lds, tid);
#undef ATT_K0
#undef ATT_LOAD
#undef ATT_STORE
    {
        const int chq = lane & 7;
        u32x4 gate[8];
#pragma unroll
        for (int k = 0; k < 8; ++k) gate[k] = *(const u32x4*)(p + (rowbase + ql0 + (lane >> 3) + 8 * k) * EVEN_IN + 3584 + hq * 64 + 8 * chq);
#pragma unroll
        for (int qt = 0; qt < 2; ++qt) {
            const float lt = lrun[qt] + shfl_xor_f(lrun[qt], 32), inv = __builtin_amdgcn_rcpf(lt);
#pragma unroll
            for (int dt = 0; dt < 2; ++dt)
#pragma unroll
                for (int i4 = 0; i4 < 4; ++i4) {
                    u32x2 o; o.x = pk2(O[dt][qt][4 * i4 + 0] * inv, O[dt][qt][4 * i4 + 1] * inv); o.y = pk2(O[dt][qt][4 * i4 + 2] * inv, O[dt][qt][4 * i4 + 3] * inv);
                    *(LAS u32x2*)(QL + (32 * qt + r) * 144 + (32 * dt + 8 * i4 + 4 * h) * 2) = o;
                }
        }
#pragma unroll
        for (int k = 0; k < 8; ++k) {
            const int row = (lane >> 3) + 8 * k;
            const u32x4 ov = *(const LAS u32x4*)(QL + row * 144 + chq * 16);
            const unsigned* ow = (const unsigned*)&ov; const unsigned* gw = (const unsigned*)&gate[k];
            u32x4 res; unsigned* rw = (unsigned*)&res;
#pragma unroll
            for (int e = 0; e < 4; ++e) {
                const float g0 = __uint_as_float(gw[e] << 16), g1 = __uint_as_float(gw[e] & 0xffff0000u);
                rw[e] = pk2(__uint_as_float(ow[e] << 16) * g0 * sigm(g0), __uint_as_float(ow[e] & 0xffff0000u) * g1 * sigm(g1));
            }
            *(u32x4*)(p + (rowbase + ql0 + row) * EVEN_IN + 2560 + hq * 64 + 8 * chq) = res;
        }
    }
    if (nT & 1) __syncthreads();
    TP_STOP(1, lds, tid);
}

constexpr int G2_QX = 0, G2_KF = 17408, G2_K2 = 60928, G2_VS = 79360, G2_AM = 96768, G2_ST = 105984, G2_PS = 140800, G2_BL = 144896, G2_Q1 = 145408, G2_END = 162816;
static_assert(G2_END <= LDS_BYTES - 256, "GLA LDS map");
typedef short v4i16_t __attribute__((ext_vector_type(4)));
DI bf16x8 frag_tr(const LAS bf16_t* M, int stride, int k0, int n0, int lane) {
    const int i = lane & 15, g = lane >> 4, q = i >> 2, pp = i & 3;
    const LAS bf16_t* a0 = M + (k0 + 8 * g + q) * stride + n0 + 4 * pp;
    const v4i16_t lo = __builtin_amdgcn_ds_read_tr16_b64_v4i16((LAS v4i16_t*)a0);
    const v4i16_t hi = __builtin_amdgcn_ds_read_tr16_b64_v4i16((LAS v4i16_t*)(a0 + 4 * stride));
    return (bf16x8){lo[0], lo[1], lo[2], lo[3], hi[0], hi[1], hi[2], hi[3]};
}

#ifndef GLA_SPLIT
#define GLA_SPLIT 22
#endif
DI void gla_so_stage1(const unsigned (&z)[8], const float (&lbv)[2], float (&el)[8][2], float (&kk)[8][2], LAS float* PS, int tg, int d0) {
    float run0 = 1.f, run1 = 1.f;
#pragma unroll
    for (int s = 0; s < 8; ++s) {
        const float z0 = __uint_as_float(z[s] << 16), z1 = __uint_as_float(z[s] & 0xffff0000u);
        const float t0 = __expf(-z0), t1 = __expf(-z1), sg0 = __builtin_amdgcn_rcpf(1.f + t0), sg1 = __builtin_amdgcn_rcpf(1.f + t1);
        const float f0 = fmaxf(lbv[0] + (1.f - lbv[0]) * sg0, 1e-30f), f1 = fmaxf(lbv[1] + (1.f - lbv[1]) * sg1, 1e-30f);
        kk[s][0] = (1.f - lbv[0]) * (t0 * sg0); kk[s][1] = (1.f - lbv[1]) * (t1 * sg1);
        run0 = fmaxf(run0 * f0, 1e-35f); run1 = fmaxf(run1 * f1, 1e-35f); el[s][0] = run0; el[s][1] = run1;
    }
    *(LAS f32x2*)(PS + tg * 128 + d0) = (f32x2){run0, run1};
}
DI void gla_so_stage2(const float (&el)[8][2], const float (&kk)[8][2], const LAS float* PS, LAS bf16_t* K2, LAS float* BL, int tg, int d0) {
    const int I = tg >> 1, half = tg & 1;
    float T[8][2];
#pragma unroll
    for (int q8 = 0; q8 < 8; ++q8) { const f32x2 t = *(const LAS f32x2*)(PS + q8 * 128 + d0); T[q8][0] = t[0]; T[q8][1] = t[1]; }
    float pre[2], f4[2];
#pragma unroll
    for (int x = 0; x < 2; ++x) {
        const float P0 = T[0][x] * T[1][x], P1 = T[2][x] * T[3][x], P2 = T[4][x] * T[5][x], P3 = T[6][x] * T[7][x];
        pre[x] = half ? (I == 0 ? T[0][x] : (I == 1 ? T[2][x] : (I == 2 ? T[4][x] : T[6][x]))) : 1.f;
        f4[x] = I == 0 ? P0 * P1 * P2 * P3 : (I == 1 ? P1 * P2 * P3 : (I == 2 ? P2 * P3 : P3));
        if (tg == 0) BL[d0 + x] = P0 * P1 * P2 * P3;
    }
    float k2a[8], k2b[8];
#pragma unroll
    for (int s = 0; s < 8; ++s) {
        const float e00 = fmaxf(pre[0] * el[s][0], 1e-35f), e01 = fmaxf(pre[1] * el[s][1], 1e-35f);
        k2a[s] = kk[s][0] * __builtin_amdgcn_rcpf(e00) * f4[0]; k2b[s] = kk[s][1] * __builtin_amdgcn_rcpf(e01) * f4[1];
    }
    *(LAS u32x4*)(K2 + (d0 + 0) * 72 + 8 * tg) = (u32x4){pk2(k2a[0], k2a[1]), pk2(k2a[2], k2a[3]), pk2(k2a[4], k2a[5]), pk2(k2a[6], k2a[7])};
    *(LAS u32x4*)(K2 + (d0 + 1) * 72 + 8 * tg) = (u32x4){pk2(k2b[0], k2b[1]), pk2(k2b[2], k2b[3]), pk2(k2b[4], k2b[5]), pk2(k2b[6], k2b[7])};
}

template <int DIR>
DI void gla2_item(const Params& P, LAS unsigned char* lds, int layer_j, int b, int hd, int part, int wv) {
    const int tid = get_tid(wv), lane = tid & 63, wave = tid >> 6, r = lane & 15, g = lane >> 4;
    bf16_t* p = (bf16_t*)(P.ws + WS_P);
    LAS bf16_t* QX = (LAS bf16_t*)(lds + G2_QX); LAS bf16_t* KF = (LAS bf16_t*)(lds + G2_KF); LAS bf16_t* K2 = (LAS bf16_t*)(lds + G2_K2);
    LAS bf16_t* VS = (LAS bf16_t*)(lds + G2_VS); LAS bf16_t* AM = (LAS bf16_t*)(lds + G2_AM); LAS bf16_t* ST = (LAS bf16_t*)(lds + G2_ST);
    LAS float* PS8 = (LAS float*)(lds + G2_PS); LAS float* BLAST = (LAS float*)(lds + G2_BL); LAS bf16_t* Q1 = (LAS bf16_t*)(lds + G2_Q1);
    const int d0 = 2 * lane, tg = wave, I = tg >> 1, half = tg & 1;
    float lbv[2] = {0.f, 0.f};
    if (layer_j > 0) { lbv[0] = sigm(P.od_lb_raw[1024 + hd * 128 + d0] - P.od_lb_raw[hd * 128 + d0]); lbv[1] = sigm(P.od_lb_raw[1024 + hd * 128 + d0 + 1] - P.od_lb_raw[hd * 128 + d0 + 1]); }
    unsigned* prog = (unsigned*)(P.ws + WS_CTL) + 10240 + ((layer_j * 128 + b * 16 + hd * 2 + DIR) * 8);
    const int step_end = part == 0 ? GLA_SPLIT : NCHUNK;
    TP_START(20, lds, tid);
    for (int i = tid; i < (9216 + 34816) / 4; i += 512) ((LAS unsigned*)(lds + G2_AM))[i] = 0u;
    f32x4 st[8];
#pragma unroll
    for (int e = 0; e < 8; ++e) st[e] = (f32x4){0.f, 0.f, 0.f, 0.f};
    unsigned zn[8], qn[8]; u32x4 vn[2];
    int step0 = 0;
    unsigned seen = 0u;
#define G2_OFFZ(s) ((unsigned)((DIR == 0 ? 8 * tg + (s) : 63 - 8 * tg - (s)) * ODD_IN + d0) * 2u)
#define G2_OFFV(rep) ((unsigned)((DIR == 0 ? ((tid + (rep) * 512) >> 4) : 63 - ((tid + (rep) * 512) >> 4)) * ODD_IN + 8 * ((tid + (rep) * 512) & 15)) * 2u)
    const size_t colz = (size_t)DIR * 1024 + hd * 128, colq = 3072 + hd * 128, colv = 2048 + hd * 128;
#define G2_CHUNK(st_) (DIR == 0 ? (st_) : ((st_) < 4 ? 3 - (st_) : 39 - (st_)))
    const int so_end = part == 1 ? GLA_SPLIT : (layer_j == 1 ? 4 : 0);
    if (so_end > 0) {
        LAS bf16_t* VSb = (LAS bf16_t*)(lds + G2_QX); LAS bf16_t* K2b = (LAS bf16_t*)(lds + G2_KF);
        LAS float* PSb = (LAS float*)(lds + G2_KF + 18432); LAS float* BLb = (LAS float*)(lds + G2_KF + 18432 + 4096);
        unsigned za[8], zb[8]; u32x4 va[2], vb[2];
#define G2_LOADZV(zdst, vdst, st_) do { const char* slab_ = (const char*)(p + ((size_t)b * LT + (size_t)G2_CHUNK(st_) * 64) * ODD_IN); \
            _Pragma("unroll") for (int s = 0; s < 8; ++s) (zdst)[s] = *(const unsigned*)(slab_ + colz * 2 + G2_OFFZ(s)); \
            _Pragma("unroll") for (int rep = 0; rep < 2; ++rep) (vdst)[rep] = *(const u32x4*)(slab_ + colv * 2 + G2_OFFV(rep)); } while (0)
        G2_LOADZV(za, va, 0); G2_LOADZV(zb, vb, 1);
        __syncthreads();
#pragma unroll 1
        for (int sp = 0; sp < so_end; sp += 2) {
            float ela[8][2], kka[8][2], elb[8][2], kkb[8][2];
            gla_so_stage1(za, lbv, ela, kka, PS8, tg, d0); gla_so_stage1(zb, lbv, elb, kkb, PSb, tg, d0);
#pragma unroll
            for (int rep = 0; rep < 2; ++rep) { const int idx = tid + rep * 512, tau = idx >> 4, chn = idx & 15; *(LAS u32x4*)(VS + tau * 136 + 8 * chn) = va[rep]; *(LAS u32x4*)(VSb + tau * 136 + 8 * chn) = vb[rep]; }
            __syncthreads();
            if (part == 1 && tid == 0) __hip_atomic_store(prog, (unsigned)(sp + 2), __ATOMIC_RELAXED, __HIP_MEMORY_SCOPE_AGENT);
            if (sp + 2 < so_end) { G2_LOADZV(za, va, sp + 2); G2_LOADZV(zb, vb, sp + 3); }
            gla_so_stage2(ela, kka, PS8, K2, BLAST, tg, d0); gla_so_stage2(elb, kkb, PSb, K2b, BLb, tg, d0);
            __syncthreads();
#pragma unroll
            for (int two = 0; two < 2; ++two) {
                const LAS bf16_t* K2x = two ? K2b : K2; const LAS bf16_t* VSx = two ? VSb : VS; const LAS float* BLx = two ? BLb : BLAST;
                float bl[4];
#pragma unroll
                for (int i = 0; i < 4; ++i) bl[i] = BLx[16 * wave + 4 * g + i];
                bf16x8 ak[2];
#pragma unroll
                for (int ks = 0; ks < 2; ++ks) ak[ks] = *(const LAS bf16x8*)(K2x + (16 * wave + r) * 72 + 32 * ks + 8 * g);
#pragma unroll
                for (int et = 0; et < 8; ++et) {
#pragma unroll
                    for (int i = 0; i < 4; ++i) st[et][i] *= bl[i];
#pragma unroll
                    for (int ks = 0; ks < 2; ++ks) st[et] = MFMA16(ak[ks], frag_tr(VSx, 136, 32 * ks, 16 * et, lane), st[et]);
                    if (et & 1) __builtin_amdgcn_sched_barrier(0);
                }
            }
            __syncthreads();
        }
#undef G2_LOADZV
#pragma unroll
        for (int et = 0; et < 8; ++et) { u32x2 w; w.x = pk2(st[et][0], st[et][1]); w.y = pk2(st[et][2], st[et][3]); *(LAS u32x2*)(ST + (16 * et + r) * 136 + 16 * wave + 4 * g) = w; }
        step0 = so_end;
    }
    {
        const char* slab = (const char*)(p + ((size_t)b * LT + (size_t)G2_CHUNK(step0) * 64) * ODD_IN);
#pragma unroll
        for (int s = 0; s < 8; ++s) { zn[s] = *(const unsigned*)(slab + colz * 2 + G2_OFFZ(s)); qn[s] = *(const unsigned*)(slab + colq * 2 + G2_OFFZ(s)); }
#pragma unroll
        for (int rep = 0; rep < 2; ++rep) vn[rep] = *(const u32x4*)(slab + colv * 2 + G2_OFFV(rep));
    }
    __syncthreads();
#pragma unroll 1
    for (int step = step0; step < step_end; ++step) {
        const bool sonly = false;
        const int chunk = DIR == 0 ? step : (step < 4 ? 3 - step : 39 - step);
        const size_t Rc0 = (size_t)b * LT + (size_t)chunk * 64;
        unsigned zc[8], qc[8]; u32x4 vc[2];
#pragma unroll
        for (int s = 0; s < 8; ++s) { zc[s] = zn[s]; qc[s] = qn[s]; }
        vc[0] = vn[0]; vc[1] = vn[1];
        TP_START(21, lds, tid);
        float el[8][2], kk[8][2], qq[8][2];
        {
            float run0 = 1.f, run1 = 1.f;
#pragma unroll
            for (int s = 0; s < 8; ++s) {
                const float z0 = __uint_as_float(zc[s] << 16), z1 = __uint_as_float(zc[s] & 0xffff0000u);
                const float t0 = __expf(-z0), t1 = __expf(-z1), sg0 = __builtin_amdgcn_rcpf(1.f + t0), sg1 = __builtin_amdgcn_rcpf(1.f + t1);
                const float f0 = fmaxf(lbv[0] + (1.f - lbv[0]) * sg0, 1e-30f), f1 = fmaxf(lbv[1] + (1.f - lbv[1]) * sg1, 1e-30f);
                kk[s][0] = (1.f - lbv[0]) * (t0 * sg0); kk[s][1] = (1.f - lbv[1]) * (t1 * sg1);
                run0 = fmaxf(run0 * f0, 1e-35f); run1 = fmaxf(run1 * f1, 1e-35f); el[s][0] = run0; el[s][1] = run1;
                if (!sonly) {
                const float q0 = __uint_as_float(qc[s] << 16), q1 = __uint_as_float(qc[s] & 0xffff0000u);
                qq[s][0] = q0 * __builtin_amdgcn_rcpf(1.f + __expf(-q0)); qq[s][1] = q1 * __builtin_amdgcn_rcpf(1.f + __expf(-q1));
                } else { qq[s][0] = 0.f; qq[s][1] = 0.f; }
                if ((s & 1) == 1) __builtin_amdgcn_sched_barrier(0);
            }
            *(LAS f32x2*)(PS8 + tg * 128 + d0) = (f32x2){run0, run1};
#pragma unroll
            for (int rep = 0; rep < 2; ++rep) { const int idx = tid + rep * 512, tau = idx >> 4, chn = idx & 15; *(LAS u32x4*)(VS + tau * 136 + 8 * chn) = vc[rep]; }
        }
        __syncthreads();
        if (part == 1 && step < GLA_SPLIT && tid == 0) __hip_atomic_store(prog, (unsigned)(step + 1), __ATOMIC_RELAXED, __HIP_MEMORY_SCOPE_AGENT);
        TP_STOP(21, lds, tid); TP_START(22, lds, tid);
        float RI[2];
        {
            float T[8][2];
#pragma unroll
            for (int q8 = 0; q8 < 8; ++q8) { const f32x2 t = *(const LAS f32x2*)(PS8 + q8 * 128 + d0); T[q8][0] = t[0]; T[q8][1] = t[1]; }
            float pre[2], fac[4][2], f4[2];
#pragma unroll
            for (int x = 0; x < 2; ++x) {
                const float P0 = T[0][x] * T[1][x], P1 = T[2][x] * T[3][x], P2 = T[4][x] * T[5][x], P3 = T[6][x] * T[7][x];
                pre[x] = half ? (I == 0 ? T[0][x] : (I == 1 ? T[2][x] : (I == 2 ? T[4][x] : T[6][x]))) : 1.f;
                RI[x] = I == 0 ? 1.f : (I == 1 ? P0 : (I == 2 ? P0 * P1 : P0 * P1 * P2));
                float cur = 1.f;
                fac[0][x] = cur; if (I <= 0) cur *= P0;
                fac[1][x] = cur; if (I <= 1) cur *= P1;
                fac[2][x] = cur; if (I <= 2) cur *= P2;
                fac[3][x] = cur; cur *= P3;
                f4[x] = cur;
                if (tg == 0) BLAST[d0 + x] = P0 * P1 * P2 * P3;
            }
            float k2a[8], k2b[8];
#pragma unroll
            for (int s = 0; s < 8; ++s) {
                const int tau = 8 * tg + s;
                const float e00 = fmaxf(pre[0] * el[s][0], 1e-35f), e01 = fmaxf(pre[1] * el[s][1], 1e-35f);
                const float qi0 = qq[s][0] * e00, qi1 = qq[s][1] * e01;
                const float kd0 = kk[s][0] * __builtin_amdgcn_rcpf(e00), kd1 = kk[s][1] * __builtin_amdgcn_rcpf(e01);
                if (!sonly) {
                *(LAS unsigned*)(QX + tau * 136 + d0) = pk2(qi0, qi1);
                *(LAS unsigned*)(Q1 + tau * 136 + d0) = pk2(qi0 * RI[0], qi1 * RI[1]);
                if (I <= 0) *(LAS unsigned*)(KF + (0 + tau) * 136 + d0) = pk2(kd0 * fac[0][0], kd1 * fac[0][1]);
                if (I <= 1) *(LAS unsigned*)(KF + (16 + tau) * 136 + d0) = pk2(kd0 * fac[1][0], kd1 * fac[1][1]);
                if (I <= 2) *(LAS unsigned*)(KF + (48 + tau) * 136 + d0) = pk2(kd0 * fac[2][0], kd1 * fac[2][1]);
                *(LAS unsigned*)(KF + (96 + tau) * 136 + d0) = pk2(kd0 * fac[3][0], kd1 * fac[3][1]);
                }
                k2a[s] = kd0 * f4[0]; k2b[s] = kd1 * f4[1];
                if ((s & 1) == 1) __builtin_amdgcn_sched_barrier(0);
            }
            *(LAS u32x4*)(K2 + (d0 + 0) * 72 + 8 * tg) = (u32x4){pk2(k2a[0], k2a[1]), pk2(k2a[2], k2a[3]), pk2(k2a[4], k2a[5]), pk2(k2a[6], k2a[7])};
            *(LAS u32x4*)(K2 + (d0 + 1) * 72 + 8 * tg) = (u32x4){pk2(k2b[0], k2b[1]), pk2(k2b[2], k2b[3]), pk2(k2b[4], k2b[5]), pk2(k2b[6], k2b[7])};
        }
        __syncthreads();
        TP_STOP(22, lds, tid); TP_START(23, lds, tid);
        if (step + 1 < step_end) {
            const int nchunk = DIR == 0 ? step + 1 : (step + 1 < 4 ? 2 - step : 38 - step);
            const char* slab = (const char*)(p + ((size_t)b * LT + (size_t)nchunk * 64) * ODD_IN);
#pragma unroll
            for (int s = 0; s < 8; ++s) { zn[s] = *(const unsigned*)(slab + colz * 2 + G2_OFFZ(s)); qn[s] = *(const unsigned*)(slab + colq * 2 + G2_OFFZ(s)); }
#pragma unroll
            for (int rep = 0; rep < 2; ++rep) vn[rep] = *(const u32x4*)(slab + colv * 2 + G2_OFFV(rep));
        }
#pragma unroll 1
        for (int bi = sonly ? 10 : wave; bi < 10; bi += 8) {
            const int Ib = bi < 1 ? 0 : (bi < 3 ? 1 : (bi < 6 ? 2 : 3)), Jb = bi - (Ib * (Ib + 1)) / 2;
            const int foff = Ib == 0 ? 0 : (Ib == 1 ? 16 : (Ib == 2 ? 48 : 96));
            f32x4 acc = {0.f, 0.f, 0.f, 0.f};
#pragma unroll
            for (int ks = 0; ks < 4; ++ks) {
                const bf16x8 a = *(const LAS bf16x8*)(QX + (16 * Ib + r) * 136 + 32 * ks + 8 * g);
                const bf16x8 bb = *(const LAS bf16x8*)(KF + (foff + 16 * Jb + r) * 136 + 32 * ks + 8 * g);
                acc = MFMA16(a, bb, acc);
            }
#pragma unroll
            for (int i = 0; i < 4; ++i) { float v = acc[i]; if (Jb == Ib && r > 4 * g + i) v = 0.f; AM[(16 * Ib + 4 * g + i) * 72 + 16 * Jb + r] = bf1(v); }
        }
        if (!sonly) __syncthreads();
        TP_STOP(23, lds, tid); TP_START(24, lds, tid);
        {
            if (!sonly) {
            const int tt = wave >> 1, eb = 4 * (wave & 1);
            bf16x8 aq[4], am[2];
#pragma unroll
            for (int ks = 0; ks < 4; ++ks) aq[ks] = *(const LAS bf16x8*)(Q1 + (16 * tt + r) * 136 + 32 * ks + 8 * g);
#pragma unroll
            for (int ks = 0; ks < 2; ++ks) am[ks] = *(const LAS bf16x8*)(AM + (16 * tt + r) * 72 + 32 * ks + 8 * g);
#pragma unroll
            for (int e4 = 0; e4 < 4; ++e4) {
                const int et = eb + e4;
                f32x4 acc = {0.f, 0.f, 0.f, 0.f};
#pragma unroll
                for (int ks = 0; ks < 4; ++ks) { const bf16x8 bb = *(const LAS bf16x8*)(ST + (16 * et + r) * 136 + 32 * ks + 8 * g); acc = MFMA16(aq[ks], bb, acc); }
#pragma unroll
                for (int ks = 0; ks < 2; ++ks) acc = MFMA16(am[ks], frag_tr(VS, 136, 32 * ks, 16 * et, lane), acc);
#pragma unroll
                for (int i = 0; i < 4; ++i) KF[(16 * tt + 4 * g + i) * 136 + 16 * et + r] = bf1(acc[i]);
                __builtin_amdgcn_sched_barrier(0);
            }
            }
            float bl[4];
#pragma unroll
            for (int i = 0; i < 4; ++i) bl[i] = BLAST[16 * wave + 4 * g + i];
            bf16x8 ak[2];
#pragma unroll
            for (int ks = 0; ks < 2; ++ks) ak[ks] = *(const LAS bf16x8*)(K2 + (16 * wave + r) * 72 + 32 * ks + 8 * g);
#pragma unroll
            for (int et = 0; et < 8; ++et) {
#pragma unroll
                for (int i = 0; i < 4; ++i) st[et][i] *= bl[i];
#pragma unroll
                for (int ks = 0; ks < 2; ++ks) st[et] = MFMA16(ak[ks], frag_tr(VS, 136, 32 * ks, 16 * et, lane), st[et]);
                if (et & 1) __builtin_amdgcn_sched_barrier(0);
            }
        }
        if (part == 0 && tid == 0 && seen < (unsigned)(step + 1)) {
            unsigned spins = 0;
            for (;;) { seen = __hip_atomic_load(prog, __ATOMIC_RELAXED, __HIP_MEMORY_SCOPE_AGENT); if (seen >= (unsigned)(step + 1)) break; __builtin_amdgcn_s_sleep(2); if (++spins > (1u << 22)) break; }
        }
        __syncthreads();
        TP_STOP(24, lds, tid); TP_START(25, lds, tid);
        if (!sonly) {
            char* oslab = (char*)(p + Rc0 * ODD_IN + colz);
#pragma unroll
            for (int rep = 0; rep < 2; ++rep) {
                const int idx = tid + rep * 512, tau = idx >> 4, chn = idx & 15;
                const u32x4 ov = *(const LAS u32x4*)(KF + tau * 136 + 8 * chn);
                *(u32x4*)(oslab + (unsigned)((DIR == 0 ? tau : 63 - tau) * ODD_IN + 8 * chn) * 2u) = ov;
            }
        }
        if (!sonly || step == GLA_SPLIT - 1) {
#pragma unroll
        for (int et = 0; et < 8; ++et) { u32x2 w; w.x = pk2(st[et][0], st[et][1]); w.y = pk2(st[et][2], st[et][3]); *(LAS u32x2*)(ST + (16 * et + r) * 136 + 16 * wave + 4 * g) = w; }
        }
        TP_STOP(25, lds, tid);
    }
    __syncthreads();
    TP_STOP(20, lds, tid);
}

DI void phase_readout(const Params& P, int layer_j, int wv) {
    const int tid = get_tid(wv), lane = tid & 63, wave = tid >> 6;
    const int gw = get_bid() * 8 + wave, NGW = gridDim.x * 8;
    bf16_t* p = (bf16_t*)(P.ws + WS_P);
    const float* gwt = P.od_gnorm_w + layer_j * 128 + (lane & 7) * 16;
    const bool last = layer_j == 1; const int nrows = last ? NB * SEQ : MROWS;
    auto rowR = [&](int idx) -> int { return last ? (idx >> 11) * LT + CTXL + (idx & 2047) : idx; };
    struct RoSet { u32x4 o0, o1, c0, c1, g0, g1; };
    auto ld = [&](RoSet& S, int idx) { const int R = rowR(idx);
        const bf16_t* op = p + (size_t)R * ODD_IN + 16 * lane; const bf16_t* yp = p + (size_t)R * ODD_IN + 4096 + 16 * lane;
        S.o0 = *(const u32x4*)op; S.o1 = *(const u32x4*)(op + 8); S.c0 = *(const u32x4*)(op + 1024); S.c1 = *(const u32x4*)(op + 1032); S.g0 = *(const u32x4*)yp; S.g1 = *(const u32x4*)(yp + 8); };
    auto proc = [&](const RoSet& S, int idx) {
        const int R = rowR(idx);
        bf16_t* yp = p + (size_t)R * ODD_IN + 4096 + 16 * lane;
        const u32x4 o0 = S.o0, o1 = S.o1, c0 = S.c0, c1 = S.c1, g0 = S.g0, g1 = S.g1;
        float ov[16], gv[16];
        const unsigned* ow0 = (const unsigned*)&o0; const unsigned* ow1 = (const unsigned*)&o1; const unsigned* cw0 = (const unsigned*)&c0; const unsigned* cw1 = (const unsigned*)&c1;
        const unsigned* gw0 = (const unsigned*)&g0; const unsigned* gw1 = (const unsigned*)&g1;
#pragma unroll
        for (int i = 0; i < 4; ++i) {
            ov[2 * i] = __uint_as_float(ow0[i] << 16) + __uint_as_float(cw0[i] << 16); ov[2 * i + 1] = __uint_as_float(ow0[i] & 0xffff0000u) + __uint_as_float(cw0[i] & 0xffff0000u);
            ov[8 + 2 * i] = __uint_as_float(ow1[i] << 16) + __uint_as_float(cw1[i] << 16); ov[8 + 2 * i + 1] = __uint_as_float(ow1[i] & 0xffff0000u) + __uint_as_float(cw1[i] & 0xffff0000u);
            gv[2 * i] = __uint_as_float(gw0[i] << 16); gv[2 * i + 1] = __uint_as_float(gw0[i] & 0xffff0000u); gv[8 + 2 * i] = __uint_as_float(gw1[i] << 16); gv[8 + 2 * i + 1] = __uint_as_float(gw1[i] & 0xffff0000u);
        }
        float ss = 0.f;
#pragma unroll
        for (int i = 0; i < 16; ++i) ss += ov[i] * ov[i];
        ss += shfl_xor_f(ss, 1); ss += shfl_xor_f(ss, 2); ss += shfl_xor_f(ss, 4);
        const float rstd = rsqrtf(ss * (1.f / 128.f) + RMS_EPS);
        float y[16];
#pragma unroll
        for (int i = 0; i < 16; ++i) y[i] = ov[i] * rstd * gwt[i] * (gv[i] * sigm(gv[i]));
        u32x4 w0, w1;
        w0.x = pk2(y[0], y[1]); w0.y = pk2(y[2], y[3]); w0.z = pk2(y[4], y[5]); w0.w = pk2(y[6], y[7]);
        w1.x = pk2(y[8], y[9]); w1.y = pk2(y[10], y[11]); w1.z = pk2(y[12], y[13]); w1.w = pk2(y[14], y[15]);
        *(u32x4*)yp = w0; *(u32x4*)(yp + 8) = w1;
    };
    RoSet SA, SB;
    int i = gw;
    if (i < nrows) ld(SA, i);
    while (i < nrows) {
        if (i + NGW < nrows) ld(SB, i + NGW);
        proc(SA, i);
        if (i + NGW >= nrows) break;
        if (i + 2 * NGW < nrows) ld(SA, i + 2 * NGW);
        proc(SB, i + NGW);
        i += 2 * NGW;
    }
}

DI void phase_final(const Params& P, int wv) {
    const int tid = get_tid(wv), lane = tid & 63, wave = tid >> 6;
    const int gw = get_bid() * 8 + wave, NGW = gridDim.x * 8;
    for (int R = gw; R < NB * SEQ; R += NGW) {
        float* row = P.out + (size_t)R * DM;
        f32x4 v[4]; float ss = 0.f;
#pragma unroll
        for (int q = 0; q < 4; ++q) { v[q] = *(const f32x4*)(row + 4 * lane + 256 * q); ss += (v[q][0] * v[q][0] + v[q][1] * v[q][1]) + (v[q][2] * v[q][2] + v[q][3] * v[q][3]); }
        const float rstd = rsqrtf(wave_sum(ss) * (1.f / DM) + RMS_EPS);
#pragma unroll
        for (int q = 0; q < 4; ++q) { const f32x4 w4 = *(const f32x4*)(P.final_norm_w + 4 * lane + 256 * q); *(f32x4*)(row + 4 * lane + 256 * q) = (v[q] * rstd) * w4; }
    }
}

#define XB_TMO      128
#define XB_XCNT(j)  (256  + 64 * (j))
#define XB_XSUB(j)  (1280 + 64 * (j))
#define XB_XGEN(j)  (2304 + 64 * (j))
#define XB_TOP      3328
#define XB_TOPGEN   3392
#define XCD_BAR_WORDS 3456
#define XB_SPIN_CAP (1u << 18)

__device__ __forceinline__ unsigned xb_ld(unsigned* p)              { return __hip_atomic_load(p, __ATOMIC_RELAXED, __HIP_MEMORY_SCOPE_AGENT); }
__device__ __forceinline__ unsigned xb_add(unsigned* p, unsigned v) { return __hip_atomic_fetch_add(p, v, __ATOMIC_RELAXED, __HIP_MEMORY_SCOPE_AGENT); }
__device__ __forceinline__ unsigned xb_xcc_id() { return (unsigned)__builtin_amdgcn_s_getreg((3 << 11) | 20) & 0xFu; }
#define XB_SPIN(cond, bar) do { unsigned _sp = 0; while (cond) { __builtin_amdgcn_s_sleep(1); \
    if ((++_sp & 255u) == 0u) { if (xb_ld(&(bar)[XB_TMO])) break; if (_sp > XB_SPIN_CAP) { atomicAdd(&(bar)[XB_TMO], 1u); break; } } } } while (0)

struct XcdBarrier {
    unsigned* bar; unsigned x;
    volatile LAS unsigned* st;
};

__device__ __forceinline__ XcdBarrier xcd_barrier_post(unsigned* bar, volatile LAS unsigned* st, int wv) {
    XcdBarrier b; b.bar = bar; b.x = xb_xcc_id(); b.st = st;
    if (get_tid(wv) == 0) (void)xb_add(&bar[XB_XCNT(b.x)], 1u);
    return b;
}
__device__ __forceinline__ void xcd_barrier_complete(unsigned* bar, unsigned x, unsigned& nloc, unsigned& nx) {
    const unsigned G = gridDim.x * gridDim.y * gridDim.z;
    unsigned sum, cnt, mine, sp = 0u;
    for (;;) {
        sum = 0u; cnt = 0u; mine = 0u;
#pragma unroll
        for (unsigned j = 0; j < 16; ++j) { const unsigned c = xb_ld(&bar[XB_XCNT(j)]); sum += c; cnt += (c > 0u) ? 1u : 0u; mine = (j == x) ? c : mine; }
        if (sum == G) break;
        __builtin_amdgcn_s_sleep(1);
        if ((++sp & 255u) == 0u) { if (xb_ld(&bar[XB_TMO])) break; if (sp > XB_SPIN_CAP) { atomicAdd(&bar[XB_TMO], 1u); break; } }
    }
    nloc = mine > 0u ? mine : 1u; nx = cnt > 0u ? cnt : 1u;
}

__device__ __forceinline__ void xcd_barrier(const XcdBarrier& b, int wv) {
    asm volatile("s_waitcnt vmcnt(0)" ::: "memory");
    __syncthreads();
    if (get_tid(wv) == 0) {
        unsigned* bar = b.bar;
        __builtin_amdgcn_s_waitcnt(0);
        unsigned nloc = b.st[0], nx = b.st[1];
        if (nloc == 0u) { xcd_barrier_complete(bar, b.x, nloc, nx); b.st[0] = nloc; b.st[1] = nx; }
        const unsigned old = xb_add(&bar[XB_XSUB(b.x)], 1u);
        const unsigned gen = old / nloc;
        if (old + 1u == (gen + 1u) * nloc) {
            __builtin_amdgcn_fence(__ATOMIC_RELEASE, "agent");
            asm volatile("s_waitcnt vmcnt(0)" ::: "memory");
            const unsigned og = xb_add(&bar[XB_TOP], 1u);
            const unsigned tg = og / nx;
            if (og + 1u == (tg + 1u) * nx) xb_add(&bar[XB_TOPGEN], 1u);
            else XB_SPIN(xb_ld(&bar[XB_TOPGEN]) == tg, bar);
            __builtin_amdgcn_fence(__ATOMIC_ACQUIRE, "agent");
            xb_add(&bar[XB_XGEN(b.x)], 1u);
            asm volatile("s_waitcnt vmcnt(0)" ::: "memory");
        } else {
            XB_SPIN(xb_ld(&bar[XB_XGEN(b.x)]) == gen, bar);
            __builtin_amdgcn_fence(__ATOMIC_ACQUIRE, "agent");
            asm volatile("s_waitcnt vmcnt(0)" ::: "memory");
        }
    }
    __syncthreads();
}

constexpr int PARAM_OFF = LDS_BYTES - 256;
static_assert(G2_END <= PARAM_OFF && sizeof(Params) <= 208, "LDS map");
DI const float* ld_uptr(const LAS unsigned long long* s, int i) {
    const unsigned long long v = s[i];
    const unsigned lo = __builtin_amdgcn_readfirstlane((unsigned)v), hi = __builtin_amdgcn_readfirstlane((unsigned)(v >> 32));
    return (const float*)(const __attribute__((address_space(1))) float*)(((unsigned long long)hi << 32) | lo);
}
DI Params load_params(LAS unsigned char* lds) {
    LAS unsigned char* pb = lds + PARAM_OFF; asm volatile("" : "+v"(pb));
    const LAS unsigned long long* s = (const LAS unsigned long long*)pb;
    Params Q;
    Q.x = ld_uptr(s, 0); Q.c = ld_uptr(s, 1); Q.ctx = ld_uptr(s, 2); Q.c_ctx = ld_uptr(s, 3); Q.ada_w = ld_uptr(s, 4); Q.ada_b = ld_uptr(s, 5); Q.norm_w = ld_uptr(s, 6);
    Q.ev_w_in = ld_uptr(s, 7); Q.ev_conv_w = ld_uptr(s, 8); Q.ev_conv_b = ld_uptr(s, 9); Q.ev_rg_wx = ld_uptr(s, 10); Q.ev_rg_bx = ld_uptr(s, 11); Q.ev_rg_wa = ld_uptr(s, 12);
    Q.ev_rg_ba = ld_uptr(s, 13); Q.ev_rg_lambda = ld_uptr(s, 14); Q.ev_sink = ld_uptr(s, 15); Q.ev_w_out = ld_uptr(s, 16); Q.od_w_in = ld_uptr(s, 17); Q.od_lb_raw = ld_uptr(s, 18);
    Q.od_gnorm_w = ld_uptr(s, 19); Q.od_w_out = ld_uptr(s, 20); Q.final_norm_w = ld_uptr(s, 21); Q.out = (float*)ld_uptr(s, 22); Q.ws = (unsigned char*)ld_uptr(s, 23);
    Q.ph_lo = 0; Q.ph_hi = 0;
    return Q;
}
DI void run_phase(LAS unsigned char* lds, int ph, int wv) {
    #ifndef PHMASK
#define PHMASK 0xffff
#endif
    if (ph == 0) { if (PHMASK & 1) { const Params P = load_params(lds); phase_pro(P, lds, wv, 0, 768, true); } return; }
    const int layer = (ph - 1) / 5, sub = (ph - 1) % 5, j = layer >> 1;
    const bool even = (layer & 1) == 0;
    if (sub == 0) { if (PHMASK & 4) { const Params P = load_params(lds); phase_norm(P, lds, layer, wv); } return; }
    if (sub == 1) {
        const Params P = load_params(lds); bf16_t* pbuf = (bf16_t*)(P.ws + WS_P);
        const int N = even ? EVEN_IN : ODD_IN;
        pg8::Gemm gm{(const bf16_t*)(P.ws + WS_OV), (const bf16_t*)(P.ws + WS_WIN), MROWS, N, 1024, 1024};
        pg8::StaticOrder S; S.init(MROWS, N, (int)gridDim.x, get_bid());
        EpiStoreBf16 E{pbuf, N};
        if (even) S.limit = 1280;
        if (even) {
            TP_START(51, lds, get_tid(wv));
            for (int t = get_bid(); t < 128; t += gridDim.x) {
                pg8::Unit u; S.tile_of(1280 + (t >> 3), u);
                const int m0 = 256 * u.pm + 64 * ((t & 7) >> 1), n0 = 256 * u.pn + 128 * (t & 1);
                auto epi = [&](const f32x16& acc, int row0, int col, int hh) {
#pragma unroll
                    for (int i = 0; i < 16; ++i) pbuf[(size_t)(m0 + row0 + crow(i, hh)) * N + n0 + col] = bf1(acc[i]);
                };
                mini_gemm_tile(lds, (const bf16_t*)(P.ws + WS_OV) + (size_t)m0 * 1024, 1024, (const bf16_t*)(P.ws + WS_WIN) + (size_t)n0 * 1024, 1024, epi, wv);
            }
            TP_STOP(51, lds, get_tid(wv));
        }
        TP_START(50, lds, get_tid(wv));
        if (PHMASK & 8) pg8::gemm_phase<EpiStoreBf16, pg8::StaticOrder, true, true>(lds, gm, S, E, wv);
        TP_STOP(50, lds, get_tid(wv));
        return;
    }
    if (sub == 2) {
        const Params P = load_params(lds);
        if (even) {
            constexpr int NRG = NB * NCHUNK * 8;
#if defined(SPLIT_ATTN)
#else
            {
                int it = get_bid(), k = 0;
                const int G = (int)gridDim.x;
                RgPre R;
                if (it < NRG) { rg_prefetch(P, j, it, get_tid(wv), R); rglru_item(P, lds, j, it, 0, 0, R, wv, 0); if (it + G < NRG) rg_prefetch(P, j, it + G, get_tid(wv), R); }
                for (; it < NRG; it += G, ++k) {
                    if (it + G < NRG) { rglru_item(P, lds, j, it + G, 0, (k + 1) & 1, R, wv, 1); if (it + 2 * G < NRG) rg_prefetch(P, j, it + 2 * G, get_tid(wv), R); }
                    rglru_item(P, lds, j, it, 1, k & 1, R, wv, it + G < NRG ? it + G : -1);
                }
                for (it -= NRG; it < 576; it += gridDim.x) attn_item(P, lds, j, it, wv);
            }
#endif
        } else {
            for (int it = get_bid(); it < 256; it += gridDim.x) { if (PHMASK & 64) { if (it & 2) gla2_item<1>(P, lds, j, it >> 5, (it >> 2) & 7, it & 1, wv); else gla2_item<0>(P, lds, j, it >> 5, (it >> 2) & 7, it & 1, wv); } }
        }
        return;
    }
    if (sub == 3) {
        const Params P = load_params(lds);
        if (!even) { if (PHMASK & 256) phase_readout(P, j, wv); }
#if defined(SPLIT_ATTN)
        else { for (int it = get_bid(); it < 576; it += gridDim.x) attn_item(P, lds, j, it, wv); }
#endif
        return;
    }
    {
        const Params P = load_params(lds); bf16_t* pbuf = (bf16_t*)(P.ws + WS_P);
        const int K = even ? 2048 : 1024, lda = even ? EVEN_IN : ODD_IN;
        pg8::Gemm gm{pbuf + (even ? 1536 : 4096), (const bf16_t*)(P.ws + WS_WOUT), MROWS, 1024, K, lda};
        pg8::StaticOrder S; S.init(NB * SEQ, 1024, (int)gridDim.x, get_bid(), 1);
        const float* hc = layer == 0 ? P.ctx : (const float*)(P.ws + WS_HCTX);
        const float* modb = (const float*)(P.ws + WS_MOD);
        EpiResidNorm E{layer == 0 ? P.x : nullptr, P.out, modb + (size_t)layer * 9 * 3072 + 2048, layer < 3 ? P.norm_w + (layer + 1) * 1024 : P.final_norm_w,
                       layer < 3 ? modb + (size_t)(layer + 1) * 9 * 3072 : nullptr, (bf16_t*)(P.ws + WS_OV), (float*)(P.ws + WS_AGG), (unsigned*)(P.ws + WS_CTL) + 12288 + layer * 1024};
        TP_START(30, lds, get_tid(wv));
        if (PHMASK & 512) pg8::gemm_phase<EpiResidNorm, pg8::StaticOrder, false, true>(lds, gm, S, E, wv);
        TP_STOP(30, lds, get_tid(wv)); TP_START(31, lds, get_tid(wv));
        if (layer < 3) {
            for (int t = get_bid(); t < 256; t += gridDim.x) {
                const int mt = t >> 3, nt = t & 7, mc0 = 64 * mt, bctx = mc0 >> 8, n0 = 128 * nt;
                const bf16_t* At = pbuf + ((size_t)bctx * LT + (mc0 & 255)) * lda + (even ? 1536 : 4096);
                const float* gctx = (const float*)(P.ws + WS_MOD) + (size_t)layer * 9 * 3072 + 2048 + 8 * 3072;
                float* hco = (float*)(P.ws + WS_HCTX);
                float gate = 0.f, hv[16];
                auto pre = [&](int row0, int col, int hh) {
                    gate = gctx[n0 + col];
#pragma unroll
                    for (int i = 0; i < 16; ++i) hv[i] = hc[(size_t)(mc0 + row0 + crow(i, hh)) * DM + n0 + col];
                };
                auto epi = [&](const f32x16& acc, int row0, int col, int hh) {
#pragma unroll
                    for (int i = 0; i < 16; ++i) { const size_t off = (size_t)(mc0 + row0 + crow(i, hh)) * DM + n0 + col; hco[off] = hv[i] + gate * acc[i]; }
                };
                mini_gemm_tile(lds, At, lda, (const bf16_t*)(P.ws + WS_WOUT) + (size_t)n0 * K, K, epi, wv, pre);
            }
        }
        TP_STOP(31, lds, get_tid(wv));
    }
}

#ifndef USE_CG_SYNC
#define USE_CG_SYNC 0
#endif
__global__ void __launch_bounds__(512, 2) mega(Params P) {
    extern __shared__ __attribute__((aligned(16))) unsigned char lds_raw[];
    LAS unsigned char* lds = (LAS unsigned char*)lds_raw;
    cg::grid_group grid = cg::this_grid();
    const int wv = __builtin_amdgcn_readfirstlane((int)(threadIdx.x >> 6));
    if (get_tid(wv) == 0) {
#if defined(TP_ID)
        ((LAS unsigned long long*)(lds + 163840 - 32))[0] = 0ull; ((LAS unsigned long long*)(lds + 163840 - 32))[1] = 0ull;
#endif
        ((LAS unsigned*)(lds + PARAM_OFF + 208))[0] = 0u; ((LAS unsigned*)(lds + PARAM_OFF + 208))[1] = 0u;
        LAS unsigned long long* d = (LAS unsigned long long*)(lds + PARAM_OFF);
        d[0] = (unsigned long long)P.x; d[1] = (unsigned long long)P.c; d[2] = (unsigned long long)P.ctx; d[3] = (unsigned long long)P.c_ctx; d[4] = (unsigned long long)P.ada_w;
        d[5] = (unsigned long long)P.ada_b; d[6] = (unsigned long long)P.norm_w; d[7] = (unsigned long long)P.ev_w_in; d[8] = (unsigned long long)P.ev_conv_w; d[9] = (unsigned long long)P.ev_conv_b;
        d[10] = (unsigned long long)P.ev_rg_wx; d[11] = (unsigned long long)P.ev_rg_bx; d[12] = (unsigned long long)P.ev_rg_wa; d[13] = (unsigned long long)P.ev_rg_ba; d[14] = (unsigned long long)P.ev_rg_lambda;
        d[15] = (unsigned long long)P.ev_sink; d[16] = (unsigned long long)P.ev_w_out; d[17] = (unsigned long long)P.od_w_in; d[18] = (unsigned long long)P.od_lb_raw; d[19] = (unsigned long long)P.od_gnorm_w;
        d[20] = (unsigned long long)P.od_w_out; d[21] = (unsigned long long)P.final_norm_w; d[22] = (unsigned long long)P.out; d[23] = (unsigned long long)P.ws;
    }
    __syncthreads();
    const int ph_lo = P.ph_lo, ph_hi = P.ph_hi;
    (void)xcd_barrier_post((unsigned*)(P.ws + WS_CTL) + 4096, (volatile LAS unsigned*)(lds + PARAM_OFF + 208), wv);
#define GRID_SYNC(first) do { if (USE_CG_SYNC && (first)) grid.sync(); else { XcdBarrier xb_; xb_.bar = (unsigned*)(load_params(lds).ws + WS_CTL) + 4096; xb_.x = xb_xcc_id(); xb_.st = (volatile LAS unsigned*)(lds + PARAM_OFF + 208); xcd_barrier(xb_, wv); } } while (0)
#if defined(PROBE_S)
    constexpr int PREP = PROBE_E - PROBE_S + 1;
#pragma unroll 1
    for (int seq = ph_lo; seq < ph_hi + PREP; ++seq) {
        if (seq > ph_lo) GRID_SYNC(seq == ph_lo + 1);
        const int ph = seq <= PROBE_E ? seq : seq - PREP;
        run_phase(lds, ph, wv);
    }
#else
#pragma unroll 1
    for (int ph = ph_lo; ph < ph_hi; ++ph) {
#if !defined(SPLIT_ATTN)
        if (ph >= 1 && ph < NPHASE - 1 && (ph - 1) % 5 == 3 && (((ph - 1) / 5) & 1) == 0) continue;
#endif
#if defined(TP_ID)
        const int pk_ = ph <= 1 ? 214 : ((ph - 2) % 5 == 0 ? 214 : ((ph - 2) % 5 == 1 ? 211 : ((ph - 2) % 5 == 2 ? 212 : ((ph - 2) % 5 == 3 ? 214 : 213))));
        if (pk_ == TP_ID) TP_START(TP_ID, lds, get_tid(wv));
#endif
        TP_START(200, lds, get_tid(wv));
#if defined(TP_ID)
        if (300 + ph == TP_ID) TP_START(TP_ID, lds, get_tid(wv));
#endif
        if (ph > ph_lo) GRID_SYNC(ph == ph_lo + 1);
#if defined(TP_ID)
        if (300 + ph == TP_ID) TP_STOP(TP_ID, lds, get_tid(wv));
#endif
        TP_STOP(200, lds, get_tid(wv));
#if defined(TP_ID)
        if (pk_ == TP_ID) TP_STOP(TP_ID, lds, get_tid(wv));
#endif
#if defined(TP_ID)
        const int kid_ = ph == 0 ? 207 : ((ph - 1) % 5 == 0 ? 205 : ((ph - 1) % 5 == 1 ? 201 : ((ph - 1) % 5 == 2 ? ((((ph - 1) / 5) & 1) ? 203 : 202) : ((ph - 1) % 5 == 3 ? 206 : 204))));
        if (kid_ == TP_ID) TP_START(TP_ID, lds, get_tid(wv));
#endif
        run_phase(lds, ph, wv);
#if defined(TP_ID)
        if (kid_ == TP_ID) TP_STOP(TP_ID, lds, get_tid(wv));
#endif
    }
#endif
#if defined(TP_ID)
    if (get_tid(wv) == 0 && blockIdx.x == TP_BLOCK) {
        const unsigned long long acc = ((LAS unsigned long long*)(lds + 163840 - 32))[1], t0 = __builtin_amdgcn_s_memrealtime();
        while (__builtin_amdgcn_s_memrealtime() - t0 < (unsigned long long)TP_AMP * acc) __builtin_amdgcn_s_sleep(8);
    }
#endif
}

extern "C" void kernel_launch(void* const* d_in, const int* in_sizes, int n_in, void* d_out, int out_size, void* d_ws, size_t ws_size, hipStream_t stream) {
    static int grid = 0;
    if (grid == 0) {
        if (n_in != 22 || ws_size < WS_END) { fprintf(stderr, "kernel_launch: unexpected inputs (n_in %d, ws %zu)\n", n_in, ws_size); grid = -1; return; }
        int dev = 0, cus = 0, per_cu = 0;
        hipGetDevice(&dev);
        hipDeviceGetAttribute(&cus, hipDeviceAttributeMultiprocessorCount, dev);
        if (hipFuncSetAttribute((const void*)mega, hipFuncAttributeMaxDynamicSharedMemorySize, LDS_BYTES) != hipSuccess) { fprintf(stderr, "kernel_launch: hipFuncSetAttribute failed\n"); grid = -1; return; }
        if (hipOccupancyMaxActiveBlocksPerMultiprocessor(&per_cu, (const void*)mega, 512, LDS_BYTES) != hipSuccess || per_cu < 1) { fprintf(stderr, "kernel_launch: occupancy query gives %d\n", per_cu); per_cu = 1; }
        (void)hipGetLastError();
        if (cus < 256) { fprintf(stderr, "kernel_launch: this kernel needs 256 co-resident workgroups (device reports %d CUs)\n", cus); grid = -1; return; }
        grid = 256;
    }
    if (grid < 0) return;
    if (hipMemsetAsync((char*)d_ws + WS_CTL, 0, 65536, stream) != hipSuccess) { fprintf(stderr, "kernel_launch: memset failed\n"); return; }
    Params P{};
    const float** pp = (const float**)&P;
    for (int i = 0; i < 22; ++i) pp[i] = (const float*)d_in[i];
    P.out = (float*)d_out; P.ws = (unsigned char*)d_ws;
#if ONE_LAUNCH
    P.ph_lo = 0; P.ph_hi = NPHASE;
    { void* args[] = {&P}; hipError_t e = hipLaunchCooperativeKernel((const void*)mega, dim3(grid), dim3(512), args, LDS_BYTES, stream);
      if (e != hipSuccess) fprintf(stderr, "cooperative launch failed: %s (grid %d)\n", hipGetErrorString(e), grid); }
#else
    for (int ph = 0; ph < NPHASE; ++ph) {
        P.ph_lo = ph; P.ph_hi = ph + 1;
        void* args[] = {&P}; hipError_t e = hipLaunchCooperativeKernel((const void*)mega, dim3(grid), dim3(512), args, LDS_BYTES, stream);
        if (e != hipSuccess) { fprintf(stderr, "launch %d failed: %s (grid %d)\n", ph, hipGetErrorString(e), grid); break; }
    }
#endif
}
```
